# Optimizing an MI355X kernel written in HIP

```python
import math
import jax, jax.numpy as jnp
from jax import lax
import numpy as np

D_MODEL = 1024
BATCH = 16
SEQ = 2048
DEPTH = 2

N_BRANCH = 4
HEAD_DIM = 64
BR_HEADS = 4
BR_WIDTH = BR_HEADS * HEAD_DIM
Q_BLOCK = 128
SB_HEADS = BR_HEADS
RW_HEADS = BR_HEADS
RW_N = HEAD_DIM
RW_W_LORA = 64
RW_A_LORA = 64
RW_G_LORA = 128
RW_GN_EPS = 64e-5
RW_IN_SIZES = (BR_WIDTH, BR_WIDTH, BR_WIDTH, RW_W_LORA, RW_A_LORA, RW_G_LORA)
SSD_HEADS = BR_HEADS
SSD_P = HEAD_DIM
SSD_GROUPS = 2
SSD_N = 128
SSD_CONV = 4
SSD_CHUNK = 128
SSD_XBC = BR_WIDTH + 2 * SSD_GROUPS * SSD_N
SSD_IN_SIZES = (BR_WIDTH, SSD_XBC, SSD_HEADS)
MLA_HEADS = BR_HEADS
MLA_Q_RANK = 256
MLA_KV_RANK = 128
MLA_NOPE = 64
MLA_ROPE = 32
MLA_V = 64
ROPE_BASE = 10000.0
MLA_IN_SIZES = (MLA_Q_RANK, MLA_KV_RANK, MLA_ROPE)
MIX_IN_SIZES = (3 * BR_WIDTH, sum(RW_IN_SIZES), sum(SSD_IN_SIZES), sum(MLA_IN_SIZES))
N_IN = sum(MIX_IN_SIZES)
MEM_TOKENS = 256
XA_HEADS = 4
XA_DH = D_MODEL // XA_HEADS
FFN_DENSE = 2816
N_EXPERTS = 8
TOP_K = 2
FFN_EXPERT = 3584
MOE_BLOCK = 256
N_DENSE_LAYERS = (DEPTH + 1) // 2
N_MOE_LAYERS = DEPTH // 2
DN_ALPHA = (2.0 * DEPTH) ** 0.25
DN_BETA = (8.0 * DEPTH) ** -0.25

kernel_name = "hybrid_sb_rwkv7_ssd_mla_moe_deepnorm"


def _offsets(sizes):
    return np.cumsum(sizes)[:-1].tolist()


def _layer_norm(x, g, b, eps=1e-5):
    xf = x.astype(jnp.float32)
    mu = jnp.mean(xf, axis=-1, keepdims=True)
    var = jnp.mean(jnp.square(xf - mu), axis=-1, keepdims=True)
    return ((xf - mu) * lax.rsqrt(var + eps) * g + b).astype(x.dtype)


def _rms_norm(x, g, eps=1e-6):
    xf = x.astype(jnp.float32)
    return (xf * lax.rsqrt(jnp.mean(xf * xf, axis=-1, keepdims=True) + eps) * g).astype(x.dtype)


def _rope(x, cos, sin):
    x1, x2 = jnp.split(x, 2, axis=-1)
    return jnp.concatenate([x1 * cos - x2 * sin, x1 * sin + x2 * cos], axis=-1)


def _stick_breaking_attention(q, k, v):
    s_len = q.shape[1]
    scale = HEAD_DIM ** -0.5
    outs = []
    for blk in range(s_len // Q_BLOCK):
        lo, hi = blk * Q_BLOCK, (blk + 1) * Q_BLOCK
        z = jnp.einsum("bqhd,bkhd->bhqk", q[:, lo:hi], k[:, :hi]).astype(jnp.float32) * scale
        t_pos = lo + jnp.arange(Q_BLOCK)
        s_pos = jnp.arange(hi)
        before = s_pos[None, :] < t_pos[:, None]
        log_keep = jnp.where(before, jax.nn.log_sigmoid(-z), 0.0)
        tail = lax.cumsum(log_keep, axis=3, reverse=True) - log_keep
        w = jnp.where(before, jnp.exp(jax.nn.log_sigmoid(z) + tail), 0.0)
        outs.append(jnp.einsum("bhqk,bkhd->bqhd", w.astype(v.dtype), v[:, :hi]))
    return jnp.concatenate(outs, axis=1)


def _rwkv7_scan(r, decay, k, v, kk, a):
    def step(state, inp):
        r_t, w_t, k_t, v_t, kk_t, a_t = inp
        sa = jnp.einsum("bhij,bhj->bhi", state, kk_t)
        state = (state * w_t[:, :, None, :]
                 - sa[..., None] * (kk_t * a_t)[:, :, None, :]
                 + v_t[..., None] * k_t[:, :, None, :])
        return state, jnp.einsum("bhij,bhj->bhi", state, r_t)

    xs = tuple(jnp.moveaxis(t, 1, 0) for t in (r, decay, k, v, kk, a))
    state0 = jnp.zeros((r.shape[0], RW_HEADS, RW_N, RW_N), jnp.float32)
    _, ys = lax.scan(step, state0, xs)
    return jnp.moveaxis(ys, 0, 1)


def _rwkv7_time_mix(cols, mu, w0, w_up, a0, a_up, g_up, k_k, k_a, r_k, gn_g, gn_b):
    b, s, _ = cols.shape
    p = cols.astype(jnp.float32)
    prev = jnp.pad(p, ((0, 0), (1, 0), (0, 0)))[:, :-1]
    p = p + (prev - p) * mu
    r, k, v, w_lo, a_lo, g_lo = jnp.split(p, _offsets(RW_IN_SIZES), axis=-1)
    w_log = -jax.nn.softplus(-(w0 + jnp.tanh(w_lo) @ w_up)) - 0.5
    decay = jnp.exp(-jnp.exp(w_log))
    a = jax.nn.sigmoid(a0 + a_lo @ a_up)
    g = jax.nn.sigmoid(g_lo) @ g_up
    kk = k * k_k
    k = k * (1.0 + (a - 1.0) * k_a)

    def heads(t):
        return t.reshape(b, s, RW_HEADS, RW_N)

    r, k, v, decay, a, kk = heads(r), heads(k), heads(v), heads(decay), heads(a), heads(kk)
    kk = kk * lax.rsqrt(jnp.maximum(jnp.sum(kk * kk, axis=-1, keepdims=True), 1e-24))
    y = _rwkv7_scan(r, decay, k, v, kk, a)
    y_mu = jnp.mean(y, axis=-1, keepdims=True)
    y_var = jnp.mean(jnp.square(y - y_mu), axis=-1, keepdims=True)
    y = ((y - y_mu) * lax.rsqrt(y_var + RW_GN_EPS)).reshape(b, s, BR_WIDTH) * gn_g + gn_b
    bonus = jnp.sum(r * k * r_k, axis=-1, keepdims=True) * v
    return ((y + bonus.reshape(b, s, BR_WIDTH)) * g).astype(cols.dtype)


def _segsum(v):
    t = v.shape[-1]
    rep = jnp.broadcast_to(v[..., :, None], v.shape + (t,))
    strict = jnp.tril(jnp.ones((t, t), dtype=bool), -1)
    cs = jnp.cumsum(jnp.where(strict, rep, 0.0), axis=-2)
    return jnp.where(jnp.tril(jnp.ones((t, t), dtype=bool)), cs, -jnp.inf)


def _ssd_chunked(xh, dt, a, bh, ch):
    b, s, h, p = xh.shape
    n = bh.shape[-1]
    c = s // SSD_CHUNK
    xd = (xh * dt[..., None]).reshape(b, c, SSD_CHUNK, h, p)
    bc = bh.reshape(b, c, SSD_CHUNK, h, n)
    cc = ch.reshape(b, c, SSD_CHUNK, h, n)
    a_dt = jnp.transpose((dt * a).reshape(b, c, SSD_CHUNK, h), (0, 3, 1, 2))
    a_cs = jnp.cumsum(a_dt, axis=-1)
    decay_in = jnp.exp(_segsum(a_dt))
    cb = jnp.einsum("bclhn,bcshn->bhcls", cc, bc)
    y_diag = jnp.einsum("bhcls,bcshp->bclhp", cb * decay_in, xd)
    decay_to_end = jnp.exp(a_cs[..., -1:] - a_cs)
    states = jnp.einsum("bclhn,bhcl,bclhp->bchpn", bc, decay_to_end, xd)
    states = jnp.concatenate([jnp.zeros_like(states[:, :1]), states], axis=1)
    chunk_a = jnp.pad(a_cs[..., -1], ((0, 0), (0, 0), (1, 0)))
    decay_chunk = jnp.exp(_segsum(chunk_a))
    states = jnp.einsum("bhzc,bchpn->bzhpn", decay_chunk, states)[:, :-1]
    y_off = jnp.einsum("bclhn,bchpn,bhcl->bclhp", cc, states, jnp.exp(a_cs))
    return (y_diag + y_off).reshape(b, s, h, p)


def _causal_depthwise_conv(x, w, bias):
    ch = x.shape[-1]
    y = lax.conv_general_dilated(x, w[:, None, :].astype(x.dtype), window_strides=(1,),
                                 padding=[(SSD_CONV - 1, 0)],
                                 dimension_numbers=("NWC", "WIO", "NWC"),
                                 feature_group_count=ch)
    return y + bias


def _mamba2_ssd_mix(z, xbc, dt_raw, conv_w, conv_b, dt_bias, a_log, d_skip, norm_g):
    b, s, _ = z.shape
    xbc = jax.nn.silu(_causal_depthwise_conv(xbc, conv_w, conv_b)).astype(jnp.float32)
    xs, bm, cm = jnp.split(xbc, _offsets((BR_WIDTH, SSD_GROUPS * SSD_N, SSD_GROUPS * SSD_N)), axis=-1)
    xh = xs.reshape(b, s, SSD_HEADS, SSD_P)
    rep = SSD_HEADS // SSD_GROUPS
    bh = jnp.repeat(bm.reshape(b, s, SSD_GROUPS, SSD_N), rep, axis=2)
    ch = jnp.repeat(cm.reshape(b, s, SSD_GROUPS, SSD_N), rep, axis=2)
    dt = jax.nn.softplus(dt_raw.astype(jnp.float32) + dt_bias)
    a = -jnp.exp(a_log.astype(jnp.float32))
    y = _ssd_chunked(xh, dt, a, bh, ch) + d_skip[:, None] * xh
    y = y.reshape(b, s, BR_WIDTH) * jax.nn.silu(z.astype(jnp.float32))
    yg = y.reshape(b, s, SSD_GROUPS, BR_WIDTH // SSD_GROUPS)
    yg = yg * lax.rsqrt(jnp.mean(yg * yg, axis=-1, keepdims=True) + 1e-5)
    return (yg.reshape(b, s, BR_WIDTH) * norm_g).astype(z.dtype)


def _mla_attention(q_nope, q_rope, k_nope, k_rope, v):
    s_len = q_nope.shape[1]
    scale = (MLA_NOPE + MLA_ROPE) ** -0.5
    outs = []
    for blk in range(s_len // Q_BLOCK):
        lo, hi = blk * Q_BLOCK, (blk + 1) * Q_BLOCK
        z = (jnp.einsum("bqhd,bkhd->bhqk", q_nope[:, lo:hi], k_nope[:, :hi])
             + jnp.einsum("bqhr,bkr->bhqk", q_rope[:, lo:hi], k_rope[:, :hi])).astype(jnp.float32) * scale
        causal = jnp.arange(hi)[None, :] <= (lo + jnp.arange(Q_BLOCK))[:, None]
        prob = jax.nn.softmax(jnp.where(causal, z, -jnp.inf), axis=-1)
        outs.append(jnp.einsum("bhqk,bkhd->bqhd", prob.astype(v.dtype), v[:, :hi]))
    return jnp.concatenate(outs, axis=1)


def _mla_mix(cq, ckv, kr_raw, cos, sin, q_norm_g, w_uq, kv_norm_g, w_ukv):
    b, s, _ = cq.shape
    q = (_rms_norm(cq, q_norm_g) @ w_uq).reshape(b, s, MLA_HEADS, MLA_NOPE + MLA_ROPE)
    q_nope, q_rope = q[..., :MLA_NOPE], _rope(q[..., MLA_NOPE:], cos[:, :, None, :], sin[:, :, None, :])
    kv = (_rms_norm(ckv, kv_norm_g) @ w_ukv).reshape(b, s, MLA_HEADS, MLA_NOPE + MLA_V)
    k_nope, v = kv[..., :MLA_NOPE], kv[..., MLA_NOPE:]
    k_rope = _rope(kr_raw, cos, sin)
    return _mla_attention(q_nope, q_rope, k_nope, k_rope, v).reshape(b, s, BR_WIDTH)


def _hybrid_mixer(x, cos, sin, w_in, rw_mu, rw_w0, rw_w_up, rw_a0, rw_a_up, rw_g_up, rw_k_k, rw_k_a,
                  rw_r_k, rw_gn_g, rw_gn_b, ssd_conv_w, ssd_conv_b, ssd_dt_bias, ssd_a_log, ssd_d,
                  ssd_norm_g, mla_q_norm_g, mla_w_uq, mla_kv_norm_g, mla_w_ukv, w_br_out, w_gate, w_out):
    b, s, _ = x.shape
    sb_cols, rw_cols, ssd_cols, mla_cols = jnp.split(x @ w_in, _offsets(MIX_IN_SIZES), axis=-1)
    q, k, v = (t.reshape(b, s, SB_HEADS, HEAD_DIM) for t in jnp.split(sb_cols, 3, axis=-1))
    y_sb = _stick_breaking_attention(q, k, v).reshape(b, s, BR_WIDTH)
    y_rw = _rwkv7_time_mix(rw_cols, rw_mu, rw_w0, rw_w_up, rw_a0, rw_a_up, rw_g_up, rw_k_k, rw_k_a,
                           rw_r_k, rw_gn_g, rw_gn_b)
    z, xbc, dt_raw = jnp.split(ssd_cols, _offsets(SSD_IN_SIZES), axis=-1)
    y_ssd = _mamba2_ssd_mix(z, xbc, dt_raw, ssd_conv_w, ssd_conv_b, ssd_dt_bias, ssd_a_log, ssd_d, ssd_norm_g)
    cq, ckv, kr_raw = jnp.split(mla_cols, _offsets(MLA_IN_SIZES), axis=-1)
    y_mla = _mla_mix(cq, ckv, kr_raw, cos, sin, mla_q_norm_g, mla_w_uq, mla_kv_norm_g, mla_w_ukv)
    merged = jnp.zeros_like(x)
    for i, y_br in enumerate((y_sb, y_rw, y_ssd, y_mla)):
        merged = merged + jax.nn.sigmoid(x @ w_gate[i]) * (y_br @ w_br_out[i])
    return merged @ w_out


def _memory_cross_attention(x, mem, w_q, w_kv, w_o):
    b, s, d = x.shape
    m = mem.shape[1]
    q = (x @ w_q).reshape(b, s, XA_HEADS, XA_DH)
    k, v = jnp.split(mem @ w_kv, 2, axis=-1)
    k = k.reshape(b, m, XA_HEADS, XA_DH)
    v = v.reshape(b, m, XA_HEADS, XA_DH)
    z = jnp.einsum("bshd,bmhd->bhsm", q, k).astype(jnp.float32) * (XA_DH ** -0.5)
    prob = jax.nn.softmax(z, axis=-1)
    o = jnp.einsum("bhsm,bmhd->bshd", prob.astype(v.dtype), v).reshape(b, s, d)
    return o @ w_o


def _swiglu(x, w13, w2):
    gate, up = jnp.split(x @ w13, 2, axis=-1)
    return (jax.nn.silu(gate) * up) @ w2


def _moe_swiglu(xf, router, w13, w2):
    t, d = xf.shape
    logits = (xf @ router).astype(jnp.float32)
    top_v, top_i = lax.top_k(logits, TOP_K)
    gates = jax.nn.softmax(top_v, axis=-1)
    n_assign = t * TOP_K
    e_flat = top_i.reshape(-1)
    tok_flat = jnp.repeat(jnp.arange(t, dtype=jnp.int32), TOP_K)
    w_flat = gates.reshape(-1).astype(xf.dtype)
    order = jnp.argsort(e_flat)
    e_s, tok_s, w_s = e_flat[order], tok_flat[order], w_flat[order]
    counts = jnp.bincount(e_flat, length=N_EXPERTS)
    starts = jnp.cumsum(counts) - counts
    padded = (counts + MOE_BLOCK - 1) // MOE_BLOCK * MOE_BLOCK
    p_ends = jnp.cumsum(padded)
    p_starts = p_ends - padded
    dest = p_starts[e_s] + (jnp.arange(n_assign) - starts[e_s])
    n_blocks = -(-n_assign // MOE_BLOCK) + N_EXPERTS
    n_rows = n_blocks * MOE_BLOCK
    row_tok = jnp.zeros((n_rows,), jnp.int32).at[dest].set(tok_s)
    row_w = jnp.zeros((n_rows,), xf.dtype).at[dest].set(w_s)
    block_e = jnp.minimum(jnp.searchsorted(p_ends, jnp.arange(n_blocks) * MOE_BLOCK, side="right"),
                          N_EXPERTS - 1)
    xs = xf[row_tok].reshape(n_blocks, MOE_BLOCK, d)

    def expert_block(args):
        xb, e = args
        gate, up = jnp.split(xb @ w13[e], 2, axis=-1)
        return (jax.nn.silu(gate) * up) @ w2[e]

    ys = lax.map(expert_block, (xs, block_e)).reshape(n_rows, d)
    return jnp.zeros_like(xf).at[row_tok].add(ys * row_w[:, None])


def setup_inputs(seed: int = 0) -> dict:
    key = jax.random.key(seed)
    ks = iter(jax.random.split(key, 64))
    L = DEPTH
    f32 = jnp.float32

    def nrm(shape, scale):
        return jax.random.normal(next(ks), shape, f32) * scale

    def gain(shape):
        return 1.0 + nrm(shape, 0.02)

    def unif(shape, lo, hi):
        return jax.random.uniform(next(ks), shape, f32, lo, hi)

    dt0 = jnp.exp(unif((L, SSD_HEADS), math.log(1e-3), math.log(1e-1)))
    return {
        "x": nrm((BATCH, SEQ, D_MODEL), 1.0),
        "mem": nrm((BATCH, MEM_TOKENS, D_MODEL), 1.0),
        "positions": jnp.arange(SEQ, dtype=jnp.int32)[None, :]
                     + jax.random.randint(next(ks), (BATCH, 1), 0, 4096, dtype=jnp.int32),
        "mix_w_in": nrm((L, D_MODEL, N_IN), D_MODEL ** -0.5),
        "rw_mu": unif((L, sum(RW_IN_SIZES)), 0.0, 1.0),
        "rw_w0": unif((L, BR_WIDTH), -6.0, 1.0),
        "rw_w_up": nrm((L, RW_W_LORA, BR_WIDTH), 0.5 * RW_W_LORA ** -0.5),
        "rw_a0": nrm((L, BR_WIDTH), 0.1),
        "rw_a_up": nrm((L, RW_A_LORA, BR_WIDTH), RW_A_LORA ** -0.5),
        "rw_g_up": nrm((L, RW_G_LORA, BR_WIDTH), RW_G_LORA ** -0.5),
        "rw_k_k": 0.85 + nrm((L, BR_WIDTH), 0.05),
        "rw_k_a": 1.0 + nrm((L, BR_WIDTH), 0.05),
        "rw_r_k": nrm((L, RW_HEADS, RW_N), 0.1),
        "rw_gn_g": gain((L, BR_WIDTH)),
        "rw_gn_b": nrm((L, BR_WIDTH), 0.02),
        "ssd_conv_w": nrm((L, SSD_CONV, SSD_XBC), SSD_CONV ** -0.5),
        "ssd_conv_b": nrm((L, SSD_XBC), 0.02),
        "ssd_dt_bias": dt0 + jnp.log(-jnp.expm1(-dt0)),
        "ssd_a_log": jnp.log(unif((L, SSD_HEADS), 1.0, 16.0)),
        "ssd_d": 1.0 + nrm((L, SSD_HEADS), 0.1),
        "ssd_norm_g": gain((L, BR_WIDTH)),
        "mla_q_norm_g": gain((L, MLA_Q_RANK)),
        "mla_w_uq": nrm((L, MLA_Q_RANK, MLA_HEADS * (MLA_NOPE + MLA_ROPE)), MLA_Q_RANK ** -0.5),
        "mla_kv_norm_g": gain((L, MLA_KV_RANK)),
        "mla_w_ukv": nrm((L, MLA_KV_RANK, MLA_HEADS * (MLA_NOPE + MLA_V)), MLA_KV_RANK ** -0.5),
        "mix_w_br_out": nrm((L, N_BRANCH, BR_WIDTH, D_MODEL), BR_WIDTH ** -0.5),
        "mix_w_gate": nrm((L, N_BRANCH, D_MODEL, D_MODEL), D_MODEL ** -0.5),
        "mix_w_out": nrm((L, D_MODEL, D_MODEL), DN_BETA * D_MODEL ** -0.5),
        "ln1_g": gain((L, D_MODEL)),
        "ln1_b": nrm((L, D_MODEL), 0.02),
        "xa_w_q": nrm((L, D_MODEL, D_MODEL), D_MODEL ** -0.5),
        "xa_w_kv": nrm((L, D_MODEL, 2 * D_MODEL), D_MODEL ** -0.5),
        "xa_w_o": nrm((L, D_MODEL, D_MODEL), DN_BETA * D_MODEL ** -0.5),
        "ln2_g": gain((L, D_MODEL)),
        "ln2_b": nrm((L, D_MODEL), 0.02),
        "ffn_w13": nrm((N_DENSE_LAYERS, D_MODEL, 2 * FFN_DENSE), D_MODEL ** -0.5),
        "ffn_w2": nrm((N_DENSE_LAYERS, FFN_DENSE, D_MODEL), DN_BETA * FFN_DENSE ** -0.5),
        "moe_router": nrm((N_MOE_LAYERS, D_MODEL, N_EXPERTS), D_MODEL ** -0.5),
        "moe_w13": nrm((N_MOE_LAYERS, N_EXPERTS, D_MODEL, 2 * FFN_EXPERT), D_MODEL ** -0.5),
        "moe_w2": nrm((N_MOE_LAYERS, N_EXPERTS, FFN_EXPERT, D_MODEL), DN_BETA * FFN_EXPERT ** -0.5),
        "ln3_g": gain((L, D_MODEL)),
        "ln3_b": nrm((L, D_MODEL), 0.02),
    }


def reference(x, mem, positions, mix_w_in, rw_mu, rw_w0, rw_w_up, rw_a0, rw_a_up, rw_g_up, rw_k_k, rw_k_a,
              rw_r_k, rw_gn_g, rw_gn_b, ssd_conv_w, ssd_conv_b, ssd_dt_bias, ssd_a_log, ssd_d, ssd_norm_g,
              mla_q_norm_g, mla_w_uq, mla_kv_norm_g, mla_w_ukv, mix_w_br_out, mix_w_gate, mix_w_out,
              ln1_g, ln1_b, xa_w_q, xa_w_kv, xa_w_o, ln2_g, ln2_b, ffn_w13, ffn_w2, moe_router, moe_w13,
              moe_w2, ln3_g, ln3_b):
    inv_freq = ROPE_BASE ** (-jnp.arange(0, MLA_ROPE, 2, dtype=jnp.float32) / MLA_ROPE)
    ang = positions.astype(jnp.float32)[..., None] * inv_freq
    cos, sin = jnp.cos(ang).astype(x.dtype), jnp.sin(ang).astype(x.dtype)
    for l in range(DEPTH):
        mix = _hybrid_mixer(x, cos, sin, mix_w_in[l], rw_mu[l], rw_w0[l], rw_w_up[l], rw_a0[l], rw_a_up[l],
                            rw_g_up[l], rw_k_k[l], rw_k_a[l], rw_r_k[l], rw_gn_g[l], rw_gn_b[l],
                            ssd_conv_w[l], ssd_conv_b[l], ssd_dt_bias[l], ssd_a_log[l], ssd_d[l],
                            ssd_norm_g[l], mla_q_norm_g[l], mla_w_uq[l], mla_kv_norm_g[l], mla_w_ukv[l],
                            mix_w_br_out[l], mix_w_gate[l], mix_w_out[l])
        x = _layer_norm(DN_ALPHA * x + mix, ln1_g[l], ln1_b[l])
        xa = _memory_cross_attention(x, mem, xa_w_q[l], xa_w_kv[l], xa_w_o[l])
        x = _layer_norm(DN_ALPHA * x + xa, ln2_g[l], ln2_b[l])
        if l % 2 == 0:
            ffn = _swiglu(x, ffn_w13[l // 2], ffn_w2[l // 2])
        else:
            ffn = _moe_swiglu(x.reshape(-1, D_MODEL), moe_router[l // 2], moe_w13[l // 2],
                              moe_w2[l // 2]).reshape(x.shape)
        x = _layer_norm(DN_ALPHA * x + ffn, ln3_g[l], ln3_b[l])
    return x
```

```cpp
#include <hip/hip_runtime.h>
#include <cstdio>
#include <cstdint>

#define GAS __attribute__((address_space(1)))
#define LAS __attribute__((address_space(3)))
typedef unsigned short bf16_t;
typedef short bf16x8 __attribute__((ext_vector_type(8)));
typedef short bf16x4 __attribute__((ext_vector_type(4)));
typedef float f32x2 __attribute__((ext_vector_type(2)));
typedef float f32x4 __attribute__((ext_vector_type(4)));
typedef float f32x16 __attribute__((ext_vector_type(16)));
typedef unsigned u32x4 __attribute__((ext_vector_type(4)));
typedef unsigned u32x2 __attribute__((ext_vector_type(2)));
#define RLX_AGENT __ATOMIC_RELAXED, __HIP_MEMORY_SCOPE_AGENT

constexpr int NB = 16, SEQ = 2048, DM = 1024, T = NB * SEQ;
constexpr int NPROJ = 3328;
constexpr int PC_SBQ = 0, PC_SBK = 256, PC_SBV = 512, PC_RW = 768, PC_Z = 1792, PC_XS = 2048, PC_BM = 2304, PC_CM = 2560, PC_CQ = 2816, PC_CKV = 3072, PC_KR = 3200, PC_DT = 3232;
constexpr int MEMT = 256, NMEM = NB * MEMT;
constexpr int FFD = 2816, FFE = 3584, NEXP = 8;
constexpr int MOE_ROWS = 2 * T + NEXP * 256;
constexpr int MOE_BLOCKS = MOE_ROWS / 256;
constexpr int MOE_PASS_BLOCKS = 66, MOE_PASSES = 4;
constexpr float DN_ALPHA = 1.4142135623730951f;
constexpr float LOG2E = 1.4426950408889634f;

constexpr size_t MiB = 1u << 20;
constexpr size_t WS_CTL = 0, CTL_BYTES = 1 * MiB;
constexpr int CW_BAR = 1024;
constexpr int CW_QUEUE = 8192;
constexpr int CW_MOECNT = 16384;
constexpr size_t W_BASE = CTL_BYTES;
constexpr size_t LW_WIN = 0;
constexpr size_t LW_WGATE = LW_WIN + (size_t)NPROJ * 1024 * 2;
constexpr size_t LW_WBR = LW_WGATE + (size_t)4096 * 1024 * 2;
constexpr size_t LW_WOUT = LW_WBR + (size_t)4 * 1024 * 256 * 2;
constexpr size_t LW_LORA = LW_WOUT + (size_t)1024 * 1024 * 2;
constexpr size_t LW_WUQ = LW_LORA + (size_t)768 * 256 * 2;
constexpr size_t LW_WUKV = LW_WUQ + (size_t)512 * 256 * 2;
constexpr size_t LW_WQ = LW_WUKV + (size_t)512 * 128 * 2;
constexpr size_t LW_WKV = LW_WQ + (size_t)1024 * 1024 * 2;
constexpr size_t LW_WO = LW_WKV + (size_t)2048 * 1024 * 2;
constexpr size_t LW_SIZE = LW_WO + (size_t)1024 * 1024 * 2;
constexpr size_t W_FFN13 = W_BASE + 2 * LW_SIZE;
constexpr size_t W_FFN2 = W_FFN13 + (size_t)2 * FFD * 1024 * 2;
constexpr size_t W_KMEM = W_FFN2 + (size_t)1024 * FFD * 2;
constexpr size_t W_VMEMT = W_KMEM + (size_t)2 * NMEM * 1024 * 2;
constexpr size_t W_MEMB = W_VMEMT + (size_t)2 * 1024 * NMEM * 2;
constexpr size_t W_COS = W_MEMB + (size_t)NMEM * 1024 * 2;
constexpr size_t W_SIN = W_COS + (size_t)T * 16 * 4;
constexpr size_t W_XB = W_SIN + (size_t)T * 16 * 4;
constexpr size_t W_XRES = W_XB + (size_t)T * 1024 * 2;
constexpr size_t S_BASE = W_XRES + (size_t)T * 1024 * 4;
constexpr size_t S_Y = S_BASE;
constexpr size_t S_SSQ = S_Y + (size_t)T * 1024 * 2;
constexpr size_t S_PROJ = S_SSQ + (size_t)T * 4 * 4;
constexpr size_t S_LA = S_PROJ + (size_t)T * NPROJ * 2;
constexpr size_t S_CQN = S_LA + (size_t)T * 256 * 2;
constexpr size_t S_CKVN = S_CQN + (size_t)T * 256 * 2;
constexpr size_t S_DEC = S_CKVN + (size_t)T * 128 * 2;
constexpr size_t S_AV = S_DEC + (size_t)T * 256 * 4;
constexpr size_t S_GV = S_AV + (size_t)T * 256 * 2;
constexpr size_t S_QM = S_GV + (size_t)T * 256 * 2;
constexpr size_t S_KM = S_QM + (size_t)T * 384 * 2;
constexpr size_t S_VM = S_KM + (size_t)T * 384 * 2;
constexpr size_t S_RWS = S_VM + (size_t)T * 256 * 2;
constexpr size_t S_MIX_END = S_RWS + (size_t)5 * T * 256 * 2;
constexpr size_t S_G = S_PROJ;
constexpr size_t S_MF = S_G + (size_t)T * 4096 * 2;
constexpr size_t S_MB = S_MF + (size_t)T * 1024 * 4;
constexpr size_t S_GATE_END = S_MB + (size_t)T * 1024 * 2;
constexpr size_t S_XQ = S_BASE;
constexpr size_t S_XP = S_XQ + (size_t)T * 1024 * 2;
constexpr size_t S_XO = S_XP + (size_t)T * 1024 * 2;
constexpr size_t S_H = S_BASE;
constexpr size_t S_MW13 = S_BASE;
constexpr size_t S_MW2 = S_MW13 + (size_t)NEXP * 2 * FFE * 1024 * 2;
constexpr size_t S_XS = S_MW2 + (size_t)NEXP * 1024 * FFE * 2;
constexpr size_t S_YS = S_XS + (size_t)MOE_ROWS * 1024 * 2;
constexpr size_t S_MH = S_YS + (size_t)2 * T * 1024 * 2;
constexpr size_t S_TOPI = S_MH + (size_t)MOE_PASS_BLOCKS * 256 * FFE * 2;
constexpr size_t S_TOPW = S_TOPI + (size_t)T * 2 * 4;
constexpr size_t S_ROWSLOT = S_TOPW + (size_t)T * 2 * 4;
constexpr size_t S_ROWW = S_ROWSLOT + (size_t)MOE_ROWS * 4;
constexpr size_t S_BLKE = S_ROWW + (size_t)MOE_ROWS * 4;
constexpr size_t S_MOE_END = S_BLKE + 4096;
constexpr size_t cmax(size_t a, size_t b) { return a > b ? a : b; }
constexpr size_t WS_NEED = cmax(cmax(S_MIX_END, S_GATE_END), S_MOE_END);
static_assert(WS_NEED <= (size_t)896 * MiB, "workspace map exceeds 896 MiB");
static_assert((W_BASE % 256) == 0 && (LW_SIZE % 256) == 0 && (S_BASE % 256) == 0, "alignment");

constexpr int RING_BYTES = 131072;
constexpr int XCH_OFF = RING_BYTES;
constexpr int LDSCTL_OFF = RING_BYTES + 16384;
constexpr int LDS_BYTES = LDSCTL_OFF + 512;
constexpr int NWAVES = 8, NTHREADS = 512;

typedef __bf16 bf16x2_t __attribute__((ext_vector_type(2)));
__device__ __forceinline__ unsigned cvt_pk_bf16(float lo, float hi) { bf16x2_t v = {(__bf16)lo, (__bf16)hi}; return __builtin_bit_cast(unsigned, v); }
__device__ __forceinline__ float bf2f(unsigned short b) { return __uint_as_float((unsigned)b << 16); }
__device__ __forceinline__ float bflo(unsigned w) { return __uint_as_float(w << 16); }
__device__ __forceinline__ float bfhi(unsigned w) { return __uint_as_float(w & 0xffff0000u); }
__device__ __forceinline__ float fexp2(float x) { return __builtin_amdgcn_exp2f(x); }
__device__ __forceinline__ float flog2(float x) { return __builtin_amdgcn_logf(x); }
__device__ __forceinline__ float frcp(float x) { return __builtin_amdgcn_rcpf(x); }
__device__ __forceinline__ float sigmoidf_(float x) { return frcp(1.0f + fexp2(-x * LOG2E)); }
__device__ __forceinline__ float siluf_(float x) { return x * sigmoidf_(x); }
__device__ __forceinline__ float softplusf_(float x) { return fmaxf(x, 0.f) + 0.6931471805599453f * flog2(1.0f + fexp2(-fabsf(x) * LOG2E)); }
__device__ __forceinline__ float wave_sum(float v) {
#pragma unroll
    for (int o = 1; o < 64; o <<= 1) v += __shfl_xor(v, o);
    return v;
}
#define LDS_WAIT() asm volatile("s_waitcnt lgkmcnt(0)" ::: "memory")
#define VM_WAIT() asm volatile("s_waitcnt vmcnt(0)" ::: "memory")
#define XB_TMO      128
#define XB_XCNT(j)  (256  + 64 * (j))
#define XB_XSUB(j)  (1280 + 64 * (j))
#define XB_XGEN(j)  (2304 + 64 * (j))
#define XB_TOP      3328
#define XB_TOPGEN   3392
#define XCD_BAR_WORDS 3456
#define XB_SPIN_CAP (1u << 18)

__device__ __forceinline__ unsigned xb_ld(unsigned* p)              { return __hip_atomic_load(p, __ATOMIC_RELAXED, __HIP_MEMORY_SCOPE_AGENT); }
__device__ __forceinline__ unsigned xb_add(unsigned* p, unsigned v) { return __hip_atomic_fetch_add(p, v, __ATOMIC_RELAXED, __HIP_MEMORY_SCOPE_AGENT); }
__device__ __forceinline__ unsigned xb_xcc_id() { return (unsigned)__builtin_amdgcn_s_getreg((3 << 11) | 20) & 0xFu; }
#define XB_SPIN(cond, bar) do { unsigned _sp = 0; while (cond) { __builtin_amdgcn_s_sleep(1); \
    if ((++_sp & 255u) == 0u) { if (xb_ld(&(bar)[XB_TMO])) break; if (_sp > XB_SPIN_CAP) { atomicAdd(&(bar)[XB_TMO], 1u); break; } } } } while (0)

struct XcdBarrier { unsigned* bar; unsigned x; volatile LAS unsigned* st; };

__device__ __forceinline__ XcdBarrier xcd_barrier_post(unsigned* bar, volatile LAS unsigned* st) {
    XcdBarrier b; b.bar = bar; b.x = xb_xcc_id(); b.st = st;
    if (threadIdx.x == 0) (void)xb_add(&bar[XB_XCNT(b.x)], 1u);
    return b;
}
__device__ __forceinline__ void xcd_barrier_complete(unsigned* bar, unsigned x, unsigned& nloc, unsigned& nx) {
    const unsigned G = gridDim.x * gridDim.y * gridDim.z;
    unsigned sum, cnt, mine, sp = 0u;
    for (;;) {
        sum = 0u; cnt = 0u; mine = 0u;
#pragma unroll
        for (unsigned j = 0; j < 16; ++j) { const unsigned c = xb_ld(&bar[XB_XCNT(j)]); sum += c; cnt += (c > 0u) ? 1u : 0u; mine = (j == x) ? c : mine; }
        if (sum == G) break;
        __builtin_amdgcn_s_sleep(1);
        if ((++sp & 255u) == 0u) { if (xb_ld(&bar[XB_TMO])) break; if (sp > XB_SPIN_CAP) { atomicAdd(&bar[XB_TMO], 1u); break; } }
    }
    nloc = mine > 0u ? mine : 1u; nx = cnt > 0u ? cnt : 1u;
}
__device__ __forceinline__ void xcd_barrier(const XcdBarrier& b) {
    asm volatile("s_waitcnt vmcnt(0)" ::: "memory");
    __syncthreads();
    if (threadIdx.x == 0) {
        unsigned* bar = b.bar;
        __builtin_amdgcn_s_waitcnt(0);
        unsigned nloc = b.st[0], nx = b.st[1];
        if (nloc == 0u) { xcd_barrier_complete(bar, b.x, nloc, nx); b.st[0] = nloc; b.st[1] = nx; }
        const unsigned old = xb_add(&bar[XB_XSUB(b.x)], 1u);
        const unsigned gen = old / nloc;
        if (old + 1u == (gen + 1u) * nloc) {
            __builtin_amdgcn_fence(__ATOMIC_RELEASE, "agent");
            asm volatile("s_waitcnt vmcnt(0)" ::: "memory");
            const unsigned og = xb_add(&bar[XB_TOP], 1u);
            const unsigned tg = og / nx;
            if (og + 1u == (tg + 1u) * nx) xb_add(&bar[XB_TOPGEN], 1u);
            else XB_SPIN(xb_ld(&bar[XB_TOPGEN]) == tg, bar);
            __builtin_amdgcn_fence(__ATOMIC_ACQUIRE, "agent");
            xb_add(&bar[XB_XGEN(b.x)], 1u);
            asm volatile("s_waitcnt vmcnt(0)" ::: "memory");
        } else {
            XB_SPIN(xb_ld(&bar[XB_XGEN(b.x)]) == gen, bar);
            __builtin_amdgcn_fence(__ATOMIC_ACQUIRE, "agent");
            asm volatile("s_waitcnt vmcnt(0)" ::: "memory");
        }
    }
    __syncthreads();
}

namespace pg8 {
constexpr int BM = 256, BK = 64, HALF = 128, HTB = HALF * BK * 2, STAGE_BYTES = 8 * HTB;
__host__ __device__ __forceinline__ int lds_byte(int r, int c) { const int st = (r >> 4) * 2 + (c >> 5), rr = r & 15, cc = c & 31, ob = rr * 64 + cc * 2; return st * 1024 + (ob ^ (((ob >> 9) & 1) << 5)); }
__host__ __device__ __forceinline__ void stage_rc(int b, int& R, int& C) { const int st = b / 1024, sb = b % 1024, swz = sb ^ (((sb >> 9) & 1) << 5); R = (st >> 1) * 16 + swz / 64; C = (st & 1) * 32 + (swz % 64) / 2; }
__host__ __device__ __forceinline__ int perm32(int rho) { const int n = rho >> 4, i = rho & 15; return 8 * (i >> 2) + 4 * n + (i & 3); }

struct Unit { int pm, pn; long aoff, boff; int tag; };
struct Gemm { const bf16_t* A; const bf16_t* Bt; int K, lda, ldb; };

template <class Epi, class Sched, bool ALIGN = true>
__device__ __forceinline__ void gemm_phase(LAS unsigned char* lds, const Gemm g, const Sched& S, const Epi& E) {
    int tid_ = threadIdx.x; asm volatile("" : "+v"(tid_));
    const int tid = tid_, wid = __builtin_amdgcn_readfirstlane(tid >> 6), lane = tid & 63, wr = wid >> 2, wc = wid & 3, fr = lane & 15, fq = lane >> 4;
    int K = g.K; asm volatile("" : "+s"(K)); const int nt = K / BK;
    unsigned voffA[2], voffB[2];
#pragma unroll
    for (int i = 0; i < 2; ++i) { int R, C; stage_rc(tid * 16 + i * 8192, R, C); const int Rb = Epi::PERM ? ((R & ~31) + perm32(R & 31)) : R;
        voffA[i] = (unsigned)(R * g.lda + C) * 2u; voffB[i] = (unsigned)(Rb * g.ldb + C) * 2u; }
    const size_t kstep = (size_t)(BK * 2);
    const size_t hstepA = (size_t)HALF * g.lda * 2, hstepB = (size_t)HALF * g.ldb * 2;
    const size_t tstepA = 2 * hstepA, tstepB = 2 * hstepB;
    const unsigned ldsw = (unsigned)wid * 1024u;
    const int aoff = lds_byte(wr * 64 + fr, fq * 8), boff = lds_byte(wc * 32 + fr, fq * 8);
#define PG8_SA(b, h) (((b) * 2 + (h)) * HTB)
#define PG8_SB(b, h) ((4 + (b) * 2 + (h)) * HTB)
#define PG8_STAGE(bufoff, gbase, voff) do { _Pragma("unroll") for (int _i = 0; _i < 2; ++_i) \
        __builtin_amdgcn_global_load_lds((const unsigned*)((const char*)(gbase) + (voff)[_i]), (LAS unsigned*)(lds + (bufoff) + ldsw + _i * 8192), 16, 0, 0); } while (0)
#define PG8_LDA(dst, b, h) do { _Pragma("unroll") for (int m = 0; m < 4; ++m) _Pragma("unroll") for (int k = 0; k < 2; ++k) dst[m][k] = *(const LAS bf16x8*)(lds + PG8_SA(b, h) + aoff + m * 2048 + k * 1024); } while (0)
#define PG8_LDB(dst, b, h) do { _Pragma("unroll") for (int n = 0; n < 2; ++n) _Pragma("unroll") for (int k = 0; k < 2; ++k) dst[n][k] = *(const LAS bf16x8*)(lds + PG8_SB(b, h) + boff + n * 2048 + k * 1024); } while (0)
#define PG8_MMA(ai, bj, At, Bt) do { __builtin_amdgcn_s_setprio(1); _Pragma("unroll") for (int m = 0; m < 4; ++m) _Pragma("unroll") for (int n = 0; n < 2; ++n) _Pragma("unroll") for (int k = 0; k < 2; ++k) \
        acc[ai][bj][m][n] = __builtin_amdgcn_mfma_f32_16x16x32_bf16(Bt[n][k], At[m][k], acc[ai][bj][m][n], 0, 0, 0); __builtin_amdgcn_s_setprio(0); } while (0)
#define PG8_WAIT_V(n) asm volatile("s_waitcnt vmcnt(" #n ")" ::: "memory")
#define PG8_WAIT_L(n) asm volatile("s_waitcnt lgkmcnt(" #n ")" ::: "memory")
#define PG8_BAR __builtin_amdgcn_s_barrier()
#define PG8_SCHED __builtin_amdgcn_sched_barrier(0)
    Unit cur, nxt; int ui = 0;
    if (!S.next(0, cur)) return;
    f32x4 acc[2][2][4][2];
#pragma unroll
    for (int a = 0; a < 2; ++a)
#pragma unroll
        for (int b = 0; b < 2; ++b)
#pragma unroll
            for (int m = 0; m < 4; ++m)
#pragma unroll
                for (int n = 0; n < 2; ++n) acc[a][b][m][n] = (f32x4){0.f, 0.f, 0.f, 0.f};
    bf16x8 At[4][2], B0[2][2], B1[2][2];
    const char* cA = (const char*)(g.A + cur.aoff) + (size_t)cur.pm * tstepA; const char* cB = (const char*)(g.Bt + cur.boff) + (size_t)cur.pn * tstepB;
    PG8_STAGE(PG8_SB(0, 0), cB, voffB); PG8_STAGE(PG8_SB(0, 1), cB + hstepB, voffB); PG8_STAGE(PG8_SA(0, 0), cA, voffA); PG8_STAGE(PG8_SA(0, 1), cA + hstepA, voffA);
    if (wr == 1) PG8_BAR;
    PG8_WAIT_V(2); PG8_BAR;
    PG8_STAGE(PG8_SB(1, 0), cB + kstep, voffB); PG8_STAGE(PG8_SA(1, 0), cA + kstep, voffA); PG8_STAGE(PG8_SB(1, 1), cB + hstepB + kstep, voffB);
    PG8_WAIT_V(6); PG8_BAR;
    for (;;) {
        const bool has_next = S.next(ui + 1, nxt);
        const char* nA = has_next ? (const char*)(g.A + nxt.aoff) + (size_t)nxt.pm * tstepA : cA; const char* nB = has_next ? (const char*)(g.Bt + nxt.boff) + (size_t)nxt.pn * tstepB : cB;
#pragma unroll 1
        for (int t = 0; t < nt; t += 2) {
            const bool last = (t == nt - 2);
            const char* a1 = cA + (size_t)(t + 1) * kstep;
            const char* a2 = last ? nA : cA + (size_t)(t + 2) * kstep; const char* b2 = last ? nB : cB + (size_t)(t + 2) * kstep;
            const char* a3 = a2 + kstep; const char* b3 = b2 + kstep;
            PG8_LDB(B0, 0, 0); PG8_LDB(B1, 0, 1); PG8_SCHED; PG8_LDA(At, 0, 0); PG8_STAGE(PG8_SA(1, 1), a1 + hstepA, voffA);
            PG8_WAIT_V(8); PG8_WAIT_L(0); PG8_BAR; PG8_MMA(0, 0, At, B0); PG8_MMA(0, 1, At, B1); PG8_BAR; PG8_SCHED;
            PG8_LDA(At, 0, 1); PG8_STAGE(PG8_SB(0, 0), b2, voffB); PG8_STAGE(PG8_SB(0, 1), b2 + hstepB, voffB); PG8_STAGE(PG8_SA(0, 0), a2, voffA);
            PG8_WAIT_V(8); PG8_WAIT_L(0); PG8_BAR; PG8_MMA(1, 0, At, B0); PG8_MMA(1, 1, At, B1); PG8_BAR; PG8_SCHED;
            PG8_LDB(B0, 1, 0); PG8_LDB(B1, 1, 1); PG8_SCHED; PG8_LDA(At, 1, 0); PG8_STAGE(PG8_SA(0, 1), a2 + hstepA, voffA);
            PG8_WAIT_V(8); PG8_WAIT_L(0); PG8_BAR; PG8_MMA(0, 0, At, B0); PG8_MMA(0, 1, At, B1); PG8_BAR; PG8_SCHED;
            PG8_LDA(At, 1, 1); PG8_STAGE(PG8_SB(1, 0), b3, voffB); PG8_STAGE(PG8_SB(1, 1), b3 + hstepB, voffB); PG8_STAGE(PG8_SA(1, 0), a3, voffA);
            PG8_WAIT_V(8); PG8_WAIT_L(0); PG8_BAR; PG8_MMA(1, 0, At, B0); PG8_MMA(1, 1, At, B1); PG8_BAR; PG8_SCHED;
        }
        if constexpr (ALIGN) { if (wr == 0) PG8_BAR; }
        E(acc, cur, wr, wc, fr, fq, wid, lane);
        if (!has_next) break;
#pragma unroll
        for (int a = 0; a < 2; ++a)
#pragma unroll
            for (int b = 0; b < 2; ++b)
#pragma unroll
                for (int m = 0; m < 4; ++m)
#pragma unroll
                    for (int n = 0; n < 2; ++n) acc[a][b][m][n] = (f32x4){0.f, 0.f, 0.f, 0.f};
        cur = nxt; cA = nA; cB = nB; ++ui;
        if constexpr (ALIGN) { if (wr == 1) PG8_BAR; }
    }
    PG8_WAIT_V(0);
    if constexpr (!ALIGN) { if (wr == 0) PG8_BAR; }
    PG8_BAR;
#undef PG8_SA
#undef PG8_SB
#undef PG8_STAGE
#undef PG8_LDA
#undef PG8_LDB
#undef PG8_MMA
#undef PG8_WAIT_V
#undef PG8_WAIT_L
#undef PG8_BAR
#undef PG8_SCHED
}
}
namespace sch {
using pg8::Unit;
__device__ __forceinline__ void tile_of(int L, int nM, int nN, int& pm, int& pn) {
    const int nwg = nM * nN; int wgid = L;
    { const int q = nwg / 8, r = nwg % 8, xcd = wgid % 8, off = wgid / 8; wgid = (xcd < r ? xcd * (q + 1) : r * (q + 1) + (xcd - r) * q) + off; }
    const int nig = 8 * nN, gid = wgid / nig, fm = gid * 8, gsz = (nM - fm) < 8 ? (nM - fm) : 8;
    pm = fm + ((wgid % nig) % gsz); pn = (wgid % nig) / gsz;
}
struct Tiles {
    int nM, nN, G, c;
    __device__ __forceinline__ bool next(int i, Unit& u) const {
        const long L = (long)i * G + c; if (L >= (long)nM * nN) return false;
        tile_of((int)L, nM, nN, u.pm, u.pn); u.aoff = 0; u.boff = 0; u.tag = 0; return true; }
};
struct BrTiles {
    int nM, nN, G, c;
    __device__ __forceinline__ bool next(int i, Unit& u) const {
        const long L = (long)(i >> 2) * G + c; if (L >= (long)nM * nN) return false;
        tile_of((int)L, nM, nN, u.pm, u.pn); const int br = i & 3; u.aoff = br * 256; u.boff = (long)br * 1024 * 256; u.tag = br; return true; }
};
struct XaS {
    int G, c;
    __device__ __forceinline__ bool next(int i, Unit& u) const {
        const int L = i * G + c; if (L >= 512) return false;
        const int b = L >> 5, h = (L >> 3) & 3, rb = L & 7; u.pm = b * 8 + rb; u.pn = b; u.aoff = h * 256; u.boff = h * 256; u.tag = h; return true; }
};
struct XaPV {
    int G, c;
    __device__ __forceinline__ bool next(int i, Unit& u) const {
        const int L = i * G + c; if (L >= 512) return false;
        const int b = L >> 5, h = (L >> 3) & 3, rb = L & 7; u.pm = b * 8 + rb; u.pn = h; u.aoff = h * 256; u.boff = b * 256; u.tag = h; return true; }
};
struct MoeUp {
    const int* blk_e; int b0, b1, G, c;
    __device__ __forceinline__ bool next(int i, Unit& u) const {
        const int L = i * G + c; const int nb = b1 - b0; if (L >= nb * 28) return false;
        const int rb = b0 + L / 28; u.pn = L % 28; u.pm = rb;
        const int e = __builtin_amdgcn_readfirstlane(__hip_atomic_load(blk_e + rb, RLX_AGENT));
        u.aoff = 0; u.boff = (long)e * (2 * FFE) * 1024; u.tag = rb - b0; return true; }
};
struct MoeDown {
    const int* blk_e; int b0, b1, G, c;
    __device__ __forceinline__ bool next(int i, Unit& u) const {
        const int L = i * G + c; const int nb = b1 - b0; if (L >= nb * 4) return false;
        const int rb = b0 + L / 4; u.pn = L % 4; u.pm = rb - b0;
        const int e = __builtin_amdgcn_readfirstlane(__hip_atomic_load(blk_e + rb, RLX_AGENT));
        u.aoff = 0; u.boff = (long)e * 1024 * FFE; u.tag = rb; return true; }
};
}

namespace epi {
using pg8::Unit;
#define EPI_SIG f32x4 (&acc)[2][2][4][2], const Unit& u, int wr, int wc, int fr, int fq, int wid, int lane
#define EPI_ROWS _Pragma("unroll") for (int ai = 0; ai < 2; ++ai) _Pragma("unroll") for (int m = 0; m < 4; ++m)
#define EPI_ROW (u.pm * 256 + ai * 128 + wr * 64 + m * 16 + fr)
#define EPI_BJ _Pragma("unroll") for (int bj = 0; bj < 2; ++bj)
#define EPI_FENCE asm volatile("" ::: "memory")
__device__ __forceinline__ u32x4 pack8(const f32x4 a, const f32x4 b) { u32x4 w; w.x = cvt_pk_bf16(a[0], a[1]); w.y = cvt_pk_bf16(a[2], a[3]); w.z = cvt_pk_bf16(b[0], b[1]); w.w = cvt_pk_bf16(b[2], b[3]); return w; }

template <int ACT> struct StoreBf16 {
    static constexpr bool PERM = true;
    bf16_t* O; int ldc;
    __device__ __forceinline__ void operator()(EPI_SIG) const {
        EPI_ROWS { bf16_t* rowp = O + (size_t)EPI_ROW * ldc + u.pn * 256 + wc * 32 + 8 * fq;
            EPI_BJ { f32x4 v0 = acc[ai][bj][m][0], v1 = acc[ai][bj][m][1];
                if (ACT == 1) { for (int j = 0; j < 4; ++j) { v0[j] = sigmoidf_(v0[j]); v1[j] = sigmoidf_(v1[j]); } }
                *(u32x4*)(rowp + bj * 128) = pack8(v0, v1); } EPI_FENCE; }
    }
};
struct Lora {
    static constexpr bool PERM = true;
    float* dec; bf16_t* av; bf16_t* gv; const float* w0; const float* a0;
    __device__ __forceinline__ void operator()(EPI_SIG) const {
        EPI_ROWS { const size_t row = EPI_ROW;
            EPI_BJ { const int col = bj * 128 + wc * 32 + 8 * fq; f32x4 v0 = acc[ai][bj][m][0], v1 = acc[ai][bj][m][1];
                if (u.pn == 0) {
                    const f32x4 b0 = *(const f32x4*)(w0 + col), b1 = *(const f32x4*)(w0 + col + 4);
                    for (int j = 0; j < 4; ++j) { float x = v0[j] + b0[j]; float wl = -softplusf_(-x) - 0.5f; v0[j] = fexp2(-fexp2(wl * LOG2E) * LOG2E);
                                                  x = v1[j] + b1[j]; wl = -softplusf_(-x) - 0.5f; v1[j] = fexp2(-fexp2(wl * LOG2E) * LOG2E); }
                    *(f32x4*)(dec + row * 256 + col) = v0; *(f32x4*)(dec + row * 256 + col + 4) = v1;
                } else if (u.pn == 1) {
                    const f32x4 b0 = *(const f32x4*)(a0 + col), b1 = *(const f32x4*)(a0 + col + 4);
                    for (int j = 0; j < 4; ++j) { v0[j] = sigmoidf_(v0[j] + b0[j]); v1[j] = sigmoidf_(v1[j] + b1[j]); }
                    *(u32x4*)(av + row * 256 + col) = pack8(v0, v1);
                } else { *(u32x4*)(gv + row * 256 + col) = pack8(v0, v1); } } EPI_FENCE; }
    }
};
struct Uq {
    static constexpr bool PERM = false;
    bf16_t* Q; const float* cosT; const float* sinT;
    __device__ __forceinline__ void operator()(EPI_SIG) const {
        EPI_ROWS { const size_t row = EPI_ROW;
            EPI_BJ { const int c32 = u.pn * 256 + bj * 128 + wc * 32; if (c32 >= 384) continue;
                f32x4 v0 = acc[ai][bj][m][0], v1 = acc[ai][bj][m][1];
                if ((c32 >> 5) % 3 == 2) {
                    const f32x4 cs = *(const f32x4*)(cosT + row * 16 + 4 * fq), sn = *(const f32x4*)(sinT + row * 16 + 4 * fq);
                    const f32x4 o0 = v0 * cs - v1 * sn, o1 = v0 * sn + v1 * cs; v0 = o0; v1 = o1; }
                u32x2 w0, w1; w0.x = cvt_pk_bf16(v0[0], v0[1]); w0.y = cvt_pk_bf16(v0[2], v0[3]); w1.x = cvt_pk_bf16(v1[0], v1[1]); w1.y = cvt_pk_bf16(v1[2], v1[3]);
                *(u32x2*)(Q + row * 384 + c32 + 4 * fq) = w0; *(u32x2*)(Q + row * 384 + c32 + 16 + 4 * fq) = w1; } EPI_FENCE; }
    }
};
struct Ukv {
    static constexpr bool PERM = true;
    bf16_t* Km; bf16_t* Vm;
    __device__ __forceinline__ void operator()(EPI_SIG) const {
        EPI_ROWS { const size_t row = EPI_ROW;
            EPI_BJ { const int col = u.pn * 256 + bj * 128 + wc * 32 + 8 * fq; const int h = col >> 7, j = col & 127;
                const u32x4 w = pack8(acc[ai][bj][m][0], acc[ai][bj][m][1]);
                if (j < 64) *(u32x4*)(Km + row * 384 + h * 96 + j) = w; else *(u32x4*)(Vm + row * 256 + h * 64 + (j - 64)) = w; } EPI_FENCE; }
    }
};
struct Resid {
    static constexpr bool PERM = false;
    const float* res; float* out; float ascale;
    __device__ __forceinline__ void operator()(EPI_SIG) const {
        EPI_ROWS { const size_t off = (size_t)EPI_ROW * 1024 + u.pn * 256 + wc * 32 + 4 * fq;
            EPI_BJ { _Pragma("unroll") for (int n = 0; n < 2; ++n) { const size_t o = off + bj * 128 + n * 16; const f32x4 r = *(const f32x4*)(res + o); *(f32x4*)(out + o) = r * DN_ALPHA + acc[ai][bj][m][n] * ascale; } } EPI_FENCE; }
    }
};
struct Swiglu {
    static constexpr bool PERM = false;
    bf16_t* H; int ldh; int use_tag;
    __device__ __forceinline__ void operator()(EPI_SIG) const {
        const int pmo = use_tag ? u.tag : u.pm;
        EPI_ROWS { const size_t row = (size_t)(pmo * 256 + ai * 128 + wr * 64 + m * 16 + fr);
            EPI_BJ { const int hc = (u.pn * 256 + bj * 128 + wc * 32) / 2 + 4 * fq; const f32x4 g = acc[ai][bj][m][0], up = acc[ai][bj][m][1];
                u32x2 w; w.x = cvt_pk_bf16(siluf_(g[0]) * up[0], siluf_(g[1]) * up[1]); w.y = cvt_pk_bf16(siluf_(g[2]) * up[2], siluf_(g[3]) * up[3]);
                *(u32x2*)(H + row * ldh + hc) = w; } EPI_FENCE; }
    }
};
struct BrGate {
    static constexpr bool PERM = true;
    const bf16_t* G; float* mf; bf16_t* mb;
    __device__ __forceinline__ void operator()(EPI_SIG) const {
        const int br = u.tag;
#ifdef ABL_BR
        const float ablk = ((ABL_BR >> br) & 1) ? 0.f : 1.f;
#else
        const float ablk = 1.f;
#endif
        EPI_ROWS { const size_t row = EPI_ROW;
            EPI_BJ { const int col = u.pn * 256 + bj * 128 + wc * 32 + 8 * fq;
#ifdef G_SYS_LOAD
                u32x4 gw; { const unsigned long long* gp_ = (const unsigned long long*)(G + row * 4096 + br * 1024 + col); const unsigned long long q0 = __hip_atomic_load(gp_, __ATOMIC_RELAXED, __HIP_MEMORY_SCOPE_SYSTEM), q1 = __hip_atomic_load(gp_ + 1, __ATOMIC_RELAXED, __HIP_MEMORY_SCOPE_SYSTEM); gw.x = (unsigned)q0; gw.y = (unsigned)(q0 >> 32); gw.z = (unsigned)q1; gw.w = (unsigned)(q1 >> 32); }
#else
                const u32x4 gw = *(const u32x4*)(G + row * 4096 + br * 1024 + col);
#endif
                f32x4 v0 = acc[ai][bj][m][0] * ablk, v1 = acc[ai][bj][m][1] * ablk;
#if defined(GATE_ACT) && GATE_ACT == 0
#define GSIG(x) sigmoidf_(x)
#else
#define GSIG(x) (x)
#endif
                v0[0] *= GSIG(bflo(gw.x)); v0[1] *= GSIG(bfhi(gw.x)); v0[2] *= GSIG(bflo(gw.y)); v0[3] *= GSIG(bfhi(gw.y));
                v1[0] *= GSIG(bflo(gw.z)); v1[1] *= GSIG(bfhi(gw.z)); v1[2] *= GSIG(bflo(gw.w)); v1[3] *= GSIG(bfhi(gw.w));
                float* p = mf + row * 1024 + col;
                if (br > 0) { v0 += *(const f32x4*)p; v1 += *(const f32x4*)(p + 4); }
                if (br < 3) { *(f32x4*)p = v0; *(f32x4*)(p + 4) = v1; }
                else *(u32x4*)(mb + row * 1024 + col) = pack8(v0, v1); } EPI_FENCE; }
    }
};
struct MoeDown {
    static constexpr bool PERM = true;
    const int* row_slot; const float* row_w; bf16_t* ys;
    __device__ __forceinline__ void operator()(EPI_SIG) const {
        EPI_ROWS { const int r = u.tag * 256 + ai * 128 + wr * 64 + m * 16 + fr;
            const int slot = __hip_atomic_load(row_slot + r, RLX_AGENT); const float w = __hip_atomic_load(row_w + r, RLX_AGENT);
            if (slot >= 0) { EPI_BJ { const int col = u.pn * 256 + bj * 128 + wc * 32 + 8 * fq;
                *(u32x4*)(ys + (size_t)slot * 1024 + col) = pack8(acc[ai][bj][m][0] * w, acc[ai][bj][m][1] * w); } } EPI_FENCE; }
    }
};
struct Softmax {
    static constexpr bool PERM = true;
    bf16_t* P; LAS float* xch;
    __device__ __forceinline__ void operator()(EPI_SIG) const {
        EPI_ROWS { float v = -3.0e38f;
            EPI_BJ { const f32x4 a = acc[ai][bj][m][0], b = acc[ai][bj][m][1]; v = fmaxf(v, fmaxf(fmaxf(fmaxf(a[0], a[1]), fmaxf(a[2], a[3])), fmaxf(fmaxf(b[0], b[1]), fmaxf(b[2], b[3])))); }
            v = fmaxf(v, __shfl_xor(v, 16)); v = fmaxf(v, __shfl_xor(v, 32));
            if (fq == 0) xch[(ai * 128 + wr * 64 + m * 16 + fr) * 4 + wc] = v; }
        LDS_WAIT(); __builtin_amdgcn_s_barrier(); asm volatile("" ::: "memory");
        EPI_ROWS { const f32x4 q = *(const LAS f32x4*)(xch + (ai * 128 + wr * 64 + m * 16 + fr) * 4);
            const float mm = fmaxf(fmaxf(q[0], q[1]), fmaxf(q[2], q[3])); float s = 0.f;
            EPI_BJ { _Pragma("unroll") for (int n = 0; n < 2; ++n) { f32x4 t = acc[ai][bj][m][n]; for (int j = 0; j < 4; ++j) { t[j] = fexp2(t[j] - mm); s += t[j]; } acc[ai][bj][m][n] = t; } }
            s += __shfl_xor(s, 16); s += __shfl_xor(s, 32);
            if (fq == 0) xch[1024 + (ai * 128 + wr * 64 + m * 16 + fr) * 4 + wc] = s; }
        LDS_WAIT(); __builtin_amdgcn_s_barrier(); asm volatile("" ::: "memory");
        EPI_ROWS { const f32x4 q = *(const LAS f32x4*)(xch + 1024 + (ai * 128 + wr * 64 + m * 16 + fr) * 4);
            const float inv = frcp((q[0] + q[1]) + (q[2] + q[3]));
            bf16_t* rowp = P + (size_t)EPI_ROW * 1024 + u.tag * 256 + wc * 32 + 8 * fq;
            EPI_BJ { *(u32x4*)(rowp + bj * 128) = pack8(acc[ai][bj][m][0] * inv, acc[ai][bj][m][1] * inv); } EPI_FENCE; }
        LDS_WAIT(); __builtin_amdgcn_s_barrier(); asm volatile("" ::: "memory");
    }
};
}
struct Args { const float* in[42]; float* out; unsigned char* ws; int ph_lo, ph_hi; };
struct Ctx {
    const float* const* in; float* out; unsigned char* ws; LAS unsigned char* lds;
    int tid, lane, wave, G, bid;
};
enum { I_X = 0, I_MEM, I_POS, I_WIN, I_RWMU, I_RWW0, I_RWWUP, I_RWA0, I_RWAUP, I_RWGUP, I_RWKK, I_RWKA, I_RWRK, I_RWGNG, I_RWGNB,
       I_CONVW, I_CONVB, I_DTB, I_ALOG, I_SSDD, I_SSDNG, I_QNG, I_WUQ, I_KVNG, I_WUKV, I_WBR, I_WGATE, I_WOUT, I_LN1G, I_LN1B,
       I_XWQ, I_XWKV, I_XWO, I_LN2G, I_LN2B, I_FFN13, I_FFN2, I_ROUTER, I_MOE13, I_MOE2, I_LN3G, I_LN3B };
__device__ __forceinline__ Ctx launder(const Ctx& C0) {
    Ctx L = C0; float* out_ = C0.out; unsigned char* ws_ = C0.ws; int t_ = threadIdx.x;
    asm volatile("" : "+s"(out_), "+s"(ws_), "+v"(t_));
    L.out = out_; L.ws = ws_; L.tid = t_; L.lane = t_ & 63; L.wave = __builtin_amdgcn_readfirstlane(t_ >> 6); return L;
}
#define WSP(T_, off) ((T_*)(C.ws + (off)))
#define GW (C.bid * NWAVES + C.wave)
#define NGW (C.G * NWAVES)

struct TJob { const float* W; int ldw, K, N; bf16_t* WT; int ldt; int map; float scale; int items; };
__device__ __forceinline__ int tj_items(int K, int N) { return (K / 64) * ((N + 31) / 32); }
__device__ __forceinline__ int tj_dest(int map, int n, int N) {
    if (map == 0) return n;
    if (map == 1) return n < 2816 ? n : (n < 2820 ? PC_DT + (n - 2816) : n - 4);
    const int half = N >> 1, j = n < half ? n : n - half;
    return (j >> 4) * 32 + (j & 15) + (n < half ? 0 : 16);
}
__device__ __forceinline__ void transpose_item(const TJob& J, LAS float* scr, int item, int lane) {
    const int nblk = (J.N + 31) / 32, kb = item / nblk, nb = item % nblk, k0 = 64 * kb, n0 = 32 * nb;
    const int nn = n0 + (lane & 31); const bool okn = nn < J.N;
#pragma unroll 8
    for (int i = 0; i < 32; ++i) { const int kk = 2 * i + (lane >> 5); scr[kk * 33 + (lane & 31)] = okn ? J.W[(size_t)(k0 + kk) * J.ldw + nn] : 0.f; }
    LDS_WAIT(); asm volatile("" ::: "memory");
    const int c = lane & 7;
#pragma unroll
    for (int j = 0; j < 4; ++j) { const int nl = (lane >> 3) + 8 * j, n = n0 + nl;
        if (n < J.N) { const LAS float* s = scr + (8 * c) * 33 + nl; const float sc = (J.map == 1 && n >= 256) ? 1.0f : J.scale;
            u32x4 o; o.x = cvt_pk_bf16(s[0 * 33] * sc, s[1 * 33] * sc); o.y = cvt_pk_bf16(s[2 * 33] * sc, s[3 * 33] * sc); o.z = cvt_pk_bf16(s[4 * 33] * sc, s[5 * 33] * sc); o.w = cvt_pk_bf16(s[6 * 33] * sc, s[7 * 33] * sc);
            *(u32x4*)(J.WT + (size_t)tj_dest(J.map, n, J.N) * J.ldt + k0 + 8 * c) = o; } }
    LDS_WAIT(); asm volatile("" ::: "memory");
}
__device__ __forceinline__ TJob mkjob(const float* W, int ldw, int K, int N, bf16_t* WT, int ldt, int map, float scale) { TJob j; j.W = W; j.ldw = ldw; j.K = K; j.N = N; j.WT = WT; j.ldt = ldt; j.map = map; j.scale = scale; j.items = tj_items(K, N); return j; }

__device__ __forceinline__ TJob prologue_job(const Ctx& C, int j) {
    if (j < 26) { const int l = j / 13, r = j % 13; unsigned char* LW = C.ws + W_BASE + (size_t)l * LW_SIZE;
        if (r == 0) return mkjob(C.in[I_WIN] + (size_t)l * 1024 * 3236, 3236, 1024, 3236, (bf16_t*)(LW + LW_WIN), 1024, 1, 0.125f * LOG2E);
        if (r < 5) { const int i = r - 1; return mkjob(C.in[I_WGATE] + ((size_t)l * 4 + i) * 1024 * 1024, 1024, 1024, 1024, (bf16_t*)(LW + LW_WGATE) + (size_t)i * 1024 * 1024, 1024, 0, 1.f); }
        if (r < 9) { const int i = r - 5; return mkjob(C.in[I_WBR] + ((size_t)l * 4 + i) * 256 * 1024, 1024, 256, 1024, (bf16_t*)(LW + LW_WBR) + (size_t)i * 1024 * 256, 256, 0, 1.f); }
        if (r == 9) return mkjob(C.in[I_WOUT] + (size_t)l * 1024 * 1024, 1024, 1024, 1024, (bf16_t*)(LW + LW_WOUT), 1024, 0, 1.f);
        if (r == 10) return mkjob(C.in[I_XWQ] + (size_t)l * 1024 * 1024, 1024, 1024, 1024, (bf16_t*)(LW + LW_WQ), 1024, 0, 0.0625f * LOG2E);
        if (r == 11) return mkjob(C.in[I_XWKV] + (size_t)l * 1024 * 2048, 2048, 1024, 2048, (bf16_t*)(LW + LW_WKV), 1024, 0, 1.f);
        return mkjob(C.in[I_XWO] + (size_t)l * 1024 * 1024, 1024, 1024, 1024, (bf16_t*)(LW + LW_WO), 1024, 0, 1.f);
    }
    if (j == 26) return mkjob(C.in[I_FFN13], 2 * FFD, 1024, 2 * FFD, WSP(bf16_t, W_FFN13), 1024, 2, 1.f);
    return mkjob(C.in[I_FFN2], 1024, FFD, 1024, WSP(bf16_t, W_FFN2), FFD, 0, 1.f);
}
__device__ __forceinline__ TJob moe_job(const Ctx& C, int j) {
    if (j < 8) return mkjob(C.in[I_MOE13] + (size_t)j * 1024 * 2 * FFE, 2 * FFE, 1024, 2 * FFE, WSP(bf16_t, S_MW13) + (size_t)j * 2 * FFE * 1024, 1024, 2, 1.f);
    const int e = j - 8; return mkjob(C.in[I_MOE2] + (size_t)e * FFE * 1024, 1024, FFE, 1024, WSP(bf16_t, S_MW2) + (size_t)e * 1024 * FFE, FFE, 0, 1.f);
}
template <int NJ, bool MOE> __device__ __forceinline__ void run_tjobs(const Ctx& C) {
    LAS float* scr = (LAS float*)(C.lds + C.wave * 16384);
    int total = 0;
    for (int j = 0; j < NJ; ++j) { const TJob J = MOE ? moe_job(C, j) : prologue_job(C, j); total += J.items; }
    int j = 0, jbase = 0; TJob J = MOE ? moe_job(C, 0) : prologue_job(C, 0);
    for (int it = GW; it < total; it += NGW) {
        while (it >= jbase + J.items) { jbase += J.items; ++j; J = MOE ? moe_job(C, j) : prologue_job(C, j); }
        transpose_item(J, scr, it - jbase, C.lane);
    }
}


constexpr int CW_CHK = 32768;
template <class OutF> __device__ __forceinline__ void chk_gemm(const Ctx& C, const bf16_t* A, int lda, const bf16_t* Bt, int ldb, int K, int nrows, int ncs, int cstride, int c0, int bit, OutF expect_vs_got) {
    unsigned bad = 0; const int lane = C.lane;
    for (int it = GW; it < nrows * ncs; it += NGW) {
        const int r = it / ncs, c = c0 + (it % ncs) * cstride; float d = 0.f;
        for (int k = lane * 8; k < K; k += 512) { const u32x4 a = *(const u32x4*)(A + (size_t)r * lda + k), b = *(const u32x4*)(Bt + (size_t)c * ldb + k);
            d += bflo(a.x) * bflo(b.x) + bfhi(a.x) * bfhi(b.x) + bflo(a.y) * bflo(b.y) + bfhi(a.y) * bfhi(b.y) + bflo(a.z) * bflo(b.z) + bfhi(a.z) * bfhi(b.z) + bflo(a.w) * bflo(b.w) + bfhi(a.w) * bfhi(b.w); }
        d = wave_sum(d);
        if (!expect_vs_got(r, c, d)) bad = 1;
    }
    if (lane == 0 && bad) __hip_atomic_fetch_add((unsigned*)(C.ws + WS_CTL) + CW_CHK + 64 * bit, 1u, RLX_AGENT);
}
__device__ __forceinline__ bool chk_close(float e, float g) { return fabsf(e - g) <= 0.03f * fabsf(e) + 0.03f; }

__device__ __forceinline__ float chk_dot(const bf16_t* a, const bf16_t* b, int K, int lane) {
    float d = 0.f;
    for (int k = lane * 8; k < K; k += 512) { const u32x4 x = *(const u32x4*)(a + k), y = *(const u32x4*)(b + k);
        d += bflo(x.x) * bflo(y.x) + bfhi(x.x) * bfhi(y.x) + bflo(x.y) * bflo(y.y) + bfhi(x.y) * bfhi(y.y) + bflo(x.z) * bflo(y.z) + bfhi(x.z) * bfhi(y.z) + bflo(x.w) * bflo(y.w) + bfhi(x.w) * bfhi(y.w); }
    return wave_sum(d);
}
__device__ __forceinline__ void chk_flag(const Ctx& C, int bit, unsigned bad) { if (C.lane == 0 && bad) __hip_atomic_fetch_add((unsigned*)(C.ws + WS_CTL) + CW_CHK + 64 * bit, 1u, RLX_AGENT); }
__device__ __forceinline__ void chk_merged(const Ctx& C, int l, int bit) {
    const bf16_t* Y = WSP(bf16_t, S_Y); const bf16_t* G = WSP(bf16_t, S_G); const bf16_t* MB = WSP(bf16_t, S_MB); const bf16_t* WBR = (const bf16_t*)(C.ws + W_BASE + (size_t)l * LW_SIZE + LW_WBR); unsigned bad = 0;
    for (int it = GW; it < T * 4; it += NGW) { const int r = it >> 2, c = 13 + 256 * (it & 3); float e = 0.f;
        for (int i = 0; i < 4; ++i) e += bf2f(G[(size_t)r * 4096 + i * 1024 + c]) * chk_dot(Y + (size_t)r * 1024 + 256 * i, WBR + ((size_t)i * 1024 + c) * 256, 256, C.lane);
        if (!chk_close(e, bf2f(MB[(size_t)r * 1024 + c]))) bad = 1; }
    chk_flag(C, bit, bad);
}
__device__ __forceinline__ void chk_swiglu(const Ctx& C, int bit) {
    const bf16_t* XB = WSP(bf16_t, W_XB); const bf16_t* W = WSP(bf16_t, W_FFN13); const bf16_t* H = WSP(bf16_t, S_H); unsigned bad = 0;
    for (int it = GW; it < T * 22; it += NGW) { const int r = it / 22, hc = 5 + 128 * (it % 22); const int grow = (hc >> 4) * 32 + (hc & 15);
        const float g = chk_dot(XB + (size_t)r * 1024, W + (size_t)grow * 1024, 1024, C.lane), u = chk_dot(XB + (size_t)r * 1024, W + (size_t)(grow + 16) * 1024, 1024, C.lane);
        if (!chk_close(siluf_(g) * u, bf2f(H[(size_t)r * FFD + hc]))) bad = 1; }
    chk_flag(C, bit, bad);
}

constexpr size_t S_CHKBUF = S_BASE + (size_t)400 * MiB;
__device__ __forceinline__ void chk_resid_stash(const Ctx& C, const bf16_t* A, int lda, const bf16_t* Bt, int ldb, int K, int slot) {
    const float* XR = WSP(float, W_XRES); float* CB = WSP(float, S_CHKBUF);
    for (int it = GW; it < T * 4; it += NGW) { const int r = it >> 2, q = it & 3, c = 17 + 256 * q; const float d = chk_dot(A + (size_t)r * lda, Bt + (size_t)c * ldb, K, C.lane);
        if (C.lane == 0) CB[(size_t)r * 8 + slot * 4 + q] = XR[(size_t)r * 1024 + c] * DN_ALPHA + d; }
}
__device__ __forceinline__ void chk_resid_cmp(const Ctx& C, int slot, int bit) {
    const float* XR = WSP(float, W_XRES); const float* CB = WSP(float, S_CHKBUF); unsigned bad = 0;
    for (int it = GW; it < T * 4; it += NGW) { const int r = it >> 2, q = it & 3, c = 17 + 256 * q; if (!chk_close(CB[(size_t)r * 8 + slot * 4 + q], XR[(size_t)r * 1024 + c])) bad = 1; }
    chk_flag(C, bit, bad);
}
__device__ __forceinline__ void chk_ln_stash(const Ctx& C, const float* g, const float* b, int slot) {
    const float* XR = WSP(float, W_XRES); float* CB = WSP(float, S_CHKBUF); const int lane = C.lane;
    for (int t = GW; t < T; t += NGW) { float s = 0.f, s2 = 0.f; float v[16];
        for (int j = 0; j < 16; ++j) { v[j] = XR[(size_t)t * 1024 + lane + 64 * j]; s += v[j]; }
        const float mean = wave_sum(s) * (1.0f / 1024.0f); for (int j = 0; j < 16; ++j) { const float d = v[j] - mean; s2 += d * d; }
        const float rstd = 1.0f / sqrtf(wave_sum(s2) * (1.0f / 1024.0f) + 1e-5f);
        if (lane < 4) { const int c = 17 + 256 * lane; CB[(size_t)t * 8 + slot * 4 + lane] = (XR[(size_t)t * 1024 + c] - mean) * rstd * g[c] + b[c]; } }
}
__device__ __forceinline__ void chk_ln_cmp(const Ctx& C, int slot, int bit) {
    const float* XR = WSP(float, W_XRES); const bf16_t* XB = WSP(bf16_t, W_XB); const float* CB = WSP(float, S_CHKBUF); unsigned bad = 0;
    for (int it = GW; it < T * 4; it += NGW) { const int r = it >> 2, q = it & 3, c = 17 + 256 * q; const float e = CB[(size_t)r * 8 + slot * 4 + q];
        if (!chk_close(e, XR[(size_t)r * 1024 + c]) || !chk_close(e, bf2f(XB[(size_t)r * 1024 + c]))) bad = 1; }
    chk_flag(C, bit, bad);
}

template <int NJ, bool MOE> __device__ __forceinline__ void chk_weights(const Ctx& C, int bit) {
    unsigned bad = 0; const int gt = C.bid * NTHREADS + C.tid, NT = C.G * NTHREADS;
    for (int j = 0; j < NJ; ++j) { const TJob J = MOE ? moe_job(C, j) : prologue_job(C, j);
        for (size_t i = gt; i < (size_t)J.K * J.N; i += NT) { const int k = (int)(i / J.N), n = (int)(i % J.N);
            const float sc = (J.map == 1 && n >= 256) ? 1.0f : J.scale; const bf16_t e = (bf16_t)(cvt_pk_bf16(J.W[(size_t)k * J.ldw + n] * sc, 0.f) & 0xffffu);
            if (J.WT[(size_t)tj_dest(J.map, n, J.N) * J.ldt + k] != e) bad = 1; } }
    if (bad) __hip_atomic_fetch_add((unsigned*)(C.ws + WS_CTL) + CW_CHK + 64 * bit, 1u, RLX_AGENT);
}

__device__ __forceinline__ void chk_mla_inputs(const Ctx& C, int l, int bit) {
    const bf16_t* proj = WSP(bf16_t, S_PROJ); const bf16_t* QM = WSP(bf16_t, S_QM); const bf16_t* KM = WSP(bf16_t, S_KM); const bf16_t* VM = WSP(bf16_t, S_VM);
    const float* wuq = C.in[I_WUQ] + (size_t)l * 256 * 384; const float* wukv = C.in[I_WUKV] + (size_t)l * 128 * 512; const float* qg = C.in[I_QNG] + l * 256; const float* kvg = C.in[I_KVNG] + l * 128;
    const int* pos = (const int*)C.in[I_POS]; const int lane = C.lane; unsigned bad = 0; const float qs = 0.10206207261596575f * LOG2E;
    for (int t = GW; t < T; t += NGW) {
        const bf16_t* pr = proj + (size_t)t * NPROJ; float cq[4], ck[2]; float ss = 0.f;
        for (int i = 0; i < 4; ++i) { cq[i] = bf2f(pr[PC_CQ + lane + 64 * i]); ss += cq[i] * cq[i]; }
        float rs = 1.0f / sqrtf(wave_sum(ss) * (1.0f / 256.0f) + 1e-6f); for (int i = 0; i < 4; ++i) cq[i] *= rs * qg[lane + 64 * i];
        ss = 0.f; for (int i = 0; i < 2; ++i) { ck[i] = bf2f(pr[PC_CKV + lane + 64 * i]); ss += ck[i] * ck[i]; }
        rs = 1.0f / sqrtf(wave_sum(ss) * (1.0f / 128.0f) + 1e-6f); for (int i = 0; i < 2; ++i) ck[i] *= rs * kvg[lane + 64 * i];
        const float ang = (float)pos[t] * exp2f(-6.0f * (13.287712379549449f / 32.0f)); const float c3 = cosf(ang), s3 = sinf(ang);
        const int h = t & 3;
        float qn = 0.f, q1 = 0.f, q2 = 0.f, kn = 0.f, vv = 0.f;
        for (int i = 0; i < 4; ++i) { const int k = lane + 64 * i; qn += cq[i] * wuq[(size_t)k * 384 + h * 96 + 5]; q1 += cq[i] * wuq[(size_t)k * 384 + h * 96 + 67]; q2 += cq[i] * wuq[(size_t)k * 384 + h * 96 + 83]; }
        for (int i = 0; i < 2; ++i) { const int k = lane + 64 * i; kn += ck[i] * wukv[(size_t)k * 512 + h * 128 + 7]; vv += ck[i] * wukv[(size_t)k * 512 + h * 128 + 64 + 9]; }
        qn = wave_sum(qn) * qs; q1 = wave_sum(q1) * qs; q2 = wave_sum(q2) * qs; kn = wave_sum(kn); vv = wave_sum(vv);
        const float kr1 = bf2f(pr[PC_KR + 3]), kr2 = bf2f(pr[PC_KR + 19]);
        const bf16_t* qrow = QM + (size_t)t * 384 + h * 96; const bf16_t* krow = KM + (size_t)t * 384 + h * 96;
        if (!chk_close(qn, bf2f(qrow[5])) || !chk_close(q1 * c3 - q2 * s3, bf2f(qrow[67])) || !chk_close(q1 * s3 + q2 * c3, bf2f(qrow[83])) || !chk_close(kn, bf2f(krow[7])) ||
            !chk_close(kr1 * c3 - kr2 * s3, bf2f(krow[67])) || !chk_close(kr1 * s3 + kr2 * c3, bf2f(krow[83])) || !chk_close(vv, bf2f(VM[(size_t)t * 256 + h * 64 + 9]))) bad = 1;
    }
    chk_flag(C, bit, bad);
}

__device__ __forceinline__ void chk_rw_inputs(const Ctx& C, int l, int bit) {
    const bf16_t* proj = WSP(bf16_t, S_PROJ); const float* DEC = WSP(float, S_DEC); const bf16_t* RWS = WSP(bf16_t, S_RWS); const bf16_t* GV = WSP(bf16_t, S_GV); const size_t PL = (size_t)T * 256;
    const float* mu = C.in[I_RWMU] + l * 1024; const float* w0 = C.in[I_RWW0] + l * 256; const float* a0 = C.in[I_RWA0] + l * 256;
    const float* wup = C.in[I_RWWUP] + l * 64 * 256; const float* aup = C.in[I_RWAUP] + l * 64 * 256; const float* gup = C.in[I_RWGUP] + l * 128 * 256;
    const float* kkw = C.in[I_RWKK] + l * 256; const float* kaw = C.in[I_RWKA] + l * 256; const int lane = C.lane; unsigned bad = 0;
    for (int t = GW; t < T; t += NGW) {
        const bf16_t* pr = proj + (size_t)t * NPROJ + PC_RW; const bool first = (t % SEQ) == 0; const int h = t & 3, c = h * 64 + 11;
        auto sh = [&](int col) { const float cur = bf2f(pr[col]); const float prv = first ? 0.f : bf2f(pr[col - NPROJ]); return cur + (prv - cur) * mu[col]; };
        float dw = tanhf(sh(768 + lane)) * wup[lane * 256 + c], da = sh(832 + lane) * aup[lane * 256 + c];
        float dg = (1.0f / (1.0f + expf(-sh(896 + lane)))) * gup[lane * 256 + c] + (1.0f / (1.0f + expf(-sh(960 + lane)))) * gup[(64 + lane) * 256 + c];
        dw = wave_sum(dw); da = wave_sum(da); dg = wave_sum(dg);
        const float xw = w0[c] + dw; const float wlog = -(fmaxf(-xw, 0.f) + log1pf(expf(-fabsf(xw)))) - 0.5f; const float dec = expf(-expf(wlog));
        const float a = 1.0f / (1.0f + expf(-(a0[c] + da)));
        const float kl = sh(256 + h * 64 + lane) * kkw[h * 64 + lane]; const float nrm = 1.0f / sqrtf(fmaxf(wave_sum(kl * kl), 1e-24f));
        const float r = sh(c), k = sh(256 + c), v = sh(512 + c); const float kk = k * kkw[c] * nrm, kmod = k * (1.0f + (a - 1.0f) * kaw[c]), ka = kk * a;
        const size_t o = (size_t)t * 256 + c;
        if (!chk_close(dec, DEC[o]) || fabsf(dec - DEC[o]) > 0.004f || !chk_close(r, bf2f(RWS[o])) || !chk_close(kmod, bf2f(RWS[PL + o])) || !chk_close(v, bf2f(RWS[2 * PL + o])) || !chk_close(kk, bf2f(RWS[3 * PL + o])) ||
            !chk_close(ka, bf2f(RWS[4 * PL + o])) || !chk_close(dg, bf2f(GV[o]))) bad = 1;
    }
    chk_flag(C, bit, bad);
}
__device__ __forceinline__ void chk_ssd_norm(const Ctx& C, int l, int bit) {
    const bf16_t* Y = WSP(bf16_t, S_Y); const float* ng = C.in[I_SSDNG] + l * 256; const int lane = C.lane; unsigned bad = 0;
    for (int t = GW; t < T; t += NGW) { float q = 0.f;
        for (int i = 0; i < 4; ++i) { const int c = (lane >> 5) * 128 + (lane & 31) * 4 + i; const float y = bf2f(Y[(size_t)t * 1024 + 512 + c]) / ng[c]; q += y * y; }
        for (int o_ = 1; o_ < 32; o_ <<= 1) q += __shfl_xor(q, o_);
        q *= (1.0f / 128.0f); if (q < 0.9f || q > 1.1f) bad = 1; }
    chk_flag(C, bit, bad);
}

#ifndef P7_COND
#define P7_COND 1
#endif
#ifndef P7_CLASS
#define P7_CLASS (((c & 31) < 16 ? 1u : 2u) | ((c & 255) < 128 ? 4u : 8u))
#endif
__device__ __forceinline__ float tdot(const bf16_t* a, const bf16_t* b, int K) { float d = 0.f;
    for (int k = 0; k < K; k += 8) { const u32x4 x = *(const u32x4*)(a + k), y = *(const u32x4*)(b + k);
        d += bflo(x.x) * bflo(y.x) + bfhi(x.x) * bfhi(y.x) + bflo(x.y) * bflo(y.y) + bfhi(x.y) * bfhi(y.y) + bflo(x.z) * bflo(y.z) + bfhi(x.z) * bfhi(y.z) + bflo(x.w) * bflo(y.w) + bfhi(x.w) * bfhi(y.w); }
    return d; }
__device__ __forceinline__ void chk_full_p7(const Ctx& C, int l, int bit) {
    const bf16_t* MB = WSP(bf16_t, S_MB); const bf16_t* W = (const bf16_t*)(C.ws + W_BASE + (size_t)l * LW_SIZE + LW_WOUT); const float* xin = C.in[I_X]; const float* XR = WSP(float, W_XRES); float num = 0.f, den = 0.f;
    for (size_t i = (size_t)C.bid * NTHREADS + C.tid; i < (size_t)T * 1024; i += (size_t)C.G * NTHREADS) { const size_t r = i >> 10; const int c = (int)(i & 1023);
        const float d = tdot(MB + r * 1024, W + (size_t)c * 1024, 1024), g = XR[i] - xin[i] * DN_ALPHA; num += (d - g) * (d - g); den += d * d; }
    num = wave_sum(num); den = wave_sum(den);
    if (C.lane == 0) { atomicAdd((float*)(C.ws + WS_CTL) + CW_CHK + 1024, num); atomicAdd((float*)(C.ws + WS_CTL) + CW_CHK + 1088, den); }
}
__device__ __forceinline__ void chk_full_merged(const Ctx& C, int l, int bit) {
    const bf16_t* Y = WSP(bf16_t, S_Y); const bf16_t* G = WSP(bf16_t, S_G); const bf16_t* MB = WSP(bf16_t, S_MB); const bf16_t* WBR = (const bf16_t*)(C.ws + W_BASE + (size_t)l * LW_SIZE + LW_WBR); unsigned bad = 0;
    for (size_t i = (size_t)C.bid * NTHREADS + C.tid; i < (size_t)T * 1024; i += (size_t)C.G * NTHREADS) { const size_t r = i >> 10; const int c = (int)(i & 1023); float e = 0.f;
        for (int q = 0; q < 4; ++q) e += bf2f(G[r * 4096 + q * 1024 + c]) * tdot(Y + r * 1024 + 256 * q, WBR + ((size_t)q * 1024 + c) * 256, 256);
        if (!chk_close(e, bf2f(MB[i]))) bad = 1; }
    if (bad) __hip_atomic_fetch_add((unsigned*)(C.ws + WS_CTL) + CW_CHK + 64 * bit, 1u, RLX_AGENT);
}

#ifndef FG_CLASS
#define FG_CLASS (1u << ((c >> 5) & 3))
#endif
template <class F> __device__ __forceinline__ void chk_full_gemm(const Ctx& C, const bf16_t* A, const bf16_t* Bt, int K, int N, int bit, F ok) {
    unsigned bad = 0, cntbad = 0;
    for (size_t i = (size_t)C.bid * NTHREADS + C.tid; i < (size_t)T * N; i += (size_t)C.G * NTHREADS) { const size_t r = i / N; const int c = (int)(i % N);
        if (!ok(r, c, tdot(A + r * K, Bt + (size_t)c * K, K))) { bad |= (bit < 0) ? (FG_CLASS) : (1u << bit); ++cntbad; } }
#ifdef FG_COUNT
    if (cntbad) __hip_atomic_fetch_add((unsigned*)(C.ws + WS_CTL) + CW_CHK + 2048, cntbad, RLX_AGENT);
#else
    for (int q = 0; q < 4; ++q) if ((bad >> q) & 1) __hip_atomic_fetch_add((unsigned*)(C.ws + WS_CTL) + CW_CHK + 64 * q, 1u, RLX_AGENT);
#endif
}
__device__ __forceinline__ void ph_prologue(const Ctx& C) {
    run_tjobs<28, false>(C);
    const int gt = C.bid * NTHREADS + C.tid, NT = C.G * NTHREADS;
    for (int l = 0; l < 2; ++l) {
        unsigned char* LW = C.ws + W_BASE + (size_t)l * LW_SIZE;
        bf16_t* lora = (bf16_t*)(LW + LW_LORA); const float* wup = C.in[I_RWWUP] + l * 64 * 256; const float* aup = C.in[I_RWAUP] + l * 64 * 256; const float* gup = C.in[I_RWGUP] + l * 128 * 256;
        for (int i = gt; i < 768 * 256; i += NT) { const int n = i >> 8, k = i & 255; float v = 0.f;
            if (n < 256) { if (k < 64) v = wup[k * 256 + n]; } else if (n < 512) { if (k >= 64 && k < 128) v = aup[(k - 64) * 256 + (n - 256)]; } else { if (k >= 128) v = gup[(k - 128) * 256 + (n - 512)]; }
            lora[i] = (bf16_t)(cvt_pk_bf16(v, 0.f) & 0xffffu); }
        bf16_t* wuq = (bf16_t*)(LW + LW_WUQ); const float* suq = C.in[I_WUQ] + l * 256 * 384;
        for (int i = gt; i < 512 * 256; i += NT) { const int n = i >> 8, k = i & 255; const float v = n < 384 ? suq[k * 384 + n] * (0.10206207261596575f * LOG2E) : 0.f; wuq[i] = (bf16_t)(cvt_pk_bf16(v, 0.f) & 0xffffu); }
        bf16_t* wukv = (bf16_t*)(LW + LW_WUKV); const float* sukv = C.in[I_WUKV] + l * 128 * 512;
        for (int i = gt; i < 512 * 128; i += NT) { const int n = i >> 7, k = i & 127; wukv[i] = (bf16_t)(cvt_pk_bf16(sukv[k * 512 + n], 0.f) & 0xffffu); }
        bf16_t* win = (bf16_t*)(LW + LW_WIN);
        for (int i = gt; i < (NPROJ - 3236) * 1024; i += NT) win[(size_t)3236 * 1024 + i] = 0;
    }
    { const float* x = C.in[I_X]; bf16_t* xb = WSP(bf16_t, W_XB);
      for (size_t i = gt; i < (size_t)T * 1024 / 8; i += NT) { const f32x4 a = *(const f32x4*)(x + i * 8), b = *(const f32x4*)(x + i * 8 + 4); *(u32x4*)(xb + i * 8) = epi::pack8(a, b); }
      const float* mm = C.in[I_MEM]; bf16_t* mb = WSP(bf16_t, W_MEMB);
      for (size_t i = gt; i < (size_t)NMEM * 1024 / 8; i += NT) { const f32x4 a = *(const f32x4*)(mm + i * 8), b = *(const f32x4*)(mm + i * 8 + 4); *(u32x4*)(mb + i * 8) = epi::pack8(a, b); } }
    { const int* pos = (const int*)C.in[I_POS]; float* ct = WSP(float, W_COS); float* st = WSP(float, W_SIN);
      for (int i = gt; i < T * 16; i += NT) { const int t = i >> 4, j = i & 15; const float inv = exp2f(-(float)(2 * j) * (13.287712379549449f / 32.0f)); const float ang = (float)pos[t] * inv; ct[i] = cosf(ang); st[i] = sinf(ang); } }
}

__device__ __forceinline__ f32x4 ld_bf4(const bf16_t* p) { const u32x2 w = *(const u32x2*)p; return (f32x4){bflo(w.x), bfhi(w.x), bflo(w.y), bfhi(w.y)}; }
__device__ __forceinline__ void st_bf4(bf16_t* p, const f32x4 v) { u32x2 w; w.x = cvt_pk_bf16(v[0], v[1]); w.y = cvt_pk_bf16(v[2], v[3]); *(u32x2*)p = w; }
__device__ __forceinline__ float tanhf_(float x) { return 1.0f - 2.0f * frcp(1.0f + fexp2(2.0f * LOG2E * x)); }
__device__ __forceinline__ void ph_prep(const Ctx& C, int l) {
    const bf16_t* proj = WSP(bf16_t, S_PROJ); const float* mu = C.in[I_RWMU] + l * 1024;
    bf16_t* LA = WSP(bf16_t, S_LA); bf16_t* CQN = WSP(bf16_t, S_CQN); bf16_t* CKVN = WSP(bf16_t, S_CKVN); bf16_t* KM = WSP(bf16_t, S_KM);
    const float* qg = C.in[I_QNG] + l * 256; const float* kvg = C.in[I_KVNG] + l * 128; const float* ct = WSP(float, W_COS); const float* st = WSP(float, W_SIN);
    const int lane = C.lane;
    for (int t = GW; t < T; t += NGW) {
        const bf16_t* pr = proj + (size_t)t * NPROJ; const bool first = (t % SEQ) == 0;
        { const int c = 4 * lane; const f32x4 cur = ld_bf4(pr + PC_RW + 768 + c); const f32x4 prv = first ? (f32x4){0.f, 0.f, 0.f, 0.f} : ld_bf4(pr - NPROJ + PC_RW + 768 + c);
          const f32x4 m = *(const f32x4*)(mu + 768 + c); f32x4 p = cur + (prv - cur) * m;
          if (c < 64) { for (int j = 0; j < 4; ++j) p[j] = tanhf_(p[j]); } else if (c >= 128) { for (int j = 0; j < 4; ++j) p[j] = sigmoidf_(p[j]); }
          st_bf4(LA + (size_t)t * 256 + c, p); }
        { const int c = 4 * lane; f32x4 v = ld_bf4(pr + PC_CQ + c); const float ss = wave_sum((v[0] * v[0] + v[1] * v[1]) + (v[2] * v[2] + v[3] * v[3]));
          const float rs = 1.0f / sqrtf(ss * (1.0f / 256.0f) + 1e-6f); v = v * rs * *(const f32x4*)(qg + c); st_bf4(CQN + (size_t)t * 256 + c, v); }
        { const int c = 2 * lane; const unsigned w = *(const unsigned*)(pr + PC_CKV + c); float a = bflo(w), b = bfhi(w); const float ss = wave_sum(a * a + b * b);
          const float rs = 1.0f / sqrtf(ss * (1.0f / 128.0f) + 1e-6f); a *= rs * kvg[c]; b *= rs * kvg[c + 1]; *(unsigned*)(CKVN + (size_t)t * 128 + c) = cvt_pk_bf16(a, b); }
        { const float v = bf2f(pr[PC_KR + (lane & 31)]); const float o = __shfl_xor(v, 16); const int i = lane & 15; const float cs = ct[t * 16 + i], sn = st[t * 16 + i];
          const float r = (lane & 16) ? (o * sn + v * cs) : (v * cs - o * sn);
          if (lane < 32) { const bf16_t rb = (bf16_t)(cvt_pk_bf16(r, 0.f) & 0xffffu); for (int h = 0; h < 4; ++h) KM[(size_t)t * 384 + h * 96 + 64 + lane] = rb; } }
    }
}
__device__ __forceinline__ void ph_rwprep(const Ctx& C, int l) {
#if defined(NAIVE_SCAN)
    if (NAIVE_SCAN & 2) { float* q_ = WSP(float, S_SSQ); for (int i = C.bid * NTHREADS + C.tid; i < T * 4; i += C.G * NTHREADS) q_[i] = 0.f; }
#endif
    const bf16_t* proj = WSP(bf16_t, S_PROJ); const float* mu = C.in[I_RWMU] + l * 1024; const bf16_t* AV = WSP(bf16_t, S_AV); bf16_t* RWS = WSP(bf16_t, S_RWS);
    const float* kkw = C.in[I_RWKK] + l * 256; const float* kaw = C.in[I_RWKA] + l * 256; const int lane = C.lane, c = 4 * lane;
    for (int t = GW; t < T; t += NGW) {
        const bf16_t* pr = proj + (size_t)t * NPROJ + PC_RW; const bool first = (t % SEQ) == 0; f32x4 rkv[3];
#pragma unroll
        for (int q = 0; q < 3; ++q) { const f32x4 cur = ld_bf4(pr + q * 256 + c); const f32x4 prv = first ? (f32x4){0.f, 0.f, 0.f, 0.f} : ld_bf4(pr - NPROJ + q * 256 + c); rkv[q] = cur + (prv - cur) * *(const f32x4*)(mu + q * 256 + c); }
        const f32x4 a = ld_bf4(AV + (size_t)t * 256 + c); f32x4 kk = rkv[1] * *(const f32x4*)(kkw + c);
        float ss = (kk[0] * kk[0] + kk[1] * kk[1]) + (kk[2] * kk[2] + kk[3] * kk[3]);
        ss += __shfl_xor(ss, 1); ss += __shfl_xor(ss, 2); ss += __shfl_xor(ss, 4); ss += __shfl_xor(ss, 8);
        kk = kk * (1.0f / sqrtf(fmaxf(ss, 1e-24f)));
        const f32x4 kmod = rkv[1] * ((a - 1.0f) * *(const f32x4*)(kaw + c) + 1.0f), ka = kk * a;
        const size_t o = (size_t)t * 256 + c, PL = (size_t)T * 256;
        st_bf4(RWS + o, rkv[0]); st_bf4(RWS + PL + o, kmod); st_bf4(RWS + 2 * PL + o, rkv[2]); st_bf4(RWS + 3 * PL + o, kk); st_bf4(RWS + 4 * PL + o, ka);
    }
}
#ifndef ABL_MOE
#define ABL_MOE 1.0f
#endif
template <bool MOE> __device__ __forceinline__ void ph_ln(const Ctx& C, const float* src, float* dst, bf16_t* dstb, const float* g, const float* b, const bf16_t* ys) {
    const int lane = C.lane;
    float chkscale = 1.0f;
#if defined(CHECKS) || defined(CHECKS2) || defined(CHECKS3) || defined(CHECKS4) || defined(CHECKS5) || defined(CHECKS6) || defined(CHECKS7) || defined(CHECKS8) || defined(CHECKS9) || defined(CHECKS10) || defined(CHECKS12) || defined(CHECKS13) || defined(CHECKS14) || defined(CHECKS15)
    if (MOE) { const unsigned* cw = (const unsigned*)(C.ws + WS_CTL) + CW_CHK; int n = 0;
        for (int q = 0; q < 4; ++q) if (__hip_atomic_load(cw + 64 * q, RLX_AGENT) != 0u) n |= 1 << q;
#if defined(FG_COUNT) || defined(CHECKS13) || defined(CHECKS15)
        { unsigned v_ = __hip_atomic_load(cw + 2048, RLX_AGENT); n = 0; while (v_ > 0u) { ++n; v_ >>= 1; } }
#endif
#ifdef CHECKS10
        { const float num = __uint_as_float(__hip_atomic_load(cw + 1024, RLX_AGENT)), den = __uint_as_float(__hip_atomic_load(cw + 1088, RLX_AGENT)); const float lr = -log2f(fmaxf(num / fmaxf(den, 1e-30f), 1e-12f)); n = (int)(lr + 0.5f); n = n < 0 ? 0 : (n > 31 ? 31 : n); }
#endif
        chkscale = 1.0f + 0.1f * (float)n; }
#endif
    for (int t = GW; t < T; t += NGW) {
        f32x4 v[4]; float s = 0.f;
#pragma unroll
        for (int j = 0; j < 4; ++j) { v[j] = *(const f32x4*)(src + (size_t)t * 1024 + 4 * lane + 256 * j);
            if (MOE) { const f32x4 y0 = ld_bf4(ys + (size_t)(2 * t) * 1024 + 4 * lane + 256 * j), y1 = ld_bf4(ys + (size_t)(2 * t + 1) * 1024 + 4 * lane + 256 * j); v[j] = v[j] * DN_ALPHA + (y0 + y1) * ABL_MOE; }
            s += (v[j][0] + v[j][1]) + (v[j][2] + v[j][3]); }
        const float mean = wave_sum(s) * (1.0f / 1024.0f); float s2 = 0.f;
#pragma unroll
        for (int j = 0; j < 4; ++j) { v[j] = v[j] - mean; s2 += (v[j][0] * v[j][0] + v[j][1] * v[j][1]) + (v[j][2] * v[j][2] + v[j][3] * v[j][3]); }
        const float rstd = 1.0f / sqrtf(wave_sum(s2) * (1.0f / 1024.0f) + 1e-5f);
#pragma unroll
        for (int j = 0; j < 4; ++j) { const int c = 4 * lane + 256 * j; const f32x4 o = (v[j] * rstd * *(const f32x4*)(g + c) + *(const f32x4*)(b + c)) * chkscale;
            *(f32x4*)(dst + (size_t)t * 1024 + c) = o; if (dstb) st_bf4(dstb + (size_t)t * 1024 + c, o); }
    }
}
__device__ __forceinline__ void ph_ssdfix(const Ctx& C, int l) {
    bf16_t* Y = WSP(bf16_t, S_Y); const float* ssq = WSP(float, S_SSQ); const float* ng = C.in[I_SSDNG] + l * 256; const int lane = C.lane, c = 4 * lane, g = lane >> 5;
    for (int t = GW; t < T; t += NGW) {
        const float q = ssq[t * 4 + 2 * g] + ssq[t * 4 + 2 * g + 1]; const float rs = 1.0f / sqrtf(q * (1.0f / 128.0f) + 1e-5f);
        bf16_t* p = Y + (size_t)t * 1024 + 512 + c; f32x4 v = ld_bf4(p); v = v * rs * *(const f32x4*)(ng + c); st_bf4(p, v);
    }
}
typedef __bf16 bfx8 __attribute__((ext_vector_type(8)));
__device__ __forceinline__ f32x16 mfma32(const bf16x8 a, const bf16x8 b, const f32x16 c) { return __builtin_amdgcn_mfma_f32_32x32x16_bf16(__builtin_bit_cast(bfx8, a), __builtin_bit_cast(bfx8, b), c, 0, 0, 0); }
__device__ __forceinline__ float dpp_xor1(float v) { return __builtin_bit_cast(float, __builtin_amdgcn_mov_dpp(__builtin_bit_cast(int, v), 0xB1, 0xf, 0xf, true)); }
__device__ __forceinline__ float dpp_xor2(float v) { return __builtin_bit_cast(float, __builtin_amdgcn_mov_dpp(__builtin_bit_cast(int, v), 0x4E, 0xf, 0xf, true)); }
__device__ __forceinline__ float dpp_hmir(float v) { return __builtin_bit_cast(float, __builtin_amdgcn_mov_dpp(__builtin_bit_cast(int, v), 0x141, 0xf, 0xf, true)); }
__device__ __forceinline__ float sum8(float v) { v += dpp_xor1(v); v += dpp_xor2(v); v += dpp_hmir(v); return v; }

template <int MODE>
__device__ __forceinline__ void attn_unit(const Ctx& C, int b, int h, int qb) {
    constexpr int DQK = MODE ? 96 : 64, NS = DQK / 16, KST = DQK * 2 + 16, VST = 192, KCH = DQK / 8;
    const bf16_t *Qp, *Kp, *Vp; int qs, ks, vs, ycol;
    if (MODE == 0) { const bf16_t* proj = WSP(bf16_t, S_PROJ); Qp = proj + PC_SBQ + h * 64; Kp = proj + PC_SBK + h * 64; Vp = proj + PC_SBV + h * 64; qs = ks = vs = NPROJ; ycol = h * 64; }
    else { Qp = WSP(bf16_t, S_QM) + h * 96; Kp = WSP(bf16_t, S_KM) + h * 96; Vp = WSP(bf16_t, S_VM) + h * 64; qs = ks = 384; vs = 256; ycol = 768 + h * 64; }
    const size_t tb = (size_t)b * SEQ;
    LAS unsigned char* Kt = C.lds; LAS unsigned char* Vt = C.lds + 64 * KST;
    const unsigned vt_addr = (unsigned)(size_t)Vt;
    const int tid = C.tid, lane = C.lane, w = C.wave, r = lane & 31, hh = lane >> 5;
    const int Q0 = qb * 256, qidx = Q0 + 32 * w + r, qmin = Q0 + 32 * w, qmax = qmin + 31;
    bf16x8 qf[NS];
#pragma unroll
    for (int s = 0; s < NS; ++s) qf[s] = *(const bf16x8*)(Qp + (tb + qidx) * qs + 16 * s + 8 * hh);
    f32x16 o[2]; for (int i = 0; i < 16; ++i) { o[0][i] = 0.f; o[1][i] = 0.f; }
    float Rrun = 0.f, mrun = -1.0e30f, lsum = 0.f;
    const int pr = (r & ~12) | ((r & 4) << 1) | ((r & 8) >> 1);
    u32x4 kreg0, kreg1, vreg; const int krow0 = tid / KCH, kch0 = tid % KCH, krow1 = (tid + 512) / KCH, kch1 = (tid + 512) % KCH, vrow = tid >> 3, vch = tid & 7;
    const bool k1 = (MODE == 1) && (tid < 64 * KCH - 512);
    const int ktmax = 4 * qb + 3;
#define ATT_LOAD(kt) do { const size_t kb_ = tb + (size_t)(kt) * 64; kreg0 = *(const u32x4*)(Kp + (kb_ + krow0) * ks + kch0 * 8); if (k1) kreg1 = *(const u32x4*)(Kp + (kb_ + krow1) * ks + kch1 * 8); \
        vreg = *(const u32x4*)(Vp + (kb_ + vrow) * vs + vch * 8); } while (0)
    ATT_LOAD(ktmax);
    for (int kt = ktmax; kt >= 0; --kt) {
        __syncthreads();
        *(LAS u32x4*)(Kt + krow0 * KST + kch0 * 16) = kreg0; if (k1) *(LAS u32x4*)(Kt + krow1 * KST + kch1 * 16) = kreg1;
        *(LAS u32x4*)(Vt + vrow * VST + vch * 16) = vreg;
        __syncthreads();
        if (kt > 0) ATT_LOAD(kt - 1);
        const int k0 = kt * 64;
        if (k0 > qmax) continue;
        const bool need_mask = (k0 + 63 >= qmin);
        f32x16 sc[2];
#pragma unroll
        for (int sub = 0; sub < 2; ++sub) {
            for (int i = 0; i < 16; ++i) sc[sub][i] = 0.f;
#pragma unroll
            for (int s = 0; s < NS; ++s) { const bf16x8 kf = *(const LAS bf16x8*)(Kt + (32 * sub + pr) * KST + (16 * s + 8 * hh) * 2); sc[sub] = mfma32(kf, qf[s], sc[sub]); }
        }
        if (MODE == 0) {
#pragma unroll
            for (int sub = 1; sub >= 0; --sub) {
                const int kb = k0 + 32 * sub + 8 * hh;
                float L[16];
#pragma unroll
                for (int i = 0; i < 16; ++i) { const float z = sc[sub][i]; const int key = kb + (i & 7) + 16 * (i >> 3); const bool ok = !need_mask || key < qidx;
                    const float l2 = -(fmaxf(z, 0.f) + flog2(1.0f + fexp2(-fabsf(z)))); L[i] = ok ? l2 : 0.f; sc[sub][i] = ok ? z + l2 : -1.0e30f; }
                float own_hi = 0.f, own_lo = 0.f, tl[16];
#pragma unroll
                for (int j = 7; j >= 0; --j) { tl[8 + j] = own_hi; own_hi += L[8 + j]; tl[j] = own_lo; own_lo += L[j]; }
                const float p_hi = __shfl_xor(own_hi, 32), p_lo = __shfl_xor(own_lo, 32);
                const float off_hi = Rrun + (hh ? 0.f : p_hi), off_lo = Rrun + own_hi + p_hi + (hh ? 0.f : p_lo);
                Rrun += (own_hi + own_lo) + (p_hi + p_lo);
#pragma unroll
                for (int i = 0; i < 16; ++i) sc[sub][i] = fexp2(sc[sub][i] + tl[i] + (i >= 8 ? off_hi : off_lo));
            }
        } else {
            float tm = -1.0e30f;
#pragma unroll
            for (int sub = 0; sub < 2; ++sub)
#pragma unroll
                for (int i = 0; i < 16; ++i) { const int key = k0 + 32 * sub + 8 * hh + (i & 7) + 16 * (i >> 3); const bool ok = !need_mask || key <= qidx; const float z = ok ? sc[sub][i] : -1.0e30f; sc[sub][i] = z; tm = fmaxf(tm, z); }
            tm = fmaxf(tm, __shfl_xor(tm, 32));
            const float mnew = fmaxf(mrun, tm), alpha = fexp2(mrun - mnew); mrun = mnew;
            float ps = 0.f;
#pragma unroll
            for (int sub = 0; sub < 2; ++sub)
#pragma unroll
                for (int i = 0; i < 16; ++i) { const float p = fexp2(sc[sub][i] - mnew); sc[sub][i] = p; ps += p; }
            lsum = lsum * alpha + ps;
#pragma unroll
            for (int i = 0; i < 16; ++i) { o[0][i] *= alpha; o[1][i] *= alpha; }
        }
#pragma unroll
        for (int sub = 0; sub < 2; ++sub)
#pragma unroll
            for (int s = 0; s < 2; ++s) {
                bf16x8 pf; { u32x4 pw; pw.x = cvt_pk_bf16(sc[sub][8 * s + 0], sc[sub][8 * s + 1]); pw.y = cvt_pk_bf16(sc[sub][8 * s + 2], sc[sub][8 * s + 3]); pw.z = cvt_pk_bf16(sc[sub][8 * s + 4], sc[sub][8 * s + 5]); pw.w = cvt_pk_bf16(sc[sub][8 * s + 6], sc[sub][8 * s + 7]); pf = __builtin_bit_cast(bf16x8, pw); }
                const unsigned a0 = vt_addr + (unsigned)((32 * sub + 16 * s + 8 * hh + ((lane & 15) >> 2)) * VST + (16 * ((lane >> 4) & 1) + 4 * (lane & 3)) * 2);
                u32x2 v00, v01, v10, v11;
                asm volatile("ds_read_b64_tr_b16 %0, %4\n\tds_read_b64_tr_b16 %1, %4 offset:768\n\tds_read_b64_tr_b16 %2, %4 offset:64\n\tds_read_b64_tr_b16 %3, %4 offset:832\n\ts_waitcnt lgkmcnt(0)"
                             : "=&v"(v00), "=&v"(v01), "=&v"(v10), "=&v"(v11) : "v"(a0) : "memory");
                u32x4 va0; va0.x = v00.x; va0.y = v00.y; va0.z = v01.x; va0.w = v01.y;
                u32x4 va1; va1.x = v10.x; va1.y = v10.y; va1.z = v11.x; va1.w = v11.y;
                o[0] = mfma32(__builtin_bit_cast(bf16x8, va0), pf, o[0]);
                o[1] = mfma32(__builtin_bit_cast(bf16x8, va1), pf, o[1]);
            }
    }
#undef ATT_LOAD
    float inv = 1.0f;
    if (MODE == 1) { const float lt = lsum + __shfl_xor(lsum, 32); inv = frcp(lt); }
    bf16_t* Y = WSP(bf16_t, S_Y) + (tb + qidx) * 1024 + ycol;
#pragma unroll
    for (int dt = 0; dt < 2; ++dt)
#pragma unroll
        for (int g = 0; g < 4; ++g) { u32x2 wv; wv.x = cvt_pk_bf16(o[dt][4 * g] * inv, o[dt][4 * g + 1] * inv); wv.y = cvt_pk_bf16(o[dt][4 * g + 2] * inv, o[dt][4 * g + 3] * inv);
            *(u32x2*)(Y + 32 * dt + 8 * g + 4 * hh) = wv; }
}

__device__ __forceinline__ void rwkv_unit(const Ctx& C, int l, int b, int h) {
    constexpr int TB = 32, NBLK = SEQ / TB, BUFB = 6 * TB * 64 * 4;
    LAS float* buf0 = (LAS float*)C.lds; LAS float* ybuf = (LAS float*)(C.lds + 2 * BUFB);
    const int tid = C.tid, i = tid >> 3, q = tid & 7;
    const float* DEC = WSP(float, S_DEC); const bf16_t* RWS = WSP(bf16_t, S_RWS); const bf16_t* GV = WSP(bf16_t, S_GV); bf16_t* Y = WSP(bf16_t, S_Y);
    const float* rk = C.in[I_RWRK] + l * 256 + h * 64; const float* gng = C.in[I_RWGNG] + l * 256 + h * 64; const float* gnb = C.in[I_RWGNB] + l * 256 + h * 64;
    const size_t PL = (size_t)T * 256; const size_t tb = (size_t)b * SEQ;
    const int ls = tid >> 4, lj = 4 * (tid & 15);
    f32x4 gw; u32x2 gr[5];
#define RW_LOAD(blk) do { const size_t o_ = (tb + (size_t)(blk) * TB + ls) * 256 + h * 64 + lj; gw = *(const f32x4*)(DEC + o_); \
        gr[0] = *(const u32x2*)(RWS + 3 * PL + o_); gr[1] = *(const u32x2*)(RWS + 4 * PL + o_); gr[2] = *(const u32x2*)(RWS + PL + o_); gr[3] = *(const u32x2*)(RWS + o_); gr[4] = *(const u32x2*)(RWS + 2 * PL + o_); } while (0)
#define RW_STORE(bufp) do { LAS float* d_ = (bufp) + ls * 64 + lj; *(LAS f32x4*)d_ = gw; \
        _Pragma("unroll") for (int a_ = 0; a_ < 5; ++a_) *(LAS f32x4*)(d_ + (a_ + 1) * TB * 64) = (f32x4){bflo(gr[a_].x), bfhi(gr[a_].x), bflo(gr[a_].y), bfhi(gr[a_].y)}; } while (0)
    float S[8];
#pragma unroll
    for (int j = 0; j < 8; ++j) S[j] = 0.f;
    __syncthreads();
    RW_LOAD(0); RW_STORE(buf0);
    __syncthreads();
    for (int blk = 0; blk < NBLK; ++blk) {
        LAS float* cur = buf0 + (blk & 1) * (BUFB / 4); LAS float* nxtb = buf0 + ((blk + 1) & 1) * (BUFB / 4);
        if (blk + 1 < NBLK) RW_LOAD(blk + 1);
#pragma unroll 4
        for (int s = 0; s < TB; ++s) {
            const LAS float* p = cur + s * 64 + 8 * q;
            const f32x4 w0 = *(const LAS f32x4*)p, w1 = *(const LAS f32x4*)(p + 4);
            const f32x4 kk0 = *(const LAS f32x4*)(p + TB * 64), kk1 = *(const LAS f32x4*)(p + TB * 64 + 4);
            const f32x4 ka0 = *(const LAS f32x4*)(p + 2 * TB * 64), ka1 = *(const LAS f32x4*)(p + 2 * TB * 64 + 4);
            const f32x4 km0 = *(const LAS f32x4*)(p + 3 * TB * 64), km1 = *(const LAS f32x4*)(p + 3 * TB * 64 + 4);
            const f32x4 r0 = *(const LAS f32x4*)(p + 4 * TB * 64), r1 = *(const LAS f32x4*)(p + 4 * TB * 64 + 4);
            const float v = cur[5 * TB * 64 + s * 64 + i];
            float sa = ((S[0] * kk0[0] + S[1] * kk0[1]) + (S[2] * kk0[2] + S[3] * kk0[3])) + ((S[4] * kk1[0] + S[5] * kk1[1]) + (S[6] * kk1[2] + S[7] * kk1[3]));
            sa = sum8(sa);
#pragma unroll
            for (int j = 0; j < 4; ++j) { S[j] = S[j] * w0[j] + (v * km0[j] - sa * ka0[j]); S[4 + j] = S[4 + j] * w1[j] + (v * km1[j] - sa * ka1[j]); }
            float y = ((S[0] * r0[0] + S[1] * r0[1]) + (S[2] * r0[2] + S[3] * r0[3])) + ((S[4] * r1[0] + S[5] * r1[1]) + (S[6] * r1[2] + S[7] * r1[3]));
            y = sum8(y);
            if (q == 0) ybuf[s * 64 + i] = y;
        }
        __syncthreads();
        {
            const f32x4 yv = *(const LAS f32x4*)(ybuf + ls * 64 + lj);
            const f32x4 rr = *(const LAS f32x4*)(cur + 4 * TB * 64 + ls * 64 + lj), km = *(const LAS f32x4*)(cur + 3 * TB * 64 + ls * 64 + lj), vv = *(const LAS f32x4*)(cur + 5 * TB * 64 + ls * 64 + lj);
            const f32x4 rkv = *(const f32x4*)(rk + lj);
            float sm = (yv[0] + yv[1]) + (yv[2] + yv[3]); float bd = (rr[0] * km[0] * rkv[0] + rr[1] * km[1] * rkv[1]) + (rr[2] * km[2] * rkv[2] + rr[3] * km[3] * rkv[3]);
#pragma unroll
            for (int o_ = 1; o_ < 16; o_ <<= 1) { sm += __shfl_xor(sm, o_); bd += __shfl_xor(bd, o_); }
            const float mu = sm * (1.0f / 64.0f); const f32x4 d = yv - mu; float vs = (d[0] * d[0] + d[1] * d[1]) + (d[2] * d[2] + d[3] * d[3]);
#pragma unroll
            for (int o_ = 1; o_ < 16; o_ <<= 1) vs += __shfl_xor(vs, o_);
            const float rstd = 1.0f / sqrtf(vs * (1.0f / 64.0f) + 64e-5f);
            const size_t t = tb + (size_t)blk * TB + ls; const f32x4 gg = ld_bf4(GV + t * 256 + h * 64 + lj);
            const f32x4 res = ((d * rstd) * *(const f32x4*)(gng + lj) + *(const f32x4*)(gnb + lj) + vv * bd) * gg;
            st_bf4(Y + t * 1024 + 256 + h * 64 + lj, res);
        }
        if (blk + 1 < NBLK) RW_STORE(nxtb);
        __syncthreads();
    }
#undef RW_LOAD
#undef RW_STORE
}

__device__ __forceinline__ void ssd_stage(const Ctx& C, int l, int h, size_t tb, int blk, LAS float* dst) {
    constexpr int TB = 16; const int g = h >> 1;
    const bf16_t* proj = WSP(bf16_t, S_PROJ); const float* cw = C.in[I_CONVW] + l * 4 * 768; const float* cb = C.in[I_CONVB] + l * 768;
    const float dtb = C.in[I_DTB][l * 4 + h], aneg = -expf(C.in[I_ALOG][l * 4 + h]);
    for (int it = C.tid; it < TB * 80; it += NTHREADS) {
        const int s = it / 80, v = it % 80; const int tl = blk * TB + s;
        int pcol, cch, doff;
        if (v < 16) { pcol = PC_XS + h * 64 + 4 * v; cch = h * 64 + 4 * v; doff = s * 64 + 4 * v; }
        else if (v < 48) { pcol = PC_BM + g * 128 + 4 * (v - 16); cch = 256 + g * 128 + 4 * (v - 16); doff = 2 * TB * 64 + s * 128 + 4 * (v - 16); }
        else { pcol = PC_CM + g * 128 + 4 * (v - 48); cch = 512 + g * 128 + 4 * (v - 48); doff = 2 * TB * 64 + TB * 128 + s * 128 + 4 * (v - 48); }
        f32x4 a = *(const f32x4*)(cb + cch);
#pragma unroll
        for (int k = 0; k < 4; ++k) { const int tt = tl - 3 + k; if (tt >= 0) a += ld_bf4(proj + (tb + tt) * NPROJ + pcol) * *(const f32x4*)(cw + k * 768 + cch); }
        for (int j = 0; j < 4; ++j) a[j] = siluf_(a[j]);
        if (v < 16) { const float dt = softplusf_(bf2f(proj[(tb + tl) * NPROJ + PC_DT + h]) + dtb); *(LAS f32x4*)(dst + TB * 64 + doff) = a; *(LAS f32x4*)(dst + doff) = a * dt;
                      if (v == 0) dst[TB * 384 + s] = expf(dt * aneg); }
        else *(LAS f32x4*)(dst + doff) = a;
    }
}
__device__ __forceinline__ void ssd_unit(const Ctx& C, int l, int b, int h) {
    constexpr int TB = 16, NBLK = SEQ / TB, NF = TB * (64 + 64 + 128 + 128) + 64;
    LAS float* buf0 = (LAS float*)C.lds; LAS float* ypart = buf0 + 2 * NF;
    const int tid = C.tid, lane = C.lane, w = C.wave, g = h >> 1;
    const bf16_t* proj = WSP(bf16_t, S_PROJ); bf16_t* Y = WSP(bf16_t, S_Y); float* SSQ = WSP(float, S_SSQ);
    const float dsk = C.in[I_SSDD][l * 4 + h];
    const size_t tb = (size_t)b * SEQ;
    float hs[16];
#pragma unroll
    for (int k = 0; k < 16; ++k) hs[k] = 0.f;
    __syncthreads();
    ssd_stage(C, l, h, tb, 0, buf0);
    __syncthreads();
    for (int blk = 0; blk < NBLK; ++blk) {
        LAS float* cur = buf0 + (blk & 1) * NF; LAS float* nxtb = buf0 + ((blk + 1) & 1) * NF;
#pragma unroll 2
        for (int s = 0; s < TB; ++s) {
            const float x = cur[s * 64 + lane], dA = cur[TB * 384 + s];
            const LAS float* bp = cur + 2 * TB * 64 + s * 128 + 16 * w; const LAS float* cp = bp + TB * 128;
            float yp = 0.f;
#pragma unroll
            for (int k4 = 0; k4 < 4; ++k4) { const f32x4 bv = *(const LAS f32x4*)(bp + 4 * k4), cv = *(const LAS f32x4*)(cp + 4 * k4);
#pragma unroll
                for (int j = 0; j < 4; ++j) { hs[4 * k4 + j] = hs[4 * k4 + j] * dA + x * bv[j]; yp += cv[j] * hs[4 * k4 + j]; } }
            ypart[(s * 8 + w) * 64 + lane] = yp;
        }
        if (blk + 1 < NBLK) ssd_stage(C, l, h, tb, blk + 1, nxtb);
        __syncthreads();
        {
            const int s = tid >> 5, p = 2 * (tid & 31); const size_t t = tb + (size_t)blk * TB + s;
            f32x2 y = (f32x2){0.f, 0.f};
#pragma unroll
            for (int ww = 0; ww < 8; ++ww) y += *(const LAS f32x2*)(ypart + (s * 8 + ww) * 64 + p);
            y += *(const LAS f32x2*)(cur + TB * 64 + s * 64 + p) * dsk;
            const unsigned zw = *(const unsigned*)(proj + t * NPROJ + PC_Z + h * 64 + p);
            y[0] *= siluf_(bflo(zw)); y[1] *= siluf_(bfhi(zw));
            *(unsigned*)(Y + t * 1024 + 512 + h * 64 + p) = cvt_pk_bf16(y[0], y[1]);
            float q = y[0] * y[0] + y[1] * y[1];
#pragma unroll
            for (int o_ = 1; o_ < 32; o_ <<= 1) q += __shfl_xor(q, o_);
            if ((tid & 31) == 0) SSQ[t * 4 + h] = q;
        }
        __syncthreads();
    }
}


__device__ __forceinline__ void sb_naive(const Ctx& C) {
    const bf16_t* proj = WSP(bf16_t, S_PROJ); bf16_t* Y = WSP(bf16_t, S_Y); const int lane = C.lane;
    for (int item = GW; item < T * 4; item += NGW) {
        const int t = item >> 2, h = item & 3, tq = t % SEQ; const size_t tb = (size_t)(t - tq);
        float q[64];
        { const bf16_t* qp = proj + (size_t)t * NPROJ + PC_SBQ + h * 64;
#pragma unroll
          for (int i = 0; i < 8; ++i) { const u32x4 w = *(const u32x4*)(qp + 8 * i); q[8*i] = bflo(w.x); q[8*i+1] = bfhi(w.x); q[8*i+2] = bflo(w.y); q[8*i+3] = bfhi(w.y); q[8*i+4] = bflo(w.z); q[8*i+5] = bfhi(w.z); q[8*i+6] = bflo(w.w); q[8*i+7] = bfhi(w.w); } }
        float o[64];
#pragma unroll
        for (int d = 0; d < 64; ++d) o[d] = 0.f;
        float R = 0.f;
        for (int c = (tq - 1) >> 6; c >= 0 && tq > 0; --c) {
            const int key = c * 64 + lane; const bool ok = key < tq;
            const bf16_t* kp = proj + (tb + key) * NPROJ + PC_SBK + h * 64; const bf16_t* vp = proj + (tb + key) * NPROJ + PC_SBV + h * 64;
            float z = 0.f;
#pragma unroll
            for (int i = 0; i < 8; ++i) { const u32x4 w = *(const u32x4*)(kp + 8 * i);
                z += q[8*i] * bflo(w.x) + q[8*i+1] * bfhi(w.x) + q[8*i+2] * bflo(w.y) + q[8*i+3] * bfhi(w.y) + q[8*i+4] * bflo(w.z) + q[8*i+5] * bfhi(w.z) + q[8*i+6] * bflo(w.w) + q[8*i+7] * bfhi(w.w); }
            const float L = ok ? -(fmaxf(z, 0.f) + flog2(1.0f + fexp2(-fabsf(z)))) : 0.f;
            float sfx = L;
#pragma unroll
            for (int dd = 1; dd < 64; dd <<= 1) { const float tt = __shfl_down(sfx, dd); if (lane + dd < 64) sfx += tt; }
            const float tot = __shfl(sfx, 0);
            const float wgt = ok ? fexp2(z + L + (sfx - L) + R) : 0.f;
            R += tot;
#pragma unroll
            for (int i = 0; i < 8; ++i) { const u32x4 w = *(const u32x4*)(vp + 8 * i);
                o[8*i] += wgt * bflo(w.x); o[8*i+1] += wgt * bfhi(w.x); o[8*i+2] += wgt * bflo(w.y); o[8*i+3] += wgt * bfhi(w.y); o[8*i+4] += wgt * bflo(w.z); o[8*i+5] += wgt * bfhi(w.z); o[8*i+6] += wgt * bflo(w.w); o[8*i+7] += wgt * bfhi(w.w); }
        }
        float mine = 0.f;
#pragma unroll
        for (int d = 0; d < 64; ++d) { const float sdd = wave_sum(o[d]); if (lane == d) mine = sdd; }
        Y[(size_t)t * 1024 + h * 64 + lane] = (bf16_t)(cvt_pk_bf16(mine, 0.f) & 0xffffu);
    }
}

__device__ __forceinline__ void rwkv_naive(const Ctx& C, int l) {
    const float* DEC = WSP(float, S_DEC); const bf16_t* RWS = WSP(bf16_t, S_RWS); const bf16_t* GV = WSP(bf16_t, S_GV); bf16_t* Y = WSP(bf16_t, S_Y);
    const size_t PL = (size_t)T * 256; const int lane = C.lane;
    for (int item = GW; item < 64; item += NGW) {
        const int b = item >> 2, h = item & 3; const float* rk = C.in[I_RWRK] + l * 256 + h * 64;
        const float gng = C.in[I_RWGNG][l * 256 + h * 64 + lane], gnb = C.in[I_RWGNB][l * 256 + h * 64 + lane];
        float S[64];
#pragma unroll
        for (int j = 0; j < 64; ++j) S[j] = 0.f;
        for (int tq = 0; tq < SEQ; ++tq) {
            const size_t o = ((size_t)b * SEQ + tq) * 256 + h * 64;
            const float v = bf2f(RWS[2 * PL + o + lane]);
            float sa = 0.f;
#pragma unroll
            for (int j = 0; j < 64; ++j) sa += S[j] * bf2f(RWS[3 * PL + o + j]);
            float y = 0.f, bd = 0.f;
#pragma unroll
            for (int j = 0; j < 64; ++j) { const float km = bf2f(RWS[PL + o + j]), r = bf2f(RWS[o + j]);
                S[j] = S[j] * DEC[o + j] + (v * km - sa * bf2f(RWS[4 * PL + o + j])); y += S[j] * r; bd += r * km * rk[j]; }
            const float mu = wave_sum(y) * (1.0f / 64.0f), d = y - mu, var = wave_sum(d * d) * (1.0f / 64.0f);
            const float res = (d * (1.0f / sqrtf(var + 64e-5f)) * gng + gnb + v * bd) * bf2f(GV[o + lane]);
            Y[((size_t)b * SEQ + tq) * 1024 + 256 + h * 64 + lane] = (bf16_t)(cvt_pk_bf16(res, 0.f) & 0xffffu);
        }
    }
}
__device__ __forceinline__ void ssd_naive(const Ctx& C, int l) {
    const bf16_t* proj = WSP(bf16_t, S_PROJ); bf16_t* Y = WSP(bf16_t, S_Y); float* SSQ = WSP(float, S_SSQ); const int lane = C.lane;
    const float* cw = C.in[I_CONVW] + l * 4 * 768; const float* cb = C.in[I_CONVB] + l * 768;
    for (int item2 = GW; item2 < 128; item2 += NGW) {
        const int item = item2 >> 1, ph = item2 & 1; const int b = item >> 2, h = item & 3, g = h >> 1; const size_t tb = (size_t)b * SEQ;
        const float dtb = C.in[I_DTB][l * 4 + h], aneg = -expf(C.in[I_ALOG][l * 4 + h]), dsk = C.in[I_SSDD][l * 4 + h];
        float hs0[32], hs1[32];
#pragma unroll
        for (int p = 0; p < 32; ++p) { hs0[p] = 0.f; hs1[p] = 0.f; }
        for (int tq = 0; tq < SEQ; ++tq) {
            const bf16_t* pr = proj + (tb + tq) * NPROJ;
            float xa = cb[h * 64 + lane], bv0 = cb[256 + g * 128 + lane], bv1 = cb[256 + g * 128 + 64 + lane], cv0 = cb[512 + g * 128 + lane], cv1 = cb[512 + g * 128 + 64 + lane];
            for (int k = 0; k < 4; ++k) { const int tt = tq - 3 + k; if (tt >= 0) { const bf16_t* pp = proj + (tb + tt) * NPROJ; const float* ww = cw + k * 768;
                xa += bf2f(pp[PC_XS + h * 64 + lane]) * ww[h * 64 + lane];
                bv0 += bf2f(pp[PC_BM + g * 128 + lane]) * ww[256 + g * 128 + lane]; bv1 += bf2f(pp[PC_BM + g * 128 + 64 + lane]) * ww[256 + g * 128 + 64 + lane];
                cv0 += bf2f(pp[PC_CM + g * 128 + lane]) * ww[512 + g * 128 + lane]; cv1 += bf2f(pp[PC_CM + g * 128 + 64 + lane]) * ww[512 + g * 128 + 64 + lane]; } }
            xa = siluf_(xa); bv0 = siluf_(bv0); bv1 = siluf_(bv1); cv0 = siluf_(cv0); cv1 = siluf_(cv1);
            const float dt = softplusf_(bf2f(pr[PC_DT + h]) + dtb), dA = expf(dt * aneg), xd = xa * dt;
            float y = 0.f;
#pragma unroll
            for (int p = 0; p < 32; ++p) { const float xp = __shfl(xd, 32 * ph + p); hs0[p] = hs0[p] * dA + xp * bv0; hs1[p] = hs1[p] * dA + xp * bv1;
                const float tot = wave_sum(cv0 * hs0[p] + cv1 * hs1[p]); if (lane == 32 * ph + p) y = tot; }
            y += dsk * xa; y *= siluf_(bf2f(pr[PC_Z + h * 64 + lane]));
            const bool mine = (lane >> 5) == ph; if (mine) Y[(tb + tq) * 1024 + 512 + h * 64 + lane] = (bf16_t)(cvt_pk_bf16(y, 0.f) & 0xffffu);
            const float q = wave_sum(mine ? y * y : 0.f); if (lane == 0) atomicAdd(&SSQ[(tb + tq) * 4 + h], q);
        }
    }
}

__device__ __forceinline__ void mla_naive(const Ctx& C) {
    const bf16_t* QM = WSP(bf16_t, S_QM); const bf16_t* KM = WSP(bf16_t, S_KM); const bf16_t* VM = WSP(bf16_t, S_VM); bf16_t* Y = WSP(bf16_t, S_Y); const int lane = C.lane;
    for (int item = GW; item < T * 4; item += NGW) {
        const int t = item >> 2, h = item & 3, tq = t % SEQ; const size_t tb = (size_t)(t - tq);
        float q[96];
        { const bf16_t* qp = QM + (size_t)t * 384 + h * 96;
#pragma unroll
          for (int i = 0; i < 12; ++i) { const u32x4 w = *(const u32x4*)(qp + 8 * i); q[8*i] = bflo(w.x); q[8*i+1] = bfhi(w.x); q[8*i+2] = bflo(w.y); q[8*i+3] = bfhi(w.y); q[8*i+4] = bflo(w.z); q[8*i+5] = bfhi(w.z); q[8*i+6] = bflo(w.w); q[8*i+7] = bfhi(w.w); } }
        float o[64];
#pragma unroll
        for (int d = 0; d < 64; ++d) o[d] = 0.f;
        float m = -1.0e30f, lsum = 0.f;
        for (int c = tq >> 6; c >= 0; --c) {
            const int key = c * 64 + lane; const bool ok = key <= tq;
            const bf16_t* kp = KM + (tb + (ok ? key : 0)) * 384 + h * 96; const bf16_t* vp = VM + (tb + (ok ? key : 0)) * 256 + h * 64;
            float z = 0.f;
#pragma unroll
            for (int i = 0; i < 12; ++i) { const u32x4 w = *(const u32x4*)(kp + 8 * i);
                z += q[8*i] * bflo(w.x) + q[8*i+1] * bfhi(w.x) + q[8*i+2] * bflo(w.y) + q[8*i+3] * bfhi(w.y) + q[8*i+4] * bflo(w.z) + q[8*i+5] * bfhi(w.z) + q[8*i+6] * bflo(w.w) + q[8*i+7] * bfhi(w.w); }
            z = ok ? z : -1.0e30f;
            float cm = z;
#pragma unroll
            for (int dd = 1; dd < 64; dd <<= 1) cm = fmaxf(cm, __shfl_xor(cm, dd));
            const float mn = fmaxf(m, cm), al = fexp2(m - mn), pw = ok ? fexp2(z - mn) : 0.f; m = mn; lsum = lsum * al + pw;
#pragma unroll
            for (int i = 0; i < 8; ++i) { const u32x4 w = *(const u32x4*)(vp + 8 * i);
                o[8*i] = o[8*i] * al + pw * bflo(w.x); o[8*i+1] = o[8*i+1] * al + pw * bfhi(w.x); o[8*i+2] = o[8*i+2] * al + pw * bflo(w.y); o[8*i+3] = o[8*i+3] * al + pw * bfhi(w.y);
                o[8*i+4] = o[8*i+4] * al + pw * bflo(w.z); o[8*i+5] = o[8*i+5] * al + pw * bfhi(w.z); o[8*i+6] = o[8*i+6] * al + pw * bflo(w.w); o[8*i+7] = o[8*i+7] * al + pw * bfhi(w.w); }
        }
        const float lt = wave_sum(lsum); float mine = 0.f;
#pragma unroll
        for (int d = 0; d < 64; ++d) { const float sdd = wave_sum(o[d]); if (lane == d) mine = sdd; }
        Y[(size_t)t * 1024 + 768 + h * 64 + lane] = (bf16_t)(cvt_pk_bf16(mine / lt, 0.f) & 0xffffu);
    }
}
__device__ __forceinline__ void xattn_naive(const Ctx& C, int l) {
    const bf16_t* XQ = WSP(bf16_t, S_XQ); const bf16_t* KMEM = WSP(bf16_t, W_KMEM) + (size_t)l * NMEM * 1024; const bf16_t* VT = WSP(bf16_t, W_VMEMT) + (size_t)l * 1024 * NMEM; bf16_t* XO = WSP(bf16_t, S_XO); const int lane = C.lane;
    for (int item = GW; item < T * 4; item += NGW) {
        const int t = item >> 2, h = item & 3, b = t / SEQ;
        float z[4] = {0.f, 0.f, 0.f, 0.f};
        for (int d8 = 0; d8 < 32; ++d8) { const u32x4 qw = *(const u32x4*)(XQ + (size_t)t * 1024 + h * 256 + 8 * d8);
            const float qv[8] = {bflo(qw.x), bfhi(qw.x), bflo(qw.y), bfhi(qw.y), bflo(qw.z), bfhi(qw.z), bflo(qw.w), bfhi(qw.w)};
#pragma unroll
            for (int j = 0; j < 4; ++j) { const u32x4 kw = *(const u32x4*)(KMEM + (size_t)(b * 256 + lane + 64 * j) * 1024 + h * 256 + 8 * d8);
                z[j] += qv[0] * bflo(kw.x) + qv[1] * bfhi(kw.x) + qv[2] * bflo(kw.y) + qv[3] * bfhi(kw.y) + qv[4] * bflo(kw.z) + qv[5] * bfhi(kw.z) + qv[6] * bflo(kw.w) + qv[7] * bfhi(kw.w); } }
        float mx = fmaxf(fmaxf(z[0], z[1]), fmaxf(z[2], z[3]));
#pragma unroll
        for (int dd = 1; dd < 64; dd <<= 1) mx = fmaxf(mx, __shfl_xor(mx, dd));
        float p[4], ps = 0.f;
#pragma unroll
        for (int j = 0; j < 4; ++j) { p[j] = fexp2(z[j] - mx); ps += p[j]; }
        const float inv = 1.0f / wave_sum(ps);
        float o[4] = {0.f, 0.f, 0.f, 0.f};
        for (int mm = 0; mm < 256; ++mm) { const float pm = __shfl(p[mm >> 6], mm & 63);
#pragma unroll
            for (int jd = 0; jd < 4; ++jd) o[jd] += pm * bf2f(VT[(size_t)(h * 256 + lane + 64 * jd) * NMEM + b * 256 + mm]); }
#pragma unroll
        for (int jd = 0; jd < 4; ++jd) XO[(size_t)t * 1024 + h * 256 + lane + 64 * jd] = (bf16_t)(cvt_pk_bf16(o[jd] * inv, 0.f) & 0xffffu);
    }
}
__device__ __forceinline__ void ph_mixers(const Ctx& C, int l) {
    unsigned* head = (unsigned*)(C.ws + WS_CTL) + CW_QUEUE + 64 * l;
    volatile LAS unsigned* slot = (volatile LAS unsigned*)(C.lds + LDSCTL_OFF + 64);
    constexpr int N_RW = 64, N_SSD = 64, N_ATT = 512, NITEMS = N_RW + N_SSD + N_ATT;
    for (;;) {
        __syncthreads();
        if (C.tid == 0) slot[0] = __hip_atomic_fetch_add(head, 1u, RLX_AGENT);
        __syncthreads();
        const int it = (int)slot[0];
        if (it >= NITEMS) break;

#ifndef NAIVE_SCAN
#define NAIVE_SCAN 0
#endif
        if (it < N_RW) { if (!(NAIVE_SCAN & 1)) rwkv_unit(C, l, it >> 2, it & 3); }
        else if (it < N_RW + N_SSD) { const int k = it - N_RW; if (!(NAIVE_SCAN & 2)) ssd_unit(C, l, k >> 2, k & 3); }
        else { const int k = it - N_RW - N_SSD; const int mode = k & 1, pp = (k >> 1) & 3, bh = k >> 3, b = bh >> 2, h = bh & 3;
#ifndef NAIVE_SB
            if (mode == 0) { attn_unit<0>(C, b, h, 7 - pp); __syncthreads(); attn_unit<0>(C, b, h, pp); }
#else
            if (mode == 0) { }
#endif
#ifndef NAIVE_MLA
            else { attn_unit<1>(C, b, h, 7 - pp); __syncthreads(); attn_unit<1>(C, b, h, pp); } }
#else
            else { } }
#endif
    }
#ifdef NAIVE_SB
    sb_naive(C);
#endif
#ifdef NAIVE_MLA
    mla_naive(C);
#endif
    if (NAIVE_SCAN & 1) rwkv_naive(C, l);
    if (NAIVE_SCAN & 2) ssd_naive(C, l);
}
__device__ __forceinline__ void ph_router(const Ctx& C) {
    run_tjobs<16, true>(C);
    __syncthreads();
    LAS unsigned* lc = (LAS unsigned*)(C.lds + XCH_OFF);
    if (C.tid < 8) lc[C.tid] = 0u;
    __syncthreads();
    const float* xr = WSP(float, W_XRES); const float* rt = C.in[I_ROUTER]; int* topi = WSP(int, S_TOPI); float* topw = WSP(float, S_TOPW); const int lane = C.lane;
    for (int k = 0; k < 16; ++k) {
        const int t = C.bid * 128 + C.wave * 16 + k; float a[8];
#pragma unroll
        for (int e = 0; e < 8; ++e) a[e] = 0.f;
#pragma unroll
        for (int j = 0; j < 4; ++j) { const f32x4 xv = *(const f32x4*)(xr + (size_t)t * 1024 + 4 * lane + 256 * j);
#pragma unroll
            for (int q = 0; q < 4; ++q) { const float* rp = rt + (size_t)(4 * lane + 256 * j + q) * 8; const f32x4 r0 = *(const f32x4*)rp, r1 = *(const f32x4*)(rp + 4);
                a[0] += xv[q] * r0[0]; a[1] += xv[q] * r0[1]; a[2] += xv[q] * r0[2]; a[3] += xv[q] * r0[3]; a[4] += xv[q] * r1[0]; a[5] += xv[q] * r1[1]; a[6] += xv[q] * r1[2]; a[7] += xv[q] * r1[3]; } }
#pragma unroll
        for (int e = 0; e < 8; ++e) a[e] = wave_sum(a[e]);
#ifdef ROUTER_NOISE
        for (int e = 0; e < 8; ++e) { unsigned hsh = (unsigned)t * 2654435761u + (unsigned)e * 40503u; hsh ^= hsh >> 13; hsh *= 0x5bd1e995u; hsh ^= hsh >> 15; a[e] += ROUTER_NOISE * ((float)(hsh & 0xffff) * (1.0f / 32768.0f) - 1.0f); }
#endif
        if (lane == 0) {
            int i1 = 0; float v1 = a[0];
#pragma unroll
            for (int e = 1; e < 8; ++e) if (a[e] > v1) { v1 = a[e]; i1 = e; }
            int i2 = -1; float v2 = -3.0e38f;
#pragma unroll
            for (int e = 0; e < 8; ++e) if (e != i1 && a[e] > v2) { v2 = a[e]; i2 = e; }
            const float g1 = 1.0f / (1.0f + expf(v2 - v1));
            topi[2 * t] = i1; topi[2 * t + 1] = i2; topw[2 * t] = g1; topw[2 * t + 1] = 1.0f - g1;
            __hip_atomic_fetch_add(&lc[i1], 1u, __ATOMIC_RELAXED, __HIP_MEMORY_SCOPE_WORKGROUP); __hip_atomic_fetch_add(&lc[i2], 1u, __ATOMIC_RELAXED, __HIP_MEMORY_SCOPE_WORKGROUP);
        }
    }
    __syncthreads();
    if (C.tid < 8) ((unsigned*)(C.ws + WS_CTL))[CW_MOECNT + C.bid * 8 + C.tid] = lc[C.tid];
}
__device__ __forceinline__ void ph_scatter(const Ctx& C) {
    LAS int* sh = (LAS int*)(C.lds + XCH_OFF);
    const unsigned* cnt = (const unsigned*)(C.ws + WS_CTL) + CW_MOECNT;
    int* row_slot = WSP(int, S_ROWSLOT); float* row_w = WSP(float, S_ROWW); int* blk_e = WSP(int, S_BLKE);
    const int* topi = WSP(int, S_TOPI); const float* topw = WSP(float, S_TOPW);
    const int tid = C.tid;
    if (tid < 8) { int tot = 0, mine = 0; for (int wg = 0; wg < 256; ++wg) { const int c = (int)cnt[wg * 8 + tid]; if (wg < C.bid) mine += c; tot += c; } sh[tid] = tot; sh[8 + tid] = mine; sh[32 + tid] = 0; }
    __syncthreads();
    if (tid == 0) { int ps = 0; for (int e = 0; e < 8; ++e) { sh[16 + e] = ps; const int pad = (sh[e] + 255) / 256 * 256; sh[24 + e] = pad; ps += pad; } sh[40] = ps / 256; }
    __syncthreads();
    if (C.bid == 0) {
        const int used = sh[40];
        for (int rb = tid; rb < MOE_BLOCKS; rb += NTHREADS) { int e = 7; if (rb < used) { e = 0; for (int q = 1; q < 8; ++q) if (sh[16 + q] <= rb * 256) e = q; } blk_e[rb] = e; }
        if (tid == 0) blk_e[MOE_BLOCKS] = used;
    }
    if (C.bid < 8) { const int e = C.bid; for (int r = sh[16 + e] + sh[e] + tid; r < sh[16 + e] + sh[24 + e]; r += NTHREADS) { row_slot[r] = -1; row_w[r] = 0.f; } }
    if (tid < 256) { const int t = C.bid * 128 + (tid >> 1), k = tid & 1, e = topi[2 * t + k];
        const int pos = __hip_atomic_fetch_add(&sh[32 + e], 1, __ATOMIC_RELAXED, __HIP_MEMORY_SCOPE_WORKGROUP); const int dest = sh[16 + e] + sh[8 + e] + pos; row_slot[dest] = 2 * t + k; row_w[dest] = topw[2 * t + k]; sh[64 + tid] = dest; }
    __syncthreads();
    const bf16_t* xb = WSP(bf16_t, W_XB); bf16_t* xs = WSP(bf16_t, S_XS);
    for (int a = C.wave * 32; a < C.wave * 32 + 32; ++a) { const int t = C.bid * 128 + (a >> 1); const size_t d = (size_t)sh[64 + a] * 1024;
#pragma unroll
        for (int j = 0; j < 2; ++j) *(u32x4*)(xs + d + (C.lane + 64 * j) * 8) = *(const u32x4*)(xb + (size_t)t * 1024 + (C.lane + 64 * j) * 8); }
}


__device__ __forceinline__ void chk_moe(const Ctx& C, int bit) {
    const float* xr = WSP(float, W_XRES); const float* rt = C.in[I_ROUTER]; const float* w13 = C.in[I_MOE13]; const float* w2 = C.in[I_MOE2]; const bf16_t* ys = WSP(bf16_t, S_YS);
    LAS float* hb = (LAS float*)(C.lds + C.wave * 14336); const int lane = C.lane; unsigned bad = 0;
    float* stash = WSP(float, W_KMEM); const float* g3 = C.in[I_LN3G] + 1024; const float* b3 = C.in[I_LN3B] + 1024;
    for (int s = GW; s < 1024; s += NGW) {
        const int t = (int)(((long)s * 1021 + 7) % T); float x[16];
#pragma unroll
        for (int j = 0; j < 16; ++j) x[j] = xr[(size_t)t * 1024 + lane + 64 * j];
        float lg[8];
#pragma unroll
        for (int e = 0; e < 8; ++e) { float a = 0.f;
#pragma unroll
            for (int j = 0; j < 16; ++j) a += x[j] * rt[(size_t)(lane + 64 * j) * 8 + e]; lg[e] = wave_sum(a); }
        int i1 = 0; for (int e = 1; e < 8; ++e) if (lg[e] > lg[i1]) i1 = e;
        int i2 = -1; for (int e = 0; e < 8; ++e) if (e != i1 && (i2 < 0 || lg[e] > lg[i2])) i2 = e;
        float v3 = -3.0e38f; for (int e = 0; e < 8; ++e) if (e != i1 && e != i2) v3 = fmaxf(v3, lg[e]);
        if (lg[i2] - v3 < 0.02f) { if (lane == 0) stash[(size_t)s * 1024] = 1.0e30f; continue; }
        const float g1 = 1.0f / (1.0f + expf(lg[i2] - lg[i1]));
        float out[16];
#pragma unroll
        for (int j = 0; j < 16; ++j) out[j] = 0.f;
        for (int q = 0; q < 2; ++q) { const int e = q ? i2 : i1; const float gw = q ? 1.0f - g1 : g1; const float* W1 = w13 + (size_t)e * 1024 * 2 * FFE;
            for (int i0 = 0; i0 < 56; i0 += 4) { float ag[4], au[4];
#pragma unroll
                for (int i = 0; i < 4; ++i) { ag[i] = 0.f; au[i] = 0.f; }
                for (int k = 0; k < 1024; ++k) { const float xk = __shfl(x[k >> 6], k & 63); const float* wr = W1 + (size_t)k * 2 * FFE + lane + 64 * i0;
#pragma unroll
                    for (int i = 0; i < 4; ++i) { ag[i] += xk * wr[64 * i]; au[i] += xk * wr[FFE + 64 * i]; } }
#pragma unroll
                for (int i = 0; i < 4; ++i) hb[lane + 64 * (i0 + i)] = (ag[i] / (1.0f + expf(-ag[i]))) * au[i]; }
            LDS_WAIT();
            const float* W2 = w2 + (size_t)e * FFE * 1024;
            for (int hh = 0; hh < FFE; ++hh) { const float hv = hb[hh] * gw;
#pragma unroll
                for (int j = 0; j < 16; ++j) out[j] += hv * W2[(size_t)hh * 1024 + lane + 64 * j]; }
            LDS_WAIT(); }
#pragma unroll
        for (int j = 0; j < 16; ++j) { const int c = lane + 64 * j; const float got = bf2f(ys[(size_t)(2 * t) * 1024 + c]) + bf2f(ys[(size_t)(2 * t + 1) * 1024 + c]);
            if (fabsf(got - out[j]) > 0.05f * fabsf(out[j]) + 0.03f) bad = 1; }
        { float v[16], sm = 0.f, s2 = 0.f;
#pragma unroll
          for (int j = 0; j < 16; ++j) { v[j] = x[j] * DN_ALPHA + out[j]; sm += v[j]; }
          const float mean = wave_sum(sm) * (1.0f / 1024.0f);
#pragma unroll
          for (int j = 0; j < 16; ++j) { v[j] -= mean; s2 += v[j] * v[j]; }
          const float rstd = 1.0f / sqrtf(wave_sum(s2) * (1.0f / 1024.0f) + 1e-5f);
          int zz = 0; asm volatile("" : "+v"(zz));
#pragma unroll
          for (int j = 0; j < 16; ++j) { const int c = lane + 64 * j + zz; stash[(size_t)s * 1024 + c] = v[j] * rstd * g3[c] + b3[c]; } }
    }
    chk_flag(C, bit, bad);
}
#ifndef ABL_MIX
#define ABL_MIX 1.0f
#endif
#ifndef ABL_XA
#define ABL_XA 1.0f
#endif
#ifndef ABL_FF
#define ABL_FF 1.0f
#endif
#ifndef CHK_TOL2
#define CHK_TOL2 0.05f
#endif
#ifndef GATE_ACT
#define GATE_ACT 1
#endif
#ifndef GATE_ALIGN
#define GATE_ALIGN true
#endif
#ifndef FG_TOL
#define FG_TOL 0.05f
#endif
#ifndef FG_BIT
#define FG_BIT 1
#endif
#ifndef CHECKS_LAYER
#define CHECKS_LAYER 0
#endif
#ifndef MK_SPLIT
#define MK_SPLIT 0
#endif
constexpr int PH_L0 = 1, PH_L1 = 18, PH_MOE = 32, PH_TOTAL = 43;

__global__ void __launch_bounds__(NTHREADS, 2) hybrid_fwd(Args args) {
    extern __shared__ __attribute__((aligned(16))) unsigned char lds_raw[];
    Ctx C; C.in = args.in; C.out = args.out; C.ws = args.ws; C.lds = (LAS unsigned char*)lds_raw;
    C.tid = threadIdx.x; C.lane = C.tid & 63; C.wave = __builtin_amdgcn_readfirstlane(C.tid >> 6); C.G = gridDim.x; C.bid = blockIdx.x;
    const Ctx C0 = C;
    for (int u = C.tid; u < (LDS_BYTES - LDSCTL_OFF) / 4; u += NTHREADS) ((LAS unsigned*)(C.lds + LDSCTL_OFF))[u] = 0u;
    __syncthreads();
    const int lo = args.ph_lo, hi = args.ph_hi;
    XcdBarrier bar; bar.bar = (unsigned*)(C.ws + WS_CTL) + CW_BAR; bar.x = 0; bar.st = (volatile LAS unsigned*)(C.lds + LDSCTL_OFF);
    if (hi - lo > 1) bar = xcd_barrier_post((unsigned*)(C.ws + WS_CTL) + CW_BAR, (volatile LAS unsigned*)(C.lds + LDSCTL_OFF));
#ifndef SITE_MASK
#define SITE_MASK 0xffffffffu
#endif
#define SITE(n) (((SITE_MASK) >> (n)) & 1u)
#define IN(k) (lo <= (k) && (k) < hi)
#define ENDPH(k) do { if ((k) + 1 < hi) xcd_barrier(bar); } while (0)
#define SITE_BEGIN const Ctx C = launder(C0); unsigned char* LW = C.ws + W_BASE + (size_t)l * LW_SIZE; const bf16_t* XB = WSP(bf16_t, W_XB); float* XRES = WSP(float, W_XRES); (void)LW; (void)XB; (void)XRES; LAS unsigned char* ring = C.lds; (void)ring;

    if (SITE(0) && IN(0)) { const int l = 0; SITE_BEGIN ph_prologue(C); ENDPH(0); }

    for (int l = 0; l < 2; ++l) {
        const int pb = l == 0 ? PH_L0 : PH_L1;
        if (SITE(1) && IN(pb + 0)) { SITE_BEGIN
#ifdef CHECKS3
            if (l == 1) chk_ln_cmp(C, 1, 1);
#endif
            { pg8::Gemm g{XB, (const bf16_t*)(LW + LW_WIN), 1024, 1024, 1024}; sch::Tiles S{T / 256, NPROJ / 256, C.G, C.bid}; epi::StoreBf16<0> E{WSP(bf16_t, S_PROJ), NPROJ}; pg8::gemm_phase(ring, g, S, E); }
            { pg8::Gemm g{WSP(bf16_t, W_MEMB), (const bf16_t*)(LW + LW_WKV), 1024, 1024, 1024}; sch::Tiles S{NMEM / 256, 4, C.G, C.bid}; epi::StoreBf16<0> E{WSP(bf16_t, W_KMEM) + (size_t)l * NMEM * 1024, 1024}; pg8::gemm_phase(ring, g, S, E); }
            { pg8::Gemm g{(const bf16_t*)(LW + LW_WKV) + (size_t)1024 * 1024, WSP(bf16_t, W_MEMB), 1024, 1024, 1024}; sch::Tiles S{4, NMEM / 256, C.G, (C.bid + 192) & 255}; epi::StoreBf16<0> E{WSP(bf16_t, W_VMEMT) + (size_t)l * 1024 * NMEM, NMEM}; pg8::gemm_phase(ring, g, S, E); }
            ENDPH(pb + 0);
        }
        if (SITE(2) && IN(pb + 1)) { SITE_BEGIN
#ifdef CHECKS5
            if (l == 0) chk_weights<28, false>(C, 0);
#endif
#ifdef CHECKS9
            if (l == 0) { unsigned bad = 0; const float* x = C.in[I_X]; const float* mm = C.in[I_MEM]; const bf16_t* mb = WSP(bf16_t, W_MEMB);
                for (size_t i = (size_t)C.bid * NTHREADS + C.tid; i < (size_t)T * 1024; i += (size_t)C.G * NTHREADS) if (!chk_close(x[i], bf2f(XB[i]))) bad = 1;
                for (size_t i = (size_t)C.bid * NTHREADS + C.tid; i < (size_t)NMEM * 1024; i += (size_t)C.G * NTHREADS) if (!chk_close(mm[i], bf2f(mb[i]))) bad = 1;
                if (bad) __hip_atomic_fetch_add((unsigned*)(C.ws + WS_CTL) + CW_CHK, 1u, RLX_AGENT); }
#endif
#ifdef CHECKS12P
            if (l == CHECKS_LAYER) { const bf16_t* proj = WSP(bf16_t, S_PROJ); chk_full_gemm(C, XB, (const bf16_t*)(LW + LW_WIN), 1024, 3236, 0, [&](size_t r, int c, float d) { return chk_close(d, bf2f(proj[r * NPROJ + c])); }); xcd_barrier(bar); }
#endif
#ifdef CHECKS4
            if (l == CHECKS_LAYER) { const bf16_t* KM_ = WSP(bf16_t, W_KMEM) + (size_t)l * NMEM * 1024; const bf16_t* VT_ = WSP(bf16_t, W_VMEMT) + (size_t)l * 1024 * NMEM;
                chk_gemm(C, WSP(bf16_t, W_MEMB), 1024, (const bf16_t*)(LW + LW_WKV), 1024, 1024, NMEM, 64, 16, 3, 0, [&](int r, int c, float d) { return chk_close(d, bf2f(KM_[(size_t)r * 1024 + c])); });
                chk_gemm(C, (const bf16_t*)(LW + LW_WKV) + (size_t)1024 * 1024, 1024, WSP(bf16_t, W_MEMB), 1024, 1024, 1024, 256, 16, 5, 1, [&](int r, int c, float d) { return chk_close(d, bf2f(VT_[(size_t)r * NMEM + c])); }); }
#endif
#ifdef CHECKS
            if (l == CHECKS_LAYER) { const bf16_t* proj = WSP(bf16_t, S_PROJ); chk_gemm(C, XB, 1024, (const bf16_t*)(LW + LW_WIN), 1024, 1024, T, 13, 256, 7, 0, [&](int r, int c, float d) { return chk_close(d, bf2f(proj[(size_t)r * NPROJ + c])); }); }
#endif
            ph_prep(C, l); ENDPH(pb + 1); }
        if (SITE(3) && IN(pb + 2)) { SITE_BEGIN
            { pg8::Gemm g{WSP(bf16_t, S_LA), (const bf16_t*)(LW + LW_LORA), 256, 256, 256}; sch::Tiles S{T / 256, 3, C.G, C.bid}; epi::Lora E{WSP(float, S_DEC), WSP(bf16_t, S_AV), WSP(bf16_t, S_GV), C.in[I_RWW0] + l * 256, C.in[I_RWA0] + l * 256}; pg8::gemm_phase(ring, g, S, E); }
            { pg8::Gemm g{WSP(bf16_t, S_CQN), (const bf16_t*)(LW + LW_WUQ), 256, 256, 256}; sch::Tiles S{T / 256, 2, C.G, (C.bid + 128) & 255}; epi::Uq E{WSP(bf16_t, S_QM), WSP(float, W_COS), WSP(float, W_SIN)}; pg8::gemm_phase(ring, g, S, E); }
            { pg8::Gemm g{WSP(bf16_t, S_CKVN), (const bf16_t*)(LW + LW_WUKV), 128, 128, 128}; sch::Tiles S{T / 256, 2, C.G, C.bid}; epi::Ukv E{WSP(bf16_t, S_KM), WSP(bf16_t, S_VM)}; pg8::gemm_phase(ring, g, S, E); }
            ENDPH(pb + 2);
        }
        if (SITE(4) && IN(pb + 3)) { SITE_BEGIN ph_rwprep(C, l); ENDPH(pb + 3); }
        if (SITE(5) && IN(pb + 4)) { SITE_BEGIN
#ifdef CHECKS6
            if (l == CHECKS_LAYER) chk_mla_inputs(C, l, 0);
#endif
#ifdef CHECKS7
            if (l == CHECKS_LAYER) chk_rw_inputs(C, l, 0);
#endif
            ph_mixers(C, l); ENDPH(pb + 4); }
        if (SITE(6) && IN(pb + 5)) { SITE_BEGIN
            ph_ssdfix(C, l);
            { pg8::Gemm g{XB, (const bf16_t*)(LW + LW_WGATE), 1024, 1024, 1024}; sch::Tiles S{T / 256, 16, C.G, C.bid}; epi::StoreBf16<GATE_ACT> E{WSP(bf16_t, S_G), 4096}; pg8::gemm_phase<epi::StoreBf16<GATE_ACT>, sch::Tiles, GATE_ALIGN>(ring, g, S, E); }
#ifdef CHECKS14
            if (l == 0) { xcd_barrier(bar); const bf16_t* Gp = WSP(bf16_t, S_G); chk_full_gemm(C, XB, (const bf16_t*)(LW + LW_WGATE), 1024, 4096, 0, [&](size_t r, int c, float d) { return chk_close(sigmoidf_(d), bf2f(Gp[r * 4096 + c])); }); }
#endif
#ifdef CHECKS13
            if (l == 0) { xcd_barrier(bar);
              { pg8::Gemm g{XB, (const bf16_t*)(LW + LW_WGATE), 1024, 1024, 1024}; sch::Tiles S{T / 256, 16, C.G, C.bid}; epi::StoreBf16<1> E{WSP(bf16_t, S_G) + (size_t)T * 4096, 4096}; pg8::gemm_phase(ring, g, S, E); }
              xcd_barrier(bar);
              { const unsigned short* g1 = WSP(unsigned short, S_G); const unsigned short* g2 = g1 + (size_t)T * 4096; unsigned cnt = 0;
                for (size_t i = (size_t)C.bid * NTHREADS + C.tid; i < (size_t)T * 4096; i += (size_t)C.G * NTHREADS) if (g1[i] != g2[i]) ++cnt;
                if (cnt) __hip_atomic_fetch_add((unsigned*)(C.ws + WS_CTL) + CW_CHK + 2048, cnt, RLX_AGENT); } }
#endif
            ENDPH(pb + 5);
        }
        if (SITE(7) && IN(pb + 6)) { SITE_BEGIN
#ifdef FIX_G
            { bf16_t* Gw = WSP(bf16_t, S_G); const bf16_t* Wg = (const bf16_t*)(LW + LW_WGATE);
              for (size_t i = (size_t)C.bid * NTHREADS + C.tid; i < (size_t)T * 4096; i += (size_t)C.G * NTHREADS) { const size_t r = i >> 12; const int c = (int)(i & 4095);
                  Gw[i] = (bf16_t)(cvt_pk_bf16(sigmoidf_(tdot(XB + r * 1024, Wg + (size_t)c * 1024, 1024)), 0.f) & 0xffffu); }
              xcd_barrier(bar); }
#endif
#ifdef CHECKS15
            if (l == 0) { unsigned cnt = 0; const float* x = C.in[I_X];
                for (size_t i = (size_t)C.bid * NTHREADS + C.tid; i < (size_t)T * 1024; i += (size_t)C.G * NTHREADS) if (!chk_close(x[i], bf2f(XB[i]))) ++cnt;
                if (cnt) __hip_atomic_fetch_add((unsigned*)(C.ws + WS_CTL) + CW_CHK + 2048, cnt, RLX_AGENT); }
#endif
#ifdef CHECKS7
            if (l == CHECKS_LAYER) chk_ssd_norm(C, l, 1);
#endif
#ifdef CHECKS12
            if (l == CHECKS_LAYER) { const bf16_t* Gp = WSP(bf16_t, S_G); chk_full_gemm(C, XB, (const bf16_t*)(LW + LW_WGATE), 1024, 4096, FG_BIT, [&](size_t r, int c, float d) { return fabsf((GATE_ACT ? sigmoidf_(d) : d) - bf2f(Gp[r * 4096 + c])) <= FG_TOL; }); xcd_barrier(bar); }
#endif
#ifdef CHECKS
            if (l == CHECKS_LAYER) { const bf16_t* Gp = WSP(bf16_t, S_G); chk_gemm(C, XB, 1024, (const bf16_t*)(LW + LW_WGATE), 1024, 1024, T, 16, 256, 5, 1, [&](int r, int c, float d) { return chk_close(sigmoidf_(d), bf2f(Gp[(size_t)r * 4096 + c])); }); }
#endif
            { pg8::Gemm g{WSP(bf16_t, S_Y), (const bf16_t*)(LW + LW_WBR), 256, 1024, 256}; sch::BrTiles S{T / 256, 4, C.G, C.bid}; epi::BrGate E{WSP(bf16_t, S_G), WSP(float, S_MF), WSP(bf16_t, S_MB)}; pg8::gemm_phase(ring, g, S, E); }
            ENDPH(pb + 6);
        }
        if (SITE(8) && IN(pb + 7)) { SITE_BEGIN
#ifdef CHECKS2
            if (l == CHECKS_LAYER) chk_merged(C, l, 0);
#endif
            { pg8::Gemm g{WSP(bf16_t, S_MB), (const bf16_t*)(LW + LW_WOUT), 1024, 1024, 1024}; sch::Tiles S{T / 256, 4, C.G, C.bid}; epi::Resid E{l == 0 ? C.in[I_X] : XRES, XRES, ABL_MIX}; pg8::gemm_phase(ring, g, S, E); }
            ENDPH(pb + 7);
        }
        if (SITE(9) && IN(pb + 8)) { SITE_BEGIN
#ifdef CHECKS10
            if (l == 0) { chk_full_p7(C, l, 1); xcd_barrier(bar); }
#endif
#ifdef CHECKS
            if (l == 0) { const float* xin = C.in[I_X]; chk_gemm(C, WSP(bf16_t, S_MB), 1024, (const bf16_t*)(LW + LW_WOUT), 1024, 1024, T, 4, 256, 9, 2, [&](int r, int c, float d) { return fabsf(xin[(size_t)r * 1024 + c] * DN_ALPHA + d - XRES[(size_t)r * 1024 + c]) <= CHK_TOL2; }); }
#endif
            ph_ln<false>(C, XRES, XRES, WSP(bf16_t, W_XB), C.in[I_LN1G] + l * 1024, C.in[I_LN1B] + l * 1024, nullptr); ENDPH(pb + 8); }
        if (SITE(10) && IN(pb + 9)) { SITE_BEGIN
            { pg8::Gemm g{XB, (const bf16_t*)(LW + LW_WQ), 1024, 1024, 1024}; sch::Tiles S{T / 256, 4, C.G, C.bid}; epi::StoreBf16<0> E{WSP(bf16_t, S_XQ), 1024}; pg8::gemm_phase(ring, g, S, E); }
            ENDPH(pb + 9);
        }
        if (SITE(11) && IN(pb + 10)) { SITE_BEGIN
#ifdef CHECKS
            if (l == CHECKS_LAYER) { const bf16_t* XQ = WSP(bf16_t, S_XQ); chk_gemm(C, XB, 1024, (const bf16_t*)(LW + LW_WQ), 1024, 1024, T, 4, 256, 11, 3, [&](int r, int c, float d) { return chk_close(d, bf2f(XQ[(size_t)r * 1024 + c])); }); }
#endif
            { pg8::Gemm g{WSP(bf16_t, S_XQ), WSP(bf16_t, W_KMEM) + (size_t)l * NMEM * 1024, 256, 1024, 1024}; sch::XaS S{C.G, C.bid}; epi::Softmax E{WSP(bf16_t, S_XP), (LAS float*)(C.lds + XCH_OFF)};
#ifndef NAIVE_XA
              pg8::gemm_phase(ring, g, S, E);
#else
              (void)g; (void)S; (void)E; xattn_naive(C, l);
#endif
            }
            ENDPH(pb + 10);
        }
        if (SITE(12) && IN(pb + 11)) { SITE_BEGIN
            { pg8::Gemm g{WSP(bf16_t, S_XP), WSP(bf16_t, W_VMEMT) + (size_t)l * 1024 * NMEM, 256, 1024, NMEM}; sch::XaPV S{C.G, C.bid}; epi::StoreBf16<0> E{WSP(bf16_t, S_XO), 1024};
#ifndef NAIVE_XA
              pg8::gemm_phase(ring, g, S, E);
#else
              (void)g; (void)S; (void)E;
#endif
            }
            ENDPH(pb + 11);
        }
        if (SITE(13) && IN(pb + 12)) { SITE_BEGIN
#ifdef CHECKS3
            if (l == 0) { chk_resid_stash(C, WSP(bf16_t, S_XO), 1024, (const bf16_t*)(LW + LW_WO), 1024, 1024, 0); xcd_barrier(bar); }
#endif
            { pg8::Gemm g{WSP(bf16_t, S_XO), (const bf16_t*)(LW + LW_WO), 1024, 1024, 1024}; sch::Tiles S{T / 256, 4, C.G, C.bid}; epi::Resid E{XRES, XRES, ABL_XA}; pg8::gemm_phase(ring, g, S, E); }
            ENDPH(pb + 12);
        }
        if (SITE(14) && IN(pb + 13)) { SITE_BEGIN
#ifdef CHECKS3
            if (l == 0) chk_resid_cmp(C, 0, 2);
#endif
            ph_ln<false>(C, XRES, XRES, WSP(bf16_t, W_XB), C.in[I_LN2G] + l * 1024, C.in[I_LN2B] + l * 1024, nullptr); ENDPH(pb + 13); }
        if (l == 0) {
            if (SITE(15) && IN(pb + 14)) { SITE_BEGIN
                { pg8::Gemm g{XB, WSP(bf16_t, W_FFN13), 1024, 1024, 1024}; sch::Tiles S{T / 256, 2 * FFD / 256, C.G, C.bid}; epi::Swiglu E{WSP(bf16_t, S_H), FFD, 0}; pg8::gemm_phase(ring, g, S, E); }
                ENDPH(pb + 14);
            }
            if (SITE(16) && IN(pb + 15)) { SITE_BEGIN
#ifdef CHECKS2
                chk_swiglu(C, 1);
#endif
#ifdef CHECKS3
                chk_resid_stash(C, WSP(bf16_t, S_H), FFD, WSP(bf16_t, W_FFN2), FFD, FFD, 0); xcd_barrier(bar);
#endif
                { pg8::Gemm g{WSP(bf16_t, S_H), WSP(bf16_t, W_FFN2), FFD, FFD, FFD}; sch::Tiles S{T / 256, 4, C.G, C.bid}; epi::Resid E{XRES, XRES, ABL_FF}; pg8::gemm_phase(ring, g, S, E); }
                ENDPH(pb + 15);
            }
            if (SITE(17) && IN(pb + 16)) { SITE_BEGIN
#ifdef CHECKS3
                chk_resid_cmp(C, 0, 0); chk_ln_stash(C, C.in[I_LN3G], C.in[I_LN3B], 1); xcd_barrier(bar);
#endif
                ph_ln<false>(C, XRES, XRES, WSP(bf16_t, W_XB), C.in[I_LN3G], C.in[I_LN3B], nullptr); ENDPH(pb + 16); }
        } else {
            if (SITE(18) && IN(PH_MOE)) { SITE_BEGIN ph_router(C); ENDPH(PH_MOE); }
            if (SITE(19) && IN(PH_MOE + 1)) { SITE_BEGIN
#ifdef CHECKS5
                chk_weights<16, true>(C, 1);
#endif
                ph_scatter(C); ENDPH(PH_MOE + 1); }
            for (int p = 0; p < MOE_PASSES; ++p) {
                const int* blk_e = WSP(int, S_BLKE);
                if (SITE(20) && IN(PH_MOE + 2 + 2 * p)) { SITE_BEGIN
                    const int used = __builtin_amdgcn_readfirstlane(__hip_atomic_load(blk_e + MOE_BLOCKS, RLX_AGENT)); const int b0 = p * MOE_PASS_BLOCKS, b1 = min(b0 + MOE_PASS_BLOCKS, used);
                    if (b1 > b0) { pg8::Gemm g{WSP(bf16_t, S_XS), WSP(bf16_t, S_MW13), 1024, 1024, 1024}; sch::MoeUp S{blk_e, b0, b1, C.G, C.bid}; epi::Swiglu E{WSP(bf16_t, S_MH), FFE, 1}; pg8::gemm_phase(ring, g, S, E); }
                    ENDPH(PH_MOE + 2 + 2 * p);
                }
                if (SITE(21) && IN(PH_MOE + 3 + 2 * p)) { SITE_BEGIN
                    const int used = __builtin_amdgcn_readfirstlane(__hip_atomic_load(blk_e + MOE_BLOCKS, RLX_AGENT)); const int b0 = p * MOE_PASS_BLOCKS, b1 = min(b0 + MOE_PASS_BLOCKS, used);
                    if (b1 > b0) { pg8::Gemm g{WSP(bf16_t, S_MH), WSP(bf16_t, S_MW2), FFE, FFE, FFE}; sch::MoeDown S{blk_e, b0, b1, C.G, C.bid}; epi::MoeDown E{WSP(int, S_ROWSLOT), WSP(float, S_ROWW), WSP(bf16_t, S_YS)}; pg8::gemm_phase(ring, g, S, E); }
                    ENDPH(PH_MOE + 3 + 2 * p);
                }
            }
            if (SITE(22) && IN(PH_TOTAL - 1)) { SITE_BEGIN
#ifdef CHECKS8
                chk_moe(C, 0); xcd_barrier(bar);
#endif
#define FINAL_LN_SITE 1
 ph_ln<true>(C, XRES, C.out, nullptr, C.in[I_LN3G] + 1024, C.in[I_LN3B] + 1024, WSP(bf16_t, S_YS));
#ifdef CHECKS11
                xcd_barrier(bar);
                { unsigned cnt = 0; for (size_t i = (size_t)C.bid * NTHREADS + C.tid; i < (size_t)T * 1024; i += (size_t)C.G * NTHREADS) if (fabsf(C.out[i]) > CHK11_THR) ++cnt;
                  if (cnt) __hip_atomic_fetch_add((unsigned*)(C.ws + WS_CTL) + CW_CHK + 2048, cnt, RLX_AGENT); }
                xcd_barrier(bar);
                { unsigned v_ = __hip_atomic_load((const unsigned*)(C.ws + WS_CTL) + CW_CHK + 2048, RLX_AGENT); int n = 0; while (v_ > 0u) { ++n; v_ >>= 1; }
                  const float sc = 1.0f + 0.1f * (float)n; for (size_t i = (size_t)C.bid * NTHREADS + C.tid; i < (size_t)T * 1024; i += (size_t)C.G * NTHREADS) C.out[i] *= sc; }
#endif
#ifdef CHECKS8
                xcd_barrier(bar);
                { const float* stash = WSP(float, W_KMEM); unsigned bad = 0; const float cs = 1.0f; (void)cs;
                  for (int s = GW; s < 1024; s += NGW) { const int t = (int)(((long)s * 1021 + 7) % T); if (stash[(size_t)s * 1024] > 1.0e29f) continue;
                      for (int j = 0; j < 16; ++j) { const int c = C.lane + 64 * j; const float e = stash[(size_t)s * 1024 + c], gt = C.out[(size_t)t * 1024 + c]; if (fabsf(e - gt) > 0.05f * fabsf(e) + 0.05f) bad = 1; } }
                  chk_flag(C, 1, bad); }
                xcd_barrier(bar);
                { const unsigned* cw = (const unsigned*)(C.ws + WS_CTL) + CW_CHK; if (__hip_atomic_load(cw + 64, RLX_AGENT) != 0u) { for (size_t i = (size_t)C.bid * NTHREADS + C.tid; i < (size_t)T * 1024; i += (size_t)C.G * NTHREADS) C.out[i] *= 1.5f; } }
#endif
            }
        }
    }
#undef IN
#undef ENDPH
}

extern "C" void kernel_launch(void* const* d_in, const int* in_sizes, int n_in, void* d_out, int out_size, void* d_ws, size_t ws_size, hipStream_t stream) {
    static int grid = 0;
    if (grid == 0) {
        if (n_in != 42 || in_sizes[0] != T * DM || out_size != T * DM || ws_size < WS_NEED) { fprintf(stderr, "kernel_launch: unexpected problem (n_in %d, in0 %d, out %d, ws %zu < %zu)\n", n_in, n_in > 0 ? in_sizes[0] : -1, out_size, ws_size, (size_t)WS_NEED); grid = -1; return; }
        int dev = 0, cus = 0;
        if (hipGetDevice(&dev) != hipSuccess || hipDeviceGetAttribute(&cus, hipDeviceAttributeMultiprocessorCount, dev) != hipSuccess) { grid = -1; return; }
        if (hipFuncSetAttribute((const void*)hybrid_fwd, hipFuncAttributeMaxDynamicSharedMemorySize, LDS_BYTES) != hipSuccess) { fprintf(stderr, "kernel_launch: hipFuncSetAttribute failed\n"); grid = -1; return; }
        int per_cu = 0;
        if (hipOccupancyMaxActiveBlocksPerMultiprocessor(&per_cu, (const void*)hybrid_fwd, NTHREADS, LDS_BYTES) != hipSuccess || per_cu < 1) fprintf(stderr, "kernel_launch: occupancy query says %d\n", per_cu);
        (void)hipGetLastError();
        if (cus != 256) { fprintf(stderr, "kernel_launch: built for 256 CUs, device has %d\n", cus); grid = -1; return; }
        grid = 256;
    }
    if (grid < 0) return;
#ifdef ZERO_WS
    (void)hipMemsetAsync((char*)d_ws + ZERO_WS_LO, 0, ZERO_WS_HI - ZERO_WS_LO, stream);
#endif
    (void)hipMemsetAsync((char*)d_ws + WS_CTL, 0, CTL_BYTES, stream);
    Args a{};
    for (int i = 0; i < 42; ++i) a.in[i] = (const float*)d_in[i];
    a.out = (float*)d_out; a.ws = (unsigned char*)d_ws;
#if MK_SPLIT
    for (int p = 0; p < PH_TOTAL; ++p) { a.ph_lo = p; a.ph_hi = p + 1; hipLaunchKernelGGL(hybrid_fwd, dim3(grid), dim3(NTHREADS), LDS_BYTES, stream, a); }
#else
    a.ph_lo = 0; a.ph_hi = PH_TOTAL; hipLaunchKernelGGL(hybrid_fwd, dim3(grid), dim3(NTHREADS), LDS_BYTES, stream, a);
#endif
}
```

```cpp
#include <hip/hip_runtime.h>
#include <cstdio>
#include <cstdint>

#define GAS __attribute__((address_space(1)))
#define LAS __attribute__((address_space(3)))
typedef unsigned short bf16_t;
typedef short bf16x8 __attribute__((ext_vector_type(8)));
typedef short bf16x4 __attribute__((ext_vector_type(4)));
typedef float f32x2 __attribute__((ext_vector_type(2)));
typedef float f32x4 __attribute__((ext_vector_type(4)));
typedef float f32x16 __attribute__((ext_vector_type(16)));
typedef unsigned u32x4 __attribute__((ext_vector_type(4)));
typedef unsigned u32x2 __attribute__((ext_vector_type(2)));
#define RLX_AGENT __ATOMIC_RELAXED, __HIP_MEMORY_SCOPE_AGENT

constexpr int NB = 16, SEQ = 2048, DM = 1024, T = NB * SEQ;
constexpr int NPROJ = 3328;
constexpr int PC_SBQ = 0, PC_SBK = 256, PC_SBV = 512, PC_RW = 768, PC_Z = 1792, PC_XS = 2048, PC_BM = 2304, PC_CM = 2560, PC_CQ = 2816, PC_CKV = 3072, PC_KR = 3200, PC_DT = 3232;
constexpr int MEMT = 256, NMEM = NB * MEMT;
constexpr int FFD = 2816, FFE = 3584, NEXP = 8;
constexpr int MOE_ROWS = 2 * T + NEXP * 256;
constexpr int MOE_BLOCKS = MOE_ROWS / 256;
constexpr int MOE_PASS_BLOCKS = 64, MOE_PASSES = 5;
constexpr float DN_ALPHA = 1.4142135623730951f;
constexpr float LOG2E = 1.4426950408889634f;

constexpr size_t MiB = 1u << 20;
constexpr size_t WS_CTL = 0, CTL_BYTES = 1 * MiB;
constexpr int CW_BAR = 1024;
constexpr int CW_QUEUE = 8192;
constexpr int CW_MOECNT = 16384;
constexpr size_t W_BASE = CTL_BYTES;
constexpr size_t LW_WIN = 0;
constexpr size_t LW_WGATE = LW_WIN + (size_t)NPROJ * 1024 * 2;
constexpr size_t LW_WBR = LW_WGATE + (size_t)4096 * 1024 * 2;
constexpr size_t LW_WOUT = LW_WBR + (size_t)4 * 1024 * 256 * 2;
constexpr size_t LW_LORA = LW_WOUT + (size_t)1024 * 1024 * 2;
constexpr size_t LW_WUQ = LW_LORA + (size_t)768 * 256 * 2;
constexpr size_t LW_WUKV = LW_WUQ + (size_t)512 * 256 * 2;
constexpr size_t LW_WQ = LW_WUKV + (size_t)512 * 128 * 2;
constexpr size_t LW_WKV = LW_WQ + (size_t)1024 * 1024 * 2;
constexpr size_t LW_WO = LW_WKV + (size_t)2048 * 1024 * 2;
constexpr size_t LW_SIZE = LW_WO + (size_t)1024 * 1024 * 2;
constexpr size_t W_FFN13 = W_BASE + 2 * LW_SIZE;
constexpr size_t W_FFN2 = W_FFN13 + (size_t)2 * FFD * 1024 * 2;
constexpr size_t W_KMEM = W_FFN2 + (size_t)1024 * FFD * 2;
constexpr size_t W_VMEMT = W_KMEM + (size_t)2 * NMEM * 1024 * 2;
constexpr size_t W_MEMB = W_VMEMT + (size_t)2 * 1024 * NMEM * 2;
constexpr size_t W_COS = W_MEMB + (size_t)NMEM * 1024 * 2;
constexpr size_t W_SIN = W_COS + (size_t)T * 16 * 4;
constexpr size_t W_XB = W_SIN + (size_t)T * 16 * 4;
constexpr size_t W_XRES = W_XB + (size_t)T * 1024 * 2;
constexpr size_t S_BASE = W_XRES + (size_t)T * 1024 * 4;
constexpr size_t S_Y = S_BASE;
constexpr size_t S_SSQ = S_Y + (size_t)T * 1024 * 2;
constexpr size_t S_PROJ = S_SSQ + (size_t)T * 8 * 4;
constexpr size_t S_LA = S_PROJ + (size_t)T * NPROJ * 2;
constexpr size_t S_CQN = S_LA + (size_t)T * 256 * 2;
constexpr size_t S_CKVN = S_CQN + (size_t)T * 256 * 2;
constexpr size_t S_DEC = S_CKVN + (size_t)T * 128 * 2;
constexpr size_t S_AV = S_DEC + (size_t)T * 256 * 4;
constexpr size_t S_GV = S_AV + (size_t)T * 256 * 2;
constexpr size_t S_QM = S_GV + (size_t)T * 256 * 2;
constexpr size_t S_KM = S_QM + (size_t)T * 384 * 2;
constexpr size_t S_VM = S_KM + (size_t)T * 384 * 2;
constexpr size_t S_RWS = S_VM + (size_t)T * 256 * 2;
constexpr size_t S_MIX_END = S_RWS + (size_t)5 * T * 256 * 2;
constexpr size_t S_G = S_PROJ;
constexpr size_t S_MF = S_G + (size_t)T * 4096 * 2;
constexpr size_t S_MB = S_MF + (size_t)T * 1024 * 4;
constexpr size_t S_GATE_END = S_MB + (size_t)T * 1024 * 2;
constexpr size_t S_XQ = S_BASE;
constexpr size_t S_XP = S_XQ + (size_t)T * 1024 * 2;
constexpr size_t S_XO = S_XP + (size_t)T * 1024 * 2;
constexpr size_t S_H = S_BASE;
constexpr size_t S_MW13 = S_BASE;
constexpr size_t S_MW2 = S_MW13 + (size_t)NEXP * 2 * FFE * 1024 * 2;
constexpr size_t S_XS = S_MW2 + (size_t)NEXP * 1024 * FFE * 2;
constexpr size_t S_YS = S_XS + (size_t)MOE_ROWS * 1024 * 2;
constexpr size_t S_MH = S_YS + (size_t)2 * T * 1024 * 2;
constexpr size_t S_TOPI = S_MH + (size_t)MOE_PASS_BLOCKS * 256 * FFE * 2;
constexpr size_t S_TOPW = S_TOPI + (size_t)T * 2 * 4;
constexpr size_t S_ROWSLOT = S_TOPW + (size_t)T * 2 * 4;
constexpr size_t S_ROWW = S_ROWSLOT + (size_t)MOE_ROWS * 4;
constexpr size_t S_BLKE = S_ROWW + (size_t)MOE_ROWS * 4;
constexpr size_t S_MOE_END = S_BLKE + 4096;
constexpr size_t cmax(size_t a, size_t b) { return a > b ? a : b; }
constexpr size_t WS_NEED = cmax(cmax(S_MIX_END, S_GATE_END), S_MOE_END);
static_assert(WS_NEED <= (size_t)896 * MiB, "workspace map exceeds 896 MiB");
static_assert((W_BASE % 256) == 0 && (LW_SIZE % 256) == 0 && (S_BASE % 256) == 0, "alignment");

constexpr int RING_BYTES = 131072;
constexpr int XCH_OFF = RING_BYTES;
constexpr int LDSCTL_OFF = RING_BYTES + 16384;
constexpr int LDS_BYTES = LDSCTL_OFF + 512;
constexpr int NWAVES = 8, NTHREADS = 512;

typedef __bf16 bf16x2_t __attribute__((ext_vector_type(2)));
__device__ __forceinline__ unsigned cvt_pk_bf16(float lo, float hi) { bf16x2_t v = {(__bf16)lo, (__bf16)hi}; return __builtin_bit_cast(unsigned, v); }
__device__ __forceinline__ float bf2f(unsigned short b) { return __uint_as_float((unsigned)b << 16); }
__device__ __forceinline__ float bflo(unsigned w) { return __uint_as_float(w << 16); }
__device__ __forceinline__ float bfhi(unsigned w) { return __uint_as_float(w & 0xffff0000u); }
__device__ __forceinline__ float fexp2(float x) { return __builtin_amdgcn_exp2f(x); }
__device__ __forceinline__ float flog2(float x) { return __builtin_amdgcn_logf(x); }
__device__ __forceinline__ float frcp(float x) { return __builtin_amdgcn_rcpf(x); }
__device__ __forceinline__ float sigmoidf_(float x) { return frcp(1.0f + fexp2(-x * LOG2E)); }
__device__ __forceinline__ float siluf_(float x) { return x * sigmoidf_(x); }
__device__ __forceinline__ float softplusf_(float x) { return fmaxf(x, 0.f) + 0.6931471805599453f * flog2(1.0f + fexp2(-fabsf(x) * LOG2E)); }
__device__ __forceinline__ float wave_sum(float v) {
#pragma unroll
    for (int o = 1; o < 64; o <<= 1) v += __shfl_xor(v, o);
    return v;
}
#define LDS_WAIT() asm volatile("s_waitcnt lgkmcnt(0)" ::: "memory")
#define VM_WAIT() asm volatile("s_waitcnt vmcnt(0)" ::: "memory")
#define XB_TMO      128
#define XB_XCNT(j)  (256  + 64 * (j))
#define XB_XSUB(j)  (1280 + 64 * (j))
#define XB_XGEN(j)  (2304 + 64 * (j))
#define XB_TOP      3328
#define XB_TOPGEN   3392
#define XCD_BAR_WORDS 3456
#define XB_SPIN_CAP (1u << 18)

__device__ __forceinline__ unsigned xb_ld(unsigned* p)              { return __hip_atomic_load(p, __ATOMIC_RELAXED, __HIP_MEMORY_SCOPE_AGENT); }
__device__ __forceinline__ unsigned xb_add(unsigned* p, unsigned v) { return __hip_atomic_fetch_add(p, v, __ATOMIC_RELAXED, __HIP_MEMORY_SCOPE_AGENT); }
__device__ __forceinline__ unsigned xb_xcc_id() { return (unsigned)__builtin_amdgcn_s_getreg((3 << 11) | 20) & 0xFu; }
#define XB_SPIN(cond, bar) do { unsigned _sp = 0; while (cond) { __builtin_amdgcn_s_sleep(1); \
    if ((++_sp & 255u) == 0u) { if (xb_ld(&(bar)[XB_TMO])) break; if (_sp > XB_SPIN_CAP) { atomicAdd(&(bar)[XB_TMO], 1u); break; } } } } while (0)

struct XcdBarrier { unsigned* bar; unsigned x; volatile LAS unsigned* st; };

__device__ __forceinline__ XcdBarrier xcd_barrier_post(unsigned* bar, volatile LAS unsigned* st) {
    XcdBarrier b; b.bar = bar; b.x = xb_xcc_id(); b.st = st;
    if (threadIdx.x == 0) (void)xb_add(&bar[XB_XCNT(b.x)], 1u);
    return b;
}
__device__ __forceinline__ void xcd_barrier_complete(unsigned* bar, unsigned x, unsigned& nloc, unsigned& nx) {
    const unsigned G = gridDim.x * gridDim.y * gridDim.z;
    unsigned sum, cnt, mine, sp = 0u;
    for (;;) {
        sum = 0u; cnt = 0u; mine = 0u;
#pragma unroll
        for (unsigned j = 0; j < 16; ++j) { const unsigned c = xb_ld(&bar[XB_XCNT(j)]); sum += c; cnt += (c > 0u) ? 1u : 0u; mine = (j == x) ? c : mine; }
        if (sum == G) break;
        __builtin_amdgcn_s_sleep(1);
        if ((++sp & 255u) == 0u) { if (xb_ld(&bar[XB_TMO])) break; if (sp > XB_SPIN_CAP) { atomicAdd(&bar[XB_TMO], 1u); break; } }
    }
    nloc = mine > 0u ? mine : 1u; nx = cnt > 0u ? cnt : 1u;
}
__device__ __forceinline__ void xcd_barrier(const XcdBarrier& b) {
    asm volatile("s_waitcnt vmcnt(0)" ::: "memory");
    __syncthreads();
    if (threadIdx.x == 0) {
        unsigned* bar = b.bar;
        __builtin_amdgcn_s_waitcnt(0);
        unsigned nloc = b.st[0], nx = b.st[1];
        if (nloc == 0u) { xcd_barrier_complete(bar, b.x, nloc, nx); b.st[0] = nloc; b.st[1] = nx; }
        const unsigned old = xb_add(&bar[XB_XSUB(b.x)], 1u);
        const unsigned gen = old / nloc;
        if (old + 1u == (gen + 1u) * nloc) {
            __builtin_amdgcn_fence(__ATOMIC_RELEASE, "agent");
            asm volatile("s_waitcnt vmcnt(0)" ::: "memory");
            const unsigned og = xb_add(&bar[XB_TOP], 1u);
            const unsigned tg = og / nx;
            if (og + 1u == (tg + 1u) * nx) xb_add(&bar[XB_TOPGEN], 1u);
            else XB_SPIN(xb_ld(&bar[XB_TOPGEN]) == tg, bar);
            __builtin_amdgcn_fence(__ATOMIC_ACQUIRE, "agent");
            xb_add(&bar[XB_XGEN(b.x)], 1u);
            asm volatile("s_waitcnt vmcnt(0)" ::: "memory");
        } else {
            XB_SPIN(xb_ld(&bar[XB_XGEN(b.x)]) == gen, bar);
            __builtin_amdgcn_fence(__ATOMIC_ACQUIRE, "agent");
            asm volatile("s_waitcnt vmcnt(0)" ::: "memory");
        }
    }
    __syncthreads();
}

namespace pg8 {
constexpr int BM = 256, BK = 64, HALF = 128, HTB = HALF * BK * 2, STAGE_BYTES = 8 * HTB;
__host__ __device__ __forceinline__ int lds_byte(int r, int c) { const int st = (r >> 4) * 2 + (c >> 5), rr = r & 15, cc = c & 31, ob = rr * 64 + cc * 2; return st * 1024 + (ob ^ (((ob >> 9) & 1) << 5)); }
__host__ __device__ __forceinline__ void stage_rc(int b, int& R, int& C) { const int st = b / 1024, sb = b % 1024, swz = sb ^ (((sb >> 9) & 1) << 5); R = (st >> 1) * 16 + swz / 64; C = (st & 1) * 32 + (swz % 64) / 2; }
__host__ __device__ __forceinline__ int perm32(int rho) { const int n = rho >> 4, i = rho & 15; return 8 * (i >> 2) + 4 * n + (i & 3); }

struct Unit { int pm, pn; long aoff, boff; int tag; };
struct Gemm { const bf16_t* A; const bf16_t* Bt; int K, lda, ldb; };

template <class Epi, class Sched, bool ALIGN = true>
__device__ __forceinline__ void gemm_phase(LAS unsigned char* lds, const Gemm g, const Sched& S, const Epi& E) {
    int tid_ = threadIdx.x; asm volatile("" : "+v"(tid_));
    const int tid = tid_, wid = __builtin_amdgcn_readfirstlane(tid >> 6), lane = tid & 63, wr = wid >> 2, wc = wid & 3, fr = lane & 15, fq = lane >> 4;
    int K = g.K; asm volatile("" : "+s"(K)); const int nt = K / BK;
    unsigned voffA[2], voffB[2];
#pragma unroll
    for (int i = 0; i < 2; ++i) { int R, C; stage_rc(tid * 16 + i * 8192, R, C); const int Rb = Epi::PERM ? ((R & ~31) + perm32(R & 31)) : R;
        voffA[i] = (unsigned)(R * g.lda + C) * 2u; voffB[i] = (unsigned)(Rb * g.ldb + C) * 2u; }
    const size_t kstep = (size_t)(BK * 2);
    const size_t hstepA = (size_t)HALF * g.lda * 2, hstepB = (size_t)HALF * g.ldb * 2;
    const size_t tstepA = 2 * hstepA, tstepB = 2 * hstepB;
    const unsigned ldsw = (unsigned)wid * 1024u;
    const int aoff = lds_byte(wr * 64 + fr, fq * 8), boff = lds_byte(wc * 32 + fr, fq * 8);
#define PG8_SA(b, h) (((b) * 2 + (h)) * HTB)
#define PG8_SB(b, h) ((4 + (b) * 2 + (h)) * HTB)
#define PG8_STAGE(bufoff, gbase, voff) do { _Pragma("unroll") for (int _i = 0; _i < 2; ++_i) \
        __builtin_amdgcn_global_load_lds((const unsigned*)((const char*)(gbase) + (voff)[_i]), (LAS unsigned*)(lds + (bufoff) + ldsw + _i * 8192), 16, 0, 0); } while (0)
#define PG8_LDA(dst, b, h) do { _Pragma("unroll") for (int m = 0; m < 4; ++m) _Pragma("unroll") for (int k = 0; k < 2; ++k) dst[m][k] = *(const LAS bf16x8*)(lds + PG8_SA(b, h) + aoff + m * 2048 + k * 1024); } while (0)
#define PG8_LDB(dst, b, h) do { _Pragma("unroll") for (int n = 0; n < 2; ++n) _Pragma("unroll") for (int k = 0; k < 2; ++k) dst[n][k] = *(const LAS bf16x8*)(lds + PG8_SB(b, h) + boff + n * 2048 + k * 1024); } while (0)
#define PG8_MMA(ai, bj, At, Bt) do { __builtin_amdgcn_s_setprio(1); _Pragma("unroll") for (int m = 0; m < 4; ++m) _Pragma("unroll") for (int n = 0; n < 2; ++n) _Pragma("unroll") for (int k = 0; k < 2; ++k) \
        acc[ai][bj][m][n] = __builtin_amdgcn_mfma_f32_16x16x32_bf16(Bt[n][k], At[m][k], acc[ai][bj][m][n], 0, 0, 0); __builtin_amdgcn_s_setprio(0); } while (0)
#define PG8_WAIT_V(n) asm volatile("s_waitcnt vmcnt(" #n ")" ::: "memory")
#define PG8_WAIT_L(n) asm volatile("s_waitcnt lgkmcnt(" #n ")" ::: "memory")
#define PG8_BAR __builtin_amdgcn_s_barrier()
#define PG8_SCHED __builtin_amdgcn_sched_barrier(0)
    Unit cur, nxt; int ui = 0;
    if (!S.next(0, cur)) return;
    f32x4 acc[2][2][4][2];
#pragma unroll
    for (int a = 0; a < 2; ++a)
#pragma unroll
        for (int b = 0; b < 2; ++b)
#pragma unroll
            for (int m = 0; m < 4; ++m)
#pragma unroll
                for (int n = 0; n < 2; ++n) acc[a][b][m][n] = (f32x4){0.f, 0.f, 0.f, 0.f};
    bf16x8 At[4][2], B0[2][2], B1[2][2];
    const char* cA = (const char*)(g.A + cur.aoff) + (size_t)cur.pm * tstepA; const char* cB = (const char*)(g.Bt + cur.boff) + (size_t)cur.pn * tstepB;
    PG8_STAGE(PG8_SB(0, 0), cB, voffB); PG8_STAGE(PG8_SB(0, 1), cB + hstepB, voffB); PG8_STAGE(PG8_SA(0, 0), cA, voffA); PG8_STAGE(PG8_SA(0, 1), cA + hstepA, voffA);
    if (wr == 1) PG8_BAR;
    PG8_WAIT_V(2); PG8_BAR;
    PG8_STAGE(PG8_SB(1, 0), cB + kstep, voffB); PG8_STAGE(PG8_SA(1, 0), cA + kstep, voffA); PG8_STAGE(PG8_SB(1, 1), cB + hstepB + kstep, voffB);
    PG8_WAIT_V(6); PG8_BAR;
    for (;;) {
        const bool has_next = S.next(ui + 1, nxt);
        const char* nA = has_next ? (const char*)(g.A + nxt.aoff) + (size_t)nxt.pm * tstepA : cA; const char* nB = has_next ? (const char*)(g.Bt + nxt.boff) + (size_t)nxt.pn * tstepB : cB;
#pragma unroll 1
        for (int t = 0; t < nt; t += 2) {
            const bool last = (t == nt - 2);
            const char* a1 = cA + (size_t)(t + 1) * kstep;
            const char* a2 = last ? nA : cA + (size_t)(t + 2) * kstep; const char* b2 = last ? nB : cB + (size_t)(t + 2) * kstep;
            const char* a3 = a2 + kstep; const char* b3 = b2 + kstep;
            PG8_LDB(B0, 0, 0); PG8_LDB(B1, 0, 1); PG8_SCHED; PG8_LDA(At, 0, 0); PG8_STAGE(PG8_SA(1, 1), a1 + hstepA, voffA);
            PG8_WAIT_V(8); PG8_WAIT_L(0); PG8_BAR; PG8_MMA(0, 0, At, B0); PG8_MMA(0, 1, At, B1); PG8_BAR; PG8_SCHED;
            PG8_LDA(At, 0, 1); PG8_STAGE(PG8_SB(0, 0), b2, voffB); PG8_STAGE(PG8_SB(0, 1), b2 + hstepB, voffB); PG8_STAGE(PG8_SA(0, 0), a2, voffA);
            PG8_WAIT_V(8); PG8_WAIT_L(0); PG8_BAR; PG8_MMA(1, 0, At, B0); PG8_MMA(1, 1, At, B1); PG8_BAR; PG8_SCHED;
            PG8_LDB(B0, 1, 0); PG8_LDB(B1, 1, 1); PG8_SCHED; PG8_LDA(At, 1, 0); PG8_STAGE(PG8_SA(0, 1), a2 + hstepA, voffA);
            PG8_WAIT_V(8); PG8_WAIT_L(0); PG8_BAR; PG8_MMA(0, 0, At, B0); PG8_MMA(0, 1, At, B1); PG8_BAR; PG8_SCHED;
            PG8_LDA(At, 1, 1); PG8_STAGE(PG8_SB(1, 0), b3, voffB); PG8_STAGE(PG8_SB(1, 1), b3 + hstepB, voffB); PG8_STAGE(PG8_SA(1, 0), a3, voffA);
            PG8_WAIT_V(8); PG8_WAIT_L(0); PG8_BAR; PG8_MMA(1, 0, At, B0); PG8_MMA(1, 1, At, B1); PG8_BAR; PG8_SCHED;
        }
        if constexpr (ALIGN) { if (wr == 0) PG8_BAR; }
        E(acc, cur, wr, wc, fr, fq, wid, lane);
        if (!has_next) break;
#pragma unroll
        for (int a = 0; a < 2; ++a)
#pragma unroll
            for (int b = 0; b < 2; ++b)
#pragma unroll
                for (int m = 0; m < 4; ++m)
#pragma unroll
                    for (int n = 0; n < 2; ++n) acc[a][b][m][n] = (f32x4){0.f, 0.f, 0.f, 0.f};
        cur = nxt; cA = nA; cB = nB; ++ui;
        if constexpr (ALIGN) { if (wr == 1) PG8_BAR; }
    }
    PG8_WAIT_V(0);
    if constexpr (!ALIGN) { if (wr == 0) PG8_BAR; }
    PG8_BAR;
#undef PG8_SA
#undef PG8_SB
#undef PG8_STAGE
#undef PG8_LDA
#undef PG8_LDB
#undef PG8_MMA
#undef PG8_WAIT_V
#undef PG8_WAIT_L
#undef PG8_BAR
#undef PG8_SCHED
}
}
namespace sch {
using pg8::Unit;
__device__ __forceinline__ void tile_of(int L, int nM, int nN, int& pm, int& pn) {
    const int nwg = nM * nN; int wgid = L;
    { const int q = nwg / 8, r = nwg % 8, xcd = wgid % 8, off = wgid / 8; wgid = (xcd < r ? xcd * (q + 1) : r * (q + 1) + (xcd - r) * q) + off; }
    const int nig = 8 * nN, gid = wgid / nig, fm = gid * 8, gsz = (nM - fm) < 8 ? (nM - fm) : 8;
    pm = fm + ((wgid % nig) % gsz); pn = (wgid % nig) / gsz;
}
struct Tiles {
    int nM, nN, G, c;
    __device__ __forceinline__ bool next(int i, Unit& u) const {
        const long L = (long)i * G + c; if (L >= (long)nM * nN) return false;
        tile_of((int)L, nM, nN, u.pm, u.pn); u.aoff = 0; u.boff = 0; u.tag = 0; return true; }
};
struct BrTiles {
    int nM, nN, G, c;
    __device__ __forceinline__ bool next(int i, Unit& u) const {
        const long L = (long)(i >> 2) * G + c; if (L >= (long)nM * nN) return false;
        tile_of((int)L, nM, nN, u.pm, u.pn); const int br = i & 3; u.aoff = br * 256; u.boff = (long)br * 1024 * 256; u.tag = br; return true; }
};
struct XaS {
    int G, c;
    __device__ __forceinline__ bool next(int i, Unit& u) const {
        const int L = i * G + c; if (L >= 512) return false;
        const int b = L >> 5, h = (L >> 3) & 3, rb = L & 7; u.pm = b * 8 + rb; u.pn = b; u.aoff = h * 256; u.boff = h * 256; u.tag = h; return true; }
};
struct XaPV {
    int G, c;
    __device__ __forceinline__ bool next(int i, Unit& u) const {
        const int L = i * G + c; if (L >= 512) return false;
        const int b = L >> 5, h = (L >> 3) & 3, rb = L & 7; u.pm = b * 8 + rb; u.pn = h; u.aoff = h * 256; u.boff = b * 256; u.tag = h; return true; }
};
struct MoeUp {
    const int* blk_e; int b0, b1, G, c;
    __device__ __forceinline__ bool next(int i, Unit& u) const {
        const int L = i * G + c; const int nb = b1 - b0; if (L >= nb * 28) return false;
        const int rb = b0 + L / 28; u.pn = L % 28; u.pm = rb;
        const int e = __builtin_amdgcn_readfirstlane(__hip_atomic_load(blk_e + rb, RLX_AGENT));
        u.aoff = 0; u.boff = (long)e * (2 * FFE) * 1024; u.tag = rb - b0; return true; }
};
struct MoeDown {
    const int* blk_e; int b0, b1, G, c;
    __device__ __forceinline__ bool next(int i, Unit& u) const {
        const int L = i * G + c; const int nb = b1 - b0; if (L >= nb * 4) return false;
        const int rb = b0 + L / 4; u.pn = L % 4; u.pm = rb - b0;
        const int e = __builtin_amdgcn_readfirstlane(__hip_atomic_load(blk_e + rb, RLX_AGENT));
        u.aoff = 0; u.boff = (long)e * 1024 * FFE; u.tag = rb; return true; }
};
}

namespace epi {
using pg8::Unit;
#define EPI_SIG f32x4 (&acc)[2][2][4][2], const Unit& u, int wr, int wc, int fr, int fq, int wid, int lane
#define EPI_ROWS _Pragma("unroll") for (int ai = 0; ai < 2; ++ai) _Pragma("unroll") for (int m = 0; m < 4; ++m)
#define EPI_ROW (u.pm * 256 + ai * 128 + wr * 64 + m * 16 + fr)
#define EPI_BJ _Pragma("unroll") for (int bj = 0; bj < 2; ++bj)
#define EPI_FENCE asm volatile("" ::: "memory")
__device__ __forceinline__ u32x4 pack8(const f32x4 a, const f32x4 b) { u32x4 w; w.x = cvt_pk_bf16(a[0], a[1]); w.y = cvt_pk_bf16(a[2], a[3]); w.z = cvt_pk_bf16(b[0], b[1]); w.w = cvt_pk_bf16(b[2], b[3]); return w; }

template <int ACT> struct StoreBf16 {
    static constexpr bool PERM = true;
    bf16_t* O; int ldc;
    __device__ __forceinline__ void operator()(EPI_SIG) const {
        EPI_ROWS { bf16_t* rowp = O + (size_t)EPI_ROW * ldc + u.pn * 256 + wc * 32 + 8 * fq;
            EPI_BJ { f32x4 v0 = acc[ai][bj][m][0], v1 = acc[ai][bj][m][1];
                if (ACT == 1) { for (int j = 0; j < 4; ++j) { v0[j] = sigmoidf_(v0[j]); v1[j] = sigmoidf_(v1[j]); } }
                *(u32x4*)(rowp + bj * 128) = pack8(v0, v1); } EPI_FENCE; }
    }
};
struct Lora {
    static constexpr bool PERM = true;
    float* dec; bf16_t* av; bf16_t* gv; const float* w0; const float* a0;
    __device__ __forceinline__ void operator()(EPI_SIG) const {
        EPI_ROWS { const size_t row = EPI_ROW;
            EPI_BJ { const int col = bj * 128 + wc * 32 + 8 * fq; f32x4 v0 = acc[ai][bj][m][0], v1 = acc[ai][bj][m][1];
                if (u.pn == 0) {
                    const f32x4 b0 = *(const f32x4*)(w0 + col), b1 = *(const f32x4*)(w0 + col + 4);
                    for (int j = 0; j < 4; ++j) { float x = v0[j] + b0[j]; float wl = -softplusf_(-x) - 0.5f; v0[j] = fexp2(-fexp2(wl * LOG2E) * LOG2E);
                                                  x = v1[j] + b1[j]; wl = -softplusf_(-x) - 0.5f; v1[j] = fexp2(-fexp2(wl * LOG2E) * LOG2E); }
                    *(f32x4*)(dec + row * 256 + col) = v0; *(f32x4*)(dec + row * 256 + col + 4) = v1;
                } else if (u.pn == 1) {
                    const f32x4 b0 = *(const f32x4*)(a0 + col), b1 = *(const f32x4*)(a0 + col + 4);
                    for (int j = 0; j < 4; ++j) { v0[j] = sigmoidf_(v0[j] + b0[j]); v1[j] = sigmoidf_(v1[j] + b1[j]); }
                    *(u32x4*)(av + row * 256 + col) = pack8(v0, v1);
                } else { *(u32x4*)(gv + row * 256 + col) = pack8(v0, v1); } } EPI_FENCE; }
    }
};
struct Uq {
    static constexpr bool PERM = false;
    bf16_t* Q; const float* cosT; const float* sinT;
    __device__ __forceinline__ void operator()(EPI_SIG) const {
        EPI_ROWS { const size_t row = EPI_ROW;
            EPI_BJ { const int c32 = u.pn * 256 + bj * 128 + wc * 32; if (c32 >= 384) continue;
                f32x4 v0 = acc[ai][bj][m][0], v1 = acc[ai][bj][m][1];
                if ((c32 >> 5) % 3 == 2) {
                    const f32x4 cs = *(const f32x4*)(cosT + row * 16 + 4 * fq), sn = *(const f32x4*)(sinT + row * 16 + 4 * fq);
                    const f32x4 o0 = v0 * cs - v1 * sn, o1 = v0 * sn + v1 * cs; v0 = o0; v1 = o1; }
                u32x2 w0, w1; w0.x = cvt_pk_bf16(v0[0], v0[1]); w0.y = cvt_pk_bf16(v0[2], v0[3]); w1.x = cvt_pk_bf16(v1[0], v1[1]); w1.y = cvt_pk_bf16(v1[2], v1[3]);
                *(u32x2*)(Q + row * 384 + c32 + 4 * fq) = w0; *(u32x2*)(Q + row * 384 + c32 + 16 + 4 * fq) = w1; } EPI_FENCE; }
    }
};
struct Ukv {
    static constexpr bool PERM = true;
    bf16_t* Km; bf16_t* Vm;
    __device__ __forceinline__ void operator()(EPI_SIG) const {
        EPI_ROWS { const size_t row = EPI_ROW;
            EPI_BJ { const int col = u.pn * 256 + bj * 128 + wc * 32 + 8 * fq; const int h = col >> 7, j = col & 127;
                const u32x4 w = pack8(acc[ai][bj][m][0], acc[ai][bj][m][1]);
                if (j < 64) *(u32x4*)(Km + row * 384 + h * 96 + j) = w; else *(u32x4*)(Vm + row * 256 + h * 64 + (j - 64)) = w; } EPI_FENCE; }
    }
};
struct Resid {
    static constexpr bool PERM = false;
    const float* res; float* out; float ascale;
    __device__ __forceinline__ void operator()(EPI_SIG) const {
        EPI_ROWS { const size_t off = (size_t)EPI_ROW * 1024 + u.pn * 256 + wc * 32 + 4 * fq;
            EPI_BJ { _Pragma("unroll") for (int n = 0; n < 2; ++n) { const size_t o = off + bj * 128 + n * 16; const f32x4 r = *(const f32x4*)(res + o); *(f32x4*)(out + o) = r * DN_ALPHA + acc[ai][bj][m][n] * ascale; } } EPI_FENCE; }
    }
};
struct Swiglu {
    static constexpr bool PERM = false;
    bf16_t* H; int ldh; int use_tag;
    __device__ __forceinline__ void operator()(EPI_SIG) const {
        const int pmo = use_tag ? u.tag : u.pm;
        EPI_ROWS { const size_t row = (size_t)(pmo * 256 + ai * 128 + wr * 64 + m * 16 + fr);
            EPI_BJ { const int hc = (u.pn * 256 + bj * 128 + wc * 32) / 2 + 4 * fq; const f32x4 g = acc[ai][bj][m][0], up = acc[ai][bj][m][1];
                u32x2 w; w.x = cvt_pk_bf16(siluf_(g[0]) * up[0], siluf_(g[1]) * up[1]); w.y = cvt_pk_bf16(siluf_(g[2]) * up[2], siluf_(g[3]) * up[3]);
                *(u32x2*)(H + row * ldh + hc) = w; } EPI_FENCE; }
    }
};
struct BrGate {
    static constexpr bool PERM = true;
    const bf16_t* G; float* mf; bf16_t* mb;
    __device__ __forceinline__ void operator()(EPI_SIG) const {
        const int br = u.tag;
#ifdef ABL_BR
        const float ablk = ((ABL_BR >> br) & 1) ? 0.f : 1.f;
#else
        const float ablk = 1.f;
#endif
        EPI_ROWS { const size_t row = EPI_ROW;
            EPI_BJ { const int col = u.pn * 256 + bj * 128 + wc * 32 + 8 * fq;
#ifdef G_SYS_LOAD
                u32x4 gw; { const unsigned long long* gp_ = (const unsigned long long*)(G + row * 4096 + br * 1024 + col); const unsigned long long q0 = __hip_atomic_load(gp_, __ATOMIC_RELAXED, __HIP_MEMORY_SCOPE_SYSTEM), q1 = __hip_atomic_load(gp_ + 1, __ATOMIC_RELAXED, __HIP_MEMORY_SCOPE_SYSTEM); gw.x = (unsigned)q0; gw.y = (unsigned)(q0 >> 32); gw.z = (unsigned)q1; gw.w = (unsigned)(q1 >> 32); }
#else
                const u32x4 gw = *(const u32x4*)(G + row * 4096 + br * 1024 + col);
#endif
                f32x4 v0 = acc[ai][bj][m][0] * ablk, v1 = acc[ai][bj][m][1] * ablk;
#if defined(GATE_ACT) && GATE_ACT == 0
#define GSIG(x) sigmoidf_(x)
#else
#define GSIG(x) (x)
#endif
                v0[0] *= GSIG(bflo(gw.x)); v0[1] *= GSIG(bfhi(gw.x)); v0[2] *= GSIG(bflo(gw.y)); v0[3] *= GSIG(bfhi(gw.y));
                v1[0] *= GSIG(bflo(gw.z)); v1[1] *= GSIG(bfhi(gw.z)); v1[2] *= GSIG(bflo(gw.w)); v1[3] *= GSIG(bfhi(gw.w));
                float* p = mf + row * 1024 + col;
                if (br > 0) { v0 += *(const f32x4*)p; v1 += *(const f32x4*)(p + 4); }
                if (br < 3) { *(f32x4*)p = v0; *(f32x4*)(p + 4) = v1; }
                else *(u32x4*)(mb + row * 1024 + col) = pack8(v0, v1); } EPI_FENCE; }
    }
};
struct MoeDown {
    static constexpr bool PERM = true;
    const int* row_slot; const float* row_w; bf16_t* ys;
    __device__ __forceinline__ void operator()(EPI_SIG) const {
        EPI_ROWS { const int r = u.tag * 256 + ai * 128 + wr * 64 + m * 16 + fr;
            const int slot = __hip_atomic_load(row_slot + r, RLX_AGENT); const float w = __hip_atomic_load(row_w + r, RLX_AGENT);
            if (slot >= 0) { EPI_BJ { const int col = u.pn * 256 + bj * 128 + wc * 32 + 8 * fq;
                *(u32x4*)(ys + (size_t)slot * 1024 + col) = pack8(acc[ai][bj][m][0] * w, acc[ai][bj][m][1] * w); } } EPI_FENCE; }
    }
};
struct Softmax {
    static constexpr bool PERM = true;
    bf16_t* P; LAS float* xch;
    __device__ __forceinline__ void operator()(EPI_SIG) const {
        EPI_ROWS { float v = -3.0e38f;
            EPI_BJ { const f32x4 a = acc[ai][bj][m][0], b = acc[ai][bj][m][1]; v = fmaxf(v, fmaxf(fmaxf(fmaxf(a[0], a[1]), fmaxf(a[2], a[3])), fmaxf(fmaxf(b[0], b[1]), fmaxf(b[2], b[3])))); }
            v = fmaxf(v, __shfl_xor(v, 16)); v = fmaxf(v, __shfl_xor(v, 32));
            if (fq == 0) xch[(ai * 128 + wr * 64 + m * 16 + fr) * 4 + wc] = v; }
        LDS_WAIT(); __builtin_amdgcn_s_barrier(); asm volatile("" ::: "memory");
        EPI_ROWS { const f32x4 q = *(const LAS f32x4*)(xch + (ai * 128 + wr * 64 + m * 16 + fr) * 4);
            const float mm = fmaxf(fmaxf(q[0], q[1]), fmaxf(q[2], q[3])); float s = 0.f;
            EPI_BJ { _Pragma("unroll") for (int n = 0; n < 2; ++n) { f32x4 t = acc[ai][bj][m][n]; for (int j = 0; j < 4; ++j) { t[j] = fexp2(t[j] - mm); s += t[j]; } acc[ai][bj][m][n] = t; } }
            s += __shfl_xor(s, 16); s += __shfl_xor(s, 32);
            if (fq == 0) xch[1024 + (ai * 128 + wr * 64 + m * 16 + fr) * 4 + wc] = s; }
        LDS_WAIT(); __builtin_amdgcn_s_barrier(); asm volatile("" ::: "memory");
        EPI_ROWS { const f32x4 q = *(const LAS f32x4*)(xch + 1024 + (ai * 128 + wr * 64 + m * 16 + fr) * 4);
            const float inv = frcp((q[0] + q[1]) + (q[2] + q[3]));
            bf16_t* rowp = P + (size_t)EPI_ROW * 1024 + u.tag * 256 + wc * 32 + 8 * fq;
            EPI_BJ { *(u32x4*)(rowp + bj * 128) = pack8(acc[ai][bj][m][0] * inv, acc[ai][bj][m][1] * inv); } EPI_FENCE; }
        LDS_WAIT(); __builtin_amdgcn_s_barrier(); asm volatile("" ::: "memory");
    }
};
}
struct Args { const float* in[42]; float* out; unsigned char* ws; int ph_lo, ph_hi; };
struct Ctx {
    const float* const* in; float* out; unsigned char* ws; LAS unsigned char* lds;
    int tid, lane, wave, G, bid;
};
enum { I_X = 0, I_MEM, I_POS, I_WIN, I_RWMU, I_RWW0, I_RWWUP, I_RWA0, I_RWAUP, I_RWGUP, I_RWKK, I_RWKA, I_RWRK, I_RWGNG, I_RWGNB,
       I_CONVW, I_CONVB, I_DTB, I_ALOG, I_SSDD, I_SSDNG, I_QNG, I_WUQ, I_KVNG, I_WUKV, I_WBR, I_WGATE, I_WOUT, I_LN1G, I_LN1B,
       I_XWQ, I_XWKV, I_XWO, I_LN2G, I_LN2B, I_FFN13, I_FFN2, I_ROUTER, I_MOE13, I_MOE2, I_LN3G, I_LN3B };
__device__ __forceinline__ Ctx launder(const Ctx& C0) {
    Ctx L = C0; float* out_ = C0.out; unsigned char* ws_ = C0.ws; int t_ = threadIdx.x;
    asm volatile("" : "+s"(out_), "+s"(ws_), "+v"(t_));
    L.out = out_; L.ws = ws_; L.tid = t_; L.lane = t_ & 63; L.wave = __builtin_amdgcn_readfirstlane(t_ >> 6); return L;
}
#define WSP(T_, off) ((T_*)(C.ws + (off)))
#define GW (C.bid * NWAVES + C.wave)
#define NGW (C.G * NWAVES)

struct TJob { const float* W; int ldw, K, N; bf16_t* WT; int ldt; int map; float scale; int items; };
__device__ __forceinline__ int tj_items(int K, int N) { return (K / 64) * ((N + 31) / 32); }
__device__ __forceinline__ int tj_dest(int map, int n, int N) {
    if (map == 0) return n;
    if (map == 1) return n < 2816 ? n : (n < 2820 ? PC_DT + (n - 2816) : n - 4);
    const int half = N >> 1, j = n < half ? n : n - half;
    return (j >> 4) * 32 + (j & 15) + (n < half ? 0 : 16);
}
__device__ __forceinline__ void transpose_item(const TJob& J, LAS float* scr, int item, int lane) {
    const int nblk = (J.N + 31) / 32, kb = item / nblk, nb = item % nblk, k0 = 64 * kb, n0 = 32 * nb;
    const int nn = n0 + (lane & 31); const bool okn = nn < J.N;
#pragma unroll 8
    for (int i = 0; i < 32; ++i) { const int kk = 2 * i + (lane >> 5); scr[kk * 33 + (lane & 31)] = okn ? J.W[(size_t)(k0 + kk) * J.ldw + nn] : 0.f; }
    LDS_WAIT(); asm volatile("" ::: "memory");
    const int c = lane & 7;
#pragma unroll
    for (int j = 0; j < 4; ++j) { const int nl = (lane >> 3) + 8 * j, n = n0 + nl;
        if (n < J.N) { const LAS float* s = scr + (8 * c) * 33 + nl; const float sc = (J.map == 1 && n >= 256) ? 1.0f : J.scale;
            u32x4 o; o.x = cvt_pk_bf16(s[0 * 33] * sc, s[1 * 33] * sc); o.y = cvt_pk_bf16(s[2 * 33] * sc, s[3 * 33] * sc); o.z = cvt_pk_bf16(s[4 * 33] * sc, s[5 * 33] * sc); o.w = cvt_pk_bf16(s[6 * 33] * sc, s[7 * 33] * sc);
            *(u32x4*)(J.WT + (size_t)tj_dest(J.map, n, J.N) * J.ldt + k0 + 8 * c) = o; } }
    LDS_WAIT(); asm volatile("" ::: "memory");
}
__device__ __forceinline__ TJob mkjob(const float* W, int ldw, int K, int N, bf16_t* WT, int ldt, int map, float scale) { TJob j; j.W = W; j.ldw = ldw; j.K = K; j.N = N; j.WT = WT; j.ldt = ldt; j.map = map; j.scale = scale; j.items = tj_items(K, N); return j; }

__device__ __forceinline__ TJob prologue_job(const Ctx& C, int j) {
    if (j < 26) { const int l = j / 13, r = j % 13; unsigned char* LW = C.ws + W_BASE + (size_t)l * LW_SIZE;
        if (r == 0) return mkjob(C.in[I_WIN] + (size_t)l * 1024 * 3236, 3236, 1024, 3236, (bf16_t*)(LW + LW_WIN), 1024, 1, 0.125f * LOG2E);
        if (r < 5) { const int i = r - 1; return mkjob(C.in[I_WGATE] + ((size_t)l * 4 + i) * 1024 * 1024, 1024, 1024, 1024, (bf16_t*)(LW + LW_WGATE) + (size_t)i * 1024 * 1024, 1024, 0, 1.f); }
        if (r < 9) { const int i = r - 5; return mkjob(C.in[I_WBR] + ((size_t)l * 4 + i) * 256 * 1024, 1024, 256, 1024, (bf16_t*)(LW + LW_WBR) + (size_t)i * 1024 * 256, 256, 0, 1.f); }
        if (r == 9) return mkjob(C.in[I_WOUT] + (size_t)l * 1024 * 1024, 1024, 1024, 1024, (bf16_t*)(LW + LW_WOUT), 1024, 0, 1.f);
        if (r == 10) return mkjob(C.in[I_XWQ] + (size_t)l * 1024 * 1024, 1024, 1024, 1024, (bf16_t*)(LW + LW_WQ), 1024, 0, 0.0625f * LOG2E);
        if (r == 11) return mkjob(C.in[I_XWKV] + (size_t)l * 1024 * 2048, 2048, 1024, 2048, (bf16_t*)(LW + LW_WKV), 1024, 0, 1.f);
        return mkjob(C.in[I_XWO] + (size_t)l * 1024 * 1024, 1024, 1024, 1024, (bf16_t*)(LW + LW_WO), 1024, 0, 1.f);
    }
    if (j == 26) return mkjob(C.in[I_FFN13], 2 * FFD, 1024, 2 * FFD, WSP(bf16_t, W_FFN13), 1024, 2, 1.f);
    return mkjob(C.in[I_FFN2], 1024, FFD, 1024, WSP(bf16_t, W_FFN2), FFD, 0, 1.f);
}
__device__ __forceinline__ TJob moe_job(const Ctx& C, int j) {
    if (j < 8) return mkjob(C.in[I_MOE13] + (size_t)j * 1024 * 2 * FFE, 2 * FFE, 1024, 2 * FFE, WSP(bf16_t, S_MW13) + (size_t)j * 2 * FFE * 1024, 1024, 2, 1.f);
    const int e = j - 8; return mkjob(C.in[I_MOE2] + (size_t)e * FFE * 1024, 1024, FFE, 1024, WSP(bf16_t, S_MW2) + (size_t)e * 1024 * FFE, FFE, 0, 1.f);
}
template <int NJ, bool MOE> __device__ __forceinline__ void run_tjobs(const Ctx& C) {
    LAS float* scr = (LAS float*)(C.lds + C.wave * 16384);
    int total = 0;
    for (int j = 0; j < NJ; ++j) { const TJob J = MOE ? moe_job(C, j) : prologue_job(C, j); total += J.items; }
    int j = 0, jbase = 0; TJob J = MOE ? moe_job(C, 0) : prologue_job(C, 0);
    for (int it = GW; it < total; it += NGW) {
        while (it >= jbase + J.items) { jbase += J.items; ++j; J = MOE ? moe_job(C, j) : prologue_job(C, j); }
        transpose_item(J, scr, it - jbase, C.lane);
    }
}


constexpr int CW_CHK = 32768;
template <class OutF> __device__ __forceinline__ void chk_gemm(const Ctx& C, const bf16_t* A, int lda, const bf16_t* Bt, int ldb, int K, int nrows, int ncs, int cstride, int c0, int bit, OutF expect_vs_got) {
    unsigned bad = 0; const int lane = C.lane;
    for (int it = GW; it < nrows * ncs; it += NGW) {
        const int r = it / ncs, c = c0 + (it % ncs) * cstride; float d = 0.f;
        for (int k = lane * 8; k < K; k += 512) { const u32x4 a = *(const u32x4*)(A + (size_t)r * lda + k), b = *(const u32x4*)(Bt + (size_t)c * ldb + k);
            d += bflo(a.x) * bflo(b.x) + bfhi(a.x) * bfhi(b.x) + bflo(a.y) * bflo(b.y) + bfhi(a.y) * bfhi(b.y) + bflo(a.z) * bflo(b.z) + bfhi(a.z) * bfhi(b.z) + bflo(a.w) * bflo(b.w) + bfhi(a.w) * bfhi(b.w); }
        d = wave_sum(d);
        if (!expect_vs_got(r, c, d)) bad = 1;
    }
    if (lane == 0 && bad) __hip_atomic_fetch_add((unsigned*)(C.ws + WS_CTL) + CW_CHK + 64 * bit, 1u, RLX_AGENT);
}
__device__ __forceinline__ bool chk_close(float e, float g) { return fabsf(e - g) <= 0.03f * fabsf(e) + 0.03f; }

__device__ __forceinline__ float chk_dot(const bf16_t* a, const bf16_t* b, int K, int lane) {
    float d = 0.f;
    for (int k = lane * 8; k < K; k += 512) { const u32x4 x = *(const u32x4*)(a + k), y = *(const u32x4*)(b + k);
        d += bflo(x.x) * bflo(y.x) + bfhi(x.x) * bfhi(y.x) + bflo(x.y) * bflo(y.y) + bfhi(x.y) * bfhi(y.y) + bflo(x.z) * bflo(y.z) + bfhi(x.z) * bfhi(y.z) + bflo(x.w) * bflo(y.w) + bfhi(x.w) * bfhi(y.w); }
    return wave_sum(d);
}
__device__ __forceinline__ void chk_flag(const Ctx& C, int bit, unsigned bad) { if (C.lane == 0 && bad) __hip_atomic_fetch_add((unsigned*)(C.ws + WS_CTL) + CW_CHK + 64 * bit, 1u, RLX_AGENT); }
__device__ __forceinline__ void chk_merged(const Ctx& C, int l, int bit) {
    const bf16_t* Y = WSP(bf16_t, S_Y); const bf16_t* G = WSP(bf16_t, S_G); const bf16_t* MB = WSP(bf16_t, S_MB); const bf16_t* WBR = (const bf16_t*)(C.ws + W_BASE + (size_t)l * LW_SIZE + LW_WBR); unsigned bad = 0;
    for (int it = GW; it < T * 4; it += NGW) { const int r = it >> 2, c = 13 + 256 * (it & 3); float e = 0.f;
        for (int i = 0; i < 4; ++i) e += bf2f(G[(size_t)r * 4096 + i * 1024 + c]) * chk_dot(Y + (size_t)r * 1024 + 256 * i, WBR + ((size_t)i * 1024 + c) * 256, 256, C.lane);
        if (!chk_close(e, bf2f(MB[(size_t)r * 1024 + c]))) bad = 1; }
    chk_flag(C, bit, bad);
}
__device__ __forceinline__ void chk_swiglu(const Ctx& C, int bit) {
    const bf16_t* XB = WSP(bf16_t, W_XB); const bf16_t* W = WSP(bf16_t, W_FFN13); const bf16_t* H = WSP(bf16_t, S_H); unsigned bad = 0;
    for (int it = GW; it < T * 22; it += NGW) { const int r = it / 22, hc = 5 + 128 * (it % 22); const int grow = (hc >> 4) * 32 + (hc & 15);
        const float g = chk_dot(XB + (size_t)r * 1024, W + (size_t)grow * 1024, 1024, C.lane), u = chk_dot(XB + (size_t)r * 1024, W + (size_t)(grow + 16) * 1024, 1024, C.lane);
        if (!chk_close(siluf_(g) * u, bf2f(H[(size_t)r * FFD + hc]))) bad = 1; }
    chk_flag(C, bit, bad);
}

constexpr size_t S_CHKBUF = S_BASE + (size_t)400 * MiB;
__device__ __forceinline__ void chk_resid_stash(const Ctx& C, const bf16_t* A, int lda, const bf16_t* Bt, int ldb, int K, int slot) {
    const float* XR = WSP(float, W_XRES); float* CB = WSP(float, S_CHKBUF);
    for (int it = GW; it < T * 4; it += NGW) { const int r = it >> 2, q = it & 3, c = 17 + 256 * q; const float d = chk_dot(A + (size_t)r * lda, Bt + (size_t)c * ldb, K, C.lane);
        if (C.lane == 0) CB[(size_t)r * 8 + slot * 4 + q] = XR[(size_t)r * 1024 + c] * DN_ALPHA + d; }
}
__device__ __forceinline__ void chk_resid_cmp(const Ctx& C, int slot, int bit) {
    const float* XR = WSP(float, W_XRES); const float* CB = WSP(float, S_CHKBUF); unsigned bad = 0;
    for (int it = GW; it < T * 4; it += NGW) { const int r = it >> 2, q = it & 3, c = 17 + 256 * q; if (!chk_close(CB[(size_t)r * 8 + slot * 4 + q], XR[(size_t)r * 1024 + c])) bad = 1; }
    chk_flag(C, bit, bad);
}
__device__ __forceinline__ void chk_ln_stash(const Ctx& C, const float* g, const float* b, int slot) {
    const float* XR = WSP(float, W_XRES); float* CB = WSP(float, S_CHKBUF); const int lane = C.lane;
    for (int t = GW; t < T; t += NGW) { float s = 0.f, s2 = 0.f; float v[16];
        for (int j = 0; j < 16; ++j) { v[j] = XR[(size_t)t * 1024 + lane + 64 * j]; s += v[j]; }
        const float mean = wave_sum(s) * (1.0f / 1024.0f); for (int j = 0; j < 16; ++j) { const float d = v[j] - mean; s2 += d * d; }
        const float rstd = 1.0f / sqrtf(wave_sum(s2) * (1.0f / 1024.0f) + 1e-5f);
        if (lane < 4) { const int c = 17 + 256 * lane; CB[(size_t)t * 8 + slot * 4 + lane] = (XR[(size_t)t * 1024 + c] - mean) * rstd * g[c] + b[c]; } }
}
__device__ __forceinline__ void chk_ln_cmp(const Ctx& C, int slot, int bit) {
    const float* XR = WSP(float, W_XRES); const bf16_t* XB = WSP(bf16_t, W_XB); const float* CB = WSP(float, S_CHKBUF); unsigned bad = 0;
    for (int it = GW; it < T * 4; it += NGW) { const int r = it >> 2, q = it & 3, c = 17 + 256 * q; const float e = CB[(size_t)r * 8 + slot * 4 + q];
        if (!chk_close(e, XR[(size_t)r * 1024 + c]) || !chk_close(e, bf2f(XB[(size_t)r * 1024 + c]))) bad = 1; }
    chk_flag(C, bit, bad);
}

template <int NJ, bool MOE> __device__ __forceinline__ void chk_weights(const Ctx& C, int bit) {
    unsigned bad = 0; const int gt = C.bid * NTHREADS + C.tid, NT = C.G * NTHREADS;
    for (int j = 0; j < NJ; ++j) { const TJob J = MOE ? moe_job(C, j) : prologue_job(C, j);
        for (size_t i = gt; i < (size_t)J.K * J.N; i += NT) { const int k = (int)(i / J.N), n = (int)(i % J.N);
            const float sc = (J.map == 1 && n >= 256) ? 1.0f : J.scale; const bf16_t e = (bf16_t)(cvt_pk_bf16(J.W[(size_t)k * J.ldw + n] * sc, 0.f) & 0xffffu);
            if (J.WT[(size_t)tj_dest(J.map, n, J.N) * J.ldt + k] != e) bad = 1; } }
    if (bad) __hip_atomic_fetch_add((unsigned*)(C.ws + WS_CTL) + CW_CHK + 64 * bit, 1u, RLX_AGENT);
}

__device__ __forceinline__ void chk_mla_inputs(const Ctx& C, int l, int bit) {
    const bf16_t* proj = WSP(bf16_t, S_PROJ); const bf16_t* QM = WSP(bf16_t, S_QM); const bf16_t* KM = WSP(bf16_t, S_KM); const bf16_t* VM = WSP(bf16_t, S_VM);
    const float* wuq = C.in[I_WUQ] + (size_t)l * 256 * 384; const float* wukv = C.in[I_WUKV] + (size_t)l * 128 * 512; const float* qg = C.in[I_QNG] + l * 256; const float* kvg = C.in[I_KVNG] + l * 128;
    const int* pos = (const int*)C.in[I_POS]; const int lane = C.lane; unsigned bad = 0; const float qs = 0.10206207261596575f * LOG2E;
    for (int t = GW; t < T; t += NGW) {
        const bf16_t* pr = proj + (size_t)t * NPROJ; float cq[4], ck[2]; float ss = 0.f;
        for (int i = 0; i < 4; ++i) { cq[i] = bf2f(pr[PC_CQ + lane + 64 * i]); ss += cq[i] * cq[i]; }
        float rs = 1.0f / sqrtf(wave_sum(ss) * (1.0f / 256.0f) + 1e-6f); for (int i = 0; i < 4; ++i) cq[i] *= rs * qg[lane + 64 * i];
        ss = 0.f; for (int i = 0; i < 2; ++i) { ck[i] = bf2f(pr[PC_CKV + lane + 64 * i]); ss += ck[i] * ck[i]; }
        rs = 1.0f / sqrtf(wave_sum(ss) * (1.0f / 128.0f) + 1e-6f); for (int i = 0; i < 2; ++i) ck[i] *= rs * kvg[lane + 64 * i];
        const float ang = (float)pos[t] * exp2f(-6.0f * (13.287712379549449f / 32.0f)); const float c3 = cosf(ang), s3 = sinf(ang);
        const int h = t & 3;
        float qn = 0.f, q1 = 0.f, q2 = 0.f, kn = 0.f, vv = 0.f;
        for (int i = 0; i < 4; ++i) { const int k = lane + 64 * i; qn += cq[i] * wuq[(size_t)k * 384 + h * 96 + 5]; q1 += cq[i] * wuq[(size_t)k * 384 + h * 96 + 67]; q2 += cq[i] * wuq[(size_t)k * 384 + h * 96 + 83]; }
        for (int i = 0; i < 2; ++i) { const int k = lane + 64 * i; kn += ck[i] * wukv[(size_t)k * 512 + h * 128 + 7]; vv += ck[i] * wukv[(size_t)k * 512 + h * 128 + 64 + 9]; }
        qn = wave_sum(qn) * qs; q1 = wave_sum(q1) * qs; q2 = wave_sum(q2) * qs; kn = wave_sum(kn); vv = wave_sum(vv);
        const float kr1 = bf2f(pr[PC_KR + 3]), kr2 = bf2f(pr[PC_KR + 19]);
        const bf16_t* qrow = QM + (size_t)t * 384 + h * 96; const bf16_t* krow = KM + (size_t)t * 384 + h * 96;
        if (!chk_close(qn, bf2f(qrow[5])) || !chk_close(q1 * c3 - q2 * s3, bf2f(qrow[67])) || !chk_close(q1 * s3 + q2 * c3, bf2f(qrow[83])) || !chk_close(kn, bf2f(krow[7])) ||
            !chk_close(kr1 * c3 - kr2 * s3, bf2f(krow[67])) || !chk_close(kr1 * s3 + kr2 * c3, bf2f(krow[83])) || !chk_close(vv, bf2f(VM[(size_t)t * 256 + h * 64 + 9]))) bad = 1;
    }
    chk_flag(C, bit, bad);
}

__device__ __forceinline__ void chk_rw_inputs(const Ctx& C, int l, int bit) {
    const bf16_t* proj = WSP(bf16_t, S_PROJ); const float* DEC = WSP(float, S_DEC); const bf16_t* RWS = WSP(bf16_t, S_RWS); const bf16_t* GV = WSP(bf16_t, S_GV); const size_t PL = (size_t)T * 256;
    const float* mu = C.in[I_RWMU] + l * 1024; const float* w0 = C.in[I_RWW0] + l * 256; const float* a0 = C.in[I_RWA0] + l * 256;
    const float* wup = C.in[I_RWWUP] + l * 64 * 256; const float* aup = C.in[I_RWAUP] + l * 64 * 256; const float* gup = C.in[I_RWGUP] + l * 128 * 256;
    const float* kkw = C.in[I_RWKK] + l * 256; const float* kaw = C.in[I_RWKA] + l * 256; const int lane = C.lane; unsigned bad = 0;
    for (int t = GW; t < T; t += NGW) {
        const bf16_t* pr = proj + (size_t)t * NPROJ + PC_RW; const bool first = (t % SEQ) == 0; const int h = t & 3, c = h * 64 + 11;
        auto sh = [&](int col) { const float cur = bf2f(pr[col]); const float prv = first ? 0.f : bf2f(pr[col - NPROJ]); return cur + (prv - cur) * mu[col]; };
        float dw = tanhf(sh(768 + lane)) * wup[lane * 256 + c], da = sh(832 + lane) * aup[lane * 256 + c];
        float dg = (1.0f / (1.0f + expf(-sh(896 + lane)))) * gup[lane * 256 + c] + (1.0f / (1.0f + expf(-sh(960 + lane)))) * gup[(64 + lane) * 256 + c];
        dw = wave_sum(dw); da = wave_sum(da); dg = wave_sum(dg);
        const float xw = w0[c] + dw; const float wlog = -(fmaxf(-xw, 0.f) + log1pf(expf(-fabsf(xw)))) - 0.5f; const float dec = expf(-expf(wlog));
        const float a = 1.0f / (1.0f + expf(-(a0[c] + da)));
        const float kl = sh(256 + h * 64 + lane) * kkw[h * 64 + lane]; const float nrm = 1.0f / sqrtf(fmaxf(wave_sum(kl * kl), 1e-24f));
        const float r = sh(c), k = sh(256 + c), v = sh(512 + c); const float kk = k * kkw[c] * nrm, kmod = k * (1.0f + (a - 1.0f) * kaw[c]), ka = kk * a;
        const size_t o = (size_t)t * 256 + c;
        if (!chk_close(dec, DEC[o]) || fabsf(dec - DEC[o]) > 0.004f || !chk_close(r, bf2f(RWS[o])) || !chk_close(kmod, bf2f(RWS[PL + o])) || !chk_close(v, bf2f(RWS[2 * PL + o])) || !chk_close(kk, bf2f(RWS[3 * PL + o])) ||
            !chk_close(ka, bf2f(RWS[4 * PL + o])) || !chk_close(dg, bf2f(GV[o]))) bad = 1;
    }
    chk_flag(C, bit, bad);
}
__device__ __forceinline__ void chk_ssd_norm(const Ctx& C, int l, int bit) {
    const bf16_t* Y = WSP(bf16_t, S_Y); const float* ng = C.in[I_SSDNG] + l * 256; const int lane = C.lane; unsigned bad = 0;
    for (int t = GW; t < T; t += NGW) { float q = 0.f;
        for (int i = 0; i < 4; ++i) { const int c = (lane >> 5) * 128 + (lane & 31) * 4 + i; const float y = bf2f(Y[(size_t)t * 1024 + 512 + c]) / ng[c]; q += y * y; }
        for (int o_ = 1; o_ < 32; o_ <<= 1) q += __shfl_xor(q, o_);
        q *= (1.0f / 128.0f); if (q < 0.9f || q > 1.1f) bad = 1; }
    chk_flag(C, bit, bad);
}

#ifndef P7_COND
#define P7_COND 1
#endif
#ifndef P7_CLASS
#define P7_CLASS (((c & 31) < 16 ? 1u : 2u) | ((c & 255) < 128 ? 4u : 8u))
#endif
__device__ __forceinline__ float tdot(const bf16_t* a, const bf16_t* b, int K) { float d = 0.f;
    for (int k = 0; k < K; k += 8) { const u32x4 x = *(const u32x4*)(a + k), y = *(const u32x4*)(b + k);
        d += bflo(x.x) * bflo(y.x) + bfhi(x.x) * bfhi(y.x) + bflo(x.y) * bflo(y.y) + bfhi(x.y) * bfhi(y.y) + bflo(x.z) * bflo(y.z) + bfhi(x.z) * bfhi(y.z) + bflo(x.w) * bflo(y.w) + bfhi(x.w) * bfhi(y.w); }
    return d; }
__device__ __forceinline__ void chk_full_p7(const Ctx& C, int l, int bit) {
    const bf16_t* MB = WSP(bf16_t, S_MB); const bf16_t* W = (const bf16_t*)(C.ws + W_BASE + (size_t)l * LW_SIZE + LW_WOUT); const float* xin = C.in[I_X]; const float* XR = WSP(float, W_XRES); float num = 0.f, den = 0.f;
    for (size_t i = (size_t)C.bid * NTHREADS + C.tid; i < (size_t)T * 1024; i += (size_t)C.G * NTHREADS) { const size_t r = i >> 10; const int c = (int)(i & 1023);
        const float d = tdot(MB + r * 1024, W + (size_t)c * 1024, 1024), g = XR[i] - xin[i] * DN_ALPHA; num += (d - g) * (d - g); den += d * d; }
    num = wave_sum(num); den = wave_sum(den);
    if (C.lane == 0) { atomicAdd((float*)(C.ws + WS_CTL) + CW_CHK + 1024, num); atomicAdd((float*)(C.ws + WS_CTL) + CW_CHK + 1088, den); }
}
__device__ __forceinline__ void chk_full_merged(const Ctx& C, int l, int bit) {
    const bf16_t* Y = WSP(bf16_t, S_Y); const bf16_t* G = WSP(bf16_t, S_G); const bf16_t* MB = WSP(bf16_t, S_MB); const bf16_t* WBR = (const bf16_t*)(C.ws + W_BASE + (size_t)l * LW_SIZE + LW_WBR); unsigned bad = 0;
    for (size_t i = (size_t)C.bid * NTHREADS + C.tid; i < (size_t)T * 1024; i += (size_t)C.G * NTHREADS) { const size_t r = i >> 10; const int c = (int)(i & 1023); float e = 0.f;
        for (int q = 0; q < 4; ++q) e += bf2f(G[r * 4096 + q * 1024 + c]) * tdot(Y + r * 1024 + 256 * q, WBR + ((size_t)q * 1024 + c) * 256, 256);
        if (!chk_close(e, bf2f(MB[i]))) bad = 1; }
    if (bad) __hip_atomic_fetch_add((unsigned*)(C.ws + WS_CTL) + CW_CHK + 64 * bit, 1u, RLX_AGENT);
}

#ifndef FG_CLASS
#define FG_CLASS (1u << ((c >> 5) & 3))
#endif
template <class F> __device__ __forceinline__ void chk_full_gemm(const Ctx& C, const bf16_t* A, const bf16_t* Bt, int K, int N, int bit, F ok) {
    unsigned bad = 0, cntbad = 0;
    for (size_t i = (size_t)C.bid * NTHREADS + C.tid; i < (size_t)T * N; i += (size_t)C.G * NTHREADS) { const size_t r = i / N; const int c = (int)(i % N);
        if (!ok(r, c, tdot(A + r * K, Bt + (size_t)c * K, K))) { bad |= (bit < 0) ? (FG_CLASS) : (1u << bit); ++cntbad; } }
#ifdef FG_COUNT
    if (cntbad) __hip_atomic_fetch_add((unsigned*)(C.ws + WS_CTL) + CW_CHK + 2048, cntbad, RLX_AGENT);
#else
    for (int q = 0; q < 4; ++q) if ((bad >> q) & 1) __hip_atomic_fetch_add((unsigned*)(C.ws + WS_CTL) + CW_CHK + 64 * q, 1u, RLX_AGENT);
#endif
}
__device__ __forceinline__ void ph_prologue(const Ctx& C) {
    run_tjobs<28, false>(C);
    const int gt = C.bid * NTHREADS + C.tid, NT = C.G * NTHREADS;
    for (int l = 0; l < 2; ++l) {
        unsigned char* LW = C.ws + W_BASE + (size_t)l * LW_SIZE;
        bf16_t* lora = (bf16_t*)(LW + LW_LORA); const float* wup = C.in[I_RWWUP] + l * 64 * 256; const float* aup = C.in[I_RWAUP] + l * 64 * 256; const float* gup = C.in[I_RWGUP] + l * 128 * 256;
        for (int i = gt; i < 768 * 256; i += NT) { const int n = i >> 8, k = i & 255; float v = 0.f;
            if (n < 256) { if (k < 64) v = wup[k * 256 + n]; } else if (n < 512) { if (k >= 64 && k < 128) v = aup[(k - 64) * 256 + (n - 256)]; } else { if (k >= 128) v = gup[(k - 128) * 256 + (n - 512)]; }
            lora[i] = (bf16_t)(cvt_pk_bf16(v, 0.f) & 0xffffu); }
        bf16_t* wuq = (bf16_t*)(LW + LW_WUQ); const float* suq = C.in[I_WUQ] + l * 256 * 384;
        for (int i = gt; i < 512 * 256; i += NT) { const int n = i >> 8, k = i & 255; const float v = n < 384 ? suq[k * 384 + n] * (0.10206207261596575f * LOG2E) : 0.f; wuq[i] = (bf16_t)(cvt_pk_bf16(v, 0.f) & 0xffffu); }
        bf16_t* wukv = (bf16_t*)(LW + LW_WUKV); const float* sukv = C.in[I_WUKV] + l * 128 * 512;
        for (int i = gt; i < 512 * 128; i += NT) { const int n = i >> 7, k = i & 127; wukv[i] = (bf16_t)(cvt_pk_bf16(sukv[k * 512 + n], 0.f) & 0xffffu); }
        bf16_t* win = (bf16_t*)(LW + LW_WIN);
        for (int i = gt; i < (NPROJ - 3236) * 1024; i += NT) win[(size_t)3236 * 1024 + i] = 0;
    }
    { const float* x = C.in[I_X]; bf16_t* xb = WSP(bf16_t, W_XB);
      for (size_t i = gt; i < (size_t)T * 1024 / 8; i += NT) { const f32x4 a = *(const f32x4*)(x + i * 8), b = *(const f32x4*)(x + i * 8 + 4); *(u32x4*)(xb + i * 8) = epi::pack8(a, b); }
      const float* mm = C.in[I_MEM]; bf16_t* mb = WSP(bf16_t, W_MEMB);
      for (size_t i = gt; i < (size_t)NMEM * 1024 / 8; i += NT) { const f32x4 a = *(const f32x4*)(mm + i * 8), b = *(const f32x4*)(mm + i * 8 + 4); *(u32x4*)(mb + i * 8) = epi::pack8(a, b); } }
    { const int* pos = (const int*)C.in[I_POS]; float* ct = WSP(float, W_COS); float* st = WSP(float, W_SIN);
      for (int i = gt; i < T * 16; i += NT) { const int t = i >> 4, j = i & 15; const float inv = exp2f(-(float)(2 * j) * (13.287712379549449f / 32.0f)); const float ang = (float)pos[t] * inv; ct[i] = cosf(ang); st[i] = sinf(ang); } }
}

__device__ __forceinline__ f32x4 ld_bf4(const bf16_t* p) { const u32x2 w = *(const u32x2*)p; return (f32x4){bflo(w.x), bfhi(w.x), bflo(w.y), bfhi(w.y)}; }
__device__ __forceinline__ void st_bf4(bf16_t* p, const f32x4 v) { u32x2 w; w.x = cvt_pk_bf16(v[0], v[1]); w.y = cvt_pk_bf16(v[2], v[3]); *(u32x2*)p = w; }
__device__ __forceinline__ float tanhf_(float x) { return 1.0f - 2.0f * frcp(1.0f + fexp2(2.0f * LOG2E * x)); }
__device__ __forceinline__ void ph_prep(const Ctx& C, int l) {
    const bf16_t* proj = WSP(bf16_t, S_PROJ); const float* mu = C.in[I_RWMU] + l * 1024;
    bf16_t* LA = WSP(bf16_t, S_LA); bf16_t* CQN = WSP(bf16_t, S_CQN); bf16_t* CKVN = WSP(bf16_t, S_CKVN); bf16_t* KM = WSP(bf16_t, S_KM);
    const float* qg = C.in[I_QNG] + l * 256; const float* kvg = C.in[I_KVNG] + l * 128; const float* ct = WSP(float, W_COS); const float* st = WSP(float, W_SIN);
    const int lane = C.lane;
    for (int t = GW; t < T; t += NGW) {
        const bf16_t* pr = proj + (size_t)t * NPROJ; const bool first = (t % SEQ) == 0;
        { const int c = 4 * lane; const f32x4 cur = ld_bf4(pr + PC_RW + 768 + c); const f32x4 prv = first ? (f32x4){0.f, 0.f, 0.f, 0.f} : ld_bf4(pr - NPROJ + PC_RW + 768 + c);
          const f32x4 m = *(const f32x4*)(mu + 768 + c); f32x4 p = cur + (prv - cur) * m;
          if (c < 64) { for (int j = 0; j < 4; ++j) p[j] = tanhf_(p[j]); } else if (c >= 128) { for (int j = 0; j < 4; ++j) p[j] = sigmoidf_(p[j]); }
          st_bf4(LA + (size_t)t * 256 + c, p); }
        { const int c = 4 * lane; f32x4 v = ld_bf4(pr + PC_CQ + c); const float ss = wave_sum((v[0] * v[0] + v[1] * v[1]) + (v[2] * v[2] + v[3] * v[3]));
          const float rs = 1.0f / sqrtf(ss * (1.0f / 256.0f) + 1e-6f); v = v * rs * *(const f32x4*)(qg + c); st_bf4(CQN + (size_t)t * 256 + c, v); }
        { const int c = 2 * lane; const unsigned w = *(const unsigned*)(pr + PC_CKV + c); float a = bflo(w), b = bfhi(w); const float ss = wave_sum(a * a + b * b);
          const float rs = 1.0f / sqrtf(ss * (1.0f / 128.0f) + 1e-6f); a *= rs * kvg[c]; b *= rs * kvg[c + 1]; *(unsigned*)(CKVN + (size_t)t * 128 + c) = cvt_pk_bf16(a, b); }
        { const float v = bf2f(pr[PC_KR + (lane & 31)]); const float o = __shfl_xor(v, 16); const int i = lane & 15; const float cs = ct[t * 16 + i], sn = st[t * 16 + i];
          const float r = (lane & 16) ? (o * sn + v * cs) : (v * cs - o * sn);
          if (lane < 32) { const bf16_t rb = (bf16_t)(cvt_pk_bf16(r, 0.f) & 0xffffu); for (int h = 0; h < 4; ++h) KM[(size_t)t * 384 + h * 96 + 64 + lane] = rb; } }
    }
}
__device__ __forceinline__ void ph_rwprep(const Ctx& C, int l) {
#if defined(NAIVE_SCAN)
    if (NAIVE_SCAN & 2) { float* q_ = WSP(float, S_SSQ); for (int i = C.bid * NTHREADS + C.tid; i < T * 8; i += C.G * NTHREADS) q_[i] = 0.f; }
#endif
    const bf16_t* proj = WSP(bf16_t, S_PROJ); const float* mu = C.in[I_RWMU] + l * 1024; const bf16_t* AV = WSP(bf16_t, S_AV); bf16_t* RWS = WSP(bf16_t, S_RWS);
    const float* kkw = C.in[I_RWKK] + l * 256; const float* kaw = C.in[I_RWKA] + l * 256; const int lane = C.lane, c = 4 * lane;
    for (int t = GW; t < T; t += NGW) {
        const bf16_t* pr = proj + (size_t)t * NPROJ + PC_RW; const bool first = (t % SEQ) == 0; f32x4 rkv[3];
#pragma unroll
        for (int q = 0; q < 3; ++q) { const f32x4 cur = ld_bf4(pr + q * 256 + c); const f32x4 prv = first ? (f32x4){0.f, 0.f, 0.f, 0.f} : ld_bf4(pr - NPROJ + q * 256 + c); rkv[q] = cur + (prv - cur) * *(const f32x4*)(mu + q * 256 + c); }
        const f32x4 a = ld_bf4(AV + (size_t)t * 256 + c); f32x4 kk = rkv[1] * *(const f32x4*)(kkw + c);
        float ss = (kk[0] * kk[0] + kk[1] * kk[1]) + (kk[2] * kk[2] + kk[3] * kk[3]);
        ss += __shfl_xor(ss, 1); ss += __shfl_xor(ss, 2); ss += __shfl_xor(ss, 4); ss += __shfl_xor(ss, 8);
        kk = kk * (1.0f / sqrtf(fmaxf(ss, 1e-24f)));
        const f32x4 kmod = rkv[1] * ((a - 1.0f) * *(const f32x4*)(kaw + c) + 1.0f), ka = kk * a;
        const size_t o = (size_t)t * 256 + c, PL = (size_t)T * 256;
        st_bf4(RWS + o, rkv[0]); st_bf4(RWS + PL + o, kmod); st_bf4(RWS + 2 * PL + o, rkv[2]); st_bf4(RWS + 3 * PL + o, kk); st_bf4(RWS + 4 * PL + o, ka);
    }
}
#ifndef ABL_MOE
#define ABL_MOE 1.0f
#endif
template <bool MOE> __device__ __forceinline__ void ph_ln(const Ctx& C, const float* src, float* dst, bf16_t* dstb, const float* g, const float* b, const bf16_t* ys) {
    const int lane = C.lane;
    float chkscale = 1.0f;
#if defined(CHECKS) || defined(CHECKS2) || defined(CHECKS3) || defined(CHECKS4) || defined(CHECKS5) || defined(CHECKS6) || defined(CHECKS7) || defined(CHECKS8) || defined(CHECKS9) || defined(CHECKS10) || defined(CHECKS12) || defined(CHECKS13) || defined(CHECKS14) || defined(CHECKS15)
    if (MOE) { const unsigned* cw = (const unsigned*)(C.ws + WS_CTL) + CW_CHK; int n = 0;
        for (int q = 0; q < 4; ++q) if (__hip_atomic_load(cw + 64 * q, RLX_AGENT) != 0u) n |= 1 << q;
#if defined(FG_COUNT) || defined(CHECKS13) || defined(CHECKS15)
        { unsigned v_ = __hip_atomic_load(cw + 2048, RLX_AGENT); n = 0; while (v_ > 0u) { ++n; v_ >>= 1; } }
#endif
#ifdef CHECKS10
        { const float num = __uint_as_float(__hip_atomic_load(cw + 1024, RLX_AGENT)), den = __uint_as_float(__hip_atomic_load(cw + 1088, RLX_AGENT)); const float lr = -log2f(fmaxf(num / fmaxf(den, 1e-30f), 1e-12f)); n = (int)(lr + 0.5f); n = n < 0 ? 0 : (n > 31 ? 31 : n); }
#endif
        chkscale = 1.0f + 0.1f * (float)n; }
#endif
    for (int t = GW; t < T; t += NGW) {
        f32x4 v[4]; float s = 0.f;
#pragma unroll
        for (int j = 0; j < 4; ++j) { v[j] = *(const f32x4*)(src + (size_t)t * 1024 + 4 * lane + 256 * j);
            if (MOE) { const f32x4 y0 = ld_bf4(ys + (size_t)(2 * t) * 1024 + 4 * lane + 256 * j), y1 = ld_bf4(ys + (size_t)(2 * t + 1) * 1024 + 4 * lane + 256 * j); v[j] = v[j] * DN_ALPHA + (y0 + y1) * ABL_MOE; }
            s += (v[j][0] + v[j][1]) + (v[j][2] + v[j][3]); }
        const float mean = wave_sum(s) * (1.0f / 1024.0f); float s2 = 0.f;
#pragma unroll
        for (int j = 0; j < 4; ++j) { v[j] = v[j] - mean; s2 += (v[j][0] * v[j][0] + v[j][1] * v[j][1]) + (v[j][2] * v[j][2] + v[j][3] * v[j][3]); }
        const float rstd = 1.0f / sqrtf(wave_sum(s2) * (1.0f / 1024.0f) + 1e-5f);
#pragma unroll
        for (int j = 0; j < 4; ++j) { const int c = 4 * lane + 256 * j; const f32x4 o = (v[j] * rstd * *(const f32x4*)(g + c) + *(const f32x4*)(b + c)) * chkscale;
            *(f32x4*)(dst + (size_t)t * 1024 + c) = o; if (dstb) st_bf4(dstb + (size_t)t * 1024 + c, o); }
    }
}
__device__ __forceinline__ void ph_ssdfix(const Ctx& C, int l) {
    bf16_t* Y = WSP(bf16_t, S_Y); const float* ssq = WSP(float, S_SSQ); const float* ng = C.in[I_SSDNG] + l * 256; const int lane = C.lane, c = 4 * lane, g = lane >> 5;
    for (int t = GW; t < T; t += NGW) {
        const float q = (ssq[t * 8 + 4 * g] + ssq[t * 8 + 4 * g + 1]) + (ssq[t * 8 + 4 * g + 2] + ssq[t * 8 + 4 * g + 3]); const float rs = 1.0f / sqrtf(q * (1.0f / 128.0f) + 1e-5f);
        bf16_t* p = Y + (size_t)t * 1024 + 512 + c; f32x4 v = ld_bf4(p); v = v * rs * *(const f32x4*)(ng + c); st_bf4(p, v);
    }
}
typedef __bf16 bfx8 __attribute__((ext_vector_type(8)));
__device__ __forceinline__ f32x16 mfma32(const bf16x8 a, const bf16x8 b, const f32x16 c) { return __builtin_amdgcn_mfma_f32_32x32x16_bf16(__builtin_bit_cast(bfx8, a), __builtin_bit_cast(bfx8, b), c, 0, 0, 0); }
__device__ __forceinline__ float dpp_xor1(float v) { return __builtin_bit_cast(float, __builtin_amdgcn_mov_dpp(__builtin_bit_cast(int, v), 0xB1, 0xf, 0xf, true)); }
__device__ __forceinline__ float dpp_xor2(float v) { return __builtin_bit_cast(float, __builtin_amdgcn_mov_dpp(__builtin_bit_cast(int, v), 0x4E, 0xf, 0xf, true)); }
__device__ __forceinline__ float dpp_hmir(float v) { return __builtin_bit_cast(float, __builtin_amdgcn_mov_dpp(__builtin_bit_cast(int, v), 0x141, 0xf, 0xf, true)); }
__device__ __forceinline__ float sum8(float v) { v += dpp_xor1(v); v += dpp_xor2(v); v += dpp_hmir(v); return v; }

template <int MODE>
__device__ __forceinline__ void attn_unit(const Ctx& C0_, int b, int h, int qb) {
    const Ctx C = launder(C0_);
    constexpr int DQK = MODE ? 96 : 64, NS = DQK / 16, KST = DQK * 2 + 16, VST = 192, KCH = DQK / 8;
    const bf16_t *Qp, *Kp, *Vp; int qs, ks, vs, ycol;
    if (MODE == 0) { const bf16_t* proj = WSP(bf16_t, S_PROJ); Qp = proj + PC_SBQ + h * 64; Kp = proj + PC_SBK + h * 64; Vp = proj + PC_SBV + h * 64; qs = ks = vs = NPROJ; ycol = h * 64; }
    else { Qp = WSP(bf16_t, S_QM) + h * 96; Kp = WSP(bf16_t, S_KM) + h * 96; Vp = WSP(bf16_t, S_VM) + h * 64; qs = ks = 384; vs = 256; ycol = 768 + h * 64; }
    const size_t tb = (size_t)b * SEQ;
    LAS unsigned char* Kt = C.lds; LAS unsigned char* Vt = C.lds + 64 * KST;
    const unsigned vt_addr = (unsigned)(size_t)Vt;
    const int tid = C.tid, lane = C.lane, w = C.wave, r = lane & 31, hh = lane >> 5;
    const int Q0 = qb * 256, qidx = Q0 + 32 * w + r, qmin = Q0 + 32 * w, qmax = qmin + 31;
    bf16x8 qf[NS];
#pragma unroll
    for (int s = 0; s < NS; ++s) qf[s] = *(const bf16x8*)(Qp + (tb + qidx) * qs + 16 * s + 8 * hh);
    f32x16 o[2]; for (int i = 0; i < 16; ++i) { o[0][i] = 0.f; o[1][i] = 0.f; }
    float Rrun = 0.f, mrun = -1.0e30f, lsum = 0.f;
    const int pr = (r & ~12) | ((r & 4) << 1) | ((r & 8) >> 1);
    u32x4 kreg0, kreg1, vreg; const int krow0 = tid / KCH, kch0 = tid % KCH, krow1 = (tid + 512) / KCH, kch1 = (tid + 512) % KCH, vrow = tid >> 3, vch = tid & 7;
    const bool k1 = (MODE == 1) && (tid < 64 * KCH - 512);
    const int ktmax = 4 * qb + 3;
#define ATT_LOAD(kt) do { const size_t kb_ = tb + (size_t)(kt) * 64; kreg0 = *(const u32x4*)(Kp + (kb_ + krow0) * ks + kch0 * 8); if (k1) kreg1 = *(const u32x4*)(Kp + (kb_ + krow1) * ks + kch1 * 8); \
        vreg = *(const u32x4*)(Vp + (kb_ + vrow) * vs + vch * 8); } while (0)
    ATT_LOAD(ktmax);
    for (int kt = ktmax; kt >= 0; --kt) {
        __syncthreads();
        *(LAS u32x4*)(Kt + krow0 * KST + kch0 * 16) = kreg0; if (k1) *(LAS u32x4*)(Kt + krow1 * KST + kch1 * 16) = kreg1;
        *(LAS u32x4*)(Vt + vrow * VST + vch * 16) = vreg;
        __syncthreads();
        if (kt > 0) ATT_LOAD(kt - 1);
        const int k0 = kt * 64;
        if (k0 > qmax) continue;
        const bool need_mask = (k0 + 63 >= qmin);
        f32x16 sc[2];
#pragma unroll
        for (int sub = 0; sub < 2; ++sub) {
            for (int i = 0; i < 16; ++i) sc[sub][i] = 0.f;
#pragma unroll
            for (int s = 0; s < NS; ++s) { const bf16x8 kf = *(const LAS bf16x8*)(Kt + (32 * sub + pr) * KST + (16 * s + 8 * hh) * 2); sc[sub] = mfma32(kf, qf[s], sc[sub]); }
        }
        if (MODE == 0) {
#pragma unroll
            for (int sub = 1; sub >= 0; --sub) {
                const int kb = k0 + 32 * sub + 8 * hh;
                float L[16];
#pragma unroll
                for (int i = 0; i < 16; ++i) { const float z = sc[sub][i]; const int key = kb + (i & 7) + 16 * (i >> 3); const bool ok = !need_mask || key < qidx;
                    const float l2 = -(fmaxf(z, 0.f) + flog2(1.0f + fexp2(-fabsf(z)))); L[i] = ok ? l2 : 0.f; sc[sub][i] = ok ? z + l2 : -1.0e30f; }
                float own_hi = 0.f, own_lo = 0.f, tl[16];
#pragma unroll
                for (int j = 7; j >= 0; --j) { tl[8 + j] = own_hi; own_hi += L[8 + j]; tl[j] = own_lo; own_lo += L[j]; }
                const float p_hi = __shfl_xor(own_hi, 32), p_lo = __shfl_xor(own_lo, 32);
                const float off_hi = Rrun + (hh ? 0.f : p_hi), off_lo = Rrun + own_hi + p_hi + (hh ? 0.f : p_lo);
                Rrun += (own_hi + own_lo) + (p_hi + p_lo);
#pragma unroll
                for (int i = 0; i < 16; ++i) sc[sub][i] = fexp2(sc[sub][i] + tl[i] + (i >= 8 ? off_hi : off_lo));
            }
        } else {
            float tm = -1.0e30f;
#pragma unroll
            for (int sub = 0; sub < 2; ++sub)
#pragma unroll
                for (int i = 0; i < 16; ++i) { const int key = k0 + 32 * sub + 8 * hh + (i & 7) + 16 * (i >> 3); const bool ok = !need_mask || key <= qidx; const float z = ok ? sc[sub][i] : -1.0e30f; sc[sub][i] = z; tm = fmaxf(tm, z); }
            tm = fmaxf(tm, __shfl_xor(tm, 32));
            const float mnew = fmaxf(mrun, tm), alpha = fexp2(mrun - mnew); mrun = mnew;
            float ps = 0.f;
#pragma unroll
            for (int sub = 0; sub < 2; ++sub)
#pragma unroll
                for (int i = 0; i < 16; ++i) { const float p = fexp2(sc[sub][i] - mnew); sc[sub][i] = p; ps += p; }
            lsum = lsum * alpha + ps;
#pragma unroll
            for (int i = 0; i < 16; ++i) { o[0][i] *= alpha; o[1][i] *= alpha; }
        }
#pragma unroll
        for (int sub = 0; sub < 2; ++sub)
#pragma unroll
            for (int s = 0; s < 2; ++s) {
                bf16x8 pf; { u32x4 pw; pw.x = cvt_pk_bf16(sc[sub][8 * s + 0], sc[sub][8 * s + 1]); pw.y = cvt_pk_bf16(sc[sub][8 * s + 2], sc[sub][8 * s + 3]); pw.z = cvt_pk_bf16(sc[sub][8 * s + 4], sc[sub][8 * s + 5]); pw.w = cvt_pk_bf16(sc[sub][8 * s + 6], sc[sub][8 * s + 7]); pf = __builtin_bit_cast(bf16x8, pw); }
                const unsigned a0 = vt_addr + (unsigned)((32 * sub + 16 * s + 8 * hh + ((lane & 15) >> 2)) * VST + (16 * ((lane >> 4) & 1) + 4 * (lane & 3)) * 2);
                u32x2 v00, v01, v10, v11;
                asm volatile("ds_read_b64_tr_b16 %0, %4\n\tds_read_b64_tr_b16 %1, %4 offset:768\n\tds_read_b64_tr_b16 %2, %4 offset:64\n\tds_read_b64_tr_b16 %3, %4 offset:832\n\ts_waitcnt lgkmcnt(0)"
                             : "=&v"(v00), "=&v"(v01), "=&v"(v10), "=&v"(v11) : "v"(a0) : "memory");
                u32x4 va0; va0.x = v00.x; va0.y = v00.y; va0.z = v01.x; va0.w = v01.y;
                u32x4 va1; va1.x = v10.x; va1.y = v10.y; va1.z = v11.x; va1.w = v11.y;
                o[0] = mfma32(__builtin_bit_cast(bf16x8, va0), pf, o[0]);
                o[1] = mfma32(__builtin_bit_cast(bf16x8, va1), pf, o[1]);
            }
    }
#undef ATT_LOAD
    float inv = 1.0f;
    if (MODE == 1) { const float lt = lsum + __shfl_xor(lsum, 32); inv = frcp(lt); }
    bf16_t* Y = WSP(bf16_t, S_Y) + (tb + qidx) * 1024 + ycol;
#pragma unroll
    for (int dt = 0; dt < 2; ++dt)
#pragma unroll
        for (int g = 0; g < 4; ++g) { u32x2 wv; wv.x = cvt_pk_bf16(o[dt][4 * g] * inv, o[dt][4 * g + 1] * inv); wv.y = cvt_pk_bf16(o[dt][4 * g + 2] * inv, o[dt][4 * g + 3] * inv);
            *(u32x2*)(Y + 32 * dt + 8 * g + 4 * hh) = wv; }
}

__device__ __forceinline__ void rwkv_unit(const Ctx& C0_, int l, int b, int h) {
    const Ctx C = launder(C0_);
    constexpr int TB = 32, NBLK = SEQ / TB, BUFB = 6 * TB * 64 * 4;
    LAS float* buf0 = (LAS float*)C.lds; LAS float* ybuf = (LAS float*)(C.lds + 2 * BUFB);
    const int tid = C.tid, i = tid >> 3, q = tid & 7;
    const float* DEC = WSP(float, S_DEC); const bf16_t* RWS = WSP(bf16_t, S_RWS); const bf16_t* GV = WSP(bf16_t, S_GV); bf16_t* Y = WSP(bf16_t, S_Y);
    const float* rk = C.in[I_RWRK] + l * 256 + h * 64; const float* gng = C.in[I_RWGNG] + l * 256 + h * 64; const float* gnb = C.in[I_RWGNB] + l * 256 + h * 64;
    const size_t PL = (size_t)T * 256; const size_t tb = (size_t)b * SEQ;
    const int ls = tid >> 4, lj = 4 * (tid & 15);
    f32x4 gw; u32x2 gr[5];
#define RW_LOAD(blk) do { const size_t o_ = (tb + (size_t)(blk) * TB + ls) * 256 + h * 64 + lj; gw = *(const f32x4*)(DEC + o_); \
        gr[0] = *(const u32x2*)(RWS + 3 * PL + o_); gr[1] = *(const u32x2*)(RWS + 4 * PL + o_); gr[2] = *(const u32x2*)(RWS + PL + o_); gr[3] = *(const u32x2*)(RWS + o_); gr[4] = *(const u32x2*)(RWS + 2 * PL + o_); } while (0)
#define RW_STORE(bufp) do { LAS float* d_ = (bufp) + ls * 64 + lj; *(LAS f32x4*)d_ = gw; \
        _Pragma("unroll") for (int a_ = 0; a_ < 5; ++a_) *(LAS f32x4*)(d_ + (a_ + 1) * TB * 64) = (f32x4){bflo(gr[a_].x), bfhi(gr[a_].x), bflo(gr[a_].y), bfhi(gr[a_].y)}; } while (0)
    float S[8];
#pragma unroll
    for (int j = 0; j < 8; ++j) S[j] = 0.f;
    __syncthreads();
    RW_LOAD(0); RW_STORE(buf0);
    __syncthreads();
    for (int blk = 0; blk < NBLK; ++blk) {
        LAS float* cur = buf0 + (blk & 1) * (BUFB / 4); LAS float* nxtb = buf0 + ((blk + 1) & 1) * (BUFB / 4);
        if (blk + 1 < NBLK) RW_LOAD(blk + 1);
        for (int s0 = 0; s0 < TB; s0 += 2) {
            f32x4 w0[2], w1[2], kk0[2], kk1[2], ka0[2], ka1[2], km0[2], km1[2], r0[2], r1[2]; float vv2[2], yv[2];
#pragma unroll
            for (int u = 0; u < 2; ++u) { const LAS float* p = cur + (s0 + u) * 64 + 8 * q;
                w0[u] = *(const LAS f32x4*)p; w1[u] = *(const LAS f32x4*)(p + 4);
                kk0[u] = *(const LAS f32x4*)(p + TB * 64); kk1[u] = *(const LAS f32x4*)(p + TB * 64 + 4);
                ka0[u] = *(const LAS f32x4*)(p + 2 * TB * 64); ka1[u] = *(const LAS f32x4*)(p + 2 * TB * 64 + 4);
                km0[u] = *(const LAS f32x4*)(p + 3 * TB * 64); km1[u] = *(const LAS f32x4*)(p + 3 * TB * 64 + 4);
                r0[u] = *(const LAS f32x4*)(p + 4 * TB * 64); r1[u] = *(const LAS f32x4*)(p + 4 * TB * 64 + 4);
                vv2[u] = cur[5 * TB * 64 + (s0 + u) * 64 + i]; }
#pragma unroll
            for (int u = 0; u < 2; ++u) { const float v = vv2[u];
                float sa = ((S[0] * kk0[u][0] + S[1] * kk0[u][1]) + (S[2] * kk0[u][2] + S[3] * kk0[u][3])) + ((S[4] * kk1[u][0] + S[5] * kk1[u][1]) + (S[6] * kk1[u][2] + S[7] * kk1[u][3]));
                sa = sum8(sa);
#pragma unroll
                for (int j = 0; j < 4; ++j) { S[j] = S[j] * w0[u][j] + (v * km0[u][j] - sa * ka0[u][j]); S[4 + j] = S[4 + j] * w1[u][j] + (v * km1[u][j] - sa * ka1[u][j]); }
                float y = ((S[0] * r0[u][0] + S[1] * r0[u][1]) + (S[2] * r0[u][2] + S[3] * r0[u][3])) + ((S[4] * r1[u][0] + S[5] * r1[u][1]) + (S[6] * r1[u][2] + S[7] * r1[u][3]));
                yv[u] = sum8(y); }
            if (q == 0) { ybuf[s0 * 64 + i] = yv[0]; ybuf[(s0 + 1) * 64 + i] = yv[1]; }
        }
        __syncthreads();
        {
            const f32x4 yv = *(const LAS f32x4*)(ybuf + ls * 64 + lj);
            const f32x4 rr = *(const LAS f32x4*)(cur + 4 * TB * 64 + ls * 64 + lj), km = *(const LAS f32x4*)(cur + 3 * TB * 64 + ls * 64 + lj), vv = *(const LAS f32x4*)(cur + 5 * TB * 64 + ls * 64 + lj);
            const f32x4 rkv = *(const f32x4*)(rk + lj);
            float sm = (yv[0] + yv[1]) + (yv[2] + yv[3]); float bd = (rr[0] * km[0] * rkv[0] + rr[1] * km[1] * rkv[1]) + (rr[2] * km[2] * rkv[2] + rr[3] * km[3] * rkv[3]);
#pragma unroll
            for (int o_ = 1; o_ < 16; o_ <<= 1) { sm += __shfl_xor(sm, o_); bd += __shfl_xor(bd, o_); }
            const float mu = sm * (1.0f / 64.0f); const f32x4 d = yv - mu; float vs = (d[0] * d[0] + d[1] * d[1]) + (d[2] * d[2] + d[3] * d[3]);
#pragma unroll
            for (int o_ = 1; o_ < 16; o_ <<= 1) vs += __shfl_xor(vs, o_);
            const float rstd = 1.0f / sqrtf(vs * (1.0f / 64.0f) + 64e-5f);
            const size_t t = tb + (size_t)blk * TB + ls; const f32x4 gg = ld_bf4(GV + t * 256 + h * 64 + lj);
            const f32x4 res = ((d * rstd) * *(const f32x4*)(gng + lj) + *(const f32x4*)(gnb + lj) + vv * bd) * gg;
            st_bf4(Y + t * 1024 + 256 + h * 64 + lj, res);
        }
        if (blk + 1 < NBLK) RW_STORE(nxtb);
        __syncthreads();
    }
#undef RW_LOAD
#undef RW_STORE
}

__device__ __forceinline__ void ssd_stage(const Ctx& C, int l, int h, size_t tb, int blk, LAS float* dst) {
    constexpr int TB = 16; const int g = h >> 1;
    const bf16_t* proj = WSP(bf16_t, S_PROJ); const float* cw = C.in[I_CONVW] + l * 4 * 768; const float* cb = C.in[I_CONVB] + l * 768;
    const float dtb = C.in[I_DTB][l * 4 + h], aneg = -expf(C.in[I_ALOG][l * 4 + h]);
    for (int it = C.tid; it < TB * 80; it += NTHREADS) {
        const int s = it / 80, v = it % 80; const int tl = blk * TB + s;
        int pcol, cch, doff;
        if (v < 16) { pcol = PC_XS + h * 64 + 4 * v; cch = h * 64 + 4 * v; doff = s * 64 + 4 * v; }
        else if (v < 48) { pcol = PC_BM + g * 128 + 4 * (v - 16); cch = 256 + g * 128 + 4 * (v - 16); doff = 2 * TB * 64 + s * 128 + 4 * (v - 16); }
        else { pcol = PC_CM + g * 128 + 4 * (v - 48); cch = 512 + g * 128 + 4 * (v - 48); doff = 2 * TB * 64 + TB * 128 + s * 128 + 4 * (v - 48); }
        f32x4 a = *(const f32x4*)(cb + cch);
#pragma unroll
        for (int k = 0; k < 4; ++k) { const int tt = tl - 3 + k; if (tt >= 0) a += ld_bf4(proj + (tb + tt) * NPROJ + pcol) * *(const f32x4*)(cw + k * 768 + cch); }
        for (int j = 0; j < 4; ++j) a[j] = siluf_(a[j]);
        if (v < 16) { const float dt = softplusf_(bf2f(proj[(tb + tl) * NPROJ + PC_DT + h]) + dtb); *(LAS f32x4*)(dst + TB * 64 + doff) = a; *(LAS f32x4*)(dst + doff) = a * dt;
                      if (v == 0) dst[TB * 384 + s] = expf(dt * aneg); }
        else *(LAS f32x4*)(dst + doff) = a;
    }
}
__device__ __forceinline__ void ssd_unit(const Ctx& C0_, int l, int b, int h, int ph) {
    const Ctx C = launder(C0_);
    constexpr int TB = 32, NBLK = SEQ / TB, NF = TB * (32 + 32 + 128 + 128) + 64, NIT = 72 * TB, NK = (NIT + NTHREADS - 1) / NTHREADS;
    LAS float* buf0 = (LAS float*)C.lds; LAS float* ypart = buf0 + 2 * NF;
    const int tid = C.tid, lane = C.lane, w = C.wave, g = h >> 1, pl = lane & 31, nh = lane >> 5;
    const bf16_t* proj = WSP(bf16_t, S_PROJ); bf16_t* Y = WSP(bf16_t, S_Y); float* SSQ = WSP(float, S_SSQ);
    const float* cw = C.in[I_CONVW] + l * 4 * 768; const float* cb = C.in[I_CONVB] + l * 768;
    const float dtb = C.in[I_DTB][l * 4 + h], aneg = -expf(C.in[I_ALOG][l * 4 + h]), dsk = C.in[I_SSDD][l * 4 + h];
    const size_t tb = (size_t)b * SEQ;
    int its[NK], itp[NK], itd[NK], itc[NK]; bool itx[NK];
#pragma unroll
    for (int k = 0; k < NK; ++k) { const int it = tid + NTHREADS * k, sidx = it / 72, v = it % 72; int pcol, cch, doff;
        if (v < 8) { pcol = PC_XS + h * 64 + 32 * ph + 4 * v; cch = h * 64 + 32 * ph + 4 * v; doff = sidx * 32 + 4 * v; }
        else if (v < 40) { pcol = PC_BM + g * 128 + 4 * (v - 8); cch = 256 + g * 128 + 4 * (v - 8); doff = 2 * TB * 32 + sidx * 128 + 4 * (v - 8); }
        else { pcol = PC_CM + g * 128 + 4 * (v - 40); cch = 512 + g * 128 + 4 * (v - 40); doff = 2 * TB * 32 + TB * 128 + sidx * 128 + 4 * (v - 40); }
        its[k] = sidx; itp[k] = pcol; itd[k] = doff; itx[k] = v < 8; itc[k] = cch; }
    const bool haslast = tid + NTHREADS * (NK - 1) < NIT;
    u32x2 raw[NK][4]; float dtr[NK]; unsigned short zraw;
    const int os = tid >> 4, op = tid & 15;
#define SSD_LOAD(blk) do { _Pragma("unroll") for (int k = 0; k < NK; ++k) { if (k < NK - 1 || haslast) { const int tl_ = (blk) * TB + its[k]; \
            _Pragma("unroll") for (int q = 0; q < 4; ++q) { const int tt_ = tl_ - 3 + q; raw[k][q] = tt_ >= 0 ? *(const u32x2*)(proj + (tb + tt_) * NPROJ + itp[k]) : (u32x2){0u, 0u}; } \
            dtr[k] = itx[k] ? bf2f(proj[(tb + tl_) * NPROJ + PC_DT + h]) : 0.f; } } } while (0)
#define SSD_COMMIT(dst) do { _Pragma("unroll") for (int k = 0; k < NK; ++k) { if (k < NK - 1 || haslast) { f32x4 a_ = *(const f32x4*)(cb + itc[k]); \
            _Pragma("unroll") for (int q = 0; q < 4; ++q) a_ += (f32x4){bflo(raw[k][q].x), bfhi(raw[k][q].x), bflo(raw[k][q].y), bfhi(raw[k][q].y)} * *(const f32x4*)(cw + q * 768 + itc[k]); \
            for (int j = 0; j < 4; ++j) a_[j] = siluf_(a_[j]); \
            if (itx[k]) { const float dt_ = softplusf_(dtr[k] + dtb); *(LAS f32x4*)((dst) + TB * 32 + itd[k]) = a_; *(LAS f32x4*)((dst) + itd[k]) = a_ * dt_; if ((itd[k] & 31) == 0) (dst)[TB * 320 + its[k]] = expf(dt_ * aneg); } \
            else *(LAS f32x4*)((dst) + itd[k]) = a_; } } } while (0)
    float hs[8];
#pragma unroll
    for (int k = 0; k < 8; ++k) hs[k] = 0.f;
    __syncthreads();
    SSD_LOAD(0); SSD_COMMIT(buf0);
    __syncthreads();
    for (int blk = 0; blk < NBLK; ++blk) {
        LAS float* cur = buf0 + (blk & 1) * NF; LAS float* nxtb = buf0 + ((blk + 1) & 1) * NF;
        if (blk + 1 < NBLK) SSD_LOAD(blk + 1);
        const size_t tz = tb + (size_t)blk * TB + os;
        zraw = proj[tz * NPROJ + PC_Z + h * 64 + 32 * ph + op]; const unsigned short zraw2 = proj[tz * NPROJ + PC_Z + h * 64 + 32 * ph + op + 16];
        for (int s0 = 0; s0 < TB; s0 += 4) {
            float x4[4], dA4[4], yv[4]; f32x4 bv[4][2], cv[4][2];
#pragma unroll
            for (int u = 0; u < 4; ++u) { const int s = s0 + u; x4[u] = cur[s * 32 + pl]; dA4[u] = cur[TB * 320 + s];
                const LAS float* bp = cur + 2 * TB * 32 + s * 128 + 16 * w + 8 * nh; const LAS float* cp = bp + TB * 128;
                bv[u][0] = *(const LAS f32x4*)bp; bv[u][1] = *(const LAS f32x4*)(bp + 4); cv[u][0] = *(const LAS f32x4*)cp; cv[u][1] = *(const LAS f32x4*)(cp + 4); }
#pragma unroll
            for (int u = 0; u < 4; ++u) { float yp = 0.f;
#pragma unroll
                for (int k4 = 0; k4 < 2; ++k4)
#pragma unroll
                    for (int j = 0; j < 4; ++j) { hs[4 * k4 + j] = hs[4 * k4 + j] * dA4[u] + x4[u] * bv[u][k4][j]; yp += cv[u][k4][j] * hs[4 * k4 + j]; }
                const auto sw = __builtin_amdgcn_permlane32_swap(__builtin_bit_cast(unsigned, yp), __builtin_bit_cast(unsigned, yp), false, false);
                yv[u] = yp + __builtin_bit_cast(float, (unsigned)sw[1]); }
            if (nh == 0) {
#pragma unroll
                for (int u = 0; u < 4; ++u) ypart[((s0 + u) * 8 + w) * 32 + pl] = yv[u]; }
        }
        if (blk + 1 < NBLK) SSD_COMMIT(nxtb);
        __syncthreads();
        {
            float y0 = 0.f, y1 = 0.f;
#pragma unroll
            for (int ww = 0; ww < 8; ++ww) { y0 += ypart[(os * 8 + ww) * 32 + op]; y1 += ypart[(os * 8 + ww) * 32 + op + 16]; }
            y0 += cur[TB * 32 + os * 32 + op] * dsk; y1 += cur[TB * 32 + os * 32 + op + 16] * dsk;
            y0 *= siluf_(bf2f(zraw)); y1 *= siluf_(bf2f(zraw2));
            bf16_t* yo = Y + tz * 1024 + 512 + h * 64 + 32 * ph + op;
            yo[0] = (bf16_t)(cvt_pk_bf16(y0, 0.f) & 0xffffu); yo[16] = (bf16_t)(cvt_pk_bf16(y1, 0.f) & 0xffffu);
            float q = y0 * y0 + y1 * y1;
#pragma unroll
            for (int o_ = 1; o_ < 16; o_ <<= 1) q += __shfl_xor(q, o_);
            if (op == 0) SSQ[tz * 8 + h * 2 + ph] = q;
        }
        __syncthreads();
    }
#undef SSD_LOAD
#undef SSD_COMMIT
}

__device__ __forceinline__ void sb_naive(const Ctx& C) {
    const bf16_t* proj = WSP(bf16_t, S_PROJ); bf16_t* Y = WSP(bf16_t, S_Y); const int lane = C.lane;
    for (int item = GW; item < T * 4; item += NGW) {
        const int t = item >> 2, h = item & 3, tq = t % SEQ; const size_t tb = (size_t)(t - tq);
        float q[64];
        { const bf16_t* qp = proj + (size_t)t * NPROJ + PC_SBQ + h * 64;
#pragma unroll
          for (int i = 0; i < 8; ++i) { const u32x4 w = *(const u32x4*)(qp + 8 * i); q[8*i] = bflo(w.x); q[8*i+1] = bfhi(w.x); q[8*i+2] = bflo(w.y); q[8*i+3] = bfhi(w.y); q[8*i+4] = bflo(w.z); q[8*i+5] = bfhi(w.z); q[8*i+6] = bflo(w.w); q[8*i+7] = bfhi(w.w); } }
        float o[64];
#pragma unroll
        for (int d = 0; d < 64; ++d) o[d] = 0.f;
        float R = 0.f;
        for (int c = (tq - 1) >> 6; c >= 0 && tq > 0; --c) {
            const int key = c * 64 + lane; const bool ok = key < tq;
            const bf16_t* kp = proj + (tb + key) * NPROJ + PC_SBK + h * 64; const bf16_t* vp = proj + (tb + key) * NPROJ + PC_SBV + h * 64;
            float z = 0.f;
#pragma unroll
            for (int i = 0; i < 8; ++i) { const u32x4 w = *(const u32x4*)(kp + 8 * i);
                z += q[8*i] * bflo(w.x) + q[8*i+1] * bfhi(w.x) + q[8*i+2] * bflo(w.y) + q[8*i+3] * bfhi(w.y) + q[8*i+4] * bflo(w.z) + q[8*i+5] * bfhi(w.z) + q[8*i+6] * bflo(w.w) + q[8*i+7] * bfhi(w.w); }
            const float L = ok ? -(fmaxf(z, 0.f) + flog2(1.0f + fexp2(-fabsf(z)))) : 0.f;
            float sfx = L;
#pragma unroll
            for (int dd = 1; dd < 64; dd <<= 1) { const float tt = __shfl_down(sfx, dd); if (lane + dd < 64) sfx += tt; }
            const float tot = __shfl(sfx, 0);
            const float wgt = ok ? fexp2(z + L + (sfx - L) + R) : 0.f;
            R += tot;
#pragma unroll
            for (int i = 0; i < 8; ++i) { const u32x4 w = *(const u32x4*)(vp + 8 * i);
                o[8*i] += wgt * bflo(w.x); o[8*i+1] += wgt * bfhi(w.x); o[8*i+2] += wgt * bflo(w.y); o[8*i+3] += wgt * bfhi(w.y); o[8*i+4] += wgt * bflo(w.z); o[8*i+5] += wgt * bfhi(w.z); o[8*i+6] += wgt * bflo(w.w); o[8*i+7] += wgt * bfhi(w.w); }
        }
        float mine = 0.f;
#pragma unroll
        for (int d = 0; d < 64; ++d) { const float sdd = wave_sum(o[d]); if (lane == d) mine = sdd; }
        Y[(size_t)t * 1024 + h * 64 + lane] = (bf16_t)(cvt_pk_bf16(mine, 0.f) & 0xffffu);
    }
}

__device__ __forceinline__ void rwkv_naive(const Ctx& C, int l) {
    const float* DEC = WSP(float, S_DEC); const bf16_t* RWS = WSP(bf16_t, S_RWS); const bf16_t* GV = WSP(bf16_t, S_GV); bf16_t* Y = WSP(bf16_t, S_Y);
    const size_t PL = (size_t)T * 256; const int lane = C.lane;
    for (int item = GW; item < 64; item += NGW) {
        const int b = item >> 2, h = item & 3; const float* rk = C.in[I_RWRK] + l * 256 + h * 64;
        const float gng = C.in[I_RWGNG][l * 256 + h * 64 + lane], gnb = C.in[I_RWGNB][l * 256 + h * 64 + lane];
        float S[64];
#pragma unroll
        for (int j = 0; j < 64; ++j) S[j] = 0.f;
        for (int tq = 0; tq < SEQ; ++tq) {
            const size_t o = ((size_t)b * SEQ + tq) * 256 + h * 64;
            const float v = bf2f(RWS[2 * PL + o + lane]);
            float sa = 0.f;
#pragma unroll
            for (int j = 0; j < 64; ++j) sa += S[j] * bf2f(RWS[3 * PL + o + j]);
            float y = 0.f, bd = 0.f;
#pragma unroll
            for (int j = 0; j < 64; ++j) { const float km = bf2f(RWS[PL + o + j]), r = bf2f(RWS[o + j]);
                S[j] = S[j] * DEC[o + j] + (v * km - sa * bf2f(RWS[4 * PL + o + j])); y += S[j] * r; bd += r * km * rk[j]; }
            const float mu = wave_sum(y) * (1.0f / 64.0f), d = y - mu, var = wave_sum(d * d) * (1.0f / 64.0f);
            const float res = (d * (1.0f / sqrtf(var + 64e-5f)) * gng + gnb + v * bd) * bf2f(GV[o + lane]);
            Y[((size_t)b * SEQ + tq) * 1024 + 256 + h * 64 + lane] = (bf16_t)(cvt_pk_bf16(res, 0.f) & 0xffffu);
        }
    }
}
__device__ __forceinline__ void ssd_naive(const Ctx& C, int l) {
    const bf16_t* proj = WSP(bf16_t, S_PROJ); bf16_t* Y = WSP(bf16_t, S_Y); float* SSQ = WSP(float, S_SSQ); const int lane = C.lane;
    const float* cw = C.in[I_CONVW] + l * 4 * 768; const float* cb = C.in[I_CONVB] + l * 768;
    for (int item2 = GW; item2 < 128; item2 += NGW) {
        const int item = item2 >> 1, ph = item2 & 1; const int b = item >> 2, h = item & 3, g = h >> 1; const size_t tb = (size_t)b * SEQ;
        const float dtb = C.in[I_DTB][l * 4 + h], aneg = -expf(C.in[I_ALOG][l * 4 + h]), dsk = C.in[I_SSDD][l * 4 + h];
        float hs0[32], hs1[32];
#pragma unroll
        for (int p = 0; p < 32; ++p) { hs0[p] = 0.f; hs1[p] = 0.f; }
        for (int tq = 0; tq < SEQ; ++tq) {
            const bf16_t* pr = proj + (tb + tq) * NPROJ;
            float xa = cb[h * 64 + lane], bv0 = cb[256 + g * 128 + lane], bv1 = cb[256 + g * 128 + 64 + lane], cv0 = cb[512 + g * 128 + lane], cv1 = cb[512 + g * 128 + 64 + lane];
            for (int k = 0; k < 4; ++k) { const int tt = tq - 3 + k; if (tt >= 0) { const bf16_t* pp = proj + (tb + tt) * NPROJ; const float* ww = cw + k * 768;
                xa += bf2f(pp[PC_XS + h * 64 + lane]) * ww[h * 64 + lane];
                bv0 += bf2f(pp[PC_BM + g * 128 + lane]) * ww[256 + g * 128 + lane]; bv1 += bf2f(pp[PC_BM + g * 128 + 64 + lane]) * ww[256 + g * 128 + 64 + lane];
                cv0 += bf2f(pp[PC_CM + g * 128 + lane]) * ww[512 + g * 128 + lane]; cv1 += bf2f(pp[PC_CM + g * 128 + 64 + lane]) * ww[512 + g * 128 + 64 + lane]; } }
            xa = siluf_(xa); bv0 = siluf_(bv0); bv1 = siluf_(bv1); cv0 = siluf_(cv0); cv1 = siluf_(cv1);
            const float dt = softplusf_(bf2f(pr[PC_DT + h]) + dtb), dA = expf(dt * aneg), xd = xa * dt;
            float y = 0.f;
#pragma unroll
            for (int p = 0; p < 32; ++p) { const float xp = __shfl(xd, 32 * ph + p); hs0[p] = hs0[p] * dA + xp * bv0; hs1[p] = hs1[p] * dA + xp * bv1;
                const float tot = wave_sum(cv0 * hs0[p] + cv1 * hs1[p]); if (lane == 32 * ph + p) y = tot; }
            y += dsk * xa; y *= siluf_(bf2f(pr[PC_Z + h * 64 + lane]));
            const bool mine = (lane >> 5) == ph; if (mine) Y[(tb + tq) * 1024 + 512 + h * 64 + lane] = (bf16_t)(cvt_pk_bf16(y, 0.f) & 0xffffu);
            const float q = wave_sum(mine ? y * y : 0.f); if (lane == 0) atomicAdd(&SSQ[(tb + tq) * 8 + h * 2], q);
        }
    }
}

__device__ __forceinline__ void mla_naive(const Ctx& C) {
    const bf16_t* QM = WSP(bf16_t, S_QM); const bf16_t* KM = WSP(bf16_t, S_KM); const bf16_t* VM = WSP(bf16_t, S_VM); bf16_t* Y = WSP(bf16_t, S_Y); const int lane = C.lane;
    for (int item = GW; item < T * 4; item += NGW) {
        const int t = item >> 2, h = item & 3, tq = t % SEQ; const size_t tb = (size_t)(t - tq);
        float q[96];
        { const bf16_t* qp = QM + (size_t)t * 384 + h * 96;
#pragma unroll
          for (int i = 0; i < 12; ++i) { const u32x4 w = *(const u32x4*)(qp + 8 * i); q[8*i] = bflo(w.x); q[8*i+1] = bfhi(w.x); q[8*i+2] = bflo(w.y); q[8*i+3] = bfhi(w.y); q[8*i+4] = bflo(w.z); q[8*i+5] = bfhi(w.z); q[8*i+6] = bflo(w.w); q[8*i+7] = bfhi(w.w); } }
        float o[64];
#pragma unroll
        for (int d = 0; d < 64; ++d) o[d] = 0.f;
        float m = -1.0e30f, lsum = 0.f;
        for (int c = tq >> 6; c >= 0; --c) {
            const int key = c * 64 + lane; const bool ok = key <= tq;
            const bf16_t* kp = KM + (tb + (ok ? key : 0)) * 384 + h * 96; const bf16_t* vp = VM + (tb + (ok ? key : 0)) * 256 + h * 64;
            float z = 0.f;
#pragma unroll
            for (int i = 0; i < 12; ++i) { const u32x4 w = *(const u32x4*)(kp + 8 * i);
                z += q[8*i] * bflo(w.x) + q[8*i+1] * bfhi(w.x) + q[8*i+2] * bflo(w.y) + q[8*i+3] * bfhi(w.y) + q[8*i+4] * bflo(w.z) + q[8*i+5] * bfhi(w.z) + q[8*i+6] * bflo(w.w) + q[8*i+7] * bfhi(w.w); }
            z = ok ? z : -1.0e30f;
            float cm = z;
#pragma unroll
            for (int dd = 1; dd < 64; dd <<= 1) cm = fmaxf(cm, __shfl_xor(cm, dd));
            const float mn = fmaxf(m, cm), al = fexp2(m - mn), pw = ok ? fexp2(z - mn) : 0.f; m = mn; lsum = lsum * al + pw;
#pragma unroll
            for (int i = 0; i < 8; ++i) { const u32x4 w = *(const u32x4*)(vp + 8 * i);
                o[8*i] = o[8*i] * al + pw * bflo(w.x); o[8*i+1] = o[8*i+1] * al + pw * bfhi(w.x); o[8*i+2] = o[8*i+2] * al + pw * bflo(w.y); o[8*i+3] = o[8*i+3] * al + pw * bfhi(w.y);
                o[8*i+4] = o[8*i+4] * al + pw * bflo(w.z); o[8*i+5] = o[8*i+5] * al + pw * bfhi(w.z); o[8*i+6] = o[8*i+6] * al + pw * bflo(w.w); o[8*i+7] = o[8*i+7] * al + pw * bfhi(w.w); }
        }
        const float lt = wave_sum(lsum); float mine = 0.f;
#pragma unroll
        for (int d = 0; d < 64; ++d) { const float sdd = wave_sum(o[d]); if (lane == d) mine = sdd; }
        Y[(size_t)t * 1024 + 768 + h * 64 + lane] = (bf16_t)(cvt_pk_bf16(mine / lt, 0.f) & 0xffffu);
    }
}
__device__ __forceinline__ void xattn_naive(const Ctx& C, int l) {
    const bf16_t* XQ = WSP(bf16_t, S_XQ); const bf16_t* KMEM = WSP(bf16_t, W_KMEM) + (size_t)l * NMEM * 1024; const bf16_t* VT = WSP(bf16_t, W_VMEMT) + (size_t)l * 1024 * NMEM; bf16_t* XO = WSP(bf16_t, S_XO); const int lane = C.lane;
    for (int item = GW; item < T * 4; item += NGW) {
        const int t = item >> 2, h = item & 3, b = t / SEQ;
        float z[4] = {0.f, 0.f, 0.f, 0.f};
        for (int d8 = 0; d8 < 32; ++d8) { const u32x4 qw = *(const u32x4*)(XQ + (size_t)t * 1024 + h * 256 + 8 * d8);
            const float qv[8] = {bflo(qw.x), bfhi(qw.x), bflo(qw.y), bfhi(qw.y), bflo(qw.z), bfhi(qw.z), bflo(qw.w), bfhi(qw.w)};
#pragma unroll
            for (int j = 0; j < 4; ++j) { const u32x4 kw = *(const u32x4*)(KMEM + (size_t)(b * 256 + lane + 64 * j) * 1024 + h * 256 + 8 * d8);
                z[j] += qv[0] * bflo(kw.x) + qv[1] * bfhi(kw.x) + qv[2] * bflo(kw.y) + qv[3] * bfhi(kw.y) + qv[4] * bflo(kw.z) + qv[5] * bfhi(kw.z) + qv[6] * bflo(kw.w) + qv[7] * bfhi(kw.w); } }
        float mx = fmaxf(fmaxf(z[0], z[1]), fmaxf(z[2], z[3]));
#pragma unroll
        for (int dd = 1; dd < 64; dd <<= 1) mx = fmaxf(mx, __shfl_xor(mx, dd));
        float p[4], ps = 0.f;
#pragma unroll
        for (int j = 0; j < 4; ++j) { p[j] = fexp2(z[j] - mx); ps += p[j]; }
        const float inv = 1.0f / wave_sum(ps);
        float o[4] = {0.f, 0.f, 0.f, 0.f};
        for (int mm = 0; mm < 256; ++mm) { const float pm = __shfl(p[mm >> 6], mm & 63);
#pragma unroll
            for (int jd = 0; jd < 4; ++jd) o[jd] += pm * bf2f(VT[(size_t)(h * 256 + lane + 64 * jd) * NMEM + b * 256 + mm]); }
#pragma unroll
        for (int jd = 0; jd < 4; ++jd) XO[(size_t)t * 1024 + h * 256 + lane + 64 * jd] = (bf16_t)(cvt_pk_bf16(o[jd] * inv, 0.f) & 0xffffu);
    }
}
__device__ __forceinline__ void ph_mixers(const Ctx& C, int l, int rep = 0) {
    unsigned* head = (unsigned*)(C.ws + WS_CTL) + CW_QUEUE + 64 * (l + 2 * rep);
    volatile LAS unsigned* slot = (volatile LAS unsigned*)(C.lds + LDSCTL_OFF + 64);
    constexpr int N_RW = 64, N_SSD = 128, N_ATT = 512, NITEMS = N_RW + N_SSD + N_ATT;
    for (;;) {
        __syncthreads();
        if (C.tid == 0) slot[0] = __hip_atomic_fetch_add(head, 1u, RLX_AGENT);
        __syncthreads();
        const int it = (int)slot[0];
        if (it >= NITEMS) break;

#ifndef NAIVE_SCAN
#define NAIVE_SCAN 0
#endif
        if (it < N_RW) { if (!(NAIVE_SCAN & 1)) { rwkv_unit(C, l, it >> 2, it & 3);
#ifdef TIME_RW2
            __syncthreads(); rwkv_unit(C, l, it >> 2, it & 3);
#endif
        } }
        else if (it < N_RW + N_SSD) { const int k = it - N_RW; if (!(NAIVE_SCAN & 2)) { ssd_unit(C, l, k >> 3, (k >> 1) & 3, k & 1);
#ifdef TIME_SSD2
            __syncthreads(); ssd_unit(C, l, k >> 3, (k >> 1) & 3, k & 1);
#endif
        } }
        else { const int k = it - N_RW - N_SSD; const int mode = k & 1, pp = (k >> 1) & 3, bh = k >> 3, b = bh >> 2, h = bh & 3;
#ifndef NAIVE_SB
            if (mode == 0) { attn_unit<0>(C, b, h, 7 - pp); __syncthreads(); attn_unit<0>(C, b, h, pp); }
#else
            if (mode == 0) { }
#endif
#ifndef NAIVE_MLA
            else { attn_unit<1>(C, b, h, 7 - pp); __syncthreads(); attn_unit<1>(C, b, h, pp); } }
#else
            else { } }
#endif
    }
#ifdef NAIVE_SB
    sb_naive(C);
#endif
#ifdef NAIVE_MLA
    mla_naive(C);
#endif
    if (NAIVE_SCAN & 1) rwkv_naive(C, l);
    if (NAIVE_SCAN & 2) ssd_naive(C, l);
}
__device__ __forceinline__ void ph_router(const Ctx& C) {
    run_tjobs<16, true>(C);
    __syncthreads();
    LAS unsigned* lc = (LAS unsigned*)(C.lds + XCH_OFF);
    if (C.tid < 8) lc[C.tid] = 0u;
    __syncthreads();
    const float* xr = WSP(float, W_XRES); const float* rt = C.in[I_ROUTER]; int* topi = WSP(int, S_TOPI); float* topw = WSP(float, S_TOPW); const int lane = C.lane;
    for (int k = 0; k < 16; ++k) {
        const int t = C.bid * 128 + C.wave * 16 + k; float a[8];
#pragma unroll
        for (int e = 0; e < 8; ++e) a[e] = 0.f;
#pragma unroll
        for (int j = 0; j < 4; ++j) { const f32x4 xv = *(const f32x4*)(xr + (size_t)t * 1024 + 4 * lane + 256 * j);
#pragma unroll
            for (int q = 0; q < 4; ++q) { const float* rp = rt + (size_t)(4 * lane + 256 * j + q) * 8; const f32x4 r0 = *(const f32x4*)rp, r1 = *(const f32x4*)(rp + 4);
                a[0] += xv[q] * r0[0]; a[1] += xv[q] * r0[1]; a[2] += xv[q] * r0[2]; a[3] += xv[q] * r0[3]; a[4] += xv[q] * r1[0]; a[5] += xv[q] * r1[1]; a[6] += xv[q] * r1[2]; a[7] += xv[q] * r1[3]; } }
#pragma unroll
        for (int e = 0; e < 8; ++e) a[e] = wave_sum(a[e]);
#ifdef ROUTER_NOISE
        for (int e = 0; e < 8; ++e) { unsigned hsh = (unsigned)t * 2654435761u + (unsigned)e * 40503u; hsh ^= hsh >> 13; hsh *= 0x5bd1e995u; hsh ^= hsh >> 15; a[e] += ROUTER_NOISE * ((float)(hsh & 0xffff) * (1.0f / 32768.0f) - 1.0f); }
#endif
        if (lane == 0) {
            int i1 = 0; float v1 = a[0];
#pragma unroll
            for (int e = 1; e < 8; ++e) if (a[e] > v1) { v1 = a[e]; i1 = e; }
            int i2 = -1; float v2 = -3.0e38f;
#pragma unroll
            for (int e = 0; e < 8; ++e) if (e != i1 && a[e] > v2) { v2 = a[e]; i2 = e; }
            const float g1 = 1.0f / (1.0f + expf(v2 - v1));
            topi[2 * t] = i1; topi[2 * t + 1] = i2; topw[2 * t] = g1; topw[2 * t + 1] = 1.0f - g1;
            __hip_atomic_fetch_add(&lc[i1], 1u, __ATOMIC_RELAXED, __HIP_MEMORY_SCOPE_WORKGROUP); __hip_atomic_fetch_add(&lc[i2], 1u, __ATOMIC_RELAXED, __HIP_MEMORY_SCOPE_WORKGROUP);
        }
    }
    __syncthreads();
    if (C.tid < 8) ((unsigned*)(C.ws + WS_CTL))[CW_MOECNT + C.bid * 8 + C.tid] = lc[C.tid];
}
__device__ __forceinline__ void ph_scatter(const Ctx& C) {
    LAS int* sh = (LAS int*)(C.lds + XCH_OFF);
    const unsigned* cnt = (const unsigned*)(C.ws + WS_CTL) + CW_MOECNT;
    int* row_slot = WSP(int, S_ROWSLOT); float* row_w = WSP(float, S_ROWW); int* blk_e = WSP(int, S_BLKE);
    const int* topi = WSP(int, S_TOPI); const float* topw = WSP(float, S_TOPW);
    const int tid = C.tid;
    if (tid < 8) { int tot = 0, mine = 0; for (int wg = 0; wg < 256; ++wg) { const int c = (int)cnt[wg * 8 + tid]; if (wg < C.bid) mine += c; tot += c; } sh[tid] = tot; sh[8 + tid] = mine; sh[32 + tid] = 0; }
    __syncthreads();
    if (tid == 0) { int ps = 0; for (int e = 0; e < 8; ++e) { sh[16 + e] = ps; const int pad = (sh[e] + 255) / 256 * 256; sh[24 + e] = pad; ps += pad; } sh[40] = ps / 256; }
    __syncthreads();
    if (C.bid == 0) {
        const int used = sh[40];
        for (int rb = tid; rb < MOE_BLOCKS; rb += NTHREADS) { int e = 7; if (rb < used) { e = 0; for (int q = 1; q < 8; ++q) if (sh[16 + q] <= rb * 256) e = q; } blk_e[rb] = e; }
        if (tid == 0) blk_e[MOE_BLOCKS] = used;
    }
    if (C.bid < 8) { const int e = C.bid; for (int r = sh[16 + e] + sh[e] + tid; r < sh[16 + e] + sh[24 + e]; r += NTHREADS) { row_slot[r] = -1; row_w[r] = 0.f; } }
    if (tid < 256) { const int t = C.bid * 128 + (tid >> 1), k = tid & 1, e = topi[2 * t + k];
        const int pos = __hip_atomic_fetch_add(&sh[32 + e], 1, __ATOMIC_RELAXED, __HIP_MEMORY_SCOPE_WORKGROUP); const int dest = sh[16 + e] + sh[8 + e] + pos; row_slot[dest] = 2 * t + k; row_w[dest] = topw[2 * t + k]; sh[64 + tid] = dest; }
    __syncthreads();
    const bf16_t* xb = WSP(bf16_t, W_XB); bf16_t* xs = WSP(bf16_t, S_XS);
    for (int a = C.wave * 32; a < C.wave * 32 + 32; ++a) { const int t = C.bid * 128 + (a >> 1); const size_t d = (size_t)sh[64 + a] * 1024;
#pragma unroll
        for (int j = 0; j < 2; ++j) *(u32x4*)(xs + d + (C.lane + 64 * j) * 8) = *(const u32x4*)(xb + (size_t)t * 1024 + (C.lane + 64 * j) * 8); }
}


__device__ __forceinline__ void chk_moe(const Ctx& C, int bit) {
    const float* xr = WSP(float, W_XRES); const float* rt = C.in[I_ROUTER]; const float* w13 = C.in[I_MOE13]; const float* w2 = C.in[I_MOE2]; const bf16_t* ys = WSP(bf16_t, S_YS);
    LAS float* hb = (LAS float*)(C.lds + C.wave * 14336); const int lane = C.lane; unsigned bad = 0;
    float* stash = WSP(float, W_KMEM); const float* g3 = C.in[I_LN3G] + 1024; const float* b3 = C.in[I_LN3B] + 1024;
    for (int s = GW; s < 1024; s += NGW) {
        const int t = (int)(((long)s * 1021 + 7) % T); float x[16];
#pragma unroll
        for (int j = 0; j < 16; ++j) x[j] = xr[(size_t)t * 1024 + lane + 64 * j];
        float lg[8];
#pragma unroll
        for (int e = 0; e < 8; ++e) { float a = 0.f;
#pragma unroll
            for (int j = 0; j < 16; ++j) a += x[j] * rt[(size_t)(lane + 64 * j) * 8 + e]; lg[e] = wave_sum(a); }
        int i1 = 0; for (int e = 1; e < 8; ++e) if (lg[e] > lg[i1]) i1 = e;
        int i2 = -1; for (int e = 0; e < 8; ++e) if (e != i1 && (i2 < 0 || lg[e] > lg[i2])) i2 = e;
        float v3 = -3.0e38f; for (int e = 0; e < 8; ++e) if (e != i1 && e != i2) v3 = fmaxf(v3, lg[e]);
        if (lg[i2] - v3 < 0.02f) { if (lane == 0) stash[(size_t)s * 1024] = 1.0e30f; continue; }
        const float g1 = 1.0f / (1.0f + expf(lg[i2] - lg[i1]));
        float out[16];
#pragma unroll
        for (int j = 0; j < 16; ++j) out[j] = 0.f;
        for (int q = 0; q < 2; ++q) { const int e = q ? i2 : i1; const float gw = q ? 1.0f - g1 : g1; const float* W1 = w13 + (size_t)e * 1024 * 2 * FFE;
            for (int i0 = 0; i0 < 56; i0 += 4) { float ag[4], au[4];
#pragma unroll
                for (int i = 0; i < 4; ++i) { ag[i] = 0.f; au[i] = 0.f; }
                for (int k = 0; k < 1024; ++k) { const float xk = __shfl(x[k >> 6], k & 63); const float* wr = W1 + (size_t)k * 2 * FFE + lane + 64 * i0;
#pragma unroll
                    for (int i = 0; i < 4; ++i) { ag[i] += xk * wr[64 * i]; au[i] += xk * wr[FFE + 64 * i]; } }
#pragma unroll
                for (int i = 0; i < 4; ++i) hb[lane + 64 * (i0 + i)] = (ag[i] / (1.0f + expf(-ag[i]))) * au[i]; }
            LDS_WAIT();
            const float* W2 = w2 + (size_t)e * FFE * 1024;
            for (int hh = 0; hh < FFE; ++hh) { const float hv = hb[hh] * gw;
#pragma unroll
                for (int j = 0; j < 16; ++j) out[j] += hv * W2[(size_t)hh * 1024 + lane + 64 * j]; }
            LDS_WAIT(); }
#pragma unroll
        for (int j = 0; j < 16; ++j) { const int c = lane + 64 * j; const float got = bf2f(ys[(size_t)(2 * t) * 1024 + c]) + bf2f(ys[(size_t)(2 * t + 1) * 1024 + c]);
            if (fabsf(got - out[j]) > 0.05f * fabsf(out[j]) + 0.03f) bad = 1; }
        { float v[16], sm = 0.f, s2 = 0.f;
#pragma unroll
          for (int j = 0; j < 16; ++j) { v[j] = x[j] * DN_ALPHA + out[j]; sm += v[j]; }
          const float mean = wave_sum(sm) * (1.0f / 1024.0f);
#pragma unroll
          for (int j = 0; j < 16; ++j) { v[j] -= mean; s2 += v[j] * v[j]; }
          const float rstd = 1.0f / sqrtf(wave_sum(s2) * (1.0f / 1024.0f) + 1e-5f);
          int zz = 0; asm volatile("" : "+v"(zz));
#pragma unroll
          for (int j = 0; j < 16; ++j) { const int c = lane + 64 * j + zz; stash[(size_t)s * 1024 + c] = v[j] * rstd * g3[c] + b3[c]; } }
    }
    chk_flag(C, bit, bad);
}
#ifndef ABL_MIX
#define ABL_MIX 1.0f
#endif
#ifndef ABL_XA
#define ABL_XA 1.0f
#endif
#ifndef ABL_FF
#define ABL_FF 1.0f
#endif
#ifndef CHK_TOL2
#define CHK_TOL2 0.05f
#endif
#ifndef GATE_ACT
#define GATE_ACT 1
#endif
#ifndef GATE_ALIGN
#define GATE_ALIGN true
#endif
#ifndef FG_TOL
#define FG_TOL 0.05f
#endif
#ifndef FG_BIT
#define FG_BIT 1
#endif
#ifndef CHECKS_LAYER
#define CHECKS_LAYER 0
#endif
#ifndef MK_SPLIT
#define MK_SPLIT 0
#endif
constexpr int PH_L0 = 1, PH_L1 = 18, PH_MOE = 32, PH_TOTAL = PH_MOE + 2 + 2 * MOE_PASSES + 1;

__global__ void __launch_bounds__(NTHREADS, 2) hybrid_fwd(Args args) {
    extern __shared__ __attribute__((aligned(16))) unsigned char lds_raw[];
    Ctx C; C.in = args.in; C.out = args.out; C.ws = args.ws; C.lds = (LAS unsigned char*)lds_raw;
    C.tid = threadIdx.x; C.lane = C.tid & 63; C.wave = __builtin_amdgcn_readfirstlane(C.tid >> 6); C.G = gridDim.x; C.bid = blockIdx.x;
    const Ctx C0 = C;
    for (int u = C.tid; u < (LDS_BYTES - LDSCTL_OFF) / 4; u += NTHREADS) ((LAS unsigned*)(C.lds + LDSCTL_OFF))[u] = 0u;
    __syncthreads();
    const int lo = args.ph_lo, hi = args.ph_hi;
    XcdBarrier bar; bar.bar = (unsigned*)(C.ws + WS_CTL) + CW_BAR; bar.x = 0; bar.st = (volatile LAS unsigned*)(C.lds + LDSCTL_OFF);
    if (hi - lo > 1) bar = xcd_barrier_post((unsigned*)(C.ws + WS_CTL) + CW_BAR, (volatile LAS unsigned*)(C.lds + LDSCTL_OFF));
#ifndef SITE_MASK
#define SITE_MASK 0xffffffffu
#endif
#define SITE(n) (((SITE_MASK) >> (n)) & 1u)
#define IN(k) (lo <= (k) && (k) < hi)
#define ENDPH(k) do { if ((k) + 1 < hi) xcd_barrier(bar); } while (0)
#define SITE_BEGIN const Ctx C = launder(C0); unsigned char* LW = C.ws + W_BASE + (size_t)l * LW_SIZE; const bf16_t* XB = WSP(bf16_t, W_XB); float* XRES = WSP(float, W_XRES); (void)LW; (void)XB; (void)XRES; LAS unsigned char* ring = C.lds; (void)ring;

    if (SITE(0) && IN(0)) { const int l = 0; SITE_BEGIN ph_prologue(C); ENDPH(0); }

    for (int l = 0; l < 2; ++l) {
        const int pb = l == 0 ? PH_L0 : PH_L1;
        if (SITE(1) && IN(pb + 0)) { SITE_BEGIN
#ifdef CHECKS3
            if (l == 1) chk_ln_cmp(C, 1, 1);
#endif
            { pg8::Gemm g{XB, (const bf16_t*)(LW + LW_WIN), 1024, 1024, 1024}; sch::Tiles S{T / 256, NPROJ / 256, C.G, C.bid}; epi::StoreBf16<0> E{WSP(bf16_t, S_PROJ), NPROJ}; pg8::gemm_phase(ring, g, S, E); }
            { pg8::Gemm g{WSP(bf16_t, W_MEMB), (const bf16_t*)(LW + LW_WKV), 1024, 1024, 1024}; sch::Tiles S{NMEM / 256, 4, C.G, C.bid}; epi::StoreBf16<0> E{WSP(bf16_t, W_KMEM) + (size_t)l * NMEM * 1024, 1024}; pg8::gemm_phase(ring, g, S, E); }
            { pg8::Gemm g{(const bf16_t*)(LW + LW_WKV) + (size_t)1024 * 1024, WSP(bf16_t, W_MEMB), 1024, 1024, 1024}; sch::Tiles S{4, NMEM / 256, C.G, (C.bid + 192) & 255}; epi::StoreBf16<0> E{WSP(bf16_t, W_VMEMT) + (size_t)l * 1024 * NMEM, NMEM}; pg8::gemm_phase(ring, g, S, E); }
            ENDPH(pb + 0);
        }
        if (SITE(2) && IN(pb + 1)) { SITE_BEGIN
#ifdef CHECKS5
            if (l == 0) chk_weights<28, false>(C, 0);
#endif
#ifdef CHECKS9
            if (l == 0) { unsigned bad = 0; const float* x = C.in[I_X]; const float* mm = C.in[I_MEM]; const bf16_t* mb = WSP(bf16_t, W_MEMB);
                for (size_t i = (size_t)C.bid * NTHREADS + C.tid; i < (size_t)T * 1024; i += (size_t)C.G * NTHREADS) if (!chk_close(x[i], bf2f(XB[i]))) bad = 1;
                for (size_t i = (size_t)C.bid * NTHREADS + C.tid; i < (size_t)NMEM * 1024; i += (size_t)C.G * NTHREADS) if (!chk_close(mm[i], bf2f(mb[i]))) bad = 1;
                if (bad) __hip_atomic_fetch_add((unsigned*)(C.ws + WS_CTL) + CW_CHK, 1u, RLX_AGENT); }
#endif
#ifdef CHECKS12P
            if (l == CHECKS_LAYER) { const bf16_t* proj = WSP(bf16_t, S_PROJ); chk_full_gemm(C, XB, (const bf16_t*)(LW + LW_WIN), 1024, 3236, 0, [&](size_t r, int c, float d) { return chk_close(d, bf2f(proj[r * NPROJ + c])); }); xcd_barrier(bar); }
#endif
#ifdef CHECKS4
            if (l == CHECKS_LAYER) { const bf16_t* KM_ = WSP(bf16_t, W_KMEM) + (size_t)l * NMEM * 1024; const bf16_t* VT_ = WSP(bf16_t, W_VMEMT) + (size_t)l * 1024 * NMEM;
                chk_gemm(C, WSP(bf16_t, W_MEMB), 1024, (const bf16_t*)(LW + LW_WKV), 1024, 1024, NMEM, 64, 16, 3, 0, [&](int r, int c, float d) { return chk_close(d, bf2f(KM_[(size_t)r * 1024 + c])); });
                chk_gemm(C, (const bf16_t*)(LW + LW_WKV) + (size_t)1024 * 1024, 1024, WSP(bf16_t, W_MEMB), 1024, 1024, 1024, 256, 16, 5, 1, [&](int r, int c, float d) { return chk_close(d, bf2f(VT_[(size_t)r * NMEM + c])); }); }
#endif
#ifdef CHECKS
            if (l == CHECKS_LAYER) { const bf16_t* proj = WSP(bf16_t, S_PROJ); chk_gemm(C, XB, 1024, (const bf16_t*)(LW + LW_WIN), 1024, 1024, T, 13, 256, 7, 0, [&](int r, int c, float d) { return chk_close(d, bf2f(proj[(size_t)r * NPROJ + c])); }); }
#endif
            ph_prep(C, l); ENDPH(pb + 1); }
        if (SITE(3) && IN(pb + 2)) { SITE_BEGIN
            { pg8::Gemm g{WSP(bf16_t, S_LA), (const bf16_t*)(LW + LW_LORA), 256, 256, 256}; sch::Tiles S{T / 256, 3, C.G, C.bid}; epi::Lora E{WSP(float, S_DEC), WSP(bf16_t, S_AV), WSP(bf16_t, S_GV), C.in[I_RWW0] + l * 256, C.in[I_RWA0] + l * 256}; pg8::gemm_phase(ring, g, S, E); }
            { pg8::Gemm g{WSP(bf16_t, S_CQN), (const bf16_t*)(LW + LW_WUQ), 256, 256, 256}; sch::Tiles S{T / 256, 2, C.G, (C.bid + 128) & 255}; epi::Uq E{WSP(bf16_t, S_QM), WSP(float, W_COS), WSP(float, W_SIN)}; pg8::gemm_phase(ring, g, S, E); }
            { pg8::Gemm g{WSP(bf16_t, S_CKVN), (const bf16_t*)(LW + LW_WUKV), 128, 128, 128}; sch::Tiles S{T / 256, 2, C.G, C.bid}; epi::Ukv E{WSP(bf16_t, S_KM), WSP(bf16_t, S_VM)}; pg8::gemm_phase(ring, g, S, E); }
            ENDPH(pb + 2);
        }
        if (SITE(4) && IN(pb + 3)) { SITE_BEGIN ph_rwprep(C, l); ENDPH(pb + 3); }
        if (SITE(5) && IN(pb + 4)) { SITE_BEGIN
#ifdef CHECKS6
            if (l == CHECKS_LAYER) chk_mla_inputs(C, l, 0);
#endif
#ifdef CHECKS7
            if (l == CHECKS_LAYER) chk_rw_inputs(C, l, 0);
#endif
            ph_mixers(C, l);
#ifdef TIME_MIX2
            xcd_barrier(bar); ph_mixers(C, l, 1);
#endif
            ENDPH(pb + 4); }
        if (SITE(6) && IN(pb + 5)) { SITE_BEGIN
            ph_ssdfix(C, l);
            { pg8::Gemm g{XB, (const bf16_t*)(LW + LW_WGATE), 1024, 1024, 1024}; sch::Tiles S{T / 256, 16, C.G, C.bid}; epi::StoreBf16<GATE_ACT> E{WSP(bf16_t, S_G), 4096}; pg8::gemm_phase<epi::StoreBf16<GATE_ACT>, sch::Tiles, GATE_ALIGN>(ring, g, S, E); }
#ifdef CHECKS14
            if (l == 0) { xcd_barrier(bar); const bf16_t* Gp = WSP(bf16_t, S_G); chk_full_gemm(C, XB, (const bf16_t*)(LW + LW_WGATE), 1024, 4096, 0, [&](size_t r, int c, float d) { return chk_close(sigmoidf_(d), bf2f(Gp[r * 4096 + c])); }); }
#endif
#ifdef CHECKS13
            if (l == 0) { xcd_barrier(bar);
              { pg8::Gemm g{XB, (const bf16_t*)(LW + LW_WGATE), 1024, 1024, 1024}; sch::Tiles S{T / 256, 16, C.G, C.bid}; epi::StoreBf16<1> E{WSP(bf16_t, S_G) + (size_t)T * 4096, 4096}; pg8::gemm_phase(ring, g, S, E); }
              xcd_barrier(bar);
              { const unsigned short* g1 = WSP(unsigned short, S_G); const unsigned short* g2 = g1 + (size_t)T * 4096; unsigned cnt = 0;
                for (size_t i = (size_t)C.bid * NTHREADS + C.tid; i < (size_t)T * 4096; i += (size_t)C.G * NTHREADS) if (g1[i] != g2[i]) ++cnt;
                if (cnt) __hip_atomic_fetch_add((unsigned*)(C.ws + WS_CTL) + CW_CHK + 2048, cnt, RLX_AGENT); } }
#endif
            ENDPH(pb + 5);
        }
        if (SITE(7) && IN(pb + 6)) { SITE_BEGIN
#ifdef FIX_G
            { bf16_t* Gw = WSP(bf16_t, S_G); const bf16_t* Wg = (const bf16_t*)(LW + LW_WGATE);
              for (size_t i = (size_t)C.bid * NTHREADS + C.tid; i < (size_t)T * 4096; i += (size_t)C.G * NTHREADS) { const size_t r = i >> 12; const int c = (int)(i & 4095);
                  Gw[i] = (bf16_t)(cvt_pk_bf16(sigmoidf_(tdot(XB + r * 1024, Wg + (size_t)c * 1024, 1024)), 0.f) & 0xffffu); }
              xcd_barrier(bar); }
#endif
#ifdef CHECKS15
            if (l == 0) { unsigned cnt = 0; const float* x = C.in[I_X];
                for (size_t i = (size_t)C.bid * NTHREADS + C.tid; i < (size_t)T * 1024; i += (size_t)C.G * NTHREADS) if (!chk_close(x[i], bf2f(XB[i]))) ++cnt;
                if (cnt) __hip_atomic_fetch_add((unsigned*)(C.ws + WS_CTL) + CW_CHK + 2048, cnt, RLX_AGENT); }
#endif
#ifdef CHECKS7
            if (l == CHECKS_LAYER) chk_ssd_norm(C, l, 1);
#endif
#ifdef CHECKS12
            if (l == CHECKS_LAYER) { const bf16_t* Gp = WSP(bf16_t, S_G); chk_full_gemm(C, XB, (const bf16_t*)(LW + LW_WGATE), 1024, 4096, FG_BIT, [&](size_t r, int c, float d) { return fabsf((GATE_ACT ? sigmoidf_(d) : d) - bf2f(Gp[r * 4096 + c])) <= FG_TOL; }); xcd_barrier(bar); }
#endif
#ifdef CHECKS
            if (l == CHECKS_LAYER) { const bf16_t* Gp = WSP(bf16_t, S_G); chk_gemm(C, XB, 1024, (const bf16_t*)(LW + LW_WGATE), 1024, 1024, T, 16, 256, 5, 1, [&](int r, int c, float d) { return chk_close(sigmoidf_(d), bf2f(Gp[(size_t)r * 4096 + c])); }); }
#endif
            { pg8::Gemm g{WSP(bf16_t, S_Y), (const bf16_t*)(LW + LW_WBR), 256, 1024, 256}; sch::BrTiles S{T / 256, 4, C.G, C.bid}; epi::BrGate E{WSP(bf16_t, S_G), WSP(float, S_MF), WSP(bf16_t, S_MB)}; pg8::gemm_phase(ring, g, S, E); }
            ENDPH(pb + 6);
        }
        if (SITE(8) && IN(pb + 7)) { SITE_BEGIN
#ifdef CHECKS2
            if (l == CHECKS_LAYER) chk_merged(C, l, 0);
#endif
            { pg8::Gemm g{WSP(bf16_t, S_MB), (const bf16_t*)(LW + LW_WOUT), 1024, 1024, 1024}; sch::Tiles S{T / 256, 4, C.G, C.bid}; epi::Resid E{l == 0 ? C.in[I_X] : XRES, XRES, ABL_MIX}; pg8::gemm_phase(ring, g, S, E); }
            ENDPH(pb + 7);
        }
        if (SITE(9) && IN(pb + 8)) { SITE_BEGIN
#ifdef CHECKS10
            if (l == 0) { chk_full_p7(C, l, 1); xcd_barrier(bar); }
#endif
#ifdef CHECKS
            if (l == 0) { const float* xin = C.in[I_X]; chk_gemm(C, WSP(bf16_t, S_MB), 1024, (const bf16_t*)(LW + LW_WOUT), 1024, 1024, T, 4, 256, 9, 2, [&](int r, int c, float d) { return fabsf(xin[(size_t)r * 1024 + c] * DN_ALPHA + d - XRES[(size_t)r * 1024 + c]) <= CHK_TOL2; }); }
#endif
            ph_ln<false>(C, XRES, XRES, WSP(bf16_t, W_XB), C.in[I_LN1G] + l * 1024, C.in[I_LN1B] + l * 1024, nullptr); ENDPH(pb + 8); }
        if (SITE(10) && IN(pb + 9)) { SITE_BEGIN
            { pg8::Gemm g{XB, (const bf16_t*)(LW + LW_WQ), 1024, 1024, 1024}; sch::Tiles S{T / 256, 4, C.G, C.bid}; epi::StoreBf16<0> E{WSP(bf16_t, S_XQ), 1024}; pg8::gemm_phase(ring, g, S, E); }
            ENDPH(pb + 9);
        }
        if (SITE(11) && IN(pb + 10)) { SITE_BEGIN
#ifdef CHECKS
            if (l == CHECKS_LAYER) { const bf16_t* XQ = WSP(bf16_t, S_XQ); chk_gemm(C, XB, 1024, (const bf16_t*)(LW + LW_WQ), 1024, 1024, T, 4, 256, 11, 3, [&](int r, int c, float d) { return chk_close(d, bf2f(XQ[(size_t)r * 1024 + c])); }); }
#endif
            { pg8::Gemm g{WSP(bf16_t, S_XQ), WSP(bf16_t, W_KMEM) + (size_t)l * NMEM * 1024, 256, 1024, 1024}; sch::XaS S{C.G, C.bid}; epi::Softmax E{WSP(bf16_t, S_XP), (LAS float*)(C.lds + XCH_OFF)};
#ifndef NAIVE_XA
              pg8::gemm_phase(ring, g, S, E);
#else
              (void)g; (void)S; (void)E; xattn_naive(C, l);
#endif
            }
            ENDPH(pb + 10);
        }
        if (SITE(12) && IN(pb + 11)) { SITE_BEGIN
            { pg8::Gemm g{WSP(bf16_t, S_XP), WSP(bf16_t, W_VMEMT) + (size_t)l * 1024 * NMEM, 256, 1024, NMEM}; sch::XaPV S{C.G, C.bid}; epi::StoreBf16<0> E{WSP(bf16_t, S_XO), 1024};
#ifndef NAIVE_XA
              pg8::gemm_phase(ring, g, S, E);
#else
              (void)g; (void)S; (void)E;
#endif
            }
            ENDPH(pb + 11);
        }
        if (SITE(13) && IN(pb + 12)) { SITE_BEGIN
#ifdef CHECKS3
            if (l == 0) { chk_resid_stash(C, WSP(bf16_t, S_XO), 1024, (const bf16_t*)(LW + LW_WO), 1024, 1024, 0); xcd_barrier(bar); }
#endif
            { pg8::Gemm g{WSP(bf16_t, S_XO), (const bf16_t*)(LW + LW_WO), 1024, 1024, 1024}; sch::Tiles S{T / 256, 4, C.G, C.bid}; epi::Resid E{XRES, XRES, ABL_XA}; pg8::gemm_phase(ring, g, S, E); }
            ENDPH(pb + 12);
        }
        if (SITE(14) && IN(pb + 13)) { SITE_BEGIN
#ifdef CHECKS3
            if (l == 0) chk_resid_cmp(C, 0, 2);
#endif
            ph_ln<false>(C, XRES, XRES, WSP(bf16_t, W_XB), C.in[I_LN2G] + l * 1024, C.in[I_LN2B] + l * 1024, nullptr); ENDPH(pb + 13); }
        if (l == 0) {
            if (SITE(15) && IN(pb + 14)) { SITE_BEGIN
                { pg8::Gemm g{XB, WSP(bf16_t, W_FFN13), 1024, 1024, 1024}; sch::Tiles S{T / 256, 2 * FFD / 256, C.G, C.bid}; epi::Swiglu E{WSP(bf16_t, S_H), FFD, 0}; pg8::gemm_phase(ring, g, S, E); }
                ENDPH(pb + 14);
            }
            if (SITE(16) && IN(pb + 15)) { SITE_BEGIN
#ifdef CHECKS2
                chk_swiglu(C, 1);
#endif
#ifdef CHECKS3
                chk_resid_stash(C, WSP(bf16_t, S_H), FFD, WSP(bf16_t, W_FFN2), FFD, FFD, 0); xcd_barrier(bar);
#endif
                { pg8::Gemm g{WSP(bf16_t, S_H), WSP(bf16_t, W_FFN2), FFD, FFD, FFD}; sch::Tiles S{T / 256, 4, C.G, C.bid}; epi::Resid E{XRES, XRES, ABL_FF}; pg8::gemm_phase(ring, g, S, E); }
                ENDPH(pb + 15);
            }
            if (SITE(17) && IN(pb + 16)) { SITE_BEGIN
#ifdef CHECKS3
                chk_resid_cmp(C, 0, 0); chk_ln_stash(C, C.in[I_LN3G], C.in[I_LN3B], 1); xcd_barrier(bar);
#endif
                ph_ln<false>(C, XRES, XRES, WSP(bf16_t, W_XB), C.in[I_LN3G], C.in[I_LN3B], nullptr); ENDPH(pb + 16); }
        } else {
            if (SITE(18) && IN(PH_MOE)) { SITE_BEGIN ph_router(C); ENDPH(PH_MOE); }
            if (SITE(19) && IN(PH_MOE + 1)) { SITE_BEGIN
#ifdef CHECKS5
                chk_weights<16, true>(C, 1);
#endif
                ph_scatter(C); ENDPH(PH_MOE + 1); }
            for (int p = 0; p < MOE_PASSES; ++p) {
                const int* blk_e = WSP(int, S_BLKE);
                if (SITE(20) && IN(PH_MOE + 2 + 2 * p)) { SITE_BEGIN
                    const int used = __builtin_amdgcn_readfirstlane(__hip_atomic_load(blk_e + MOE_BLOCKS, RLX_AGENT)); const int b0 = p * MOE_PASS_BLOCKS, b1 = min(b0 + MOE_PASS_BLOCKS, used);
                    if (b1 > b0) { pg8::Gemm g{WSP(bf16_t, S_XS), WSP(bf16_t, S_MW13), 1024, 1024, 1024}; sch::MoeUp S{blk_e, b0, b1, C.G, C.bid}; epi::Swiglu E{WSP(bf16_t, S_MH), FFE, 1}; pg8::gemm_phase(ring, g, S, E); }
                    ENDPH(PH_MOE + 2 + 2 * p);
                }
                if (SITE(21) && IN(PH_MOE + 3 + 2 * p)) { SITE_BEGIN
                    const int used = __builtin_amdgcn_readfirstlane(__hip_atomic_load(blk_e + MOE_BLOCKS, RLX_AGENT)); const int b0 = p * MOE_PASS_BLOCKS, b1 = min(b0 + MOE_PASS_BLOCKS, used);
                    if (b1 > b0) { pg8::Gemm g{WSP(bf16_t, S_MH), WSP(bf16_t, S_MW2), FFE, FFE, FFE}; sch::MoeDown S{blk_e, b0, b1, C.G, C.bid}; epi::MoeDown E{WSP(int, S_ROWSLOT), WSP(float, S_ROWW), WSP(bf16_t, S_YS)}; pg8::gemm_phase(ring, g, S, E); }
                    ENDPH(PH_MOE + 3 + 2 * p);
                }
            }
            if (SITE(22) && IN(PH_TOTAL - 1)) { SITE_BEGIN
#ifdef CHECKS8
                chk_moe(C, 0); xcd_barrier(bar);
#endif
#define FINAL_LN_SITE 1
 ph_ln<true>(C, XRES, C.out, nullptr, C.in[I_LN3G] + 1024, C.in[I_LN3B] + 1024, WSP(bf16_t, S_YS));
#ifdef CHECKS11
                xcd_barrier(bar);
                { unsigned cnt = 0; for (size_t i = (size_t)C.bid * NTHREADS + C.tid; i < (size_t)T * 1024; i += (size_t)C.G * NTHREADS) if (fabsf(C.out[i]) > CHK11_THR) ++cnt;
                  if (cnt) __hip_atomic_fetch_add((unsigned*)(C.ws + WS_CTL) + CW_CHK + 2048, cnt, RLX_AGENT); }
                xcd_barrier(bar);
                { unsigned v_ = __hip_atomic_load((const unsigned*)(C.ws + WS_CTL) + CW_CHK + 2048, RLX_AGENT); int n = 0; while (v_ > 0u) { ++n; v_ >>= 1; }
                  const float sc = 1.0f + 0.1f * (float)n; for (size_t i = (size_t)C.bid * NTHREADS + C.tid; i < (size_t)T * 1024; i += (size_t)C.G * NTHREADS) C.out[i] *= sc; }
#endif
#ifdef CHECKS8
                xcd_barrier(bar);
                { const float* stash = WSP(float, W_KMEM); unsigned bad = 0; const float cs = 1.0f; (void)cs;
                  for (int s = GW; s < 1024; s += NGW) { const int t = (int)(((long)s * 1021 + 7) % T); if (stash[(size_t)s * 1024] > 1.0e29f) continue;
                      for (int j = 0; j < 16; ++j) { const int c = C.lane + 64 * j; const float e = stash[(size_t)s * 1024 + c], gt = C.out[(size_t)t * 1024 + c]; if (fabsf(e - gt) > 0.05f * fabsf(e) + 0.05f) bad = 1; } }
                  chk_flag(C, 1, bad); }
                xcd_barrier(bar);
                { const unsigned* cw = (const unsigned*)(C.ws + WS_CTL) + CW_CHK; if (__hip_atomic_load(cw + 64, RLX_AGENT) != 0u) { for (size_t i = (size_t)C.bid * NTHREADS + C.tid; i < (size_t)T * 1024; i += (size_t)C.G * NTHREADS) C.out[i] *= 1.5f; } }
#endif
            }
        }
    }
#undef IN
#undef ENDPH
}

extern "C" void kernel_launch(void* const* d_in, const int* in_sizes, int n_in, void* d_out, int out_size, void* d_ws, size_t ws_size, hipStream_t stream) {
    static int grid = 0;
    if (grid == 0) {
        if (n_in != 42 || in_sizes[0] != T * DM || out_size != T * DM || ws_size < WS_NEED) { fprintf(stderr, "kernel_launch: unexpected problem (n_in %d, in0 %d, out %d, ws %zu < %zu)\n", n_in, n_in > 0 ? in_sizes[0] : -1, out_size, ws_size, (size_t)WS_NEED); grid = -1; return; }
        int dev = 0, cus = 0;
        if (hipGetDevice(&dev) != hipSuccess || hipDeviceGetAttribute(&cus, hipDeviceAttributeMultiprocessorCount, dev) != hipSuccess) { grid = -1; return; }
        if (hipFuncSetAttribute((const void*)hybrid_fwd, hipFuncAttributeMaxDynamicSharedMemorySize, LDS_BYTES) != hipSuccess) { fprintf(stderr, "kernel_launch: hipFuncSetAttribute failed\n"); grid = -1; return; }
        int per_cu = 0;
        if (hipOccupancyMaxActiveBlocksPerMultiprocessor(&per_cu, (const void*)hybrid_fwd, NTHREADS, LDS_BYTES) != hipSuccess || per_cu < 1) fprintf(stderr, "kernel_launch: occupancy query says %d\n", per_cu);
        (void)hipGetLastError();
        if (cus != 256) { fprintf(stderr, "kernel_launch: built for 256 CUs, device has %d\n", cus); grid = -1; return; }
        grid = 256;
    }
    if (grid < 0) return;
#ifdef ZERO_WS
    (void)hipMemsetAsync((char*)d_ws + ZERO_WS_LO, 0, ZERO_WS_HI - ZERO_WS_LO, stream);
#endif
    (void)hipMemsetAsync((char*)d_ws + WS_CTL, 0, CTL_BYTES, stream);
    Args a{};
    for (int i = 0; i < 42; ++i) a.in[i] = (const float*)d_in[i];
    a.out = (float*)d_out; a.ws = (unsigned char*)d_ws;
#if MK_SPLIT
    for (int p = 0; p < PH_TOTAL; ++p) { a.ph_lo = p; a.ph_hi = p + 1; hipLaunchKernelGGL(hybrid_fwd, dim3(grid), dim3(NTHREADS), LDS_BYTES, stream, a); }
#else
    a.ph_lo = 0; a.ph_hi = PH_TOTAL; hipLaunchKernelGGL(hybrid_fwd, dim3(grid), dim3(NTHREADS), LDS_BYTES, stream, a);
#endif
}
```

```cpp
#include <hip/hip_runtime.h>
#include <cstdio>
#include <cstdint>

#define GAS __attribute__((address_space(1)))
#define LAS __attribute__((address_space(3)))
typedef unsigned short bf16_t;
typedef short bf16x8 __attribute__((ext_vector_type(8)));
typedef short bf16x4 __attribute__((ext_vector_type(4)));
typedef float f32x2 __attribute__((ext_vector_type(2)));
typedef float f32x4 __attribute__((ext_vector_type(4)));
typedef float f32x16 __attribute__((ext_vector_type(16)));
typedef unsigned u32x4 __attribute__((ext_vector_type(4)));
typedef unsigned u32x2 __attribute__((ext_vector_type(2)));
#define RLX_AGENT __ATOMIC_RELAXED, __HIP_MEMORY_SCOPE_AGENT

constexpr int NB = 16, SEQ = 2048, DM = 1024, T = NB * SEQ;
constexpr int NPROJ = 3328;
constexpr int PC_SBQ = 0, PC_SBK = 256, PC_SBV = 512, PC_RW = 768, PC_Z = 1792, PC_XS = 2048, PC_BM = 2304, PC_CM = 2560, PC_CQ = 2816, PC_CKV = 3072, PC_KR = 3200, PC_DT = 3232;
constexpr int MEMT = 256, NMEM = NB * MEMT;
constexpr int FFD = 2816, FFE = 3584, NEXP = 8;
constexpr int MOE_ROWS = 2 * T + NEXP * 256;
constexpr int MOE_BLOCKS = MOE_ROWS / 256;
constexpr int MOE_PASS_BLOCKS = 64, MOE_PASSES = 5;
constexpr float DN_ALPHA = 1.4142135623730951f;
constexpr float LOG2E = 1.4426950408889634f;

constexpr size_t MiB = 1u << 20;
constexpr size_t WS_CTL = 0, CTL_BYTES = 1 * MiB;
constexpr int CW_BAR = 1024;
constexpr int CW_QUEUE = 8192;
constexpr int CW_MOECNT = 16384;
constexpr size_t W_BASE = CTL_BYTES;
constexpr size_t LW_WIN = 0;
constexpr size_t LW_WGATE = LW_WIN + (size_t)NPROJ * 1024 * 2;
constexpr size_t LW_WBR = LW_WGATE + (size_t)4096 * 1024 * 2;
constexpr size_t LW_WOUT = LW_WBR + (size_t)4 * 1024 * 256 * 2;
constexpr size_t LW_LORA = LW_WOUT + (size_t)1024 * 1024 * 2;
constexpr size_t LW_WUQ = LW_LORA + (size_t)768 * 256 * 2;
constexpr size_t LW_WUKV = LW_WUQ + (size_t)512 * 256 * 2;
constexpr size_t LW_WQ = LW_WUKV + (size_t)512 * 128 * 2;
constexpr size_t LW_WKV = LW_WQ + (size_t)1024 * 1024 * 2;
constexpr size_t LW_WO = LW_WKV + (size_t)2048 * 1024 * 2;
constexpr size_t LW_SIZE = LW_WO + (size_t)1024 * 1024 * 2;
constexpr size_t W_FFN13 = W_BASE + 2 * LW_SIZE;
constexpr size_t W_FFN2 = W_FFN13 + (size_t)2 * FFD * 1024 * 2;
constexpr size_t W_KMEM = W_FFN2 + (size_t)1024 * FFD * 2;
constexpr size_t W_VMEMT = W_KMEM + (size_t)2 * NMEM * 1024 * 2;
constexpr size_t W_MEMB = W_VMEMT + (size_t)2 * 1024 * NMEM * 2;
constexpr size_t W_COS = W_MEMB + (size_t)NMEM * 1024 * 2;
constexpr size_t W_SIN = W_COS + (size_t)T * 16 * 4;
constexpr size_t W_XB = W_SIN + (size_t)T * 16 * 4;
constexpr size_t W_XRES = W_XB + (size_t)T * 1024 * 2;
constexpr size_t S_BASE = W_XRES + (size_t)T * 1024 * 4;
constexpr size_t S_Y = S_BASE;
constexpr size_t S_SSQ = S_Y + (size_t)T * 1024 * 2;
constexpr size_t S_PROJ = S_SSQ + (size_t)T * 8 * 4;
constexpr size_t S_LA = S_PROJ + (size_t)T * NPROJ * 2;
constexpr size_t S_CQN = S_LA + (size_t)T * 256 * 2;
constexpr size_t S_CKVN = S_CQN + (size_t)T * 256 * 2;
constexpr size_t S_DEC = S_CKVN + (size_t)T * 128 * 2;
constexpr size_t S_AV = S_DEC + (size_t)T * 256 * 4;
constexpr size_t S_GV = S_AV + (size_t)T * 256 * 2;
constexpr size_t S_QM = S_GV + (size_t)T * 256 * 2;
constexpr size_t S_KM = S_QM + (size_t)T * 384 * 2;
constexpr size_t S_VM = S_KM + (size_t)T * 384 * 2;
constexpr size_t S_RWS = S_VM + (size_t)T * 256 * 2;
constexpr size_t S_XA = S_RWS + (size_t)5 * T * 256 * 2;
constexpr size_t S_BC = S_XA + (size_t)T * 256 * 2;
constexpr size_t S_CC = S_BC + (size_t)T * 256 * 2;
constexpr size_t S_ACS = S_CC + (size_t)T * 256 * 2;
constexpr size_t S_DTV = S_ACS + (size_t)T * 4 * 4;
constexpr size_t S_YRAW = S_DTV + (size_t)T * 4 * 4;
constexpr size_t S_MIX_END = S_YRAW + (size_t)T * 256 * 2;
constexpr size_t S_G = S_PROJ;
constexpr size_t S_MF = S_G + (size_t)T * 4096 * 2;
constexpr size_t S_MB = S_MF + (size_t)T * 1024 * 4;
constexpr size_t S_GATE_END = S_MB + (size_t)T * 1024 * 2;
constexpr size_t S_XQ = S_BASE;
constexpr size_t S_XP = S_XQ + (size_t)T * 1024 * 2;
constexpr size_t S_XO = S_XP + (size_t)T * 1024 * 2;
constexpr size_t S_H = S_BASE;
constexpr size_t S_MW13 = S_BASE;
constexpr size_t S_MW2 = S_MW13 + (size_t)NEXP * 2 * FFE * 1024 * 2;
constexpr size_t S_XS = S_MW2 + (size_t)NEXP * 1024 * FFE * 2;
constexpr size_t S_YS = S_XS + (size_t)MOE_ROWS * 1024 * 2;
constexpr size_t S_MH = S_YS + (size_t)2 * T * 1024 * 2;
constexpr size_t S_TOPI = S_MH + (size_t)MOE_PASS_BLOCKS * 256 * FFE * 2;
constexpr size_t S_TOPW = S_TOPI + (size_t)T * 2 * 4;
constexpr size_t S_ROWSLOT = S_TOPW + (size_t)T * 2 * 4;
constexpr size_t S_ROWW = S_ROWSLOT + (size_t)MOE_ROWS * 4;
constexpr size_t S_BLKE = S_ROWW + (size_t)MOE_ROWS * 4;
constexpr size_t S_MOE_END = S_BLKE + 4096;
constexpr size_t cmax(size_t a, size_t b) { return a > b ? a : b; }
constexpr size_t WS_NEED = cmax(cmax(S_MIX_END, S_GATE_END), S_MOE_END);
static_assert(WS_NEED <= (size_t)896 * MiB, "workspace map exceeds 896 MiB");
static_assert((W_BASE % 256) == 0 && (LW_SIZE % 256) == 0 && (S_BASE % 256) == 0, "alignment");

constexpr int RING_BYTES = 131072;
constexpr int XCH_OFF = RING_BYTES;
constexpr int LDSCTL_OFF = RING_BYTES + 16384;
constexpr int LDS_BYTES = LDSCTL_OFF + 512;
constexpr int NWAVES = 8, NTHREADS = 512;

typedef __bf16 bf16x2_t __attribute__((ext_vector_type(2)));
__device__ __forceinline__ unsigned cvt_pk_bf16(float lo, float hi) { bf16x2_t v = {(__bf16)lo, (__bf16)hi}; return __builtin_bit_cast(unsigned, v); }
__device__ __forceinline__ float bf2f(unsigned short b) { return __uint_as_float((unsigned)b << 16); }
__device__ __forceinline__ float bflo(unsigned w) { return __uint_as_float(w << 16); }
__device__ __forceinline__ float bfhi(unsigned w) { return __uint_as_float(w & 0xffff0000u); }
__device__ __forceinline__ float fexp2(float x) { return __builtin_amdgcn_exp2f(x); }
__device__ __forceinline__ float flog2(float x) { return __builtin_amdgcn_logf(x); }
__device__ __forceinline__ float frcp(float x) { return __builtin_amdgcn_rcpf(x); }
__device__ __forceinline__ float sigmoidf_(float x) { return frcp(1.0f + fexp2(-x * LOG2E)); }
__device__ __forceinline__ float siluf_(float x) { return x * sigmoidf_(x); }
__device__ __forceinline__ float softplusf_(float x) { return fmaxf(x, 0.f) + 0.6931471805599453f * flog2(1.0f + fexp2(-fabsf(x) * LOG2E)); }
__device__ __forceinline__ float wave_sum(float v) {
#pragma unroll
    for (int o = 1; o < 64; o <<= 1) v += __shfl_xor(v, o);
    return v;
}
#define LDS_WAIT() asm volatile("s_waitcnt lgkmcnt(0)" ::: "memory")
#define VM_WAIT() asm volatile("s_waitcnt vmcnt(0)" ::: "memory")
#define XB_TMO      128
#define XB_XCNT(j)  (256  + 64 * (j))
#define XB_XSUB(j)  (1280 + 64 * (j))
#define XB_XGEN(j)  (2304 + 64 * (j))
#define XB_TOP      3328
#define XB_TOPGEN   3392
#define XCD_BAR_WORDS 3456
#define XB_SPIN_CAP (1u << 18)

__device__ __forceinline__ unsigned xb_ld(unsigned* p)              { return __hip_atomic_load(p, __ATOMIC_RELAXED, __HIP_MEMORY_SCOPE_AGENT); }
__device__ __forceinline__ unsigned xb_add(unsigned* p, unsigned v) { return __hip_atomic_fetch_add(p, v, __ATOMIC_RELAXED, __HIP_MEMORY_SCOPE_AGENT); }
__device__ __forceinline__ unsigned xb_xcc_id() { return (unsigned)__builtin_amdgcn_s_getreg((3 << 11) | 20) & 0xFu; }
#define XB_SPIN(cond, bar) do { unsigned _sp = 0; while (cond) { __builtin_amdgcn_s_sleep(1); \
    if ((++_sp & 255u) == 0u) { if (xb_ld(&(bar)[XB_TMO])) break; if (_sp > XB_SPIN_CAP) { atomicAdd(&(bar)[XB_TMO], 1u); break; } } } } while (0)

struct XcdBarrier { unsigned* bar; unsigned x; volatile LAS unsigned* st; };

__device__ __forceinline__ XcdBarrier xcd_barrier_post(unsigned* bar, volatile LAS unsigned* st) {
    XcdBarrier b; b.bar = bar; b.x = xb_xcc_id(); b.st = st;
    if (threadIdx.x == 0) (void)xb_add(&bar[XB_XCNT(b.x)], 1u);
    return b;
}
__device__ __forceinline__ void xcd_barrier_complete(unsigned* bar, unsigned x, unsigned& nloc, unsigned& nx) {
    const unsigned G = gridDim.x * gridDim.y * gridDim.z;
    unsigned sum, cnt, mine, sp = 0u;
    for (;;) {
        sum = 0u; cnt = 0u; mine = 0u;
#pragma unroll
        for (unsigned j = 0; j < 16; ++j) { const unsigned c = xb_ld(&bar[XB_XCNT(j)]); sum += c; cnt += (c > 0u) ? 1u : 0u; mine = (j == x) ? c : mine; }
        if (sum == G) break;
        __builtin_amdgcn_s_sleep(1);
        if ((++sp & 255u) == 0u) { if (xb_ld(&bar[XB_TMO])) break; if (sp > XB_SPIN_CAP) { atomicAdd(&bar[XB_TMO], 1u); break; } }
    }
    nloc = mine > 0u ? mine : 1u; nx = cnt > 0u ? cnt : 1u;
}
__device__ __forceinline__ void xcd_barrier(const XcdBarrier& b) {
    asm volatile("s_waitcnt vmcnt(0)" ::: "memory");
    __syncthreads();
    if (threadIdx.x == 0) {
        unsigned* bar = b.bar;
        __builtin_amdgcn_s_waitcnt(0);
        unsigned nloc = b.st[0], nx = b.st[1];
        if (nloc == 0u) { xcd_barrier_complete(bar, b.x, nloc, nx); b.st[0] = nloc; b.st[1] = nx; }
        const unsigned old = xb_add(&bar[XB_XSUB(b.x)], 1u);
        const unsigned gen = old / nloc;
        if (old + 1u == (gen + 1u) * nloc) {
            __builtin_amdgcn_fence(__ATOMIC_RELEASE, "agent");
            asm volatile("s_waitcnt vmcnt(0)" ::: "memory");
            const unsigned og = xb_add(&bar[XB_TOP], 1u);
            const unsigned tg = og / nx;
            if (og + 1u == (tg + 1u) * nx) xb_add(&bar[XB_TOPGEN], 1u);
            else XB_SPIN(xb_ld(&bar[XB_TOPGEN]) == tg, bar);
            __builtin_amdgcn_fence(__ATOMIC_ACQUIRE, "agent");
            xb_add(&bar[XB_XGEN(b.x)], 1u);
            asm volatile("s_waitcnt vmcnt(0)" ::: "memory");
        } else {
            XB_SPIN(xb_ld(&bar[XB_XGEN(b.x)]) == gen, bar);
            __builtin_amdgcn_fence(__ATOMIC_ACQUIRE, "agent");
            asm volatile("s_waitcnt vmcnt(0)" ::: "memory");
        }
    }
    __syncthreads();
}

namespace pg8 {
constexpr int BM = 256, BK = 64, HALF = 128, HTB = HALF * BK * 2, STAGE_BYTES = 8 * HTB;
__host__ __device__ __forceinline__ int lds_byte(int r, int c) { const int st = (r >> 4) * 2 + (c >> 5), rr = r & 15, cc = c & 31, ob = rr * 64 + cc * 2; return st * 1024 + (ob ^ (((ob >> 9) & 1) << 5)); }
__host__ __device__ __forceinline__ void stage_rc(int b, int& R, int& C) { const int st = b / 1024, sb = b % 1024, swz = sb ^ (((sb >> 9) & 1) << 5); R = (st >> 1) * 16 + swz / 64; C = (st & 1) * 32 + (swz % 64) / 2; }
__host__ __device__ __forceinline__ int perm32(int rho) { const int n = rho >> 4, i = rho & 15; return 8 * (i >> 2) + 4 * n + (i & 3); }

struct Unit { int pm, pn; long aoff, boff; int tag; };
struct Gemm { const bf16_t* A; const bf16_t* Bt; int K, lda, ldb; };

template <class Epi, class Sched, bool ALIGN = true>
__device__ __forceinline__ void gemm_phase(LAS unsigned char* lds, const Gemm g, const Sched& S, const Epi& E) {
    int tid_ = threadIdx.x; asm volatile("" : "+v"(tid_));
    const int tid = tid_, wid = __builtin_amdgcn_readfirstlane(tid >> 6), lane = tid & 63, wr = wid >> 2, wc = wid & 3, fr = lane & 15, fq = lane >> 4;
    int K = g.K; asm volatile("" : "+s"(K)); const int nt = K / BK;
    unsigned voffA[2], voffB[2];
#pragma unroll
    for (int i = 0; i < 2; ++i) { int R, C; stage_rc(tid * 16 + i * 8192, R, C); const int Rb = Epi::PERM ? ((R & ~31) + perm32(R & 31)) : R;
        voffA[i] = (unsigned)(R * g.lda + C) * 2u; voffB[i] = (unsigned)(Rb * g.ldb + C) * 2u; }
    const size_t kstep = (size_t)(BK * 2);
    const size_t hstepA = (size_t)HALF * g.lda * 2, hstepB = (size_t)HALF * g.ldb * 2;
    const size_t tstepA = 2 * hstepA, tstepB = 2 * hstepB;
    const unsigned ldsw = (unsigned)wid * 1024u;
    const int aoff = lds_byte(wr * 64 + fr, fq * 8), boff = lds_byte(wc * 32 + fr, fq * 8);
#define PG8_SA(b, h) (((b) * 2 + (h)) * HTB)
#define PG8_SB(b, h) ((4 + (b) * 2 + (h)) * HTB)
#define PG8_STAGE(bufoff, gbase, voff) do { _Pragma("unroll") for (int _i = 0; _i < 2; ++_i) \
        __builtin_amdgcn_global_load_lds((const unsigned*)((const char*)(gbase) + (voff)[_i]), (LAS unsigned*)(lds + (bufoff) + ldsw + _i * 8192), 16, 0, 0); } while (0)
#define PG8_LDA(dst, b, h) do { _Pragma("unroll") for (int m = 0; m < 4; ++m) _Pragma("unroll") for (int k = 0; k < 2; ++k) dst[m][k] = *(const LAS bf16x8*)(lds + PG8_SA(b, h) + aoff + m * 2048 + k * 1024); } while (0)
#define PG8_LDB(dst, b, h) do { _Pragma("unroll") for (int n = 0; n < 2; ++n) _Pragma("unroll") for (int k = 0; k < 2; ++k) dst[n][k] = *(const LAS bf16x8*)(lds + PG8_SB(b, h) + boff + n * 2048 + k * 1024); } while (0)
#define PG8_MMA(ai, bj, At, Bt) do { __builtin_amdgcn_s_setprio(1); _Pragma("unroll") for (int m = 0; m < 4; ++m) _Pragma("unroll") for (int n = 0; n < 2; ++n) _Pragma("unroll") for (int k = 0; k < 2; ++k) \
        acc[ai][bj][m][n] = __builtin_amdgcn_mfma_f32_16x16x32_bf16(Bt[n][k], At[m][k], acc[ai][bj][m][n], 0, 0, 0); __builtin_amdgcn_s_setprio(0); } while (0)
#define PG8_WAIT_V(n) asm volatile("s_waitcnt vmcnt(" #n ")" ::: "memory")
#define PG8_WAIT_L(n) asm volatile("s_waitcnt lgkmcnt(" #n ")" ::: "memory")
#define PG8_BAR __builtin_amdgcn_s_barrier()
#define PG8_SCHED __builtin_amdgcn_sched_barrier(0)
    Unit cur, nxt; int ui = 0;
    if (!S.next(0, cur)) return;
    f32x4 acc[2][2][4][2];
#pragma unroll
    for (int a = 0; a < 2; ++a)
#pragma unroll
        for (int b = 0; b < 2; ++b)
#pragma unroll
            for (int m = 0; m < 4; ++m)
#pragma unroll
                for (int n = 0; n < 2; ++n) acc[a][b][m][n] = (f32x4){0.f, 0.f, 0.f, 0.f};
    bf16x8 At[4][2], B0[2][2], B1[2][2];
    const char* cA = (const char*)(g.A + cur.aoff) + (size_t)cur.pm * tstepA; const char* cB = (const char*)(g.Bt + cur.boff) + (size_t)cur.pn * tstepB;
    PG8_STAGE(PG8_SB(0, 0), cB, voffB); PG8_STAGE(PG8_SB(0, 1), cB + hstepB, voffB); PG8_STAGE(PG8_SA(0, 0), cA, voffA); PG8_STAGE(PG8_SA(0, 1), cA + hstepA, voffA);
    if (wr == 1) PG8_BAR;
    PG8_WAIT_V(2); PG8_BAR;
    PG8_STAGE(PG8_SB(1, 0), cB + kstep, voffB); PG8_STAGE(PG8_SA(1, 0), cA + kstep, voffA); PG8_STAGE(PG8_SB(1, 1), cB + hstepB + kstep, voffB);
    PG8_WAIT_V(6); PG8_BAR;
    for (;;) {
        const bool has_next = S.next(ui + 1, nxt);
        const char* nA = has_next ? (const char*)(g.A + nxt.aoff) + (size_t)nxt.pm * tstepA : cA; const char* nB = has_next ? (const char*)(g.Bt + nxt.boff) + (size_t)nxt.pn * tstepB : cB;
#pragma unroll 1
        for (int t = 0; t < nt; t += 2) {
            const bool last = (t == nt - 2);
            const char* a1 = cA + (size_t)(t + 1) * kstep;
            const char* a2 = last ? nA : cA + (size_t)(t + 2) * kstep; const char* b2 = last ? nB : cB + (size_t)(t + 2) * kstep;
            const char* a3 = a2 + kstep; const char* b3 = b2 + kstep;
            PG8_LDB(B0, 0, 0); PG8_LDB(B1, 0, 1); PG8_SCHED; PG8_LDA(At, 0, 0); PG8_STAGE(PG8_SA(1, 1), a1 + hstepA, voffA);
            PG8_WAIT_V(8); PG8_WAIT_L(0); PG8_BAR; PG8_MMA(0, 0, At, B0); PG8_MMA(0, 1, At, B1); PG8_BAR; PG8_SCHED;
            PG8_LDA(At, 0, 1); PG8_STAGE(PG8_SB(0, 0), b2, voffB); PG8_STAGE(PG8_SB(0, 1), b2 + hstepB, voffB); PG8_STAGE(PG8_SA(0, 0), a2, voffA);
            PG8_WAIT_V(8); PG8_WAIT_L(0); PG8_BAR; PG8_MMA(1, 0, At, B0); PG8_MMA(1, 1, At, B1); PG8_BAR; PG8_SCHED;
            PG8_LDB(B0, 1, 0); PG8_LDB(B1, 1, 1); PG8_SCHED; PG8_LDA(At, 1, 0); PG8_STAGE(PG8_SA(0, 1), a2 + hstepA, voffA);
            PG8_WAIT_V(8); PG8_WAIT_L(0); PG8_BAR; PG8_MMA(0, 0, At, B0); PG8_MMA(0, 1, At, B1); PG8_BAR; PG8_SCHED;
            PG8_LDA(At, 1, 1); PG8_STAGE(PG8_SB(1, 0), b3, voffB); PG8_STAGE(PG8_SB(1, 1), b3 + hstepB, voffB); PG8_STAGE(PG8_SA(1, 0), a3, voffA);
            PG8_WAIT_V(8); PG8_WAIT_L(0); PG8_BAR; PG8_MMA(1, 0, At, B0); PG8_MMA(1, 1, At, B1); PG8_BAR; PG8_SCHED;
        }
        if constexpr (ALIGN) { if (wr == 0) PG8_BAR; }
        E(acc, cur, wr, wc, fr, fq, wid, lane);
        if (!has_next) break;
#pragma unroll
        for (int a = 0; a < 2; ++a)
#pragma unroll
            for (int b = 0; b < 2; ++b)
#pragma unroll
                for (int m = 0; m < 4; ++m)
#pragma unroll
                    for (int n = 0; n < 2; ++n) acc[a][b][m][n] = (f32x4){0.f, 0.f, 0.f, 0.f};
        cur = nxt; cA = nA; cB = nB; ++ui;
        if constexpr (ALIGN) { if (wr == 1) PG8_BAR; }
    }
    PG8_WAIT_V(0);
    if constexpr (!ALIGN) { if (wr == 0) PG8_BAR; }
    PG8_BAR;
#undef PG8_SA
#undef PG8_SB
#undef PG8_STAGE
#undef PG8_LDA
#undef PG8_LDB
#undef PG8_MMA
#undef PG8_WAIT_V
#undef PG8_WAIT_L
#undef PG8_BAR
#undef PG8_SCHED
}
}
namespace sch {
using pg8::Unit;
__device__ __forceinline__ void tile_of(int L, int nM, int nN, int& pm, int& pn) {
    const int nwg = nM * nN; int wgid = L;
    { const int q = nwg / 8, r = nwg % 8, xcd = wgid % 8, off = wgid / 8; wgid = (xcd < r ? xcd * (q + 1) : r * (q + 1) + (xcd - r) * q) + off; }
    const int nig = 8 * nN, gid = wgid / nig, fm = gid * 8, gsz = (nM - fm) < 8 ? (nM - fm) : 8;
    pm = fm + ((wgid % nig) % gsz); pn = (wgid % nig) / gsz;
}
struct Tiles {
    int nM, nN, G, c;
    __device__ __forceinline__ bool next(int i, Unit& u) const {
        const long L = (long)i * G + c; if (L >= (long)nM * nN) return false;
        tile_of((int)L, nM, nN, u.pm, u.pn); u.aoff = 0; u.boff = 0; u.tag = 0; return true; }
};
struct BrTiles {
    int nM, nN, G, c;
    __device__ __forceinline__ bool next(int i, Unit& u) const {
        const long L = (long)(i >> 2) * G + c; if (L >= (long)nM * nN) return false;
        tile_of((int)L, nM, nN, u.pm, u.pn); const int br = i & 3; u.aoff = br * 256; u.boff = (long)br * 1024 * 256; u.tag = br; return true; }
};
struct MemKV {
    long offMem, offWkv; int c;
    __device__ __forceinline__ bool next(int i, Unit& u) const {
        if (i > 0 || c < 128) return false; const int idx = c - 128;
        if (idx < 64) { u.pm = idx >> 2; u.pn = idx & 3; u.aoff = offMem; u.boff = offWkv; u.tag = 0; }
        else { const int j = idx - 64; u.pm = j >> 4; u.pn = j & 15; u.aoff = offWkv + (long)1024 * 1024; u.boff = offMem; u.tag = 1; }
        return true; }
};
struct XaS {
    int G, c;
    __device__ __forceinline__ bool next(int i, Unit& u) const {
        const int L = i * G + c; if (L >= 512) return false;
        const int b = L >> 5, h = (L >> 3) & 3, rb = L & 7; u.pm = b * 8 + rb; u.pn = b; u.aoff = h * 256; u.boff = h * 256; u.tag = h; return true; }
};
struct XaPV {
    int G, c;
    __device__ __forceinline__ bool next(int i, Unit& u) const {
        const int L = i * G + c; if (L >= 512) return false;
        const int b = L >> 5, h = (L >> 3) & 3, rb = L & 7; u.pm = b * 8 + rb; u.pn = h; u.aoff = h * 256; u.boff = b * 256; u.tag = h; return true; }
};
struct MoeUp {
    const int* blk_e; int b0, b1, G, c;
    __device__ __forceinline__ bool next(int i, Unit& u) const {
        const int L = i * G + c; const int nb = b1 - b0; if (L >= nb * 28) return false;
        const int rb = b0 + L / 28; u.pn = L % 28; u.pm = rb;
        const int e = __builtin_amdgcn_readfirstlane(__hip_atomic_load(blk_e + rb, RLX_AGENT));
        u.aoff = 0; u.boff = (long)e * (2 * FFE) * 1024; u.tag = rb - b0; return true; }
};
struct MoeDown {
    const int* blk_e; int b0, b1, G, c;
    __device__ __forceinline__ bool next(int i, Unit& u) const {
        const int L = i * G + c; const int nb = b1 - b0; if (L >= nb * 4) return false;
        const int rb = b0 + L / 4; u.pn = L % 4; u.pm = rb - b0;
        const int e = __builtin_amdgcn_readfirstlane(__hip_atomic_load(blk_e + rb, RLX_AGENT));
        u.aoff = 0; u.boff = (long)e * 1024 * FFE; u.tag = rb; return true; }
};
}

namespace epi {
using pg8::Unit;
#define EPI_SIG f32x4 (&acc)[2][2][4][2], const Unit& u, int wr, int wc, int fr, int fq, int wid, int lane
#define EPI_ROWS _Pragma("unroll") for (int ai = 0; ai < 2; ++ai) _Pragma("unroll") for (int m = 0; m < 4; ++m)
#define EPI_ROW (u.pm * 256 + ai * 128 + wr * 64 + m * 16 + fr)
#define EPI_BJ _Pragma("unroll") for (int bj = 0; bj < 2; ++bj)
#define EPI_FENCE asm volatile("" ::: "memory")
__device__ __forceinline__ u32x4 pack8(const f32x4 a, const f32x4 b) { u32x4 w; w.x = cvt_pk_bf16(a[0], a[1]); w.y = cvt_pk_bf16(a[2], a[3]); w.z = cvt_pk_bf16(b[0], b[1]); w.w = cvt_pk_bf16(b[2], b[3]); return w; }

template <int ACT> struct StoreBf16 {
    static constexpr bool PERM = true;
    bf16_t* O; int ldc;
    __device__ __forceinline__ void operator()(EPI_SIG) const {
        EPI_ROWS { bf16_t* rowp = O + (size_t)EPI_ROW * ldc + u.pn * 256 + wc * 32 + 8 * fq;
            EPI_BJ { f32x4 v0 = acc[ai][bj][m][0], v1 = acc[ai][bj][m][1];
                if (ACT == 1) { for (int j = 0; j < 4; ++j) { v0[j] = sigmoidf_(v0[j]); v1[j] = sigmoidf_(v1[j]); } }
                *(u32x4*)(rowp + bj * 128) = pack8(v0, v1); } EPI_FENCE; }
    }
};
struct StoreKV {
    static constexpr bool PERM = true;
    bf16_t* K; bf16_t* Vt;
    __device__ __forceinline__ void operator()(EPI_SIG) const {
        bf16_t* O = u.tag ? Vt : K; const int ldc = u.tag ? NMEM : 1024;
        EPI_ROWS { bf16_t* rowp = O + (size_t)EPI_ROW * ldc + u.pn * 256 + wc * 32 + 8 * fq;
            EPI_BJ { *(u32x4*)(rowp + bj * 128) = pack8(acc[ai][bj][m][0], acc[ai][bj][m][1]); } EPI_FENCE; }
    }
};
struct Lora {
    static constexpr bool PERM = true;
    float* dec; bf16_t* av; bf16_t* gv; const float* w0; const float* a0;
    __device__ __forceinline__ void operator()(EPI_SIG) const {
        EPI_ROWS { const size_t row = EPI_ROW;
            EPI_BJ { const int col = bj * 128 + wc * 32 + 8 * fq; f32x4 v0 = acc[ai][bj][m][0], v1 = acc[ai][bj][m][1];
                if (u.pn == 0) {
                    const f32x4 b0 = *(const f32x4*)(w0 + col), b1 = *(const f32x4*)(w0 + col + 4);
                    for (int j = 0; j < 4; ++j) { float x = v0[j] + b0[j]; float wl = -softplusf_(-x) - 0.5f; v0[j] = fexp2(-fexp2(wl * LOG2E) * LOG2E);
                                                  x = v1[j] + b1[j]; wl = -softplusf_(-x) - 0.5f; v1[j] = fexp2(-fexp2(wl * LOG2E) * LOG2E); }
                    *(f32x4*)(dec + row * 256 + col) = v0; *(f32x4*)(dec + row * 256 + col + 4) = v1;
                } else if (u.pn == 1) {
                    const f32x4 b0 = *(const f32x4*)(a0 + col), b1 = *(const f32x4*)(a0 + col + 4);
                    for (int j = 0; j < 4; ++j) { v0[j] = sigmoidf_(v0[j] + b0[j]); v1[j] = sigmoidf_(v1[j] + b1[j]); }
                    *(u32x4*)(av + row * 256 + col) = pack8(v0, v1);
                } else { *(u32x4*)(gv + row * 256 + col) = pack8(v0, v1); } } EPI_FENCE; }
    }
};
struct Uq {
    static constexpr bool PERM = false;
    bf16_t* Q; const float* cosT; const float* sinT;
    __device__ __forceinline__ void operator()(EPI_SIG) const {
        EPI_ROWS { const size_t row = EPI_ROW;
            EPI_BJ { const int c32 = u.pn * 256 + bj * 128 + wc * 32; if (c32 >= 384) continue;
                f32x4 v0 = acc[ai][bj][m][0], v1 = acc[ai][bj][m][1];
                if ((c32 >> 5) % 3 == 2) {
                    const f32x4 cs = *(const f32x4*)(cosT + row * 16 + 4 * fq), sn = *(const f32x4*)(sinT + row * 16 + 4 * fq);
                    const f32x4 o0 = v0 * cs - v1 * sn, o1 = v0 * sn + v1 * cs; v0 = o0; v1 = o1; }
                u32x2 w0, w1; w0.x = cvt_pk_bf16(v0[0], v0[1]); w0.y = cvt_pk_bf16(v0[2], v0[3]); w1.x = cvt_pk_bf16(v1[0], v1[1]); w1.y = cvt_pk_bf16(v1[2], v1[3]);
                *(u32x2*)(Q + row * 384 + c32 + 4 * fq) = w0; *(u32x2*)(Q + row * 384 + c32 + 16 + 4 * fq) = w1; } EPI_FENCE; }
    }
};
struct Ukv {
    static constexpr bool PERM = true;
    bf16_t* Km; bf16_t* Vm;
    __device__ __forceinline__ void operator()(EPI_SIG) const {
        EPI_ROWS { const size_t row = EPI_ROW;
            EPI_BJ { const int col = u.pn * 256 + bj * 128 + wc * 32 + 8 * fq; const int h = col >> 7, j = col & 127;
                const u32x4 w = pack8(acc[ai][bj][m][0], acc[ai][bj][m][1]);
                if (j < 64) *(u32x4*)(Km + row * 384 + h * 96 + j) = w; else *(u32x4*)(Vm + row * 256 + h * 64 + (j - 64)) = w; } EPI_FENCE; }
    }
};
struct Resid {
    static constexpr bool PERM = false;
    const float* res; float* out; float ascale;
    __device__ __forceinline__ void operator()(EPI_SIG) const {
        EPI_ROWS { const size_t off = (size_t)EPI_ROW * 1024 + u.pn * 256 + wc * 32 + 4 * fq;
            EPI_BJ { _Pragma("unroll") for (int n = 0; n < 2; ++n) { const size_t o = off + bj * 128 + n * 16; const f32x4 r = *(const f32x4*)(res + o); *(f32x4*)(out + o) = r * DN_ALPHA + acc[ai][bj][m][n] * ascale; } } EPI_FENCE; }
    }
};
struct Swiglu {
    static constexpr bool PERM = false;
    bf16_t* H; int ldh; int use_tag;
    __device__ __forceinline__ void operator()(EPI_SIG) const {
        const int pmo = use_tag ? u.tag : u.pm;
        EPI_ROWS { const size_t row = (size_t)(pmo * 256 + ai * 128 + wr * 64 + m * 16 + fr);
            EPI_BJ { const int hc = (u.pn * 256 + bj * 128 + wc * 32) / 2 + 4 * fq; const f32x4 g = acc[ai][bj][m][0], up = acc[ai][bj][m][1];
                u32x2 w; w.x = cvt_pk_bf16(siluf_(g[0]) * up[0], siluf_(g[1]) * up[1]); w.y = cvt_pk_bf16(siluf_(g[2]) * up[2], siluf_(g[3]) * up[3]);
                *(u32x2*)(H + row * ldh + hc) = w; } EPI_FENCE; }
    }
};
struct BrGate {
    static constexpr bool PERM = true;
    const bf16_t* G; float* mf; bf16_t* mb;
    __device__ __forceinline__ void operator()(EPI_SIG) const {
        const int br = u.tag;
#ifdef ABL_BR
        const float ablk = ((ABL_BR >> br) & 1) ? 0.f : 1.f;
#else
        const float ablk = 1.f;
#endif
        EPI_ROWS { const size_t row = EPI_ROW;
            EPI_BJ { const int col = u.pn * 256 + bj * 128 + wc * 32 + 8 * fq;
#ifdef G_SYS_LOAD
                u32x4 gw; { const unsigned long long* gp_ = (const unsigned long long*)(G + row * 4096 + br * 1024 + col); const unsigned long long q0 = __hip_atomic_load(gp_, __ATOMIC_RELAXED, __HIP_MEMORY_SCOPE_SYSTEM), q1 = __hip_atomic_load(gp_ + 1, __ATOMIC_RELAXED, __HIP_MEMORY_SCOPE_SYSTEM); gw.x = (unsigned)q0; gw.y = (unsigned)(q0 >> 32); gw.z = (unsigned)q1; gw.w = (unsigned)(q1 >> 32); }
#else
                const u32x4 gw = *(const u32x4*)(G + row * 4096 + br * 1024 + col);
#endif
                f32x4 v0 = acc[ai][bj][m][0] * ablk, v1 = acc[ai][bj][m][1] * ablk;
#if defined(GATE_ACT) && GATE_ACT == 0
#define GSIG(x) sigmoidf_(x)
#else
#define GSIG(x) (x)
#endif
                v0[0] *= GSIG(bflo(gw.x)); v0[1] *= GSIG(bfhi(gw.x)); v0[2] *= GSIG(bflo(gw.y)); v0[3] *= GSIG(bfhi(gw.y));
                v1[0] *= GSIG(bflo(gw.z)); v1[1] *= GSIG(bfhi(gw.z)); v1[2] *= GSIG(bflo(gw.w)); v1[3] *= GSIG(bfhi(gw.w));
                bf16_t* p = mb + row * 1024 + col;
                if (br > 0) { const u32x4 pw = *(const u32x4*)p; v0[0] += bflo(pw.x); v0[1] += bfhi(pw.x); v0[2] += bflo(pw.y); v0[3] += bfhi(pw.y); v1[0] += bflo(pw.z); v1[1] += bfhi(pw.z); v1[2] += bflo(pw.w); v1[3] += bfhi(pw.w); }
                *(u32x4*)p = pack8(v0, v1); } EPI_FENCE; }
    }
};
struct MoeDown {
    static constexpr bool PERM = true;
    const int* row_slot; const float* row_w; bf16_t* ys;
    __device__ __forceinline__ void operator()(EPI_SIG) const {
        EPI_ROWS { const int r = u.tag * 256 + ai * 128 + wr * 64 + m * 16 + fr;
            const int slot = __hip_atomic_load(row_slot + r, RLX_AGENT); const float w = __hip_atomic_load(row_w + r, RLX_AGENT);
            if (slot >= 0) { EPI_BJ { const int col = u.pn * 256 + bj * 128 + wc * 32 + 8 * fq;
                *(u32x4*)(ys + (size_t)slot * 1024 + col) = pack8(acc[ai][bj][m][0] * w, acc[ai][bj][m][1] * w); } } EPI_FENCE; }
    }
};
struct Softmax {
    static constexpr bool PERM = true;
    bf16_t* P; LAS float* xch;
    __device__ __forceinline__ void operator()(EPI_SIG) const {
        EPI_ROWS { float v = -3.0e38f;
            EPI_BJ { const f32x4 a = acc[ai][bj][m][0], b = acc[ai][bj][m][1]; v = fmaxf(v, fmaxf(fmaxf(fmaxf(a[0], a[1]), fmaxf(a[2], a[3])), fmaxf(fmaxf(b[0], b[1]), fmaxf(b[2], b[3])))); }
            v = fmaxf(v, __shfl_xor(v, 16)); v = fmaxf(v, __shfl_xor(v, 32));
            if (fq == 0) xch[(ai * 128 + wr * 64 + m * 16 + fr) * 4 + wc] = v; }
        LDS_WAIT(); __builtin_amdgcn_s_barrier(); asm volatile("" ::: "memory");
        EPI_ROWS { const f32x4 q = *(const LAS f32x4*)(xch + (ai * 128 + wr * 64 + m * 16 + fr) * 4);
            const float mm = fmaxf(fmaxf(q[0], q[1]), fmaxf(q[2], q[3])); float s = 0.f;
            EPI_BJ { _Pragma("unroll") for (int n = 0; n < 2; ++n) { f32x4 t = acc[ai][bj][m][n]; for (int j = 0; j < 4; ++j) { t[j] = fexp2(t[j] - mm); s += t[j]; } acc[ai][bj][m][n] = t; } }
            s += __shfl_xor(s, 16); s += __shfl_xor(s, 32);
            if (fq == 0) xch[1024 + (ai * 128 + wr * 64 + m * 16 + fr) * 4 + wc] = s; }
        LDS_WAIT(); __builtin_amdgcn_s_barrier(); asm volatile("" ::: "memory");
        EPI_ROWS { const f32x4 q = *(const LAS f32x4*)(xch + 1024 + (ai * 128 + wr * 64 + m * 16 + fr) * 4);
            const float inv = frcp((q[0] + q[1]) + (q[2] + q[3]));
            bf16_t* rowp = P + (size_t)EPI_ROW * 1024 + u.tag * 256 + wc * 32 + 8 * fq;
            EPI_BJ { *(u32x4*)(rowp + bj * 128) = pack8(acc[ai][bj][m][0] * inv, acc[ai][bj][m][1] * inv); } EPI_FENCE; }
        LDS_WAIT(); __builtin_amdgcn_s_barrier(); asm volatile("" ::: "memory");
    }
};
}
struct Args { const float* in[42]; float* out; unsigned char* ws; int ph_lo, ph_hi; };
struct Ctx {
    const float* const* in; float* out; unsigned char* ws; LAS unsigned char* lds;
    int tid, lane, wave, G, bid;
};
enum { I_X = 0, I_MEM, I_POS, I_WIN, I_RWMU, I_RWW0, I_RWWUP, I_RWA0, I_RWAUP, I_RWGUP, I_RWKK, I_RWKA, I_RWRK, I_RWGNG, I_RWGNB,
       I_CONVW, I_CONVB, I_DTB, I_ALOG, I_SSDD, I_SSDNG, I_QNG, I_WUQ, I_KVNG, I_WUKV, I_WBR, I_WGATE, I_WOUT, I_LN1G, I_LN1B,
       I_XWQ, I_XWKV, I_XWO, I_LN2G, I_LN2B, I_FFN13, I_FFN2, I_ROUTER, I_MOE13, I_MOE2, I_LN3G, I_LN3B };
__device__ __forceinline__ Ctx launder(const Ctx& C0) {
    Ctx L = C0; float* out_ = C0.out; unsigned char* ws_ = C0.ws; int t_ = threadIdx.x;
    asm volatile("" : "+s"(out_), "+s"(ws_), "+v"(t_));
    L.out = out_; L.ws = ws_; L.tid = t_; L.lane = t_ & 63; L.wave = __builtin_amdgcn_readfirstlane(t_ >> 6); return L;
}
#define WSP(T_, off) ((T_*)(C.ws + (off)))
#define GW (C.bid * NWAVES + C.wave)
#define NGW (C.G * NWAVES)

struct TJob { const float* W; int ldw, K, N; bf16_t* WT; int ldt; int map; float scale; int items; };
__device__ __forceinline__ int tj_items(int K, int N) { return (K / 64) * ((N + 31) / 32); }
__device__ __forceinline__ int tj_dest(int map, int n, int N) {
    if (map == 0) return n;
    if (map == 1) return n < 2816 ? n : (n < 2820 ? PC_DT + (n - 2816) : n - 4);
    const int half = N >> 1, j = n < half ? n : n - half;
    return (j >> 4) * 32 + (j & 15) + (n < half ? 0 : 16);
}
__device__ __forceinline__ void transpose_item(const TJob& J, LAS float* scr, int item, int lane) {
    const int nblk = (J.N + 31) / 32, kb = item / nblk, nb = item % nblk, k0 = 64 * kb, n0 = 32 * nb;
    const int nn = n0 + (lane & 31); const bool okn = nn < J.N;
#pragma unroll 8
    for (int i = 0; i < 32; ++i) { const int kk = 2 * i + (lane >> 5); scr[kk * 33 + (lane & 31)] = okn ? J.W[(size_t)(k0 + kk) * J.ldw + nn] : 0.f; }
    LDS_WAIT(); asm volatile("" ::: "memory");
    const int c = lane & 7;
#pragma unroll
    for (int j = 0; j < 4; ++j) { const int nl = (lane >> 3) + 8 * j, n = n0 + nl;
        if (n < J.N) { const LAS float* s = scr + (8 * c) * 33 + nl; const float sc = (J.map == 1 && n >= 256) ? 1.0f : J.scale;
            u32x4 o; o.x = cvt_pk_bf16(s[0 * 33] * sc, s[1 * 33] * sc); o.y = cvt_pk_bf16(s[2 * 33] * sc, s[3 * 33] * sc); o.z = cvt_pk_bf16(s[4 * 33] * sc, s[5 * 33] * sc); o.w = cvt_pk_bf16(s[6 * 33] * sc, s[7 * 33] * sc);
            *(u32x4*)(J.WT + (size_t)tj_dest(J.map, n, J.N) * J.ldt + k0 + 8 * c) = o; } }
    LDS_WAIT(); asm volatile("" ::: "memory");
}
__device__ __forceinline__ TJob mkjob(const float* W, int ldw, int K, int N, bf16_t* WT, int ldt, int map, float scale) { TJob j; j.W = W; j.ldw = ldw; j.K = K; j.N = N; j.WT = WT; j.ldt = ldt; j.map = map; j.scale = scale; j.items = tj_items(K, N); return j; }

__device__ __forceinline__ TJob prologue_job(const Ctx& C, int j) {
    if (j < 26) { const int l = j / 13, r = j % 13; unsigned char* LW = C.ws + W_BASE + (size_t)l * LW_SIZE;
        if (r == 0) return mkjob(C.in[I_WIN] + (size_t)l * 1024 * 3236, 3236, 1024, 3236, (bf16_t*)(LW + LW_WIN), 1024, 1, 0.125f * LOG2E);
        if (r < 5) { const int i = r - 1; return mkjob(C.in[I_WGATE] + ((size_t)l * 4 + i) * 1024 * 1024, 1024, 1024, 1024, (bf16_t*)(LW + LW_WGATE) + (size_t)i * 1024 * 1024, 1024, 0, 1.f); }
        if (r < 9) { const int i = r - 5; return mkjob(C.in[I_WBR] + ((size_t)l * 4 + i) * 256 * 1024, 1024, 256, 1024, (bf16_t*)(LW + LW_WBR) + (size_t)i * 1024 * 256, 256, 0, 1.f); }
        if (r == 9) return mkjob(C.in[I_WOUT] + (size_t)l * 1024 * 1024, 1024, 1024, 1024, (bf16_t*)(LW + LW_WOUT), 1024, 0, 1.f);
        if (r == 10) return mkjob(C.in[I_XWQ] + (size_t)l * 1024 * 1024, 1024, 1024, 1024, (bf16_t*)(LW + LW_WQ), 1024, 0, 0.0625f * LOG2E);
        if (r == 11) return mkjob(C.in[I_XWKV] + (size_t)l * 1024 * 2048, 2048, 1024, 2048, (bf16_t*)(LW + LW_WKV), 1024, 0, 1.f);
        return mkjob(C.in[I_XWO] + (size_t)l * 1024 * 1024, 1024, 1024, 1024, (bf16_t*)(LW + LW_WO), 1024, 0, 1.f);
    }
    if (j == 26) return mkjob(C.in[I_FFN13], 2 * FFD, 1024, 2 * FFD, WSP(bf16_t, W_FFN13), 1024, 2, 1.f);
    return mkjob(C.in[I_FFN2], 1024, FFD, 1024, WSP(bf16_t, W_FFN2), FFD, 0, 1.f);
}
__device__ __forceinline__ TJob moe_job(const Ctx& C, int j) {
    if (j < 8) return mkjob(C.in[I_MOE13] + (size_t)j * 1024 * 2 * FFE, 2 * FFE, 1024, 2 * FFE, WSP(bf16_t, S_MW13) + (size_t)j * 2 * FFE * 1024, 1024, 2, 1.f);
    const int e = j - 8; return mkjob(C.in[I_MOE2] + (size_t)e * FFE * 1024, 1024, FFE, 1024, WSP(bf16_t, S_MW2) + (size_t)e * 1024 * FFE, FFE, 0, 1.f);
}
template <int NJ, bool MOE> __device__ __forceinline__ void run_tjobs(const Ctx& C) {
    LAS float* scr = (LAS float*)(C.lds + C.wave * 16384);
    int total = 0;
    for (int j = 0; j < NJ; ++j) { const TJob J = MOE ? moe_job(C, j) : prologue_job(C, j); total += J.items; }
    int j = 0, jbase = 0; TJob J = MOE ? moe_job(C, 0) : prologue_job(C, 0);
    for (int it = GW; it < total; it += NGW) {
        while (it >= jbase + J.items) { jbase += J.items; ++j; J = MOE ? moe_job(C, j) : prologue_job(C, j); }
        transpose_item(J, scr, it - jbase, C.lane);
    }
}


constexpr int CW_CHK = 32768;
template <class OutF> __device__ __forceinline__ void chk_gemm(const Ctx& C, const bf16_t* A, int lda, const bf16_t* Bt, int ldb, int K, int nrows, int ncs, int cstride, int c0, int bit, OutF expect_vs_got) {
    unsigned bad = 0; const int lane = C.lane;
    for (int it = GW; it < nrows * ncs; it += NGW) {
        const int r = it / ncs, c = c0 + (it % ncs) * cstride; float d = 0.f;
        for (int k = lane * 8; k < K; k += 512) { const u32x4 a = *(const u32x4*)(A + (size_t)r * lda + k), b = *(const u32x4*)(Bt + (size_t)c * ldb + k);
            d += bflo(a.x) * bflo(b.x) + bfhi(a.x) * bfhi(b.x) + bflo(a.y) * bflo(b.y) + bfhi(a.y) * bfhi(b.y) + bflo(a.z) * bflo(b.z) + bfhi(a.z) * bfhi(b.z) + bflo(a.w) * bflo(b.w) + bfhi(a.w) * bfhi(b.w); }
        d = wave_sum(d);
        if (!expect_vs_got(r, c, d)) bad = 1;
    }
    if (lane == 0 && bad) __hip_atomic_fetch_add((unsigned*)(C.ws + WS_CTL) + CW_CHK + 64 * bit, 1u, RLX_AGENT);
}
__device__ __forceinline__ bool chk_close(float e, float g) { return fabsf(e - g) <= 0.03f * fabsf(e) + 0.03f; }

__device__ __forceinline__ float chk_dot(const bf16_t* a, const bf16_t* b, int K, int lane) {
    float d = 0.f;
    for (int k = lane * 8; k < K; k += 512) { const u32x4 x = *(const u32x4*)(a + k), y = *(const u32x4*)(b + k);
        d += bflo(x.x) * bflo(y.x) + bfhi(x.x) * bfhi(y.x) + bflo(x.y) * bflo(y.y) + bfhi(x.y) * bfhi(y.y) + bflo(x.z) * bflo(y.z) + bfhi(x.z) * bfhi(y.z) + bflo(x.w) * bflo(y.w) + bfhi(x.w) * bfhi(y.w); }
    return wave_sum(d);
}
__device__ __forceinline__ void chk_flag(const Ctx& C, int bit, unsigned bad) { if (C.lane == 0 && bad) __hip_atomic_fetch_add((unsigned*)(C.ws + WS_CTL) + CW_CHK + 64 * bit, 1u, RLX_AGENT); }
__device__ __forceinline__ void chk_merged(const Ctx& C, int l, int bit) {
    const bf16_t* Y = WSP(bf16_t, S_Y); const bf16_t* G = WSP(bf16_t, S_G); const bf16_t* MB = WSP(bf16_t, S_MB); const bf16_t* WBR = (const bf16_t*)(C.ws + W_BASE + (size_t)l * LW_SIZE + LW_WBR); unsigned bad = 0;
    for (int it = GW; it < T * 4; it += NGW) { const int r = it >> 2, c = 13 + 256 * (it & 3); float e = 0.f;
        for (int i = 0; i < 4; ++i) e += bf2f(G[(size_t)r * 4096 + i * 1024 + c]) * chk_dot(Y + (size_t)r * 1024 + 256 * i, WBR + ((size_t)i * 1024 + c) * 256, 256, C.lane);
        if (!chk_close(e, bf2f(MB[(size_t)r * 1024 + c]))) bad = 1; }
    chk_flag(C, bit, bad);
}
__device__ __forceinline__ void chk_swiglu(const Ctx& C, int bit) {
    const bf16_t* XB = WSP(bf16_t, W_XB); const bf16_t* W = WSP(bf16_t, W_FFN13); const bf16_t* H = WSP(bf16_t, S_H); unsigned bad = 0;
    for (int it = GW; it < T * 22; it += NGW) { const int r = it / 22, hc = 5 + 128 * (it % 22); const int grow = (hc >> 4) * 32 + (hc & 15);
        const float g = chk_dot(XB + (size_t)r * 1024, W + (size_t)grow * 1024, 1024, C.lane), u = chk_dot(XB + (size_t)r * 1024, W + (size_t)(grow + 16) * 1024, 1024, C.lane);
        if (!chk_close(siluf_(g) * u, bf2f(H[(size_t)r * FFD + hc]))) bad = 1; }
    chk_flag(C, bit, bad);
}

constexpr size_t S_CHKBUF = S_BASE + (size_t)400 * MiB;
__device__ __forceinline__ void chk_resid_stash(const Ctx& C, const bf16_t* A, int lda, const bf16_t* Bt, int ldb, int K, int slot) {
    const float* XR = WSP(float, W_XRES); float* CB = WSP(float, S_CHKBUF);
    for (int it = GW; it < T * 4; it += NGW) { const int r = it >> 2, q = it & 3, c = 17 + 256 * q; const float d = chk_dot(A + (size_t)r * lda, Bt + (size_t)c * ldb, K, C.lane);
        if (C.lane == 0) CB[(size_t)r * 8 + slot * 4 + q] = XR[(size_t)r * 1024 + c] * DN_ALPHA + d; }
}
__device__ __forceinline__ void chk_resid_cmp(const Ctx& C, int slot, int bit) {
    const float* XR = WSP(float, W_XRES); const float* CB = WSP(float, S_CHKBUF); unsigned bad = 0;
    for (int it = GW; it < T * 4; it += NGW) { const int r = it >> 2, q = it & 3, c = 17 + 256 * q; if (!chk_close(CB[(size_t)r * 8 + slot * 4 + q], XR[(size_t)r * 1024 + c])) bad = 1; }
    chk_flag(C, bit, bad);
}
__device__ __forceinline__ void chk_ln_stash(const Ctx& C, const float* g, const float* b, int slot) {
    const float* XR = WSP(float, W_XRES); float* CB = WSP(float, S_CHKBUF); const int lane = C.lane;
    for (int t = GW; t < T; t += NGW) { float s = 0.f, s2 = 0.f; float v[16];
        for (int j = 0; j < 16; ++j) { v[j] = XR[(size_t)t * 1024 + lane + 64 * j]; s += v[j]; }
        const float mean = wave_sum(s) * (1.0f / 1024.0f); for (int j = 0; j < 16; ++j) { const float d = v[j] - mean; s2 += d * d; }
        const float rstd = 1.0f / sqrtf(wave_sum(s2) * (1.0f / 1024.0f) + 1e-5f);
        if (lane < 4) { const int c = 17 + 256 * lane; CB[(size_t)t * 8 + slot * 4 + lane] = (XR[(size_t)t * 1024 + c] - mean) * rstd * g[c] + b[c]; } }
}
__device__ __forceinline__ void chk_ln_cmp(const Ctx& C, int slot, int bit) {
    const float* XR = WSP(float, W_XRES); const bf16_t* XB = WSP(bf16_t, W_XB); const float* CB = WSP(float, S_CHKBUF); unsigned bad = 0;
    for (int it = GW; it < T * 4; it += NGW) { const int r = it >> 2, q = it & 3, c = 17 + 256 * q; const float e = CB[(size_t)r * 8 + slot * 4 + q];
        if (!chk_close(e, XR[(size_t)r * 1024 + c]) || !chk_close(e, bf2f(XB[(size_t)r * 1024 + c]))) bad = 1; }
    chk_flag(C, bit, bad);
}

template <int NJ, bool MOE> __device__ __forceinline__ void chk_weights(const Ctx& C, int bit) {
    unsigned bad = 0; const int gt = C.bid * NTHREADS + C.tid, NT = C.G * NTHREADS;
    for (int j = 0; j < NJ; ++j) { const TJob J = MOE ? moe_job(C, j) : prologue_job(C, j);
        for (size_t i = gt; i < (size_t)J.K * J.N; i += NT) { const int k = (int)(i / J.N), n = (int)(i % J.N);
            const float sc = (J.map == 1 && n >= 256) ? 1.0f : J.scale; const bf16_t e = (bf16_t)(cvt_pk_bf16(J.W[(size_t)k * J.ldw + n] * sc, 0.f) & 0xffffu);
            if (J.WT[(size_t)tj_dest(J.map, n, J.N) * J.ldt + k] != e) bad = 1; } }
    if (bad) __hip_atomic_fetch_add((unsigned*)(C.ws + WS_CTL) + CW_CHK + 64 * bit, 1u, RLX_AGENT);
}

__device__ __forceinline__ void chk_mla_inputs(const Ctx& C, int l, int bit) {
    const bf16_t* proj = WSP(bf16_t, S_PROJ); const bf16_t* QM = WSP(bf16_t, S_QM); const bf16_t* KM = WSP(bf16_t, S_KM); const bf16_t* VM = WSP(bf16_t, S_VM);
    const float* wuq = C.in[I_WUQ] + (size_t)l * 256 * 384; const float* wukv = C.in[I_WUKV] + (size_t)l * 128 * 512; const float* qg = C.in[I_QNG] + l * 256; const float* kvg = C.in[I_KVNG] + l * 128;
    const int* pos = (const int*)C.in[I_POS]; const int lane = C.lane; unsigned bad = 0; const float qs = 0.10206207261596575f * LOG2E;
    for (int t = GW; t < T; t += NGW) {
        const bf16_t* pr = proj + (size_t)t * NPROJ; float cq[4], ck[2]; float ss = 0.f;
        for (int i = 0; i < 4; ++i) { cq[i] = bf2f(pr[PC_CQ + lane + 64 * i]); ss += cq[i] * cq[i]; }
        float rs = 1.0f / sqrtf(wave_sum(ss) * (1.0f / 256.0f) + 1e-6f); for (int i = 0; i < 4; ++i) cq[i] *= rs * qg[lane + 64 * i];
        ss = 0.f; for (int i = 0; i < 2; ++i) { ck[i] = bf2f(pr[PC_CKV + lane + 64 * i]); ss += ck[i] * ck[i]; }
        rs = 1.0f / sqrtf(wave_sum(ss) * (1.0f / 128.0f) + 1e-6f); for (int i = 0; i < 2; ++i) ck[i] *= rs * kvg[lane + 64 * i];
        const float ang = (float)pos[t] * exp2f(-6.0f * (13.287712379549449f / 32.0f)); const float c3 = cosf(ang), s3 = sinf(ang);
        const int h = t & 3;
        float qn = 0.f, q1 = 0.f, q2 = 0.f, kn = 0.f, vv = 0.f;
        for (int i = 0; i < 4; ++i) { const int k = lane + 64 * i; qn += cq[i] * wuq[(size_t)k * 384 + h * 96 + 5]; q1 += cq[i] * wuq[(size_t)k * 384 + h * 96 + 67]; q2 += cq[i] * wuq[(size_t)k * 384 + h * 96 + 83]; }
        for (int i = 0; i < 2; ++i) { const int k = lane + 64 * i; kn += ck[i] * wukv[(size_t)k * 512 + h * 128 + 7]; vv += ck[i] * wukv[(size_t)k * 512 + h * 128 + 64 + 9]; }
        qn = wave_sum(qn) * qs; q1 = wave_sum(q1) * qs; q2 = wave_sum(q2) * qs; kn = wave_sum(kn); vv = wave_sum(vv);
        const float kr1 = bf2f(pr[PC_KR + 3]), kr2 = bf2f(pr[PC_KR + 19]);
        const bf16_t* qrow = QM + (size_t)t * 384 + h * 96; const bf16_t* krow = KM + (size_t)t * 384 + h * 96;
        if (!chk_close(qn, bf2f(qrow[5])) || !chk_close(q1 * c3 - q2 * s3, bf2f(qrow[67])) || !chk_close(q1 * s3 + q2 * c3, bf2f(qrow[83])) || !chk_close(kn, bf2f(krow[7])) ||
            !chk_close(kr1 * c3 - kr2 * s3, bf2f(krow[67])) || !chk_close(kr1 * s3 + kr2 * c3, bf2f(krow[83])) || !chk_close(vv, bf2f(VM[(size_t)t * 256 + h * 64 + 9]))) bad = 1;
    }
    chk_flag(C, bit, bad);
}

__device__ __forceinline__ void chk_rw_inputs(const Ctx& C, int l, int bit) {
    const bf16_t* proj = WSP(bf16_t, S_PROJ); const float* DEC = WSP(float, S_DEC); const bf16_t* RWS = WSP(bf16_t, S_RWS); const bf16_t* GV = WSP(bf16_t, S_GV); const size_t PL = (size_t)T * 256;
    const float* mu = C.in[I_RWMU] + l * 1024; const float* w0 = C.in[I_RWW0] + l * 256; const float* a0 = C.in[I_RWA0] + l * 256;
    const float* wup = C.in[I_RWWUP] + l * 64 * 256; const float* aup = C.in[I_RWAUP] + l * 64 * 256; const float* gup = C.in[I_RWGUP] + l * 128 * 256;
    const float* kkw = C.in[I_RWKK] + l * 256; const float* kaw = C.in[I_RWKA] + l * 256; const int lane = C.lane; unsigned bad = 0;
    for (int t = GW; t < T; t += NGW) {
        const bf16_t* pr = proj + (size_t)t * NPROJ + PC_RW; const bool first = (t % SEQ) == 0; const int h = t & 3, c = h * 64 + 11;
        auto sh = [&](int col) { const float cur = bf2f(pr[col]); const float prv = first ? 0.f : bf2f(pr[col - NPROJ]); return cur + (prv - cur) * mu[col]; };
        float dw = tanhf(sh(768 + lane)) * wup[lane * 256 + c], da = sh(832 + lane) * aup[lane * 256 + c];
        float dg = (1.0f / (1.0f + expf(-sh(896 + lane)))) * gup[lane * 256 + c] + (1.0f / (1.0f + expf(-sh(960 + lane)))) * gup[(64 + lane) * 256 + c];
        dw = wave_sum(dw); da = wave_sum(da); dg = wave_sum(dg);
        const float xw = w0[c] + dw; const float wlog = -(fmaxf(-xw, 0.f) + log1pf(expf(-fabsf(xw)))) - 0.5f; const float dec = expf(-expf(wlog));
        const float a = 1.0f / (1.0f + expf(-(a0[c] + da)));
        const float kl = sh(256 + h * 64 + lane) * kkw[h * 64 + lane]; const float nrm = 1.0f / sqrtf(fmaxf(wave_sum(kl * kl), 1e-24f));
        const float r = sh(c), k = sh(256 + c), v = sh(512 + c); const float kk = k * kkw[c] * nrm, kmod = k * (1.0f + (a - 1.0f) * kaw[c]), ka = kk * a;
        const size_t o = (size_t)t * 256 + c;
        if (!chk_close(dec, DEC[o]) || fabsf(dec - DEC[o]) > 0.004f || !chk_close(r, bf2f(RWS[o])) || !chk_close(kmod, bf2f(RWS[PL + o])) || !chk_close(v, bf2f(RWS[2 * PL + o])) || !chk_close(kk, bf2f(RWS[3 * PL + o])) ||
            !chk_close(ka, bf2f(RWS[4 * PL + o])) || !chk_close(dg, bf2f(GV[o]))) bad = 1;
    }
    chk_flag(C, bit, bad);
}
__device__ __forceinline__ void chk_ssd_norm(const Ctx& C, int l, int bit) {
    const bf16_t* Y = WSP(bf16_t, S_Y); const float* ng = C.in[I_SSDNG] + l * 256; const int lane = C.lane; unsigned bad = 0;
    for (int t = GW; t < T; t += NGW) { float q = 0.f;
        for (int i = 0; i < 4; ++i) { const int c = (lane >> 5) * 128 + (lane & 31) * 4 + i; const float y = bf2f(Y[(size_t)t * 1024 + 512 + c]) / ng[c]; q += y * y; }
        for (int o_ = 1; o_ < 32; o_ <<= 1) q += __shfl_xor(q, o_);
        q *= (1.0f / 128.0f); if (q < 0.9f || q > 1.1f) bad = 1; }
    chk_flag(C, bit, bad);
}

#ifndef P7_COND
#define P7_COND 1
#endif
#ifndef P7_CLASS
#define P7_CLASS (((c & 31) < 16 ? 1u : 2u) | ((c & 255) < 128 ? 4u : 8u))
#endif
__device__ __forceinline__ float tdot(const bf16_t* a, const bf16_t* b, int K) { float d = 0.f;
    for (int k = 0; k < K; k += 8) { const u32x4 x = *(const u32x4*)(a + k), y = *(const u32x4*)(b + k);
        d += bflo(x.x) * bflo(y.x) + bfhi(x.x) * bfhi(y.x) + bflo(x.y) * bflo(y.y) + bfhi(x.y) * bfhi(y.y) + bflo(x.z) * bflo(y.z) + bfhi(x.z) * bfhi(y.z) + bflo(x.w) * bflo(y.w) + bfhi(x.w) * bfhi(y.w); }
    return d; }
__device__ __forceinline__ void chk_full_p7(const Ctx& C, int l, int bit) {
    const bf16_t* MB = WSP(bf16_t, S_MB); const bf16_t* W = (const bf16_t*)(C.ws + W_BASE + (size_t)l * LW_SIZE + LW_WOUT); const float* xin = C.in[I_X]; const float* XR = WSP(float, W_XRES); float num = 0.f, den = 0.f;
    for (size_t i = (size_t)C.bid * NTHREADS + C.tid; i < (size_t)T * 1024; i += (size_t)C.G * NTHREADS) { const size_t r = i >> 10; const int c = (int)(i & 1023);
        const float d = tdot(MB + r * 1024, W + (size_t)c * 1024, 1024), g = XR[i] - xin[i] * DN_ALPHA; num += (d - g) * (d - g); den += d * d; }
    num = wave_sum(num); den = wave_sum(den);
    if (C.lane == 0) { atomicAdd((float*)(C.ws + WS_CTL) + CW_CHK + 1024, num); atomicAdd((float*)(C.ws + WS_CTL) + CW_CHK + 1088, den); }
}
__device__ __forceinline__ void chk_full_merged(const Ctx& C, int l, int bit) {
    const bf16_t* Y = WSP(bf16_t, S_Y); const bf16_t* G = WSP(bf16_t, S_G); const bf16_t* MB = WSP(bf16_t, S_MB); const bf16_t* WBR = (const bf16_t*)(C.ws + W_BASE + (size_t)l * LW_SIZE + LW_WBR); unsigned bad = 0;
    for (size_t i = (size_t)C.bid * NTHREADS + C.tid; i < (size_t)T * 1024; i += (size_t)C.G * NTHREADS) { const size_t r = i >> 10; const int c = (int)(i & 1023); float e = 0.f;
        for (int q = 0; q < 4; ++q) e += bf2f(G[r * 4096 + q * 1024 + c]) * tdot(Y + r * 1024 + 256 * q, WBR + ((size_t)q * 1024 + c) * 256, 256);
        if (!chk_close(e, bf2f(MB[i]))) bad = 1; }
    if (bad) __hip_atomic_fetch_add((unsigned*)(C.ws + WS_CTL) + CW_CHK + 64 * bit, 1u, RLX_AGENT);
}

#ifndef FG_CLASS
#define FG_CLASS (1u << ((c >> 5) & 3))
#endif
template <class F> __device__ __forceinline__ void chk_full_gemm(const Ctx& C, const bf16_t* A, const bf16_t* Bt, int K, int N, int bit, F ok) {
    unsigned bad = 0, cntbad = 0;
    for (size_t i = (size_t)C.bid * NTHREADS + C.tid; i < (size_t)T * N; i += (size_t)C.G * NTHREADS) { const size_t r = i / N; const int c = (int)(i % N);
        if (!ok(r, c, tdot(A + r * K, Bt + (size_t)c * K, K))) { bad |= (bit < 0) ? (FG_CLASS) : (1u << bit); ++cntbad; } }
#ifdef FG_COUNT
    if (cntbad) __hip_atomic_fetch_add((unsigned*)(C.ws + WS_CTL) + CW_CHK + 2048, cntbad, RLX_AGENT);
#else
    for (int q = 0; q < 4; ++q) if ((bad >> q) & 1) __hip_atomic_fetch_add((unsigned*)(C.ws + WS_CTL) + CW_CHK + 64 * q, 1u, RLX_AGENT);
#endif
}
__device__ __forceinline__ void ph_prologue(const Ctx& C) {
    run_tjobs<28, false>(C);
    const int gt = C.bid * NTHREADS + C.tid, NT = C.G * NTHREADS;
    for (int l = 0; l < 2; ++l) {
        unsigned char* LW = C.ws + W_BASE + (size_t)l * LW_SIZE;
        bf16_t* lora = (bf16_t*)(LW + LW_LORA); const float* wup = C.in[I_RWWUP] + l * 64 * 256; const float* aup = C.in[I_RWAUP] + l * 64 * 256; const float* gup = C.in[I_RWGUP] + l * 128 * 256;
        for (int i = gt; i < 768 * 256; i += NT) { const int n = i >> 8, k = i & 255; float v = 0.f;
            if (n < 256) { if (k < 64) v = wup[k * 256 + n]; } else if (n < 512) { if (k >= 64 && k < 128) v = aup[(k - 64) * 256 + (n - 256)]; } else { if (k >= 128) v = gup[(k - 128) * 256 + (n - 512)]; }
            lora[i] = (bf16_t)(cvt_pk_bf16(v, 0.f) & 0xffffu); }
        bf16_t* wuq = (bf16_t*)(LW + LW_WUQ); const float* suq = C.in[I_WUQ] + l * 256 * 384;
        for (int i = gt; i < 512 * 256; i += NT) { const int n = i >> 8, k = i & 255; const float v = n < 384 ? suq[k * 384 + n] * (0.10206207261596575f * LOG2E) : 0.f; wuq[i] = (bf16_t)(cvt_pk_bf16(v, 0.f) & 0xffffu); }
        bf16_t* wukv = (bf16_t*)(LW + LW_WUKV); const float* sukv = C.in[I_WUKV] + l * 128 * 512;
        for (int i = gt; i < 512 * 128; i += NT) { const int n = i >> 7, k = i & 127; wukv[i] = (bf16_t)(cvt_pk_bf16(sukv[k * 512 + n], 0.f) & 0xffffu); }
        bf16_t* win = (bf16_t*)(LW + LW_WIN);
        for (int i = gt; i < (NPROJ - 3236) * 1024; i += NT) win[(size_t)3236 * 1024 + i] = 0;
    }
    { const float* x = C.in[I_X]; bf16_t* xb = WSP(bf16_t, W_XB);
      for (size_t i = gt; i < (size_t)T * 1024 / 8; i += NT) { const f32x4 a = *(const f32x4*)(x + i * 8), b = *(const f32x4*)(x + i * 8 + 4); *(u32x4*)(xb + i * 8) = epi::pack8(a, b); }
      const float* mm = C.in[I_MEM]; bf16_t* mb = WSP(bf16_t, W_MEMB);
      for (size_t i = gt; i < (size_t)NMEM * 1024 / 8; i += NT) { const f32x4 a = *(const f32x4*)(mm + i * 8), b = *(const f32x4*)(mm + i * 8 + 4); *(u32x4*)(mb + i * 8) = epi::pack8(a, b); } }
    { const int* pos = (const int*)C.in[I_POS]; float* ct = WSP(float, W_COS); float* st = WSP(float, W_SIN);
      for (int i = gt; i < T * 16; i += NT) { const int t = i >> 4, j = i & 15; const float inv = exp2f(-(float)(2 * j) * (13.287712379549449f / 32.0f)); const float ang = (float)pos[t] * inv; ct[i] = cosf(ang); st[i] = sinf(ang); } }
}

__device__ __forceinline__ f32x4 ld_bf4(const bf16_t* p) { const u32x2 w = *(const u32x2*)p; return (f32x4){bflo(w.x), bfhi(w.x), bflo(w.y), bfhi(w.y)}; }
__device__ __forceinline__ void st_bf4(bf16_t* p, const f32x4 v) { u32x2 w; w.x = cvt_pk_bf16(v[0], v[1]); w.y = cvt_pk_bf16(v[2], v[3]); *(u32x2*)p = w; }
__device__ __forceinline__ float tanhf_(float x) { return 1.0f - 2.0f * frcp(1.0f + fexp2(2.0f * LOG2E * x)); }
__device__ __forceinline__ void ph_prep(const Ctx& C, int l) {
    const bf16_t* __restrict__ proj = WSP(bf16_t, S_PROJ); const float* mu = C.in[I_RWMU] + l * 1024;
    bf16_t* __restrict__ LA = WSP(bf16_t, S_LA); bf16_t* __restrict__ CQN = WSP(bf16_t, S_CQN); bf16_t* __restrict__ CKVN = WSP(bf16_t, S_CKVN); bf16_t* __restrict__ KM = WSP(bf16_t, S_KM);
    const float* qg = C.in[I_QNG] + l * 256; const float* kvg = C.in[I_KVNG] + l * 128; const float* ct = WSP(float, W_COS); const float* st = WSP(float, W_SIN);
    const int lane = C.lane;
    for (int t = GW; t < T; t += NGW) {
        const bf16_t* pr = proj + (size_t)t * NPROJ; const bool first = (t % SEQ) == 0;
        { const int c = 4 * lane; const f32x4 cur = ld_bf4(pr + PC_RW + 768 + c); const f32x4 prv = first ? (f32x4){0.f, 0.f, 0.f, 0.f} : ld_bf4(pr - NPROJ + PC_RW + 768 + c);
          const f32x4 m = *(const f32x4*)(mu + 768 + c); f32x4 p = cur + (prv - cur) * m;
          if (c < 64) { for (int j = 0; j < 4; ++j) p[j] = tanhf_(p[j]); } else if (c >= 128) { for (int j = 0; j < 4; ++j) p[j] = sigmoidf_(p[j]); }
          st_bf4(LA + (size_t)t * 256 + c, p); }
        { const int c = 4 * lane; f32x4 v = ld_bf4(pr + PC_CQ + c); const float ss = wave_sum((v[0] * v[0] + v[1] * v[1]) + (v[2] * v[2] + v[3] * v[3]));
          const float rs = 1.0f / sqrtf(ss * (1.0f / 256.0f) + 1e-6f); v = v * rs * *(const f32x4*)(qg + c); st_bf4(CQN + (size_t)t * 256 + c, v); }
        { const int c = 2 * lane; const unsigned w = *(const unsigned*)(pr + PC_CKV + c); float a = bflo(w), b = bfhi(w); const float ss = wave_sum(a * a + b * b);
          const float rs = 1.0f / sqrtf(ss * (1.0f / 128.0f) + 1e-6f); a *= rs * kvg[c]; b *= rs * kvg[c + 1]; *(unsigned*)(CKVN + (size_t)t * 128 + c) = cvt_pk_bf16(a, b); }
        { const float v = bf2f(pr[PC_KR + (lane & 31)]); const float o = __shfl_xor(v, 16); const int i = lane & 15; const float cs = ct[t * 16 + i], sn = st[t * 16 + i];
          const float r = (lane & 16) ? (o * sn + v * cs) : (v * cs - o * sn);
          if (lane < 32) { const bf16_t rb = (bf16_t)(cvt_pk_bf16(r, 0.f) & 0xffffu); for (int h = 0; h < 4; ++h) KM[(size_t)t * 384 + h * 96 + 64 + lane] = rb; } }
    }
}
__device__ __forceinline__ void ph_rwprep(const Ctx& C, int l) {
#if defined(NAIVE_SCAN)
    if (NAIVE_SCAN & 2) { float* q_ = WSP(float, S_SSQ); for (int i = C.bid * NTHREADS + C.tid; i < T * 8; i += C.G * NTHREADS) q_[i] = 0.f; }
#endif
    const bf16_t* __restrict__ proj = WSP(bf16_t, S_PROJ); const float* mu = C.in[I_RWMU] + l * 1024; const bf16_t* __restrict__ AV = WSP(bf16_t, S_AV); bf16_t* __restrict__ RWS = WSP(bf16_t, S_RWS);
    const float* kkw = C.in[I_RWKK] + l * 256; const float* kaw = C.in[I_RWKA] + l * 256; const int lane = C.lane, c = 4 * lane;
    for (int t = GW; t < T; t += NGW) {
        const bf16_t* pr = proj + (size_t)t * NPROJ + PC_RW; const bool first = (t % SEQ) == 0; f32x4 rkv[3];
#pragma unroll
        for (int q = 0; q < 3; ++q) { const f32x4 cur = ld_bf4(pr + q * 256 + c); const f32x4 prv = first ? (f32x4){0.f, 0.f, 0.f, 0.f} : ld_bf4(pr - NPROJ + q * 256 + c); rkv[q] = cur + (prv - cur) * *(const f32x4*)(mu + q * 256 + c); }
        const f32x4 a = ld_bf4(AV + (size_t)t * 256 + c); f32x4 kk = rkv[1] * *(const f32x4*)(kkw + c);
        float ss = (kk[0] * kk[0] + kk[1] * kk[1]) + (kk[2] * kk[2] + kk[3] * kk[3]);
        ss += __shfl_xor(ss, 1); ss += __shfl_xor(ss, 2); ss += __shfl_xor(ss, 4); ss += __shfl_xor(ss, 8);
        kk = kk * (1.0f / sqrtf(fmaxf(ss, 1e-24f)));
        const f32x4 kmod = rkv[1] * ((a - 1.0f) * *(const f32x4*)(kaw + c) + 1.0f), ka = kk * a;
        const size_t o = (size_t)t * 256 + c, PL = (size_t)T * 256;
        st_bf4(RWS + o, rkv[0]); st_bf4(RWS + PL + o, kmod); st_bf4(RWS + 2 * PL + o, rkv[2]); st_bf4(RWS + 3 * PL + o, kk); st_bf4(RWS + 4 * PL + o, ka);
    }
}
__device__ __forceinline__ void ph_ssdprep(const Ctx& C, int l) {
    const bf16_t* __restrict__ proj = WSP(bf16_t, S_PROJ); bf16_t* __restrict__ XA = WSP(bf16_t, S_XA); bf16_t* __restrict__ BC = WSP(bf16_t, S_BC); bf16_t* __restrict__ CC = WSP(bf16_t, S_CC); float* __restrict__ ACS = WSP(float, S_ACS); float* __restrict__ DTV = WSP(float, S_DTV);
    const float* cw = C.in[I_CONVW] + l * 4 * 768; const float* cb = C.in[I_CONVB] + l * 768; const float* dtbp = C.in[I_DTB] + l * 4; const float* alog = C.in[I_ALOG] + l * 4; const int lane = C.lane;
    for (int item = GW; item < 64; item += NGW) { const int b = item >> 2, h = item & 3; const float dtb = dtbp[h], a2 = -expf(alog[h]) * LOG2E; const size_t t0 = (size_t)b * SEQ + lane;
        float carry = 0.f;
#pragma unroll 4
        for (int c = 0; c < SEQ / 64; ++c) { float v = softplusf_(bf2f(proj[(t0 + 64 * c) * NPROJ + PC_DT + h]) + dtb) * a2;
#pragma unroll
            for (int d = 1; d < 64; d <<= 1) { const float o = __shfl_up(v, d); if (lane >= d) v += o; }
            v += carry; ACS[(t0 + 64 * c) * 4 + h] = v; carry = __shfl(v, 63); } }
    for (int t = GW; t < T; t += NGW) { const int tl = t % SEQ;
#pragma unroll
        for (int j = 0; j < 3; ++j) { const int c = 4 * lane + 256 * j; f32x4 a = *(const f32x4*)(cb + c);
#pragma unroll
            for (int k = 0; k < 4; ++k) { if (tl - 3 + k >= 0) a += ld_bf4(proj + (size_t)(t - 3 + k) * NPROJ + PC_XS + c) * *(const f32x4*)(cw + k * 768 + c); }
            for (int q = 0; q < 4; ++q) a[q] = siluf_(a[q]);
            st_bf4((j == 0 ? XA : (j == 1 ? BC : CC)) + (size_t)t * 256 + 4 * lane, a); }
        if (lane < 4) DTV[(size_t)t * 4 + lane] = softplusf_(bf2f(proj[(size_t)t * NPROJ + PC_DT + lane]) + dtbp[lane]);
    }
}
#ifndef ABL_MOE
#define ABL_MOE 1.0f
#endif
template <bool MOE> __device__ __forceinline__ void ph_ln(const Ctx& C, const float* src, float* dst, bf16_t* dstb, const float* g, const float* b, const bf16_t* ys) {
    const int lane = C.lane;
    float chkscale = 1.0f;
#if defined(CHECKS) || defined(CHECKS2) || defined(CHECKS3) || defined(CHECKS4) || defined(CHECKS5) || defined(CHECKS6) || defined(CHECKS7) || defined(CHECKS8) || defined(CHECKS9) || defined(CHECKS10) || defined(CHECKS12) || defined(CHECKS13) || defined(CHECKS14) || defined(CHECKS15)
    if (MOE) { const unsigned* cw = (const unsigned*)(C.ws + WS_CTL) + CW_CHK; int n = 0;
        for (int q = 0; q < 4; ++q) if (__hip_atomic_load(cw + 64 * q, RLX_AGENT) != 0u) n |= 1 << q;
#if defined(FG_COUNT) || defined(CHECKS13) || defined(CHECKS15)
        { unsigned v_ = __hip_atomic_load(cw + 2048, RLX_AGENT); n = 0; while (v_ > 0u) { ++n; v_ >>= 1; } }
#endif
#ifdef CHECKS10
        { const float num = __uint_as_float(__hip_atomic_load(cw + 1024, RLX_AGENT)), den = __uint_as_float(__hip_atomic_load(cw + 1088, RLX_AGENT)); const float lr = -log2f(fmaxf(num / fmaxf(den, 1e-30f), 1e-12f)); n = (int)(lr + 0.5f); n = n < 0 ? 0 : (n > 31 ? 31 : n); }
#endif
        chkscale = 1.0f + 0.1f * (float)n; }
#endif
    for (int t = GW; t < T; t += NGW) {
        f32x4 v[4]; float s = 0.f;
#pragma unroll
        for (int j = 0; j < 4; ++j) { v[j] = *(const f32x4*)(src + (size_t)t * 1024 + 4 * lane + 256 * j);
            if (MOE) { const f32x4 y0 = ld_bf4(ys + (size_t)(2 * t) * 1024 + 4 * lane + 256 * j), y1 = ld_bf4(ys + (size_t)(2 * t + 1) * 1024 + 4 * lane + 256 * j); v[j] = v[j] * DN_ALPHA + (y0 + y1) * ABL_MOE; }
            s += (v[j][0] + v[j][1]) + (v[j][2] + v[j][3]); }
        const float mean = wave_sum(s) * (1.0f / 1024.0f); float s2 = 0.f;
#pragma unroll
        for (int j = 0; j < 4; ++j) { v[j] = v[j] - mean; s2 += (v[j][0] * v[j][0] + v[j][1] * v[j][1]) + (v[j][2] * v[j][2] + v[j][3] * v[j][3]); }
        const float rstd = 1.0f / sqrtf(wave_sum(s2) * (1.0f / 1024.0f) + 1e-5f);
#pragma unroll
        for (int j = 0; j < 4; ++j) { const int c = 4 * lane + 256 * j; const f32x4 o = (v[j] * rstd * *(const f32x4*)(g + c) + *(const f32x4*)(b + c)) * chkscale;
            *(f32x4*)(dst + (size_t)t * 1024 + c) = o; if (dstb) st_bf4(dstb + (size_t)t * 1024 + c, o); }
    }
}
__device__ __forceinline__ void ph_ssdfix(const Ctx& C, int l) {
    bf16_t* Y = WSP(bf16_t, S_Y); const float* ssq = WSP(float, S_SSQ); const float* ng = C.in[I_SSDNG] + l * 256; const int lane = C.lane, c = 4 * lane, g = lane >> 5;
    const bf16_t* YRAW = WSP(bf16_t, S_YRAW); const bf16_t* RWS = WSP(bf16_t, S_RWS); const bf16_t* GV = WSP(bf16_t, S_GV); const size_t PL = (size_t)T * 256;
    const f32x4 rk = *(const f32x4*)(C.in[I_RWRK] + l * 256 + c), gng = *(const f32x4*)(C.in[I_RWGNG] + l * 256 + c), gnb = *(const f32x4*)(C.in[I_RWGNB] + l * 256 + c);
    for (int t = GW; t < T; t += NGW) {
        const float q = (ssq[t * 8 + 4 * g] + ssq[t * 8 + 4 * g + 1]) + (ssq[t * 8 + 4 * g + 2] + ssq[t * 8 + 4 * g + 3]); const float rs = 1.0f / sqrtf(q * (1.0f / 128.0f) + 1e-5f);
        bf16_t* p = Y + (size_t)t * 1024 + 512 + c; f32x4 v = ld_bf4(p); v = v * rs * *(const f32x4*)(ng + c); st_bf4(p, v);
#ifndef RW_NAIVE_OUT
        {   const size_t o = (size_t)t * 256 + c; const f32x4 yv = ld_bf4(YRAW + o), rr = ld_bf4(RWS + o), km = ld_bf4(RWS + PL + o), vv = ld_bf4(RWS + 2 * PL + o), gg = ld_bf4(GV + o);
            float sm = (yv[0] + yv[1]) + (yv[2] + yv[3]), bd = (rr[0] * km[0] * rk[0] + rr[1] * km[1] * rk[1]) + (rr[2] * km[2] * rk[2] + rr[3] * km[3] * rk[3]);
#pragma unroll
            for (int o_ = 1; o_ < 16; o_ <<= 1) { sm += __shfl_xor(sm, o_); bd += __shfl_xor(bd, o_); }
            const float mu = sm * (1.0f / 64.0f); const f32x4 d = yv - mu; float vs = (d[0] * d[0] + d[1] * d[1]) + (d[2] * d[2] + d[3] * d[3]);
#pragma unroll
            for (int o_ = 1; o_ < 16; o_ <<= 1) vs += __shfl_xor(vs, o_);
            const float rstd = 1.0f / sqrtf(vs * (1.0f / 64.0f) + 64e-5f);
            st_bf4(Y + (size_t)t * 1024 + 256 + c, ((d * rstd) * gng + gnb + vv * bd) * gg); }
#endif
    }
}
typedef __bf16 bfx8 __attribute__((ext_vector_type(8)));
__device__ __forceinline__ f32x16 mfma32(const bf16x8 a, const bf16x8 b, const f32x16 c) { return __builtin_amdgcn_mfma_f32_32x32x16_bf16(__builtin_bit_cast(bfx8, a), __builtin_bit_cast(bfx8, b), c, 0, 0, 0); }
__device__ __forceinline__ float dpp_xor1(float v) { return __builtin_bit_cast(float, __builtin_amdgcn_mov_dpp(__builtin_bit_cast(int, v), 0xB1, 0xf, 0xf, true)); }
__device__ __forceinline__ float dpp_xor2(float v) { return __builtin_bit_cast(float, __builtin_amdgcn_mov_dpp(__builtin_bit_cast(int, v), 0x4E, 0xf, 0xf, true)); }
__device__ __forceinline__ float dpp_hmir(float v) { return __builtin_bit_cast(float, __builtin_amdgcn_mov_dpp(__builtin_bit_cast(int, v), 0x141, 0xf, 0xf, true)); }
__device__ __forceinline__ float sum8(float v) { v += dpp_xor1(v); v += dpp_xor2(v); v += dpp_hmir(v); return v; }

template <int MODE>
__device__ __forceinline__ void attn_unit(const Ctx& C0_, int l, int b, int h, int qb) {
    const Ctx C = launder(C0_);
    constexpr int DQK = MODE == 2 ? 128 : (MODE == 1 ? 96 : 64), NS = DQK / 16, KST = DQK * 2 + 16, VST = 192, KCH = DQK / 8;
    const bf16_t *Qp, *Kp, *Vp; int qs, ks, vs, ycol;
    if (MODE == 0) { const bf16_t* proj = WSP(bf16_t, S_PROJ); Qp = proj + PC_SBQ + h * 64; Kp = proj + PC_SBK + h * 64; Vp = proj + PC_SBV + h * 64; qs = ks = vs = NPROJ; ycol = h * 64; }
    else if (MODE == 1) { Qp = WSP(bf16_t, S_QM) + h * 96; Kp = WSP(bf16_t, S_KM) + h * 96; Vp = WSP(bf16_t, S_VM) + h * 64; qs = ks = 384; vs = 256; ycol = 768 + h * 64; }
    else { Qp = WSP(bf16_t, S_CC) + (h >> 1) * 128; Kp = WSP(bf16_t, S_BC) + (h >> 1) * 128; Vp = WSP(bf16_t, S_XA) + h * 64; qs = ks = vs = 256; ycol = 512 + h * 64; }
    const float* ACS = WSP(float, S_ACS); const float* DTV = WSP(float, S_DTV);
    const size_t tb = (size_t)b * SEQ;
    constexpr int ABUF = 64 * KST + 64 * VST + 512;
    LAS unsigned char* const abase = C.lds;
    const int tid = C.tid, lane = C.lane, w = C.wave, r = lane & 31, hh = lane >> 5;
    const int Q0 = qb * 256, qidx = Q0 + 32 * w + r, qmin = Q0 + 32 * w, qmax = qmin + 31;
    bf16x8 qf[NS];
#pragma unroll
    for (int s = 0; s < NS; ++s) qf[s] = *(const bf16x8*)(Qp + (tb + qidx) * qs + 16 * s + 8 * hh);
    f32x16 o[2]; for (int i = 0; i < 16; ++i) { o[0][i] = 0.f; o[1][i] = 0.f; }
    float Rrun = 0.f, mrun = -1.0e30f, lsum = 0.f;
    const int pr = (r & ~12) | ((r & 4) << 1) | ((r & 8) >> 1);
    u32x4 kreg0, kreg1, vreg; const int krow0 = tid / KCH, kch0 = tid % KCH, krow1 = (tid + 512) / KCH, kch1 = (tid + 512) % KCH, vrow = tid >> 3, vch = tid & 7;
    const bool k1 = (MODE == 2) || ((MODE == 1) && (tid < 64 * KCH - 512));
    float areg = 0.f, dreg = 0.f; float aq = 0.f; if (MODE == 2) aq = ACS[(tb + qidx) * 4 + h];
    const int ktmax = 4 * qb + 3;
#define ATT_LOAD(kt) do { const size_t kb_ = tb + (size_t)(kt) * 64; kreg0 = *(const u32x4*)(Kp + (kb_ + krow0) * ks + kch0 * 8); if (k1) kreg1 = *(const u32x4*)(Kp + (kb_ + krow1) * ks + kch1 * 8); \
        vreg = *(const u32x4*)(Vp + (kb_ + vrow) * vs + vch * 8); if (MODE == 2 && tid < 64) { areg = ACS[(kb_ + tid) * 4 + h]; dreg = DTV[(kb_ + tid) * 4 + h]; } } while (0)
#define ATT_STORE(bi) do { LAS unsigned char* Kt_ = abase + (bi) * ABUF; LAS unsigned char* Vt_ = Kt_ + 64 * KST; \
        *(LAS u32x4*)(Kt_ + krow0 * KST + kch0 * 16) = kreg0; if (k1) *(LAS u32x4*)(Kt_ + krow1 * KST + kch1 * 16) = kreg1; \
        *(LAS u32x4*)(Vt_ + vrow * VST + vch * 16) = vreg; if (MODE == 2 && tid < 64) { ((LAS float*)(Vt_ + 64 * VST))[tid] = areg; ((LAS float*)(Vt_ + 64 * VST))[64 + tid] = dreg; } } while (0)
    __syncthreads();
    ATT_LOAD(ktmax); ATT_STORE(0); if (ktmax > 0) ATT_LOAD(ktmax - 1);
    __syncthreads();
    for (int kt = ktmax; kt >= 0; --kt) {
        const int bi = (ktmax - kt) & 1;
        LAS unsigned char* Kt = abase + bi * ABUF; LAS unsigned char* Vt = Kt + 64 * KST; LAS float* AkL = (LAS float*)(Vt + 64 * VST); LAS float* DkL = AkL + 64;
        const unsigned vt_addr = (unsigned)(size_t)Vt;
        if (kt > 0) { ATT_STORE(bi ^ 1); if (kt > 1) ATT_LOAD(kt - 2); }
        const int k0 = kt * 64;
        if (k0 <= qmax) {
        const bool need_mask = (k0 + 63 >= qmin);
        f32x16 sc[2];
#pragma unroll
        for (int sub = 0; sub < 2; ++sub) {
            for (int i = 0; i < 16; ++i) sc[sub][i] = 0.f;
#pragma unroll
            for (int s = 0; s < NS; ++s) { const bf16x8 kf = *(const LAS bf16x8*)(Kt + (32 * sub + pr) * KST + (16 * s + 8 * hh) * 2); sc[sub] = mfma32(kf, qf[s], sc[sub]); }
        }
        if (MODE == 0) {
#pragma unroll
            for (int sub = 1; sub >= 0; --sub) {
                const int kb = k0 + 32 * sub + 8 * hh;
                float L[16];
#pragma unroll
                for (int i = 0; i < 16; ++i) { const float z = sc[sub][i]; const int key = kb + (i & 7) + 16 * (i >> 3); const bool ok = !need_mask || key < qidx;
                    const float l2 = -(fmaxf(z, 0.f) + flog2(1.0f + fexp2(-fabsf(z)))); L[i] = ok ? l2 : 0.f; sc[sub][i] = ok ? z + l2 : -1.0e30f; }
                float own_hi = 0.f, own_lo = 0.f, tl[16];
#pragma unroll
                for (int j = 7; j >= 0; --j) { tl[8 + j] = own_hi; own_hi += L[8 + j]; tl[j] = own_lo; own_lo += L[j]; }
                const float p_hi = __shfl_xor(own_hi, 32), p_lo = __shfl_xor(own_lo, 32);
                const float off_hi = Rrun + (hh ? 0.f : p_hi), off_lo = Rrun + own_hi + p_hi + (hh ? 0.f : p_lo);
                Rrun += (own_hi + own_lo) + (p_hi + p_lo);
#pragma unroll
                for (int i = 0; i < 16; ++i) sc[sub][i] = fexp2(sc[sub][i] + tl[i] + (i >= 8 ? off_hi : off_lo));
            }
        } else if (MODE == 2) {
#pragma unroll
            for (int sub = 0; sub < 2; ++sub) { f32x4 ak[4], dk[4];
#pragma unroll
                for (int r4 = 0; r4 < 4; ++r4) { const int o_ = 32 * sub + 8 * hh + 16 * (r4 >> 1) + 4 * (r4 & 1); ak[r4] = *(const LAS f32x4*)(AkL + o_); dk[r4] = *(const LAS f32x4*)(DkL + o_); }
#pragma unroll
                for (int i = 0; i < 16; ++i) { const int key = k0 + 32 * sub + 8 * hh + (i & 7) + 16 * (i >> 3); const bool ok = !need_mask || key <= qidx;
                    const float a_ = ak[(i >> 3) * 2 + ((i & 7) >> 2)][i & 3], d_ = dk[(i >> 3) * 2 + ((i & 7) >> 2)][i & 3];
                    const float pv = sc[sub][i] * d_ * fexp2(fminf(aq - a_, 0.f)); sc[sub][i] = ok ? pv : 0.f; } }
        } else {
            float tm = -1.0e30f;
#pragma unroll
            for (int sub = 0; sub < 2; ++sub)
#pragma unroll
                for (int i = 0; i < 16; ++i) { const int key = k0 + 32 * sub + 8 * hh + (i & 7) + 16 * (i >> 3); const bool ok = !need_mask || key <= qidx; const float z = ok ? sc[sub][i] : -1.0e30f; sc[sub][i] = z; tm = fmaxf(tm, z); }
            tm = fmaxf(tm, __shfl_xor(tm, 32));
            const float mnew = fmaxf(mrun, tm), alpha = fexp2(mrun - mnew); mrun = mnew;
            float ps = 0.f;
#pragma unroll
            for (int sub = 0; sub < 2; ++sub)
#pragma unroll
                for (int i = 0; i < 16; ++i) { const float p = fexp2(sc[sub][i] - mnew); sc[sub][i] = p; ps += p; }
            lsum = lsum * alpha + ps;
#pragma unroll
            for (int i = 0; i < 16; ++i) { o[0][i] *= alpha; o[1][i] *= alpha; }
        }
#pragma unroll
        for (int sub = 0; sub < 2; ++sub)
#pragma unroll
            for (int s = 0; s < 2; ++s) {
                bf16x8 pf; { u32x4 pw; pw.x = cvt_pk_bf16(sc[sub][8 * s + 0], sc[sub][8 * s + 1]); pw.y = cvt_pk_bf16(sc[sub][8 * s + 2], sc[sub][8 * s + 3]); pw.z = cvt_pk_bf16(sc[sub][8 * s + 4], sc[sub][8 * s + 5]); pw.w = cvt_pk_bf16(sc[sub][8 * s + 6], sc[sub][8 * s + 7]); pf = __builtin_bit_cast(bf16x8, pw); }
                const unsigned a0 = vt_addr + (unsigned)((32 * sub + 16 * s + 8 * hh + ((lane & 15) >> 2)) * VST + (16 * ((lane >> 4) & 1) + 4 * (lane & 3)) * 2);
                u32x2 v00, v01, v10, v11;
                asm volatile("ds_read_b64_tr_b16 %0, %4\n\tds_read_b64_tr_b16 %1, %4 offset:768\n\tds_read_b64_tr_b16 %2, %4 offset:64\n\tds_read_b64_tr_b16 %3, %4 offset:832\n\ts_waitcnt lgkmcnt(0)"
                             : "=&v"(v00), "=&v"(v01), "=&v"(v10), "=&v"(v11) : "v"(a0) : "memory");
                u32x4 va0; va0.x = v00.x; va0.y = v00.y; va0.z = v01.x; va0.w = v01.y;
                u32x4 va1; va1.x = v10.x; va1.y = v10.y; va1.z = v11.x; va1.w = v11.y;
                o[0] = mfma32(__builtin_bit_cast(bf16x8, va0), pf, o[0]);
                o[1] = mfma32(__builtin_bit_cast(bf16x8, va1), pf, o[1]);
            }
        }
        bool dead = false;
        if (MODE == 0) dead = Rrun < -64.0f;
        if (MODE == 2) dead = aq - AkL[0] < -64.0f;
        if (MODE == 1) { __syncthreads(); }
        else { volatile LAS unsigned* votes = (volatile LAS unsigned*)(C.lds + LDSCTL_OFF + 128) + 8 * bi;
            const bool wdead = __all(dead ? 1 : 0); if (lane == 0) votes[w] = wdead ? 1u : 0u;
            __syncthreads();
            unsigned all_ = 1u;
#pragma unroll
            for (int q_ = 0; q_ < 8; ++q_) all_ &= votes[q_];
            if (all_) break; }
    }
#undef ATT_LOAD
#undef ATT_STORE
    float inv = 1.0f;
    if (MODE == 1) { const float lt = lsum + __shfl_xor(lsum, 32); inv = frcp(lt); }
    bf16_t* Y = WSP(bf16_t, S_Y) + (tb + qidx) * 1024 + ycol;
    if (MODE == 2) {
        const float dsk = C.in[I_SSDD][l * 4 + h]; const bf16_t* xa = Vp + (tb + qidx) * 256; const bf16_t* zp = WSP(bf16_t, S_PROJ) + (tb + qidx) * NPROJ + PC_Z + h * 64; float q_ = 0.f;
#pragma unroll
        for (int dt = 0; dt < 2; ++dt)
#pragma unroll
            for (int g = 0; g < 4; ++g) { const int d0 = 32 * dt + 8 * g + 4 * hh; const f32x4 xv = ld_bf4(xa + d0), zv = ld_bf4(zp + d0); f32x4 y;
                for (int j = 0; j < 4; ++j) { y[j] = (o[dt][4 * g + j] + dsk * xv[j]) * siluf_(zv[j]); q_ += y[j] * y[j]; }
                st_bf4(Y + d0, y); }
        q_ += __shfl_xor(q_, 32);
        if (hh == 0) { float* SSQ = WSP(float, S_SSQ); SSQ[(tb + qidx) * 8 + h * 2] = q_; SSQ[(tb + qidx) * 8 + h * 2 + 1] = 0.f; }
        return;
    }
#pragma unroll
    for (int dt = 0; dt < 2; ++dt)
#pragma unroll
        for (int g = 0; g < 4; ++g) { u32x2 wv; wv.x = cvt_pk_bf16(o[dt][4 * g] * inv, o[dt][4 * g + 1] * inv); wv.y = cvt_pk_bf16(o[dt][4 * g + 2] * inv, o[dt][4 * g + 3] * inv);
            *(u32x2*)(Y + 32 * dt + 8 * g + 4 * hh) = wv; }
}

__device__ __forceinline__ float sum16(float v) { v = sum8(v); v += __builtin_bit_cast(float, __builtin_amdgcn_mov_dpp(__builtin_bit_cast(int, v), 0x140, 0xf, 0xf, true)); return v; }
__device__ __forceinline__ void rwkv_unit(const Ctx& C0_, int l, int b, int h, int half) {
    const Ctx C = launder(C0_);
    constexpr int TB = 32, NBLK = SEQ / TB, BUFB = 6 * TB * 64 * 4;
    LAS float* buf0 = (LAS float*)C.lds; LAS float* ybuf = (LAS float*)(C.lds + 2 * BUFB);
    const int tid = C.tid, il = tid >> 4, q = tid & 15, i = 32 * half + il;
    const float* DEC = WSP(float, S_DEC); const bf16_t* RWS = WSP(bf16_t, S_RWS); bf16_t* YRAW = WSP(bf16_t, S_YRAW);
    const size_t PL = (size_t)T * 256; const size_t tb = (size_t)b * SEQ;
    const int ls = tid >> 4, lj = 4 * (tid & 15);
    f32x4 gw; u32x2 gr[5];
#define RW_LOAD(blk) do { const size_t o_ = (tb + (size_t)(blk) * TB + ls) * 256 + h * 64 + lj; gw = *(const f32x4*)(DEC + o_); \
        gr[0] = *(const u32x2*)(RWS + 3 * PL + o_); gr[1] = *(const u32x2*)(RWS + 4 * PL + o_); gr[2] = *(const u32x2*)(RWS + PL + o_); gr[3] = *(const u32x2*)(RWS + o_); gr[4] = *(const u32x2*)(RWS + 2 * PL + o_); } while (0)
#define RW_STORE(bufp) do { LAS float* d_ = (bufp) + ls * 64 + lj; *(LAS f32x4*)d_ = gw; \
        _Pragma("unroll") for (int a_ = 0; a_ < 5; ++a_) *(LAS f32x4*)(d_ + (a_ + 1) * TB * 64) = (f32x4){bflo(gr[a_].x), bfhi(gr[a_].x), bflo(gr[a_].y), bfhi(gr[a_].y)}; } while (0)
    f32x4 S = (f32x4){0.f, 0.f, 0.f, 0.f};
    __syncthreads();
    RW_LOAD(0); RW_STORE(buf0);
    __syncthreads();
    for (int blk = 0; blk < NBLK; ++blk) {
        LAS float* cur = buf0 + (blk & 1) * (BUFB / 4); LAS float* nxtb = buf0 + ((blk + 1) & 1) * (BUFB / 4);
        if (blk + 1 < NBLK) RW_LOAD(blk + 1);
        for (int s0 = 0; s0 < TB; s0 += 4) {
            f32x4 w4[4], kk4[4], ka4[4], km4[4], r4[4]; float vv[4], yv[4];
#pragma unroll
            for (int u = 0; u < 4; ++u) { const LAS float* p = cur + (s0 + u) * 64 + 4 * q;
                w4[u] = *(const LAS f32x4*)p; kk4[u] = *(const LAS f32x4*)(p + TB * 64); ka4[u] = *(const LAS f32x4*)(p + 2 * TB * 64); km4[u] = *(const LAS f32x4*)(p + 3 * TB * 64); r4[u] = *(const LAS f32x4*)(p + 4 * TB * 64);
                vv[u] = cur[5 * TB * 64 + (s0 + u) * 64 + i]; }
#pragma unroll
            for (int u = 0; u < 4; ++u) {
                float sa = (S[0] * kk4[u][0] + S[1] * kk4[u][1]) + (S[2] * kk4[u][2] + S[3] * kk4[u][3]);
                sa = sum16(sa);
                S = S * w4[u] + (km4[u] * vv[u] - ka4[u] * sa);
                const float y = (S[0] * r4[u][0] + S[1] * r4[u][1]) + (S[2] * r4[u][2] + S[3] * r4[u][3]);
                yv[u] = sum16(y); }
            if (q == 0) {
#pragma unroll
                for (int u = 0; u < 4; ++u) ybuf[(s0 + u) * 32 + il] = yv[u]; }
        }
        __syncthreads();
        {
            const int os = tid >> 4, r2 = 2 * (tid & 15); const size_t t = tb + (size_t)blk * TB + os;
            *(unsigned*)(YRAW + t * 256 + h * 64 + 32 * half + r2) = cvt_pk_bf16(ybuf[os * 32 + r2], ybuf[os * 32 + r2 + 1]);
        }
        if (blk + 1 < NBLK) RW_STORE(nxtb);
        __syncthreads();
    }
#undef RW_LOAD
#undef RW_STORE
}

__device__ __forceinline__ void ssd_stage(const Ctx& C, int l, int h, size_t tb, int blk, LAS float* dst) {
    constexpr int TB = 16; const int g = h >> 1;
    const bf16_t* proj = WSP(bf16_t, S_PROJ); const float* cw = C.in[I_CONVW] + l * 4 * 768; const float* cb = C.in[I_CONVB] + l * 768;
    const float dtb = C.in[I_DTB][l * 4 + h], aneg = -expf(C.in[I_ALOG][l * 4 + h]);
    for (int it = C.tid; it < TB * 80; it += NTHREADS) {
        const int s = it / 80, v = it % 80; const int tl = blk * TB + s;
        int pcol, cch, doff;
        if (v < 16) { pcol = PC_XS + h * 64 + 4 * v; cch = h * 64 + 4 * v; doff = s * 64 + 4 * v; }
        else if (v < 48) { pcol = PC_BM + g * 128 + 4 * (v - 16); cch = 256 + g * 128 + 4 * (v - 16); doff = 2 * TB * 64 + s * 128 + 4 * (v - 16); }
        else { pcol = PC_CM + g * 128 + 4 * (v - 48); cch = 512 + g * 128 + 4 * (v - 48); doff = 2 * TB * 64 + TB * 128 + s * 128 + 4 * (v - 48); }
        f32x4 a = *(const f32x4*)(cb + cch);
#pragma unroll
        for (int k = 0; k < 4; ++k) { const int tt = tl - 3 + k; if (tt >= 0) a += ld_bf4(proj + (tb + tt) * NPROJ + pcol) * *(const f32x4*)(cw + k * 768 + cch); }
        for (int j = 0; j < 4; ++j) a[j] = siluf_(a[j]);
        if (v < 16) { const float dt = softplusf_(bf2f(proj[(tb + tl) * NPROJ + PC_DT + h]) + dtb); *(LAS f32x4*)(dst + TB * 64 + doff) = a; *(LAS f32x4*)(dst + doff) = a * dt;
                      if (v == 0) dst[TB * 384 + s] = expf(dt * aneg); }
        else *(LAS f32x4*)(dst + doff) = a;
    }
}
__device__ __forceinline__ void ssd_unit(const Ctx& C0_, int l, int b, int h, int ph) {
    const Ctx C = launder(C0_);
    constexpr int TB = 32, NBLK = SEQ / TB, NF = TB * (32 + 32 + 128 + 128) + 64, NIT = 72 * TB, NK = (NIT + NTHREADS - 1) / NTHREADS;
    LAS float* buf0 = (LAS float*)C.lds; LAS float* ypart = buf0 + 2 * NF;
    const int tid = C.tid, lane = C.lane, w = C.wave, g = h >> 1, pl = lane & 31, nh = lane >> 5;
    const bf16_t* proj = WSP(bf16_t, S_PROJ); bf16_t* Y = WSP(bf16_t, S_Y); float* SSQ = WSP(float, S_SSQ);
    const float* cw = C.in[I_CONVW] + l * 4 * 768; const float* cb = C.in[I_CONVB] + l * 768;
    const float dtb = C.in[I_DTB][l * 4 + h], aneg = -expf(C.in[I_ALOG][l * 4 + h]), dsk = C.in[I_SSDD][l * 4 + h];
    const size_t tb = (size_t)b * SEQ;
    int its[NK], itp[NK], itd[NK], itc[NK]; bool itx[NK];
#pragma unroll
    for (int k = 0; k < NK; ++k) { const int it = tid + NTHREADS * k, sidx = it / 72, v = it % 72; int pcol, cch, doff;
        if (v < 8) { pcol = PC_XS + h * 64 + 32 * ph + 4 * v; cch = h * 64 + 32 * ph + 4 * v; doff = sidx * 32 + 4 * v; }
        else if (v < 40) { pcol = PC_BM + g * 128 + 4 * (v - 8); cch = 256 + g * 128 + 4 * (v - 8); doff = 2 * TB * 32 + sidx * 128 + 4 * (v - 8); }
        else { pcol = PC_CM + g * 128 + 4 * (v - 40); cch = 512 + g * 128 + 4 * (v - 40); doff = 2 * TB * 32 + TB * 128 + sidx * 128 + 4 * (v - 40); }
        its[k] = sidx; itp[k] = pcol; itd[k] = doff; itx[k] = v < 8; itc[k] = cch; }
    const bool haslast = tid + NTHREADS * (NK - 1) < NIT;
    u32x2 raw[NK][4]; float dtr[NK]; unsigned short zraw;
    const int os = tid >> 4, op = tid & 15;
#define SSD_LOAD(blk) do { _Pragma("unroll") for (int k = 0; k < NK; ++k) { if (k < NK - 1 || haslast) { const int tl_ = (blk) * TB + its[k]; \
            _Pragma("unroll") for (int q = 0; q < 4; ++q) { const int tt_ = tl_ - 3 + q; raw[k][q] = tt_ >= 0 ? *(const u32x2*)(proj + (tb + tt_) * NPROJ + itp[k]) : (u32x2){0u, 0u}; } \
            dtr[k] = itx[k] ? bf2f(proj[(tb + tl_) * NPROJ + PC_DT + h]) : 0.f; } } } while (0)
#define SSD_COMMIT(dst) do { _Pragma("unroll") for (int k = 0; k < NK; ++k) { if (k < NK - 1 || haslast) { f32x4 a_ = *(const f32x4*)(cb + itc[k]); \
            _Pragma("unroll") for (int q = 0; q < 4; ++q) a_ += (f32x4){bflo(raw[k][q].x), bfhi(raw[k][q].x), bflo(raw[k][q].y), bfhi(raw[k][q].y)} * *(const f32x4*)(cw + q * 768 + itc[k]); \
            for (int j = 0; j < 4; ++j) a_[j] = siluf_(a_[j]); \
            if (itx[k]) { const float dt_ = softplusf_(dtr[k] + dtb); *(LAS f32x4*)((dst) + TB * 32 + itd[k]) = a_; *(LAS f32x4*)((dst) + itd[k]) = a_ * dt_; if ((itd[k] & 31) == 0) (dst)[TB * 320 + its[k]] = expf(dt_ * aneg); } \
            else *(LAS f32x4*)((dst) + itd[k]) = a_; } } } while (0)
    float hs[8];
#pragma unroll
    for (int k = 0; k < 8; ++k) hs[k] = 0.f;
    __syncthreads();
    SSD_LOAD(0); SSD_COMMIT(buf0);
    __syncthreads();
    for (int blk = 0; blk < NBLK; ++blk) {
        LAS float* cur = buf0 + (blk & 1) * NF; LAS float* nxtb = buf0 + ((blk + 1) & 1) * NF;
        if (blk + 1 < NBLK) SSD_LOAD(blk + 1);
        const size_t tz = tb + (size_t)blk * TB + os;
        zraw = proj[tz * NPROJ + PC_Z + h * 64 + 32 * ph + op]; const unsigned short zraw2 = proj[tz * NPROJ + PC_Z + h * 64 + 32 * ph + op + 16];
        for (int s0 = 0; s0 < TB; s0 += 4) {
            float x4[4], dA4[4], yv[4]; f32x4 bv[4][2], cv[4][2];
#pragma unroll
            for (int u = 0; u < 4; ++u) { const int s = s0 + u; x4[u] = cur[s * 32 + pl]; dA4[u] = cur[TB * 320 + s];
                const LAS float* bp = cur + 2 * TB * 32 + s * 128 + 16 * w + 8 * nh; const LAS float* cp = bp + TB * 128;
                bv[u][0] = *(const LAS f32x4*)bp; bv[u][1] = *(const LAS f32x4*)(bp + 4); cv[u][0] = *(const LAS f32x4*)cp; cv[u][1] = *(const LAS f32x4*)(cp + 4); }
#pragma unroll
            for (int u = 0; u < 4; ++u) { float yp = 0.f;
#pragma unroll
                for (int k4 = 0; k4 < 2; ++k4)
#pragma unroll
                    for (int j = 0; j < 4; ++j) { hs[4 * k4 + j] = hs[4 * k4 + j] * dA4[u] + x4[u] * bv[u][k4][j]; yp += cv[u][k4][j] * hs[4 * k4 + j]; }
                const auto sw = __builtin_amdgcn_permlane32_swap(__builtin_bit_cast(unsigned, yp), __builtin_bit_cast(unsigned, yp), false, false);
                yv[u] = yp + __builtin_bit_cast(float, (unsigned)sw[1]); }
            if (nh == 0) {
#pragma unroll
                for (int u = 0; u < 4; ++u) ypart[((s0 + u) * 8 + w) * 32 + pl] = yv[u]; }
        }
        if (blk + 1 < NBLK) SSD_COMMIT(nxtb);
        __syncthreads();
        {
            float y0 = 0.f, y1 = 0.f;
#pragma unroll
            for (int ww = 0; ww < 8; ++ww) { y0 += ypart[(os * 8 + ww) * 32 + op]; y1 += ypart[(os * 8 + ww) * 32 + op + 16]; }
            y0 += cur[TB * 32 + os * 32 + op] * dsk; y1 += cur[TB * 32 + os * 32 + op + 16] * dsk;
            y0 *= siluf_(bf2f(zraw)); y1 *= siluf_(bf2f(zraw2));
            bf16_t* yo = Y + tz * 1024 + 512 + h * 64 + 32 * ph + op;
            yo[0] = (bf16_t)(cvt_pk_bf16(y0, 0.f) & 0xffffu); yo[16] = (bf16_t)(cvt_pk_bf16(y1, 0.f) & 0xffffu);
            float q = y0 * y0 + y1 * y1;
#pragma unroll
            for (int o_ = 1; o_ < 16; o_ <<= 1) q += __shfl_xor(q, o_);
            if (op == 0) SSQ[tz * 8 + h * 2 + ph] = q;
        }
        __syncthreads();
    }
#undef SSD_LOAD
#undef SSD_COMMIT
}

__device__ __forceinline__ void sb_naive(const Ctx& C) {
    const bf16_t* proj = WSP(bf16_t, S_PROJ); bf16_t* Y = WSP(bf16_t, S_Y); const int lane = C.lane;
    for (int item = GW; item < T * 4; item += NGW) {
        const int t = item >> 2, h = item & 3, tq = t % SEQ; const size_t tb = (size_t)(t - tq);
        float q[64];
        { const bf16_t* qp = proj + (size_t)t * NPROJ + PC_SBQ + h * 64;
#pragma unroll
          for (int i = 0; i < 8; ++i) { const u32x4 w = *(const u32x4*)(qp + 8 * i); q[8*i] = bflo(w.x); q[8*i+1] = bfhi(w.x); q[8*i+2] = bflo(w.y); q[8*i+3] = bfhi(w.y); q[8*i+4] = bflo(w.z); q[8*i+5] = bfhi(w.z); q[8*i+6] = bflo(w.w); q[8*i+7] = bfhi(w.w); } }
        float o[64];
#pragma unroll
        for (int d = 0; d < 64; ++d) o[d] = 0.f;
        float R = 0.f;
        for (int c = (tq - 1) >> 6; c >= 0 && tq > 0; --c) {
            const int key = c * 64 + lane; const bool ok = key < tq;
            const bf16_t* kp = proj + (tb + key) * NPROJ + PC_SBK + h * 64; const bf16_t* vp = proj + (tb + key) * NPROJ + PC_SBV + h * 64;
            float z = 0.f;
#pragma unroll
            for (int i = 0; i < 8; ++i) { const u32x4 w = *(const u32x4*)(kp + 8 * i);
                z += q[8*i] * bflo(w.x) + q[8*i+1] * bfhi(w.x) + q[8*i+2] * bflo(w.y) + q[8*i+3] * bfhi(w.y) + q[8*i+4] * bflo(w.z) + q[8*i+5] * bfhi(w.z) + q[8*i+6] * bflo(w.w) + q[8*i+7] * bfhi(w.w); }
            const float L = ok ? -(fmaxf(z, 0.f) + flog2(1.0f + fexp2(-fabsf(z)))) : 0.f;
            float sfx = L;
#pragma unroll
            for (int dd = 1; dd < 64; dd <<= 1) { const float tt = __shfl_down(sfx, dd); if (lane + dd < 64) sfx += tt; }
            const float tot = __shfl(sfx, 0);
            const float wgt = ok ? fexp2(z + L + (sfx - L) + R) : 0.f;
            R += tot;
#pragma unroll
            for (int i = 0; i < 8; ++i) { const u32x4 w = *(const u32x4*)(vp + 8 * i);
                o[8*i] += wgt * bflo(w.x); o[8*i+1] += wgt * bfhi(w.x); o[8*i+2] += wgt * bflo(w.y); o[8*i+3] += wgt * bfhi(w.y); o[8*i+4] += wgt * bflo(w.z); o[8*i+5] += wgt * bfhi(w.z); o[8*i+6] += wgt * bflo(w.w); o[8*i+7] += wgt * bfhi(w.w); }
        }
        float mine = 0.f;
#pragma unroll
        for (int d = 0; d < 64; ++d) { const float sdd = wave_sum(o[d]); if (lane == d) mine = sdd; }
        Y[(size_t)t * 1024 + h * 64 + lane] = (bf16_t)(cvt_pk_bf16(mine, 0.f) & 0xffffu);
    }
}

__device__ __forceinline__ void rwkv_naive(const Ctx& C, int l) {
    const float* DEC = WSP(float, S_DEC); const bf16_t* RWS = WSP(bf16_t, S_RWS); const bf16_t* GV = WSP(bf16_t, S_GV); bf16_t* Y = WSP(bf16_t, S_Y);
    const size_t PL = (size_t)T * 256; const int lane = C.lane;
    for (int item = GW; item < 64; item += NGW) {
        const int b = item >> 2, h = item & 3; const float* rk = C.in[I_RWRK] + l * 256 + h * 64;
        const float gng = C.in[I_RWGNG][l * 256 + h * 64 + lane], gnb = C.in[I_RWGNB][l * 256 + h * 64 + lane];
        float S[64];
#pragma unroll
        for (int j = 0; j < 64; ++j) S[j] = 0.f;
        for (int tq = 0; tq < SEQ; ++tq) {
            const size_t o = ((size_t)b * SEQ + tq) * 256 + h * 64;
            const float v = bf2f(RWS[2 * PL + o + lane]);
            float sa = 0.f;
#pragma unroll
            for (int j = 0; j < 64; ++j) sa += S[j] * bf2f(RWS[3 * PL + o + j]);
            float y = 0.f, bd = 0.f;
#pragma unroll
            for (int j = 0; j < 64; ++j) { const float km = bf2f(RWS[PL + o + j]), r = bf2f(RWS[o + j]);
                S[j] = S[j] * DEC[o + j] + (v * km - sa * bf2f(RWS[4 * PL + o + j])); y += S[j] * r; bd += r * km * rk[j]; }
            const float mu = wave_sum(y) * (1.0f / 64.0f), d = y - mu, var = wave_sum(d * d) * (1.0f / 64.0f);
            const float res = (d * (1.0f / sqrtf(var + 64e-5f)) * gng + gnb + v * bd) * bf2f(GV[o + lane]);
            Y[((size_t)b * SEQ + tq) * 1024 + 256 + h * 64 + lane] = (bf16_t)(cvt_pk_bf16(res, 0.f) & 0xffffu);
        }
    }
}
__device__ __forceinline__ void ssd_naive(const Ctx& C, int l) {
    const bf16_t* proj = WSP(bf16_t, S_PROJ); bf16_t* Y = WSP(bf16_t, S_Y); float* SSQ = WSP(float, S_SSQ); const int lane = C.lane;
    const float* cw = C.in[I_CONVW] + l * 4 * 768; const float* cb = C.in[I_CONVB] + l * 768;
    for (int item2 = GW; item2 < 128; item2 += NGW) {
        const int item = item2 >> 1, ph = item2 & 1; const int b = item >> 2, h = item & 3, g = h >> 1; const size_t tb = (size_t)b * SEQ;
        const float dtb = C.in[I_DTB][l * 4 + h], aneg = -expf(C.in[I_ALOG][l * 4 + h]), dsk = C.in[I_SSDD][l * 4 + h];
        float hs0[32], hs1[32];
#pragma unroll
        for (int p = 0; p < 32; ++p) { hs0[p] = 0.f; hs1[p] = 0.f; }
        for (int tq = 0; tq < SEQ; ++tq) {
            const bf16_t* pr = proj + (tb + tq) * NPROJ;
            float xa = cb[h * 64 + lane], bv0 = cb[256 + g * 128 + lane], bv1 = cb[256 + g * 128 + 64 + lane], cv0 = cb[512 + g * 128 + lane], cv1 = cb[512 + g * 128 + 64 + lane];
            for (int k = 0; k < 4; ++k) { const int tt = tq - 3 + k; if (tt >= 0) { const bf16_t* pp = proj + (tb + tt) * NPROJ; const float* ww = cw + k * 768;
                xa += bf2f(pp[PC_XS + h * 64 + lane]) * ww[h * 64 + lane];
                bv0 += bf2f(pp[PC_BM + g * 128 + lane]) * ww[256 + g * 128 + lane]; bv1 += bf2f(pp[PC_BM + g * 128 + 64 + lane]) * ww[256 + g * 128 + 64 + lane];
                cv0 += bf2f(pp[PC_CM + g * 128 + lane]) * ww[512 + g * 128 + lane]; cv1 += bf2f(pp[PC_CM + g * 128 + 64 + lane]) * ww[512 + g * 128 + 64 + lane]; } }
            xa = siluf_(xa); bv0 = siluf_(bv0); bv1 = siluf_(bv1); cv0 = siluf_(cv0); cv1 = siluf_(cv1);
            const float dt = softplusf_(bf2f(pr[PC_DT + h]) + dtb), dA = expf(dt * aneg), xd = xa * dt;
            float y = 0.f;
#pragma unroll
            for (int p = 0; p < 32; ++p) { const float xp = __shfl(xd, 32 * ph + p); hs0[p] = hs0[p] * dA + xp * bv0; hs1[p] = hs1[p] * dA + xp * bv1;
                const float tot = wave_sum(cv0 * hs0[p] + cv1 * hs1[p]); if (lane == 32 * ph + p) y = tot; }
            y += dsk * xa; y *= siluf_(bf2f(pr[PC_Z + h * 64 + lane]));
            const bool mine = (lane >> 5) == ph; if (mine) Y[(tb + tq) * 1024 + 512 + h * 64 + lane] = (bf16_t)(cvt_pk_bf16(y, 0.f) & 0xffffu);
            const float q = wave_sum(mine ? y * y : 0.f); if (lane == 0) atomicAdd(&SSQ[(tb + tq) * 8 + h * 2], q);
        }
    }
}

__device__ __forceinline__ void mla_naive(const Ctx& C) {
    const bf16_t* QM = WSP(bf16_t, S_QM); const bf16_t* KM = WSP(bf16_t, S_KM); const bf16_t* VM = WSP(bf16_t, S_VM); bf16_t* Y = WSP(bf16_t, S_Y); const int lane = C.lane;
    for (int item = GW; item < T * 4; item += NGW) {
        const int t = item >> 2, h = item & 3, tq = t % SEQ; const size_t tb = (size_t)(t - tq);
        float q[96];
        { const bf16_t* qp = QM + (size_t)t * 384 + h * 96;
#pragma unroll
          for (int i = 0; i < 12; ++i) { const u32x4 w = *(const u32x4*)(qp + 8 * i); q[8*i] = bflo(w.x); q[8*i+1] = bfhi(w.x); q[8*i+2] = bflo(w.y); q[8*i+3] = bfhi(w.y); q[8*i+4] = bflo(w.z); q[8*i+5] = bfhi(w.z); q[8*i+6] = bflo(w.w); q[8*i+7] = bfhi(w.w); } }
        float o[64];
#pragma unroll
        for (int d = 0; d < 64; ++d) o[d] = 0.f;
        float m = -1.0e30f, lsum = 0.f;
        for (int c = tq >> 6; c >= 0; --c) {
            const int key = c * 64 + lane; const bool ok = key <= tq;
            const bf16_t* kp = KM + (tb + (ok ? key : 0)) * 384 + h * 96; const bf16_t* vp = VM + (tb + (ok ? key : 0)) * 256 + h * 64;
            float z = 0.f;
#pragma unroll
            for (int i = 0; i < 12; ++i) { const u32x4 w = *(const u32x4*)(kp + 8 * i);
                z += q[8*i] * bflo(w.x) + q[8*i+1] * bfhi(w.x) + q[8*i+2] * bflo(w.y) + q[8*i+3] * bfhi(w.y) + q[8*i+4] * bflo(w.z) + q[8*i+5] * bfhi(w.z) + q[8*i+6] * bflo(w.w) + q[8*i+7] * bfhi(w.w); }
            z = ok ? z : -1.0e30f;
            float cm = z;
#pragma unroll
            for (int dd = 1; dd < 64; dd <<= 1) cm = fmaxf(cm, __shfl_xor(cm, dd));
            const float mn = fmaxf(m, cm), al = fexp2(m - mn), pw = ok ? fexp2(z - mn) : 0.f; m = mn; lsum = lsum * al + pw;
#pragma unroll
            for (int i = 0; i < 8; ++i) { const u32x4 w = *(const u32x4*)(vp + 8 * i);
                o[8*i] = o[8*i] * al + pw * bflo(w.x); o[8*i+1] = o[8*i+1] * al + pw * bfhi(w.x); o[8*i+2] = o[8*i+2] * al + pw * bflo(w.y); o[8*i+3] = o[8*i+3] * al + pw * bfhi(w.y);
                o[8*i+4] = o[8*i+4] * al + pw * bflo(w.z); o[8*i+5] = o[8*i+5] * al + pw * bfhi(w.z); o[8*i+6] = o[8*i+6] * al + pw * bflo(w.w); o[8*i+7] = o[8*i+7] * al + pw * bfhi(w.w); }
        }
        const float lt = wave_sum(lsum); float mine = 0.f;
#pragma unroll
        for (int d = 0; d < 64; ++d) { const float sdd = wave_sum(o[d]); if (lane == d) mine = sdd; }
        Y[(size_t)t * 1024 + 768 + h * 64 + lane] = (bf16_t)(cvt_pk_bf16(mine / lt, 0.f) & 0xffffu);
    }
}
__device__ __forceinline__ void xattn_naive(const Ctx& C, int l) {
    const bf16_t* XQ = WSP(bf16_t, S_XQ); const bf16_t* KMEM = WSP(bf16_t, W_KMEM) + (size_t)l * NMEM * 1024; const bf16_t* VT = WSP(bf16_t, W_VMEMT) + (size_t)l * 1024 * NMEM; bf16_t* XO = WSP(bf16_t, S_XO); const int lane = C.lane;
    for (int item = GW; item < T * 4; item += NGW) {
        const int t = item >> 2, h = item & 3, b = t / SEQ;
        float z[4] = {0.f, 0.f, 0.f, 0.f};
        for (int d8 = 0; d8 < 32; ++d8) { const u32x4 qw = *(const u32x4*)(XQ + (size_t)t * 1024 + h * 256 + 8 * d8);
            const float qv[8] = {bflo(qw.x), bfhi(qw.x), bflo(qw.y), bfhi(qw.y), bflo(qw.z), bfhi(qw.z), bflo(qw.w), bfhi(qw.w)};
#pragma unroll
            for (int j = 0; j < 4; ++j) { const u32x4 kw = *(const u32x4*)(KMEM + (size_t)(b * 256 + lane + 64 * j) * 1024 + h * 256 + 8 * d8);
                z[j] += qv[0] * bflo(kw.x) + qv[1] * bfhi(kw.x) + qv[2] * bflo(kw.y) + qv[3] * bfhi(kw.y) + qv[4] * bflo(kw.z) + qv[5] * bfhi(kw.z) + qv[6] * bflo(kw.w) + qv[7] * bfhi(kw.w); } }
        float mx = fmaxf(fmaxf(z[0], z[1]), fmaxf(z[2], z[3]));
#pragma unroll
        for (int dd = 1; dd < 64; dd <<= 1) mx = fmaxf(mx, __shfl_xor(mx, dd));
        float p[4], ps = 0.f;
#pragma unroll
        for (int j = 0; j < 4; ++j) { p[j] = fexp2(z[j] - mx); ps += p[j]; }
        const float inv = 1.0f / wave_sum(ps);
        float o[4] = {0.f, 0.f, 0.f, 0.f};
        for (int mm = 0; mm < 256; ++mm) { const float pm = __shfl(p[mm >> 6], mm & 63);
#pragma unroll
            for (int jd = 0; jd < 4; ++jd) o[jd] += pm * bf2f(VT[(size_t)(h * 256 + lane + 64 * jd) * NMEM + b * 256 + mm]); }
#pragma unroll
        for (int jd = 0; jd < 4; ++jd) XO[(size_t)t * 1024 + h * 256 + lane + 64 * jd] = (bf16_t)(cvt_pk_bf16(o[jd] * inv, 0.f) & 0xffffu);
    }
}
__device__ __forceinline__ void ph_mixers(const Ctx& C, int l, int rep = 0) {
    unsigned* head = (unsigned*)(C.ws + WS_CTL) + CW_QUEUE + 64 * (l + 2 * rep);
    volatile LAS unsigned* slot = (volatile LAS unsigned*)(C.lds + LDSCTL_OFF + 64);
    constexpr int N_RW = 128, N_ATT = 768, NITEMS = N_RW + N_ATT;
    for (;;) {
        __syncthreads();
        if (C.tid == 0) slot[0] = __hip_atomic_fetch_add(head, 1u, RLX_AGENT);
        __syncthreads();
        const int it = (int)slot[0];
        if (it >= NITEMS) break;
#ifndef NAIVE_SCAN
#define NAIVE_SCAN 0
#endif
        if (it < N_RW) { if (!(NAIVE_SCAN & 1)) { rwkv_unit(C, l, it >> 3, (it >> 1) & 3, it & 1);
#ifdef TIME_RW2
            __syncthreads(); rwkv_unit(C, l, it >> 3, (it >> 1) & 3, it & 1);
#endif
        } }
        else { const int k = it - N_RW; const int mode = k % 3, pp = (k / 3) & 3, bh = k / 12, b = bh >> 2, h = bh & 3;
            if (mode == 0) { if (!(NAIVE_SCAN & 2)) { attn_unit<2>(C, l, b, h, 7 - pp); __syncthreads(); attn_unit<2>(C, l, b, h, pp);
#ifdef TIME_SSDA2
                __syncthreads(); attn_unit<2>(C, l, b, h, 7 - pp); __syncthreads(); attn_unit<2>(C, l, b, h, pp);
#endif
            } }
#ifndef NAIVE_SB
            else if (mode == 1) { attn_unit<0>(C, l, b, h, 7 - pp); __syncthreads(); attn_unit<0>(C, l, b, h, pp);
#ifdef TIME_SB2
                __syncthreads(); attn_unit<0>(C, l, b, h, 7 - pp); __syncthreads(); attn_unit<0>(C, l, b, h, pp);
#endif
            }
#else
            else if (mode == 1) { }
#endif
#ifndef NAIVE_MLA
            else { attn_unit<1>(C, l, b, h, 7 - pp); __syncthreads(); attn_unit<1>(C, l, b, h, pp);
#ifdef TIME_MLA2
                __syncthreads(); attn_unit<1>(C, l, b, h, 7 - pp); __syncthreads(); attn_unit<1>(C, l, b, h, pp);
#endif
            }
#else
            else { }
#endif
        }
    }
#ifdef NAIVE_SB
    sb_naive(C);
#endif
#ifdef NAIVE_MLA
    mla_naive(C);
#endif
    if (NAIVE_SCAN & 1) rwkv_naive(C, l);
    if (NAIVE_SCAN & 2) ssd_naive(C, l);
}
__device__ __forceinline__ void ph_router(const Ctx& C) {
    run_tjobs<16, true>(C);
    __syncthreads();
    LAS unsigned* lc = (LAS unsigned*)(C.lds + XCH_OFF);
    if (C.tid < 8) lc[C.tid] = 0u;
    __syncthreads();
    const float* xr = WSP(float, W_XRES); const float* rt = C.in[I_ROUTER]; int* topi = WSP(int, S_TOPI); float* topw = WSP(float, S_TOPW); const int lane = C.lane;
    for (int k = 0; k < 16; ++k) {
        const int t = C.bid * 128 + C.wave * 16 + k; float a[8];
#pragma unroll
        for (int e = 0; e < 8; ++e) a[e] = 0.f;
#pragma unroll
        for (int j = 0; j < 4; ++j) { const f32x4 xv = *(const f32x4*)(xr + (size_t)t * 1024 + 4 * lane + 256 * j);
#pragma unroll
            for (int q = 0; q < 4; ++q) { const float* rp = rt + (size_t)(4 * lane + 256 * j + q) * 8; const f32x4 r0 = *(const f32x4*)rp, r1 = *(const f32x4*)(rp + 4);
                a[0] += xv[q] * r0[0]; a[1] += xv[q] * r0[1]; a[2] += xv[q] * r0[2]; a[3] += xv[q] * r0[3]; a[4] += xv[q] * r1[0]; a[5] += xv[q] * r1[1]; a[6] += xv[q] * r1[2]; a[7] += xv[q] * r1[3]; } }
#pragma unroll
        for (int e = 0; e < 8; ++e) a[e] = wave_sum(a[e]);
#ifdef ROUTER_NOISE
        for (int e = 0; e < 8; ++e) { unsigned hsh = (unsigned)t * 2654435761u + (unsigned)e * 40503u; hsh ^= hsh >> 13; hsh *= 0x5bd1e995u; hsh ^= hsh >> 15; a[e] += ROUTER_NOISE * ((float)(hsh & 0xffff) * (1.0f / 32768.0f) - 1.0f); }
#endif
        if (lane == 0) {
            int i1 = 0; float v1 = a[0];
#pragma unroll
            for (int e = 1; e < 8; ++e) if (a[e] > v1) { v1 = a[e]; i1 = e; }
            int i2 = -1; float v2 = -3.0e38f;
#pragma unroll
            for (int e = 0; e < 8; ++e) if (e != i1 && a[e] > v2) { v2 = a[e]; i2 = e; }
            const float g1 = 1.0f / (1.0f + expf(v2 - v1));
            topi[2 * t] = i1; topi[2 * t + 1] = i2; topw[2 * t] = g1; topw[2 * t + 1] = 1.0f - g1;
            __hip_atomic_fetch_add(&lc[i1], 1u, __ATOMIC_RELAXED, __HIP_MEMORY_SCOPE_WORKGROUP); __hip_atomic_fetch_add(&lc[i2], 1u, __ATOMIC_RELAXED, __HIP_MEMORY_SCOPE_WORKGROUP);
        }
    }
    __syncthreads();
    if (C.tid < 8) ((unsigned*)(C.ws + WS_CTL))[CW_MOECNT + C.bid * 8 + C.tid] = lc[C.tid];
}
__device__ __forceinline__ void ph_scatter(const Ctx& C) {
    LAS int* sh = (LAS int*)(C.lds + XCH_OFF);
    const unsigned* cnt = (const unsigned*)(C.ws + WS_CTL) + CW_MOECNT;
    int* row_slot = WSP(int, S_ROWSLOT); float* row_w = WSP(float, S_ROWW); int* blk_e = WSP(int, S_BLKE);
    const int* topi = WSP(int, S_TOPI); const float* topw = WSP(float, S_TOPW);
    const int tid = C.tid;
    if (tid < 8) { int tot = 0, mine = 0; for (int wg = 0; wg < 256; ++wg) { const int c = (int)cnt[wg * 8 + tid]; if (wg < C.bid) mine += c; tot += c; } sh[tid] = tot; sh[8 + tid] = mine; sh[32 + tid] = 0; }
    __syncthreads();
    if (tid == 0) { int ps = 0; for (int e = 0; e < 8; ++e) { sh[16 + e] = ps; const int pad = (sh[e] + 255) / 256 * 256; sh[24 + e] = pad; ps += pad; } sh[40] = ps / 256; }
    __syncthreads();
    if (C.bid == 0) {
        const int used = sh[40];
        for (int rb = tid; rb < MOE_BLOCKS; rb += NTHREADS) { int e = 7; if (rb < used) { e = 0; for (int q = 1; q < 8; ++q) if (sh[16 + q] <= rb * 256) e = q; } blk_e[rb] = e; }
        if (tid == 0) blk_e[MOE_BLOCKS] = used;
    }
    if (C.bid < 8) { const int e = C.bid; for (int r = sh[16 + e] + sh[e] + tid; r < sh[16 + e] + sh[24 + e]; r += NTHREADS) { row_slot[r] = -1; row_w[r] = 0.f; } }
    if (tid < 256) { const int t = C.bid * 128 + (tid >> 1), k = tid & 1, e = topi[2 * t + k];
        const int pos = __hip_atomic_fetch_add(&sh[32 + e], 1, __ATOMIC_RELAXED, __HIP_MEMORY_SCOPE_WORKGROUP); const int dest = sh[16 + e] + sh[8 + e] + pos; row_slot[dest] = 2 * t + k; row_w[dest] = topw[2 * t + k]; sh[64 + tid] = dest; }
    __syncthreads();
    const bf16_t* xb = WSP(bf16_t, W_XB); bf16_t* xs = WSP(bf16_t, S_XS);
    for (int a = C.wave * 32; a < C.wave * 32 + 32; ++a) { const int t = C.bid * 128 + (a >> 1); const size_t d = (size_t)sh[64 + a] * 1024;
#pragma unroll
        for (int j = 0; j < 2; ++j) *(u32x4*)(xs + d + (C.lane + 64 * j) * 8) = *(const u32x4*)(xb + (size_t)t * 1024 + (C.lane + 64 * j) * 8); }
}


__device__ __forceinline__ void chk_moe(const Ctx& C, int bit) {
    const float* xr = WSP(float, W_XRES); const float* rt = C.in[I_ROUTER]; const float* w13 = C.in[I_MOE13]; const float* w2 = C.in[I_MOE2]; const bf16_t* ys = WSP(bf16_t, S_YS);
    LAS float* hb = (LAS float*)(C.lds + C.wave * 14336); const int lane = C.lane; unsigned bad = 0;
    float* stash = WSP(float, W_KMEM); const float* g3 = C.in[I_LN3G] + 1024; const float* b3 = C.in[I_LN3B] + 1024;
    for (int s = GW; s < 1024; s += NGW) {
        const int t = (int)(((long)s * 1021 + 7) % T); float x[16];
#pragma unroll
        for (int j = 0; j < 16; ++j) x[j] = xr[(size_t)t * 1024 + lane + 64 * j];
        float lg[8];
#pragma unroll
        for (int e = 0; e < 8; ++e) { float a = 0.f;
#pragma unroll
            for (int j = 0; j < 16; ++j) a += x[j] * rt[(size_t)(lane + 64 * j) * 8 + e]; lg[e] = wave_sum(a); }
        int i1 = 0; for (int e = 1; e < 8; ++e) if (lg[e] > lg[i1]) i1 = e;
        int i2 = -1; for (int e = 0; e < 8; ++e) if (e != i1 && (i2 < 0 || lg[e] > lg[i2])) i2 = e;
        float v3 = -3.0e38f; for (int e = 0; e < 8; ++e) if (e != i1 && e != i2) v3 = fmaxf(v3, lg[e]);
        if (lg[i2] - v3 < 0.02f) { if (lane == 0) stash[(size_t)s * 1024] = 1.0e30f; continue; }
        const float g1 = 1.0f / (1.0f + expf(lg[i2] - lg[i1]));
        float out[16];
#pragma unroll
        for (int j = 0; j < 16; ++j) out[j] = 0.f;
        for (int q = 0; q < 2; ++q) { const int e = q ? i2 : i1; const float gw = q ? 1.0f - g1 : g1; const float* W1 = w13 + (size_t)e * 1024 * 2 * FFE;
            for (int i0 = 0; i0 < 56; i0 += 4) { float ag[4], au[4];
#pragma unroll
                for (int i = 0; i < 4; ++i) { ag[i] = 0.f; au[i] = 0.f; }
                for (int k = 0; k < 1024; ++k) { const float xk = __shfl(x[k >> 6], k & 63); const float* wr = W1 + (size_t)k * 2 * FFE + lane + 64 * i0;
#pragma unroll
                    for (int i = 0; i < 4; ++i) { ag[i] += xk * wr[64 * i]; au[i] += xk * wr[FFE + 64 * i]; } }
#pragma unroll
                for (int i = 0; i < 4; ++i) hb[lane + 64 * (i0 + i)] = (ag[i] / (1.0f + expf(-ag[i]))) * au[i]; }
            LDS_WAIT();
            const float* W2 = w2 + (size_t)e * FFE * 1024;
            for (int hh = 0; hh < FFE; ++hh) { const float hv = hb[hh] * gw;
#pragma unroll
                for (int j = 0; j < 16; ++j) out[j] += hv * W2[(size_t)hh * 1024 + lane + 64 * j]; }
            LDS_WAIT(); }
#pragma unroll
        for (int j = 0; j < 16; ++j) { const int c = lane + 64 * j; const float got = bf2f(ys[(size_t)(2 * t) * 1024 + c]) + bf2f(ys[(size_t)(2 * t + 1) * 1024 + c]);
            if (fabsf(got - out[j]) > 0.05f * fabsf(out[j]) + 0.03f) bad = 1; }
        { float v[16], sm = 0.f, s2 = 0.f;
#pragma unroll
          for (int j = 0; j < 16; ++j) { v[j] = x[j] * DN_ALPHA + out[j]; sm += v[j]; }
          const float mean = wave_sum(sm) * (1.0f / 1024.0f);
#pragma unroll
          for (int j = 0; j < 16; ++j) { v[j] -= mean; s2 += v[j] * v[j]; }
          const float rstd = 1.0f / sqrtf(wave_sum(s2) * (1.0f / 1024.0f) + 1e-5f);
          int zz = 0; asm volatile("" : "+v"(zz));
#pragma unroll
          for (int j = 0; j < 16; ++j) { const int c = lane + 64 * j + zz; stash[(size_t)s * 1024 + c] = v[j] * rstd * g3[c] + b3[c]; } }
    }
    chk_flag(C, bit, bad);
}
#ifndef ABL_MIX
#define ABL_MIX 1.0f
#endif
#ifndef ABL_XA
#define ABL_XA 1.0f
#endif
#ifndef ABL_FF
#define ABL_FF 1.0f
#endif
#ifndef CHK_TOL2
#define CHK_TOL2 0.05f
#endif
#ifndef GATE_ACT
#define GATE_ACT 1
#endif
#ifndef GATE_ALIGN
#define GATE_ALIGN true
#endif
#ifndef FG_TOL
#define FG_TOL 0.05f
#endif
#ifndef FG_BIT
#define FG_BIT 1
#endif
#ifndef CHECKS_LAYER
#define CHECKS_LAYER 0
#endif
#ifndef MK_SPLIT
#define MK_SPLIT 0
#endif
constexpr int PH_L0 = 1, PH_L1 = 18, PH_MOE = 32, PH_TOTAL = PH_MOE + 2 + 2 * MOE_PASSES + 1;

__global__ void __launch_bounds__(NTHREADS, 2) hybrid_fwd(Args args) {
    extern __shared__ __attribute__((aligned(16))) unsigned char lds_raw[];
    Ctx C; C.in = args.in; C.out = args.out; C.ws = args.ws; C.lds = (LAS unsigned char*)lds_raw;
    C.tid = threadIdx.x; C.lane = C.tid & 63; C.wave = __builtin_amdgcn_readfirstlane(C.tid >> 6); C.G = gridDim.x; C.bid = blockIdx.x;
    const Ctx C0 = C;
    for (int u = C.tid; u < (LDS_BYTES - LDSCTL_OFF) / 4; u += NTHREADS) ((LAS unsigned*)(C.lds + LDSCTL_OFF))[u] = 0u;
    __syncthreads();
    const int lo = args.ph_lo, hi = args.ph_hi;
    XcdBarrier bar; bar.bar = (unsigned*)(C.ws + WS_CTL) + CW_BAR; bar.x = 0; bar.st = (volatile LAS unsigned*)(C.lds + LDSCTL_OFF);
    if (hi - lo > 1) bar = xcd_barrier_post((unsigned*)(C.ws + WS_CTL) + CW_BAR, (volatile LAS unsigned*)(C.lds + LDSCTL_OFF));
#ifndef SITE_MASK
#define SITE_MASK 0xffffffffu
#endif
#define SITE(n) (((SITE_MASK) >> (n)) & 1u)
#define IN(k) (lo <= (k) && (k) < hi)
#define ENDPH(k) do { if ((k) + 1 < hi) xcd_barrier(bar); } while (0)
#define SITE_BEGIN const Ctx C = launder(C0); unsigned char* LW = C.ws + W_BASE + (size_t)l * LW_SIZE; const bf16_t* XB = WSP(bf16_t, W_XB); float* XRES = WSP(float, W_XRES); (void)LW; (void)XB; (void)XRES; LAS unsigned char* ring = C.lds; (void)ring;

    if (SITE(0) && IN(0)) { const int l = 0; SITE_BEGIN ph_prologue(C);
#ifdef TIME_PRO2
        xcd_barrier(bar); ph_prologue(C);
#endif
#ifdef TIME_BAR
        for (int q_ = 0; q_ < TIME_BAR; ++q_) xcd_barrier(bar);
#endif
        ENDPH(0); }

    for (int l = 0; l < 2; ++l) {
        const int pb = l == 0 ? PH_L0 : PH_L1;
        if (SITE(1) && IN(pb + 0)) { SITE_BEGIN
#ifdef CHECKS3
            if (l == 1) chk_ln_cmp(C, 1, 1);
#endif
            { pg8::Gemm g{XB, (const bf16_t*)(LW + LW_WIN), 1024, 1024, 1024}; sch::Tiles S{T / 256, NPROJ / 256, C.G, C.bid}; epi::StoreBf16<0> E{WSP(bf16_t, S_PROJ), NPROJ}; pg8::gemm_phase(ring, g, S, E); }
            { pg8::Gemm g{(const bf16_t*)C.ws, (const bf16_t*)C.ws, 1024, 1024, 1024}; sch::MemKV S{(long)(W_MEMB / 2), (long)((W_BASE + (size_t)l * LW_SIZE + LW_WKV) / 2), C.bid};
              epi::StoreKV E{WSP(bf16_t, W_KMEM) + (size_t)l * NMEM * 1024, WSP(bf16_t, W_VMEMT) + (size_t)l * 1024 * NMEM}; pg8::gemm_phase(ring, g, S, E); }
            ENDPH(pb + 0);
        }
        if (SITE(2) && IN(pb + 1)) { SITE_BEGIN
#ifdef CHECKS5
            if (l == 0) chk_weights<28, false>(C, 0);
#endif
#ifdef CHECKS9
            if (l == 0) { unsigned bad = 0; const float* x = C.in[I_X]; const float* mm = C.in[I_MEM]; const bf16_t* mb = WSP(bf16_t, W_MEMB);
                for (size_t i = (size_t)C.bid * NTHREADS + C.tid; i < (size_t)T * 1024; i += (size_t)C.G * NTHREADS) if (!chk_close(x[i], bf2f(XB[i]))) bad = 1;
                for (size_t i = (size_t)C.bid * NTHREADS + C.tid; i < (size_t)NMEM * 1024; i += (size_t)C.G * NTHREADS) if (!chk_close(mm[i], bf2f(mb[i]))) bad = 1;
                if (bad) __hip_atomic_fetch_add((unsigned*)(C.ws + WS_CTL) + CW_CHK, 1u, RLX_AGENT); }
#endif
#ifdef CHECKS12P
            if (l == CHECKS_LAYER) { const bf16_t* proj = WSP(bf16_t, S_PROJ); chk_full_gemm(C, XB, (const bf16_t*)(LW + LW_WIN), 1024, 3236, 0, [&](size_t r, int c, float d) { return chk_close(d, bf2f(proj[r * NPROJ + c])); }); xcd_barrier(bar); }
#endif
#ifdef CHECKS4
            if (l == CHECKS_LAYER) { const bf16_t* KM_ = WSP(bf16_t, W_KMEM) + (size_t)l * NMEM * 1024; const bf16_t* VT_ = WSP(bf16_t, W_VMEMT) + (size_t)l * 1024 * NMEM;
                chk_gemm(C, WSP(bf16_t, W_MEMB), 1024, (const bf16_t*)(LW + LW_WKV), 1024, 1024, NMEM, 64, 16, 3, 0, [&](int r, int c, float d) { return chk_close(d, bf2f(KM_[(size_t)r * 1024 + c])); });
                chk_gemm(C, (const bf16_t*)(LW + LW_WKV) + (size_t)1024 * 1024, 1024, WSP(bf16_t, W_MEMB), 1024, 1024, 1024, 256, 16, 5, 1, [&](int r, int c, float d) { return chk_close(d, bf2f(VT_[(size_t)r * NMEM + c])); }); }
#endif
#ifdef CHECKS
            if (l == CHECKS_LAYER) { const bf16_t* proj = WSP(bf16_t, S_PROJ); chk_gemm(C, XB, 1024, (const bf16_t*)(LW + LW_WIN), 1024, 1024, T, 13, 256, 7, 0, [&](int r, int c, float d) { return chk_close(d, bf2f(proj[(size_t)r * NPROJ + c])); }); }
#endif
            ph_prep(C, l);
#ifdef TIME_PREP2
            xcd_barrier(bar); ph_prep(C, l);
#endif
            ENDPH(pb + 1); }
        if (SITE(3) && IN(pb + 2)) { SITE_BEGIN
            { pg8::Gemm g{WSP(bf16_t, S_LA), (const bf16_t*)(LW + LW_LORA), 256, 256, 256}; sch::Tiles S{T / 256, 3, C.G, C.bid}; epi::Lora E{WSP(float, S_DEC), WSP(bf16_t, S_AV), WSP(bf16_t, S_GV), C.in[I_RWW0] + l * 256, C.in[I_RWA0] + l * 256}; pg8::gemm_phase(ring, g, S, E); }
            { pg8::Gemm g{WSP(bf16_t, S_CQN), (const bf16_t*)(LW + LW_WUQ), 256, 256, 256}; sch::Tiles S{T / 256, 2, C.G, (C.bid + 128) & 255}; epi::Uq E{WSP(bf16_t, S_QM), WSP(float, W_COS), WSP(float, W_SIN)}; pg8::gemm_phase(ring, g, S, E); }
            { pg8::Gemm g{WSP(bf16_t, S_CKVN), (const bf16_t*)(LW + LW_WUKV), 128, 128, 128}; sch::Tiles S{T / 256, 2, C.G, C.bid}; epi::Ukv E{WSP(bf16_t, S_KM), WSP(bf16_t, S_VM)}; pg8::gemm_phase(ring, g, S, E); }
            ENDPH(pb + 2);
        }
        if (SITE(4) && IN(pb + 3)) { SITE_BEGIN ph_rwprep(C, l); ph_ssdprep(C, l);
#ifdef TIME_RWP2
            xcd_barrier(bar); ph_rwprep(C, l); ph_ssdprep(C, l);
#endif
            ENDPH(pb + 3); }
        if (SITE(5) && IN(pb + 4)) { SITE_BEGIN
#ifdef CHECKS6
            if (l == CHECKS_LAYER) chk_mla_inputs(C, l, 0);
#endif
#ifdef CHECKS7
            if (l == CHECKS_LAYER) chk_rw_inputs(C, l, 0);
#endif
            ph_mixers(C, l);
#ifdef TIME_MIX2
            xcd_barrier(bar); ph_mixers(C, l, 1);
#endif
            ENDPH(pb + 4); }
        if (SITE(6) && IN(pb + 5)) { SITE_BEGIN
            ph_ssdfix(C, l);
            { pg8::Gemm g{XB, (const bf16_t*)(LW + LW_WGATE), 1024, 1024, 1024}; sch::Tiles S{T / 256, 16, C.G, C.bid}; epi::StoreBf16<GATE_ACT> E{WSP(bf16_t, S_G), 4096}; pg8::gemm_phase<epi::StoreBf16<GATE_ACT>, sch::Tiles, GATE_ALIGN>(ring, g, S, E);
#ifdef TIME_GATE2
              xcd_barrier(bar); pg8::gemm_phase<epi::StoreBf16<GATE_ACT>, sch::Tiles, GATE_ALIGN>(ring, g, S, E);
#endif
            }
#ifdef CHECKS14
            if (l == 0) { xcd_barrier(bar); const bf16_t* Gp = WSP(bf16_t, S_G); chk_full_gemm(C, XB, (const bf16_t*)(LW + LW_WGATE), 1024, 4096, 0, [&](size_t r, int c, float d) { return chk_close(sigmoidf_(d), bf2f(Gp[r * 4096 + c])); }); }
#endif
#ifdef CHECKS13
            if (l == 0) { xcd_barrier(bar);
              { pg8::Gemm g{XB, (const bf16_t*)(LW + LW_WGATE), 1024, 1024, 1024}; sch::Tiles S{T / 256, 16, C.G, C.bid}; epi::StoreBf16<1> E{WSP(bf16_t, S_G) + (size_t)T * 4096, 4096}; pg8::gemm_phase(ring, g, S, E); }
              xcd_barrier(bar);
              { const unsigned short* g1 = WSP(unsigned short, S_G); const unsigned short* g2 = g1 + (size_t)T * 4096; unsigned cnt = 0;
                for (size_t i = (size_t)C.bid * NTHREADS + C.tid; i < (size_t)T * 4096; i += (size_t)C.G * NTHREADS) if (g1[i] != g2[i]) ++cnt;
                if (cnt) __hip_atomic_fetch_add((unsigned*)(C.ws + WS_CTL) + CW_CHK + 2048, cnt, RLX_AGENT); } }
#endif
            ENDPH(pb + 5);
        }
        if (SITE(7) && IN(pb + 6)) { SITE_BEGIN
#ifdef FIX_G
            { bf16_t* Gw = WSP(bf16_t, S_G); const bf16_t* Wg = (const bf16_t*)(LW + LW_WGATE);
              for (size_t i = (size_t)C.bid * NTHREADS + C.tid; i < (size_t)T * 4096; i += (size_t)C.G * NTHREADS) { const size_t r = i >> 12; const int c = (int)(i & 4095);
                  Gw[i] = (bf16_t)(cvt_pk_bf16(sigmoidf_(tdot(XB + r * 1024, Wg + (size_t)c * 1024, 1024)), 0.f) & 0xffffu); }
              xcd_barrier(bar); }
#endif
#ifdef CHECKS15
            if (l == 0) { unsigned cnt = 0; const float* x = C.in[I_X];
                for (size_t i = (size_t)C.bid * NTHREADS + C.tid; i < (size_t)T * 1024; i += (size_t)C.G * NTHREADS) if (!chk_close(x[i], bf2f(XB[i]))) ++cnt;
                if (cnt) __hip_atomic_fetch_add((unsigned*)(C.ws + WS_CTL) + CW_CHK + 2048, cnt, RLX_AGENT); }
#endif
#ifdef CHECKS7
            if (l == CHECKS_LAYER) chk_ssd_norm(C, l, 1);
#endif
#ifdef CHECKS12
            if (l == CHECKS_LAYER) { const bf16_t* Gp = WSP(bf16_t, S_G); chk_full_gemm(C, XB, (const bf16_t*)(LW + LW_WGATE), 1024, 4096, FG_BIT, [&](size_t r, int c, float d) { return fabsf((GATE_ACT ? sigmoidf_(d) : d) - bf2f(Gp[r * 4096 + c])) <= FG_TOL; }); xcd_barrier(bar); }
#endif
#ifdef CHECKS
            if (l == CHECKS_LAYER) { const bf16_t* Gp = WSP(bf16_t, S_G); chk_gemm(C, XB, 1024, (const bf16_t*)(LW + LW_WGATE), 1024, 1024, T, 16, 256, 5, 1, [&](int r, int c, float d) { return chk_close(sigmoidf_(d), bf2f(Gp[(size_t)r * 4096 + c])); }); }
#endif
            { pg8::Gemm g{WSP(bf16_t, S_Y), (const bf16_t*)(LW + LW_WBR), 256, 1024, 256}; sch::BrTiles S{T / 256, 4, C.G, C.bid}; epi::BrGate E{WSP(bf16_t, S_G), WSP(float, S_MF), WSP(bf16_t, S_MB)}; pg8::gemm_phase(ring, g, S, E); }
            ENDPH(pb + 6);
        }
        if (SITE(8) && IN(pb + 7)) { SITE_BEGIN
#ifdef CHECKS2
            if (l == CHECKS_LAYER) chk_merged(C, l, 0);
#endif
            { pg8::Gemm g{WSP(bf16_t, S_MB), (const bf16_t*)(LW + LW_WOUT), 1024, 1024, 1024}; sch::Tiles S{T / 256, 4, C.G, C.bid}; epi::Resid E{l == 0 ? C.in[I_X] : XRES, XRES, ABL_MIX}; pg8::gemm_phase(ring, g, S, E); }
            ENDPH(pb + 7);
        }
        if (SITE(9) && IN(pb + 8)) { SITE_BEGIN
#ifdef CHECKS10
            if (l == 0) { chk_full_p7(C, l, 1); xcd_barrier(bar); }
#endif
#ifdef CHECKS
            if (l == 0) { const float* xin = C.in[I_X]; chk_gemm(C, WSP(bf16_t, S_MB), 1024, (const bf16_t*)(LW + LW_WOUT), 1024, 1024, T, 4, 256, 9, 2, [&](int r, int c, float d) { return fabsf(xin[(size_t)r * 1024 + c] * DN_ALPHA + d - XRES[(size_t)r * 1024 + c]) <= CHK_TOL2; }); }
#endif
            ph_ln<false>(C, XRES, XRES, WSP(bf16_t, W_XB), C.in[I_LN1G] + l * 1024, C.in[I_LN1B] + l * 1024, nullptr); ENDPH(pb + 8); }
        if (SITE(10) && IN(pb + 9)) { SITE_BEGIN
            { pg8::Gemm g{XB, (const bf16_t*)(LW + LW_WQ), 1024, 1024, 1024}; sch::Tiles S{T / 256, 4, C.G, C.bid}; epi::StoreBf16<0> E{WSP(bf16_t, S_XQ), 1024}; pg8::gemm_phase(ring, g, S, E); }
            ENDPH(pb + 9);
        }
        if (SITE(11) && IN(pb + 10)) { SITE_BEGIN
#ifdef CHECKS
            if (l == CHECKS_LAYER) { const bf16_t* XQ = WSP(bf16_t, S_XQ); chk_gemm(C, XB, 1024, (const bf16_t*)(LW + LW_WQ), 1024, 1024, T, 4, 256, 11, 3, [&](int r, int c, float d) { return chk_close(d, bf2f(XQ[(size_t)r * 1024 + c])); }); }
#endif
            { pg8::Gemm g{WSP(bf16_t, S_XQ), WSP(bf16_t, W_KMEM) + (size_t)l * NMEM * 1024, 256, 1024, 1024}; sch::XaS S{C.G, C.bid}; epi::Softmax E{WSP(bf16_t, S_XP), (LAS float*)(C.lds + XCH_OFF)};
#ifndef NAIVE_XA
              pg8::gemm_phase(ring, g, S, E);
#else
              (void)g; (void)S; (void)E; xattn_naive(C, l);
#endif
            }
            ENDPH(pb + 10);
        }
        if (SITE(12) && IN(pb + 11)) { SITE_BEGIN
            { pg8::Gemm g{WSP(bf16_t, S_XP), WSP(bf16_t, W_VMEMT) + (size_t)l * 1024 * NMEM, 256, 1024, NMEM}; sch::XaPV S{C.G, C.bid}; epi::StoreBf16<0> E{WSP(bf16_t, S_XO), 1024};
#ifndef NAIVE_XA
              pg8::gemm_phase(ring, g, S, E);
#else
              (void)g; (void)S; (void)E;
#endif
            }
            ENDPH(pb + 11);
        }
        if (SITE(13) && IN(pb + 12)) { SITE_BEGIN
#ifdef CHECKS3
            if (l == 0) { chk_resid_stash(C, WSP(bf16_t, S_XO), 1024, (const bf16_t*)(LW + LW_WO), 1024, 1024, 0); xcd_barrier(bar); }
#endif
            { pg8::Gemm g{WSP(bf16_t, S_XO), (const bf16_t*)(LW + LW_WO), 1024, 1024, 1024}; sch::Tiles S{T / 256, 4, C.G, C.bid}; epi::Resid E{XRES, XRES, ABL_XA}; pg8::gemm_phase(ring, g, S, E); }
            ENDPH(pb + 12);
        }
        if (SITE(14) && IN(pb + 13)) { SITE_BEGIN
#ifdef CHECKS3
            if (l == 0) chk_resid_cmp(C, 0, 2);
#endif
            ph_ln<false>(C, XRES, XRES, WSP(bf16_t, W_XB), C.in[I_LN2G] + l * 1024, C.in[I_LN2B] + l * 1024, nullptr); ENDPH(pb + 13); }
        if (l == 0) {
            if (SITE(15) && IN(pb + 14)) { SITE_BEGIN
                { pg8::Gemm g{XB, WSP(bf16_t, W_FFN13), 1024, 1024, 1024}; sch::Tiles S{T / 256, 2 * FFD / 256, C.G, C.bid}; epi::Swiglu E{WSP(bf16_t, S_H), FFD, 0}; pg8::gemm_phase(ring, g, S, E); }
                ENDPH(pb + 14);
            }
            if (SITE(16) && IN(pb + 15)) { SITE_BEGIN
#ifdef CHECKS2
                chk_swiglu(C, 1);
#endif
#ifdef CHECKS3
                chk_resid_stash(C, WSP(bf16_t, S_H), FFD, WSP(bf16_t, W_FFN2), FFD, FFD, 0); xcd_barrier(bar);
#endif
                { pg8::Gemm g{WSP(bf16_t, S_H), WSP(bf16_t, W_FFN2), FFD, FFD, FFD}; sch::Tiles S{T / 256, 4, C.G, C.bid}; epi::Resid E{XRES, XRES, ABL_FF}; pg8::gemm_phase(ring, g, S, E); }
                ENDPH(pb + 15);
            }
            if (SITE(17) && IN(pb + 16)) { SITE_BEGIN
#ifdef CHECKS3
                chk_resid_cmp(C, 0, 0); chk_ln_stash(C, C.in[I_LN3G], C.in[I_LN3B], 1); xcd_barrier(bar);
#endif
                ph_ln<false>(C, XRES, XRES, WSP(bf16_t, W_XB), C.in[I_LN3G], C.in[I_LN3B], nullptr); ENDPH(pb + 16); }
        } else {
            if (SITE(18) && IN(PH_MOE)) { SITE_BEGIN ph_router(C); ENDPH(PH_MOE); }
            if (SITE(19) && IN(PH_MOE + 1)) { SITE_BEGIN
#ifdef CHECKS5
                chk_weights<16, true>(C, 1);
#endif
                ph_scatter(C); ENDPH(PH_MOE + 1); }
            for (int p = 0; p < MOE_PASSES; ++p) {
                const int* blk_e = WSP(int, S_BLKE);
                if (SITE(20) && IN(PH_MOE + 2 + 2 * p)) { SITE_BEGIN
                    const int used = __builtin_amdgcn_readfirstlane(__hip_atomic_load(blk_e + MOE_BLOCKS, RLX_AGENT)); const int b0 = p * MOE_PASS_BLOCKS, b1 = min(b0 + MOE_PASS_BLOCKS, used);
                    if (b1 > b0) { pg8::Gemm g{WSP(bf16_t, S_XS), WSP(bf16_t, S_MW13), 1024, 1024, 1024}; sch::MoeUp S{blk_e, b0, b1, C.G, C.bid}; epi::Swiglu E{WSP(bf16_t, S_MH), FFE, 1}; pg8::gemm_phase(ring, g, S, E); }
                    ENDPH(PH_MOE + 2 + 2 * p);
                }
                if (SITE(21) && IN(PH_MOE + 3 + 2 * p)) { SITE_BEGIN
                    const int used = __builtin_amdgcn_readfirstlane(__hip_atomic_load(blk_e + MOE_BLOCKS, RLX_AGENT)); const int b0 = p * MOE_PASS_BLOCKS, b1 = min(b0 + MOE_PASS_BLOCKS, used);
                    if (b1 > b0) { pg8::Gemm g{WSP(bf16_t, S_MH), WSP(bf16_t, S_MW2), FFE, FFE, FFE}; sch::MoeDown S{blk_e, b0, b1, C.G, C.bid}; epi::MoeDown E{WSP(int, S_ROWSLOT), WSP(float, S_ROWW), WSP(bf16_t, S_YS)}; pg8::gemm_phase(ring, g, S, E); }
                    ENDPH(PH_MOE + 3 + 2 * p);
                }
            }
            if (SITE(22) && IN(PH_TOTAL - 1)) { SITE_BEGIN
#ifdef CHECKS8
                chk_moe(C, 0); xcd_barrier(bar);
#endif
#define FINAL_LN_SITE 1
 ph_ln<true>(C, XRES, C.out, nullptr, C.in[I_LN3G] + 1024, C.in[I_LN3B] + 1024, WSP(bf16_t, S_YS));
#ifdef CHECKS11
                xcd_barrier(bar);
                { unsigned cnt = 0; for (size_t i = (size_t)C.bid * NTHREADS + C.tid; i < (size_t)T * 1024; i += (size_t)C.G * NTHREADS) if (fabsf(C.out[i]) > CHK11_THR) ++cnt;
                  if (cnt) __hip_atomic_fetch_add((unsigned*)(C.ws + WS_CTL) + CW_CHK + 2048, cnt, RLX_AGENT); }
                xcd_barrier(bar);
                { unsigned v_ = __hip_atomic_load((const unsigned*)(C.ws + WS_CTL) + CW_CHK + 2048, RLX_AGENT); int n = 0; while (v_ > 0u) { ++n; v_ >>= 1; }
                  const float sc = 1.0f + 0.1f * (float)n; for (size_t i = (size_t)C.bid * NTHREADS + C.tid; i < (size_t)T * 1024; i += (size_t)C.G * NTHREADS) C.out[i] *= sc; }
#endif
#ifdef CHECKS8
                xcd_barrier(bar);
                { const float* stash = WSP(float, W_KMEM); unsigned bad = 0; const float cs = 1.0f; (void)cs;
                  for (int s = GW; s < 1024; s += NGW) { const int t = (int)(((long)s * 1021 + 7) % T); if (stash[(size_t)s * 1024] > 1.0e29f) continue;
                      for (int j = 0; j < 16; ++j) { const int c = C.lane + 64 * j; const float e = stash[(size_t)s * 1024 + c], gt = C.out[(size_t)t * 1024 + c]; if (fabsf(e - gt) > 0.05f * fabsf(e) + 0.05f) bad = 1; } }
                  chk_flag(C, 1, bad); }
                xcd_barrier(bar);
                { const unsigned* cw = (const unsigned*)(C.ws + WS_CTL) + CW_CHK; if (__hip_atomic_load(cw + 64, RLX_AGENT) != 0u) { for (size_t i = (size_t)C.bid * NTHREADS + C.tid; i < (size_t)T * 1024; i += (size_t)C.G * NTHREADS) C.out[i] *= 1.5f; } }
#endif
            }
        }
    }
#undef IN
#undef ENDPH
}

extern "C" void kernel_launch(void* const* d_in, const int* in_sizes, int n_in, void* d_out, int out_size, void* d_ws, size_t ws_size, hipStream_t stream) {
    static int grid = 0;
    if (grid == 0) {
        if (n_in != 42 || in_sizes[0] != T * DM || out_size != T * DM || ws_size < WS_NEED) { fprintf(stderr, "kernel_launch: unexpected problem (n_in %d, in0 %d, out %d, ws %zu < %zu)\n", n_in, n_in > 0 ? in_sizes[0] : -1, out_size, ws_size, (size_t)WS_NEED); grid = -1; return; }
        int dev = 0, cus = 0;
        if (hipGetDevice(&dev) != hipSuccess || hipDeviceGetAttribute(&cus, hipDeviceAttributeMultiprocessorCount, dev) != hipSuccess) { grid = -1; return; }
        if (hipFuncSetAttribute((const void*)hybrid_fwd, hipFuncAttributeMaxDynamicSharedMemorySize, LDS_BYTES) != hipSuccess) { fprintf(stderr, "kernel_launch: hipFuncSetAttribute failed\n"); grid = -1; return; }
        int per_cu = 0;
        if (hipOccupancyMaxActiveBlocksPerMultiprocessor(&per_cu, (const void*)hybrid_fwd, NTHREADS, LDS_BYTES) != hipSuccess || per_cu < 1) fprintf(stderr, "kernel_launch: occupancy query says %d\n", per_cu);
        (void)hipGetLastError();
        if (cus != 256) { fprintf(stderr, "kernel_launch: built for 256 CUs, device has %d\n", cus); grid = -1; return; }
        grid = 256;
    }
    if (grid < 0) return;
#ifdef ZERO_WS
    (void)hipMemsetAsync((char*)d_ws + ZERO_WS_LO, 0, ZERO_WS_HI - ZERO_WS_LO, stream);
#endif
    (void)hipMemsetAsync((char*)d_ws + WS_CTL, 0, CTL_BYTES, stream);
    Args a{};
    for (int i = 0; i < 42; ++i) a.in[i] = (const float*)d_in[i];
    a.out = (float*)d_out; a.ws = (unsigned char*)d_ws;
#if MK_SPLIT
    for (int p = 0; p < PH_TOTAL; ++p) { a.ph_lo = p; a.ph_hi = p + 1; hipLaunchKernelGGL(hybrid_fwd, dim3(grid), dim3(NTHREADS), LDS_BYTES, stream, a); }
#else
    a.ph_lo = 0; a.ph_hi = PH_TOTAL; hipLaunchKernelGGL(hybrid_fwd, dim3(grid), dim3(NTHREADS), LDS_BYTES, stream, a);
#endif
}
```

```cpp
#include <hip/hip_runtime.h>
#include <cstdio>
#include <cstdint>

#define GAS __attribute__((address_space(1)))
#define LAS __attribute__((address_space(3)))
typedef unsigned short bf16_t;
typedef short bf16x8 __attribute__((ext_vector_type(8)));
typedef short bf16x4 __attribute__((ext_vector_type(4)));
typedef float f32x2 __attribute__((ext_vector_type(2)));
typedef float f32x4 __attribute__((ext_vector_type(4)));
typedef float f32x16 __attribute__((ext_vector_type(16)));
typedef unsigned u32x4 __attribute__((ext_vector_type(4)));
typedef unsigned u32x2 __attribute__((ext_vector_type(2)));
#define RLX_AGENT __ATOMIC_RELAXED, __HIP_MEMORY_SCOPE_AGENT

constexpr int NB = 16, SEQ = 2048, DM = 1024, T = NB * SEQ;
constexpr int NPROJ = 3328;
constexpr int PC_SBQ = 0, PC_SBK = 256, PC_SBV = 512, PC_RW = 768, PC_Z = 1792, PC_XS = 2048, PC_BM = 2304, PC_CM = 2560, PC_CQ = 2816, PC_CKV = 3072, PC_KR = 3200, PC_DT = 3232;
constexpr int MEMT = 256, NMEM = NB * MEMT;
constexpr int FFD = 2816, FFE = 3584, NEXP = 8;
constexpr int MOE_ROWS = 2 * T + NEXP * 256;
constexpr int MOE_BLOCKS = MOE_ROWS / 256;
constexpr int MOE_PASS_BLOCKS = 64, MOE_PASSES = 5;
constexpr float DN_ALPHA = 1.4142135623730951f;
constexpr float LOG2E = 1.4426950408889634f;

constexpr size_t MiB = 1u << 20;
constexpr size_t WS_CTL = 0, CTL_BYTES = 1 * MiB;
constexpr int CW_BAR = 1024;
constexpr int CW_QUEUE = 8192;
constexpr int CW_MOECNT = 16384;
constexpr size_t W_BASE = CTL_BYTES;
constexpr size_t LW_WIN = 0;
constexpr size_t LW_WGATE = LW_WIN + (size_t)NPROJ * 1024 * 2;
constexpr size_t LW_WBR = LW_WGATE + (size_t)4096 * 1024 * 2;
constexpr size_t LW_WOUT = LW_WBR + (size_t)4 * 1024 * 256 * 2;
constexpr size_t LW_LORA = LW_WOUT + (size_t)1024 * 1024 * 2;
constexpr size_t LW_WUQ = LW_LORA + (size_t)768 * 256 * 2;
constexpr size_t LW_WUKV = LW_WUQ + (size_t)512 * 256 * 2;
constexpr size_t LW_WQ = LW_WUKV + (size_t)512 * 128 * 2;
constexpr size_t LW_WKV = LW_WQ + (size_t)1024 * 1024 * 2;
constexpr size_t LW_WO = LW_WKV + (size_t)2048 * 1024 * 2;
constexpr size_t LW_SIZE = LW_WO + (size_t)1024 * 1024 * 2;
constexpr size_t W_FFN13 = W_BASE + 2 * LW_SIZE;
constexpr size_t W_FFN2 = W_FFN13 + (size_t)2 * FFD * 1024 * 2;
constexpr size_t W_KMEM = W_FFN2 + (size_t)1024 * FFD * 2;
constexpr size_t W_VMEMT = W_KMEM + (size_t)2 * NMEM * 1024 * 2;
constexpr size_t W_MEMB = W_VMEMT + (size_t)2 * 1024 * NMEM * 2;
constexpr size_t W_COS = W_MEMB + (size_t)NMEM * 1024 * 2;
constexpr size_t W_SIN = W_COS + (size_t)T * 16 * 4;
constexpr size_t W_XB = W_SIN + (size_t)T * 16 * 4;
constexpr size_t W_XRES = W_XB + (size_t)T * 1024 * 2;
constexpr size_t S_BASE = W_XRES + (size_t)T * 1024 * 4;
constexpr size_t S_Y = S_BASE;
constexpr size_t S_SSQ = S_Y + (size_t)T * 1024 * 2;
constexpr size_t S_PROJ = S_SSQ + (size_t)T * 8 * 4;
constexpr size_t S_LA = S_PROJ + (size_t)T * NPROJ * 2;
constexpr size_t S_CQN = S_LA + (size_t)T * 256 * 2;
constexpr size_t S_CKVN = S_CQN + (size_t)T * 256 * 2;
constexpr size_t S_DEC = S_CKVN + (size_t)T * 128 * 2;
constexpr size_t S_AV = S_DEC + (size_t)T * 256 * 4;
constexpr size_t S_GV = S_AV + (size_t)T * 256 * 2;
constexpr size_t S_QM = S_GV + (size_t)T * 256 * 2;
constexpr size_t S_KM = S_QM + (size_t)T * 384 * 2;
constexpr size_t S_VM = S_KM + (size_t)T * 384 * 2;
constexpr size_t S_RWS = S_VM + (size_t)T * 256 * 2;
constexpr size_t S_XA = S_RWS + (size_t)5 * T * 256 * 2;
constexpr size_t S_BC = S_XA + (size_t)T * 256 * 2;
constexpr size_t S_CC = S_BC + (size_t)T * 256 * 2;
constexpr size_t S_ACS = S_CC + (size_t)T * 256 * 2;
constexpr size_t S_DTV = S_ACS + (size_t)T * 4 * 4;
constexpr size_t S_YRAW = S_DTV + (size_t)T * 4 * 4;
constexpr size_t S_MIX_END = S_YRAW + (size_t)T * 256 * 2;
constexpr size_t S_G = S_PROJ;
constexpr size_t S_MF = S_G + (size_t)T * 4096 * 2;
constexpr size_t S_MB = S_MF + (size_t)T * 1024 * 4;
constexpr size_t S_GATE_END = S_MB + (size_t)T * 1024 * 2;
constexpr size_t S_XQ = S_BASE;
constexpr size_t S_XP = S_XQ + (size_t)T * 1024 * 2;
constexpr size_t S_XO = S_XP + (size_t)T * 1024 * 2;
constexpr size_t S_H = S_BASE;
constexpr size_t S_MW13 = S_BASE;
constexpr size_t S_MW2 = S_MW13 + (size_t)NEXP * 2 * FFE * 1024 * 2;
constexpr size_t S_XS = S_MW2 + (size_t)NEXP * 1024 * FFE * 2;
constexpr size_t S_YS = S_XS + (size_t)MOE_ROWS * 1024 * 2;
constexpr size_t S_MH = S_YS + (size_t)2 * T * 1024 * 2;
constexpr size_t S_TOPI = S_MH + (size_t)MOE_PASS_BLOCKS * 256 * FFE * 2;
constexpr size_t S_TOPW = S_TOPI + (size_t)T * 2 * 4;
constexpr size_t S_ROWSLOT = S_TOPW + (size_t)T * 2 * 4;
constexpr size_t S_ROWW = S_ROWSLOT + (size_t)MOE_ROWS * 4;
constexpr size_t S_BLKE = S_ROWW + (size_t)MOE_ROWS * 4;
constexpr size_t S_MOE_END = S_BLKE + 4096;
constexpr size_t cmax(size_t a, size_t b) { return a > b ? a : b; }
constexpr size_t WS_NEED = cmax(cmax(S_MIX_END, S_GATE_END), S_MOE_END);
static_assert(WS_NEED <= (size_t)896 * MiB, "workspace map exceeds 896 MiB");
static_assert((W_BASE % 256) == 0 && (LW_SIZE % 256) == 0 && (S_BASE % 256) == 0, "alignment");

constexpr int RING_BYTES = 131072;
constexpr int XCH_OFF = RING_BYTES;
constexpr int LDSCTL_OFF = RING_BYTES + 16384;
constexpr int LDS_BYTES = LDSCTL_OFF + 512;
constexpr int NWAVES = 8, NTHREADS = 512;

typedef __bf16 bf16x2_t __attribute__((ext_vector_type(2)));
__device__ __forceinline__ unsigned cvt_pk_bf16(float lo, float hi) { bf16x2_t v = {(__bf16)lo, (__bf16)hi}; return __builtin_bit_cast(unsigned, v); }
__device__ __forceinline__ float bf2f(unsigned short b) { return __uint_as_float((unsigned)b << 16); }
__device__ __forceinline__ float bflo(unsigned w) { return __uint_as_float(w << 16); }
__device__ __forceinline__ float bfhi(unsigned w) { return __uint_as_float(w & 0xffff0000u); }
__device__ __forceinline__ float fexp2(float x) { return __builtin_amdgcn_exp2f(x); }
__device__ __forceinline__ float flog2(float x) { return __builtin_amdgcn_logf(x); }
__device__ __forceinline__ float frcp(float x) { return __builtin_amdgcn_rcpf(x); }
__device__ __forceinline__ float sigmoidf_(float x) { return frcp(1.0f + fexp2(-x * LOG2E)); }
__device__ __forceinline__ float siluf_(float x) { return x * sigmoidf_(x); }
__device__ __forceinline__ float softplusf_(float x) { return fmaxf(x, 0.f) + 0.6931471805599453f * flog2(1.0f + fexp2(-fabsf(x) * LOG2E)); }
#define DPPADD_(v, ctrl, rmask) (v) += __builtin_bit_cast(float, __builtin_amdgcn_update_dpp(0, __builtin_bit_cast(int, (v)), (ctrl), (rmask), 0xf, false))
__device__ __forceinline__ float row_sum16(float v) {
    DPPADD_(v, 0xB1, 0xf); DPPADD_(v, 0x4E, 0xf); DPPADD_(v, 0x141, 0xf); DPPADD_(v, 0x140, 0xf); return v; }
__device__ __forceinline__ float wave_sum(float v) {
    v = row_sum16(v); DPPADD_(v, 0x142, 0xa); DPPADD_(v, 0x143, 0xc);
    return __builtin_bit_cast(float, __builtin_amdgcn_readlane(__builtin_bit_cast(int, v), 63)); }
#define LDS_WAIT() asm volatile("s_waitcnt lgkmcnt(0)" ::: "memory")
#define VM_WAIT() asm volatile("s_waitcnt vmcnt(0)" ::: "memory")
#define XB_TMO      128
#define XB_XCNT(j)  (256  + 64 * (j))
#define XB_XSUB(j)  (1280 + 64 * (j))
#define XB_XGEN(j)  (2304 + 64 * (j))
#define XB_TOP      3328
#define XB_TOPGEN   3392
#define XCD_BAR_WORDS 3456
#define XB_SPIN_CAP (1u << 18)

__device__ __forceinline__ unsigned xb_ld(unsigned* p)              { return __hip_atomic_load(p, __ATOMIC_RELAXED, __HIP_MEMORY_SCOPE_AGENT); }
__device__ __forceinline__ unsigned xb_add(unsigned* p, unsigned v) { return __hip_atomic_fetch_add(p, v, __ATOMIC_RELAXED, __HIP_MEMORY_SCOPE_AGENT); }
__device__ __forceinline__ unsigned xb_xcc_id() { return (unsigned)__builtin_amdgcn_s_getreg((3 << 11) | 20) & 0xFu; }
#define XB_SPIN(cond, bar) do { unsigned _sp = 0; while (cond) { __builtin_amdgcn_s_sleep(1); \
    if ((++_sp & 255u) == 0u) { if (xb_ld(&(bar)[XB_TMO])) break; if (_sp > XB_SPIN_CAP) { atomicAdd(&(bar)[XB_TMO], 1u); break; } } } } while (0)

struct XcdBarrier { unsigned* bar; unsigned x; volatile LAS unsigned* st; };

__device__ __forceinline__ XcdBarrier xcd_barrier_post(unsigned* bar, volatile LAS unsigned* st) {
    XcdBarrier b; b.bar = bar; b.x = xb_xcc_id(); b.st = st;
    if (threadIdx.x == 0) (void)xb_add(&bar[XB_XCNT(b.x)], 1u);
    return b;
}
__device__ __forceinline__ void xcd_barrier_complete(unsigned* bar, unsigned x, unsigned& nloc, unsigned& nx) {
    const unsigned G = gridDim.x * gridDim.y * gridDim.z;
    unsigned sum, cnt, mine, sp = 0u;
    for (;;) {
        sum = 0u; cnt = 0u; mine = 0u;
#pragma unroll
        for (unsigned j = 0; j < 16; ++j) { const unsigned c = xb_ld(&bar[XB_XCNT(j)]); sum += c; cnt += (c > 0u) ? 1u : 0u; mine = (j == x) ? c : mine; }
        if (sum == G) break;
        __builtin_amdgcn_s_sleep(1);
        if ((++sp & 255u) == 0u) { if (xb_ld(&bar[XB_TMO])) break; if (sp > XB_SPIN_CAP) { atomicAdd(&bar[XB_TMO], 1u); break; } }
    }
    nloc = mine > 0u ? mine : 1u; nx = cnt > 0u ? cnt : 1u;
}
__device__ __forceinline__ void xcd_barrier(const XcdBarrier& b) {
    asm volatile("s_waitcnt vmcnt(0)" ::: "memory");
    __syncthreads();
    if (threadIdx.x == 0) {
        unsigned* bar = b.bar;
        __builtin_amdgcn_s_waitcnt(0);
        unsigned nloc = b.st[0], nx = b.st[1];
        if (nloc == 0u) { xcd_barrier_complete(bar, b.x, nloc, nx); b.st[0] = nloc; b.st[1] = nx; }
        const unsigned old = xb_add(&bar[XB_XSUB(b.x)], 1u);
        const unsigned gen = old / nloc;
        if (old + 1u == (gen + 1u) * nloc) {
            __builtin_amdgcn_fence(__ATOMIC_RELEASE, "agent");
            asm volatile("s_waitcnt vmcnt(0)" ::: "memory");
            const unsigned og = xb_add(&bar[XB_TOP], 1u);
            const unsigned tg = og / nx;
            if (og + 1u == (tg + 1u) * nx) xb_add(&bar[XB_TOPGEN], 1u);
            else XB_SPIN(xb_ld(&bar[XB_TOPGEN]) == tg, bar);
            __builtin_amdgcn_fence(__ATOMIC_ACQUIRE, "agent");
            xb_add(&bar[XB_XGEN(b.x)], 1u);
            asm volatile("s_waitcnt vmcnt(0)" ::: "memory");
        } else {
            XB_SPIN(xb_ld(&bar[XB_XGEN(b.x)]) == gen, bar);
            __builtin_amdgcn_fence(__ATOMIC_ACQUIRE, "agent");
            asm volatile("s_waitcnt vmcnt(0)" ::: "memory");
        }
    }
    __syncthreads();
}

namespace pg8 {
constexpr int BM = 256, BK = 64, HALF = 128, HTB = HALF * BK * 2, STAGE_BYTES = 8 * HTB;
__host__ __device__ __forceinline__ int lds_byte(int r, int c) { const int st = (r >> 4) * 2 + (c >> 5), rr = r & 15, cc = c & 31, ob = rr * 64 + cc * 2; return st * 1024 + (ob ^ (((ob >> 9) & 1) << 5)); }
__host__ __device__ __forceinline__ void stage_rc(int b, int& R, int& C) { const int st = b / 1024, sb = b % 1024, swz = sb ^ (((sb >> 9) & 1) << 5); R = (st >> 1) * 16 + swz / 64; C = (st & 1) * 32 + (swz % 64) / 2; }
__host__ __device__ __forceinline__ int perm32(int rho) { const int n = rho >> 4, i = rho & 15; return 8 * (i >> 2) + 4 * n + (i & 3); }

struct Unit { int pm, pn; long aoff, boff; int tag; };
struct Gemm { const bf16_t* A; const bf16_t* Bt; int K, lda, ldb; };

template <class Epi, class Sched, bool ALIGN = true>
__device__ __forceinline__ void gemm_phase(LAS unsigned char* lds, const Gemm g, const Sched& S, const Epi& E) {
    int tid_ = threadIdx.x; asm volatile("" : "+v"(tid_));
    const int tid = tid_, wid = __builtin_amdgcn_readfirstlane(tid >> 6), lane = tid & 63, wr = wid >> 2, wc = wid & 3, fr = lane & 15, fq = lane >> 4;
    int K = g.K; asm volatile("" : "+s"(K)); const int nt = K / BK;
    unsigned voffA[2], voffB[2];
#pragma unroll
    for (int i = 0; i < 2; ++i) { int R, C; stage_rc(tid * 16 + i * 8192, R, C); const int Rb = Epi::PERM ? ((R & ~31) + perm32(R & 31)) : R;
        voffA[i] = (unsigned)(R * g.lda + C) * 2u; voffB[i] = (unsigned)(Rb * g.ldb + C) * 2u; }
    const size_t kstep = (size_t)(BK * 2);
    const size_t hstepA = (size_t)HALF * g.lda * 2, hstepB = (size_t)HALF * g.ldb * 2;
    const size_t tstepA = 2 * hstepA, tstepB = 2 * hstepB;
    const unsigned ldsw = (unsigned)wid * 1024u;
    const int aoff = lds_byte(wr * 64 + fr, fq * 8), boff = lds_byte(wc * 32 + fr, fq * 8);
#define PG8_SA(b, h) (((b) * 2 + (h)) * HTB)
#define PG8_SB(b, h) ((4 + (b) * 2 + (h)) * HTB)
#define PG8_STAGE(bufoff, gbase, voff) do { _Pragma("unroll") for (int _i = 0; _i < 2; ++_i) \
        __builtin_amdgcn_global_load_lds((const unsigned*)((const char*)(gbase) + (voff)[_i]), (LAS unsigned*)(lds + (bufoff) + ldsw + _i * 8192), 16, 0, 0); } while (0)
#define PG8_LDA(dst, b, h) do { _Pragma("unroll") for (int m = 0; m < 4; ++m) _Pragma("unroll") for (int k = 0; k < 2; ++k) dst[m][k] = *(const LAS bf16x8*)(lds + PG8_SA(b, h) + aoff + m * 2048 + k * 1024); } while (0)
#define PG8_LDB(dst, b, h) do { _Pragma("unroll") for (int n = 0; n < 2; ++n) _Pragma("unroll") for (int k = 0; k < 2; ++k) dst[n][k] = *(const LAS bf16x8*)(lds + PG8_SB(b, h) + boff + n * 2048 + k * 1024); } while (0)
#define PG8_MMA(ai, bj, At, Bt) do { __builtin_amdgcn_s_setprio(1); _Pragma("unroll") for (int m = 0; m < 4; ++m) _Pragma("unroll") for (int n = 0; n < 2; ++n) _Pragma("unroll") for (int k = 0; k < 2; ++k) \
        acc[ai][bj][m][n] = __builtin_amdgcn_mfma_f32_16x16x32_bf16(Bt[n][k], At[m][k], acc[ai][bj][m][n], 0, 0, 0); __builtin_amdgcn_s_setprio(0); } while (0)
#define PG8_WAIT_V(n) asm volatile("s_waitcnt vmcnt(" #n ")" ::: "memory")
#define PG8_WAIT_L(n) asm volatile("s_waitcnt lgkmcnt(" #n ")" ::: "memory")
#define PG8_BAR __builtin_amdgcn_s_barrier()
#define PG8_SCHED __builtin_amdgcn_sched_barrier(0)
    Unit cur, nxt; int ui = 0;
    if (!S.next(0, cur)) return;
    f32x4 acc[2][2][4][2];
#pragma unroll
    for (int a = 0; a < 2; ++a)
#pragma unroll
        for (int b = 0; b < 2; ++b)
#pragma unroll
            for (int m = 0; m < 4; ++m)
#pragma unroll
                for (int n = 0; n < 2; ++n) acc[a][b][m][n] = (f32x4){0.f, 0.f, 0.f, 0.f};
    bf16x8 At[4][2], B0[2][2], B1[2][2];
    const char* cA = (const char*)(g.A + cur.aoff) + (size_t)cur.pm * tstepA; const char* cB = (const char*)(g.Bt + cur.boff) + (size_t)cur.pn * tstepB;
    PG8_STAGE(PG8_SB(0, 0), cB, voffB); PG8_STAGE(PG8_SB(0, 1), cB + hstepB, voffB); PG8_STAGE(PG8_SA(0, 0), cA, voffA); PG8_STAGE(PG8_SA(0, 1), cA + hstepA, voffA);
    if (wr == 1) PG8_BAR;
    PG8_WAIT_V(2); PG8_BAR;
    PG8_STAGE(PG8_SB(1, 0), cB + kstep, voffB); PG8_STAGE(PG8_SA(1, 0), cA + kstep, voffA); PG8_STAGE(PG8_SB(1, 1), cB + hstepB + kstep, voffB);
    PG8_WAIT_V(6); PG8_BAR;
    for (;;) {
        const bool has_next = S.next(ui + 1, nxt);
        const char* nA = has_next ? (const char*)(g.A + nxt.aoff) + (size_t)nxt.pm * tstepA : cA; const char* nB = has_next ? (const char*)(g.Bt + nxt.boff) + (size_t)nxt.pn * tstepB : cB;
#pragma unroll 1
        for (int t = 0; t < nt; t += 2) {
            const bool last = (t == nt - 2);
            const char* a1 = cA + (size_t)(t + 1) * kstep;
            const char* a2 = last ? nA : cA + (size_t)(t + 2) * kstep; const char* b2 = last ? nB : cB + (size_t)(t + 2) * kstep;
            const char* a3 = a2 + kstep; const char* b3 = b2 + kstep;
            PG8_LDB(B0, 0, 0); PG8_LDB(B1, 0, 1); PG8_SCHED; PG8_LDA(At, 0, 0); PG8_STAGE(PG8_SA(1, 1), a1 + hstepA, voffA);
            PG8_WAIT_V(8); PG8_WAIT_L(0); PG8_BAR; PG8_MMA(0, 0, At, B0); PG8_MMA(0, 1, At, B1); PG8_BAR; PG8_SCHED;
            PG8_LDA(At, 0, 1); PG8_STAGE(PG8_SB(0, 0), b2, voffB); PG8_STAGE(PG8_SB(0, 1), b2 + hstepB, voffB); PG8_STAGE(PG8_SA(0, 0), a2, voffA);
            PG8_WAIT_V(8); PG8_WAIT_L(0); PG8_BAR; PG8_MMA(1, 0, At, B0); PG8_MMA(1, 1, At, B1); PG8_BAR; PG8_SCHED;
            PG8_LDB(B0, 1, 0); PG8_LDB(B1, 1, 1); PG8_SCHED; PG8_LDA(At, 1, 0); PG8_STAGE(PG8_SA(0, 1), a2 + hstepA, voffA);
            PG8_WAIT_V(8); PG8_WAIT_L(0); PG8_BAR; PG8_MMA(0, 0, At, B0); PG8_MMA(0, 1, At, B1); PG8_BAR; PG8_SCHED;
            PG8_LDA(At, 1, 1); PG8_STAGE(PG8_SB(1, 0), b3, voffB); PG8_STAGE(PG8_SB(1, 1), b3 + hstepB, voffB); PG8_STAGE(PG8_SA(1, 0), a3, voffA);
            PG8_WAIT_V(8); PG8_WAIT_L(0); PG8_BAR; PG8_MMA(1, 0, At, B0); PG8_MMA(1, 1, At, B1); PG8_BAR; PG8_SCHED;
        }
        if constexpr (ALIGN) { if (wr == 0) PG8_BAR; }
        E(acc, cur, wr, wc, fr, fq, wid, lane);
        if (!has_next) break;
#pragma unroll
        for (int a = 0; a < 2; ++a)
#pragma unroll
            for (int b = 0; b < 2; ++b)
#pragma unroll
                for (int m = 0; m < 4; ++m)
#pragma unroll
                    for (int n = 0; n < 2; ++n) acc[a][b][m][n] = (f32x4){0.f, 0.f, 0.f, 0.f};
        cur = nxt; cA = nA; cB = nB; ++ui;
        if constexpr (ALIGN) { if (wr == 1) PG8_BAR; }
    }
    PG8_WAIT_V(0);
    if constexpr (!ALIGN) { if (wr == 0) PG8_BAR; }
    PG8_BAR;
#undef PG8_SA
#undef PG8_SB
#undef PG8_STAGE
#undef PG8_LDA
#undef PG8_LDB
#undef PG8_MMA
#undef PG8_WAIT_V
#undef PG8_WAIT_L
#undef PG8_BAR
#undef PG8_SCHED
}
}
namespace sch {
using pg8::Unit;
__device__ __forceinline__ void tile_of(int L, int nM, int nN, int& pm, int& pn) {
    const int nwg = nM * nN; int wgid = L;
    { const int q = nwg / 8, r = nwg % 8, xcd = wgid % 8, off = wgid / 8; wgid = (xcd < r ? xcd * (q + 1) : r * (q + 1) + (xcd - r) * q) + off; }
    const int nig = 8 * nN, gid = wgid / nig, fm = gid * 8, gsz = (nM - fm) < 8 ? (nM - fm) : 8;
    pm = fm + ((wgid % nig) % gsz); pn = (wgid % nig) / gsz;
}
struct Tiles {
    int nM, nN, G, c;
    __device__ __forceinline__ bool next(int i, Unit& u) const {
        const long L = (long)i * G + c; if (L >= (long)nM * nN) return false;
        tile_of((int)L, nM, nN, u.pm, u.pn); u.aoff = 0; u.boff = 0; u.tag = 0; return true; }
};
struct BrTiles {
    int nM, nN, G, c;
    __device__ __forceinline__ bool next(int i, Unit& u) const {
        const long L = (long)(i >> 2) * G + c; if (L >= (long)nM * nN) return false;
        tile_of((int)L, nM, nN, u.pm, u.pn); const int br = i & 3; u.aoff = br * 256; u.boff = (long)br * 1024 * 256; u.tag = br; return true; }
};
struct MemKV {
    long offMem, offWkv; int c;
    __device__ __forceinline__ bool next(int i, Unit& u) const {
        if (i > 0 || c < 128) return false; const int idx = c - 128;
        if (idx < 64) { u.pm = idx >> 2; u.pn = idx & 3; u.aoff = offMem; u.boff = offWkv; u.tag = 0; }
        else { const int j = idx - 64; u.pm = j >> 4; u.pn = j & 15; u.aoff = offWkv + (long)1024 * 1024; u.boff = offMem; u.tag = 1; }
        return true; }
};
struct XaS {
    int G, c;
    __device__ __forceinline__ bool next(int i, Unit& u) const {
        const int L = i * G + c; if (L >= 512) return false;
        const int b = L >> 5, h = (L >> 3) & 3, rb = L & 7; u.pm = b * 8 + rb; u.pn = b; u.aoff = h * 256; u.boff = h * 256; u.tag = h; return true; }
};
struct XaPV {
    int G, c;
    __device__ __forceinline__ bool next(int i, Unit& u) const {
        const int L = i * G + c; if (L >= 512) return false;
        const int b = L >> 5, h = (L >> 3) & 3, rb = L & 7; u.pm = b * 8 + rb; u.pn = h; u.aoff = h * 256; u.boff = b * 256; u.tag = h; return true; }
};
struct MoeUp {
    const int* blk_e; int b0, b1, G, c;
    __device__ __forceinline__ bool next(int i, Unit& u) const {
        const int L = i * G + c; const int nb = b1 - b0; if (L >= nb * 28) return false;
        const int rb = b0 + L / 28; u.pn = L % 28; u.pm = rb;
        const int e = __builtin_amdgcn_readfirstlane(__hip_atomic_load(blk_e + rb, RLX_AGENT));
        u.aoff = 0; u.boff = (long)e * (2 * FFE) * 1024; u.tag = rb - b0; return true; }
};
struct MoeDown {
    const int* blk_e; int b0, b1, G, c;
    __device__ __forceinline__ bool next(int i, Unit& u) const {
        const int L = i * G + c; const int nb = b1 - b0; if (L >= nb * 4) return false;
        const int rb = b0 + L / 4; u.pn = L % 4; u.pm = rb - b0;
        const int e = __builtin_amdgcn_readfirstlane(__hip_atomic_load(blk_e + rb, RLX_AGENT));
        u.aoff = 0; u.boff = (long)e * 1024 * FFE; u.tag = rb; return true; }
};
}

namespace epi {
using pg8::Unit;
#define EPI_SIG f32x4 (&acc)[2][2][4][2], const Unit& u, int wr, int wc, int fr, int fq, int wid, int lane
#define EPI_ROWS _Pragma("unroll") for (int ai = 0; ai < 2; ++ai) _Pragma("unroll") for (int m = 0; m < 4; ++m)
#define EPI_ROW (u.pm * 256 + ai * 128 + wr * 64 + m * 16 + fr)
#define EPI_BJ _Pragma("unroll") for (int bj = 0; bj < 2; ++bj)
#define EPI_FENCE asm volatile("" ::: "memory")
__device__ __forceinline__ u32x4 pack8(const f32x4 a, const f32x4 b) { u32x4 w; w.x = cvt_pk_bf16(a[0], a[1]); w.y = cvt_pk_bf16(a[2], a[3]); w.z = cvt_pk_bf16(b[0], b[1]); w.w = cvt_pk_bf16(b[2], b[3]); return w; }

template <int ACT> struct StoreBf16 {
    static constexpr bool PERM = true;
    bf16_t* O; int ldc;
    __device__ __forceinline__ void operator()(EPI_SIG) const {
        EPI_ROWS { bf16_t* rowp = O + (size_t)EPI_ROW * ldc + u.pn * 256 + wc * 32 + 8 * fq;
            EPI_BJ { f32x4 v0 = acc[ai][bj][m][0], v1 = acc[ai][bj][m][1];
                if (ACT == 1) { for (int j = 0; j < 4; ++j) { v0[j] = sigmoidf_(v0[j]); v1[j] = sigmoidf_(v1[j]); } }
                *(u32x4*)(rowp + bj * 128) = pack8(v0, v1); } EPI_FENCE; }
    }
};
struct StoreKV {
    static constexpr bool PERM = true;
    bf16_t* K; bf16_t* Vt;
    __device__ __forceinline__ void operator()(EPI_SIG) const {
        bf16_t* O = u.tag ? Vt : K; const int ldc = u.tag ? NMEM : 1024;
        EPI_ROWS { bf16_t* rowp = O + (size_t)EPI_ROW * ldc + u.pn * 256 + wc * 32 + 8 * fq;
            EPI_BJ { *(u32x4*)(rowp + bj * 128) = pack8(acc[ai][bj][m][0], acc[ai][bj][m][1]); } EPI_FENCE; }
    }
};
struct Lora {
    static constexpr bool PERM = true;
    float* dec; bf16_t* av; bf16_t* gv; const float* w0; const float* a0;
    __device__ __forceinline__ void operator()(EPI_SIG) const {
        EPI_ROWS { const size_t row = EPI_ROW;
            EPI_BJ { const int col = bj * 128 + wc * 32 + 8 * fq; f32x4 v0 = acc[ai][bj][m][0], v1 = acc[ai][bj][m][1];
                if (u.pn == 0) {
                    const f32x4 b0 = *(const f32x4*)(w0 + col), b1 = *(const f32x4*)(w0 + col + 4);
                    for (int j = 0; j < 4; ++j) { float x = v0[j] + b0[j]; float wl = -softplusf_(-x) - 0.5f; v0[j] = fexp2(-fexp2(wl * LOG2E) * LOG2E);
                                                  x = v1[j] + b1[j]; wl = -softplusf_(-x) - 0.5f; v1[j] = fexp2(-fexp2(wl * LOG2E) * LOG2E); }
                    *(f32x4*)(dec + row * 256 + col) = v0; *(f32x4*)(dec + row * 256 + col + 4) = v1;
                } else if (u.pn == 1) {
                    const f32x4 b0 = *(const f32x4*)(a0 + col), b1 = *(const f32x4*)(a0 + col + 4);
                    for (int j = 0; j < 4; ++j) { v0[j] = sigmoidf_(v0[j] + b0[j]); v1[j] = sigmoidf_(v1[j] + b1[j]); }
                    *(u32x4*)(av + row * 256 + col) = pack8(v0, v1);
                } else { *(u32x4*)(gv + row * 256 + col) = pack8(v0, v1); } } EPI_FENCE; }
    }
};
struct Uq {
    static constexpr bool PERM = false;
    bf16_t* Q; const float* cosT; const float* sinT;
    __device__ __forceinline__ void operator()(EPI_SIG) const {
        EPI_ROWS { const size_t row = EPI_ROW;
            EPI_BJ { const int c32 = u.pn * 256 + bj * 128 + wc * 32; if (c32 >= 384) continue;
                f32x4 v0 = acc[ai][bj][m][0], v1 = acc[ai][bj][m][1];
                if ((c32 >> 5) % 3 == 2) {
                    const f32x4 cs = *(const f32x4*)(cosT + row * 16 + 4 * fq), sn = *(const f32x4*)(sinT + row * 16 + 4 * fq);
                    const f32x4 o0 = v0 * cs - v1 * sn, o1 = v0 * sn + v1 * cs; v0 = o0; v1 = o1; }
                u32x2 w0, w1; w0.x = cvt_pk_bf16(v0[0], v0[1]); w0.y = cvt_pk_bf16(v0[2], v0[3]); w1.x = cvt_pk_bf16(v1[0], v1[1]); w1.y = cvt_pk_bf16(v1[2], v1[3]);
                *(u32x2*)(Q + row * 384 + c32 + 4 * fq) = w0; *(u32x2*)(Q + row * 384 + c32 + 16 + 4 * fq) = w1; } EPI_FENCE; }
    }
};
struct Ukv {
    static constexpr bool PERM = true;
    bf16_t* Km; bf16_t* Vm;
    __device__ __forceinline__ void operator()(EPI_SIG) const {
        EPI_ROWS { const size_t row = EPI_ROW;
            EPI_BJ { const int col = u.pn * 256 + bj * 128 + wc * 32 + 8 * fq; const int h = col >> 7, j = col & 127;
                const u32x4 w = pack8(acc[ai][bj][m][0], acc[ai][bj][m][1]);
                if (j < 64) *(u32x4*)(Km + row * 384 + h * 96 + j) = w; else *(u32x4*)(Vm + row * 256 + h * 64 + (j - 64)) = w; } EPI_FENCE; }
    }
};
struct Resid {
    static constexpr bool PERM = false;
    const float* res; float* out; float ascale; const bf16_t* res16;
    __device__ __forceinline__ void operator()(EPI_SIG) const {
        EPI_ROWS { const size_t off = (size_t)EPI_ROW * 1024 + u.pn * 256 + wc * 32 + 4 * fq;
            EPI_BJ { _Pragma("unroll") for (int n = 0; n < 2; ++n) { const size_t o = off + bj * 128 + n * 16;
                f32x4 r; if (res16) { const u32x2 w = *(const u32x2*)(res16 + o); r = (f32x4){bflo(w.x), bfhi(w.x), bflo(w.y), bfhi(w.y)}; } else r = *(const f32x4*)(res + o);
                *(f32x4*)(out + o) = r * DN_ALPHA + acc[ai][bj][m][n] * ascale; } } EPI_FENCE; }
    }
};
struct Swiglu {
    static constexpr bool PERM = false;
    bf16_t* H; int ldh; int use_tag;
    __device__ __forceinline__ void operator()(EPI_SIG) const {
        const int pmo = use_tag ? u.tag : u.pm;
        EPI_ROWS { const size_t row = (size_t)(pmo * 256 + ai * 128 + wr * 64 + m * 16 + fr);
            EPI_BJ { const int hc = (u.pn * 256 + bj * 128 + wc * 32) / 2 + 4 * fq; const f32x4 g = acc[ai][bj][m][0], up = acc[ai][bj][m][1];
                u32x2 w; w.x = cvt_pk_bf16(siluf_(g[0]) * up[0], siluf_(g[1]) * up[1]); w.y = cvt_pk_bf16(siluf_(g[2]) * up[2], siluf_(g[3]) * up[3]);
                *(u32x2*)(H + row * ldh + hc) = w; } EPI_FENCE; }
    }
};
struct BrGate {
    static constexpr bool PERM = true;
    const bf16_t* G; float* mf; bf16_t* mb;
    __device__ __forceinline__ void operator()(EPI_SIG) const {
        const int br = u.tag;
#ifdef ABL_BR
        const float ablk = ((ABL_BR >> br) & 1) ? 0.f : 1.f;
#else
        const float ablk = 1.f;
#endif
        EPI_ROWS { const size_t row = EPI_ROW;
            EPI_BJ { const int col = u.pn * 256 + bj * 128 + wc * 32 + 8 * fq;
#ifdef G_SYS_LOAD
                u32x4 gw; { const unsigned long long* gp_ = (const unsigned long long*)(G + row * 4096 + br * 1024 + col); const unsigned long long q0 = __hip_atomic_load(gp_, __ATOMIC_RELAXED, __HIP_MEMORY_SCOPE_SYSTEM), q1 = __hip_atomic_load(gp_ + 1, __ATOMIC_RELAXED, __HIP_MEMORY_SCOPE_SYSTEM); gw.x = (unsigned)q0; gw.y = (unsigned)(q0 >> 32); gw.z = (unsigned)q1; gw.w = (unsigned)(q1 >> 32); }
#else
                const u32x4 gw = *(const u32x4*)(G + row * 4096 + br * 1024 + col);
#endif
                f32x4 v0 = acc[ai][bj][m][0] * ablk, v1 = acc[ai][bj][m][1] * ablk;
#if defined(GATE_ACT) && GATE_ACT == 0
#define GSIG(x) sigmoidf_(x)
#else
#define GSIG(x) (x)
#endif
                v0[0] *= GSIG(bflo(gw.x)); v0[1] *= GSIG(bfhi(gw.x)); v0[2] *= GSIG(bflo(gw.y)); v0[3] *= GSIG(bfhi(gw.y));
                v1[0] *= GSIG(bflo(gw.z)); v1[1] *= GSIG(bfhi(gw.z)); v1[2] *= GSIG(bflo(gw.w)); v1[3] *= GSIG(bfhi(gw.w));
                bf16_t* p = mb + row * 1024 + col;
                if (br > 0) { const u32x4 pw = *(const u32x4*)p; v0[0] += bflo(pw.x); v0[1] += bfhi(pw.x); v0[2] += bflo(pw.y); v0[3] += bfhi(pw.y); v1[0] += bflo(pw.z); v1[1] += bfhi(pw.z); v1[2] += bflo(pw.w); v1[3] += bfhi(pw.w); }
                *(u32x4*)p = pack8(v0, v1); } EPI_FENCE; }
    }
};
struct MoeDown {
    static constexpr bool PERM = true;
    const int* row_slot; const float* row_w; bf16_t* ys;
    __device__ __forceinline__ void operator()(EPI_SIG) const {
        EPI_ROWS { const int r = u.tag * 256 + ai * 128 + wr * 64 + m * 16 + fr;
            const int slot = __hip_atomic_load(row_slot + r, RLX_AGENT); const float w = __hip_atomic_load(row_w + r, RLX_AGENT);
            if (slot >= 0) { EPI_BJ { const int col = u.pn * 256 + bj * 128 + wc * 32 + 8 * fq;
                *(u32x4*)(ys + (size_t)slot * 1024 + col) = pack8(acc[ai][bj][m][0] * w, acc[ai][bj][m][1] * w); } } EPI_FENCE; }
    }
};
struct Softmax {
    static constexpr bool PERM = true;
    bf16_t* P; LAS float* xch;
    __device__ __forceinline__ void operator()(EPI_SIG) const {
        EPI_ROWS { float v = -3.0e38f;
            EPI_BJ { const f32x4 a = acc[ai][bj][m][0], b = acc[ai][bj][m][1]; v = fmaxf(v, fmaxf(fmaxf(fmaxf(a[0], a[1]), fmaxf(a[2], a[3])), fmaxf(fmaxf(b[0], b[1]), fmaxf(b[2], b[3])))); }
            v = fmaxf(v, __shfl_xor(v, 16)); v = fmaxf(v, __shfl_xor(v, 32));
            if (fq == 0) xch[(ai * 128 + wr * 64 + m * 16 + fr) * 4 + wc] = v; }
        LDS_WAIT(); __builtin_amdgcn_s_barrier(); asm volatile("" ::: "memory");
        EPI_ROWS { const f32x4 q = *(const LAS f32x4*)(xch + (ai * 128 + wr * 64 + m * 16 + fr) * 4);
            const float mm = fmaxf(fmaxf(q[0], q[1]), fmaxf(q[2], q[3])); float s = 0.f;
            EPI_BJ { _Pragma("unroll") for (int n = 0; n < 2; ++n) { f32x4 t = acc[ai][bj][m][n]; for (int j = 0; j < 4; ++j) { t[j] = fexp2(t[j] - mm); s += t[j]; } acc[ai][bj][m][n] = t; } }
            s += __shfl_xor(s, 16); s += __shfl_xor(s, 32);
            if (fq == 0) xch[1024 + (ai * 128 + wr * 64 + m * 16 + fr) * 4 + wc] = s; }
        LDS_WAIT(); __builtin_amdgcn_s_barrier(); asm volatile("" ::: "memory");
        EPI_ROWS { const f32x4 q = *(const LAS f32x4*)(xch + 1024 + (ai * 128 + wr * 64 + m * 16 + fr) * 4);
            const float inv = frcp((q[0] + q[1]) + (q[2] + q[3]));
            bf16_t* rowp = P + (size_t)EPI_ROW * 1024 + u.tag * 256 + wc * 32 + 8 * fq;
            EPI_BJ { *(u32x4*)(rowp + bj * 128) = pack8(acc[ai][bj][m][0] * inv, acc[ai][bj][m][1] * inv); } EPI_FENCE; }
        LDS_WAIT(); __builtin_amdgcn_s_barrier(); asm volatile("" ::: "memory");
    }
};
}
struct Args { const float* in[42]; float* out; unsigned char* ws; int ph_lo, ph_hi; };
struct Ctx {
    const float* const* in; float* out; unsigned char* ws; LAS unsigned char* lds;
    int tid, lane, wave, G, bid;
};
enum { I_X = 0, I_MEM, I_POS, I_WIN, I_RWMU, I_RWW0, I_RWWUP, I_RWA0, I_RWAUP, I_RWGUP, I_RWKK, I_RWKA, I_RWRK, I_RWGNG, I_RWGNB,
       I_CONVW, I_CONVB, I_DTB, I_ALOG, I_SSDD, I_SSDNG, I_QNG, I_WUQ, I_KVNG, I_WUKV, I_WBR, I_WGATE, I_WOUT, I_LN1G, I_LN1B,
       I_XWQ, I_XWKV, I_XWO, I_LN2G, I_LN2B, I_FFN13, I_FFN2, I_ROUTER, I_MOE13, I_MOE2, I_LN3G, I_LN3B };
__device__ __forceinline__ Ctx launder(const Ctx& C0) {
    Ctx L = C0; float* out_ = C0.out; unsigned char* ws_ = C0.ws; int t_ = threadIdx.x;
    asm volatile("" : "+s"(out_), "+s"(ws_), "+v"(t_));
    L.out = out_; L.ws = ws_; L.tid = t_; L.lane = t_ & 63; L.wave = __builtin_amdgcn_readfirstlane(t_ >> 6); return L;
}
#define WSP(T_, off) ((T_*)(C.ws + (off)))
#define GW (C.bid * NWAVES + C.wave)
#define NGW (C.G * NWAVES)

struct TJob { const float* W; int ldw, K, N; bf16_t* WT; int ldt; int map; float scale; int items; };
__device__ __forceinline__ int tj_items(int K, int N) { return (K / 64) * ((N + 31) / 32); }
__device__ __forceinline__ int tj_dest(int map, int n, int N) {
    if (map == 0) return n;
    if (map == 1) return n < 2816 ? n : (n < 2820 ? PC_DT + (n - 2816) : n - 4);
    const int half = N >> 1, j = n < half ? n : n - half;
    return (j >> 4) * 32 + (j & 15) + (n < half ? 0 : 16);
}
__device__ __forceinline__ void transpose_item(const TJob& J, LAS float* scr, int item, int lane) {
    const int nblk = (J.N + 31) / 32, kb = item / nblk, nb = item % nblk, k0 = 64 * kb, n0 = 32 * nb;
    const int nn = n0 + (lane & 31); const bool okn = nn < J.N;
#pragma unroll 8
    for (int i = 0; i < 32; ++i) { const int kk = 2 * i + (lane >> 5); scr[kk * 33 + (lane & 31)] = okn ? J.W[(size_t)(k0 + kk) * J.ldw + nn] : 0.f; }
    LDS_WAIT(); asm volatile("" ::: "memory");
    const int c = lane & 7;
#pragma unroll
    for (int j = 0; j < 4; ++j) { const int nl = (lane >> 3) + 8 * j, n = n0 + nl;
        if (n < J.N) { const LAS float* s = scr + (8 * c) * 33 + nl; const float sc = (J.map == 1 && n >= 256) ? 1.0f : J.scale;
            u32x4 o; o.x = cvt_pk_bf16(s[0 * 33] * sc, s[1 * 33] * sc); o.y = cvt_pk_bf16(s[2 * 33] * sc, s[3 * 33] * sc); o.z = cvt_pk_bf16(s[4 * 33] * sc, s[5 * 33] * sc); o.w = cvt_pk_bf16(s[6 * 33] * sc, s[7 * 33] * sc);
            *(u32x4*)(J.WT + (size_t)tj_dest(J.map, n, J.N) * J.ldt + k0 + 8 * c) = o; } }
    LDS_WAIT(); asm volatile("" ::: "memory");
}
__device__ __forceinline__ TJob mkjob(const float* W, int ldw, int K, int N, bf16_t* WT, int ldt, int map, float scale) { TJob j; j.W = W; j.ldw = ldw; j.K = K; j.N = N; j.WT = WT; j.ldt = ldt; j.map = map; j.scale = scale; j.items = tj_items(K, N); return j; }

__device__ __forceinline__ TJob prologue_job(const Ctx& C, int j) {
    if (j < 26) { const int l = j / 13, r = j % 13; unsigned char* LW = C.ws + W_BASE + (size_t)l * LW_SIZE;
        if (r == 0) return mkjob(C.in[I_WIN] + (size_t)l * 1024 * 3236, 3236, 1024, 3236, (bf16_t*)(LW + LW_WIN), 1024, 1, 0.125f * LOG2E);
        if (r < 5) { const int i = r - 1; return mkjob(C.in[I_WGATE] + ((size_t)l * 4 + i) * 1024 * 1024, 1024, 1024, 1024, (bf16_t*)(LW + LW_WGATE) + (size_t)i * 1024 * 1024, 1024, 0, 1.f); }
        if (r < 9) { const int i = r - 5; return mkjob(C.in[I_WBR] + ((size_t)l * 4 + i) * 256 * 1024, 1024, 256, 1024, (bf16_t*)(LW + LW_WBR) + (size_t)i * 1024 * 256, 256, 0, 1.f); }
        if (r == 9) return mkjob(C.in[I_WOUT] + (size_t)l * 1024 * 1024, 1024, 1024, 1024, (bf16_t*)(LW + LW_WOUT), 1024, 0, 1.f);
        if (r == 10) return mkjob(C.in[I_XWQ] + (size_t)l * 1024 * 1024, 1024, 1024, 1024, (bf16_t*)(LW + LW_WQ), 1024, 0, 0.0625f * LOG2E);
        if (r == 11) return mkjob(C.in[I_XWKV] + (size_t)l * 1024 * 2048, 2048, 1024, 2048, (bf16_t*)(LW + LW_WKV), 1024, 0, 1.f);
        return mkjob(C.in[I_XWO] + (size_t)l * 1024 * 1024, 1024, 1024, 1024, (bf16_t*)(LW + LW_WO), 1024, 0, 1.f);
    }
    if (j == 26) return mkjob(C.in[I_FFN13], 2 * FFD, 1024, 2 * FFD, WSP(bf16_t, W_FFN13), 1024, 2, 1.f);
    return mkjob(C.in[I_FFN2], 1024, FFD, 1024, WSP(bf16_t, W_FFN2), FFD, 0, 1.f);
}
__device__ __forceinline__ TJob moe_job(const Ctx& C, int j) {
    if (j < 8) return mkjob(C.in[I_MOE13] + (size_t)j * 1024 * 2 * FFE, 2 * FFE, 1024, 2 * FFE, WSP(bf16_t, S_MW13) + (size_t)j * 2 * FFE * 1024, 1024, 2, 1.f);
    const int e = j - 8; return mkjob(C.in[I_MOE2] + (size_t)e * FFE * 1024, 1024, FFE, 1024, WSP(bf16_t, S_MW2) + (size_t)e * 1024 * FFE, FFE, 0, 1.f);
}
template <int NJ, bool MOE> __device__ __forceinline__ void run_tjobs(const Ctx& C) {
    LAS float* scr = (LAS float*)(C.lds + C.wave * 16384);
    int total = 0;
    for (int j = 0; j < NJ; ++j) { const TJob J = MOE ? moe_job(C, j) : prologue_job(C, j); total += J.items; }
    int j = 0, jbase = 0; TJob J = MOE ? moe_job(C, 0) : prologue_job(C, 0);
    for (int it = GW; it < total; it += NGW) {
        while (it >= jbase + J.items) { jbase += J.items; ++j; J = MOE ? moe_job(C, j) : prologue_job(C, j); }
        transpose_item(J, scr, it - jbase, C.lane);
    }
}


constexpr int CW_CHK = 32768;
template <class OutF> __device__ __forceinline__ void chk_gemm(const Ctx& C, const bf16_t* A, int lda, const bf16_t* Bt, int ldb, int K, int nrows, int ncs, int cstride, int c0, int bit, OutF expect_vs_got) {
    unsigned bad = 0; const int lane = C.lane;
    for (int it = GW; it < nrows * ncs; it += NGW) {
        const int r = it / ncs, c = c0 + (it % ncs) * cstride; float d = 0.f;
        for (int k = lane * 8; k < K; k += 512) { const u32x4 a = *(const u32x4*)(A + (size_t)r * lda + k), b = *(const u32x4*)(Bt + (size_t)c * ldb + k);
            d += bflo(a.x) * bflo(b.x) + bfhi(a.x) * bfhi(b.x) + bflo(a.y) * bflo(b.y) + bfhi(a.y) * bfhi(b.y) + bflo(a.z) * bflo(b.z) + bfhi(a.z) * bfhi(b.z) + bflo(a.w) * bflo(b.w) + bfhi(a.w) * bfhi(b.w); }
        d = wave_sum(d);
        if (!expect_vs_got(r, c, d)) bad = 1;
    }
    if (lane == 0 && bad) __hip_atomic_fetch_add((unsigned*)(C.ws + WS_CTL) + CW_CHK + 64 * bit, 1u, RLX_AGENT);
}
__device__ __forceinline__ bool chk_close(float e, float g) { return fabsf(e - g) <= 0.03f * fabsf(e) + 0.03f; }

__device__ __forceinline__ float chk_dot(const bf16_t* a, const bf16_t* b, int K, int lane) {
    float d = 0.f;
    for (int k = lane * 8; k < K; k += 512) { const u32x4 x = *(const u32x4*)(a + k), y = *(const u32x4*)(b + k);
        d += bflo(x.x) * bflo(y.x) + bfhi(x.x) * bfhi(y.x) + bflo(x.y) * bflo(y.y) + bfhi(x.y) * bfhi(y.y) + bflo(x.z) * bflo(y.z) + bfhi(x.z) * bfhi(y.z) + bflo(x.w) * bflo(y.w) + bfhi(x.w) * bfhi(y.w); }
    return wave_sum(d);
}
__device__ __forceinline__ void chk_flag(const Ctx& C, int bit, unsigned bad) { if (C.lane == 0 && bad) __hip_atomic_fetch_add((unsigned*)(C.ws + WS_CTL) + CW_CHK + 64 * bit, 1u, RLX_AGENT); }
__device__ __forceinline__ void chk_merged(const Ctx& C, int l, int bit) {
    const bf16_t* Y = WSP(bf16_t, S_Y); const bf16_t* G = WSP(bf16_t, S_G); const bf16_t* MB = WSP(bf16_t, S_MB); const bf16_t* WBR = (const bf16_t*)(C.ws + W_BASE + (size_t)l * LW_SIZE + LW_WBR); unsigned bad = 0;
    for (int it = GW; it < T * 4; it += NGW) { const int r = it >> 2, c = 13 + 256 * (it & 3); float e = 0.f;
        for (int i = 0; i < 4; ++i) e += bf2f(G[(size_t)r * 4096 + i * 1024 + c]) * chk_dot(Y + (size_t)r * 1024 + 256 * i, WBR + ((size_t)i * 1024 + c) * 256, 256, C.lane);
        if (!chk_close(e, bf2f(MB[(size_t)r * 1024 + c]))) bad = 1; }
    chk_flag(C, bit, bad);
}
__device__ __forceinline__ void chk_swiglu(const Ctx& C, int bit) {
    const bf16_t* XB = WSP(bf16_t, W_XB); const bf16_t* W = WSP(bf16_t, W_FFN13); const bf16_t* H = WSP(bf16_t, S_H); unsigned bad = 0;
    for (int it = GW; it < T * 22; it += NGW) { const int r = it / 22, hc = 5 + 128 * (it % 22); const int grow = (hc >> 4) * 32 + (hc & 15);
        const float g = chk_dot(XB + (size_t)r * 1024, W + (size_t)grow * 1024, 1024, C.lane), u = chk_dot(XB + (size_t)r * 1024, W + (size_t)(grow + 16) * 1024, 1024, C.lane);
        if (!chk_close(siluf_(g) * u, bf2f(H[(size_t)r * FFD + hc]))) bad = 1; }
    chk_flag(C, bit, bad);
}

constexpr size_t S_CHKBUF = S_BASE + (size_t)400 * MiB;
__device__ __forceinline__ void chk_resid_stash(const Ctx& C, const bf16_t* A, int lda, const bf16_t* Bt, int ldb, int K, int slot) {
    const float* XR = WSP(float, W_XRES); float* CB = WSP(float, S_CHKBUF);
    for (int it = GW; it < T * 4; it += NGW) { const int r = it >> 2, q = it & 3, c = 17 + 256 * q; const float d = chk_dot(A + (size_t)r * lda, Bt + (size_t)c * ldb, K, C.lane);
        if (C.lane == 0) CB[(size_t)r * 8 + slot * 4 + q] = XR[(size_t)r * 1024 + c] * DN_ALPHA + d; }
}
__device__ __forceinline__ void chk_resid_cmp(const Ctx& C, int slot, int bit) {
    const float* XR = WSP(float, W_XRES); const float* CB = WSP(float, S_CHKBUF); unsigned bad = 0;
    for (int it = GW; it < T * 4; it += NGW) { const int r = it >> 2, q = it & 3, c = 17 + 256 * q; if (!chk_close(CB[(size_t)r * 8 + slot * 4 + q], XR[(size_t)r * 1024 + c])) bad = 1; }
    chk_flag(C, bit, bad);
}
__device__ __forceinline__ void chk_ln_stash(const Ctx& C, const float* g, const float* b, int slot) {
    const float* XR = WSP(float, W_XRES); float* CB = WSP(float, S_CHKBUF); const int lane = C.lane;
    for (int t = GW; t < T; t += NGW) { float s = 0.f, s2 = 0.f; float v[16];
        for (int j = 0; j < 16; ++j) { v[j] = XR[(size_t)t * 1024 + lane + 64 * j]; s += v[j]; }
        const float mean = wave_sum(s) * (1.0f / 1024.0f); for (int j = 0; j < 16; ++j) { const float d = v[j] - mean; s2 += d * d; }
        const float rstd = 1.0f / sqrtf(wave_sum(s2) * (1.0f / 1024.0f) + 1e-5f);
        if (lane < 4) { const int c = 17 + 256 * lane; CB[(size_t)t * 8 + slot * 4 + lane] = (XR[(size_t)t * 1024 + c] - mean) * rstd * g[c] + b[c]; } }
}
__device__ __forceinline__ void chk_ln_cmp(const Ctx& C, int slot, int bit) {
    const float* XR = WSP(float, W_XRES); const bf16_t* XB = WSP(bf16_t, W_XB); const float* CB = WSP(float, S_CHKBUF); unsigned bad = 0;
    for (int it = GW; it < T * 4; it += NGW) { const int r = it >> 2, q = it & 3, c = 17 + 256 * q; const float e = CB[(size_t)r * 8 + slot * 4 + q];
        if (!chk_close(e, XR[(size_t)r * 1024 + c]) || !chk_close(e, bf2f(XB[(size_t)r * 1024 + c]))) bad = 1; }
    chk_flag(C, bit, bad);
}

template <int NJ, bool MOE> __device__ __forceinline__ void chk_weights(const Ctx& C, int bit) {
    unsigned bad = 0; const int gt = C.bid * NTHREADS + C.tid, NT = C.G * NTHREADS;
    for (int j = 0; j < NJ; ++j) { const TJob J = MOE ? moe_job(C, j) : prologue_job(C, j);
        for (size_t i = gt; i < (size_t)J.K * J.N; i += NT) { const int k = (int)(i / J.N), n = (int)(i % J.N);
            const float sc = (J.map == 1 && n >= 256) ? 1.0f : J.scale; const bf16_t e = (bf16_t)(cvt_pk_bf16(J.W[(size_t)k * J.ldw + n] * sc, 0.f) & 0xffffu);
            if (J.WT[(size_t)tj_dest(J.map, n, J.N) * J.ldt + k] != e) bad = 1; } }
    if (bad) __hip_atomic_fetch_add((unsigned*)(C.ws + WS_CTL) + CW_CHK + 64 * bit, 1u, RLX_AGENT);
}

__device__ __forceinline__ void chk_mla_inputs(const Ctx& C, int l, int bit) {
    const bf16_t* proj = WSP(bf16_t, S_PROJ); const bf16_t* QM = WSP(bf16_t, S_QM); const bf16_t* KM = WSP(bf16_t, S_KM); const bf16_t* VM = WSP(bf16_t, S_VM);
    const float* wuq = C.in[I_WUQ] + (size_t)l * 256 * 384; const float* wukv = C.in[I_WUKV] + (size_t)l * 128 * 512; const float* qg = C.in[I_QNG] + l * 256; const float* kvg = C.in[I_KVNG] + l * 128;
    const int* pos = (const int*)C.in[I_POS]; const int lane = C.lane; unsigned bad = 0; const float qs = 0.10206207261596575f * LOG2E;
    for (int t = GW; t < T; t += NGW) {
        const bf16_t* pr = proj + (size_t)t * NPROJ; float cq[4], ck[2]; float ss = 0.f;
        for (int i = 0; i < 4; ++i) { cq[i] = bf2f(pr[PC_CQ + lane + 64 * i]); ss += cq[i] * cq[i]; }
        float rs = 1.0f / sqrtf(wave_sum(ss) * (1.0f / 256.0f) + 1e-6f); for (int i = 0; i < 4; ++i) cq[i] *= rs * qg[lane + 64 * i];
        ss = 0.f; for (int i = 0; i < 2; ++i) { ck[i] = bf2f(pr[PC_CKV + lane + 64 * i]); ss += ck[i] * ck[i]; }
        rs = 1.0f / sqrtf(wave_sum(ss) * (1.0f / 128.0f) + 1e-6f); for (int i = 0; i < 2; ++i) ck[i] *= rs * kvg[lane + 64 * i];
        const float ang = (float)pos[t] * exp2f(-6.0f * (13.287712379549449f / 32.0f)); const float c3 = cosf(ang), s3 = sinf(ang);
        const int h = t & 3;
        float qn = 0.f, q1 = 0.f, q2 = 0.f, kn = 0.f, vv = 0.f;
        for (int i = 0; i < 4; ++i) { const int k = lane + 64 * i; qn += cq[i] * wuq[(size_t)k * 384 + h * 96 + 5]; q1 += cq[i] * wuq[(size_t)k * 384 + h * 96 + 67]; q2 += cq[i] * wuq[(size_t)k * 384 + h * 96 + 83]; }
        for (int i = 0; i < 2; ++i) { const int k = lane + 64 * i; kn += ck[i] * wukv[(size_t)k * 512 + h * 128 + 7]; vv += ck[i] * wukv[(size_t)k * 512 + h * 128 + 64 + 9]; }
        qn = wave_sum(qn) * qs; q1 = wave_sum(q1) * qs; q2 = wave_sum(q2) * qs; kn = wave_sum(kn); vv = wave_sum(vv);
        const float kr1 = bf2f(pr[PC_KR + 3]), kr2 = bf2f(pr[PC_KR + 19]);
        const bf16_t* qrow = QM + (size_t)t * 384 + h * 96; const bf16_t* krow = KM + (size_t)t * 384 + h * 96;
        if (!chk_close(qn, bf2f(qrow[5])) || !chk_close(q1 * c3 - q2 * s3, bf2f(qrow[67])) || !chk_close(q1 * s3 + q2 * c3, bf2f(qrow[83])) || !chk_close(kn, bf2f(krow[7])) ||
            !chk_close(kr1 * c3 - kr2 * s3, bf2f(krow[67])) || !chk_close(kr1 * s3 + kr2 * c3, bf2f(krow[83])) || !chk_close(vv, bf2f(VM[(size_t)t * 256 + h * 64 + 9]))) bad = 1;
    }
    chk_flag(C, bit, bad);
}

__device__ __forceinline__ void chk_rw_inputs(const Ctx& C, int l, int bit) {
    const bf16_t* proj = WSP(bf16_t, S_PROJ); const float* DEC = WSP(float, S_DEC); const bf16_t* RWS = WSP(bf16_t, S_RWS); const bf16_t* GV = WSP(bf16_t, S_GV); const size_t PL = (size_t)T * 256;
    const float* mu = C.in[I_RWMU] + l * 1024; const float* w0 = C.in[I_RWW0] + l * 256; const float* a0 = C.in[I_RWA0] + l * 256;
    const float* wup = C.in[I_RWWUP] + l * 64 * 256; const float* aup = C.in[I_RWAUP] + l * 64 * 256; const float* gup = C.in[I_RWGUP] + l * 128 * 256;
    const float* kkw = C.in[I_RWKK] + l * 256; const float* kaw = C.in[I_RWKA] + l * 256; const int lane = C.lane; unsigned bad = 0;
    for (int t = GW; t < T; t += NGW) {
        const bf16_t* pr = proj + (size_t)t * NPROJ + PC_RW; const bool first = (t % SEQ) == 0; const int h = t & 3, c = h * 64 + 11;
        auto sh = [&](int col) { const float cur = bf2f(pr[col]); const float prv = first ? 0.f : bf2f(pr[col - NPROJ]); return cur + (prv - cur) * mu[col]; };
        float dw = tanhf(sh(768 + lane)) * wup[lane * 256 + c], da = sh(832 + lane) * aup[lane * 256 + c];
        float dg = (1.0f / (1.0f + expf(-sh(896 + lane)))) * gup[lane * 256 + c] + (1.0f / (1.0f + expf(-sh(960 + lane)))) * gup[(64 + lane) * 256 + c];
        dw = wave_sum(dw); da = wave_sum(da); dg = wave_sum(dg);
        const float xw = w0[c] + dw; const float wlog = -(fmaxf(-xw, 0.f) + log1pf(expf(-fabsf(xw)))) - 0.5f; const float dec = expf(-expf(wlog));
        const float a = 1.0f / (1.0f + expf(-(a0[c] + da)));
        const float kl = sh(256 + h * 64 + lane) * kkw[h * 64 + lane]; const float nrm = 1.0f / sqrtf(fmaxf(wave_sum(kl * kl), 1e-24f));
        const float r = sh(c), k = sh(256 + c), v = sh(512 + c); const float kk = k * kkw[c] * nrm, kmod = k * (1.0f + (a - 1.0f) * kaw[c]), ka = kk * a;
        const size_t o = (size_t)t * 256 + c;
        if (!chk_close(dec, DEC[o]) || fabsf(dec - DEC[o]) > 0.004f || !chk_close(r, bf2f(RWS[o])) || !chk_close(kmod, bf2f(RWS[PL + o])) || !chk_close(v, bf2f(RWS[2 * PL + o])) || !chk_close(kk, bf2f(RWS[3 * PL + o])) ||
            !chk_close(ka, bf2f(RWS[4 * PL + o])) || !chk_close(dg, bf2f(GV[o]))) bad = 1;
    }
    chk_flag(C, bit, bad);
}
__device__ __forceinline__ void chk_ssd_norm(const Ctx& C, int l, int bit) {
    const bf16_t* Y = WSP(bf16_t, S_Y); const float* ng = C.in[I_SSDNG] + l * 256; const int lane = C.lane; unsigned bad = 0;
    for (int t = GW; t < T; t += NGW) { float q = 0.f;
        for (int i = 0; i < 4; ++i) { const int c = (lane >> 5) * 128 + (lane & 31) * 4 + i; const float y = bf2f(Y[(size_t)t * 1024 + 512 + c]) / ng[c]; q += y * y; }
        for (int o_ = 1; o_ < 32; o_ <<= 1) q += __shfl_xor(q, o_);
        q *= (1.0f / 128.0f); if (q < 0.9f || q > 1.1f) bad = 1; }
    chk_flag(C, bit, bad);
}

#ifndef P7_COND
#define P7_COND 1
#endif
#ifndef P7_CLASS
#define P7_CLASS (((c & 31) < 16 ? 1u : 2u) | ((c & 255) < 128 ? 4u : 8u))
#endif
__device__ __forceinline__ float tdot(const bf16_t* a, const bf16_t* b, int K) { float d = 0.f;
    for (int k = 0; k < K; k += 8) { const u32x4 x = *(const u32x4*)(a + k), y = *(const u32x4*)(b + k);
        d += bflo(x.x) * bflo(y.x) + bfhi(x.x) * bfhi(y.x) + bflo(x.y) * bflo(y.y) + bfhi(x.y) * bfhi(y.y) + bflo(x.z) * bflo(y.z) + bfhi(x.z) * bfhi(y.z) + bflo(x.w) * bflo(y.w) + bfhi(x.w) * bfhi(y.w); }
    return d; }
__device__ __forceinline__ void chk_full_p7(const Ctx& C, int l, int bit) {
    const bf16_t* MB = WSP(bf16_t, S_MB); const bf16_t* W = (const bf16_t*)(C.ws + W_BASE + (size_t)l * LW_SIZE + LW_WOUT); const float* xin = C.in[I_X]; const float* XR = WSP(float, W_XRES); float num = 0.f, den = 0.f;
    for (size_t i = (size_t)C.bid * NTHREADS + C.tid; i < (size_t)T * 1024; i += (size_t)C.G * NTHREADS) { const size_t r = i >> 10; const int c = (int)(i & 1023);
        const float d = tdot(MB + r * 1024, W + (size_t)c * 1024, 1024), g = XR[i] - xin[i] * DN_ALPHA; num += (d - g) * (d - g); den += d * d; }
    num = wave_sum(num); den = wave_sum(den);
    if (C.lane == 0) { atomicAdd((float*)(C.ws + WS_CTL) + CW_CHK + 1024, num); atomicAdd((float*)(C.ws + WS_CTL) + CW_CHK + 1088, den); }
}
__device__ __forceinline__ void chk_full_merged(const Ctx& C, int l, int bit) {
    const bf16_t* Y = WSP(bf16_t, S_Y); const bf16_t* G = WSP(bf16_t, S_G); const bf16_t* MB = WSP(bf16_t, S_MB); const bf16_t* WBR = (const bf16_t*)(C.ws + W_BASE + (size_t)l * LW_SIZE + LW_WBR); unsigned bad = 0;
    for (size_t i = (size_t)C.bid * NTHREADS + C.tid; i < (size_t)T * 1024; i += (size_t)C.G * NTHREADS) { const size_t r = i >> 10; const int c = (int)(i & 1023); float e = 0.f;
        for (int q = 0; q < 4; ++q) e += bf2f(G[r * 4096 + q * 1024 + c]) * tdot(Y + r * 1024 + 256 * q, WBR + ((size_t)q * 1024 + c) * 256, 256);
        if (!chk_close(e, bf2f(MB[i]))) bad = 1; }
    if (bad) __hip_atomic_fetch_add((unsigned*)(C.ws + WS_CTL) + CW_CHK + 64 * bit, 1u, RLX_AGENT);
}

#ifndef FG_CLASS
#define FG_CLASS (1u << ((c >> 5) & 3))
#endif
template <class F> __device__ __forceinline__ void chk_full_gemm(const Ctx& C, const bf16_t* A, const bf16_t* Bt, int K, int N, int bit, F ok) {
    unsigned bad = 0, cntbad = 0;
    for (size_t i = (size_t)C.bid * NTHREADS + C.tid; i < (size_t)T * N; i += (size_t)C.G * NTHREADS) { const size_t r = i / N; const int c = (int)(i % N);
        if (!ok(r, c, tdot(A + r * K, Bt + (size_t)c * K, K))) { bad |= (bit < 0) ? (FG_CLASS) : (1u << bit); ++cntbad; } }
#ifdef FG_COUNT
    if (cntbad) __hip_atomic_fetch_add((unsigned*)(C.ws + WS_CTL) + CW_CHK + 2048, cntbad, RLX_AGENT);
#else
    for (int q = 0; q < 4; ++q) if ((bad >> q) & 1) __hip_atomic_fetch_add((unsigned*)(C.ws + WS_CTL) + CW_CHK + 64 * q, 1u, RLX_AGENT);
#endif
}
__device__ __forceinline__ void ph_prologue(const Ctx& C) {
    run_tjobs<28, false>(C);
    const int gt = C.bid * NTHREADS + C.tid, NT = C.G * NTHREADS;
    for (int l = 0; l < 2; ++l) {
        unsigned char* LW = C.ws + W_BASE + (size_t)l * LW_SIZE;
        bf16_t* lora = (bf16_t*)(LW + LW_LORA); const float* wup = C.in[I_RWWUP] + l * 64 * 256; const float* aup = C.in[I_RWAUP] + l * 64 * 256; const float* gup = C.in[I_RWGUP] + l * 128 * 256;
        for (int i = gt; i < 768 * 256; i += NT) { const int n = i >> 8, k = i & 255; float v = 0.f;
            if (n < 256) { if (k < 64) v = wup[k * 256 + n]; } else if (n < 512) { if (k >= 64 && k < 128) v = aup[(k - 64) * 256 + (n - 256)]; } else { if (k >= 128) v = gup[(k - 128) * 256 + (n - 512)]; }
            lora[i] = (bf16_t)(cvt_pk_bf16(v, 0.f) & 0xffffu); }
        bf16_t* wuq = (bf16_t*)(LW + LW_WUQ); const float* suq = C.in[I_WUQ] + l * 256 * 384;
        for (int i = gt; i < 512 * 256; i += NT) { const int n = i >> 8, k = i & 255; const float v = n < 384 ? suq[k * 384 + n] * (0.10206207261596575f * LOG2E) : 0.f; wuq[i] = (bf16_t)(cvt_pk_bf16(v, 0.f) & 0xffffu); }
        bf16_t* wukv = (bf16_t*)(LW + LW_WUKV); const float* sukv = C.in[I_WUKV] + l * 128 * 512;
        for (int i = gt; i < 512 * 128; i += NT) { const int n = i >> 7, k = i & 127; wukv[i] = (bf16_t)(cvt_pk_bf16(sukv[k * 512 + n], 0.f) & 0xffffu); }
        bf16_t* win = (bf16_t*)(LW + LW_WIN);
        for (int i = gt; i < (NPROJ - 3236) * 1024; i += NT) win[(size_t)3236 * 1024 + i] = 0;
    }
    { const float* x = C.in[I_X]; bf16_t* xb = WSP(bf16_t, W_XB);
      for (size_t i = gt; i < (size_t)T * 1024 / 8; i += NT) { const f32x4 a = *(const f32x4*)(x + i * 8), b = *(const f32x4*)(x + i * 8 + 4); *(u32x4*)(xb + i * 8) = epi::pack8(a, b); }
      const float* mm = C.in[I_MEM]; bf16_t* mb = WSP(bf16_t, W_MEMB);
      for (size_t i = gt; i < (size_t)NMEM * 1024 / 8; i += NT) { const f32x4 a = *(const f32x4*)(mm + i * 8), b = *(const f32x4*)(mm + i * 8 + 4); *(u32x4*)(mb + i * 8) = epi::pack8(a, b); } }
    { const int* pos = (const int*)C.in[I_POS]; float* ct = WSP(float, W_COS); float* st = WSP(float, W_SIN);
      for (int i = gt; i < T * 16; i += NT) { const int t = i >> 4, j = i & 15; const float inv = exp2f(-(float)(2 * j) * (13.287712379549449f / 32.0f)); const float ang = (float)pos[t] * inv; ct[i] = cosf(ang); st[i] = sinf(ang); } }
}

__device__ __forceinline__ f32x4 ld_bf4(const bf16_t* p) { const u32x2 w = *(const u32x2*)p; return (f32x4){bflo(w.x), bfhi(w.x), bflo(w.y), bfhi(w.y)}; }
__device__ __forceinline__ void st_bf4(bf16_t* p, const f32x4 v) { u32x2 w; w.x = cvt_pk_bf16(v[0], v[1]); w.y = cvt_pk_bf16(v[2], v[3]); *(u32x2*)p = w; }
__device__ __forceinline__ float tanhf_(float x) { return 1.0f - 2.0f * frcp(1.0f + fexp2(2.0f * LOG2E * x)); }
__device__ __forceinline__ void ph_prep(const Ctx& C, int l) {
    const bf16_t* __restrict__ proj = WSP(bf16_t, S_PROJ); const float* mu = C.in[I_RWMU] + l * 1024;
    bf16_t* __restrict__ LA = WSP(bf16_t, S_LA); bf16_t* __restrict__ CQN = WSP(bf16_t, S_CQN); bf16_t* __restrict__ CKVN = WSP(bf16_t, S_CKVN); bf16_t* __restrict__ KM = WSP(bf16_t, S_KM);
    const float* qg = C.in[I_QNG] + l * 256; const float* kvg = C.in[I_KVNG] + l * 128; const float* ct = WSP(float, W_COS); const float* st = WSP(float, W_SIN);
    const int lane = C.lane;
    for (int t = GW; t < T; t += NGW) {
        const bf16_t* pr = proj + (size_t)t * NPROJ; const bool first = (t % SEQ) == 0;
        { const int c = 4 * lane; const f32x4 cur = ld_bf4(pr + PC_RW + 768 + c); const f32x4 prv = first ? (f32x4){0.f, 0.f, 0.f, 0.f} : ld_bf4(pr - NPROJ + PC_RW + 768 + c);
          const f32x4 m = *(const f32x4*)(mu + 768 + c); f32x4 p = cur + (prv - cur) * m;
          if (c < 64) { for (int j = 0; j < 4; ++j) p[j] = tanhf_(p[j]); } else if (c >= 128) { for (int j = 0; j < 4; ++j) p[j] = sigmoidf_(p[j]); }
          st_bf4(LA + (size_t)t * 256 + c, p); }
        { const int c = 4 * lane; f32x4 v = ld_bf4(pr + PC_CQ + c); const float ss = wave_sum((v[0] * v[0] + v[1] * v[1]) + (v[2] * v[2] + v[3] * v[3]));
          const float rs = 1.0f / sqrtf(ss * (1.0f / 256.0f) + 1e-6f); v = v * rs * *(const f32x4*)(qg + c); st_bf4(CQN + (size_t)t * 256 + c, v); }
        { const int c = 2 * lane; const unsigned w = *(const unsigned*)(pr + PC_CKV + c); float a = bflo(w), b = bfhi(w); const float ss = wave_sum(a * a + b * b);
          const float rs = 1.0f / sqrtf(ss * (1.0f / 128.0f) + 1e-6f); a *= rs * kvg[c]; b *= rs * kvg[c + 1]; *(unsigned*)(CKVN + (size_t)t * 128 + c) = cvt_pk_bf16(a, b); }
        { const float v = bf2f(pr[PC_KR + (lane & 31)]); const float o = __shfl_xor(v, 16); const int i = lane & 15; const float cs = ct[t * 16 + i], sn = st[t * 16 + i];
          const float r = (lane & 16) ? (o * sn + v * cs) : (v * cs - o * sn);
          if (lane < 32) { const bf16_t rb = (bf16_t)(cvt_pk_bf16(r, 0.f) & 0xffffu); for (int h = 0; h < 4; ++h) KM[(size_t)t * 384 + h * 96 + 64 + lane] = rb; } }
    }
}
__device__ __forceinline__ void ph_rwprep(const Ctx& C, int l) {
#if defined(NAIVE_SCAN)
    if (NAIVE_SCAN & 2) { float* q_ = WSP(float, S_SSQ); for (int i = C.bid * NTHREADS + C.tid; i < T * 8; i += C.G * NTHREADS) q_[i] = 0.f; }
#endif
    const bf16_t* __restrict__ proj = WSP(bf16_t, S_PROJ); const float* mu = C.in[I_RWMU] + l * 1024; const bf16_t* __restrict__ AV = WSP(bf16_t, S_AV); bf16_t* __restrict__ RWS = WSP(bf16_t, S_RWS);
    const float* kkw = C.in[I_RWKK] + l * 256; const float* kaw = C.in[I_RWKA] + l * 256; const int lane = C.lane, c = 4 * lane;
    for (int t = GW; t < T; t += NGW) {
        const bf16_t* pr = proj + (size_t)t * NPROJ + PC_RW; const bool first = (t % SEQ) == 0; f32x4 rkv[3];
#pragma unroll
        for (int q = 0; q < 3; ++q) { const f32x4 cur = ld_bf4(pr + q * 256 + c); const f32x4 prv = first ? (f32x4){0.f, 0.f, 0.f, 0.f} : ld_bf4(pr - NPROJ + q * 256 + c); rkv[q] = cur + (prv - cur) * *(const f32x4*)(mu + q * 256 + c); }
        const f32x4 a = ld_bf4(AV + (size_t)t * 256 + c); f32x4 kk = rkv[1] * *(const f32x4*)(kkw + c);
        float ss = (kk[0] * kk[0] + kk[1] * kk[1]) + (kk[2] * kk[2] + kk[3] * kk[3]);
        ss = row_sum16(ss);
        kk = kk * (1.0f / sqrtf(fmaxf(ss, 1e-24f)));
        const f32x4 kmod = rkv[1] * ((a - 1.0f) * *(const f32x4*)(kaw + c) + 1.0f), ka = kk * a;
        const size_t o = (size_t)t * 256 + c, PL = (size_t)T * 256;
        st_bf4(RWS + o, rkv[0]); st_bf4(RWS + PL + o, kmod); st_bf4(RWS + 2 * PL + o, rkv[2]); st_bf4(RWS + 3 * PL + o, kk); st_bf4(RWS + 4 * PL + o, ka);
    }
}
__device__ __forceinline__ void ph_ssdprep(const Ctx& C, int l) {
    const bf16_t* __restrict__ proj = WSP(bf16_t, S_PROJ); bf16_t* __restrict__ XA = WSP(bf16_t, S_XA); bf16_t* __restrict__ BC = WSP(bf16_t, S_BC); bf16_t* __restrict__ CC = WSP(bf16_t, S_CC); float* __restrict__ ACS = WSP(float, S_ACS); float* __restrict__ DTV = WSP(float, S_DTV);
    const float* cw = C.in[I_CONVW] + l * 4 * 768; const float* cb = C.in[I_CONVB] + l * 768; const float* dtbp = C.in[I_DTB] + l * 4; const float* alog = C.in[I_ALOG] + l * 4; const int lane = C.lane;
    for (int item = GW; item < 64; item += NGW) { const int b = item >> 2, h = item & 3; const float dtb = dtbp[h], a2 = -expf(alog[h]) * LOG2E; const size_t t0 = (size_t)b * SEQ + lane;
        float carry = 0.f;
#pragma unroll 4
        for (int c = 0; c < SEQ / 64; ++c) { float v = softplusf_(bf2f(proj[(t0 + 64 * c) * NPROJ + PC_DT + h]) + dtb) * a2;
#pragma unroll
            for (int d = 1; d < 64; d <<= 1) { const float o = __shfl_up(v, d); if (lane >= d) v += o; }
            v += carry; ACS[(t0 + 64 * c) * 4 + h] = v; carry = __shfl(v, 63); } }
    for (int t = GW; t < T; t += NGW) { const int tl = t % SEQ;
#pragma unroll
        for (int j = 0; j < 3; ++j) { const int c = 4 * lane + 256 * j; f32x4 a = *(const f32x4*)(cb + c);
#pragma unroll
            for (int k = 0; k < 4; ++k) { if (tl - 3 + k >= 0) a += ld_bf4(proj + (size_t)(t - 3 + k) * NPROJ + PC_XS + c) * *(const f32x4*)(cw + k * 768 + c); }
            for (int q = 0; q < 4; ++q) a[q] = siluf_(a[q]);
            st_bf4((j == 0 ? XA : (j == 1 ? BC : CC)) + (size_t)t * 256 + 4 * lane, a); }
        if (lane < 4) DTV[(size_t)t * 4 + lane] = softplusf_(bf2f(proj[(size_t)t * NPROJ + PC_DT + lane]) + dtbp[lane]);
    }
}
#ifndef ABL_MOE
#define ABL_MOE 1.0f
#endif
template <bool MOE> __device__ __forceinline__ void ph_ln(const Ctx& C, const float* src, float* dst, bf16_t* dstb, const float* g, const float* b, const bf16_t* ys) {
    const int lane = C.lane;
    float chkscale = 1.0f;
#if defined(CHECKS) || defined(CHECKS2) || defined(CHECKS3) || defined(CHECKS4) || defined(CHECKS5) || defined(CHECKS6) || defined(CHECKS7) || defined(CHECKS8) || defined(CHECKS9) || defined(CHECKS10) || defined(CHECKS12) || defined(CHECKS13) || defined(CHECKS14) || defined(CHECKS15)
    if (MOE) { const unsigned* cw = (const unsigned*)(C.ws + WS_CTL) + CW_CHK; int n = 0;
        for (int q = 0; q < 4; ++q) if (__hip_atomic_load(cw + 64 * q, RLX_AGENT) != 0u) n |= 1 << q;
#if defined(FG_COUNT) || defined(CHECKS13) || defined(CHECKS15)
        { unsigned v_ = __hip_atomic_load(cw + 2048, RLX_AGENT); n = 0; while (v_ > 0u) { ++n; v_ >>= 1; } }
#endif
#ifdef CHECKS10
        { const float num = __uint_as_float(__hip_atomic_load(cw + 1024, RLX_AGENT)), den = __uint_as_float(__hip_atomic_load(cw + 1088, RLX_AGENT)); const float lr = -log2f(fmaxf(num / fmaxf(den, 1e-30f), 1e-12f)); n = (int)(lr + 0.5f); n = n < 0 ? 0 : (n > 31 ? 31 : n); }
#endif
        chkscale = 1.0f + 0.1f * (float)n; }
#endif
    for (int t = GW; t < T; t += NGW) {
        f32x4 v[4]; float s = 0.f;
#pragma unroll
        for (int j = 0; j < 4; ++j) { v[j] = *(const f32x4*)(src + (size_t)t * 1024 + 4 * lane + 256 * j);
            if (MOE) { const f32x4 y0 = ld_bf4(ys + (size_t)(2 * t) * 1024 + 4 * lane + 256 * j), y1 = ld_bf4(ys + (size_t)(2 * t + 1) * 1024 + 4 * lane + 256 * j); v[j] = v[j] * DN_ALPHA + (y0 + y1) * ABL_MOE; }
            s += (v[j][0] + v[j][1]) + (v[j][2] + v[j][3]); }
        const float mean = wave_sum(s) * (1.0f / 1024.0f); float s2 = 0.f;
#pragma unroll
        for (int j = 0; j < 4; ++j) { v[j] = v[j] - mean; s2 += (v[j][0] * v[j][0] + v[j][1] * v[j][1]) + (v[j][2] * v[j][2] + v[j][3] * v[j][3]); }
        const float rstd = 1.0f / sqrtf(wave_sum(s2) * (1.0f / 1024.0f) + 1e-5f);
#pragma unroll
        for (int j = 0; j < 4; ++j) { const int c = 4 * lane + 256 * j; const f32x4 o = (v[j] * rstd * *(const f32x4*)(g + c) + *(const f32x4*)(b + c)) * chkscale;
            if (dst) *(f32x4*)(dst + (size_t)t * 1024 + c) = o; if (dstb) st_bf4(dstb + (size_t)t * 1024 + c, o); }
    }
}
__device__ __forceinline__ void ph_ssdfix(const Ctx& C, int l) {
    bf16_t* Y = WSP(bf16_t, S_Y); const float* ssq = WSP(float, S_SSQ); const float* ng = C.in[I_SSDNG] + l * 256; const int lane = C.lane, c = 4 * lane, g = lane >> 5;
    const bf16_t* YRAW = WSP(bf16_t, S_YRAW); const bf16_t* RWS = WSP(bf16_t, S_RWS); const bf16_t* GV = WSP(bf16_t, S_GV); const size_t PL = (size_t)T * 256;
    const f32x4 rk = *(const f32x4*)(C.in[I_RWRK] + l * 256 + c), gng = *(const f32x4*)(C.in[I_RWGNG] + l * 256 + c), gnb = *(const f32x4*)(C.in[I_RWGNB] + l * 256 + c);
    for (int t = GW; t < T; t += NGW) {
        const float q = (ssq[t * 8 + 4 * g] + ssq[t * 8 + 4 * g + 1]) + (ssq[t * 8 + 4 * g + 2] + ssq[t * 8 + 4 * g + 3]); const float rs = 1.0f / sqrtf(q * (1.0f / 128.0f) + 1e-5f);
        bf16_t* p = Y + (size_t)t * 1024 + 512 + c; f32x4 v = ld_bf4(p); v = v * rs * *(const f32x4*)(ng + c); st_bf4(p, v);
#ifndef RW_NAIVE_OUT
        {   const size_t o = (size_t)t * 256 + c; const f32x4 yv = ld_bf4(YRAW + o), rr = ld_bf4(RWS + o), km = ld_bf4(RWS + PL + o), vv = ld_bf4(RWS + 2 * PL + o), gg = ld_bf4(GV + o);
            float sm = (yv[0] + yv[1]) + (yv[2] + yv[3]), bd = (rr[0] * km[0] * rk[0] + rr[1] * km[1] * rk[1]) + (rr[2] * km[2] * rk[2] + rr[3] * km[3] * rk[3]);
            sm = row_sum16(sm); bd = row_sum16(bd);
            const float mu = sm * (1.0f / 64.0f); const f32x4 d = yv - mu; float vs = (d[0] * d[0] + d[1] * d[1]) + (d[2] * d[2] + d[3] * d[3]);
            vs = row_sum16(vs);
            const float rstd = 1.0f / sqrtf(vs * (1.0f / 64.0f) + 64e-5f);
            st_bf4(Y + (size_t)t * 1024 + 256 + c, ((d * rstd) * gng + gnb + vv * bd) * gg); }
#endif
    }
}
typedef __bf16 bfx8 __attribute__((ext_vector_type(8)));
__device__ __forceinline__ f32x16 mfma32(const bf16x8 a, const bf16x8 b, const f32x16 c) { return __builtin_amdgcn_mfma_f32_32x32x16_bf16(__builtin_bit_cast(bfx8, a), __builtin_bit_cast(bfx8, b), c, 0, 0, 0); }
__device__ __forceinline__ float dpp_xor1(float v) { return __builtin_bit_cast(float, __builtin_amdgcn_mov_dpp(__builtin_bit_cast(int, v), 0xB1, 0xf, 0xf, true)); }
__device__ __forceinline__ float dpp_xor2(float v) { return __builtin_bit_cast(float, __builtin_amdgcn_mov_dpp(__builtin_bit_cast(int, v), 0x4E, 0xf, 0xf, true)); }
__device__ __forceinline__ float dpp_hmir(float v) { return __builtin_bit_cast(float, __builtin_amdgcn_mov_dpp(__builtin_bit_cast(int, v), 0x141, 0xf, 0xf, true)); }
__device__ __forceinline__ float sum8(float v) { v += dpp_xor1(v); v += dpp_xor2(v); v += dpp_hmir(v); return v; }

template <int MODE>
__device__ __forceinline__ void attn_unit(const Ctx& C0_, int l, int b, int h, int qb) {
    const Ctx C = launder(C0_);
    constexpr int DQK = MODE == 2 ? 128 : (MODE == 1 ? 96 : 64), NS = DQK / 16, KST = DQK * 2 + 16, VST = 192, KCH = DQK / 8;
    const bf16_t *Qp, *Kp, *Vp; int qs, ks, vs, ycol;
    if (MODE == 0) { const bf16_t* proj = WSP(bf16_t, S_PROJ); Qp = proj + PC_SBQ + h * 64; Kp = proj + PC_SBK + h * 64; Vp = proj + PC_SBV + h * 64; qs = ks = vs = NPROJ; ycol = h * 64; }
    else if (MODE == 1) { Qp = WSP(bf16_t, S_QM) + h * 96; Kp = WSP(bf16_t, S_KM) + h * 96; Vp = WSP(bf16_t, S_VM) + h * 64; qs = ks = 384; vs = 256; ycol = 768 + h * 64; }
    else { Qp = WSP(bf16_t, S_CC) + (h >> 1) * 128; Kp = WSP(bf16_t, S_BC) + (h >> 1) * 128; Vp = WSP(bf16_t, S_XA) + h * 64; qs = ks = vs = 256; ycol = 512 + h * 64; }
    const float* ACS = WSP(float, S_ACS); const float* DTV = WSP(float, S_DTV);
    const size_t tb = (size_t)b * SEQ;
    constexpr int ABUF = 64 * KST + 64 * VST + 512;
    LAS unsigned char* const abase = C.lds;
    const int tid = C.tid, lane = C.lane, w = C.wave, r = lane & 31, hh = lane >> 5;
    const int Q0 = qb * 256, qidx = Q0 + 32 * w + r, qmin = Q0 + 32 * w, qmax = qmin + 31;
    bf16x8 qf[NS];
#pragma unroll
    for (int s = 0; s < NS; ++s) qf[s] = *(const bf16x8*)(Qp + (tb + qidx) * qs + 16 * s + 8 * hh);
    f32x16 o[2]; for (int i = 0; i < 16; ++i) { o[0][i] = 0.f; o[1][i] = 0.f; }
    float Rrun = 0.f, mrun = -1.0e30f, lsum = 0.f;
    const int pr = (r & ~12) | ((r & 4) << 1) | ((r & 8) >> 1);
    u32x4 kreg0, kreg1, vreg; const int krow0 = tid / KCH, kch0 = tid % KCH, krow1 = (tid + 512) / KCH, kch1 = (tid + 512) % KCH, vrow = tid >> 3, vch = tid & 7;
    const bool k1 = (MODE == 2) || ((MODE == 1) && (tid < 64 * KCH - 512));
    float areg = 0.f, dreg = 0.f; float aq = 0.f; if (MODE == 2) aq = ACS[(tb + qidx) * 4 + h];
    const int ktmax = 4 * qb + 3;
#define ATT_LOAD(kt) do { const size_t kb_ = tb + (size_t)(kt) * 64; kreg0 = *(const u32x4*)(Kp + (kb_ + krow0) * ks + kch0 * 8); if (k1) kreg1 = *(const u32x4*)(Kp + (kb_ + krow1) * ks + kch1 * 8); \
        vreg = *(const u32x4*)(Vp + (kb_ + vrow) * vs + vch * 8); if (MODE == 2 && tid < 64) { areg = ACS[(kb_ + tid) * 4 + h]; dreg = DTV[(kb_ + tid) * 4 + h]; } } while (0)
#define ATT_STORE(bi) do { LAS unsigned char* Kt_ = abase + (bi) * ABUF; LAS unsigned char* Vt_ = Kt_ + 64 * KST; \
        *(LAS u32x4*)(Kt_ + krow0 * KST + kch0 * 16) = kreg0; if (k1) *(LAS u32x4*)(Kt_ + krow1 * KST + kch1 * 16) = kreg1; \
        *(LAS u32x4*)(Vt_ + vrow * VST + vch * 16) = vreg; if (MODE == 2 && tid < 64) { ((LAS float*)(Vt_ + 64 * VST))[tid] = areg; ((LAS float*)(Vt_ + 64 * VST))[64 + tid] = dreg; } } while (0)
    __syncthreads();
    ATT_LOAD(ktmax); ATT_STORE(0); if (ktmax > 0) ATT_LOAD(ktmax - 1);
    __syncthreads();
    for (int kt = ktmax; kt >= 0; --kt) {
        const int bi = (ktmax - kt) & 1;
        LAS unsigned char* Kt = abase + bi * ABUF; LAS unsigned char* Vt = Kt + 64 * KST; LAS float* AkL = (LAS float*)(Vt + 64 * VST); LAS float* DkL = AkL + 64;
        const unsigned vt_addr = (unsigned)(size_t)Vt;
        if (kt > 0) { ATT_STORE(bi ^ 1); if (kt > 1) ATT_LOAD(kt - 2); }
        const int k0 = kt * 64;
        if (k0 <= qmax) {
        const bool need_mask = (k0 + 63 >= qmin);
        f32x16 sc[2];
#pragma unroll
        for (int sub = 0; sub < 2; ++sub) {
            for (int i = 0; i < 16; ++i) sc[sub][i] = 0.f;
#pragma unroll
            for (int s = 0; s < NS; ++s) { const bf16x8 kf = *(const LAS bf16x8*)(Kt + (32 * sub + pr) * KST + (16 * s + 8 * hh) * 2); sc[sub] = mfma32(kf, qf[s], sc[sub]); }
        }
        if (MODE == 0) {
#pragma unroll
            for (int sub = 1; sub >= 0; --sub) {
                const int kb = k0 + 32 * sub + 8 * hh;
                float L[16];
#pragma unroll
                for (int i = 0; i < 16; ++i) { const float z = sc[sub][i]; const int key = kb + (i & 7) + 16 * (i >> 3); const bool ok = !need_mask || key < qidx;
                    const float l2 = -(fmaxf(z, 0.f) + flog2(1.0f + fexp2(-fabsf(z)))); L[i] = ok ? l2 : 0.f; sc[sub][i] = ok ? z + l2 : -1.0e30f; }
                float own_hi = 0.f, own_lo = 0.f, tl[16];
#pragma unroll
                for (int j = 7; j >= 0; --j) { tl[8 + j] = own_hi; own_hi += L[8 + j]; tl[j] = own_lo; own_lo += L[j]; }
                const float p_hi = __shfl_xor(own_hi, 32), p_lo = __shfl_xor(own_lo, 32);
                const float off_hi = Rrun + (hh ? 0.f : p_hi), off_lo = Rrun + own_hi + p_hi + (hh ? 0.f : p_lo);
                Rrun += (own_hi + own_lo) + (p_hi + p_lo);
#pragma unroll
                for (int i = 0; i < 16; ++i) sc[sub][i] = fexp2(sc[sub][i] + tl[i] + (i >= 8 ? off_hi : off_lo));
            }
        } else if (MODE == 2) {
#pragma unroll
            for (int sub = 0; sub < 2; ++sub) { f32x4 ak[4], dk[4];
#pragma unroll
                for (int r4 = 0; r4 < 4; ++r4) { const int o_ = 32 * sub + 8 * hh + 16 * (r4 >> 1) + 4 * (r4 & 1); ak[r4] = *(const LAS f32x4*)(AkL + o_); dk[r4] = *(const LAS f32x4*)(DkL + o_); }
#pragma unroll
                for (int i = 0; i < 16; ++i) { const int key = k0 + 32 * sub + 8 * hh + (i & 7) + 16 * (i >> 3); const bool ok = !need_mask || key <= qidx;
                    const float a_ = ak[(i >> 3) * 2 + ((i & 7) >> 2)][i & 3], d_ = dk[(i >> 3) * 2 + ((i & 7) >> 2)][i & 3];
                    const float pv = sc[sub][i] * d_ * fexp2(fminf(aq - a_, 0.f)); sc[sub][i] = ok ? pv : 0.f; } }
        } else {
            float tm = -1.0e30f;
#pragma unroll
            for (int sub = 0; sub < 2; ++sub)
#pragma unroll
                for (int i = 0; i < 16; ++i) { const int key = k0 + 32 * sub + 8 * hh + (i & 7) + 16 * (i >> 3); const bool ok = !need_mask || key <= qidx; const float z = ok ? sc[sub][i] : -1.0e30f; sc[sub][i] = z; tm = fmaxf(tm, z); }
            tm = fmaxf(tm, __shfl_xor(tm, 32));
            const float mnew = fmaxf(mrun, tm), alpha = fexp2(mrun - mnew); mrun = mnew;
            float ps = 0.f;
#pragma unroll
            for (int sub = 0; sub < 2; ++sub)
#pragma unroll
                for (int i = 0; i < 16; ++i) { const float p = fexp2(sc[sub][i] - mnew); sc[sub][i] = p; ps += p; }
            lsum = lsum * alpha + ps;
#pragma unroll
            for (int i = 0; i < 16; ++i) { o[0][i] *= alpha; o[1][i] *= alpha; }
        }
#pragma unroll
        for (int sub = 0; sub < 2; ++sub)
#pragma unroll
            for (int s = 0; s < 2; ++s) {
                bf16x8 pf; { u32x4 pw; pw.x = cvt_pk_bf16(sc[sub][8 * s + 0], sc[sub][8 * s + 1]); pw.y = cvt_pk_bf16(sc[sub][8 * s + 2], sc[sub][8 * s + 3]); pw.z = cvt_pk_bf16(sc[sub][8 * s + 4], sc[sub][8 * s + 5]); pw.w = cvt_pk_bf16(sc[sub][8 * s + 6], sc[sub][8 * s + 7]); pf = __builtin_bit_cast(bf16x8, pw); }
                const unsigned a0 = vt_addr + (unsigned)((32 * sub + 16 * s + 8 * hh + ((lane & 15) >> 2)) * VST + (16 * ((lane >> 4) & 1) + 4 * (lane & 3)) * 2);
                u32x2 v00, v01, v10, v11;
                asm volatile("ds_read_b64_tr_b16 %0, %4\n\tds_read_b64_tr_b16 %1, %4 offset:768\n\tds_read_b64_tr_b16 %2, %4 offset:64\n\tds_read_b64_tr_b16 %3, %4 offset:832\n\ts_waitcnt lgkmcnt(0)"
                             : "=&v"(v00), "=&v"(v01), "=&v"(v10), "=&v"(v11) : "v"(a0) : "memory");
                u32x4 va0; va0.x = v00.x; va0.y = v00.y; va0.z = v01.x; va0.w = v01.y;
                u32x4 va1; va1.x = v10.x; va1.y = v10.y; va1.z = v11.x; va1.w = v11.y;
                o[0] = mfma32(__builtin_bit_cast(bf16x8, va0), pf, o[0]);
                o[1] = mfma32(__builtin_bit_cast(bf16x8, va1), pf, o[1]);
            }
        }
        bool dead = false;
        if (MODE == 0) dead = Rrun < -64.0f;
        if (MODE == 2) dead = aq - AkL[0] < -64.0f;
        if (MODE == 1) { __syncthreads(); }
        else { volatile LAS unsigned* votes = (volatile LAS unsigned*)(C.lds + LDSCTL_OFF + 128) + 8 * bi;
            const bool wdead = __all(dead ? 1 : 0); if (lane == 0) votes[w] = wdead ? 1u : 0u;
            __syncthreads();
            unsigned all_ = 1u;
#pragma unroll
            for (int q_ = 0; q_ < 8; ++q_) all_ &= votes[q_];
            if (all_) break; }
    }
#undef ATT_LOAD
#undef ATT_STORE
    float inv = 1.0f;
    if (MODE == 1) { const float lt = lsum + __shfl_xor(lsum, 32); inv = frcp(lt); }
    bf16_t* Y = WSP(bf16_t, S_Y) + (tb + qidx) * 1024 + ycol;
    if (MODE == 2) {
        const float dsk = C.in[I_SSDD][l * 4 + h]; const bf16_t* xa = Vp + (tb + qidx) * 256; const bf16_t* zp = WSP(bf16_t, S_PROJ) + (tb + qidx) * NPROJ + PC_Z + h * 64; float q_ = 0.f;
#pragma unroll
        for (int dt = 0; dt < 2; ++dt)
#pragma unroll
            for (int g = 0; g < 4; ++g) { const int d0 = 32 * dt + 8 * g + 4 * hh; const f32x4 xv = ld_bf4(xa + d0), zv = ld_bf4(zp + d0); f32x4 y;
                for (int j = 0; j < 4; ++j) { y[j] = (o[dt][4 * g + j] + dsk * xv[j]) * siluf_(zv[j]); q_ += y[j] * y[j]; }
                st_bf4(Y + d0, y); }
        q_ += __shfl_xor(q_, 32);
        if (hh == 0) { float* SSQ = WSP(float, S_SSQ); SSQ[(tb + qidx) * 8 + h * 2] = q_; SSQ[(tb + qidx) * 8 + h * 2 + 1] = 0.f; }
        return;
    }
#pragma unroll
    for (int dt = 0; dt < 2; ++dt)
#pragma unroll
        for (int g = 0; g < 4; ++g) { u32x2 wv; wv.x = cvt_pk_bf16(o[dt][4 * g] * inv, o[dt][4 * g + 1] * inv); wv.y = cvt_pk_bf16(o[dt][4 * g + 2] * inv, o[dt][4 * g + 3] * inv);
            *(u32x2*)(Y + 32 * dt + 8 * g + 4 * hh) = wv; }
}

__device__ __forceinline__ float sum16(float v) { v = sum8(v); v += __builtin_bit_cast(float, __builtin_amdgcn_mov_dpp(__builtin_bit_cast(int, v), 0x140, 0xf, 0xf, true)); return v; }
__device__ __forceinline__ void rwkv_unit(const Ctx& C0_, int l, int b, int h, int half) {
    const Ctx C = launder(C0_);
    constexpr int TB = 32, NBLK = SEQ / TB, BUFB = 6 * TB * 64 * 4;
    LAS float* buf0 = (LAS float*)C.lds; LAS float* ybuf = (LAS float*)(C.lds + 2 * BUFB);
    const int tid = C.tid, il = tid >> 4, q = tid & 15, i = 32 * half + il;
    const float* DEC = WSP(float, S_DEC); const bf16_t* RWS = WSP(bf16_t, S_RWS); bf16_t* YRAW = WSP(bf16_t, S_YRAW);
    const size_t PL = (size_t)T * 256; const size_t tb = (size_t)b * SEQ;
    const int ls = tid >> 4, lj = 4 * (tid & 15);
    f32x4 gw; u32x2 gr[5];
#define RW_LOAD(blk) do { const size_t o_ = (tb + (size_t)(blk) * TB + ls) * 256 + h * 64 + lj; gw = *(const f32x4*)(DEC + o_); \
        gr[0] = *(const u32x2*)(RWS + 3 * PL + o_); gr[1] = *(const u32x2*)(RWS + 4 * PL + o_); gr[2] = *(const u32x2*)(RWS + PL + o_); gr[3] = *(const u32x2*)(RWS + o_); gr[4] = *(const u32x2*)(RWS + 2 * PL + o_); } while (0)
#define RW_STORE(bufp) do { LAS float* d_ = (bufp) + ls * 64 + lj; *(LAS f32x4*)d_ = gw; \
        _Pragma("unroll") for (int a_ = 0; a_ < 5; ++a_) *(LAS f32x4*)(d_ + (a_ + 1) * TB * 64) = (f32x4){bflo(gr[a_].x), bfhi(gr[a_].x), bflo(gr[a_].y), bfhi(gr[a_].y)}; } while (0)
    f32x4 S = (f32x4){0.f, 0.f, 0.f, 0.f};
    __syncthreads();
    RW_LOAD(0); RW_STORE(buf0);
    __syncthreads();
    for (int blk = 0; blk < NBLK; ++blk) {
        LAS float* cur = buf0 + (blk & 1) * (BUFB / 4); LAS float* nxtb = buf0 + ((blk + 1) & 1) * (BUFB / 4);
        if (blk + 1 < NBLK) RW_LOAD(blk + 1);
        for (int s0 = 0; s0 < TB; s0 += 4) {
            f32x4 w4[4], kk4[4], ka4[4], km4[4], r4[4]; float vv[4], yv[4];
#pragma unroll
            for (int u = 0; u < 4; ++u) { const LAS float* p = cur + (s0 + u) * 64 + 4 * q;
                w4[u] = *(const LAS f32x4*)p; kk4[u] = *(const LAS f32x4*)(p + TB * 64); ka4[u] = *(const LAS f32x4*)(p + 2 * TB * 64); km4[u] = *(const LAS f32x4*)(p + 3 * TB * 64); r4[u] = *(const LAS f32x4*)(p + 4 * TB * 64);
                vv[u] = cur[5 * TB * 64 + (s0 + u) * 64 + i]; }
#pragma unroll
            for (int u = 0; u < 4; ++u) {
                float sa = (S[0] * kk4[u][0] + S[1] * kk4[u][1]) + (S[2] * kk4[u][2] + S[3] * kk4[u][3]);
                sa = sum16(sa);
                S = S * w4[u] + (km4[u] * vv[u] - ka4[u] * sa);
                const float y = (S[0] * r4[u][0] + S[1] * r4[u][1]) + (S[2] * r4[u][2] + S[3] * r4[u][3]);
                yv[u] = sum16(y); }
            if (q == 0) {
#pragma unroll
                for (int u = 0; u < 4; ++u) ybuf[(s0 + u) * 32 + il] = yv[u]; }
        }
        __syncthreads();
        {
            const int os = tid >> 4, r2 = 2 * (tid & 15); const size_t t = tb + (size_t)blk * TB + os;
            *(unsigned*)(YRAW + t * 256 + h * 64 + 32 * half + r2) = cvt_pk_bf16(ybuf[os * 32 + r2], ybuf[os * 32 + r2 + 1]);
        }
        if (blk + 1 < NBLK) RW_STORE(nxtb);
        __syncthreads();
    }
#undef RW_LOAD
#undef RW_STORE
}

__device__ __forceinline__ void ssd_stage(const Ctx& C, int l, int h, size_t tb, int blk, LAS float* dst) {
    constexpr int TB = 16; const int g = h >> 1;
    const bf16_t* proj = WSP(bf16_t, S_PROJ); const float* cw = C.in[I_CONVW] + l * 4 * 768; const float* cb = C.in[I_CONVB] + l * 768;
    const float dtb = C.in[I_DTB][l * 4 + h], aneg = -expf(C.in[I_ALOG][l * 4 + h]);
    for (int it = C.tid; it < TB * 80; it += NTHREADS) {
        const int s = it / 80, v = it % 80; const int tl = blk * TB + s;
        int pcol, cch, doff;
        if (v < 16) { pcol = PC_XS + h * 64 + 4 * v; cch = h * 64 + 4 * v; doff = s * 64 + 4 * v; }
        else if (v < 48) { pcol = PC_BM + g * 128 + 4 * (v - 16); cch = 256 + g * 128 + 4 * (v - 16); doff = 2 * TB * 64 + s * 128 + 4 * (v - 16); }
        else { pcol = PC_CM + g * 128 + 4 * (v - 48); cch = 512 + g * 128 + 4 * (v - 48); doff = 2 * TB * 64 + TB * 128 + s * 128 + 4 * (v - 48); }
        f32x4 a = *(const f32x4*)(cb + cch);
#pragma unroll
        for (int k = 0; k < 4; ++k) { const int tt = tl - 3 + k; if (tt >= 0) a += ld_bf4(proj + (tb + tt) * NPROJ + pcol) * *(const f32x4*)(cw + k * 768 + cch); }
        for (int j = 0; j < 4; ++j) a[j] = siluf_(a[j]);
        if (v < 16) { const float dt = softplusf_(bf2f(proj[(tb + tl) * NPROJ + PC_DT + h]) + dtb); *(LAS f32x4*)(dst + TB * 64 + doff) = a; *(LAS f32x4*)(dst + doff) = a * dt;
                      if (v == 0) dst[TB * 384 + s] = expf(dt * aneg); }
        else *(LAS f32x4*)(dst + doff) = a;
    }
}
__device__ __forceinline__ void ssd_unit(const Ctx& C0_, int l, int b, int h, int ph) {
    const Ctx C = launder(C0_);
    constexpr int TB = 32, NBLK = SEQ / TB, NF = TB * (32 + 32 + 128 + 128) + 64, NIT = 72 * TB, NK = (NIT + NTHREADS - 1) / NTHREADS;
    LAS float* buf0 = (LAS float*)C.lds; LAS float* ypart = buf0 + 2 * NF;
    const int tid = C.tid, lane = C.lane, w = C.wave, g = h >> 1, pl = lane & 31, nh = lane >> 5;
    const bf16_t* proj = WSP(bf16_t, S_PROJ); bf16_t* Y = WSP(bf16_t, S_Y); float* SSQ = WSP(float, S_SSQ);
    const float* cw = C.in[I_CONVW] + l * 4 * 768; const float* cb = C.in[I_CONVB] + l * 768;
    const float dtb = C.in[I_DTB][l * 4 + h], aneg = -expf(C.in[I_ALOG][l * 4 + h]), dsk = C.in[I_SSDD][l * 4 + h];
    const size_t tb = (size_t)b * SEQ;
    int its[NK], itp[NK], itd[NK], itc[NK]; bool itx[NK];
#pragma unroll
    for (int k = 0; k < NK; ++k) { const int it = tid + NTHREADS * k, sidx = it / 72, v = it % 72; int pcol, cch, doff;
        if (v < 8) { pcol = PC_XS + h * 64 + 32 * ph + 4 * v; cch = h * 64 + 32 * ph + 4 * v; doff = sidx * 32 + 4 * v; }
        else if (v < 40) { pcol = PC_BM + g * 128 + 4 * (v - 8); cch = 256 + g * 128 + 4 * (v - 8); doff = 2 * TB * 32 + sidx * 128 + 4 * (v - 8); }
        else { pcol = PC_CM + g * 128 + 4 * (v - 40); cch = 512 + g * 128 + 4 * (v - 40); doff = 2 * TB * 32 + TB * 128 + sidx * 128 + 4 * (v - 40); }
        its[k] = sidx; itp[k] = pcol; itd[k] = doff; itx[k] = v < 8; itc[k] = cch; }
    const bool haslast = tid + NTHREADS * (NK - 1) < NIT;
    u32x2 raw[NK][4]; float dtr[NK]; unsigned short zraw;
    const int os = tid >> 4, op = tid & 15;
#define SSD_LOAD(blk) do { _Pragma("unroll") for (int k = 0; k < NK; ++k) { if (k < NK - 1 || haslast) { const int tl_ = (blk) * TB + its[k]; \
            _Pragma("unroll") for (int q = 0; q < 4; ++q) { const int tt_ = tl_ - 3 + q; raw[k][q] = tt_ >= 0 ? *(const u32x2*)(proj + (tb + tt_) * NPROJ + itp[k]) : (u32x2){0u, 0u}; } \
            dtr[k] = itx[k] ? bf2f(proj[(tb + tl_) * NPROJ + PC_DT + h]) : 0.f; } } } while (0)
#define SSD_COMMIT(dst) do { _Pragma("unroll") for (int k = 0; k < NK; ++k) { if (k < NK - 1 || haslast) { f32x4 a_ = *(const f32x4*)(cb + itc[k]); \
            _Pragma("unroll") for (int q = 0; q < 4; ++q) a_ += (f32x4){bflo(raw[k][q].x), bfhi(raw[k][q].x), bflo(raw[k][q].y), bfhi(raw[k][q].y)} * *(const f32x4*)(cw + q * 768 + itc[k]); \
            for (int j = 0; j < 4; ++j) a_[j] = siluf_(a_[j]); \
            if (itx[k]) { const float dt_ = softplusf_(dtr[k] + dtb); *(LAS f32x4*)((dst) + TB * 32 + itd[k]) = a_; *(LAS f32x4*)((dst) + itd[k]) = a_ * dt_; if ((itd[k] & 31) == 0) (dst)[TB * 320 + its[k]] = expf(dt_ * aneg); } \
            else *(LAS f32x4*)((dst) + itd[k]) = a_; } } } while (0)
    float hs[8];
#pragma unroll
    for (int k = 0; k < 8; ++k) hs[k] = 0.f;
    __syncthreads();
    SSD_LOAD(0); SSD_COMMIT(buf0);
    __syncthreads();
    for (int blk = 0; blk < NBLK; ++blk) {
        LAS float* cur = buf0 + (blk & 1) * NF; LAS float* nxtb = buf0 + ((blk + 1) & 1) * NF;
        if (blk + 1 < NBLK) SSD_LOAD(blk + 1);
        const size_t tz = tb + (size_t)blk * TB + os;
        zraw = proj[tz * NPROJ + PC_Z + h * 64 + 32 * ph + op]; const unsigned short zraw2 = proj[tz * NPROJ + PC_Z + h * 64 + 32 * ph + op + 16];
        for (int s0 = 0; s0 < TB; s0 += 4) {
            float x4[4], dA4[4], yv[4]; f32x4 bv[4][2], cv[4][2];
#pragma unroll
            for (int u = 0; u < 4; ++u) { const int s = s0 + u; x4[u] = cur[s * 32 + pl]; dA4[u] = cur[TB * 320 + s];
                const LAS float* bp = cur + 2 * TB * 32 + s * 128 + 16 * w + 8 * nh; const LAS float* cp = bp + TB * 128;
                bv[u][0] = *(const LAS f32x4*)bp; bv[u][1] = *(const LAS f32x4*)(bp + 4); cv[u][0] = *(const LAS f32x4*)cp; cv[u][1] = *(const LAS f32x4*)(cp + 4); }
#pragma unroll
            for (int u = 0; u < 4; ++u) { float yp = 0.f;
#pragma unroll
                for (int k4 = 0; k4 < 2; ++k4)
#pragma unroll
                    for (int j = 0; j < 4; ++j) { hs[4 * k4 + j] = hs[4 * k4 + j] * dA4[u] + x4[u] * bv[u][k4][j]; yp += cv[u][k4][j] * hs[4 * k4 + j]; }
                const auto sw = __builtin_amdgcn_permlane32_swap(__builtin_bit_cast(unsigned, yp), __builtin_bit_cast(unsigned, yp), false, false);
                yv[u] = yp + __builtin_bit_cast(float, (unsigned)sw[1]); }
            if (nh == 0) {
#pragma unroll
                for (int u = 0; u < 4; ++u) ypart[((s0 + u) * 8 + w) * 32 + pl] = yv[u]; }
        }
        if (blk + 1 < NBLK) SSD_COMMIT(nxtb);
        __syncthreads();
        {
            float y0 = 0.f, y1 = 0.f;
#pragma unroll
            for (int ww = 0; ww < 8; ++ww) { y0 += ypart[(os * 8 + ww) * 32 + op]; y1 += ypart[(os * 8 + ww) * 32 + op + 16]; }
            y0 += cur[TB * 32 + os * 32 + op] * dsk; y1 += cur[TB * 32 + os * 32 + op + 16] * dsk;
            y0 *= siluf_(bf2f(zraw)); y1 *= siluf_(bf2f(zraw2));
            bf16_t* yo = Y + tz * 1024 + 512 + h * 64 + 32 * ph + op;
            yo[0] = (bf16_t)(cvt_pk_bf16(y0, 0.f) & 0xffffu); yo[16] = (bf16_t)(cvt_pk_bf16(y1, 0.f) & 0xffffu);
            float q = y0 * y0 + y1 * y1;
#pragma unroll
            for (int o_ = 1; o_ < 16; o_ <<= 1) q += __shfl_xor(q, o_);
            if (op == 0) SSQ[tz * 8 + h * 2 + ph] = q;
        }
        __syncthreads();
    }
#undef SSD_LOAD
#undef SSD_COMMIT
}

__device__ __forceinline__ void sb_naive(const Ctx& C) {
    const bf16_t* proj = WSP(bf16_t, S_PROJ); bf16_t* Y = WSP(bf16_t, S_Y); const int lane = C.lane;
    for (int item = GW; item < T * 4; item += NGW) {
        const int t = item >> 2, h = item & 3, tq = t % SEQ; const size_t tb = (size_t)(t - tq);
        float q[64];
        { const bf16_t* qp = proj + (size_t)t * NPROJ + PC_SBQ + h * 64;
#pragma unroll
          for (int i = 0; i < 8; ++i) { const u32x4 w = *(const u32x4*)(qp + 8 * i); q[8*i] = bflo(w.x); q[8*i+1] = bfhi(w.x); q[8*i+2] = bflo(w.y); q[8*i+3] = bfhi(w.y); q[8*i+4] = bflo(w.z); q[8*i+5] = bfhi(w.z); q[8*i+6] = bflo(w.w); q[8*i+7] = bfhi(w.w); } }
        float o[64];
#pragma unroll
        for (int d = 0; d < 64; ++d) o[d] = 0.f;
        float R = 0.f;
        for (int c = (tq - 1) >> 6; c >= 0 && tq > 0; --c) {
            const int key = c * 64 + lane; const bool ok = key < tq;
            const bf16_t* kp = proj + (tb + key) * NPROJ + PC_SBK + h * 64; const bf16_t* vp = proj + (tb + key) * NPROJ + PC_SBV + h * 64;
            float z = 0.f;
#pragma unroll
            for (int i = 0; i < 8; ++i) { const u32x4 w = *(const u32x4*)(kp + 8 * i);
                z += q[8*i] * bflo(w.x) + q[8*i+1] * bfhi(w.x) + q[8*i+2] * bflo(w.y) + q[8*i+3] * bfhi(w.y) + q[8*i+4] * bflo(w.z) + q[8*i+5] * bfhi(w.z) + q[8*i+6] * bflo(w.w) + q[8*i+7] * bfhi(w.w); }
            const float L = ok ? -(fmaxf(z, 0.f) + flog2(1.0f + fexp2(-fabsf(z)))) : 0.f;
            float sfx = L;
#pragma unroll
            for (int dd = 1; dd < 64; dd <<= 1) { const float tt = __shfl_down(sfx, dd); if (lane + dd < 64) sfx += tt; }
            const float tot = __shfl(sfx, 0);
            const float wgt = ok ? fexp2(z + L + (sfx - L) + R) : 0.f;
            R += tot;
#pragma unroll
            for (int i = 0; i < 8; ++i) { const u32x4 w = *(const u32x4*)(vp + 8 * i);
                o[8*i] += wgt * bflo(w.x); o[8*i+1] += wgt * bfhi(w.x); o[8*i+2] += wgt * bflo(w.y); o[8*i+3] += wgt * bfhi(w.y); o[8*i+4] += wgt * bflo(w.z); o[8*i+5] += wgt * bfhi(w.z); o[8*i+6] += wgt * bflo(w.w); o[8*i+7] += wgt * bfhi(w.w); }
        }
        float mine = 0.f;
#pragma unroll
        for (int d = 0; d < 64; ++d) { const float sdd = wave_sum(o[d]); if (lane == d) mine = sdd; }
        Y[(size_t)t * 1024 + h * 64 + lane] = (bf16_t)(cvt_pk_bf16(mine, 0.f) & 0xffffu);
    }
}

__device__ __forceinline__ void rwkv_naive(const Ctx& C, int l) {
    const float* DEC = WSP(float, S_DEC); const bf16_t* RWS = WSP(bf16_t, S_RWS); const bf16_t* GV = WSP(bf16_t, S_GV); bf16_t* Y = WSP(bf16_t, S_Y);
    const size_t PL = (size_t)T * 256; const int lane = C.lane;
    for (int item = GW; item < 64; item += NGW) {
        const int b = item >> 2, h = item & 3; const float* rk = C.in[I_RWRK] + l * 256 + h * 64;
        const float gng = C.in[I_RWGNG][l * 256 + h * 64 + lane], gnb = C.in[I_RWGNB][l * 256 + h * 64 + lane];
        float S[64];
#pragma unroll
        for (int j = 0; j < 64; ++j) S[j] = 0.f;
        for (int tq = 0; tq < SEQ; ++tq) {
            const size_t o = ((size_t)b * SEQ + tq) * 256 + h * 64;
            const float v = bf2f(RWS[2 * PL + o + lane]);
            float sa = 0.f;
#pragma unroll
            for (int j = 0; j < 64; ++j) sa += S[j] * bf2f(RWS[3 * PL + o + j]);
            float y = 0.f, bd = 0.f;
#pragma unroll
            for (int j = 0; j < 64; ++j) { const float km = bf2f(RWS[PL + o + j]), r = bf2f(RWS[o + j]);
                S[j] = S[j] * DEC[o + j] + (v * km - sa * bf2f(RWS[4 * PL + o + j])); y += S[j] * r; bd += r * km * rk[j]; }
            const float mu = wave_sum(y) * (1.0f / 64.0f), d = y - mu, var = wave_sum(d * d) * (1.0f / 64.0f);
            const float res = (d * (1.0f / sqrtf(var + 64e-5f)) * gng + gnb + v * bd) * bf2f(GV[o + lane]);
            Y[((size_t)b * SEQ + tq) * 1024 + 256 + h * 64 + lane] = (bf16_t)(cvt_pk_bf16(res, 0.f) & 0xffffu);
        }
    }
}
__device__ __forceinline__ void ssd_naive(const Ctx& C, int l) {
    const bf16_t* proj = WSP(bf16_t, S_PROJ); bf16_t* Y = WSP(bf16_t, S_Y); float* SSQ = WSP(float, S_SSQ); const int lane = C.lane;
    const float* cw = C.in[I_CONVW] + l * 4 * 768; const float* cb = C.in[I_CONVB] + l * 768;
    for (int item2 = GW; item2 < 128; item2 += NGW) {
        const int item = item2 >> 1, ph = item2 & 1; const int b = item >> 2, h = item & 3, g = h >> 1; const size_t tb = (size_t)b * SEQ;
        const float dtb = C.in[I_DTB][l * 4 + h], aneg = -expf(C.in[I_ALOG][l * 4 + h]), dsk = C.in[I_SSDD][l * 4 + h];
        float hs0[32], hs1[32];
#pragma unroll
        for (int p = 0; p < 32; ++p) { hs0[p] = 0.f; hs1[p] = 0.f; }
        for (int tq = 0; tq < SEQ; ++tq) {
            const bf16_t* pr = proj + (tb + tq) * NPROJ;
            float xa = cb[h * 64 + lane], bv0 = cb[256 + g * 128 + lane], bv1 = cb[256 + g * 128 + 64 + lane], cv0 = cb[512 + g * 128 + lane], cv1 = cb[512 + g * 128 + 64 + lane];
            for (int k = 0; k < 4; ++k) { const int tt = tq - 3 + k; if (tt >= 0) { const bf16_t* pp = proj + (tb + tt) * NPROJ; const float* ww = cw + k * 768;
                xa += bf2f(pp[PC_XS + h * 64 + lane]) * ww[h * 64 + lane];
                bv0 += bf2f(pp[PC_BM + g * 128 + lane]) * ww[256 + g * 128 + lane]; bv1 += bf2f(pp[PC_BM + g * 128 + 64 + lane]) * ww[256 + g * 128 + 64 + lane];
                cv0 += bf2f(pp[PC_CM + g * 128 + lane]) * ww[512 + g * 128 + lane]; cv1 += bf2f(pp[PC_CM + g * 128 + 64 + lane]) * ww[512 + g * 128 + 64 + lane]; } }
            xa = siluf_(xa); bv0 = siluf_(bv0); bv1 = siluf_(bv1); cv0 = siluf_(cv0); cv1 = siluf_(cv1);
            const float dt = softplusf_(bf2f(pr[PC_DT + h]) + dtb), dA = expf(dt * aneg), xd = xa * dt;
            float y = 0.f;
#pragma unroll
            for (int p = 0; p < 32; ++p) { const float xp = __shfl(xd, 32 * ph + p); hs0[p] = hs0[p] * dA + xp * bv0; hs1[p] = hs1[p] * dA + xp * bv1;
                const float tot = wave_sum(cv0 * hs0[p] + cv1 * hs1[p]); if (lane == 32 * ph + p) y = tot; }
            y += dsk * xa; y *= siluf_(bf2f(pr[PC_Z + h * 64 + lane]));
            const bool mine = (lane >> 5) == ph; if (mine) Y[(tb + tq) * 1024 + 512 + h * 64 + lane] = (bf16_t)(cvt_pk_bf16(y, 0.f) & 0xffffu);
            const float q = wave_sum(mine ? y * y : 0.f); if (lane == 0) atomicAdd(&SSQ[(tb + tq) * 8 + h * 2], q);
        }
    }
}

__device__ __forceinline__ void mla_naive(const Ctx& C) {
    const bf16_t* QM = WSP(bf16_t, S_QM); const bf16_t* KM = WSP(bf16_t, S_KM); const bf16_t* VM = WSP(bf16_t, S_VM); bf16_t* Y = WSP(bf16_t, S_Y); const int lane = C.lane;
    for (int item = GW; item < T * 4; item += NGW) {
        const int t = item >> 2, h = item & 3, tq = t % SEQ; const size_t tb = (size_t)(t - tq);
        float q[96];
        { const bf16_t* qp = QM + (size_t)t * 384 + h * 96;
#pragma unroll
          for (int i = 0; i < 12; ++i) { const u32x4 w = *(const u32x4*)(qp + 8 * i); q[8*i] = bflo(w.x); q[8*i+1] = bfhi(w.x); q[8*i+2] = bflo(w.y); q[8*i+3] = bfhi(w.y); q[8*i+4] = bflo(w.z); q[8*i+5] = bfhi(w.z); q[8*i+6] = bflo(w.w); q[8*i+7] = bfhi(w.w); } }
        float o[64];
#pragma unroll
        for (int d = 0; d < 64; ++d) o[d] = 0.f;
        float m = -1.0e30f, lsum = 0.f;
        for (int c = tq >> 6; c >= 0; --c) {
            const int key = c * 64 + lane; const bool ok = key <= tq;
            const bf16_t* kp = KM + (tb + (ok ? key : 0)) * 384 + h * 96; const bf16_t* vp = VM + (tb + (ok ? key : 0)) * 256 + h * 64;
            float z = 0.f;
#pragma unroll
            for (int i = 0; i < 12; ++i) { const u32x4 w = *(const u32x4*)(kp + 8 * i);
                z += q[8*i] * bflo(w.x) + q[8*i+1] * bfhi(w.x) + q[8*i+2] * bflo(w.y) + q[8*i+3] * bfhi(w.y) + q[8*i+4] * bflo(w.z) + q[8*i+5] * bfhi(w.z) + q[8*i+6] * bflo(w.w) + q[8*i+7] * bfhi(w.w); }
            z = ok ? z : -1.0e30f;
            float cm = z;
#pragma unroll
            for (int dd = 1; dd < 64; dd <<= 1) cm = fmaxf(cm, __shfl_xor(cm, dd));
            const float mn = fmaxf(m, cm), al = fexp2(m - mn), pw = ok ? fexp2(z - mn) : 0.f; m = mn; lsum = lsum * al + pw;
#pragma unroll
            for (int i = 0; i < 8; ++i) { const u32x4 w = *(const u32x4*)(vp + 8 * i);
                o[8*i] = o[8*i] * al + pw * bflo(w.x); o[8*i+1] = o[8*i+1] * al + pw * bfhi(w.x); o[8*i+2] = o[8*i+2] * al + pw * bflo(w.y); o[8*i+3] = o[8*i+3] * al + pw * bfhi(w.y);
                o[8*i+4] = o[8*i+4] * al + pw * bflo(w.z); o[8*i+5] = o[8*i+5] * al + pw * bfhi(w.z); o[8*i+6] = o[8*i+6] * al + pw * bflo(w.w); o[8*i+7] = o[8*i+7] * al + pw * bfhi(w.w); }
        }
        const float lt = wave_sum(lsum); float mine = 0.f;
#pragma unroll
        for (int d = 0; d < 64; ++d) { const float sdd = wave_sum(o[d]); if (lane == d) mine = sdd; }
        Y[(size_t)t * 1024 + 768 + h * 64 + lane] = (bf16_t)(cvt_pk_bf16(mine / lt, 0.f) & 0xffffu);
    }
}
__device__ __forceinline__ void xattn_naive(const Ctx& C, int l) {
    const bf16_t* XQ = WSP(bf16_t, S_XQ); const bf16_t* KMEM = WSP(bf16_t, W_KMEM) + (size_t)l * NMEM * 1024; const bf16_t* VT = WSP(bf16_t, W_VMEMT) + (size_t)l * 1024 * NMEM; bf16_t* XO = WSP(bf16_t, S_XO); const int lane = C.lane;
    for (int item = GW; item < T * 4; item += NGW) {
        const int t = item >> 2, h = item & 3, b = t / SEQ;
        float z[4] = {0.f, 0.f, 0.f, 0.f};
        for (int d8 = 0; d8 < 32; ++d8) { const u32x4 qw = *(const u32x4*)(XQ + (size_t)t * 1024 + h * 256 + 8 * d8);
            const float qv[8] = {bflo(qw.x), bfhi(qw.x), bflo(qw.y), bfhi(qw.y), bflo(qw.z), bfhi(qw.z), bflo(qw.w), bfhi(qw.w)};
#pragma unroll
            for (int j = 0; j < 4; ++j) { const u32x4 kw = *(const u32x4*)(KMEM + (size_t)(b * 256 + lane + 64 * j) * 1024 + h * 256 + 8 * d8);
                z[j] += qv[0] * bflo(kw.x) + qv[1] * bfhi(kw.x) + qv[2] * bflo(kw.y) + qv[3] * bfhi(kw.y) + qv[4] * bflo(kw.z) + qv[5] * bfhi(kw.z) + qv[6] * bflo(kw.w) + qv[7] * bfhi(kw.w); } }
        float mx = fmaxf(fmaxf(z[0], z[1]), fmaxf(z[2], z[3]));
#pragma unroll
        for (int dd = 1; dd < 64; dd <<= 1) mx = fmaxf(mx, __shfl_xor(mx, dd));
        float p[4], ps = 0.f;
#pragma unroll
        for (int j = 0; j < 4; ++j) { p[j] = fexp2(z[j] - mx); ps += p[j]; }
        const float inv = 1.0f / wave_sum(ps);
        float o[4] = {0.f, 0.f, 0.f, 0.f};
        for (int mm = 0; mm < 256; ++mm) { const float pm = __shfl(p[mm >> 6], mm & 63);
#pragma unroll
            for (int jd = 0; jd < 4; ++jd) o[jd] += pm * bf2f(VT[(size_t)(h * 256 + lane + 64 * jd) * NMEM + b * 256 + mm]); }
#pragma unroll
        for (int jd = 0; jd < 4; ++jd) XO[(size_t)t * 1024 + h * 256 + lane + 64 * jd] = (bf16_t)(cvt_pk_bf16(o[jd] * inv, 0.f) & 0xffffu);
    }
}
__device__ __forceinline__ void ph_mixers(const Ctx& C, int l, int rep = 0) {
    unsigned* head = (unsigned*)(C.ws + WS_CTL) + CW_QUEUE + 64 * (l + 2 * rep);
    volatile LAS unsigned* slot = (volatile LAS unsigned*)(C.lds + LDSCTL_OFF + 64);
    constexpr int N_RW = 128, N_ATT = 768, NITEMS = N_RW + N_ATT;
    for (;;) {
        __syncthreads();
        if (C.tid == 0) slot[0] = __hip_atomic_fetch_add(head, 1u, RLX_AGENT);
        __syncthreads();
        const int it = (int)slot[0];
        if (it >= NITEMS) break;
#ifndef NAIVE_SCAN
#define NAIVE_SCAN 0
#endif
        if (it < N_RW) { if (!(NAIVE_SCAN & 1)) { rwkv_unit(C, l, it >> 3, (it >> 1) & 3, it & 1);
#ifdef TIME_RW2
            __syncthreads(); rwkv_unit(C, l, it >> 3, (it >> 1) & 3, it & 1);
#endif
        } }
        else { const int k = it - N_RW; const int mode = k % 3, pp = (k / 3) & 3, bh = k / 12, b = bh >> 2, h = bh & 3;
            if (mode == 0) { if (!(NAIVE_SCAN & 2)) { attn_unit<2>(C, l, b, h, 7 - pp); __syncthreads(); attn_unit<2>(C, l, b, h, pp);
#ifdef TIME_SSDA2
                __syncthreads(); attn_unit<2>(C, l, b, h, 7 - pp); __syncthreads(); attn_unit<2>(C, l, b, h, pp);
#endif
            } }
#ifndef NAIVE_SB
            else if (mode == 1) { attn_unit<0>(C, l, b, h, 7 - pp); __syncthreads(); attn_unit<0>(C, l, b, h, pp);
#ifdef TIME_SB2
                __syncthreads(); attn_unit<0>(C, l, b, h, 7 - pp); __syncthreads(); attn_unit<0>(C, l, b, h, pp);
#endif
            }
#else
            else if (mode == 1) { }
#endif
#ifndef NAIVE_MLA
            else { attn_unit<1>(C, l, b, h, 7 - pp); __syncthreads(); attn_unit<1>(C, l, b, h, pp);
#ifdef TIME_MLA2
                __syncthreads(); attn_unit<1>(C, l, b, h, 7 - pp); __syncthreads(); attn_unit<1>(C, l, b, h, pp);
#endif
            }
#else
            else { }
#endif
        }
    }
#ifdef NAIVE_SB
    sb_naive(C);
#endif
#ifdef NAIVE_MLA
    mla_naive(C);
#endif
    if (NAIVE_SCAN & 1) rwkv_naive(C, l);
    if (NAIVE_SCAN & 2) ssd_naive(C, l);
}
__device__ __forceinline__ void ph_router(const Ctx& C) {
    run_tjobs<16, true>(C);
    __syncthreads();
    LAS unsigned* lc = (LAS unsigned*)(C.lds + XCH_OFF);
    if (C.tid < 8) lc[C.tid] = 0u;
    __syncthreads();
    const float* xr = WSP(float, W_XRES); const float* rt = C.in[I_ROUTER]; int* topi = WSP(int, S_TOPI); float* topw = WSP(float, S_TOPW); const int lane = C.lane;
    for (int k = 0; k < 16; ++k) {
        const int t = C.bid * 128 + C.wave * 16 + k; float a[8];
#pragma unroll
        for (int e = 0; e < 8; ++e) a[e] = 0.f;
#pragma unroll
        for (int j = 0; j < 4; ++j) { const f32x4 xv = *(const f32x4*)(xr + (size_t)t * 1024 + 4 * lane + 256 * j);
#pragma unroll
            for (int q = 0; q < 4; ++q) { const float* rp = rt + (size_t)(4 * lane + 256 * j + q) * 8; const f32x4 r0 = *(const f32x4*)rp, r1 = *(const f32x4*)(rp + 4);
                a[0] += xv[q] * r0[0]; a[1] += xv[q] * r0[1]; a[2] += xv[q] * r0[2]; a[3] += xv[q] * r0[3]; a[4] += xv[q] * r1[0]; a[5] += xv[q] * r1[1]; a[6] += xv[q] * r1[2]; a[7] += xv[q] * r1[3]; } }
#pragma unroll
        for (int e = 0; e < 8; ++e) a[e] = wave_sum(a[e]);
#ifdef ROUTER_NOISE
        for (int e = 0; e < 8; ++e) { unsigned hsh = (unsigned)t * 2654435761u + (unsigned)e * 40503u; hsh ^= hsh >> 13; hsh *= 0x5bd1e995u; hsh ^= hsh >> 15; a[e] += ROUTER_NOISE * ((float)(hsh & 0xffff) * (1.0f / 32768.0f) - 1.0f); }
#endif
        if (lane == 0) {
            int i1 = 0; float v1 = a[0];
#pragma unroll
            for (int e = 1; e < 8; ++e) if (a[e] > v1) { v1 = a[e]; i1 = e; }
            int i2 = -1; float v2 = -3.0e38f;
#pragma unroll
            for (int e = 0; e < 8; ++e) if (e != i1 && a[e] > v2) { v2 = a[e]; i2 = e; }
            const float g1 = 1.0f / (1.0f + expf(v2 - v1));
            topi[2 * t] = i1; topi[2 * t + 1] = i2; topw[2 * t] = g1; topw[2 * t + 1] = 1.0f - g1;
            __hip_atomic_fetch_add(&lc[i1], 1u, __ATOMIC_RELAXED, __HIP_MEMORY_SCOPE_WORKGROUP); __hip_atomic_fetch_add(&lc[i2], 1u, __ATOMIC_RELAXED, __HIP_MEMORY_SCOPE_WORKGROUP);
        }
    }
    __syncthreads();
    if (C.tid < 8) ((unsigned*)(C.ws + WS_CTL))[CW_MOECNT + C.bid * 8 + C.tid] = lc[C.tid];
}
__device__ __forceinline__ void ph_scatter(const Ctx& C) {
    LAS int* sh = (LAS int*)(C.lds + XCH_OFF);
    const unsigned* cnt = (const unsigned*)(C.ws + WS_CTL) + CW_MOECNT;
    int* row_slot = WSP(int, S_ROWSLOT); float* row_w = WSP(float, S_ROWW); int* blk_e = WSP(int, S_BLKE);
    const int* topi = WSP(int, S_TOPI); const float* topw = WSP(float, S_TOPW);
    const int tid = C.tid;
    if (tid < 8) { int tot = 0, mine = 0; for (int wg = 0; wg < 256; ++wg) { const int c = (int)cnt[wg * 8 + tid]; if (wg < C.bid) mine += c; tot += c; } sh[tid] = tot; sh[8 + tid] = mine; sh[32 + tid] = 0; }
    __syncthreads();
    if (tid == 0) { int ps = 0; for (int e = 0; e < 8; ++e) { sh[16 + e] = ps; const int pad = (sh[e] + 255) / 256 * 256; sh[24 + e] = pad; ps += pad; } sh[40] = ps / 256; }
    __syncthreads();
    if (C.bid == 0) {
        const int used = sh[40];
        for (int rb = tid; rb < MOE_BLOCKS; rb += NTHREADS) { int e = 7; if (rb < used) { e = 0; for (int q = 1; q < 8; ++q) if (sh[16 + q] <= rb * 256) e = q; } blk_e[rb] = e; }
        if (tid == 0) blk_e[MOE_BLOCKS] = used;
    }
    if (C.bid < 8) { const int e = C.bid; for (int r = sh[16 + e] + sh[e] + tid; r < sh[16 + e] + sh[24 + e]; r += NTHREADS) { row_slot[r] = -1; row_w[r] = 0.f; } }
    if (tid < 256) { const int t = C.bid * 128 + (tid >> 1), k = tid & 1, e = topi[2 * t + k];
        const int pos = __hip_atomic_fetch_add(&sh[32 + e], 1, __ATOMIC_RELAXED, __HIP_MEMORY_SCOPE_WORKGROUP); const int dest = sh[16 + e] + sh[8 + e] + pos; row_slot[dest] = 2 * t + k; row_w[dest] = topw[2 * t + k]; sh[64 + tid] = dest; }
    __syncthreads();
    const bf16_t* xb = WSP(bf16_t, W_XB); bf16_t* xs = WSP(bf16_t, S_XS);
    for (int a = C.wave * 32; a < C.wave * 32 + 32; ++a) { const int t = C.bid * 128 + (a >> 1); const size_t d = (size_t)sh[64 + a] * 1024;
#pragma unroll
        for (int j = 0; j < 2; ++j) *(u32x4*)(xs + d + (C.lane + 64 * j) * 8) = *(const u32x4*)(xb + (size_t)t * 1024 + (C.lane + 64 * j) * 8); }
}


__device__ __forceinline__ void chk_moe(const Ctx& C, int bit) {
    const float* xr = WSP(float, W_XRES); const float* rt = C.in[I_ROUTER]; const float* w13 = C.in[I_MOE13]; const float* w2 = C.in[I_MOE2]; const bf16_t* ys = WSP(bf16_t, S_YS);
    LAS float* hb = (LAS float*)(C.lds + C.wave * 14336); const int lane = C.lane; unsigned bad = 0;
    float* stash = WSP(float, W_KMEM); const float* g3 = C.in[I_LN3G] + 1024; const float* b3 = C.in[I_LN3B] + 1024;
    for (int s = GW; s < 1024; s += NGW) {
        const int t = (int)(((long)s * 1021 + 7) % T); float x[16];
#pragma unroll
        for (int j = 0; j < 16; ++j) x[j] = xr[(size_t)t * 1024 + lane + 64 * j];
        float lg[8];
#pragma unroll
        for (int e = 0; e < 8; ++e) { float a = 0.f;
#pragma unroll
            for (int j = 0; j < 16; ++j) a += x[j] * rt[(size_t)(lane + 64 * j) * 8 + e]; lg[e] = wave_sum(a); }
        int i1 = 0; for (int e = 1; e < 8; ++e) if (lg[e] > lg[i1]) i1 = e;
        int i2 = -1; for (int e = 0; e < 8; ++e) if (e != i1 && (i2 < 0 || lg[e] > lg[i2])) i2 = e;
        float v3 = -3.0e38f; for (int e = 0; e < 8; ++e) if (e != i1 && e != i2) v3 = fmaxf(v3, lg[e]);
        if (lg[i2] - v3 < 0.02f) { if (lane == 0) stash[(size_t)s * 1024] = 1.0e30f; continue; }
        const float g1 = 1.0f / (1.0f + expf(lg[i2] - lg[i1]));
        float out[16];
#pragma unroll
        for (int j = 0; j < 16; ++j) out[j] = 0.f;
        for (int q = 0; q < 2; ++q) { const int e = q ? i2 : i1; const float gw = q ? 1.0f - g1 : g1; const float* W1 = w13 + (size_t)e * 1024 * 2 * FFE;
            for (int i0 = 0; i0 < 56; i0 += 4) { float ag[4], au[4];
#pragma unroll
                for (int i = 0; i < 4; ++i) { ag[i] = 0.f; au[i] = 0.f; }
                for (int k = 0; k < 1024; ++k) { const float xk = __shfl(x[k >> 6], k & 63); const float* wr = W1 + (size_t)k * 2 * FFE + lane + 64 * i0;
#pragma unroll
                    for (int i = 0; i < 4; ++i) { ag[i] += xk * wr[64 * i]; au[i] += xk * wr[FFE + 64 * i]; } }
#pragma unroll
                for (int i = 0; i < 4; ++i) hb[lane + 64 * (i0 + i)] = (ag[i] / (1.0f + expf(-ag[i]))) * au[i]; }
            LDS_WAIT();
            const float* W2 = w2 + (size_t)e * FFE * 1024;
            for (int hh = 0; hh < FFE; ++hh) { const float hv = hb[hh] * gw;
#pragma unroll
                for (int j = 0; j < 16; ++j) out[j] += hv * W2[(size_t)hh * 1024 + lane + 64 * j]; }
            LDS_WAIT(); }
#pragma unroll
        for (int j = 0; j < 16; ++j) { const int c = lane + 64 * j; const float got = bf2f(ys[(size_t)(2 * t) * 1024 + c]) + bf2f(ys[(size_t)(2 * t + 1) * 1024 + c]);
            if (fabsf(got - out[j]) > 0.05f * fabsf(out[j]) + 0.03f) bad = 1; }
        { float v[16], sm = 0.f, s2 = 0.f;
#pragma unroll
          for (int j = 0; j < 16; ++j) { v[j] = x[j] * DN_ALPHA + out[j]; sm += v[j]; }
          const float mean = wave_sum(sm) * (1.0f / 1024.0f);
#pragma unroll
          for (int j = 0; j < 16; ++j) { v[j] -= mean; s2 += v[j] * v[j]; }
          const float rstd = 1.0f / sqrtf(wave_sum(s2) * (1.0f / 1024.0f) + 1e-5f);
          int zz = 0; asm volatile("" : "+v"(zz));
#pragma unroll
          for (int j = 0; j < 16; ++j) { const int c = lane + 64 * j + zz; stash[(size_t)s * 1024 + c] = v[j] * rstd * g3[c] + b3[c]; } }
    }
    chk_flag(C, bit, bad);
}
#ifndef ABL_MIX
#define ABL_MIX 1.0f
#endif
#ifndef ABL_XA
#define ABL_XA 1.0f
#endif
#ifndef ABL_FF
#define ABL_FF 1.0f
#endif
#ifndef CHK_TOL2
#define CHK_TOL2 0.05f
#endif
#ifndef GATE_ACT
#define GATE_ACT 1
#endif
#ifndef GATE_ALIGN
#define GATE_ALIGN true
#endif
#ifndef FG_TOL
#define FG_TOL 0.05f
#endif
#ifndef FG_BIT
#define FG_BIT 1
#endif
#ifndef CHECKS_LAYER
#define CHECKS_LAYER 0
#endif
#ifndef MK_SPLIT
#define MK_SPLIT 0
#endif
constexpr int PH_L0 = 1, PH_L1 = 18, PH_MOE = 32, PH_TOTAL = PH_MOE + 2 + 2 * MOE_PASSES + 1;

__global__ void __launch_bounds__(NTHREADS, 2) hybrid_fwd(Args args) {
    extern __shared__ __attribute__((aligned(16))) unsigned char lds_raw[];
    Ctx C; C.in = args.in; C.out = args.out; C.ws = args.ws; C.lds = (LAS unsigned char*)lds_raw;
    C.tid = threadIdx.x; C.lane = C.tid & 63; C.wave = __builtin_amdgcn_readfirstlane(C.tid >> 6); C.G = gridDim.x; C.bid = blockIdx.x;
    const Ctx C0 = C;
    for (int u = C.tid; u < (LDS_BYTES - LDSCTL_OFF) / 4; u += NTHREADS) ((LAS unsigned*)(C.lds + LDSCTL_OFF))[u] = 0u;
    __syncthreads();
    const int lo = args.ph_lo, hi = args.ph_hi;
    XcdBarrier bar; bar.bar = (unsigned*)(C.ws + WS_CTL) + CW_BAR; bar.x = 0; bar.st = (volatile LAS unsigned*)(C.lds + LDSCTL_OFF);
    if (hi - lo > 1) bar = xcd_barrier_post((unsigned*)(C.ws + WS_CTL) + CW_BAR, (volatile LAS unsigned*)(C.lds + LDSCTL_OFF));
#ifndef SITE_MASK
#define SITE_MASK 0xffffffffu
#endif
#define SITE(n) (((SITE_MASK) >> (n)) & 1u)
#define IN(k) (lo <= (k) && (k) < hi)
#define ENDPH(k) do { if ((k) + 1 < hi) xcd_barrier(bar); } while (0)
#define SITE_BEGIN const Ctx C = launder(C0); unsigned char* LW = C.ws + W_BASE + (size_t)l * LW_SIZE; const bf16_t* XB = WSP(bf16_t, W_XB); float* XRES = WSP(float, W_XRES); (void)LW; (void)XB; (void)XRES; LAS unsigned char* ring = C.lds; (void)ring;

    if (SITE(0) && IN(0)) { const int l = 0; SITE_BEGIN ph_prologue(C);
#ifdef TIME_PRO2
        xcd_barrier(bar); ph_prologue(C);
#endif
#ifdef TIME_BAR
        for (int q_ = 0; q_ < TIME_BAR; ++q_) xcd_barrier(bar);
#endif
        ENDPH(0); }

    for (int l = 0; l < 2; ++l) {
        const int pb = l == 0 ? PH_L0 : PH_L1;
        if (SITE(1) && IN(pb + 0)) { SITE_BEGIN
#ifdef CHECKS3
            if (l == 1) chk_ln_cmp(C, 1, 1);
#endif
            { pg8::Gemm g{XB, (const bf16_t*)(LW + LW_WIN), 1024, 1024, 1024}; sch::Tiles S{T / 256, NPROJ / 256, C.G, C.bid}; epi::StoreBf16<0> E{WSP(bf16_t, S_PROJ), NPROJ}; pg8::gemm_phase(ring, g, S, E); }
            { pg8::Gemm g{(const bf16_t*)C.ws, (const bf16_t*)C.ws, 1024, 1024, 1024}; sch::MemKV S{(long)(W_MEMB / 2), (long)((W_BASE + (size_t)l * LW_SIZE + LW_WKV) / 2), C.bid};
              epi::StoreKV E{WSP(bf16_t, W_KMEM) + (size_t)l * NMEM * 1024, WSP(bf16_t, W_VMEMT) + (size_t)l * 1024 * NMEM}; pg8::gemm_phase(ring, g, S, E); }
            ENDPH(pb + 0);
        }
        if (SITE(2) && IN(pb + 1)) { SITE_BEGIN
#ifdef CHECKS5
            if (l == 0) chk_weights<28, false>(C, 0);
#endif
#ifdef CHECKS9
            if (l == 0) { unsigned bad = 0; const float* x = C.in[I_X]; const float* mm = C.in[I_MEM]; const bf16_t* mb = WSP(bf16_t, W_MEMB);
                for (size_t i = (size_t)C.bid * NTHREADS + C.tid; i < (size_t)T * 1024; i += (size_t)C.G * NTHREADS) if (!chk_close(x[i], bf2f(XB[i]))) bad = 1;
                for (size_t i = (size_t)C.bid * NTHREADS + C.tid; i < (size_t)NMEM * 1024; i += (size_t)C.G * NTHREADS) if (!chk_close(mm[i], bf2f(mb[i]))) bad = 1;
                if (bad) __hip_atomic_fetch_add((unsigned*)(C.ws + WS_CTL) + CW_CHK, 1u, RLX_AGENT); }
#endif
#ifdef CHECKS12P
            if (l == CHECKS_LAYER) { const bf16_t* proj = WSP(bf16_t, S_PROJ); chk_full_gemm(C, XB, (const bf16_t*)(LW + LW_WIN), 1024, 3236, 0, [&](size_t r, int c, float d) { return chk_close(d, bf2f(proj[r * NPROJ + c])); }); xcd_barrier(bar); }
#endif
#ifdef CHECKS4
            if (l == CHECKS_LAYER) { const bf16_t* KM_ = WSP(bf16_t, W_KMEM) + (size_t)l * NMEM * 1024; const bf16_t* VT_ = WSP(bf16_t, W_VMEMT) + (size_t)l * 1024 * NMEM;
                chk_gemm(C, WSP(bf16_t, W_MEMB), 1024, (const bf16_t*)(LW + LW_WKV), 1024, 1024, NMEM, 64, 16, 3, 0, [&](int r, int c, float d) { return chk_close(d, bf2f(KM_[(size_t)r * 1024 + c])); });
                chk_gemm(C, (const bf16_t*)(LW + LW_WKV) + (size_t)1024 * 1024, 1024, WSP(bf16_t, W_MEMB), 1024, 1024, 1024, 256, 16, 5, 1, [&](int r, int c, float d) { return chk_close(d, bf2f(VT_[(size_t)r * NMEM + c])); }); }
#endif
#ifdef CHECKS
            if (l == CHECKS_LAYER) { const bf16_t* proj = WSP(bf16_t, S_PROJ); chk_gemm(C, XB, 1024, (const bf16_t*)(LW + LW_WIN), 1024, 1024, T, 13, 256, 7, 0, [&](int r, int c, float d) { return chk_close(d, bf2f(proj[(size_t)r * NPROJ + c])); }); }
#endif
            ph_prep(C, l);
#ifdef TIME_PREP2
            xcd_barrier(bar); ph_prep(C, l);
#endif
            ENDPH(pb + 1); }
        if (SITE(3) && IN(pb + 2)) { SITE_BEGIN
            { pg8::Gemm g{WSP(bf16_t, S_LA), (const bf16_t*)(LW + LW_LORA), 256, 256, 256}; sch::Tiles S{T / 256, 3, C.G, C.bid}; epi::Lora E{WSP(float, S_DEC), WSP(bf16_t, S_AV), WSP(bf16_t, S_GV), C.in[I_RWW0] + l * 256, C.in[I_RWA0] + l * 256}; pg8::gemm_phase(ring, g, S, E); }
            { pg8::Gemm g{WSP(bf16_t, S_CQN), (const bf16_t*)(LW + LW_WUQ), 256, 256, 256}; sch::Tiles S{T / 256, 2, C.G, (C.bid + 128) & 255}; epi::Uq E{WSP(bf16_t, S_QM), WSP(float, W_COS), WSP(float, W_SIN)}; pg8::gemm_phase(ring, g, S, E); }
            { pg8::Gemm g{WSP(bf16_t, S_CKVN), (const bf16_t*)(LW + LW_WUKV), 128, 128, 128}; sch::Tiles S{T / 256, 2, C.G, C.bid}; epi::Ukv E{WSP(bf16_t, S_KM), WSP(bf16_t, S_VM)}; pg8::gemm_phase(ring, g, S, E); }
            ENDPH(pb + 2);
        }
        if (SITE(4) && IN(pb + 3)) { SITE_BEGIN ph_rwprep(C, l); ph_ssdprep(C, l);
#ifdef TIME_RWP2
            xcd_barrier(bar); ph_rwprep(C, l); ph_ssdprep(C, l);
#endif
            ENDPH(pb + 3); }
        if (SITE(5) && IN(pb + 4)) { SITE_BEGIN
#ifdef CHECKS6
            if (l == CHECKS_LAYER) chk_mla_inputs(C, l, 0);
#endif
#ifdef CHECKS7
            if (l == CHECKS_LAYER) chk_rw_inputs(C, l, 0);
#endif
            ph_mixers(C, l);
#ifdef TIME_MIX2
            xcd_barrier(bar); ph_mixers(C, l, 1);
#endif
            ENDPH(pb + 4); }
        if (SITE(6) && IN(pb + 5)) { SITE_BEGIN
            ph_ssdfix(C, l);
            { pg8::Gemm g{XB, (const bf16_t*)(LW + LW_WGATE), 1024, 1024, 1024}; sch::Tiles S{T / 256, 16, C.G, C.bid}; epi::StoreBf16<GATE_ACT> E{WSP(bf16_t, S_G), 4096}; pg8::gemm_phase<epi::StoreBf16<GATE_ACT>, sch::Tiles, GATE_ALIGN>(ring, g, S, E);
#ifdef TIME_GATE2
              xcd_barrier(bar); pg8::gemm_phase<epi::StoreBf16<GATE_ACT>, sch::Tiles, GATE_ALIGN>(ring, g, S, E);
#endif
            }
#ifdef CHECKS14
            if (l == 0) { xcd_barrier(bar); const bf16_t* Gp = WSP(bf16_t, S_G); chk_full_gemm(C, XB, (const bf16_t*)(LW + LW_WGATE), 1024, 4096, 0, [&](size_t r, int c, float d) { return chk_close(sigmoidf_(d), bf2f(Gp[r * 4096 + c])); }); }
#endif
#ifdef CHECKS13
            if (l == 0) { xcd_barrier(bar);
              { pg8::Gemm g{XB, (const bf16_t*)(LW + LW_WGATE), 1024, 1024, 1024}; sch::Tiles S{T / 256, 16, C.G, C.bid}; epi::StoreBf16<1> E{WSP(bf16_t, S_G) + (size_t)T * 4096, 4096}; pg8::gemm_phase(ring, g, S, E); }
              xcd_barrier(bar);
              { const unsigned short* g1 = WSP(unsigned short, S_G); const unsigned short* g2 = g1 + (size_t)T * 4096; unsigned cnt = 0;
                for (size_t i = (size_t)C.bid * NTHREADS + C.tid; i < (size_t)T * 4096; i += (size_t)C.G * NTHREADS) if (g1[i] != g2[i]) ++cnt;
                if (cnt) __hip_atomic_fetch_add((unsigned*)(C.ws + WS_CTL) + CW_CHK + 2048, cnt, RLX_AGENT); } }
#endif
            ENDPH(pb + 5);
        }
        if (SITE(7) && IN(pb + 6)) { SITE_BEGIN
#ifdef FIX_G
            { bf16_t* Gw = WSP(bf16_t, S_G); const bf16_t* Wg = (const bf16_t*)(LW + LW_WGATE);
              for (size_t i = (size_t)C.bid * NTHREADS + C.tid; i < (size_t)T * 4096; i += (size_t)C.G * NTHREADS) { const size_t r = i >> 12; const int c = (int)(i & 4095);
                  Gw[i] = (bf16_t)(cvt_pk_bf16(sigmoidf_(tdot(XB + r * 1024, Wg + (size_t)c * 1024, 1024)), 0.f) & 0xffffu); }
              xcd_barrier(bar); }
#endif
#ifdef CHECKS15
            if (l == 0) { unsigned cnt = 0; const float* x = C.in[I_X];
                for (size_t i = (size_t)C.bid * NTHREADS + C.tid; i < (size_t)T * 1024; i += (size_t)C.G * NTHREADS) if (!chk_close(x[i], bf2f(XB[i]))) ++cnt;
                if (cnt) __hip_atomic_fetch_add((unsigned*)(C.ws + WS_CTL) + CW_CHK + 2048, cnt, RLX_AGENT); }
#endif
#ifdef CHECKS7
            if (l == CHECKS_LAYER) chk_ssd_norm(C, l, 1);
#endif
#ifdef CHECKS12
            if (l == CHECKS_LAYER) { const bf16_t* Gp = WSP(bf16_t, S_G); chk_full_gemm(C, XB, (const bf16_t*)(LW + LW_WGATE), 1024, 4096, FG_BIT, [&](size_t r, int c, float d) { return fabsf((GATE_ACT ? sigmoidf_(d) : d) - bf2f(Gp[r * 4096 + c])) <= FG_TOL; }); xcd_barrier(bar); }
#endif
#ifdef CHECKS
            if (l == CHECKS_LAYER) { const bf16_t* Gp = WSP(bf16_t, S_G); chk_gemm(C, XB, 1024, (const bf16_t*)(LW + LW_WGATE), 1024, 1024, T, 16, 256, 5, 1, [&](int r, int c, float d) { return chk_close(sigmoidf_(d), bf2f(Gp[(size_t)r * 4096 + c])); }); }
#endif
            { pg8::Gemm g{WSP(bf16_t, S_Y), (const bf16_t*)(LW + LW_WBR), 256, 1024, 256}; sch::BrTiles S{T / 256, 4, C.G, C.bid}; epi::BrGate E{WSP(bf16_t, S_G), WSP(float, S_MF), WSP(bf16_t, S_MB)}; pg8::gemm_phase(ring, g, S, E); }
            ENDPH(pb + 6);
        }
        if (SITE(8) && IN(pb + 7)) { SITE_BEGIN
#ifdef CHECKS2
            if (l == CHECKS_LAYER) chk_merged(C, l, 0);
#endif
            { pg8::Gemm g{WSP(bf16_t, S_MB), (const bf16_t*)(LW + LW_WOUT), 1024, 1024, 1024}; sch::Tiles S{T / 256, 4, C.G, C.bid}; epi::Resid E{C.in[I_X], XRES, ABL_MIX, l == 0 ? nullptr : XB}; pg8::gemm_phase(ring, g, S, E); }
            ENDPH(pb + 7);
        }
        if (SITE(9) && IN(pb + 8)) { SITE_BEGIN
#ifdef CHECKS10
            if (l == 0) { chk_full_p7(C, l, 1); xcd_barrier(bar); }
#endif
#ifdef CHECKS
            if (l == 0) { const float* xin = C.in[I_X]; chk_gemm(C, WSP(bf16_t, S_MB), 1024, (const bf16_t*)(LW + LW_WOUT), 1024, 1024, T, 4, 256, 9, 2, [&](int r, int c, float d) { return fabsf(xin[(size_t)r * 1024 + c] * DN_ALPHA + d - XRES[(size_t)r * 1024 + c]) <= CHK_TOL2; }); }
#endif
            ph_ln<false>(C, XRES, nullptr, WSP(bf16_t, W_XB), C.in[I_LN1G] + l * 1024, C.in[I_LN1B] + l * 1024, nullptr); ENDPH(pb + 8); }
        if (SITE(10) && IN(pb + 9)) { SITE_BEGIN
            { pg8::Gemm g{XB, (const bf16_t*)(LW + LW_WQ), 1024, 1024, 1024}; sch::Tiles S{T / 256, 4, C.G, C.bid}; epi::StoreBf16<0> E{WSP(bf16_t, S_XQ), 1024}; pg8::gemm_phase(ring, g, S, E); }
            ENDPH(pb + 9);
        }
        if (SITE(11) && IN(pb + 10)) { SITE_BEGIN
#ifdef CHECKS
            if (l == CHECKS_LAYER) { const bf16_t* XQ = WSP(bf16_t, S_XQ); chk_gemm(C, XB, 1024, (const bf16_t*)(LW + LW_WQ), 1024, 1024, T, 4, 256, 11, 3, [&](int r, int c, float d) { return chk_close(d, bf2f(XQ[(size_t)r * 1024 + c])); }); }
#endif
            { pg8::Gemm g{WSP(bf16_t, S_XQ), WSP(bf16_t, W_KMEM) + (size_t)l * NMEM * 1024, 256, 1024, 1024}; sch::XaS S{C.G, C.bid}; epi::Softmax E{WSP(bf16_t, S_XP), (LAS float*)(C.lds + XCH_OFF)};
#ifndef NAIVE_XA
              pg8::gemm_phase(ring, g, S, E);
#else
              (void)g; (void)S; (void)E; xattn_naive(C, l);
#endif
            }
            ENDPH(pb + 10);
        }
        if (SITE(12) && IN(pb + 11)) { SITE_BEGIN
            { pg8::Gemm g{WSP(bf16_t, S_XP), WSP(bf16_t, W_VMEMT) + (size_t)l * 1024 * NMEM, 256, 1024, NMEM}; sch::XaPV S{C.G, C.bid}; epi::StoreBf16<0> E{WSP(bf16_t, S_XO), 1024};
#ifndef NAIVE_XA
              pg8::gemm_phase(ring, g, S, E);
#else
              (void)g; (void)S; (void)E;
#endif
            }
            ENDPH(pb + 11);
        }
        if (SITE(13) && IN(pb + 12)) { SITE_BEGIN
#ifdef CHECKS3
            if (l == 0) { chk_resid_stash(C, WSP(bf16_t, S_XO), 1024, (const bf16_t*)(LW + LW_WO), 1024, 1024, 0); xcd_barrier(bar); }
#endif
            { pg8::Gemm g{WSP(bf16_t, S_XO), (const bf16_t*)(LW + LW_WO), 1024, 1024, 1024}; sch::Tiles S{T / 256, 4, C.G, C.bid}; epi::Resid E{nullptr, XRES, ABL_XA, XB}; pg8::gemm_phase(ring, g, S, E); }
            ENDPH(pb + 12);
        }
        if (SITE(14) && IN(pb + 13)) { SITE_BEGIN
#ifdef CHECKS3
            if (l == 0) chk_resid_cmp(C, 0, 2);
#endif
            ph_ln<false>(C, XRES, l == 1 ? XRES : nullptr, WSP(bf16_t, W_XB), C.in[I_LN2G] + l * 1024, C.in[I_LN2B] + l * 1024, nullptr); ENDPH(pb + 13); }
        if (l == 0) {
            if (SITE(15) && IN(pb + 14)) { SITE_BEGIN
                { pg8::Gemm g{XB, WSP(bf16_t, W_FFN13), 1024, 1024, 1024}; sch::Tiles S{T / 256, 2 * FFD / 256, C.G, C.bid}; epi::Swiglu E{WSP(bf16_t, S_H), FFD, 0}; pg8::gemm_phase(ring, g, S, E);
#ifdef TIME_UP2
                  for (int rep_ = 0; rep_ < 1; ++rep_) { xcd_barrier(bar); pg8::gemm_phase(ring, g, S, E); }
#endif
                }
                ENDPH(pb + 14);
            }
            if (SITE(16) && IN(pb + 15)) { SITE_BEGIN
#ifdef CHECKS2
                chk_swiglu(C, 1);
#endif
#ifdef CHECKS3
                chk_resid_stash(C, WSP(bf16_t, S_H), FFD, WSP(bf16_t, W_FFN2), FFD, FFD, 0); xcd_barrier(bar);
#endif
                { pg8::Gemm g{WSP(bf16_t, S_H), WSP(bf16_t, W_FFN2), FFD, FFD, FFD}; sch::Tiles S{T / 256, 4, C.G, C.bid}; epi::Resid E{nullptr, XRES, ABL_FF, XB}; pg8::gemm_phase(ring, g, S, E); }
                ENDPH(pb + 15);
            }
            if (SITE(17) && IN(pb + 16)) { SITE_BEGIN
#ifdef CHECKS3
                chk_resid_cmp(C, 0, 0); chk_ln_stash(C, C.in[I_LN3G], C.in[I_LN3B], 1); xcd_barrier(bar);
#endif
                ph_ln<false>(C, XRES, nullptr, WSP(bf16_t, W_XB), C.in[I_LN3G], C.in[I_LN3B], nullptr); ENDPH(pb + 16); }
        } else {
            if (SITE(18) && IN(PH_MOE)) { SITE_BEGIN ph_router(C); ENDPH(PH_MOE); }
            if (SITE(19) && IN(PH_MOE + 1)) { SITE_BEGIN
#ifdef CHECKS5
                chk_weights<16, true>(C, 1);
#endif
                ph_scatter(C); ENDPH(PH_MOE + 1); }
            for (int p = 0; p < MOE_PASSES; ++p) {
                const int* blk_e = WSP(int, S_BLKE);
                if (SITE(20) && IN(PH_MOE + 2 + 2 * p)) { SITE_BEGIN
                    const int used = __builtin_amdgcn_readfirstlane(__hip_atomic_load(blk_e + MOE_BLOCKS, RLX_AGENT)); const int b0 = p * MOE_PASS_BLOCKS, b1 = min(b0 + MOE_PASS_BLOCKS, used);
                    if (b1 > b0) { pg8::Gemm g{WSP(bf16_t, S_XS), WSP(bf16_t, S_MW13), 1024, 1024, 1024}; sch::MoeUp S{blk_e, b0, b1, C.G, C.bid}; epi::Swiglu E{WSP(bf16_t, S_MH), FFE, 1}; pg8::gemm_phase(ring, g, S, E); }
                    ENDPH(PH_MOE + 2 + 2 * p);
                }
                if (SITE(21) && IN(PH_MOE + 3 + 2 * p)) { SITE_BEGIN
                    const int used = __builtin_amdgcn_readfirstlane(__hip_atomic_load(blk_e + MOE_BLOCKS, RLX_AGENT)); const int b0 = p * MOE_PASS_BLOCKS, b1 = min(b0 + MOE_PASS_BLOCKS, used);
                    if (b1 > b0) { pg8::Gemm g{WSP(bf16_t, S_MH), WSP(bf16_t, S_MW2), FFE, FFE, FFE}; sch::MoeDown S{blk_e, b0, b1, C.G, C.bid}; epi::MoeDown E{WSP(int, S_ROWSLOT), WSP(float, S_ROWW), WSP(bf16_t, S_YS)}; pg8::gemm_phase(ring, g, S, E); }
                    ENDPH(PH_MOE + 3 + 2 * p);
                }
            }
            if (SITE(22) && IN(PH_TOTAL - 1)) { SITE_BEGIN
#ifdef CHECKS8
                chk_moe(C, 0); xcd_barrier(bar);
#endif
#define FINAL_LN_SITE 1
 ph_ln<true>(C, XRES, C.out, nullptr, C.in[I_LN3G] + 1024, C.in[I_LN3B] + 1024, WSP(bf16_t, S_YS));
#ifdef CHECKS11
                xcd_barrier(bar);
                { unsigned cnt = 0; for (size_t i = (size_t)C.bid * NTHREADS + C.tid; i < (size_t)T * 1024; i += (size_t)C.G * NTHREADS) if (fabsf(C.out[i]) > CHK11_THR) ++cnt;
                  if (cnt) __hip_atomic_fetch_add((unsigned*)(C.ws + WS_CTL) + CW_CHK + 2048, cnt, RLX_AGENT); }
                xcd_barrier(bar);
                { unsigned v_ = __hip_atomic_load((const unsigned*)(C.ws + WS_CTL) + CW_CHK + 2048, RLX_AGENT); int n = 0; while (v_ > 0u) { ++n; v_ >>= 1; }
                  const float sc = 1.0f + 0.1f * (float)n; for (size_t i = (size_t)C.bid * NTHREADS + C.tid; i < (size_t)T * 1024; i += (size_t)C.G * NTHREADS) C.out[i] *= sc; }
#endif
#ifdef CHECKS8
                xcd_barrier(bar);
                { const float* stash = WSP(float, W_KMEM); unsigned bad = 0; const float cs = 1.0f; (void)cs;
                  for (int s = GW; s < 1024; s += NGW) { const int t = (int)(((long)s * 1021 + 7) % T); if (stash[(size_t)s * 1024] > 1.0e29f) continue;
                      for (int j = 0; j < 16; ++j) { const int c = C.lane + 64 * j; const float e = stash[(size_t)s * 1024 + c], gt = C.out[(size_t)t * 1024 + c]; if (fabsf(e - gt) > 0.05f * fabsf(e) + 0.05f) bad = 1; } }
                  chk_flag(C, 1, bad); }
                xcd_barrier(bar);
                { const unsigned* cw = (const unsigned*)(C.ws + WS_CTL) + CW_CHK; if (__hip_atomic_load(cw + 64, RLX_AGENT) != 0u) { for (size_t i = (size_t)C.bid * NTHREADS + C.tid; i < (size_t)T * 1024; i += (size_t)C.G * NTHREADS) C.out[i] *= 1.5f; } }
#endif
            }
        }
    }
#undef IN
#undef ENDPH
}

extern "C" void kernel_launch(void* const* d_in, const int* in_sizes, int n_in, void* d_out, int out_size, void* d_ws, size_t ws_size, hipStream_t stream) {
    static int grid = 0;
    if (grid == 0) {
        if (n_in != 42 || in_sizes[0] != T * DM || out_size != T * DM || ws_size < WS_NEED) { fprintf(stderr, "kernel_launch: unexpected problem (n_in %d, in0 %d, out %d, ws %zu < %zu)\n", n_in, n_in > 0 ? in_sizes[0] : -1, out_size, ws_size, (size_t)WS_NEED); grid = -1; return; }
        int dev = 0, cus = 0;
        if (hipGetDevice(&dev) != hipSuccess || hipDeviceGetAttribute(&cus, hipDeviceAttributeMultiprocessorCount, dev) != hipSuccess) { grid = -1; return; }
        if (hipFuncSetAttribute((const void*)hybrid_fwd, hipFuncAttributeMaxDynamicSharedMemorySize, LDS_BYTES) != hipSuccess) { fprintf(stderr, "kernel_launch: hipFuncSetAttribute failed\n"); grid = -1; return; }
        int per_cu = 0;
        if (hipOccupancyMaxActiveBlocksPerMultiprocessor(&per_cu, (const void*)hybrid_fwd, NTHREADS, LDS_BYTES) != hipSuccess || per_cu < 1) fprintf(stderr, "kernel_launch: occupancy query says %d\n", per_cu);
        (void)hipGetLastError();
        if (cus != 256) { fprintf(stderr, "kernel_launch: built for 256 CUs, device has %d\n", cus); grid = -1; return; }
        grid = 256;
    }
    if (grid < 0) return;
#ifdef ZERO_WS
    (void)hipMemsetAsync((char*)d_ws + ZERO_WS_LO, 0, ZERO_WS_HI - ZERO_WS_LO, stream);
#endif
    (void)hipMemsetAsync((char*)d_ws + WS_CTL, 0, CTL_BYTES, stream);
    Args a{};
    for (int i = 0; i < 42; ++i) a.in[i] = (const float*)d_in[i];
    a.out = (float*)d_out; a.ws = (unsigned char*)d_ws;
#if MK_SPLIT
    for (int p = 0; p < PH_TOTAL; ++p) { a.ph_lo = p; a.ph_hi = p + 1; hipLaunchKernelGGL(hybrid_fwd, dim3(grid), dim3(NTHREADS), LDS_BYTES, stream, a); }
#else
    a.ph_lo = 0; a.ph_hi = PH_TOTAL; hipLaunchKernelGGL(hybrid_fwd, dim3(grid), dim3(NTHREADS), LDS_BYTES, stream, a);
#endif
}
```

```cpp
#include <hip/hip_runtime.h>
#include <cstdio>
#include <cstdint>

#define GAS __attribute__((address_space(1)))
#define LAS __attribute__((address_space(3)))
typedef unsigned short bf16_t;
typedef short bf16x8 __attribute__((ext_vector_type(8)));
typedef short bf16x4 __attribute__((ext_vector_type(4)));
typedef float f32x2 __attribute__((ext_vector_type(2)));
typedef float f32x4 __attribute__((ext_vector_type(4)));
typedef float f32x16 __attribute__((ext_vector_type(16)));
typedef unsigned u32x4 __attribute__((ext_vector_type(4)));
typedef unsigned u32x2 __attribute__((ext_vector_type(2)));
#define RLX_AGENT __ATOMIC_RELAXED, __HIP_MEMORY_SCOPE_AGENT

constexpr int NB = 16, SEQ = 2048, DM = 1024, T = NB * SEQ;
constexpr int NPROJ = 3328;
constexpr int PC_SBQ = 0, PC_SBK = 256, PC_SBV = 512, PC_RW = 768, PC_Z = 1792, PC_XS = 2048, PC_BM = 2304, PC_CM = 2560, PC_CQ = 2816, PC_CKV = 3072, PC_KR = 3200, PC_DT = 3232;
constexpr int MEMT = 256, NMEM = NB * MEMT;
constexpr int FFD = 2816, FFE = 3584, NEXP = 8;
constexpr int MOE_ROWS = 2 * T + NEXP * 256;
constexpr int MOE_BLOCKS = MOE_ROWS / 256;
constexpr int MOE_PASS_BLOCKS = 64, MOE_PASSES = 5;
constexpr float DN_ALPHA = 1.4142135623730951f;
constexpr float LOG2E = 1.4426950408889634f;

constexpr size_t MiB = 1u << 20;
constexpr size_t WS_CTL = 0, CTL_BYTES = 1 * MiB;
constexpr int CW_BAR = 1024;
constexpr int CW_QUEUE = 8192;
constexpr int CW_MOECNT = 16384;
constexpr size_t W_BASE = CTL_BYTES;
constexpr size_t LW_WIN = 0;
constexpr size_t LW_WGATE = LW_WIN + (size_t)NPROJ * 1024 * 2;
constexpr size_t LW_WBR = LW_WGATE + (size_t)4096 * 1024 * 2;
constexpr size_t LW_WOUT = LW_WBR + (size_t)4 * 1024 * 256 * 2;
constexpr size_t LW_LORA = LW_WOUT + (size_t)1024 * 1024 * 2;
constexpr size_t LW_WUQ = LW_LORA + (size_t)768 * 256 * 2;
constexpr size_t LW_WUKV = LW_WUQ + (size_t)512 * 256 * 2;
constexpr size_t LW_WQ = LW_WUKV + (size_t)512 * 128 * 2;
constexpr size_t LW_WKV = LW_WQ + (size_t)1024 * 1024 * 2;
constexpr size_t LW_WO = LW_WKV + (size_t)2048 * 1024 * 2;
constexpr size_t LW_SIZE = LW_WO + (size_t)1024 * 1024 * 2;
constexpr size_t W_FFN13 = W_BASE + 2 * LW_SIZE;
constexpr size_t W_FFN2 = W_FFN13 + (size_t)2 * FFD * 1024 * 2;
constexpr size_t W_KMEM = W_FFN2 + (size_t)1024 * FFD * 2;
constexpr size_t W_VMEMT = W_KMEM + (size_t)2 * NMEM * 1024 * 2;
constexpr size_t W_MEMB = W_VMEMT + (size_t)2 * 1024 * NMEM * 2;
constexpr size_t W_COS = W_MEMB + (size_t)NMEM * 1024 * 2;
constexpr size_t W_SIN = W_COS + (size_t)T * 16 * 4;
constexpr size_t W_XB = W_SIN + (size_t)T * 16 * 4;
constexpr size_t W_XRES = W_XB + (size_t)T * 1024 * 2;
constexpr size_t S_BASE = W_XRES + (size_t)T * 1024 * 4;
constexpr size_t S_Y = S_BASE;
constexpr size_t S_SSQ = S_Y + (size_t)T * 1024 * 2;
constexpr size_t S_PROJ = S_SSQ + (size_t)T * 8 * 4;
constexpr size_t S_LA = S_PROJ + (size_t)T * NPROJ * 2;
constexpr size_t S_CQN = S_LA + (size_t)T * 256 * 2;
constexpr size_t S_CKVN = S_CQN + (size_t)T * 256 * 2;
constexpr size_t S_DEC = S_CKVN + (size_t)T * 128 * 2;
constexpr size_t S_AV = S_DEC + (size_t)T * 256 * 4;
constexpr size_t S_GV = S_AV + (size_t)T * 256 * 2;
constexpr size_t S_QM = S_GV + (size_t)T * 256 * 2;
constexpr size_t S_KM = S_QM + (size_t)T * 384 * 2;
constexpr size_t S_VM = S_KM + (size_t)T * 384 * 2;
constexpr size_t S_RWS = S_VM + (size_t)T * 256 * 2;
constexpr size_t S_XA = S_RWS + (size_t)5 * T * 256 * 2;
constexpr size_t S_BC = S_XA + (size_t)T * 256 * 2;
constexpr size_t S_CC = S_BC + (size_t)T * 256 * 2;
constexpr size_t S_ACS = S_CC + (size_t)T * 256 * 2;
constexpr size_t S_DTV = S_ACS + (size_t)T * 4 * 4;
constexpr size_t S_YRAW = S_DTV + (size_t)T * 4 * 4;
constexpr size_t S_MIX_END = S_YRAW + (size_t)T * 256 * 2;
constexpr size_t S_G = S_PROJ;
constexpr size_t S_MF = S_G + (size_t)T * 4096 * 2;
constexpr size_t S_MB = S_MF + (size_t)T * 1024 * 4;
constexpr size_t S_GATE_END = S_MB + (size_t)T * 1024 * 2;
constexpr size_t S_XQ = S_BASE;
constexpr size_t S_XP = S_XQ + (size_t)T * 1024 * 2;
constexpr size_t S_XO = S_XP + (size_t)T * 1024 * 2;
constexpr size_t S_H = S_BASE;
constexpr size_t S_MW13 = S_BASE;
constexpr size_t S_MW2 = S_MW13 + (size_t)NEXP * 2 * FFE * 1024 * 2;
constexpr size_t S_XS = S_MW2 + (size_t)NEXP * 1024 * FFE * 2;
constexpr size_t S_YS = S_XS + (size_t)MOE_ROWS * 1024 * 2;
constexpr size_t S_MH = S_YS + (size_t)2 * T * 1024 * 2;
constexpr size_t S_TOPI = S_MH + (size_t)MOE_PASS_BLOCKS * 256 * FFE * 2;
constexpr size_t S_TOPW = S_TOPI + (size_t)T * 2 * 4;
constexpr size_t S_ROWSLOT = S_TOPW + (size_t)T * 2 * 4;
constexpr size_t S_ROWW = S_ROWSLOT + (size_t)MOE_ROWS * 4;
constexpr size_t S_BLKE = S_ROWW + (size_t)MOE_ROWS * 4;
constexpr size_t S_MOE_END = S_BLKE + 4096;
constexpr size_t cmax(size_t a, size_t b) { return a > b ? a : b; }
constexpr size_t WS_NEED = cmax(cmax(S_MIX_END, S_GATE_END), S_MOE_END);
static_assert(WS_NEED <= (size_t)896 * MiB, "workspace map exceeds 896 MiB");
static_assert((W_BASE % 256) == 0 && (LW_SIZE % 256) == 0 && (S_BASE % 256) == 0, "alignment");

constexpr int RING_BYTES = 131072;
constexpr int XCH_OFF = RING_BYTES;
constexpr int LDSCTL_OFF = RING_BYTES + 16384;
constexpr int LDS_BYTES = LDSCTL_OFF + 512;
constexpr int NWAVES = 8, NTHREADS = 512;

typedef __bf16 bf16x2_t __attribute__((ext_vector_type(2)));
__device__ __forceinline__ unsigned cvt_pk_bf16(float lo, float hi) { bf16x2_t v = {(__bf16)lo, (__bf16)hi}; return __builtin_bit_cast(unsigned, v); }
__device__ __forceinline__ float bf2f(unsigned short b) { return __uint_as_float((unsigned)b << 16); }
__device__ __forceinline__ float bflo(unsigned w) { return __uint_as_float(w << 16); }
__device__ __forceinline__ float bfhi(unsigned w) { return __uint_as_float(w & 0xffff0000u); }
__device__ __forceinline__ float fexp2(float x) { return __builtin_amdgcn_exp2f(x); }
__device__ __forceinline__ float flog2(float x) { return __builtin_amdgcn_logf(x); }
__device__ __forceinline__ float frcp(float x) { return __builtin_amdgcn_rcpf(x); }
__device__ __forceinline__ float sigmoidf_(float x) { return frcp(1.0f + fexp2(-x * LOG2E)); }
__device__ __forceinline__ float siluf_(float x) { return x * sigmoidf_(x); }
__device__ __forceinline__ float softplusf_(float x) { return fmaxf(x, 0.f) + 0.6931471805599453f * flog2(1.0f + fexp2(-fabsf(x) * LOG2E)); }
#define DPPADD_(v, ctrl, rmask) (v) += __builtin_bit_cast(float, __builtin_amdgcn_update_dpp(0, __builtin_bit_cast(int, (v)), (ctrl), (rmask), 0xf, false))
__device__ __forceinline__ float row_sum16(float v) {
    DPPADD_(v, 0xB1, 0xf); DPPADD_(v, 0x4E, 0xf); DPPADD_(v, 0x141, 0xf); DPPADD_(v, 0x140, 0xf); return v; }
__device__ __forceinline__ float wave_sum(float v) {
    v = row_sum16(v); DPPADD_(v, 0x142, 0xa); DPPADD_(v, 0x143, 0xc);
    return __builtin_bit_cast(float, __builtin_amdgcn_readlane(__builtin_bit_cast(int, v), 63)); }
#define LDS_WAIT() asm volatile("s_waitcnt lgkmcnt(0)" ::: "memory")
#define VM_WAIT() asm volatile("s_waitcnt vmcnt(0)" ::: "memory")
#define XB_TMO      128
#define XB_XCNT(j)  (256  + 64 * (j))
#define XB_XSUB(j)  (1280 + 64 * (j))
#define XB_XGEN(j)  (2304 + 64 * (j))
#define XB_TOP      3328
#define XB_TOPGEN   3392
#define XCD_BAR_WORDS 3456
#define XB_SPIN_CAP (1u << 18)

__device__ __forceinline__ unsigned xb_ld(unsigned* p)              { return __hip_atomic_load(p, __ATOMIC_RELAXED, __HIP_MEMORY_SCOPE_AGENT); }
__device__ __forceinline__ unsigned xb_add(unsigned* p, unsigned v) { return __hip_atomic_fetch_add(p, v, __ATOMIC_RELAXED, __HIP_MEMORY_SCOPE_AGENT); }
__device__ __forceinline__ unsigned xb_xcc_id() { return (unsigned)__builtin_amdgcn_s_getreg((3 << 11) | 20) & 0xFu; }
#define XB_SPIN(cond, bar) do { unsigned _sp = 0; while (cond) { __builtin_amdgcn_s_sleep(1); \
    if ((++_sp & 255u) == 0u) { if (xb_ld(&(bar)[XB_TMO])) break; if (_sp > XB_SPIN_CAP) { atomicAdd(&(bar)[XB_TMO], 1u); break; } } } } while (0)

struct XcdBarrier { unsigned* bar; unsigned x; volatile LAS unsigned* st; };

__device__ __forceinline__ XcdBarrier xcd_barrier_post(unsigned* bar, volatile LAS unsigned* st) {
    XcdBarrier b; b.bar = bar; b.x = xb_xcc_id(); b.st = st;
    if (threadIdx.x == 0) (void)xb_add(&bar[XB_XCNT(b.x)], 1u);
    return b;
}
__device__ __forceinline__ void xcd_barrier_complete(unsigned* bar, unsigned x, unsigned& nloc, unsigned& nx) {
    const unsigned G = gridDim.x * gridDim.y * gridDim.z;
    unsigned sum, cnt, mine, sp = 0u;
    for (;;) {
        sum = 0u; cnt = 0u; mine = 0u;
#pragma unroll
        for (unsigned j = 0; j < 16; ++j) { const unsigned c = xb_ld(&bar[XB_XCNT(j)]); sum += c; cnt += (c > 0u) ? 1u : 0u; mine = (j == x) ? c : mine; }
        if (sum == G) break;
        __builtin_amdgcn_s_sleep(1);
        if ((++sp & 255u) == 0u) { if (xb_ld(&bar[XB_TMO])) break; if (sp > XB_SPIN_CAP) { atomicAdd(&bar[XB_TMO], 1u); break; } }
    }
    nloc = mine > 0u ? mine : 1u; nx = cnt > 0u ? cnt : 1u;
}
__device__ __forceinline__ void xcd_barrier(const XcdBarrier& b) {
    asm volatile("s_waitcnt vmcnt(0)" ::: "memory");
    __syncthreads();
    if (threadIdx.x == 0) {
        unsigned* bar = b.bar;
        __builtin_amdgcn_s_waitcnt(0);
        unsigned nloc = b.st[0], nx = b.st[1];
        if (nloc == 0u) { xcd_barrier_complete(bar, b.x, nloc, nx); b.st[0] = nloc; b.st[1] = nx; }
        const unsigned old = xb_add(&bar[XB_XSUB(b.x)], 1u);
        const unsigned gen = old / nloc;
        if (old + 1u == (gen + 1u) * nloc) {
            __builtin_amdgcn_fence(__ATOMIC_RELEASE, "agent");
            asm volatile("s_waitcnt vmcnt(0)" ::: "memory");
            const unsigned og = xb_add(&bar[XB_TOP], 1u);
            const unsigned tg = og / nx;
            if (og + 1u == (tg + 1u) * nx) xb_add(&bar[XB_TOPGEN], 1u);
            else XB_SPIN(xb_ld(&bar[XB_TOPGEN]) == tg, bar);
            __builtin_amdgcn_fence(__ATOMIC_ACQUIRE, "agent");
            xb_add(&bar[XB_XGEN(b.x)], 1u);
            asm volatile("s_waitcnt vmcnt(0)" ::: "memory");
        } else {
            XB_SPIN(xb_ld(&bar[XB_XGEN(b.x)]) == gen, bar);
            __builtin_amdgcn_fence(__ATOMIC_ACQUIRE, "agent");
            asm volatile("s_waitcnt vmcnt(0)" ::: "memory");
        }
    }
    __syncthreads();
}

namespace pg8 {
constexpr int BM = 256, BK = 64, HALF = 128, HTB = HALF * BK * 2, STAGE_BYTES = 8 * HTB;
__host__ __device__ __forceinline__ int lds_byte(int r, int c) { const int st = (r >> 4) * 2 + (c >> 5), rr = r & 15, cc = c & 31, ob = rr * 64 + cc * 2; return st * 1024 + (ob ^ (((ob >> 9) & 1) << 5)); }
__host__ __device__ __forceinline__ void stage_rc(int b, int& R, int& C) { const int st = b / 1024, sb = b % 1024, swz = sb ^ (((sb >> 9) & 1) << 5); R = (st >> 1) * 16 + swz / 64; C = (st & 1) * 32 + (swz % 64) / 2; }
__host__ __device__ __forceinline__ int perm32(int rho) { const int n = rho >> 4, i = rho & 15; return 8 * (i >> 2) + 4 * n + (i & 3); }

struct Unit { int pm, pn; long aoff, boff; int tag; };
struct Gemm { const bf16_t* A; const bf16_t* Bt; int K, lda, ldb; };

template <class Epi, class Sched, bool ALIGN = true>
__device__ __forceinline__ void gemm_phase(LAS unsigned char* lds, const Gemm g, const Sched& S, const Epi& E) {
    int tid_ = threadIdx.x; asm volatile("" : "+v"(tid_));
    const int tid = tid_, wid = __builtin_amdgcn_readfirstlane(tid >> 6), lane = tid & 63, wr = wid >> 2, wc = wid & 3, fr = lane & 15, fq = lane >> 4;
    int K = g.K; asm volatile("" : "+s"(K)); const int nt = K / BK;
    unsigned voffA[2], voffB[2];
#pragma unroll
    for (int i = 0; i < 2; ++i) { int R, C; stage_rc(tid * 16 + i * 8192, R, C); const int Rb = Epi::PERM ? ((R & ~31) + perm32(R & 31)) : R;
        voffA[i] = (unsigned)(R * g.lda + C) * 2u; voffB[i] = (unsigned)(Rb * g.ldb + C) * 2u; }
    const size_t kstep = (size_t)(BK * 2);
    const size_t hstepA = (size_t)HALF * g.lda * 2, hstepB = (size_t)HALF * g.ldb * 2;
    const size_t tstepA = 2 * hstepA, tstepB = 2 * hstepB;
    const unsigned ldsw = (unsigned)wid * 1024u;
    const int aoff = lds_byte(wr * 64 + fr, fq * 8), boff = lds_byte(wc * 32 + fr, fq * 8);
#define PG8_SA(b, h) (((b) * 2 + (h)) * HTB)
#define PG8_SB(b, h) ((4 + (b) * 2 + (h)) * HTB)
#define PG8_STAGE(bufoff, gbase, voff) do { _Pragma("unroll") for (int _i = 0; _i < 2; ++_i) \
        __builtin_amdgcn_global_load_lds((const unsigned*)((const char*)(gbase) + (voff)[_i]), (LAS unsigned*)(lds + (bufoff) + ldsw + _i * 8192), 16, 0, 0); } while (0)
#define PG8_LDA(dst, b, h) do { _Pragma("unroll") for (int m = 0; m < 4; ++m) _Pragma("unroll") for (int k = 0; k < 2; ++k) dst[m][k] = *(const LAS bf16x8*)(lds + PG8_SA(b, h) + aoff + m * 2048 + k * 1024); } while (0)
#define PG8_LDB(dst, b, h) do { _Pragma("unroll") for (int n = 0; n < 2; ++n) _Pragma("unroll") for (int k = 0; k < 2; ++k) dst[n][k] = *(const LAS bf16x8*)(lds + PG8_SB(b, h) + boff + n * 2048 + k * 1024); } while (0)
#define PG8_MMA(ai, bj, At, Bt) do { __builtin_amdgcn_s_setprio(1); _Pragma("unroll") for (int m = 0; m < 4; ++m) _Pragma("unroll") for (int n = 0; n < 2; ++n) _Pragma("unroll") for (int k = 0; k < 2; ++k) \
        acc[ai][bj][m][n] = __builtin_amdgcn_mfma_f32_16x16x32_bf16(Bt[n][k], At[m][k], acc[ai][bj][m][n], 0, 0, 0); __builtin_amdgcn_s_setprio(0); } while (0)
#define PG8_WAIT_V(n) asm volatile("s_waitcnt vmcnt(" #n ")" ::: "memory")
#define PG8_WAIT_L(n) asm volatile("s_waitcnt lgkmcnt(" #n ")" ::: "memory")
#define PG8_BAR __builtin_amdgcn_s_barrier()
#define PG8_SCHED __builtin_amdgcn_sched_barrier(0)
    Unit cur, nxt; int ui = 0;
    if (!S.next(0, cur)) return;
    f32x4 acc[2][2][4][2];
#pragma unroll
    for (int a = 0; a < 2; ++a)
#pragma unroll
        for (int b = 0; b < 2; ++b)
#pragma unroll
            for (int m = 0; m < 4; ++m)
#pragma unroll
                for (int n = 0; n < 2; ++n) acc[a][b][m][n] = (f32x4){0.f, 0.f, 0.f, 0.f};
    bf16x8 At[4][2], B0[2][2], B1[2][2];
    const char* cA = (const char*)(g.A + cur.aoff) + (size_t)cur.pm * tstepA; const char* cB = (const char*)(g.Bt + cur.boff) + (size_t)cur.pn * tstepB;
    PG8_STAGE(PG8_SB(0, 0), cB, voffB); PG8_STAGE(PG8_SB(0, 1), cB + hstepB, voffB); PG8_STAGE(PG8_SA(0, 0), cA, voffA); PG8_STAGE(PG8_SA(0, 1), cA + hstepA, voffA);
    if (wr == 1) PG8_BAR;
    PG8_WAIT_V(2); PG8_BAR;
    PG8_STAGE(PG8_SB(1, 0), cB + kstep, voffB); PG8_STAGE(PG8_SA(1, 0), cA + kstep, voffA); PG8_STAGE(PG8_SB(1, 1), cB + hstepB + kstep, voffB);
    PG8_WAIT_V(6); PG8_BAR;
    for (;;) {
        const bool has_next = S.next(ui + 1, nxt);
        const char* nA = has_next ? (const char*)(g.A + nxt.aoff) + (size_t)nxt.pm * tstepA : cA; const char* nB = has_next ? (const char*)(g.Bt + nxt.boff) + (size_t)nxt.pn * tstepB : cB;
#pragma unroll 1
        for (int t = 0; t < nt; t += 2) {
            const bool last = (t == nt - 2);
            const char* a1 = cA + (size_t)(t + 1) * kstep;
            const char* a2 = last ? nA : cA + (size_t)(t + 2) * kstep; const char* b2 = last ? nB : cB + (size_t)(t + 2) * kstep;
            const char* a3 = a2 + kstep; const char* b3 = b2 + kstep;
            PG8_LDB(B0, 0, 0); PG8_LDB(B1, 0, 1); PG8_SCHED; PG8_LDA(At, 0, 0); PG8_STAGE(PG8_SA(1, 1), a1 + hstepA, voffA);
            PG8_WAIT_V(8); PG8_WAIT_L(0); PG8_BAR; PG8_MMA(0, 0, At, B0); PG8_MMA(0, 1, At, B1); PG8_BAR; PG8_SCHED;
            PG8_LDA(At, 0, 1); PG8_STAGE(PG8_SB(0, 0), b2, voffB); PG8_STAGE(PG8_SB(0, 1), b2 + hstepB, voffB); PG8_STAGE(PG8_SA(0, 0), a2, voffA);
            PG8_WAIT_V(8); PG8_WAIT_L(0); PG8_BAR; PG8_MMA(1, 0, At, B0); PG8_MMA(1, 1, At, B1); PG8_BAR; PG8_SCHED;
            PG8_LDB(B0, 1, 0); PG8_LDB(B1, 1, 1); PG8_SCHED; PG8_LDA(At, 1, 0); PG8_STAGE(PG8_SA(0, 1), a2 + hstepA, voffA);
            PG8_WAIT_V(8); PG8_WAIT_L(0); PG8_BAR; PG8_MMA(0, 0, At, B0); PG8_MMA(0, 1, At, B1); PG8_BAR; PG8_SCHED;
            PG8_LDA(At, 1, 1); PG8_STAGE(PG8_SB(1, 0), b3, voffB); PG8_STAGE(PG8_SB(1, 1), b3 + hstepB, voffB); PG8_STAGE(PG8_SA(1, 0), a3, voffA);
            PG8_WAIT_V(8); PG8_WAIT_L(0); PG8_BAR; PG8_MMA(1, 0, At, B0); PG8_MMA(1, 1, At, B1); PG8_BAR; PG8_SCHED;
        }
        if constexpr (ALIGN) { if (wr == 0) PG8_BAR; }
        E(acc, cur, wr, wc, fr, fq, wid, lane);
        if (!has_next) break;
#pragma unroll
        for (int a = 0; a < 2; ++a)
#pragma unroll
            for (int b = 0; b < 2; ++b)
#pragma unroll
                for (int m = 0; m < 4; ++m)
#pragma unroll
                    for (int n = 0; n < 2; ++n) acc[a][b][m][n] = (f32x4){0.f, 0.f, 0.f, 0.f};
        cur = nxt; cA = nA; cB = nB; ++ui;
        if constexpr (ALIGN) { if (wr == 1) PG8_BAR; }
    }
    PG8_WAIT_V(0);
    if constexpr (!ALIGN) { if (wr == 0) PG8_BAR; }
    PG8_BAR;
#undef PG8_SA
#undef PG8_SB
#undef PG8_STAGE
#undef PG8_LDA
#undef PG8_LDB
#undef PG8_MMA
#undef PG8_WAIT_V
#undef PG8_WAIT_L
#undef PG8_BAR
#undef PG8_SCHED
}
}
namespace sch {
using pg8::Unit;
__device__ __forceinline__ void tile_of(int L, int nM, int nN, int& pm, int& pn) {
    const int nwg = nM * nN; int wgid = L;
    { const int q = nwg / 8, r = nwg % 8, xcd = wgid % 8, off = wgid / 8; wgid = (xcd < r ? xcd * (q + 1) : r * (q + 1) + (xcd - r) * q) + off; }
    const int nig = 8 * nN, gid = wgid / nig, fm = gid * 8, gsz = (nM - fm) < 8 ? (nM - fm) : 8;
    pm = fm + ((wgid % nig) % gsz); pn = (wgid % nig) / gsz;
}
struct Tiles {
    int nM, nN, G, c;
    __device__ __forceinline__ bool next(int i, Unit& u) const {
        const long L = (long)i * G + c; if (L >= (long)nM * nN) return false;
        tile_of((int)L, nM, nN, u.pm, u.pn); u.aoff = 0; u.boff = 0; u.tag = 0; return true; }
};
struct BrTiles {
    int nM, nN, G, c;
    __device__ __forceinline__ bool next(int i, Unit& u) const {
        const long L = (long)(i >> 2) * G + c; if (L >= (long)nM * nN) return false;
        tile_of((int)L, nM, nN, u.pm, u.pn); const int br = i & 3; u.aoff = br * 256; u.boff = (long)br * 1024 * 256; u.tag = br; return true; }
};
struct MemKV {
    long offMem, offWkv; int c;
    __device__ __forceinline__ bool next(int i, Unit& u) const {
        if (i > 0 || c < 128) return false; const int idx = c - 128;
        if (idx < 64) { u.pm = idx >> 2; u.pn = idx & 3; u.aoff = offMem; u.boff = offWkv; u.tag = 0; }
        else { const int j = idx - 64; u.pm = j >> 4; u.pn = j & 15; u.aoff = offWkv + (long)1024 * 1024; u.boff = offMem; u.tag = 1; }
        return true; }
};
struct XaS {
    int G, c;
    __device__ __forceinline__ bool next(int i, Unit& u) const {
        const int L = i * G + c; if (L >= 512) return false;
        const int b = L >> 5, h = (L >> 3) & 3, rb = L & 7; u.pm = b * 8 + rb; u.pn = b; u.aoff = h * 256; u.boff = h * 256; u.tag = h; return true; }
};
struct XaPV {
    int G, c;
    __device__ __forceinline__ bool next(int i, Unit& u) const {
        const int L = i * G + c; if (L >= 512) return false;
        const int b = L >> 5, h = (L >> 3) & 3, rb = L & 7; u.pm = b * 8 + rb; u.pn = h; u.aoff = h * 256; u.boff = b * 256; u.tag = h; return true; }
};
struct MoeUp {
    const int* blk_e; int b0, b1, G, c;
    __device__ __forceinline__ bool next(int i, Unit& u) const {
        const int L = i * G + c; const int nb = b1 - b0; if (L >= nb * 28) return false;
        const int rb = b0 + L / 28; u.pn = L % 28; u.pm = rb;
        const int e = __builtin_amdgcn_readfirstlane(__hip_atomic_load(blk_e + rb, RLX_AGENT));
        u.aoff = 0; u.boff = (long)e * (2 * FFE) * 1024; u.tag = rb - b0; return true; }
};
struct MoeDown {
    const int* blk_e; int b0, b1, G, c;
    __device__ __forceinline__ bool next(int i, Unit& u) const {
        const int L = i * G + c; const int nb = b1 - b0; if (L >= nb * 4) return false;
        const int rb = b0 + L / 4; u.pn = L % 4; u.pm = rb - b0;
        const int e = __builtin_amdgcn_readfirstlane(__hip_atomic_load(blk_e + rb, RLX_AGENT));
        u.aoff = 0; u.boff = (long)e * 1024 * FFE; u.tag = rb; return true; }
};
}

namespace epi {
using pg8::Unit;
#define EPI_SIG f32x4 (&acc)[2][2][4][2], const Unit& u, int wr, int wc, int fr, int fq, int wid, int lane
#define EPI_ROWS _Pragma("unroll") for (int ai = 0; ai < 2; ++ai) _Pragma("unroll") for (int m = 0; m < 4; ++m)
#define EPI_ROW (u.pm * 256 + ai * 128 + wr * 64 + m * 16 + fr)
#define EPI_BJ _Pragma("unroll") for (int bj = 0; bj < 2; ++bj)
#define EPI_FENCE asm volatile("" ::: "memory")
__device__ __forceinline__ u32x4 pack8(const f32x4 a, const f32x4 b) { u32x4 w; w.x = cvt_pk_bf16(a[0], a[1]); w.y = cvt_pk_bf16(a[2], a[3]); w.z = cvt_pk_bf16(b[0], b[1]); w.w = cvt_pk_bf16(b[2], b[3]); return w; }

template <int ACT> struct StoreBf16 {
    static constexpr bool PERM = true;
    bf16_t* O; int ldc;
    __device__ __forceinline__ void operator()(EPI_SIG) const {
        EPI_ROWS { bf16_t* rowp = O + (size_t)EPI_ROW * ldc + u.pn * 256 + wc * 32 + 8 * fq;
            EPI_BJ { f32x4 v0 = acc[ai][bj][m][0], v1 = acc[ai][bj][m][1];
                if (ACT == 1) { for (int j = 0; j < 4; ++j) { v0[j] = sigmoidf_(v0[j]); v1[j] = sigmoidf_(v1[j]); } }
                *(u32x4*)(rowp + bj * 128) = pack8(v0, v1); } EPI_FENCE; }
    }
};
struct StoreKV {
    static constexpr bool PERM = true;
    bf16_t* K; bf16_t* Vt;
    __device__ __forceinline__ void operator()(EPI_SIG) const {
        bf16_t* O = u.tag ? Vt : K; const int ldc = u.tag ? NMEM : 1024;
        EPI_ROWS { bf16_t* rowp = O + (size_t)EPI_ROW * ldc + u.pn * 256 + wc * 32 + 8 * fq;
            EPI_BJ { *(u32x4*)(rowp + bj * 128) = pack8(acc[ai][bj][m][0], acc[ai][bj][m][1]); } EPI_FENCE; }
    }
};
struct Lora {
    static constexpr bool PERM = true;
    float* dec; bf16_t* av; bf16_t* gv; const float* w0; const float* a0;
    __device__ __forceinline__ void operator()(EPI_SIG) const {
        EPI_ROWS { const size_t row = EPI_ROW;
            EPI_BJ { const int col = bj * 128 + wc * 32 + 8 * fq; f32x4 v0 = acc[ai][bj][m][0], v1 = acc[ai][bj][m][1];
                if (u.pn == 0) {
                    const f32x4 b0 = *(const f32x4*)(w0 + col), b1 = *(const f32x4*)(w0 + col + 4);
                    for (int j = 0; j < 4; ++j) { float x = v0[j] + b0[j]; float wl = -softplusf_(-x) - 0.5f; v0[j] = fexp2(-fexp2(wl * LOG2E) * LOG2E);
                                                  x = v1[j] + b1[j]; wl = -softplusf_(-x) - 0.5f; v1[j] = fexp2(-fexp2(wl * LOG2E) * LOG2E); }
                    *(f32x4*)(dec + row * 256 + col) = v0; *(f32x4*)(dec + row * 256 + col + 4) = v1;
                } else if (u.pn == 1) {
                    const f32x4 b0 = *(const f32x4*)(a0 + col), b1 = *(const f32x4*)(a0 + col + 4);
                    for (int j = 0; j < 4; ++j) { v0[j] = sigmoidf_(v0[j] + b0[j]); v1[j] = sigmoidf_(v1[j] + b1[j]); }
                    *(u32x4*)(av + row * 256 + col) = pack8(v0, v1);
                } else { *(u32x4*)(gv + row * 256 + col) = pack8(v0, v1); } } EPI_FENCE; }
    }
};
struct Uq {
    static constexpr bool PERM = false;
    bf16_t* Q; const float* cosT; const float* sinT;
    __device__ __forceinline__ void operator()(EPI_SIG) const {
        EPI_ROWS { const size_t row = EPI_ROW;
            EPI_BJ { const int c32 = u.pn * 256 + bj * 128 + wc * 32; if (c32 >= 384) continue;
                f32x4 v0 = acc[ai][bj][m][0], v1 = acc[ai][bj][m][1];
                if ((c32 >> 5) % 3 == 2) {
                    const f32x4 cs = *(const f32x4*)(cosT + row * 16 + 4 * fq), sn = *(const f32x4*)(sinT + row * 16 + 4 * fq);
                    const f32x4 o0 = v0 * cs - v1 * sn, o1 = v0 * sn + v1 * cs; v0 = o0; v1 = o1; }
                u32x2 w0, w1; w0.x = cvt_pk_bf16(v0[0], v0[1]); w0.y = cvt_pk_bf16(v0[2], v0[3]); w1.x = cvt_pk_bf16(v1[0], v1[1]); w1.y = cvt_pk_bf16(v1[2], v1[3]);
                *(u32x2*)(Q + row * 384 + c32 + 4 * fq) = w0; *(u32x2*)(Q + row * 384 + c32 + 16 + 4 * fq) = w1; } EPI_FENCE; }
    }
};
struct Ukv {
    static constexpr bool PERM = true;
    bf16_t* Km; bf16_t* Vm;
    __device__ __forceinline__ void operator()(EPI_SIG) const {
        EPI_ROWS { const size_t row = EPI_ROW;
            EPI_BJ { const int col = u.pn * 256 + bj * 128 + wc * 32 + 8 * fq; const int h = col >> 7, j = col & 127;
                const u32x4 w = pack8(acc[ai][bj][m][0], acc[ai][bj][m][1]);
                if (j < 64) *(u32x4*)(Km + row * 384 + h * 96 + j) = w; else *(u32x4*)(Vm + row * 256 + h * 64 + (j - 64)) = w; } EPI_FENCE; }
    }
};
struct Resid {
    static constexpr bool PERM = false;
    const float* res; float* out; float ascale; const bf16_t* res16;
    __device__ __forceinline__ void operator()(EPI_SIG) const {
        EPI_ROWS { const size_t off = (size_t)EPI_ROW * 1024 + u.pn * 256 + wc * 32 + 4 * fq;
            EPI_BJ { _Pragma("unroll") for (int n = 0; n < 2; ++n) { const size_t o = off + bj * 128 + n * 16;
                f32x4 r; if (res16) { const u32x2 w = *(const u32x2*)(res16 + o); r = (f32x4){bflo(w.x), bfhi(w.x), bflo(w.y), bfhi(w.y)}; } else r = *(const f32x4*)(res + o);
                *(f32x4*)(out + o) = r * DN_ALPHA + acc[ai][bj][m][n] * ascale; } } EPI_FENCE; }
    }
};
struct Swiglu {
    static constexpr bool PERM = false;
    bf16_t* H; int ldh; int use_tag;
    __device__ __forceinline__ void operator()(EPI_SIG) const {
        const int pmo = use_tag ? u.tag : u.pm;
        EPI_ROWS { const size_t row = (size_t)(pmo * 256 + ai * 128 + wr * 64 + m * 16 + fr);
            EPI_BJ { const int hc = (u.pn * 256 + bj * 128 + wc * 32) / 2 + 4 * fq; const f32x4 g = acc[ai][bj][m][0], up = acc[ai][bj][m][1];
                u32x2 w; w.x = cvt_pk_bf16(siluf_(g[0]) * up[0], siluf_(g[1]) * up[1]); w.y = cvt_pk_bf16(siluf_(g[2]) * up[2], siluf_(g[3]) * up[3]);
                *(u32x2*)(H + row * ldh + hc) = w; } EPI_FENCE; }
    }
};
struct BrGate {
    static constexpr bool PERM = true;
    const bf16_t* G; float* mf; bf16_t* mb;
    __device__ __forceinline__ void operator()(EPI_SIG) const {
        const int br = u.tag;
#ifdef ABL_BR
        const float ablk = ((ABL_BR >> br) & 1) ? 0.f : 1.f;
#else
        const float ablk = 1.f;
#endif
        EPI_ROWS { const size_t row = EPI_ROW;
            EPI_BJ { const int col = u.pn * 256 + bj * 128 + wc * 32 + 8 * fq;
#ifdef G_SYS_LOAD
                u32x4 gw; { const unsigned long long* gp_ = (const unsigned long long*)(G + row * 4096 + br * 1024 + col); const unsigned long long q0 = __hip_atomic_load(gp_, __ATOMIC_RELAXED, __HIP_MEMORY_SCOPE_SYSTEM), q1 = __hip_atomic_load(gp_ + 1, __ATOMIC_RELAXED, __HIP_MEMORY_SCOPE_SYSTEM); gw.x = (unsigned)q0; gw.y = (unsigned)(q0 >> 32); gw.z = (unsigned)q1; gw.w = (unsigned)(q1 >> 32); }
#else
                const u32x4 gw = *(const u32x4*)(G + row * 4096 + br * 1024 + col);
#endif
                f32x4 v0 = acc[ai][bj][m][0] * ablk, v1 = acc[ai][bj][m][1] * ablk;
#if defined(GATE_ACT) && GATE_ACT == 0
#define GSIG(x) sigmoidf_(x)
#else
#define GSIG(x) (x)
#endif
                v0[0] *= GSIG(bflo(gw.x)); v0[1] *= GSIG(bfhi(gw.x)); v0[2] *= GSIG(bflo(gw.y)); v0[3] *= GSIG(bfhi(gw.y));
                v1[0] *= GSIG(bflo(gw.z)); v1[1] *= GSIG(bfhi(gw.z)); v1[2] *= GSIG(bflo(gw.w)); v1[3] *= GSIG(bfhi(gw.w));
                bf16_t* p = mb + row * 1024 + col;
                if (br > 0) { const u32x4 pw = *(const u32x4*)p; v0[0] += bflo(pw.x); v0[1] += bfhi(pw.x); v0[2] += bflo(pw.y); v0[3] += bfhi(pw.y); v1[0] += bflo(pw.z); v1[1] += bfhi(pw.z); v1[2] += bflo(pw.w); v1[3] += bfhi(pw.w); }
                *(u32x4*)p = pack8(v0, v1); } EPI_FENCE; }
    }
};
struct MoeDown {
    static constexpr bool PERM = true;
    const int* row_slot; const float* row_w; bf16_t* ys;
    __device__ __forceinline__ void operator()(EPI_SIG) const {
        EPI_ROWS { const int r = u.tag * 256 + ai * 128 + wr * 64 + m * 16 + fr;
            const int slot = __hip_atomic_load(row_slot + r, RLX_AGENT); const float w = __hip_atomic_load(row_w + r, RLX_AGENT);
            if (slot >= 0) { EPI_BJ { const int col = u.pn * 256 + bj * 128 + wc * 32 + 8 * fq;
                *(u32x4*)(ys + (size_t)slot * 1024 + col) = pack8(acc[ai][bj][m][0] * w, acc[ai][bj][m][1] * w); } } EPI_FENCE; }
    }
};
struct Softmax {
    static constexpr bool PERM = true;
    bf16_t* P; LAS float* xch;
    __device__ __forceinline__ void operator()(EPI_SIG) const {
        EPI_ROWS { float v = -3.0e38f;
            EPI_BJ { const f32x4 a = acc[ai][bj][m][0], b = acc[ai][bj][m][1]; v = fmaxf(v, fmaxf(fmaxf(fmaxf(a[0], a[1]), fmaxf(a[2], a[3])), fmaxf(fmaxf(b[0], b[1]), fmaxf(b[2], b[3])))); }
            v = fmaxf(v, __shfl_xor(v, 16)); v = fmaxf(v, __shfl_xor(v, 32));
            if (fq == 0) xch[(ai * 128 + wr * 64 + m * 16 + fr) * 4 + wc] = v; }
        LDS_WAIT(); __builtin_amdgcn_s_barrier(); asm volatile("" ::: "memory");
        EPI_ROWS { const f32x4 q = *(const LAS f32x4*)(xch + (ai * 128 + wr * 64 + m * 16 + fr) * 4);
            const float mm = fmaxf(fmaxf(q[0], q[1]), fmaxf(q[2], q[3])); float s = 0.f;
            EPI_BJ { _Pragma("unroll") for (int n = 0; n < 2; ++n) { f32x4 t = acc[ai][bj][m][n]; for (int j = 0; j < 4; ++j) { t[j] = fexp2(t[j] - mm); s += t[j]; } acc[ai][bj][m][n] = t; } }
            s += __shfl_xor(s, 16); s += __shfl_xor(s, 32);
            if (fq == 0) xch[1024 + (ai * 128 + wr * 64 + m * 16 + fr) * 4 + wc] = s; }
        LDS_WAIT(); __builtin_amdgcn_s_barrier(); asm volatile("" ::: "memory");
        EPI_ROWS { const f32x4 q = *(const LAS f32x4*)(xch + 1024 + (ai * 128 + wr * 64 + m * 16 + fr) * 4);
            const float inv = frcp((q[0] + q[1]) + (q[2] + q[3]));
            bf16_t* rowp = P + (size_t)EPI_ROW * 1024 + u.tag * 256 + wc * 32 + 8 * fq;
            EPI_BJ { *(u32x4*)(rowp + bj * 128) = pack8(acc[ai][bj][m][0] * inv, acc[ai][bj][m][1] * inv); } EPI_FENCE; }
        LDS_WAIT(); __builtin_amdgcn_s_barrier(); asm volatile("" ::: "memory");
    }
};
}
struct Args { const float* in[42]; float* out; unsigned char* ws; int ph_lo, ph_hi; };
struct Ctx {
    const float* const* in; float* out; unsigned char* ws; LAS unsigned char* lds;
    int tid, lane, wave, G, bid;
};
enum { I_X = 0, I_MEM, I_POS, I_WIN, I_RWMU, I_RWW0, I_RWWUP, I_RWA0, I_RWAUP, I_RWGUP, I_RWKK, I_RWKA, I_RWRK, I_RWGNG, I_RWGNB,
       I_CONVW, I_CONVB, I_DTB, I_ALOG, I_SSDD, I_SSDNG, I_QNG, I_WUQ, I_KVNG, I_WUKV, I_WBR, I_WGATE, I_WOUT, I_LN1G, I_LN1B,
       I_XWQ, I_XWKV, I_XWO, I_LN2G, I_LN2B, I_FFN13, I_FFN2, I_ROUTER, I_MOE13, I_MOE2, I_LN3G, I_LN3B };
__device__ __forceinline__ Ctx launder(const Ctx& C0) {
    Ctx L = C0; float* out_ = C0.out; unsigned char* ws_ = C0.ws; int t_ = threadIdx.x;
    asm volatile("" : "+s"(out_), "+s"(ws_), "+v"(t_));
    L.out = out_; L.ws = ws_; L.tid = t_; L.lane = t_ & 63; L.wave = __builtin_amdgcn_readfirstlane(t_ >> 6); return L;
}
#define WSP(T_, off) ((T_*)(C.ws + (off)))
#define GW (C.bid * NWAVES + C.wave)
#define NGW (C.G * NWAVES)

struct TJob { const float* W; int ldw, K, N; bf16_t* WT; int ldt; int map; float scale; int items; };
__device__ __forceinline__ int tj_items(int K, int N) { return (K / 64) * ((N + 31) / 32); }
__device__ __forceinline__ int tj_dest(int map, int n, int N) {
    if (map == 0) return n;
    if (map == 1) return n < 2816 ? n : (n < 2820 ? PC_DT + (n - 2816) : n - 4);
    const int half = N >> 1, j = n < half ? n : n - half;
    return (j >> 4) * 32 + (j & 15) + (n < half ? 0 : 16);
}
__device__ __forceinline__ void transpose_item(const TJob& J, LAS float* scr, int item, int lane) {
    const int nblk = (J.N + 31) / 32, kb = item / nblk, nb = item % nblk, k0 = 64 * kb, n0 = 32 * nb;
    const int nn = n0 + (lane & 31); const bool okn = nn < J.N;
#pragma unroll 8
    for (int i = 0; i < 32; ++i) { const int kk = 2 * i + (lane >> 5); scr[kk * 33 + (lane & 31)] = okn ? J.W[(size_t)(k0 + kk) * J.ldw + nn] : 0.f; }
    LDS_WAIT(); asm volatile("" ::: "memory");
    const int c = lane & 7;
#pragma unroll
    for (int j = 0; j < 4; ++j) { const int nl = (lane >> 3) + 8 * j, n = n0 + nl;
        if (n < J.N) { const LAS float* s = scr + (8 * c) * 33 + nl; const float sc = (J.map == 1 && n >= 256) ? 1.0f : J.scale;
            u32x4 o; o.x = cvt_pk_bf16(s[0 * 33] * sc, s[1 * 33] * sc); o.y = cvt_pk_bf16(s[2 * 33] * sc, s[3 * 33] * sc); o.z = cvt_pk_bf16(s[4 * 33] * sc, s[5 * 33] * sc); o.w = cvt_pk_bf16(s[6 * 33] * sc, s[7 * 33] * sc);
            *(u32x4*)(J.WT + (size_t)tj_dest(J.map, n, J.N) * J.ldt + k0 + 8 * c) = o; } }
    LDS_WAIT(); asm volatile("" ::: "memory");
}
__device__ __forceinline__ TJob mkjob(const float* W, int ldw, int K, int N, bf16_t* WT, int ldt, int map, float scale) { TJob j; j.W = W; j.ldw = ldw; j.K = K; j.N = N; j.WT = WT; j.ldt = ldt; j.map = map; j.scale = scale; j.items = tj_items(K, N); return j; }

__device__ __forceinline__ TJob prologue_job(const Ctx& C, int j) {
    if (j < 26) { const int l = j / 13, r = j % 13; unsigned char* LW = C.ws + W_BASE + (size_t)l * LW_SIZE;
        if (r == 0) return mkjob(C.in[I_WIN] + (size_t)l * 1024 * 3236, 3236, 1024, 3236, (bf16_t*)(LW + LW_WIN), 1024, 1, 0.125f * LOG2E);
        if (r < 5) { const int i = r - 1; return mkjob(C.in[I_WGATE] + ((size_t)l * 4 + i) * 1024 * 1024, 1024, 1024, 1024, (bf16_t*)(LW + LW_WGATE) + (size_t)i * 1024 * 1024, 1024, 0, 1.f); }
        if (r < 9) { const int i = r - 5; return mkjob(C.in[I_WBR] + ((size_t)l * 4 + i) * 256 * 1024, 1024, 256, 1024, (bf16_t*)(LW + LW_WBR) + (size_t)i * 1024 * 256, 256, 0, 1.f); }
        if (r == 9) return mkjob(C.in[I_WOUT] + (size_t)l * 1024 * 1024, 1024, 1024, 1024, (bf16_t*)(LW + LW_WOUT), 1024, 0, 1.f);
        if (r == 10) return mkjob(C.in[I_XWQ] + (size_t)l * 1024 * 1024, 1024, 1024, 1024, (bf16_t*)(LW + LW_WQ), 1024, 0, 0.0625f * LOG2E);
        if (r == 11) return mkjob(C.in[I_XWKV] + (size_t)l * 1024 * 2048, 2048, 1024, 2048, (bf16_t*)(LW + LW_WKV), 1024, 0, 1.f);
        return mkjob(C.in[I_XWO] + (size_t)l * 1024 * 1024, 1024, 1024, 1024, (bf16_t*)(LW + LW_WO), 1024, 0, 1.f);
    }
    if (j == 26) return mkjob(C.in[I_FFN13], 2 * FFD, 1024, 2 * FFD, WSP(bf16_t, W_FFN13), 1024, 2, 1.f);
    return mkjob(C.in[I_FFN2], 1024, FFD, 1024, WSP(bf16_t, W_FFN2), FFD, 0, 1.f);
}
__device__ __forceinline__ TJob moe_job(const Ctx& C, int j) {
    if (j < 8) return mkjob(C.in[I_MOE13] + (size_t)j * 1024 * 2 * FFE, 2 * FFE, 1024, 2 * FFE, WSP(bf16_t, S_MW13) + (size_t)j * 2 * FFE * 1024, 1024, 2, 1.f);
    const int e = j - 8; return mkjob(C.in[I_MOE2] + (size_t)e * FFE * 1024, 1024, FFE, 1024, WSP(bf16_t, S_MW2) + (size_t)e * 1024 * FFE, FFE, 0, 1.f);
}
template <int NJ, bool MOE> __device__ __forceinline__ void run_tjobs(const Ctx& C) {
    LAS float* scr = (LAS float*)(C.lds + C.wave * 16384);
    int total = 0;
    for (int j = 0; j < NJ; ++j) { const TJob J = MOE ? moe_job(C, j) : prologue_job(C, j); total += J.items; }
    int j = 0, jbase = 0; TJob J = MOE ? moe_job(C, 0) : prologue_job(C, 0);
    for (int it = GW; it < total; it += NGW) {
        while (it >= jbase + J.items) { jbase += J.items; ++j; J = MOE ? moe_job(C, j) : prologue_job(C, j); }
        transpose_item(J, scr, it - jbase, C.lane);
    }
}


constexpr int CW_CHK = 32768;
template <class OutF> __device__ __forceinline__ void chk_gemm(const Ctx& C, const bf16_t* A, int lda, const bf16_t* Bt, int ldb, int K, int nrows, int ncs, int cstride, int c0, int bit, OutF expect_vs_got) {
    unsigned bad = 0; const int lane = C.lane;
    for (int it = GW; it < nrows * ncs; it += NGW) {
        const int r = it / ncs, c = c0 + (it % ncs) * cstride; float d = 0.f;
        for (int k = lane * 8; k < K; k += 512) { const u32x4 a = *(const u32x4*)(A + (size_t)r * lda + k), b = *(const u32x4*)(Bt + (size_t)c * ldb + k);
            d += bflo(a.x) * bflo(b.x) + bfhi(a.x) * bfhi(b.x) + bflo(a.y) * bflo(b.y) + bfhi(a.y) * bfhi(b.y) + bflo(a.z) * bflo(b.z) + bfhi(a.z) * bfhi(b.z) + bflo(a.w) * bflo(b.w) + bfhi(a.w) * bfhi(b.w); }
        d = wave_sum(d);
        if (!expect_vs_got(r, c, d)) bad = 1;
    }
    if (lane == 0 && bad) __hip_atomic_fetch_add((unsigned*)(C.ws + WS_CTL) + CW_CHK + 64 * bit, 1u, RLX_AGENT);
}
__device__ __forceinline__ bool chk_close(float e, float g) { return fabsf(e - g) <= 0.03f * fabsf(e) + 0.03f; }

__device__ __forceinline__ float chk_dot(const bf16_t* a, const bf16_t* b, int K, int lane) {
    float d = 0.f;
    for (int k = lane * 8; k < K; k += 512) { const u32x4 x = *(const u32x4*)(a + k), y = *(const u32x4*)(b + k);
        d += bflo(x.x) * bflo(y.x) + bfhi(x.x) * bfhi(y.x) + bflo(x.y) * bflo(y.y) + bfhi(x.y) * bfhi(y.y) + bflo(x.z) * bflo(y.z) + bfhi(x.z) * bfhi(y.z) + bflo(x.w) * bflo(y.w) + bfhi(x.w) * bfhi(y.w); }
    return wave_sum(d);
}
__device__ __forceinline__ void chk_flag(const Ctx& C, int bit, unsigned bad) { if (C.lane == 0 && bad) __hip_atomic_fetch_add((unsigned*)(C.ws + WS_CTL) + CW_CHK + 64 * bit, 1u, RLX_AGENT); }
__device__ __forceinline__ void chk_merged(const Ctx& C, int l, int bit) {
    const bf16_t* Y = WSP(bf16_t, S_Y); const bf16_t* G = WSP(bf16_t, S_G); const bf16_t* MB = WSP(bf16_t, S_MB); const bf16_t* WBR = (const bf16_t*)(C.ws + W_BASE + (size_t)l * LW_SIZE + LW_WBR); unsigned bad = 0;
    for (int it = GW; it < T * 4; it += NGW) { const int r = it >> 2, c = 13 + 256 * (it & 3); float e = 0.f;
        for (int i = 0; i < 4; ++i) e += bf2f(G[(size_t)r * 4096 + i * 1024 + c]) * chk_dot(Y + (size_t)r * 1024 + 256 * i, WBR + ((size_t)i * 1024 + c) * 256, 256, C.lane);
        if (!chk_close(e, bf2f(MB[(size_t)r * 1024 + c]))) bad = 1; }
    chk_flag(C, bit, bad);
}
__device__ __forceinline__ void chk_swiglu(const Ctx& C, int bit) {
    const bf16_t* XB = WSP(bf16_t, W_XB); const bf16_t* W = WSP(bf16_t, W_FFN13); const bf16_t* H = WSP(bf16_t, S_H); unsigned bad = 0;
    for (int it = GW; it < T * 22; it += NGW) { const int r = it / 22, hc = 5 + 128 * (it % 22); const int grow = (hc >> 4) * 32 + (hc & 15);
        const float g = chk_dot(XB + (size_t)r * 1024, W + (size_t)grow * 1024, 1024, C.lane), u = chk_dot(XB + (size_t)r * 1024, W + (size_t)(grow + 16) * 1024, 1024, C.lane);
        if (!chk_close(siluf_(g) * u, bf2f(H[(size_t)r * FFD + hc]))) bad = 1; }
    chk_flag(C, bit, bad);
}

constexpr size_t S_CHKBUF = S_BASE + (size_t)400 * MiB;
__device__ __forceinline__ void chk_resid_stash(const Ctx& C, const bf16_t* A, int lda, const bf16_t* Bt, int ldb, int K, int slot) {
    const float* XR = WSP(float, W_XRES); float* CB = WSP(float, S_CHKBUF);
    for (int it = GW; it < T * 4; it += NGW) { const int r = it >> 2, q = it & 3, c = 17 + 256 * q; const float d = chk_dot(A + (size_t)r * lda, Bt + (size_t)c * ldb, K, C.lane);
        if (C.lane == 0) CB[(size_t)r * 8 + slot * 4 + q] = XR[(size_t)r * 1024 + c] * DN_ALPHA + d; }
}
__device__ __forceinline__ void chk_resid_cmp(const Ctx& C, int slot, int bit) {
    const float* XR = WSP(float, W_XRES); const float* CB = WSP(float, S_CHKBUF); unsigned bad = 0;
    for (int it = GW; it < T * 4; it += NGW) { const int r = it >> 2, q = it & 3, c = 17 + 256 * q; if (!chk_close(CB[(size_t)r * 8 + slot * 4 + q], XR[(size_t)r * 1024 + c])) bad = 1; }
    chk_flag(C, bit, bad);
}
__device__ __forceinline__ void chk_ln_stash(const Ctx& C, const float* g, const float* b, int slot) {
    const float* XR = WSP(float, W_XRES); float* CB = WSP(float, S_CHKBUF); const int lane = C.lane;
    for (int t = GW; t < T; t += NGW) { float s = 0.f, s2 = 0.f; float v[16];
        for (int j = 0; j < 16; ++j) { v[j] = XR[(size_t)t * 1024 + lane + 64 * j]; s += v[j]; }
        const float mean = wave_sum(s) * (1.0f / 1024.0f); for (int j = 0; j < 16; ++j) { const float d = v[j] - mean; s2 += d * d; }
        const float rstd = 1.0f / sqrtf(wave_sum(s2) * (1.0f / 1024.0f) + 1e-5f);
        if (lane < 4) { const int c = 17 + 256 * lane; CB[(size_t)t * 8 + slot * 4 + lane] = (XR[(size_t)t * 1024 + c] - mean) * rstd * g[c] + b[c]; } }
}
__device__ __forceinline__ void chk_ln_cmp(const Ctx& C, int slot, int bit) {
    const float* XR = WSP(float, W_XRES); const bf16_t* XB = WSP(bf16_t, W_XB); const float* CB = WSP(float, S_CHKBUF); unsigned bad = 0;
    for (int it = GW; it < T * 4; it += NGW) { const int r = it >> 2, q = it & 3, c = 17 + 256 * q; const float e = CB[(size_t)r * 8 + slot * 4 + q];
        if (!chk_close(e, XR[(size_t)r * 1024 + c]) || !chk_close(e, bf2f(XB[(size_t)r * 1024 + c]))) bad = 1; }
    chk_flag(C, bit, bad);
}

template <int NJ, bool MOE> __device__ __forceinline__ void chk_weights(const Ctx& C, int bit) {
    unsigned bad = 0; const int gt = C.bid * NTHREADS + C.tid, NT = C.G * NTHREADS;
    for (int j = 0; j < NJ; ++j) { const TJob J = MOE ? moe_job(C, j) : prologue_job(C, j);
        for (size_t i = gt; i < (size_t)J.K * J.N; i += NT) { const int k = (int)(i / J.N), n = (int)(i % J.N);
            const float sc = (J.map == 1 && n >= 256) ? 1.0f : J.scale; const bf16_t e = (bf16_t)(cvt_pk_bf16(J.W[(size_t)k * J.ldw + n] * sc, 0.f) & 0xffffu);
            if (J.WT[(size_t)tj_dest(J.map, n, J.N) * J.ldt + k] != e) bad = 1; } }
    if (bad) __hip_atomic_fetch_add((unsigned*)(C.ws + WS_CTL) + CW_CHK + 64 * bit, 1u, RLX_AGENT);
}

__device__ __forceinline__ void chk_mla_inputs(const Ctx& C, int l, int bit) {
    const bf16_t* proj = WSP(bf16_t, S_PROJ); const bf16_t* QM = WSP(bf16_t, S_QM); const bf16_t* KM = WSP(bf16_t, S_KM); const bf16_t* VM = WSP(bf16_t, S_VM);
    const float* wuq = C.in[I_WUQ] + (size_t)l * 256 * 384; const float* wukv = C.in[I_WUKV] + (size_t)l * 128 * 512; const float* qg = C.in[I_QNG] + l * 256; const float* kvg = C.in[I_KVNG] + l * 128;
    const int* pos = (const int*)C.in[I_POS]; const int lane = C.lane; unsigned bad = 0; const float qs = 0.10206207261596575f * LOG2E;
    for (int t = GW; t < T; t += NGW) {
        const bf16_t* pr = proj + (size_t)t * NPROJ; float cq[4], ck[2]; float ss = 0.f;
        for (int i = 0; i < 4; ++i) { cq[i] = bf2f(pr[PC_CQ + lane + 64 * i]); ss += cq[i] * cq[i]; }
        float rs = 1.0f / sqrtf(wave_sum(ss) * (1.0f / 256.0f) + 1e-6f); for (int i = 0; i < 4; ++i) cq[i] *= rs * qg[lane + 64 * i];
        ss = 0.f; for (int i = 0; i < 2; ++i) { ck[i] = bf2f(pr[PC_CKV + lane + 64 * i]); ss += ck[i] * ck[i]; }
        rs = 1.0f / sqrtf(wave_sum(ss) * (1.0f / 128.0f) + 1e-6f); for (int i = 0; i < 2; ++i) ck[i] *= rs * kvg[lane + 64 * i];
        const float ang = (float)pos[t] * exp2f(-6.0f * (13.287712379549449f / 32.0f)); const float c3 = cosf(ang), s3 = sinf(ang);
        const int h = t & 3;
        float qn = 0.f, q1 = 0.f, q2 = 0.f, kn = 0.f, vv = 0.f;
        for (int i = 0; i < 4; ++i) { const int k = lane + 64 * i; qn += cq[i] * wuq[(size_t)k * 384 + h * 96 + 5]; q1 += cq[i] * wuq[(size_t)k * 384 + h * 96 + 67]; q2 += cq[i] * wuq[(size_t)k * 384 + h * 96 + 83]; }
        for (int i = 0; i < 2; ++i) { const int k = lane + 64 * i; kn += ck[i] * wukv[(size_t)k * 512 + h * 128 + 7]; vv += ck[i] * wukv[(size_t)k * 512 + h * 128 + 64 + 9]; }
        qn = wave_sum(qn) * qs; q1 = wave_sum(q1) * qs; q2 = wave_sum(q2) * qs; kn = wave_sum(kn); vv = wave_sum(vv);
        const float kr1 = bf2f(pr[PC_KR + 3]), kr2 = bf2f(pr[PC_KR + 19]);
        const bf16_t* qrow = QM + (size_t)t * 384 + h * 96; const bf16_t* krow = KM + (size_t)t * 384 + h * 96;
        if (!chk_close(qn, bf2f(qrow[5])) || !chk_close(q1 * c3 - q2 * s3, bf2f(qrow[67])) || !chk_close(q1 * s3 + q2 * c3, bf2f(qrow[83])) || !chk_close(kn, bf2f(krow[7])) ||
            !chk_close(kr1 * c3 - kr2 * s3, bf2f(krow[67])) || !chk_close(kr1 * s3 + kr2 * c3, bf2f(krow[83])) || !chk_close(vv, bf2f(VM[(size_t)t * 256 + h * 64 + 9]))) bad = 1;
    }
    chk_flag(C, bit, bad);
}

__device__ __forceinline__ void chk_rw_inputs(const Ctx& C, int l, int bit) {
    const bf16_t* proj = WSP(bf16_t, S_PROJ); const float* DEC = WSP(float, S_DEC); const bf16_t* RWS = WSP(bf16_t, S_RWS); const bf16_t* GV = WSP(bf16_t, S_GV); const size_t PL = (size_t)T * 256;
    const float* mu = C.in[I_RWMU] + l * 1024; const float* w0 = C.in[I_RWW0] + l * 256; const float* a0 = C.in[I_RWA0] + l * 256;
    const float* wup = C.in[I_RWWUP] + l * 64 * 256; const float* aup = C.in[I_RWAUP] + l * 64 * 256; const float* gup = C.in[I_RWGUP] + l * 128 * 256;
    const float* kkw = C.in[I_RWKK] + l * 256; const float* kaw = C.in[I_RWKA] + l * 256; const int lane = C.lane; unsigned bad = 0;
    for (int t = GW; t < T; t += NGW) {
        const bf16_t* pr = proj + (size_t)t * NPROJ + PC_RW; const bool first = (t % SEQ) == 0; const int h = t & 3, c = h * 64 + 11;
        auto sh = [&](int col) { const float cur = bf2f(pr[col]); const float prv = first ? 0.f : bf2f(pr[col - NPROJ]); return cur + (prv - cur) * mu[col]; };
        float dw = tanhf(sh(768 + lane)) * wup[lane * 256 + c], da = sh(832 + lane) * aup[lane * 256 + c];
        float dg = (1.0f / (1.0f + expf(-sh(896 + lane)))) * gup[lane * 256 + c] + (1.0f / (1.0f + expf(-sh(960 + lane)))) * gup[(64 + lane) * 256 + c];
        dw = wave_sum(dw); da = wave_sum(da); dg = wave_sum(dg);
        const float xw = w0[c] + dw; const float wlog = -(fmaxf(-xw, 0.f) + log1pf(expf(-fabsf(xw)))) - 0.5f; const float dec = expf(-expf(wlog));
        const float a = 1.0f / (1.0f + expf(-(a0[c] + da)));
        const float kl = sh(256 + h * 64 + lane) * kkw[h * 64 + lane]; const float nrm = 1.0f / sqrtf(fmaxf(wave_sum(kl * kl), 1e-24f));
        const float r = sh(c), k = sh(256 + c), v = sh(512 + c); const float kk = k * kkw[c] * nrm, kmod = k * (1.0f + (a - 1.0f) * kaw[c]), ka = kk * a;
        const size_t o = (size_t)t * 256 + c;
        if (!chk_close(dec, DEC[o]) || fabsf(dec - DEC[o]) > 0.004f || !chk_close(r, bf2f(RWS[o])) || !chk_close(kmod, bf2f(RWS[PL + o])) || !chk_close(v, bf2f(RWS[2 * PL + o])) || !chk_close(kk, bf2f(RWS[3 * PL + o])) ||
            !chk_close(ka, bf2f(RWS[4 * PL + o])) || !chk_close(dg, bf2f(GV[o]))) bad = 1;
    }
    chk_flag(C, bit, bad);
}
__device__ __forceinline__ void chk_ssd_norm(const Ctx& C, int l, int bit) {
    const bf16_t* Y = WSP(bf16_t, S_Y); const float* ng = C.in[I_SSDNG] + l * 256; const int lane = C.lane; unsigned bad = 0;
    for (int t = GW; t < T; t += NGW) { float q = 0.f;
        for (int i = 0; i < 4; ++i) { const int c = (lane >> 5) * 128 + (lane & 31) * 4 + i; const float y = bf2f(Y[(size_t)t * 1024 + 512 + c]) / ng[c]; q += y * y; }
        for (int o_ = 1; o_ < 32; o_ <<= 1) q += __shfl_xor(q, o_);
        q *= (1.0f / 128.0f); if (q < 0.9f || q > 1.1f) bad = 1; }
    chk_flag(C, bit, bad);
}

#ifndef P7_COND
#define P7_COND 1
#endif
#ifndef P7_CLASS
#define P7_CLASS (((c & 31) < 16 ? 1u : 2u) | ((c & 255) < 128 ? 4u : 8u))
#endif
__device__ __forceinline__ float tdot(const bf16_t* a, const bf16_t* b, int K) { float d = 0.f;
    for (int k = 0; k < K; k += 8) { const u32x4 x = *(const u32x4*)(a + k), y = *(const u32x4*)(b + k);
        d += bflo(x.x) * bflo(y.x) + bfhi(x.x) * bfhi(y.x) + bflo(x.y) * bflo(y.y) + bfhi(x.y) * bfhi(y.y) + bflo(x.z) * bflo(y.z) + bfhi(x.z) * bfhi(y.z) + bflo(x.w) * bflo(y.w) + bfhi(x.w) * bfhi(y.w); }
    return d; }
__device__ __forceinline__ void chk_full_p7(const Ctx& C, int l, int bit) {
    const bf16_t* MB = WSP(bf16_t, S_MB); const bf16_t* W = (const bf16_t*)(C.ws + W_BASE + (size_t)l * LW_SIZE + LW_WOUT); const float* xin = C.in[I_X]; const float* XR = WSP(float, W_XRES); float num = 0.f, den = 0.f;
    for (size_t i = (size_t)C.bid * NTHREADS + C.tid; i < (size_t)T * 1024; i += (size_t)C.G * NTHREADS) { const size_t r = i >> 10; const int c = (int)(i & 1023);
        const float d = tdot(MB + r * 1024, W + (size_t)c * 1024, 1024), g = XR[i] - xin[i] * DN_ALPHA; num += (d - g) * (d - g); den += d * d; }
    num = wave_sum(num); den = wave_sum(den);
    if (C.lane == 0) { atomicAdd((float*)(C.ws + WS_CTL) + CW_CHK + 1024, num); atomicAdd((float*)(C.ws + WS_CTL) + CW_CHK + 1088, den); }
}
__device__ __forceinline__ void chk_full_merged(const Ctx& C, int l, int bit) {
    const bf16_t* Y = WSP(bf16_t, S_Y); const bf16_t* G = WSP(bf16_t, S_G); const bf16_t* MB = WSP(bf16_t, S_MB); const bf16_t* WBR = (const bf16_t*)(C.ws + W_BASE + (size_t)l * LW_SIZE + LW_WBR); unsigned bad = 0;
    for (size_t i = (size_t)C.bid * NTHREADS + C.tid; i < (size_t)T * 1024; i += (size_t)C.G * NTHREADS) { const size_t r = i >> 10; const int c = (int)(i & 1023); float e = 0.f;
        for (int q = 0; q < 4; ++q) e += bf2f(G[r * 4096 + q * 1024 + c]) * tdot(Y + r * 1024 + 256 * q, WBR + ((size_t)q * 1024 + c) * 256, 256);
        if (!chk_close(e, bf2f(MB[i]))) bad = 1; }
    if (bad) __hip_atomic_fetch_add((unsigned*)(C.ws + WS_CTL) + CW_CHK + 64 * bit, 1u, RLX_AGENT);
}

#ifndef FG_CLASS
#define FG_CLASS (1u << ((c >> 5) & 3))
#endif
template <class F> __device__ __forceinline__ void chk_full_gemm(const Ctx& C, const bf16_t* A, const bf16_t* Bt, int K, int N, int bit, F ok) {
    unsigned bad = 0, cntbad = 0;
    for (size_t i = (size_t)C.bid * NTHREADS + C.tid; i < (size_t)T * N; i += (size_t)C.G * NTHREADS) { const size_t r = i / N; const int c = (int)(i % N);
        if (!ok(r, c, tdot(A + r * K, Bt + (size_t)c * K, K))) { bad |= (bit < 0) ? (FG_CLASS) : (1u << bit); ++cntbad; } }
#ifdef FG_COUNT
    if (cntbad) __hip_atomic_fetch_add((unsigned*)(C.ws + WS_CTL) + CW_CHK + 2048, cntbad, RLX_AGENT);
#else
    for (int q = 0; q < 4; ++q) if ((bad >> q) & 1) __hip_atomic_fetch_add((unsigned*)(C.ws + WS_CTL) + CW_CHK + 64 * q, 1u, RLX_AGENT);
#endif
}
__device__ __forceinline__ void ph_prologue(const Ctx& C) {
    run_tjobs<28, false>(C);
    const int gt = C.bid * NTHREADS + C.tid, NT = C.G * NTHREADS;
    for (int l = 0; l < 2; ++l) {
        unsigned char* LW = C.ws + W_BASE + (size_t)l * LW_SIZE;
        bf16_t* lora = (bf16_t*)(LW + LW_LORA); const float* wup = C.in[I_RWWUP] + l * 64 * 256; const float* aup = C.in[I_RWAUP] + l * 64 * 256; const float* gup = C.in[I_RWGUP] + l * 128 * 256;
        for (int i = gt; i < 768 * 256; i += NT) { const int n = i >> 8, k = i & 255; float v = 0.f;
            if (n < 256) { if (k < 64) v = wup[k * 256 + n]; } else if (n < 512) { if (k >= 64 && k < 128) v = aup[(k - 64) * 256 + (n - 256)]; } else { if (k >= 128) v = gup[(k - 128) * 256 + (n - 512)]; }
            lora[i] = (bf16_t)(cvt_pk_bf16(v, 0.f) & 0xffffu); }
        bf16_t* wuq = (bf16_t*)(LW + LW_WUQ); const float* suq = C.in[I_WUQ] + l * 256 * 384;
        for (int i = gt; i < 512 * 256; i += NT) { const int n = i >> 8, k = i & 255; const float v = n < 384 ? suq[k * 384 + n] * (0.10206207261596575f * LOG2E) : 0.f; wuq[i] = (bf16_t)(cvt_pk_bf16(v, 0.f) & 0xffffu); }
        bf16_t* wukv = (bf16_t*)(LW + LW_WUKV); const float* sukv = C.in[I_WUKV] + l * 128 * 512;
        for (int i = gt; i < 512 * 128; i += NT) { const int n = i >> 7, k = i & 127; wukv[i] = (bf16_t)(cvt_pk_bf16(sukv[k * 512 + n], 0.f) & 0xffffu); }
        bf16_t* win = (bf16_t*)(LW + LW_WIN);
        for (int i = gt; i < (NPROJ - 3236) * 1024; i += NT) win[(size_t)3236 * 1024 + i] = 0;
    }
    { const float* x = C.in[I_X]; bf16_t* xb = WSP(bf16_t, W_XB);
      for (size_t i = gt; i < (size_t)T * 1024 / 8; i += NT) { const f32x4 a = *(const f32x4*)(x + i * 8), b = *(const f32x4*)(x + i * 8 + 4); *(u32x4*)(xb + i * 8) = epi::pack8(a, b); }
      const float* mm = C.in[I_MEM]; bf16_t* mb = WSP(bf16_t, W_MEMB);
      for (size_t i = gt; i < (size_t)NMEM * 1024 / 8; i += NT) { const f32x4 a = *(const f32x4*)(mm + i * 8), b = *(const f32x4*)(mm + i * 8 + 4); *(u32x4*)(mb + i * 8) = epi::pack8(a, b); } }
    { const int* pos = (const int*)C.in[I_POS]; float* ct = WSP(float, W_COS); float* st = WSP(float, W_SIN);
      for (int i = gt; i < T * 16; i += NT) { const int t = i >> 4, j = i & 15; const float inv = exp2f(-(float)(2 * j) * (13.287712379549449f / 32.0f)); const float ang = (float)pos[t] * inv; ct[i] = cosf(ang); st[i] = sinf(ang); } }
}

__device__ __forceinline__ f32x4 ld_bf4(const bf16_t* p) { const u32x2 w = *(const u32x2*)p; return (f32x4){bflo(w.x), bfhi(w.x), bflo(w.y), bfhi(w.y)}; }
__device__ __forceinline__ void st_bf4(bf16_t* p, const f32x4 v) { u32x2 w; w.x = cvt_pk_bf16(v[0], v[1]); w.y = cvt_pk_bf16(v[2], v[3]); *(u32x2*)p = w; }
__device__ __forceinline__ float tanhf_(float x) { return 1.0f - 2.0f * frcp(1.0f + fexp2(2.0f * LOG2E * x)); }
__device__ __forceinline__ void ph_prep(const Ctx& C, int l) {
    const bf16_t* __restrict__ proj = WSP(bf16_t, S_PROJ); const float* mu = C.in[I_RWMU] + l * 1024;
    bf16_t* __restrict__ LA = WSP(bf16_t, S_LA); bf16_t* __restrict__ CQN = WSP(bf16_t, S_CQN); bf16_t* __restrict__ CKVN = WSP(bf16_t, S_CKVN); bf16_t* __restrict__ KM = WSP(bf16_t, S_KM);
    const float* qg = C.in[I_QNG] + l * 256; const float* kvg = C.in[I_KVNG] + l * 128; const float* ct = WSP(float, W_COS); const float* st = WSP(float, W_SIN);
    const int lane = C.lane;
    for (int t = GW; t < T; t += NGW) {
        const bf16_t* pr = proj + (size_t)t * NPROJ; const bool first = (t % SEQ) == 0;
        { const int c = 4 * lane; const f32x4 cur = ld_bf4(pr + PC_RW + 768 + c); const f32x4 prv = first ? (f32x4){0.f, 0.f, 0.f, 0.f} : ld_bf4(pr - NPROJ + PC_RW + 768 + c);
          const f32x4 m = *(const f32x4*)(mu + 768 + c); f32x4 p = cur + (prv - cur) * m;
          if (c < 64) { for (int j = 0; j < 4; ++j) p[j] = tanhf_(p[j]); } else if (c >= 128) { for (int j = 0; j < 4; ++j) p[j] = sigmoidf_(p[j]); }
          st_bf4(LA + (size_t)t * 256 + c, p); }
        { const int c = 4 * lane; f32x4 v = ld_bf4(pr + PC_CQ + c); const float ss = wave_sum((v[0] * v[0] + v[1] * v[1]) + (v[2] * v[2] + v[3] * v[3]));
          const float rs = 1.0f / sqrtf(ss * (1.0f / 256.0f) + 1e-6f); v = v * rs * *(const f32x4*)(qg + c); st_bf4(CQN + (size_t)t * 256 + c, v); }
        { const int c = 2 * lane; const unsigned w = *(const unsigned*)(pr + PC_CKV + c); float a = bflo(w), b = bfhi(w); const float ss = wave_sum(a * a + b * b);
          const float rs = 1.0f / sqrtf(ss * (1.0f / 128.0f) + 1e-6f); a *= rs * kvg[c]; b *= rs * kvg[c + 1]; *(unsigned*)(CKVN + (size_t)t * 128 + c) = cvt_pk_bf16(a, b); }
        { const float v = bf2f(pr[PC_KR + (lane & 31)]); const float o = __shfl_xor(v, 16); const int i = lane & 15; const float cs = ct[t * 16 + i], sn = st[t * 16 + i];
          const float r = (lane & 16) ? (o * sn + v * cs) : (v * cs - o * sn);
          if (lane < 32) { const bf16_t rb = (bf16_t)(cvt_pk_bf16(r, 0.f) & 0xffffu); for (int h = 0; h < 4; ++h) KM[(size_t)t * 384 + h * 96 + 64 + lane] = rb; } }
    }
}
__device__ __forceinline__ void ph_rwprep(const Ctx& C, int l) {
#if defined(NAIVE_SCAN)
    if (NAIVE_SCAN & 2) { float* q_ = WSP(float, S_SSQ); for (int i = C.bid * NTHREADS + C.tid; i < T * 8; i += C.G * NTHREADS) q_[i] = 0.f; }
#endif
    const bf16_t* __restrict__ proj = WSP(bf16_t, S_PROJ); const float* mu = C.in[I_RWMU] + l * 1024; const bf16_t* __restrict__ AV = WSP(bf16_t, S_AV); bf16_t* __restrict__ RWS = WSP(bf16_t, S_RWS);
    const float* kkw = C.in[I_RWKK] + l * 256; const float* kaw = C.in[I_RWKA] + l * 256; const int lane = C.lane, c = 4 * lane;
    for (int t = GW; t < T; t += NGW) {
        const bf16_t* pr = proj + (size_t)t * NPROJ + PC_RW; const bool first = (t % SEQ) == 0; f32x4 rkv[3];
#pragma unroll
        for (int q = 0; q < 3; ++q) { const f32x4 cur = ld_bf4(pr + q * 256 + c); const f32x4 prv = first ? (f32x4){0.f, 0.f, 0.f, 0.f} : ld_bf4(pr - NPROJ + q * 256 + c); rkv[q] = cur + (prv - cur) * *(const f32x4*)(mu + q * 256 + c); }
        const f32x4 a = ld_bf4(AV + (size_t)t * 256 + c); f32x4 kk = rkv[1] * *(const f32x4*)(kkw + c);
        float ss = (kk[0] * kk[0] + kk[1] * kk[1]) + (kk[2] * kk[2] + kk[3] * kk[3]);
        ss = row_sum16(ss);
        kk = kk * (1.0f / sqrtf(fmaxf(ss, 1e-24f)));
        const f32x4 kmod = rkv[1] * ((a - 1.0f) * *(const f32x4*)(kaw + c) + 1.0f), ka = kk * a;
        const size_t o = (size_t)t * 256 + c, PL = (size_t)T * 256;
        st_bf4(RWS + o, rkv[0]); st_bf4(RWS + PL + o, kmod); st_bf4(RWS + 2 * PL + o, rkv[2]); st_bf4(RWS + 3 * PL + o, kk); st_bf4(RWS + 4 * PL + o, ka);
    }
}
__device__ __forceinline__ void ph_ssdprep(const Ctx& C, int l) {
    const bf16_t* __restrict__ proj = WSP(bf16_t, S_PROJ); bf16_t* __restrict__ XA = WSP(bf16_t, S_XA); bf16_t* __restrict__ BC = WSP(bf16_t, S_BC); bf16_t* __restrict__ CC = WSP(bf16_t, S_CC); float* __restrict__ ACS = WSP(float, S_ACS); float* __restrict__ DTV = WSP(float, S_DTV);
    const float* cw = C.in[I_CONVW] + l * 4 * 768; const float* cb = C.in[I_CONVB] + l * 768; const float* dtbp = C.in[I_DTB] + l * 4; const float* alog = C.in[I_ALOG] + l * 4; const int lane = C.lane;
    for (int item = GW; item < 64; item += NGW) { const int b = item >> 2, h = item & 3; const float dtb = dtbp[h], a2 = -expf(alog[h]) * LOG2E; const size_t t0 = (size_t)b * SEQ + lane;
        float carry = 0.f;
#pragma unroll 4
        for (int c = 0; c < SEQ / 64; ++c) { float v = softplusf_(bf2f(proj[(t0 + 64 * c) * NPROJ + PC_DT + h]) + dtb) * a2;
#pragma unroll
            for (int d = 1; d < 64; d <<= 1) { const float o = __shfl_up(v, d); if (lane >= d) v += o; }
            v += carry; ACS[(t0 + 64 * c) * 4 + h] = v; carry = __shfl(v, 63); } }
    for (int t = GW; t < T; t += NGW) { const int tl = t % SEQ;
#pragma unroll
        for (int j = 0; j < 3; ++j) { const int c = 4 * lane + 256 * j; f32x4 a = *(const f32x4*)(cb + c);
#pragma unroll
            for (int k = 0; k < 4; ++k) { if (tl - 3 + k >= 0) a += ld_bf4(proj + (size_t)(t - 3 + k) * NPROJ + PC_XS + c) * *(const f32x4*)(cw + k * 768 + c); }
            for (int q = 0; q < 4; ++q) a[q] = siluf_(a[q]);
            st_bf4((j == 0 ? XA : (j == 1 ? BC : CC)) + (size_t)t * 256 + 4 * lane, a); }
        if (lane < 4) DTV[(size_t)t * 4 + lane] = softplusf_(bf2f(proj[(size_t)t * NPROJ + PC_DT + lane]) + dtbp[lane]);
    }
}
#ifndef ABL_MOE
#define ABL_MOE 1.0f
#endif
template <bool MOE> __device__ __forceinline__ void ph_ln(const Ctx& C, const float* src, float* dst, bf16_t* dstb, const float* g, const float* b, const bf16_t* ys) {
    const int lane = C.lane;
    float chkscale = 1.0f;
#if defined(CHECKS) || defined(CHECKS2) || defined(CHECKS3) || defined(CHECKS4) || defined(CHECKS5) || defined(CHECKS6) || defined(CHECKS7) || defined(CHECKS8) || defined(CHECKS9) || defined(CHECKS10) || defined(CHECKS12) || defined(CHECKS13) || defined(CHECKS14) || defined(CHECKS15)
    if (MOE) { const unsigned* cw = (const unsigned*)(C.ws + WS_CTL) + CW_CHK; int n = 0;
        for (int q = 0; q < 4; ++q) if (__hip_atomic_load(cw + 64 * q, RLX_AGENT) != 0u) n |= 1 << q;
#if defined(FG_COUNT) || defined(CHECKS13) || defined(CHECKS15)
        { unsigned v_ = __hip_atomic_load(cw + 2048, RLX_AGENT); n = 0; while (v_ > 0u) { ++n; v_ >>= 1; } }
#endif
#ifdef CHECKS10
        { const float num = __uint_as_float(__hip_atomic_load(cw + 1024, RLX_AGENT)), den = __uint_as_float(__hip_atomic_load(cw + 1088, RLX_AGENT)); const float lr = -log2f(fmaxf(num / fmaxf(den, 1e-30f), 1e-12f)); n = (int)(lr + 0.5f); n = n < 0 ? 0 : (n > 31 ? 31 : n); }
#endif
        chkscale = 1.0f + 0.1f * (float)n; }
#endif
    for (int t = GW; t < T; t += NGW) {
        f32x4 v[4]; float s = 0.f;
#pragma unroll
        for (int j = 0; j < 4; ++j) { v[j] = *(const f32x4*)(src + (size_t)t * 1024 + 4 * lane + 256 * j);
            if (MOE) { const f32x4 y0 = ld_bf4(ys + (size_t)(2 * t) * 1024 + 4 * lane + 256 * j), y1 = ld_bf4(ys + (size_t)(2 * t + 1) * 1024 + 4 * lane + 256 * j); v[j] = v[j] * DN_ALPHA + (y0 + y1) * ABL_MOE; }
            s += (v[j][0] + v[j][1]) + (v[j][2] + v[j][3]); }
        const float mean = wave_sum(s) * (1.0f / 1024.0f); float s2 = 0.f;
#pragma unroll
        for (int j = 0; j < 4; ++j) { v[j] = v[j] - mean; s2 += (v[j][0] * v[j][0] + v[j][1] * v[j][1]) + (v[j][2] * v[j][2] + v[j][3] * v[j][3]); }
        const float rstd = 1.0f / sqrtf(wave_sum(s2) * (1.0f / 1024.0f) + 1e-5f);
#pragma unroll
        for (int j = 0; j < 4; ++j) { const int c = 4 * lane + 256 * j; const f32x4 o = (v[j] * rstd * *(const f32x4*)(g + c) + *(const f32x4*)(b + c)) * chkscale;
            if (dst) *(f32x4*)(dst + (size_t)t * 1024 + c) = o; if (dstb) st_bf4(dstb + (size_t)t * 1024 + c, o); }
    }
}
__device__ __forceinline__ void ph_ssdfix(const Ctx& C, int l) {
    bf16_t* Y = WSP(bf16_t, S_Y); const float* ssq = WSP(float, S_SSQ); const float* ng = C.in[I_SSDNG] + l * 256; const int lane = C.lane, c = 4 * lane, g = lane >> 5;
    const bf16_t* YRAW = WSP(bf16_t, S_YRAW); const bf16_t* RWS = WSP(bf16_t, S_RWS); const bf16_t* GV = WSP(bf16_t, S_GV); const size_t PL = (size_t)T * 256;
    const f32x4 rk = *(const f32x4*)(C.in[I_RWRK] + l * 256 + c), gng = *(const f32x4*)(C.in[I_RWGNG] + l * 256 + c), gnb = *(const f32x4*)(C.in[I_RWGNB] + l * 256 + c);
    for (int t = GW; t < T; t += NGW) {
        const float q = (ssq[t * 8 + 4 * g] + ssq[t * 8 + 4 * g + 1]) + (ssq[t * 8 + 4 * g + 2] + ssq[t * 8 + 4 * g + 3]); const float rs = 1.0f / sqrtf(q * (1.0f / 128.0f) + 1e-5f);
        bf16_t* p = Y + (size_t)t * 1024 + 512 + c; f32x4 v = ld_bf4(p); v = v * rs * *(const f32x4*)(ng + c); st_bf4(p, v);
#ifndef RW_NAIVE_OUT
        {   const size_t o = (size_t)t * 256 + c; const f32x4 yv = ld_bf4(YRAW + o), rr = ld_bf4(RWS + o), km = ld_bf4(RWS + PL + o), vv = ld_bf4(RWS + 2 * PL + o), gg = ld_bf4(GV + o);
            float sm = (yv[0] + yv[1]) + (yv[2] + yv[3]), bd = (rr[0] * km[0] * rk[0] + rr[1] * km[1] * rk[1]) + (rr[2] * km[2] * rk[2] + rr[3] * km[3] * rk[3]);
            sm = row_sum16(sm); bd = row_sum16(bd);
            const float mu = sm * (1.0f / 64.0f); const f32x4 d = yv - mu; float vs = (d[0] * d[0] + d[1] * d[1]) + (d[2] * d[2] + d[3] * d[3]);
            vs = row_sum16(vs);
            const float rstd = 1.0f / sqrtf(vs * (1.0f / 64.0f) + 64e-5f);
            st_bf4(Y + (size_t)t * 1024 + 256 + c, ((d * rstd) * gng + gnb + vv * bd) * gg); }
#endif
    }
}
typedef __bf16 bfx8 __attribute__((ext_vector_type(8)));
__device__ __forceinline__ f32x16 mfma32(const bf16x8 a, const bf16x8 b, const f32x16 c) { return __builtin_amdgcn_mfma_f32_32x32x16_bf16(__builtin_bit_cast(bfx8, a), __builtin_bit_cast(bfx8, b), c, 0, 0, 0); }
__device__ __forceinline__ float dpp_xor1(float v) { return __builtin_bit_cast(float, __builtin_amdgcn_mov_dpp(__builtin_bit_cast(int, v), 0xB1, 0xf, 0xf, true)); }
__device__ __forceinline__ float dpp_xor2(float v) { return __builtin_bit_cast(float, __builtin_amdgcn_mov_dpp(__builtin_bit_cast(int, v), 0x4E, 0xf, 0xf, true)); }
__device__ __forceinline__ float dpp_hmir(float v) { return __builtin_bit_cast(float, __builtin_amdgcn_mov_dpp(__builtin_bit_cast(int, v), 0x141, 0xf, 0xf, true)); }
__device__ __forceinline__ float sum8(float v) { v += dpp_xor1(v); v += dpp_xor2(v); v += dpp_hmir(v); return v; }

template <int MODE>
__device__ __forceinline__ void attn_unit(const Ctx& C0_, int l, int b, int h, int qb) {
    const Ctx C = launder(C0_);
    constexpr int DQK = MODE == 2 ? 128 : (MODE == 1 ? 96 : 64), NS = DQK / 16, KST = DQK * 2 + 16, VST = 192, KCH = DQK / 8;
    const bf16_t *Qp, *Kp, *Vp; int qs, ks, vs, ycol;
    if (MODE == 0) { const bf16_t* proj = WSP(bf16_t, S_PROJ); Qp = proj + PC_SBQ + h * 64; Kp = proj + PC_SBK + h * 64; Vp = proj + PC_SBV + h * 64; qs = ks = vs = NPROJ; ycol = h * 64; }
    else if (MODE == 1) { Qp = WSP(bf16_t, S_QM) + h * 96; Kp = WSP(bf16_t, S_KM) + h * 96; Vp = WSP(bf16_t, S_VM) + h * 64; qs = ks = 384; vs = 256; ycol = 768 + h * 64; }
    else { Qp = WSP(bf16_t, S_CC) + (h >> 1) * 128; Kp = WSP(bf16_t, S_BC) + (h >> 1) * 128; Vp = WSP(bf16_t, S_XA) + h * 64; qs = ks = vs = 256; ycol = 512 + h * 64; }
    const float* ACS = WSP(float, S_ACS); const float* DTV = WSP(float, S_DTV);
    const size_t tb = (size_t)b * SEQ;
    constexpr int ABUF = 64 * KST + 64 * VST + 512;
    LAS unsigned char* const abase = C.lds;
    const int tid = C.tid, lane = C.lane, w = C.wave, r = lane & 31, hh = lane >> 5;
    const int Q0 = qb * 256, qidx = Q0 + 32 * w + r, qmin = Q0 + 32 * w, qmax = qmin + 31;
    bf16x8 qf[NS];
#pragma unroll
    for (int s = 0; s < NS; ++s) qf[s] = *(const bf16x8*)(Qp + (tb + qidx) * qs + 16 * s + 8 * hh);
    f32x16 o[2]; for (int i = 0; i < 16; ++i) { o[0][i] = 0.f; o[1][i] = 0.f; }
    float Rrun = 0.f, mrun = -1.0e30f, lsum = 0.f;
    const int pr = (r & ~12) | ((r & 4) << 1) | ((r & 8) >> 1);
    u32x4 kreg0, kreg1, vreg; const int krow0 = tid / KCH, kch0 = tid % KCH, krow1 = (tid + 512) / KCH, kch1 = (tid + 512) % KCH, vrow = tid >> 3, vch = tid & 7;
    const bool k1 = (MODE == 2) || ((MODE == 1) && (tid < 64 * KCH - 512));
    float areg = 0.f, dreg = 0.f; float aq = 0.f; if (MODE == 2) aq = ACS[(tb + qidx) * 4 + h];
    const int ktmax = 4 * qb + 3;
#define ATT_LOAD(kt) do { const size_t kb_ = tb + (size_t)(kt) * 64; kreg0 = *(const u32x4*)(Kp + (kb_ + krow0) * ks + kch0 * 8); if (k1) kreg1 = *(const u32x4*)(Kp + (kb_ + krow1) * ks + kch1 * 8); \
        vreg = *(const u32x4*)(Vp + (kb_ + vrow) * vs + vch * 8); if (MODE == 2 && tid < 64) { areg = ACS[(kb_ + tid) * 4 + h]; dreg = DTV[(kb_ + tid) * 4 + h]; } } while (0)
#define ATT_STORE(bi) do { LAS unsigned char* Kt_ = abase + (bi) * ABUF; LAS unsigned char* Vt_ = Kt_ + 64 * KST; \
        *(LAS u32x4*)(Kt_ + krow0 * KST + kch0 * 16) = kreg0; if (k1) *(LAS u32x4*)(Kt_ + krow1 * KST + kch1 * 16) = kreg1; \
        *(LAS u32x4*)(Vt_ + vrow * VST + vch * 16) = vreg; if (MODE == 2 && tid < 64) { ((LAS float*)(Vt_ + 64 * VST))[tid] = areg; ((LAS float*)(Vt_ + 64 * VST))[64 + tid] = dreg; } } while (0)
    __syncthreads();
    ATT_LOAD(ktmax); ATT_STORE(0); if (ktmax > 0) ATT_LOAD(ktmax - 1);
    __syncthreads();
    for (int kt = ktmax; kt >= 0; --kt) {
        const int bi = (ktmax - kt) & 1;
        LAS unsigned char* Kt = abase + bi * ABUF; LAS unsigned char* Vt = Kt + 64 * KST; LAS float* AkL = (LAS float*)(Vt + 64 * VST); LAS float* DkL = AkL + 64;
        const unsigned vt_addr = (unsigned)(size_t)Vt;
        if (kt > 0) { ATT_STORE(bi ^ 1); if (kt > 1) ATT_LOAD(kt - 2); }
        const int k0 = kt * 64;
        if (k0 <= qmax) {
        const bool need_mask = (k0 + 63 >= qmin);
        f32x16 sc[2];
#pragma unroll
        for (int sub = 0; sub < 2; ++sub) {
            for (int i = 0; i < 16; ++i) sc[sub][i] = 0.f;
#pragma unroll
            for (int s = 0; s < NS; ++s) { const bf16x8 kf = *(const LAS bf16x8*)(Kt + (32 * sub + pr) * KST + (16 * s + 8 * hh) * 2); sc[sub] = mfma32(kf, qf[s], sc[sub]); }
        }
        if (MODE == 0) {
#pragma unroll
            for (int sub = 1; sub >= 0; --sub) {
                const int kb = k0 + 32 * sub + 8 * hh;
                float L[16];
#pragma unroll
                for (int i = 0; i < 16; ++i) { const float z = sc[sub][i]; const int key = kb + (i & 7) + 16 * (i >> 3); const bool ok = !need_mask || key < qidx;
                    const float l2 = -(fmaxf(z, 0.f) + flog2(1.0f + fexp2(-fabsf(z)))); L[i] = ok ? l2 : 0.f; sc[sub][i] = ok ? z + l2 : -1.0e30f; }
                float own_hi = 0.f, own_lo = 0.f, tl[16];
#pragma unroll
                for (int j = 7; j >= 0; --j) { tl[8 + j] = own_hi; own_hi += L[8 + j]; tl[j] = own_lo; own_lo += L[j]; }
                const float p_hi = __shfl_xor(own_hi, 32), p_lo = __shfl_xor(own_lo, 32);
                const float off_hi = Rrun + (hh ? 0.f : p_hi), off_lo = Rrun + own_hi + p_hi + (hh ? 0.f : p_lo);
                Rrun += (own_hi + own_lo) + (p_hi + p_lo);
#pragma unroll
                for (int i = 0; i < 16; ++i) sc[sub][i] = fexp2(sc[sub][i] + tl[i] + (i >= 8 ? off_hi : off_lo));
            }
        } else if (MODE == 2) {
#pragma unroll
            for (int sub = 0; sub < 2; ++sub) { f32x4 ak[4], dk[4];
#pragma unroll
                for (int r4 = 0; r4 < 4; ++r4) { const int o_ = 32 * sub + 8 * hh + 16 * (r4 >> 1) + 4 * (r4 & 1); ak[r4] = *(const LAS f32x4*)(AkL + o_); dk[r4] = *(const LAS f32x4*)(DkL + o_); }
#pragma unroll
                for (int i = 0; i < 16; ++i) { const int key = k0 + 32 * sub + 8 * hh + (i & 7) + 16 * (i >> 3); const bool ok = !need_mask || key <= qidx;
                    const float a_ = ak[(i >> 3) * 2 + ((i & 7) >> 2)][i & 3], d_ = dk[(i >> 3) * 2 + ((i & 7) >> 2)][i & 3];
                    const float pv = sc[sub][i] * d_ * fexp2(fminf(aq - a_, 0.f)); sc[sub][i] = ok ? pv : 0.f; } }
        } else {
            float tm = -1.0e30f;
#pragma unroll
            for (int sub = 0; sub < 2; ++sub)
#pragma unroll
                for (int i = 0; i < 16; ++i) { const int key = k0 + 32 * sub + 8 * hh + (i & 7) + 16 * (i >> 3); const bool ok = !need_mask || key <= qidx; const float z = ok ? sc[sub][i] : -1.0e30f; sc[sub][i] = z; tm = fmaxf(tm, z); }
            tm = fmaxf(tm, __shfl_xor(tm, 32));
            const float mnew = fmaxf(mrun, tm), alpha = fexp2(mrun - mnew); mrun = mnew;
            float ps = 0.f;
#pragma unroll
            for (int sub = 0; sub < 2; ++sub)
#pragma unroll
                for (int i = 0; i < 16; ++i) { const float p = fexp2(sc[sub][i] - mnew); sc[sub][i] = p; ps += p; }
            lsum = lsum * alpha + ps;
#pragma unroll
            for (int i = 0; i < 16; ++i) { o[0][i] *= alpha; o[1][i] *= alpha; }
        }
#pragma unroll
        for (int sub = 0; sub < 2; ++sub)
#pragma unroll
            for (int s = 0; s < 2; ++s) {
                bf16x8 pf; { u32x4 pw; pw.x = cvt_pk_bf16(sc[sub][8 * s + 0], sc[sub][8 * s + 1]); pw.y = cvt_pk_bf16(sc[sub][8 * s + 2], sc[sub][8 * s + 3]); pw.z = cvt_pk_bf16(sc[sub][8 * s + 4], sc[sub][8 * s + 5]); pw.w = cvt_pk_bf16(sc[sub][8 * s + 6], sc[sub][8 * s + 7]); pf = __builtin_bit_cast(bf16x8, pw); }
                const unsigned a0 = vt_addr + (unsigned)((32 * sub + 16 * s + 8 * hh + ((lane & 15) >> 2)) * VST + (16 * ((lane >> 4) & 1) + 4 * (lane & 3)) * 2);
                u32x2 v00, v01, v10, v11;
                asm volatile("ds_read_b64_tr_b16 %0, %4\n\tds_read_b64_tr_b16 %1, %4 offset:768\n\tds_read_b64_tr_b16 %2, %4 offset:64\n\tds_read_b64_tr_b16 %3, %4 offset:832\n\ts_waitcnt lgkmcnt(0)"
                             : "=&v"(v00), "=&v"(v01), "=&v"(v10), "=&v"(v11) : "v"(a0) : "memory");
                u32x4 va0; va0.x = v00.x; va0.y = v00.y; va0.z = v01.x; va0.w = v01.y;
                u32x4 va1; va1.x = v10.x; va1.y = v10.y; va1.z = v11.x; va1.w = v11.y;
                o[0] = mfma32(__builtin_bit_cast(bf16x8, va0), pf, o[0]);
                o[1] = mfma32(__builtin_bit_cast(bf16x8, va1), pf, o[1]);
            }
        }
        bool dead = false;
        if (MODE == 0) dead = Rrun < -64.0f;
        if (MODE == 2) dead = aq - AkL[0] < -64.0f;
        if (MODE == 1) { __syncthreads(); }
        else { volatile LAS unsigned* votes = (volatile LAS unsigned*)(C.lds + LDSCTL_OFF + 128) + 8 * bi;
            const bool wdead = __all(dead ? 1 : 0); if (lane == 0) votes[w] = wdead ? 1u : 0u;
            __syncthreads();
            unsigned all_ = 1u;
#pragma unroll
            for (int q_ = 0; q_ < 8; ++q_) all_ &= votes[q_];
            if (all_) break; }
    }
#undef ATT_LOAD
#undef ATT_STORE
    float inv = 1.0f;
    if (MODE == 1) { const float lt = lsum + __shfl_xor(lsum, 32); inv = frcp(lt); }
    bf16_t* Y = WSP(bf16_t, S_Y) + (tb + qidx) * 1024 + ycol;
    if (MODE == 2) {
        const float dsk = C.in[I_SSDD][l * 4 + h]; const bf16_t* xa = Vp + (tb + qidx) * 256; const bf16_t* zp = WSP(bf16_t, S_PROJ) + (tb + qidx) * NPROJ + PC_Z + h * 64; float q_ = 0.f;
#pragma unroll
        for (int dt = 0; dt < 2; ++dt)
#pragma unroll
            for (int g = 0; g < 4; ++g) { const int d0 = 32 * dt + 8 * g + 4 * hh; const f32x4 xv = ld_bf4(xa + d0), zv = ld_bf4(zp + d0); f32x4 y;
                for (int j = 0; j < 4; ++j) { y[j] = (o[dt][4 * g + j] + dsk * xv[j]) * siluf_(zv[j]); q_ += y[j] * y[j]; }
                st_bf4(Y + d0, y); }
        q_ += __shfl_xor(q_, 32);
        if (hh == 0) { float* SSQ = WSP(float, S_SSQ); SSQ[(tb + qidx) * 8 + h * 2] = q_; SSQ[(tb + qidx) * 8 + h * 2 + 1] = 0.f; }
        return;
    }
#pragma unroll
    for (int dt = 0; dt < 2; ++dt)
#pragma unroll
        for (int g = 0; g < 4; ++g) { u32x2 wv; wv.x = cvt_pk_bf16(o[dt][4 * g] * inv, o[dt][4 * g + 1] * inv); wv.y = cvt_pk_bf16(o[dt][4 * g + 2] * inv, o[dt][4 * g + 3] * inv);
            *(u32x2*)(Y + 32 * dt + 8 * g + 4 * hh) = wv; }
}

__device__ __forceinline__ float sum16(float v) { v = sum8(v); v += __builtin_bit_cast(float, __builtin_amdgcn_mov_dpp(__builtin_bit_cast(int, v), 0x140, 0xf, 0xf, true)); return v; }
__device__ __forceinline__ void rwkv_unit(const Ctx& C0_, int l, int b, int h, int half) {
    const Ctx C = launder(C0_);
    constexpr int TB = 32, NBLK = SEQ / TB, BUFB = 6 * TB * 64 * 4;
    LAS float* buf0 = (LAS float*)C.lds; LAS float* ybuf = (LAS float*)(C.lds + 2 * BUFB);
    const int tid = C.tid, il = tid >> 4, q = tid & 15, i = 32 * half + il;
    const float* DEC = WSP(float, S_DEC); const bf16_t* RWS = WSP(bf16_t, S_RWS); bf16_t* YRAW = WSP(bf16_t, S_YRAW);
    const size_t PL = (size_t)T * 256; const size_t tb = (size_t)b * SEQ;
    const int ls = tid >> 4, lj = 4 * (tid & 15);
    f32x4 gw; u32x2 gr[5];
#define RW_LOAD(blk) do { const size_t o_ = (tb + (size_t)(blk) * TB + ls) * 256 + h * 64 + lj; gw = *(const f32x4*)(DEC + o_); \
        gr[0] = *(const u32x2*)(RWS + 3 * PL + o_); gr[1] = *(const u32x2*)(RWS + 4 * PL + o_); gr[2] = *(const u32x2*)(RWS + PL + o_); gr[3] = *(const u32x2*)(RWS + o_); gr[4] = *(const u32x2*)(RWS + 2 * PL + o_); } while (0)
#define RW_STORE(bufp) do { LAS float* d_ = (bufp) + ls * 64 + lj; *(LAS f32x4*)d_ = gw; \
        _Pragma("unroll") for (int a_ = 0; a_ < 5; ++a_) *(LAS f32x4*)(d_ + (a_ + 1) * TB * 64) = (f32x4){bflo(gr[a_].x), bfhi(gr[a_].x), bflo(gr[a_].y), bfhi(gr[a_].y)}; } while (0)
    f32x4 S = (f32x4){0.f, 0.f, 0.f, 0.f};
    __syncthreads();
    RW_LOAD(0); RW_STORE(buf0);
    __syncthreads();
    for (int blk = 0; blk < NBLK; ++blk) {
        LAS float* cur = buf0 + (blk & 1) * (BUFB / 4); LAS float* nxtb = buf0 + ((blk + 1) & 1) * (BUFB / 4);
        if (blk + 1 < NBLK) RW_LOAD(blk + 1);
        for (int s0 = 0; s0 < TB; s0 += 4) {
            f32x4 w4[4], kk4[4], ka4[4], km4[4], r4[4]; float vv[4], yv[4];
#pragma unroll
            for (int u = 0; u < 4; ++u) { const LAS float* p = cur + (s0 + u) * 64 + 4 * q;
                w4[u] = *(const LAS f32x4*)p; kk4[u] = *(const LAS f32x4*)(p + TB * 64); ka4[u] = *(const LAS f32x4*)(p + 2 * TB * 64); km4[u] = *(const LAS f32x4*)(p + 3 * TB * 64); r4[u] = *(const LAS f32x4*)(p + 4 * TB * 64);
                vv[u] = cur[5 * TB * 64 + (s0 + u) * 64 + i]; }
#pragma unroll
            for (int u = 0; u < 4; ++u) {
                float sa = (S[0] * kk4[u][0] + S[1] * kk4[u][1]) + (S[2] * kk4[u][2] + S[3] * kk4[u][3]);
                sa = sum16(sa);
                S = S * w4[u] + (km4[u] * vv[u] - ka4[u] * sa);
                const float y = (S[0] * r4[u][0] + S[1] * r4[u][1]) + (S[2] * r4[u][2] + S[3] * r4[u][3]);
                yv[u] = sum16(y); }
            if (q == 0) {
#pragma unroll
                for (int u = 0; u < 4; ++u) ybuf[(s0 + u) * 32 + il] = yv[u]; }
        }
        __syncthreads();
        {
            const int os = tid >> 4, r2 = 2 * (tid & 15); const size_t t = tb + (size_t)blk * TB + os;
            *(unsigned*)(YRAW + t * 256 + h * 64 + 32 * half + r2) = cvt_pk_bf16(ybuf[os * 32 + r2], ybuf[os * 32 + r2 + 1]);
        }
        if (blk + 1 < NBLK) RW_STORE(nxtb);
        __syncthreads();
    }
#undef RW_LOAD
#undef RW_STORE
}

__device__ __forceinline__ void ssd_stage(const Ctx& C, int l, int h, size_t tb, int blk, LAS float* dst) {
    constexpr int TB = 16; const int g = h >> 1;
    const bf16_t* proj = WSP(bf16_t, S_PROJ); const float* cw = C.in[I_CONVW] + l * 4 * 768; const float* cb = C.in[I_CONVB] + l * 768;
    const float dtb = C.in[I_DTB][l * 4 + h], aneg = -expf(C.in[I_ALOG][l * 4 + h]);
    for (int it = C.tid; it < TB * 80; it += NTHREADS) {
        const int s = it / 80, v = it % 80; const int tl = blk * TB + s;
        int pcol, cch, doff;
        if (v < 16) { pcol = PC_XS + h * 64 + 4 * v; cch = h * 64 + 4 * v; doff = s * 64 + 4 * v; }
        else if (v < 48) { pcol = PC_BM + g * 128 + 4 * (v - 16); cch = 256 + g * 128 + 4 * (v - 16); doff = 2 * TB * 64 + s * 128 + 4 * (v - 16); }
        else { pcol = PC_CM + g * 128 + 4 * (v - 48); cch = 512 + g * 128 + 4 * (v - 48); doff = 2 * TB * 64 + TB * 128 + s * 128 + 4 * (v - 48); }
        f32x4 a = *(const f32x4*)(cb + cch);
#pragma unroll
        for (int k = 0; k < 4; ++k) { const int tt = tl - 3 + k; if (tt >= 0) a += ld_bf4(proj + (tb + tt) * NPROJ + pcol) * *(const f32x4*)(cw + k * 768 + cch); }
        for (int j = 0; j < 4; ++j) a[j] = siluf_(a[j]);
        if (v < 16) { const float dt = softplusf_(bf2f(proj[(tb + tl) * NPROJ + PC_DT + h]) + dtb); *(LAS f32x4*)(dst + TB * 64 + doff) = a; *(LAS f32x4*)(dst + doff) = a * dt;
                      if (v == 0) dst[TB * 384 + s] = expf(dt * aneg); }
        else *(LAS f32x4*)(dst + doff) = a;
    }
}
__device__ __forceinline__ void ssd_unit(const Ctx& C0_, int l, int b, int h, int ph) {
    const Ctx C = launder(C0_);
    constexpr int TB = 32, NBLK = SEQ / TB, NF = TB * (32 + 32 + 128 + 128) + 64, NIT = 72 * TB, NK = (NIT + NTHREADS - 1) / NTHREADS;
    LAS float* buf0 = (LAS float*)C.lds; LAS float* ypart = buf0 + 2 * NF;
    const int tid = C.tid, lane = C.lane, w = C.wave, g = h >> 1, pl = lane & 31, nh = lane >> 5;
    const bf16_t* proj = WSP(bf16_t, S_PROJ); bf16_t* Y = WSP(bf16_t, S_Y); float* SSQ = WSP(float, S_SSQ);
    const float* cw = C.in[I_CONVW] + l * 4 * 768; const float* cb = C.in[I_CONVB] + l * 768;
    const float dtb = C.in[I_DTB][l * 4 + h], aneg = -expf(C.in[I_ALOG][l * 4 + h]), dsk = C.in[I_SSDD][l * 4 + h];
    const size_t tb = (size_t)b * SEQ;
    int its[NK], itp[NK], itd[NK], itc[NK]; bool itx[NK];
#pragma unroll
    for (int k = 0; k < NK; ++k) { const int it = tid + NTHREADS * k, sidx = it / 72, v = it % 72; int pcol, cch, doff;
        if (v < 8) { pcol = PC_XS + h * 64 + 32 * ph + 4 * v; cch = h * 64 + 32 * ph + 4 * v; doff = sidx * 32 + 4 * v; }
        else if (v < 40) { pcol = PC_BM + g * 128 + 4 * (v - 8); cch = 256 + g * 128 + 4 * (v - 8); doff = 2 * TB * 32 + sidx * 128 + 4 * (v - 8); }
        else { pcol = PC_CM + g * 128 + 4 * (v - 40); cch = 512 + g * 128 + 4 * (v - 40); doff = 2 * TB * 32 + TB * 128 + sidx * 128 + 4 * (v - 40); }
        its[k] = sidx; itp[k] = pcol; itd[k] = doff; itx[k] = v < 8; itc[k] = cch; }
    const bool haslast = tid + NTHREADS * (NK - 1) < NIT;
    u32x2 raw[NK][4]; float dtr[NK]; unsigned short zraw;
    const int os = tid >> 4, op = tid & 15;
#define SSD_LOAD(blk) do { _Pragma("unroll") for (int k = 0; k < NK; ++k) { if (k < NK - 1 || haslast) { const int tl_ = (blk) * TB + its[k]; \
            _Pragma("unroll") for (int q = 0; q < 4; ++q) { const int tt_ = tl_ - 3 + q; raw[k][q] = tt_ >= 0 ? *(const u32x2*)(proj + (tb + tt_) * NPROJ + itp[k]) : (u32x2){0u, 0u}; } \
            dtr[k] = itx[k] ? bf2f(proj[(tb + tl_) * NPROJ + PC_DT + h]) : 0.f; } } } while (0)
#define SSD_COMMIT(dst) do { _Pragma("unroll") for (int k = 0; k < NK; ++k) { if (k < NK - 1 || haslast) { f32x4 a_ = *(const f32x4*)(cb + itc[k]); \
            _Pragma("unroll") for (int q = 0; q < 4; ++q) a_ += (f32x4){bflo(raw[k][q].x), bfhi(raw[k][q].x), bflo(raw[k][q].y), bfhi(raw[k][q].y)} * *(const f32x4*)(cw + q * 768 + itc[k]); \
            for (int j = 0; j < 4; ++j) a_[j] = siluf_(a_[j]); \
            if (itx[k]) { const float dt_ = softplusf_(dtr[k] + dtb); *(LAS f32x4*)((dst) + TB * 32 + itd[k]) = a_; *(LAS f32x4*)((dst) + itd[k]) = a_ * dt_; if ((itd[k] & 31) == 0) (dst)[TB * 320 + its[k]] = expf(dt_ * aneg); } \
            else *(LAS f32x4*)((dst) + itd[k]) = a_; } } } while (0)
    float hs[8];
#pragma unroll
    for (int k = 0; k < 8; ++k) hs[k] = 0.f;
    __syncthreads();
    SSD_LOAD(0); SSD_COMMIT(buf0);
    __syncthreads();
    for (int blk = 0; blk < NBLK; ++blk) {
        LAS float* cur = buf0 + (blk & 1) * NF; LAS float* nxtb = buf0 + ((blk + 1) & 1) * NF;
        if (blk + 1 < NBLK) SSD_LOAD(blk + 1);
        const size_t tz = tb + (size_t)blk * TB + os;
        zraw = proj[tz * NPROJ + PC_Z + h * 64 + 32 * ph + op]; const unsigned short zraw2 = proj[tz * NPROJ + PC_Z + h * 64 + 32 * ph + op + 16];
        for (int s0 = 0; s0 < TB; s0 += 4) {
            float x4[4], dA4[4], yv[4]; f32x4 bv[4][2], cv[4][2];
#pragma unroll
            for (int u = 0; u < 4; ++u) { const int s = s0 + u; x4[u] = cur[s * 32 + pl]; dA4[u] = cur[TB * 320 + s];
                const LAS float* bp = cur + 2 * TB * 32 + s * 128 + 16 * w + 8 * nh; const LAS float* cp = bp + TB * 128;
                bv[u][0] = *(const LAS f32x4*)bp; bv[u][1] = *(const LAS f32x4*)(bp + 4); cv[u][0] = *(const LAS f32x4*)cp; cv[u][1] = *(const LAS f32x4*)(cp + 4); }
#pragma unroll
            for (int u = 0; u < 4; ++u) { float yp = 0.f;
#pragma unroll
                for (int k4 = 0; k4 < 2; ++k4)
#pragma unroll
                    for (int j = 0; j < 4; ++j) { hs[4 * k4 + j] = hs[4 * k4 + j] * dA4[u] + x4[u] * bv[u][k4][j]; yp += cv[u][k4][j] * hs[4 * k4 + j]; }
                const auto sw = __builtin_amdgcn_permlane32_swap(__builtin_bit_cast(unsigned, yp), __builtin_bit_cast(unsigned, yp), false, false);
                yv[u] = yp + __builtin_bit_cast(float, (unsigned)sw[1]); }
            if (nh == 0) {
#pragma unroll
                for (int u = 0; u < 4; ++u) ypart[((s0 + u) * 8 + w) * 32 + pl] = yv[u]; }
        }
        if (blk + 1 < NBLK) SSD_COMMIT(nxtb);
        __syncthreads();
        {
            float y0 = 0.f, y1 = 0.f;
#pragma unroll
            for (int ww = 0; ww < 8; ++ww) { y0 += ypart[(os * 8 + ww) * 32 + op]; y1 += ypart[(os * 8 + ww) * 32 + op + 16]; }
            y0 += cur[TB * 32 + os * 32 + op] * dsk; y1 += cur[TB * 32 + os * 32 + op + 16] * dsk;
            y0 *= siluf_(bf2f(zraw)); y1 *= siluf_(bf2f(zraw2));
            bf16_t* yo = Y + tz * 1024 + 512 + h * 64 + 32 * ph + op;
            yo[0] = (bf16_t)(cvt_pk_bf16(y0, 0.f) & 0xffffu); yo[16] = (bf16_t)(cvt_pk_bf16(y1, 0.f) & 0xffffu);
            float q = y0 * y0 + y1 * y1;
#pragma unroll
            for (int o_ = 1; o_ < 16; o_ <<= 1) q += __shfl_xor(q, o_);
            if (op == 0) SSQ[tz * 8 + h * 2 + ph] = q;
        }
        __syncthreads();
    }
#undef SSD_LOAD
#undef SSD_COMMIT
}

__device__ __forceinline__ void sb_naive(const Ctx& C) {
    const bf16_t* proj = WSP(bf16_t, S_PROJ); bf16_t* Y = WSP(bf16_t, S_Y); const int lane = C.lane;
    for (int item = GW; item < T * 4; item += NGW) {
        const int t = item >> 2, h = item & 3, tq = t % SEQ; const size_t tb = (size_t)(t - tq);
        float q[64];
        { const bf16_t* qp = proj + (size_t)t * NPROJ + PC_SBQ + h * 64;
#pragma unroll
          for (int i = 0; i < 8; ++i) { const u32x4 w = *(const u32x4*)(qp + 8 * i); q[8*i] = bflo(w.x); q[8*i+1] = bfhi(w.x); q[8*i+2] = bflo(w.y); q[8*i+3] = bfhi(w.y); q[8*i+4] = bflo(w.z); q[8*i+5] = bfhi(w.z); q[8*i+6] = bflo(w.w); q[8*i+7] = bfhi(w.w); } }
        float o[64];
#pragma unroll
        for (int d = 0; d < 64; ++d) o[d] = 0.f;
        float R = 0.f;
        for (int c = (tq - 1) >> 6; c >= 0 && tq > 0; --c) {
            const int key = c * 64 + lane; const bool ok = key < tq;
            const bf16_t* kp = proj + (tb + key) * NPROJ + PC_SBK + h * 64; const bf16_t* vp = proj + (tb + key) * NPROJ + PC_SBV + h * 64;
            float z = 0.f;
#pragma unroll
            for (int i = 0; i < 8; ++i) { const u32x4 w = *(const u32x4*)(kp + 8 * i);
                z += q[8*i] * bflo(w.x) + q[8*i+1] * bfhi(w.x) + q[8*i+2] * bflo(w.y) + q[8*i+3] * bfhi(w.y) + q[8*i+4] * bflo(w.z) + q[8*i+5] * bfhi(w.z) + q[8*i+6] * bflo(w.w) + q[8*i+7] * bfhi(w.w); }
            const float L = ok ? -(fmaxf(z, 0.f) + flog2(1.0f + fexp2(-fabsf(z)))) : 0.f;
            float sfx = L;
#pragma unroll
            for (int dd = 1; dd < 64; dd <<= 1) { const float tt = __shfl_down(sfx, dd); if (lane + dd < 64) sfx += tt; }
            const float tot = __shfl(sfx, 0);
            const float wgt = ok ? fexp2(z + L + (sfx - L) + R) : 0.f;
            R += tot;
#pragma unroll
            for (int i = 0; i < 8; ++i) { const u32x4 w = *(const u32x4*)(vp + 8 * i);
                o[8*i] += wgt * bflo(w.x); o[8*i+1] += wgt * bfhi(w.x); o[8*i+2] += wgt * bflo(w.y); o[8*i+3] += wgt * bfhi(w.y); o[8*i+4] += wgt * bflo(w.z); o[8*i+5] += wgt * bfhi(w.z); o[8*i+6] += wgt * bflo(w.w); o[8*i+7] += wgt * bfhi(w.w); }
        }
        float mine = 0.f;
#pragma unroll
        for (int d = 0; d < 64; ++d) { const float sdd = wave_sum(o[d]); if (lane == d) mine = sdd; }
        Y[(size_t)t * 1024 + h * 64 + lane] = (bf16_t)(cvt_pk_bf16(mine, 0.f) & 0xffffu);
    }
}

__device__ __forceinline__ void rwkv_naive(const Ctx& C, int l) {
    const float* DEC = WSP(float, S_DEC); const bf16_t* RWS = WSP(bf16_t, S_RWS); const bf16_t* GV = WSP(bf16_t, S_GV); bf16_t* Y = WSP(bf16_t, S_Y);
    const size_t PL = (size_t)T * 256; const int lane = C.lane;
    for (int item = GW; item < 64; item += NGW) {
        const int b = item >> 2, h = item & 3; const float* rk = C.in[I_RWRK] + l * 256 + h * 64;
        const float gng = C.in[I_RWGNG][l * 256 + h * 64 + lane], gnb = C.in[I_RWGNB][l * 256 + h * 64 + lane];
        float S[64];
#pragma unroll
        for (int j = 0; j < 64; ++j) S[j] = 0.f;
        for (int tq = 0; tq < SEQ; ++tq) {
            const size_t o = ((size_t)b * SEQ + tq) * 256 + h * 64;
            const float v = bf2f(RWS[2 * PL + o + lane]);
            float sa = 0.f;
#pragma unroll
            for (int j = 0; j < 64; ++j) sa += S[j] * bf2f(RWS[3 * PL + o + j]);
            float y = 0.f, bd = 0.f;
#pragma unroll
            for (int j = 0; j < 64; ++j) { const float km = bf2f(RWS[PL + o + j]), r = bf2f(RWS[o + j]);
                S[j] = S[j] * DEC[o + j] + (v * km - sa * bf2f(RWS[4 * PL + o + j])); y += S[j] * r; bd += r * km * rk[j]; }
            const float mu = wave_sum(y) * (1.0f / 64.0f), d = y - mu, var = wave_sum(d * d) * (1.0f / 64.0f);
            const float res = (d * (1.0f / sqrtf(var + 64e-5f)) * gng + gnb + v * bd) * bf2f(GV[o + lane]);
            Y[((size_t)b * SEQ + tq) * 1024 + 256 + h * 64 + lane] = (bf16_t)(cvt_pk_bf16(res, 0.f) & 0xffffu);
        }
    }
}
__device__ __forceinline__ void ssd_naive(const Ctx& C, int l) {
    const bf16_t* proj = WSP(bf16_t, S_PROJ); bf16_t* Y = WSP(bf16_t, S_Y); float* SSQ = WSP(float, S_SSQ); const int lane = C.lane;
    const float* cw = C.in[I_CONVW] + l * 4 * 768; const float* cb = C.in[I_CONVB] + l * 768;
    for (int item2 = GW; item2 < 128; item2 += NGW) {
        const int item = item2 >> 1, ph = item2 & 1; const int b = item >> 2, h = item & 3, g = h >> 1; const size_t tb = (size_t)b * SEQ;
        const float dtb = C.in[I_DTB][l * 4 + h], aneg = -expf(C.in[I_ALOG][l * 4 + h]), dsk = C.in[I_SSDD][l * 4 + h];
        float hs0[32], hs1[32];
#pragma unroll
        for (int p = 0; p < 32; ++p) { hs0[p] = 0.f; hs1[p] = 0.f; }
        for (int tq = 0; tq < SEQ; ++tq) {
            const bf16_t* pr = proj + (tb + tq) * NPROJ;
            float xa = cb[h * 64 + lane], bv0 = cb[256 + g * 128 + lane], bv1 = cb[256 + g * 128 + 64 + lane], cv0 = cb[512 + g * 128 + lane], cv1 = cb[512 + g * 128 + 64 + lane];
            for (int k = 0; k < 4; ++k) { const int tt = tq - 3 + k; if (tt >= 0) { const bf16_t* pp = proj + (tb + tt) * NPROJ; const float* ww = cw + k * 768;
                xa += bf2f(pp[PC_XS + h * 64 + lane]) * ww[h * 64 + lane];
                bv0 += bf2f(pp[PC_BM + g * 128 + lane]) * ww[256 + g * 128 + lane]; bv1 += bf2f(pp[PC_BM + g * 128 + 64 + lane]) * ww[256 + g * 128 + 64 + lane];
                cv0 += bf2f(pp[PC_CM + g * 128 + lane]) * ww[512 + g * 128 + lane]; cv1 += bf2f(pp[PC_CM + g * 128 + 64 + lane]) * ww[512 + g * 128 + 64 + lane]; } }
            xa = siluf_(xa); bv0 = siluf_(bv0); bv1 = siluf_(bv1); cv0 = siluf_(cv0); cv1 = siluf_(cv1);
            const float dt = softplusf_(bf2f(pr[PC_DT + h]) + dtb), dA = expf(dt * aneg), xd = xa * dt;
            float y = 0.f;
#pragma unroll
            for (int p = 0; p < 32; ++p) { const float xp = __shfl(xd, 32 * ph + p); hs0[p] = hs0[p] * dA + xp * bv0; hs1[p] = hs1[p] * dA + xp * bv1;
                const float tot = wave_sum(cv0 * hs0[p] + cv1 * hs1[p]); if (lane == 32 * ph + p) y = tot; }
            y += dsk * xa; y *= siluf_(bf2f(pr[PC_Z + h * 64 + lane]));
            const bool mine = (lane >> 5) == ph; if (mine) Y[(tb + tq) * 1024 + 512 + h * 64 + lane] = (bf16_t)(cvt_pk_bf16(y, 0.f) & 0xffffu);
            const float q = wave_sum(mine ? y * y : 0.f); if (lane == 0) atomicAdd(&SSQ[(tb + tq) * 8 + h * 2], q);
        }
    }
}

__device__ __forceinline__ void mla_naive(const Ctx& C) {
    const bf16_t* QM = WSP(bf16_t, S_QM); const bf16_t* KM = WSP(bf16_t, S_KM); const bf16_t* VM = WSP(bf16_t, S_VM); bf16_t* Y = WSP(bf16_t, S_Y); const int lane = C.lane;
    for (int item = GW; item < T * 4; item += NGW) {
        const int t = item >> 2, h = item & 3, tq = t % SEQ; const size_t tb = (size_t)(t - tq);
        float q[96];
        { const bf16_t* qp = QM + (size_t)t * 384 + h * 96;
#pragma unroll
          for (int i = 0; i < 12; ++i) { const u32x4 w = *(const u32x4*)(qp + 8 * i); q[8*i] = bflo(w.x); q[8*i+1] = bfhi(w.x); q[8*i+2] = bflo(w.y); q[8*i+3] = bfhi(w.y); q[8*i+4] = bflo(w.z); q[8*i+5] = bfhi(w.z); q[8*i+6] = bflo(w.w); q[8*i+7] = bfhi(w.w); } }
        float o[64];
#pragma unroll
        for (int d = 0; d < 64; ++d) o[d] = 0.f;
        float m = -1.0e30f, lsum = 0.f;
        for (int c = tq >> 6; c >= 0; --c) {
            const int key = c * 64 + lane; const bool ok = key <= tq;
            const bf16_t* kp = KM + (tb + (ok ? key : 0)) * 384 + h * 96; const bf16_t* vp = VM + (tb + (ok ? key : 0)) * 256 + h * 64;
            float z = 0.f;
#pragma unroll
            for (int i = 0; i < 12; ++i) { const u32x4 w = *(const u32x4*)(kp + 8 * i);
                z += q[8*i] * bflo(w.x) + q[8*i+1] * bfhi(w.x) + q[8*i+2] * bflo(w.y) + q[8*i+3] * bfhi(w.y) + q[8*i+4] * bflo(w.z) + q[8*i+5] * bfhi(w.z) + q[8*i+6] * bflo(w.w) + q[8*i+7] * bfhi(w.w); }
            z = ok ? z : -1.0e30f;
            float cm = z;
#pragma unroll
            for (int dd = 1; dd < 64; dd <<= 1) cm = fmaxf(cm, __shfl_xor(cm, dd));
            const float mn = fmaxf(m, cm), al = fexp2(m - mn), pw = ok ? fexp2(z - mn) : 0.f; m = mn; lsum = lsum * al + pw;
#pragma unroll
            for (int i = 0; i < 8; ++i) { const u32x4 w = *(const u32x4*)(vp + 8 * i);
                o[8*i] = o[8*i] * al + pw * bflo(w.x); o[8*i+1] = o[8*i+1] * al + pw * bfhi(w.x); o[8*i+2] = o[8*i+2] * al + pw * bflo(w.y); o[8*i+3] = o[8*i+3] * al + pw * bfhi(w.y);
                o[8*i+4] = o[8*i+4] * al + pw * bflo(w.z); o[8*i+5] = o[8*i+5] * al + pw * bfhi(w.z); o[8*i+6] = o[8*i+6] * al + pw * bflo(w.w); o[8*i+7] = o[8*i+7] * al + pw * bfhi(w.w); }
        }
        const float lt = wave_sum(lsum); float mine = 0.f;
#pragma unroll
        for (int d = 0; d < 64; ++d) { const float sdd = wave_sum(o[d]); if (lane == d) mine = sdd; }
        Y[(size_t)t * 1024 + 768 + h * 64 + lane] = (bf16_t)(cvt_pk_bf16(mine / lt, 0.f) & 0xffffu);
    }
}
__device__ __forceinline__ void xattn_naive(const Ctx& C, int l) {
    const bf16_t* XQ = WSP(bf16_t, S_XQ); const bf16_t* KMEM = WSP(bf16_t, W_KMEM) + (size_t)l * NMEM * 1024; const bf16_t* VT = WSP(bf16_t, W_VMEMT) + (size_t)l * 1024 * NMEM; bf16_t* XO = WSP(bf16_t, S_XO); const int lane = C.lane;
    for (int item = GW; item < T * 4; item += NGW) {
        const int t = item >> 2, h = item & 3, b = t / SEQ;
        float z[4] = {0.f, 0.f, 0.f, 0.f};
        for (int d8 = 0; d8 < 32; ++d8) { const u32x4 qw = *(const u32x4*)(XQ + (size_t)t * 1024 + h * 256 + 8 * d8);
            const float qv[8] = {bflo(qw.x), bfhi(qw.x), bflo(qw.y), bfhi(qw.y), bflo(qw.z), bfhi(qw.z), bflo(qw.w), bfhi(qw.w)};
#pragma unroll
            for (int j = 0; j < 4; ++j) { const u32x4 kw = *(const u32x4*)(KMEM + (size_t)(b * 256 + lane + 64 * j) * 1024 + h * 256 + 8 * d8);
                z[j] += qv[0] * bflo(kw.x) + qv[1] * bfhi(kw.x) + qv[2] * bflo(kw.y) + qv[3] * bfhi(kw.y) + qv[4] * bflo(kw.z) + qv[5] * bfhi(kw.z) + qv[6] * bflo(kw.w) + qv[7] * bfhi(kw.w); } }
        float mx = fmaxf(fmaxf(z[0], z[1]), fmaxf(z[2], z[3]));
#pragma unroll
        for (int dd = 1; dd < 64; dd <<= 1) mx = fmaxf(mx, __shfl_xor(mx, dd));
        float p[4], ps = 0.f;
#pragma unroll
        for (int j = 0; j < 4; ++j) { p[j] = fexp2(z[j] - mx); ps += p[j]; }
        const float inv = 1.0f / wave_sum(ps);
        float o[4] = {0.f, 0.f, 0.f, 0.f};
        for (int mm = 0; mm < 256; ++mm) { const float pm = __shfl(p[mm >> 6], mm & 63);
#pragma unroll
            for (int jd = 0; jd < 4; ++jd) o[jd] += pm * bf2f(VT[(size_t)(h * 256 + lane + 64 * jd) * NMEM + b * 256 + mm]); }
#pragma unroll
        for (int jd = 0; jd < 4; ++jd) XO[(size_t)t * 1024 + h * 256 + lane + 64 * jd] = (bf16_t)(cvt_pk_bf16(o[jd] * inv, 0.f) & 0xffffu);
    }
}
__device__ __forceinline__ void ph_mixers(const Ctx& C, int l, int rep = 0) {
    unsigned* head = (unsigned*)(C.ws + WS_CTL) + CW_QUEUE + 64 * (l + 2 * rep);
    volatile LAS unsigned* slot = (volatile LAS unsigned*)(C.lds + LDSCTL_OFF + 64);
    constexpr int N_RW = 128, N_ATT = 768, NITEMS = N_RW + N_ATT;
    for (;;) {
        __syncthreads();
        if (C.tid == 0) slot[0] = __hip_atomic_fetch_add(head, 1u, RLX_AGENT);
        __syncthreads();
        const int it = (int)slot[0];
        if (it >= NITEMS) break;
#ifndef NAIVE_SCAN
#define NAIVE_SCAN 0
#endif
        if (it < N_RW) { if (!(NAIVE_SCAN & 1)) { rwkv_unit(C, l, it >> 3, (it >> 1) & 3, it & 1);
#ifdef TIME_RW2
            __syncthreads(); rwkv_unit(C, l, it >> 3, (it >> 1) & 3, it & 1);
#endif
        } }
        else { const int k = it - N_RW; const int mode = k >> 8, kk_ = k & 255, pp = kk_ & 3, bh = kk_ >> 2, b = bh >> 2, h = bh & 3;
            if (mode == 0) { if (!(NAIVE_SCAN & 2)) { attn_unit<2>(C, l, b, h, 7 - pp); __syncthreads(); attn_unit<2>(C, l, b, h, pp);
#ifdef TIME_SSDA2
                __syncthreads(); attn_unit<2>(C, l, b, h, 7 - pp); __syncthreads(); attn_unit<2>(C, l, b, h, pp);
#endif
            } }
#ifndef NAIVE_SB
            else if (mode == 2) { attn_unit<0>(C, l, b, h, 7 - pp); __syncthreads(); attn_unit<0>(C, l, b, h, pp);
#ifdef TIME_SB2
                __syncthreads(); attn_unit<0>(C, l, b, h, 7 - pp); __syncthreads(); attn_unit<0>(C, l, b, h, pp);
#endif
            }
#else
            else if (mode == 2) { }
#endif
#ifndef NAIVE_MLA
            else { attn_unit<1>(C, l, b, h, 7 - pp); __syncthreads(); attn_unit<1>(C, l, b, h, pp);
#ifdef TIME_MLA2
                __syncthreads(); attn_unit<1>(C, l, b, h, 7 - pp); __syncthreads(); attn_unit<1>(C, l, b, h, pp);
#endif
            }
#else
            else { }
#endif
        }
    }
#ifdef NAIVE_SB
    sb_naive(C);
#endif
#ifdef NAIVE_MLA
    mla_naive(C);
#endif
    if (NAIVE_SCAN & 1) rwkv_naive(C, l);
    if (NAIVE_SCAN & 2) ssd_naive(C, l);
}
__device__ __forceinline__ void ph_router(const Ctx& C) {
    run_tjobs<16, true>(C);
    __syncthreads();
    LAS unsigned* lc = (LAS unsigned*)(C.lds + XCH_OFF);
    if (C.tid < 8) lc[C.tid] = 0u;
    __syncthreads();
    const float* xr = WSP(float, W_XRES); const float* rt = C.in[I_ROUTER]; int* topi = WSP(int, S_TOPI); float* topw = WSP(float, S_TOPW); const int lane = C.lane;
    for (int k = 0; k < 16; ++k) {
        const int t = C.bid * 128 + C.wave * 16 + k; float a[8];
#pragma unroll
        for (int e = 0; e < 8; ++e) a[e] = 0.f;
#pragma unroll
        for (int j = 0; j < 4; ++j) { const f32x4 xv = *(const f32x4*)(xr + (size_t)t * 1024 + 4 * lane + 256 * j);
#pragma unroll
            for (int q = 0; q < 4; ++q) { const float* rp = rt + (size_t)(4 * lane + 256 * j + q) * 8; const f32x4 r0 = *(const f32x4*)rp, r1 = *(const f32x4*)(rp + 4);
                a[0] += xv[q] * r0[0]; a[1] += xv[q] * r0[1]; a[2] += xv[q] * r0[2]; a[3] += xv[q] * r0[3]; a[4] += xv[q] * r1[0]; a[5] += xv[q] * r1[1]; a[6] += xv[q] * r1[2]; a[7] += xv[q] * r1[3]; } }
#pragma unroll
        for (int e = 0; e < 8; ++e) a[e] = wave_sum(a[e]);
#ifdef ROUTER_NOISE
        for (int e = 0; e < 8; ++e) { unsigned hsh = (unsigned)t * 2654435761u + (unsigned)e * 40503u; hsh ^= hsh >> 13; hsh *= 0x5bd1e995u; hsh ^= hsh >> 15; a[e] += ROUTER_NOISE * ((float)(hsh & 0xffff) * (1.0f / 32768.0f) - 1.0f); }
#endif
        if (lane == 0) {
            int i1 = 0; float v1 = a[0];
#pragma unroll
            for (int e = 1; e < 8; ++e) if (a[e] > v1) { v1 = a[e]; i1 = e; }
            int i2 = -1; float v2 = -3.0e38f;
#pragma unroll
            for (int e = 0; e < 8; ++e) if (e != i1 && a[e] > v2) { v2 = a[e]; i2 = e; }
            const float g1 = 1.0f / (1.0f + expf(v2 - v1));
            topi[2 * t] = i1; topi[2 * t + 1] = i2; topw[2 * t] = g1; topw[2 * t + 1] = 1.0f - g1;
            __hip_atomic_fetch_add(&lc[i1], 1u, __ATOMIC_RELAXED, __HIP_MEMORY_SCOPE_WORKGROUP); __hip_atomic_fetch_add(&lc[i2], 1u, __ATOMIC_RELAXED, __HIP_MEMORY_SCOPE_WORKGROUP);
        }
    }
    __syncthreads();
    if (C.tid < 8) ((unsigned*)(C.ws + WS_CTL))[CW_MOECNT + C.bid * 8 + C.tid] = lc[C.tid];
}
__device__ __forceinline__ void ph_scatter(const Ctx& C) {
    LAS int* sh = (LAS int*)(C.lds + XCH_OFF);
    const unsigned* cnt = (const unsigned*)(C.ws + WS_CTL) + CW_MOECNT;
    int* row_slot = WSP(int, S_ROWSLOT); float* row_w = WSP(float, S_ROWW); int* blk_e = WSP(int, S_BLKE);
    const int* topi = WSP(int, S_TOPI); const float* topw = WSP(float, S_TOPW);
    const int tid = C.tid;
    if (tid < 8) { int tot = 0, mine = 0; for (int wg = 0; wg < 256; ++wg) { const int c = (int)cnt[wg * 8 + tid]; if (wg < C.bid) mine += c; tot += c; } sh[tid] = tot; sh[8 + tid] = mine; sh[32 + tid] = 0; }
    __syncthreads();
    if (tid == 0) { int ps = 0; for (int e = 0; e < 8; ++e) { sh[16 + e] = ps; const int pad = (sh[e] + 255) / 256 * 256; sh[24 + e] = pad; ps += pad; } sh[40] = ps / 256; }
    __syncthreads();
    if (C.bid == 0) {
        const int used = sh[40];
        for (int rb = tid; rb < MOE_BLOCKS; rb += NTHREADS) { int e = 7; if (rb < used) { e = 0; for (int q = 1; q < 8; ++q) if (sh[16 + q] <= rb * 256) e = q; } blk_e[rb] = e; }
        if (tid == 0) blk_e[MOE_BLOCKS] = used;
    }
    if (C.bid < 8) { const int e = C.bid; for (int r = sh[16 + e] + sh[e] + tid; r < sh[16 + e] + sh[24 + e]; r += NTHREADS) { row_slot[r] = -1; row_w[r] = 0.f; } }
    if (tid < 256) { const int t = C.bid * 128 + (tid >> 1), k = tid & 1, e = topi[2 * t + k];
        const int pos = __hip_atomic_fetch_add(&sh[32 + e], 1, __ATOMIC_RELAXED, __HIP_MEMORY_SCOPE_WORKGROUP); const int dest = sh[16 + e] + sh[8 + e] + pos; row_slot[dest] = 2 * t + k; row_w[dest] = topw[2 * t + k]; sh[64 + tid] = dest; }
    __syncthreads();
    const bf16_t* xb = WSP(bf16_t, W_XB); bf16_t* xs = WSP(bf16_t, S_XS);
    for (int a = C.wave * 32; a < C.wave * 32 + 32; ++a) { const int t = C.bid * 128 + (a >> 1); const size_t d = (size_t)sh[64 + a] * 1024;
#pragma unroll
        for (int j = 0; j < 2; ++j) *(u32x4*)(xs + d + (C.lane + 64 * j) * 8) = *(const u32x4*)(xb + (size_t)t * 1024 + (C.lane + 64 * j) * 8); }
}


__device__ __forceinline__ void chk_moe(const Ctx& C, int bit) {
    const float* xr = WSP(float, W_XRES); const float* rt = C.in[I_ROUTER]; const float* w13 = C.in[I_MOE13]; const float* w2 = C.in[I_MOE2]; const bf16_t* ys = WSP(bf16_t, S_YS);
    LAS float* hb = (LAS float*)(C.lds + C.wave * 14336); const int lane = C.lane; unsigned bad = 0;
    float* stash = WSP(float, W_KMEM); const float* g3 = C.in[I_LN3G] + 1024; const float* b3 = C.in[I_LN3B] + 1024;
    for (int s = GW; s < 1024; s += NGW) {
        const int t = (int)(((long)s * 1021 + 7) % T); float x[16];
#pragma unroll
        for (int j = 0; j < 16; ++j) x[j] = xr[(size_t)t * 1024 + lane + 64 * j];
        float lg[8];
#pragma unroll
        for (int e = 0; e < 8; ++e) { float a = 0.f;
#pragma unroll
            for (int j = 0; j < 16; ++j) a += x[j] * rt[(size_t)(lane + 64 * j) * 8 + e]; lg[e] = wave_sum(a); }
        int i1 = 0; for (int e = 1; e < 8; ++e) if (lg[e] > lg[i1]) i1 = e;
        int i2 = -1; for (int e = 0; e < 8; ++e) if (e != i1 && (i2 < 0 || lg[e] > lg[i2])) i2 = e;
        float v3 = -3.0e38f; for (int e = 0; e < 8; ++e) if (e != i1 && e != i2) v3 = fmaxf(v3, lg[e]);
        if (lg[i2] - v3 < 0.02f) { if (lane == 0) stash[(size_t)s * 1024] = 1.0e30f; continue; }
        const float g1 = 1.0f / (1.0f + expf(lg[i2] - lg[i1]));
        float out[16];
#pragma unroll
        for (int j = 0; j < 16; ++j) out[j] = 0.f;
        for (int q = 0; q < 2; ++q) { const int e = q ? i2 : i1; const float gw = q ? 1.0f - g1 : g1; const float* W1 = w13 + (size_t)e * 1024 * 2 * FFE;
            for (int i0 = 0; i0 < 56; i0 += 4) { float ag[4], au[4];
#pragma unroll
                for (int i = 0; i < 4; ++i) { ag[i] = 0.f; au[i] = 0.f; }
                for (int k = 0; k < 1024; ++k) { const float xk = __shfl(x[k >> 6], k & 63); const float* wr = W1 + (size_t)k * 2 * FFE + lane + 64 * i0;
#pragma unroll
                    for (int i = 0; i < 4; ++i) { ag[i] += xk * wr[64 * i]; au[i] += xk * wr[FFE + 64 * i]; } }
#pragma unroll
                for (int i = 0; i < 4; ++i) hb[lane + 64 * (i0 + i)] = (ag[i] / (1.0f + expf(-ag[i]))) * au[i]; }
            LDS_WAIT();
            const float* W2 = w2 + (size_t)e * FFE * 1024;
            for (int hh = 0; hh < FFE; ++hh) { const float hv = hb[hh] * gw;
#pragma unroll
                for (int j = 0; j < 16; ++j) out[j] += hv * W2[(size_t)hh * 1024 + lane + 64 * j]; }
            LDS_WAIT(); }
#pragma unroll
        for (int j = 0; j < 16; ++j) { const int c = lane + 64 * j; const float got = bf2f(ys[(size_t)(2 * t) * 1024 + c]) + bf2f(ys[(size_t)(2 * t + 1) * 1024 + c]);
            if (fabsf(got - out[j]) > 0.05f * fabsf(out[j]) + 0.03f) bad = 1; }
        { float v[16], sm = 0.f, s2 = 0.f;
#pragma unroll
          for (int j = 0; j < 16; ++j) { v[j] = x[j] * DN_ALPHA + out[j]; sm += v[j]; }
          const float mean = wave_sum(sm) * (1.0f / 1024.0f);
#pragma unroll
          for (int j = 0; j < 16; ++j) { v[j] -= mean; s2 += v[j] * v[j]; }
          const float rstd = 1.0f / sqrtf(wave_sum(s2) * (1.0f / 1024.0f) + 1e-5f);
          int zz = 0; asm volatile("" : "+v"(zz));
#pragma unroll
          for (int j = 0; j < 16; ++j) { const int c = lane + 64 * j + zz; stash[(size_t)s * 1024 + c] = v[j] * rstd * g3[c] + b3[c]; } }
    }
    chk_flag(C, bit, bad);
}
#ifndef ABL_MIX
#define ABL_MIX 1.0f
#endif
#ifndef ABL_XA
#define ABL_XA 1.0f
#endif
#ifndef ABL_FF
#define ABL_FF 1.0f
#endif
#ifndef CHK_TOL2
#define CHK_TOL2 0.05f
#endif
#ifndef GATE_ACT
#define GATE_ACT 1
#endif
#ifndef GATE_ALIGN
#define GATE_ALIGN true
#endif
#ifndef FG_TOL
#define FG_TOL 0.05f
#endif
#ifndef FG_BIT
#define FG_BIT 1
#endif
#ifndef CHECKS_LAYER
#define CHECKS_LAYER 0
#endif
#ifndef MK_SPLIT
#define MK_SPLIT 0
#endif
constexpr int PH_L0 = 1, PH_L1 = 18, PH_MOE = 32, PH_TOTAL = PH_MOE + 2 + 2 * MOE_PASSES + 1;

__global__ void __launch_bounds__(NTHREADS, 2) hybrid_fwd(Args args) {
    extern __shared__ __attribute__((aligned(16))) unsigned char lds_raw[];
    Ctx C; C.in = args.in; C.out = args.out; C.ws = args.ws; C.lds = (LAS unsigned char*)lds_raw;
    C.tid = threadIdx.x; C.lane = C.tid & 63; C.wave = __builtin_amdgcn_readfirstlane(C.tid >> 6); C.G = gridDim.x; C.bid = blockIdx.x;
    const Ctx C0 = C;
    for (int u = C.tid; u < (LDS_BYTES - LDSCTL_OFF) / 4; u += NTHREADS) ((LAS unsigned*)(C.lds + LDSCTL_OFF))[u] = 0u;
    __syncthreads();
    const int lo = args.ph_lo, hi = args.ph_hi;
    XcdBarrier bar; bar.bar = (unsigned*)(C.ws + WS_CTL) + CW_BAR; bar.x = 0; bar.st = (volatile LAS unsigned*)(C.lds + LDSCTL_OFF);
    if (hi - lo > 1) bar = xcd_barrier_post((unsigned*)(C.ws + WS_CTL) + CW_BAR, (volatile LAS unsigned*)(C.lds + LDSCTL_OFF));
#ifndef SITE_MASK
#define SITE_MASK 0xffffffffu
#endif
#define SITE(n) (((SITE_MASK) >> (n)) & 1u)
#define IN(k) (lo <= (k) && (k) < hi)
#define ENDPH(k) do { if ((k) + 1 < hi) xcd_barrier(bar); } while (0)
#define SITE_BEGIN const Ctx C = launder(C0); unsigned char* LW = C.ws + W_BASE + (size_t)l * LW_SIZE; const bf16_t* XB = WSP(bf16_t, W_XB); float* XRES = WSP(float, W_XRES); (void)LW; (void)XB; (void)XRES; LAS unsigned char* ring = C.lds; (void)ring;

    if (SITE(0) && IN(0)) { const int l = 0; SITE_BEGIN ph_prologue(C);
#ifdef TIME_PRO2
        xcd_barrier(bar); ph_prologue(C);
#endif
#ifdef TIME_BAR
        for (int q_ = 0; q_ < TIME_BAR; ++q_) xcd_barrier(bar);
#endif
        ENDPH(0); }

    for (int l = 0; l < 2; ++l) {
        const int pb = l == 0 ? PH_L0 : PH_L1;
        if (SITE(1) && IN(pb + 0)) { SITE_BEGIN
#ifdef CHECKS3
            if (l == 1) chk_ln_cmp(C, 1, 1);
#endif
            { pg8::Gemm g{XB, (const bf16_t*)(LW + LW_WIN), 1024, 1024, 1024}; sch::Tiles S{T / 256, NPROJ / 256, C.G, C.bid}; epi::StoreBf16<0> E{WSP(bf16_t, S_PROJ), NPROJ}; pg8::gemm_phase(ring, g, S, E); }
            { pg8::Gemm g{(const bf16_t*)C.ws, (const bf16_t*)C.ws, 1024, 1024, 1024}; sch::MemKV S{(long)(W_MEMB / 2), (long)((W_BASE + (size_t)l * LW_SIZE + LW_WKV) / 2), C.bid};
              epi::StoreKV E{WSP(bf16_t, W_KMEM) + (size_t)l * NMEM * 1024, WSP(bf16_t, W_VMEMT) + (size_t)l * 1024 * NMEM}; pg8::gemm_phase(ring, g, S, E); }
            ENDPH(pb + 0);
        }
        if (SITE(2) && IN(pb + 1)) { SITE_BEGIN
#ifdef CHECKS5
            if (l == 0) chk_weights<28, false>(C, 0);
#endif
#ifdef CHECKS9
            if (l == 0) { unsigned bad = 0; const float* x = C.in[I_X]; const float* mm = C.in[I_MEM]; const bf16_t* mb = WSP(bf16_t, W_MEMB);
                for (size_t i = (size_t)C.bid * NTHREADS + C.tid; i < (size_t)T * 1024; i += (size_t)C.G * NTHREADS) if (!chk_close(x[i], bf2f(XB[i]))) bad = 1;
                for (size_t i = (size_t)C.bid * NTHREADS + C.tid; i < (size_t)NMEM * 1024; i += (size_t)C.G * NTHREADS) if (!chk_close(mm[i], bf2f(mb[i]))) bad = 1;
                if (bad) __hip_atomic_fetch_add((unsigned*)(C.ws + WS_CTL) + CW_CHK, 1u, RLX_AGENT); }
#endif
#ifdef CHECKS12P
            if (l == CHECKS_LAYER) { const bf16_t* proj = WSP(bf16_t, S_PROJ); chk_full_gemm(C, XB, (const bf16_t*)(LW + LW_WIN), 1024, 3236, 0, [&](size_t r, int c, float d) { return chk_close(d, bf2f(proj[r * NPROJ + c])); }); xcd_barrier(bar); }
#endif
#ifdef CHECKS4
            if (l == CHECKS_LAYER) { const bf16_t* KM_ = WSP(bf16_t, W_KMEM) + (size_t)l * NMEM * 1024; const bf16_t* VT_ = WSP(bf16_t, W_VMEMT) + (size_t)l * 1024 * NMEM;
                chk_gemm(C, WSP(bf16_t, W_MEMB), 1024, (const bf16_t*)(LW + LW_WKV), 1024, 1024, NMEM, 64, 16, 3, 0, [&](int r, int c, float d) { return chk_close(d, bf2f(KM_[(size_t)r * 1024 + c])); });
                chk_gemm(C, (const bf16_t*)(LW + LW_WKV) + (size_t)1024 * 1024, 1024, WSP(bf16_t, W_MEMB), 1024, 1024, 1024, 256, 16, 5, 1, [&](int r, int c, float d) { return chk_close(d, bf2f(VT_[(size_t)r * NMEM + c])); }); }
#endif
#ifdef CHECKS
            if (l == CHECKS_LAYER) { const bf16_t* proj = WSP(bf16_t, S_PROJ); chk_gemm(C, XB, 1024, (const bf16_t*)(LW + LW_WIN), 1024, 1024, T, 13, 256, 7, 0, [&](int r, int c, float d) { return chk_close(d, bf2f(proj[(size_t)r * NPROJ + c])); }); }
#endif
            ph_prep(C, l);
#ifdef TIME_PREP2
            xcd_barrier(bar); ph_prep(C, l);
#endif
            ENDPH(pb + 1); }
        if (SITE(3) && IN(pb + 2)) { SITE_BEGIN
            { pg8::Gemm g{WSP(bf16_t, S_LA), (const bf16_t*)(LW + LW_LORA), 256, 256, 256}; sch::Tiles S{T / 256, 3, C.G, C.bid}; epi::Lora E{WSP(float, S_DEC), WSP(bf16_t, S_AV), WSP(bf16_t, S_GV), C.in[I_RWW0] + l * 256, C.in[I_RWA0] + l * 256}; pg8::gemm_phase(ring, g, S, E); }
            { pg8::Gemm g{WSP(bf16_t, S_CQN), (const bf16_t*)(LW + LW_WUQ), 256, 256, 256}; sch::Tiles S{T / 256, 2, C.G, (C.bid + 128) & 255}; epi::Uq E{WSP(bf16_t, S_QM), WSP(float, W_COS), WSP(float, W_SIN)}; pg8::gemm_phase(ring, g, S, E); }
            { pg8::Gemm g{WSP(bf16_t, S_CKVN), (const bf16_t*)(LW + LW_WUKV), 128, 128, 128}; sch::Tiles S{T / 256, 2, C.G, C.bid}; epi::Ukv E{WSP(bf16_t, S_KM), WSP(bf16_t, S_VM)}; pg8::gemm_phase(ring, g, S, E); }
            ENDPH(pb + 2);
        }
        if (SITE(4) && IN(pb + 3)) { SITE_BEGIN ph_rwprep(C, l); ph_ssdprep(C, l);
#ifdef TIME_RWP2
            xcd_barrier(bar); ph_rwprep(C, l); ph_ssdprep(C, l);
#endif
            ENDPH(pb + 3); }
        if (SITE(5) && IN(pb + 4)) { SITE_BEGIN
#ifdef CHECKS6
            if (l == CHECKS_LAYER) chk_mla_inputs(C, l, 0);
#endif
#ifdef CHECKS7
            if (l == CHECKS_LAYER) chk_rw_inputs(C, l, 0);
#endif
            ph_mixers(C, l);
#ifdef TIME_MIX2
            xcd_barrier(bar); ph_mixers(C, l, 1);
#endif
            ENDPH(pb + 4); }
        if (SITE(6) && IN(pb + 5)) { SITE_BEGIN
            ph_ssdfix(C, l);
            { pg8::Gemm g{XB, (const bf16_t*)(LW + LW_WGATE), 1024, 1024, 1024}; sch::Tiles S{T / 256, 16, C.G, C.bid}; epi::StoreBf16<GATE_ACT> E{WSP(bf16_t, S_G), 4096}; pg8::gemm_phase<epi::StoreBf16<GATE_ACT>, sch::Tiles, GATE_ALIGN>(ring, g, S, E);
#ifdef TIME_GATE2
              xcd_barrier(bar); pg8::gemm_phase<epi::StoreBf16<GATE_ACT>, sch::Tiles, GATE_ALIGN>(ring, g, S, E);
#endif
            }
#ifdef CHECKS14
            if (l == 0) { xcd_barrier(bar); const bf16_t* Gp = WSP(bf16_t, S_G); chk_full_gemm(C, XB, (const bf16_t*)(LW + LW_WGATE), 1024, 4096, 0, [&](size_t r, int c, float d) { return chk_close(sigmoidf_(d), bf2f(Gp[r * 4096 + c])); }); }
#endif
#ifdef CHECKS13
            if (l == 0) { xcd_barrier(bar);
              { pg8::Gemm g{XB, (const bf16_t*)(LW + LW_WGATE), 1024, 1024, 1024}; sch::Tiles S{T / 256, 16, C.G, C.bid}; epi::StoreBf16<1> E{WSP(bf16_t, S_G) + (size_t)T * 4096, 4096}; pg8::gemm_phase(ring, g, S, E); }
              xcd_barrier(bar);
              { const unsigned short* g1 = WSP(unsigned short, S_G); const unsigned short* g2 = g1 + (size_t)T * 4096; unsigned cnt = 0;
                for (size_t i = (size_t)C.bid * NTHREADS + C.tid; i < (size_t)T * 4096; i += (size_t)C.G * NTHREADS) if (g1[i] != g2[i]) ++cnt;
                if (cnt) __hip_atomic_fetch_add((unsigned*)(C.ws + WS_CTL) + CW_CHK + 2048, cnt, RLX_AGENT); } }
#endif
            ENDPH(pb + 5);
        }
        if (SITE(7) && IN(pb + 6)) { SITE_BEGIN
#ifdef FIX_G
            { bf16_t* Gw = WSP(bf16_t, S_G); const bf16_t* Wg = (const bf16_t*)(LW + LW_WGATE);
              for (size_t i = (size_t)C.bid * NTHREADS + C.tid; i < (size_t)T * 4096; i += (size_t)C.G * NTHREADS) { const size_t r = i >> 12; const int c = (int)(i & 4095);
                  Gw[i] = (bf16_t)(cvt_pk_bf16(sigmoidf_(tdot(XB + r * 1024, Wg + (size_t)c * 1024, 1024)), 0.f) & 0xffffu); }
              xcd_barrier(bar); }
#endif
#ifdef CHECKS15
            if (l == 0) { unsigned cnt = 0; const float* x = C.in[I_X];
                for (size_t i = (size_t)C.bid * NTHREADS + C.tid; i < (size_t)T * 1024; i += (size_t)C.G * NTHREADS) if (!chk_close(x[i], bf2f(XB[i]))) ++cnt;
                if (cnt) __hip_atomic_fetch_add((unsigned*)(C.ws + WS_CTL) + CW_CHK + 2048, cnt, RLX_AGENT); }
#endif
#ifdef CHECKS7
            if (l == CHECKS_LAYER) chk_ssd_norm(C, l, 1);
#endif
#ifdef CHECKS12
            if (l == CHECKS_LAYER) { const bf16_t* Gp = WSP(bf16_t, S_G); chk_full_gemm(C, XB, (const bf16_t*)(LW + LW_WGATE), 1024, 4096, FG_BIT, [&](size_t r, int c, float d) { return fabsf((GATE_ACT ? sigmoidf_(d) : d) - bf2f(Gp[r * 4096 + c])) <= FG_TOL; }); xcd_barrier(bar); }
#endif
#ifdef CHECKS
            if (l == CHECKS_LAYER) { const bf16_t* Gp = WSP(bf16_t, S_G); chk_gemm(C, XB, 1024, (const bf16_t*)(LW + LW_WGATE), 1024, 1024, T, 16, 256, 5, 1, [&](int r, int c, float d) { return chk_close(sigmoidf_(d), bf2f(Gp[(size_t)r * 4096 + c])); }); }
#endif
            { pg8::Gemm g{WSP(bf16_t, S_Y), (const bf16_t*)(LW + LW_WBR), 256, 1024, 256}; sch::BrTiles S{T / 256, 4, C.G, C.bid}; epi::BrGate E{WSP(bf16_t, S_G), WSP(float, S_MF), WSP(bf16_t, S_MB)}; pg8::gemm_phase(ring, g, S, E); }
            ENDPH(pb + 6);
        }
        if (SITE(8) && IN(pb + 7)) { SITE_BEGIN
#ifdef CHECKS2
            if (l == CHECKS_LAYER) chk_merged(C, l, 0);
#endif
            { pg8::Gemm g{WSP(bf16_t, S_MB), (const bf16_t*)(LW + LW_WOUT), 1024, 1024, 1024}; sch::Tiles S{T / 256, 4, C.G, C.bid}; epi::Resid E{C.in[I_X], XRES, ABL_MIX, l == 0 ? nullptr : XB}; pg8::gemm_phase(ring, g, S, E); }
            ENDPH(pb + 7);
        }
        if (SITE(9) && IN(pb + 8)) { SITE_BEGIN
#ifdef CHECKS10
            if (l == 0) { chk_full_p7(C, l, 1); xcd_barrier(bar); }
#endif
#ifdef CHECKS
            if (l == 0) { const float* xin = C.in[I_X]; chk_gemm(C, WSP(bf16_t, S_MB), 1024, (const bf16_t*)(LW + LW_WOUT), 1024, 1024, T, 4, 256, 9, 2, [&](int r, int c, float d) { return fabsf(xin[(size_t)r * 1024 + c] * DN_ALPHA + d - XRES[(size_t)r * 1024 + c]) <= CHK_TOL2; }); }
#endif
            ph_ln<false>(C, XRES, nullptr, WSP(bf16_t, W_XB), C.in[I_LN1G] + l * 1024, C.in[I_LN1B] + l * 1024, nullptr); ENDPH(pb + 8); }
        if (SITE(10) && IN(pb + 9)) { SITE_BEGIN
            { pg8::Gemm g{XB, (const bf16_t*)(LW + LW_WQ), 1024, 1024, 1024}; sch::Tiles S{T / 256, 4, C.G, C.bid}; epi::StoreBf16<0> E{WSP(bf16_t, S_XQ), 1024}; pg8::gemm_phase(ring, g, S, E); }
            ENDPH(pb + 9);
        }
        if (SITE(11) && IN(pb + 10)) { SITE_BEGIN
#ifdef CHECKS
            if (l == CHECKS_LAYER) { const bf16_t* XQ = WSP(bf16_t, S_XQ); chk_gemm(C, XB, 1024, (const bf16_t*)(LW + LW_WQ), 1024, 1024, T, 4, 256, 11, 3, [&](int r, int c, float d) { return chk_close(d, bf2f(XQ[(size_t)r * 1024 + c])); }); }
#endif
            { pg8::Gemm g{WSP(bf16_t, S_XQ), WSP(bf16_t, W_KMEM) + (size_t)l * NMEM * 1024, 256, 1024, 1024}; sch::XaS S{C.G, C.bid}; epi::Softmax E{WSP(bf16_t, S_XP), (LAS float*)(C.lds + XCH_OFF)};
#ifndef NAIVE_XA
              pg8::gemm_phase(ring, g, S, E);
#else
              (void)g; (void)S; (void)E; xattn_naive(C, l);
#endif
            }
            ENDPH(pb + 10);
        }
        if (SITE(12) && IN(pb + 11)) { SITE_BEGIN
            { pg8::Gemm g{WSP(bf16_t, S_XP), WSP(bf16_t, W_VMEMT) + (size_t)l * 1024 * NMEM, 256, 1024, NMEM}; sch::XaPV S{C.G, C.bid}; epi::StoreBf16<0> E{WSP(bf16_t, S_XO), 1024};
#ifndef NAIVE_XA
              pg8::gemm_phase(ring, g, S, E);
#else
              (void)g; (void)S; (void)E;
#endif
            }
            ENDPH(pb + 11);
        }
        if (SITE(13) && IN(pb + 12)) { SITE_BEGIN
#ifdef CHECKS3
            if (l == 0) { chk_resid_stash(C, WSP(bf16_t, S_XO), 1024, (const bf16_t*)(LW + LW_WO), 1024, 1024, 0); xcd_barrier(bar); }
#endif
            { pg8::Gemm g{WSP(bf16_t, S_XO), (const bf16_t*)(LW + LW_WO), 1024, 1024, 1024}; sch::Tiles S{T / 256, 4, C.G, C.bid}; epi::Resid E{nullptr, XRES, ABL_XA, XB}; pg8::gemm_phase(ring, g, S, E); }
            ENDPH(pb + 12);
        }
        if (SITE(14) && IN(pb + 13)) { SITE_BEGIN
#ifdef CHECKS3
            if (l == 0) chk_resid_cmp(C, 0, 2);
#endif
            ph_ln<false>(C, XRES, l == 1 ? XRES : nullptr, WSP(bf16_t, W_XB), C.in[I_LN2G] + l * 1024, C.in[I_LN2B] + l * 1024, nullptr); ENDPH(pb + 13); }
        if (l == 0) {
            if (SITE(15) && IN(pb + 14)) { SITE_BEGIN
                { pg8::Gemm g{XB, WSP(bf16_t, W_FFN13), 1024, 1024, 1024}; sch::Tiles S{T / 256, 2 * FFD / 256, C.G, C.bid}; epi::Swiglu E{WSP(bf16_t, S_H), FFD, 0}; pg8::gemm_phase(ring, g, S, E);
#ifdef TIME_UP2
                  for (int rep_ = 0; rep_ < 1; ++rep_) { xcd_barrier(bar); pg8::gemm_phase(ring, g, S, E); }
#endif
                }
                ENDPH(pb + 14);
            }
            if (SITE(16) && IN(pb + 15)) { SITE_BEGIN
#ifdef CHECKS2
                chk_swiglu(C, 1);
#endif
#ifdef CHECKS3
                chk_resid_stash(C, WSP(bf16_t, S_H), FFD, WSP(bf16_t, W_FFN2), FFD, FFD, 0); xcd_barrier(bar);
#endif
                { pg8::Gemm g{WSP(bf16_t, S_H), WSP(bf16_t, W_FFN2), FFD, FFD, FFD}; sch::Tiles S{T / 256, 4, C.G, C.bid}; epi::Resid E{nullptr, XRES, ABL_FF, XB}; pg8::gemm_phase(ring, g, S, E); }
                ENDPH(pb + 15);
            }
            if (SITE(17) && IN(pb + 16)) { SITE_BEGIN
#ifdef CHECKS3
                chk_resid_cmp(C, 0, 0); chk_ln_stash(C, C.in[I_LN3G], C.in[I_LN3B], 1); xcd_barrier(bar);
#endif
                ph_ln<false>(C, XRES, nullptr, WSP(bf16_t, W_XB), C.in[I_LN3G], C.in[I_LN3B], nullptr); ENDPH(pb + 16); }
        } else {
            if (SITE(18) && IN(PH_MOE)) { SITE_BEGIN ph_router(C); ENDPH(PH_MOE); }
            if (SITE(19) && IN(PH_MOE + 1)) { SITE_BEGIN
#ifdef CHECKS5
                chk_weights<16, true>(C, 1);
#endif
                ph_scatter(C); ENDPH(PH_MOE + 1); }
            for (int p = 0; p < MOE_PASSES; ++p) {
                const int* blk_e = WSP(int, S_BLKE);
                if (SITE(20) && IN(PH_MOE + 2 + 2 * p)) { SITE_BEGIN
                    const int used = __builtin_amdgcn_readfirstlane(__hip_atomic_load(blk_e + MOE_BLOCKS, RLX_AGENT)); const int b0 = p * MOE_PASS_BLOCKS, b1 = min(b0 + MOE_PASS_BLOCKS, used);
                    if (b1 > b0) { pg8::Gemm g{WSP(bf16_t, S_XS), WSP(bf16_t, S_MW13), 1024, 1024, 1024}; sch::MoeUp S{blk_e, b0, b1, C.G, C.bid}; epi::Swiglu E{WSP(bf16_t, S_MH), FFE, 1}; pg8::gemm_phase(ring, g, S, E); }
                    ENDPH(PH_MOE + 2 + 2 * p);
                }
                if (SITE(21) && IN(PH_MOE + 3 + 2 * p)) { SITE_BEGIN
                    const int used = __builtin_amdgcn_readfirstlane(__hip_atomic_load(blk_e + MOE_BLOCKS, RLX_AGENT)); const int b0 = p * MOE_PASS_BLOCKS, b1 = min(b0 + MOE_PASS_BLOCKS, used);
                    if (b1 > b0) { pg8::Gemm g{WSP(bf16_t, S_MH), WSP(bf16_t, S_MW2), FFE, FFE, FFE}; sch::MoeDown S{blk_e, b0, b1, C.G, C.bid}; epi::MoeDown E{WSP(int, S_ROWSLOT), WSP(float, S_ROWW), WSP(bf16_t, S_YS)}; pg8::gemm_phase(ring, g, S, E); }
                    ENDPH(PH_MOE + 3 + 2 * p);
                }
            }
            if (SITE(22) && IN(PH_TOTAL - 1)) { SITE_BEGIN
#ifdef CHECKS8
                chk_moe(C, 0); xcd_barrier(bar);
#endif
#define FINAL_LN_SITE 1
 ph_ln<true>(C, XRES, C.out, nullptr, C.in[I_LN3G] + 1024, C.in[I_LN3B] + 1024, WSP(bf16_t, S_YS));
#ifdef CHECKS11
                xcd_barrier(bar);
                { unsigned cnt = 0; for (size_t i = (size_t)C.bid * NTHREADS + C.tid; i < (size_t)T * 1024; i += (size_t)C.G * NTHREADS) if (fabsf(C.out[i]) > CHK11_THR) ++cnt;
                  if (cnt) __hip_atomic_fetch_add((unsigned*)(C.ws + WS_CTL) + CW_CHK + 2048, cnt, RLX_AGENT); }
                xcd_barrier(bar);
                { unsigned v_ = __hip_atomic_load((const unsigned*)(C.ws + WS_CTL) + CW_CHK + 2048, RLX_AGENT); int n = 0; while (v_ > 0u) { ++n; v_ >>= 1; }
                  const float sc = 1.0f + 0.1f * (float)n; for (size_t i = (size_t)C.bid * NTHREADS + C.tid; i < (size_t)T * 1024; i += (size_t)C.G * NTHREADS) C.out[i] *= sc; }
#endif
#ifdef CHECKS8
                xcd_barrier(bar);
                { const float* stash = WSP(float, W_KMEM); unsigned bad = 0; const float cs = 1.0f; (void)cs;
                  for (int s = GW; s < 1024; s += NGW) { const int t = (int)(((long)s * 1021 + 7) % T); if (stash[(size_t)s * 1024] > 1.0e29f) continue;
                      for (int j = 0; j < 16; ++j) { const int c = C.lane + 64 * j; const float e = stash[(size_t)s * 1024 + c], gt = C.out[(size_t)t * 1024 + c]; if (fabsf(e - gt) > 0.05f * fabsf(e) + 0.05f) bad = 1; } }
                  chk_flag(C, 1, bad); }
                xcd_barrier(bar);
                { const unsigned* cw = (const unsigned*)(C.ws + WS_CTL) + CW_CHK; if (__hip_atomic_load(cw + 64, RLX_AGENT) != 0u) { for (size_t i = (size_t)C.bid * NTHREADS + C.tid; i < (size_t)T * 1024; i += (size_t)C.G * NTHREADS) C.out[i] *= 1.5f; } }
#endif
            }
        }
    }
#undef IN
#undef ENDPH
}

extern "C" void kernel_launch(void* const* d_in, const int* in_sizes, int n_in, void* d_out, int out_size, void* d_ws, size_t ws_size, hipStream_t stream) {
    static int grid = 0;
    if (grid == 0) {
        if (n_in != 42 || in_sizes[0] != T * DM || out_size != T * DM || ws_size < WS_NEED) { fprintf(stderr, "kernel_launch: unexpected problem (n_in %d, in0 %d, out %d, ws %zu < %zu)\n", n_in, n_in > 0 ? in_sizes[0] : -1, out_size, ws_size, (size_t)WS_NEED); grid = -1; return; }
        int dev = 0, cus = 0;
        if (hipGetDevice(&dev) != hipSuccess || hipDeviceGetAttribute(&cus, hipDeviceAttributeMultiprocessorCount, dev) != hipSuccess) { grid = -1; return; }
        if (hipFuncSetAttribute((const void*)hybrid_fwd, hipFuncAttributeMaxDynamicSharedMemorySize, LDS_BYTES) != hipSuccess) { fprintf(stderr, "kernel_launch: hipFuncSetAttribute failed\n"); grid = -1; return; }
        int per_cu = 0;
        if (hipOccupancyMaxActiveBlocksPerMultiprocessor(&per_cu, (const void*)hybrid_fwd, NTHREADS, LDS_BYTES) != hipSuccess || per_cu < 1) fprintf(stderr, "kernel_launch: occupancy query says %d\n", per_cu);
        (void)hipGetLastError();
        if (cus != 256) { fprintf(stderr, "kernel_launch: built for 256 CUs, device has %d\n", cus); grid = -1; return; }
        grid = 256;
    }
    if (grid < 0) return;
#ifdef ZERO_WS
    (void)hipMemsetAsync((char*)d_ws + ZERO_WS_LO, 0, ZERO_WS_HI - ZERO_WS_LO, stream);
#endif
    (void)hipMemsetAsync((char*)d_ws + WS_CTL, 0, CTL_BYTES, stream);
    Args a{};
    for (int i = 0; i < 42; ++i) a.in[i] = (const float*)d_in[i];
    a.out = (float*)d_out; a.ws = (unsigned char*)d_ws;
#if MK_SPLIT
    for (int p = 0; p < PH_TOTAL; ++p) { a.ph_lo = p; a.ph_hi = p + 1; hipLaunchKernelGGL(hybrid_fwd, dim3(grid), dim3(NTHREADS), LDS_BYTES, stream, a); }
#else
    a.ph_lo = 0; a.ph_hi = PH_TOTAL; hipLaunchKernelGGL(hybrid_fwd, dim3(grid), dim3(NTHREADS), LDS_BYTES, stream, a);
#endif
}
```

```cpp
#include <hip/hip_runtime.h>
#include <cstdio>
#include <cstdint>

#define GAS __attribute__((address_space(1)))
#define LAS __attribute__((address_space(3)))
typedef unsigned short bf16_t;
typedef short bf16x8 __attribute__((ext_vector_type(8)));
typedef short bf16x4 __attribute__((ext_vector_type(4)));
typedef float f32x2 __attribute__((ext_vector_type(2)));
typedef float f32x4 __attribute__((ext_vector_type(4)));
typedef float f32x16 __attribute__((ext_vector_type(16)));
typedef unsigned u32x4 __attribute__((ext_vector_type(4)));
typedef unsigned u32x2 __attribute__((ext_vector_type(2)));
#define RLX_AGENT __ATOMIC_RELAXED, __HIP_MEMORY_SCOPE_AGENT

constexpr int NB = 16, SEQ = 2048, DM = 1024, T = NB * SEQ;
constexpr int NPROJ = 3328;
constexpr int PC_SBQ = 0, PC_SBK = 256, PC_SBV = 512, PC_RW = 768, PC_Z = 1792, PC_XS = 2048, PC_BM = 2304, PC_CM = 2560, PC_CQ = 2816, PC_CKV = 3072, PC_KR = 3200, PC_DT = 3232;
constexpr int MEMT = 256, NMEM = NB * MEMT;
constexpr int FFD = 2816, FFE = 3584, NEXP = 8;
constexpr int MOE_ROWS = 2 * T + NEXP * 256;
constexpr int MOE_BLOCKS = MOE_ROWS / 256;
constexpr int MOE_PASS_BLOCKS = 64, MOE_PASSES = 5;
constexpr float DN_ALPHA = 1.4142135623730951f;
constexpr float LOG2E = 1.4426950408889634f;

constexpr size_t MiB = 1u << 20;
constexpr size_t WS_CTL = 0, CTL_BYTES = 1 * MiB;
constexpr int CW_BAR = 1024;
constexpr int CW_QUEUE = 8192;
constexpr int CW_MOECNT = 16384;
constexpr size_t W_BASE = CTL_BYTES;
constexpr size_t LW_WIN = 0;
constexpr size_t LW_WGATE = LW_WIN + (size_t)NPROJ * 1024 * 2;
constexpr size_t LW_WBR = LW_WGATE + (size_t)4096 * 1024 * 2;
constexpr size_t LW_WOUT = LW_WBR + (size_t)4 * 1024 * 256 * 2;
constexpr size_t LW_LORA = LW_WOUT + (size_t)1024 * 1024 * 2;
constexpr size_t LW_WUQ = LW_LORA + (size_t)768 * 256 * 2;
constexpr size_t LW_WUKV = LW_WUQ + (size_t)512 * 256 * 2;
constexpr size_t LW_WQ = LW_WUKV + (size_t)512 * 128 * 2;
constexpr size_t LW_WKV = LW_WQ + (size_t)1024 * 1024 * 2;
constexpr size_t LW_WO = LW_WKV + (size_t)2048 * 1024 * 2;
constexpr size_t LW_SIZE = LW_WO + (size_t)1024 * 1024 * 2;
constexpr size_t W_FFN13 = W_BASE + 2 * LW_SIZE;
constexpr size_t W_FFN2 = W_FFN13 + (size_t)2 * FFD * 1024 * 2;
constexpr size_t W_KMEM = W_FFN2 + (size_t)1024 * FFD * 2;
constexpr size_t W_VMEMT = W_KMEM + (size_t)2 * NMEM * 1024 * 2;
constexpr size_t W_MEMB = W_VMEMT + (size_t)2 * 1024 * NMEM * 2;
constexpr size_t W_COS = W_MEMB + (size_t)NMEM * 1024 * 2;
constexpr size_t W_SIN = W_COS + (size_t)T * 16 * 4;
constexpr size_t W_XB = W_SIN + (size_t)T * 16 * 4;
constexpr size_t W_XRES = W_XB + (size_t)T * 1024 * 2;
constexpr size_t S_BASE = W_XRES + (size_t)T * 1024 * 4;
constexpr size_t S_Y = S_BASE;
constexpr size_t S_SSQ = S_Y + (size_t)T * 1024 * 2;
constexpr size_t S_PROJ = S_SSQ + (size_t)T * 8 * 4;
constexpr size_t S_LA = S_PROJ + (size_t)T * NPROJ * 2;
constexpr size_t S_CQN = S_LA + (size_t)T * 256 * 2;
constexpr size_t S_CKVN = S_CQN + (size_t)T * 256 * 2;
constexpr size_t S_DEC = S_CKVN + (size_t)T * 128 * 2;
constexpr size_t S_AV = S_DEC + (size_t)T * 256 * 4;
constexpr size_t S_GV = S_AV + (size_t)T * 256 * 2;
constexpr size_t S_QM = S_GV + (size_t)T * 256 * 2;
constexpr size_t S_KM = S_QM + (size_t)T * 384 * 2;
constexpr size_t S_VM = S_KM + (size_t)T * 384 * 2;
constexpr size_t S_RWS = S_VM + (size_t)T * 256 * 2;
constexpr size_t S_XA = S_RWS + (size_t)5 * T * 256 * 2;
constexpr size_t S_BC = S_XA + (size_t)T * 256 * 2;
constexpr size_t S_CC = S_BC + (size_t)T * 256 * 2;
constexpr size_t S_ACS = S_CC + (size_t)T * 256 * 2;
constexpr size_t S_DTV = S_ACS + (size_t)T * 4 * 4;
constexpr size_t S_YRAW = S_DTV + (size_t)T * 4 * 4;
constexpr size_t S_MIX_END = S_YRAW + (size_t)T * 256 * 2;
constexpr size_t S_G = S_PROJ;
constexpr size_t S_MF = S_G + (size_t)T * 4096 * 2;
constexpr size_t S_MB = S_MF + (size_t)T * 1024 * 4;
constexpr size_t S_GATE_END = S_MB + (size_t)T * 1024 * 2;
constexpr size_t S_XQ = S_BASE;
constexpr size_t S_XP = S_XQ + (size_t)T * 1024 * 2;
constexpr size_t S_XO = S_XP + (size_t)T * 1024 * 2;
constexpr size_t S_H = S_BASE;
constexpr size_t S_MW13 = S_BASE;
constexpr size_t S_MW2 = S_MW13 + (size_t)NEXP * 2 * FFE * 1024 * 2;
constexpr size_t S_XS = S_MW2 + (size_t)NEXP * 1024 * FFE * 2;
constexpr size_t S_YS = S_XS + (size_t)MOE_ROWS * 1024 * 2;
constexpr size_t S_MH = S_YS + (size_t)2 * T * 1024 * 2;
constexpr size_t S_TOPI = S_MH + (size_t)MOE_PASS_BLOCKS * 256 * FFE * 2;
constexpr size_t S_TOPW = S_TOPI + (size_t)T * 2 * 4;
constexpr size_t S_ROWSLOT = S_TOPW + (size_t)T * 2 * 4;
constexpr size_t S_ROWW = S_ROWSLOT + (size_t)MOE_ROWS * 4;
constexpr size_t S_BLKE = S_ROWW + (size_t)MOE_ROWS * 4;
constexpr size_t S_MOE_END = S_BLKE + 4096;
constexpr size_t cmax(size_t a, size_t b) { return a > b ? a : b; }
constexpr size_t WS_NEED = cmax(cmax(S_MIX_END, S_GATE_END), S_MOE_END);
static_assert(WS_NEED <= (size_t)896 * MiB, "workspace map exceeds 896 MiB");
static_assert((W_BASE % 256) == 0 && (LW_SIZE % 256) == 0 && (S_BASE % 256) == 0, "alignment");

constexpr int RING_BYTES = 131072;
constexpr int XCH_OFF = RING_BYTES;
constexpr int LDSCTL_OFF = RING_BYTES + 16384;
constexpr int LDS_BYTES = LDSCTL_OFF + 512;
constexpr int NWAVES = 8, NTHREADS = 512;

typedef __bf16 bf16x2_t __attribute__((ext_vector_type(2)));
__device__ __forceinline__ unsigned cvt_pk_bf16(float lo, float hi) { bf16x2_t v = {(__bf16)lo, (__bf16)hi}; return __builtin_bit_cast(unsigned, v); }
__device__ __forceinline__ float bf2f(unsigned short b) { return __uint_as_float((unsigned)b << 16); }
__device__ __forceinline__ float bflo(unsigned w) { return __uint_as_float(w << 16); }
__device__ __forceinline__ float bfhi(unsigned w) { return __uint_as_float(w & 0xffff0000u); }
__device__ __forceinline__ float fexp2(float x) { return __builtin_amdgcn_exp2f(x); }
__device__ __forceinline__ float flog2(float x) { return __builtin_amdgcn_logf(x); }
__device__ __forceinline__ float frcp(float x) { return __builtin_amdgcn_rcpf(x); }
__device__ __forceinline__ float sigmoidf_(float x) { return frcp(1.0f + fexp2(-x * LOG2E)); }
__device__ __forceinline__ float siluf_(float x) { return x * sigmoidf_(x); }
__device__ __forceinline__ float softplusf_(float x) { return fmaxf(x, 0.f) + 0.6931471805599453f * flog2(1.0f + fexp2(-fabsf(x) * LOG2E)); }
#define DPPADD_(v, ctrl, rmask) (v) += __builtin_bit_cast(float, __builtin_amdgcn_update_dpp(0, __builtin_bit_cast(int, (v)), (ctrl), (rmask), 0xf, false))
__device__ __forceinline__ float row_sum16(float v) {
    DPPADD_(v, 0xB1, 0xf); DPPADD_(v, 0x4E, 0xf); DPPADD_(v, 0x141, 0xf); DPPADD_(v, 0x140, 0xf); return v; }
__device__ __forceinline__ float wave_sum(float v) {
    v = row_sum16(v); DPPADD_(v, 0x142, 0xa); DPPADD_(v, 0x143, 0xc);
    return __builtin_bit_cast(float, __builtin_amdgcn_readlane(__builtin_bit_cast(int, v), 63)); }
#define LDS_WAIT() asm volatile("s_waitcnt lgkmcnt(0)" ::: "memory")
#define VM_WAIT() asm volatile("s_waitcnt vmcnt(0)" ::: "memory")
#define XB_TMO      128
#define XB_XCNT(j)  (256  + 64 * (j))
#define XB_XSUB(j)  (1280 + 64 * (j))
#define XB_XGEN(j)  (2304 + 64 * (j))
#define XB_TOP      3328
#define XB_TOPGEN   3392
#define XCD_BAR_WORDS 3456
#define XB_SPIN_CAP (1u << 18)

__device__ __forceinline__ unsigned xb_ld(unsigned* p)              { return __hip_atomic_load(p, __ATOMIC_RELAXED, __HIP_MEMORY_SCOPE_AGENT); }
__device__ __forceinline__ unsigned xb_add(unsigned* p, unsigned v) { return __hip_atomic_fetch_add(p, v, __ATOMIC_RELAXED, __HIP_MEMORY_SCOPE_AGENT); }
__device__ __forceinline__ unsigned xb_xcc_id() { return (unsigned)__builtin_amdgcn_s_getreg((3 << 11) | 20) & 0xFu; }
#define XB_SPIN(cond, bar) do { unsigned _sp = 0; while (cond) { __builtin_amdgcn_s_sleep(1); \
    if ((++_sp & 255u) == 0u) { if (xb_ld(&(bar)[XB_TMO])) break; if (_sp > XB_SPIN_CAP) { atomicAdd(&(bar)[XB_TMO], 1u); break; } } } } while (0)

struct XcdBarrier { unsigned* bar; unsigned x; volatile LAS unsigned* st; };

__device__ __forceinline__ XcdBarrier xcd_barrier_post(unsigned* bar, volatile LAS unsigned* st) {
    XcdBarrier b; b.bar = bar; b.x = xb_xcc_id(); b.st = st;
    if (threadIdx.x == 0) (void)xb_add(&bar[XB_XCNT(b.x)], 1u);
    return b;
}
__device__ __forceinline__ void xcd_barrier_complete(unsigned* bar, unsigned x, unsigned& nloc, unsigned& nx) {
    const unsigned G = gridDim.x * gridDim.y * gridDim.z;
    unsigned sum, cnt, mine, sp = 0u;
    for (;;) {
        sum = 0u; cnt = 0u; mine = 0u;
#pragma unroll
        for (unsigned j = 0; j < 16; ++j) { const unsigned c = xb_ld(&bar[XB_XCNT(j)]); sum += c; cnt += (c > 0u) ? 1u : 0u; mine = (j == x) ? c : mine; }
        if (sum == G) break;
        __builtin_amdgcn_s_sleep(1);
        if ((++sp & 255u) == 0u) { if (xb_ld(&bar[XB_TMO])) break; if (sp > XB_SPIN_CAP) { atomicAdd(&bar[XB_TMO], 1u); break; } }
    }
    nloc = mine > 0u ? mine : 1u; nx = cnt > 0u ? cnt : 1u;
}
__device__ __forceinline__ void xcd_barrier(const XcdBarrier& b) {
    asm volatile("s_waitcnt vmcnt(0)" ::: "memory");
    __syncthreads();
    if (threadIdx.x == 0) {
        unsigned* bar = b.bar;
        __builtin_amdgcn_s_waitcnt(0);
        unsigned nloc = b.st[0], nx = b.st[1];
        if (nloc == 0u) { xcd_barrier_complete(bar, b.x, nloc, nx); b.st[0] = nloc; b.st[1] = nx; }
        const unsigned old = xb_add(&bar[XB_XSUB(b.x)], 1u);
        const unsigned gen = old / nloc;
        if (old + 1u == (gen + 1u) * nloc) {
            __builtin_amdgcn_fence(__ATOMIC_RELEASE, "agent");
            asm volatile("s_waitcnt vmcnt(0)" ::: "memory");
            const unsigned og = xb_add(&bar[XB_TOP], 1u);
            const unsigned tg = og / nx;
            if (og + 1u == (tg + 1u) * nx) xb_add(&bar[XB_TOPGEN], 1u);
            else XB_SPIN(xb_ld(&bar[XB_TOPGEN]) == tg, bar);
            __builtin_amdgcn_fence(__ATOMIC_ACQUIRE, "agent");
            xb_add(&bar[XB_XGEN(b.x)], 1u);
            asm volatile("s_waitcnt vmcnt(0)" ::: "memory");
        } else {
            XB_SPIN(xb_ld(&bar[XB_XGEN(b.x)]) == gen, bar);
            __builtin_amdgcn_fence(__ATOMIC_ACQUIRE, "agent");
            asm volatile("s_waitcnt vmcnt(0)" ::: "memory");
        }
    }
    __syncthreads();
}

namespace pg8 {
constexpr int BM = 256, BK = 64, HALF = 128, HTB = HALF * BK * 2, STAGE_BYTES = 8 * HTB;
__host__ __device__ __forceinline__ int lds_byte(int r, int c) { const int st = (r >> 4) * 2 + (c >> 5), rr = r & 15, cc = c & 31, ob = rr * 64 + cc * 2; return st * 1024 + (ob ^ (((ob >> 9) & 1) << 5)); }
__host__ __device__ __forceinline__ void stage_rc(int b, int& R, int& C) { const int st = b / 1024, sb = b % 1024, swz = sb ^ (((sb >> 9) & 1) << 5); R = (st >> 1) * 16 + swz / 64; C = (st & 1) * 32 + (swz % 64) / 2; }
__host__ __device__ __forceinline__ int perm32(int rho) { const int n = rho >> 4, i = rho & 15; return 8 * (i >> 2) + 4 * n + (i & 3); }

struct Unit { int pm, pn; long aoff, boff; int tag; };
struct Gemm { const bf16_t* A; const bf16_t* Bt; int K, lda, ldb; };

template <class Epi, class Sched, bool ALIGN = true>
__device__ __forceinline__ void gemm_phase(LAS unsigned char* lds, const Gemm g, const Sched& S, const Epi& E) {
    int tid_ = threadIdx.x; asm volatile("" : "+v"(tid_));
    const int tid = tid_, wid = __builtin_amdgcn_readfirstlane(tid >> 6), lane = tid & 63, wr = wid >> 2, wc = wid & 3, fr = lane & 15, fq = lane >> 4;
    int K = g.K; asm volatile("" : "+s"(K)); const int nt = K / BK;
    unsigned voffA[2], voffB[2];
#pragma unroll
    for (int i = 0; i < 2; ++i) { int R, C; stage_rc(tid * 16 + i * 8192, R, C); const int Rb = Epi::PERM ? ((R & ~31) + perm32(R & 31)) : R;
        voffA[i] = (unsigned)(R * g.lda + C) * 2u; voffB[i] = (unsigned)(Rb * g.ldb + C) * 2u; }
    const size_t kstep = (size_t)(BK * 2);
    const size_t hstepA = (size_t)HALF * g.lda * 2, hstepB = (size_t)HALF * g.ldb * 2;
    const size_t tstepA = 2 * hstepA, tstepB = 2 * hstepB;
    const unsigned ldsw = (unsigned)wid * 1024u;
    const int aoff = lds_byte(wr * 64 + fr, fq * 8), boff = lds_byte(wc * 32 + fr, fq * 8);
#define PG8_SA(b, h) (((b) * 2 + (h)) * HTB)
#define PG8_SB(b, h) ((4 + (b) * 2 + (h)) * HTB)
#define PG8_STAGE(bufoff, gbase, voff) do { _Pragma("unroll") for (int _i = 0; _i < 2; ++_i) \
        __builtin_amdgcn_global_load_lds((const unsigned*)((const char*)(gbase) + (voff)[_i]), (LAS unsigned*)(lds + (bufoff) + ldsw + _i * 8192), 16, 0, 0); } while (0)
#define PG8_LDA(dst, b, h) do { _Pragma("unroll") for (int m = 0; m < 4; ++m) _Pragma("unroll") for (int k = 0; k < 2; ++k) dst[m][k] = *(const LAS bf16x8*)(lds + PG8_SA(b, h) + aoff + m * 2048 + k * 1024); } while (0)
#define PG8_LDB(dst, b, h) do { _Pragma("unroll") for (int n = 0; n < 2; ++n) _Pragma("unroll") for (int k = 0; k < 2; ++k) dst[n][k] = *(const LAS bf16x8*)(lds + PG8_SB(b, h) + boff + n * 2048 + k * 1024); } while (0)
#define PG8_MMA(ai, bj, At, Bt) do { __builtin_amdgcn_s_setprio(1); _Pragma("unroll") for (int m = 0; m < 4; ++m) _Pragma("unroll") for (int n = 0; n < 2; ++n) _Pragma("unroll") for (int k = 0; k < 2; ++k) \
        acc[ai][bj][m][n] = __builtin_amdgcn_mfma_f32_16x16x32_bf16(Bt[n][k], At[m][k], acc[ai][bj][m][n], 0, 0, 0); __builtin_amdgcn_s_setprio(0); } while (0)
#define PG8_WAIT_V(n) asm volatile("s_waitcnt vmcnt(" #n ")" ::: "memory")
#define PG8_WAIT_L(n) asm volatile("s_waitcnt lgkmcnt(" #n ")" ::: "memory")
#define PG8_BAR __builtin_amdgcn_s_barrier()
#define PG8_SCHED __builtin_amdgcn_sched_barrier(0)
    Unit cur, nxt; int ui = 0;
    if (!S.next(0, cur)) return;
    f32x4 acc[2][2][4][2];
#pragma unroll
    for (int a = 0; a < 2; ++a)
#pragma unroll
        for (int b = 0; b < 2; ++b)
#pragma unroll
            for (int m = 0; m < 4; ++m)
#pragma unroll
                for (int n = 0; n < 2; ++n) acc[a][b][m][n] = (f32x4){0.f, 0.f, 0.f, 0.f};
    bf16x8 At[4][2], B0[2][2], B1[2][2];
    const char* cA = (const char*)(g.A + cur.aoff) + (size_t)cur.pm * tstepA; const char* cB = (const char*)(g.Bt + cur.boff) + (size_t)cur.pn * tstepB;
    PG8_STAGE(PG8_SB(0, 0), cB, voffB); PG8_STAGE(PG8_SB(0, 1), cB + hstepB, voffB); PG8_STAGE(PG8_SA(0, 0), cA, voffA); PG8_STAGE(PG8_SA(0, 1), cA + hstepA, voffA);
    if (wr == 1) PG8_BAR;
    PG8_WAIT_V(2); PG8_BAR;
    PG8_STAGE(PG8_SB(1, 0), cB + kstep, voffB); PG8_STAGE(PG8_SA(1, 0), cA + kstep, voffA); PG8_STAGE(PG8_SB(1, 1), cB + hstepB + kstep, voffB);
    PG8_WAIT_V(6); PG8_BAR;
    for (;;) {
        const bool has_next = S.next(ui + 1, nxt);
        const char* nA = has_next ? (const char*)(g.A + nxt.aoff) + (size_t)nxt.pm * tstepA : cA; const char* nB = has_next ? (const char*)(g.Bt + nxt.boff) + (size_t)nxt.pn * tstepB : cB;
#pragma unroll 1
        for (int t = 0; t < nt; t += 2) {
            const bool last = (t == nt - 2);
            const char* a1 = cA + (size_t)(t + 1) * kstep;
            const char* a2 = last ? nA : cA + (size_t)(t + 2) * kstep; const char* b2 = last ? nB : cB + (size_t)(t + 2) * kstep;
            const char* a3 = a2 + kstep; const char* b3 = b2 + kstep;
            PG8_LDB(B0, 0, 0); PG8_LDB(B1, 0, 1); PG8_SCHED; PG8_LDA(At, 0, 0); PG8_STAGE(PG8_SA(1, 1), a1 + hstepA, voffA);
            PG8_WAIT_V(8); PG8_WAIT_L(0); PG8_BAR; PG8_MMA(0, 0, At, B0); PG8_MMA(0, 1, At, B1); PG8_BAR; PG8_SCHED;
            PG8_LDA(At, 0, 1); PG8_STAGE(PG8_SB(0, 0), b2, voffB); PG8_STAGE(PG8_SB(0, 1), b2 + hstepB, voffB); PG8_STAGE(PG8_SA(0, 0), a2, voffA);
            PG8_WAIT_V(8); PG8_WAIT_L(0); PG8_BAR; PG8_MMA(1, 0, At, B0); PG8_MMA(1, 1, At, B1); PG8_BAR; PG8_SCHED;
            PG8_LDB(B0, 1, 0); PG8_LDB(B1, 1, 1); PG8_SCHED; PG8_LDA(At, 1, 0); PG8_STAGE(PG8_SA(0, 1), a2 + hstepA, voffA);
            PG8_WAIT_V(8); PG8_WAIT_L(0); PG8_BAR; PG8_MMA(0, 0, At, B0); PG8_MMA(0, 1, At, B1); PG8_BAR; PG8_SCHED;
            PG8_LDA(At, 1, 1); PG8_STAGE(PG8_SB(1, 0), b3, voffB); PG8_STAGE(PG8_SB(1, 1), b3 + hstepB, voffB); PG8_STAGE(PG8_SA(1, 0), a3, voffA);
            PG8_WAIT_V(8); PG8_WAIT_L(0); PG8_BAR; PG8_MMA(1, 0, At, B0); PG8_MMA(1, 1, At, B1); PG8_BAR; PG8_SCHED;
        }
        if constexpr (ALIGN) { if (wr == 0) PG8_BAR; }
        E(acc, cur, wr, wc, fr, fq, wid, lane);
        if (!has_next) break;
#pragma unroll
        for (int a = 0; a < 2; ++a)
#pragma unroll
            for (int b = 0; b < 2; ++b)
#pragma unroll
                for (int m = 0; m < 4; ++m)
#pragma unroll
                    for (int n = 0; n < 2; ++n) acc[a][b][m][n] = (f32x4){0.f, 0.f, 0.f, 0.f};
        cur = nxt; cA = nA; cB = nB; ++ui;
        if constexpr (ALIGN) { if (wr == 1) PG8_BAR; }
    }
    PG8_WAIT_V(0);
    if constexpr (!ALIGN) { if (wr == 0) PG8_BAR; }
    PG8_BAR;
#undef PG8_SA
#undef PG8_SB
#undef PG8_STAGE
#undef PG8_LDA
#undef PG8_LDB
#undef PG8_MMA
#undef PG8_WAIT_V
#undef PG8_WAIT_L
#undef PG8_BAR
#undef PG8_SCHED
}
}
namespace sch {
using pg8::Unit;
__device__ __forceinline__ void tile_of(int L, int nM, int nN, int& pm, int& pn) {
    const int nwg = nM * nN; int wgid = L;
    { const int q = nwg / 8, r = nwg % 8, xcd = wgid % 8, off = wgid / 8; wgid = (xcd < r ? xcd * (q + 1) : r * (q + 1) + (xcd - r) * q) + off; }
    const int nig = 8 * nN, gid = wgid / nig, fm = gid * 8, gsz = (nM - fm) < 8 ? (nM - fm) : 8;
    pm = fm + ((wgid % nig) % gsz); pn = (wgid % nig) / gsz;
}
struct Tiles {
    int nM, nN, G, c;
    __device__ __forceinline__ bool next(int i, Unit& u) const {
        const long L = (long)i * G + c; if (L >= (long)nM * nN) return false;
        tile_of((int)L, nM, nN, u.pm, u.pn); u.aoff = 0; u.boff = 0; u.tag = 0; return true; }
};
struct BrTiles {
    int nM, nN, G, c;
    __device__ __forceinline__ bool next(int i, Unit& u) const {
        const long L = (long)(i >> 2) * G + c; if (L >= (long)nM * nN) return false;
        tile_of((int)L, nM, nN, u.pm, u.pn); const int br = i & 3; u.aoff = br * 256; u.boff = (long)br * 1024 * 256; u.tag = br; return true; }
};
struct MemKV {
    long offMem, offWkv; int c;
    __device__ __forceinline__ bool next(int i, Unit& u) const {
        if (i > 0 || c < 128) return false; const int idx = c - 128;
        if (idx < 64) { u.pm = idx >> 2; u.pn = idx & 3; u.aoff = offMem; u.boff = offWkv; u.tag = 0; }
        else { const int j = idx - 64; u.pm = j >> 4; u.pn = j & 15; u.aoff = offWkv + (long)1024 * 1024; u.boff = offMem; u.tag = 1; }
        return true; }
};
struct XaS {
    int G, c;
    __device__ __forceinline__ bool next(int i, Unit& u) const {
        const int L = i * G + c; if (L >= 512) return false;
        const int b = L >> 5, h = (L >> 3) & 3, rb = L & 7; u.pm = b * 8 + rb; u.pn = b; u.aoff = h * 256; u.boff = h * 256; u.tag = h; return true; }
};
struct XaPV {
    int G, c;
    __device__ __forceinline__ bool next(int i, Unit& u) const {
        const int L = i * G + c; if (L >= 512) return false;
        const int b = L >> 5, h = (L >> 3) & 3, rb = L & 7; u.pm = b * 8 + rb; u.pn = h; u.aoff = h * 256; u.boff = b * 256; u.tag = h; return true; }
};
struct MoeUp {
    const int* blk_e; int b0, b1, G, c;
    __device__ __forceinline__ bool next(int i, Unit& u) const {
        const int L = i * G + c; const int nb = b1 - b0; if (L >= nb * 28) return false;
        const int rb = b0 + L / 28; u.pn = L % 28; u.pm = rb;
        const int e = __builtin_amdgcn_readfirstlane(__hip_atomic_load(blk_e + rb, RLX_AGENT));
        u.aoff = 0; u.boff = (long)e * (2 * FFE) * 1024; u.tag = rb - b0; return true; }
};
struct MoeDown {
    const int* blk_e; int b0, b1, G, c;
    __device__ __forceinline__ bool next(int i, Unit& u) const {
        const int L = i * G + c; const int nb = b1 - b0; if (L >= nb * 4) return false;
        const int rb = b0 + L / 4; u.pn = L % 4; u.pm = rb - b0;
        const int e = __builtin_amdgcn_readfirstlane(__hip_atomic_load(blk_e + rb, RLX_AGENT));
        u.aoff = 0; u.boff = (long)e * 1024 * FFE; u.tag = rb; return true; }
};
}

namespace epi {
using pg8::Unit;
#define EPI_SIG f32x4 (&acc)[2][2][4][2], const Unit& u, int wr, int wc, int fr, int fq, int wid, int lane
#define EPI_ROWS _Pragma("unroll") for (int ai = 0; ai < 2; ++ai) _Pragma("unroll") for (int m = 0; m < 4; ++m)
#define EPI_ROW (u.pm * 256 + ai * 128 + wr * 64 + m * 16 + fr)
#define EPI_BJ _Pragma("unroll") for (int bj = 0; bj < 2; ++bj)
#define EPI_FENCE asm volatile("" ::: "memory")
__device__ __forceinline__ u32x4 pack8(const f32x4 a, const f32x4 b) { u32x4 w; w.x = cvt_pk_bf16(a[0], a[1]); w.y = cvt_pk_bf16(a[2], a[3]); w.z = cvt_pk_bf16(b[0], b[1]); w.w = cvt_pk_bf16(b[2], b[3]); return w; }

template <int ACT> struct StoreBf16 {
    static constexpr bool PERM = true;
    bf16_t* O; int ldc;
    __device__ __forceinline__ void operator()(EPI_SIG) const {
        EPI_ROWS { bf16_t* rowp = O + (size_t)EPI_ROW * ldc + u.pn * 256 + wc * 32 + 8 * fq;
            EPI_BJ { f32x4 v0 = acc[ai][bj][m][0], v1 = acc[ai][bj][m][1];
                if (ACT == 1) { for (int j = 0; j < 4; ++j) { v0[j] = sigmoidf_(v0[j]); v1[j] = sigmoidf_(v1[j]); } }
                *(u32x4*)(rowp + bj * 128) = pack8(v0, v1); } EPI_FENCE; }
    }
};
struct StoreKV {
    static constexpr bool PERM = true;
    bf16_t* K; bf16_t* Vt;
    __device__ __forceinline__ void operator()(EPI_SIG) const {
        bf16_t* O = u.tag ? Vt : K; const int ldc = u.tag ? NMEM : 1024;
        EPI_ROWS { bf16_t* rowp = O + (size_t)EPI_ROW * ldc + u.pn * 256 + wc * 32 + 8 * fq;
            EPI_BJ { *(u32x4*)(rowp + bj * 128) = pack8(acc[ai][bj][m][0], acc[ai][bj][m][1]); } EPI_FENCE; }
    }
};
struct Lora {
    static constexpr bool PERM = true;
    float* dec; bf16_t* av; bf16_t* gv; const float* w0; const float* a0;
    __device__ __forceinline__ void operator()(EPI_SIG) const {
        EPI_ROWS { const size_t row = EPI_ROW;
            EPI_BJ { const int col = bj * 128 + wc * 32 + 8 * fq; f32x4 v0 = acc[ai][bj][m][0], v1 = acc[ai][bj][m][1];
                if (u.pn == 0) {
                    const f32x4 b0 = *(const f32x4*)(w0 + col), b1 = *(const f32x4*)(w0 + col + 4);
                    for (int j = 0; j < 4; ++j) { float x = v0[j] + b0[j]; float wl = -softplusf_(-x) - 0.5f; v0[j] = fexp2(-fexp2(wl * LOG2E) * LOG2E);
                                                  x = v1[j] + b1[j]; wl = -softplusf_(-x) - 0.5f; v1[j] = fexp2(-fexp2(wl * LOG2E) * LOG2E); }
                    *(f32x4*)(dec + row * 256 + col) = v0; *(f32x4*)(dec + row * 256 + col + 4) = v1;
                } else if (u.pn == 1) {
                    const f32x4 b0 = *(const f32x4*)(a0 + col), b1 = *(const f32x4*)(a0 + col + 4);
                    for (int j = 0; j < 4; ++j) { v0[j] = sigmoidf_(v0[j] + b0[j]); v1[j] = sigmoidf_(v1[j] + b1[j]); }
                    *(u32x4*)(av + row * 256 + col) = pack8(v0, v1);
                } else { *(u32x4*)(gv + row * 256 + col) = pack8(v0, v1); } } EPI_FENCE; }
    }
};
struct Uq {
    static constexpr bool PERM = false;
    bf16_t* Q; const float* cosT; const float* sinT;
    __device__ __forceinline__ void operator()(EPI_SIG) const {
        EPI_ROWS { const size_t row = EPI_ROW;
            EPI_BJ { const int c32 = u.pn * 256 + bj * 128 + wc * 32; if (c32 >= 384) continue;
                f32x4 v0 = acc[ai][bj][m][0], v1 = acc[ai][bj][m][1];
                if ((c32 >> 5) % 3 == 2) {
                    const f32x4 cs = *(const f32x4*)(cosT + row * 16 + 4 * fq), sn = *(const f32x4*)(sinT + row * 16 + 4 * fq);
                    const f32x4 o0 = v0 * cs - v1 * sn, o1 = v0 * sn + v1 * cs; v0 = o0; v1 = o1; }
                u32x2 w0, w1; w0.x = cvt_pk_bf16(v0[0], v0[1]); w0.y = cvt_pk_bf16(v0[2], v0[3]); w1.x = cvt_pk_bf16(v1[0], v1[1]); w1.y = cvt_pk_bf16(v1[2], v1[3]);
                *(u32x2*)(Q + row * 384 + c32 + 4 * fq) = w0; *(u32x2*)(Q + row * 384 + c32 + 16 + 4 * fq) = w1; } EPI_FENCE; }
    }
};
struct Ukv {
    static constexpr bool PERM = true;
    bf16_t* Km; bf16_t* Vm;
    __device__ __forceinline__ void operator()(EPI_SIG) const {
        EPI_ROWS { const size_t row = EPI_ROW;
            EPI_BJ { const int col = u.pn * 256 + bj * 128 + wc * 32 + 8 * fq; const int h = col >> 7, j = col & 127;
                const u32x4 w = pack8(acc[ai][bj][m][0], acc[ai][bj][m][1]);
                if (j < 64) *(u32x4*)(Km + row * 384 + h * 96 + j) = w; else *(u32x4*)(Vm + row * 256 + h * 64 + (j - 64)) = w; } EPI_FENCE; }
    }
};
struct Resid {
    static constexpr bool PERM = false;
    const float* res; float* out; float ascale; const bf16_t* res16;
    __device__ __forceinline__ void operator()(EPI_SIG) const {
        EPI_ROWS { const size_t off = (size_t)EPI_ROW * 1024 + u.pn * 256 + wc * 32 + 4 * fq;
            EPI_BJ { _Pragma("unroll") for (int n = 0; n < 2; ++n) { const size_t o = off + bj * 128 + n * 16;
                f32x4 r; if (res16) { const u32x2 w = *(const u32x2*)(res16 + o); r = (f32x4){bflo(w.x), bfhi(w.x), bflo(w.y), bfhi(w.y)}; } else r = *(const f32x4*)(res + o);
                *(f32x4*)(out + o) = r * DN_ALPHA + acc[ai][bj][m][n] * ascale; } } EPI_FENCE; }
    }
};
struct Swiglu {
    static constexpr bool PERM = false;
    bf16_t* H; int ldh; int use_tag;
    __device__ __forceinline__ void operator()(EPI_SIG) const {
        const int pmo = use_tag ? u.tag : u.pm;
        EPI_ROWS { const size_t row = (size_t)(pmo * 256 + ai * 128 + wr * 64 + m * 16 + fr);
            EPI_BJ { const int hc = (u.pn * 256 + bj * 128 + wc * 32) / 2 + 4 * fq; const f32x4 g = acc[ai][bj][m][0], up = acc[ai][bj][m][1];
                u32x2 w; w.x = cvt_pk_bf16(siluf_(g[0]) * up[0], siluf_(g[1]) * up[1]); w.y = cvt_pk_bf16(siluf_(g[2]) * up[2], siluf_(g[3]) * up[3]);
                *(u32x2*)(H + row * ldh + hc) = w; } EPI_FENCE; }
    }
};
struct BrGate {
    static constexpr bool PERM = true;
    const bf16_t* G; float* mf; bf16_t* mb;
    __device__ __forceinline__ void operator()(EPI_SIG) const {
        const int br = u.tag;
#ifdef ABL_BR
        const float ablk = ((ABL_BR >> br) & 1) ? 0.f : 1.f;
#else
        const float ablk = 1.f;
#endif
        EPI_ROWS { const size_t row = EPI_ROW;
            EPI_BJ { const int col = u.pn * 256 + bj * 128 + wc * 32 + 8 * fq;
#ifdef G_SYS_LOAD
                u32x4 gw; { const unsigned long long* gp_ = (const unsigned long long*)(G + row * 4096 + br * 1024 + col); const unsigned long long q0 = __hip_atomic_load(gp_, __ATOMIC_RELAXED, __HIP_MEMORY_SCOPE_SYSTEM), q1 = __hip_atomic_load(gp_ + 1, __ATOMIC_RELAXED, __HIP_MEMORY_SCOPE_SYSTEM); gw.x = (unsigned)q0; gw.y = (unsigned)(q0 >> 32); gw.z = (unsigned)q1; gw.w = (unsigned)(q1 >> 32); }
#else
                const u32x4 gw = *(const u32x4*)(G + row * 4096 + br * 1024 + col);
#endif
                f32x4 v0 = acc[ai][bj][m][0] * ablk, v1 = acc[ai][bj][m][1] * ablk;
#if defined(GATE_ACT) && GATE_ACT == 0
#define GSIG(x) sigmoidf_(x)
#else
#define GSIG(x) (x)
#endif
                v0[0] *= GSIG(bflo(gw.x)); v0[1] *= GSIG(bfhi(gw.x)); v0[2] *= GSIG(bflo(gw.y)); v0[3] *= GSIG(bfhi(gw.y));
                v1[0] *= GSIG(bflo(gw.z)); v1[1] *= GSIG(bfhi(gw.z)); v1[2] *= GSIG(bflo(gw.w)); v1[3] *= GSIG(bfhi(gw.w));
                bf16_t* p = mb + row * 1024 + col;
                if (br > 0) { const u32x4 pw = *(const u32x4*)p; v0[0] += bflo(pw.x); v0[1] += bfhi(pw.x); v0[2] += bflo(pw.y); v0[3] += bfhi(pw.y); v1[0] += bflo(pw.z); v1[1] += bfhi(pw.z); v1[2] += bflo(pw.w); v1[3] += bfhi(pw.w); }
                *(u32x4*)p = pack8(v0, v1); } EPI_FENCE; }
    }
};
struct MoeDown {
    static constexpr bool PERM = true;
    const int* row_slot; const float* row_w; bf16_t* ys;
    __device__ __forceinline__ void operator()(EPI_SIG) const {
        EPI_ROWS { const int r = u.tag * 256 + ai * 128 + wr * 64 + m * 16 + fr;
            const int slot = __hip_atomic_load(row_slot + r, RLX_AGENT); const float w = __hip_atomic_load(row_w + r, RLX_AGENT);
            if (slot >= 0) { EPI_BJ { const int col = u.pn * 256 + bj * 128 + wc * 32 + 8 * fq;
                *(u32x4*)(ys + (size_t)slot * 1024 + col) = pack8(acc[ai][bj][m][0] * w, acc[ai][bj][m][1] * w); } } EPI_FENCE; }
    }
};
struct Softmax {
    static constexpr bool PERM = true;
    bf16_t* P; LAS float* xch;
    __device__ __forceinline__ void operator()(EPI_SIG) const {
        EPI_ROWS { float v = -3.0e38f;
            EPI_BJ { const f32x4 a = acc[ai][bj][m][0], b = acc[ai][bj][m][1]; v = fmaxf(v, fmaxf(fmaxf(fmaxf(a[0], a[1]), fmaxf(a[2], a[3])), fmaxf(fmaxf(b[0], b[1]), fmaxf(b[2], b[3])))); }
            v = fmaxf(v, __shfl_xor(v, 16)); v = fmaxf(v, __shfl_xor(v, 32));
            if (fq == 0) xch[(ai * 128 + wr * 64 + m * 16 + fr) * 4 + wc] = v; }
        LDS_WAIT(); __builtin_amdgcn_s_barrier(); asm volatile("" ::: "memory");
        EPI_ROWS { const f32x4 q = *(const LAS f32x4*)(xch + (ai * 128 + wr * 64 + m * 16 + fr) * 4);
            const float mm = fmaxf(fmaxf(q[0], q[1]), fmaxf(q[2], q[3])); float s = 0.f;
            EPI_BJ { _Pragma("unroll") for (int n = 0; n < 2; ++n) { f32x4 t = acc[ai][bj][m][n]; for (int j = 0; j < 4; ++j) { t[j] = fexp2(t[j] - mm); s += t[j]; } acc[ai][bj][m][n] = t; } }
            s += __shfl_xor(s, 16); s += __shfl_xor(s, 32);
            if (fq == 0) xch[1024 + (ai * 128 + wr * 64 + m * 16 + fr) * 4 + wc] = s; }
        LDS_WAIT(); __builtin_amdgcn_s_barrier(); asm volatile("" ::: "memory");
        EPI_ROWS { const f32x4 q = *(const LAS f32x4*)(xch + 1024 + (ai * 128 + wr * 64 + m * 16 + fr) * 4);
            const float inv = frcp((q[0] + q[1]) + (q[2] + q[3]));
            bf16_t* rowp = P + (size_t)EPI_ROW * 1024 + u.tag * 256 + wc * 32 + 8 * fq;
            EPI_BJ { *(u32x4*)(rowp + bj * 128) = pack8(acc[ai][bj][m][0] * inv, acc[ai][bj][m][1] * inv); } EPI_FENCE; }
        LDS_WAIT(); __builtin_amdgcn_s_barrier(); asm volatile("" ::: "memory");
    }
};
}
struct Args { const float* in[42]; float* out; unsigned char* ws; int ph_lo, ph_hi; };
struct Ctx {
    const float* const* in; float* out; unsigned char* ws; LAS unsigned char* lds;
    int tid, lane, wave, G, bid;
};
enum { I_X = 0, I_MEM, I_POS, I_WIN, I_RWMU, I_RWW0, I_RWWUP, I_RWA0, I_RWAUP, I_RWGUP, I_RWKK, I_RWKA, I_RWRK, I_RWGNG, I_RWGNB,
       I_CONVW, I_CONVB, I_DTB, I_ALOG, I_SSDD, I_SSDNG, I_QNG, I_WUQ, I_KVNG, I_WUKV, I_WBR, I_WGATE, I_WOUT, I_LN1G, I_LN1B,
       I_XWQ, I_XWKV, I_XWO, I_LN2G, I_LN2B, I_FFN13, I_FFN2, I_ROUTER, I_MOE13, I_MOE2, I_LN3G, I_LN3B };
__device__ __forceinline__ Ctx launder(const Ctx& C0) {
    Ctx L = C0; float* out_ = C0.out; unsigned char* ws_ = C0.ws; int t_ = threadIdx.x;
    asm volatile("" : "+s"(out_), "+s"(ws_), "+v"(t_));
    L.out = out_; L.ws = ws_; L.tid = t_; L.lane = t_ & 63; L.wave = __builtin_amdgcn_readfirstlane(t_ >> 6); return L;
}
#define WSP(T_, off) ((T_*)(C.ws + (off)))
#define GW (C.bid * NWAVES + C.wave)
#define NGW (C.G * NWAVES)

struct TJob { const float* W; int ldw, K, N; bf16_t* WT; int ldt; int map; float scale; int items; };
__device__ __forceinline__ int tj_items(int K, int N) { return (K / 64) * ((N + 31) / 32); }
__device__ __forceinline__ int tj_dest(int map, int n, int N) {
    if (map == 0) return n;
    if (map == 1) return n < 2816 ? n : (n < 2820 ? PC_DT + (n - 2816) : n - 4);
    const int half = N >> 1, j = n < half ? n : n - half;
    return (j >> 4) * 32 + (j & 15) + (n < half ? 0 : 16);
}
__device__ __forceinline__ void t_load(const TJob& J, int item, int lane, float (&v)[32]) {
    const int nblk = (J.N + 31) / 32, kb = item / nblk, nb = item % nblk, k0 = 64 * kb, n0 = 32 * nb;
    const int nn = n0 + (lane & 31); const bool okn = nn < J.N; const float* src = J.W + (size_t)(k0 + (lane >> 5)) * J.ldw + nn;
#pragma unroll
    for (int i = 0; i < 32; ++i) v[i] = okn ? src[(size_t)(2 * i) * J.ldw] : 0.f;
}
__device__ __forceinline__ void t_commit(const TJob& J, LAS float* scr, int item, int lane, const float (&v)[32]) {
    const int nblk = (J.N + 31) / 32, kb = item / nblk, nb = item % nblk, k0 = 64 * kb, n0 = 32 * nb;
#pragma unroll
    for (int i = 0; i < 32; ++i) scr[(2 * i + (lane >> 5)) * 33 + (lane & 31)] = v[i];
    LDS_WAIT(); asm volatile("" ::: "memory");
    const int c = lane & 7;
#pragma unroll
    for (int j = 0; j < 4; ++j) { const int nl = (lane >> 3) + 8 * j, n = n0 + nl;
        if (n < J.N) { const LAS float* s = scr + (8 * c) * 33 + nl; const float sc = (J.map == 1 && n >= 256) ? 1.0f : J.scale;
            u32x4 o; o.x = cvt_pk_bf16(s[0 * 33] * sc, s[1 * 33] * sc); o.y = cvt_pk_bf16(s[2 * 33] * sc, s[3 * 33] * sc); o.z = cvt_pk_bf16(s[4 * 33] * sc, s[5 * 33] * sc); o.w = cvt_pk_bf16(s[6 * 33] * sc, s[7 * 33] * sc);
            *(u32x4*)(J.WT + (size_t)tj_dest(J.map, n, J.N) * J.ldt + k0 + 8 * c) = o; } }
    LDS_WAIT(); asm volatile("" ::: "memory");
}
__device__ __forceinline__ TJob mkjob(const float* W, int ldw, int K, int N, bf16_t* WT, int ldt, int map, float scale) { TJob j; j.W = W; j.ldw = ldw; j.K = K; j.N = N; j.WT = WT; j.ldt = ldt; j.map = map; j.scale = scale; j.items = tj_items(K, N); return j; }

__device__ __forceinline__ TJob prologue_job(const Ctx& C, int j) {
    if (j < 26) { const int l = j / 13, r = j % 13; unsigned char* LW = C.ws + W_BASE + (size_t)l * LW_SIZE;
        if (r == 0) return mkjob(C.in[I_WIN] + (size_t)l * 1024 * 3236, 3236, 1024, 3236, (bf16_t*)(LW + LW_WIN), 1024, 1, 0.125f * LOG2E);
        if (r < 5) { const int i = r - 1; return mkjob(C.in[I_WGATE] + ((size_t)l * 4 + i) * 1024 * 1024, 1024, 1024, 1024, (bf16_t*)(LW + LW_WGATE) + (size_t)i * 1024 * 1024, 1024, 0, 1.f); }
        if (r < 9) { const int i = r - 5; return mkjob(C.in[I_WBR] + ((size_t)l * 4 + i) * 256 * 1024, 1024, 256, 1024, (bf16_t*)(LW + LW_WBR) + (size_t)i * 1024 * 256, 256, 0, 1.f); }
        if (r == 9) return mkjob(C.in[I_WOUT] + (size_t)l * 1024 * 1024, 1024, 1024, 1024, (bf16_t*)(LW + LW_WOUT), 1024, 0, 1.f);
        if (r == 10) return mkjob(C.in[I_XWQ] + (size_t)l * 1024 * 1024, 1024, 1024, 1024, (bf16_t*)(LW + LW_WQ), 1024, 0, 0.0625f * LOG2E);
        if (r == 11) return mkjob(C.in[I_XWKV] + (size_t)l * 1024 * 2048, 2048, 1024, 2048, (bf16_t*)(LW + LW_WKV), 1024, 0, 1.f);
        return mkjob(C.in[I_XWO] + (size_t)l * 1024 * 1024, 1024, 1024, 1024, (bf16_t*)(LW + LW_WO), 1024, 0, 1.f);
    }
    if (j == 26) return mkjob(C.in[I_FFN13], 2 * FFD, 1024, 2 * FFD, WSP(bf16_t, W_FFN13), 1024, 2, 1.f);
    return mkjob(C.in[I_FFN2], 1024, FFD, 1024, WSP(bf16_t, W_FFN2), FFD, 0, 1.f);
}
__device__ __forceinline__ TJob moe_job(const Ctx& C, int j) {
    if (j < 8) return mkjob(C.in[I_MOE13] + (size_t)j * 1024 * 2 * FFE, 2 * FFE, 1024, 2 * FFE, WSP(bf16_t, S_MW13) + (size_t)j * 2 * FFE * 1024, 1024, 2, 1.f);
    const int e = j - 8; return mkjob(C.in[I_MOE2] + (size_t)e * FFE * 1024, 1024, FFE, 1024, WSP(bf16_t, S_MW2) + (size_t)e * 1024 * FFE, FFE, 0, 1.f);
}
template <int NJ, bool MOE> __device__ __forceinline__ void run_tjobs(const Ctx& C) {
    LAS float* scr = (LAS float*)(C.lds + C.wave * 16384);
    int total = 0;
    for (int j = 0; j < NJ; ++j) { const TJob J = MOE ? moe_job(C, j) : prologue_job(C, j); total += J.items; }
    int j = 0, jbase = 0; TJob J = MOE ? moe_job(C, 0) : prologue_job(C, 0);
    int it = GW; if (it >= total) return;
    while (it >= jbase + J.items) { jbase += J.items; ++j; J = MOE ? moe_job(C, j) : prologue_job(C, j); }
    float va[32], vb[32];
    t_load(J, it - jbase, C.lane, va);
    for (;;) {
        TJob Jc = J; int itc = it - jbase; it += NGW; bool more = it < total;
        if (more) { while (it >= jbase + J.items) { jbase += J.items; ++j; J = MOE ? moe_job(C, j) : prologue_job(C, j); } t_load(J, it - jbase, C.lane, vb); }
        t_commit(Jc, scr, itc, C.lane, va);
        if (!more) break;
        Jc = J; itc = it - jbase; it += NGW; more = it < total;
        if (more) { while (it >= jbase + J.items) { jbase += J.items; ++j; J = MOE ? moe_job(C, j) : prologue_job(C, j); } t_load(J, it - jbase, C.lane, va); }
        t_commit(Jc, scr, itc, C.lane, vb);
        if (!more) break;
    }
}


constexpr int CW_CHK = 32768;
template <class OutF> __device__ __forceinline__ void chk_gemm(const Ctx& C, const bf16_t* A, int lda, const bf16_t* Bt, int ldb, int K, int nrows, int ncs, int cstride, int c0, int bit, OutF expect_vs_got) {
    unsigned bad = 0; const int lane = C.lane;
    for (int it = GW; it < nrows * ncs; it += NGW) {
        const int r = it / ncs, c = c0 + (it % ncs) * cstride; float d = 0.f;
        for (int k = lane * 8; k < K; k += 512) { const u32x4 a = *(const u32x4*)(A + (size_t)r * lda + k), b = *(const u32x4*)(Bt + (size_t)c * ldb + k);
            d += bflo(a.x) * bflo(b.x) + bfhi(a.x) * bfhi(b.x) + bflo(a.y) * bflo(b.y) + bfhi(a.y) * bfhi(b.y) + bflo(a.z) * bflo(b.z) + bfhi(a.z) * bfhi(b.z) + bflo(a.w) * bflo(b.w) + bfhi(a.w) * bfhi(b.w); }
        d = wave_sum(d);
        if (!expect_vs_got(r, c, d)) bad = 1;
    }
    if (lane == 0 && bad) __hip_atomic_fetch_add((unsigned*)(C.ws + WS_CTL) + CW_CHK + 64 * bit, 1u, RLX_AGENT);
}
__device__ __forceinline__ bool chk_close(float e, float g) { return fabsf(e - g) <= 0.03f * fabsf(e) + 0.03f; }

__device__ __forceinline__ float chk_dot(const bf16_t* a, const bf16_t* b, int K, int lane) {
    float d = 0.f;
    for (int k = lane * 8; k < K; k += 512) { const u32x4 x = *(const u32x4*)(a + k), y = *(const u32x4*)(b + k);
        d += bflo(x.x) * bflo(y.x) + bfhi(x.x) * bfhi(y.x) + bflo(x.y) * bflo(y.y) + bfhi(x.y) * bfhi(y.y) + bflo(x.z) * bflo(y.z) + bfhi(x.z) * bfhi(y.z) + bflo(x.w) * bflo(y.w) + bfhi(x.w) * bfhi(y.w); }
    return wave_sum(d);
}
__device__ __forceinline__ void chk_flag(const Ctx& C, int bit, unsigned bad) { if (C.lane == 0 && bad) __hip_atomic_fetch_add((unsigned*)(C.ws + WS_CTL) + CW_CHK + 64 * bit, 1u, RLX_AGENT); }
__device__ __forceinline__ void chk_merged(const Ctx& C, int l, int bit) {
    const bf16_t* Y = WSP(bf16_t, S_Y); const bf16_t* G = WSP(bf16_t, S_G); const bf16_t* MB = WSP(bf16_t, S_MB); const bf16_t* WBR = (const bf16_t*)(C.ws + W_BASE + (size_t)l * LW_SIZE + LW_WBR); unsigned bad = 0;
    for (int it = GW; it < T * 4; it += NGW) { const int r = it >> 2, c = 13 + 256 * (it & 3); float e = 0.f;
        for (int i = 0; i < 4; ++i) e += bf2f(G[(size_t)r * 4096 + i * 1024 + c]) * chk_dot(Y + (size_t)r * 1024 + 256 * i, WBR + ((size_t)i * 1024 + c) * 256, 256, C.lane);
        if (!chk_close(e, bf2f(MB[(size_t)r * 1024 + c]))) bad = 1; }
    chk_flag(C, bit, bad);
}
__device__ __forceinline__ void chk_swiglu(const Ctx& C, int bit) {
    const bf16_t* XB = WSP(bf16_t, W_XB); const bf16_t* W = WSP(bf16_t, W_FFN13); const bf16_t* H = WSP(bf16_t, S_H); unsigned bad = 0;
    for (int it = GW; it < T * 22; it += NGW) { const int r = it / 22, hc = 5 + 128 * (it % 22); const int grow = (hc >> 4) * 32 + (hc & 15);
        const float g = chk_dot(XB + (size_t)r * 1024, W + (size_t)grow * 1024, 1024, C.lane), u = chk_dot(XB + (size_t)r * 1024, W + (size_t)(grow + 16) * 1024, 1024, C.lane);
        if (!chk_close(siluf_(g) * u, bf2f(H[(size_t)r * FFD + hc]))) bad = 1; }
    chk_flag(C, bit, bad);
}

constexpr size_t S_CHKBUF = S_BASE + (size_t)400 * MiB;
__device__ __forceinline__ void chk_resid_stash(const Ctx& C, const bf16_t* A, int lda, const bf16_t* Bt, int ldb, int K, int slot) {
    const float* XR = WSP(float, W_XRES); float* CB = WSP(float, S_CHKBUF);
    for (int it = GW; it < T * 4; it += NGW) { const int r = it >> 2, q = it & 3, c = 17 + 256 * q; const float d = chk_dot(A + (size_t)r * lda, Bt + (size_t)c * ldb, K, C.lane);
        if (C.lane == 0) CB[(size_t)r * 8 + slot * 4 + q] = XR[(size_t)r * 1024 + c] * DN_ALPHA + d; }
}
__device__ __forceinline__ void chk_resid_cmp(const Ctx& C, int slot, int bit) {
    const float* XR = WSP(float, W_XRES); const float* CB = WSP(float, S_CHKBUF); unsigned bad = 0;
    for (int it = GW; it < T * 4; it += NGW) { const int r = it >> 2, q = it & 3, c = 17 + 256 * q; if (!chk_close(CB[(size_t)r * 8 + slot * 4 + q], XR[(size_t)r * 1024 + c])) bad = 1; }
    chk_flag(C, bit, bad);
}
__device__ __forceinline__ void chk_ln_stash(const Ctx& C, const float* g, const float* b, int slot) {
    const float* XR = WSP(float, W_XRES); float* CB = WSP(float, S_CHKBUF); const int lane = C.lane;
    for (int t = GW; t < T; t += NGW) { float s = 0.f, s2 = 0.f; float v[16];
        for (int j = 0; j < 16; ++j) { v[j] = XR[(size_t)t * 1024 + lane + 64 * j]; s += v[j]; }
        const float mean = wave_sum(s) * (1.0f / 1024.0f); for (int j = 0; j < 16; ++j) { const float d = v[j] - mean; s2 += d * d; }
        const float rstd = 1.0f / sqrtf(wave_sum(s2) * (1.0f / 1024.0f) + 1e-5f);
        if (lane < 4) { const int c = 17 + 256 * lane; CB[(size_t)t * 8 + slot * 4 + lane] = (XR[(size_t)t * 1024 + c] - mean) * rstd * g[c] + b[c]; } }
}
__device__ __forceinline__ void chk_ln_cmp(const Ctx& C, int slot, int bit) {
    const float* XR = WSP(float, W_XRES); const bf16_t* XB = WSP(bf16_t, W_XB); const float* CB = WSP(float, S_CHKBUF); unsigned bad = 0;
    for (int it = GW; it < T * 4; it += NGW) { const int r = it >> 2, q = it & 3, c = 17 + 256 * q; const float e = CB[(size_t)r * 8 + slot * 4 + q];
        if (!chk_close(e, XR[(size_t)r * 1024 + c]) || !chk_close(e, bf2f(XB[(size_t)r * 1024 + c]))) bad = 1; }
    chk_flag(C, bit, bad);
}

template <int NJ, bool MOE> __device__ __forceinline__ void chk_weights(const Ctx& C, int bit) {
    unsigned bad = 0; const int gt = C.bid * NTHREADS + C.tid, NT = C.G * NTHREADS;
    for (int j = 0; j < NJ; ++j) { const TJob J = MOE ? moe_job(C, j) : prologue_job(C, j);
        for (size_t i = gt; i < (size_t)J.K * J.N; i += NT) { const int k = (int)(i / J.N), n = (int)(i % J.N);
            const float sc = (J.map == 1 && n >= 256) ? 1.0f : J.scale; const bf16_t e = (bf16_t)(cvt_pk_bf16(J.W[(size_t)k * J.ldw + n] * sc, 0.f) & 0xffffu);
            if (J.WT[(size_t)tj_dest(J.map, n, J.N) * J.ldt + k] != e) bad = 1; } }
    if (bad) __hip_atomic_fetch_add((unsigned*)(C.ws + WS_CTL) + CW_CHK + 64 * bit, 1u, RLX_AGENT);
}

__device__ __forceinline__ void chk_mla_inputs(const Ctx& C, int l, int bit) {
    const bf16_t* proj = WSP(bf16_t, S_PROJ); const bf16_t* QM = WSP(bf16_t, S_QM); const bf16_t* KM = WSP(bf16_t, S_KM); const bf16_t* VM = WSP(bf16_t, S_VM);
    const float* wuq = C.in[I_WUQ] + (size_t)l * 256 * 384; const float* wukv = C.in[I_WUKV] + (size_t)l * 128 * 512; const float* qg = C.in[I_QNG] + l * 256; const float* kvg = C.in[I_KVNG] + l * 128;
    const int* pos = (const int*)C.in[I_POS]; const int lane = C.lane; unsigned bad = 0; const float qs = 0.10206207261596575f * LOG2E;
    for (int t = GW; t < T; t += NGW) {
        const bf16_t* pr = proj + (size_t)t * NPROJ; float cq[4], ck[2]; float ss = 0.f;
        for (int i = 0; i < 4; ++i) { cq[i] = bf2f(pr[PC_CQ + lane + 64 * i]); ss += cq[i] * cq[i]; }
        float rs = 1.0f / sqrtf(wave_sum(ss) * (1.0f / 256.0f) + 1e-6f); for (int i = 0; i < 4; ++i) cq[i] *= rs * qg[lane + 64 * i];
        ss = 0.f; for (int i = 0; i < 2; ++i) { ck[i] = bf2f(pr[PC_CKV + lane + 64 * i]); ss += ck[i] * ck[i]; }
        rs = 1.0f / sqrtf(wave_sum(ss) * (1.0f / 128.0f) + 1e-6f); for (int i = 0; i < 2; ++i) ck[i] *= rs * kvg[lane + 64 * i];
        const float ang = (float)pos[t] * exp2f(-6.0f * (13.287712379549449f / 32.0f)); const float c3 = cosf(ang), s3 = sinf(ang);
        const int h = t & 3;
        float qn = 0.f, q1 = 0.f, q2 = 0.f, kn = 0.f, vv = 0.f;
        for (int i = 0; i < 4; ++i) { const int k = lane + 64 * i; qn += cq[i] * wuq[(size_t)k * 384 + h * 96 + 5]; q1 += cq[i] * wuq[(size_t)k * 384 + h * 96 + 67]; q2 += cq[i] * wuq[(size_t)k * 384 + h * 96 + 83]; }
        for (int i = 0; i < 2; ++i) { const int k = lane + 64 * i; kn += ck[i] * wukv[(size_t)k * 512 + h * 128 + 7]; vv += ck[i] * wukv[(size_t)k * 512 + h * 128 + 64 + 9]; }
        qn = wave_sum(qn) * qs; q1 = wave_sum(q1) * qs; q2 = wave_sum(q2) * qs; kn = wave_sum(kn); vv = wave_sum(vv);
        const float kr1 = bf2f(pr[PC_KR + 3]), kr2 = bf2f(pr[PC_KR + 19]);
        const bf16_t* qrow = QM + (size_t)t * 384 + h * 96; const bf16_t* krow = KM + (size_t)t * 384 + h * 96;
        if (!chk_close(qn, bf2f(qrow[5])) || !chk_close(q1 * c3 - q2 * s3, bf2f(qrow[67])) || !chk_close(q1 * s3 + q2 * c3, bf2f(qrow[83])) || !chk_close(kn, bf2f(krow[7])) ||
            !chk_close(kr1 * c3 - kr2 * s3, bf2f(krow[67])) || !chk_close(kr1 * s3 + kr2 * c3, bf2f(krow[83])) || !chk_close(vv, bf2f(VM[(size_t)t * 256 + h * 64 + 9]))) bad = 1;
    }
    chk_flag(C, bit, bad);
}

__device__ __forceinline__ void chk_rw_inputs(const Ctx& C, int l, int bit) {
    const bf16_t* proj = WSP(bf16_t, S_PROJ); const float* DEC = WSP(float, S_DEC); const bf16_t* RWS = WSP(bf16_t, S_RWS); const bf16_t* GV = WSP(bf16_t, S_GV); const size_t PL = (size_t)T * 256;
    const float* mu = C.in[I_RWMU] + l * 1024; const float* w0 = C.in[I_RWW0] + l * 256; const float* a0 = C.in[I_RWA0] + l * 256;
    const float* wup = C.in[I_RWWUP] + l * 64 * 256; const float* aup = C.in[I_RWAUP] + l * 64 * 256; const float* gup = C.in[I_RWGUP] + l * 128 * 256;
    const float* kkw = C.in[I_RWKK] + l * 256; const float* kaw = C.in[I_RWKA] + l * 256; const int lane = C.lane; unsigned bad = 0;
    for (int t = GW; t < T; t += NGW) {
        const bf16_t* pr = proj + (size_t)t * NPROJ + PC_RW; const bool first = (t % SEQ) == 0; const int h = t & 3, c = h * 64 + 11;
        auto sh = [&](int col) { const float cur = bf2f(pr[col]); const float prv = first ? 0.f : bf2f(pr[col - NPROJ]); return cur + (prv - cur) * mu[col]; };
        float dw = tanhf(sh(768 + lane)) * wup[lane * 256 + c], da = sh(832 + lane) * aup[lane * 256 + c];
        float dg = (1.0f / (1.0f + expf(-sh(896 + lane)))) * gup[lane * 256 + c] + (1.0f / (1.0f + expf(-sh(960 + lane)))) * gup[(64 + lane) * 256 + c];
        dw = wave_sum(dw); da = wave_sum(da); dg = wave_sum(dg);
        const float xw = w0[c] + dw; const float wlog = -(fmaxf(-xw, 0.f) + log1pf(expf(-fabsf(xw)))) - 0.5f; const float dec = expf(-expf(wlog));
        const float a = 1.0f / (1.0f + expf(-(a0[c] + da)));
        const float kl = sh(256 + h * 64 + lane) * kkw[h * 64 + lane]; const float nrm = 1.0f / sqrtf(fmaxf(wave_sum(kl * kl), 1e-24f));
        const float r = sh(c), k = sh(256 + c), v = sh(512 + c); const float kk = k * kkw[c] * nrm, kmod = k * (1.0f + (a - 1.0f) * kaw[c]), ka = kk * a;
        const size_t o = (size_t)t * 256 + c;
        if (!chk_close(dec, DEC[o]) || fabsf(dec - DEC[o]) > 0.004f || !chk_close(r, bf2f(RWS[o])) || !chk_close(kmod, bf2f(RWS[PL + o])) || !chk_close(v, bf2f(RWS[2 * PL + o])) || !chk_close(kk, bf2f(RWS[3 * PL + o])) ||
            !chk_close(ka, bf2f(RWS[4 * PL + o])) || !chk_close(dg, bf2f(GV[o]))) bad = 1;
    }
    chk_flag(C, bit, bad);
}
__device__ __forceinline__ void chk_ssd_norm(const Ctx& C, int l, int bit) {
    const bf16_t* Y = WSP(bf16_t, S_Y); const float* ng = C.in[I_SSDNG] + l * 256; const int lane = C.lane; unsigned bad = 0;
    for (int t = GW; t < T; t += NGW) { float q = 0.f;
        for (int i = 0; i < 4; ++i) { const int c = (lane >> 5) * 128 + (lane & 31) * 4 + i; const float y = bf2f(Y[(size_t)t * 1024 + 512 + c]) / ng[c]; q += y * y; }
        for (int o_ = 1; o_ < 32; o_ <<= 1) q += __shfl_xor(q, o_);
        q *= (1.0f / 128.0f); if (q < 0.9f || q > 1.1f) bad = 1; }
    chk_flag(C, bit, bad);
}

#ifndef P7_COND
#define P7_COND 1
#endif
#ifndef P7_CLASS
#define P7_CLASS (((c & 31) < 16 ? 1u : 2u) | ((c & 255) < 128 ? 4u : 8u))
#endif
__device__ __forceinline__ float tdot(const bf16_t* a, const bf16_t* b, int K) { float d = 0.f;
    for (int k = 0; k < K; k += 8) { const u32x4 x = *(const u32x4*)(a + k), y = *(const u32x4*)(b + k);
        d += bflo(x.x) * bflo(y.x) + bfhi(x.x) * bfhi(y.x) + bflo(x.y) * bflo(y.y) + bfhi(x.y) * bfhi(y.y) + bflo(x.z) * bflo(y.z) + bfhi(x.z) * bfhi(y.z) + bflo(x.w) * bflo(y.w) + bfhi(x.w) * bfhi(y.w); }
    return d; }
__device__ __forceinline__ void chk_full_p7(const Ctx& C, int l, int bit) {
    const bf16_t* MB = WSP(bf16_t, S_MB); const bf16_t* W = (const bf16_t*)(C.ws + W_BASE + (size_t)l * LW_SIZE + LW_WOUT); const float* xin = C.in[I_X]; const float* XR = WSP(float, W_XRES); float num = 0.f, den = 0.f;
    for (size_t i = (size_t)C.bid * NTHREADS + C.tid; i < (size_t)T * 1024; i += (size_t)C.G * NTHREADS) { const size_t r = i >> 10; const int c = (int)(i & 1023);
        const float d = tdot(MB + r * 1024, W + (size_t)c * 1024, 1024), g = XR[i] - xin[i] * DN_ALPHA; num += (d - g) * (d - g); den += d * d; }
    num = wave_sum(num); den = wave_sum(den);
    if (C.lane == 0) { atomicAdd((float*)(C.ws + WS_CTL) + CW_CHK + 1024, num); atomicAdd((float*)(C.ws + WS_CTL) + CW_CHK + 1088, den); }
}
__device__ __forceinline__ void chk_full_merged(const Ctx& C, int l, int bit) {
    const bf16_t* Y = WSP(bf16_t, S_Y); const bf16_t* G = WSP(bf16_t, S_G); const bf16_t* MB = WSP(bf16_t, S_MB); const bf16_t* WBR = (const bf16_t*)(C.ws + W_BASE + (size_t)l * LW_SIZE + LW_WBR); unsigned bad = 0;
    for (size_t i = (size_t)C.bid * NTHREADS + C.tid; i < (size_t)T * 1024; i += (size_t)C.G * NTHREADS) { const size_t r = i >> 10; const int c = (int)(i & 1023); float e = 0.f;
        for (int q = 0; q < 4; ++q) e += bf2f(G[r * 4096 + q * 1024 + c]) * tdot(Y + r * 1024 + 256 * q, WBR + ((size_t)q * 1024 + c) * 256, 256);
        if (!chk_close(e, bf2f(MB[i]))) bad = 1; }
    if (bad) __hip_atomic_fetch_add((unsigned*)(C.ws + WS_CTL) + CW_CHK + 64 * bit, 1u, RLX_AGENT);
}

#ifndef FG_CLASS
#define FG_CLASS (1u << ((c >> 5) & 3))
#endif
template <class F> __device__ __forceinline__ void chk_full_gemm(const Ctx& C, const bf16_t* A, const bf16_t* Bt, int K, int N, int bit, F ok) {
    unsigned bad = 0, cntbad = 0;
    for (size_t i = (size_t)C.bid * NTHREADS + C.tid; i < (size_t)T * N; i += (size_t)C.G * NTHREADS) { const size_t r = i / N; const int c = (int)(i % N);
        if (!ok(r, c, tdot(A + r * K, Bt + (size_t)c * K, K))) { bad |= (bit < 0) ? (FG_CLASS) : (1u << bit); ++cntbad; } }
#ifdef FG_COUNT
    if (cntbad) __hip_atomic_fetch_add((unsigned*)(C.ws + WS_CTL) + CW_CHK + 2048, cntbad, RLX_AGENT);
#else
    for (int q = 0; q < 4; ++q) if ((bad >> q) & 1) __hip_atomic_fetch_add((unsigned*)(C.ws + WS_CTL) + CW_CHK + 64 * q, 1u, RLX_AGENT);
#endif
}
__device__ __forceinline__ void ph_prologue(const Ctx& C) {
    run_tjobs<28, false>(C);
    const int gt = C.bid * NTHREADS + C.tid, NT = C.G * NTHREADS;
    for (int l = 0; l < 2; ++l) {
        unsigned char* LW = C.ws + W_BASE + (size_t)l * LW_SIZE;
        bf16_t* lora = (bf16_t*)(LW + LW_LORA); const float* wup = C.in[I_RWWUP] + l * 64 * 256; const float* aup = C.in[I_RWAUP] + l * 64 * 256; const float* gup = C.in[I_RWGUP] + l * 128 * 256;
        for (int i = gt; i < 768 * 256; i += NT) { const int n = i >> 8, k = i & 255; float v = 0.f;
            if (n < 256) { if (k < 64) v = wup[k * 256 + n]; } else if (n < 512) { if (k >= 64 && k < 128) v = aup[(k - 64) * 256 + (n - 256)]; } else { if (k >= 128) v = gup[(k - 128) * 256 + (n - 512)]; }
            lora[i] = (bf16_t)(cvt_pk_bf16(v, 0.f) & 0xffffu); }
        bf16_t* wuq = (bf16_t*)(LW + LW_WUQ); const float* suq = C.in[I_WUQ] + l * 256 * 384;
        for (int i = gt; i < 512 * 256; i += NT) { const int n = i >> 8, k = i & 255; const float v = n < 384 ? suq[k * 384 + n] * (0.10206207261596575f * LOG2E) : 0.f; wuq[i] = (bf16_t)(cvt_pk_bf16(v, 0.f) & 0xffffu); }
        bf16_t* wukv = (bf16_t*)(LW + LW_WUKV); const float* sukv = C.in[I_WUKV] + l * 128 * 512;
        for (int i = gt; i < 512 * 128; i += NT) { const int n = i >> 7, k = i & 127; wukv[i] = (bf16_t)(cvt_pk_bf16(sukv[k * 512 + n], 0.f) & 0xffffu); }
        bf16_t* win = (bf16_t*)(LW + LW_WIN);
        for (int i = gt; i < (NPROJ - 3236) * 1024; i += NT) win[(size_t)3236 * 1024 + i] = 0;
    }
    { const float* x = C.in[I_X]; bf16_t* xb = WSP(bf16_t, W_XB);
      for (size_t i = gt; i < (size_t)T * 1024 / 8; i += NT) { const f32x4 a = *(const f32x4*)(x + i * 8), b = *(const f32x4*)(x + i * 8 + 4); *(u32x4*)(xb + i * 8) = epi::pack8(a, b); }
      const float* mm = C.in[I_MEM]; bf16_t* mb = WSP(bf16_t, W_MEMB);
      for (size_t i = gt; i < (size_t)NMEM * 1024 / 8; i += NT) { const f32x4 a = *(const f32x4*)(mm + i * 8), b = *(const f32x4*)(mm + i * 8 + 4); *(u32x4*)(mb + i * 8) = epi::pack8(a, b); } }
    { const int* pos = (const int*)C.in[I_POS]; float* ct = WSP(float, W_COS); float* st = WSP(float, W_SIN);
      for (int i = gt; i < T * 16; i += NT) { const int t = i >> 4, j = i & 15; const float inv = exp2f(-(float)(2 * j) * (13.287712379549449f / 32.0f)); const float ang = (float)pos[t] * inv; ct[i] = cosf(ang); st[i] = sinf(ang); } }
}

__device__ __forceinline__ f32x4 ld_bf4(const bf16_t* p) { const u32x2 w = *(const u32x2*)p; return (f32x4){bflo(w.x), bfhi(w.x), bflo(w.y), bfhi(w.y)}; }
__device__ __forceinline__ void st_bf4(bf16_t* p, const f32x4 v) { u32x2 w; w.x = cvt_pk_bf16(v[0], v[1]); w.y = cvt_pk_bf16(v[2], v[3]); *(u32x2*)p = w; }
__device__ __forceinline__ float tanhf_(float x) { return 1.0f - 2.0f * frcp(1.0f + fexp2(2.0f * LOG2E * x)); }
__device__ __forceinline__ void ph_prep(const Ctx& C, int l) {
    const bf16_t* __restrict__ proj = WSP(bf16_t, S_PROJ); const float* mu = C.in[I_RWMU] + l * 1024;
    bf16_t* __restrict__ LA = WSP(bf16_t, S_LA); bf16_t* __restrict__ CQN = WSP(bf16_t, S_CQN); bf16_t* __restrict__ CKVN = WSP(bf16_t, S_CKVN); bf16_t* __restrict__ KM = WSP(bf16_t, S_KM);
    const float* qg = C.in[I_QNG] + l * 256; const float* kvg = C.in[I_KVNG] + l * 128; const float* ct = WSP(float, W_COS); const float* st = WSP(float, W_SIN);
    const int lane = C.lane;
    for (int t = GW; t < T; t += NGW) {
        const bf16_t* pr = proj + (size_t)t * NPROJ; const bool first = (t % SEQ) == 0;
        { const int c = 4 * lane; const f32x4 cur = ld_bf4(pr + PC_RW + 768 + c); const f32x4 prv = first ? (f32x4){0.f, 0.f, 0.f, 0.f} : ld_bf4(pr - NPROJ + PC_RW + 768 + c);
          const f32x4 m = *(const f32x4*)(mu + 768 + c); f32x4 p = cur + (prv - cur) * m;
          if (c < 64) { for (int j = 0; j < 4; ++j) p[j] = tanhf_(p[j]); } else if (c >= 128) { for (int j = 0; j < 4; ++j) p[j] = sigmoidf_(p[j]); }
          st_bf4(LA + (size_t)t * 256 + c, p); }
        { const int c = 4 * lane; f32x4 v = ld_bf4(pr + PC_CQ + c); const float ss = wave_sum((v[0] * v[0] + v[1] * v[1]) + (v[2] * v[2] + v[3] * v[3]));
          const float rs = 1.0f / sqrtf(ss * (1.0f / 256.0f) + 1e-6f); v = v * rs * *(const f32x4*)(qg + c); st_bf4(CQN + (size_t)t * 256 + c, v); }
        { const int c = 2 * lane; const unsigned w = *(const unsigned*)(pr + PC_CKV + c); float a = bflo(w), b = bfhi(w); const float ss = wave_sum(a * a + b * b);
          const float rs = 1.0f / sqrtf(ss * (1.0f / 128.0f) + 1e-6f); a *= rs * kvg[c]; b *= rs * kvg[c + 1]; *(unsigned*)(CKVN + (size_t)t * 128 + c) = cvt_pk_bf16(a, b); }
        { const float v = bf2f(pr[PC_KR + (lane & 31)]); const float o = __shfl_xor(v, 16); const int i = lane & 15; const float cs = ct[t * 16 + i], sn = st[t * 16 + i];
          const float r = (lane & 16) ? (o * sn + v * cs) : (v * cs - o * sn);
          if (lane < 32) { const bf16_t rb = (bf16_t)(cvt_pk_bf16(r, 0.f) & 0xffffu); for (int h = 0; h < 4; ++h) KM[(size_t)t * 384 + h * 96 + 64 + lane] = rb; } }
    }
}
__device__ __forceinline__ void ph_rwprep(const Ctx& C, int l) {
#if defined(NAIVE_SCAN)
    if (NAIVE_SCAN & 2) { float* q_ = WSP(float, S_SSQ); for (int i = C.bid * NTHREADS + C.tid; i < T * 8; i += C.G * NTHREADS) q_[i] = 0.f; }
#endif
    const bf16_t* __restrict__ proj = WSP(bf16_t, S_PROJ); const float* mu = C.in[I_RWMU] + l * 1024; const bf16_t* __restrict__ AV = WSP(bf16_t, S_AV); bf16_t* __restrict__ RWS = WSP(bf16_t, S_RWS);
    const float* kkw = C.in[I_RWKK] + l * 256; const float* kaw = C.in[I_RWKA] + l * 256; const int lane = C.lane, c = 4 * lane;
    for (int t = GW; t < T; t += NGW) {
        const bf16_t* pr = proj + (size_t)t * NPROJ + PC_RW; const bool first = (t % SEQ) == 0; f32x4 rkv[3];
#pragma unroll
        for (int q = 0; q < 3; ++q) { const f32x4 cur = ld_bf4(pr + q * 256 + c); const f32x4 prv = first ? (f32x4){0.f, 0.f, 0.f, 0.f} : ld_bf4(pr - NPROJ + q * 256 + c); rkv[q] = cur + (prv - cur) * *(const f32x4*)(mu + q * 256 + c); }
        const f32x4 a = ld_bf4(AV + (size_t)t * 256 + c); f32x4 kk = rkv[1] * *(const f32x4*)(kkw + c);
        float ss = (kk[0] * kk[0] + kk[1] * kk[1]) + (kk[2] * kk[2] + kk[3] * kk[3]);
        ss = row_sum16(ss);
        kk = kk * (1.0f / sqrtf(fmaxf(ss, 1e-24f)));
        const f32x4 kmod = rkv[1] * ((a - 1.0f) * *(const f32x4*)(kaw + c) + 1.0f), ka = kk * a;
        const size_t o = (size_t)t * 256 + c, PL = (size_t)T * 256;
        st_bf4(RWS + o, rkv[0]); st_bf4(RWS + PL + o, kmod); st_bf4(RWS + 2 * PL + o, rkv[2]); st_bf4(RWS + 3 * PL + o, kk); st_bf4(RWS + 4 * PL + o, ka);
    }
}
__device__ __forceinline__ void ph_ssdprep(const Ctx& C, int l) {
    const bf16_t* __restrict__ proj = WSP(bf16_t, S_PROJ); bf16_t* __restrict__ XA = WSP(bf16_t, S_XA); bf16_t* __restrict__ BC = WSP(bf16_t, S_BC); bf16_t* __restrict__ CC = WSP(bf16_t, S_CC); float* __restrict__ ACS = WSP(float, S_ACS); float* __restrict__ DTV = WSP(float, S_DTV);
    const float* cw = C.in[I_CONVW] + l * 4 * 768; const float* cb = C.in[I_CONVB] + l * 768; const float* dtbp = C.in[I_DTB] + l * 4; const float* alog = C.in[I_ALOG] + l * 4; const int lane = C.lane;
    for (int item = GW; item < 64; item += NGW) { const int b = item >> 2, h = item & 3; const float dtb = dtbp[h], a2 = -expf(alog[h]) * LOG2E; const size_t t0 = (size_t)b * SEQ + lane;
        float carry = 0.f;
#pragma unroll 4
        for (int c = 0; c < SEQ / 64; ++c) { float v = softplusf_(bf2f(proj[(t0 + 64 * c) * NPROJ + PC_DT + h]) + dtb) * a2;
#pragma unroll
            for (int d = 1; d < 64; d <<= 1) { const float o = __shfl_up(v, d); if (lane >= d) v += o; }
            v += carry; ACS[(t0 + 64 * c) * 4 + h] = v; carry = __shfl(v, 63); } }
    for (int t = GW; t < T; t += NGW) { const int tl = t % SEQ;
#pragma unroll
        for (int j = 0; j < 3; ++j) { const int c = 4 * lane + 256 * j; f32x4 a = *(const f32x4*)(cb + c);
#pragma unroll
            for (int k = 0; k < 4; ++k) { if (tl - 3 + k >= 0) a += ld_bf4(proj + (size_t)(t - 3 + k) * NPROJ + PC_XS + c) * *(const f32x4*)(cw + k * 768 + c); }
            for (int q = 0; q < 4; ++q) a[q] = siluf_(a[q]);
            st_bf4((j == 0 ? XA : (j == 1 ? BC : CC)) + (size_t)t * 256 + 4 * lane, a); }
        if (lane < 4) DTV[(size_t)t * 4 + lane] = softplusf_(bf2f(proj[(size_t)t * NPROJ + PC_DT + lane]) + dtbp[lane]);
    }
}
#ifndef ABL_MOE
#define ABL_MOE 1.0f
#endif
template <bool MOE> __device__ __forceinline__ void ph_ln(const Ctx& C, const float* src, float* dst, bf16_t* dstb, const float* g, const float* b, const bf16_t* ys) {
    const int lane = C.lane;
    float chkscale = 1.0f;
#if defined(CHECKS) || defined(CHECKS2) || defined(CHECKS3) || defined(CHECKS4) || defined(CHECKS5) || defined(CHECKS6) || defined(CHECKS7) || defined(CHECKS8) || defined(CHECKS9) || defined(CHECKS10) || defined(CHECKS12) || defined(CHECKS13) || defined(CHECKS14) || defined(CHECKS15)
    if (MOE) { const unsigned* cw = (const unsigned*)(C.ws + WS_CTL) + CW_CHK; int n = 0;
        for (int q = 0; q < 4; ++q) if (__hip_atomic_load(cw + 64 * q, RLX_AGENT) != 0u) n |= 1 << q;
#if defined(FG_COUNT) || defined(CHECKS13) || defined(CHECKS15)
        { unsigned v_ = __hip_atomic_load(cw + 2048, RLX_AGENT); n = 0; while (v_ > 0u) { ++n; v_ >>= 1; } }
#endif
#ifdef CHECKS10
        { const float num = __uint_as_float(__hip_atomic_load(cw + 1024, RLX_AGENT)), den = __uint_as_float(__hip_atomic_load(cw + 1088, RLX_AGENT)); const float lr = -log2f(fmaxf(num / fmaxf(den, 1e-30f), 1e-12f)); n = (int)(lr + 0.5f); n = n < 0 ? 0 : (n > 31 ? 31 : n); }
#endif
        chkscale = 1.0f + 0.1f * (float)n; }
#endif
    for (int t = GW; t < T; t += NGW) {
        f32x4 v[4]; float s = 0.f;
#pragma unroll
        for (int j = 0; j < 4; ++j) { v[j] = *(const f32x4*)(src + (size_t)t * 1024 + 4 * lane + 256 * j);
            if (MOE) { const f32x4 y0 = ld_bf4(ys + (size_t)(2 * t) * 1024 + 4 * lane + 256 * j), y1 = ld_bf4(ys + (size_t)(2 * t + 1) * 1024 + 4 * lane + 256 * j); v[j] = v[j] * DN_ALPHA + (y0 + y1) * ABL_MOE; }
            s += (v[j][0] + v[j][1]) + (v[j][2] + v[j][3]); }
        const float mean = wave_sum(s) * (1.0f / 1024.0f); float s2 = 0.f;
#pragma unroll
        for (int j = 0; j < 4; ++j) { v[j] = v[j] - mean; s2 += (v[j][0] * v[j][0] + v[j][1] * v[j][1]) + (v[j][2] * v[j][2] + v[j][3] * v[j][3]); }
        const float rstd = 1.0f / sqrtf(wave_sum(s2) * (1.0f / 1024.0f) + 1e-5f);
#pragma unroll
        for (int j = 0; j < 4; ++j) { const int c = 4 * lane + 256 * j; const f32x4 o = (v[j] * rstd * *(const f32x4*)(g + c) + *(const f32x4*)(b + c)) * chkscale;
            if (dst) *(f32x4*)(dst + (size_t)t * 1024 + c) = o; if (dstb) st_bf4(dstb + (size_t)t * 1024 + c, o); }
    }
}
__device__ __forceinline__ void ph_ssdfix(const Ctx& C, int l) {
    bf16_t* Y = WSP(bf16_t, S_Y); const float* ssq = WSP(float, S_SSQ); const float* ng = C.in[I_SSDNG] + l * 256; const int lane = C.lane, c = 4 * lane, g = lane >> 5;
    const bf16_t* YRAW = WSP(bf16_t, S_YRAW); const bf16_t* RWS = WSP(bf16_t, S_RWS); const bf16_t* GV = WSP(bf16_t, S_GV); const size_t PL = (size_t)T * 256;
    const f32x4 rk = *(const f32x4*)(C.in[I_RWRK] + l * 256 + c), gng = *(const f32x4*)(C.in[I_RWGNG] + l * 256 + c), gnb = *(const f32x4*)(C.in[I_RWGNB] + l * 256 + c);
    for (int t = GW; t < T; t += NGW) {
        const float q = (ssq[t * 8 + 4 * g] + ssq[t * 8 + 4 * g + 1]) + (ssq[t * 8 + 4 * g + 2] + ssq[t * 8 + 4 * g + 3]); const float rs = 1.0f / sqrtf(q * (1.0f / 128.0f) + 1e-5f);
        bf16_t* p = Y + (size_t)t * 1024 + 512 + c; f32x4 v = ld_bf4(p); v = v * rs * *(const f32x4*)(ng + c); st_bf4(p, v);
#ifndef RW_NAIVE_OUT
        {   const size_t o = (size_t)t * 256 + c; const f32x4 yv = ld_bf4(YRAW + o), rr = ld_bf4(RWS + o), km = ld_bf4(RWS + PL + o), vv = ld_bf4(RWS + 2 * PL + o), gg = ld_bf4(GV + o);
            float sm = (yv[0] + yv[1]) + (yv[2] + yv[3]), bd = (rr[0] * km[0] * rk[0] + rr[1] * km[1] * rk[1]) + (rr[2] * km[2] * rk[2] + rr[3] * km[3] * rk[3]);
            sm = row_sum16(sm); bd = row_sum16(bd);
            const float mu = sm * (1.0f / 64.0f); const f32x4 d = yv - mu; float vs = (d[0] * d[0] + d[1] * d[1]) + (d[2] * d[2] + d[3] * d[3]);
            vs = row_sum16(vs);
            const float rstd = 1.0f / sqrtf(vs * (1.0f / 64.0f) + 64e-5f);
            st_bf4(Y + (size_t)t * 1024 + 256 + c, ((d * rstd) * gng + gnb + vv * bd) * gg); }
#endif
    }
}
typedef __bf16 bfx8 __attribute__((ext_vector_type(8)));
__device__ __forceinline__ f32x16 mfma32(const bf16x8 a, const bf16x8 b, const f32x16 c) { return __builtin_amdgcn_mfma_f32_32x32x16_bf16(__builtin_bit_cast(bfx8, a), __builtin_bit_cast(bfx8, b), c, 0, 0, 0); }
__device__ __forceinline__ float dpp_xor1(float v) { return __builtin_bit_cast(float, __builtin_amdgcn_mov_dpp(__builtin_bit_cast(int, v), 0xB1, 0xf, 0xf, true)); }
__device__ __forceinline__ float dpp_xor2(float v) { return __builtin_bit_cast(float, __builtin_amdgcn_mov_dpp(__builtin_bit_cast(int, v), 0x4E, 0xf, 0xf, true)); }
__device__ __forceinline__ float dpp_hmir(float v) { return __builtin_bit_cast(float, __builtin_amdgcn_mov_dpp(__builtin_bit_cast(int, v), 0x141, 0xf, 0xf, true)); }
__device__ __forceinline__ float sum8(float v) { v += dpp_xor1(v); v += dpp_xor2(v); v += dpp_hmir(v); return v; }

__device__ __forceinline__ float xor32(float v, int hh) { const auto sw = __builtin_amdgcn_permlane32_swap(__builtin_bit_cast(unsigned, v), __builtin_bit_cast(unsigned, v), false, false); return __builtin_bit_cast(float, (unsigned)(hh ? sw[0] : sw[1])); }
template <int MODE>
__device__ __forceinline__ void attn_unit(const Ctx& C0_, int l, int b, int h, int qb) {
    const Ctx C = launder(C0_);
    constexpr int DQK = MODE == 2 ? 128 : (MODE == 1 ? 96 : 64), NS = DQK / 16, KST = DQK * 2 + 16, VST = 192, KCH = DQK / 8;
    const bf16_t *Qp, *Kp, *Vp; int qs, ks, vs, ycol;
    if (MODE == 0) { const bf16_t* proj = WSP(bf16_t, S_PROJ); Qp = proj + PC_SBQ + h * 64; Kp = proj + PC_SBK + h * 64; Vp = proj + PC_SBV + h * 64; qs = ks = vs = NPROJ; ycol = h * 64; }
    else if (MODE == 1) { Qp = WSP(bf16_t, S_QM) + h * 96; Kp = WSP(bf16_t, S_KM) + h * 96; Vp = WSP(bf16_t, S_VM) + h * 64; qs = ks = 384; vs = 256; ycol = 768 + h * 64; }
    else { Qp = WSP(bf16_t, S_CC) + (h >> 1) * 128; Kp = WSP(bf16_t, S_BC) + (h >> 1) * 128; Vp = WSP(bf16_t, S_XA) + h * 64; qs = ks = vs = 256; ycol = 512 + h * 64; }
    const float* ACS = WSP(float, S_ACS); const float* DTV = WSP(float, S_DTV);
    const size_t tb = (size_t)b * SEQ;
    constexpr int ABUF = 64 * KST + 64 * VST + 512;
    LAS unsigned char* const abase = C.lds;
    const int tid = C.tid, lane = C.lane, w = C.wave, r = lane & 31, hh = lane >> 5;
    const int Q0 = qb * 256, qidx = Q0 + 32 * w + r, qmin = Q0 + 32 * w, qmax = qmin + 31;
    bf16x8 qf[NS];
#pragma unroll
    for (int s = 0; s < NS; ++s) qf[s] = *(const bf16x8*)(Qp + (tb + qidx) * qs + 16 * s + 8 * hh);
    f32x16 o[2]; for (int i = 0; i < 16; ++i) { o[0][i] = 0.f; o[1][i] = 0.f; }
    float Rrun = 0.f, mrun = -1.0e30f, lsum = 0.f;
    const int pr = (r & ~12) | ((r & 4) << 1) | ((r & 8) >> 1);
    u32x4 kreg0, kreg1, vreg; const int krow0 = tid / KCH, kch0 = tid % KCH, krow1 = (tid + 512) / KCH, kch1 = (tid + 512) % KCH, vrow = tid >> 3, vch = tid & 7;
    const bool k1 = (MODE == 2) || ((MODE == 1) && (tid < 64 * KCH - 512));
    float areg = 0.f, dreg = 0.f; float aq = 0.f; if (MODE == 2) aq = ACS[(tb + qidx) * 4 + h];
    const int ktmax = 4 * qb + 3;
#define ATT_LOAD(kt) do { const size_t kb_ = tb + (size_t)(kt) * 64; kreg0 = *(const u32x4*)(Kp + (kb_ + krow0) * ks + kch0 * 8); if (k1) kreg1 = *(const u32x4*)(Kp + (kb_ + krow1) * ks + kch1 * 8); \
        vreg = *(const u32x4*)(Vp + (kb_ + vrow) * vs + vch * 8); if (MODE == 2 && tid < 64) { areg = ACS[(kb_ + tid) * 4 + h]; dreg = DTV[(kb_ + tid) * 4 + h]; } } while (0)
#define ATT_STORE(bi) do { LAS unsigned char* Kt_ = abase + (bi) * ABUF; LAS unsigned char* Vt_ = Kt_ + 64 * KST; \
        *(LAS u32x4*)(Kt_ + krow0 * KST + kch0 * 16) = kreg0; if (k1) *(LAS u32x4*)(Kt_ + krow1 * KST + kch1 * 16) = kreg1; \
        *(LAS u32x4*)(Vt_ + vrow * VST + vch * 16) = vreg; if (MODE == 2 && tid < 64) { ((LAS float*)(Vt_ + 64 * VST))[tid] = areg; ((LAS float*)(Vt_ + 64 * VST))[64 + tid] = dreg; } } while (0)
    __syncthreads();
    ATT_LOAD(ktmax); ATT_STORE(0); if (ktmax > 0) ATT_LOAD(ktmax - 1);
    __syncthreads();
    for (int kt = ktmax; kt >= 0; --kt) {
        const int bi = (ktmax - kt) & 1;
        LAS unsigned char* Kt = abase + bi * ABUF; LAS unsigned char* Vt = Kt + 64 * KST; LAS float* AkL = (LAS float*)(Vt + 64 * VST); LAS float* DkL = AkL + 64;
        const unsigned vt_addr = (unsigned)(size_t)Vt;
        if (kt > 0) { ATT_STORE(bi ^ 1); if (kt > 1) ATT_LOAD(kt - 2); }
        const int k0 = kt * 64;
        if (k0 <= qmax) {
        const bool need_mask = (k0 + 63 >= qmin);
        f32x16 sc[2];
#pragma unroll
        for (int sub = 0; sub < 2; ++sub) {
            for (int i = 0; i < 16; ++i) sc[sub][i] = 0.f;
#pragma unroll
            for (int s = 0; s < NS; ++s) { const bf16x8 kf = *(const LAS bf16x8*)(Kt + (32 * sub + pr) * KST + (16 * s + 8 * hh) * 2); sc[sub] = mfma32(kf, qf[s], sc[sub]); }
        }
        if (MODE == 0) {
#pragma unroll
            for (int sub = 1; sub >= 0; --sub) {
                const int kb = k0 + 32 * sub + 8 * hh;
                float L[16];
#pragma unroll
                for (int i = 0; i < 16; ++i) { const float z = sc[sub][i]; const float l2 = -(fmaxf(z, 0.f) + flog2(1.0f + fexp2(-fabsf(z)))); L[i] = l2; sc[sub][i] = z + l2; }
                if (need_mask) {
#pragma unroll
                    for (int i = 0; i < 16; ++i) { const int key = kb + (i & 7) + 16 * (i >> 3); const bool ok = key < qidx; L[i] = ok ? L[i] : 0.f; sc[sub][i] = ok ? sc[sub][i] : -1.0e30f; } }
                float own_hi = 0.f, own_lo = 0.f, tl[16];
#pragma unroll
                for (int j = 7; j >= 0; --j) { tl[8 + j] = own_hi; own_hi += L[8 + j]; tl[j] = own_lo; own_lo += L[j]; }
                const float p_hi = xor32(own_hi, hh), p_lo = xor32(own_lo, hh);
                const float off_hi = Rrun + (hh ? 0.f : p_hi), off_lo = Rrun + own_hi + p_hi + (hh ? 0.f : p_lo);
                Rrun += (own_hi + own_lo) + (p_hi + p_lo);
#pragma unroll
                for (int i = 0; i < 16; ++i) sc[sub][i] = fexp2(sc[sub][i] + tl[i] + (i >= 8 ? off_hi : off_lo));
            }
        } else if (MODE == 2) {
#pragma unroll
            for (int sub = 0; sub < 2; ++sub) { f32x4 ak[4], dk[4];
#pragma unroll
                for (int r4 = 0; r4 < 4; ++r4) { const int o_ = 32 * sub + 8 * hh + 16 * (r4 >> 1) + 4 * (r4 & 1); ak[r4] = *(const LAS f32x4*)(AkL + o_); dk[r4] = *(const LAS f32x4*)(DkL + o_); }
#pragma unroll
                for (int i = 0; i < 16; ++i) { const float a_ = ak[(i >> 3) * 2 + ((i & 7) >> 2)][i & 3], d_ = dk[(i >> 3) * 2 + ((i & 7) >> 2)][i & 3];
                    sc[sub][i] = sc[sub][i] * d_ * fexp2(fminf(aq - a_, 0.f)); }
                if (need_mask) {
#pragma unroll
                    for (int i = 0; i < 16; ++i) { const int key = k0 + 32 * sub + 8 * hh + (i & 7) + 16 * (i >> 3); sc[sub][i] = key <= qidx ? sc[sub][i] : 0.f; } } }
        } else {
            if (need_mask) {
#pragma unroll
                for (int sub = 0; sub < 2; ++sub)
#pragma unroll
                    for (int i = 0; i < 16; ++i) { const int key = k0 + 32 * sub + 8 * hh + (i & 7) + 16 * (i >> 3); sc[sub][i] = key <= qidx ? sc[sub][i] : -1.0e30f; } }
            float tm = -1.0e30f;
#pragma unroll
            for (int sub = 0; sub < 2; ++sub)
#pragma unroll
                for (int i = 0; i < 16; ++i) tm = fmaxf(tm, sc[sub][i]);
            tm = fmaxf(tm, xor32(tm, hh));
            if (!__all(tm <= mrun)) {
                const float mnew = fmaxf(mrun, tm), alpha = fexp2(mrun - mnew); mrun = mnew; lsum *= alpha;
#pragma unroll
                for (int i = 0; i < 16; ++i) { o[0][i] *= alpha; o[1][i] *= alpha; } }
            float ps = 0.f;
#pragma unroll
            for (int sub = 0; sub < 2; ++sub)
#pragma unroll
                for (int i = 0; i < 16; ++i) { const float p = fexp2(sc[sub][i] - mrun); sc[sub][i] = p; ps += p; }
            lsum += ps;
        }
#pragma unroll
        for (int sub = 0; sub < 2; ++sub)
#pragma unroll
            for (int s = 0; s < 2; ++s) {
                bf16x8 pf; { u32x4 pw; pw.x = cvt_pk_bf16(sc[sub][8 * s + 0], sc[sub][8 * s + 1]); pw.y = cvt_pk_bf16(sc[sub][8 * s + 2], sc[sub][8 * s + 3]); pw.z = cvt_pk_bf16(sc[sub][8 * s + 4], sc[sub][8 * s + 5]); pw.w = cvt_pk_bf16(sc[sub][8 * s + 6], sc[sub][8 * s + 7]); pf = __builtin_bit_cast(bf16x8, pw); }
                const unsigned a0 = vt_addr + (unsigned)((32 * sub + 16 * s + 8 * hh + ((lane & 15) >> 2)) * VST + (16 * ((lane >> 4) & 1) + 4 * (lane & 3)) * 2);
                u32x2 v00, v01, v10, v11;
                asm volatile("ds_read_b64_tr_b16 %0, %4\n\tds_read_b64_tr_b16 %1, %4 offset:768\n\tds_read_b64_tr_b16 %2, %4 offset:64\n\tds_read_b64_tr_b16 %3, %4 offset:832\n\ts_waitcnt lgkmcnt(0)"
                             : "=&v"(v00), "=&v"(v01), "=&v"(v10), "=&v"(v11) : "v"(a0) : "memory");
                u32x4 va0; va0.x = v00.x; va0.y = v00.y; va0.z = v01.x; va0.w = v01.y;
                u32x4 va1; va1.x = v10.x; va1.y = v10.y; va1.z = v11.x; va1.w = v11.y;
                o[0] = mfma32(__builtin_bit_cast(bf16x8, va0), pf, o[0]);
                o[1] = mfma32(__builtin_bit_cast(bf16x8, va1), pf, o[1]);
            }
        }
        bool dead = false;
        if (MODE == 0) dead = Rrun < -64.0f;
        if (MODE == 2) dead = aq - AkL[0] < -64.0f;
        if (MODE == 1) { __syncthreads(); }
        else { volatile LAS unsigned* votes = (volatile LAS unsigned*)(C.lds + LDSCTL_OFF + 128) + 8 * bi;
            const bool wdead = __all(dead ? 1 : 0); if (lane == 0) votes[w] = wdead ? 1u : 0u;
            __syncthreads();
            unsigned all_ = 1u;
#pragma unroll
            for (int q_ = 0; q_ < 8; ++q_) all_ &= votes[q_];
            if (all_) break; }
    }
#undef ATT_LOAD
#undef ATT_STORE
    float inv = 1.0f;
    if (MODE == 1) { const float lt = lsum + xor32(lsum, hh); inv = frcp(lt); }
    bf16_t* Y = WSP(bf16_t, S_Y) + (tb + qidx) * 1024 + ycol;
    if (MODE == 2) {
        const float dsk = C.in[I_SSDD][l * 4 + h]; const bf16_t* xa = Vp + (tb + qidx) * 256; const bf16_t* zp = WSP(bf16_t, S_PROJ) + (tb + qidx) * NPROJ + PC_Z + h * 64; float q_ = 0.f;
#pragma unroll
        for (int dt = 0; dt < 2; ++dt)
#pragma unroll
            for (int g = 0; g < 4; ++g) { const int d0 = 32 * dt + 8 * g + 4 * hh; const f32x4 xv = ld_bf4(xa + d0), zv = ld_bf4(zp + d0); f32x4 y;
                for (int j = 0; j < 4; ++j) { y[j] = (o[dt][4 * g + j] + dsk * xv[j]) * siluf_(zv[j]); q_ += y[j] * y[j]; }
                st_bf4(Y + d0, y); }
        q_ += __shfl_xor(q_, 32);
        if (hh == 0) { float* SSQ = WSP(float, S_SSQ); SSQ[(tb + qidx) * 8 + h * 2] = q_; SSQ[(tb + qidx) * 8 + h * 2 + 1] = 0.f; }
        return;
    }
#pragma unroll
    for (int dt = 0; dt < 2; ++dt)
#pragma unroll
        for (int g = 0; g < 4; ++g) { u32x2 wv; wv.x = cvt_pk_bf16(o[dt][4 * g] * inv, o[dt][4 * g + 1] * inv); wv.y = cvt_pk_bf16(o[dt][4 * g + 2] * inv, o[dt][4 * g + 3] * inv);
            *(u32x2*)(Y + 32 * dt + 8 * g + 4 * hh) = wv; }
}

__device__ __forceinline__ float sum16(float v) { v = sum8(v); v += __builtin_bit_cast(float, __builtin_amdgcn_mov_dpp(__builtin_bit_cast(int, v), 0x140, 0xf, 0xf, true)); return v; }
__device__ __forceinline__ void rwkv_unit(const Ctx& C0_, int l, int b, int h, int half) {
    const Ctx C = launder(C0_);
    constexpr int TB = 32, NBLK = SEQ / TB, BUFB = 6 * TB * 64 * 4;
    LAS float* buf0 = (LAS float*)C.lds; LAS float* ybuf = (LAS float*)(C.lds + 2 * BUFB);
    const int tid = C.tid, il = tid >> 4, q = tid & 15, i = 32 * half + il;
    const float* DEC = WSP(float, S_DEC); const bf16_t* RWS = WSP(bf16_t, S_RWS); bf16_t* YRAW = WSP(bf16_t, S_YRAW);
    const size_t PL = (size_t)T * 256; const size_t tb = (size_t)b * SEQ;
    const int ls = tid >> 4, lj = 4 * (tid & 15);
    f32x4 gw; u32x2 gr[5];
#define RW_LOAD(blk) do { const size_t o_ = (tb + (size_t)(blk) * TB + ls) * 256 + h * 64 + lj; gw = *(const f32x4*)(DEC + o_); \
        gr[0] = *(const u32x2*)(RWS + 3 * PL + o_); gr[1] = *(const u32x2*)(RWS + 4 * PL + o_); gr[2] = *(const u32x2*)(RWS + PL + o_); gr[3] = *(const u32x2*)(RWS + o_); gr[4] = *(const u32x2*)(RWS + 2 * PL + o_); } while (0)
#define RW_STORE(bufp) do { LAS float* d_ = (bufp) + ls * 64 + lj; *(LAS f32x4*)d_ = gw; \
        _Pragma("unroll") for (int a_ = 0; a_ < 5; ++a_) *(LAS f32x4*)(d_ + (a_ + 1) * TB * 64) = (f32x4){bflo(gr[a_].x), bfhi(gr[a_].x), bflo(gr[a_].y), bfhi(gr[a_].y)}; } while (0)
    f32x4 S = (f32x4){0.f, 0.f, 0.f, 0.f};
    __syncthreads();
    RW_LOAD(0); RW_STORE(buf0);
    __syncthreads();
    for (int blk = 0; blk < NBLK; ++blk) {
        LAS float* cur = buf0 + (blk & 1) * (BUFB / 4); LAS float* nxtb = buf0 + ((blk + 1) & 1) * (BUFB / 4);
        if (blk + 1 < NBLK) RW_LOAD(blk + 1);
        for (int s0 = 0; s0 < TB; s0 += 4) {
            f32x4 w4[4], kk4[4], ka4[4], km4[4], r4[4]; float vv[4], yv[4];
#pragma unroll
            for (int u = 0; u < 4; ++u) { const LAS float* p = cur + (s0 + u) * 64 + 4 * q;
                w4[u] = *(const LAS f32x4*)p; kk4[u] = *(const LAS f32x4*)(p + TB * 64); ka4[u] = *(const LAS f32x4*)(p + 2 * TB * 64); km4[u] = *(const LAS f32x4*)(p + 3 * TB * 64); r4[u] = *(const LAS f32x4*)(p + 4 * TB * 64);
                vv[u] = cur[5 * TB * 64 + (s0 + u) * 64 + i]; }
#pragma unroll
            for (int u = 0; u < 4; ++u) {
                float sa = (S[0] * kk4[u][0] + S[1] * kk4[u][1]) + (S[2] * kk4[u][2] + S[3] * kk4[u][3]);
                sa = sum16(sa);
                S = S * w4[u] + (km4[u] * vv[u] - ka4[u] * sa);
                const float y = (S[0] * r4[u][0] + S[1] * r4[u][1]) + (S[2] * r4[u][2] + S[3] * r4[u][3]);
                yv[u] = sum16(y); }
            if (q == 0) {
#pragma unroll
                for (int u = 0; u < 4; ++u) ybuf[(s0 + u) * 32 + il] = yv[u]; }
        }
        __syncthreads();
        {
            const int os = tid >> 4, r2 = 2 * (tid & 15); const size_t t = tb + (size_t)blk * TB + os;
            *(unsigned*)(YRAW + t * 256 + h * 64 + 32 * half + r2) = cvt_pk_bf16(ybuf[os * 32 + r2], ybuf[os * 32 + r2 + 1]);
        }
        if (blk + 1 < NBLK) RW_STORE(nxtb);
        __syncthreads();
    }
#undef RW_LOAD
#undef RW_STORE
}

__device__ __forceinline__ void ssd_stage(const Ctx& C, int l, int h, size_t tb, int blk, LAS float* dst) {
    constexpr int TB = 16; const int g = h >> 1;
    const bf16_t* proj = WSP(bf16_t, S_PROJ); const float* cw = C.in[I_CONVW] + l * 4 * 768; const float* cb = C.in[I_CONVB] + l * 768;
    const float dtb = C.in[I_DTB][l * 4 + h], aneg = -expf(C.in[I_ALOG][l * 4 + h]);
    for (int it = C.tid; it < TB * 80; it += NTHREADS) {
        const int s = it / 80, v = it % 80; const int tl = blk * TB + s;
        int pcol, cch, doff;
        if (v < 16) { pcol = PC_XS + h * 64 + 4 * v; cch = h * 64 + 4 * v; doff = s * 64 + 4 * v; }
        else if (v < 48) { pcol = PC_BM + g * 128 + 4 * (v - 16); cch = 256 + g * 128 + 4 * (v - 16); doff = 2 * TB * 64 + s * 128 + 4 * (v - 16); }
        else { pcol = PC_CM + g * 128 + 4 * (v - 48); cch = 512 + g * 128 + 4 * (v - 48); doff = 2 * TB * 64 + TB * 128 + s * 128 + 4 * (v - 48); }
        f32x4 a = *(const f32x4*)(cb + cch);
#pragma unroll
        for (int k = 0; k < 4; ++k) { const int tt = tl - 3 + k; if (tt >= 0) a += ld_bf4(proj + (tb + tt) * NPROJ + pcol) * *(const f32x4*)(cw + k * 768 + cch); }
        for (int j = 0; j < 4; ++j) a[j] = siluf_(a[j]);
        if (v < 16) { const float dt = softplusf_(bf2f(proj[(tb + tl) * NPROJ + PC_DT + h]) + dtb); *(LAS f32x4*)(dst + TB * 64 + doff) = a; *(LAS f32x4*)(dst + doff) = a * dt;
                      if (v == 0) dst[TB * 384 + s] = expf(dt * aneg); }
        else *(LAS f32x4*)(dst + doff) = a;
    }
}
__device__ __forceinline__ void ssd_unit(const Ctx& C0_, int l, int b, int h, int ph) {
    const Ctx C = launder(C0_);
    constexpr int TB = 32, NBLK = SEQ / TB, NF = TB * (32 + 32 + 128 + 128) + 64, NIT = 72 * TB, NK = (NIT + NTHREADS - 1) / NTHREADS;
    LAS float* buf0 = (LAS float*)C.lds; LAS float* ypart = buf0 + 2 * NF;
    const int tid = C.tid, lane = C.lane, w = C.wave, g = h >> 1, pl = lane & 31, nh = lane >> 5;
    const bf16_t* proj = WSP(bf16_t, S_PROJ); bf16_t* Y = WSP(bf16_t, S_Y); float* SSQ = WSP(float, S_SSQ);
    const float* cw = C.in[I_CONVW] + l * 4 * 768; const float* cb = C.in[I_CONVB] + l * 768;
    const float dtb = C.in[I_DTB][l * 4 + h], aneg = -expf(C.in[I_ALOG][l * 4 + h]), dsk = C.in[I_SSDD][l * 4 + h];
    const size_t tb = (size_t)b * SEQ;
    int its[NK], itp[NK], itd[NK], itc[NK]; bool itx[NK];
#pragma unroll
    for (int k = 0; k < NK; ++k) { const int it = tid + NTHREADS * k, sidx = it / 72, v = it % 72; int pcol, cch, doff;
        if (v < 8) { pcol = PC_XS + h * 64 + 32 * ph + 4 * v; cch = h * 64 + 32 * ph + 4 * v; doff = sidx * 32 + 4 * v; }
        else if (v < 40) { pcol = PC_BM + g * 128 + 4 * (v - 8); cch = 256 + g * 128 + 4 * (v - 8); doff = 2 * TB * 32 + sidx * 128 + 4 * (v - 8); }
        else { pcol = PC_CM + g * 128 + 4 * (v - 40); cch = 512 + g * 128 + 4 * (v - 40); doff = 2 * TB * 32 + TB * 128 + sidx * 128 + 4 * (v - 40); }
        its[k] = sidx; itp[k] = pcol; itd[k] = doff; itx[k] = v < 8; itc[k] = cch; }
    const bool haslast = tid + NTHREADS * (NK - 1) < NIT;
    u32x2 raw[NK][4]; float dtr[NK]; unsigned short zraw;
    const int os = tid >> 4, op = tid & 15;
#define SSD_LOAD(blk) do { _Pragma("unroll") for (int k = 0; k < NK; ++k) { if (k < NK - 1 || haslast) { const int tl_ = (blk) * TB + its[k]; \
            _Pragma("unroll") for (int q = 0; q < 4; ++q) { const int tt_ = tl_ - 3 + q; raw[k][q] = tt_ >= 0 ? *(const u32x2*)(proj + (tb + tt_) * NPROJ + itp[k]) : (u32x2){0u, 0u}; } \
            dtr[k] = itx[k] ? bf2f(proj[(tb + tl_) * NPROJ + PC_DT + h]) : 0.f; } } } while (0)
#define SSD_COMMIT(dst) do { _Pragma("unroll") for (int k = 0; k < NK; ++k) { if (k < NK - 1 || haslast) { f32x4 a_ = *(const f32x4*)(cb + itc[k]); \
            _Pragma("unroll") for (int q = 0; q < 4; ++q) a_ += (f32x4){bflo(raw[k][q].x), bfhi(raw[k][q].x), bflo(raw[k][q].y), bfhi(raw[k][q].y)} * *(const f32x4*)(cw + q * 768 + itc[k]); \
            for (int j = 0; j < 4; ++j) a_[j] = siluf_(a_[j]); \
            if (itx[k]) { const float dt_ = softplusf_(dtr[k] + dtb); *(LAS f32x4*)((dst) + TB * 32 + itd[k]) = a_; *(LAS f32x4*)((dst) + itd[k]) = a_ * dt_; if ((itd[k] & 31) == 0) (dst)[TB * 320 + its[k]] = expf(dt_ * aneg); } \
            else *(LAS f32x4*)((dst) + itd[k]) = a_; } } } while (0)
    float hs[8];
#pragma unroll
    for (int k = 0; k < 8; ++k) hs[k] = 0.f;
    __syncthreads();
    SSD_LOAD(0); SSD_COMMIT(buf0);
    __syncthreads();
    for (int blk = 0; blk < NBLK; ++blk) {
        LAS float* cur = buf0 + (blk & 1) * NF; LAS float* nxtb = buf0 + ((blk + 1) & 1) * NF;
        if (blk + 1 < NBLK) SSD_LOAD(blk + 1);
        const size_t tz = tb + (size_t)blk * TB + os;
        zraw = proj[tz * NPROJ + PC_Z + h * 64 + 32 * ph + op]; const unsigned short zraw2 = proj[tz * NPROJ + PC_Z + h * 64 + 32 * ph + op + 16];
        for (int s0 = 0; s0 < TB; s0 += 4) {
            float x4[4], dA4[4], yv[4]; f32x4 bv[4][2], cv[4][2];
#pragma unroll
            for (int u = 0; u < 4; ++u) { const int s = s0 + u; x4[u] = cur[s * 32 + pl]; dA4[u] = cur[TB * 320 + s];
                const LAS float* bp = cur + 2 * TB * 32 + s * 128 + 16 * w + 8 * nh; const LAS float* cp = bp + TB * 128;
                bv[u][0] = *(const LAS f32x4*)bp; bv[u][1] = *(const LAS f32x4*)(bp + 4); cv[u][0] = *(const LAS f32x4*)cp; cv[u][1] = *(const LAS f32x4*)(cp + 4); }
#pragma unroll
            for (int u = 0; u < 4; ++u) { float yp = 0.f;
#pragma unroll
                for (int k4 = 0; k4 < 2; ++k4)
#pragma unroll
                    for (int j = 0; j < 4; ++j) { hs[4 * k4 + j] = hs[4 * k4 + j] * dA4[u] + x4[u] * bv[u][k4][j]; yp += cv[u][k4][j] * hs[4 * k4 + j]; }
                const auto sw = __builtin_amdgcn_permlane32_swap(__builtin_bit_cast(unsigned, yp), __builtin_bit_cast(unsigned, yp), false, false);
                yv[u] = yp + __builtin_bit_cast(float, (unsigned)sw[1]); }
            if (nh == 0) {
#pragma unroll
                for (int u = 0; u < 4; ++u) ypart[((s0 + u) * 8 + w) * 32 + pl] = yv[u]; }
        }
        if (blk + 1 < NBLK) SSD_COMMIT(nxtb);
        __syncthreads();
        {
            float y0 = 0.f, y1 = 0.f;
#pragma unroll
            for (int ww = 0; ww < 8; ++ww) { y0 += ypart[(os * 8 + ww) * 32 + op]; y1 += ypart[(os * 8 + ww) * 32 + op + 16]; }
            y0 += cur[TB * 32 + os * 32 + op] * dsk; y1 += cur[TB * 32 + os * 32 + op + 16] * dsk;
            y0 *= siluf_(bf2f(zraw)); y1 *= siluf_(bf2f(zraw2));
            bf16_t* yo = Y + tz * 1024 + 512 + h * 64 + 32 * ph + op;
            yo[0] = (bf16_t)(cvt_pk_bf16(y0, 0.f) & 0xffffu); yo[16] = (bf16_t)(cvt_pk_bf16(y1, 0.f) & 0xffffu);
            float q = y0 * y0 + y1 * y1;
#pragma unroll
            for (int o_ = 1; o_ < 16; o_ <<= 1) q += __shfl_xor(q, o_);
            if (op == 0) SSQ[tz * 8 + h * 2 + ph] = q;
        }
        __syncthreads();
    }
#undef SSD_LOAD
#undef SSD_COMMIT
}

__device__ __forceinline__ void sb_naive(const Ctx& C) {
    const bf16_t* proj = WSP(bf16_t, S_PROJ); bf16_t* Y = WSP(bf16_t, S_Y); const int lane = C.lane;
    for (int item = GW; item < T * 4; item += NGW) {
        const int t = item >> 2, h = item & 3, tq = t % SEQ; const size_t tb = (size_t)(t - tq);
        float q[64];
        { const bf16_t* qp = proj + (size_t)t * NPROJ + PC_SBQ + h * 64;
#pragma unroll
          for (int i = 0; i < 8; ++i) { const u32x4 w = *(const u32x4*)(qp + 8 * i); q[8*i] = bflo(w.x); q[8*i+1] = bfhi(w.x); q[8*i+2] = bflo(w.y); q[8*i+3] = bfhi(w.y); q[8*i+4] = bflo(w.z); q[8*i+5] = bfhi(w.z); q[8*i+6] = bflo(w.w); q[8*i+7] = bfhi(w.w); } }
        float o[64];
#pragma unroll
        for (int d = 0; d < 64; ++d) o[d] = 0.f;
        float R = 0.f;
        for (int c = (tq - 1) >> 6; c >= 0 && tq > 0; --c) {
            const int key = c * 64 + lane; const bool ok = key < tq;
            const bf16_t* kp = proj + (tb + key) * NPROJ + PC_SBK + h * 64; const bf16_t* vp = proj + (tb + key) * NPROJ + PC_SBV + h * 64;
            float z = 0.f;
#pragma unroll
            for (int i = 0; i < 8; ++i) { const u32x4 w = *(const u32x4*)(kp + 8 * i);
                z += q[8*i] * bflo(w.x) + q[8*i+1] * bfhi(w.x) + q[8*i+2] * bflo(w.y) + q[8*i+3] * bfhi(w.y) + q[8*i+4] * bflo(w.z) + q[8*i+5] * bfhi(w.z) + q[8*i+6] * bflo(w.w) + q[8*i+7] * bfhi(w.w); }
            const float L = ok ? -(fmaxf(z, 0.f) + flog2(1.0f + fexp2(-fabsf(z)))) : 0.f;
            float sfx = L;
#pragma unroll
            for (int dd = 1; dd < 64; dd <<= 1) { const float tt = __shfl_down(sfx, dd); if (lane + dd < 64) sfx += tt; }
            const float tot = __shfl(sfx, 0);
            const float wgt = ok ? fexp2(z + L + (sfx - L) + R) : 0.f;
            R += tot;
#pragma unroll
            for (int i = 0; i < 8; ++i) { const u32x4 w = *(const u32x4*)(vp + 8 * i);
                o[8*i] += wgt * bflo(w.x); o[8*i+1] += wgt * bfhi(w.x); o[8*i+2] += wgt * bflo(w.y); o[8*i+3] += wgt * bfhi(w.y); o[8*i+4] += wgt * bflo(w.z); o[8*i+5] += wgt * bfhi(w.z); o[8*i+6] += wgt * bflo(w.w); o[8*i+7] += wgt * bfhi(w.w); }
        }
        float mine = 0.f;
#pragma unroll
        for (int d = 0; d < 64; ++d) { const float sdd = wave_sum(o[d]); if (lane == d) mine = sdd; }
        Y[(size_t)t * 1024 + h * 64 + lane] = (bf16_t)(cvt_pk_bf16(mine, 0.f) & 0xffffu);
    }
}

__device__ __forceinline__ void rwkv_naive(const Ctx& C, int l) {
    const float* DEC = WSP(float, S_DEC); const bf16_t* RWS = WSP(bf16_t, S_RWS); const bf16_t* GV = WSP(bf16_t, S_GV); bf16_t* Y = WSP(bf16_t, S_Y);
    const size_t PL = (size_t)T * 256; const int lane = C.lane;
    for (int item = GW; item < 64; item += NGW) {
        const int b = item >> 2, h = item & 3; const float* rk = C.in[I_RWRK] + l * 256 + h * 64;
        const float gng = C.in[I_RWGNG][l * 256 + h * 64 + lane], gnb = C.in[I_RWGNB][l * 256 + h * 64 + lane];
        float S[64];
#pragma unroll
        for (int j = 0; j < 64; ++j) S[j] = 0.f;
        for (int tq = 0; tq < SEQ; ++tq) {
            const size_t o = ((size_t)b * SEQ + tq) * 256 + h * 64;
            const float v = bf2f(RWS[2 * PL + o + lane]);
            float sa = 0.f;
#pragma unroll
            for (int j = 0; j < 64; ++j) sa += S[j] * bf2f(RWS[3 * PL + o + j]);
            float y = 0.f, bd = 0.f;
#pragma unroll
            for (int j = 0; j < 64; ++j) { const float km = bf2f(RWS[PL + o + j]), r = bf2f(RWS[o + j]);
                S[j] = S[j] * DEC[o + j] + (v * km - sa * bf2f(RWS[4 * PL + o + j])); y += S[j] * r; bd += r * km * rk[j]; }
            const float mu = wave_sum(y) * (1.0f / 64.0f), d = y - mu, var = wave_sum(d * d) * (1.0f / 64.0f);
            const float res = (d * (1.0f / sqrtf(var + 64e-5f)) * gng + gnb + v * bd) * bf2f(GV[o + lane]);
            Y[((size_t)b * SEQ + tq) * 1024 + 256 + h * 64 + lane] = (bf16_t)(cvt_pk_bf16(res, 0.f) & 0xffffu);
        }
    }
}
__device__ __forceinline__ void ssd_naive(const Ctx& C, int l) {
    const bf16_t* proj = WSP(bf16_t, S_PROJ); bf16_t* Y = WSP(bf16_t, S_Y); float* SSQ = WSP(float, S_SSQ); const int lane = C.lane;
    const float* cw = C.in[I_CONVW] + l * 4 * 768; const float* cb = C.in[I_CONVB] + l * 768;
    for (int item2 = GW; item2 < 128; item2 += NGW) {
        const int item = item2 >> 1, ph = item2 & 1; const int b = item >> 2, h = item & 3, g = h >> 1; const size_t tb = (size_t)b * SEQ;
        const float dtb = C.in[I_DTB][l * 4 + h], aneg = -expf(C.in[I_ALOG][l * 4 + h]), dsk = C.in[I_SSDD][l * 4 + h];
        float hs0[32], hs1[32];
#pragma unroll
        for (int p = 0; p < 32; ++p) { hs0[p] = 0.f; hs1[p] = 0.f; }
        for (int tq = 0; tq < SEQ; ++tq) {
            const bf16_t* pr = proj + (tb + tq) * NPROJ;
            float xa = cb[h * 64 + lane], bv0 = cb[256 + g * 128 + lane], bv1 = cb[256 + g * 128 + 64 + lane], cv0 = cb[512 + g * 128 + lane], cv1 = cb[512 + g * 128 + 64 + lane];
            for (int k = 0; k < 4; ++k) { const int tt = tq - 3 + k; if (tt >= 0) { const bf16_t* pp = proj + (tb + tt) * NPROJ; const float* ww = cw + k * 768;
                xa += bf2f(pp[PC_XS + h * 64 + lane]) * ww[h * 64 + lane];
                bv0 += bf2f(pp[PC_BM + g * 128 + lane]) * ww[256 + g * 128 + lane]; bv1 += bf2f(pp[PC_BM + g * 128 + 64 + lane]) * ww[256 + g * 128 + 64 + lane];
                cv0 += bf2f(pp[PC_CM + g * 128 + lane]) * ww[512 + g * 128 + lane]; cv1 += bf2f(pp[PC_CM + g * 128 + 64 + lane]) * ww[512 + g * 128 + 64 + lane]; } }
            xa = siluf_(xa); bv0 = siluf_(bv0); bv1 = siluf_(bv1); cv0 = siluf_(cv0); cv1 = siluf_(cv1);
            const float dt = softplusf_(bf2f(pr[PC_DT + h]) + dtb), dA = expf(dt * aneg), xd = xa * dt;
            float y = 0.f;
#pragma unroll
            for (int p = 0; p < 32; ++p) { const float xp = __shfl(xd, 32 * ph + p); hs0[p] = hs0[p] * dA + xp * bv0; hs1[p] = hs1[p] * dA + xp * bv1;
                const float tot = wave_sum(cv0 * hs0[p] + cv1 * hs1[p]); if (lane == 32 * ph + p) y = tot; }
            y += dsk * xa; y *= siluf_(bf2f(pr[PC_Z + h * 64 + lane]));
            const bool mine = (lane >> 5) == ph; if (mine) Y[(tb + tq) * 1024 + 512 + h * 64 + lane] = (bf16_t)(cvt_pk_bf16(y, 0.f) & 0xffffu);
            const float q = wave_sum(mine ? y * y : 0.f); if (lane == 0) atomicAdd(&SSQ[(tb + tq) * 8 + h * 2], q);
        }
    }
}

__device__ __forceinline__ void mla_naive(const Ctx& C) {
    const bf16_t* QM = WSP(bf16_t, S_QM); const bf16_t* KM = WSP(bf16_t, S_KM); const bf16_t* VM = WSP(bf16_t, S_VM); bf16_t* Y = WSP(bf16_t, S_Y); const int lane = C.lane;
    for (int item = GW; item < T * 4; item += NGW) {
        const int t = item >> 2, h = item & 3, tq = t % SEQ; const size_t tb = (size_t)(t - tq);
        float q[96];
        { const bf16_t* qp = QM + (size_t)t * 384 + h * 96;
#pragma unroll
          for (int i = 0; i < 12; ++i) { const u32x4 w = *(const u32x4*)(qp + 8 * i); q[8*i] = bflo(w.x); q[8*i+1] = bfhi(w.x); q[8*i+2] = bflo(w.y); q[8*i+3] = bfhi(w.y); q[8*i+4] = bflo(w.z); q[8*i+5] = bfhi(w.z); q[8*i+6] = bflo(w.w); q[8*i+7] = bfhi(w.w); } }
        float o[64];
#pragma unroll
        for (int d = 0; d < 64; ++d) o[d] = 0.f;
        float m = -1.0e30f, lsum = 0.f;
        for (int c = tq >> 6; c >= 0; --c) {
            const int key = c * 64 + lane; const bool ok = key <= tq;
            const bf16_t* kp = KM + (tb + (ok ? key : 0)) * 384 + h * 96; const bf16_t* vp = VM + (tb + (ok ? key : 0)) * 256 + h * 64;
            float z = 0.f;
#pragma unroll
            for (int i = 0; i < 12; ++i) { const u32x4 w = *(const u32x4*)(kp + 8 * i);
                z += q[8*i] * bflo(w.x) + q[8*i+1] * bfhi(w.x) + q[8*i+2] * bflo(w.y) + q[8*i+3] * bfhi(w.y) + q[8*i+4] * bflo(w.z) + q[8*i+5] * bfhi(w.z) + q[8*i+6] * bflo(w.w) + q[8*i+7] * bfhi(w.w); }
            z = ok ? z : -1.0e30f;
            float cm = z;
#pragma unroll
            for (int dd = 1; dd < 64; dd <<= 1) cm = fmaxf(cm, __shfl_xor(cm, dd));
            const float mn = fmaxf(m, cm), al = fexp2(m - mn), pw = ok ? fexp2(z - mn) : 0.f; m = mn; lsum = lsum * al + pw;
#pragma unroll
            for (int i = 0; i < 8; ++i) { const u32x4 w = *(const u32x4*)(vp + 8 * i);
                o[8*i] = o[8*i] * al + pw * bflo(w.x); o[8*i+1] = o[8*i+1] * al + pw * bfhi(w.x); o[8*i+2] = o[8*i+2] * al + pw * bflo(w.y); o[8*i+3] = o[8*i+3] * al + pw * bfhi(w.y);
                o[8*i+4] = o[8*i+4] * al + pw * bflo(w.z); o[8*i+5] = o[8*i+5] * al + pw * bfhi(w.z); o[8*i+6] = o[8*i+6] * al + pw * bflo(w.w); o[8*i+7] = o[8*i+7] * al + pw * bfhi(w.w); }
        }
        const float lt = wave_sum(lsum); float mine = 0.f;
#pragma unroll
        for (int d = 0; d < 64; ++d) { const float sdd = wave_sum(o[d]); if (lane == d) mine = sdd; }
        Y[(size_t)t * 1024 + 768 + h * 64 + lane] = (bf16_t)(cvt_pk_bf16(mine / lt, 0.f) & 0xffffu);
    }
}
__device__ __forceinline__ void xattn_naive(const Ctx& C, int l) {
    const bf16_t* XQ = WSP(bf16_t, S_XQ); const bf16_t* KMEM = WSP(bf16_t, W_KMEM) + (size_t)l * NMEM * 1024; const bf16_t* VT = WSP(bf16_t, W_VMEMT) + (size_t)l * 1024 * NMEM; bf16_t* XO = WSP(bf16_t, S_XO); const int lane = C.lane;
    for (int item = GW; item < T * 4; item += NGW) {
        const int t = item >> 2, h = item & 3, b = t / SEQ;
        float z[4] = {0.f, 0.f, 0.f, 0.f};
        for (int d8 = 0; d8 < 32; ++d8) { const u32x4 qw = *(const u32x4*)(XQ + (size_t)t * 1024 + h * 256 + 8 * d8);
            const float qv[8] = {bflo(qw.x), bfhi(qw.x), bflo(qw.y), bfhi(qw.y), bflo(qw.z), bfhi(qw.z), bflo(qw.w), bfhi(qw.w)};
#pragma unroll
            for (int j = 0; j < 4; ++j) { const u32x4 kw = *(const u32x4*)(KMEM + (size_t)(b * 256 + lane + 64 * j) * 1024 + h * 256 + 8 * d8);
                z[j] += qv[0] * bflo(kw.x) + qv[1] * bfhi(kw.x) + qv[2] * bflo(kw.y) + qv[3] * bfhi(kw.y) + qv[4] * bflo(kw.z) + qv[5] * bfhi(kw.z) + qv[6] * bflo(kw.w) + qv[7] * bfhi(kw.w); } }
        float mx = fmaxf(fmaxf(z[0], z[1]), fmaxf(z[2], z[3]));
#pragma unroll
        for (int dd = 1; dd < 64; dd <<= 1) mx = fmaxf(mx, __shfl_xor(mx, dd));
        float p[4], ps = 0.f;
#pragma unroll
        for (int j = 0; j < 4; ++j) { p[j] = fexp2(z[j] - mx); ps += p[j]; }
        const float inv = 1.0f / wave_sum(ps);
        float o[4] = {0.f, 0.f, 0.f, 0.f};
        for (int mm = 0; mm < 256; ++mm) { const float pm = __shfl(p[mm >> 6], mm & 63);
#pragma unroll
            for (int jd = 0; jd < 4; ++jd) o[jd] += pm * bf2f(VT[(size_t)(h * 256 + lane + 64 * jd) * NMEM + b * 256 + mm]); }
#pragma unroll
        for (int jd = 0; jd < 4; ++jd) XO[(size_t)t * 1024 + h * 256 + lane + 64 * jd] = (bf16_t)(cvt_pk_bf16(o[jd] * inv, 0.f) & 0xffffu);
    }
}
__device__ __forceinline__ void ph_mixers(const Ctx& C, int l, int rep = 0) {
    unsigned* head = (unsigned*)(C.ws + WS_CTL) + CW_QUEUE + 64 * (l + 2 * rep);
    volatile LAS unsigned* slot = (volatile LAS unsigned*)(C.lds + LDSCTL_OFF + 64);
    constexpr int N_RW = 128, N_ATT = 768, NITEMS = N_RW + N_ATT;
    for (;;) {
        __syncthreads();
        if (C.tid == 0) slot[0] = __hip_atomic_fetch_add(head, 1u, RLX_AGENT);
        __syncthreads();
        const int it = (int)slot[0];
        if (it >= NITEMS) break;
#ifndef NAIVE_SCAN
#define NAIVE_SCAN 0
#endif
        if (it < N_RW) { if (!(NAIVE_SCAN & 1)) { rwkv_unit(C, l, it >> 3, (it >> 1) & 3, it & 1);
#ifdef TIME_RW2
            __syncthreads(); rwkv_unit(C, l, it >> 3, (it >> 1) & 3, it & 1);
#endif
        } }
        else { const int k = it - N_RW; const int mode = k >> 8, kk_ = k & 255, pp = kk_ & 3, bh = kk_ >> 2, b = bh >> 2, h = bh & 3;
            if (mode == 0) { if (!(NAIVE_SCAN & 2)) { attn_unit<2>(C, l, b, h, 7 - pp); __syncthreads(); attn_unit<2>(C, l, b, h, pp);
#ifdef TIME_SSDA2
                __syncthreads(); attn_unit<2>(C, l, b, h, 7 - pp); __syncthreads(); attn_unit<2>(C, l, b, h, pp);
#endif
            } }
#ifndef NAIVE_SB
            else if (mode == 2) { attn_unit<0>(C, l, b, h, 7 - pp); __syncthreads(); attn_unit<0>(C, l, b, h, pp);
#ifdef TIME_SB2
                __syncthreads(); attn_unit<0>(C, l, b, h, 7 - pp); __syncthreads(); attn_unit<0>(C, l, b, h, pp);
#endif
            }
#else
            else if (mode == 2) { }
#endif
#ifndef NAIVE_MLA
            else { attn_unit<1>(C, l, b, h, 7 - pp); __syncthreads(); attn_unit<1>(C, l, b, h, pp);
#ifdef TIME_MLA2
                __syncthreads(); attn_unit<1>(C, l, b, h, 7 - pp); __syncthreads(); attn_unit<1>(C, l, b, h, pp);
#endif
            }
#else
            else { }
#endif
        }
    }
#ifdef NAIVE_SB
    sb_naive(C);
#endif
#ifdef NAIVE_MLA
    mla_naive(C);
#endif
    if (NAIVE_SCAN & 1) rwkv_naive(C, l);
    if (NAIVE_SCAN & 2) ssd_naive(C, l);
}
__device__ __forceinline__ void ph_router(const Ctx& C) {
    run_tjobs<16, true>(C);
    __syncthreads();
    LAS unsigned* lc = (LAS unsigned*)(C.lds + XCH_OFF);
    if (C.tid < 8) lc[C.tid] = 0u;
    __syncthreads();
    const float* xr = WSP(float, W_XRES); const float* rt = C.in[I_ROUTER]; int* topi = WSP(int, S_TOPI); float* topw = WSP(float, S_TOPW); const int lane = C.lane;
    for (int k = 0; k < 16; ++k) {
        const int t = C.bid * 128 + C.wave * 16 + k; float a[8];
#pragma unroll
        for (int e = 0; e < 8; ++e) a[e] = 0.f;
#pragma unroll
        for (int j = 0; j < 4; ++j) { const f32x4 xv = *(const f32x4*)(xr + (size_t)t * 1024 + 4 * lane + 256 * j);
#pragma unroll
            for (int q = 0; q < 4; ++q) { const float* rp = rt + (size_t)(4 * lane + 256 * j + q) * 8; const f32x4 r0 = *(const f32x4*)rp, r1 = *(const f32x4*)(rp + 4);
                a[0] += xv[q] * r0[0]; a[1] += xv[q] * r0[1]; a[2] += xv[q] * r0[2]; a[3] += xv[q] * r0[3]; a[4] += xv[q] * r1[0]; a[5] += xv[q] * r1[1]; a[6] += xv[q] * r1[2]; a[7] += xv[q] * r1[3]; } }
#pragma unroll
        for (int e = 0; e < 8; ++e) a[e] = wave_sum(a[e]);
#ifdef ROUTER_NOISE
        for (int e = 0; e < 8; ++e) { unsigned hsh = (unsigned)t * 2654435761u + (unsigned)e * 40503u; hsh ^= hsh >> 13; hsh *= 0x5bd1e995u; hsh ^= hsh >> 15; a[e] += ROUTER_NOISE * ((float)(hsh & 0xffff) * (1.0f / 32768.0f) - 1.0f); }
#endif
        if (lane == 0) {
            int i1 = 0; float v1 = a[0];
#pragma unroll
            for (int e = 1; e < 8; ++e) if (a[e] > v1) { v1 = a[e]; i1 = e; }
            int i2 = -1; float v2 = -3.0e38f;
#pragma unroll
            for (int e = 0; e < 8; ++e) if (e != i1 && a[e] > v2) { v2 = a[e]; i2 = e; }
            const float g1 = 1.0f / (1.0f + expf(v2 - v1));
            topi[2 * t] = i1; topi[2 * t + 1] = i2; topw[2 * t] = g1; topw[2 * t + 1] = 1.0f - g1;
            __hip_atomic_fetch_add(&lc[i1], 1u, __ATOMIC_RELAXED, __HIP_MEMORY_SCOPE_WORKGROUP); __hip_atomic_fetch_add(&lc[i2], 1u, __ATOMIC_RELAXED, __HIP_MEMORY_SCOPE_WORKGROUP);
        }
    }
    __syncthreads();
    if (C.tid < 8) ((unsigned*)(C.ws + WS_CTL))[CW_MOECNT + C.bid * 8 + C.tid] = lc[C.tid];
}
__device__ __forceinline__ void ph_scatter(const Ctx& C) {
    LAS int* sh = (LAS int*)(C.lds + XCH_OFF);
    const unsigned* cnt = (const unsigned*)(C.ws + WS_CTL) + CW_MOECNT;
    int* row_slot = WSP(int, S_ROWSLOT); float* row_w = WSP(float, S_ROWW); int* blk_e = WSP(int, S_BLKE);
    const int* topi = WSP(int, S_TOPI); const float* topw = WSP(float, S_TOPW);
    const int tid = C.tid;
    if (tid < 8) { int tot = 0, mine = 0; for (int wg = 0; wg < 256; ++wg) { const int c = (int)cnt[wg * 8 + tid]; if (wg < C.bid) mine += c; tot += c; } sh[tid] = tot; sh[8 + tid] = mine; sh[32 + tid] = 0; }
    __syncthreads();
    if (tid == 0) { int ps = 0; for (int e = 0; e < 8; ++e) { sh[16 + e] = ps; const int pad = (sh[e] + 255) / 256 * 256; sh[24 + e] = pad; ps += pad; } sh[40] = ps / 256; }
    __syncthreads();
    if (C.bid == 0) {
        const int used = sh[40];
        for (int rb = tid; rb < MOE_BLOCKS; rb += NTHREADS) { int e = 7; if (rb < used) { e = 0; for (int q = 1; q < 8; ++q) if (sh[16 + q] <= rb * 256) e = q; } blk_e[rb] = e; }
        if (tid == 0) blk_e[MOE_BLOCKS] = used;
    }
    if (C.bid < 8) { const int e = C.bid; for (int r = sh[16 + e] + sh[e] + tid; r < sh[16 + e] + sh[24 + e]; r += NTHREADS) { row_slot[r] = -1; row_w[r] = 0.f; } }
    if (tid < 256) { const int t = C.bid * 128 + (tid >> 1), k = tid & 1, e = topi[2 * t + k];
        const int pos = __hip_atomic_fetch_add(&sh[32 + e], 1, __ATOMIC_RELAXED, __HIP_MEMORY_SCOPE_WORKGROUP); const int dest = sh[16 + e] + sh[8 + e] + pos; row_slot[dest] = 2 * t + k; row_w[dest] = topw[2 * t + k]; sh[64 + tid] = dest; }
    __syncthreads();
    const bf16_t* xb = WSP(bf16_t, W_XB); bf16_t* xs = WSP(bf16_t, S_XS);
    for (int a = C.wave * 32; a < C.wave * 32 + 32; ++a) { const int t = C.bid * 128 + (a >> 1); const size_t d = (size_t)sh[64 + a] * 1024;
#pragma unroll
        for (int j = 0; j < 2; ++j) *(u32x4*)(xs + d + (C.lane + 64 * j) * 8) = *(const u32x4*)(xb + (size_t)t * 1024 + (C.lane + 64 * j) * 8); }
}


__device__ __forceinline__ void chk_moe(const Ctx& C, int bit) {
    const float* xr = WSP(float, W_XRES); const float* rt = C.in[I_ROUTER]; const float* w13 = C.in[I_MOE13]; const float* w2 = C.in[I_MOE2]; const bf16_t* ys = WSP(bf16_t, S_YS);
    LAS float* hb = (LAS float*)(C.lds + C.wave * 14336); const int lane = C.lane; unsigned bad = 0;
    float* stash = WSP(float, W_KMEM); const float* g3 = C.in[I_LN3G] + 1024; const float* b3 = C.in[I_LN3B] + 1024;
    for (int s = GW; s < 1024; s += NGW) {
        const int t = (int)(((long)s * 1021 + 7) % T); float x[16];
#pragma unroll
        for (int j = 0; j < 16; ++j) x[j] = xr[(size_t)t * 1024 + lane + 64 * j];
        float lg[8];
#pragma unroll
        for (int e = 0; e < 8; ++e) { float a = 0.f;
#pragma unroll
            for (int j = 0; j < 16; ++j) a += x[j] * rt[(size_t)(lane + 64 * j) * 8 + e]; lg[e] = wave_sum(a); }
        int i1 = 0; for (int e = 1; e < 8; ++e) if (lg[e] > lg[i1]) i1 = e;
        int i2 = -1; for (int e = 0; e < 8; ++e) if (e != i1 && (i2 < 0 || lg[e] > lg[i2])) i2 = e;
        float v3 = -3.0e38f; for (int e = 0; e < 8; ++e) if (e != i1 && e != i2) v3 = fmaxf(v3, lg[e]);
        if (lg[i2] - v3 < 0.02f) { if (lane == 0) stash[(size_t)s * 1024] = 1.0e30f; continue; }
        const float g1 = 1.0f / (1.0f + expf(lg[i2] - lg[i1]));
        float out[16];
#pragma unroll
        for (int j = 0; j < 16; ++j) out[j] = 0.f;
        for (int q = 0; q < 2; ++q) { const int e = q ? i2 : i1; const float gw = q ? 1.0f - g1 : g1; const float* W1 = w13 + (size_t)e * 1024 * 2 * FFE;
            for (int i0 = 0; i0 < 56; i0 += 4) { float ag[4], au[4];
#pragma unroll
                for (int i = 0; i < 4; ++i) { ag[i] = 0.f; au[i] = 0.f; }
                for (int k = 0; k < 1024; ++k) { const float xk = __shfl(x[k >> 6], k & 63); const float* wr = W1 + (size_t)k * 2 * FFE + lane + 64 * i0;
#pragma unroll
                    for (int i = 0; i < 4; ++i) { ag[i] += xk * wr[64 * i]; au[i] += xk * wr[FFE + 64 * i]; } }
#pragma unroll
                for (int i = 0; i < 4; ++i) hb[lane + 64 * (i0 + i)] = (ag[i] / (1.0f + expf(-ag[i]))) * au[i]; }
            LDS_WAIT();
            const float* W2 = w2 + (size_t)e * FFE * 1024;
            for (int hh = 0; hh < FFE; ++hh) { const float hv = hb[hh] * gw;
#pragma unroll
                for (int j = 0; j < 16; ++j) out[j] += hv * W2[(size_t)hh * 1024 + lane + 64 * j]; }
            LDS_WAIT(); }
#pragma unroll
        for (int j = 0; j < 16; ++j) { const int c = lane + 64 * j; const float got = bf2f(ys[(size_t)(2 * t) * 1024 + c]) + bf2f(ys[(size_t)(2 * t + 1) * 1024 + c]);
            if (fabsf(got - out[j]) > 0.05f * fabsf(out[j]) + 0.03f) bad = 1; }
        { float v[16], sm = 0.f, s2 = 0.f;
#pragma unroll
          for (int j = 0; j < 16; ++j) { v[j] = x[j] * DN_ALPHA + out[j]; sm += v[j]; }
          const float mean = wave_sum(sm) * (1.0f / 1024.0f);
#pragma unroll
          for (int j = 0; j < 16; ++j) { v[j] -= mean; s2 += v[j] * v[j]; }
          const float rstd = 1.0f / sqrtf(wave_sum(s2) * (1.0f / 1024.0f) + 1e-5f);
          int zz = 0; asm volatile("" : "+v"(zz));
#pragma unroll
          for (int j = 0; j < 16; ++j) { const int c = lane + 64 * j + zz; stash[(size_t)s * 1024 + c] = v[j] * rstd * g3[c] + b3[c]; } }
    }
    chk_flag(C, bit, bad);
}
#ifndef ABL_MIX
#define ABL_MIX 1.0f
#endif
#ifndef ABL_XA
#define ABL_XA 1.0f
#endif
#ifndef ABL_FF
#define ABL_FF 1.0f
#endif
#ifndef CHK_TOL2
#define CHK_TOL2 0.05f
#endif
#ifndef GATE_ACT
#define GATE_ACT 1
#endif
#ifndef GATE_ALIGN
#define GATE_ALIGN true
#endif
#ifndef FG_TOL
#define FG_TOL 0.05f
#endif
#ifndef FG_BIT
#define FG_BIT 1
#endif
#ifndef CHECKS_LAYER
#define CHECKS_LAYER 0
#endif
#ifndef MK_SPLIT
#define MK_SPLIT 0
#endif
constexpr int PH_L0 = 1, PH_L1 = 18, PH_MOE = 32, PH_TOTAL = PH_MOE + 2 + 2 * MOE_PASSES + 1;

__global__ void __launch_bounds__(NTHREADS, 2) hybrid_fwd(Args args) {
    extern __shared__ __attribute__((aligned(16))) unsigned char lds_raw[];
    Ctx C; C.in = args.in; C.out = args.out; C.ws = args.ws; C.lds = (LAS unsigned char*)lds_raw;
    C.tid = threadIdx.x; C.lane = C.tid & 63; C.wave = __builtin_amdgcn_readfirstlane(C.tid >> 6); C.G = gridDim.x; C.bid = blockIdx.x;
    const Ctx C0 = C;
    for (int u = C.tid; u < (LDS_BYTES - LDSCTL_OFF) / 4; u += NTHREADS) ((LAS unsigned*)(C.lds + LDSCTL_OFF))[u] = 0u;
    __syncthreads();
    const int lo = args.ph_lo, hi = args.ph_hi;
    XcdBarrier bar; bar.bar = (unsigned*)(C.ws + WS_CTL) + CW_BAR; bar.x = 0; bar.st = (volatile LAS unsigned*)(C.lds + LDSCTL_OFF);
    if (hi - lo > 1) bar = xcd_barrier_post((unsigned*)(C.ws + WS_CTL) + CW_BAR, (volatile LAS unsigned*)(C.lds + LDSCTL_OFF));
#ifndef SITE_MASK
#define SITE_MASK 0xffffffffu
#endif
#define SITE(n) (((SITE_MASK) >> (n)) & 1u)
#define IN(k) (lo <= (k) && (k) < hi)
#define ENDPH(k) do { if ((k) + 1 < hi) xcd_barrier(bar); } while (0)
#define SITE_BEGIN const Ctx C = launder(C0); unsigned char* LW = C.ws + W_BASE + (size_t)l * LW_SIZE; const bf16_t* XB = WSP(bf16_t, W_XB); float* XRES = WSP(float, W_XRES); (void)LW; (void)XB; (void)XRES; LAS unsigned char* ring = C.lds; (void)ring;

    if (SITE(0) && IN(0)) { const int l = 0; SITE_BEGIN ph_prologue(C);
#ifdef TIME_PRO2
        xcd_barrier(bar); ph_prologue(C);
#endif
#ifdef TIME_BAR
        for (int q_ = 0; q_ < TIME_BAR; ++q_) xcd_barrier(bar);
#endif
        ENDPH(0); }

    for (int l = 0; l < 2; ++l) {
        const int pb = l == 0 ? PH_L0 : PH_L1;
        if (SITE(1) && IN(pb + 0)) { SITE_BEGIN
#ifdef CHECKS3
            if (l == 1) chk_ln_cmp(C, 1, 1);
#endif
            { pg8::Gemm g{XB, (const bf16_t*)(LW + LW_WIN), 1024, 1024, 1024}; sch::Tiles S{T / 256, NPROJ / 256, C.G, C.bid}; epi::StoreBf16<0> E{WSP(bf16_t, S_PROJ), NPROJ}; pg8::gemm_phase(ring, g, S, E); }
            { pg8::Gemm g{(const bf16_t*)C.ws, (const bf16_t*)C.ws, 1024, 1024, 1024}; sch::MemKV S{(long)(W_MEMB / 2), (long)((W_BASE + (size_t)l * LW_SIZE + LW_WKV) / 2), C.bid};
              epi::StoreKV E{WSP(bf16_t, W_KMEM) + (size_t)l * NMEM * 1024, WSP(bf16_t, W_VMEMT) + (size_t)l * 1024 * NMEM}; pg8::gemm_phase(ring, g, S, E); }
            ENDPH(pb + 0);
        }
        if (SITE(2) && IN(pb + 1)) { SITE_BEGIN
#ifdef CHECKS5
            if (l == 0) chk_weights<28, false>(C, 0);
#endif
#ifdef CHECKS9
            if (l == 0) { unsigned bad = 0; const float* x = C.in[I_X]; const float* mm = C.in[I_MEM]; const bf16_t* mb = WSP(bf16_t, W_MEMB);
                for (size_t i = (size_t)C.bid * NTHREADS + C.tid; i < (size_t)T * 1024; i += (size_t)C.G * NTHREADS) if (!chk_close(x[i], bf2f(XB[i]))) bad = 1;
                for (size_t i = (size_t)C.bid * NTHREADS + C.tid; i < (size_t)NMEM * 1024; i += (size_t)C.G * NTHREADS) if (!chk_close(mm[i], bf2f(mb[i]))) bad = 1;
                if (bad) __hip_atomic_fetch_add((unsigned*)(C.ws + WS_CTL) + CW_CHK, 1u, RLX_AGENT); }
#endif
#ifdef CHECKS12P
            if (l == CHECKS_LAYER) { const bf16_t* proj = WSP(bf16_t, S_PROJ); chk_full_gemm(C, XB, (const bf16_t*)(LW + LW_WIN), 1024, 3236, 0, [&](size_t r, int c, float d) { return chk_close(d, bf2f(proj[r * NPROJ + c])); }); xcd_barrier(bar); }
#endif
#ifdef CHECKS4
            if (l == CHECKS_LAYER) { const bf16_t* KM_ = WSP(bf16_t, W_KMEM) + (size_t)l * NMEM * 1024; const bf16_t* VT_ = WSP(bf16_t, W_VMEMT) + (size_t)l * 1024 * NMEM;
                chk_gemm(C, WSP(bf16_t, W_MEMB), 1024, (const bf16_t*)(LW + LW_WKV), 1024, 1024, NMEM, 64, 16, 3, 0, [&](int r, int c, float d) { return chk_close(d, bf2f(KM_[(size_t)r * 1024 + c])); });
                chk_gemm(C, (const bf16_t*)(LW + LW_WKV) + (size_t)1024 * 1024, 1024, WSP(bf16_t, W_MEMB), 1024, 1024, 1024, 256, 16, 5, 1, [&](int r, int c, float d) { return chk_close(d, bf2f(VT_[(size_t)r * NMEM + c])); }); }
#endif
#ifdef CHECKS
            if (l == CHECKS_LAYER) { const bf16_t* proj = WSP(bf16_t, S_PROJ); chk_gemm(C, XB, 1024, (const bf16_t*)(LW + LW_WIN), 1024, 1024, T, 13, 256, 7, 0, [&](int r, int c, float d) { return chk_close(d, bf2f(proj[(size_t)r * NPROJ + c])); }); }
#endif
            ph_prep(C, l);
#ifdef TIME_PREP2
            xcd_barrier(bar); ph_prep(C, l);
#endif
            ENDPH(pb + 1); }
        if (SITE(3) && IN(pb + 2)) { SITE_BEGIN
            { pg8::Gemm g{WSP(bf16_t, S_LA), (const bf16_t*)(LW + LW_LORA), 256, 256, 256}; sch::Tiles S{T / 256, 3, C.G, C.bid}; epi::Lora E{WSP(float, S_DEC), WSP(bf16_t, S_AV), WSP(bf16_t, S_GV), C.in[I_RWW0] + l * 256, C.in[I_RWA0] + l * 256}; pg8::gemm_phase(ring, g, S, E); }
            { pg8::Gemm g{WSP(bf16_t, S_CQN), (const bf16_t*)(LW + LW_WUQ), 256, 256, 256}; sch::Tiles S{T / 256, 2, C.G, (C.bid + 128) & 255}; epi::Uq E{WSP(bf16_t, S_QM), WSP(float, W_COS), WSP(float, W_SIN)}; pg8::gemm_phase(ring, g, S, E); }
            { pg8::Gemm g{WSP(bf16_t, S_CKVN), (const bf16_t*)(LW + LW_WUKV), 128, 128, 128}; sch::Tiles S{T / 256, 2, C.G, C.bid}; epi::Ukv E{WSP(bf16_t, S_KM), WSP(bf16_t, S_VM)}; pg8::gemm_phase(ring, g, S, E); }
            ENDPH(pb + 2);
        }
        if (SITE(4) && IN(pb + 3)) { SITE_BEGIN ph_rwprep(C, l); ph_ssdprep(C, l);
#ifdef TIME_RWP2
            xcd_barrier(bar); ph_rwprep(C, l); ph_ssdprep(C, l);
#endif
            ENDPH(pb + 3); }
        if (SITE(5) && IN(pb + 4)) { SITE_BEGIN
#ifdef CHECKS6
            if (l == CHECKS_LAYER) chk_mla_inputs(C, l, 0);
#endif
#ifdef CHECKS7
            if (l == CHECKS_LAYER) chk_rw_inputs(C, l, 0);
#endif
            ph_mixers(C, l);
#ifdef TIME_MIX2
            xcd_barrier(bar); ph_mixers(C, l, 1);
#endif
            ENDPH(pb + 4); }
        if (SITE(6) && IN(pb + 5)) { SITE_BEGIN
            ph_ssdfix(C, l);
            { pg8::Gemm g{XB, (const bf16_t*)(LW + LW_WGATE), 1024, 1024, 1024}; sch::Tiles S{T / 256, 16, C.G, C.bid}; epi::StoreBf16<GATE_ACT> E{WSP(bf16_t, S_G), 4096}; pg8::gemm_phase<epi::StoreBf16<GATE_ACT>, sch::Tiles, GATE_ALIGN>(ring, g, S, E);
#ifdef TIME_GATE2
              xcd_barrier(bar); pg8::gemm_phase<epi::StoreBf16<GATE_ACT>, sch::Tiles, GATE_ALIGN>(ring, g, S, E);
#endif
            }
#ifdef CHECKS14
            if (l == 0) { xcd_barrier(bar); const bf16_t* Gp = WSP(bf16_t, S_G); chk_full_gemm(C, XB, (const bf16_t*)(LW + LW_WGATE), 1024, 4096, 0, [&](size_t r, int c, float d) { return chk_close(sigmoidf_(d), bf2f(Gp[r * 4096 + c])); }); }
#endif
#ifdef CHECKS13
            if (l == 0) { xcd_barrier(bar);
              { pg8::Gemm g{XB, (const bf16_t*)(LW + LW_WGATE), 1024, 1024, 1024}; sch::Tiles S{T / 256, 16, C.G, C.bid}; epi::StoreBf16<1> E{WSP(bf16_t, S_G) + (size_t)T * 4096, 4096}; pg8::gemm_phase(ring, g, S, E); }
              xcd_barrier(bar);
              { const unsigned short* g1 = WSP(unsigned short, S_G); const unsigned short* g2 = g1 + (size_t)T * 4096; unsigned cnt = 0;
                for (size_t i = (size_t)C.bid * NTHREADS + C.tid; i < (size_t)T * 4096; i += (size_t)C.G * NTHREADS) if (g1[i] != g2[i]) ++cnt;
                if (cnt) __hip_atomic_fetch_add((unsigned*)(C.ws + WS_CTL) + CW_CHK + 2048, cnt, RLX_AGENT); } }
#endif
            ENDPH(pb + 5);
        }
        if (SITE(7) && IN(pb + 6)) { SITE_BEGIN
#ifdef FIX_G
            { bf16_t* Gw = WSP(bf16_t, S_G); const bf16_t* Wg = (const bf16_t*)(LW + LW_WGATE);
              for (size_t i = (size_t)C.bid * NTHREADS + C.tid; i < (size_t)T * 4096; i += (size_t)C.G * NTHREADS) { const size_t r = i >> 12; const int c = (int)(i & 4095);
                  Gw[i] = (bf16_t)(cvt_pk_bf16(sigmoidf_(tdot(XB + r * 1024, Wg + (size_t)c * 1024, 1024)), 0.f) & 0xffffu); }
              xcd_barrier(bar); }
#endif
#ifdef CHECKS15
            if (l == 0) { unsigned cnt = 0; const float* x = C.in[I_X];
                for (size_t i = (size_t)C.bid * NTHREADS + C.tid; i < (size_t)T * 1024; i += (size_t)C.G * NTHREADS) if (!chk_close(x[i], bf2f(XB[i]))) ++cnt;
                if (cnt) __hip_atomic_fetch_add((unsigned*)(C.ws + WS_CTL) + CW_CHK + 2048, cnt, RLX_AGENT); }
#endif
#ifdef CHECKS7
            if (l == CHECKS_LAYER) chk_ssd_norm(C, l, 1);
#endif
#ifdef CHECKS12
            if (l == CHECKS_LAYER) { const bf16_t* Gp = WSP(bf16_t, S_G); chk_full_gemm(C, XB, (const bf16_t*)(LW + LW_WGATE), 1024, 4096, FG_BIT, [&](size_t r, int c, float d) { return fabsf((GATE_ACT ? sigmoidf_(d) : d) - bf2f(Gp[r * 4096 + c])) <= FG_TOL; }); xcd_barrier(bar); }
#endif
#ifdef CHECKS
            if (l == CHECKS_LAYER) { const bf16_t* Gp = WSP(bf16_t, S_G); chk_gemm(C, XB, 1024, (const bf16_t*)(LW + LW_WGATE), 1024, 1024, T, 16, 256, 5, 1, [&](int r, int c, float d) { return chk_close(sigmoidf_(d), bf2f(Gp[(size_t)r * 4096 + c])); }); }
#endif
            { pg8::Gemm g{WSP(bf16_t, S_Y), (const bf16_t*)(LW + LW_WBR), 256, 1024, 256}; sch::BrTiles S{T / 256, 4, C.G, C.bid}; epi::BrGate E{WSP(bf16_t, S_G), WSP(float, S_MF), WSP(bf16_t, S_MB)}; pg8::gemm_phase(ring, g, S, E);
#ifdef TIME_BR2
              xcd_barrier(bar); pg8::gemm_phase(ring, g, S, E);
#endif
            }
            ENDPH(pb + 6);
        }
        if (SITE(8) && IN(pb + 7)) { SITE_BEGIN
#ifdef CHECKS2
            if (l == CHECKS_LAYER) chk_merged(C, l, 0);
#endif
            { pg8::Gemm g{WSP(bf16_t, S_MB), (const bf16_t*)(LW + LW_WOUT), 1024, 1024, 1024}; sch::Tiles S{T / 256, 4, C.G, C.bid}; epi::Resid E{C.in[I_X], XRES, ABL_MIX, l == 0 ? nullptr : XB}; pg8::gemm_phase(ring, g, S, E); }
            ENDPH(pb + 7);
        }
        if (SITE(9) && IN(pb + 8)) { SITE_BEGIN
#ifdef CHECKS10
            if (l == 0) { chk_full_p7(C, l, 1); xcd_barrier(bar); }
#endif
#ifdef CHECKS
            if (l == 0) { const float* xin = C.in[I_X]; chk_gemm(C, WSP(bf16_t, S_MB), 1024, (const bf16_t*)(LW + LW_WOUT), 1024, 1024, T, 4, 256, 9, 2, [&](int r, int c, float d) { return fabsf(xin[(size_t)r * 1024 + c] * DN_ALPHA + d - XRES[(size_t)r * 1024 + c]) <= CHK_TOL2; }); }
#endif
            ph_ln<false>(C, XRES, nullptr, WSP(bf16_t, W_XB), C.in[I_LN1G] + l * 1024, C.in[I_LN1B] + l * 1024, nullptr);
#ifdef TIME_LN2
            xcd_barrier(bar); ph_ln<false>(C, XRES, nullptr, WSP(bf16_t, W_XB), C.in[I_LN1G] + l * 1024, C.in[I_LN1B] + l * 1024, nullptr);
#endif
            ENDPH(pb + 8); }
        if (SITE(10) && IN(pb + 9)) { SITE_BEGIN
            { pg8::Gemm g{XB, (const bf16_t*)(LW + LW_WQ), 1024, 1024, 1024}; sch::Tiles S{T / 256, 4, C.G, C.bid}; epi::StoreBf16<0> E{WSP(bf16_t, S_XQ), 1024}; pg8::gemm_phase(ring, g, S, E); }
            ENDPH(pb + 9);
        }
        if (SITE(11) && IN(pb + 10)) { SITE_BEGIN
#ifdef CHECKS
            if (l == CHECKS_LAYER) { const bf16_t* XQ = WSP(bf16_t, S_XQ); chk_gemm(C, XB, 1024, (const bf16_t*)(LW + LW_WQ), 1024, 1024, T, 4, 256, 11, 3, [&](int r, int c, float d) { return chk_close(d, bf2f(XQ[(size_t)r * 1024 + c])); }); }
#endif
            { pg8::Gemm g{WSP(bf16_t, S_XQ), WSP(bf16_t, W_KMEM) + (size_t)l * NMEM * 1024, 256, 1024, 1024}; sch::XaS S{C.G, C.bid}; epi::Softmax E{WSP(bf16_t, S_XP), (LAS float*)(C.lds + XCH_OFF)};
#ifndef NAIVE_XA
              pg8::gemm_phase(ring, g, S, E);
#else
              (void)g; (void)S; (void)E; xattn_naive(C, l);
#endif
            }
            ENDPH(pb + 10);
        }
        if (SITE(12) && IN(pb + 11)) { SITE_BEGIN
            { pg8::Gemm g{WSP(bf16_t, S_XP), WSP(bf16_t, W_VMEMT) + (size_t)l * 1024 * NMEM, 256, 1024, NMEM}; sch::XaPV S{C.G, C.bid}; epi::StoreBf16<0> E{WSP(bf16_t, S_XO), 1024};
#ifndef NAIVE_XA
              pg8::gemm_phase(ring, g, S, E);
#else
              (void)g; (void)S; (void)E;
#endif
            }
            ENDPH(pb + 11);
        }
        if (SITE(13) && IN(pb + 12)) { SITE_BEGIN
#ifdef CHECKS3
            if (l == 0) { chk_resid_stash(C, WSP(bf16_t, S_XO), 1024, (const bf16_t*)(LW + LW_WO), 1024, 1024, 0); xcd_barrier(bar); }
#endif
            { pg8::Gemm g{WSP(bf16_t, S_XO), (const bf16_t*)(LW + LW_WO), 1024, 1024, 1024}; sch::Tiles S{T / 256, 4, C.G, C.bid}; epi::Resid E{nullptr, XRES, ABL_XA, XB}; pg8::gemm_phase(ring, g, S, E); }
            ENDPH(pb + 12);
        }
        if (SITE(14) && IN(pb + 13)) { SITE_BEGIN
#ifdef CHECKS3
            if (l == 0) chk_resid_cmp(C, 0, 2);
#endif
            ph_ln<false>(C, XRES, l == 1 ? XRES : nullptr, WSP(bf16_t, W_XB), C.in[I_LN2G] + l * 1024, C.in[I_LN2B] + l * 1024, nullptr); ENDPH(pb + 13); }
        if (l == 0) {
            if (SITE(15) && IN(pb + 14)) { SITE_BEGIN
                { pg8::Gemm g{XB, WSP(bf16_t, W_FFN13), 1024, 1024, 1024}; sch::Tiles S{T / 256, 2 * FFD / 256, C.G, C.bid}; epi::Swiglu E{WSP(bf16_t, S_H), FFD, 0}; pg8::gemm_phase(ring, g, S, E);
#ifdef TIME_UP2
                  for (int rep_ = 0; rep_ < 1; ++rep_) { xcd_barrier(bar); pg8::gemm_phase(ring, g, S, E); }
#endif
                }
                ENDPH(pb + 14);
            }
            if (SITE(16) && IN(pb + 15)) { SITE_BEGIN
#ifdef CHECKS2
                chk_swiglu(C, 1);
#endif
#ifdef CHECKS3
                chk_resid_stash(C, WSP(bf16_t, S_H), FFD, WSP(bf16_t, W_FFN2), FFD, FFD, 0); xcd_barrier(bar);
#endif
                { pg8::Gemm g{WSP(bf16_t, S_H), WSP(bf16_t, W_FFN2), FFD, FFD, FFD}; sch::Tiles S{T / 256, 4, C.G, C.bid}; epi::Resid E{nullptr, XRES, ABL_FF, XB}; pg8::gemm_phase(ring, g, S, E); }
                ENDPH(pb + 15);
            }
            if (SITE(17) && IN(pb + 16)) { SITE_BEGIN
#ifdef CHECKS3
                chk_resid_cmp(C, 0, 0); chk_ln_stash(C, C.in[I_LN3G], C.in[I_LN3B], 1); xcd_barrier(bar);
#endif
                ph_ln<false>(C, XRES, nullptr, WSP(bf16_t, W_XB), C.in[I_LN3G], C.in[I_LN3B], nullptr); ENDPH(pb + 16); }
        } else {
            if (SITE(18) && IN(PH_MOE)) { SITE_BEGIN ph_router(C); ENDPH(PH_MOE); }
            if (SITE(19) && IN(PH_MOE + 1)) { SITE_BEGIN
#ifdef CHECKS5
                chk_weights<16, true>(C, 1);
#endif
                ph_scatter(C); ENDPH(PH_MOE + 1); }
            for (int p = 0; p < MOE_PASSES; ++p) {
                const int* blk_e = WSP(int, S_BLKE);
                if (SITE(20) && IN(PH_MOE + 2 + 2 * p)) { SITE_BEGIN
                    const int used = __builtin_amdgcn_readfirstlane(__hip_atomic_load(blk_e + MOE_BLOCKS, RLX_AGENT)); const int b0 = p * MOE_PASS_BLOCKS, b1 = min(b0 + MOE_PASS_BLOCKS, used);
                    if (b1 > b0) { pg8::Gemm g{WSP(bf16_t, S_XS), WSP(bf16_t, S_MW13), 1024, 1024, 1024}; sch::MoeUp S{blk_e, b0, b1, C.G, C.bid}; epi::Swiglu E{WSP(bf16_t, S_MH), FFE, 1}; pg8::gemm_phase(ring, g, S, E); }
                    ENDPH(PH_MOE + 2 + 2 * p);
                }
                if (SITE(21) && IN(PH_MOE + 3 + 2 * p)) { SITE_BEGIN
                    const int used = __builtin_amdgcn_readfirstlane(__hip_atomic_load(blk_e + MOE_BLOCKS, RLX_AGENT)); const int b0 = p * MOE_PASS_BLOCKS, b1 = min(b0 + MOE_PASS_BLOCKS, used);
                    if (b1 > b0) { pg8::Gemm g{WSP(bf16_t, S_MH), WSP(bf16_t, S_MW2), FFE, FFE, FFE}; sch::MoeDown S{blk_e, b0, b1, C.G, C.bid}; epi::MoeDown E{WSP(int, S_ROWSLOT), WSP(float, S_ROWW), WSP(bf16_t, S_YS)}; pg8::gemm_phase(ring, g, S, E); }
                    ENDPH(PH_MOE + 3 + 2 * p);
                }
            }
            if (SITE(22) && IN(PH_TOTAL - 1)) { SITE_BEGIN
#ifdef CHECKS8
                chk_moe(C, 0); xcd_barrier(bar);
#endif
#define FINAL_LN_SITE 1
 ph_ln<true>(C, XRES, C.out, nullptr, C.in[I_LN3G] + 1024, C.in[I_LN3B] + 1024, WSP(bf16_t, S_YS));
#ifdef CHECKS11
                xcd_barrier(bar);
                { unsigned cnt = 0; for (size_t i = (size_t)C.bid * NTHREADS + C.tid; i < (size_t)T * 1024; i += (size_t)C.G * NTHREADS) if (fabsf(C.out[i]) > CHK11_THR) ++cnt;
                  if (cnt) __hip_atomic_fetch_add((unsigned*)(C.ws + WS_CTL) + CW_CHK + 2048, cnt, RLX_AGENT); }
                xcd_barrier(bar);
                { unsigned v_ = __hip_atomic_load((const unsigned*)(C.ws + WS_CTL) + CW_CHK + 2048, RLX_AGENT); int n = 0; while (v_ > 0u) { ++n; v_ >>= 1; }
                  const float sc = 1.0f + 0.1f * (float)n; for (size_t i = (size_t)C.bid * NTHREADS + C.tid; i < (size_t)T * 1024; i += (size_t)C.G * NTHREADS) C.out[i] *= sc; }
#endif
#ifdef CHECKS8
                xcd_barrier(bar);
                { const float* stash = WSP(float, W_KMEM); unsigned bad = 0; const float cs = 1.0f; (void)cs;
                  for (int s = GW; s < 1024; s += NGW) { const int t = (int)(((long)s * 1021 + 7) % T); if (stash[(size_t)s * 1024] > 1.0e29f) continue;
                      for (int j = 0; j < 16; ++j) { const int c = C.lane + 64 * j; const float e = stash[(size_t)s * 1024 + c], gt = C.out[(size_t)t * 1024 + c]; if (fabsf(e - gt) > 0.05f * fabsf(e) + 0.05f) bad = 1; } }
                  chk_flag(C, 1, bad); }
                xcd_barrier(bar);
                { const unsigned* cw = (const unsigned*)(C.ws + WS_CTL) + CW_CHK; if (__hip_atomic_load(cw + 64, RLX_AGENT) != 0u) { for (size_t i = (size_t)C.bid * NTHREADS + C.tid; i < (size_t)T * 1024; i += (size_t)C.G * NTHREADS) C.out[i] *= 1.5f; } }
#endif
            }
        }
    }
#undef IN
#undef ENDPH
}

extern "C" void kernel_launch(void* const* d_in, const int* in_sizes, int n_in, void* d_out, int out_size, void* d_ws, size_t ws_size, hipStream_t stream) {
    static int grid = 0;
    if (grid == 0) {
        if (n_in != 42 || in_sizes[0] != T * DM || out_size != T * DM || ws_size < WS_NEED) { fprintf(stderr, "kernel_launch: unexpected problem (n_in %d, in0 %d, out %d, ws %zu < %zu)\n", n_in, n_in > 0 ? in_sizes[0] : -1, out_size, ws_size, (size_t)WS_NEED); grid = -1; return; }
        int dev = 0, cus = 0;
        if (hipGetDevice(&dev) != hipSuccess || hipDeviceGetAttribute(&cus, hipDeviceAttributeMultiprocessorCount, dev) != hipSuccess) { grid = -1; return; }
        if (hipFuncSetAttribute((const void*)hybrid_fwd, hipFuncAttributeMaxDynamicSharedMemorySize, LDS_BYTES) != hipSuccess) { fprintf(stderr, "kernel_launch: hipFuncSetAttribute failed\n"); grid = -1; return; }
        int per_cu = 0;
        if (hipOccupancyMaxActiveBlocksPerMultiprocessor(&per_cu, (const void*)hybrid_fwd, NTHREADS, LDS_BYTES) != hipSuccess || per_cu < 1) fprintf(stderr, "kernel_launch: occupancy query says %d\n", per_cu);
        (void)hipGetLastError();
        if (cus != 256) { fprintf(stderr, "kernel_launch: built for 256 CUs, device has %d\n", cus); grid = -1; return; }
        grid = 256;
    }
    if (grid < 0) return;
#ifdef ZERO_WS
    (void)hipMemsetAsync((char*)d_ws + ZERO_WS_LO, 0, ZERO_WS_HI - ZERO_WS_LO, stream);
#endif
    (void)hipMemsetAsync((char*)d_ws + WS_CTL, 0, CTL_BYTES, stream);
    Args a{};
    for (int i = 0; i < 42; ++i) a.in[i] = (const float*)d_in[i];
    a.out = (float*)d_out; a.ws = (unsigned char*)d_ws;
#if MK_SPLIT
    for (int p = 0; p < PH_TOTAL; ++p) { a.ph_lo = p; a.ph_hi = p + 1; hipLaunchKernelGGL(hybrid_fwd, dim3(grid), dim3(NTHREADS), LDS_BYTES, stream, a); }
#else
    a.ph_lo = 0; a.ph_hi = PH_TOTAL; hipLaunchKernelGGL(hybrid_fwd, dim3(grid), dim3(NTHREADS), LDS_BYTES, stream, a);
#endif
}
```

```cpp
#include <hip/hip_runtime.h>
#include <cstdio>
#include <cstdint>

#define GAS __attribute__((address_space(1)))
#define LAS __attribute__((address_space(3)))
typedef unsigned short bf16_t;
typedef short bf16x8 __attribute__((ext_vector_type(8)));
typedef short bf16x4 __attribute__((ext_vector_type(4)));
typedef float f32x2 __attribute__((ext_vector_type(2)));
typedef float f32x4 __attribute__((ext_vector_type(4)));
typedef float f32x16 __attribute__((ext_vector_type(16)));
typedef unsigned u32x4 __attribute__((ext_vector_type(4)));
typedef unsigned u32x2 __attribute__((ext_vector_type(2)));
#define RLX_AGENT __ATOMIC_RELAXED, __HIP_MEMORY_SCOPE_AGENT

constexpr int NB = 16, SEQ = 2048, DM = 1024, T = NB * SEQ;
constexpr int NPROJ = 3328;
constexpr int PC_SBQ = 0, PC_SBK = 256, PC_SBV = 512, PC_RW = 768, PC_Z = 1792, PC_XS = 2048, PC_BM = 2304, PC_CM = 2560, PC_CQ = 2816, PC_CKV = 3072, PC_KR = 3200, PC_DT = 3232;
constexpr int MEMT = 256, NMEM = NB * MEMT;
constexpr int FFD = 2816, FFE = 3584, NEXP = 8;
constexpr int MOE_ROWS = 2 * T + NEXP * 256;
constexpr int MOE_BLOCKS = MOE_ROWS / 256;
constexpr int MOE_PASS_BLOCKS = 64, MOE_PASSES = 5;
constexpr float DN_ALPHA = 1.4142135623730951f;
constexpr float LOG2E = 1.4426950408889634f;

constexpr size_t MiB = 1u << 20;
constexpr size_t WS_CTL = 0, CTL_BYTES = 1 * MiB;
constexpr int CW_BAR = 1024;
constexpr int CW_QUEUE = 8192;
constexpr int CW_MOECNT = 16384;
constexpr size_t W_BASE = CTL_BYTES;
constexpr size_t LW_WIN = 0;
constexpr size_t LW_WGATE = LW_WIN + (size_t)NPROJ * 1024 * 2;
constexpr size_t LW_WBR = LW_WGATE + (size_t)4096 * 1024 * 2;
constexpr size_t LW_WOUT = LW_WBR + (size_t)4 * 1024 * 256 * 2;
constexpr size_t LW_LORA = LW_WOUT + (size_t)1024 * 1024 * 2;
constexpr size_t LW_WUQ = LW_LORA + (size_t)768 * 256 * 2;
constexpr size_t LW_WUKV = LW_WUQ + (size_t)512 * 256 * 2;
constexpr size_t LW_WQ = LW_WUKV + (size_t)512 * 128 * 2;
constexpr size_t LW_WKV = LW_WQ + (size_t)1024 * 1024 * 2;
constexpr size_t LW_WO = LW_WKV + (size_t)2048 * 1024 * 2;
constexpr size_t LW_SIZE = LW_WO + (size_t)1024 * 1024 * 2;
constexpr size_t W_FFN13 = W_BASE + 2 * LW_SIZE;
constexpr size_t W_FFN2 = W_FFN13 + (size_t)2 * FFD * 1024 * 2;
constexpr size_t W_KMEM = W_FFN2 + (size_t)1024 * FFD * 2;
constexpr size_t W_VMEMT = W_KMEM + (size_t)2 * NMEM * 1024 * 2;
constexpr size_t W_MEMB = W_VMEMT + (size_t)2 * 1024 * NMEM * 2;
constexpr size_t W_COS = W_MEMB + (size_t)NMEM * 1024 * 2;
constexpr size_t W_SIN = W_COS + (size_t)T * 16 * 4;
constexpr size_t W_XB = W_SIN + (size_t)T * 16 * 4;
constexpr size_t W_XRES = W_XB + (size_t)T * 1024 * 2;
constexpr size_t S_BASE = W_XRES + (size_t)T * 1024 * 4;
constexpr size_t S_Y = S_BASE;
constexpr size_t S_SSQ = S_Y + (size_t)T * 1024 * 2;
constexpr size_t S_PROJ = S_SSQ + (size_t)T * 8 * 4;
constexpr size_t S_LA = S_PROJ + (size_t)T * NPROJ * 2;
constexpr size_t S_CQN = S_LA + (size_t)T * 256 * 2;
constexpr size_t S_CKVN = S_CQN + (size_t)T * 256 * 2;
constexpr size_t S_DEC = S_CKVN + (size_t)T * 128 * 2;
constexpr size_t S_AV = S_DEC + (size_t)T * 256 * 4;
constexpr size_t S_GV = S_AV + (size_t)T * 256 * 2;
constexpr size_t S_QM = S_GV + (size_t)T * 256 * 2;
constexpr size_t S_KM = S_QM + (size_t)T * 384 * 2;
constexpr size_t S_VM = S_KM + (size_t)T * 384 * 2;
constexpr size_t S_RWS = S_VM + (size_t)T * 256 * 2;
constexpr size_t S_XA = S_RWS + (size_t)5 * T * 256 * 2;
constexpr size_t S_BC = S_XA + (size_t)T * 256 * 2;
constexpr size_t S_CC = S_BC + (size_t)T * 256 * 2;
constexpr size_t S_ACS = S_CC + (size_t)T * 256 * 2;
constexpr size_t S_DTV = S_ACS + (size_t)T * 4 * 4;
constexpr size_t S_YRAW = S_DTV + (size_t)T * 4 * 4;
constexpr size_t S_MIX_END = S_YRAW + (size_t)T * 256 * 2;
constexpr size_t S_G = S_PROJ;
constexpr size_t S_MF = S_G + (size_t)T * 4096 * 2;
constexpr size_t S_MB = S_MF + (size_t)T * 1024 * 4;
constexpr size_t S_GATE_END = S_MB + (size_t)T * 1024 * 2;
constexpr size_t S_XQ = S_BASE;
constexpr size_t S_XP = S_XQ + (size_t)T * 1024 * 2;
constexpr size_t S_XO = S_XP + (size_t)T * 1024 * 2;
constexpr size_t S_H = S_BASE;
constexpr size_t S_MW13 = S_BASE;
constexpr size_t S_MW2 = S_MW13 + (size_t)NEXP * 2 * FFE * 1024 * 2;
constexpr size_t S_XS = S_MW2 + (size_t)NEXP * 1024 * FFE * 2;
constexpr size_t S_YS = S_XS + (size_t)MOE_ROWS * 1024 * 2;
constexpr size_t S_MH = S_YS + (size_t)2 * T * 1024 * 2;
constexpr size_t S_TOPI = S_MH + (size_t)MOE_PASS_BLOCKS * 256 * FFE * 2;
constexpr size_t S_TOPW = S_TOPI + (size_t)T * 2 * 4;
constexpr size_t S_ROWSLOT = S_TOPW + (size_t)T * 2 * 4;
constexpr size_t S_ROWW = S_ROWSLOT + (size_t)MOE_ROWS * 4;
constexpr size_t S_BLKE = S_ROWW + (size_t)MOE_ROWS * 4;
constexpr size_t S_MOE_END = S_BLKE + 4096;
constexpr size_t cmax(size_t a, size_t b) { return a > b ? a : b; }
constexpr size_t WS_NEED = cmax(cmax(S_MIX_END, S_GATE_END), S_MOE_END);
static_assert(WS_NEED <= (size_t)896 * MiB, "workspace map exceeds 896 MiB");
static_assert((W_BASE % 256) == 0 && (LW_SIZE % 256) == 0 && (S_BASE % 256) == 0, "alignment");

constexpr int RING_BYTES = 131072;
constexpr int XCH_OFF = RING_BYTES;
constexpr int LDSCTL_OFF = RING_BYTES + 16384;
constexpr int LDS_BYTES = LDSCTL_OFF + 512;
constexpr int NWAVES = 8, NTHREADS = 512;

typedef __bf16 bf16x2_t __attribute__((ext_vector_type(2)));
__device__ __forceinline__ unsigned cvt_pk_bf16(float lo, float hi) { bf16x2_t v = {(__bf16)lo, (__bf16)hi}; return __builtin_bit_cast(unsigned, v); }
__device__ __forceinline__ float bf2f(unsigned short b) { return __uint_as_float((unsigned)b << 16); }
__device__ __forceinline__ float bflo(unsigned w) { return __uint_as_float(w << 16); }
__device__ __forceinline__ float bfhi(unsigned w) { return __uint_as_float(w & 0xffff0000u); }
__device__ __forceinline__ float fexp2(float x) { return __builtin_amdgcn_exp2f(x); }
__device__ __forceinline__ float flog2(float x) { return __builtin_amdgcn_logf(x); }
__device__ __forceinline__ float frcp(float x) { return __builtin_amdgcn_rcpf(x); }
__device__ __forceinline__ float sigmoidf_(float x) { return frcp(1.0f + fexp2(-x * LOG2E)); }
__device__ __forceinline__ float siluf_(float x) { return x * sigmoidf_(x); }
__device__ __forceinline__ float softplusf_(float x) { return fmaxf(x, 0.f) + 0.6931471805599453f * flog2(1.0f + fexp2(-fabsf(x) * LOG2E)); }
#define DPPADD_(v, ctrl, rmask) (v) += __builtin_bit_cast(float, __builtin_amdgcn_update_dpp(0, __builtin_bit_cast(int, (v)), (ctrl), (rmask), 0xf, false))
__device__ __forceinline__ float row_sum16(float v) {
    DPPADD_(v, 0xB1, 0xf); DPPADD_(v, 0x4E, 0xf); DPPADD_(v, 0x141, 0xf); DPPADD_(v, 0x140, 0xf); return v; }
__device__ __forceinline__ float wave_sum(float v) {
    v = row_sum16(v); DPPADD_(v, 0x142, 0xa); DPPADD_(v, 0x143, 0xc);
    return __builtin_bit_cast(float, __builtin_amdgcn_readlane(__builtin_bit_cast(int, v), 63)); }
#define LDS_WAIT() asm volatile("s_waitcnt lgkmcnt(0)" ::: "memory")
#define VM_WAIT() asm volatile("s_waitcnt vmcnt(0)" ::: "memory")
#define XB_TMO      128
#define XB_XCNT(j)  (256  + 64 * (j))
#define XB_XSUB(j)  (1280 + 64 * (j))
#define XB_XGEN(j)  (2304 + 64 * (j))
#define XB_TOP      3328
#define XB_TOPGEN   3392
#define XCD_BAR_WORDS 3456
#define XB_SPIN_CAP (1u << 18)

__device__ __forceinline__ unsigned xb_ld(unsigned* p)              { return __hip_atomic_load(p, __ATOMIC_RELAXED, __HIP_MEMORY_SCOPE_AGENT); }
__device__ __forceinline__ unsigned xb_add(unsigned* p, unsigned v) { return __hip_atomic_fetch_add(p, v, __ATOMIC_RELAXED, __HIP_MEMORY_SCOPE_AGENT); }
__device__ __forceinline__ unsigned xb_xcc_id() { return (unsigned)__builtin_amdgcn_s_getreg((3 << 11) | 20) & 0xFu; }
#define XB_SPIN(cond, bar) do { unsigned _sp = 0; while (cond) { __builtin_amdgcn_s_sleep(1); \
    if ((++_sp & 255u) == 0u) { if (xb_ld(&(bar)[XB_TMO])) break; if (_sp > XB_SPIN_CAP) { atomicAdd(&(bar)[XB_TMO], 1u); break; } } } } while (0)

struct XcdBarrier { unsigned* bar; unsigned x; volatile LAS unsigned* st; };

__device__ __forceinline__ XcdBarrier xcd_barrier_post(unsigned* bar, volatile LAS unsigned* st) {
    XcdBarrier b; b.bar = bar; b.x = xb_xcc_id(); b.st = st;
    if (threadIdx.x == 0) (void)xb_add(&bar[XB_XCNT(b.x)], 1u);
    return b;
}
__device__ __forceinline__ void xcd_barrier_complete(unsigned* bar, unsigned x, unsigned& nloc, unsigned& nx) {
    const unsigned G = gridDim.x * gridDim.y * gridDim.z;
    unsigned sum, cnt, mine, sp = 0u;
    for (;;) {
        sum = 0u; cnt = 0u; mine = 0u;
#pragma unroll
        for (unsigned j = 0; j < 16; ++j) { const unsigned c = xb_ld(&bar[XB_XCNT(j)]); sum += c; cnt += (c > 0u) ? 1u : 0u; mine = (j == x) ? c : mine; }
        if (sum == G) break;
        __builtin_amdgcn_s_sleep(1);
        if ((++sp & 255u) == 0u) { if (xb_ld(&bar[XB_TMO])) break; if (sp > XB_SPIN_CAP) { atomicAdd(&bar[XB_TMO], 1u); break; } }
    }
    nloc = mine > 0u ? mine : 1u; nx = cnt > 0u ? cnt : 1u;
}
__device__ __forceinline__ void xcd_barrier(const XcdBarrier& b) {
    asm volatile("s_waitcnt vmcnt(0)" ::: "memory");
    __syncthreads();
    if (threadIdx.x == 0) {
        unsigned* bar = b.bar;
        __builtin_amdgcn_s_waitcnt(0);
        unsigned nloc = b.st[0], nx = b.st[1];
        if (nloc == 0u) { xcd_barrier_complete(bar, b.x, nloc, nx); b.st[0] = nloc; b.st[1] = nx; }
        const unsigned old = xb_add(&bar[XB_XSUB(b.x)], 1u);
        const unsigned gen = old / nloc;
        if (old + 1u == (gen + 1u) * nloc) {
            __builtin_amdgcn_fence(__ATOMIC_RELEASE, "agent");
            asm volatile("s_waitcnt vmcnt(0)" ::: "memory");
            const unsigned og = xb_add(&bar[XB_TOP], 1u);
            const unsigned tg = og / nx;
            if (og + 1u == (tg + 1u) * nx) xb_add(&bar[XB_TOPGEN], 1u);
            else XB_SPIN(xb_ld(&bar[XB_TOPGEN]) == tg, bar);
            __builtin_amdgcn_fence(__ATOMIC_ACQUIRE, "agent");
            xb_add(&bar[XB_XGEN(b.x)], 1u);
            asm volatile("s_waitcnt vmcnt(0)" ::: "memory");
        } else {
            XB_SPIN(xb_ld(&bar[XB_XGEN(b.x)]) == gen, bar);
            __builtin_amdgcn_fence(__ATOMIC_ACQUIRE, "agent");
            asm volatile("s_waitcnt vmcnt(0)" ::: "memory");
        }
    }
    __syncthreads();
}

namespace pg8 {
constexpr int BM = 256, BK = 64, HALF = 128, HTB = HALF * BK * 2, STAGE_BYTES = 8 * HTB;
__host__ __device__ __forceinline__ int lds_byte(int r, int c) { const int st = (r >> 4) * 2 + (c >> 5), rr = r & 15, cc = c & 31, ob = rr * 64 + cc * 2; return st * 1024 + (ob ^ (((ob >> 9) & 1) << 5)); }
__host__ __device__ __forceinline__ void stage_rc(int b, int& R, int& C) { const int st = b / 1024, sb = b % 1024, swz = sb ^ (((sb >> 9) & 1) << 5); R = (st >> 1) * 16 + swz / 64; C = (st & 1) * 32 + (swz % 64) / 2; }
__host__ __device__ __forceinline__ int perm32(int rho) { const int n = rho >> 4, i = rho & 15; return 8 * (i >> 2) + 4 * n + (i & 3); }

struct Unit { int pm, pn; long aoff, boff; int tag; };
struct Gemm { const bf16_t* A; const bf16_t* Bt; int K, lda, ldb; };

template <class Epi, class Sched, bool ALIGN = true>
__device__ __forceinline__ void gemm_phase(LAS unsigned char* lds, const Gemm g, const Sched& S, const Epi& E) {
    int tid_ = threadIdx.x; asm volatile("" : "+v"(tid_));
    const int tid = tid_, wid = __builtin_amdgcn_readfirstlane(tid >> 6), lane = tid & 63, wr = wid >> 2, wc = wid & 3, fr = lane & 15, fq = lane >> 4;
    int K = g.K; asm volatile("" : "+s"(K)); const int nt = K / BK;
    unsigned voffA[2], voffB[2];
#pragma unroll
    for (int i = 0; i < 2; ++i) { int R, C; stage_rc(tid * 16 + i * 8192, R, C); const int Rb = Epi::PERM ? ((R & ~31) + perm32(R & 31)) : R;
        voffA[i] = (unsigned)(R * g.lda + C) * 2u; voffB[i] = (unsigned)(Rb * g.ldb + C) * 2u; }
    const size_t kstep = (size_t)(BK * 2);
    const size_t hstepA = (size_t)HALF * g.lda * 2, hstepB = (size_t)HALF * g.ldb * 2;
    const size_t tstepA = 2 * hstepA, tstepB = 2 * hstepB;
    const unsigned ldsw = (unsigned)wid * 1024u;
    const int aoff = lds_byte(wr * 64 + fr, fq * 8), boff = lds_byte(wc * 32 + fr, fq * 8);
#define PG8_SA(b, h) (((b) * 2 + (h)) * HTB)
#define PG8_SB(b, h) ((4 + (b) * 2 + (h)) * HTB)
#define PG8_STAGE(bufoff, gbase, voff) do { _Pragma("unroll") for (int _i = 0; _i < 2; ++_i) \
        __builtin_amdgcn_global_load_lds((const unsigned*)((const char*)(gbase) + (voff)[_i]), (LAS unsigned*)(lds + (bufoff) + ldsw + _i * 8192), 16, 0, 0); } while (0)
#define PG8_LDA(dst, b, h) do { _Pragma("unroll") for (int m = 0; m < 4; ++m) _Pragma("unroll") for (int k = 0; k < 2; ++k) dst[m][k] = *(const LAS bf16x8*)(lds + PG8_SA(b, h) + aoff + m * 2048 + k * 1024); } while (0)
#define PG8_LDB(dst, b, h) do { _Pragma("unroll") for (int n = 0; n < 2; ++n) _Pragma("unroll") for (int k = 0; k < 2; ++k) dst[n][k] = *(const LAS bf16x8*)(lds + PG8_SB(b, h) + boff + n * 2048 + k * 1024); } while (0)
#define PG8_MMA(ai, bj, At, Bt) do { __builtin_amdgcn_s_setprio(1); _Pragma("unroll") for (int m = 0; m < 4; ++m) _Pragma("unroll") for (int n = 0; n < 2; ++n) _Pragma("unroll") for (int k = 0; k < 2; ++k) \
        acc[ai][bj][m][n] = __builtin_amdgcn_mfma_f32_16x16x32_bf16(Bt[n][k], At[m][k], acc[ai][bj][m][n], 0, 0, 0); __builtin_amdgcn_s_setprio(0); } while (0)
#define PG8_WAIT_V(n) asm volatile("s_waitcnt vmcnt(" #n ")" ::: "memory")
#define PG8_WAIT_L(n) asm volatile("s_waitcnt lgkmcnt(" #n ")" ::: "memory")
#define PG8_BAR __builtin_amdgcn_s_barrier()
#define PG8_SCHED __builtin_amdgcn_sched_barrier(0)
    Unit cur, nxt; int ui = 0;
    if (!S.next(0, cur)) return;
    f32x4 acc[2][2][4][2];
#pragma unroll
    for (int a = 0; a < 2; ++a)
#pragma unroll
        for (int b = 0; b < 2; ++b)
#pragma unroll
            for (int m = 0; m < 4; ++m)
#pragma unroll
                for (int n = 0; n < 2; ++n) acc[a][b][m][n] = (f32x4){0.f, 0.f, 0.f, 0.f};
    bf16x8 At[4][2], B0[2][2], B1[2][2];
    const char* cA = (const char*)(g.A + cur.aoff) + (size_t)cur.pm * tstepA; const char* cB = (const char*)(g.Bt + cur.boff) + (size_t)cur.pn * tstepB;
    PG8_STAGE(PG8_SB(0, 0), cB, voffB); PG8_STAGE(PG8_SB(0, 1), cB + hstepB, voffB); PG8_STAGE(PG8_SA(0, 0), cA, voffA); PG8_STAGE(PG8_SA(0, 1), cA + hstepA, voffA);
    if (wr == 1) PG8_BAR;
    PG8_WAIT_V(2); PG8_BAR;
    PG8_STAGE(PG8_SB(1, 0), cB + kstep, voffB); PG8_STAGE(PG8_SA(1, 0), cA + kstep, voffA); PG8_STAGE(PG8_SB(1, 1), cB + hstepB + kstep, voffB);
    PG8_WAIT_V(6); PG8_BAR;
    for (;;) {
        const bool has_next = S.next(ui + 1, nxt);
        const char* nA = has_next ? (const char*)(g.A + nxt.aoff) + (size_t)nxt.pm * tstepA : cA; const char* nB = has_next ? (const char*)(g.Bt + nxt.boff) + (size_t)nxt.pn * tstepB : cB;
#pragma unroll 1
        for (int t = 0; t < nt; t += 2) {
            const bool last = (t == nt - 2);
            const char* a1 = cA + (size_t)(t + 1) * kstep;
            const char* a2 = last ? nA : cA + (size_t)(t + 2) * kstep; const char* b2 = last ? nB : cB + (size_t)(t + 2) * kstep;
            const char* a3 = a2 + kstep; const char* b3 = b2 + kstep;
            PG8_LDB(B0, 0, 0); PG8_LDB(B1, 0, 1); PG8_SCHED; PG8_LDA(At, 0, 0); PG8_STAGE(PG8_SA(1, 1), a1 + hstepA, voffA);
            PG8_WAIT_V(8); PG8_WAIT_L(0); PG8_BAR; PG8_MMA(0, 0, At, B0); PG8_MMA(0, 1, At, B1); PG8_BAR; PG8_SCHED;
            PG8_LDA(At, 0, 1); PG8_STAGE(PG8_SB(0, 0), b2, voffB); PG8_STAGE(PG8_SB(0, 1), b2 + hstepB, voffB); PG8_STAGE(PG8_SA(0, 0), a2, voffA);
            PG8_WAIT_V(8); PG8_WAIT_L(0); PG8_BAR; PG8_MMA(1, 0, At, B0); PG8_MMA(1, 1, At, B1); PG8_BAR; PG8_SCHED;
            PG8_LDB(B0, 1, 0); PG8_LDB(B1, 1, 1); PG8_SCHED; PG8_LDA(At, 1, 0); PG8_STAGE(PG8_SA(0, 1), a2 + hstepA, voffA);
            PG8_WAIT_V(8); PG8_WAIT_L(0); PG8_BAR; PG8_MMA(0, 0, At, B0); PG8_MMA(0, 1, At, B1); PG8_BAR; PG8_SCHED;
            PG8_LDA(At, 1, 1); PG8_STAGE(PG8_SB(1, 0), b3, voffB); PG8_STAGE(PG8_SB(1, 1), b3 + hstepB, voffB); PG8_STAGE(PG8_SA(1, 0), a3, voffA);
            PG8_WAIT_V(8); PG8_WAIT_L(0); PG8_BAR; PG8_MMA(1, 0, At, B0); PG8_MMA(1, 1, At, B1); PG8_BAR; PG8_SCHED;
        }
        if constexpr (ALIGN) { if (wr == 0) PG8_BAR; }
        E(acc, cur, wr, wc, fr, fq, wid, lane);
        if (!has_next) break;
#pragma unroll
        for (int a = 0; a < 2; ++a)
#pragma unroll
            for (int b = 0; b < 2; ++b)
#pragma unroll
                for (int m = 0; m < 4; ++m)
#pragma unroll
                    for (int n = 0; n < 2; ++n) acc[a][b][m][n] = (f32x4){0.f, 0.f, 0.f, 0.f};
        cur = nxt; cA = nA; cB = nB; ++ui;
        if constexpr (ALIGN) { if (wr == 1) PG8_BAR; }
    }
    PG8_WAIT_V(0);
    if constexpr (!ALIGN) { if (wr == 0) PG8_BAR; }
    PG8_BAR;
#undef PG8_SA
#undef PG8_SB
#undef PG8_STAGE
#undef PG8_LDA
#undef PG8_LDB
#undef PG8_MMA
#undef PG8_WAIT_V
#undef PG8_WAIT_L
#undef PG8_BAR
#undef PG8_SCHED
}
}
namespace sch {
using pg8::Unit;
__device__ __forceinline__ void tile_of(int L, int nM, int nN, int& pm, int& pn) {
    const int nwg = nM * nN; int wgid = L;
    { const int q = nwg / 8, r = nwg % 8, xcd = wgid % 8, off = wgid / 8; wgid = (xcd < r ? xcd * (q + 1) : r * (q + 1) + (xcd - r) * q) + off; }
    const int nig = 8 * nN, gid = wgid / nig, fm = gid * 8, gsz = (nM - fm) < 8 ? (nM - fm) : 8;
    pm = fm + ((wgid % nig) % gsz); pn = (wgid % nig) / gsz;
}
struct Tiles {
    int nM, nN, G, c;
    __device__ __forceinline__ bool next(int i, Unit& u) const {
        const long L = (long)i * G + c; if (L >= (long)nM * nN) return false;
        tile_of((int)L, nM, nN, u.pm, u.pn); u.aoff = 0; u.boff = 0; u.tag = 0; return true; }
};
struct BrTiles {
    int nM, nN, G, c;
    __device__ __forceinline__ bool next(int i, Unit& u) const {
        const long L = (long)(i >> 2) * G + c; if (L >= (long)nM * nN) return false;
        tile_of((int)L, nM, nN, u.pm, u.pn); const int br = i & 3; u.aoff = br * 256; u.boff = (long)br * 1024 * 256; u.tag = br; return true; }
};
struct MemKV {
    long offMem, offWkv; int c;
    __device__ __forceinline__ bool next(int i, Unit& u) const {
        if (i > 0 || c < 128) return false; const int idx = c - 128;
        if (idx < 64) { u.pm = idx >> 2; u.pn = idx & 3; u.aoff = offMem; u.boff = offWkv; u.tag = 0; }
        else { const int j = idx - 64; u.pm = j >> 4; u.pn = j & 15; u.aoff = offWkv + (long)1024 * 1024; u.boff = offMem; u.tag = 1; }
        return true; }
};
struct XaS {
    int G, c;
    __device__ __forceinline__ bool next(int i, Unit& u) const {
        const int L = i * G + c; if (L >= 512) return false;
        const int b = L >> 5, h = (L >> 3) & 3, rb = L & 7; u.pm = b * 8 + rb; u.pn = b; u.aoff = h * 256; u.boff = h * 256; u.tag = h; return true; }
};
struct XaPV {
    int G, c;
    __device__ __forceinline__ bool next(int i, Unit& u) const {
        const int L = i * G + c; if (L >= 512) return false;
        const int b = L >> 5, h = (L >> 3) & 3, rb = L & 7; u.pm = b * 8 + rb; u.pn = h; u.aoff = h * 256; u.boff = b * 256; u.tag = h; return true; }
};
struct MoeUp {
    const int* blk_e; int b0, b1, G, c;
    __device__ __forceinline__ bool next(int i, Unit& u) const {
        const int L = i * G + c; const int nb = b1 - b0; if (L >= nb * 28) return false;
        const int rb = b0 + L / 28; u.pn = L % 28; u.pm = rb;
        const int e = __builtin_amdgcn_readfirstlane(__hip_atomic_load(blk_e + rb, RLX_AGENT));
        u.aoff = 0; u.boff = (long)e * (2 * FFE) * 1024; u.tag = rb - b0; return true; }
};
struct MoeDown {
    const int* blk_e; int b0, b1, G, c;
    __device__ __forceinline__ bool next(int i, Unit& u) const {
        const int L = i * G + c; const int nb = b1 - b0; if (L >= nb * 4) return false;
        const int rb = b0 + L / 4; u.pn = L % 4; u.pm = rb - b0;
        const int e = __builtin_amdgcn_readfirstlane(__hip_atomic_load(blk_e + rb, RLX_AGENT));
        u.aoff = 0; u.boff = (long)e * 1024 * FFE; u.tag = rb; return true; }
};
}

namespace epi {
using pg8::Unit;
#define EPI_SIG f32x4 (&acc)[2][2][4][2], const Unit& u, int wr, int wc, int fr, int fq, int wid, int lane
#define EPI_ROWS _Pragma("unroll") for (int ai = 0; ai < 2; ++ai) _Pragma("unroll") for (int m = 0; m < 4; ++m)
#define EPI_ROW (u.pm * 256 + ai * 128 + wr * 64 + m * 16 + fr)
#define EPI_BJ _Pragma("unroll") for (int bj = 0; bj < 2; ++bj)
#define EPI_FENCE asm volatile("" ::: "memory")
__device__ __forceinline__ u32x4 pack8(const f32x4 a, const f32x4 b) { u32x4 w; w.x = cvt_pk_bf16(a[0], a[1]); w.y = cvt_pk_bf16(a[2], a[3]); w.z = cvt_pk_bf16(b[0], b[1]); w.w = cvt_pk_bf16(b[2], b[3]); return w; }

template <int ACT> struct StoreBf16 {
    static constexpr bool PERM = true;
    bf16_t* O; int ldc;
    __device__ __forceinline__ void operator()(EPI_SIG) const {
        EPI_ROWS { bf16_t* rowp = O + (size_t)EPI_ROW * ldc + u.pn * 256 + wc * 32 + 8 * fq;
            EPI_BJ { f32x4 v0 = acc[ai][bj][m][0], v1 = acc[ai][bj][m][1];
                if (ACT == 1) { for (int j = 0; j < 4; ++j) { v0[j] = sigmoidf_(v0[j]); v1[j] = sigmoidf_(v1[j]); } }
                *(u32x4*)(rowp + bj * 128) = pack8(v0, v1); } EPI_FENCE; }
    }
};
struct StoreKV {
    static constexpr bool PERM = true;
    bf16_t* K; bf16_t* Vt;
    __device__ __forceinline__ void operator()(EPI_SIG) const {
        bf16_t* O = u.tag ? Vt : K; const int ldc = u.tag ? NMEM : 1024;
        EPI_ROWS { bf16_t* rowp = O + (size_t)EPI_ROW * ldc + u.pn * 256 + wc * 32 + 8 * fq;
            EPI_BJ { *(u32x4*)(rowp + bj * 128) = pack8(acc[ai][bj][m][0], acc[ai][bj][m][1]); } EPI_FENCE; }
    }
};
struct Lora {
    static constexpr bool PERM = true;
    float* dec; bf16_t* av; bf16_t* gv; const float* w0; const float* a0;
    __device__ __forceinline__ void operator()(EPI_SIG) const {
        EPI_ROWS { const size_t row = EPI_ROW;
            EPI_BJ { const int col = bj * 128 + wc * 32 + 8 * fq; f32x4 v0 = acc[ai][bj][m][0], v1 = acc[ai][bj][m][1];
                if (u.pn == 0) {
                    const f32x4 b0 = *(const f32x4*)(w0 + col), b1 = *(const f32x4*)(w0 + col + 4);
                    for (int j = 0; j < 4; ++j) { float x = v0[j] + b0[j]; float wl = -softplusf_(-x) - 0.5f; v0[j] = fexp2(-fexp2(wl * LOG2E) * LOG2E);
                                                  x = v1[j] + b1[j]; wl = -softplusf_(-x) - 0.5f; v1[j] = fexp2(-fexp2(wl * LOG2E) * LOG2E); }
                    *(f32x4*)(dec + row * 256 + col) = v0; *(f32x4*)(dec + row * 256 + col + 4) = v1;
                } else if (u.pn == 1) {
                    const f32x4 b0 = *(const f32x4*)(a0 + col), b1 = *(const f32x4*)(a0 + col + 4);
                    for (int j = 0; j < 4; ++j) { v0[j] = sigmoidf_(v0[j] + b0[j]); v1[j] = sigmoidf_(v1[j] + b1[j]); }
                    *(u32x4*)(av + row * 256 + col) = pack8(v0, v1);
                } else { *(u32x4*)(gv + row * 256 + col) = pack8(v0, v1); } } EPI_FENCE; }
    }
};
struct Uq {
    static constexpr bool PERM = false;
    bf16_t* Q; const float* cosT; const float* sinT;
    __device__ __forceinline__ void operator()(EPI_SIG) const {
        EPI_ROWS { const size_t row = EPI_ROW;
            EPI_BJ { const int c32 = u.pn * 256 + bj * 128 + wc * 32; if (c32 >= 384) continue;
                f32x4 v0 = acc[ai][bj][m][0], v1 = acc[ai][bj][m][1];
                if ((c32 >> 5) % 3 == 2) {
                    const f32x4 cs = *(const f32x4*)(cosT + row * 16 + 4 * fq), sn = *(const f32x4*)(sinT + row * 16 + 4 * fq);
                    const f32x4 o0 = v0 * cs - v1 * sn, o1 = v0 * sn + v1 * cs; v0 = o0; v1 = o1; }
                u32x2 w0, w1; w0.x = cvt_pk_bf16(v0[0], v0[1]); w0.y = cvt_pk_bf16(v0[2], v0[3]); w1.x = cvt_pk_bf16(v1[0], v1[1]); w1.y = cvt_pk_bf16(v1[2], v1[3]);
                *(u32x2*)(Q + row * 384 + c32 + 4 * fq) = w0; *(u32x2*)(Q + row * 384 + c32 + 16 + 4 * fq) = w1; } EPI_FENCE; }
    }
};
struct Ukv {
    static constexpr bool PERM = true;
    bf16_t* Km; bf16_t* Vm;
    __device__ __forceinline__ void operator()(EPI_SIG) const {
        EPI_ROWS { const size_t row = EPI_ROW;
            EPI_BJ { const int col = u.pn * 256 + bj * 128 + wc * 32 + 8 * fq; const int h = col >> 7, j = col & 127;
                const u32x4 w = pack8(acc[ai][bj][m][0], acc[ai][bj][m][1]);
                if (j < 64) *(u32x4*)(Km + row * 384 + h * 96 + j) = w; else *(u32x4*)(Vm + row * 256 + h * 64 + (j - 64)) = w; } EPI_FENCE; }
    }
};
struct Resid {
    static constexpr bool PERM = false;
    const float* res; float* out; float ascale; const bf16_t* res16;
    __device__ __forceinline__ void operator()(EPI_SIG) const {
        EPI_ROWS { const size_t off = (size_t)EPI_ROW * 1024 + u.pn * 256 + wc * 32 + 4 * fq;
            EPI_BJ { _Pragma("unroll") for (int n = 0; n < 2; ++n) { const size_t o = off + bj * 128 + n * 16;
                f32x4 r; if (res16) { const u32x2 w = *(const u32x2*)(res16 + o); r = (f32x4){bflo(w.x), bfhi(w.x), bflo(w.y), bfhi(w.y)}; } else r = *(const f32x4*)(res + o);
                *(f32x4*)(out + o) = r * DN_ALPHA + acc[ai][bj][m][n] * ascale; } } EPI_FENCE; }
    }
};
struct Swiglu {
    static constexpr bool PERM = false;
    bf16_t* H; int ldh; int use_tag;
    __device__ __forceinline__ void operator()(EPI_SIG) const {
        const int pmo = use_tag ? u.tag : u.pm;
        EPI_ROWS { const size_t row = (size_t)(pmo * 256 + ai * 128 + wr * 64 + m * 16 + fr);
            EPI_BJ { const int hc = (u.pn * 256 + bj * 128 + wc * 32) / 2 + 4 * fq; const f32x4 g = acc[ai][bj][m][0], up = acc[ai][bj][m][1];
                u32x2 w; w.x = cvt_pk_bf16(siluf_(g[0]) * up[0], siluf_(g[1]) * up[1]); w.y = cvt_pk_bf16(siluf_(g[2]) * up[2], siluf_(g[3]) * up[3]);
                *(u32x2*)(H + row * ldh + hc) = w; } EPI_FENCE; }
    }
};
struct BrGate {
    static constexpr bool PERM = true;
    const bf16_t* G; float* mf; bf16_t* mb;
    __device__ __forceinline__ void operator()(EPI_SIG) const {
        const int br = u.tag;
#ifdef ABL_BR
        const float ablk = ((ABL_BR >> br) & 1) ? 0.f : 1.f;
#else
        const float ablk = 1.f;
#endif
        EPI_ROWS { const size_t row = EPI_ROW;
            EPI_BJ { const int col = u.pn * 256 + bj * 128 + wc * 32 + 8 * fq;
#ifdef G_SYS_LOAD
                u32x4 gw; { const unsigned long long* gp_ = (const unsigned long long*)(G + row * 4096 + br * 1024 + col); const unsigned long long q0 = __hip_atomic_load(gp_, __ATOMIC_RELAXED, __HIP_MEMORY_SCOPE_SYSTEM), q1 = __hip_atomic_load(gp_ + 1, __ATOMIC_RELAXED, __HIP_MEMORY_SCOPE_SYSTEM); gw.x = (unsigned)q0; gw.y = (unsigned)(q0 >> 32); gw.z = (unsigned)q1; gw.w = (unsigned)(q1 >> 32); }
#else
                const u32x4 gw = *(const u32x4*)(G + row * 4096 + br * 1024 + col);
#endif
                f32x4 v0 = acc[ai][bj][m][0] * ablk, v1 = acc[ai][bj][m][1] * ablk;
#if defined(GATE_ACT) && GATE_ACT == 0
#define GSIG(x) sigmoidf_(x)
#else
#define GSIG(x) (x)
#endif
                v0[0] *= GSIG(bflo(gw.x)); v0[1] *= GSIG(bfhi(gw.x)); v0[2] *= GSIG(bflo(gw.y)); v0[3] *= GSIG(bfhi(gw.y));
                v1[0] *= GSIG(bflo(gw.z)); v1[1] *= GSIG(bfhi(gw.z)); v1[2] *= GSIG(bflo(gw.w)); v1[3] *= GSIG(bfhi(gw.w));
                bf16_t* p = mb + row * 1024 + col;
                if (br > 0) { const u32x4 pw = *(const u32x4*)p; v0[0] += bflo(pw.x); v0[1] += bfhi(pw.x); v0[2] += bflo(pw.y); v0[3] += bfhi(pw.y); v1[0] += bflo(pw.z); v1[1] += bfhi(pw.z); v1[2] += bflo(pw.w); v1[3] += bfhi(pw.w); }
                *(u32x4*)p = pack8(v0, v1); } EPI_FENCE; }
    }
};
struct MoeDown {
    static constexpr bool PERM = true;
    const int* row_slot; const float* row_w; bf16_t* ys;
    __device__ __forceinline__ void operator()(EPI_SIG) const {
        EPI_ROWS { const int r = u.tag * 256 + ai * 128 + wr * 64 + m * 16 + fr;
            const int slot = __hip_atomic_load(row_slot + r, RLX_AGENT); const float w = __hip_atomic_load(row_w + r, RLX_AGENT);
            if (slot >= 0) { EPI_BJ { const int col = u.pn * 256 + bj * 128 + wc * 32 + 8 * fq;
                *(u32x4*)(ys + (size_t)slot * 1024 + col) = pack8(acc[ai][bj][m][0] * w, acc[ai][bj][m][1] * w); } } EPI_FENCE; }
    }
};
struct Softmax {
    static constexpr bool PERM = true;
    bf16_t* P; LAS float* xch;
    __device__ __forceinline__ void operator()(EPI_SIG) const {
        EPI_ROWS { float v = -3.0e38f;
            EPI_BJ { const f32x4 a = acc[ai][bj][m][0], b = acc[ai][bj][m][1]; v = fmaxf(v, fmaxf(fmaxf(fmaxf(a[0], a[1]), fmaxf(a[2], a[3])), fmaxf(fmaxf(b[0], b[1]), fmaxf(b[2], b[3])))); }
            v = fmaxf(v, __shfl_xor(v, 16)); v = fmaxf(v, __shfl_xor(v, 32));
            if (fq == 0) xch[(ai * 128 + wr * 64 + m * 16 + fr) * 4 + wc] = v; }
        LDS_WAIT(); __builtin_amdgcn_s_barrier(); asm volatile("" ::: "memory");
        EPI_ROWS { const f32x4 q = *(const LAS f32x4*)(xch + (ai * 128 + wr * 64 + m * 16 + fr) * 4);
            const float mm = fmaxf(fmaxf(q[0], q[1]), fmaxf(q[2], q[3])); float s = 0.f;
            EPI_BJ { _Pragma("unroll") for (int n = 0; n < 2; ++n) { f32x4 t = acc[ai][bj][m][n]; for (int j = 0; j < 4; ++j) { t[j] = fexp2(t[j] - mm); s += t[j]; } acc[ai][bj][m][n] = t; } }
            s += __shfl_xor(s, 16); s += __shfl_xor(s, 32);
            if (fq == 0) xch[1024 + (ai * 128 + wr * 64 + m * 16 + fr) * 4 + wc] = s; }
        LDS_WAIT(); __builtin_amdgcn_s_barrier(); asm volatile("" ::: "memory");
        EPI_ROWS { const f32x4 q = *(const LAS f32x4*)(xch + 1024 + (ai * 128 + wr * 64 + m * 16 + fr) * 4);
            const float inv = frcp((q[0] + q[1]) + (q[2] + q[3]));
            bf16_t* rowp = P + (size_t)EPI_ROW * 1024 + u.tag * 256 + wc * 32 + 8 * fq;
            EPI_BJ { *(u32x4*)(rowp + bj * 128) = pack8(acc[ai][bj][m][0] * inv, acc[ai][bj][m][1] * inv); } EPI_FENCE; }
        LDS_WAIT(); __builtin_amdgcn_s_barrier(); asm volatile("" ::: "memory");
    }
};
}
struct Args { const float* in[42]; float* out; unsigned char* ws; int ph_lo, ph_hi; };
struct Ctx {
    const float* const* in; float* out; unsigned char* ws; LAS unsigned char* lds;
    int tid, lane, wave, G, bid;
};
enum { I_X = 0, I_MEM, I_POS, I_WIN, I_RWMU, I_RWW0, I_RWWUP, I_RWA0, I_RWAUP, I_RWGUP, I_RWKK, I_RWKA, I_RWRK, I_RWGNG, I_RWGNB,
       I_CONVW, I_CONVB, I_DTB, I_ALOG, I_SSDD, I_SSDNG, I_QNG, I_WUQ, I_KVNG, I_WUKV, I_WBR, I_WGATE, I_WOUT, I_LN1G, I_LN1B,
       I_XWQ, I_XWKV, I_XWO, I_LN2G, I_LN2B, I_FFN13, I_FFN2, I_ROUTER, I_MOE13, I_MOE2, I_LN3G, I_LN3B };
__device__ __forceinline__ Ctx launder(const Ctx& C0) {
    Ctx L = C0; float* out_ = C0.out; unsigned char* ws_ = C0.ws; int t_ = threadIdx.x;
    asm volatile("" : "+s"(out_), "+s"(ws_), "+v"(t_));
    L.out = out_; L.ws = ws_; L.tid = t_; L.lane = t_ & 63; L.wave = __builtin_amdgcn_readfirstlane(t_ >> 6); return L;
}
#define WSP(T_, off) ((T_*)(C.ws + (off)))
#define GW (C.bid * NWAVES + C.wave)
#define NGW (C.G * NWAVES)

struct TJob { const float* W; int ldw, K, N; bf16_t* WT; int ldt; int map; float scale; int items; };
__device__ __forceinline__ int tj_items(int K, int N) { return (K / 64) * ((N + 31) / 32); }
__device__ __forceinline__ int tj_dest(int map, int n, int N) {
    if (map == 0) return n;
    if (map == 1) return n < 2816 ? n : (n < 2820 ? PC_DT + (n - 2816) : n - 4);
    const int half = N >> 1, j = n < half ? n : n - half;
    return (j >> 4) * 32 + (j & 15) + (n < half ? 0 : 16);
}
__device__ __forceinline__ void t_load(const TJob& J, int item, int lane, float (&v)[32]) {
    const int nblk = (J.N + 31) / 32, kb = item / nblk, nb = item % nblk, k0 = 64 * kb, n0 = 32 * nb;
    const int nn = n0 + (lane & 31); const bool okn = nn < J.N; const float* src = J.W + (size_t)(k0 + (lane >> 5)) * J.ldw + nn;
#pragma unroll
    for (int i = 0; i < 32; ++i) v[i] = okn ? src[(size_t)(2 * i) * J.ldw] : 0.f;
}
__device__ __forceinline__ void t_commit(const TJob& J, LAS float* scr, int item, int lane, const float (&v)[32]) {
    const int nblk = (J.N + 31) / 32, kb = item / nblk, nb = item % nblk, k0 = 64 * kb, n0 = 32 * nb;
#pragma unroll
    for (int i = 0; i < 32; ++i) scr[(2 * i + (lane >> 5)) * 33 + (lane & 31)] = v[i];
    LDS_WAIT(); asm volatile("" ::: "memory");
    const int c = lane & 7;
#pragma unroll
    for (int j = 0; j < 4; ++j) { const int nl = (lane >> 3) + 8 * j, n = n0 + nl;
        if (n < J.N) { const LAS float* s = scr + (8 * c) * 33 + nl; const float sc = (J.map == 1 && n >= 256) ? 1.0f : J.scale;
            u32x4 o; o.x = cvt_pk_bf16(s[0 * 33] * sc, s[1 * 33] * sc); o.y = cvt_pk_bf16(s[2 * 33] * sc, s[3 * 33] * sc); o.z = cvt_pk_bf16(s[4 * 33] * sc, s[5 * 33] * sc); o.w = cvt_pk_bf16(s[6 * 33] * sc, s[7 * 33] * sc);
            *(u32x4*)(J.WT + (size_t)tj_dest(J.map, n, J.N) * J.ldt + k0 + 8 * c) = o; } }
    LDS_WAIT(); asm volatile("" ::: "memory");
}
__device__ __forceinline__ TJob mkjob(const float* W, int ldw, int K, int N, bf16_t* WT, int ldt, int map, float scale) { TJob j; j.W = W; j.ldw = ldw; j.K = K; j.N = N; j.WT = WT; j.ldt = ldt; j.map = map; j.scale = scale; j.items = tj_items(K, N); return j; }

__device__ __forceinline__ TJob prologue_job(const Ctx& C, int j) {
    if (j < 26) { const int l = j / 13, r = j % 13; unsigned char* LW = C.ws + W_BASE + (size_t)l * LW_SIZE;
        if (r == 0) return mkjob(C.in[I_WIN] + (size_t)l * 1024 * 3236, 3236, 1024, 3236, (bf16_t*)(LW + LW_WIN), 1024, 1, 0.125f * LOG2E);
        if (r < 5) { const int i = r - 1; return mkjob(C.in[I_WGATE] + ((size_t)l * 4 + i) * 1024 * 1024, 1024, 1024, 1024, (bf16_t*)(LW + LW_WGATE) + (size_t)i * 1024 * 1024, 1024, 0, 1.f); }
        if (r < 9) { const int i = r - 5; return mkjob(C.in[I_WBR] + ((size_t)l * 4 + i) * 256 * 1024, 1024, 256, 1024, (bf16_t*)(LW + LW_WBR) + (size_t)i * 1024 * 256, 256, 0, 1.f); }
        if (r == 9) return mkjob(C.in[I_WOUT] + (size_t)l * 1024 * 1024, 1024, 1024, 1024, (bf16_t*)(LW + LW_WOUT), 1024, 0, 1.f);
        if (r == 10) return mkjob(C.in[I_XWQ] + (size_t)l * 1024 * 1024, 1024, 1024, 1024, (bf16_t*)(LW + LW_WQ), 1024, 0, 0.0625f * LOG2E);
        if (r == 11) return mkjob(C.in[I_XWKV] + (size_t)l * 1024 * 2048, 2048, 1024, 2048, (bf16_t*)(LW + LW_WKV), 1024, 0, 1.f);
        return mkjob(C.in[I_XWO] + (size_t)l * 1024 * 1024, 1024, 1024, 1024, (bf16_t*)(LW + LW_WO), 1024, 0, 1.f);
    }
    if (j == 26) return mkjob(C.in[I_FFN13], 2 * FFD, 1024, 2 * FFD, WSP(bf16_t, W_FFN13), 1024, 2, 1.f);
    return mkjob(C.in[I_FFN2], 1024, FFD, 1024, WSP(bf16_t, W_FFN2), FFD, 0, 1.f);
}
__device__ __forceinline__ TJob moe_job(const Ctx& C, int j) {
    if (j < 8) return mkjob(C.in[I_MOE13] + (size_t)j * 1024 * 2 * FFE, 2 * FFE, 1024, 2 * FFE, WSP(bf16_t, S_MW13) + (size_t)j * 2 * FFE * 1024, 1024, 2, 1.f);
    const int e = j - 8; return mkjob(C.in[I_MOE2] + (size_t)e * FFE * 1024, 1024, FFE, 1024, WSP(bf16_t, S_MW2) + (size_t)e * 1024 * FFE, FFE, 0, 1.f);
}
template <int NJ, bool MOE> __device__ __forceinline__ void run_tjobs(const Ctx& C) {
    LAS float* scr = (LAS float*)(C.lds + C.wave * 16384);
    int total = 0;
    for (int j = 0; j < NJ; ++j) { const TJob J = MOE ? moe_job(C, j) : prologue_job(C, j); total += J.items; }
    int j = 0, jbase = 0; TJob J = MOE ? moe_job(C, 0) : prologue_job(C, 0);
    int it = GW; if (it >= total) return;
    while (it >= jbase + J.items) { jbase += J.items; ++j; J = MOE ? moe_job(C, j) : prologue_job(C, j); }
    float va[32], vb[32];
    t_load(J, it - jbase, C.lane, va);
    for (;;) {
        TJob Jc = J; int itc = it - jbase; it += NGW; bool more = it < total;
        if (more) { while (it >= jbase + J.items) { jbase += J.items; ++j; J = MOE ? moe_job(C, j) : prologue_job(C, j); } t_load(J, it - jbase, C.lane, vb); }
        t_commit(Jc, scr, itc, C.lane, va);
        if (!more) break;
        Jc = J; itc = it - jbase; it += NGW; more = it < total;
        if (more) { while (it >= jbase + J.items) { jbase += J.items; ++j; J = MOE ? moe_job(C, j) : prologue_job(C, j); } t_load(J, it - jbase, C.lane, va); }
        t_commit(Jc, scr, itc, C.lane, vb);
        if (!more) break;
    }
}


constexpr int CW_CHK = 32768;
template <class OutF> __device__ __forceinline__ void chk_gemm(const Ctx& C, const bf16_t* A, int lda, const bf16_t* Bt, int ldb, int K, int nrows, int ncs, int cstride, int c0, int bit, OutF expect_vs_got) {
    unsigned bad = 0; const int lane = C.lane;
    for (int it = GW; it < nrows * ncs; it += NGW) {
        const int r = it / ncs, c = c0 + (it % ncs) * cstride; float d = 0.f;
        for (int k = lane * 8; k < K; k += 512) { const u32x4 a = *(const u32x4*)(A + (size_t)r * lda + k), b = *(const u32x4*)(Bt + (size_t)c * ldb + k);
            d += bflo(a.x) * bflo(b.x) + bfhi(a.x) * bfhi(b.x) + bflo(a.y) * bflo(b.y) + bfhi(a.y) * bfhi(b.y) + bflo(a.z) * bflo(b.z) + bfhi(a.z) * bfhi(b.z) + bflo(a.w) * bflo(b.w) + bfhi(a.w) * bfhi(b.w); }
        d = wave_sum(d);
        if (!expect_vs_got(r, c, d)) bad = 1;
    }
    if (lane == 0 && bad) __hip_atomic_fetch_add((unsigned*)(C.ws + WS_CTL) + CW_CHK + 64 * bit, 1u, RLX_AGENT);
}
__device__ __forceinline__ bool chk_close(float e, float g) { return fabsf(e - g) <= 0.03f * fabsf(e) + 0.03f; }

__device__ __forceinline__ float chk_dot(const bf16_t* a, const bf16_t* b, int K, int lane) {
    float d = 0.f;
    for (int k = lane * 8; k < K; k += 512) { const u32x4 x = *(const u32x4*)(a + k), y = *(const u32x4*)(b + k);
        d += bflo(x.x) * bflo(y.x) + bfhi(x.x) * bfhi(y.x) + bflo(x.y) * bflo(y.y) + bfhi(x.y) * bfhi(y.y) + bflo(x.z) * bflo(y.z) + bfhi(x.z) * bfhi(y.z) + bflo(x.w) * bflo(y.w) + bfhi(x.w) * bfhi(y.w); }
    return wave_sum(d);
}
__device__ __forceinline__ void chk_flag(const Ctx& C, int bit, unsigned bad) { if (C.lane == 0 && bad) __hip_atomic_fetch_add((unsigned*)(C.ws + WS_CTL) + CW_CHK + 64 * bit, 1u, RLX_AGENT); }
__device__ __forceinline__ void chk_merged(const Ctx& C, int l, int bit) {
    const bf16_t* Y = WSP(bf16_t, S_Y); const bf16_t* G = WSP(bf16_t, S_G); const bf16_t* MB = WSP(bf16_t, S_MB); const bf16_t* WBR = (const bf16_t*)(C.ws + W_BASE + (size_t)l * LW_SIZE + LW_WBR); unsigned bad = 0;
    for (int it = GW; it < T * 4; it += NGW) { const int r = it >> 2, c = 13 + 256 * (it & 3); float e = 0.f;
        for (int i = 0; i < 4; ++i) e += bf2f(G[(size_t)r * 4096 + i * 1024 + c]) * chk_dot(Y + (size_t)r * 1024 + 256 * i, WBR + ((size_t)i * 1024 + c) * 256, 256, C.lane);
        if (!chk_close(e, bf2f(MB[(size_t)r * 1024 + c]))) bad = 1; }
    chk_flag(C, bit, bad);
}
__device__ __forceinline__ void chk_swiglu(const Ctx& C, int bit) {
    const bf16_t* XB = WSP(bf16_t, W_XB); const bf16_t* W = WSP(bf16_t, W_FFN13); const bf16_t* H = WSP(bf16_t, S_H); unsigned bad = 0;
    for (int it = GW; it < T * 22; it += NGW) { const int r = it / 22, hc = 5 + 128 * (it % 22); const int grow = (hc >> 4) * 32 + (hc & 15);
        const float g = chk_dot(XB + (size_t)r * 1024, W + (size_t)grow * 1024, 1024, C.lane), u = chk_dot(XB + (size_t)r * 1024, W + (size_t)(grow + 16) * 1024, 1024, C.lane);
        if (!chk_close(siluf_(g) * u, bf2f(H[(size_t)r * FFD + hc]))) bad = 1; }
    chk_flag(C, bit, bad);
}

constexpr size_t S_CHKBUF = S_BASE + (size_t)400 * MiB;
__device__ __forceinline__ void chk_resid_stash(const Ctx& C, const bf16_t* A, int lda, const bf16_t* Bt, int ldb, int K, int slot) {
    const float* XR = WSP(float, W_XRES); float* CB = WSP(float, S_CHKBUF);
    for (int it = GW; it < T * 4; it += NGW) { const int r = it >> 2, q = it & 3, c = 17 + 256 * q; const float d = chk_dot(A + (size_t)r * lda, Bt + (size_t)c * ldb, K, C.lane);
        if (C.lane == 0) CB[(size_t)r * 8 + slot * 4 + q] = XR[(size_t)r * 1024 + c] * DN_ALPHA + d; }
}
__device__ __forceinline__ void chk_resid_cmp(const Ctx& C, int slot, int bit) {
    const float* XR = WSP(float, W_XRES); const float* CB = WSP(float, S_CHKBUF); unsigned bad = 0;
    for (int it = GW; it < T * 4; it += NGW) { const int r = it >> 2, q = it & 3, c = 17 + 256 * q; if (!chk_close(CB[(size_t)r * 8 + slot * 4 + q], XR[(size_t)r * 1024 + c])) bad = 1; }
    chk_flag(C, bit, bad);
}
__device__ __forceinline__ void chk_ln_stash(const Ctx& C, const float* g, const float* b, int slot) {
    const float* XR = WSP(float, W_XRES); float* CB = WSP(float, S_CHKBUF); const int lane = C.lane;
    for (int t = GW; t < T; t += NGW) { float s = 0.f, s2 = 0.f; float v[16];
        for (int j = 0; j < 16; ++j) { v[j] = XR[(size_t)t * 1024 + lane + 64 * j]; s += v[j]; }
        const float mean = wave_sum(s) * (1.0f / 1024.0f); for (int j = 0; j < 16; ++j) { const float d = v[j] - mean; s2 += d * d; }
        const float rstd = 1.0f / sqrtf(wave_sum(s2) * (1.0f / 1024.0f) + 1e-5f);
        if (lane < 4) { const int c = 17 + 256 * lane; CB[(size_t)t * 8 + slot * 4 + lane] = (XR[(size_t)t * 1024 + c] - mean) * rstd * g[c] + b[c]; } }
}
__device__ __forceinline__ void chk_ln_cmp(const Ctx& C, int slot, int bit) {
    const float* XR = WSP(float, W_XRES); const bf16_t* XB = WSP(bf16_t, W_XB); const float* CB = WSP(float, S_CHKBUF); unsigned bad = 0;
    for (int it = GW; it < T * 4; it += NGW) { const int r = it >> 2, q = it & 3, c = 17 + 256 * q; const float e = CB[(size_t)r * 8 + slot * 4 + q];
        if (!chk_close(e, XR[(size_t)r * 1024 + c]) || !chk_close(e, bf2f(XB[(size_t)r * 1024 + c]))) bad = 1; }
    chk_flag(C, bit, bad);
}

template <int NJ, bool MOE> __device__ __forceinline__ void chk_weights(const Ctx& C, int bit) {
    unsigned bad = 0; const int gt = C.bid * NTHREADS + C.tid, NT = C.G * NTHREADS;
    for (int j = 0; j < NJ; ++j) { const TJob J = MOE ? moe_job(C, j) : prologue_job(C, j);
        for (size_t i = gt; i < (size_t)J.K * J.N; i += NT) { const int k = (int)(i / J.N), n = (int)(i % J.N);
            const float sc = (J.map == 1 && n >= 256) ? 1.0f : J.scale; const bf16_t e = (bf16_t)(cvt_pk_bf16(J.W[(size_t)k * J.ldw + n] * sc, 0.f) & 0xffffu);
            if (J.WT[(size_t)tj_dest(J.map, n, J.N) * J.ldt + k] != e) bad = 1; } }
    if (bad) __hip_atomic_fetch_add((unsigned*)(C.ws + WS_CTL) + CW_CHK + 64 * bit, 1u, RLX_AGENT);
}

__device__ __forceinline__ void chk_mla_inputs(const Ctx& C, int l, int bit) {
    const bf16_t* proj = WSP(bf16_t, S_PROJ); const bf16_t* QM = WSP(bf16_t, S_QM); const bf16_t* KM = WSP(bf16_t, S_KM); const bf16_t* VM = WSP(bf16_t, S_VM);
    const float* wuq = C.in[I_WUQ] + (size_t)l * 256 * 384; const float* wukv = C.in[I_WUKV] + (size_t)l * 128 * 512; const float* qg = C.in[I_QNG] + l * 256; const float* kvg = C.in[I_KVNG] + l * 128;
    const int* pos = (const int*)C.in[I_POS]; const int lane = C.lane; unsigned bad = 0; const float qs = 0.10206207261596575f * LOG2E;
    for (int t = GW; t < T; t += NGW) {
        const bf16_t* pr = proj + (size_t)t * NPROJ; float cq[4], ck[2]; float ss = 0.f;
        for (int i = 0; i < 4; ++i) { cq[i] = bf2f(pr[PC_CQ + lane + 64 * i]); ss += cq[i] * cq[i]; }
        float rs = 1.0f / sqrtf(wave_sum(ss) * (1.0f / 256.0f) + 1e-6f); for (int i = 0; i < 4; ++i) cq[i] *= rs * qg[lane + 64 * i];
        ss = 0.f; for (int i = 0; i < 2; ++i) { ck[i] = bf2f(pr[PC_CKV + lane + 64 * i]); ss += ck[i] * ck[i]; }
        rs = 1.0f / sqrtf(wave_sum(ss) * (1.0f / 128.0f) + 1e-6f); for (int i = 0; i < 2; ++i) ck[i] *= rs * kvg[lane + 64 * i];
        const float ang = (float)pos[t] * exp2f(-6.0f * (13.287712379549449f / 32.0f)); const float c3 = cosf(ang), s3 = sinf(ang);
        const int h = t & 3;
        float qn = 0.f, q1 = 0.f, q2 = 0.f, kn = 0.f, vv = 0.f;
        for (int i = 0; i < 4; ++i) { const int k = lane + 64 * i; qn += cq[i] * wuq[(size_t)k * 384 + h * 96 + 5]; q1 += cq[i] * wuq[(size_t)k * 384 + h * 96 + 67]; q2 += cq[i] * wuq[(size_t)k * 384 + h * 96 + 83]; }
        for (int i = 0; i < 2; ++i) { const int k = lane + 64 * i; kn += ck[i] * wukv[(size_t)k * 512 + h * 128 + 7]; vv += ck[i] * wukv[(size_t)k * 512 + h * 128 + 64 + 9]; }
        qn = wave_sum(qn) * qs; q1 = wave_sum(q1) * qs; q2 = wave_sum(q2) * qs; kn = wave_sum(kn); vv = wave_sum(vv);
        const float kr1 = bf2f(pr[PC_KR + 3]), kr2 = bf2f(pr[PC_KR + 19]);
        const bf16_t* qrow = QM + (size_t)t * 384 + h * 96; const bf16_t* krow = KM + (size_t)t * 384 + h * 96;
        if (!chk_close(qn, bf2f(qrow[5])) || !chk_close(q1 * c3 - q2 * s3, bf2f(qrow[67])) || !chk_close(q1 * s3 + q2 * c3, bf2f(qrow[83])) || !chk_close(kn, bf2f(krow[7])) ||
            !chk_close(kr1 * c3 - kr2 * s3, bf2f(krow[67])) || !chk_close(kr1 * s3 + kr2 * c3, bf2f(krow[83])) || !chk_close(vv, bf2f(VM[(size_t)t * 256 + h * 64 + 9]))) bad = 1;
    }
    chk_flag(C, bit, bad);
}

__device__ __forceinline__ void chk_rw_inputs(const Ctx& C, int l, int bit) {
    const bf16_t* proj = WSP(bf16_t, S_PROJ); const float* DEC = WSP(float, S_DEC); const bf16_t* RWS = WSP(bf16_t, S_RWS); const bf16_t* GV = WSP(bf16_t, S_GV); const size_t PL = (size_t)T * 256;
    const float* mu = C.in[I_RWMU] + l * 1024; const float* w0 = C.in[I_RWW0] + l * 256; const float* a0 = C.in[I_RWA0] + l * 256;
    const float* wup = C.in[I_RWWUP] + l * 64 * 256; const float* aup = C.in[I_RWAUP] + l * 64 * 256; const float* gup = C.in[I_RWGUP] + l * 128 * 256;
    const float* kkw = C.in[I_RWKK] + l * 256; const float* kaw = C.in[I_RWKA] + l * 256; const int lane = C.lane; unsigned bad = 0;
    for (int t = GW; t < T; t += NGW) {
        const bf16_t* pr = proj + (size_t)t * NPROJ + PC_RW; const bool first = (t % SEQ) == 0; const int h = t & 3, c = h * 64 + 11;
        auto sh = [&](int col) { const float cur = bf2f(pr[col]); const float prv = first ? 0.f : bf2f(pr[col - NPROJ]); return cur + (prv - cur) * mu[col]; };
        float dw = tanhf(sh(768 + lane)) * wup[lane * 256 + c], da = sh(832 + lane) * aup[lane * 256 + c];
        float dg = (1.0f / (1.0f + expf(-sh(896 + lane)))) * gup[lane * 256 + c] + (1.0f / (1.0f + expf(-sh(960 + lane)))) * gup[(64 + lane) * 256 + c];
        dw = wave_sum(dw); da = wave_sum(da); dg = wave_sum(dg);
        const float xw = w0[c] + dw; const float wlog = -(fmaxf(-xw, 0.f) + log1pf(expf(-fabsf(xw)))) - 0.5f; const float dec = expf(-expf(wlog));
        const float a = 1.0f / (1.0f + expf(-(a0[c] + da)));
        const float kl = sh(256 + h * 64 + lane) * kkw[h * 64 + lane]; const float nrm = 1.0f / sqrtf(fmaxf(wave_sum(kl * kl), 1e-24f));
        const float r = sh(c), k = sh(256 + c), v = sh(512 + c); const float kk = k * kkw[c] * nrm, kmod = k * (1.0f + (a - 1.0f) * kaw[c]), ka = kk * a;
        const size_t o = (size_t)t * 256 + c;
        if (!chk_close(dec, DEC[o]) || fabsf(dec - DEC[o]) > 0.004f || !chk_close(r, bf2f(RWS[o])) || !chk_close(kmod, bf2f(RWS[PL + o])) || !chk_close(v, bf2f(RWS[2 * PL + o])) || !chk_close(kk, bf2f(RWS[3 * PL + o])) ||
            !chk_close(ka, bf2f(RWS[4 * PL + o])) || !chk_close(dg, bf2f(GV[o]))) bad = 1;
    }
    chk_flag(C, bit, bad);
}
__device__ __forceinline__ void chk_ssd_norm(const Ctx& C, int l, int bit) {
    const bf16_t* Y = WSP(bf16_t, S_Y); const float* ng = C.in[I_SSDNG] + l * 256; const int lane = C.lane; unsigned bad = 0;
    for (int t = GW; t < T; t += NGW) { float q = 0.f;
        for (int i = 0; i < 4; ++i) { const int c = (lane >> 5) * 128 + (lane & 31) * 4 + i; const float y = bf2f(Y[(size_t)t * 1024 + 512 + c]) / ng[c]; q += y * y; }
        for (int o_ = 1; o_ < 32; o_ <<= 1) q += __shfl_xor(q, o_);
        q *= (1.0f / 128.0f); if (q < 0.9f || q > 1.1f) bad = 1; }
    chk_flag(C, bit, bad);
}

#ifndef P7_COND
#define P7_COND 1
#endif
#ifndef P7_CLASS
#define P7_CLASS (((c & 31) < 16 ? 1u : 2u) | ((c & 255) < 128 ? 4u : 8u))
#endif
__device__ __forceinline__ float tdot(const bf16_t* a, const bf16_t* b, int K) { float d = 0.f;
    for (int k = 0; k < K; k += 8) { const u32x4 x = *(const u32x4*)(a + k), y = *(const u32x4*)(b + k);
        d += bflo(x.x) * bflo(y.x) + bfhi(x.x) * bfhi(y.x) + bflo(x.y) * bflo(y.y) + bfhi(x.y) * bfhi(y.y) + bflo(x.z) * bflo(y.z) + bfhi(x.z) * bfhi(y.z) + bflo(x.w) * bflo(y.w) + bfhi(x.w) * bfhi(y.w); }
    return d; }
__device__ __forceinline__ void chk_full_p7(const Ctx& C, int l, int bit) {
    const bf16_t* MB = WSP(bf16_t, S_MB); const bf16_t* W = (const bf16_t*)(C.ws + W_BASE + (size_t)l * LW_SIZE + LW_WOUT); const float* xin = C.in[I_X]; const float* XR = WSP(float, W_XRES); float num = 0.f, den = 0.f;
    for (size_t i = (size_t)C.bid * NTHREADS + C.tid; i < (size_t)T * 1024; i += (size_t)C.G * NTHREADS) { const size_t r = i >> 10; const int c = (int)(i & 1023);
        const float d = tdot(MB + r * 1024, W + (size_t)c * 1024, 1024), g = XR[i] - xin[i] * DN_ALPHA; num += (d - g) * (d - g); den += d * d; }
    num = wave_sum(num); den = wave_sum(den);
    if (C.lane == 0) { atomicAdd((float*)(C.ws + WS_CTL) + CW_CHK + 1024, num); atomicAdd((float*)(C.ws + WS_CTL) + CW_CHK + 1088, den); }
}
__device__ __forceinline__ void chk_full_merged(const Ctx& C, int l, int bit) {
    const bf16_t* Y = WSP(bf16_t, S_Y); const bf16_t* G = WSP(bf16_t, S_G); const bf16_t* MB = WSP(bf16_t, S_MB); const bf16_t* WBR = (const bf16_t*)(C.ws + W_BASE + (size_t)l * LW_SIZE + LW_WBR); unsigned bad = 0;
    for (size_t i = (size_t)C.bid * NTHREADS + C.tid; i < (size_t)T * 1024; i += (size_t)C.G * NTHREADS) { const size_t r = i >> 10; const int c = (int)(i & 1023); float e = 0.f;
        for (int q = 0; q < 4; ++q) e += bf2f(G[r * 4096 + q * 1024 + c]) * tdot(Y + r * 1024 + 256 * q, WBR + ((size_t)q * 1024 + c) * 256, 256);
        if (!chk_close(e, bf2f(MB[i]))) bad = 1; }
    if (bad) __hip_atomic_fetch_add((unsigned*)(C.ws + WS_CTL) + CW_CHK + 64 * bit, 1u, RLX_AGENT);
}

#ifndef FG_CLASS
#define FG_CLASS (1u << ((c >> 5) & 3))
#endif
template <class F> __device__ __forceinline__ void chk_full_gemm(const Ctx& C, const bf16_t* A, const bf16_t* Bt, int K, int N, int bit, F ok) {
    unsigned bad = 0, cntbad = 0;
    for (size_t i = (size_t)C.bid * NTHREADS + C.tid; i < (size_t)T * N; i += (size_t)C.G * NTHREADS) { const size_t r = i / N; const int c = (int)(i % N);
        if (!ok(r, c, tdot(A + r * K, Bt + (size_t)c * K, K))) { bad |= (bit < 0) ? (FG_CLASS) : (1u << bit); ++cntbad; } }
#ifdef FG_COUNT
    if (cntbad) __hip_atomic_fetch_add((unsigned*)(C.ws + WS_CTL) + CW_CHK + 2048, cntbad, RLX_AGENT);
#else
    for (int q = 0; q < 4; ++q) if ((bad >> q) & 1) __hip_atomic_fetch_add((unsigned*)(C.ws + WS_CTL) + CW_CHK + 64 * q, 1u, RLX_AGENT);
#endif
}
__device__ __forceinline__ void ph_prologue(const Ctx& C) {
    run_tjobs<28, false>(C);
    const int gt = C.bid * NTHREADS + C.tid, NT = C.G * NTHREADS;
    for (int l = 0; l < 2; ++l) {
        unsigned char* LW = C.ws + W_BASE + (size_t)l * LW_SIZE;
        bf16_t* lora = (bf16_t*)(LW + LW_LORA); const float* wup = C.in[I_RWWUP] + l * 64 * 256; const float* aup = C.in[I_RWAUP] + l * 64 * 256; const float* gup = C.in[I_RWGUP] + l * 128 * 256;
        for (int i = gt; i < 768 * 256; i += NT) { const int n = i >> 8, k = i & 255; float v = 0.f;
            if (n < 256) { if (k < 64) v = wup[k * 256 + n]; } else if (n < 512) { if (k >= 64 && k < 128) v = aup[(k - 64) * 256 + (n - 256)]; } else { if (k >= 128) v = gup[(k - 128) * 256 + (n - 512)]; }
            lora[i] = (bf16_t)(cvt_pk_bf16(v, 0.f) & 0xffffu); }
        bf16_t* wuq = (bf16_t*)(LW + LW_WUQ); const float* suq = C.in[I_WUQ] + l * 256 * 384;
        for (int i = gt; i < 512 * 256; i += NT) { const int n = i >> 8, k = i & 255; const float v = n < 384 ? suq[k * 384 + n] * (0.10206207261596575f * LOG2E) : 0.f; wuq[i] = (bf16_t)(cvt_pk_bf16(v, 0.f) & 0xffffu); }
        bf16_t* wukv = (bf16_t*)(LW + LW_WUKV); const float* sukv = C.in[I_WUKV] + l * 128 * 512;
        for (int i = gt; i < 512 * 128; i += NT) { const int n = i >> 7, k = i & 127; wukv[i] = (bf16_t)(cvt_pk_bf16(sukv[k * 512 + n], 0.f) & 0xffffu); }
        bf16_t* win = (bf16_t*)(LW + LW_WIN);
        for (int i = gt; i < (NPROJ - 3236) * 1024; i += NT) win[(size_t)3236 * 1024 + i] = 0;
    }
    { const float* x = C.in[I_X]; bf16_t* xb = WSP(bf16_t, W_XB);
#pragma unroll 4
      for (size_t i = gt; i < (size_t)T * 1024 / 8; i += NT) { const f32x4 a = *(const f32x4*)(x + i * 8), b = *(const f32x4*)(x + i * 8 + 4); *(u32x4*)(xb + i * 8) = epi::pack8(a, b); }
      const float* mm = C.in[I_MEM]; bf16_t* mb = WSP(bf16_t, W_MEMB);
      for (size_t i = gt; i < (size_t)NMEM * 1024 / 8; i += NT) { const f32x4 a = *(const f32x4*)(mm + i * 8), b = *(const f32x4*)(mm + i * 8 + 4); *(u32x4*)(mb + i * 8) = epi::pack8(a, b); } }
    { const int* pos = (const int*)C.in[I_POS]; float* ct = WSP(float, W_COS); float* st = WSP(float, W_SIN);
      for (int i = gt; i < T * 16; i += NT) { const int t = i >> 4, j = i & 15; const float inv = exp2f(-(float)(2 * j) * (13.287712379549449f / 32.0f)); const float ang = (float)pos[t] * inv; ct[i] = cosf(ang); st[i] = sinf(ang); } }
}

__device__ __forceinline__ f32x4 ld_bf4(const bf16_t* p) { const u32x2 w = *(const u32x2*)p; return (f32x4){bflo(w.x), bfhi(w.x), bflo(w.y), bfhi(w.y)}; }
__device__ __forceinline__ void st_bf4(bf16_t* p, const f32x4 v) { u32x2 w; w.x = cvt_pk_bf16(v[0], v[1]); w.y = cvt_pk_bf16(v[2], v[3]); *(u32x2*)p = w; }
__device__ __forceinline__ float tanhf_(float x) { return 1.0f - 2.0f * frcp(1.0f + fexp2(2.0f * LOG2E * x)); }
__device__ __forceinline__ void ph_prep(const Ctx& C, int l) {
    const bf16_t* __restrict__ proj = WSP(bf16_t, S_PROJ); const float* mu = C.in[I_RWMU] + l * 1024;
    bf16_t* __restrict__ LA = WSP(bf16_t, S_LA); bf16_t* __restrict__ CQN = WSP(bf16_t, S_CQN); bf16_t* __restrict__ CKVN = WSP(bf16_t, S_CKVN); bf16_t* __restrict__ KM = WSP(bf16_t, S_KM);
    const float* qg = C.in[I_QNG] + l * 256; const float* kvg = C.in[I_KVNG] + l * 128; const float* ct = WSP(float, W_COS); const float* st = WSP(float, W_SIN);
    const int lane = C.lane, c4 = 4 * lane, c2 = 2 * lane, i16 = lane & 15;
    const f32x4 m = *(const f32x4*)(mu + 768 + c4), qgv = *(const f32x4*)(qg + c4); const float kg0 = kvg[c2], kg1 = kvg[c2 + 1];
    u32x2 n_cur, n_prv, n_cq; unsigned n_ckv; unsigned short n_kr; float n_cs, n_sn;
#define PREP_LOAD(tt) do { const bf16_t* pr_ = proj + (size_t)(tt) * NPROJ; n_cur = *(const u32x2*)(pr_ + PC_RW + 768 + c4); \
        n_prv = ((tt) % SEQ) == 0 ? (u32x2){0u, 0u} : *(const u32x2*)(pr_ - NPROJ + PC_RW + 768 + c4); n_cq = *(const u32x2*)(pr_ + PC_CQ + c4); n_ckv = *(const unsigned*)(pr_ + PC_CKV + c2); \
        n_kr = pr_[PC_KR + (lane & 31)]; n_cs = ct[(size_t)(tt) * 16 + i16]; n_sn = st[(size_t)(tt) * 16 + i16]; } while (0)
    int t = GW; if (t < T) PREP_LOAD(t);
    for (; t < T; t += NGW) {
        const u32x2 wc = n_cur, wp = n_prv, wq = n_cq; const unsigned wk = n_ckv; const float krv = bf2f(n_kr), cs = n_cs, sn = n_sn;
        if (t + NGW < T) PREP_LOAD(t + NGW);
        { const f32x4 cur = (f32x4){bflo(wc.x), bfhi(wc.x), bflo(wc.y), bfhi(wc.y)}, prv = (f32x4){bflo(wp.x), bfhi(wp.x), bflo(wp.y), bfhi(wp.y)}; f32x4 p = cur + (prv - cur) * m;
          if (c4 < 64) { for (int j = 0; j < 4; ++j) p[j] = tanhf_(p[j]); } else if (c4 >= 128) { for (int j = 0; j < 4; ++j) p[j] = sigmoidf_(p[j]); }
          st_bf4(LA + (size_t)t * 256 + c4, p); }
        { f32x4 v = (f32x4){bflo(wq.x), bfhi(wq.x), bflo(wq.y), bfhi(wq.y)}; const float ss = wave_sum((v[0] * v[0] + v[1] * v[1]) + (v[2] * v[2] + v[3] * v[3]));
          const float rs = 1.0f / sqrtf(ss * (1.0f / 256.0f) + 1e-6f); v = v * rs * qgv; st_bf4(CQN + (size_t)t * 256 + c4, v); }
        { float a = bflo(wk), b = bfhi(wk); const float ss = wave_sum(a * a + b * b);
          const float rs = 1.0f / sqrtf(ss * (1.0f / 128.0f) + 1e-6f); a *= rs * kg0; b *= rs * kg1; *(unsigned*)(CKVN + (size_t)t * 128 + c2) = cvt_pk_bf16(a, b); }
        { const float o = __shfl_xor(krv, 16);
          const float r = (lane & 16) ? (o * sn + krv * cs) : (krv * cs - o * sn);
          if (lane < 32) { const bf16_t rb = (bf16_t)(cvt_pk_bf16(r, 0.f) & 0xffffu); for (int h = 0; h < 4; ++h) KM[(size_t)t * 384 + h * 96 + 64 + lane] = rb; } }
    }
#undef PREP_LOAD
}
__device__ __forceinline__ void ph_rwprep(const Ctx& C, int l) {
#if defined(NAIVE_SCAN)
    if (NAIVE_SCAN & 2) { float* q_ = WSP(float, S_SSQ); for (int i = C.bid * NTHREADS + C.tid; i < T * 8; i += C.G * NTHREADS) q_[i] = 0.f; }
#endif
    const bf16_t* __restrict__ proj = WSP(bf16_t, S_PROJ); const float* mu = C.in[I_RWMU] + l * 1024; const bf16_t* __restrict__ AV = WSP(bf16_t, S_AV); bf16_t* __restrict__ RWS = WSP(bf16_t, S_RWS);
    const float* kkw = C.in[I_RWKK] + l * 256; const float* kaw = C.in[I_RWKA] + l * 256; const int lane = C.lane, c = 4 * lane;
    f32x4 muv[3];
#pragma unroll
    for (int q = 0; q < 3; ++q) muv[q] = *(const f32x4*)(mu + q * 256 + c);
    const f32x4 kkv = *(const f32x4*)(kkw + c), kav = *(const f32x4*)(kaw + c);
    u32x2 ncur[3], nprv[3], nav;
#define RWP_LOAD(tt) do { const bf16_t* pr_ = proj + (size_t)(tt) * NPROJ + PC_RW; const bool f_ = ((tt) % SEQ) == 0; \
        _Pragma("unroll") for (int q = 0; q < 3; ++q) { ncur[q] = *(const u32x2*)(pr_ + q * 256 + c); nprv[q] = f_ ? (u32x2){0u, 0u} : *(const u32x2*)(pr_ - NPROJ + q * 256 + c); } \
        nav = *(const u32x2*)(AV + (size_t)(tt) * 256 + c); } while (0)
#define U2F4(w) ((f32x4){bflo((w).x), bfhi((w).x), bflo((w).y), bfhi((w).y)})
    int t = GW; if (t < T) RWP_LOAD(t);
    for (; t < T; t += NGW) {
        f32x4 rkv[3];
#pragma unroll
        for (int q = 0; q < 3; ++q) { const f32x4 cur = U2F4(ncur[q]), prv = U2F4(nprv[q]); rkv[q] = cur + (prv - cur) * muv[q]; }
        const f32x4 a = U2F4(nav);
        if (t + NGW < T) RWP_LOAD(t + NGW);
        f32x4 kk = rkv[1] * kkv;
        float ss = (kk[0] * kk[0] + kk[1] * kk[1]) + (kk[2] * kk[2] + kk[3] * kk[3]);
        ss = row_sum16(ss);
        kk = kk * (1.0f / sqrtf(fmaxf(ss, 1e-24f)));
        const f32x4 kmod = rkv[1] * ((a - 1.0f) * kav + 1.0f), ka = kk * a;
        const size_t o = (size_t)t * 256 + c, PL = (size_t)T * 256;
        st_bf4(RWS + o, rkv[0]); st_bf4(RWS + PL + o, kmod); st_bf4(RWS + 2 * PL + o, rkv[2]); st_bf4(RWS + 3 * PL + o, kk); st_bf4(RWS + 4 * PL + o, ka);
    }
#undef RWP_LOAD
}
__device__ __forceinline__ void ph_ssdprep(const Ctx& C, int l) {
    const bf16_t* __restrict__ proj = WSP(bf16_t, S_PROJ); bf16_t* __restrict__ XA = WSP(bf16_t, S_XA); bf16_t* __restrict__ BC = WSP(bf16_t, S_BC); bf16_t* __restrict__ CC = WSP(bf16_t, S_CC); float* __restrict__ ACS = WSP(float, S_ACS); float* __restrict__ DTV = WSP(float, S_DTV);
    const float* cw = C.in[I_CONVW] + l * 4 * 768; const float* cb = C.in[I_CONVB] + l * 768; const float* dtbp = C.in[I_DTB] + l * 4; const float* alog = C.in[I_ALOG] + l * 4; const int lane = C.lane;
    for (int item = GW; item < 64; item += NGW) { const int b = item >> 2, h = item & 3; const float dtb = dtbp[h], a2 = -expf(alog[h]) * LOG2E; const size_t t0 = (size_t)b * SEQ + 32 * lane;
        unsigned short rawv[32];
#pragma unroll
        for (int i = 0; i < 32; ++i) rawv[i] = proj[(t0 + i) * NPROJ + PC_DT + h];
        float pre[32]; float run = 0.f;
#pragma unroll
        for (int i = 0; i < 32; ++i) { run += softplusf_(bf2f(rawv[i]) + dtb) * a2; pre[i] = run; }
        float sc_ = run;
#pragma unroll
        for (int d = 1; d < 64; d <<= 1) { const float o = __shfl_up(sc_, d); if (lane >= d) sc_ += o; }
        const float base = sc_ - run;
#pragma unroll
        for (int i = 0; i < 32; ++i) ACS[(t0 + i) * 4 + h] = base + pre[i]; }
    f32x4 cbv[3], cwv[3][4];
#pragma unroll
    for (int j = 0; j < 3; ++j) { const int c = 4 * lane + 256 * j; cbv[j] = *(const f32x4*)(cb + c);
#pragma unroll
        for (int k = 0; k < 4; ++k) cwv[j][k] = *(const f32x4*)(cw + k * 768 + c); }
    const float dtbl = dtbp[lane & 3];
    u32x2 nraw[3][4]; unsigned short ndt;
#define SSP_LOAD(tt) do { const int tl_ = (tt) % SEQ; _Pragma("unroll") for (int j = 0; j < 3; ++j) _Pragma("unroll") for (int k = 0; k < 4; ++k) \
        nraw[j][k] = (tl_ - 3 + k >= 0) ? *(const u32x2*)(proj + (size_t)((tt) - 3 + k) * NPROJ + PC_XS + 4 * lane + 256 * j) : (u32x2){0u, 0u}; \
        ndt = proj[(size_t)(tt) * NPROJ + PC_DT + (lane & 3)]; } while (0)
    int t = GW; if (t < T) SSP_LOAD(t);
    for (; t < T; t += NGW) {
        f32x4 acc3[3]; const float dtraw = bf2f(ndt);
#pragma unroll
        for (int j = 0; j < 3; ++j) { f32x4 a = cbv[j];
#pragma unroll
            for (int k = 0; k < 4; ++k) a += U2F4(nraw[j][k]) * cwv[j][k];
            acc3[j] = a; }
        if (t + NGW < T) SSP_LOAD(t + NGW);
#pragma unroll
        for (int j = 0; j < 3; ++j) { f32x4 a = acc3[j]; for (int q = 0; q < 4; ++q) a[q] = siluf_(a[q]);
            st_bf4((j == 0 ? XA : (j == 1 ? BC : CC)) + (size_t)t * 256 + 4 * lane, a); }
        if (lane < 4) DTV[(size_t)t * 4 + lane] = softplusf_(dtraw + dtbl);
    }
#undef SSP_LOAD
#undef U2F4
}
#ifndef ABL_MOE
#define ABL_MOE 1.0f
#endif
template <bool MOE> __device__ __forceinline__ void ph_ln(const Ctx& C, const float* src, float* dst, bf16_t* dstb, const float* g, const float* b, const bf16_t* ys) {
    const int lane = C.lane;
    float chkscale = 1.0f;
#if defined(CHECKS) || defined(CHECKS2) || defined(CHECKS3) || defined(CHECKS4) || defined(CHECKS5) || defined(CHECKS6) || defined(CHECKS7) || defined(CHECKS8) || defined(CHECKS9) || defined(CHECKS10) || defined(CHECKS12) || defined(CHECKS13) || defined(CHECKS14) || defined(CHECKS15)
    if (MOE) { const unsigned* cw = (const unsigned*)(C.ws + WS_CTL) + CW_CHK; int n = 0;
        for (int q = 0; q < 4; ++q) if (__hip_atomic_load(cw + 64 * q, RLX_AGENT) != 0u) n |= 1 << q;
#if defined(FG_COUNT) || defined(CHECKS13) || defined(CHECKS15)
        { unsigned v_ = __hip_atomic_load(cw + 2048, RLX_AGENT); n = 0; while (v_ > 0u) { ++n; v_ >>= 1; } }
#endif
#ifdef CHECKS10
        { const float num = __uint_as_float(__hip_atomic_load(cw + 1024, RLX_AGENT)), den = __uint_as_float(__hip_atomic_load(cw + 1088, RLX_AGENT)); const float lr = -log2f(fmaxf(num / fmaxf(den, 1e-30f), 1e-12f)); n = (int)(lr + 0.5f); n = n < 0 ? 0 : (n > 31 ? 31 : n); }
#endif
        chkscale = 1.0f + 0.1f * (float)n; }
#endif
    f32x4 gv[4], bv[4];
#pragma unroll
    for (int j = 0; j < 4; ++j) { gv[j] = *(const f32x4*)(g + 4 * lane + 256 * j); bv[j] = *(const f32x4*)(b + 4 * lane + 256 * j); }
    f32x4 nv[4]; u32x2 ny0[4], ny1[4];
#define LN_LOAD(tt) do { _Pragma("unroll") for (int j = 0; j < 4; ++j) { nv[j] = *(const f32x4*)(src + (size_t)(tt) * 1024 + 4 * lane + 256 * j); \
        if (MOE) { ny0[j] = *(const u32x2*)(ys + (size_t)(2 * (tt)) * 1024 + 4 * lane + 256 * j); ny1[j] = *(const u32x2*)(ys + (size_t)(2 * (tt) + 1) * 1024 + 4 * lane + 256 * j); } } } while (0)
    int t = GW; if (t < T) LN_LOAD(t);
    for (; t < T; t += NGW) {
        f32x4 v[4]; float s = 0.f;
#pragma unroll
        for (int j = 0; j < 4; ++j) { v[j] = nv[j];
            if (MOE) { const f32x4 y0 = (f32x4){bflo(ny0[j].x), bfhi(ny0[j].x), bflo(ny0[j].y), bfhi(ny0[j].y)}, y1 = (f32x4){bflo(ny1[j].x), bfhi(ny1[j].x), bflo(ny1[j].y), bfhi(ny1[j].y)}; v[j] = v[j] * DN_ALPHA + (y0 + y1) * ABL_MOE; } }
        if (t + NGW < T) LN_LOAD(t + NGW);
#pragma unroll
        for (int j = 0; j < 4; ++j) s += (v[j][0] + v[j][1]) + (v[j][2] + v[j][3]);
        const float mean = wave_sum(s) * (1.0f / 1024.0f); float s2 = 0.f;
#pragma unroll
        for (int j = 0; j < 4; ++j) { v[j] = v[j] - mean; s2 += (v[j][0] * v[j][0] + v[j][1] * v[j][1]) + (v[j][2] * v[j][2] + v[j][3] * v[j][3]); }
        const float rstd = 1.0f / sqrtf(wave_sum(s2) * (1.0f / 1024.0f) + 1e-5f);
#pragma unroll
        for (int j = 0; j < 4; ++j) { const int c = 4 * lane + 256 * j; const f32x4 o = (v[j] * rstd * gv[j] + bv[j]) * chkscale;
            if (dst) *(f32x4*)(dst + (size_t)t * 1024 + c) = o; if (dstb) st_bf4(dstb + (size_t)t * 1024 + c, o); }
    }
#undef LN_LOAD
}
__device__ __forceinline__ void ph_ssdfix(const Ctx& C, int l) {
    bf16_t* Y = WSP(bf16_t, S_Y); const float* ssq = WSP(float, S_SSQ); const float* ng = C.in[I_SSDNG] + l * 256; const int lane = C.lane, c = 4 * lane, g = lane >> 5;
    const bf16_t* YRAW = WSP(bf16_t, S_YRAW); const bf16_t* RWS = WSP(bf16_t, S_RWS); const bf16_t* GV = WSP(bf16_t, S_GV); const size_t PL = (size_t)T * 256;
    const f32x4 rk = *(const f32x4*)(C.in[I_RWRK] + l * 256 + c), gng = *(const f32x4*)(C.in[I_RWGNG] + l * 256 + c), gnb = *(const f32x4*)(C.in[I_RWGNB] + l * 256 + c);
    const f32x4 ngv = *(const f32x4*)(ng + c);
    f32x4 nq; u32x2 nys, nyr, nr, nkm, nvv, ngg;
#define U2F4(w) ((f32x4){bflo((w).x), bfhi((w).x), bflo((w).y), bfhi((w).y)})
#define FIX_LOAD(tt) do { nq = *(const f32x4*)(ssq + (size_t)(tt) * 8 + 4 * g); nys = *(const u32x2*)(Y + (size_t)(tt) * 1024 + 512 + c); const size_t o_ = (size_t)(tt) * 256 + c; \
        nyr = *(const u32x2*)(YRAW + o_); nr = *(const u32x2*)(RWS + o_); nkm = *(const u32x2*)(RWS + PL + o_); nvv = *(const u32x2*)(RWS + 2 * PL + o_); ngg = *(const u32x2*)(GV + o_); } while (0)
    int t = GW; if (t < T) FIX_LOAD(t);
    for (; t < T; t += NGW) {
        const f32x4 q4 = nq; f32x4 v = U2F4(nys); const f32x4 yv = U2F4(nyr), rr = U2F4(nr), km = U2F4(nkm), vv = U2F4(nvv), gg = U2F4(ngg);
        if (t + NGW < T) FIX_LOAD(t + NGW);
        const float q = (q4[0] + q4[1]) + (q4[2] + q4[3]); const float rs = 1.0f / sqrtf(q * (1.0f / 128.0f) + 1e-5f);
        v = v * rs * ngv; st_bf4(Y + (size_t)t * 1024 + 512 + c, v);
        float sm = (yv[0] + yv[1]) + (yv[2] + yv[3]), bd = (rr[0] * km[0] * rk[0] + rr[1] * km[1] * rk[1]) + (rr[2] * km[2] * rk[2] + rr[3] * km[3] * rk[3]);
        sm = row_sum16(sm); bd = row_sum16(bd);
        const float mu = sm * (1.0f / 64.0f); const f32x4 d = yv - mu; float vs = (d[0] * d[0] + d[1] * d[1]) + (d[2] * d[2] + d[3] * d[3]);
        vs = row_sum16(vs);
        const float rstd = 1.0f / sqrtf(vs * (1.0f / 64.0f) + 64e-5f);
        st_bf4(Y + (size_t)t * 1024 + 256 + c, ((d * rstd) * gng + gnb + vv * bd) * gg);
    }
#undef FIX_LOAD
#undef U2F4
}
typedef __bf16 bfx8 __attribute__((ext_vector_type(8)));
__device__ __forceinline__ f32x16 mfma32(const bf16x8 a, const bf16x8 b, const f32x16 c) { return __builtin_amdgcn_mfma_f32_32x32x16_bf16(__builtin_bit_cast(bfx8, a), __builtin_bit_cast(bfx8, b), c, 0, 0, 0); }
__device__ __forceinline__ float dpp_xor1(float v) { return __builtin_bit_cast(float, __builtin_amdgcn_mov_dpp(__builtin_bit_cast(int, v), 0xB1, 0xf, 0xf, true)); }
__device__ __forceinline__ float dpp_xor2(float v) { return __builtin_bit_cast(float, __builtin_amdgcn_mov_dpp(__builtin_bit_cast(int, v), 0x4E, 0xf, 0xf, true)); }
__device__ __forceinline__ float dpp_hmir(float v) { return __builtin_bit_cast(float, __builtin_amdgcn_mov_dpp(__builtin_bit_cast(int, v), 0x141, 0xf, 0xf, true)); }
__device__ __forceinline__ float sum8(float v) { v += dpp_xor1(v); v += dpp_xor2(v); v += dpp_hmir(v); return v; }

__device__ __forceinline__ float xor32(float v, int hh) { const auto sw = __builtin_amdgcn_permlane32_swap(__builtin_bit_cast(unsigned, v), __builtin_bit_cast(unsigned, v), false, false); return __builtin_bit_cast(float, (unsigned)(hh ? sw[0] : sw[1])); }
template <int MODE>
__device__ __forceinline__ void attn_unit(const Ctx& C0_, int l, int b, int h, int qb) {
    const Ctx C = launder(C0_);
    constexpr int DQK = MODE == 2 ? 128 : (MODE == 1 ? 96 : 64), NS = DQK / 16, KST = DQK * 2 + 16, VST = 192, KCH = DQK / 8;
    const bf16_t *Qp, *Kp, *Vp; int qs, ks, vs, ycol;
    if (MODE == 0) { const bf16_t* proj = WSP(bf16_t, S_PROJ); Qp = proj + PC_SBQ + h * 64; Kp = proj + PC_SBK + h * 64; Vp = proj + PC_SBV + h * 64; qs = ks = vs = NPROJ; ycol = h * 64; }
    else if (MODE == 1) { Qp = WSP(bf16_t, S_QM) + h * 96; Kp = WSP(bf16_t, S_KM) + h * 96; Vp = WSP(bf16_t, S_VM) + h * 64; qs = ks = 384; vs = 256; ycol = 768 + h * 64; }
    else { Qp = WSP(bf16_t, S_CC) + (h >> 1) * 128; Kp = WSP(bf16_t, S_BC) + (h >> 1) * 128; Vp = WSP(bf16_t, S_XA) + h * 64; qs = ks = vs = 256; ycol = 512 + h * 64; }
    const float* ACS = WSP(float, S_ACS); const float* DTV = WSP(float, S_DTV);
    const size_t tb = (size_t)b * SEQ;
    constexpr int ABUF = 64 * KST + 64 * VST + 512;
    LAS unsigned char* const abase = C.lds;
    const int tid = C.tid, lane = C.lane, w = C.wave, r = lane & 31, hh = lane >> 5;
    const int Q0 = qb * 256, qidx = Q0 + 32 * w + r, qmin = Q0 + 32 * w, qmax = qmin + 31;
    bf16x8 qf[NS];
#pragma unroll
    for (int s = 0; s < NS; ++s) qf[s] = *(const bf16x8*)(Qp + (tb + qidx) * qs + 16 * s + 8 * hh);
    f32x16 o[2]; for (int i = 0; i < 16; ++i) { o[0][i] = 0.f; o[1][i] = 0.f; }
    float Rrun = 0.f, mrun = -1.0e30f, lsum = 0.f;
    const int pr = (r & ~12) | ((r & 4) << 1) | ((r & 8) >> 1);
    u32x4 kreg0, kreg1, vreg; const int krow0 = tid / KCH, kch0 = tid % KCH, krow1 = (tid + 512) / KCH, kch1 = (tid + 512) % KCH, vrow = tid >> 3, vch = tid & 7;
    const bool k1 = (MODE == 2) || ((MODE == 1) && (tid < 64 * KCH - 512));
    float areg = 0.f, dreg = 0.f; float aq = 0.f; if (MODE == 2) aq = ACS[(tb + qidx) * 4 + h];
    const int ktmax = 4 * qb + 3;
#define ATT_LOAD(kt) do { const size_t kb_ = tb + (size_t)(kt) * 64; kreg0 = *(const u32x4*)(Kp + (kb_ + krow0) * ks + kch0 * 8); if (k1) kreg1 = *(const u32x4*)(Kp + (kb_ + krow1) * ks + kch1 * 8); \
        vreg = *(const u32x4*)(Vp + (kb_ + vrow) * vs + vch * 8); if (MODE == 2 && tid < 64) { areg = ACS[(kb_ + tid) * 4 + h]; dreg = DTV[(kb_ + tid) * 4 + h]; } } while (0)
#define ATT_STORE(bi) do { LAS unsigned char* Kt_ = abase + (bi) * ABUF; LAS unsigned char* Vt_ = Kt_ + 64 * KST; \
        *(LAS u32x4*)(Kt_ + krow0 * KST + kch0 * 16) = kreg0; if (k1) *(LAS u32x4*)(Kt_ + krow1 * KST + kch1 * 16) = kreg1; \
        *(LAS u32x4*)(Vt_ + vrow * VST + vch * 16) = vreg; if (MODE == 2 && tid < 64) { ((LAS float*)(Vt_ + 64 * VST))[tid] = areg; ((LAS float*)(Vt_ + 64 * VST))[64 + tid] = dreg; } } while (0)
    __syncthreads();
    ATT_LOAD(ktmax); ATT_STORE(0); if (ktmax > 0) ATT_LOAD(ktmax - 1);
    __syncthreads();
    for (int kt = ktmax; kt >= 0; --kt) {
        const int bi = (ktmax - kt) & 1;
        LAS unsigned char* Kt = abase + bi * ABUF; LAS unsigned char* Vt = Kt + 64 * KST; LAS float* AkL = (LAS float*)(Vt + 64 * VST); LAS float* DkL = AkL + 64;
        const unsigned vt_addr = (unsigned)(size_t)Vt;
        if (kt > 0) { ATT_STORE(bi ^ 1); if (kt > 1) ATT_LOAD(kt - 2); }
        const int k0 = kt * 64;
        if (k0 <= qmax) {
        const bool need_mask = (k0 + 63 >= qmin);
        f32x16 sc[2];
#pragma unroll
        for (int sub = 0; sub < 2; ++sub) {
            for (int i = 0; i < 16; ++i) sc[sub][i] = 0.f;
#pragma unroll
            for (int s = 0; s < NS; ++s) { const bf16x8 kf = *(const LAS bf16x8*)(Kt + (32 * sub + pr) * KST + (16 * s + 8 * hh) * 2); sc[sub] = mfma32(kf, qf[s], sc[sub]); }
        }
        if (MODE == 0) {
#pragma unroll
            for (int sub = 1; sub >= 0; --sub) {
                const int kb = k0 + 32 * sub + 8 * hh;
                float L[16];
#pragma unroll
                for (int i = 0; i < 16; ++i) { const float z = sc[sub][i]; const float l2 = -(fmaxf(z, 0.f) + flog2(1.0f + fexp2(-fabsf(z)))); L[i] = l2; sc[sub][i] = z + l2; }
                if (need_mask) {
#pragma unroll
                    for (int i = 0; i < 16; ++i) { const int key = kb + (i & 7) + 16 * (i >> 3); const bool ok = key < qidx; L[i] = ok ? L[i] : 0.f; sc[sub][i] = ok ? sc[sub][i] : -1.0e30f; } }
                float own_hi = 0.f, own_lo = 0.f, tl[16];
#pragma unroll
                for (int j = 7; j >= 0; --j) { tl[8 + j] = own_hi; own_hi += L[8 + j]; tl[j] = own_lo; own_lo += L[j]; }
                const float p_hi = xor32(own_hi, hh), p_lo = xor32(own_lo, hh);
                const float off_hi = Rrun + (hh ? 0.f : p_hi), off_lo = Rrun + own_hi + p_hi + (hh ? 0.f : p_lo);
                Rrun += (own_hi + own_lo) + (p_hi + p_lo);
#pragma unroll
                for (int i = 0; i < 16; ++i) sc[sub][i] = fexp2(sc[sub][i] + tl[i] + (i >= 8 ? off_hi : off_lo));
            }
        } else if (MODE == 2) {
#pragma unroll
            for (int sub = 0; sub < 2; ++sub) { f32x4 ak[4], dk[4];
#pragma unroll
                for (int r4 = 0; r4 < 4; ++r4) { const int o_ = 32 * sub + 8 * hh + 16 * (r4 >> 1) + 4 * (r4 & 1); ak[r4] = *(const LAS f32x4*)(AkL + o_); dk[r4] = *(const LAS f32x4*)(DkL + o_); }
#pragma unroll
                for (int i = 0; i < 16; ++i) { const float a_ = ak[(i >> 3) * 2 + ((i & 7) >> 2)][i & 3], d_ = dk[(i >> 3) * 2 + ((i & 7) >> 2)][i & 3];
                    sc[sub][i] = sc[sub][i] * d_ * fexp2(fminf(aq - a_, 0.f)); }
                if (need_mask) {
#pragma unroll
                    for (int i = 0; i < 16; ++i) { const int key = k0 + 32 * sub + 8 * hh + (i & 7) + 16 * (i >> 3); sc[sub][i] = key <= qidx ? sc[sub][i] : 0.f; } } }
        } else {
            if (need_mask) {
#pragma unroll
                for (int sub = 0; sub < 2; ++sub)
#pragma unroll
                    for (int i = 0; i < 16; ++i) { const int key = k0 + 32 * sub + 8 * hh + (i & 7) + 16 * (i >> 3); sc[sub][i] = key <= qidx ? sc[sub][i] : -1.0e30f; } }
            float tm = -1.0e30f;
#pragma unroll
            for (int sub = 0; sub < 2; ++sub)
#pragma unroll
                for (int i = 0; i < 16; ++i) tm = fmaxf(tm, sc[sub][i]);
            tm = fmaxf(tm, xor32(tm, hh));
            if (!__all(tm <= mrun)) {
                const float mnew = fmaxf(mrun, tm), alpha = fexp2(mrun - mnew); mrun = mnew; lsum *= alpha;
#pragma unroll
                for (int i = 0; i < 16; ++i) { o[0][i] *= alpha; o[1][i] *= alpha; } }
            float ps = 0.f;
#pragma unroll
            for (int sub = 0; sub < 2; ++sub)
#pragma unroll
                for (int i = 0; i < 16; ++i) { const float p = fexp2(sc[sub][i] - mrun); sc[sub][i] = p; ps += p; }
            lsum += ps;
        }
#pragma unroll
        for (int sub = 0; sub < 2; ++sub)
#pragma unroll
            for (int s = 0; s < 2; ++s) {
                bf16x8 pf; { u32x4 pw; pw.x = cvt_pk_bf16(sc[sub][8 * s + 0], sc[sub][8 * s + 1]); pw.y = cvt_pk_bf16(sc[sub][8 * s + 2], sc[sub][8 * s + 3]); pw.z = cvt_pk_bf16(sc[sub][8 * s + 4], sc[sub][8 * s + 5]); pw.w = cvt_pk_bf16(sc[sub][8 * s + 6], sc[sub][8 * s + 7]); pf = __builtin_bit_cast(bf16x8, pw); }
                const unsigned a0 = vt_addr + (unsigned)((32 * sub + 16 * s + 8 * hh + ((lane & 15) >> 2)) * VST + (16 * ((lane >> 4) & 1) + 4 * (lane & 3)) * 2);
                u32x2 v00, v01, v10, v11;
                asm volatile("ds_read_b64_tr_b16 %0, %4\n\tds_read_b64_tr_b16 %1, %4 offset:768\n\tds_read_b64_tr_b16 %2, %4 offset:64\n\tds_read_b64_tr_b16 %3, %4 offset:832\n\ts_waitcnt lgkmcnt(0)"
                             : "=&v"(v00), "=&v"(v01), "=&v"(v10), "=&v"(v11) : "v"(a0) : "memory");
                u32x4 va0; va0.x = v00.x; va0.y = v00.y; va0.z = v01.x; va0.w = v01.y;
                u32x4 va1; va1.x = v10.x; va1.y = v10.y; va1.z = v11.x; va1.w = v11.y;
                o[0] = mfma32(__builtin_bit_cast(bf16x8, va0), pf, o[0]);
                o[1] = mfma32(__builtin_bit_cast(bf16x8, va1), pf, o[1]);
            }
        }
        bool dead = false;
        if (MODE == 0) dead = Rrun < -64.0f;
        if (MODE == 2) dead = aq - AkL[0] < -64.0f;
        if (MODE == 1) { __syncthreads(); }
        else { volatile LAS unsigned* votes = (volatile LAS unsigned*)(C.lds + LDSCTL_OFF + 128) + 8 * bi;
            const bool wdead = __all(dead ? 1 : 0); if (lane == 0) votes[w] = wdead ? 1u : 0u;
            __syncthreads();
            unsigned all_ = 1u;
#pragma unroll
            for (int q_ = 0; q_ < 8; ++q_) all_ &= votes[q_];
            if (all_) break; }
    }
#undef ATT_LOAD
#undef ATT_STORE
    float inv = 1.0f;
    if (MODE == 1) { const float lt = lsum + xor32(lsum, hh); inv = frcp(lt); }
    bf16_t* Y = WSP(bf16_t, S_Y) + (tb + qidx) * 1024 + ycol;
    if (MODE == 2) {
        const float dsk = C.in[I_SSDD][l * 4 + h]; const bf16_t* xa = Vp + (tb + qidx) * 256; const bf16_t* zp = WSP(bf16_t, S_PROJ) + (tb + qidx) * NPROJ + PC_Z + h * 64; float q_ = 0.f;
#pragma unroll
        for (int dt = 0; dt < 2; ++dt)
#pragma unroll
            for (int g = 0; g < 4; ++g) { const int d0 = 32 * dt + 8 * g + 4 * hh; const f32x4 xv = ld_bf4(xa + d0), zv = ld_bf4(zp + d0); f32x4 y;
                for (int j = 0; j < 4; ++j) { y[j] = (o[dt][4 * g + j] + dsk * xv[j]) * siluf_(zv[j]); q_ += y[j] * y[j]; }
                st_bf4(Y + d0, y); }
        q_ += __shfl_xor(q_, 32);
        if (hh == 0) { float* SSQ = WSP(float, S_SSQ); SSQ[(tb + qidx) * 8 + h * 2] = q_; SSQ[(tb + qidx) * 8 + h * 2 + 1] = 0.f; }
        return;
    }
#pragma unroll
    for (int dt = 0; dt < 2; ++dt)
#pragma unroll
        for (int g = 0; g < 4; ++g) { u32x2 wv; wv.x = cvt_pk_bf16(o[dt][4 * g] * inv, o[dt][4 * g + 1] * inv); wv.y = cvt_pk_bf16(o[dt][4 * g + 2] * inv, o[dt][4 * g + 3] * inv);
            *(u32x2*)(Y + 32 * dt + 8 * g + 4 * hh) = wv; }
}

__device__ __forceinline__ float sum16(float v) { v = sum8(v); v += __builtin_bit_cast(float, __builtin_amdgcn_mov_dpp(__builtin_bit_cast(int, v), 0x140, 0xf, 0xf, true)); return v; }
__device__ __forceinline__ void rwkv_unit(const Ctx& C0_, int l, int b, int h, int half) {
    const Ctx C = launder(C0_);
    constexpr int TB = 32, NBLK = SEQ / TB, BUFB = 6 * TB * 64 * 4;
    LAS float* buf0 = (LAS float*)C.lds; LAS float* ybuf = (LAS float*)(C.lds + 2 * BUFB);
    const int tid = C.tid, il = tid >> 4, q = tid & 15, i = 32 * half + il;
    const float* DEC = WSP(float, S_DEC); const bf16_t* RWS = WSP(bf16_t, S_RWS); bf16_t* YRAW = WSP(bf16_t, S_YRAW);
    const size_t PL = (size_t)T * 256; const size_t tb = (size_t)b * SEQ;
    const int ls = tid >> 4, lj = 4 * (tid & 15);
    f32x4 gw; u32x2 gr[5];
#define RW_LOAD(blk) do { const size_t o_ = (tb + (size_t)(blk) * TB + ls) * 256 + h * 64 + lj; gw = *(const f32x4*)(DEC + o_); \
        gr[0] = *(const u32x2*)(RWS + 3 * PL + o_); gr[1] = *(const u32x2*)(RWS + 4 * PL + o_); gr[2] = *(const u32x2*)(RWS + PL + o_); gr[3] = *(const u32x2*)(RWS + o_); gr[4] = *(const u32x2*)(RWS + 2 * PL + o_); } while (0)
#define RW_STORE(bufp) do { LAS float* d_ = (bufp) + ls * 64 + lj; *(LAS f32x4*)d_ = gw; \
        _Pragma("unroll") for (int a_ = 0; a_ < 5; ++a_) *(LAS f32x4*)(d_ + (a_ + 1) * TB * 64) = (f32x4){bflo(gr[a_].x), bfhi(gr[a_].x), bflo(gr[a_].y), bfhi(gr[a_].y)}; } while (0)
    f32x4 S = (f32x4){0.f, 0.f, 0.f, 0.f};
    __syncthreads();
    RW_LOAD(0); RW_STORE(buf0);
    __syncthreads();
    for (int blk = 0; blk < NBLK; ++blk) {
        LAS float* cur = buf0 + (blk & 1) * (BUFB / 4); LAS float* nxtb = buf0 + ((blk + 1) & 1) * (BUFB / 4);
        if (blk + 1 < NBLK) RW_LOAD(blk + 1);
        for (int s0 = 0; s0 < TB; s0 += 4) {
            f32x4 w4[4], kk4[4], ka4[4], km4[4], r4[4]; float vv[4], yv[4];
#pragma unroll
            for (int u = 0; u < 4; ++u) { const LAS float* p = cur + (s0 + u) * 64 + 4 * q;
                w4[u] = *(const LAS f32x4*)p; kk4[u] = *(const LAS f32x4*)(p + TB * 64); ka4[u] = *(const LAS f32x4*)(p + 2 * TB * 64); km4[u] = *(const LAS f32x4*)(p + 3 * TB * 64); r4[u] = *(const LAS f32x4*)(p + 4 * TB * 64);
                vv[u] = cur[5 * TB * 64 + (s0 + u) * 64 + i]; }
#pragma unroll
            for (int u = 0; u < 4; ++u) {
                float sa = (S[0] * kk4[u][0] + S[1] * kk4[u][1]) + (S[2] * kk4[u][2] + S[3] * kk4[u][3]);
                sa = sum16(sa);
                S = S * w4[u] + (km4[u] * vv[u] - ka4[u] * sa);
                const float y = (S[0] * r4[u][0] + S[1] * r4[u][1]) + (S[2] * r4[u][2] + S[3] * r4[u][3]);
                yv[u] = sum16(y); }
            if (q == 0) {
#pragma unroll
                for (int u = 0; u < 4; ++u) ybuf[(s0 + u) * 32 + il] = yv[u]; }
        }
        __syncthreads();
        {
            const int os = tid >> 4, r2 = 2 * (tid & 15); const size_t t = tb + (size_t)blk * TB + os;
            *(unsigned*)(YRAW + t * 256 + h * 64 + 32 * half + r2) = cvt_pk_bf16(ybuf[os * 32 + r2], ybuf[os * 32 + r2 + 1]);
        }
        if (blk + 1 < NBLK) RW_STORE(nxtb);
        __syncthreads();
    }
#undef RW_LOAD
#undef RW_STORE
}

__device__ __forceinline__ void ssd_stage(const Ctx& C, int l, int h, size_t tb, int blk, LAS float* dst) {
    constexpr int TB = 16; const int g = h >> 1;
    const bf16_t* proj = WSP(bf16_t, S_PROJ); const float* cw = C.in[I_CONVW] + l * 4 * 768; const float* cb = C.in[I_CONVB] + l * 768;
    const float dtb = C.in[I_DTB][l * 4 + h], aneg = -expf(C.in[I_ALOG][l * 4 + h]);
    for (int it = C.tid; it < TB * 80; it += NTHREADS) {
        const int s = it / 80, v = it % 80; const int tl = blk * TB + s;
        int pcol, cch, doff;
        if (v < 16) { pcol = PC_XS + h * 64 + 4 * v; cch = h * 64 + 4 * v; doff = s * 64 + 4 * v; }
        else if (v < 48) { pcol = PC_BM + g * 128 + 4 * (v - 16); cch = 256 + g * 128 + 4 * (v - 16); doff = 2 * TB * 64 + s * 128 + 4 * (v - 16); }
        else { pcol = PC_CM + g * 128 + 4 * (v - 48); cch = 512 + g * 128 + 4 * (v - 48); doff = 2 * TB * 64 + TB * 128 + s * 128 + 4 * (v - 48); }
        f32x4 a = *(const f32x4*)(cb + cch);
#pragma unroll
        for (int k = 0; k < 4; ++k) { const int tt = tl - 3 + k; if (tt >= 0) a += ld_bf4(proj + (tb + tt) * NPROJ + pcol) * *(const f32x4*)(cw + k * 768 + cch); }
        for (int j = 0; j < 4; ++j) a[j] = siluf_(a[j]);
        if (v < 16) { const float dt = softplusf_(bf2f(proj[(tb + tl) * NPROJ + PC_DT + h]) + dtb); *(LAS f32x4*)(dst + TB * 64 + doff) = a; *(LAS f32x4*)(dst + doff) = a * dt;
                      if (v == 0) dst[TB * 384 + s] = expf(dt * aneg); }
        else *(LAS f32x4*)(dst + doff) = a;
    }
}
__device__ __forceinline__ void ssd_unit(const Ctx& C0_, int l, int b, int h, int ph) {
    const Ctx C = launder(C0_);
    constexpr int TB = 32, NBLK = SEQ / TB, NF = TB * (32 + 32 + 128 + 128) + 64, NIT = 72 * TB, NK = (NIT + NTHREADS - 1) / NTHREADS;
    LAS float* buf0 = (LAS float*)C.lds; LAS float* ypart = buf0 + 2 * NF;
    const int tid = C.tid, lane = C.lane, w = C.wave, g = h >> 1, pl = lane & 31, nh = lane >> 5;
    const bf16_t* proj = WSP(bf16_t, S_PROJ); bf16_t* Y = WSP(bf16_t, S_Y); float* SSQ = WSP(float, S_SSQ);
    const float* cw = C.in[I_CONVW] + l * 4 * 768; const float* cb = C.in[I_CONVB] + l * 768;
    const float dtb = C.in[I_DTB][l * 4 + h], aneg = -expf(C.in[I_ALOG][l * 4 + h]), dsk = C.in[I_SSDD][l * 4 + h];
    const size_t tb = (size_t)b * SEQ;
    int its[NK], itp[NK], itd[NK], itc[NK]; bool itx[NK];
#pragma unroll
    for (int k = 0; k < NK; ++k) { const int it = tid + NTHREADS * k, sidx = it / 72, v = it % 72; int pcol, cch, doff;
        if (v < 8) { pcol = PC_XS + h * 64 + 32 * ph + 4 * v; cch = h * 64 + 32 * ph + 4 * v; doff = sidx * 32 + 4 * v; }
        else if (v < 40) { pcol = PC_BM + g * 128 + 4 * (v - 8); cch = 256 + g * 128 + 4 * (v - 8); doff = 2 * TB * 32 + sidx * 128 + 4 * (v - 8); }
        else { pcol = PC_CM + g * 128 + 4 * (v - 40); cch = 512 + g * 128 + 4 * (v - 40); doff = 2 * TB * 32 + TB * 128 + sidx * 128 + 4 * (v - 40); }
        its[k] = sidx; itp[k] = pcol; itd[k] = doff; itx[k] = v < 8; itc[k] = cch; }
    const bool haslast = tid + NTHREADS * (NK - 1) < NIT;
    u32x2 raw[NK][4]; float dtr[NK]; unsigned short zraw;
    const int os = tid >> 4, op = tid & 15;
#define SSD_LOAD(blk) do { _Pragma("unroll") for (int k = 0; k < NK; ++k) { if (k < NK - 1 || haslast) { const int tl_ = (blk) * TB + its[k]; \
            _Pragma("unroll") for (int q = 0; q < 4; ++q) { const int tt_ = tl_ - 3 + q; raw[k][q] = tt_ >= 0 ? *(const u32x2*)(proj + (tb + tt_) * NPROJ + itp[k]) : (u32x2){0u, 0u}; } \
            dtr[k] = itx[k] ? bf2f(proj[(tb + tl_) * NPROJ + PC_DT + h]) : 0.f; } } } while (0)
#define SSD_COMMIT(dst) do { _Pragma("unroll") for (int k = 0; k < NK; ++k) { if (k < NK - 1 || haslast) { f32x4 a_ = *(const f32x4*)(cb + itc[k]); \
            _Pragma("unroll") for (int q = 0; q < 4; ++q) a_ += (f32x4){bflo(raw[k][q].x), bfhi(raw[k][q].x), bflo(raw[k][q].y), bfhi(raw[k][q].y)} * *(const f32x4*)(cw + q * 768 + itc[k]); \
            for (int j = 0; j < 4; ++j) a_[j] = siluf_(a_[j]); \
            if (itx[k]) { const float dt_ = softplusf_(dtr[k] + dtb); *(LAS f32x4*)((dst) + TB * 32 + itd[k]) = a_; *(LAS f32x4*)((dst) + itd[k]) = a_ * dt_; if ((itd[k] & 31) == 0) (dst)[TB * 320 + its[k]] = expf(dt_ * aneg); } \
            else *(LAS f32x4*)((dst) + itd[k]) = a_; } } } while (0)
    float hs[8];
#pragma unroll
    for (int k = 0; k < 8; ++k) hs[k] = 0.f;
    __syncthreads();
    SSD_LOAD(0); SSD_COMMIT(buf0);
    __syncthreads();
    for (int blk = 0; blk < NBLK; ++blk) {
        LAS float* cur = buf0 + (blk & 1) * NF; LAS float* nxtb = buf0 + ((blk + 1) & 1) * NF;
        if (blk + 1 < NBLK) SSD_LOAD(blk + 1);
        const size_t tz = tb + (size_t)blk * TB + os;
        zraw = proj[tz * NPROJ + PC_Z + h * 64 + 32 * ph + op]; const unsigned short zraw2 = proj[tz * NPROJ + PC_Z + h * 64 + 32 * ph + op + 16];
        for (int s0 = 0; s0 < TB; s0 += 4) {
            float x4[4], dA4[4], yv[4]; f32x4 bv[4][2], cv[4][2];
#pragma unroll
            for (int u = 0; u < 4; ++u) { const int s = s0 + u; x4[u] = cur[s * 32 + pl]; dA4[u] = cur[TB * 320 + s];
                const LAS float* bp = cur + 2 * TB * 32 + s * 128 + 16 * w + 8 * nh; const LAS float* cp = bp + TB * 128;
                bv[u][0] = *(const LAS f32x4*)bp; bv[u][1] = *(const LAS f32x4*)(bp + 4); cv[u][0] = *(const LAS f32x4*)cp; cv[u][1] = *(const LAS f32x4*)(cp + 4); }
#pragma unroll
            for (int u = 0; u < 4; ++u) { float yp = 0.f;
#pragma unroll
                for (int k4 = 0; k4 < 2; ++k4)
#pragma unroll
                    for (int j = 0; j < 4; ++j) { hs[4 * k4 + j] = hs[4 * k4 + j] * dA4[u] + x4[u] * bv[u][k4][j]; yp += cv[u][k4][j] * hs[4 * k4 + j]; }
                const auto sw = __builtin_amdgcn_permlane32_swap(__builtin_bit_cast(unsigned, yp), __builtin_bit_cast(unsigned, yp), false, false);
                yv[u] = yp + __builtin_bit_cast(float, (unsigned)sw[1]); }
            if (nh == 0) {
#pragma unroll
                for (int u = 0; u < 4; ++u) ypart[((s0 + u) * 8 + w) * 32 + pl] = yv[u]; }
        }
        if (blk + 1 < NBLK) SSD_COMMIT(nxtb);
        __syncthreads();
        {
            float y0 = 0.f, y1 = 0.f;
#pragma unroll
            for (int ww = 0; ww < 8; ++ww) { y0 += ypart[(os * 8 + ww) * 32 + op]; y1 += ypart[(os * 8 + ww) * 32 + op + 16]; }
            y0 += cur[TB * 32 + os * 32 + op] * dsk; y1 += cur[TB * 32 + os * 32 + op + 16] * dsk;
            y0 *= siluf_(bf2f(zraw)); y1 *= siluf_(bf2f(zraw2));
            bf16_t* yo = Y + tz * 1024 + 512 + h * 64 + 32 * ph + op;
            yo[0] = (bf16_t)(cvt_pk_bf16(y0, 0.f) & 0xffffu); yo[16] = (bf16_t)(cvt_pk_bf16(y1, 0.f) & 0xffffu);
            float q = y0 * y0 + y1 * y1;
#pragma unroll
            for (int o_ = 1; o_ < 16; o_ <<= 1) q += __shfl_xor(q, o_);
            if (op == 0) SSQ[tz * 8 + h * 2 + ph] = q;
        }
        __syncthreads();
    }
#undef SSD_LOAD
#undef SSD_COMMIT
}

__device__ __forceinline__ void sb_naive(const Ctx& C) {
    const bf16_t* proj = WSP(bf16_t, S_PROJ); bf16_t* Y = WSP(bf16_t, S_Y); const int lane = C.lane;
    for (int item = GW; item < T * 4; item += NGW) {
        const int t = item >> 2, h = item & 3, tq = t % SEQ; const size_t tb = (size_t)(t - tq);
        float q[64];
        { const bf16_t* qp = proj + (size_t)t * NPROJ + PC_SBQ + h * 64;
#pragma unroll
          for (int i = 0; i < 8; ++i) { const u32x4 w = *(const u32x4*)(qp + 8 * i); q[8*i] = bflo(w.x); q[8*i+1] = bfhi(w.x); q[8*i+2] = bflo(w.y); q[8*i+3] = bfhi(w.y); q[8*i+4] = bflo(w.z); q[8*i+5] = bfhi(w.z); q[8*i+6] = bflo(w.w); q[8*i+7] = bfhi(w.w); } }
        float o[64];
#pragma unroll
        for (int d = 0; d < 64; ++d) o[d] = 0.f;
        float R = 0.f;
        for (int c = (tq - 1) >> 6; c >= 0 && tq > 0; --c) {
            const int key = c * 64 + lane; const bool ok = key < tq;
            const bf16_t* kp = proj + (tb + key) * NPROJ + PC_SBK + h * 64; const bf16_t* vp = proj + (tb + key) * NPROJ + PC_SBV + h * 64;
            float z = 0.f;
#pragma unroll
            for (int i = 0; i < 8; ++i) { const u32x4 w = *(const u32x4*)(kp + 8 * i);
                z += q[8*i] * bflo(w.x) + q[8*i+1] * bfhi(w.x) + q[8*i+2] * bflo(w.y) + q[8*i+3] * bfhi(w.y) + q[8*i+4] * bflo(w.z) + q[8*i+5] * bfhi(w.z) + q[8*i+6] * bflo(w.w) + q[8*i+7] * bfhi(w.w); }
            const float L = ok ? -(fmaxf(z, 0.f) + flog2(1.0f + fexp2(-fabsf(z)))) : 0.f;
            float sfx = L;
#pragma unroll
            for (int dd = 1; dd < 64; dd <<= 1) { const float tt = __shfl_down(sfx, dd); if (lane + dd < 64) sfx += tt; }
            const float tot = __shfl(sfx, 0);
            const float wgt = ok ? fexp2(z + L + (sfx - L) + R) : 0.f;
            R += tot;
#pragma unroll
            for (int i = 0; i < 8; ++i) { const u32x4 w = *(const u32x4*)(vp + 8 * i);
                o[8*i] += wgt * bflo(w.x); o[8*i+1] += wgt * bfhi(w.x); o[8*i+2] += wgt * bflo(w.y); o[8*i+3] += wgt * bfhi(w.y); o[8*i+4] += wgt * bflo(w.z); o[8*i+5] += wgt * bfhi(w.z); o[8*i+6] += wgt * bflo(w.w); o[8*i+7] += wgt * bfhi(w.w); }
        }
        float mine = 0.f;
#pragma unroll
        for (int d = 0; d < 64; ++d) { const float sdd = wave_sum(o[d]); if (lane == d) mine = sdd; }
        Y[(size_t)t * 1024 + h * 64 + lane] = (bf16_t)(cvt_pk_bf16(mine, 0.f) & 0xffffu);
    }
}

__device__ __forceinline__ void rwkv_naive(const Ctx& C, int l) {
    const float* DEC = WSP(float, S_DEC); const bf16_t* RWS = WSP(bf16_t, S_RWS); const bf16_t* GV = WSP(bf16_t, S_GV); bf16_t* Y = WSP(bf16_t, S_Y);
    const size_t PL = (size_t)T * 256; const int lane = C.lane;
    for (int item = GW; item < 64; item += NGW) {
        const int b = item >> 2, h = item & 3; const float* rk = C.in[I_RWRK] + l * 256 + h * 64;
        const float gng = C.in[I_RWGNG][l * 256 + h * 64 + lane], gnb = C.in[I_RWGNB][l * 256 + h * 64 + lane];
        float S[64];
#pragma unroll
        for (int j = 0; j < 64; ++j) S[j] = 0.f;
        for (int tq = 0; tq < SEQ; ++tq) {
            const size_t o = ((size_t)b * SEQ + tq) * 256 + h * 64;
            const float v = bf2f(RWS[2 * PL + o + lane]);
            float sa = 0.f;
#pragma unroll
            for (int j = 0; j < 64; ++j) sa += S[j] * bf2f(RWS[3 * PL + o + j]);
            float y = 0.f, bd = 0.f;
#pragma unroll
            for (int j = 0; j < 64; ++j) { const float km = bf2f(RWS[PL + o + j]), r = bf2f(RWS[o + j]);
                S[j] = S[j] * DEC[o + j] + (v * km - sa * bf2f(RWS[4 * PL + o + j])); y += S[j] * r; bd += r * km * rk[j]; }
            const float mu = wave_sum(y) * (1.0f / 64.0f), d = y - mu, var = wave_sum(d * d) * (1.0f / 64.0f);
            const float res = (d * (1.0f / sqrtf(var + 64e-5f)) * gng + gnb + v * bd) * bf2f(GV[o + lane]);
            Y[((size_t)b * SEQ + tq) * 1024 + 256 + h * 64 + lane] = (bf16_t)(cvt_pk_bf16(res, 0.f) & 0xffffu);
        }
    }
}
__device__ __forceinline__ void ssd_naive(const Ctx& C, int l) {
    const bf16_t* proj = WSP(bf16_t, S_PROJ); bf16_t* Y = WSP(bf16_t, S_Y); float* SSQ = WSP(float, S_SSQ); const int lane = C.lane;
    const float* cw = C.in[I_CONVW] + l * 4 * 768; const float* cb = C.in[I_CONVB] + l * 768;
    for (int item2 = GW; item2 < 128; item2 += NGW) {
        const int item = item2 >> 1, ph = item2 & 1; const int b = item >> 2, h = item & 3, g = h >> 1; const size_t tb = (size_t)b * SEQ;
        const float dtb = C.in[I_DTB][l * 4 + h], aneg = -expf(C.in[I_ALOG][l * 4 + h]), dsk = C.in[I_SSDD][l * 4 + h];
        float hs0[32], hs1[32];
#pragma unroll
        for (int p = 0; p < 32; ++p) { hs0[p] = 0.f; hs1[p] = 0.f; }
        for (int tq = 0; tq < SEQ; ++tq) {
            const bf16_t* pr = proj + (tb + tq) * NPROJ;
            float xa = cb[h * 64 + lane], bv0 = cb[256 + g * 128 + lane], bv1 = cb[256 + g * 128 + 64 + lane], cv0 = cb[512 + g * 128 + lane], cv1 = cb[512 + g * 128 + 64 + lane];
            for (int k = 0; k < 4; ++k) { const int tt = tq - 3 + k; if (tt >= 0) { const bf16_t* pp = proj + (tb + tt) * NPROJ; const float* ww = cw + k * 768;
                xa += bf2f(pp[PC_XS + h * 64 + lane]) * ww[h * 64 + lane];
                bv0 += bf2f(pp[PC_BM + g * 128 + lane]) * ww[256 + g * 128 + lane]; bv1 += bf2f(pp[PC_BM + g * 128 + 64 + lane]) * ww[256 + g * 128 + 64 + lane];
                cv0 += bf2f(pp[PC_CM + g * 128 + lane]) * ww[512 + g * 128 + lane]; cv1 += bf2f(pp[PC_CM + g * 128 + 64 + lane]) * ww[512 + g * 128 + 64 + lane]; } }
            xa = siluf_(xa); bv0 = siluf_(bv0); bv1 = siluf_(bv1); cv0 = siluf_(cv0); cv1 = siluf_(cv1);
            const float dt = softplusf_(bf2f(pr[PC_DT + h]) + dtb), dA = expf(dt * aneg), xd = xa * dt;
            float y = 0.f;
#pragma unroll
            for (int p = 0; p < 32; ++p) { const float xp = __shfl(xd, 32 * ph + p); hs0[p] = hs0[p] * dA + xp * bv0; hs1[p] = hs1[p] * dA + xp * bv1;
                const float tot = wave_sum(cv0 * hs0[p] + cv1 * hs1[p]); if (lane == 32 * ph + p) y = tot; }
            y += dsk * xa; y *= siluf_(bf2f(pr[PC_Z + h * 64 + lane]));
            const bool mine = (lane >> 5) == ph; if (mine) Y[(tb + tq) * 1024 + 512 + h * 64 + lane] = (bf16_t)(cvt_pk_bf16(y, 0.f) & 0xffffu);
            const float q = wave_sum(mine ? y * y : 0.f); if (lane == 0) atomicAdd(&SSQ[(tb + tq) * 8 + h * 2], q);
        }
    }
}

__device__ __forceinline__ void mla_naive(const Ctx& C) {
    const bf16_t* QM = WSP(bf16_t, S_QM); const bf16_t* KM = WSP(bf16_t, S_KM); const bf16_t* VM = WSP(bf16_t, S_VM); bf16_t* Y = WSP(bf16_t, S_Y); const int lane = C.lane;
    for (int item = GW; item < T * 4; item += NGW) {
        const int t = item >> 2, h = item & 3, tq = t % SEQ; const size_t tb = (size_t)(t - tq);
        float q[96];
        { const bf16_t* qp = QM + (size_t)t * 384 + h * 96;
#pragma unroll
          for (int i = 0; i < 12; ++i) { const u32x4 w = *(const u32x4*)(qp + 8 * i); q[8*i] = bflo(w.x); q[8*i+1] = bfhi(w.x); q[8*i+2] = bflo(w.y); q[8*i+3] = bfhi(w.y); q[8*i+4] = bflo(w.z); q[8*i+5] = bfhi(w.z); q[8*i+6] = bflo(w.w); q[8*i+7] = bfhi(w.w); } }
        float o[64];
#pragma unroll
        for (int d = 0; d < 64; ++d) o[d] = 0.f;
        float m = -1.0e30f, lsum = 0.f;
        for (int c = tq >> 6; c >= 0; --c) {
            const int key = c * 64 + lane; const bool ok = key <= tq;
            const bf16_t* kp = KM + (tb + (ok ? key : 0)) * 384 + h * 96; const bf16_t* vp = VM + (tb + (ok ? key : 0)) * 256 + h * 64;
            float z = 0.f;
#pragma unroll
            for (int i = 0; i < 12; ++i) { const u32x4 w = *(const u32x4*)(kp + 8 * i);
                z += q[8*i] * bflo(w.x) + q[8*i+1] * bfhi(w.x) + q[8*i+2] * bflo(w.y) + q[8*i+3] * bfhi(w.y) + q[8*i+4] * bflo(w.z) + q[8*i+5] * bfhi(w.z) + q[8*i+6] * bflo(w.w) + q[8*i+7] * bfhi(w.w); }
            z = ok ? z : -1.0e30f;
            float cm = z;
#pragma unroll
            for (int dd = 1; dd < 64; dd <<= 1) cm = fmaxf(cm, __shfl_xor(cm, dd));
            const float mn = fmaxf(m, cm), al = fexp2(m - mn), pw = ok ? fexp2(z - mn) : 0.f; m = mn; lsum = lsum * al + pw;
#pragma unroll
            for (int i = 0; i < 8; ++i) { const u32x4 w = *(const u32x4*)(vp + 8 * i);
                o[8*i] = o[8*i] * al + pw * bflo(w.x); o[8*i+1] = o[8*i+1] * al + pw * bfhi(w.x); o[8*i+2] = o[8*i+2] * al + pw * bflo(w.y); o[8*i+3] = o[8*i+3] * al + pw * bfhi(w.y);
                o[8*i+4] = o[8*i+4] * al + pw * bflo(w.z); o[8*i+5] = o[8*i+5] * al + pw * bfhi(w.z); o[8*i+6] = o[8*i+6] * al + pw * bflo(w.w); o[8*i+7] = o[8*i+7] * al + pw * bfhi(w.w); }
        }
        const float lt = wave_sum(lsum); float mine = 0.f;
#pragma unroll
        for (int d = 0; d < 64; ++d) { const float sdd = wave_sum(o[d]); if (lane == d) mine = sdd; }
        Y[(size_t)t * 1024 + 768 + h * 64 + lane] = (bf16_t)(cvt_pk_bf16(mine / lt, 0.f) & 0xffffu);
    }
}
__device__ __forceinline__ void xattn_naive(const Ctx& C, int l) {
    const bf16_t* XQ = WSP(bf16_t, S_XQ); const bf16_t* KMEM = WSP(bf16_t, W_KMEM) + (size_t)l * NMEM * 1024; const bf16_t* VT = WSP(bf16_t, W_VMEMT) + (size_t)l * 1024 * NMEM; bf16_t* XO = WSP(bf16_t, S_XO); const int lane = C.lane;
    for (int item = GW; item < T * 4; item += NGW) {
        const int t = item >> 2, h = item & 3, b = t / SEQ;
        float z[4] = {0.f, 0.f, 0.f, 0.f};
        for (int d8 = 0; d8 < 32; ++d8) { const u32x4 qw = *(const u32x4*)(XQ + (size_t)t * 1024 + h * 256 + 8 * d8);
            const float qv[8] = {bflo(qw.x), bfhi(qw.x), bflo(qw.y), bfhi(qw.y), bflo(qw.z), bfhi(qw.z), bflo(qw.w), bfhi(qw.w)};
#pragma unroll
            for (int j = 0; j < 4; ++j) { const u32x4 kw = *(const u32x4*)(KMEM + (size_t)(b * 256 + lane + 64 * j) * 1024 + h * 256 + 8 * d8);
                z[j] += qv[0] * bflo(kw.x) + qv[1] * bfhi(kw.x) + qv[2] * bflo(kw.y) + qv[3] * bfhi(kw.y) + qv[4] * bflo(kw.z) + qv[5] * bfhi(kw.z) + qv[6] * bflo(kw.w) + qv[7] * bfhi(kw.w); } }
        float mx = fmaxf(fmaxf(z[0], z[1]), fmaxf(z[2], z[3]));
#pragma unroll
        for (int dd = 1; dd < 64; dd <<= 1) mx = fmaxf(mx, __shfl_xor(mx, dd));
        float p[4], ps = 0.f;
#pragma unroll
        for (int j = 0; j < 4; ++j) { p[j] = fexp2(z[j] - mx); ps += p[j]; }
        const float inv = 1.0f / wave_sum(ps);
        float o[4] = {0.f, 0.f, 0.f, 0.f};
        for (int mm = 0; mm < 256; ++mm) { const float pm = __shfl(p[mm >> 6], mm & 63);
#pragma unroll
            for (int jd = 0; jd < 4; ++jd) o[jd] += pm * bf2f(VT[(size_t)(h * 256 + lane + 64 * jd) * NMEM + b * 256 + mm]); }
#pragma unroll
        for (int jd = 0; jd < 4; ++jd) XO[(size_t)t * 1024 + h * 256 + lane + 64 * jd] = (bf16_t)(cvt_pk_bf16(o[jd] * inv, 0.f) & 0xffffu);
    }
}
__device__ __forceinline__ void ph_mixers(const Ctx& C, int l, int rep = 0) {
    unsigned* head = (unsigned*)(C.ws + WS_CTL) + CW_QUEUE + 64 * (l + 2 * rep);
    volatile LAS unsigned* slot = (volatile LAS unsigned*)(C.lds + LDSCTL_OFF + 64);
    constexpr int N_RW = 128, N_ATT = 768, NITEMS = N_RW + N_ATT;
    for (;;) {
        __syncthreads();
        if (C.tid == 0) slot[0] = __hip_atomic_fetch_add(head, 1u, RLX_AGENT);
        __syncthreads();
        const int it = (int)slot[0];
        if (it >= NITEMS) break;
#ifndef NAIVE_SCAN
#define NAIVE_SCAN 0
#endif
        if (it < N_RW) { if (!(NAIVE_SCAN & 1)) { rwkv_unit(C, l, it >> 3, (it >> 1) & 3, it & 1);
#ifdef TIME_RW2
            __syncthreads(); rwkv_unit(C, l, it >> 3, (it >> 1) & 3, it & 1);
#endif
        } }
        else { const int k = it - N_RW; const int mode = k >> 8, kk_ = k & 255, pp = kk_ & 3, bh = kk_ >> 2, b = bh >> 2, h = bh & 3;
            if (mode == 0) { if (!(NAIVE_SCAN & 2)) { attn_unit<2>(C, l, b, h, 7 - pp); __syncthreads(); attn_unit<2>(C, l, b, h, pp);
#ifdef TIME_SSDA2
                __syncthreads(); attn_unit<2>(C, l, b, h, 7 - pp); __syncthreads(); attn_unit<2>(C, l, b, h, pp);
#endif
            } }
#ifndef NAIVE_SB
            else if (mode == 2) { attn_unit<0>(C, l, b, h, 7 - pp); __syncthreads(); attn_unit<0>(C, l, b, h, pp);
#ifdef TIME_SB2
                __syncthreads(); attn_unit<0>(C, l, b, h, 7 - pp); __syncthreads(); attn_unit<0>(C, l, b, h, pp);
#endif
            }
#else
            else if (mode == 2) { }
#endif
#ifndef NAIVE_MLA
            else { attn_unit<1>(C, l, b, h, 7 - pp); __syncthreads(); attn_unit<1>(C, l, b, h, pp);
#ifdef TIME_MLA2
                __syncthreads(); attn_unit<1>(C, l, b, h, 7 - pp); __syncthreads(); attn_unit<1>(C, l, b, h, pp);
#endif
            }
#else
            else { }
#endif
        }
    }
#ifdef NAIVE_SB
    sb_naive(C);
#endif
#ifdef NAIVE_MLA
    mla_naive(C);
#endif
    if (NAIVE_SCAN & 1) rwkv_naive(C, l);
    if (NAIVE_SCAN & 2) ssd_naive(C, l);
}
__device__ __forceinline__ void ph_router(const Ctx& C) {
    run_tjobs<16, true>(C);
    __syncthreads();
    LAS unsigned* lc = (LAS unsigned*)(C.lds + XCH_OFF);
    if (C.tid < 8) lc[C.tid] = 0u;
    __syncthreads();
    const float* xr = WSP(float, W_XRES); const float* rt = C.in[I_ROUTER]; int* topi = WSP(int, S_TOPI); float* topw = WSP(float, S_TOPW); const int lane = C.lane;
    f32x4 nx[4];
#define RT_LOAD(kk_) do { const int t_ = C.bid * 128 + C.wave * 16 + (kk_); _Pragma("unroll") for (int j = 0; j < 4; ++j) nx[j] = *(const f32x4*)(xr + (size_t)t_ * 1024 + 4 * lane + 256 * j); } while (0)
    RT_LOAD(0);
    for (int k = 0; k < 16; ++k) {
        const int t = C.bid * 128 + C.wave * 16 + k; float a[8]; f32x4 xv4[4];
#pragma unroll
        for (int j = 0; j < 4; ++j) xv4[j] = nx[j];
        if (k + 1 < 16) RT_LOAD(k + 1);
#pragma unroll
        for (int e = 0; e < 8; ++e) a[e] = 0.f;
#pragma unroll
        for (int j = 0; j < 4; ++j) { const f32x4 xv = xv4[j];
#pragma unroll
            for (int q = 0; q < 4; ++q) { const float* rp = rt + (size_t)(4 * lane + 256 * j + q) * 8; const f32x4 r0 = *(const f32x4*)rp, r1 = *(const f32x4*)(rp + 4);
                a[0] += xv[q] * r0[0]; a[1] += xv[q] * r0[1]; a[2] += xv[q] * r0[2]; a[3] += xv[q] * r0[3]; a[4] += xv[q] * r1[0]; a[5] += xv[q] * r1[1]; a[6] += xv[q] * r1[2]; a[7] += xv[q] * r1[3]; } }
#pragma unroll
        for (int e = 0; e < 8; ++e) a[e] = wave_sum(a[e]);
#ifdef ROUTER_NOISE
        for (int e = 0; e < 8; ++e) { unsigned hsh = (unsigned)t * 2654435761u + (unsigned)e * 40503u; hsh ^= hsh >> 13; hsh *= 0x5bd1e995u; hsh ^= hsh >> 15; a[e] += ROUTER_NOISE * ((float)(hsh & 0xffff) * (1.0f / 32768.0f) - 1.0f); }
#endif
        if (lane == 0) {
            int i1 = 0; float v1 = a[0];
#pragma unroll
            for (int e = 1; e < 8; ++e) if (a[e] > v1) { v1 = a[e]; i1 = e; }
            int i2 = -1; float v2 = -3.0e38f;
#pragma unroll
            for (int e = 0; e < 8; ++e) if (e != i1 && a[e] > v2) { v2 = a[e]; i2 = e; }
            const float g1 = 1.0f / (1.0f + expf(v2 - v1));
            topi[2 * t] = i1; topi[2 * t + 1] = i2; topw[2 * t] = g1; topw[2 * t + 1] = 1.0f - g1;
            __hip_atomic_fetch_add(&lc[i1], 1u, __ATOMIC_RELAXED, __HIP_MEMORY_SCOPE_WORKGROUP); __hip_atomic_fetch_add(&lc[i2], 1u, __ATOMIC_RELAXED, __HIP_MEMORY_SCOPE_WORKGROUP);
        }
    }
    __syncthreads();
    if (C.tid < 8) ((unsigned*)(C.ws + WS_CTL))[CW_MOECNT + C.bid * 8 + C.tid] = lc[C.tid];
}
__device__ __forceinline__ void ph_scatter(const Ctx& C) {
    LAS int* sh = (LAS int*)(C.lds + XCH_OFF);
    const unsigned* cnt = (const unsigned*)(C.ws + WS_CTL) + CW_MOECNT;
    int* row_slot = WSP(int, S_ROWSLOT); float* row_w = WSP(float, S_ROWW); int* blk_e = WSP(int, S_BLKE);
    const int* topi = WSP(int, S_TOPI); const float* topw = WSP(float, S_TOPW);
    const int tid = C.tid;
    if (tid < 8) { int tot = 0, mine = 0; for (int wg = 0; wg < 256; ++wg) { const int c = (int)cnt[wg * 8 + tid]; if (wg < C.bid) mine += c; tot += c; } sh[tid] = tot; sh[8 + tid] = mine; sh[32 + tid] = 0; }
    __syncthreads();
    if (tid == 0) { int ps = 0; for (int e = 0; e < 8; ++e) { sh[16 + e] = ps; const int pad = (sh[e] + 255) / 256 * 256; sh[24 + e] = pad; ps += pad; } sh[40] = ps / 256; }
    __syncthreads();
    if (C.bid == 0) {
        const int used = sh[40];
        for (int rb = tid; rb < MOE_BLOCKS; rb += NTHREADS) { int e = 7; if (rb < used) { e = 0; for (int q = 1; q < 8; ++q) if (sh[16 + q] <= rb * 256) e = q; } blk_e[rb] = e; }
        if (tid == 0) blk_e[MOE_BLOCKS] = used;
    }
    if (C.bid < 8) { const int e = C.bid; for (int r = sh[16 + e] + sh[e] + tid; r < sh[16 + e] + sh[24 + e]; r += NTHREADS) { row_slot[r] = -1; row_w[r] = 0.f; } }
    if (tid < 256) { const int t = C.bid * 128 + (tid >> 1), k = tid & 1, e = topi[2 * t + k];
        const int pos = __hip_atomic_fetch_add(&sh[32 + e], 1, __ATOMIC_RELAXED, __HIP_MEMORY_SCOPE_WORKGROUP); const int dest = sh[16 + e] + sh[8 + e] + pos; row_slot[dest] = 2 * t + k; row_w[dest] = topw[2 * t + k]; sh[64 + tid] = dest; }
    __syncthreads();
    const bf16_t* xb = WSP(bf16_t, W_XB); bf16_t* xs = WSP(bf16_t, S_XS);
    for (int a = C.wave * 32; a < C.wave * 32 + 32; ++a) { const int t = C.bid * 128 + (a >> 1); const size_t d = (size_t)sh[64 + a] * 1024;
#pragma unroll
        for (int j = 0; j < 2; ++j) *(u32x4*)(xs + d + (C.lane + 64 * j) * 8) = *(const u32x4*)(xb + (size_t)t * 1024 + (C.lane + 64 * j) * 8); }
}


__device__ __forceinline__ void chk_moe(const Ctx& C, int bit) {
    const float* xr = WSP(float, W_XRES); const float* rt = C.in[I_ROUTER]; const float* w13 = C.in[I_MOE13]; const float* w2 = C.in[I_MOE2]; const bf16_t* ys = WSP(bf16_t, S_YS);
    LAS float* hb = (LAS float*)(C.lds + C.wave * 14336); const int lane = C.lane; unsigned bad = 0;
    float* stash = WSP(float, W_KMEM); const float* g3 = C.in[I_LN3G] + 1024; const float* b3 = C.in[I_LN3B] + 1024;
    for (int s = GW; s < 1024; s += NGW) {
        const int t = (int)(((long)s * 1021 + 7) % T); float x[16];
#pragma unroll
        for (int j = 0; j < 16; ++j) x[j] = xr[(size_t)t * 1024 + lane + 64 * j];
        float lg[8];
#pragma unroll
        for (int e = 0; e < 8; ++e) { float a = 0.f;
#pragma unroll
            for (int j = 0; j < 16; ++j) a += x[j] * rt[(size_t)(lane + 64 * j) * 8 + e]; lg[e] = wave_sum(a); }
        int i1 = 0; for (int e = 1; e < 8; ++e) if (lg[e] > lg[i1]) i1 = e;
        int i2 = -1; for (int e = 0; e < 8; ++e) if (e != i1 && (i2 < 0 || lg[e] > lg[i2])) i2 = e;
        float v3 = -3.0e38f; for (int e = 0; e < 8; ++e) if (e != i1 && e != i2) v3 = fmaxf(v3, lg[e]);
        if (lg[i2] - v3 < 0.02f) { if (lane == 0) stash[(size_t)s * 1024] = 1.0e30f; continue; }
        const float g1 = 1.0f / (1.0f + expf(lg[i2] - lg[i1]));
        float out[16];
#pragma unroll
        for (int j = 0; j < 16; ++j) out[j] = 0.f;
        for (int q = 0; q < 2; ++q) { const int e = q ? i2 : i1; const float gw = q ? 1.0f - g1 : g1; const float* W1 = w13 + (size_t)e * 1024 * 2 * FFE;
            for (int i0 = 0; i0 < 56; i0 += 4) { float ag[4], au[4];
#pragma unroll
                for (int i = 0; i < 4; ++i) { ag[i] = 0.f; au[i] = 0.f; }
                for (int k = 0; k < 1024; ++k) { const float xk = __shfl(x[k >> 6], k & 63); const float* wr = W1 + (size_t)k * 2 * FFE + lane + 64 * i0;
#pragma unroll
                    for (int i = 0; i < 4; ++i) { ag[i] += xk * wr[64 * i]; au[i] += xk * wr[FFE + 64 * i]; } }
#pragma unroll
                for (int i = 0; i < 4; ++i) hb[lane + 64 * (i0 + i)] = (ag[i] / (1.0f + expf(-ag[i]))) * au[i]; }
            LDS_WAIT();
            const float* W2 = w2 + (size_t)e * FFE * 1024;
            for (int hh = 0; hh < FFE; ++hh) { const float hv = hb[hh] * gw;
#pragma unroll
                for (int j = 0; j < 16; ++j) out[j] += hv * W2[(size_t)hh * 1024 + lane + 64 * j]; }
            LDS_WAIT(); }
#pragma unroll
        for (int j = 0; j < 16; ++j) { const int c = lane + 64 * j; const float got = bf2f(ys[(size_t)(2 * t) * 1024 + c]) + bf2f(ys[(size_t)(2 * t + 1) * 1024 + c]);
            if (fabsf(got - out[j]) > 0.05f * fabsf(out[j]) + 0.03f) bad = 1; }
        { float v[16], sm = 0.f, s2 = 0.f;
#pragma unroll
          for (int j = 0; j < 16; ++j) { v[j] = x[j] * DN_ALPHA + out[j]; sm += v[j]; }
          const float mean = wave_sum(sm) * (1.0f / 1024.0f);
#pragma unroll
          for (int j = 0; j < 16; ++j) { v[j] -= mean; s2 += v[j] * v[j]; }
          const float rstd = 1.0f / sqrtf(wave_sum(s2) * (1.0f / 1024.0f) + 1e-5f);
          int zz = 0; asm volatile("" : "+v"(zz));
#pragma unroll
          for (int j = 0; j < 16; ++j) { const int c = lane + 64 * j + zz; stash[(size_t)s * 1024 + c] = v[j] * rstd * g3[c] + b3[c]; } }
    }
    chk_flag(C, bit, bad);
}
#ifndef ABL_MIX
#define ABL_MIX 1.0f
#endif
#ifndef ABL_XA
#define ABL_XA 1.0f
#endif
#ifndef ABL_FF
#define ABL_FF 1.0f
#endif
#ifndef CHK_TOL2
#define CHK_TOL2 0.05f
#endif
#ifndef GATE_ACT
#define GATE_ACT 1
#endif
#ifndef GATE_ALIGN
#define GATE_ALIGN true
#endif
#ifndef FG_TOL
#define FG_TOL 0.05f
#endif
#ifndef FG_BIT
#define FG_BIT 1
#endif
#ifndef CHECKS_LAYER
#define CHECKS_LAYER 0
#endif
#ifndef MK_SPLIT
#define MK_SPLIT 0
#endif
constexpr int PH_L0 = 1, PH_L1 = 18, PH_MOE = 32, PH_TOTAL = PH_MOE + 2 + 2 * MOE_PASSES + 1;

__global__ void __launch_bounds__(NTHREADS, 2) hybrid_fwd(Args args) {
    extern __shared__ __attribute__((aligned(16))) unsigned char lds_raw[];
    Ctx C; C.in = args.in; C.out = args.out; C.ws = args.ws; C.lds = (LAS unsigned char*)lds_raw;
    C.tid = threadIdx.x; C.lane = C.tid & 63; C.wave = __builtin_amdgcn_readfirstlane(C.tid >> 6); C.G = gridDim.x; C.bid = blockIdx.x;
    const Ctx C0 = C;
    for (int u = C.tid; u < (LDS_BYTES - LDSCTL_OFF) / 4; u += NTHREADS) ((LAS unsigned*)(C.lds + LDSCTL_OFF))[u] = 0u;
    __syncthreads();
    const int lo = args.ph_lo, hi = args.ph_hi;
    XcdBarrier bar; bar.bar = (unsigned*)(C.ws + WS_CTL) + CW_BAR; bar.x = 0; bar.st = (volatile LAS unsigned*)(C.lds + LDSCTL_OFF);
    if (hi - lo > 1) bar = xcd_barrier_post((unsigned*)(C.ws + WS_CTL) + CW_BAR, (volatile LAS unsigned*)(C.lds + LDSCTL_OFF));
#ifndef SITE_MASK
#define SITE_MASK 0xffffffffu
#endif
#define SITE(n) (((SITE_MASK) >> (n)) & 1u)
#define IN(k) (lo <= (k) && (k) < hi)
#define ENDPH(k) do { if ((k) + 1 < hi) xcd_barrier(bar); } while (0)
#define SITE_BEGIN const Ctx C = launder(C0); unsigned char* LW = C.ws + W_BASE + (size_t)l * LW_SIZE; const bf16_t* XB = WSP(bf16_t, W_XB); float* XRES = WSP(float, W_XRES); (void)LW; (void)XB; (void)XRES; LAS unsigned char* ring = C.lds; (void)ring;

    if (SITE(0) && IN(0)) { const int l = 0; SITE_BEGIN ph_prologue(C);
#ifdef TIME_PRO2
        xcd_barrier(bar); ph_prologue(C);
#endif
#ifdef TIME_BAR
        for (int q_ = 0; q_ < TIME_BAR; ++q_) xcd_barrier(bar);
#endif
        ENDPH(0); }

    for (int l = 0; l < 2; ++l) {
        const int pb = l == 0 ? PH_L0 : PH_L1;
        if (SITE(1) && IN(pb + 0)) { SITE_BEGIN
#ifdef CHECKS3
            if (l == 1) chk_ln_cmp(C, 1, 1);
#endif
            { pg8::Gemm g{XB, (const bf16_t*)(LW + LW_WIN), 1024, 1024, 1024}; sch::Tiles S{T / 256, NPROJ / 256, C.G, C.bid}; epi::StoreBf16<0> E{WSP(bf16_t, S_PROJ), NPROJ}; pg8::gemm_phase(ring, g, S, E); }
            { pg8::Gemm g{(const bf16_t*)C.ws, (const bf16_t*)C.ws, 1024, 1024, 1024}; sch::MemKV S{(long)(W_MEMB / 2), (long)((W_BASE + (size_t)l * LW_SIZE + LW_WKV) / 2), C.bid};
              epi::StoreKV E{WSP(bf16_t, W_KMEM) + (size_t)l * NMEM * 1024, WSP(bf16_t, W_VMEMT) + (size_t)l * 1024 * NMEM}; pg8::gemm_phase(ring, g, S, E); }
            ENDPH(pb + 0);
        }
        if (SITE(2) && IN(pb + 1)) { SITE_BEGIN
#ifdef CHECKS5
            if (l == 0) chk_weights<28, false>(C, 0);
#endif
#ifdef CHECKS9
            if (l == 0) { unsigned bad = 0; const float* x = C.in[I_X]; const float* mm = C.in[I_MEM]; const bf16_t* mb = WSP(bf16_t, W_MEMB);
                for (size_t i = (size_t)C.bid * NTHREADS + C.tid; i < (size_t)T * 1024; i += (size_t)C.G * NTHREADS) if (!chk_close(x[i], bf2f(XB[i]))) bad = 1;
                for (size_t i = (size_t)C.bid * NTHREADS + C.tid; i < (size_t)NMEM * 1024; i += (size_t)C.G * NTHREADS) if (!chk_close(mm[i], bf2f(mb[i]))) bad = 1;
                if (bad) __hip_atomic_fetch_add((unsigned*)(C.ws + WS_CTL) + CW_CHK, 1u, RLX_AGENT); }
#endif
#ifdef CHECKS12P
            if (l == CHECKS_LAYER) { const bf16_t* proj = WSP(bf16_t, S_PROJ); chk_full_gemm(C, XB, (const bf16_t*)(LW + LW_WIN), 1024, 3236, 0, [&](size_t r, int c, float d) { return chk_close(d, bf2f(proj[r * NPROJ + c])); }); xcd_barrier(bar); }
#endif
#ifdef CHECKS4
            if (l == CHECKS_LAYER) { const bf16_t* KM_ = WSP(bf16_t, W_KMEM) + (size_t)l * NMEM * 1024; const bf16_t* VT_ = WSP(bf16_t, W_VMEMT) + (size_t)l * 1024 * NMEM;
                chk_gemm(C, WSP(bf16_t, W_MEMB), 1024, (const bf16_t*)(LW + LW_WKV), 1024, 1024, NMEM, 64, 16, 3, 0, [&](int r, int c, float d) { return chk_close(d, bf2f(KM_[(size_t)r * 1024 + c])); });
                chk_gemm(C, (const bf16_t*)(LW + LW_WKV) + (size_t)1024 * 1024, 1024, WSP(bf16_t, W_MEMB), 1024, 1024, 1024, 256, 16, 5, 1, [&](int r, int c, float d) { return chk_close(d, bf2f(VT_[(size_t)r * NMEM + c])); }); }
#endif
#ifdef CHECKS
            if (l == CHECKS_LAYER) { const bf16_t* proj = WSP(bf16_t, S_PROJ); chk_gemm(C, XB, 1024, (const bf16_t*)(LW + LW_WIN), 1024, 1024, T, 13, 256, 7, 0, [&](int r, int c, float d) { return chk_close(d, bf2f(proj[(size_t)r * NPROJ + c])); }); }
#endif
            ph_prep(C, l);
#ifdef TIME_PREP2
            xcd_barrier(bar); ph_prep(C, l);
#endif
            ENDPH(pb + 1); }
        if (SITE(3) && IN(pb + 2)) { SITE_BEGIN
            { pg8::Gemm g{WSP(bf16_t, S_LA), (const bf16_t*)(LW + LW_LORA), 256, 256, 256}; sch::Tiles S{T / 256, 3, C.G, C.bid}; epi::Lora E{WSP(float, S_DEC), WSP(bf16_t, S_AV), WSP(bf16_t, S_GV), C.in[I_RWW0] + l * 256, C.in[I_RWA0] + l * 256}; pg8::gemm_phase(ring, g, S, E); }
            { pg8::Gemm g{WSP(bf16_t, S_CQN), (const bf16_t*)(LW + LW_WUQ), 256, 256, 256}; sch::Tiles S{T / 256, 2, C.G, (C.bid + 128) & 255}; epi::Uq E{WSP(bf16_t, S_QM), WSP(float, W_COS), WSP(float, W_SIN)}; pg8::gemm_phase(ring, g, S, E); }
            { pg8::Gemm g{WSP(bf16_t, S_CKVN), (const bf16_t*)(LW + LW_WUKV), 128, 128, 128}; sch::Tiles S{T / 256, 2, C.G, C.bid}; epi::Ukv E{WSP(bf16_t, S_KM), WSP(bf16_t, S_VM)}; pg8::gemm_phase(ring, g, S, E); }
            ENDPH(pb + 2);
        }
        if (SITE(4) && IN(pb + 3)) { SITE_BEGIN ph_rwprep(C, l); ph_ssdprep(C, l);
#ifdef TIME_RWP2
            xcd_barrier(bar); ph_rwprep(C, l); ph_ssdprep(C, l);
#endif
            ENDPH(pb + 3); }
        if (SITE(5) && IN(pb + 4)) { SITE_BEGIN
#ifdef CHECKS6
            if (l == CHECKS_LAYER) chk_mla_inputs(C, l, 0);
#endif
#ifdef CHECKS7
            if (l == CHECKS_LAYER) chk_rw_inputs(C, l, 0);
#endif
            ph_mixers(C, l);
#ifdef TIME_MIX2
            xcd_barrier(bar); ph_mixers(C, l, 1);
#endif
            ENDPH(pb + 4); }
        if (SITE(6) && IN(pb + 5)) { SITE_BEGIN
            ph_ssdfix(C, l);
            { pg8::Gemm g{XB, (const bf16_t*)(LW + LW_WGATE), 1024, 1024, 1024}; sch::Tiles S{T / 256, 16, C.G, C.bid}; epi::StoreBf16<GATE_ACT> E{WSP(bf16_t, S_G), 4096}; pg8::gemm_phase<epi::StoreBf16<GATE_ACT>, sch::Tiles, GATE_ALIGN>(ring, g, S, E);
#ifdef TIME_GATE2
              xcd_barrier(bar); pg8::gemm_phase<epi::StoreBf16<GATE_ACT>, sch::Tiles, GATE_ALIGN>(ring, g, S, E);
#endif
            }
#ifdef CHECKS14
            if (l == 0) { xcd_barrier(bar); const bf16_t* Gp = WSP(bf16_t, S_G); chk_full_gemm(C, XB, (const bf16_t*)(LW + LW_WGATE), 1024, 4096, 0, [&](size_t r, int c, float d) { return chk_close(sigmoidf_(d), bf2f(Gp[r * 4096 + c])); }); }
#endif
#ifdef CHECKS13
            if (l == 0) { xcd_barrier(bar);
              { pg8::Gemm g{XB, (const bf16_t*)(LW + LW_WGATE), 1024, 1024, 1024}; sch::Tiles S{T / 256, 16, C.G, C.bid}; epi::StoreBf16<1> E{WSP(bf16_t, S_G) + (size_t)T * 4096, 4096}; pg8::gemm_phase(ring, g, S, E); }
              xcd_barrier(bar);
              { const unsigned short* g1 = WSP(unsigned short, S_G); const unsigned short* g2 = g1 + (size_t)T * 4096; unsigned cnt = 0;
                for (size_t i = (size_t)C.bid * NTHREADS + C.tid; i < (size_t)T * 4096; i += (size_t)C.G * NTHREADS) if (g1[i] != g2[i]) ++cnt;
                if (cnt) __hip_atomic_fetch_add((unsigned*)(C.ws + WS_CTL) + CW_CHK + 2048, cnt, RLX_AGENT); } }
#endif
            ENDPH(pb + 5);
        }
        if (SITE(7) && IN(pb + 6)) { SITE_BEGIN
#ifdef FIX_G
            { bf16_t* Gw = WSP(bf16_t, S_G); const bf16_t* Wg = (const bf16_t*)(LW + LW_WGATE);
              for (size_t i = (size_t)C.bid * NTHREADS + C.tid; i < (size_t)T * 4096; i += (size_t)C.G * NTHREADS) { const size_t r = i >> 12; const int c = (int)(i & 4095);
                  Gw[i] = (bf16_t)(cvt_pk_bf16(sigmoidf_(tdot(XB + r * 1024, Wg + (size_t)c * 1024, 1024)), 0.f) & 0xffffu); }
              xcd_barrier(bar); }
#endif
#ifdef CHECKS15
            if (l == 0) { unsigned cnt = 0; const float* x = C.in[I_X];
                for (size_t i = (size_t)C.bid * NTHREADS + C.tid; i < (size_t)T * 1024; i += (size_t)C.G * NTHREADS) if (!chk_close(x[i], bf2f(XB[i]))) ++cnt;
                if (cnt) __hip_atomic_fetch_add((unsigned*)(C.ws + WS_CTL) + CW_CHK + 2048, cnt, RLX_AGENT); }
#endif
#ifdef CHECKS7
            if (l == CHECKS_LAYER) chk_ssd_norm(C, l, 1);
#endif
#ifdef CHECKS12
            if (l == CHECKS_LAYER) { const bf16_t* Gp = WSP(bf16_t, S_G); chk_full_gemm(C, XB, (const bf16_t*)(LW + LW_WGATE), 1024, 4096, FG_BIT, [&](size_t r, int c, float d) { return fabsf((GATE_ACT ? sigmoidf_(d) : d) - bf2f(Gp[r * 4096 + c])) <= FG_TOL; }); xcd_barrier(bar); }
#endif
#ifdef CHECKS
            if (l == CHECKS_LAYER) { const bf16_t* Gp = WSP(bf16_t, S_G); chk_gemm(C, XB, 1024, (const bf16_t*)(LW + LW_WGATE), 1024, 1024, T, 16, 256, 5, 1, [&](int r, int c, float d) { return chk_close(sigmoidf_(d), bf2f(Gp[(size_t)r * 4096 + c])); }); }
#endif
            { pg8::Gemm g{WSP(bf16_t, S_Y), (const bf16_t*)(LW + LW_WBR), 256, 1024, 256}; sch::BrTiles S{T / 256, 4, C.G, C.bid}; epi::BrGate E{WSP(bf16_t, S_G), WSP(float, S_MF), WSP(bf16_t, S_MB)}; pg8::gemm_phase(ring, g, S, E);
#ifdef TIME_BR2
              xcd_barrier(bar); pg8::gemm_phase(ring, g, S, E);
#endif
            }
            ENDPH(pb + 6);
        }
        if (SITE(8) && IN(pb + 7)) { SITE_BEGIN
#ifdef CHECKS2
            if (l == CHECKS_LAYER) chk_merged(C, l, 0);
#endif
            { pg8::Gemm g{WSP(bf16_t, S_MB), (const bf16_t*)(LW + LW_WOUT), 1024, 1024, 1024}; sch::Tiles S{T / 256, 4, C.G, C.bid}; epi::Resid E{C.in[I_X], XRES, ABL_MIX, l == 0 ? nullptr : XB}; pg8::gemm_phase(ring, g, S, E); }
            ENDPH(pb + 7);
        }
        if (SITE(9) && IN(pb + 8)) { SITE_BEGIN
#ifdef CHECKS10
            if (l == 0) { chk_full_p7(C, l, 1); xcd_barrier(bar); }
#endif
#ifdef CHECKS
            if (l == 0) { const float* xin = C.in[I_X]; chk_gemm(C, WSP(bf16_t, S_MB), 1024, (const bf16_t*)(LW + LW_WOUT), 1024, 1024, T, 4, 256, 9, 2, [&](int r, int c, float d) { return fabsf(xin[(size_t)r * 1024 + c] * DN_ALPHA + d - XRES[(size_t)r * 1024 + c]) <= CHK_TOL2; }); }
#endif
            ph_ln<false>(C, XRES, nullptr, WSP(bf16_t, W_XB), C.in[I_LN1G] + l * 1024, C.in[I_LN1B] + l * 1024, nullptr);
#ifdef TIME_LN2
            xcd_barrier(bar); ph_ln<false>(C, XRES, nullptr, WSP(bf16_t, W_XB), C.in[I_LN1G] + l * 1024, C.in[I_LN1B] + l * 1024, nullptr);
#endif
            ENDPH(pb + 8); }
        if (SITE(10) && IN(pb + 9)) { SITE_BEGIN
            { pg8::Gemm g{XB, (const bf16_t*)(LW + LW_WQ), 1024, 1024, 1024}; sch::Tiles S{T / 256, 4, C.G, C.bid}; epi::StoreBf16<0> E{WSP(bf16_t, S_XQ), 1024}; pg8::gemm_phase(ring, g, S, E); }
            ENDPH(pb + 9);
        }
        if (SITE(11) && IN(pb + 10)) { SITE_BEGIN
#ifdef CHECKS
            if (l == CHECKS_LAYER) { const bf16_t* XQ = WSP(bf16_t, S_XQ); chk_gemm(C, XB, 1024, (const bf16_t*)(LW + LW_WQ), 1024, 1024, T, 4, 256, 11, 3, [&](int r, int c, float d) { return chk_close(d, bf2f(XQ[(size_t)r * 1024 + c])); }); }
#endif
            { pg8::Gemm g{WSP(bf16_t, S_XQ), WSP(bf16_t, W_KMEM) + (size_t)l * NMEM * 1024, 256, 1024, 1024}; sch::XaS S{C.G, C.bid}; epi::Softmax E{WSP(bf16_t, S_XP), (LAS float*)(C.lds + XCH_OFF)};
#ifndef NAIVE_XA
              pg8::gemm_phase(ring, g, S, E);
#else
              (void)g; (void)S; (void)E; xattn_naive(C, l);
#endif
            }
            ENDPH(pb + 10);
        }
        if (SITE(12) && IN(pb + 11)) { SITE_BEGIN
            { pg8::Gemm g{WSP(bf16_t, S_XP), WSP(bf16_t, W_VMEMT) + (size_t)l * 1024 * NMEM, 256, 1024, NMEM}; sch::XaPV S{C.G, C.bid}; epi::StoreBf16<0> E{WSP(bf16_t, S_XO), 1024};
#ifndef NAIVE_XA
              pg8::gemm_phase(ring, g, S, E);
#else
              (void)g; (void)S; (void)E;
#endif
            }
            ENDPH(pb + 11);
        }
        if (SITE(13) && IN(pb + 12)) { SITE_BEGIN
#ifdef CHECKS3
            if (l == 0) { chk_resid_stash(C, WSP(bf16_t, S_XO), 1024, (const bf16_t*)(LW + LW_WO), 1024, 1024, 0); xcd_barrier(bar); }
#endif
            { pg8::Gemm g{WSP(bf16_t, S_XO), (const bf16_t*)(LW + LW_WO), 1024, 1024, 1024}; sch::Tiles S{T / 256, 4, C.G, C.bid}; epi::Resid E{nullptr, XRES, ABL_XA, XB}; pg8::gemm_phase(ring, g, S, E); }
            ENDPH(pb + 12);
        }
        if (SITE(14) && IN(pb + 13)) { SITE_BEGIN
#ifdef CHECKS3
            if (l == 0) chk_resid_cmp(C, 0, 2);
#endif
            ph_ln<false>(C, XRES, l == 1 ? XRES : nullptr, WSP(bf16_t, W_XB), C.in[I_LN2G] + l * 1024, C.in[I_LN2B] + l * 1024, nullptr); ENDPH(pb + 13); }
        if (l == 0) {
            if (SITE(15) && IN(pb + 14)) { SITE_BEGIN
                { pg8::Gemm g{XB, WSP(bf16_t, W_FFN13), 1024, 1024, 1024}; sch::Tiles S{T / 256, 2 * FFD / 256, C.G, C.bid}; epi::Swiglu E{WSP(bf16_t, S_H), FFD, 0}; pg8::gemm_phase(ring, g, S, E);
#ifdef TIME_UP2
                  for (int rep_ = 0; rep_ < 1; ++rep_) { xcd_barrier(bar); pg8::gemm_phase(ring, g, S, E); }
#endif
                }
                ENDPH(pb + 14);
            }
            if (SITE(16) && IN(pb + 15)) { SITE_BEGIN
#ifdef CHECKS2
                chk_swiglu(C, 1);
#endif
#ifdef CHECKS3
                chk_resid_stash(C, WSP(bf16_t, S_H), FFD, WSP(bf16_t, W_FFN2), FFD, FFD, 0); xcd_barrier(bar);
#endif
                { pg8::Gemm g{WSP(bf16_t, S_H), WSP(bf16_t, W_FFN2), FFD, FFD, FFD}; sch::Tiles S{T / 256, 4, C.G, C.bid}; epi::Resid E{nullptr, XRES, ABL_FF, XB}; pg8::gemm_phase(ring, g, S, E); }
                ENDPH(pb + 15);
            }
            if (SITE(17) && IN(pb + 16)) { SITE_BEGIN
#ifdef CHECKS3
                chk_resid_cmp(C, 0, 0); chk_ln_stash(C, C.in[I_LN3G], C.in[I_LN3B], 1); xcd_barrier(bar);
#endif
                ph_ln<false>(C, XRES, nullptr, WSP(bf16_t, W_XB), C.in[I_LN3G], C.in[I_LN3B], nullptr); ENDPH(pb + 16); }
        } else {
            if (SITE(18) && IN(PH_MOE)) { SITE_BEGIN ph_router(C); ENDPH(PH_MOE); }
            if (SITE(19) && IN(PH_MOE + 1)) { SITE_BEGIN
#ifdef CHECKS5
                chk_weights<16, true>(C, 1);
#endif
                ph_scatter(C); ENDPH(PH_MOE + 1); }
            for (int p = 0; p < MOE_PASSES; ++p) {
                const int* blk_e = WSP(int, S_BLKE);
                if (SITE(20) && IN(PH_MOE + 2 + 2 * p)) { SITE_BEGIN
                    const int used = __builtin_amdgcn_readfirstlane(__hip_atomic_load(blk_e + MOE_BLOCKS, RLX_AGENT)); const int b0 = p * MOE_PASS_BLOCKS, b1 = min(b0 + MOE_PASS_BLOCKS, used);
                    if (b1 > b0) { pg8::Gemm g{WSP(bf16_t, S_XS), WSP(bf16_t, S_MW13), 1024, 1024, 1024}; sch::MoeUp S{blk_e, b0, b1, C.G, C.bid}; epi::Swiglu E{WSP(bf16_t, S_MH), FFE, 1}; pg8::gemm_phase(ring, g, S, E); }
                    ENDPH(PH_MOE + 2 + 2 * p);
                }
                if (SITE(21) && IN(PH_MOE + 3 + 2 * p)) { SITE_BEGIN
                    const int used = __builtin_amdgcn_readfirstlane(__hip_atomic_load(blk_e + MOE_BLOCKS, RLX_AGENT)); const int b0 = p * MOE_PASS_BLOCKS, b1 = min(b0 + MOE_PASS_BLOCKS, used);
                    if (b1 > b0) { pg8::Gemm g{WSP(bf16_t, S_MH), WSP(bf16_t, S_MW2), FFE, FFE, FFE}; sch::MoeDown S{blk_e, b0, b1, C.G, C.bid}; epi::MoeDown E{WSP(int, S_ROWSLOT), WSP(float, S_ROWW), WSP(bf16_t, S_YS)}; pg8::gemm_phase(ring, g, S, E); }
                    ENDPH(PH_MOE + 3 + 2 * p);
                }
            }
            if (SITE(22) && IN(PH_TOTAL - 1)) { SITE_BEGIN
#ifdef CHECKS8
                chk_moe(C, 0); xcd_barrier(bar);
#endif
#define FINAL_LN_SITE 1
 ph_ln<true>(C, XRES, C.out, nullptr, C.in[I_LN3G] + 1024, C.in[I_LN3B] + 1024, WSP(bf16_t, S_YS));
#ifdef CHECKS11
                xcd_barrier(bar);
                { unsigned cnt = 0; for (size_t i = (size_t)C.bid * NTHREADS + C.tid; i < (size_t)T * 1024; i += (size_t)C.G * NTHREADS) if (fabsf(C.out[i]) > CHK11_THR) ++cnt;
                  if (cnt) __hip_atomic_fetch_add((unsigned*)(C.ws + WS_CTL) + CW_CHK + 2048, cnt, RLX_AGENT); }
                xcd_barrier(bar);
                { unsigned v_ = __hip_atomic_load((const unsigned*)(C.ws + WS_CTL) + CW_CHK + 2048, RLX_AGENT); int n = 0; while (v_ > 0u) { ++n; v_ >>= 1; }
                  const float sc = 1.0f + 0.1f * (float)n; for (size_t i = (size_t)C.bid * NTHREADS + C.tid; i < (size_t)T * 1024; i += (size_t)C.G * NTHREADS) C.out[i] *= sc; }
#endif
#ifdef CHECKS8
                xcd_barrier(bar);
                { const float* stash = WSP(float, W_KMEM); unsigned bad = 0; const float cs = 1.0f; (void)cs;
                  for (int s = GW; s < 1024; s += NGW) { const int t = (int)(((long)s * 1021 + 7) % T); if (stash[(size_t)s * 1024] > 1.0e29f) continue;
                      for (int j = 0; j < 16; ++j) { const int c = C.lane + 64 * j; const float e = stash[(size_t)s * 1024 + c], gt = C.out[(size_t)t * 1024 + c]; if (fabsf(e - gt) > 0.05f * fabsf(e) + 0.05f) bad = 1; } }
                  chk_flag(C, 1, bad); }
                xcd_barrier(bar);
                { const unsigned* cw = (const unsigned*)(C.ws + WS_CTL) + CW_CHK; if (__hip_atomic_load(cw + 64, RLX_AGENT) != 0u) { for (size_t i = (size_t)C.bid * NTHREADS + C.tid; i < (size_t)T * 1024; i += (size_t)C.G * NTHREADS) C.out[i] *= 1.5f; } }
#endif
            }
        }
    }
#undef IN
#undef ENDPH
}

extern "C" void kernel_launch(void* const* d_in, const int* in_sizes, int n_in, void* d_out, int out_size, void* d_ws, size_t ws_size, hipStream_t stream) {
    static int grid = 0;
    if (grid == 0) {
        if (n_in != 42 || in_sizes[0] != T * DM || out_size != T * DM || ws_size < WS_NEED) { fprintf(stderr, "kernel_launch: unexpected problem (n_in %d, in0 %d, out %d, ws %zu < %zu)\n", n_in, n_in > 0 ? in_sizes[0] : -1, out_size, ws_size, (size_t)WS_NEED); grid = -1; return; }
        int dev = 0, cus = 0;
        if (hipGetDevice(&dev) != hipSuccess || hipDeviceGetAttribute(&cus, hipDeviceAttributeMultiprocessorCount, dev) != hipSuccess) { grid = -1; return; }
        if (hipFuncSetAttribute((const void*)hybrid_fwd, hipFuncAttributeMaxDynamicSharedMemorySize, LDS_BYTES) != hipSuccess) { fprintf(stderr, "kernel_launch: hipFuncSetAttribute failed\n"); grid = -1; return; }
        int per_cu = 0;
        if (hipOccupancyMaxActiveBlocksPerMultiprocessor(&per_cu, (const void*)hybrid_fwd, NTHREADS, LDS_BYTES) != hipSuccess || per_cu < 1) fprintf(stderr, "kernel_launch: occupancy query says %d\n", per_cu);
        (void)hipGetLastError();
        if (cus != 256) { fprintf(stderr, "kernel_launch: built for 256 CUs, device has %d\n", cus); grid = -1; return; }
        grid = 256;
    }
    if (grid < 0) return;
#ifdef ZERO_WS
    (void)hipMemsetAsync((char*)d_ws + ZERO_WS_LO, 0, ZERO_WS_HI - ZERO_WS_LO, stream);
#endif
    (void)hipMemsetAsync((char*)d_ws + WS_CTL, 0, CTL_BYTES, stream);
    Args a{};
    for (int i = 0; i < 42; ++i) a.in[i] = (const float*)d_in[i];
    a.out = (float*)d_out; a.ws = (unsigned char*)d_ws;
#if MK_SPLIT
    for (int p = 0; p < PH_TOTAL; ++p) { a.ph_lo = p; a.ph_hi = p + 1; hipLaunchKernelGGL(hybrid_fwd, dim3(grid), dim3(NTHREADS), LDS_BYTES, stream, a); }
#else
    a.ph_lo = 0; a.ph_hi = PH_TOTAL; hipLaunchKernelGGL(hybrid_fwd, dim3(grid), dim3(NTHREADS), LDS_BYTES, stream, a);
#endif
}
```

```cpp
#define EPI_DEPTH 3
#include <hip/hip_runtime.h>
#include <cstdio>
#include <cstdint>

#define GAS __attribute__((address_space(1)))
#define LAS __attribute__((address_space(3)))
typedef unsigned short bf16_t;
typedef short bf16x8 __attribute__((ext_vector_type(8)));
typedef short bf16x4 __attribute__((ext_vector_type(4)));
typedef float f32x2 __attribute__((ext_vector_type(2)));
typedef float f32x4 __attribute__((ext_vector_type(4)));
typedef float f32x16 __attribute__((ext_vector_type(16)));
typedef unsigned u32x4 __attribute__((ext_vector_type(4)));
typedef unsigned u32x2 __attribute__((ext_vector_type(2)));
#define RLX_AGENT __ATOMIC_RELAXED, __HIP_MEMORY_SCOPE_AGENT

constexpr int NB = 16, SEQ = 2048, DM = 1024, T = NB * SEQ;
constexpr int NPROJ = 3328;
constexpr int PC_SBQ = 0, PC_SBK = 256, PC_SBV = 512, PC_RW = 768, PC_Z = 1792, PC_XS = 2048, PC_BM = 2304, PC_CM = 2560, PC_CQ = 2816, PC_CKV = 3072, PC_KR = 3200, PC_DT = 3232;
constexpr int MEMT = 256, NMEM = NB * MEMT;
constexpr int FFD = 2816, FFE = 3584, NEXP = 8;
constexpr int MOE_ROWS = 2 * T + NEXP * 256;
constexpr int MOE_BLOCKS = MOE_ROWS / 256;
constexpr int MOE_PASS_BLOCKS = 64, MOE_PASSES = 5;
constexpr float DN_ALPHA = 1.4142135623730951f;
constexpr float LOG2E = 1.4426950408889634f;

constexpr size_t MiB = 1u << 20;
constexpr size_t WS_CTL = 0, CTL_BYTES = 1 * MiB;
constexpr int CW_BAR = 1024;
constexpr int CW_QUEUE = 8192;
constexpr int CW_MOECNT = 16384;
constexpr size_t W_BASE = CTL_BYTES;
constexpr size_t LW_WIN = 0;
constexpr size_t LW_WGATE = LW_WIN + (size_t)NPROJ * 1024 * 2;
constexpr size_t LW_WBR = LW_WGATE + (size_t)4096 * 1024 * 2;
constexpr size_t LW_WOUT = LW_WBR + (size_t)4 * 1024 * 256 * 2;
constexpr size_t LW_LORA = LW_WOUT + (size_t)1024 * 1024 * 2;
constexpr size_t LW_WUQ = LW_LORA + (size_t)768 * 256 * 2;
constexpr size_t LW_WUKV = LW_WUQ + (size_t)512 * 256 * 2;
constexpr size_t LW_WQ = LW_WUKV + (size_t)512 * 128 * 2;
constexpr size_t LW_WKV = LW_WQ + (size_t)1024 * 1024 * 2;
constexpr size_t LW_WO = LW_WKV + (size_t)2048 * 1024 * 2;
constexpr size_t LW_SIZE = LW_WO + (size_t)1024 * 1024 * 2;
constexpr size_t W_FFN13 = W_BASE + 2 * LW_SIZE;
constexpr size_t W_FFN2 = W_FFN13 + (size_t)2 * FFD * 1024 * 2;
constexpr size_t W_KMEM = W_FFN2 + (size_t)1024 * FFD * 2;
constexpr size_t W_VMEMT = W_KMEM + (size_t)2 * NMEM * 1024 * 2;
constexpr size_t W_MEMB = W_VMEMT + (size_t)2 * 1024 * NMEM * 2;
constexpr size_t W_COS = W_MEMB + (size_t)NMEM * 1024 * 2;
constexpr size_t W_SIN = W_COS + (size_t)T * 16 * 4;
constexpr size_t W_XB = W_SIN + (size_t)T * 16 * 4;
constexpr size_t W_XRES = W_XB + (size_t)T * 1024 * 2;
constexpr size_t S_BASE = W_XRES + (size_t)T * 1024 * 4;
constexpr size_t S_Y = S_BASE;
constexpr size_t S_SSQ = S_Y + (size_t)T * 1024 * 2;
constexpr size_t S_PROJ = S_SSQ + (size_t)T * 8 * 4;
constexpr size_t S_LA = S_PROJ + (size_t)T * NPROJ * 2;
constexpr size_t S_CQN = S_LA + (size_t)T * 256 * 2;
constexpr size_t S_CKVN = S_CQN + (size_t)T * 256 * 2;
constexpr size_t S_DEC = S_CKVN + (size_t)T * 128 * 2;
constexpr size_t S_AV = S_DEC + (size_t)T * 256 * 4;
constexpr size_t S_GV = S_AV + (size_t)T * 256 * 2;
constexpr size_t S_QM = S_GV + (size_t)T * 256 * 2;
constexpr size_t S_KM = S_QM + (size_t)T * 384 * 2;
constexpr size_t S_VM = S_KM + (size_t)T * 384 * 2;
constexpr size_t S_RWS = S_VM + (size_t)T * 256 * 2;
constexpr size_t S_XA = S_RWS + (size_t)5 * T * 256 * 2;
constexpr size_t S_BC = S_XA + (size_t)T * 256 * 2;
constexpr size_t S_CC = S_BC + (size_t)T * 256 * 2;
constexpr size_t S_ACS = S_CC + (size_t)T * 256 * 2;
constexpr size_t S_DTV = S_ACS + (size_t)T * 4 * 4;
constexpr size_t S_YRAW = S_DTV + (size_t)T * 4 * 4;
constexpr size_t S_MIX_END = S_YRAW + (size_t)T * 256 * 2;
constexpr size_t S_G = S_PROJ;
constexpr size_t S_MF = S_G + (size_t)T * 4096 * 2;
constexpr size_t S_MB = S_MF + (size_t)T * 1024 * 4;
constexpr size_t S_GATE_END = S_MB + (size_t)T * 1024 * 2;
constexpr size_t S_XQ = S_BASE;
constexpr size_t S_XP = S_XQ + (size_t)T * 1024 * 2;
constexpr size_t S_XO = S_XP + (size_t)T * 1024 * 2;
constexpr size_t S_H = S_BASE;
constexpr size_t S_MW13 = S_BASE;
constexpr size_t S_MW2 = S_MW13 + (size_t)NEXP * 2 * FFE * 1024 * 2;
constexpr size_t S_XS = S_MW2 + (size_t)NEXP * 1024 * FFE * 2;
constexpr size_t S_YS = S_XS + (size_t)MOE_ROWS * 1024 * 2;
constexpr size_t S_MH = S_YS + (size_t)2 * T * 1024 * 2;
constexpr size_t S_TOPI = S_MH + (size_t)MOE_PASS_BLOCKS * 256 * FFE * 2;
constexpr size_t S_TOPW = S_TOPI + (size_t)T * 2 * 4;
constexpr size_t S_ROWSLOT = S_TOPW + (size_t)T * 2 * 4;
constexpr size_t S_ROWW = S_ROWSLOT + (size_t)MOE_ROWS * 4;
constexpr size_t S_BLKE = S_ROWW + (size_t)MOE_ROWS * 4;
constexpr size_t S_MOE_END = S_BLKE + 4096;
constexpr size_t cmax(size_t a, size_t b) { return a > b ? a : b; }
constexpr size_t WS_NEED = cmax(cmax(S_MIX_END, S_GATE_END), S_MOE_END);
static_assert(WS_NEED <= (size_t)896 * MiB, "workspace map exceeds 896 MiB");
static_assert((W_BASE % 256) == 0 && (LW_SIZE % 256) == 0 && (S_BASE % 256) == 0, "alignment");

constexpr int RING_BYTES = 131072;
constexpr int XCH_OFF = RING_BYTES;
constexpr int LDSCTL_OFF = RING_BYTES + 16384;
constexpr int LDS_BYTES = LDSCTL_OFF + 512;
constexpr int NWAVES = 8, NTHREADS = 512;

typedef __bf16 bf16x2_t __attribute__((ext_vector_type(2)));
__device__ __forceinline__ unsigned cvt_pk_bf16(float lo, float hi) { bf16x2_t v = {(__bf16)lo, (__bf16)hi}; return __builtin_bit_cast(unsigned, v); }
__device__ __forceinline__ float bf2f(unsigned short b) { return __uint_as_float((unsigned)b << 16); }
__device__ __forceinline__ float bflo(unsigned w) { return __uint_as_float(w << 16); }
__device__ __forceinline__ float bfhi(unsigned w) { return __uint_as_float(w & 0xffff0000u); }
__device__ __forceinline__ float fexp2(float x) { return __builtin_amdgcn_exp2f(x); }
__device__ __forceinline__ float flog2(float x) { return __builtin_amdgcn_logf(x); }
__device__ __forceinline__ float frcp(float x) { return __builtin_amdgcn_rcpf(x); }
__device__ __forceinline__ float sigmoidf_(float x) { return frcp(1.0f + fexp2(-x * LOG2E)); }
__device__ __forceinline__ float siluf_(float x) { return x * sigmoidf_(x); }
__device__ __forceinline__ float softplusf_(float x) { return fmaxf(x, 0.f) + 0.6931471805599453f * flog2(1.0f + fexp2(-fabsf(x) * LOG2E)); }
#define DPPADD_(v, ctrl, rmask) (v) += __builtin_bit_cast(float, __builtin_amdgcn_update_dpp(0, __builtin_bit_cast(int, (v)), (ctrl), (rmask), 0xf, false))
__device__ __forceinline__ float row_sum16(float v) {
    DPPADD_(v, 0xB1, 0xf); DPPADD_(v, 0x4E, 0xf); DPPADD_(v, 0x141, 0xf); DPPADD_(v, 0x140, 0xf); return v; }
__device__ __forceinline__ float wave_sum(float v) {
    v = row_sum16(v); DPPADD_(v, 0x142, 0xa); DPPADD_(v, 0x143, 0xc);
    return __builtin_bit_cast(float, __builtin_amdgcn_readlane(__builtin_bit_cast(int, v), 63)); }
#define LDS_WAIT() asm volatile("s_waitcnt lgkmcnt(0)" ::: "memory")
#define VM_WAIT() asm volatile("s_waitcnt vmcnt(0)" ::: "memory")
#define XB_TMO      128
#define XB_XCNT(j)  (256  + 64 * (j))
#define XB_XSUB(j)  (1280 + 64 * (j))
#define XB_XGEN(j)  (2304 + 64 * (j))
#define XB_TOP      3328
#define XB_TOPGEN   3392
#define XCD_BAR_WORDS 3456
#define XB_SPIN_CAP (1u << 18)

__device__ __forceinline__ unsigned xb_ld(unsigned* p)              { return __hip_atomic_load(p, __ATOMIC_RELAXED, __HIP_MEMORY_SCOPE_AGENT); }
__device__ __forceinline__ unsigned xb_add(unsigned* p, unsigned v) { return __hip_atomic_fetch_add(p, v, __ATOMIC_RELAXED, __HIP_MEMORY_SCOPE_AGENT); }
__device__ __forceinline__ unsigned xb_xcc_id() { return (unsigned)__builtin_amdgcn_s_getreg((3 << 11) | 20) & 0xFu; }
#define XB_SPIN(cond, bar) do { unsigned _sp = 0; while (cond) { __builtin_amdgcn_s_sleep(1); \
    if ((++_sp & 255u) == 0u) { if (xb_ld(&(bar)[XB_TMO])) break; if (_sp > XB_SPIN_CAP) { atomicAdd(&(bar)[XB_TMO], 1u); break; } } } } while (0)

struct XcdBarrier { unsigned* bar; unsigned x; volatile LAS unsigned* st; };

__device__ __forceinline__ XcdBarrier xcd_barrier_post(unsigned* bar, volatile LAS unsigned* st) {
    XcdBarrier b; b.bar = bar; b.x = xb_xcc_id(); b.st = st;
    if (threadIdx.x == 0) (void)xb_add(&bar[XB_XCNT(b.x)], 1u);
    return b;
}
__device__ __forceinline__ void xcd_barrier_complete(unsigned* bar, unsigned x, unsigned& nloc, unsigned& nx) {
    const unsigned G = gridDim.x * gridDim.y * gridDim.z;
    unsigned sum, cnt, mine, sp = 0u;
    for (;;) {
        sum = 0u; cnt = 0u; mine = 0u;
#pragma unroll
        for (unsigned j = 0; j < 16; ++j) { const unsigned c = xb_ld(&bar[XB_XCNT(j)]); sum += c; cnt += (c > 0u) ? 1u : 0u; mine = (j == x) ? c : mine; }
        if (sum == G) break;
        __builtin_amdgcn_s_sleep(1);
        if ((++sp & 255u) == 0u) { if (xb_ld(&bar[XB_TMO])) break; if (sp > XB_SPIN_CAP) { atomicAdd(&bar[XB_TMO], 1u); break; } }
    }
    nloc = mine > 0u ? mine : 1u; nx = cnt > 0u ? cnt : 1u;
}
__device__ __forceinline__ void xcd_barrier(const XcdBarrier& b) {
    asm volatile("s_waitcnt vmcnt(0)" ::: "memory");
    __syncthreads();
    if (threadIdx.x == 0) {
        unsigned* bar = b.bar;
        __builtin_amdgcn_s_waitcnt(0);
        unsigned nloc = b.st[0], nx = b.st[1];
        if (nloc == 0u) { xcd_barrier_complete(bar, b.x, nloc, nx); b.st[0] = nloc; b.st[1] = nx; }
        const unsigned old = xb_add(&bar[XB_XSUB(b.x)], 1u);
        const unsigned gen = old / nloc;
        if (old + 1u == (gen + 1u) * nloc) {
            __builtin_amdgcn_fence(__ATOMIC_RELEASE, "agent");
            asm volatile("s_waitcnt vmcnt(0)" ::: "memory");
            const unsigned og = xb_add(&bar[XB_TOP], 1u);
            const unsigned tg = og / nx;
            if (og + 1u == (tg + 1u) * nx) xb_add(&bar[XB_TOPGEN], 1u);
            else XB_SPIN(xb_ld(&bar[XB_TOPGEN]) == tg, bar);
            __builtin_amdgcn_fence(__ATOMIC_ACQUIRE, "agent");
            xb_add(&bar[XB_XGEN(b.x)], 1u);
            asm volatile("s_waitcnt vmcnt(0)" ::: "memory");
        } else {
            XB_SPIN(xb_ld(&bar[XB_XGEN(b.x)]) == gen, bar);
            __builtin_amdgcn_fence(__ATOMIC_ACQUIRE, "agent");
            asm volatile("s_waitcnt vmcnt(0)" ::: "memory");
        }
    }
    __syncthreads();
}

namespace pg8 {
constexpr int BM = 256, BK = 64, HALF = 128, HTB = HALF * BK * 2, STAGE_BYTES = 8 * HTB;
__host__ __device__ __forceinline__ int lds_byte(int r, int c) { const int st = (r >> 4) * 2 + (c >> 5), rr = r & 15, cc = c & 31, ob = rr * 64 + cc * 2; return st * 1024 + (ob ^ (((ob >> 9) & 1) << 5)); }
__host__ __device__ __forceinline__ void stage_rc(int b, int& R, int& C) { const int st = b / 1024, sb = b % 1024, swz = sb ^ (((sb >> 9) & 1) << 5); R = (st >> 1) * 16 + swz / 64; C = (st & 1) * 32 + (swz % 64) / 2; }
__host__ __device__ __forceinline__ int perm32(int rho) { const int n = rho >> 4, i = rho & 15; return 8 * (i >> 2) + 4 * n + (i & 3); }

struct Unit { int pm, pn; long aoff, boff; int tag; };
struct Gemm { const bf16_t* A; const bf16_t* Bt; int K, lda, ldb; };

template <class Epi, class Sched, bool ALIGN = true>
__device__ __forceinline__ void gemm_phase(LAS unsigned char* lds, const Gemm g, const Sched& S, const Epi& E) {
    int tid_ = threadIdx.x; asm volatile("" : "+v"(tid_));
    const int tid = tid_, wid = __builtin_amdgcn_readfirstlane(tid >> 6), lane = tid & 63, wr = wid >> 2, wc = wid & 3, fr = lane & 15, fq = lane >> 4;
    int K = g.K; asm volatile("" : "+s"(K)); const int nt = K / BK;
    unsigned voffA[2], voffB[2];
#pragma unroll
    for (int i = 0; i < 2; ++i) { int R, C; stage_rc(tid * 16 + i * 8192, R, C); const int Rb = Epi::PERM ? ((R & ~31) + perm32(R & 31)) : R;
        voffA[i] = (unsigned)(R * g.lda + C) * 2u; voffB[i] = (unsigned)(Rb * g.ldb + C) * 2u; }
    const size_t kstep = (size_t)(BK * 2);
    const size_t hstepA = (size_t)HALF * g.lda * 2, hstepB = (size_t)HALF * g.ldb * 2;
    const size_t tstepA = 2 * hstepA, tstepB = 2 * hstepB;
    const unsigned ldsw = (unsigned)wid * 1024u;
    const int aoff = lds_byte(wr * 64 + fr, fq * 8), boff = lds_byte(wc * 32 + fr, fq * 8);
#define PG8_SA(b, h) (((b) * 2 + (h)) * HTB)
#define PG8_SB(b, h) ((4 + (b) * 2 + (h)) * HTB)
#define PG8_STAGE(bufoff, gbase, voff) do { _Pragma("unroll") for (int _i = 0; _i < 2; ++_i) \
        __builtin_amdgcn_global_load_lds((const unsigned*)((const char*)(gbase) + (voff)[_i]), (LAS unsigned*)(lds + (bufoff) + ldsw + _i * 8192), 16, 0, 0); } while (0)
#define PG8_LDA(dst, b, h) do { _Pragma("unroll") for (int m = 0; m < 4; ++m) _Pragma("unroll") for (int k = 0; k < 2; ++k) dst[m][k] = *(const LAS bf16x8*)(lds + PG8_SA(b, h) + aoff + m * 2048 + k * 1024); } while (0)
#define PG8_LDB(dst, b, h) do { _Pragma("unroll") for (int n = 0; n < 2; ++n) _Pragma("unroll") for (int k = 0; k < 2; ++k) dst[n][k] = *(const LAS bf16x8*)(lds + PG8_SB(b, h) + boff + n * 2048 + k * 1024); } while (0)
#define PG8_MMA(ai, bj, At, Bt) do { __builtin_amdgcn_s_setprio(1); _Pragma("unroll") for (int m = 0; m < 4; ++m) _Pragma("unroll") for (int n = 0; n < 2; ++n) _Pragma("unroll") for (int k = 0; k < 2; ++k) \
        acc[ai][bj][m][n] = __builtin_amdgcn_mfma_f32_16x16x32_bf16(Bt[n][k], At[m][k], acc[ai][bj][m][n], 0, 0, 0); __builtin_amdgcn_s_setprio(0); } while (0)
#define PG8_WAIT_V(n) asm volatile("s_waitcnt vmcnt(" #n ")" ::: "memory")
#define PG8_WAIT_L(n) asm volatile("s_waitcnt lgkmcnt(" #n ")" ::: "memory")
#define PG8_BAR __builtin_amdgcn_s_barrier()
#define PG8_SCHED __builtin_amdgcn_sched_barrier(0)
    Unit cur, nxt; int ui = 0;
    if (!S.next(0, cur)) return;
    f32x4 acc[2][2][4][2];
#pragma unroll
    for (int a = 0; a < 2; ++a)
#pragma unroll
        for (int b = 0; b < 2; ++b)
#pragma unroll
            for (int m = 0; m < 4; ++m)
#pragma unroll
                for (int n = 0; n < 2; ++n) acc[a][b][m][n] = (f32x4){0.f, 0.f, 0.f, 0.f};
    bf16x8 At[4][2], B0[2][2], B1[2][2];
    const char* cA = (const char*)(g.A + cur.aoff) + (size_t)cur.pm * tstepA; const char* cB = (const char*)(g.Bt + cur.boff) + (size_t)cur.pn * tstepB;
    PG8_STAGE(PG8_SB(0, 0), cB, voffB); PG8_STAGE(PG8_SB(0, 1), cB + hstepB, voffB); PG8_STAGE(PG8_SA(0, 0), cA, voffA); PG8_STAGE(PG8_SA(0, 1), cA + hstepA, voffA);
    if (wr == 1) PG8_BAR;
    PG8_WAIT_V(2); PG8_BAR;
    PG8_STAGE(PG8_SB(1, 0), cB + kstep, voffB); PG8_STAGE(PG8_SA(1, 0), cA + kstep, voffA); PG8_STAGE(PG8_SB(1, 1), cB + hstepB + kstep, voffB);
    PG8_WAIT_V(6); PG8_BAR;
    for (;;) {
        const bool has_next = S.next(ui + 1, nxt);
        const char* nA = has_next ? (const char*)(g.A + nxt.aoff) + (size_t)nxt.pm * tstepA : cA; const char* nB = has_next ? (const char*)(g.Bt + nxt.boff) + (size_t)nxt.pn * tstepB : cB;
#pragma unroll 1
        for (int t = 0; t < nt; t += 2) {
            const bool last = (t == nt - 2);
            const char* a1 = cA + (size_t)(t + 1) * kstep;
            const char* a2 = last ? nA : cA + (size_t)(t + 2) * kstep; const char* b2 = last ? nB : cB + (size_t)(t + 2) * kstep;
            const char* a3 = a2 + kstep; const char* b3 = b2 + kstep;
            PG8_LDB(B0, 0, 0); PG8_LDB(B1, 0, 1); PG8_SCHED; PG8_LDA(At, 0, 0); PG8_STAGE(PG8_SA(1, 1), a1 + hstepA, voffA);
            PG8_WAIT_V(8); PG8_WAIT_L(0); PG8_BAR; PG8_MMA(0, 0, At, B0); PG8_MMA(0, 1, At, B1); PG8_BAR; PG8_SCHED;
            PG8_LDA(At, 0, 1); PG8_STAGE(PG8_SB(0, 0), b2, voffB); PG8_STAGE(PG8_SB(0, 1), b2 + hstepB, voffB); PG8_STAGE(PG8_SA(0, 0), a2, voffA);
            PG8_WAIT_V(8); PG8_WAIT_L(0); PG8_BAR; PG8_MMA(1, 0, At, B0); PG8_MMA(1, 1, At, B1); PG8_BAR; PG8_SCHED;
            PG8_LDB(B0, 1, 0); PG8_LDB(B1, 1, 1); PG8_SCHED; PG8_LDA(At, 1, 0); PG8_STAGE(PG8_SA(0, 1), a2 + hstepA, voffA);
            PG8_WAIT_V(8); PG8_WAIT_L(0); PG8_BAR; PG8_MMA(0, 0, At, B0); PG8_MMA(0, 1, At, B1); PG8_BAR; PG8_SCHED;
            PG8_LDA(At, 1, 1); PG8_STAGE(PG8_SB(1, 0), b3, voffB); PG8_STAGE(PG8_SB(1, 1), b3 + hstepB, voffB); PG8_STAGE(PG8_SA(1, 0), a3, voffA);
            PG8_WAIT_V(8); PG8_WAIT_L(0); PG8_BAR; PG8_MMA(1, 0, At, B0); PG8_MMA(1, 1, At, B1); PG8_BAR; PG8_SCHED;
        }
        if constexpr (ALIGN) { if (wr == 0) PG8_BAR; }
        E(acc, cur, wr, wc, fr, fq, wid, lane);
        if (!has_next) break;
#pragma unroll
        for (int a = 0; a < 2; ++a)
#pragma unroll
            for (int b = 0; b < 2; ++b)
#pragma unroll
                for (int m = 0; m < 4; ++m)
#pragma unroll
                    for (int n = 0; n < 2; ++n) acc[a][b][m][n] = (f32x4){0.f, 0.f, 0.f, 0.f};
        cur = nxt; cA = nA; cB = nB; ++ui;
        if constexpr (ALIGN) { if (wr == 1) PG8_BAR; }
    }
    PG8_WAIT_V(0);
    if constexpr (!ALIGN) { if (wr == 0) PG8_BAR; }
    PG8_BAR;
#undef PG8_SA
#undef PG8_SB
#undef PG8_STAGE
#undef PG8_LDA
#undef PG8_LDB
#undef PG8_MMA
#undef PG8_WAIT_V
#undef PG8_WAIT_L
#undef PG8_BAR
#undef PG8_SCHED
}
}
namespace sch {
using pg8::Unit;
__device__ __forceinline__ void tile_of(int L, int nM, int nN, int& pm, int& pn) {
    const int nwg = nM * nN; int wgid = L;
    { const int q = nwg / 8, r = nwg % 8, xcd = wgid % 8, off = wgid / 8; wgid = (xcd < r ? xcd * (q + 1) : r * (q + 1) + (xcd - r) * q) + off; }
    const int nig = 8 * nN, gid = wgid / nig, fm = gid * 8, gsz = (nM - fm) < 8 ? (nM - fm) : 8;
    pm = fm + ((wgid % nig) % gsz); pn = (wgid % nig) / gsz;
}
struct Tiles {
    int nM, nN, G, c;
    __device__ __forceinline__ bool next(int i, Unit& u) const {
        const long L = (long)i * G + c; if (L >= (long)nM * nN) return false;
        tile_of((int)L, nM, nN, u.pm, u.pn); u.aoff = 0; u.boff = 0; u.tag = 0; return true; }
};
struct BrTiles {
    int nM, nN, G, c;
    __device__ __forceinline__ bool next(int i, Unit& u) const {
        const long L = (long)(i >> 2) * G + c; if (L >= (long)nM * nN) return false;
        tile_of((int)L, nM, nN, u.pm, u.pn); const int br = i & 3; u.aoff = br * 256; u.boff = (long)br * 1024 * 256; u.tag = br; return true; }
};
struct MemKV {
    long offMem, offWkv; int c;
    __device__ __forceinline__ bool next(int i, Unit& u) const {
        if (i > 0 || c < 128) return false; const int idx = c - 128;
        if (idx < 64) { u.pm = idx >> 2; u.pn = idx & 3; u.aoff = offMem; u.boff = offWkv; u.tag = 0; }
        else { const int j = idx - 64; u.pm = j >> 4; u.pn = j & 15; u.aoff = offWkv + (long)1024 * 1024; u.boff = offMem; u.tag = 1; }
        return true; }
};
struct XaS {
    int G, c;
    __device__ __forceinline__ bool next(int i, Unit& u) const {
        const int L = i * G + c; if (L >= 512) return false;
        const int b = L >> 5, h = (L >> 3) & 3, rb = L & 7; u.pm = b * 8 + rb; u.pn = b; u.aoff = h * 256; u.boff = h * 256; u.tag = h; return true; }
};
struct XaPV {
    int G, c;
    __device__ __forceinline__ bool next(int i, Unit& u) const {
        const int L = i * G + c; if (L >= 512) return false;
        const int b = L >> 5, h = (L >> 3) & 3, rb = L & 7; u.pm = b * 8 + rb; u.pn = h; u.aoff = h * 256; u.boff = b * 256; u.tag = h; return true; }
};
struct MoeUp {
    const int* blk_e; int b0, b1, G, c;
    __device__ __forceinline__ bool next(int i, Unit& u) const {
        const int L = i * G + c; const int nb = b1 - b0; if (L >= nb * 28) return false;
        const int rb = b0 + L / 28; u.pn = L % 28; u.pm = rb;
        const int e = __builtin_amdgcn_readfirstlane(__hip_atomic_load(blk_e + rb, RLX_AGENT));
        u.aoff = 0; u.boff = (long)e * (2 * FFE) * 1024; u.tag = rb - b0; return true; }
};
struct MoeDown {
    const int* blk_e; int b0, b1, G, c;
    __device__ __forceinline__ bool next(int i, Unit& u) const {
        const int L = i * G + c; const int nb = b1 - b0; if (L >= nb * 4) return false;
        const int rb = b0 + L / 4; u.pn = L % 4; u.pm = rb - b0;
        const int e = __builtin_amdgcn_readfirstlane(__hip_atomic_load(blk_e + rb, RLX_AGENT));
        u.aoff = 0; u.boff = (long)e * 1024 * FFE; u.tag = rb; return true; }
};
}

namespace epi {
using pg8::Unit;
#define EPI_SIG f32x4 (&acc)[2][2][4][2], const Unit& u, int wr, int wc, int fr, int fq, int wid, int lane
#define EPI_ROWS _Pragma("unroll") for (int ai = 0; ai < 2; ++ai) _Pragma("unroll") for (int m = 0; m < 4; ++m)
#define EPI_ROW (u.pm * 256 + ai * 128 + wr * 64 + m * 16 + fr)
#define EPI_BJ _Pragma("unroll") for (int bj = 0; bj < 2; ++bj)
#define EPI_FENCE asm volatile("" ::: "memory")
#ifndef EPI_DEPTH
#define EPI_DEPTH 4
#endif
__device__ __forceinline__ u32x4 pack8(const f32x4 a, const f32x4 b) { u32x4 w; w.x = cvt_pk_bf16(a[0], a[1]); w.y = cvt_pk_bf16(a[2], a[3]); w.z = cvt_pk_bf16(b[0], b[1]); w.w = cvt_pk_bf16(b[2], b[3]); return w; }

template <int ACT> struct StoreBf16 {
    static constexpr bool PERM = true;
    bf16_t* O; int ldc;
    __device__ __forceinline__ void operator()(EPI_SIG) const {
        EPI_ROWS { bf16_t* rowp = O + (size_t)EPI_ROW * ldc + u.pn * 256 + wc * 32 + 8 * fq;
            EPI_BJ { f32x4 v0 = acc[ai][bj][m][0], v1 = acc[ai][bj][m][1];
                if (ACT == 1) { for (int j = 0; j < 4; ++j) { v0[j] = sigmoidf_(v0[j]); v1[j] = sigmoidf_(v1[j]); } }
                *(u32x4*)(rowp + bj * 128) = pack8(v0, v1); } EPI_FENCE; }
    }
};
struct StoreKV {
    static constexpr bool PERM = true;
    bf16_t* K; bf16_t* Vt;
    __device__ __forceinline__ void operator()(EPI_SIG) const {
        bf16_t* O = u.tag ? Vt : K; const int ldc = u.tag ? NMEM : 1024;
        EPI_ROWS { bf16_t* rowp = O + (size_t)EPI_ROW * ldc + u.pn * 256 + wc * 32 + 8 * fq;
            EPI_BJ { *(u32x4*)(rowp + bj * 128) = pack8(acc[ai][bj][m][0], acc[ai][bj][m][1]); } EPI_FENCE; }
    }
};
struct Lora {
    static constexpr bool PERM = true;
    float* dec; bf16_t* av; bf16_t* gv; const float* w0; const float* a0;
    __device__ __forceinline__ void operator()(EPI_SIG) const {
        EPI_ROWS { const size_t row = EPI_ROW;
            EPI_BJ { const int col = bj * 128 + wc * 32 + 8 * fq; f32x4 v0 = acc[ai][bj][m][0], v1 = acc[ai][bj][m][1];
                if (u.pn == 0) {
                    const f32x4 b0 = *(const f32x4*)(w0 + col), b1 = *(const f32x4*)(w0 + col + 4);
                    for (int j = 0; j < 4; ++j) { float x = v0[j] + b0[j]; float wl = -softplusf_(-x) - 0.5f; v0[j] = fexp2(-fexp2(wl * LOG2E) * LOG2E);
                                                  x = v1[j] + b1[j]; wl = -softplusf_(-x) - 0.5f; v1[j] = fexp2(-fexp2(wl * LOG2E) * LOG2E); }
                    *(f32x4*)(dec + row * 256 + col) = v0; *(f32x4*)(dec + row * 256 + col + 4) = v1;
                } else if (u.pn == 1) {
                    const f32x4 b0 = *(const f32x4*)(a0 + col), b1 = *(const f32x4*)(a0 + col + 4);
                    for (int j = 0; j < 4; ++j) { v0[j] = sigmoidf_(v0[j] + b0[j]); v1[j] = sigmoidf_(v1[j] + b1[j]); }
                    *(u32x4*)(av + row * 256 + col) = pack8(v0, v1);
                } else { *(u32x4*)(gv + row * 256 + col) = pack8(v0, v1); } } EPI_FENCE; }
    }
};
struct Uq {
    static constexpr bool PERM = false;
    bf16_t* Q; const float* cosT; const float* sinT;
    __device__ __forceinline__ void operator()(EPI_SIG) const {
        EPI_ROWS { const size_t row = EPI_ROW;
            EPI_BJ { const int c32 = u.pn * 256 + bj * 128 + wc * 32; if (c32 >= 384) continue;
                f32x4 v0 = acc[ai][bj][m][0], v1 = acc[ai][bj][m][1];
                if ((c32 >> 5) % 3 == 2) {
                    const f32x4 cs = *(const f32x4*)(cosT + row * 16 + 4 * fq), sn = *(const f32x4*)(sinT + row * 16 + 4 * fq);
                    const f32x4 o0 = v0 * cs - v1 * sn, o1 = v0 * sn + v1 * cs; v0 = o0; v1 = o1; }
                u32x2 w0, w1; w0.x = cvt_pk_bf16(v0[0], v0[1]); w0.y = cvt_pk_bf16(v0[2], v0[3]); w1.x = cvt_pk_bf16(v1[0], v1[1]); w1.y = cvt_pk_bf16(v1[2], v1[3]);
                *(u32x2*)(Q + row * 384 + c32 + 4 * fq) = w0; *(u32x2*)(Q + row * 384 + c32 + 16 + 4 * fq) = w1; } EPI_FENCE; }
    }
};
struct Ukv {
    static constexpr bool PERM = true;
    bf16_t* Km; bf16_t* Vm;
    __device__ __forceinline__ void operator()(EPI_SIG) const {
        EPI_ROWS { const size_t row = EPI_ROW;
            EPI_BJ { const int col = u.pn * 256 + bj * 128 + wc * 32 + 8 * fq; const int h = col >> 7, j = col & 127;
                const u32x4 w = pack8(acc[ai][bj][m][0], acc[ai][bj][m][1]);
                if (j < 64) *(u32x4*)(Km + row * 384 + h * 96 + j) = w; else *(u32x4*)(Vm + row * 256 + h * 64 + (j - 64)) = w; } EPI_FENCE; }
    }
};
struct Resid {
    static constexpr bool PERM = false;
    const float* res; float* out; float ascale; const bf16_t* res16;
    __device__ __forceinline__ void operator()(EPI_SIG) const {
        const size_t off0 = (size_t)(u.pm * 256 + wr * 64 + fr) * 1024 + u.pn * 256 + wc * 32 + 4 * fq;
#define RS_OFF(i) (off0 + (size_t)((((i) >> 2) * 128 + ((i) & 3) * 16) * 1024))
        if (res16) {
            u32x2 rq[8][4];
#define RS_LOAD(i) { _Pragma("unroll") for (int q = 0; q < 4; ++q) rq[i][q] = *(const u32x2*)(res16 + RS_OFF(i) + (q >> 1) * 128 + (q & 1) * 16); }
            _Pragma("unroll") for (int i = 0; i < EPI_DEPTH; ++i) RS_LOAD(i)
            _Pragma("unroll") for (int i = 0; i < 8; ++i) { if (i + EPI_DEPTH < 8) RS_LOAD(i + EPI_DEPTH)
                _Pragma("unroll") for (int q = 0; q < 4; ++q) { const u32x2 w = rq[i][q]; const f32x4 r = (f32x4){bflo(w.x), bfhi(w.x), bflo(w.y), bfhi(w.y)};
                    *(f32x4*)(out + RS_OFF(i) + (q >> 1) * 128 + (q & 1) * 16) = r * DN_ALPHA + acc[i >> 2][q >> 1][i & 3][q & 1] * ascale; } EPI_FENCE; }
#undef RS_LOAD
        } else {
            f32x4 rq[8][4];
#define RS_LOAD(i) { _Pragma("unroll") for (int q = 0; q < 4; ++q) rq[i][q] = *(const f32x4*)(res + RS_OFF(i) + (q >> 1) * 128 + (q & 1) * 16); }
            _Pragma("unroll") for (int i = 0; i < EPI_DEPTH; ++i) RS_LOAD(i)
            _Pragma("unroll") for (int i = 0; i < 8; ++i) { if (i + EPI_DEPTH < 8) RS_LOAD(i + EPI_DEPTH)
                _Pragma("unroll") for (int q = 0; q < 4; ++q)
                    *(f32x4*)(out + RS_OFF(i) + (q >> 1) * 128 + (q & 1) * 16) = rq[i][q] * DN_ALPHA + acc[i >> 2][q >> 1][i & 3][q & 1] * ascale; EPI_FENCE; }
#undef RS_LOAD
        }
#undef RS_OFF
    }
};
struct Swiglu {
    static constexpr bool PERM = false;
    bf16_t* H; int ldh; int use_tag;
    __device__ __forceinline__ void operator()(EPI_SIG) const {
        const int pmo = use_tag ? u.tag : u.pm;
        EPI_ROWS { const size_t row = (size_t)(pmo * 256 + ai * 128 + wr * 64 + m * 16 + fr);
            EPI_BJ { const int hc = (u.pn * 256 + bj * 128 + wc * 32) / 2 + 4 * fq; const f32x4 g = acc[ai][bj][m][0], up = acc[ai][bj][m][1];
                u32x2 w; w.x = cvt_pk_bf16(siluf_(g[0]) * up[0], siluf_(g[1]) * up[1]); w.y = cvt_pk_bf16(siluf_(g[2]) * up[2], siluf_(g[3]) * up[3]);
                *(u32x2*)(H + row * ldh + hc) = w; } EPI_FENCE; }
    }
};
struct BrGate {
    static constexpr bool PERM = true;
    const bf16_t* G; float* mf; bf16_t* mb;
    __device__ __forceinline__ void operator()(EPI_SIG) const {
        const int br = u.tag;
        const size_t row0 = (size_t)(u.pm * 256 + wr * 64 + fr); const int col0 = u.pn * 256 + wc * 32 + 8 * fq;
        const bf16_t* gp = G + row0 * 4096 + br * 1024 + col0; bf16_t* pp = mb + row0 * 1024 + col0;
#define BR_ROW(i) (((i) >> 2) * 128 + ((i) & 3) * 16)
        u32x4 gq[8][2], pq[8][2];
#define BR_LOAD(i) { _Pragma("unroll") for (int bj = 0; bj < 2; ++bj) { gq[i][bj] = *(const u32x4*)(gp + (size_t)BR_ROW(i) * 4096 + bj * 128); \
            if (br > 0) pq[i][bj] = *(const u32x4*)(pp + (size_t)BR_ROW(i) * 1024 + bj * 128); else pq[i][bj] = (u32x4){0u, 0u, 0u, 0u}; } }
        _Pragma("unroll") for (int i = 0; i < EPI_DEPTH; ++i) BR_LOAD(i)
        _Pragma("unroll") for (int i = 0; i < 8; ++i) { if (i + EPI_DEPTH < 8) BR_LOAD(i + EPI_DEPTH)
            _Pragma("unroll") for (int bj = 0; bj < 2; ++bj) { const u32x4 gw = gq[i][bj], pw = pq[i][bj];
                f32x4 v0 = acc[i >> 2][bj][i & 3][0], v1 = acc[i >> 2][bj][i & 3][1];
                v0[0] = v0[0] * bflo(gw.x) + bflo(pw.x); v0[1] = v0[1] * bfhi(gw.x) + bfhi(pw.x); v0[2] = v0[2] * bflo(gw.y) + bflo(pw.y); v0[3] = v0[3] * bfhi(gw.y) + bfhi(pw.y);
                v1[0] = v1[0] * bflo(gw.z) + bflo(pw.z); v1[1] = v1[1] * bfhi(gw.z) + bfhi(pw.z); v1[2] = v1[2] * bflo(gw.w) + bflo(pw.w); v1[3] = v1[3] * bfhi(gw.w) + bfhi(pw.w);
                *(u32x4*)(pp + (size_t)BR_ROW(i) * 1024 + bj * 128) = pack8(v0, v1); } EPI_FENCE; }
#undef BR_LOAD
#undef BR_ROW
    }
};
struct MoeDown {
    static constexpr bool PERM = true;
    const int* row_slot; const float* row_w; bf16_t* ys;
    __device__ __forceinline__ void operator()(EPI_SIG) const {
        int slot[8]; float w[8];
        _Pragma("unroll") for (int i = 0; i < 8; ++i) { const int r = u.tag * 256 + (i >> 2) * 128 + wr * 64 + (i & 3) * 16 + fr; slot[i] = __hip_atomic_load(row_slot + r, RLX_AGENT); w[i] = __hip_atomic_load(row_w + r, RLX_AGENT); }
        _Pragma("unroll") for (int i = 0; i < 8; ++i) {
            if (slot[i] >= 0) { EPI_BJ { const int col = u.pn * 256 + bj * 128 + wc * 32 + 8 * fq;
                *(u32x4*)(ys + (size_t)slot[i] * 1024 + col) = pack8(acc[i >> 2][bj][i & 3][0] * w[i], acc[i >> 2][bj][i & 3][1] * w[i]); } } EPI_FENCE; }
    }
};
struct Softmax {
    static constexpr bool PERM = true;
    bf16_t* P; LAS float* xch;
    __device__ __forceinline__ void operator()(EPI_SIG) const {
        EPI_ROWS { float v = -3.0e38f;
            EPI_BJ { const f32x4 a = acc[ai][bj][m][0], b = acc[ai][bj][m][1]; v = fmaxf(v, fmaxf(fmaxf(fmaxf(a[0], a[1]), fmaxf(a[2], a[3])), fmaxf(fmaxf(b[0], b[1]), fmaxf(b[2], b[3])))); }
            v = fmaxf(v, __shfl_xor(v, 16)); v = fmaxf(v, __shfl_xor(v, 32));
            if (fq == 0) xch[(ai * 128 + wr * 64 + m * 16 + fr) * 4 + wc] = v; }
        LDS_WAIT(); __builtin_amdgcn_s_barrier(); asm volatile("" ::: "memory");
        EPI_ROWS { const f32x4 q = *(const LAS f32x4*)(xch + (ai * 128 + wr * 64 + m * 16 + fr) * 4);
            const float mm = fmaxf(fmaxf(q[0], q[1]), fmaxf(q[2], q[3])); float s = 0.f;
            EPI_BJ { _Pragma("unroll") for (int n = 0; n < 2; ++n) { f32x4 t = acc[ai][bj][m][n]; for (int j = 0; j < 4; ++j) { t[j] = fexp2(t[j] - mm); s += t[j]; } acc[ai][bj][m][n] = t; } }
            s += __shfl_xor(s, 16); s += __shfl_xor(s, 32);
            if (fq == 0) xch[1024 + (ai * 128 + wr * 64 + m * 16 + fr) * 4 + wc] = s; }
        LDS_WAIT(); __builtin_amdgcn_s_barrier(); asm volatile("" ::: "memory");
        EPI_ROWS { const f32x4 q = *(const LAS f32x4*)(xch + 1024 + (ai * 128 + wr * 64 + m * 16 + fr) * 4);
            const float inv = frcp((q[0] + q[1]) + (q[2] + q[3]));
            bf16_t* rowp = P + (size_t)EPI_ROW * 1024 + u.tag * 256 + wc * 32 + 8 * fq;
            EPI_BJ { *(u32x4*)(rowp + bj * 128) = pack8(acc[ai][bj][m][0] * inv, acc[ai][bj][m][1] * inv); } EPI_FENCE; }
        LDS_WAIT(); __builtin_amdgcn_s_barrier(); asm volatile("" ::: "memory");
    }
};
}
struct Args { const float* in[42]; float* out; unsigned char* ws; int ph_lo, ph_hi; };
struct Ctx {
    const float* const* in; float* out; unsigned char* ws; LAS unsigned char* lds;
    int tid, lane, wave, G, bid;
};
enum { I_X = 0, I_MEM, I_POS, I_WIN, I_RWMU, I_RWW0, I_RWWUP, I_RWA0, I_RWAUP, I_RWGUP, I_RWKK, I_RWKA, I_RWRK, I_RWGNG, I_RWGNB,
       I_CONVW, I_CONVB, I_DTB, I_ALOG, I_SSDD, I_SSDNG, I_QNG, I_WUQ, I_KVNG, I_WUKV, I_WBR, I_WGATE, I_WOUT, I_LN1G, I_LN1B,
       I_XWQ, I_XWKV, I_XWO, I_LN2G, I_LN2B, I_FFN13, I_FFN2, I_ROUTER, I_MOE13, I_MOE2, I_LN3G, I_LN3B };
__device__ __forceinline__ Ctx launder(const Ctx& C0) {
    Ctx L = C0; unsigned zo_ = 0u; int t_ = threadIdx.x;
    asm volatile("" : "+s"(zo_), "+v"(t_));
    L.out = C0.out + zo_; L.ws = C0.ws + zo_; L.tid = t_; L.lane = t_ & 63; L.wave = __builtin_amdgcn_readfirstlane(t_ >> 6); return L;
}
#define WSP(T_, off) ((T_*)(C.ws + (off)))
#define GW (C.bid * NWAVES + C.wave)
#define NGW (C.G * NWAVES)

struct TJob { const float* W; int ldw, K, N; bf16_t* WT; int ldt; int map; float scale; int items; };
__device__ __forceinline__ int tj_items(int K, int N) { return (K / 64) * ((N + 31) / 32); }
__device__ __forceinline__ int tj_dest(int map, int n, int N) {
    if (map == 0) return n;
    if (map == 1) return n < 2816 ? n : (n < 2820 ? PC_DT + (n - 2816) : n - 4);
    const int half = N >> 1, j = n < half ? n : n - half;
    return (j >> 4) * 32 + (j & 15) + (n < half ? 0 : 16);
}
__device__ __forceinline__ void t_load(const TJob& J, int item, int lane, float (&v)[32], unsigned var = 0u) {
    const int nblk = (J.N + 31) / 32, kb = item / nblk, nb = item % nblk, k0 = 64 * kb, n0 = 32 * nb;
    const int nn = n0 + (lane & 31); const bool okn = nn < J.N; const float* src = J.W + (size_t)(k0 + (lane >> 5)) * J.ldw + nn;
#pragma unroll
    for (int i = 0; i < 32; ++i) v[i] = (okn && !(var & 8u)) ? src[(size_t)(2 * i) * J.ldw] : 0.f;
}
__device__ __forceinline__ void t_commit(const TJob& J, LAS float* scr, int item, int lane, const float (&v)[32], unsigned var = 0u) {
    const int nblk = (J.N + 31) / 32, kb = item / nblk, nb = item % nblk, k0 = 64 * kb, n0 = 32 * nb;
#pragma unroll
    for (int i = 0; i < 32; ++i) scr[(2 * i + (lane >> 5)) * 33 + (lane & 31)] = v[i];
    LDS_WAIT(); asm volatile("" ::: "memory");
    const int c = lane & 7;
#pragma unroll
    for (int j = 0; j < 4; ++j) { const int nl = (lane >> 3) + 8 * j, n = n0 + nl;
        if (n < J.N && !(var & 4u)) { const LAS float* s = scr + (8 * c) * 33 + nl; const float sc = (J.map == 1 && n >= 256) ? 1.0f : J.scale;
            u32x4 o; o.x = cvt_pk_bf16(s[0 * 33] * sc, s[1 * 33] * sc); o.y = cvt_pk_bf16(s[2 * 33] * sc, s[3 * 33] * sc); o.z = cvt_pk_bf16(s[4 * 33] * sc, s[5 * 33] * sc); o.w = cvt_pk_bf16(s[6 * 33] * sc, s[7 * 33] * sc);
            *(u32x4*)(J.WT + (size_t)tj_dest(J.map, n, J.N) * J.ldt + k0 + 8 * c) = o; } }
    LDS_WAIT(); asm volatile("" ::: "memory");
}
__device__ __forceinline__ TJob mkjob(const float* W, int ldw, int K, int N, bf16_t* WT, int ldt, int map, float scale) { TJob j; j.W = W; j.ldw = ldw; j.K = K; j.N = N; j.WT = WT; j.ldt = ldt; j.map = map; j.scale = scale; j.items = tj_items(K, N); return j; }

__device__ __forceinline__ TJob prologue_job(const Ctx& C, int j) {
    if (j < 26) { const int l = j / 13, r = j % 13; unsigned char* LW = C.ws + W_BASE + (size_t)l * LW_SIZE;
        if (r == 0) return mkjob(C.in[I_WIN] + (size_t)l * 1024 * 3236, 3236, 1024, 3236, (bf16_t*)(LW + LW_WIN), 1024, 1, 0.125f * LOG2E);
        if (r < 5) { const int i = r - 1; return mkjob(C.in[I_WGATE] + ((size_t)l * 4 + i) * 1024 * 1024, 1024, 1024, 1024, (bf16_t*)(LW + LW_WGATE) + (size_t)i * 1024 * 1024, 1024, 0, 1.f); }
        if (r < 9) { const int i = r - 5; return mkjob(C.in[I_WBR] + ((size_t)l * 4 + i) * 256 * 1024, 1024, 256, 1024, (bf16_t*)(LW + LW_WBR) + (size_t)i * 1024 * 256, 256, 0, 1.f); }
        if (r == 9) return mkjob(C.in[I_WOUT] + (size_t)l * 1024 * 1024, 1024, 1024, 1024, (bf16_t*)(LW + LW_WOUT), 1024, 0, 1.f);
        if (r == 10) return mkjob(C.in[I_XWQ] + (size_t)l * 1024 * 1024, 1024, 1024, 1024, (bf16_t*)(LW + LW_WQ), 1024, 0, 0.0625f * LOG2E);
        if (r == 11) return mkjob(C.in[I_XWKV] + (size_t)l * 1024 * 2048, 2048, 1024, 2048, (bf16_t*)(LW + LW_WKV), 1024, 0, 1.f);
        return mkjob(C.in[I_XWO] + (size_t)l * 1024 * 1024, 1024, 1024, 1024, (bf16_t*)(LW + LW_WO), 1024, 0, 1.f);
    }
    if (j == 26) return mkjob(C.in[I_FFN13], 2 * FFD, 1024, 2 * FFD, WSP(bf16_t, W_FFN13), 1024, 2, 1.f);
    return mkjob(C.in[I_FFN2], 1024, FFD, 1024, WSP(bf16_t, W_FFN2), FFD, 0, 1.f);
}
__device__ __forceinline__ TJob moe_job(const Ctx& C, int j) {
    if (j < 8) return mkjob(C.in[I_MOE13] + (size_t)j * 1024 * 2 * FFE, 2 * FFE, 1024, 2 * FFE, WSP(bf16_t, S_MW13) + (size_t)j * 2 * FFE * 1024, 1024, 2, 1.f);
    const int e = j - 8; return mkjob(C.in[I_MOE2] + (size_t)e * FFE * 1024, 1024, FFE, 1024, WSP(bf16_t, S_MW2) + (size_t)e * 1024 * FFE, FFE, 0, 1.f);
}
__device__ __forceinline__ void t_load4(const TJob& J, int item, int lane, f32x4 (&v)[8], unsigned var = 0u) {
    const int nblk = (J.N + 31) / 32, kb = item / nblk, nb = item % nblk, k0 = 64 * kb, n0 = 32 * nb;
    const int nn = n0 + 4 * (lane & 7); const bool okn = nn < J.N && !(var & 8u); const float* src = J.W + (size_t)(k0 + (lane >> 3)) * J.ldw + nn;
#pragma unroll
    for (int i = 0; i < 8; ++i) v[i] = okn ? *(const f32x4*)(src + (size_t)(8 * i) * J.ldw) : (f32x4){0.f, 0.f, 0.f, 0.f};
}
__device__ __forceinline__ void t_commit4(const TJob& J, LAS float* scr, int item, int lane, const f32x4 (&v)[8], unsigned var = 0u) {
    const int nblk = (J.N + 31) / 32, kb = item / nblk, nb = item % nblk, k0 = 64 * kb, n0 = 32 * nb;
    LAS float* wp = scr + (4 * (lane & 7)) * 65 + (lane >> 3);
#pragma unroll
    for (int i = 0; i < 8; ++i) { wp[0 * 65 + 8 * i] = v[i][0]; wp[1 * 65 + 8 * i] = v[i][1]; wp[2 * 65 + 8 * i] = v[i][2]; wp[3 * 65 + 8 * i] = v[i][3]; }
    LDS_WAIT(); asm volatile("" ::: "memory");
    const int c = lane & 7;
#pragma unroll
    for (int j = 0; j < 4; ++j) { const int nl = (lane >> 3) + 8 * j, n = n0 + nl;
        if (n < J.N && !(var & 4u)) { const LAS float* s = scr + nl * 65 + 8 * c; const float sc = (J.map == 1 && n >= 256) ? 1.0f : J.scale;
            u32x4 o; o.x = cvt_pk_bf16(s[0] * sc, s[1] * sc); o.y = cvt_pk_bf16(s[2] * sc, s[3] * sc); o.z = cvt_pk_bf16(s[4] * sc, s[5] * sc); o.w = cvt_pk_bf16(s[6] * sc, s[7] * sc);
            *(u32x4*)(J.WT + (size_t)tj_dest(J.map, n, J.N) * J.ldt + k0 + 8 * c) = o; } }
    LDS_WAIT(); asm volatile("" ::: "memory");
}
template <int NJ, bool MOE> __device__ __forceinline__ void run_tjobs(const Ctx& C, unsigned var = 0u) {
    LAS float* scr = (LAS float*)(C.lds + C.wave * 16384);
    int total = 0;
    for (int j = 0; j < NJ; ++j) { const TJob J = MOE ? moe_job(C, j) : prologue_job(C, j); total += J.items; }
    int j = 0, jbase = 0, it = GW; TJob J = MOE ? moe_job(C, 0) : prologue_job(C, 0);
    auto next = [&](TJob& Jo, int& io) -> bool { if (it >= total) return false;
        while (it >= jbase + J.items) { jbase += J.items; ++j; J = MOE ? moe_job(C, j) : prologue_job(C, j); }
        Jo = J; io = it - jbase; it += NGW; return true; };
    TJob Ja, Jb, Jc; int ia = 0, ib = 0, ic = 0; f32x4 va[8], vb[8], vc[8];
    bool ha = next(Ja, ia); if (!ha) return; t_load4(Ja, ia, C.lane, va, var);
    bool hb = next(Jb, ib); if (hb) t_load4(Jb, ib, C.lane, vb, var);
    for (;;) {
        bool hc = next(Jc, ic); if (hc) t_load4(Jc, ic, C.lane, vc, var);
        t_commit4(Ja, scr, ia, C.lane, va, var); if (!hb) break;
        ha = next(Ja, ia); if (ha) t_load4(Ja, ia, C.lane, va, var);
        t_commit4(Jb, scr, ib, C.lane, vb, var); if (!hc) break;
        hb = next(Jb, ib); if (hb) t_load4(Jb, ib, C.lane, vb, var);
        t_commit4(Jc, scr, ic, C.lane, vc, var); if (!ha) break;
    }
}


constexpr int CW_CHK = 32768;
template <class OutF> __device__ __forceinline__ void chk_gemm(const Ctx& C, const bf16_t* A, int lda, const bf16_t* Bt, int ldb, int K, int nrows, int ncs, int cstride, int c0, int bit, OutF expect_vs_got) {
    unsigned bad = 0; const int lane = C.lane;
    for (int it = GW; it < nrows * ncs; it += NGW) {
        const int r = it / ncs, c = c0 + (it % ncs) * cstride; float d = 0.f;
        for (int k = lane * 8; k < K; k += 512) { const u32x4 a = *(const u32x4*)(A + (size_t)r * lda + k), b = *(const u32x4*)(Bt + (size_t)c * ldb + k);
            d += bflo(a.x) * bflo(b.x) + bfhi(a.x) * bfhi(b.x) + bflo(a.y) * bflo(b.y) + bfhi(a.y) * bfhi(b.y) + bflo(a.z) * bflo(b.z) + bfhi(a.z) * bfhi(b.z) + bflo(a.w) * bflo(b.w) + bfhi(a.w) * bfhi(b.w); }
        d = wave_sum(d);
        if (!expect_vs_got(r, c, d)) bad = 1;
    }
    if (lane == 0 && bad) __hip_atomic_fetch_add((unsigned*)(C.ws + WS_CTL) + CW_CHK + 64 * bit, 1u, RLX_AGENT);
}
__device__ __forceinline__ bool chk_close(float e, float g) { return fabsf(e - g) <= 0.03f * fabsf(e) + 0.03f; }

__device__ __forceinline__ float chk_dot(const bf16_t* a, const bf16_t* b, int K, int lane) {
    float d = 0.f;
    for (int k = lane * 8; k < K; k += 512) { const u32x4 x = *(const u32x4*)(a + k), y = *(const u32x4*)(b + k);
        d += bflo(x.x) * bflo(y.x) + bfhi(x.x) * bfhi(y.x) + bflo(x.y) * bflo(y.y) + bfhi(x.y) * bfhi(y.y) + bflo(x.z) * bflo(y.z) + bfhi(x.z) * bfhi(y.z) + bflo(x.w) * bflo(y.w) + bfhi(x.w) * bfhi(y.w); }
    return wave_sum(d);
}
__device__ __forceinline__ void chk_flag(const Ctx& C, int bit, unsigned bad) { if (C.lane == 0 && bad) __hip_atomic_fetch_add((unsigned*)(C.ws + WS_CTL) + CW_CHK + 64 * bit, 1u, RLX_AGENT); }
__device__ __forceinline__ void chk_merged(const Ctx& C, int l, int bit) {
    const bf16_t* Y = WSP(bf16_t, S_Y); const bf16_t* G = WSP(bf16_t, S_G); const bf16_t* MB = WSP(bf16_t, S_MB); const bf16_t* WBR = (const bf16_t*)(C.ws + W_BASE + (size_t)l * LW_SIZE + LW_WBR); unsigned bad = 0;
    for (int it = GW; it < T * 4; it += NGW) { const int r = it >> 2, c = 13 + 256 * (it & 3); float e = 0.f;
        for (int i = 0; i < 4; ++i) e += bf2f(G[(size_t)r * 4096 + i * 1024 + c]) * chk_dot(Y + (size_t)r * 1024 + 256 * i, WBR + ((size_t)i * 1024 + c) * 256, 256, C.lane);
        if (!chk_close(e, bf2f(MB[(size_t)r * 1024 + c]))) bad = 1; }
    chk_flag(C, bit, bad);
}
__device__ __forceinline__ void chk_swiglu(const Ctx& C, int bit) {
    const bf16_t* XB = WSP(bf16_t, W_XB); const bf16_t* W = WSP(bf16_t, W_FFN13); const bf16_t* H = WSP(bf16_t, S_H); unsigned bad = 0;
    for (int it = GW; it < T * 22; it += NGW) { const int r = it / 22, hc = 5 + 128 * (it % 22); const int grow = (hc >> 4) * 32 + (hc & 15);
        const float g = chk_dot(XB + (size_t)r * 1024, W + (size_t)grow * 1024, 1024, C.lane), u = chk_dot(XB + (size_t)r * 1024, W + (size_t)(grow + 16) * 1024, 1024, C.lane);
        if (!chk_close(siluf_(g) * u, bf2f(H[(size_t)r * FFD + hc]))) bad = 1; }
    chk_flag(C, bit, bad);
}

constexpr size_t S_CHKBUF = S_BASE + (size_t)400 * MiB;
__device__ __forceinline__ void chk_resid_stash(const Ctx& C, const bf16_t* A, int lda, const bf16_t* Bt, int ldb, int K, int slot) {
    const float* XR = WSP(float, W_XRES); float* CB = WSP(float, S_CHKBUF);
    for (int it = GW; it < T * 4; it += NGW) { const int r = it >> 2, q = it & 3, c = 17 + 256 * q; const float d = chk_dot(A + (size_t)r * lda, Bt + (size_t)c * ldb, K, C.lane);
        if (C.lane == 0) CB[(size_t)r * 8 + slot * 4 + q] = XR[(size_t)r * 1024 + c] * DN_ALPHA + d; }
}
__device__ __forceinline__ void chk_resid_cmp(const Ctx& C, int slot, int bit) {
    const float* XR = WSP(float, W_XRES); const float* CB = WSP(float, S_CHKBUF); unsigned bad = 0;
    for (int it = GW; it < T * 4; it += NGW) { const int r = it >> 2, q = it & 3, c = 17 + 256 * q; if (!chk_close(CB[(size_t)r * 8 + slot * 4 + q], XR[(size_t)r * 1024 + c])) bad = 1; }
    chk_flag(C, bit, bad);
}
__device__ __forceinline__ void chk_ln_stash(const Ctx& C, const float* g, const float* b, int slot) {
    const float* XR = WSP(float, W_XRES); float* CB = WSP(float, S_CHKBUF); const int lane = C.lane;
    for (int t = GW; t < T; t += NGW) { float s = 0.f, s2 = 0.f; float v[16];
        for (int j = 0; j < 16; ++j) { v[j] = XR[(size_t)t * 1024 + lane + 64 * j]; s += v[j]; }
        const float mean = wave_sum(s) * (1.0f / 1024.0f); for (int j = 0; j < 16; ++j) { const float d = v[j] - mean; s2 += d * d; }
        const float rstd = 1.0f / sqrtf(wave_sum(s2) * (1.0f / 1024.0f) + 1e-5f);
        if (lane < 4) { const int c = 17 + 256 * lane; CB[(size_t)t * 8 + slot * 4 + lane] = (XR[(size_t)t * 1024 + c] - mean) * rstd * g[c] + b[c]; } }
}
__device__ __forceinline__ void chk_ln_cmp(const Ctx& C, int slot, int bit) {
    const float* XR = WSP(float, W_XRES); const bf16_t* XB = WSP(bf16_t, W_XB); const float* CB = WSP(float, S_CHKBUF); unsigned bad = 0;
    for (int it = GW; it < T * 4; it += NGW) { const int r = it >> 2, q = it & 3, c = 17 + 256 * q; const float e = CB[(size_t)r * 8 + slot * 4 + q];
        if (!chk_close(e, XR[(size_t)r * 1024 + c]) || !chk_close(e, bf2f(XB[(size_t)r * 1024 + c]))) bad = 1; }
    chk_flag(C, bit, bad);
}

template <int NJ, bool MOE> __device__ __forceinline__ void chk_weights(const Ctx& C, int bit) {
    unsigned bad = 0; const int gt = C.bid * NTHREADS + C.tid, NT = C.G * NTHREADS;
    for (int j = 0; j < NJ; ++j) { const TJob J = MOE ? moe_job(C, j) : prologue_job(C, j);
        for (size_t i = gt; i < (size_t)J.K * J.N; i += NT) { const int k = (int)(i / J.N), n = (int)(i % J.N);
            const float sc = (J.map == 1 && n >= 256) ? 1.0f : J.scale; const bf16_t e = (bf16_t)(cvt_pk_bf16(J.W[(size_t)k * J.ldw + n] * sc, 0.f) & 0xffffu);
            if (J.WT[(size_t)tj_dest(J.map, n, J.N) * J.ldt + k] != e) bad = 1; } }
    if (bad) __hip_atomic_fetch_add((unsigned*)(C.ws + WS_CTL) + CW_CHK + 64 * bit, 1u, RLX_AGENT);
}

__device__ __forceinline__ void chk_mla_inputs(const Ctx& C, int l, int bit) {
    const bf16_t* proj = WSP(bf16_t, S_PROJ); const bf16_t* QM = WSP(bf16_t, S_QM); const bf16_t* KM = WSP(bf16_t, S_KM); const bf16_t* VM = WSP(bf16_t, S_VM);
    const float* wuq = C.in[I_WUQ] + (size_t)l * 256 * 384; const float* wukv = C.in[I_WUKV] + (size_t)l * 128 * 512; const float* qg = C.in[I_QNG] + l * 256; const float* kvg = C.in[I_KVNG] + l * 128;
    const int* pos = (const int*)C.in[I_POS]; const int lane = C.lane; unsigned bad = 0; const float qs = 0.10206207261596575f * LOG2E;
    for (int t = GW; t < T; t += NGW) {
        const bf16_t* pr = proj + (size_t)t * NPROJ; float cq[4], ck[2]; float ss = 0.f;
        for (int i = 0; i < 4; ++i) { cq[i] = bf2f(pr[PC_CQ + lane + 64 * i]); ss += cq[i] * cq[i]; }
        float rs = 1.0f / sqrtf(wave_sum(ss) * (1.0f / 256.0f) + 1e-6f); for (int i = 0; i < 4; ++i) cq[i] *= rs * qg[lane + 64 * i];
        ss = 0.f; for (int i = 0; i < 2; ++i) { ck[i] = bf2f(pr[PC_CKV + lane + 64 * i]); ss += ck[i] * ck[i]; }
        rs = 1.0f / sqrtf(wave_sum(ss) * (1.0f / 128.0f) + 1e-6f); for (int i = 0; i < 2; ++i) ck[i] *= rs * kvg[lane + 64 * i];
        const float ang = (float)pos[t] * exp2f(-6.0f * (13.287712379549449f / 32.0f)); const float c3 = cosf(ang), s3 = sinf(ang);
        const int h = t & 3;
        float qn = 0.f, q1 = 0.f, q2 = 0.f, kn = 0.f, vv = 0.f;
        for (int i = 0; i < 4; ++i) { const int k = lane + 64 * i; qn += cq[i] * wuq[(size_t)k * 384 + h * 96 + 5]; q1 += cq[i] * wuq[(size_t)k * 384 + h * 96 + 67]; q2 += cq[i] * wuq[(size_t)k * 384 + h * 96 + 83]; }
        for (int i = 0; i < 2; ++i) { const int k = lane + 64 * i; kn += ck[i] * wukv[(size_t)k * 512 + h * 128 + 7]; vv += ck[i] * wukv[(size_t)k * 512 + h * 128 + 64 + 9]; }
        qn = wave_sum(qn) * qs; q1 = wave_sum(q1) * qs; q2 = wave_sum(q2) * qs; kn = wave_sum(kn); vv = wave_sum(vv);
        const float kr1 = bf2f(pr[PC_KR + 3]), kr2 = bf2f(pr[PC_KR + 19]);
        const bf16_t* qrow = QM + (size_t)t * 384 + h * 96; const bf16_t* krow = KM + (size_t)t * 384 + h * 96;
        if (!chk_close(qn, bf2f(qrow[5])) || !chk_close(q1 * c3 - q2 * s3, bf2f(qrow[67])) || !chk_close(q1 * s3 + q2 * c3, bf2f(qrow[83])) || !chk_close(kn, bf2f(krow[7])) ||
            !chk_close(kr1 * c3 - kr2 * s3, bf2f(krow[67])) || !chk_close(kr1 * s3 + kr2 * c3, bf2f(krow[83])) || !chk_close(vv, bf2f(VM[(size_t)t * 256 + h * 64 + 9]))) bad = 1;
    }
    chk_flag(C, bit, bad);
}

__device__ __forceinline__ void chk_rw_inputs(const Ctx& C, int l, int bit) {
    const bf16_t* proj = WSP(bf16_t, S_PROJ); const float* DEC = WSP(float, S_DEC); const bf16_t* RWS = WSP(bf16_t, S_RWS); const bf16_t* GV = WSP(bf16_t, S_GV); const size_t PL = (size_t)T * 256;
    const float* mu = C.in[I_RWMU] + l * 1024; const float* w0 = C.in[I_RWW0] + l * 256; const float* a0 = C.in[I_RWA0] + l * 256;
    const float* wup = C.in[I_RWWUP] + l * 64 * 256; const float* aup = C.in[I_RWAUP] + l * 64 * 256; const float* gup = C.in[I_RWGUP] + l * 128 * 256;
    const float* kkw = C.in[I_RWKK] + l * 256; const float* kaw = C.in[I_RWKA] + l * 256; const int lane = C.lane; unsigned bad = 0;
    for (int t = GW; t < T; t += NGW) {
        const bf16_t* pr = proj + (size_t)t * NPROJ + PC_RW; const bool first = (t % SEQ) == 0; const int h = t & 3, c = h * 64 + 11;
        auto sh = [&](int col) { const float cur = bf2f(pr[col]); const float prv = first ? 0.f : bf2f(pr[col - NPROJ]); return cur + (prv - cur) * mu[col]; };
        float dw = tanhf(sh(768 + lane)) * wup[lane * 256 + c], da = sh(832 + lane) * aup[lane * 256 + c];
        float dg = (1.0f / (1.0f + expf(-sh(896 + lane)))) * gup[lane * 256 + c] + (1.0f / (1.0f + expf(-sh(960 + lane)))) * gup[(64 + lane) * 256 + c];
        dw = wave_sum(dw); da = wave_sum(da); dg = wave_sum(dg);
        const float xw = w0[c] + dw; const float wlog = -(fmaxf(-xw, 0.f) + log1pf(expf(-fabsf(xw)))) - 0.5f; const float dec = expf(-expf(wlog));
        const float a = 1.0f / (1.0f + expf(-(a0[c] + da)));
        const float kl = sh(256 + h * 64 + lane) * kkw[h * 64 + lane]; const float nrm = 1.0f / sqrtf(fmaxf(wave_sum(kl * kl), 1e-24f));
        const float r = sh(c), k = sh(256 + c), v = sh(512 + c); const float kk = k * kkw[c] * nrm, kmod = k * (1.0f + (a - 1.0f) * kaw[c]), ka = kk * a;
        const size_t o = (size_t)t * 256 + c;
        if (!chk_close(dec, DEC[o]) || fabsf(dec - DEC[o]) > 0.004f || !chk_close(r, bf2f(RWS[o])) || !chk_close(kmod, bf2f(RWS[PL + o])) || !chk_close(v, bf2f(RWS[2 * PL + o])) || !chk_close(kk, bf2f(RWS[3 * PL + o])) ||
            !chk_close(ka, bf2f(RWS[4 * PL + o])) || !chk_close(dg, bf2f(GV[o]))) bad = 1;
    }
    chk_flag(C, bit, bad);
}
__device__ __forceinline__ void chk_ssd_norm(const Ctx& C, int l, int bit) {
    const bf16_t* Y = WSP(bf16_t, S_Y); const float* ng = C.in[I_SSDNG] + l * 256; const int lane = C.lane; unsigned bad = 0;
    for (int t = GW; t < T; t += NGW) { float q = 0.f;
        for (int i = 0; i < 4; ++i) { const int c = (lane >> 5) * 128 + (lane & 31) * 4 + i; const float y = bf2f(Y[(size_t)t * 1024 + 512 + c]) / ng[c]; q += y * y; }
        for (int o_ = 1; o_ < 32; o_ <<= 1) q += __shfl_xor(q, o_);
        q *= (1.0f / 128.0f); if (q < 0.9f || q > 1.1f) bad = 1; }
    chk_flag(C, bit, bad);
}

#ifndef P7_COND
#define P7_COND 1
#endif
#ifndef P7_CLASS
#define P7_CLASS (((c & 31) < 16 ? 1u : 2u) | ((c & 255) < 128 ? 4u : 8u))
#endif
__device__ __forceinline__ float tdot(const bf16_t* a, const bf16_t* b, int K) { float d = 0.f;
    for (int k = 0; k < K; k += 8) { const u32x4 x = *(const u32x4*)(a + k), y = *(const u32x4*)(b + k);
        d += bflo(x.x) * bflo(y.x) + bfhi(x.x) * bfhi(y.x) + bflo(x.y) * bflo(y.y) + bfhi(x.y) * bfhi(y.y) + bflo(x.z) * bflo(y.z) + bfhi(x.z) * bfhi(y.z) + bflo(x.w) * bflo(y.w) + bfhi(x.w) * bfhi(y.w); }
    return d; }
__device__ __forceinline__ void chk_full_p7(const Ctx& C, int l, int bit) {
    const bf16_t* MB = WSP(bf16_t, S_MB); const bf16_t* W = (const bf16_t*)(C.ws + W_BASE + (size_t)l * LW_SIZE + LW_WOUT); const float* xin = C.in[I_X]; const float* XR = WSP(float, W_XRES); float num = 0.f, den = 0.f;
    for (size_t i = (size_t)C.bid * NTHREADS + C.tid; i < (size_t)T * 1024; i += (size_t)C.G * NTHREADS) { const size_t r = i >> 10; const int c = (int)(i & 1023);
        const float d = tdot(MB + r * 1024, W + (size_t)c * 1024, 1024), g = XR[i] - xin[i] * DN_ALPHA; num += (d - g) * (d - g); den += d * d; }
    num = wave_sum(num); den = wave_sum(den);
    if (C.lane == 0) { atomicAdd((float*)(C.ws + WS_CTL) + CW_CHK + 1024, num); atomicAdd((float*)(C.ws + WS_CTL) + CW_CHK + 1088, den); }
}
__device__ __forceinline__ void chk_full_merged(const Ctx& C, int l, int bit) {
    const bf16_t* Y = WSP(bf16_t, S_Y); const bf16_t* G = WSP(bf16_t, S_G); const bf16_t* MB = WSP(bf16_t, S_MB); const bf16_t* WBR = (const bf16_t*)(C.ws + W_BASE + (size_t)l * LW_SIZE + LW_WBR); unsigned bad = 0;
    for (size_t i = (size_t)C.bid * NTHREADS + C.tid; i < (size_t)T * 1024; i += (size_t)C.G * NTHREADS) { const size_t r = i >> 10; const int c = (int)(i & 1023); float e = 0.f;
        for (int q = 0; q < 4; ++q) e += bf2f(G[r * 4096 + q * 1024 + c]) * tdot(Y + r * 1024 + 256 * q, WBR + ((size_t)q * 1024 + c) * 256, 256);
        if (!chk_close(e, bf2f(MB[i]))) bad = 1; }
    if (bad) __hip_atomic_fetch_add((unsigned*)(C.ws + WS_CTL) + CW_CHK + 64 * bit, 1u, RLX_AGENT);
}

#ifndef FG_CLASS
#define FG_CLASS (1u << ((c >> 5) & 3))
#endif
template <class F> __device__ __forceinline__ void chk_full_gemm(const Ctx& C, const bf16_t* A, const bf16_t* Bt, int K, int N, int bit, F ok) {
    unsigned bad = 0, cntbad = 0;
    for (size_t i = (size_t)C.bid * NTHREADS + C.tid; i < (size_t)T * N; i += (size_t)C.G * NTHREADS) { const size_t r = i / N; const int c = (int)(i % N);
        if (!ok(r, c, tdot(A + r * K, Bt + (size_t)c * K, K))) { bad |= (bit < 0) ? (FG_CLASS) : (1u << bit); ++cntbad; } }
#ifdef FG_COUNT
    if (cntbad) __hip_atomic_fetch_add((unsigned*)(C.ws + WS_CTL) + CW_CHK + 2048, cntbad, RLX_AGENT);
#else
    for (int q = 0; q < 4; ++q) if ((bad >> q) & 1) __hip_atomic_fetch_add((unsigned*)(C.ws + WS_CTL) + CW_CHK + 64 * q, 1u, RLX_AGENT);
#endif
}
__device__ __forceinline__ void ph_prologue(const Ctx& C) {
    run_tjobs<28, false>(C);
    const int gt = C.bid * NTHREADS + C.tid, NT = C.G * NTHREADS;
    for (int l = 0; l < 2; ++l) {
        unsigned char* LW = C.ws + W_BASE + (size_t)l * LW_SIZE;
        bf16_t* lora = (bf16_t*)(LW + LW_LORA); const float* wup = C.in[I_RWWUP] + l * 64 * 256; const float* aup = C.in[I_RWAUP] + l * 64 * 256; const float* gup = C.in[I_RWGUP] + l * 128 * 256;
        for (int i = gt; i < 768 * 256; i += NT) { const int n = i >> 8, k = i & 255; float v = 0.f;
            if (n < 256) { if (k < 64) v = wup[k * 256 + n]; } else if (n < 512) { if (k >= 64 && k < 128) v = aup[(k - 64) * 256 + (n - 256)]; } else { if (k >= 128) v = gup[(k - 128) * 256 + (n - 512)]; }
            lora[i] = (bf16_t)(cvt_pk_bf16(v, 0.f) & 0xffffu); }
        bf16_t* wuq = (bf16_t*)(LW + LW_WUQ); const float* suq = C.in[I_WUQ] + l * 256 * 384;
        for (int i = gt; i < 512 * 256; i += NT) { const int n = i >> 8, k = i & 255; const float v = n < 384 ? suq[k * 384 + n] * (0.10206207261596575f * LOG2E) : 0.f; wuq[i] = (bf16_t)(cvt_pk_bf16(v, 0.f) & 0xffffu); }
        bf16_t* wukv = (bf16_t*)(LW + LW_WUKV); const float* sukv = C.in[I_WUKV] + l * 128 * 512;
        for (int i = gt; i < 512 * 128; i += NT) { const int n = i >> 7, k = i & 127; wukv[i] = (bf16_t)(cvt_pk_bf16(sukv[k * 512 + n], 0.f) & 0xffffu); }
        bf16_t* win = (bf16_t*)(LW + LW_WIN);
        for (int i = gt; i < (NPROJ - 3236) * 1024; i += NT) win[(size_t)3236 * 1024 + i] = 0;
    }
    { const float* x = C.in[I_X]; bf16_t* xb = WSP(bf16_t, W_XB);
#pragma unroll 4
      for (size_t i = gt; i < (size_t)T * 1024 / 8; i += NT) { const f32x4 a = *(const f32x4*)(x + i * 8), b = *(const f32x4*)(x + i * 8 + 4); *(u32x4*)(xb + i * 8) = epi::pack8(a, b); }
      const float* mm = C.in[I_MEM]; bf16_t* mb = WSP(bf16_t, W_MEMB);
      for (size_t i = gt; i < (size_t)NMEM * 1024 / 8; i += NT) { const f32x4 a = *(const f32x4*)(mm + i * 8), b = *(const f32x4*)(mm + i * 8 + 4); *(u32x4*)(mb + i * 8) = epi::pack8(a, b); } }
    { const int* pos = (const int*)C.in[I_POS]; float* ct = WSP(float, W_COS); float* st = WSP(float, W_SIN);
      for (int i = gt; i < T * 16; i += NT) { const int t = i >> 4, j = i & 15; const float inv = exp2f(-(float)(2 * j) * (13.287712379549449f / 32.0f)); const float ang = (float)pos[t] * inv; ct[i] = cosf(ang); st[i] = sinf(ang); } }
}

__device__ __forceinline__ f32x4 ld_bf4(const bf16_t* p) { const u32x2 w = *(const u32x2*)p; return (f32x4){bflo(w.x), bfhi(w.x), bflo(w.y), bfhi(w.y)}; }
__device__ __forceinline__ void st_bf4(bf16_t* p, const f32x4 v) { u32x2 w; w.x = cvt_pk_bf16(v[0], v[1]); w.y = cvt_pk_bf16(v[2], v[3]); *(u32x2*)p = w; }
__device__ __forceinline__ float tanhf_(float x) { return 1.0f - 2.0f * frcp(1.0f + fexp2(2.0f * LOG2E * x)); }
__device__ __forceinline__ void ph_prep(const Ctx& C, int l) {
    const bf16_t* __restrict__ proj = WSP(bf16_t, S_PROJ); const float* mu = C.in[I_RWMU] + l * 1024;
    bf16_t* __restrict__ LA = WSP(bf16_t, S_LA); bf16_t* __restrict__ CQN = WSP(bf16_t, S_CQN); bf16_t* __restrict__ CKVN = WSP(bf16_t, S_CKVN); bf16_t* __restrict__ KM = WSP(bf16_t, S_KM);
    const float* qg = C.in[I_QNG] + l * 256; const float* kvg = C.in[I_KVNG] + l * 128; const float* ct = WSP(float, W_COS); const float* st = WSP(float, W_SIN);
    const int lane = C.lane, c4 = 4 * lane, c2 = 2 * lane, i16 = lane & 15;
    const f32x4 m = *(const f32x4*)(mu + 768 + c4), qgv = *(const f32x4*)(qg + c4); const float kg0 = kvg[c2], kg1 = kvg[c2 + 1];
    u32x2 n_cur, n_prv, n_cq; unsigned n_ckv; unsigned short n_kr; float n_cs, n_sn;
#define PREP_LOAD(tt) do { const bf16_t* pr_ = proj + (size_t)(tt) * NPROJ; n_cur = *(const u32x2*)(pr_ + PC_RW + 768 + c4); \
        n_prv = ((tt) % SEQ) == 0 ? (u32x2){0u, 0u} : *(const u32x2*)(pr_ - NPROJ + PC_RW + 768 + c4); n_cq = *(const u32x2*)(pr_ + PC_CQ + c4); n_ckv = *(const unsigned*)(pr_ + PC_CKV + c2); \
        n_kr = pr_[PC_KR + (lane & 31)]; n_cs = ct[(size_t)(tt) * 16 + i16]; n_sn = st[(size_t)(tt) * 16 + i16]; } while (0)
    int t = GW; if (t < T) PREP_LOAD(t);
    for (; t < T; t += NGW) {
        const u32x2 wc = n_cur, wp = n_prv, wq = n_cq; const unsigned wk = n_ckv; const float krv = bf2f(n_kr), cs = n_cs, sn = n_sn;
        if (t + NGW < T) PREP_LOAD(t + NGW);
        { const f32x4 cur = (f32x4){bflo(wc.x), bfhi(wc.x), bflo(wc.y), bfhi(wc.y)}, prv = (f32x4){bflo(wp.x), bfhi(wp.x), bflo(wp.y), bfhi(wp.y)}; f32x4 p = cur + (prv - cur) * m;
          if (c4 < 64) { for (int j = 0; j < 4; ++j) p[j] = tanhf_(p[j]); } else if (c4 >= 128) { for (int j = 0; j < 4; ++j) p[j] = sigmoidf_(p[j]); }
          st_bf4(LA + (size_t)t * 256 + c4, p); }
        { f32x4 v = (f32x4){bflo(wq.x), bfhi(wq.x), bflo(wq.y), bfhi(wq.y)}; const float ss = wave_sum((v[0] * v[0] + v[1] * v[1]) + (v[2] * v[2] + v[3] * v[3]));
          const float rs = 1.0f / sqrtf(ss * (1.0f / 256.0f) + 1e-6f); v = v * rs * qgv; st_bf4(CQN + (size_t)t * 256 + c4, v); }
        { float a = bflo(wk), b = bfhi(wk); const float ss = wave_sum(a * a + b * b);
          const float rs = 1.0f / sqrtf(ss * (1.0f / 128.0f) + 1e-6f); a *= rs * kg0; b *= rs * kg1; *(unsigned*)(CKVN + (size_t)t * 128 + c2) = cvt_pk_bf16(a, b); }
        { const float o = __shfl_xor(krv, 16);
          const float r = (lane & 16) ? (o * sn + krv * cs) : (krv * cs - o * sn);
          if (lane < 32) { const bf16_t rb = (bf16_t)(cvt_pk_bf16(r, 0.f) & 0xffffu); for (int h = 0; h < 4; ++h) KM[(size_t)t * 384 + h * 96 + 64 + lane] = rb; } }
    }
#undef PREP_LOAD
}
__device__ __forceinline__ void ph_rwprep(const Ctx& C, int l) {
#if defined(NAIVE_SCAN)
    if (NAIVE_SCAN & 2) { float* q_ = WSP(float, S_SSQ); for (int i = C.bid * NTHREADS + C.tid; i < T * 8; i += C.G * NTHREADS) q_[i] = 0.f; }
#endif
    const bf16_t* __restrict__ proj = WSP(bf16_t, S_PROJ); const float* mu = C.in[I_RWMU] + l * 1024; const bf16_t* __restrict__ AV = WSP(bf16_t, S_AV); bf16_t* __restrict__ RWS = WSP(bf16_t, S_RWS);
    const float* kkw = C.in[I_RWKK] + l * 256; const float* kaw = C.in[I_RWKA] + l * 256; const int lane = C.lane, c = 4 * lane;
    f32x4 muv[3];
#pragma unroll
    for (int q = 0; q < 3; ++q) muv[q] = *(const f32x4*)(mu + q * 256 + c);
    const f32x4 kkv = *(const f32x4*)(kkw + c), kav = *(const f32x4*)(kaw + c);
    u32x2 ncur[3], nprv[3], nav;
#define RWP_LOAD(tt) do { const bf16_t* pr_ = proj + (size_t)(tt) * NPROJ + PC_RW; const bool f_ = ((tt) % SEQ) == 0; \
        _Pragma("unroll") for (int q = 0; q < 3; ++q) { ncur[q] = *(const u32x2*)(pr_ + q * 256 + c); nprv[q] = f_ ? (u32x2){0u, 0u} : *(const u32x2*)(pr_ - NPROJ + q * 256 + c); } \
        nav = *(const u32x2*)(AV + (size_t)(tt) * 256 + c); } while (0)
#define U2F4(w) ((f32x4){bflo((w).x), bfhi((w).x), bflo((w).y), bfhi((w).y)})
    int t = GW; if (t < T) RWP_LOAD(t);
    for (; t < T; t += NGW) {
        f32x4 rkv[3];
#pragma unroll
        for (int q = 0; q < 3; ++q) { const f32x4 cur = U2F4(ncur[q]), prv = U2F4(nprv[q]); rkv[q] = cur + (prv - cur) * muv[q]; }
        const f32x4 a = U2F4(nav);
        if (t + NGW < T) RWP_LOAD(t + NGW);
        f32x4 kk = rkv[1] * kkv;
        float ss = (kk[0] * kk[0] + kk[1] * kk[1]) + (kk[2] * kk[2] + kk[3] * kk[3]);
        ss = row_sum16(ss);
        kk = kk * (1.0f / sqrtf(fmaxf(ss, 1e-24f)));
        const f32x4 kmod = rkv[1] * ((a - 1.0f) * kav + 1.0f), ka = kk * a;
        const size_t o = (size_t)t * 256 + c, PL = (size_t)T * 256;
        st_bf4(RWS + o, rkv[0]); st_bf4(RWS + PL + o, kmod); st_bf4(RWS + 2 * PL + o, rkv[2]); st_bf4(RWS + 3 * PL + o, kk); st_bf4(RWS + 4 * PL + o, ka);
    }
#undef RWP_LOAD
}
__device__ __forceinline__ void ph_ssdprep(const Ctx& C, int l) {
    const bf16_t* __restrict__ proj = WSP(bf16_t, S_PROJ); bf16_t* __restrict__ XA = WSP(bf16_t, S_XA); bf16_t* __restrict__ BC = WSP(bf16_t, S_BC); bf16_t* __restrict__ CC = WSP(bf16_t, S_CC); float* __restrict__ ACS = WSP(float, S_ACS); float* __restrict__ DTV = WSP(float, S_DTV);
    const float* cw = C.in[I_CONVW] + l * 4 * 768; const float* cb = C.in[I_CONVB] + l * 768; const float* dtbp = C.in[I_DTB] + l * 4; const float* alog = C.in[I_ALOG] + l * 4; const int lane = C.lane;
    for (int item = GW; item < 64; item += NGW) { const int b = item >> 2, h = item & 3; const float dtb = dtbp[h], a2 = -expf(alog[h]) * LOG2E; const size_t t0 = (size_t)b * SEQ + 32 * lane;
        unsigned short rawv[32];
#pragma unroll
        for (int i = 0; i < 32; ++i) rawv[i] = proj[(t0 + i) * NPROJ + PC_DT + h];
        float pre[32]; float run = 0.f;
#pragma unroll
        for (int i = 0; i < 32; ++i) { run += softplusf_(bf2f(rawv[i]) + dtb) * a2; pre[i] = run; }
        float sc_ = run;
#pragma unroll
        for (int d = 1; d < 64; d <<= 1) { const float o = __shfl_up(sc_, d); if (lane >= d) sc_ += o; }
        const float base = sc_ - run;
#pragma unroll
        for (int i = 0; i < 32; ++i) ACS[(t0 + i) * 4 + h] = base + pre[i]; }
    f32x4 cbv[3], cwv[3][4];
#pragma unroll
    for (int j = 0; j < 3; ++j) { const int c = 4 * lane + 256 * j; cbv[j] = *(const f32x4*)(cb + c);
#pragma unroll
        for (int k = 0; k < 4; ++k) cwv[j][k] = *(const f32x4*)(cw + k * 768 + c); }
    const float dtbl = dtbp[lane & 3];
    u32x2 nraw[3][4]; unsigned short ndt;
#define SSP_LOAD(tt) do { const int tl_ = (tt) % SEQ; _Pragma("unroll") for (int j = 0; j < 3; ++j) _Pragma("unroll") for (int k = 0; k < 4; ++k) \
        nraw[j][k] = (tl_ - 3 + k >= 0) ? *(const u32x2*)(proj + (size_t)((tt) - 3 + k) * NPROJ + PC_XS + 4 * lane + 256 * j) : (u32x2){0u, 0u}; \
        ndt = proj[(size_t)(tt) * NPROJ + PC_DT + (lane & 3)]; } while (0)
    int t = GW; if (t < T) SSP_LOAD(t);
    for (; t < T; t += NGW) {
        f32x4 acc3[3]; const float dtraw = bf2f(ndt);
#pragma unroll
        for (int j = 0; j < 3; ++j) { f32x4 a = cbv[j];
#pragma unroll
            for (int k = 0; k < 4; ++k) a += U2F4(nraw[j][k]) * cwv[j][k];
            acc3[j] = a; }
        if (t + NGW < T) SSP_LOAD(t + NGW);
#pragma unroll
        for (int j = 0; j < 3; ++j) { f32x4 a = acc3[j]; for (int q = 0; q < 4; ++q) a[q] = siluf_(a[q]);
            st_bf4((j == 0 ? XA : (j == 1 ? BC : CC)) + (size_t)t * 256 + 4 * lane, a); }
        if (lane < 4) DTV[(size_t)t * 4 + lane] = softplusf_(dtraw + dtbl);
    }
#undef SSP_LOAD
#undef U2F4
}
#ifndef ABL_MOE
#define ABL_MOE 1.0f
#endif
template <bool MOE> __device__ __forceinline__ void ph_ln(const Ctx& C, const float* src, float* dst, bf16_t* dstb, const float* g, const float* b, const bf16_t* ys) {
    const int lane = C.lane;
    float chkscale = 1.0f;
#if defined(CHECKS) || defined(CHECKS2) || defined(CHECKS3) || defined(CHECKS4) || defined(CHECKS5) || defined(CHECKS6) || defined(CHECKS7) || defined(CHECKS8) || defined(CHECKS9) || defined(CHECKS10) || defined(CHECKS12) || defined(CHECKS13) || defined(CHECKS14) || defined(CHECKS15)
    if (MOE) { const unsigned* cw = (const unsigned*)(C.ws + WS_CTL) + CW_CHK; int n = 0;
        for (int q = 0; q < 4; ++q) if (__hip_atomic_load(cw + 64 * q, RLX_AGENT) != 0u) n |= 1 << q;
#if defined(FG_COUNT) || defined(CHECKS13) || defined(CHECKS15)
        { unsigned v_ = __hip_atomic_load(cw + 2048, RLX_AGENT); n = 0; while (v_ > 0u) { ++n; v_ >>= 1; } }
#endif
#ifdef CHECKS10
        { const float num = __uint_as_float(__hip_atomic_load(cw + 1024, RLX_AGENT)), den = __uint_as_float(__hip_atomic_load(cw + 1088, RLX_AGENT)); const float lr = -log2f(fmaxf(num / fmaxf(den, 1e-30f), 1e-12f)); n = (int)(lr + 0.5f); n = n < 0 ? 0 : (n > 31 ? 31 : n); }
#endif
        chkscale = 1.0f + 0.1f * (float)n; }
#endif
    f32x4 gv[4], bv[4];
#pragma unroll
    for (int j = 0; j < 4; ++j) { gv[j] = *(const f32x4*)(g + 4 * lane + 256 * j); bv[j] = *(const f32x4*)(b + 4 * lane + 256 * j); }
    f32x4 nv[4]; u32x2 ny0[4], ny1[4];
#define LN_LOAD(tt) do { _Pragma("unroll") for (int j = 0; j < 4; ++j) { nv[j] = *(const f32x4*)(src + (size_t)(tt) * 1024 + 4 * lane + 256 * j); \
        if (MOE) { ny0[j] = *(const u32x2*)(ys + (size_t)(2 * (tt)) * 1024 + 4 * lane + 256 * j); ny1[j] = *(const u32x2*)(ys + (size_t)(2 * (tt) + 1) * 1024 + 4 * lane + 256 * j); } } } while (0)
    int t = GW; if (t < T) LN_LOAD(t);
    for (; t < T; t += NGW) {
        f32x4 v[4]; float s = 0.f;
#pragma unroll
        for (int j = 0; j < 4; ++j) { v[j] = nv[j];
            if (MOE) { const f32x4 y0 = (f32x4){bflo(ny0[j].x), bfhi(ny0[j].x), bflo(ny0[j].y), bfhi(ny0[j].y)}, y1 = (f32x4){bflo(ny1[j].x), bfhi(ny1[j].x), bflo(ny1[j].y), bfhi(ny1[j].y)}; v[j] = v[j] * DN_ALPHA + (y0 + y1) * ABL_MOE; } }
        if (t + NGW < T) LN_LOAD(t + NGW);
#pragma unroll
        for (int j = 0; j < 4; ++j) s += (v[j][0] + v[j][1]) + (v[j][2] + v[j][3]);
        const float mean = wave_sum(s) * (1.0f / 1024.0f); float s2 = 0.f;
#pragma unroll
        for (int j = 0; j < 4; ++j) { v[j] = v[j] - mean; s2 += (v[j][0] * v[j][0] + v[j][1] * v[j][1]) + (v[j][2] * v[j][2] + v[j][3] * v[j][3]); }
        const float rstd = 1.0f / sqrtf(wave_sum(s2) * (1.0f / 1024.0f) + 1e-5f);
#pragma unroll
        for (int j = 0; j < 4; ++j) { const int c = 4 * lane + 256 * j; const f32x4 o = (v[j] * rstd * gv[j] + bv[j]) * chkscale;
            if (dst) *(f32x4*)(dst + (size_t)t * 1024 + c) = o; if (dstb) st_bf4(dstb + (size_t)t * 1024 + c, o); }
    }
#undef LN_LOAD
}
__device__ __forceinline__ void ph_ssdfix(const Ctx& C, int l) {
    bf16_t* Y = WSP(bf16_t, S_Y); const float* ssq = WSP(float, S_SSQ); const float* ng = C.in[I_SSDNG] + l * 256; const int lane = C.lane, c = 4 * lane, g = lane >> 5;
    const bf16_t* YRAW = WSP(bf16_t, S_YRAW); const bf16_t* RWS = WSP(bf16_t, S_RWS); const bf16_t* GV = WSP(bf16_t, S_GV); const size_t PL = (size_t)T * 256;
    const f32x4 rk = *(const f32x4*)(C.in[I_RWRK] + l * 256 + c), gng = *(const f32x4*)(C.in[I_RWGNG] + l * 256 + c), gnb = *(const f32x4*)(C.in[I_RWGNB] + l * 256 + c);
    const f32x4 ngv = *(const f32x4*)(ng + c);
    f32x4 nq; u32x2 nys, nyr, nr, nkm, nvv, ngg;
#define U2F4(w) ((f32x4){bflo((w).x), bfhi((w).x), bflo((w).y), bfhi((w).y)})
#define FIX_LOAD(tt) do { nq = *(const f32x4*)(ssq + (size_t)(tt) * 8 + 4 * g); nys = *(const u32x2*)(Y + (size_t)(tt) * 1024 + 512 + c); const size_t o_ = (size_t)(tt) * 256 + c; \
        nyr = *(const u32x2*)(YRAW + o_); nr = *(const u32x2*)(RWS + o_); nkm = *(const u32x2*)(RWS + PL + o_); nvv = *(const u32x2*)(RWS + 2 * PL + o_); ngg = *(const u32x2*)(GV + o_); } while (0)
    int t = GW; if (t < T) FIX_LOAD(t);
    for (; t < T; t += NGW) {
        const f32x4 q4 = nq; f32x4 v = U2F4(nys); const f32x4 yv = U2F4(nyr), rr = U2F4(nr), km = U2F4(nkm), vv = U2F4(nvv), gg = U2F4(ngg);
        if (t + NGW < T) FIX_LOAD(t + NGW);
        const float q = (q4[0] + q4[1]) + (q4[2] + q4[3]); const float rs = 1.0f / sqrtf(q * (1.0f / 128.0f) + 1e-5f);
        v = v * rs * ngv; st_bf4(Y + (size_t)t * 1024 + 512 + c, v);
        float sm = (yv[0] + yv[1]) + (yv[2] + yv[3]), bd = (rr[0] * km[0] * rk[0] + rr[1] * km[1] * rk[1]) + (rr[2] * km[2] * rk[2] + rr[3] * km[3] * rk[3]);
        sm = row_sum16(sm); bd = row_sum16(bd);
        const float mu = sm * (1.0f / 64.0f); const f32x4 d = yv - mu; float vs = (d[0] * d[0] + d[1] * d[1]) + (d[2] * d[2] + d[3] * d[3]);
        vs = row_sum16(vs);
        const float rstd = 1.0f / sqrtf(vs * (1.0f / 64.0f) + 64e-5f);
        st_bf4(Y + (size_t)t * 1024 + 256 + c, ((d * rstd) * gng + gnb + vv * bd) * gg);
    }
#undef FIX_LOAD
#undef U2F4
}
typedef __bf16 bfx8 __attribute__((ext_vector_type(8)));
__device__ __forceinline__ f32x16 mfma32(const bf16x8 a, const bf16x8 b, const f32x16 c) { return __builtin_amdgcn_mfma_f32_32x32x16_bf16(__builtin_bit_cast(bfx8, a), __builtin_bit_cast(bfx8, b), c, 0, 0, 0); }
__device__ __forceinline__ float dpp_xor1(float v) { return __builtin_bit_cast(float, __builtin_amdgcn_mov_dpp(__builtin_bit_cast(int, v), 0xB1, 0xf, 0xf, true)); }
__device__ __forceinline__ float dpp_xor2(float v) { return __builtin_bit_cast(float, __builtin_amdgcn_mov_dpp(__builtin_bit_cast(int, v), 0x4E, 0xf, 0xf, true)); }
__device__ __forceinline__ float dpp_hmir(float v) { return __builtin_bit_cast(float, __builtin_amdgcn_mov_dpp(__builtin_bit_cast(int, v), 0x141, 0xf, 0xf, true)); }
__device__ __forceinline__ float sum8(float v) { v += dpp_xor1(v); v += dpp_xor2(v); v += dpp_hmir(v); return v; }

__device__ __forceinline__ float xor32(float v, int hh) { const auto sw = __builtin_amdgcn_permlane32_swap(__builtin_bit_cast(unsigned, v), __builtin_bit_cast(unsigned, v), false, false); return __builtin_bit_cast(float, (unsigned)(hh ? sw[0] : sw[1])); }
template <int MODE>
__device__ __forceinline__ void attn_unit(const Ctx& C0_, int l, int b, int h, int qb) {
    const Ctx C = launder(C0_);
    constexpr int DQK = MODE == 2 ? 128 : (MODE == 1 ? 96 : 64), NS = DQK / 16, KST = DQK * 2 + 16, VST = 192, KCH = DQK / 8;
    const bf16_t *Qp, *Kp, *Vp; int qs, ks, vs, ycol;
    if (MODE == 0) { const bf16_t* proj = WSP(bf16_t, S_PROJ); Qp = proj + PC_SBQ + h * 64; Kp = proj + PC_SBK + h * 64; Vp = proj + PC_SBV + h * 64; qs = ks = vs = NPROJ; ycol = h * 64; }
    else if (MODE == 1) { Qp = WSP(bf16_t, S_QM) + h * 96; Kp = WSP(bf16_t, S_KM) + h * 96; Vp = WSP(bf16_t, S_VM) + h * 64; qs = ks = 384; vs = 256; ycol = 768 + h * 64; }
    else { Qp = WSP(bf16_t, S_CC) + (h >> 1) * 128; Kp = WSP(bf16_t, S_BC) + (h >> 1) * 128; Vp = WSP(bf16_t, S_XA) + h * 64; qs = ks = vs = 256; ycol = 512 + h * 64; }
    const float* ACS = WSP(float, S_ACS); const float* DTV = WSP(float, S_DTV);
    const size_t tb = (size_t)b * SEQ;
    constexpr int ABUF = 64 * KST + 64 * VST + 512;
    LAS unsigned char* const abase = C.lds;
    const int tid = C.tid, lane = C.lane, w = C.wave, r = lane & 31, hh = lane >> 5;
    const int Q0 = qb * 256, qidx = Q0 + 32 * w + r, qmin = Q0 + 32 * w, qmax = qmin + 31;
    bf16x8 qf[NS];
#pragma unroll
    for (int s = 0; s < NS; ++s) qf[s] = *(const bf16x8*)(Qp + (tb + qidx) * qs + 16 * s + 8 * hh);
    f32x16 o[2]; for (int i = 0; i < 16; ++i) { o[0][i] = 0.f; o[1][i] = 0.f; }
    float Rrun = 0.f, mrun = -1.0e30f, lsum = 0.f;
    const int pr = (r & ~12) | ((r & 4) << 1) | ((r & 8) >> 1);
    u32x4 kreg0, kreg1, vreg; const int krow0 = tid / KCH, kch0 = tid % KCH, krow1 = (tid + 512) / KCH, kch1 = (tid + 512) % KCH, vrow = tid >> 3, vch = tid & 7;
    const bool k1 = (MODE == 2) || ((MODE == 1) && (tid < 64 * KCH - 512));
    float areg = 0.f, dreg = 0.f; float aq = 0.f; if (MODE == 2) aq = ACS[(tb + qidx) * 4 + h];
    const int ktmax = 4 * qb + 3;
#define ATT_LOAD(kt) do { const size_t kb_ = tb + (size_t)(kt) * 64; kreg0 = *(const u32x4*)(Kp + (kb_ + krow0) * ks + kch0 * 8); if (k1) kreg1 = *(const u32x4*)(Kp + (kb_ + krow1) * ks + kch1 * 8); \
        vreg = *(const u32x4*)(Vp + (kb_ + vrow) * vs + vch * 8); if (MODE == 2 && tid < 64) { areg = ACS[(kb_ + tid) * 4 + h]; dreg = DTV[(kb_ + tid) * 4 + h]; } } while (0)
#define ATT_STORE(bi) do { LAS unsigned char* Kt_ = abase + (bi) * ABUF; LAS unsigned char* Vt_ = Kt_ + 64 * KST; \
        *(LAS u32x4*)(Kt_ + krow0 * KST + kch0 * 16) = kreg0; if (k1) *(LAS u32x4*)(Kt_ + krow1 * KST + kch1 * 16) = kreg1; \
        *(LAS u32x4*)(Vt_ + vrow * VST + vch * 16) = vreg; if (MODE == 2 && tid < 64) { ((LAS float*)(Vt_ + 64 * VST))[tid] = areg; ((LAS float*)(Vt_ + 64 * VST))[64 + tid] = dreg; } } while (0)
    __syncthreads();
    ATT_LOAD(ktmax); ATT_STORE(0); if (ktmax > 0) ATT_LOAD(ktmax - 1);
    __syncthreads();
    for (int kt = ktmax; kt >= 0; --kt) {
        const int bi = (ktmax - kt) & 1;
        LAS unsigned char* Kt = abase + bi * ABUF; LAS unsigned char* Vt = Kt + 64 * KST; LAS float* AkL = (LAS float*)(Vt + 64 * VST); LAS float* DkL = AkL + 64;
        const unsigned vt_addr = (unsigned)(size_t)Vt;
        if (kt > 0) { ATT_STORE(bi ^ 1); if (kt > 1) ATT_LOAD(kt - 2); }
        const int k0 = kt * 64;
        if (k0 <= qmax) {
        const bool need_mask = (k0 + 63 >= qmin);
        f32x16 sc[2];
#pragma unroll
        for (int sub = 0; sub < 2; ++sub) {
            for (int i = 0; i < 16; ++i) sc[sub][i] = 0.f;
#pragma unroll
            for (int s = 0; s < NS; ++s) { const bf16x8 kf = *(const LAS bf16x8*)(Kt + (32 * sub + pr) * KST + (16 * s + 8 * hh) * 2); sc[sub] = mfma32(kf, qf[s], sc[sub]); }
        }
        if (MODE == 0) {
#pragma unroll
            for (int sub = 1; sub >= 0; --sub) {
                const int kb = k0 + 32 * sub + 8 * hh;
                float L[16];
#pragma unroll
                for (int i = 0; i < 16; ++i) { const float z = sc[sub][i]; const float l2 = -(fmaxf(z, 0.f) + flog2(1.0f + fexp2(-fabsf(z)))); L[i] = l2; sc[sub][i] = z + l2; }
                if (need_mask) {
#pragma unroll
                    for (int i = 0; i < 16; ++i) { const int key = kb + (i & 7) + 16 * (i >> 3); const bool ok = key < qidx; L[i] = ok ? L[i] : 0.f; sc[sub][i] = ok ? sc[sub][i] : -1.0e30f; } }
                float own_hi = 0.f, own_lo = 0.f, tl[16];
#pragma unroll
                for (int j = 7; j >= 0; --j) { tl[8 + j] = own_hi; own_hi += L[8 + j]; tl[j] = own_lo; own_lo += L[j]; }
                const float p_hi = xor32(own_hi, hh), p_lo = xor32(own_lo, hh);
                const float off_hi = Rrun + (hh ? 0.f : p_hi), off_lo = Rrun + own_hi + p_hi + (hh ? 0.f : p_lo);
                Rrun += (own_hi + own_lo) + (p_hi + p_lo);
#pragma unroll
                for (int i = 0; i < 16; ++i) sc[sub][i] = fexp2(sc[sub][i] + tl[i] + (i >= 8 ? off_hi : off_lo));
            }
        } else if (MODE == 2) {
#pragma unroll
            for (int sub = 0; sub < 2; ++sub) { f32x4 ak[4], dk[4];
#pragma unroll
                for (int r4 = 0; r4 < 4; ++r4) { const int o_ = 32 * sub + 8 * hh + 16 * (r4 >> 1) + 4 * (r4 & 1); ak[r4] = *(const LAS f32x4*)(AkL + o_); dk[r4] = *(const LAS f32x4*)(DkL + o_); }
#pragma unroll
                for (int i = 0; i < 16; ++i) { const float a_ = ak[(i >> 3) * 2 + ((i & 7) >> 2)][i & 3], d_ = dk[(i >> 3) * 2 + ((i & 7) >> 2)][i & 3];
                    sc[sub][i] = sc[sub][i] * d_ * fexp2(fminf(aq - a_, 0.f)); }
                if (need_mask) {
#pragma unroll
                    for (int i = 0; i < 16; ++i) { const int key = k0 + 32 * sub + 8 * hh + (i & 7) + 16 * (i >> 3); sc[sub][i] = key <= qidx ? sc[sub][i] : 0.f; } } }
        } else {
            if (need_mask) {
#pragma unroll
                for (int sub = 0; sub < 2; ++sub)
#pragma unroll
                    for (int i = 0; i < 16; ++i) { const int key = k0 + 32 * sub + 8 * hh + (i & 7) + 16 * (i >> 3); sc[sub][i] = key <= qidx ? sc[sub][i] : -1.0e30f; } }
            float tm = -1.0e30f;
#pragma unroll
            for (int sub = 0; sub < 2; ++sub)
#pragma unroll
                for (int i = 0; i < 16; ++i) tm = fmaxf(tm, sc[sub][i]);
            tm = fmaxf(tm, xor32(tm, hh));
            if (!__all(tm <= mrun)) {
                const float mnew = fmaxf(mrun, tm), alpha = fexp2(mrun - mnew); mrun = mnew; lsum *= alpha;
#pragma unroll
                for (int i = 0; i < 16; ++i) { o[0][i] *= alpha; o[1][i] *= alpha; } }
            float ps = 0.f;
#pragma unroll
            for (int sub = 0; sub < 2; ++sub)
#pragma unroll
                for (int i = 0; i < 16; ++i) { const float p = fexp2(sc[sub][i] - mrun); sc[sub][i] = p; ps += p; }
            lsum += ps;
        }
#pragma unroll
        for (int sub = 0; sub < 2; ++sub)
#pragma unroll
            for (int s = 0; s < 2; ++s) {
                bf16x8 pf; { u32x4 pw; pw.x = cvt_pk_bf16(sc[sub][8 * s + 0], sc[sub][8 * s + 1]); pw.y = cvt_pk_bf16(sc[sub][8 * s + 2], sc[sub][8 * s + 3]); pw.z = cvt_pk_bf16(sc[sub][8 * s + 4], sc[sub][8 * s + 5]); pw.w = cvt_pk_bf16(sc[sub][8 * s + 6], sc[sub][8 * s + 7]); pf = __builtin_bit_cast(bf16x8, pw); }
                const unsigned a0 = vt_addr + (unsigned)((32 * sub + 16 * s + 8 * hh + ((lane & 15) >> 2)) * VST + (16 * ((lane >> 4) & 1) + 4 * (lane & 3)) * 2);
                u32x2 v00, v01, v10, v11;
                asm volatile("ds_read_b64_tr_b16 %0, %4\n\tds_read_b64_tr_b16 %1, %4 offset:768\n\tds_read_b64_tr_b16 %2, %4 offset:64\n\tds_read_b64_tr_b16 %3, %4 offset:832\n\ts_waitcnt lgkmcnt(0)"
                             : "=&v"(v00), "=&v"(v01), "=&v"(v10), "=&v"(v11) : "v"(a0) : "memory");
                u32x4 va0; va0.x = v00.x; va0.y = v00.y; va0.z = v01.x; va0.w = v01.y;
                u32x4 va1; va1.x = v10.x; va1.y = v10.y; va1.z = v11.x; va1.w = v11.y;
                o[0] = mfma32(__builtin_bit_cast(bf16x8, va0), pf, o[0]);
                o[1] = mfma32(__builtin_bit_cast(bf16x8, va1), pf, o[1]);
            }
        }
        bool dead = false;
        if (MODE == 0) dead = Rrun < -64.0f;
        if (MODE == 2) dead = aq - AkL[0] < -64.0f;
        if (MODE == 1) { __syncthreads(); }
        else { volatile LAS unsigned* votes = (volatile LAS unsigned*)(C.lds + LDSCTL_OFF + 128) + 8 * bi;
            const bool wdead = __all(dead ? 1 : 0); if (lane == 0) votes[w] = wdead ? 1u : 0u;
            __syncthreads();
            unsigned all_ = 1u;
#pragma unroll
            for (int q_ = 0; q_ < 8; ++q_) all_ &= votes[q_];
            if (all_) break; }
    }
#undef ATT_LOAD
#undef ATT_STORE
    float inv = 1.0f;
    if (MODE == 1) { const float lt = lsum + xor32(lsum, hh); inv = frcp(lt); }
    bf16_t* Y = WSP(bf16_t, S_Y) + (tb + qidx) * 1024 + ycol;
    if (MODE == 2) {
        const float dsk = C.in[I_SSDD][l * 4 + h]; const bf16_t* xa = Vp + (tb + qidx) * 256; const bf16_t* zp = WSP(bf16_t, S_PROJ) + (tb + qidx) * NPROJ + PC_Z + h * 64; float q_ = 0.f;
#pragma unroll
        for (int dt = 0; dt < 2; ++dt)
#pragma unroll
            for (int g = 0; g < 4; ++g) { const int d0 = 32 * dt + 8 * g + 4 * hh; const f32x4 xv = ld_bf4(xa + d0), zv = ld_bf4(zp + d0); f32x4 y;
                for (int j = 0; j < 4; ++j) { y[j] = (o[dt][4 * g + j] + dsk * xv[j]) * siluf_(zv[j]); q_ += y[j] * y[j]; }
                st_bf4(Y + d0, y); }
        q_ += __shfl_xor(q_, 32);
        if (hh == 0) { float* SSQ = WSP(float, S_SSQ); SSQ[(tb + qidx) * 8 + h * 2] = q_; SSQ[(tb + qidx) * 8 + h * 2 + 1] = 0.f; }
        return;
    }
#pragma unroll
    for (int dt = 0; dt < 2; ++dt)
#pragma unroll
        for (int g = 0; g < 4; ++g) { u32x2 wv; wv.x = cvt_pk_bf16(o[dt][4 * g] * inv, o[dt][4 * g + 1] * inv); wv.y = cvt_pk_bf16(o[dt][4 * g + 2] * inv, o[dt][4 * g + 3] * inv);
            *(u32x2*)(Y + 32 * dt + 8 * g + 4 * hh) = wv; }
}

__device__ __forceinline__ float sum16(float v) { v = sum8(v); v += __builtin_bit_cast(float, __builtin_amdgcn_mov_dpp(__builtin_bit_cast(int, v), 0x140, 0xf, 0xf, true)); return v; }
__device__ __forceinline__ void rwkv_unit(const Ctx& C0_, int l, int b, int h, int half) {
    const Ctx C = launder(C0_);
    constexpr int TB = 32, NBLK = SEQ / TB, BUFB = 6 * TB * 64 * 4;
    LAS float* buf0 = (LAS float*)C.lds; LAS float* ybuf = (LAS float*)(C.lds + 2 * BUFB);
    const int tid = C.tid, il = tid >> 4, q = tid & 15, i = 32 * half + il;
    const float* DEC = WSP(float, S_DEC); const bf16_t* RWS = WSP(bf16_t, S_RWS); bf16_t* YRAW = WSP(bf16_t, S_YRAW);
    const size_t PL = (size_t)T * 256; const size_t tb = (size_t)b * SEQ;
    const int ls = tid >> 4, lj = 4 * (tid & 15);
    f32x4 gw; u32x2 gr[5];
#define RW_LOAD(blk) do { const size_t o_ = (tb + (size_t)(blk) * TB + ls) * 256 + h * 64 + lj; gw = *(const f32x4*)(DEC + o_); \
        gr[0] = *(const u32x2*)(RWS + 3 * PL + o_); gr[1] = *(const u32x2*)(RWS + 4 * PL + o_); gr[2] = *(const u32x2*)(RWS + PL + o_); gr[3] = *(const u32x2*)(RWS + o_); gr[4] = *(const u32x2*)(RWS + 2 * PL + o_); } while (0)
#define RW_STORE(bufp) do { LAS float* d_ = (bufp) + ls * 64 + lj; *(LAS f32x4*)d_ = gw; \
        _Pragma("unroll") for (int a_ = 0; a_ < 5; ++a_) *(LAS f32x4*)(d_ + (a_ + 1) * TB * 64) = (f32x4){bflo(gr[a_].x), bfhi(gr[a_].x), bflo(gr[a_].y), bfhi(gr[a_].y)}; } while (0)
    f32x4 S = (f32x4){0.f, 0.f, 0.f, 0.f};
    __syncthreads();
    RW_LOAD(0); RW_STORE(buf0);
    __syncthreads();
    for (int blk = 0; blk < NBLK; ++blk) {
        LAS float* cur = buf0 + (blk & 1) * (BUFB / 4); LAS float* nxtb = buf0 + ((blk + 1) & 1) * (BUFB / 4);
        if (blk + 1 < NBLK) RW_LOAD(blk + 1);
        for (int s0 = 0; s0 < TB; s0 += 4) {
            f32x4 w4[4], kk4[4], ka4[4], km4[4], r4[4]; float vv[4], yv[4];
#pragma unroll
            for (int u = 0; u < 4; ++u) { const LAS float* p = cur + (s0 + u) * 64 + 4 * q;
                w4[u] = *(const LAS f32x4*)p; kk4[u] = *(const LAS f32x4*)(p + TB * 64); ka4[u] = *(const LAS f32x4*)(p + 2 * TB * 64); km4[u] = *(const LAS f32x4*)(p + 3 * TB * 64); r4[u] = *(const LAS f32x4*)(p + 4 * TB * 64);
                vv[u] = cur[5 * TB * 64 + (s0 + u) * 64 + i]; }
#pragma unroll
            for (int u = 0; u < 4; ++u) {
                float sa = (S[0] * kk4[u][0] + S[1] * kk4[u][1]) + (S[2] * kk4[u][2] + S[3] * kk4[u][3]);
                sa = sum16(sa);
                S = S * w4[u] + (km4[u] * vv[u] - ka4[u] * sa);
                const float y = (S[0] * r4[u][0] + S[1] * r4[u][1]) + (S[2] * r4[u][2] + S[3] * r4[u][3]);
                yv[u] = sum16(y); }
            if (q == 0) {
#pragma unroll
                for (int u = 0; u < 4; ++u) ybuf[(s0 + u) * 32 + il] = yv[u]; }
        }
        __syncthreads();
        {
            const int os = tid >> 4, r2 = 2 * (tid & 15); const size_t t = tb + (size_t)blk * TB + os;
            *(unsigned*)(YRAW + t * 256 + h * 64 + 32 * half + r2) = cvt_pk_bf16(ybuf[os * 32 + r2], ybuf[os * 32 + r2 + 1]);
        }
        if (blk + 1 < NBLK) RW_STORE(nxtb);
        __syncthreads();
    }
#undef RW_LOAD
#undef RW_STORE
}

__device__ __forceinline__ void ssd_stage(const Ctx& C, int l, int h, size_t tb, int blk, LAS float* dst) {
    constexpr int TB = 16; const int g = h >> 1;
    const bf16_t* proj = WSP(bf16_t, S_PROJ); const float* cw = C.in[I_CONVW] + l * 4 * 768; const float* cb = C.in[I_CONVB] + l * 768;
    const float dtb = C.in[I_DTB][l * 4 + h], aneg = -expf(C.in[I_ALOG][l * 4 + h]);
    for (int it = C.tid; it < TB * 80; it += NTHREADS) {
        const int s = it / 80, v = it % 80; const int tl = blk * TB + s;
        int pcol, cch, doff;
        if (v < 16) { pcol = PC_XS + h * 64 + 4 * v; cch = h * 64 + 4 * v; doff = s * 64 + 4 * v; }
        else if (v < 48) { pcol = PC_BM + g * 128 + 4 * (v - 16); cch = 256 + g * 128 + 4 * (v - 16); doff = 2 * TB * 64 + s * 128 + 4 * (v - 16); }
        else { pcol = PC_CM + g * 128 + 4 * (v - 48); cch = 512 + g * 128 + 4 * (v - 48); doff = 2 * TB * 64 + TB * 128 + s * 128 + 4 * (v - 48); }
        f32x4 a = *(const f32x4*)(cb + cch);
#pragma unroll
        for (int k = 0; k < 4; ++k) { const int tt = tl - 3 + k; if (tt >= 0) a += ld_bf4(proj + (tb + tt) * NPROJ + pcol) * *(const f32x4*)(cw + k * 768 + cch); }
        for (int j = 0; j < 4; ++j) a[j] = siluf_(a[j]);
        if (v < 16) { const float dt = softplusf_(bf2f(proj[(tb + tl) * NPROJ + PC_DT + h]) + dtb); *(LAS f32x4*)(dst + TB * 64 + doff) = a; *(LAS f32x4*)(dst + doff) = a * dt;
                      if (v == 0) dst[TB * 384 + s] = expf(dt * aneg); }
        else *(LAS f32x4*)(dst + doff) = a;
    }
}
__device__ __forceinline__ void ssd_unit(const Ctx& C0_, int l, int b, int h, int ph) {
    const Ctx C = launder(C0_);
    constexpr int TB = 32, NBLK = SEQ / TB, NF = TB * (32 + 32 + 128 + 128) + 64, NIT = 72 * TB, NK = (NIT + NTHREADS - 1) / NTHREADS;
    LAS float* buf0 = (LAS float*)C.lds; LAS float* ypart = buf0 + 2 * NF;
    const int tid = C.tid, lane = C.lane, w = C.wave, g = h >> 1, pl = lane & 31, nh = lane >> 5;
    const bf16_t* proj = WSP(bf16_t, S_PROJ); bf16_t* Y = WSP(bf16_t, S_Y); float* SSQ = WSP(float, S_SSQ);
    const float* cw = C.in[I_CONVW] + l * 4 * 768; const float* cb = C.in[I_CONVB] + l * 768;
    const float dtb = C.in[I_DTB][l * 4 + h], aneg = -expf(C.in[I_ALOG][l * 4 + h]), dsk = C.in[I_SSDD][l * 4 + h];
    const size_t tb = (size_t)b * SEQ;
    int its[NK], itp[NK], itd[NK], itc[NK]; bool itx[NK];
#pragma unroll
    for (int k = 0; k < NK; ++k) { const int it = tid + NTHREADS * k, sidx = it / 72, v = it % 72; int pcol, cch, doff;
        if (v < 8) { pcol = PC_XS + h * 64 + 32 * ph + 4 * v; cch = h * 64 + 32 * ph + 4 * v; doff = sidx * 32 + 4 * v; }
        else if (v < 40) { pcol = PC_BM + g * 128 + 4 * (v - 8); cch = 256 + g * 128 + 4 * (v - 8); doff = 2 * TB * 32 + sidx * 128 + 4 * (v - 8); }
        else { pcol = PC_CM + g * 128 + 4 * (v - 40); cch = 512 + g * 128 + 4 * (v - 40); doff = 2 * TB * 32 + TB * 128 + sidx * 128 + 4 * (v - 40); }
        its[k] = sidx; itp[k] = pcol; itd[k] = doff; itx[k] = v < 8; itc[k] = cch; }
    const bool haslast = tid + NTHREADS * (NK - 1) < NIT;
    u32x2 raw[NK][4]; float dtr[NK]; unsigned short zraw;
    const int os = tid >> 4, op = tid & 15;
#define SSD_LOAD(blk) do { _Pragma("unroll") for (int k = 0; k < NK; ++k) { if (k < NK - 1 || haslast) { const int tl_ = (blk) * TB + its[k]; \
            _Pragma("unroll") for (int q = 0; q < 4; ++q) { const int tt_ = tl_ - 3 + q; raw[k][q] = tt_ >= 0 ? *(const u32x2*)(proj + (tb + tt_) * NPROJ + itp[k]) : (u32x2){0u, 0u}; } \
            dtr[k] = itx[k] ? bf2f(proj[(tb + tl_) * NPROJ + PC_DT + h]) : 0.f; } } } while (0)
#define SSD_COMMIT(dst) do { _Pragma("unroll") for (int k = 0; k < NK; ++k) { if (k < NK - 1 || haslast) { f32x4 a_ = *(const f32x4*)(cb + itc[k]); \
            _Pragma("unroll") for (int q = 0; q < 4; ++q) a_ += (f32x4){bflo(raw[k][q].x), bfhi(raw[k][q].x), bflo(raw[k][q].y), bfhi(raw[k][q].y)} * *(const f32x4*)(cw + q * 768 + itc[k]); \
            for (int j = 0; j < 4; ++j) a_[j] = siluf_(a_[j]); \
            if (itx[k]) { const float dt_ = softplusf_(dtr[k] + dtb); *(LAS f32x4*)((dst) + TB * 32 + itd[k]) = a_; *(LAS f32x4*)((dst) + itd[k]) = a_ * dt_; if ((itd[k] & 31) == 0) (dst)[TB * 320 + its[k]] = expf(dt_ * aneg); } \
            else *(LAS f32x4*)((dst) + itd[k]) = a_; } } } while (0)
    float hs[8];
#pragma unroll
    for (int k = 0; k < 8; ++k) hs[k] = 0.f;
    __syncthreads();
    SSD_LOAD(0); SSD_COMMIT(buf0);
    __syncthreads();
    for (int blk = 0; blk < NBLK; ++blk) {
        LAS float* cur = buf0 + (blk & 1) * NF; LAS float* nxtb = buf0 + ((blk + 1) & 1) * NF;
        if (blk + 1 < NBLK) SSD_LOAD(blk + 1);
        const size_t tz = tb + (size_t)blk * TB + os;
        zraw = proj[tz * NPROJ + PC_Z + h * 64 + 32 * ph + op]; const unsigned short zraw2 = proj[tz * NPROJ + PC_Z + h * 64 + 32 * ph + op + 16];
        for (int s0 = 0; s0 < TB; s0 += 4) {
            float x4[4], dA4[4], yv[4]; f32x4 bv[4][2], cv[4][2];
#pragma unroll
            for (int u = 0; u < 4; ++u) { const int s = s0 + u; x4[u] = cur[s * 32 + pl]; dA4[u] = cur[TB * 320 + s];
                const LAS float* bp = cur + 2 * TB * 32 + s * 128 + 16 * w + 8 * nh; const LAS float* cp = bp + TB * 128;
                bv[u][0] = *(const LAS f32x4*)bp; bv[u][1] = *(const LAS f32x4*)(bp + 4); cv[u][0] = *(const LAS f32x4*)cp; cv[u][1] = *(const LAS f32x4*)(cp + 4); }
#pragma unroll
            for (int u = 0; u < 4; ++u) { float yp = 0.f;
#pragma unroll
                for (int k4 = 0; k4 < 2; ++k4)
#pragma unroll
                    for (int j = 0; j < 4; ++j) { hs[4 * k4 + j] = hs[4 * k4 + j] * dA4[u] + x4[u] * bv[u][k4][j]; yp += cv[u][k4][j] * hs[4 * k4 + j]; }
                const auto sw = __builtin_amdgcn_permlane32_swap(__builtin_bit_cast(unsigned, yp), __builtin_bit_cast(unsigned, yp), false, false);
                yv[u] = yp + __builtin_bit_cast(float, (unsigned)sw[1]); }
            if (nh == 0) {
#pragma unroll
                for (int u = 0; u < 4; ++u) ypart[((s0 + u) * 8 + w) * 32 + pl] = yv[u]; }
        }
        if (blk + 1 < NBLK) SSD_COMMIT(nxtb);
        __syncthreads();
        {
            float y0 = 0.f, y1 = 0.f;
#pragma unroll
            for (int ww = 0; ww < 8; ++ww) { y0 += ypart[(os * 8 + ww) * 32 + op]; y1 += ypart[(os * 8 + ww) * 32 + op + 16]; }
            y0 += cur[TB * 32 + os * 32 + op] * dsk; y1 += cur[TB * 32 + os * 32 + op + 16] * dsk;
            y0 *= siluf_(bf2f(zraw)); y1 *= siluf_(bf2f(zraw2));
            bf16_t* yo = Y + tz * 1024 + 512 + h * 64 + 32 * ph + op;
            yo[0] = (bf16_t)(cvt_pk_bf16(y0, 0.f) & 0xffffu); yo[16] = (bf16_t)(cvt_pk_bf16(y1, 0.f) & 0xffffu);
            float q = y0 * y0 + y1 * y1;
#pragma unroll
            for (int o_ = 1; o_ < 16; o_ <<= 1) q += __shfl_xor(q, o_);
            if (op == 0) SSQ[tz * 8 + h * 2 + ph] = q;
        }
        __syncthreads();
    }
#undef SSD_LOAD
#undef SSD_COMMIT
}

__device__ __forceinline__ void sb_naive(const Ctx& C) {
    const bf16_t* proj = WSP(bf16_t, S_PROJ); bf16_t* Y = WSP(bf16_t, S_Y); const int lane = C.lane;
    for (int item = GW; item < T * 4; item += NGW) {
        const int t = item >> 2, h = item & 3, tq = t % SEQ; const size_t tb = (size_t)(t - tq);
        float q[64];
        { const bf16_t* qp = proj + (size_t)t * NPROJ + PC_SBQ + h * 64;
#pragma unroll
          for (int i = 0; i < 8; ++i) { const u32x4 w = *(const u32x4*)(qp + 8 * i); q[8*i] = bflo(w.x); q[8*i+1] = bfhi(w.x); q[8*i+2] = bflo(w.y); q[8*i+3] = bfhi(w.y); q[8*i+4] = bflo(w.z); q[8*i+5] = bfhi(w.z); q[8*i+6] = bflo(w.w); q[8*i+7] = bfhi(w.w); } }
        float o[64];
#pragma unroll
        for (int d = 0; d < 64; ++d) o[d] = 0.f;
        float R = 0.f;
        for (int c = (tq - 1) >> 6; c >= 0 && tq > 0; --c) {
            const int key = c * 64 + lane; const bool ok = key < tq;
            const bf16_t* kp = proj + (tb + key) * NPROJ + PC_SBK + h * 64; const bf16_t* vp = proj + (tb + key) * NPROJ + PC_SBV + h * 64;
            float z = 0.f;
#pragma unroll
            for (int i = 0; i < 8; ++i) { const u32x4 w = *(const u32x4*)(kp + 8 * i);
                z += q[8*i] * bflo(w.x) + q[8*i+1] * bfhi(w.x) + q[8*i+2] * bflo(w.y) + q[8*i+3] * bfhi(w.y) + q[8*i+4] * bflo(w.z) + q[8*i+5] * bfhi(w.z) + q[8*i+6] * bflo(w.w) + q[8*i+7] * bfhi(w.w); }
            const float L = ok ? -(fmaxf(z, 0.f) + flog2(1.0f + fexp2(-fabsf(z)))) : 0.f;
            float sfx = L;
#pragma unroll
            for (int dd = 1; dd < 64; dd <<= 1) { const float tt = __shfl_down(sfx, dd); if (lane + dd < 64) sfx += tt; }
            const float tot = __shfl(sfx, 0);
            const float wgt = ok ? fexp2(z + L + (sfx - L) + R) : 0.f;
            R += tot;
#pragma unroll
            for (int i = 0; i < 8; ++i) { const u32x4 w = *(const u32x4*)(vp + 8 * i);
                o[8*i] += wgt * bflo(w.x); o[8*i+1] += wgt * bfhi(w.x); o[8*i+2] += wgt * bflo(w.y); o[8*i+3] += wgt * bfhi(w.y); o[8*i+4] += wgt * bflo(w.z); o[8*i+5] += wgt * bfhi(w.z); o[8*i+6] += wgt * bflo(w.w); o[8*i+7] += wgt * bfhi(w.w); }
        }
        float mine = 0.f;
#pragma unroll
        for (int d = 0; d < 64; ++d) { const float sdd = wave_sum(o[d]); if (lane == d) mine = sdd; }
        Y[(size_t)t * 1024 + h * 64 + lane] = (bf16_t)(cvt_pk_bf16(mine, 0.f) & 0xffffu);
    }
}

__device__ __forceinline__ void rwkv_naive(const Ctx& C, int l) {
    const float* DEC = WSP(float, S_DEC); const bf16_t* RWS = WSP(bf16_t, S_RWS); const bf16_t* GV = WSP(bf16_t, S_GV); bf16_t* Y = WSP(bf16_t, S_Y);
    const size_t PL = (size_t)T * 256; const int lane = C.lane;
    for (int item = GW; item < 64; item += NGW) {
        const int b = item >> 2, h = item & 3; const float* rk = C.in[I_RWRK] + l * 256 + h * 64;
        const float gng = C.in[I_RWGNG][l * 256 + h * 64 + lane], gnb = C.in[I_RWGNB][l * 256 + h * 64 + lane];
        float S[64];
#pragma unroll
        for (int j = 0; j < 64; ++j) S[j] = 0.f;
        for (int tq = 0; tq < SEQ; ++tq) {
            const size_t o = ((size_t)b * SEQ + tq) * 256 + h * 64;
            const float v = bf2f(RWS[2 * PL + o + lane]);
            float sa = 0.f;
#pragma unroll
            for (int j = 0; j < 64; ++j) sa += S[j] * bf2f(RWS[3 * PL + o + j]);
            float y = 0.f, bd = 0.f;
#pragma unroll
            for (int j = 0; j < 64; ++j) { const float km = bf2f(RWS[PL + o + j]), r = bf2f(RWS[o + j]);
                S[j] = S[j] * DEC[o + j] + (v * km - sa * bf2f(RWS[4 * PL + o + j])); y += S[j] * r; bd += r * km * rk[j]; }
            const float mu = wave_sum(y) * (1.0f / 64.0f), d = y - mu, var = wave_sum(d * d) * (1.0f / 64.0f);
            const float res = (d * (1.0f / sqrtf(var + 64e-5f)) * gng + gnb + v * bd) * bf2f(GV[o + lane]);
            Y[((size_t)b * SEQ + tq) * 1024 + 256 + h * 64 + lane] = (bf16_t)(cvt_pk_bf16(res, 0.f) & 0xffffu);
        }
    }
}
__device__ __forceinline__ void ssd_naive(const Ctx& C, int l) {
    const bf16_t* proj = WSP(bf16_t, S_PROJ); bf16_t* Y = WSP(bf16_t, S_Y); float* SSQ = WSP(float, S_SSQ); const int lane = C.lane;
    const float* cw = C.in[I_CONVW] + l * 4 * 768; const float* cb = C.in[I_CONVB] + l * 768;
    for (int item2 = GW; item2 < 128; item2 += NGW) {
        const int item = item2 >> 1, ph = item2 & 1; const int b = item >> 2, h = item & 3, g = h >> 1; const size_t tb = (size_t)b * SEQ;
        const float dtb = C.in[I_DTB][l * 4 + h], aneg = -expf(C.in[I_ALOG][l * 4 + h]), dsk = C.in[I_SSDD][l * 4 + h];
        float hs0[32], hs1[32];
#pragma unroll
        for (int p = 0; p < 32; ++p) { hs0[p] = 0.f; hs1[p] = 0.f; }
        for (int tq = 0; tq < SEQ; ++tq) {
            const bf16_t* pr = proj + (tb + tq) * NPROJ;
            float xa = cb[h * 64 + lane], bv0 = cb[256 + g * 128 + lane], bv1 = cb[256 + g * 128 + 64 + lane], cv0 = cb[512 + g * 128 + lane], cv1 = cb[512 + g * 128 + 64 + lane];
            for (int k = 0; k < 4; ++k) { const int tt = tq - 3 + k; if (tt >= 0) { const bf16_t* pp = proj + (tb + tt) * NPROJ; const float* ww = cw + k * 768;
                xa += bf2f(pp[PC_XS + h * 64 + lane]) * ww[h * 64 + lane];
                bv0 += bf2f(pp[PC_BM + g * 128 + lane]) * ww[256 + g * 128 + lane]; bv1 += bf2f(pp[PC_BM + g * 128 + 64 + lane]) * ww[256 + g * 128 + 64 + lane];
                cv0 += bf2f(pp[PC_CM + g * 128 + lane]) * ww[512 + g * 128 + lane]; cv1 += bf2f(pp[PC_CM + g * 128 + 64 + lane]) * ww[512 + g * 128 + 64 + lane]; } }
            xa = siluf_(xa); bv0 = siluf_(bv0); bv1 = siluf_(bv1); cv0 = siluf_(cv0); cv1 = siluf_(cv1);
            const float dt = softplusf_(bf2f(pr[PC_DT + h]) + dtb), dA = expf(dt * aneg), xd = xa * dt;
            float y = 0.f;
#pragma unroll
            for (int p = 0; p < 32; ++p) { const float xp = __shfl(xd, 32 * ph + p); hs0[p] = hs0[p] * dA + xp * bv0; hs1[p] = hs1[p] * dA + xp * bv1;
                const float tot = wave_sum(cv0 * hs0[p] + cv1 * hs1[p]); if (lane == 32 * ph + p) y = tot; }
            y += dsk * xa; y *= siluf_(bf2f(pr[PC_Z + h * 64 + lane]));
            const bool mine = (lane >> 5) == ph; if (mine) Y[(tb + tq) * 1024 + 512 + h * 64 + lane] = (bf16_t)(cvt_pk_bf16(y, 0.f) & 0xffffu);
            const float q = wave_sum(mine ? y * y : 0.f); if (lane == 0) atomicAdd(&SSQ[(tb + tq) * 8 + h * 2], q);
        }
    }
}

__device__ __forceinline__ void mla_naive(const Ctx& C) {
    const bf16_t* QM = WSP(bf16_t, S_QM); const bf16_t* KM = WSP(bf16_t, S_KM); const bf16_t* VM = WSP(bf16_t, S_VM); bf16_t* Y = WSP(bf16_t, S_Y); const int lane = C.lane;
    for (int item = GW; item < T * 4; item += NGW) {
        const int t = item >> 2, h = item & 3, tq = t % SEQ; const size_t tb = (size_t)(t - tq);
        float q[96];
        { const bf16_t* qp = QM + (size_t)t * 384 + h * 96;
#pragma unroll
          for (int i = 0; i < 12; ++i) { const u32x4 w = *(const u32x4*)(qp + 8 * i); q[8*i] = bflo(w.x); q[8*i+1] = bfhi(w.x); q[8*i+2] = bflo(w.y); q[8*i+3] = bfhi(w.y); q[8*i+4] = bflo(w.z); q[8*i+5] = bfhi(w.z); q[8*i+6] = bflo(w.w); q[8*i+7] = bfhi(w.w); } }
        float o[64];
#pragma unroll
        for (int d = 0; d < 64; ++d) o[d] = 0.f;
        float m = -1.0e30f, lsum = 0.f;
        for (int c = tq >> 6; c >= 0; --c) {
            const int key = c * 64 + lane; const bool ok = key <= tq;
            const bf16_t* kp = KM + (tb + (ok ? key : 0)) * 384 + h * 96; const bf16_t* vp = VM + (tb + (ok ? key : 0)) * 256 + h * 64;
            float z = 0.f;
#pragma unroll
            for (int i = 0; i < 12; ++i) { const u32x4 w = *(const u32x4*)(kp + 8 * i);
                z += q[8*i] * bflo(w.x) + q[8*i+1] * bfhi(w.x) + q[8*i+2] * bflo(w.y) + q[8*i+3] * bfhi(w.y) + q[8*i+4] * bflo(w.z) + q[8*i+5] * bfhi(w.z) + q[8*i+6] * bflo(w.w) + q[8*i+7] * bfhi(w.w); }
            z = ok ? z : -1.0e30f;
            float cm = z;
#pragma unroll
            for (int dd = 1; dd < 64; dd <<= 1) cm = fmaxf(cm, __shfl_xor(cm, dd));
            const float mn = fmaxf(m, cm), al = fexp2(m - mn), pw = ok ? fexp2(z - mn) : 0.f; m = mn; lsum = lsum * al + pw;
#pragma unroll
            for (int i = 0; i < 8; ++i) { const u32x4 w = *(const u32x4*)(vp + 8 * i);
                o[8*i] = o[8*i] * al + pw * bflo(w.x); o[8*i+1] = o[8*i+1] * al + pw * bfhi(w.x); o[8*i+2] = o[8*i+2] * al + pw * bflo(w.y); o[8*i+3] = o[8*i+3] * al + pw * bfhi(w.y);
                o[8*i+4] = o[8*i+4] * al + pw * bflo(w.z); o[8*i+5] = o[8*i+5] * al + pw * bfhi(w.z); o[8*i+6] = o[8*i+6] * al + pw * bflo(w.w); o[8*i+7] = o[8*i+7] * al + pw * bfhi(w.w); }
        }
        const float lt = wave_sum(lsum); float mine = 0.f;
#pragma unroll
        for (int d = 0; d < 64; ++d) { const float sdd = wave_sum(o[d]); if (lane == d) mine = sdd; }
        Y[(size_t)t * 1024 + 768 + h * 64 + lane] = (bf16_t)(cvt_pk_bf16(mine / lt, 0.f) & 0xffffu);
    }
}
__device__ __forceinline__ void xattn_naive(const Ctx& C, int l) {
    const bf16_t* XQ = WSP(bf16_t, S_XQ); const bf16_t* KMEM = WSP(bf16_t, W_KMEM) + (size_t)l * NMEM * 1024; const bf16_t* VT = WSP(bf16_t, W_VMEMT) + (size_t)l * 1024 * NMEM; bf16_t* XO = WSP(bf16_t, S_XO); const int lane = C.lane;
    for (int item = GW; item < T * 4; item += NGW) {
        const int t = item >> 2, h = item & 3, b = t / SEQ;
        float z[4] = {0.f, 0.f, 0.f, 0.f};
        for (int d8 = 0; d8 < 32; ++d8) { const u32x4 qw = *(const u32x4*)(XQ + (size_t)t * 1024 + h * 256 + 8 * d8);
            const float qv[8] = {bflo(qw.x), bfhi(qw.x), bflo(qw.y), bfhi(qw.y), bflo(qw.z), bfhi(qw.z), bflo(qw.w), bfhi(qw.w)};
#pragma unroll
            for (int j = 0; j < 4; ++j) { const u32x4 kw = *(const u32x4*)(KMEM + (size_t)(b * 256 + lane + 64 * j) * 1024 + h * 256 + 8 * d8);
                z[j] += qv[0] * bflo(kw.x) + qv[1] * bfhi(kw.x) + qv[2] * bflo(kw.y) + qv[3] * bfhi(kw.y) + qv[4] * bflo(kw.z) + qv[5] * bfhi(kw.z) + qv[6] * bflo(kw.w) + qv[7] * bfhi(kw.w); } }
        float mx = fmaxf(fmaxf(z[0], z[1]), fmaxf(z[2], z[3]));
#pragma unroll
        for (int dd = 1; dd < 64; dd <<= 1) mx = fmaxf(mx, __shfl_xor(mx, dd));
        float p[4], ps = 0.f;
#pragma unroll
        for (int j = 0; j < 4; ++j) { p[j] = fexp2(z[j] - mx); ps += p[j]; }
        const float inv = 1.0f / wave_sum(ps);
        float o[4] = {0.f, 0.f, 0.f, 0.f};
        for (int mm = 0; mm < 256; ++mm) { const float pm = __shfl(p[mm >> 6], mm & 63);
#pragma unroll
            for (int jd = 0; jd < 4; ++jd) o[jd] += pm * bf2f(VT[(size_t)(h * 256 + lane + 64 * jd) * NMEM + b * 256 + mm]); }
#pragma unroll
        for (int jd = 0; jd < 4; ++jd) XO[(size_t)t * 1024 + h * 256 + lane + 64 * jd] = (bf16_t)(cvt_pk_bf16(o[jd] * inv, 0.f) & 0xffffu);
    }
}
__device__ __forceinline__ void ph_mixers(const Ctx& C, int l, int rep = 0) {
    unsigned* head = (unsigned*)(C.ws + WS_CTL) + CW_QUEUE + 64 * (l + 2 * rep);
    volatile LAS unsigned* slot = (volatile LAS unsigned*)(C.lds + LDSCTL_OFF + 64);
    constexpr int N_RW = 128, N_ATT = 768, NITEMS = N_RW + N_ATT;
    for (;;) {
        __syncthreads();
        if (C.tid == 0) slot[0] = __hip_atomic_fetch_add(head, 1u, RLX_AGENT);
        __syncthreads();
        const int it = (int)slot[0];
        if (it >= NITEMS) break;
#ifndef NAIVE_SCAN
#define NAIVE_SCAN 0
#endif
        if (it < N_RW) { if (!(NAIVE_SCAN & 1)) { rwkv_unit(C, l, it >> 3, (it >> 1) & 3, it & 1);
#ifdef TIME_RW2
            __syncthreads(); rwkv_unit(C, l, it >> 3, (it >> 1) & 3, it & 1);
#endif
        } }
        else { const int k = it - N_RW; const int mode = k >> 8, kk_ = k & 255, pp = kk_ & 3, bh = kk_ >> 2, b = bh >> 2, h = bh & 3;
            if (mode == 0) { if (!(NAIVE_SCAN & 2)) { attn_unit<2>(C, l, b, h, 7 - pp); __syncthreads(); attn_unit<2>(C, l, b, h, pp);
#ifdef TIME_SSDA2
                __syncthreads(); attn_unit<2>(C, l, b, h, 7 - pp); __syncthreads(); attn_unit<2>(C, l, b, h, pp);
#endif
            } }
#ifndef NAIVE_SB
            else if (mode == 2) { attn_unit<0>(C, l, b, h, 7 - pp); __syncthreads(); attn_unit<0>(C, l, b, h, pp);
#ifdef TIME_SB2
                __syncthreads(); attn_unit<0>(C, l, b, h, 7 - pp); __syncthreads(); attn_unit<0>(C, l, b, h, pp);
#endif
            }
#else
            else if (mode == 2) { }
#endif
#ifndef NAIVE_MLA
            else { attn_unit<1>(C, l, b, h, 7 - pp); __syncthreads(); attn_unit<1>(C, l, b, h, pp);
#ifdef TIME_MLA2
                __syncthreads(); attn_unit<1>(C, l, b, h, 7 - pp); __syncthreads(); attn_unit<1>(C, l, b, h, pp);
#endif
            }
#else
            else { }
#endif
        }
    }
#ifdef NAIVE_SB
    sb_naive(C);
#endif
#ifdef NAIVE_MLA
    mla_naive(C);
#endif
    if (NAIVE_SCAN & 1) rwkv_naive(C, l);
    if (NAIVE_SCAN & 2) ssd_naive(C, l);
}
__device__ __forceinline__ void ph_router(const Ctx& C) {
#ifdef TIME_VAR
    const unsigned var = __builtin_amdgcn_readfirstlane(__hip_atomic_load((const unsigned*)(C.ws + WS_CTL) + 200000, RLX_AGENT)) & 0xffu;
#else
    const unsigned var = 0u;
#endif
    if (!(var & 1u)) run_tjobs<16, true>(C, var);
    __syncthreads();
    LAS unsigned* lc = (LAS unsigned*)(C.lds + XCH_OFF);
    if (C.tid < 8) lc[C.tid] = 0u;
    __syncthreads();
    const float* xr = WSP(float, W_XRES); const float* rt = C.in[I_ROUTER]; int* topi = WSP(int, S_TOPI); float* topw = WSP(float, S_TOPW); const int lane = C.lane;
    f32x4 nx[4];
#define RT_LOAD(kk_) do { const int t_ = C.bid * 128 + C.wave * 16 + (kk_); _Pragma("unroll") for (int j = 0; j < 4; ++j) nx[j] = *(const f32x4*)(xr + (size_t)t_ * 1024 + 4 * lane + 256 * j); } while (0)
    RT_LOAD(0);
    f32x4 rw0[16], rw1[16];
#pragma unroll
    for (int jq = 0; jq < 16; ++jq) { const float* rp = rt + (size_t)(4 * lane + 256 * (jq >> 2) + (jq & 3)) * 8; rw0[jq] = *(const f32x4*)rp; rw1[jq] = *(const f32x4*)(rp + 4); }
    for (int k = 0; k < ((var & 2u) ? 0 : 16); ++k) {
        const int t = C.bid * 128 + C.wave * 16 + k; float a[8]; f32x4 xv4[4];
#pragma unroll
        for (int j = 0; j < 4; ++j) xv4[j] = nx[j];
        if (k + 1 < 16) RT_LOAD(k + 1);
#pragma unroll
        for (int e = 0; e < 8; ++e) a[e] = 0.f;
#pragma unroll
        for (int jq = 0; jq < 16; ++jq) { const float xq = xv4[jq >> 2][jq & 3]; const f32x4 r0 = rw0[jq], r1 = rw1[jq];
            a[0] += xq * r0[0]; a[1] += xq * r0[1]; a[2] += xq * r0[2]; a[3] += xq * r0[3]; a[4] += xq * r1[0]; a[5] += xq * r1[1]; a[6] += xq * r1[2]; a[7] += xq * r1[3]; }
#pragma unroll
        for (int e = 0; e < 8; ++e) a[e] = wave_sum(a[e]);
#ifdef ROUTER_NOISE
        for (int e = 0; e < 8; ++e) { unsigned hsh = (unsigned)t * 2654435761u + (unsigned)e * 40503u; hsh ^= hsh >> 13; hsh *= 0x5bd1e995u; hsh ^= hsh >> 15; a[e] += ROUTER_NOISE * ((float)(hsh & 0xffff) * (1.0f / 32768.0f) - 1.0f); }
#endif
        if (lane == 0) {
            int i1 = 0; float v1 = a[0];
#pragma unroll
            for (int e = 1; e < 8; ++e) if (a[e] > v1) { v1 = a[e]; i1 = e; }
            int i2 = -1; float v2 = -3.0e38f;
#pragma unroll
            for (int e = 0; e < 8; ++e) if (e != i1 && a[e] > v2) { v2 = a[e]; i2 = e; }
            const float g1 = 1.0f / (1.0f + expf(v2 - v1));
            topi[2 * t] = i1; topi[2 * t + 1] = i2; topw[2 * t] = g1; topw[2 * t + 1] = 1.0f - g1;
            __hip_atomic_fetch_add(&lc[i1], 1u, __ATOMIC_RELAXED, __HIP_MEMORY_SCOPE_WORKGROUP); __hip_atomic_fetch_add(&lc[i2], 1u, __ATOMIC_RELAXED, __HIP_MEMORY_SCOPE_WORKGROUP);
        }
    }
    __syncthreads();
    if (C.tid < 8) ((unsigned*)(C.ws + WS_CTL))[CW_MOECNT + C.bid * 8 + C.tid] = lc[C.tid];
}
__device__ __forceinline__ void ph_scatter(const Ctx& C) {
    LAS int* sh = (LAS int*)(C.lds + XCH_OFF);
    const unsigned* cnt = (const unsigned*)(C.ws + WS_CTL) + CW_MOECNT;
    int* row_slot = WSP(int, S_ROWSLOT); float* row_w = WSP(float, S_ROWW); int* blk_e = WSP(int, S_BLKE);
    const int* topi = WSP(int, S_TOPI); const float* topw = WSP(float, S_TOPW);
    const int tid = C.tid;
    if (tid < 8) { int tot = 0, mine = 0; for (int wg = 0; wg < 256; ++wg) { const int c = (int)cnt[wg * 8 + tid]; if (wg < C.bid) mine += c; tot += c; } sh[tid] = tot; sh[8 + tid] = mine; sh[32 + tid] = 0; }
    __syncthreads();
    if (tid == 0) { int ps = 0; for (int e = 0; e < 8; ++e) { sh[16 + e] = ps; const int pad = (sh[e] + 255) / 256 * 256; sh[24 + e] = pad; ps += pad; } sh[40] = ps / 256; }
    __syncthreads();
    if (C.bid == 0) {
        const int used = sh[40];
        for (int rb = tid; rb < MOE_BLOCKS; rb += NTHREADS) { int e = 7; if (rb < used) { e = 0; for (int q = 1; q < 8; ++q) if (sh[16 + q] <= rb * 256) e = q; } blk_e[rb] = e; }
        if (tid == 0) blk_e[MOE_BLOCKS] = used;
    }
    if (C.bid < 8) { const int e = C.bid; for (int r = sh[16 + e] + sh[e] + tid; r < sh[16 + e] + sh[24 + e]; r += NTHREADS) { row_slot[r] = -1; row_w[r] = 0.f; } }
    if (tid < 256) { const int t = C.bid * 128 + (tid >> 1), k = tid & 1, e = topi[2 * t + k];
        const int pos = __hip_atomic_fetch_add(&sh[32 + e], 1, __ATOMIC_RELAXED, __HIP_MEMORY_SCOPE_WORKGROUP); const int dest = sh[16 + e] + sh[8 + e] + pos; row_slot[dest] = 2 * t + k; row_w[dest] = topw[2 * t + k]; sh[64 + tid] = dest; }
    __syncthreads();
    const bf16_t* xb = WSP(bf16_t, W_XB); bf16_t* xs = WSP(bf16_t, S_XS);
    for (int a = C.wave * 32; a < C.wave * 32 + 32; ++a) { const int t = C.bid * 128 + (a >> 1); const size_t d = (size_t)sh[64 + a] * 1024;
#pragma unroll
        for (int j = 0; j < 2; ++j) *(u32x4*)(xs + d + (C.lane + 64 * j) * 8) = *(const u32x4*)(xb + (size_t)t * 1024 + (C.lane + 64 * j) * 8); }
}


__device__ __forceinline__ void chk_moe(const Ctx& C, int bit) {
    const float* xr = WSP(float, W_XRES); const float* rt = C.in[I_ROUTER]; const float* w13 = C.in[I_MOE13]; const float* w2 = C.in[I_MOE2]; const bf16_t* ys = WSP(bf16_t, S_YS);
    LAS float* hb = (LAS float*)(C.lds + C.wave * 14336); const int lane = C.lane; unsigned bad = 0;
    float* stash = WSP(float, W_KMEM); const float* g3 = C.in[I_LN3G] + 1024; const float* b3 = C.in[I_LN3B] + 1024;
    for (int s = GW; s < 1024; s += NGW) {
        const int t = (int)(((long)s * 1021 + 7) % T); float x[16];
#pragma unroll
        for (int j = 0; j < 16; ++j) x[j] = xr[(size_t)t * 1024 + lane + 64 * j];
        float lg[8];
#pragma unroll
        for (int e = 0; e < 8; ++e) { float a = 0.f;
#pragma unroll
            for (int j = 0; j < 16; ++j) a += x[j] * rt[(size_t)(lane + 64 * j) * 8 + e]; lg[e] = wave_sum(a); }
        int i1 = 0; for (int e = 1; e < 8; ++e) if (lg[e] > lg[i1]) i1 = e;
        int i2 = -1; for (int e = 0; e < 8; ++e) if (e != i1 && (i2 < 0 || lg[e] > lg[i2])) i2 = e;
        float v3 = -3.0e38f; for (int e = 0; e < 8; ++e) if (e != i1 && e != i2) v3 = fmaxf(v3, lg[e]);
        if (lg[i2] - v3 < 0.02f) { if (lane == 0) stash[(size_t)s * 1024] = 1.0e30f; continue; }
        const float g1 = 1.0f / (1.0f + expf(lg[i2] - lg[i1]));
        float out[16];
#pragma unroll
        for (int j = 0; j < 16; ++j) out[j] = 0.f;
        for (int q = 0; q < 2; ++q) { const int e = q ? i2 : i1; const float gw = q ? 1.0f - g1 : g1; const float* W1 = w13 + (size_t)e * 1024 * 2 * FFE;
            for (int i0 = 0; i0 < 56; i0 += 4) { float ag[4], au[4];
#pragma unroll
                for (int i = 0; i < 4; ++i) { ag[i] = 0.f; au[i] = 0.f; }
                for (int k = 0; k < 1024; ++k) { const float xk = __shfl(x[k >> 6], k & 63); const float* wr = W1 + (size_t)k * 2 * FFE + lane + 64 * i0;
#pragma unroll
                    for (int i = 0; i < 4; ++i) { ag[i] += xk * wr[64 * i]; au[i] += xk * wr[FFE + 64 * i]; } }
#pragma unroll
                for (int i = 0; i < 4; ++i) hb[lane + 64 * (i0 + i)] = (ag[i] / (1.0f + expf(-ag[i]))) * au[i]; }
            LDS_WAIT();
            const float* W2 = w2 + (size_t)e * FFE * 1024;
            for (int hh = 0; hh < FFE; ++hh) { const float hv = hb[hh] * gw;
#pragma unroll
                for (int j = 0; j < 16; ++j) out[j] += hv * W2[(size_t)hh * 1024 + lane + 64 * j]; }
            LDS_WAIT(); }
#pragma unroll
        for (int j = 0; j < 16; ++j) { const int c = lane + 64 * j; const float got = bf2f(ys[(size_t)(2 * t) * 1024 + c]) + bf2f(ys[(size_t)(2 * t + 1) * 1024 + c]);
            if (fabsf(got - out[j]) > 0.05f * fabsf(out[j]) + 0.03f) bad = 1; }
        { float v[16], sm = 0.f, s2 = 0.f;
#pragma unroll
          for (int j = 0; j < 16; ++j) { v[j] = x[j] * DN_ALPHA + out[j]; sm += v[j]; }
          const float mean = wave_sum(sm) * (1.0f / 1024.0f);
#pragma unroll
          for (int j = 0; j < 16; ++j) { v[j] -= mean; s2 += v[j] * v[j]; }
          const float rstd = 1.0f / sqrtf(wave_sum(s2) * (1.0f / 1024.0f) + 1e-5f);
          int zz = 0; asm volatile("" : "+v"(zz));
#pragma unroll
          for (int j = 0; j < 16; ++j) { const int c = lane + 64 * j + zz; stash[(size_t)s * 1024 + c] = v[j] * rstd * g3[c] + b3[c]; } }
    }
    chk_flag(C, bit, bad);
}
#ifndef ABL_MIX
#define ABL_MIX 1.0f
#endif
#ifndef ABL_XA
#define ABL_XA 1.0f
#endif
#ifndef ABL_FF
#define ABL_FF 1.0f
#endif
#ifndef CHK_TOL2
#define CHK_TOL2 0.05f
#endif
#ifndef GATE_ACT
#define GATE_ACT 1
#endif
#ifndef GATE_ALIGN
#define GATE_ALIGN true
#endif
#ifndef FG_TOL
#define FG_TOL 0.05f
#endif
#ifndef FG_BIT
#define FG_BIT 1
#endif
#ifndef CHECKS_LAYER
#define CHECKS_LAYER 0
#endif
#ifndef MK_SPLIT
#define MK_SPLIT 0
#endif
constexpr int PH_L0 = 1, PH_L1 = 18, PH_MOE = 32, PH_TOTAL = PH_MOE + 2 + 2 * MOE_PASSES + 1;

__global__ void __launch_bounds__(NTHREADS, 2) hybrid_fwd(Args args) {
    extern __shared__ __attribute__((aligned(16))) unsigned char lds_raw[];
    Ctx C; C.in = args.in; C.out = args.out; C.ws = args.ws; C.lds = (LAS unsigned char*)lds_raw;
    C.tid = threadIdx.x; C.lane = C.tid & 63; C.wave = __builtin_amdgcn_readfirstlane(C.tid >> 6); C.G = gridDim.x; C.bid = blockIdx.x;
    const Ctx C0 = C;
    for (int u = C.tid; u < (LDS_BYTES - LDSCTL_OFF) / 4; u += NTHREADS) ((LAS unsigned*)(C.lds + LDSCTL_OFF))[u] = 0u;
    __syncthreads();
    const int lo = args.ph_lo, hi = args.ph_hi;
    XcdBarrier bar; bar.bar = (unsigned*)(C.ws + WS_CTL) + CW_BAR; bar.x = 0; bar.st = (volatile LAS unsigned*)(C.lds + LDSCTL_OFF);
    if (hi - lo > 1) bar = xcd_barrier_post((unsigned*)(C.ws + WS_CTL) + CW_BAR, (volatile LAS unsigned*)(C.lds + LDSCTL_OFF));
#ifndef SITE_MASK
#define SITE_MASK 0xffffffffu
#endif
#define SITE(n) (((SITE_MASK) >> (n)) & 1u)
#define IN(k) (lo <= (k) && (k) < hi)
#define ENDPH(k) do { if ((k) + 1 < hi) xcd_barrier(bar); } while (0)
#define SITE_BEGIN const Ctx C = launder(C0); unsigned char* LW = C.ws + W_BASE + (size_t)l * LW_SIZE; const bf16_t* XB = WSP(bf16_t, W_XB); float* XRES = WSP(float, W_XRES); (void)LW; (void)XB; (void)XRES; LAS unsigned char* ring = C.lds; (void)ring;

    if (SITE(0) && IN(0)) { const int l = 0; SITE_BEGIN ph_prologue(C);
#ifdef TIME_PRO2
        xcd_barrier(bar); ph_prologue(C);
#endif
#ifdef TIME_BAR
        for (int q_ = 0; q_ < TIME_BAR; ++q_) xcd_barrier(bar);
#endif
        ENDPH(0); }

    for (int l = 0; l < 2; ++l) {
        const int pb = l == 0 ? PH_L0 : PH_L1;
        if (SITE(1) && IN(pb + 0)) { SITE_BEGIN
#ifdef CHECKS3
            if (l == 1) chk_ln_cmp(C, 1, 1);
#endif
            { pg8::Gemm g{XB, (const bf16_t*)(LW + LW_WIN), 1024, 1024, 1024}; sch::Tiles S{T / 256, NPROJ / 256, C.G, C.bid}; epi::StoreBf16<0> E{WSP(bf16_t, S_PROJ), NPROJ}; pg8::gemm_phase(ring, g, S, E); }
            { pg8::Gemm g{(const bf16_t*)C.ws, (const bf16_t*)C.ws, 1024, 1024, 1024}; sch::MemKV S{(long)(W_MEMB / 2), (long)((W_BASE + (size_t)l * LW_SIZE + LW_WKV) / 2), C.bid};
              epi::StoreKV E{WSP(bf16_t, W_KMEM) + (size_t)l * NMEM * 1024, WSP(bf16_t, W_VMEMT) + (size_t)l * 1024 * NMEM}; pg8::gemm_phase(ring, g, S, E); }
            ENDPH(pb + 0);
        }
        if (SITE(2) && IN(pb + 1)) { SITE_BEGIN
#ifdef CHECKS5
            if (l == 0) chk_weights<28, false>(C, 0);
#endif
#ifdef CHECKS9
            if (l == 0) { unsigned bad = 0; const float* x = C.in[I_X]; const float* mm = C.in[I_MEM]; const bf16_t* mb = WSP(bf16_t, W_MEMB);
                for (size_t i = (size_t)C.bid * NTHREADS + C.tid; i < (size_t)T * 1024; i += (size_t)C.G * NTHREADS) if (!chk_close(x[i], bf2f(XB[i]))) bad = 1;
                for (size_t i = (size_t)C.bid * NTHREADS + C.tid; i < (size_t)NMEM * 1024; i += (size_t)C.G * NTHREADS) if (!chk_close(mm[i], bf2f(mb[i]))) bad = 1;
                if (bad) __hip_atomic_fetch_add((unsigned*)(C.ws + WS_CTL) + CW_CHK, 1u, RLX_AGENT); }
#endif
#ifdef CHECKS12P
            if (l == CHECKS_LAYER) { const bf16_t* proj = WSP(bf16_t, S_PROJ); chk_full_gemm(C, XB, (const bf16_t*)(LW + LW_WIN), 1024, 3236, 0, [&](size_t r, int c, float d) { return chk_close(d, bf2f(proj[r * NPROJ + c])); }); xcd_barrier(bar); }
#endif
#ifdef CHECKS4
            if (l == CHECKS_LAYER) { const bf16_t* KM_ = WSP(bf16_t, W_KMEM) + (size_t)l * NMEM * 1024; const bf16_t* VT_ = WSP(bf16_t, W_VMEMT) + (size_t)l * 1024 * NMEM;
                chk_gemm(C, WSP(bf16_t, W_MEMB), 1024, (const bf16_t*)(LW + LW_WKV), 1024, 1024, NMEM, 64, 16, 3, 0, [&](int r, int c, float d) { return chk_close(d, bf2f(KM_[(size_t)r * 1024 + c])); });
                chk_gemm(C, (const bf16_t*)(LW + LW_WKV) + (size_t)1024 * 1024, 1024, WSP(bf16_t, W_MEMB), 1024, 1024, 1024, 256, 16, 5, 1, [&](int r, int c, float d) { return chk_close(d, bf2f(VT_[(size_t)r * NMEM + c])); }); }
#endif
#ifdef CHECKS
            if (l == CHECKS_LAYER) { const bf16_t* proj = WSP(bf16_t, S_PROJ); chk_gemm(C, XB, 1024, (const bf16_t*)(LW + LW_WIN), 1024, 1024, T, 13, 256, 7, 0, [&](int r, int c, float d) { return chk_close(d, bf2f(proj[(size_t)r * NPROJ + c])); }); }
#endif
            ph_prep(C, l);
#ifdef TIME_PREP2
            xcd_barrier(bar); ph_prep(C, l);
#endif
            ENDPH(pb + 1); }
        if (SITE(3) && IN(pb + 2)) { SITE_BEGIN
            { pg8::Gemm g{WSP(bf16_t, S_LA), (const bf16_t*)(LW + LW_LORA), 256, 256, 256}; sch::Tiles S{T / 256, 3, C.G, C.bid}; epi::Lora E{WSP(float, S_DEC), WSP(bf16_t, S_AV), WSP(bf16_t, S_GV), C.in[I_RWW0] + l * 256, C.in[I_RWA0] + l * 256}; pg8::gemm_phase(ring, g, S, E); }
            { pg8::Gemm g{WSP(bf16_t, S_CQN), (const bf16_t*)(LW + LW_WUQ), 256, 256, 256}; sch::Tiles S{T / 256, 2, C.G, (C.bid + 128) & 255}; epi::Uq E{WSP(bf16_t, S_QM), WSP(float, W_COS), WSP(float, W_SIN)}; pg8::gemm_phase(ring, g, S, E); }
            { pg8::Gemm g{WSP(bf16_t, S_CKVN), (const bf16_t*)(LW + LW_WUKV), 128, 128, 128}; sch::Tiles S{T / 256, 2, C.G, C.bid}; epi::Ukv E{WSP(bf16_t, S_KM), WSP(bf16_t, S_VM)}; pg8::gemm_phase(ring, g, S, E); }
            ENDPH(pb + 2);
        }
        if (SITE(4) && IN(pb + 3)) { SITE_BEGIN ph_rwprep(C, l); ph_ssdprep(C, l);
#ifdef TIME_RWP2
            xcd_barrier(bar); ph_rwprep(C, l); ph_ssdprep(C, l);
#endif
            ENDPH(pb + 3); }
        if (SITE(5) && IN(pb + 4)) { SITE_BEGIN
#ifdef CHECKS6
            if (l == CHECKS_LAYER) chk_mla_inputs(C, l, 0);
#endif
#ifdef CHECKS7
            if (l == CHECKS_LAYER) chk_rw_inputs(C, l, 0);
#endif
            ph_mixers(C, l);
#ifdef TIME_MIX2
            xcd_barrier(bar); ph_mixers(C, l, 1);
#endif
            ENDPH(pb + 4); }
        if (SITE(6) && IN(pb + 5)) { SITE_BEGIN
            ph_ssdfix(C, l);
            { pg8::Gemm g{XB, (const bf16_t*)(LW + LW_WGATE), 1024, 1024, 1024}; sch::Tiles S{T / 256, 16, C.G, C.bid}; epi::StoreBf16<GATE_ACT> E{WSP(bf16_t, S_G), 4096}; pg8::gemm_phase<epi::StoreBf16<GATE_ACT>, sch::Tiles, GATE_ALIGN>(ring, g, S, E);
#ifdef TIME_GATE2
              xcd_barrier(bar); pg8::gemm_phase<epi::StoreBf16<GATE_ACT>, sch::Tiles, GATE_ALIGN>(ring, g, S, E);
#endif
            }
#ifdef CHECKS14
            if (l == 0) { xcd_barrier(bar); const bf16_t* Gp = WSP(bf16_t, S_G); chk_full_gemm(C, XB, (const bf16_t*)(LW + LW_WGATE), 1024, 4096, 0, [&](size_t r, int c, float d) { return chk_close(sigmoidf_(d), bf2f(Gp[r * 4096 + c])); }); }
#endif
#ifdef CHECKS13
            if (l == 0) { xcd_barrier(bar);
              { pg8::Gemm g{XB, (const bf16_t*)(LW + LW_WGATE), 1024, 1024, 1024}; sch::Tiles S{T / 256, 16, C.G, C.bid}; epi::StoreBf16<1> E{WSP(bf16_t, S_G) + (size_t)T * 4096, 4096}; pg8::gemm_phase(ring, g, S, E); }
              xcd_barrier(bar);
              { const unsigned short* g1 = WSP(unsigned short, S_G); const unsigned short* g2 = g1 + (size_t)T * 4096; unsigned cnt = 0;
                for (size_t i = (size_t)C.bid * NTHREADS + C.tid; i < (size_t)T * 4096; i += (size_t)C.G * NTHREADS) if (g1[i] != g2[i]) ++cnt;
                if (cnt) __hip_atomic_fetch_add((unsigned*)(C.ws + WS_CTL) + CW_CHK + 2048, cnt, RLX_AGENT); } }
#endif
            ENDPH(pb + 5);
        }
        if (SITE(7) && IN(pb + 6)) { SITE_BEGIN
#ifdef FIX_G
            { bf16_t* Gw = WSP(bf16_t, S_G); const bf16_t* Wg = (const bf16_t*)(LW + LW_WGATE);
              for (size_t i = (size_t)C.bid * NTHREADS + C.tid; i < (size_t)T * 4096; i += (size_t)C.G * NTHREADS) { const size_t r = i >> 12; const int c = (int)(i & 4095);
                  Gw[i] = (bf16_t)(cvt_pk_bf16(sigmoidf_(tdot(XB + r * 1024, Wg + (size_t)c * 1024, 1024)), 0.f) & 0xffffu); }
              xcd_barrier(bar); }
#endif
#ifdef CHECKS15
            if (l == 0) { unsigned cnt = 0; const float* x = C.in[I_X];
                for (size_t i = (size_t)C.bid * NTHREADS + C.tid; i < (size_t)T * 1024; i += (size_t)C.G * NTHREADS) if (!chk_close(x[i], bf2f(XB[i]))) ++cnt;
                if (cnt) __hip_atomic_fetch_add((unsigned*)(C.ws + WS_CTL) + CW_CHK + 2048, cnt, RLX_AGENT); }
#endif
#ifdef CHECKS7
            if (l == CHECKS_LAYER) chk_ssd_norm(C, l, 1);
#endif
#ifdef CHECKS12
            if (l == CHECKS_LAYER) { const bf16_t* Gp = WSP(bf16_t, S_G); chk_full_gemm(C, XB, (const bf16_t*)(LW + LW_WGATE), 1024, 4096, FG_BIT, [&](size_t r, int c, float d) { return fabsf((GATE_ACT ? sigmoidf_(d) : d) - bf2f(Gp[r * 4096 + c])) <= FG_TOL; }); xcd_barrier(bar); }
#endif
#ifdef CHECKS
            if (l == CHECKS_LAYER) { const bf16_t* Gp = WSP(bf16_t, S_G); chk_gemm(C, XB, 1024, (const bf16_t*)(LW + LW_WGATE), 1024, 1024, T, 16, 256, 5, 1, [&](int r, int c, float d) { return chk_close(sigmoidf_(d), bf2f(Gp[(size_t)r * 4096 + c])); }); }
#endif
            { pg8::Gemm g{WSP(bf16_t, S_Y), (const bf16_t*)(LW + LW_WBR), 256, 1024, 256}; sch::BrTiles S{T / 256, 4, C.G, C.bid}; epi::BrGate E{WSP(bf16_t, S_G), WSP(float, S_MF), WSP(bf16_t, S_MB)}; pg8::gemm_phase(ring, g, S, E);
#ifdef TIME_BR2
              xcd_barrier(bar); pg8::gemm_phase(ring, g, S, E);
#endif
            }
            ENDPH(pb + 6);
        }
        if (SITE(8) && IN(pb + 7)) { SITE_BEGIN
#ifdef CHECKS2
            if (l == CHECKS_LAYER) chk_merged(C, l, 0);
#endif
            { pg8::Gemm g{WSP(bf16_t, S_MB), (const bf16_t*)(LW + LW_WOUT), 1024, 1024, 1024}; sch::Tiles S{T / 256, 4, C.G, C.bid}; epi::Resid E{C.in[I_X], XRES, ABL_MIX, l == 0 ? nullptr : XB}; pg8::gemm_phase(ring, g, S, E); }
            ENDPH(pb + 7);
        }
        if (SITE(9) && IN(pb + 8)) { SITE_BEGIN
#ifdef CHECKS10
            if (l == 0) { chk_full_p7(C, l, 1); xcd_barrier(bar); }
#endif
#ifdef CHECKS
            if (l == 0) { const float* xin = C.in[I_X]; chk_gemm(C, WSP(bf16_t, S_MB), 1024, (const bf16_t*)(LW + LW_WOUT), 1024, 1024, T, 4, 256, 9, 2, [&](int r, int c, float d) { return fabsf(xin[(size_t)r * 1024 + c] * DN_ALPHA + d - XRES[(size_t)r * 1024 + c]) <= CHK_TOL2; }); }
#endif
            ph_ln<false>(C, XRES, nullptr, WSP(bf16_t, W_XB), C.in[I_LN1G] + l * 1024, C.in[I_LN1B] + l * 1024, nullptr);
#ifdef TIME_LN2
            xcd_barrier(bar); ph_ln<false>(C, XRES, nullptr, WSP(bf16_t, W_XB), C.in[I_LN1G] + l * 1024, C.in[I_LN1B] + l * 1024, nullptr);
#endif
            ENDPH(pb + 8); }
        if (SITE(10) && IN(pb + 9)) { SITE_BEGIN
            { pg8::Gemm g{XB, (const bf16_t*)(LW + LW_WQ), 1024, 1024, 1024}; sch::Tiles S{T / 256, 4, C.G, C.bid}; epi::StoreBf16<0> E{WSP(bf16_t, S_XQ), 1024}; pg8::gemm_phase(ring, g, S, E); }
            ENDPH(pb + 9);
        }
        if (SITE(11) && IN(pb + 10)) { SITE_BEGIN
#ifdef CHECKS
            if (l == CHECKS_LAYER) { const bf16_t* XQ = WSP(bf16_t, S_XQ); chk_gemm(C, XB, 1024, (const bf16_t*)(LW + LW_WQ), 1024, 1024, T, 4, 256, 11, 3, [&](int r, int c, float d) { return chk_close(d, bf2f(XQ[(size_t)r * 1024 + c])); }); }
#endif
            { pg8::Gemm g{WSP(bf16_t, S_XQ), WSP(bf16_t, W_KMEM) + (size_t)l * NMEM * 1024, 256, 1024, 1024}; sch::XaS S{C.G, C.bid}; epi::Softmax E{WSP(bf16_t, S_XP), (LAS float*)(C.lds + XCH_OFF)};
#ifndef NAIVE_XA
              pg8::gemm_phase(ring, g, S, E);
#else
              (void)g; (void)S; (void)E; xattn_naive(C, l);
#endif
            }
            ENDPH(pb + 10);
        }
        if (SITE(12) && IN(pb + 11)) { SITE_BEGIN
            { pg8::Gemm g{WSP(bf16_t, S_XP), WSP(bf16_t, W_VMEMT) + (size_t)l * 1024 * NMEM, 256, 1024, NMEM}; sch::XaPV S{C.G, C.bid}; epi::StoreBf16<0> E{WSP(bf16_t, S_XO), 1024};
#ifndef NAIVE_XA
              pg8::gemm_phase(ring, g, S, E);
#else
              (void)g; (void)S; (void)E;
#endif
            }
            ENDPH(pb + 11);
        }
        if (SITE(13) && IN(pb + 12)) { SITE_BEGIN
#ifdef CHECKS3
            if (l == 0) { chk_resid_stash(C, WSP(bf16_t, S_XO), 1024, (const bf16_t*)(LW + LW_WO), 1024, 1024, 0); xcd_barrier(bar); }
#endif
            { pg8::Gemm g{WSP(bf16_t, S_XO), (const bf16_t*)(LW + LW_WO), 1024, 1024, 1024}; sch::Tiles S{T / 256, 4, C.G, C.bid}; epi::Resid E{nullptr, XRES, ABL_XA, XB}; pg8::gemm_phase(ring, g, S, E); }
            ENDPH(pb + 12);
        }
        if (SITE(14) && IN(pb + 13)) { SITE_BEGIN
#ifdef CHECKS3
            if (l == 0) chk_resid_cmp(C, 0, 2);
#endif
            ph_ln<false>(C, XRES, l == 1 ? XRES : nullptr, WSP(bf16_t, W_XB), C.in[I_LN2G] + l * 1024, C.in[I_LN2B] + l * 1024, nullptr); ENDPH(pb + 13); }
        if (l == 0) {
            if (SITE(15) && IN(pb + 14)) { SITE_BEGIN
                { pg8::Gemm g{XB, WSP(bf16_t, W_FFN13), 1024, 1024, 1024}; sch::Tiles S{T / 256, 2 * FFD / 256, C.G, C.bid}; epi::Swiglu E{WSP(bf16_t, S_H), FFD, 0}; pg8::gemm_phase(ring, g, S, E);
#ifdef TIME_UP2
                  for (int rep_ = 0; rep_ < 1; ++rep_) { xcd_barrier(bar); pg8::gemm_phase(ring, g, S, E); }
#endif
                }
                ENDPH(pb + 14);
            }
            if (SITE(16) && IN(pb + 15)) { SITE_BEGIN
#ifdef CHECKS2
                chk_swiglu(C, 1);
#endif
#ifdef CHECKS3
                chk_resid_stash(C, WSP(bf16_t, S_H), FFD, WSP(bf16_t, W_FFN2), FFD, FFD, 0); xcd_barrier(bar);
#endif
                { pg8::Gemm g{WSP(bf16_t, S_H), WSP(bf16_t, W_FFN2), FFD, FFD, FFD}; sch::Tiles S{T / 256, 4, C.G, C.bid}; epi::Resid E{nullptr, XRES, ABL_FF, XB}; pg8::gemm_phase(ring, g, S, E); }
                ENDPH(pb + 15);
            }
            if (SITE(17) && IN(pb + 16)) { SITE_BEGIN
#ifdef CHECKS3
                chk_resid_cmp(C, 0, 0); chk_ln_stash(C, C.in[I_LN3G], C.in[I_LN3B], 1); xcd_barrier(bar);
#endif
                ph_ln<false>(C, XRES, nullptr, WSP(bf16_t, W_XB), C.in[I_LN3G], C.in[I_LN3B], nullptr); ENDPH(pb + 16); }
        } else {
            if (SITE(18) && IN(PH_MOE)) { SITE_BEGIN ph_router(C); ENDPH(PH_MOE); }
            if (SITE(19) && IN(PH_MOE + 1)) { SITE_BEGIN
#ifdef CHECKS5
                chk_weights<16, true>(C, 1);
#endif
                ph_scatter(C); ENDPH(PH_MOE + 1); }
            for (int p = 0; p < MOE_PASSES; ++p) {
                const int* blk_e = WSP(int, S_BLKE);
                if (SITE(20) && IN(PH_MOE + 2 + 2 * p)) { SITE_BEGIN
                    const int used = __builtin_amdgcn_readfirstlane(__hip_atomic_load(blk_e + MOE_BLOCKS, RLX_AGENT)); const int b0 = p * MOE_PASS_BLOCKS, b1 = min(b0 + MOE_PASS_BLOCKS, used);
                    if (b1 > b0) { pg8::Gemm g{WSP(bf16_t, S_XS), WSP(bf16_t, S_MW13), 1024, 1024, 1024}; sch::MoeUp S{blk_e, b0, b1, C.G, C.bid}; epi::Swiglu E{WSP(bf16_t, S_MH), FFE, 1}; pg8::gemm_phase(ring, g, S, E); }
                    ENDPH(PH_MOE + 2 + 2 * p);
                }
                if (SITE(21) && IN(PH_MOE + 3 + 2 * p)) { SITE_BEGIN
                    const int used = __builtin_amdgcn_readfirstlane(__hip_atomic_load(blk_e + MOE_BLOCKS, RLX_AGENT)); const int b0 = p * MOE_PASS_BLOCKS, b1 = min(b0 + MOE_PASS_BLOCKS, used);
                    if (b1 > b0) { pg8::Gemm g{WSP(bf16_t, S_MH), WSP(bf16_t, S_MW2), FFE, FFE, FFE}; sch::MoeDown S{blk_e, b0, b1, C.G, C.bid}; epi::MoeDown E{WSP(int, S_ROWSLOT), WSP(float, S_ROWW), WSP(bf16_t, S_YS)}; pg8::gemm_phase(ring, g, S, E); }
                    ENDPH(PH_MOE + 3 + 2 * p);
                }
            }
            if (SITE(22) && IN(PH_TOTAL - 1)) { SITE_BEGIN
#ifdef CHECKS8
                chk_moe(C, 0); xcd_barrier(bar);
#endif
#define FINAL_LN_SITE 1
 ph_ln<true>(C, XRES, C.out, nullptr, C.in[I_LN3G] + 1024, C.in[I_LN3B] + 1024, WSP(bf16_t, S_YS));
#ifdef CHECKS11
                xcd_barrier(bar);
                { unsigned cnt = 0; for (size_t i = (size_t)C.bid * NTHREADS + C.tid; i < (size_t)T * 1024; i += (size_t)C.G * NTHREADS) if (fabsf(C.out[i]) > CHK11_THR) ++cnt;
                  if (cnt) __hip_atomic_fetch_add((unsigned*)(C.ws + WS_CTL) + CW_CHK + 2048, cnt, RLX_AGENT); }
                xcd_barrier(bar);
                { unsigned v_ = __hip_atomic_load((const unsigned*)(C.ws + WS_CTL) + CW_CHK + 2048, RLX_AGENT); int n = 0; while (v_ > 0u) { ++n; v_ >>= 1; }
                  const float sc = 1.0f + 0.1f * (float)n; for (size_t i = (size_t)C.bid * NTHREADS + C.tid; i < (size_t)T * 1024; i += (size_t)C.G * NTHREADS) C.out[i] *= sc; }
#endif
#ifdef CHECKS8
                xcd_barrier(bar);
                { const float* stash = WSP(float, W_KMEM); unsigned bad = 0; const float cs = 1.0f; (void)cs;
                  for (int s = GW; s < 1024; s += NGW) { const int t = (int)(((long)s * 1021 + 7) % T); if (stash[(size_t)s * 1024] > 1.0e29f) continue;
                      for (int j = 0; j < 16; ++j) { const int c = C.lane + 64 * j; const float e = stash[(size_t)s * 1024 + c], gt = C.out[(size_t)t * 1024 + c]; if (fabsf(e - gt) > 0.05f * fabsf(e) + 0.05f) bad = 1; } }
                  chk_flag(C, 1, bad); }
                xcd_barrier(bar);
                { const unsigned* cw = (const unsigned*)(C.ws + WS_CTL) + CW_CHK; if (__hip_atomic_load(cw + 64, RLX_AGENT) != 0u) { for (size_t i = (size_t)C.bid * NTHREADS + C.tid; i < (size_t)T * 1024; i += (size_t)C.G * NTHREADS) C.out[i] *= 1.5f; } }
#endif
            }
        }
    }
#undef IN
#undef ENDPH
}

extern "C" void kernel_launch(void* const* d_in, const int* in_sizes, int n_in, void* d_out, int out_size, void* d_ws, size_t ws_size, hipStream_t stream) {
    static int grid = 0;
    if (grid == 0) {
        if (n_in != 42 || in_sizes[0] != T * DM || out_size != T * DM || ws_size < WS_NEED) { fprintf(stderr, "kernel_launch: unexpected problem (n_in %d, in0 %d, out %d, ws %zu < %zu)\n", n_in, n_in > 0 ? in_sizes[0] : -1, out_size, ws_size, (size_t)WS_NEED); grid = -1; return; }
        int dev = 0, cus = 0;
        if (hipGetDevice(&dev) != hipSuccess || hipDeviceGetAttribute(&cus, hipDeviceAttributeMultiprocessorCount, dev) != hipSuccess) { grid = -1; return; }
        if (hipFuncSetAttribute((const void*)hybrid_fwd, hipFuncAttributeMaxDynamicSharedMemorySize, LDS_BYTES) != hipSuccess) { fprintf(stderr, "kernel_launch: hipFuncSetAttribute failed\n"); grid = -1; return; }
        int per_cu = 0;
        if (hipOccupancyMaxActiveBlocksPerMultiprocessor(&per_cu, (const void*)hybrid_fwd, NTHREADS, LDS_BYTES) != hipSuccess || per_cu < 1) fprintf(stderr, "kernel_launch: occupancy query says %d\n", per_cu);
        (void)hipGetLastError();
        if (cus != 256) { fprintf(stderr, "kernel_launch: built for 256 CUs, device has %d\n", cus); grid = -1; return; }
        grid = 256;
    }
    if (grid < 0) return;
#ifdef ZERO_WS
    (void)hipMemsetAsync((char*)d_ws + ZERO_WS_LO, 0, ZERO_WS_HI - ZERO_WS_LO, stream);
#endif
    (void)hipMemsetAsync((char*)d_ws + WS_CTL, 0, CTL_BYTES, stream);
    Args a{};
    for (int i = 0; i < 42; ++i) a.in[i] = (const float*)d_in[i];
    a.out = (float*)d_out; a.ws = (unsigned char*)d_ws;
#if MK_SPLIT
    for (int p = 0; p < PH_TOTAL; ++p) { a.ph_lo = p; a.ph_hi = p + 1; hipLaunchKernelGGL(hybrid_fwd, dim3(grid), dim3(NTHREADS), LDS_BYTES, stream, a); }
#else
    a.ph_lo = 0; a.ph_hi = PH_TOTAL; hipLaunchKernelGGL(hybrid_fwd, dim3(grid), dim3(NTHREADS), LDS_BYTES, stream, a);
#ifdef TIME_LIST
#ifdef TIME_VAR
    (void)hipMemsetAsync((char*)d_ws + WS_CTL + 200000 * 4, TIME_VAR, 4, stream);
#endif
    { const int tl_[] = TIME_LIST; for (int r_ = 0; r_ < TIME_REP; ++r_) for (int q_ = 0; q_ < (int)(sizeof(tl_) / sizeof(int)); ++q_) { a.ph_lo = tl_[q_]; a.ph_hi = tl_[q_] + (tl_[q_] >= 0 ? 1 : 0); hipLaunchKernelGGL(hybrid_fwd, dim3(grid), dim3(NTHREADS), LDS_BYTES, stream, a); } }
#endif
#endif
}
```

```cpp
#define EPI_DEPTH 3
#include <hip/hip_runtime.h>
#include <cstdio>
#include <cstdint>

#define GAS __attribute__((address_space(1)))
#define LAS __attribute__((address_space(3)))
typedef unsigned short bf16_t;
typedef short bf16x8 __attribute__((ext_vector_type(8)));
typedef short bf16x4 __attribute__((ext_vector_type(4)));
typedef float f32x2 __attribute__((ext_vector_type(2)));
typedef float f32x4 __attribute__((ext_vector_type(4)));
typedef float f32x16 __attribute__((ext_vector_type(16)));
typedef unsigned u32x4 __attribute__((ext_vector_type(4)));
typedef unsigned u32x2 __attribute__((ext_vector_type(2)));
#define RLX_AGENT __ATOMIC_RELAXED, __HIP_MEMORY_SCOPE_AGENT

constexpr int NB = 16, SEQ = 2048, DM = 1024, T = NB * SEQ;
constexpr int NPROJ = 3328;
constexpr int PC_SBQ = 0, PC_SBK = 256, PC_SBV = 512, PC_RW = 768, PC_Z = 1792, PC_XS = 2048, PC_BM = 2304, PC_CM = 2560, PC_CQ = 2816, PC_CKV = 3072, PC_KR = 3200, PC_DT = 3232;
constexpr int MEMT = 256, NMEM = NB * MEMT;
constexpr int FFD = 2816, FFE = 3584, NEXP = 8;
constexpr int MOE_ROWS = 2 * T + NEXP * 256;
constexpr int MOE_BLOCKS = MOE_ROWS / 256;
constexpr int MOE_PASS_BLOCKS = 64, MOE_PASSES = 5;
constexpr float DN_ALPHA = 1.4142135623730951f;
constexpr float LOG2E = 1.4426950408889634f;

constexpr size_t MiB = 1u << 20;
constexpr size_t WS_CTL = 0, CTL_BYTES = 1 * MiB;
constexpr int CW_BAR = 1024;
constexpr int CW_QUEUE = 8192;
constexpr int CW_MOECNT = 16384;
constexpr size_t W_BASE = CTL_BYTES;
constexpr size_t LW_WIN = 0;
constexpr size_t LW_WGATE = LW_WIN + (size_t)NPROJ * 1024 * 2;
constexpr size_t LW_WBR = LW_WGATE + (size_t)4096 * 1024 * 2;
constexpr size_t LW_WOUT = LW_WBR + (size_t)4 * 1024 * 256 * 2;
constexpr size_t LW_LORA = LW_WOUT + (size_t)1024 * 1024 * 2;
constexpr size_t LW_WUQ = LW_LORA + (size_t)768 * 256 * 2;
constexpr size_t LW_WUKV = LW_WUQ + (size_t)512 * 256 * 2;
constexpr size_t LW_WQ = LW_WUKV + (size_t)512 * 128 * 2;
constexpr size_t LW_WKV = LW_WQ + (size_t)1024 * 1024 * 2;
constexpr size_t LW_WO = LW_WKV + (size_t)2048 * 1024 * 2;
constexpr size_t LW_SIZE = LW_WO + (size_t)1024 * 1024 * 2;
constexpr size_t W_FFN13 = W_BASE + 2 * LW_SIZE;
constexpr size_t W_FFN2 = W_FFN13 + (size_t)2 * FFD * 1024 * 2;
constexpr size_t W_KMEM = W_FFN2 + (size_t)1024 * FFD * 2;
constexpr size_t W_VMEMT = W_KMEM + (size_t)2 * NMEM * 1024 * 2;
constexpr size_t W_MEMB = W_VMEMT + (size_t)2 * 1024 * NMEM * 2;
constexpr size_t W_COS = W_MEMB + (size_t)NMEM * 1024 * 2;
constexpr size_t W_SIN = W_COS + (size_t)T * 16 * 4;
constexpr size_t W_XB = W_SIN + (size_t)T * 16 * 4;
constexpr size_t W_XRES = W_XB + (size_t)T * 1024 * 2;
constexpr size_t S_BASE = W_XRES + (size_t)T * 1024 * 4;
constexpr size_t S_Y = S_BASE;
constexpr size_t S_SSQ = S_Y + (size_t)T * 1024 * 2;
constexpr size_t S_PROJ = S_SSQ + (size_t)T * 8 * 4;
constexpr size_t S_LA = S_PROJ + (size_t)T * NPROJ * 2;
constexpr size_t S_CQN = S_LA + (size_t)T * 256 * 2;
constexpr size_t S_CKVN = S_CQN + (size_t)T * 256 * 2;
constexpr size_t S_DEC = S_CKVN + (size_t)T * 128 * 2;
constexpr size_t S_AV = S_DEC + (size_t)T * 256 * 4;
constexpr size_t S_GV = S_AV + (size_t)T * 256 * 2;
constexpr size_t S_QM = S_GV + (size_t)T * 256 * 2;
constexpr size_t S_KM = S_QM + (size_t)T * 384 * 2;
constexpr size_t S_VM = S_KM + (size_t)T * 384 * 2;
constexpr size_t S_RWS = S_VM + (size_t)T * 256 * 2;
constexpr size_t S_XA = S_RWS + (size_t)5 * T * 256 * 2;
constexpr size_t S_BC = S_XA + (size_t)T * 256 * 2;
constexpr size_t S_CC = S_BC + (size_t)T * 256 * 2;
constexpr size_t S_ACS = S_CC + (size_t)T * 256 * 2;
constexpr size_t S_DTV = S_ACS + (size_t)T * 4 * 4;
constexpr size_t S_YRAW = S_DTV + (size_t)T * 4 * 4;
constexpr size_t S_MIX_END = S_YRAW + (size_t)T * 256 * 2;
constexpr size_t S_G = S_PROJ;
constexpr size_t S_MF = S_G + (size_t)T * 4096 * 2;
constexpr size_t S_MB = S_MF + (size_t)T * 1024 * 4;
constexpr size_t S_GATE_END = S_MB + (size_t)T * 1024 * 2;
constexpr size_t S_XQ = S_BASE;
constexpr size_t S_XP = S_XQ + (size_t)T * 1024 * 2;
constexpr size_t S_XO = S_XP + (size_t)T * 1024 * 2;
constexpr size_t S_H = S_BASE;
constexpr size_t S_MW13 = S_BASE;
constexpr size_t S_MW2 = S_MW13 + (size_t)NEXP * 2 * FFE * 1024 * 2;
constexpr size_t S_XS = S_MW2 + (size_t)NEXP * 1024 * FFE * 2;
constexpr size_t S_YS = S_XS + (size_t)MOE_ROWS * 1024 * 2;
constexpr size_t S_MH = S_YS + (size_t)2 * T * 1024 * 2;
constexpr size_t S_TOPI = S_MH + (size_t)MOE_PASS_BLOCKS * 256 * FFE * 2;
constexpr size_t S_TOPW = S_TOPI + (size_t)T * 2 * 4;
constexpr size_t S_ROWSLOT = S_TOPW + (size_t)T * 2 * 4;
constexpr size_t S_ROWW = S_ROWSLOT + (size_t)MOE_ROWS * 4;
constexpr size_t S_BLKE = S_ROWW + (size_t)MOE_ROWS * 4;
constexpr size_t S_MOE_END = S_BLKE + 4096;
constexpr size_t cmax(size_t a, size_t b) { return a > b ? a : b; }
constexpr size_t WS_NEED = cmax(cmax(S_MIX_END, S_GATE_END), S_MOE_END);
static_assert(WS_NEED <= (size_t)896 * MiB, "workspace map exceeds 896 MiB");
static_assert((W_BASE % 256) == 0 && (LW_SIZE % 256) == 0 && (S_BASE % 256) == 0, "alignment");

constexpr int RING_BYTES = 131072;
constexpr int XCH_OFF = RING_BYTES;
constexpr int LDSCTL_OFF = RING_BYTES + 16384;
constexpr int LDS_BYTES = LDSCTL_OFF + 512;
constexpr int NWAVES = 8, NTHREADS = 512;

typedef __bf16 bf16x2_t __attribute__((ext_vector_type(2)));
__device__ __forceinline__ unsigned cvt_pk_bf16(float lo, float hi) { bf16x2_t v = {(__bf16)lo, (__bf16)hi}; return __builtin_bit_cast(unsigned, v); }
__device__ __forceinline__ float bf2f(unsigned short b) { return __uint_as_float((unsigned)b << 16); }
__device__ __forceinline__ float bflo(unsigned w) { return __uint_as_float(w << 16); }
__device__ __forceinline__ float bfhi(unsigned w) { return __uint_as_float(w & 0xffff0000u); }
__device__ __forceinline__ float fexp2(float x) { return __builtin_amdgcn_exp2f(x); }
__device__ __forceinline__ float flog2(float x) { return __builtin_amdgcn_logf(x); }
__device__ __forceinline__ float frcp(float x) { return __builtin_amdgcn_rcpf(x); }
__device__ __forceinline__ float sigmoidf_(float x) { return frcp(1.0f + fexp2(-x * LOG2E)); }
__device__ __forceinline__ float siluf_(float x) { return x * sigmoidf_(x); }
__device__ __forceinline__ float softplusf_(float x) { return fmaxf(x, 0.f) + 0.6931471805599453f * flog2(1.0f + fexp2(-fabsf(x) * LOG2E)); }
#define DPPADD_(v, ctrl, rmask) (v) += __builtin_bit_cast(float, __builtin_amdgcn_update_dpp(0, __builtin_bit_cast(int, (v)), (ctrl), (rmask), 0xf, false))
__device__ __forceinline__ float row_sum16(float v) {
    DPPADD_(v, 0xB1, 0xf); DPPADD_(v, 0x4E, 0xf); DPPADD_(v, 0x141, 0xf); DPPADD_(v, 0x140, 0xf); return v; }
__device__ __forceinline__ float wave_sum(float v) {
    v = row_sum16(v); DPPADD_(v, 0x142, 0xa); DPPADD_(v, 0x143, 0xc);
    return __builtin_bit_cast(float, __builtin_amdgcn_readlane(__builtin_bit_cast(int, v), 63)); }
#define LDS_WAIT() asm volatile("s_waitcnt lgkmcnt(0)" ::: "memory")
#define VM_WAIT() asm volatile("s_waitcnt vmcnt(0)" ::: "memory")
#define XB_TMO      128
#define XB_XCNT(j)  (256  + 64 * (j))
#define XB_XSUB(j)  (1280 + 64 * (j))
#define XB_XGEN(j)  (2304 + 64 * (j))
#define XB_TOP      3328
#define XB_TOPGEN   3392
#define XCD_BAR_WORDS 3456
#define XB_SPIN_CAP (1u << 18)

__device__ __forceinline__ unsigned xb_ld(unsigned* p)              { return __hip_atomic_load(p, __ATOMIC_RELAXED, __HIP_MEMORY_SCOPE_AGENT); }
__device__ __forceinline__ unsigned xb_add(unsigned* p, unsigned v) { return __hip_atomic_fetch_add(p, v, __ATOMIC_RELAXED, __HIP_MEMORY_SCOPE_AGENT); }
__device__ __forceinline__ unsigned xb_xcc_id() { return (unsigned)__builtin_amdgcn_s_getreg((3 << 11) | 20) & 0xFu; }
#define XB_SPIN(cond, bar) do { unsigned _sp = 0; while (cond) { __builtin_amdgcn_s_sleep(1); \
    if ((++_sp & 255u) == 0u) { if (xb_ld(&(bar)[XB_TMO])) break; if (_sp > XB_SPIN_CAP) { atomicAdd(&(bar)[XB_TMO], 1u); break; } } } } while (0)

struct XcdBarrier { unsigned* bar; unsigned x; volatile LAS unsigned* st; };

__device__ __forceinline__ XcdBarrier xcd_barrier_post(unsigned* bar, volatile LAS unsigned* st) {
    XcdBarrier b; b.bar = bar; b.x = xb_xcc_id(); b.st = st;
    if (threadIdx.x == 0) (void)xb_add(&bar[XB_XCNT(b.x)], 1u);
    return b;
}
__device__ __forceinline__ void xcd_barrier_complete(unsigned* bar, unsigned x, unsigned& nloc, unsigned& nx) {
    const unsigned G = gridDim.x * gridDim.y * gridDim.z;
    unsigned sum, cnt, mine, sp = 0u;
    for (;;) {
        sum = 0u; cnt = 0u; mine = 0u;
#pragma unroll
        for (unsigned j = 0; j < 16; ++j) { const unsigned c = xb_ld(&bar[XB_XCNT(j)]); sum += c; cnt += (c > 0u) ? 1u : 0u; mine = (j == x) ? c : mine; }
        if (sum == G) break;
        __builtin_amdgcn_s_sleep(1);
        if ((++sp & 255u) == 0u) { if (xb_ld(&bar[XB_TMO])) break; if (sp > XB_SPIN_CAP) { atomicAdd(&bar[XB_TMO], 1u); break; } }
    }
    nloc = mine > 0u ? mine : 1u; nx = cnt > 0u ? cnt : 1u;
}
__device__ __forceinline__ void xcd_barrier(const XcdBarrier& b) {
    asm volatile("s_waitcnt vmcnt(0)" ::: "memory");
    __syncthreads();
    if (threadIdx.x == 0) {
        unsigned* bar = b.bar;
        __builtin_amdgcn_s_waitcnt(0);
        unsigned nloc = b.st[0], nx = b.st[1];
        if (nloc == 0u) { xcd_barrier_complete(bar, b.x, nloc, nx); b.st[0] = nloc; b.st[1] = nx; }
        const unsigned old = xb_add(&bar[XB_XSUB(b.x)], 1u);
        const unsigned gen = old / nloc;
        if (old + 1u == (gen + 1u) * nloc) {
            __builtin_amdgcn_fence(__ATOMIC_RELEASE, "agent");
            asm volatile("s_waitcnt vmcnt(0)" ::: "memory");
            const unsigned og = xb_add(&bar[XB_TOP], 1u);
            const unsigned tg = og / nx;
            if (og + 1u == (tg + 1u) * nx) xb_add(&bar[XB_TOPGEN], 1u);
            else XB_SPIN(xb_ld(&bar[XB_TOPGEN]) == tg, bar);
            __builtin_amdgcn_fence(__ATOMIC_ACQUIRE, "agent");
            xb_add(&bar[XB_XGEN(b.x)], 1u);
            asm volatile("s_waitcnt vmcnt(0)" ::: "memory");
        } else {
            XB_SPIN(xb_ld(&bar[XB_XGEN(b.x)]) == gen, bar);
            __builtin_amdgcn_fence(__ATOMIC_ACQUIRE, "agent");
            asm volatile("s_waitcnt vmcnt(0)" ::: "memory");
        }
    }
    __syncthreads();
}

namespace pg8 {
constexpr int BM = 256, BK = 64, HALF = 128, HTB = HALF * BK * 2, STAGE_BYTES = 8 * HTB;
__host__ __device__ __forceinline__ int lds_byte(int r, int c) { const int st = (r >> 4) * 2 + (c >> 5), rr = r & 15, cc = c & 31, ob = rr * 64 + cc * 2; return st * 1024 + (ob ^ (((ob >> 9) & 1) << 5)); }
__host__ __device__ __forceinline__ void stage_rc(int b, int& R, int& C) { const int st = b / 1024, sb = b % 1024, swz = sb ^ (((sb >> 9) & 1) << 5); R = (st >> 1) * 16 + swz / 64; C = (st & 1) * 32 + (swz % 64) / 2; }
__host__ __device__ __forceinline__ int perm32(int rho) { const int n = rho >> 4, i = rho & 15; return 8 * (i >> 2) + 4 * n + (i & 3); }

struct Unit { int pm, pn; long aoff, boff; int tag; };
struct Gemm { const bf16_t* A; const bf16_t* Bt; int K, lda, ldb; };

template <class Epi, class Sched, bool ALIGN = true>
__device__ __forceinline__ void gemm_phase(LAS unsigned char* lds, const Gemm g, const Sched& S, const Epi& E) {
    int tid_ = threadIdx.x; asm volatile("" : "+v"(tid_));
    const int tid = tid_, wid = __builtin_amdgcn_readfirstlane(tid >> 6), lane = tid & 63, wr = wid >> 2, wc = wid & 3, fr = lane & 15, fq = lane >> 4;
    int K = g.K; asm volatile("" : "+s"(K)); const int nt = K / BK;
    unsigned voffA[2], voffB[2];
#pragma unroll
    for (int i = 0; i < 2; ++i) { int R, C; stage_rc(tid * 16 + i * 8192, R, C); const int Rb = Epi::PERM ? ((R & ~31) + perm32(R & 31)) : R;
        voffA[i] = (unsigned)(R * g.lda + C) * 2u; voffB[i] = (unsigned)(Rb * g.ldb + C) * 2u; }
    const size_t kstep = (size_t)(BK * 2);
    const size_t hstepA = (size_t)HALF * g.lda * 2, hstepB = (size_t)HALF * g.ldb * 2;
    const size_t tstepA = 2 * hstepA, tstepB = 2 * hstepB;
    const unsigned ldsw = (unsigned)wid * 1024u;
    const int aoff = lds_byte(wr * 64 + fr, fq * 8), boff = lds_byte(wc * 32 + fr, fq * 8);
#define PG8_SA(b, h) (((b) * 2 + (h)) * HTB)
#define PG8_SB(b, h) ((4 + (b) * 2 + (h)) * HTB)
#define PG8_STAGE(bufoff, gbase, voff) do { _Pragma("unroll") for (int _i = 0; _i < 2; ++_i) \
        __builtin_amdgcn_global_load_lds((const unsigned*)((const char*)(gbase) + (voff)[_i]), (LAS unsigned*)(lds + (bufoff) + ldsw + _i * 8192), 16, 0, 0); } while (0)
#define PG8_LDA(dst, b, h) do { _Pragma("unroll") for (int m = 0; m < 4; ++m) _Pragma("unroll") for (int k = 0; k < 2; ++k) dst[m][k] = *(const LAS bf16x8*)(lds + PG8_SA(b, h) + aoff + m * 2048 + k * 1024); } while (0)
#define PG8_LDB(dst, b, h) do { _Pragma("unroll") for (int n = 0; n < 2; ++n) _Pragma("unroll") for (int k = 0; k < 2; ++k) dst[n][k] = *(const LAS bf16x8*)(lds + PG8_SB(b, h) + boff + n * 2048 + k * 1024); } while (0)
#define PG8_MMA(ai, bj, At, Bt) do { __builtin_amdgcn_s_setprio(1); _Pragma("unroll") for (int m = 0; m < 4; ++m) _Pragma("unroll") for (int n = 0; n < 2; ++n) _Pragma("unroll") for (int k = 0; k < 2; ++k) \
        acc[ai][bj][m][n] = __builtin_amdgcn_mfma_f32_16x16x32_bf16(Bt[n][k], At[m][k], acc[ai][bj][m][n], 0, 0, 0); __builtin_amdgcn_s_setprio(0); } while (0)
#define PG8_WAIT_V(n) asm volatile("s_waitcnt vmcnt(" #n ")" ::: "memory")
#define PG8_WAIT_L(n) asm volatile("s_waitcnt lgkmcnt(" #n ")" ::: "memory")
#define PG8_BAR __builtin_amdgcn_s_barrier()
#define PG8_SCHED __builtin_amdgcn_sched_barrier(0)
    Unit cur, nxt; int ui = 0;
    if (!S.next(0, cur)) return;
    f32x4 acc[2][2][4][2];
#pragma unroll
    for (int a = 0; a < 2; ++a)
#pragma unroll
        for (int b = 0; b < 2; ++b)
#pragma unroll
            for (int m = 0; m < 4; ++m)
#pragma unroll
                for (int n = 0; n < 2; ++n) acc[a][b][m][n] = (f32x4){0.f, 0.f, 0.f, 0.f};
    bf16x8 At[4][2], B0[2][2], B1[2][2];
    const char* cA = (const char*)(g.A + cur.aoff) + (size_t)cur.pm * tstepA; const char* cB = (const char*)(g.Bt + cur.boff) + (size_t)cur.pn * tstepB;
    PG8_STAGE(PG8_SB(0, 0), cB, voffB); PG8_STAGE(PG8_SB(0, 1), cB + hstepB, voffB); PG8_STAGE(PG8_SA(0, 0), cA, voffA); PG8_STAGE(PG8_SA(0, 1), cA + hstepA, voffA);
    if (wr == 1) PG8_BAR;
    PG8_WAIT_V(2); PG8_BAR;
    PG8_STAGE(PG8_SB(1, 0), cB + kstep, voffB); PG8_STAGE(PG8_SA(1, 0), cA + kstep, voffA); PG8_STAGE(PG8_SB(1, 1), cB + hstepB + kstep, voffB);
    PG8_WAIT_V(6); PG8_BAR;
    for (;;) {
        const bool has_next = S.next(ui + 1, nxt);
        const char* nA = has_next ? (const char*)(g.A + nxt.aoff) + (size_t)nxt.pm * tstepA : cA; const char* nB = has_next ? (const char*)(g.Bt + nxt.boff) + (size_t)nxt.pn * tstepB : cB;
#pragma unroll 1
        for (int t = 0; t < nt; t += 2) {
            const bool last = (t == nt - 2);
            const char* a1 = cA + (size_t)(t + 1) * kstep;
            const char* a2 = last ? nA : cA + (size_t)(t + 2) * kstep; const char* b2 = last ? nB : cB + (size_t)(t + 2) * kstep;
            const char* a3 = a2 + kstep; const char* b3 = b2 + kstep;
            PG8_LDB(B0, 0, 0); PG8_LDB(B1, 0, 1); PG8_SCHED; PG8_LDA(At, 0, 0); PG8_STAGE(PG8_SA(1, 1), a1 + hstepA, voffA);
            PG8_WAIT_V(8); PG8_WAIT_L(0); PG8_BAR; PG8_MMA(0, 0, At, B0); PG8_MMA(0, 1, At, B1); PG8_BAR; PG8_SCHED;
            PG8_LDA(At, 0, 1); PG8_STAGE(PG8_SB(0, 0), b2, voffB); PG8_STAGE(PG8_SB(0, 1), b2 + hstepB, voffB); PG8_STAGE(PG8_SA(0, 0), a2, voffA);
            PG8_WAIT_V(8); PG8_WAIT_L(0); PG8_BAR; PG8_MMA(1, 0, At, B0); PG8_MMA(1, 1, At, B1); PG8_BAR; PG8_SCHED;
            PG8_LDB(B0, 1, 0); PG8_LDB(B1, 1, 1); PG8_SCHED; PG8_LDA(At, 1, 0); PG8_STAGE(PG8_SA(0, 1), a2 + hstepA, voffA);
            PG8_WAIT_V(8); PG8_WAIT_L(0); PG8_BAR; PG8_MMA(0, 0, At, B0); PG8_MMA(0, 1, At, B1); PG8_BAR; PG8_SCHED;
            PG8_LDA(At, 1, 1); PG8_STAGE(PG8_SB(1, 0), b3, voffB); PG8_STAGE(PG8_SB(1, 1), b3 + hstepB, voffB); PG8_STAGE(PG8_SA(1, 0), a3, voffA);
            PG8_WAIT_V(8); PG8_WAIT_L(0); PG8_BAR; PG8_MMA(1, 0, At, B0); PG8_MMA(1, 1, At, B1); PG8_BAR; PG8_SCHED;
        }
        if constexpr (ALIGN) { if (wr == 0) PG8_BAR; }
        E(acc, cur, wr, wc, fr, fq, wid, lane);
        if (!has_next) break;
#pragma unroll
        for (int a = 0; a < 2; ++a)
#pragma unroll
            for (int b = 0; b < 2; ++b)
#pragma unroll
                for (int m = 0; m < 4; ++m)
#pragma unroll
                    for (int n = 0; n < 2; ++n) acc[a][b][m][n] = (f32x4){0.f, 0.f, 0.f, 0.f};
        cur = nxt; cA = nA; cB = nB; ++ui;
        if constexpr (ALIGN) { if (wr == 1) PG8_BAR; }
    }
    PG8_WAIT_V(0);
    if constexpr (!ALIGN) { if (wr == 0) PG8_BAR; }
    PG8_BAR;
#undef PG8_SA
#undef PG8_SB
#undef PG8_STAGE
#undef PG8_LDA
#undef PG8_LDB
#undef PG8_MMA
#undef PG8_WAIT_V
#undef PG8_WAIT_L
#undef PG8_BAR
#undef PG8_SCHED
}
template <class Epi, class Sched>
__device__ __forceinline__ void gemm_phase_hn(LAS unsigned char* lds, const Gemm g, const Sched& S, Epi& E) {
    constexpr bool ALIGN = true;
    int tid_ = threadIdx.x; asm volatile("" : "+v"(tid_));
    const int tid = tid_, wid = __builtin_amdgcn_readfirstlane(tid >> 6), lane = tid & 63, wr = wid >> 2, wc = wid & 3, fr = lane & 15, fq = lane >> 4;
    int K = g.K; asm volatile("" : "+s"(K)); const int nt = K / BK;
    unsigned voffA[2], voffB[2];
#pragma unroll
    for (int i = 0; i < 2; ++i) { int R, C; stage_rc(tid * 16 + i * 8192, R, C); const int Rb = Epi::PERM ? ((R & ~31) + perm32(R & 31)) : R;
        voffA[i] = (unsigned)(R * g.lda + C) * 2u; voffB[i] = (unsigned)(Rb * g.ldb + C) * 2u; }
    const size_t kstep = (size_t)(BK * 2);
    const size_t hstepA = (size_t)HALF * g.lda * 2, hstepB = (size_t)HALF * g.ldb * 2;
    const size_t tstepA = 2 * hstepA, tstepB = hstepB;
    const unsigned ldsw = (unsigned)wid * 1024u;
    const int aoff = lds_byte(wr * 64 + fr, fq * 8), boff = lds_byte(wc * 32 + fr, fq * 8);
#define PG8_SA(b, h) (((b) * 2 + (h)) * HTB)
#define PG8_SB(b, h) ((4 + (b) * 2 + (h)) * HTB)
#define PG8_STAGE(bufoff, gbase, voff) do { _Pragma("unroll") for (int _i = 0; _i < 2; ++_i) \
        __builtin_amdgcn_global_load_lds((const unsigned*)((const char*)(gbase) + (voff)[_i]), (LAS unsigned*)(lds + (bufoff) + ldsw + _i * 8192), 16, 0, 0); } while (0)
#define PG8_LDA(dst, b, h) do { _Pragma("unroll") for (int m = 0; m < 4; ++m) _Pragma("unroll") for (int k = 0; k < 2; ++k) dst[m][k] = *(const LAS bf16x8*)(lds + PG8_SA(b, h) + aoff + m * 2048 + k * 1024); } while (0)
#define PG8_LDB(dst, b, h) do { _Pragma("unroll") for (int n = 0; n < 2; ++n) _Pragma("unroll") for (int k = 0; k < 2; ++k) dst[n][k] = *(const LAS bf16x8*)(lds + PG8_SB(b, h) + boff + n * 2048 + k * 1024); } while (0)
#define PG8_MMA(ai, At, Bt) do { __builtin_amdgcn_s_setprio(1); _Pragma("unroll") for (int m = 0; m < 4; ++m) _Pragma("unroll") for (int n = 0; n < 2; ++n) _Pragma("unroll") for (int k = 0; k < 2; ++k) \
        acc[ai][m][n] = __builtin_amdgcn_mfma_f32_16x16x32_bf16(Bt[n][k], At[m][k], acc[ai][m][n], 0, 0, 0); __builtin_amdgcn_s_setprio(0); } while (0)
#define PG8_WAIT_V(n) asm volatile("s_waitcnt vmcnt(" #n ")" ::: "memory")
#define PG8_WAIT_L(n) asm volatile("s_waitcnt lgkmcnt(" #n ")" ::: "memory")
#define PG8_BAR __builtin_amdgcn_s_barrier()
#define PG8_SCHED __builtin_amdgcn_sched_barrier(0)
    Unit cur, nxt; int ui = 0;
    if (!S.next(0, cur)) return;
    f32x4 acc[2][4][2];
#pragma unroll
    for (int a = 0; a < 2; ++a)
#pragma unroll
        for (int m = 0; m < 4; ++m)
#pragma unroll
            for (int n = 0; n < 2; ++n) acc[a][m][n] = (f32x4){0.f, 0.f, 0.f, 0.f};
    bf16x8 At[4][2], B0[2][2];
    const char* cA = (const char*)(g.A + cur.aoff) + (size_t)cur.pm * tstepA; const char* cB = (const char*)(g.Bt + cur.boff) + (size_t)cur.pn * tstepB;
    PG8_STAGE(PG8_SB(0, 0), cB, voffB); PG8_STAGE(PG8_SA(0, 0), cA, voffA); PG8_STAGE(PG8_SA(0, 1), cA + hstepA, voffA);
    if (wr == 1) PG8_BAR;
    PG8_WAIT_V(2); PG8_BAR;
    PG8_STAGE(PG8_SB(1, 0), cB + kstep, voffB); PG8_STAGE(PG8_SA(1, 0), cA + kstep, voffA);
    PG8_WAIT_V(4); PG8_BAR;
    for (;;) {
        const bool has_next = S.next(ui + 1, nxt);
        const char* nA = has_next ? (const char*)(g.A + nxt.aoff) + (size_t)nxt.pm * tstepA : cA; const char* nB = has_next ? (const char*)(g.Bt + nxt.boff) + (size_t)nxt.pn * tstepB : cB;
#pragma unroll 1
        for (int t = 0; t < nt; t += 2) {
            const bool last = (t == nt - 2);
            const char* a1 = cA + (size_t)(t + 1) * kstep;
            const char* a2 = last ? nA : cA + (size_t)(t + 2) * kstep; const char* b2 = last ? nB : cB + (size_t)(t + 2) * kstep;
            const char* a3 = a2 + kstep; const char* b3 = b2 + kstep;
            PG8_LDB(B0, 0, 0); PG8_SCHED; PG8_LDA(At, 0, 0); PG8_STAGE(PG8_SA(1, 1), a1 + hstepA, voffA);
            PG8_WAIT_V(6); PG8_WAIT_L(0); PG8_BAR; PG8_MMA(0, At, B0); PG8_BAR; PG8_SCHED;
            PG8_LDA(At, 0, 1); PG8_STAGE(PG8_SB(0, 0), b2, voffB); PG8_STAGE(PG8_SA(0, 0), a2, voffA);
            PG8_WAIT_V(6); PG8_WAIT_L(0); PG8_BAR; PG8_MMA(1, At, B0); PG8_BAR; PG8_SCHED;
            PG8_LDB(B0, 1, 0); PG8_SCHED; PG8_LDA(At, 1, 0); PG8_STAGE(PG8_SA(0, 1), a2 + hstepA, voffA);
            PG8_WAIT_V(6); PG8_WAIT_L(0); PG8_BAR; PG8_MMA(0, At, B0); PG8_BAR; PG8_SCHED;
            PG8_LDA(At, 1, 1); PG8_STAGE(PG8_SB(1, 0), b3, voffB); PG8_STAGE(PG8_SA(1, 0), a3, voffA);
            PG8_WAIT_V(6); PG8_WAIT_L(0); PG8_BAR; PG8_MMA(1, At, B0); PG8_BAR; PG8_SCHED;
        }
        if constexpr (ALIGN) { if (wr == 0) PG8_BAR; }
        E(acc, cur, wr, wc, fr, fq, wid, lane);
        if (!has_next) break;
#pragma unroll
        for (int a = 0; a < 2; ++a)
#pragma unroll
            for (int m = 0; m < 4; ++m)
#pragma unroll
                for (int n = 0; n < 2; ++n) acc[a][m][n] = (f32x4){0.f, 0.f, 0.f, 0.f};
        cur = nxt; cA = nA; cB = nB; ++ui;
        if constexpr (ALIGN) { if (wr == 1) PG8_BAR; }
    }
    PG8_WAIT_V(0);
    if constexpr (!ALIGN) { if (wr == 0) PG8_BAR; }
    PG8_BAR;
#undef PG8_SA
#undef PG8_SB
#undef PG8_STAGE
#undef PG8_LDA
#undef PG8_LDB
#undef PG8_MMA
#undef PG8_WAIT_V
#undef PG8_WAIT_L
#undef PG8_BAR
#undef PG8_SCHED
}
}
namespace sch {
using pg8::Unit;
__device__ __forceinline__ void tile_of(int L, int nM, int nN, int& pm, int& pn) {
    const int nwg = nM * nN; int wgid = L;
    { const int q = nwg / 8, r = nwg % 8, xcd = wgid % 8, off = wgid / 8; wgid = (xcd < r ? xcd * (q + 1) : r * (q + 1) + (xcd - r) * q) + off; }
    const int nig = 8 * nN, gid = wgid / nig, fm = gid * 8, gsz = (nM - fm) < 8 ? (nM - fm) : 8;
    pm = fm + ((wgid % nig) % gsz); pn = (wgid % nig) / gsz;
}
struct Tiles {
    int nM, nN, G, c;
    __device__ __forceinline__ bool next(int i, Unit& u) const {
        const long L = (long)i * G + c; if (L >= (long)nM * nN) return false;
        tile_of((int)L, nM, nN, u.pm, u.pn); u.aoff = 0; u.boff = 0; u.tag = 0; return true; }
};
struct BrTiles {
    int nM, nN, G, c;
    __device__ __forceinline__ bool next(int i, Unit& u) const {
        const long L = (long)(i >> 2) * G + c; if (L >= (long)nM * nN) return false;
        tile_of((int)L, nM, nN, u.pm, u.pn); const int br = i & 3; u.aoff = br * 256; u.boff = (long)br * 1024 * 256; u.tag = br; return true; }
};
struct BrTilesH {
    int nM, nN, G, c;
    __device__ __forceinline__ bool next(int i, Unit& u) const {
        const long L = (long)(i >> 2) * G + c; if (L >= (long)nM * nN) return false;
        int pn8; tile_of((int)L, nM, nN, u.pm, pn8); const int br = i & 3; u.pn = pn8; u.aoff = br * 256; u.boff = (long)br * 1024 * 256; u.tag = br | (pn8 << 2); return true; }
};
struct MemKV {
    long offMem, offWkv; int c;
    __device__ __forceinline__ bool next(int i, Unit& u) const {
        if (i > 0 || c < 128) return false; const int idx = c - 128;
        u.pm = idx >> 3; u.pn = idx & 7; u.aoff = offMem; u.boff = offWkv; u.tag = 0; return true; }
};
struct AbsM {
    int c;
    __device__ __forceinline__ bool next(int i, Unit& u) const {
        if (i > 0) return false; const int b = c >> 4, h = (c >> 2) & 3, dt = c & 3;
        u.pm = b; u.pn = dt; u.aoff = h * 256; u.boff = h * 256; u.tag = (b * 4 + h) | (dt << 16); return true; }
};
struct AbsN {
    int c;
    __device__ __forceinline__ bool next(int i, Unit& u) const {
        if (i > 0) return false; const int b = c >> 4, h = (c >> 2) & 3, ci = c & 3;
        u.pm = ci; u.pn = b; u.aoff = h * 256; u.boff = h * 256; u.tag = (b * 4 + ci) | (h << 16); return true; }
};
struct XaS {
    int G, c;
    __device__ __forceinline__ bool next(int i, Unit& u) const {
        const int L = i * G + c; if (L >= 512) return false;
        const int j = c >> 3, b = (c & 7) + 8 * i, h = (j >> 3) & 3, rb = j & 7;
        u.pm = b * 8 + rb; u.pn = h; u.aoff = 0; u.boff = (long)b * 1024 * 1024; u.tag = h; return true; }
};
struct XaO {
    int G, c;
    __device__ __forceinline__ bool next(int i, Unit& u) const {
        const int L = i * G + c; if (L >= 512) return false;
        const int j = c >> 3, b = (c & 7) + 8 * i, ci = (j >> 3) & 3, rb = j & 7;
        u.pm = b * 8 + rb; u.pn = ci; u.aoff = 0; u.boff = (long)b * 1024 * 1024; u.tag = 0; return true; }
};
struct MoeUp {
    const int* blk_e; int b0, b1, G, c;
    __device__ __forceinline__ bool next(int i, Unit& u) const {
        const int L = i * G + c; const int nb = b1 - b0; if (L >= nb * 28) return false;
        const int rb = b0 + L / 28; u.pn = L % 28; u.pm = rb;
        const int e = __builtin_amdgcn_readfirstlane(__hip_atomic_load(blk_e + rb, RLX_AGENT));
        u.aoff = 0; u.boff = (long)e * (2 * FFE) * 1024; u.tag = rb - b0; return true; }
};
struct MoeDown {
    const int* blk_e; int b0, b1, G, c;
    __device__ __forceinline__ bool next(int i, Unit& u) const {
        const int L = i * G + c; const int nb = b1 - b0; if (L >= nb * 4) return false;
        const int rb = b0 + L / 4; u.pn = L % 4; u.pm = rb - b0;
        const int e = __builtin_amdgcn_readfirstlane(__hip_atomic_load(blk_e + rb, RLX_AGENT));
        u.aoff = 0; u.boff = (long)e * 1024 * FFE; u.tag = rb; return true; }
};
}

namespace epi {
using pg8::Unit;
#define EPI_SIG f32x4 (&acc)[2][2][4][2], const Unit& u, int wr, int wc, int fr, int fq, int wid, int lane
#define EPI_ROWS _Pragma("unroll") for (int ai = 0; ai < 2; ++ai) _Pragma("unroll") for (int m = 0; m < 4; ++m)
#define EPI_ROW (u.pm * 256 + ai * 128 + wr * 64 + m * 16 + fr)
#define EPI_BJ _Pragma("unroll") for (int bj = 0; bj < 2; ++bj)
#define EPI_FENCE asm volatile("" ::: "memory")
#ifndef EPI_DEPTH
#define EPI_DEPTH 4
#endif
__device__ __forceinline__ u32x4 pack8(const f32x4 a, const f32x4 b) { u32x4 w; w.x = cvt_pk_bf16(a[0], a[1]); w.y = cvt_pk_bf16(a[2], a[3]); w.z = cvt_pk_bf16(b[0], b[1]); w.w = cvt_pk_bf16(b[2], b[3]); return w; }

template <int ACT> struct StoreBf16 {
    static constexpr bool PERM = true;
    bf16_t* O; int ldc;
    __device__ __forceinline__ void operator()(EPI_SIG) const {
        EPI_ROWS { bf16_t* rowp = O + (size_t)EPI_ROW * ldc + u.pn * 256 + wc * 32 + 8 * fq;
            EPI_BJ { f32x4 v0 = acc[ai][bj][m][0], v1 = acc[ai][bj][m][1];
                if (ACT == 1) { for (int j = 0; j < 4; ++j) { v0[j] = sigmoidf_(v0[j]); v1[j] = sigmoidf_(v1[j]); } }
                *(u32x4*)(rowp + bj * 128) = pack8(v0, v1); } EPI_FENCE; }
    }
};
struct StoreAt {
    static constexpr bool PERM = true;
    bf16_t* O; int ldc;
    __device__ __forceinline__ void operator()(EPI_SIG) const {
        const int rb = u.tag & 0xffff, cb = u.tag >> 16;
        EPI_ROWS { bf16_t* rowp = O + (size_t)(rb * 256 + ai * 128 + wr * 64 + m * 16 + fr) * ldc + cb * 256 + wc * 32 + 8 * fq;
            EPI_BJ { *(u32x4*)(rowp + bj * 128) = pack8(acc[ai][bj][m][0], acc[ai][bj][m][1]); } EPI_FENCE; }
    }
};
struct Lora {
    static constexpr bool PERM = true;
    float* dec; bf16_t* av; bf16_t* gv; const float* w0; const float* a0;
    __device__ __forceinline__ void operator()(EPI_SIG) const {
        EPI_ROWS { const size_t row = EPI_ROW;
            EPI_BJ { const int col = bj * 128 + wc * 32 + 8 * fq; f32x4 v0 = acc[ai][bj][m][0], v1 = acc[ai][bj][m][1];
                if (u.pn == 0) {
                    const f32x4 b0 = *(const f32x4*)(w0 + col), b1 = *(const f32x4*)(w0 + col + 4);
                    for (int j = 0; j < 4; ++j) { float x = v0[j] + b0[j]; float wl = -softplusf_(-x) - 0.5f; v0[j] = fexp2(-fexp2(wl * LOG2E) * LOG2E);
                                                  x = v1[j] + b1[j]; wl = -softplusf_(-x) - 0.5f; v1[j] = fexp2(-fexp2(wl * LOG2E) * LOG2E); }
                    *(f32x4*)(dec + row * 256 + col) = v0; *(f32x4*)(dec + row * 256 + col + 4) = v1;
                } else if (u.pn == 1) {
                    const f32x4 b0 = *(const f32x4*)(a0 + col), b1 = *(const f32x4*)(a0 + col + 4);
                    for (int j = 0; j < 4; ++j) { v0[j] = sigmoidf_(v0[j] + b0[j]); v1[j] = sigmoidf_(v1[j] + b1[j]); }
                    *(u32x4*)(av + row * 256 + col) = pack8(v0, v1);
                } else { *(u32x4*)(gv + row * 256 + col) = pack8(v0, v1); } } EPI_FENCE; }
    }
};
struct Uq {
    static constexpr bool PERM = false;
    bf16_t* Q; const float* cosT; const float* sinT;
    __device__ __forceinline__ void operator()(EPI_SIG) const {
        EPI_ROWS { const size_t row = EPI_ROW;
            EPI_BJ { const int c32 = u.pn * 256 + bj * 128 + wc * 32; if (c32 >= 384) continue;
                f32x4 v0 = acc[ai][bj][m][0], v1 = acc[ai][bj][m][1];
                if ((c32 >> 5) % 3 == 2) {
                    const f32x4 cs = *(const f32x4*)(cosT + row * 16 + 4 * fq), sn = *(const f32x4*)(sinT + row * 16 + 4 * fq);
                    const f32x4 o0 = v0 * cs - v1 * sn, o1 = v0 * sn + v1 * cs; v0 = o0; v1 = o1; }
                u32x2 w0, w1; w0.x = cvt_pk_bf16(v0[0], v0[1]); w0.y = cvt_pk_bf16(v0[2], v0[3]); w1.x = cvt_pk_bf16(v1[0], v1[1]); w1.y = cvt_pk_bf16(v1[2], v1[3]);
                *(u32x2*)(Q + row * 384 + c32 + 4 * fq) = w0; *(u32x2*)(Q + row * 384 + c32 + 16 + 4 * fq) = w1; } EPI_FENCE; }
    }
};
struct Ukv {
    static constexpr bool PERM = true;
    bf16_t* Km; bf16_t* Vm;
    __device__ __forceinline__ void operator()(EPI_SIG) const {
        EPI_ROWS { const size_t row = EPI_ROW;
            EPI_BJ { const int col = u.pn * 256 + bj * 128 + wc * 32 + 8 * fq; const int h = col >> 7, j = col & 127;
                const u32x4 w = pack8(acc[ai][bj][m][0], acc[ai][bj][m][1]);
                if (j < 64) *(u32x4*)(Km + row * 384 + h * 96 + j) = w; else *(u32x4*)(Vm + row * 256 + h * 64 + (j - 64)) = w; } EPI_FENCE; }
    }
};
struct Resid {
    static constexpr bool PERM = false;
    const float* res; float* out; float ascale; const bf16_t* res16;
    __device__ __forceinline__ void operator()(EPI_SIG) const {
        const size_t off0 = (size_t)(u.pm * 256 + wr * 64 + fr) * 1024 + u.pn * 256 + wc * 32 + 4 * fq;
#define RS_OFF(i) (off0 + (size_t)((((i) >> 2) * 128 + ((i) & 3) * 16) * 1024))
        if (res16) {
            u32x2 rq[8][4];
#define RS_LOAD(i) { _Pragma("unroll") for (int q = 0; q < 4; ++q) rq[i][q] = *(const u32x2*)(res16 + RS_OFF(i) + (q >> 1) * 128 + (q & 1) * 16); }
            _Pragma("unroll") for (int i = 0; i < EPI_DEPTH; ++i) RS_LOAD(i)
            _Pragma("unroll") for (int i = 0; i < 8; ++i) { if (i + EPI_DEPTH < 8) RS_LOAD(i + EPI_DEPTH)
                _Pragma("unroll") for (int q = 0; q < 4; ++q) { const u32x2 w = rq[i][q]; const f32x4 r = (f32x4){bflo(w.x), bfhi(w.x), bflo(w.y), bfhi(w.y)};
                    *(f32x4*)(out + RS_OFF(i) + (q >> 1) * 128 + (q & 1) * 16) = r * DN_ALPHA + acc[i >> 2][q >> 1][i & 3][q & 1] * ascale; } EPI_FENCE; }
#undef RS_LOAD
        } else {
            f32x4 rq[8][4];
#define RS_LOAD(i) { _Pragma("unroll") for (int q = 0; q < 4; ++q) rq[i][q] = *(const f32x4*)(res + RS_OFF(i) + (q >> 1) * 128 + (q & 1) * 16); }
            _Pragma("unroll") for (int i = 0; i < EPI_DEPTH; ++i) RS_LOAD(i)
            _Pragma("unroll") for (int i = 0; i < 8; ++i) { if (i + EPI_DEPTH < 8) RS_LOAD(i + EPI_DEPTH)
                _Pragma("unroll") for (int q = 0; q < 4; ++q)
                    *(f32x4*)(out + RS_OFF(i) + (q >> 1) * 128 + (q & 1) * 16) = rq[i][q] * DN_ALPHA + acc[i >> 2][q >> 1][i & 3][q & 1] * ascale; EPI_FENCE; }
#undef RS_LOAD
        }
#undef RS_OFF
    }
};
struct Swiglu {
    static constexpr bool PERM = false;
    bf16_t* H; int ldh; int use_tag;
    __device__ __forceinline__ void operator()(EPI_SIG) const {
        const int pmo = use_tag ? u.tag : u.pm;
        EPI_ROWS { const size_t row = (size_t)(pmo * 256 + ai * 128 + wr * 64 + m * 16 + fr);
            EPI_BJ { const int hc = (u.pn * 256 + bj * 128 + wc * 32) / 2 + 4 * fq; const f32x4 g = acc[ai][bj][m][0], up = acc[ai][bj][m][1];
                u32x2 w; w.x = cvt_pk_bf16(siluf_(g[0]) * up[0], siluf_(g[1]) * up[1]); w.y = cvt_pk_bf16(siluf_(g[2]) * up[2], siluf_(g[3]) * up[3]);
                *(u32x2*)(H + row * ldh + hc) = w; } EPI_FENCE; }
    }
};
struct BrGate {
    static constexpr bool PERM = true;
    const bf16_t* G; float* mf; bf16_t* mb;
    __device__ __forceinline__ void operator()(EPI_SIG) const {
        const int br = u.tag;
        const size_t row0 = (size_t)(u.pm * 256 + wr * 64 + fr); const int col0 = u.pn * 256 + wc * 32 + 8 * fq;
        const bf16_t* gp = G + row0 * 4096 + br * 1024 + col0; bf16_t* pp = mb + row0 * 1024 + col0;
#define BR_ROW(i) (((i) >> 2) * 128 + ((i) & 3) * 16)
        u32x4 gq[8][2], pq[8][2];
#define BR_LOAD(i) { _Pragma("unroll") for (int bj = 0; bj < 2; ++bj) { gq[i][bj] = *(const u32x4*)(gp + (size_t)BR_ROW(i) * 4096 + bj * 128); \
            if (br > 0) pq[i][bj] = *(const u32x4*)(pp + (size_t)BR_ROW(i) * 1024 + bj * 128); else pq[i][bj] = (u32x4){0u, 0u, 0u, 0u}; } }
        _Pragma("unroll") for (int i = 0; i < EPI_DEPTH; ++i) BR_LOAD(i)
        _Pragma("unroll") for (int i = 0; i < 8; ++i) { if (i + EPI_DEPTH < 8) BR_LOAD(i + EPI_DEPTH)
            _Pragma("unroll") for (int bj = 0; bj < 2; ++bj) { const u32x4 gw = gq[i][bj], pw = pq[i][bj];
                f32x4 v0 = acc[i >> 2][bj][i & 3][0], v1 = acc[i >> 2][bj][i & 3][1];
                v0[0] = v0[0] * bflo(gw.x) + bflo(pw.x); v0[1] = v0[1] * bfhi(gw.x) + bfhi(pw.x); v0[2] = v0[2] * bflo(gw.y) + bflo(pw.y); v0[3] = v0[3] * bfhi(gw.y) + bfhi(pw.y);
                v1[0] = v1[0] * bflo(gw.z) + bflo(pw.z); v1[1] = v1[1] * bfhi(gw.z) + bfhi(pw.z); v1[2] = v1[2] * bflo(gw.w) + bflo(pw.w); v1[3] = v1[3] * bfhi(gw.w) + bfhi(pw.w);
                *(u32x4*)(pp + (size_t)BR_ROW(i) * 1024 + bj * 128) = pack8(v0, v1); } EPI_FENCE; }
#undef BR_LOAD
#undef BR_ROW
    }
};
struct BrGateH {
    static constexpr bool PERM = true;
    const bf16_t* G; bf16_t* mb; f32x4 racc[2][4][2];
    __device__ __forceinline__ void init() { _Pragma("unroll") for (int a = 0; a < 2; ++a) _Pragma("unroll") for (int m = 0; m < 4; ++m) _Pragma("unroll") for (int n = 0; n < 2; ++n) racc[a][m][n] = (f32x4){0.f, 0.f, 0.f, 0.f}; }
    __device__ __forceinline__ void operator()(f32x4 (&acc)[2][4][2], const Unit& u, int wr, int wc, int fr, int fq, int wid, int lane) {
        const int br = u.tag & 3; const unsigned col0 = (unsigned)((u.tag >> 2) * 128 + wc * 32 + 8 * fq), row0 = (unsigned)(u.pm * 256 + wr * 64 + fr);
        const char* gb = (const char*)G; const unsigned goff = (row0 * 4096u + (unsigned)br * 1024u + col0) * 2u;
        u32x4 gq[8];
        _Pragma("unroll") for (int i = 0; i < 8; ++i) gq[i] = *(const u32x4*)(gb + (size_t)(goff + (unsigned)(((i >> 2) * 128 + (i & 3) * 16) * 8192)));
        _Pragma("unroll") for (int i = 0; i < 8; ++i) { const u32x4 gw = gq[i]; const f32x4 v0 = acc[i >> 2][i & 3][0], v1 = acc[i >> 2][i & 3][1]; f32x4 r0 = racc[i >> 2][i & 3][0], r1 = racc[i >> 2][i & 3][1];
            r0[0] += v0[0] * bflo(gw.x); r0[1] += v0[1] * bfhi(gw.x); r0[2] += v0[2] * bflo(gw.y); r0[3] += v0[3] * bfhi(gw.y); r1[0] += v1[0] * bflo(gw.z); r1[1] += v1[1] * bfhi(gw.z); r1[2] += v1[2] * bflo(gw.w); r1[3] += v1[3] * bfhi(gw.w);
            racc[i >> 2][i & 3][0] = r0; racc[i >> 2][i & 3][1] = r1; }
        if (br == 3) { char* pb = (char*)mb; const unsigned poff = (row0 * 1024u + col0) * 2u;
            _Pragma("unroll") for (int i = 0; i < 8; ++i) { *(u32x4*)(pb + (size_t)(poff + (unsigned)(((i >> 2) * 128 + (i & 3) * 16) * 2048))) = pack8(racc[i >> 2][i & 3][0], racc[i >> 2][i & 3][1]);
                racc[i >> 2][i & 3][0] = (f32x4){0.f, 0.f, 0.f, 0.f}; racc[i >> 2][i & 3][1] = (f32x4){0.f, 0.f, 0.f, 0.f}; } }
    }
};
struct MoeDown {
    static constexpr bool PERM = true;
    const int* row_slot; const float* row_w; bf16_t* ys;
    __device__ __forceinline__ void operator()(EPI_SIG) const {
        int slot[8]; float w[8];
        _Pragma("unroll") for (int i = 0; i < 8; ++i) { const int r = u.tag * 256 + (i >> 2) * 128 + wr * 64 + (i & 3) * 16 + fr; slot[i] = __hip_atomic_load(row_slot + r, RLX_AGENT); w[i] = __hip_atomic_load(row_w + r, RLX_AGENT); }
        _Pragma("unroll") for (int i = 0; i < 8; ++i) {
            if (slot[i] >= 0) { EPI_BJ { const int col = u.pn * 256 + bj * 128 + wc * 32 + 8 * fq;
                *(u32x4*)(ys + (size_t)slot[i] * 1024 + col) = pack8(acc[i >> 2][bj][i & 3][0] * w[i], acc[i >> 2][bj][i & 3][1] * w[i]); } } EPI_FENCE; }
    }
};
struct Softmax {
    static constexpr bool PERM = true;
    bf16_t* P; LAS float* xch;
    __device__ __forceinline__ void operator()(EPI_SIG) const {
        EPI_ROWS { float v = -3.0e38f;
            EPI_BJ { const f32x4 a = acc[ai][bj][m][0], b = acc[ai][bj][m][1]; v = fmaxf(v, fmaxf(fmaxf(fmaxf(a[0], a[1]), fmaxf(a[2], a[3])), fmaxf(fmaxf(b[0], b[1]), fmaxf(b[2], b[3])))); }
            v = fmaxf(v, __shfl_xor(v, 16)); v = fmaxf(v, __shfl_xor(v, 32));
            if (fq == 0) xch[(ai * 128 + wr * 64 + m * 16 + fr) * 4 + wc] = v; }
        LDS_WAIT(); __builtin_amdgcn_s_barrier(); asm volatile("" ::: "memory");
        EPI_ROWS { const f32x4 q = *(const LAS f32x4*)(xch + (ai * 128 + wr * 64 + m * 16 + fr) * 4);
            const float mm = fmaxf(fmaxf(q[0], q[1]), fmaxf(q[2], q[3])); float s = 0.f;
            EPI_BJ { _Pragma("unroll") for (int n = 0; n < 2; ++n) { f32x4 t = acc[ai][bj][m][n]; for (int j = 0; j < 4; ++j) { t[j] = fexp2(t[j] - mm); s += t[j]; } acc[ai][bj][m][n] = t; } }
            s += __shfl_xor(s, 16); s += __shfl_xor(s, 32);
            if (fq == 0) xch[1024 + (ai * 128 + wr * 64 + m * 16 + fr) * 4 + wc] = s; }
        LDS_WAIT(); __builtin_amdgcn_s_barrier(); asm volatile("" ::: "memory");
        EPI_ROWS { const f32x4 q = *(const LAS f32x4*)(xch + 1024 + (ai * 128 + wr * 64 + m * 16 + fr) * 4);
            const float inv = frcp((q[0] + q[1]) + (q[2] + q[3]));
            bf16_t* rowp = P + (size_t)EPI_ROW * 1024 + u.tag * 256 + wc * 32 + 8 * fq;
            EPI_BJ { *(u32x4*)(rowp + bj * 128) = pack8(acc[ai][bj][m][0] * inv, acc[ai][bj][m][1] * inv); } EPI_FENCE; }
        LDS_WAIT(); __builtin_amdgcn_s_barrier(); asm volatile("" ::: "memory");
    }
};
}
struct Args { const float* in[42]; float* out; unsigned char* ws; int ph_lo, ph_hi; };
struct Ctx {
    const float* const* in; float* out; unsigned char* ws; LAS unsigned char* lds;
    int tid, lane, wave, G, bid;
};
enum { I_X = 0, I_MEM, I_POS, I_WIN, I_RWMU, I_RWW0, I_RWWUP, I_RWA0, I_RWAUP, I_RWGUP, I_RWKK, I_RWKA, I_RWRK, I_RWGNG, I_RWGNB,
       I_CONVW, I_CONVB, I_DTB, I_ALOG, I_SSDD, I_SSDNG, I_QNG, I_WUQ, I_KVNG, I_WUKV, I_WBR, I_WGATE, I_WOUT, I_LN1G, I_LN1B,
       I_XWQ, I_XWKV, I_XWO, I_LN2G, I_LN2B, I_FFN13, I_FFN2, I_ROUTER, I_MOE13, I_MOE2, I_LN3G, I_LN3B };
__device__ __forceinline__ Ctx launder(const Ctx& C0) {
    Ctx L = C0; unsigned zo_ = 0u; int t_ = threadIdx.x;
    asm volatile("" : "+s"(zo_), "+v"(t_));
    L.out = C0.out + zo_; L.ws = C0.ws + zo_; L.tid = t_; L.lane = t_ & 63; L.wave = __builtin_amdgcn_readfirstlane(t_ >> 6); return L;
}
#define WSP(T_, off) ((T_*)(C.ws + (off)))
#define GW (C.bid * NWAVES + C.wave)
#define NGW (C.G * NWAVES)

struct TJob { const float* W; int ldw, K, N; bf16_t* WT; int ldt; int map; float scale; int items; };
__device__ __forceinline__ int tj_items(int K, int N) { return (K / 64) * ((N + 31) / 32); }
__device__ __forceinline__ int tj_dest(int map, int n, int N) {
    if (map == 0) return n;
    if (map == 1) return n < 2816 ? n : (n < 2820 ? PC_DT + (n - 2816) : n - 4);
    const int half = N >> 1, j = n < half ? n : n - half;
    return (j >> 4) * 32 + (j & 15) + (n < half ? 0 : 16);
}
__device__ __forceinline__ void t_load(const TJob& J, int item, int lane, float (&v)[32], unsigned var = 0u) {
    const int nblk = (J.N + 31) / 32, kb = item / nblk, nb = item % nblk, k0 = 64 * kb, n0 = 32 * nb;
    const int nn = n0 + (lane & 31); const bool okn = nn < J.N; const float* src = J.W + (size_t)(k0 + (lane >> 5)) * J.ldw + nn;
#pragma unroll
    for (int i = 0; i < 32; ++i) v[i] = (okn && !(var & 8u)) ? src[(size_t)(2 * i) * J.ldw] : 0.f;
}
__device__ __forceinline__ void t_commit(const TJob& J, LAS float* scr, int item, int lane, const float (&v)[32], unsigned var = 0u) {
    const int nblk = (J.N + 31) / 32, kb = item / nblk, nb = item % nblk, k0 = 64 * kb, n0 = 32 * nb;
#pragma unroll
    for (int i = 0; i < 32; ++i) scr[(2 * i + (lane >> 5)) * 33 + (lane & 31)] = v[i];
    LDS_WAIT(); asm volatile("" ::: "memory");
    const int c = lane & 7;
#pragma unroll
    for (int j = 0; j < 4; ++j) { const int nl = (lane >> 3) + 8 * j, n = n0 + nl;
        if (n < J.N && !(var & 4u)) { const LAS float* s = scr + (8 * c) * 33 + nl; const float sc = (J.map == 1 && n >= 256) ? 1.0f : J.scale;
            u32x4 o; o.x = cvt_pk_bf16(s[0 * 33] * sc, s[1 * 33] * sc); o.y = cvt_pk_bf16(s[2 * 33] * sc, s[3 * 33] * sc); o.z = cvt_pk_bf16(s[4 * 33] * sc, s[5 * 33] * sc); o.w = cvt_pk_bf16(s[6 * 33] * sc, s[7 * 33] * sc);
            *(u32x4*)(J.WT + (size_t)tj_dest(J.map, n, J.N) * J.ldt + k0 + 8 * c) = o; } }
    LDS_WAIT(); asm volatile("" ::: "memory");
}
__device__ __forceinline__ TJob mkjob(const float* W, int ldw, int K, int N, bf16_t* WT, int ldt, int map, float scale) { TJob j; j.W = W; j.ldw = ldw; j.K = K; j.N = N; j.WT = WT; j.ldt = ldt; j.map = map; j.scale = scale; j.items = tj_items(K, N); return j; }

__device__ __forceinline__ TJob prologue_job(const Ctx& C, int j) {
    if (j < 26) { const int l = j / 13, r = j % 13; unsigned char* LW = C.ws + W_BASE + (size_t)l * LW_SIZE;
        if (r == 0) return mkjob(C.in[I_WIN] + (size_t)l * 1024 * 3236, 3236, 1024, 3236, (bf16_t*)(LW + LW_WIN), 1024, 1, 0.125f * LOG2E);
        if (r < 5) { const int i = r - 1; return mkjob(C.in[I_WGATE] + ((size_t)l * 4 + i) * 1024 * 1024, 1024, 1024, 1024, (bf16_t*)(LW + LW_WGATE) + (size_t)i * 1024 * 1024, 1024, 0, 1.f); }
        if (r < 9) { const int i = r - 5; return mkjob(C.in[I_WBR] + ((size_t)l * 4 + i) * 256 * 1024, 1024, 256, 1024, (bf16_t*)(LW + LW_WBR) + (size_t)i * 1024 * 256, 256, 0, 1.f); }
        if (r == 9) return mkjob(C.in[I_WOUT] + (size_t)l * 1024 * 1024, 1024, 1024, 1024, (bf16_t*)(LW + LW_WOUT), 1024, 0, 1.f);
        if (r == 10) return mkjob(C.in[I_XWQ], 1024, 0, 1024, (bf16_t*)(LW + LW_WQ), 1024, 0, 1.f);
        if (r == 11) return mkjob(C.in[I_XWKV] + (size_t)l * 1024 * 2048, 2048, 1024, 2048, (bf16_t*)(LW + LW_WKV), 1024, 0, 1.f);
        return mkjob(C.in[I_XWO] + (size_t)l * 1024 * 1024, 1024, 1024, 1024, (bf16_t*)(LW + LW_WO), 1024, 0, 1.f);
    }
    if (j == 26) return mkjob(C.in[I_FFN13], 2 * FFD, 1024, 2 * FFD, WSP(bf16_t, W_FFN13), 1024, 2, 1.f);
    return mkjob(C.in[I_FFN2], 1024, FFD, 1024, WSP(bf16_t, W_FFN2), FFD, 0, 1.f);
}
__device__ __forceinline__ TJob moe_job(const Ctx& C, int j) {
    if (j < 8) return mkjob(C.in[I_MOE13] + (size_t)j * 1024 * 2 * FFE, 2 * FFE, 1024, 2 * FFE, WSP(bf16_t, S_MW13) + (size_t)j * 2 * FFE * 1024, 1024, 2, 1.f);
    const int e = j - 8; return mkjob(C.in[I_MOE2] + (size_t)e * FFE * 1024, 1024, FFE, 1024, WSP(bf16_t, S_MW2) + (size_t)e * 1024 * FFE, FFE, 0, 1.f);
}
__device__ __forceinline__ void t_load4(const TJob& J, int item, int lane, f32x4 (&v)[8], unsigned var = 0u) {
    const int nblk = (J.N + 31) / 32, kb = item / nblk, nb = item % nblk, k0 = 64 * kb, n0 = 32 * nb;
    const int nn = n0 + 4 * (lane & 7); const bool okn = nn < J.N && !(var & 8u); const float* src = J.W + (size_t)(k0 + (lane >> 3)) * J.ldw + nn;
#pragma unroll
    for (int i = 0; i < 8; ++i) v[i] = okn ? *(const f32x4*)(src + (size_t)(8 * i) * J.ldw) : (f32x4){0.f, 0.f, 0.f, 0.f};
}
__device__ __forceinline__ void t_commit4(const TJob& J, LAS float* scr, int item, int lane, const f32x4 (&v)[8], unsigned var = 0u) {
    const int nblk = (J.N + 31) / 32, kb = item / nblk, nb = item % nblk, k0 = 64 * kb, n0 = 32 * nb;
    LAS float* wp = scr + (4 * (lane & 7)) * 65 + (lane >> 3);
#pragma unroll
    for (int i = 0; i < 8; ++i) { wp[0 * 65 + 8 * i] = v[i][0]; wp[1 * 65 + 8 * i] = v[i][1]; wp[2 * 65 + 8 * i] = v[i][2]; wp[3 * 65 + 8 * i] = v[i][3]; }
    LDS_WAIT(); asm volatile("" ::: "memory");
    const int c = lane & 7;
#pragma unroll
    for (int j = 0; j < 4; ++j) { const int nl = (lane >> 3) + 8 * j, n = n0 + nl;
        if (n < J.N && !(var & 4u)) { const LAS float* s = scr + nl * 65 + 8 * c; const float sc = (J.map == 1 && n >= 256) ? 1.0f : J.scale;
            u32x4 o; o.x = cvt_pk_bf16(s[0] * sc, s[1] * sc); o.y = cvt_pk_bf16(s[2] * sc, s[3] * sc); o.z = cvt_pk_bf16(s[4] * sc, s[5] * sc); o.w = cvt_pk_bf16(s[6] * sc, s[7] * sc);
            *(u32x4*)(J.WT + (size_t)tj_dest(J.map, n, J.N) * J.ldt + k0 + 8 * c) = o; } }
    LDS_WAIT(); asm volatile("" ::: "memory");
}
template <int NJ, bool MOE> __device__ __forceinline__ void run_tjobs(const Ctx& C, unsigned var = 0u) {
    LAS float* scr = (LAS float*)(C.lds + C.wave * 16384);
    int total = 0;
    for (int j = 0; j < NJ; ++j) { const TJob J = MOE ? moe_job(C, j) : prologue_job(C, j); total += J.items; }
    int j = 0, jbase = 0, it = GW; TJob J = MOE ? moe_job(C, 0) : prologue_job(C, 0);
    auto next = [&](TJob& Jo, int& io) -> bool { if (it >= total) return false;
        while (it >= jbase + J.items) { jbase += J.items; ++j; J = MOE ? moe_job(C, j) : prologue_job(C, j); }
        Jo = J; io = it - jbase; it += NGW; return true; };
    TJob Ja, Jb, Jc; int ia = 0, ib = 0, ic = 0; f32x4 va[8], vb[8], vc[8];
    bool ha = next(Ja, ia); if (!ha) return; t_load4(Ja, ia, C.lane, va, var);
    bool hb = next(Jb, ib); if (hb) t_load4(Jb, ib, C.lane, vb, var);
    for (;;) {
        bool hc = next(Jc, ic); if (hc) t_load4(Jc, ic, C.lane, vc, var);
        t_commit4(Ja, scr, ia, C.lane, va, var); if (!hb) break;
        ha = next(Ja, ia); if (ha) t_load4(Ja, ia, C.lane, va, var);
        t_commit4(Jb, scr, ib, C.lane, vb, var); if (!hc) break;
        hb = next(Jb, ib); if (hb) t_load4(Jb, ib, C.lane, vb, var);
        t_commit4(Jc, scr, ic, C.lane, vc, var); if (!ha) break;
    }
}


constexpr int CW_CHK = 32768;
template <class OutF> __device__ __forceinline__ void chk_gemm(const Ctx& C, const bf16_t* A, int lda, const bf16_t* Bt, int ldb, int K, int nrows, int ncs, int cstride, int c0, int bit, OutF expect_vs_got) {
    unsigned bad = 0; const int lane = C.lane;
    for (int it = GW; it < nrows * ncs; it += NGW) {
        const int r = it / ncs, c = c0 + (it % ncs) * cstride; float d = 0.f;
        for (int k = lane * 8; k < K; k += 512) { const u32x4 a = *(const u32x4*)(A + (size_t)r * lda + k), b = *(const u32x4*)(Bt + (size_t)c * ldb + k);
            d += bflo(a.x) * bflo(b.x) + bfhi(a.x) * bfhi(b.x) + bflo(a.y) * bflo(b.y) + bfhi(a.y) * bfhi(b.y) + bflo(a.z) * bflo(b.z) + bfhi(a.z) * bfhi(b.z) + bflo(a.w) * bflo(b.w) + bfhi(a.w) * bfhi(b.w); }
        d = wave_sum(d);
        if (!expect_vs_got(r, c, d)) bad = 1;
    }
    if (lane == 0 && bad) __hip_atomic_fetch_add((unsigned*)(C.ws + WS_CTL) + CW_CHK + 64 * bit, 1u, RLX_AGENT);
}
__device__ __forceinline__ bool chk_close(float e, float g) { return fabsf(e - g) <= 0.03f * fabsf(e) + 0.03f; }

__device__ __forceinline__ float chk_dot(const bf16_t* a, const bf16_t* b, int K, int lane) {
    float d = 0.f;
    for (int k = lane * 8; k < K; k += 512) { const u32x4 x = *(const u32x4*)(a + k), y = *(const u32x4*)(b + k);
        d += bflo(x.x) * bflo(y.x) + bfhi(x.x) * bfhi(y.x) + bflo(x.y) * bflo(y.y) + bfhi(x.y) * bfhi(y.y) + bflo(x.z) * bflo(y.z) + bfhi(x.z) * bfhi(y.z) + bflo(x.w) * bflo(y.w) + bfhi(x.w) * bfhi(y.w); }
    return wave_sum(d);
}
__device__ __forceinline__ void chk_flag(const Ctx& C, int bit, unsigned bad) { if (C.lane == 0 && bad) __hip_atomic_fetch_add((unsigned*)(C.ws + WS_CTL) + CW_CHK + 64 * bit, 1u, RLX_AGENT); }
__device__ __forceinline__ void chk_merged(const Ctx& C, int l, int bit) {
    const bf16_t* Y = WSP(bf16_t, S_Y); const bf16_t* G = WSP(bf16_t, S_G); const bf16_t* MB = WSP(bf16_t, S_MB); const bf16_t* WBR = (const bf16_t*)(C.ws + W_BASE + (size_t)l * LW_SIZE + LW_WBR); unsigned bad = 0;
    for (int it = GW; it < T * 4; it += NGW) { const int r = it >> 2, c = 13 + 256 * (it & 3); float e = 0.f;
        for (int i = 0; i < 4; ++i) e += bf2f(G[(size_t)r * 4096 + i * 1024 + c]) * chk_dot(Y + (size_t)r * 1024 + 256 * i, WBR + ((size_t)i * 1024 + c) * 256, 256, C.lane);
        if (!chk_close(e, bf2f(MB[(size_t)r * 1024 + c]))) bad = 1; }
    chk_flag(C, bit, bad);
}
__device__ __forceinline__ void chk_swiglu(const Ctx& C, int bit) {
    const bf16_t* XB = WSP(bf16_t, W_XB); const bf16_t* W = WSP(bf16_t, W_FFN13); const bf16_t* H = WSP(bf16_t, S_H); unsigned bad = 0;
    for (int it = GW; it < T * 22; it += NGW) { const int r = it / 22, hc = 5 + 128 * (it % 22); const int grow = (hc >> 4) * 32 + (hc & 15);
        const float g = chk_dot(XB + (size_t)r * 1024, W + (size_t)grow * 1024, 1024, C.lane), u = chk_dot(XB + (size_t)r * 1024, W + (size_t)(grow + 16) * 1024, 1024, C.lane);
        if (!chk_close(siluf_(g) * u, bf2f(H[(size_t)r * FFD + hc]))) bad = 1; }
    chk_flag(C, bit, bad);
}

constexpr size_t S_CHKBUF = S_BASE + (size_t)400 * MiB;
__device__ __forceinline__ void chk_resid_stash(const Ctx& C, const bf16_t* A, int lda, const bf16_t* Bt, int ldb, int K, int slot) {
    const float* XR = WSP(float, W_XRES); float* CB = WSP(float, S_CHKBUF);
    for (int it = GW; it < T * 4; it += NGW) { const int r = it >> 2, q = it & 3, c = 17 + 256 * q; const float d = chk_dot(A + (size_t)r * lda, Bt + (size_t)c * ldb, K, C.lane);
        if (C.lane == 0) CB[(size_t)r * 8 + slot * 4 + q] = XR[(size_t)r * 1024 + c] * DN_ALPHA + d; }
}
__device__ __forceinline__ void chk_resid_cmp(const Ctx& C, int slot, int bit) {
    const float* XR = WSP(float, W_XRES); const float* CB = WSP(float, S_CHKBUF); unsigned bad = 0;
    for (int it = GW; it < T * 4; it += NGW) { const int r = it >> 2, q = it & 3, c = 17 + 256 * q; if (!chk_close(CB[(size_t)r * 8 + slot * 4 + q], XR[(size_t)r * 1024 + c])) bad = 1; }
    chk_flag(C, bit, bad);
}
__device__ __forceinline__ void chk_ln_stash(const Ctx& C, const float* g, const float* b, int slot) {
    const float* XR = WSP(float, W_XRES); float* CB = WSP(float, S_CHKBUF); const int lane = C.lane;
    for (int t = GW; t < T; t += NGW) { float s = 0.f, s2 = 0.f; float v[16];
        for (int j = 0; j < 16; ++j) { v[j] = XR[(size_t)t * 1024 + lane + 64 * j]; s += v[j]; }
        const float mean = wave_sum(s) * (1.0f / 1024.0f); for (int j = 0; j < 16; ++j) { const float d = v[j] - mean; s2 += d * d; }
        const float rstd = 1.0f / sqrtf(wave_sum(s2) * (1.0f / 1024.0f) + 1e-5f);
        if (lane < 4) { const int c = 17 + 256 * lane; CB[(size_t)t * 8 + slot * 4 + lane] = (XR[(size_t)t * 1024 + c] - mean) * rstd * g[c] + b[c]; } }
}
__device__ __forceinline__ void chk_ln_cmp(const Ctx& C, int slot, int bit) {
    const float* XR = WSP(float, W_XRES); const bf16_t* XB = WSP(bf16_t, W_XB); const float* CB = WSP(float, S_CHKBUF); unsigned bad = 0;
    for (int it = GW; it < T * 4; it += NGW) { const int r = it >> 2, q = it & 3, c = 17 + 256 * q; const float e = CB[(size_t)r * 8 + slot * 4 + q];
        if (!chk_close(e, XR[(size_t)r * 1024 + c]) || !chk_close(e, bf2f(XB[(size_t)r * 1024 + c]))) bad = 1; }
    chk_flag(C, bit, bad);
}

template <int NJ, bool MOE> __device__ __forceinline__ void chk_weights(const Ctx& C, int bit) {
    unsigned bad = 0; const int gt = C.bid * NTHREADS + C.tid, NT = C.G * NTHREADS;
    for (int j = 0; j < NJ; ++j) { const TJob J = MOE ? moe_job(C, j) : prologue_job(C, j);
        for (size_t i = gt; i < (size_t)J.K * J.N; i += NT) { const int k = (int)(i / J.N), n = (int)(i % J.N);
            const float sc = (J.map == 1 && n >= 256) ? 1.0f : J.scale; const bf16_t e = (bf16_t)(cvt_pk_bf16(J.W[(size_t)k * J.ldw + n] * sc, 0.f) & 0xffffu);
            if (J.WT[(size_t)tj_dest(J.map, n, J.N) * J.ldt + k] != e) bad = 1; } }
    if (bad) __hip_atomic_fetch_add((unsigned*)(C.ws + WS_CTL) + CW_CHK + 64 * bit, 1u, RLX_AGENT);
}

__device__ __forceinline__ void chk_mla_inputs(const Ctx& C, int l, int bit) {
    const bf16_t* proj = WSP(bf16_t, S_PROJ); const bf16_t* QM = WSP(bf16_t, S_QM); const bf16_t* KM = WSP(bf16_t, S_KM); const bf16_t* VM = WSP(bf16_t, S_VM);
    const float* wuq = C.in[I_WUQ] + (size_t)l * 256 * 384; const float* wukv = C.in[I_WUKV] + (size_t)l * 128 * 512; const float* qg = C.in[I_QNG] + l * 256; const float* kvg = C.in[I_KVNG] + l * 128;
    const int* pos = (const int*)C.in[I_POS]; const int lane = C.lane; unsigned bad = 0; const float qs = 0.10206207261596575f * LOG2E;
    for (int t = GW; t < T; t += NGW) {
        const bf16_t* pr = proj + (size_t)t * NPROJ; float cq[4], ck[2]; float ss = 0.f;
        for (int i = 0; i < 4; ++i) { cq[i] = bf2f(pr[PC_CQ + lane + 64 * i]); ss += cq[i] * cq[i]; }
        float rs = 1.0f / sqrtf(wave_sum(ss) * (1.0f / 256.0f) + 1e-6f); for (int i = 0; i < 4; ++i) cq[i] *= rs * qg[lane + 64 * i];
        ss = 0.f; for (int i = 0; i < 2; ++i) { ck[i] = bf2f(pr[PC_CKV + lane + 64 * i]); ss += ck[i] * ck[i]; }
        rs = 1.0f / sqrtf(wave_sum(ss) * (1.0f / 128.0f) + 1e-6f); for (int i = 0; i < 2; ++i) ck[i] *= rs * kvg[lane + 64 * i];
        const float ang = (float)pos[t] * exp2f(-6.0f * (13.287712379549449f / 32.0f)); const float c3 = cosf(ang), s3 = sinf(ang);
        const int h = t & 3;
        float qn = 0.f, q1 = 0.f, q2 = 0.f, kn = 0.f, vv = 0.f;
        for (int i = 0; i < 4; ++i) { const int k = lane + 64 * i; qn += cq[i] * wuq[(size_t)k * 384 + h * 96 + 5]; q1 += cq[i] * wuq[(size_t)k * 384 + h * 96 + 67]; q2 += cq[i] * wuq[(size_t)k * 384 + h * 96 + 83]; }
        for (int i = 0; i < 2; ++i) { const int k = lane + 64 * i; kn += ck[i] * wukv[(size_t)k * 512 + h * 128 + 7]; vv += ck[i] * wukv[(size_t)k * 512 + h * 128 + 64 + 9]; }
        qn = wave_sum(qn) * qs; q1 = wave_sum(q1) * qs; q2 = wave_sum(q2) * qs; kn = wave_sum(kn); vv = wave_sum(vv);
        const float kr1 = bf2f(pr[PC_KR + 3]), kr2 = bf2f(pr[PC_KR + 19]);
        const bf16_t* qrow = QM + (size_t)t * 384 + h * 96; const bf16_t* krow = KM + (size_t)t * 384 + h * 96;
        if (!chk_close(qn, bf2f(qrow[5])) || !chk_close(q1 * c3 - q2 * s3, bf2f(qrow[67])) || !chk_close(q1 * s3 + q2 * c3, bf2f(qrow[83])) || !chk_close(kn, bf2f(krow[7])) ||
            !chk_close(kr1 * c3 - kr2 * s3, bf2f(krow[67])) || !chk_close(kr1 * s3 + kr2 * c3, bf2f(krow[83])) || !chk_close(vv, bf2f(VM[(size_t)t * 256 + h * 64 + 9]))) bad = 1;
    }
    chk_flag(C, bit, bad);
}

__device__ __forceinline__ void chk_rw_inputs(const Ctx& C, int l, int bit) {
    const bf16_t* proj = WSP(bf16_t, S_PROJ); const float* DEC = WSP(float, S_DEC); const bf16_t* RWS = WSP(bf16_t, S_RWS); const bf16_t* GV = WSP(bf16_t, S_GV); const size_t PL = (size_t)T * 256;
    const float* mu = C.in[I_RWMU] + l * 1024; const float* w0 = C.in[I_RWW0] + l * 256; const float* a0 = C.in[I_RWA0] + l * 256;
    const float* wup = C.in[I_RWWUP] + l * 64 * 256; const float* aup = C.in[I_RWAUP] + l * 64 * 256; const float* gup = C.in[I_RWGUP] + l * 128 * 256;
    const float* kkw = C.in[I_RWKK] + l * 256; const float* kaw = C.in[I_RWKA] + l * 256; const int lane = C.lane; unsigned bad = 0;
    for (int t = GW; t < T; t += NGW) {
        const bf16_t* pr = proj + (size_t)t * NPROJ + PC_RW; const bool first = (t % SEQ) == 0; const int h = t & 3, c = h * 64 + 11;
        auto sh = [&](int col) { const float cur = bf2f(pr[col]); const float prv = first ? 0.f : bf2f(pr[col - NPROJ]); return cur + (prv - cur) * mu[col]; };
        float dw = tanhf(sh(768 + lane)) * wup[lane * 256 + c], da = sh(832 + lane) * aup[lane * 256 + c];
        float dg = (1.0f / (1.0f + expf(-sh(896 + lane)))) * gup[lane * 256 + c] + (1.0f / (1.0f + expf(-sh(960 + lane)))) * gup[(64 + lane) * 256 + c];
        dw = wave_sum(dw); da = wave_sum(da); dg = wave_sum(dg);
        const float xw = w0[c] + dw; const float wlog = -(fmaxf(-xw, 0.f) + log1pf(expf(-fabsf(xw)))) - 0.5f; const float dec = expf(-expf(wlog));
        const float a = 1.0f / (1.0f + expf(-(a0[c] + da)));
        const float kl = sh(256 + h * 64 + lane) * kkw[h * 64 + lane]; const float nrm = 1.0f / sqrtf(fmaxf(wave_sum(kl * kl), 1e-24f));
        const float r = sh(c), k = sh(256 + c), v = sh(512 + c); const float kk = k * kkw[c] * nrm, kmod = k * (1.0f + (a - 1.0f) * kaw[c]), ka = kk * a;
        const size_t o = (size_t)t * 256 + c;
        if (!chk_close(dec, DEC[o]) || fabsf(dec - DEC[o]) > 0.004f || !chk_close(r, bf2f(RWS[o])) || !chk_close(kmod, bf2f(RWS[PL + o])) || !chk_close(v, bf2f(RWS[2 * PL + o])) || !chk_close(kk, bf2f(RWS[3 * PL + o])) ||
            !chk_close(ka, bf2f(RWS[4 * PL + o])) || !chk_close(dg, bf2f(GV[o]))) bad = 1;
    }
    chk_flag(C, bit, bad);
}
__device__ __forceinline__ void chk_ssd_norm(const Ctx& C, int l, int bit) {
    const bf16_t* Y = WSP(bf16_t, S_Y); const float* ng = C.in[I_SSDNG] + l * 256; const int lane = C.lane; unsigned bad = 0;
    for (int t = GW; t < T; t += NGW) { float q = 0.f;
        for (int i = 0; i < 4; ++i) { const int c = (lane >> 5) * 128 + (lane & 31) * 4 + i; const float y = bf2f(Y[(size_t)t * 1024 + 512 + c]) / ng[c]; q += y * y; }
        for (int o_ = 1; o_ < 32; o_ <<= 1) q += __shfl_xor(q, o_);
        q *= (1.0f / 128.0f); if (q < 0.9f || q > 1.1f) bad = 1; }
    chk_flag(C, bit, bad);
}

#ifndef P7_COND
#define P7_COND 1
#endif
#ifndef P7_CLASS
#define P7_CLASS (((c & 31) < 16 ? 1u : 2u) | ((c & 255) < 128 ? 4u : 8u))
#endif
__device__ __forceinline__ float tdot(const bf16_t* a, const bf16_t* b, int K) { float d = 0.f;
    for (int k = 0; k < K; k += 8) { const u32x4 x = *(const u32x4*)(a + k), y = *(const u32x4*)(b + k);
        d += bflo(x.x) * bflo(y.x) + bfhi(x.x) * bfhi(y.x) + bflo(x.y) * bflo(y.y) + bfhi(x.y) * bfhi(y.y) + bflo(x.z) * bflo(y.z) + bfhi(x.z) * bfhi(y.z) + bflo(x.w) * bflo(y.w) + bfhi(x.w) * bfhi(y.w); }
    return d; }
__device__ __forceinline__ void chk_full_p7(const Ctx& C, int l, int bit) {
    const bf16_t* MB = WSP(bf16_t, S_MB); const bf16_t* W = (const bf16_t*)(C.ws + W_BASE + (size_t)l * LW_SIZE + LW_WOUT); const float* xin = C.in[I_X]; const float* XR = WSP(float, W_XRES); float num = 0.f, den = 0.f;
    for (size_t i = (size_t)C.bid * NTHREADS + C.tid; i < (size_t)T * 1024; i += (size_t)C.G * NTHREADS) { const size_t r = i >> 10; const int c = (int)(i & 1023);
        const float d = tdot(MB + r * 1024, W + (size_t)c * 1024, 1024), g = XR[i] - xin[i] * DN_ALPHA; num += (d - g) * (d - g); den += d * d; }
    num = wave_sum(num); den = wave_sum(den);
    if (C.lane == 0) { atomicAdd((float*)(C.ws + WS_CTL) + CW_CHK + 1024, num); atomicAdd((float*)(C.ws + WS_CTL) + CW_CHK + 1088, den); }
}
__device__ __forceinline__ void chk_full_merged(const Ctx& C, int l, int bit) {
    const bf16_t* Y = WSP(bf16_t, S_Y); const bf16_t* G = WSP(bf16_t, S_G); const bf16_t* MB = WSP(bf16_t, S_MB); const bf16_t* WBR = (const bf16_t*)(C.ws + W_BASE + (size_t)l * LW_SIZE + LW_WBR); unsigned bad = 0;
    for (size_t i = (size_t)C.bid * NTHREADS + C.tid; i < (size_t)T * 1024; i += (size_t)C.G * NTHREADS) { const size_t r = i >> 10; const int c = (int)(i & 1023); float e = 0.f;
        for (int q = 0; q < 4; ++q) e += bf2f(G[r * 4096 + q * 1024 + c]) * tdot(Y + r * 1024 + 256 * q, WBR + ((size_t)q * 1024 + c) * 256, 256);
        if (!chk_close(e, bf2f(MB[i]))) bad = 1; }
    if (bad) __hip_atomic_fetch_add((unsigned*)(C.ws + WS_CTL) + CW_CHK + 64 * bit, 1u, RLX_AGENT);
}

#ifndef FG_CLASS
#define FG_CLASS (1u << ((c >> 5) & 3))
#endif
template <class F> __device__ __forceinline__ void chk_full_gemm(const Ctx& C, const bf16_t* A, const bf16_t* Bt, int K, int N, int bit, F ok) {
    unsigned bad = 0, cntbad = 0;
    for (size_t i = (size_t)C.bid * NTHREADS + C.tid; i < (size_t)T * N; i += (size_t)C.G * NTHREADS) { const size_t r = i / N; const int c = (int)(i % N);
        if (!ok(r, c, tdot(A + r * K, Bt + (size_t)c * K, K))) { bad |= (bit < 0) ? (FG_CLASS) : (1u << bit); ++cntbad; } }
#ifdef FG_COUNT
    if (cntbad) __hip_atomic_fetch_add((unsigned*)(C.ws + WS_CTL) + CW_CHK + 2048, cntbad, RLX_AGENT);
#else
    for (int q = 0; q < 4; ++q) if ((bad >> q) & 1) __hip_atomic_fetch_add((unsigned*)(C.ws + WS_CTL) + CW_CHK + 64 * q, 1u, RLX_AGENT);
#endif
}
__device__ __forceinline__ void ph_prologue(const Ctx& C) {
    run_tjobs<28, false>(C);
    const int gt = C.bid * NTHREADS + C.tid, NT = C.G * NTHREADS;
    for (int l = 0; l < 2; ++l) {
        unsigned char* LW = C.ws + W_BASE + (size_t)l * LW_SIZE;
        bf16_t* lora = (bf16_t*)(LW + LW_LORA); const float* wup = C.in[I_RWWUP] + l * 64 * 256; const float* aup = C.in[I_RWAUP] + l * 64 * 256; const float* gup = C.in[I_RWGUP] + l * 128 * 256;
        for (int i = gt; i < 768 * 256; i += NT) { const int n = i >> 8, k = i & 255; float v = 0.f;
            if (n < 256) { if (k < 64) v = wup[k * 256 + n]; } else if (n < 512) { if (k >= 64 && k < 128) v = aup[(k - 64) * 256 + (n - 256)]; } else { if (k >= 128) v = gup[(k - 128) * 256 + (n - 512)]; }
            lora[i] = (bf16_t)(cvt_pk_bf16(v, 0.f) & 0xffffu); }
        bf16_t* wuq = (bf16_t*)(LW + LW_WUQ); const float* suq = C.in[I_WUQ] + l * 256 * 384;
        for (int i = gt; i < 512 * 256; i += NT) { const int n = i >> 8, k = i & 255; const float v = n < 384 ? suq[k * 384 + n] * (0.10206207261596575f * LOG2E) : 0.f; wuq[i] = (bf16_t)(cvt_pk_bf16(v, 0.f) & 0xffffu); }
        bf16_t* wukv = (bf16_t*)(LW + LW_WUKV); const float* sukv = C.in[I_WUKV] + l * 128 * 512;
        for (int i = gt; i < 512 * 128; i += NT) { const int n = i >> 7, k = i & 127; wukv[i] = (bf16_t)(cvt_pk_bf16(sukv[k * 512 + n], 0.f) & 0xffffu); }
        { const float* wq = C.in[I_XWQ] + (size_t)l * 1024 * 1024; bf16_t* wqp = (bf16_t*)(LW + LW_WQ);
          for (size_t i = gt; i < (size_t)1024 * 1024 / 8; i += NT) { const f32x4 a = *(const f32x4*)(wq + i * 8) * (0.0625f * LOG2E), b = *(const f32x4*)(wq + i * 8 + 4) * (0.0625f * LOG2E); *(u32x4*)(wqp + i * 8) = epi::pack8(a, b); } }
        bf16_t* win = (bf16_t*)(LW + LW_WIN);
        for (int i = gt; i < (NPROJ - 3236) * 1024; i += NT) win[(size_t)3236 * 1024 + i] = 0;
    }
    { const float* x = C.in[I_X]; bf16_t* xb = WSP(bf16_t, W_XB);
#pragma unroll 4
      for (size_t i = gt; i < (size_t)T * 1024 / 8; i += NT) { const f32x4 a = *(const f32x4*)(x + i * 8), b = *(const f32x4*)(x + i * 8 + 4); *(u32x4*)(xb + i * 8) = epi::pack8(a, b); }
      const float* mm = C.in[I_MEM]; bf16_t* mb = WSP(bf16_t, W_MEMB);
      for (size_t i = gt; i < (size_t)NMEM * 1024 / 8; i += NT) { const f32x4 a = *(const f32x4*)(mm + i * 8), b = *(const f32x4*)(mm + i * 8 + 4); *(u32x4*)(mb + i * 8) = epi::pack8(a, b); } }
    { const int* pos = (const int*)C.in[I_POS]; float* ct = WSP(float, W_COS); float* st = WSP(float, W_SIN);
      for (int i = gt; i < T * 16; i += NT) { const int t = i >> 4, j = i & 15; const float inv = exp2f(-(float)(2 * j) * (13.287712379549449f / 32.0f)); const float ang = (float)pos[t] * inv; ct[i] = cosf(ang); st[i] = sinf(ang); } }
}

__device__ __forceinline__ f32x4 ld_bf4(const bf16_t* p) { const u32x2 w = *(const u32x2*)p; return (f32x4){bflo(w.x), bfhi(w.x), bflo(w.y), bfhi(w.y)}; }
__device__ __forceinline__ void st_bf4(bf16_t* p, const f32x4 v) { u32x2 w; w.x = cvt_pk_bf16(v[0], v[1]); w.y = cvt_pk_bf16(v[2], v[3]); *(u32x2*)p = w; }
__device__ __forceinline__ float tanhf_(float x) { return 1.0f - 2.0f * frcp(1.0f + fexp2(2.0f * LOG2E * x)); }
__device__ __forceinline__ void ph_prep(const Ctx& C, int l) {
    const bf16_t* __restrict__ proj = WSP(bf16_t, S_PROJ); const float* mu = C.in[I_RWMU] + l * 1024;
    bf16_t* __restrict__ LA = WSP(bf16_t, S_LA); bf16_t* __restrict__ CQN = WSP(bf16_t, S_CQN); bf16_t* __restrict__ CKVN = WSP(bf16_t, S_CKVN); bf16_t* __restrict__ KM = WSP(bf16_t, S_KM);
    const float* qg = C.in[I_QNG] + l * 256; const float* kvg = C.in[I_KVNG] + l * 128; const float* ct = WSP(float, W_COS); const float* st = WSP(float, W_SIN);
    const int lane = C.lane, c4 = 4 * lane, c2 = 2 * lane, i16 = lane & 15;
    const f32x4 m = *(const f32x4*)(mu + 768 + c4), qgv = *(const f32x4*)(qg + c4); const float kg0 = kvg[c2], kg1 = kvg[c2 + 1];
    u32x2 n_cur, n_prv, n_cq; unsigned n_ckv; unsigned short n_kr; float n_cs, n_sn;
#define PREP_LOAD(tt) do { const bf16_t* pr_ = proj + (size_t)(tt) * NPROJ; n_cur = *(const u32x2*)(pr_ + PC_RW + 768 + c4); \
        n_prv = ((tt) % SEQ) == 0 ? (u32x2){0u, 0u} : *(const u32x2*)(pr_ - NPROJ + PC_RW + 768 + c4); n_cq = *(const u32x2*)(pr_ + PC_CQ + c4); n_ckv = *(const unsigned*)(pr_ + PC_CKV + c2); \
        n_kr = pr_[PC_KR + (lane & 31)]; n_cs = ct[(size_t)(tt) * 16 + i16]; n_sn = st[(size_t)(tt) * 16 + i16]; } while (0)
    int t = GW; if (t < T) PREP_LOAD(t);
    for (; t < T; t += NGW) {
        const u32x2 wc = n_cur, wp = n_prv, wq = n_cq; const unsigned wk = n_ckv; const float krv = bf2f(n_kr), cs = n_cs, sn = n_sn;
        if (t + NGW < T) PREP_LOAD(t + NGW);
        { const f32x4 cur = (f32x4){bflo(wc.x), bfhi(wc.x), bflo(wc.y), bfhi(wc.y)}, prv = (f32x4){bflo(wp.x), bfhi(wp.x), bflo(wp.y), bfhi(wp.y)}; f32x4 p = cur + (prv - cur) * m;
          if (c4 < 64) { for (int j = 0; j < 4; ++j) p[j] = tanhf_(p[j]); } else if (c4 >= 128) { for (int j = 0; j < 4; ++j) p[j] = sigmoidf_(p[j]); }
          st_bf4(LA + (size_t)t * 256 + c4, p); }
        { f32x4 v = (f32x4){bflo(wq.x), bfhi(wq.x), bflo(wq.y), bfhi(wq.y)}; const float ss = wave_sum((v[0] * v[0] + v[1] * v[1]) + (v[2] * v[2] + v[3] * v[3]));
          const float rs = 1.0f / sqrtf(ss * (1.0f / 256.0f) + 1e-6f); v = v * rs * qgv; st_bf4(CQN + (size_t)t * 256 + c4, v); }
        { float a = bflo(wk), b = bfhi(wk); const float ss = wave_sum(a * a + b * b);
          const float rs = 1.0f / sqrtf(ss * (1.0f / 128.0f) + 1e-6f); a *= rs * kg0; b *= rs * kg1; *(unsigned*)(CKVN + (size_t)t * 128 + c2) = cvt_pk_bf16(a, b); }
        { const float o = __shfl_xor(krv, 16);
          const float r = (lane & 16) ? (o * sn + krv * cs) : (krv * cs - o * sn);
          if (lane < 32) { const bf16_t rb = (bf16_t)(cvt_pk_bf16(r, 0.f) & 0xffffu); for (int h = 0; h < 4; ++h) KM[(size_t)t * 384 + h * 96 + 64 + lane] = rb; } }
    }
#undef PREP_LOAD
}
__device__ __forceinline__ void ph_rwprep(const Ctx& C, int l) {
#if defined(NAIVE_SCAN)
    if (NAIVE_SCAN & 2) { float* q_ = WSP(float, S_SSQ); for (int i = C.bid * NTHREADS + C.tid; i < T * 8; i += C.G * NTHREADS) q_[i] = 0.f; }
#endif
    const bf16_t* __restrict__ proj = WSP(bf16_t, S_PROJ); const float* mu = C.in[I_RWMU] + l * 1024; const bf16_t* __restrict__ AV = WSP(bf16_t, S_AV); bf16_t* __restrict__ RWS = WSP(bf16_t, S_RWS);
    const float* kkw = C.in[I_RWKK] + l * 256; const float* kaw = C.in[I_RWKA] + l * 256; const int lane = C.lane, c = 4 * lane;
    f32x4 muv[3];
#pragma unroll
    for (int q = 0; q < 3; ++q) muv[q] = *(const f32x4*)(mu + q * 256 + c);
    const f32x4 kkv = *(const f32x4*)(kkw + c), kav = *(const f32x4*)(kaw + c);
    u32x2 ncur[3], nprv[3], nav;
#define RWP_LOAD(tt) do { const bf16_t* pr_ = proj + (size_t)(tt) * NPROJ + PC_RW; const bool f_ = ((tt) % SEQ) == 0; \
        _Pragma("unroll") for (int q = 0; q < 3; ++q) { ncur[q] = *(const u32x2*)(pr_ + q * 256 + c); nprv[q] = f_ ? (u32x2){0u, 0u} : *(const u32x2*)(pr_ - NPROJ + q * 256 + c); } \
        nav = *(const u32x2*)(AV + (size_t)(tt) * 256 + c); } while (0)
#define U2F4(w) ((f32x4){bflo((w).x), bfhi((w).x), bflo((w).y), bfhi((w).y)})
    int t = GW; if (t < T) RWP_LOAD(t);
    for (; t < T; t += NGW) {
        f32x4 rkv[3];
#pragma unroll
        for (int q = 0; q < 3; ++q) { const f32x4 cur = U2F4(ncur[q]), prv = U2F4(nprv[q]); rkv[q] = cur + (prv - cur) * muv[q]; }
        const f32x4 a = U2F4(nav);
        if (t + NGW < T) RWP_LOAD(t + NGW);
        f32x4 kk = rkv[1] * kkv;
        float ss = (kk[0] * kk[0] + kk[1] * kk[1]) + (kk[2] * kk[2] + kk[3] * kk[3]);
        ss = row_sum16(ss);
        kk = kk * (1.0f / sqrtf(fmaxf(ss, 1e-24f)));
        const f32x4 kmod = rkv[1] * ((a - 1.0f) * kav + 1.0f), ka = kk * a;
        const size_t o = (size_t)t * 256 + c, PL = (size_t)T * 256;
        st_bf4(RWS + o, rkv[0]); st_bf4(RWS + PL + o, kmod); st_bf4(RWS + 2 * PL + o, rkv[2]); st_bf4(RWS + 3 * PL + o, kk); st_bf4(RWS + 4 * PL + o, ka);
    }
#undef RWP_LOAD
}
__device__ __forceinline__ void ph_ssdprep(const Ctx& C, int l) {
    const bf16_t* __restrict__ proj = WSP(bf16_t, S_PROJ); bf16_t* __restrict__ XA = WSP(bf16_t, S_XA); bf16_t* __restrict__ BC = WSP(bf16_t, S_BC); bf16_t* __restrict__ CC = WSP(bf16_t, S_CC); float* __restrict__ ACS = WSP(float, S_ACS); float* __restrict__ DTV = WSP(float, S_DTV);
    const float* cw = C.in[I_CONVW] + l * 4 * 768; const float* cb = C.in[I_CONVB] + l * 768; const float* dtbp = C.in[I_DTB] + l * 4; const float* alog = C.in[I_ALOG] + l * 4; const int lane = C.lane;
    for (int item = GW; item < 64; item += NGW) { const int b = item >> 2, h = item & 3; const float dtb = dtbp[h], a2 = -expf(alog[h]) * LOG2E; const size_t t0 = (size_t)b * SEQ + 32 * lane;
        unsigned short rawv[32];
#pragma unroll
        for (int i = 0; i < 32; ++i) rawv[i] = proj[(t0 + i) * NPROJ + PC_DT + h];
        float pre[32]; float run = 0.f;
#pragma unroll
        for (int i = 0; i < 32; ++i) { run += softplusf_(bf2f(rawv[i]) + dtb) * a2; pre[i] = run; }
        float sc_ = run;
#pragma unroll
        for (int d = 1; d < 64; d <<= 1) { const float o = __shfl_up(sc_, d); if (lane >= d) sc_ += o; }
        const float base = sc_ - run;
#pragma unroll
        for (int i = 0; i < 32; ++i) ACS[(t0 + i) * 4 + h] = base + pre[i]; }
    f32x4 cbv[3], cwv[3][4];
#pragma unroll
    for (int j = 0; j < 3; ++j) { const int c = 4 * lane + 256 * j; cbv[j] = *(const f32x4*)(cb + c);
#pragma unroll
        for (int k = 0; k < 4; ++k) cwv[j][k] = *(const f32x4*)(cw + k * 768 + c); }
    const float dtbl = dtbp[lane & 3];
    u32x2 nraw[3][4]; unsigned short ndt;
#define SSP_LOAD(tt) do { const int tl_ = (tt) % SEQ; _Pragma("unroll") for (int j = 0; j < 3; ++j) _Pragma("unroll") for (int k = 0; k < 4; ++k) \
        nraw[j][k] = (tl_ - 3 + k >= 0) ? *(const u32x2*)(proj + (size_t)((tt) - 3 + k) * NPROJ + PC_XS + 4 * lane + 256 * j) : (u32x2){0u, 0u}; \
        ndt = proj[(size_t)(tt) * NPROJ + PC_DT + (lane & 3)]; } while (0)
    int t = GW; if (t < T) SSP_LOAD(t);
    for (; t < T; t += NGW) {
        f32x4 acc3[3]; const float dtraw = bf2f(ndt);
#pragma unroll
        for (int j = 0; j < 3; ++j) { f32x4 a = cbv[j];
#pragma unroll
            for (int k = 0; k < 4; ++k) a += U2F4(nraw[j][k]) * cwv[j][k];
            acc3[j] = a; }
        if (t + NGW < T) SSP_LOAD(t + NGW);
#pragma unroll
        for (int j = 0; j < 3; ++j) { f32x4 a = acc3[j]; for (int q = 0; q < 4; ++q) a[q] = siluf_(a[q]);
            st_bf4((j == 0 ? XA : (j == 1 ? BC : CC)) + (size_t)t * 256 + 4 * lane, a); }
        if (lane < 4) DTV[(size_t)t * 4 + lane] = softplusf_(dtraw + dtbl);
    }
#undef SSP_LOAD
#undef U2F4
}
#ifndef ABL_MOE
#define ABL_MOE 1.0f
#endif
template <bool MOE> __device__ __forceinline__ void ph_ln(const Ctx& C, const float* src, float* dst, bf16_t* dstb, const float* g, const float* b, const bf16_t* ys) {
    const int lane = C.lane;
    float chkscale = 1.0f;
#if defined(CHECKS) || defined(CHECKS2) || defined(CHECKS3) || defined(CHECKS4) || defined(CHECKS5) || defined(CHECKS6) || defined(CHECKS7) || defined(CHECKS8) || defined(CHECKS9) || defined(CHECKS10) || defined(CHECKS12) || defined(CHECKS13) || defined(CHECKS14) || defined(CHECKS15)
    if (MOE) { const unsigned* cw = (const unsigned*)(C.ws + WS_CTL) + CW_CHK; int n = 0;
        for (int q = 0; q < 4; ++q) if (__hip_atomic_load(cw + 64 * q, RLX_AGENT) != 0u) n |= 1 << q;
#if defined(FG_COUNT) || defined(CHECKS13) || defined(CHECKS15)
        { unsigned v_ = __hip_atomic_load(cw + 2048, RLX_AGENT); n = 0; while (v_ > 0u) { ++n; v_ >>= 1; } }
#endif
#ifdef CHECKS10
        { const float num = __uint_as_float(__hip_atomic_load(cw + 1024, RLX_AGENT)), den = __uint_as_float(__hip_atomic_load(cw + 1088, RLX_AGENT)); const float lr = -log2f(fmaxf(num / fmaxf(den, 1e-30f), 1e-12f)); n = (int)(lr + 0.5f); n = n < 0 ? 0 : (n > 31 ? 31 : n); }
#endif
        chkscale = 1.0f + 0.1f * (float)n; }
#endif
    f32x4 gv[4], bv[4];
#pragma unroll
    for (int j = 0; j < 4; ++j) { gv[j] = *(const f32x4*)(g + 4 * lane + 256 * j); bv[j] = *(const f32x4*)(b + 4 * lane + 256 * j); }
    f32x4 nv[4]; u32x2 ny0[4], ny1[4];
#define LN_LOAD(tt) do { _Pragma("unroll") for (int j = 0; j < 4; ++j) { nv[j] = *(const f32x4*)(src + (size_t)(tt) * 1024 + 4 * lane + 256 * j); \
        if (MOE) { ny0[j] = *(const u32x2*)(ys + (size_t)(2 * (tt)) * 1024 + 4 * lane + 256 * j); ny1[j] = *(const u32x2*)(ys + (size_t)(2 * (tt) + 1) * 1024 + 4 * lane + 256 * j); } } } while (0)
    int t = GW; if (t < T) LN_LOAD(t);
    for (; t < T; t += NGW) {
        f32x4 v[4]; float s = 0.f;
#pragma unroll
        for (int j = 0; j < 4; ++j) { v[j] = nv[j];
            if (MOE) { const f32x4 y0 = (f32x4){bflo(ny0[j].x), bfhi(ny0[j].x), bflo(ny0[j].y), bfhi(ny0[j].y)}, y1 = (f32x4){bflo(ny1[j].x), bfhi(ny1[j].x), bflo(ny1[j].y), bfhi(ny1[j].y)}; v[j] = v[j] * DN_ALPHA + (y0 + y1) * ABL_MOE; } }
        if (t + NGW < T) LN_LOAD(t + NGW);
#pragma unroll
        for (int j = 0; j < 4; ++j) s += (v[j][0] + v[j][1]) + (v[j][2] + v[j][3]);
        const float mean = wave_sum(s) * (1.0f / 1024.0f); float s2 = 0.f;
#pragma unroll
        for (int j = 0; j < 4; ++j) { v[j] = v[j] - mean; s2 += (v[j][0] * v[j][0] + v[j][1] * v[j][1]) + (v[j][2] * v[j][2] + v[j][3] * v[j][3]); }
        const float rstd = 1.0f / sqrtf(wave_sum(s2) * (1.0f / 1024.0f) + 1e-5f);
#pragma unroll
        for (int j = 0; j < 4; ++j) { const int c = 4 * lane + 256 * j; const f32x4 o = (v[j] * rstd * gv[j] + bv[j]) * chkscale;
            if (dst) *(f32x4*)(dst + (size_t)t * 1024 + c) = o; if (dstb) st_bf4(dstb + (size_t)t * 1024 + c, o); }
    }
#undef LN_LOAD
}
__device__ __forceinline__ void ph_ssdfix(const Ctx& C, int l) {
    bf16_t* Y = WSP(bf16_t, S_Y); const float* ssq = WSP(float, S_SSQ); const float* ng = C.in[I_SSDNG] + l * 256; const int lane = C.lane, c = 4 * lane, g = lane >> 5;
    const bf16_t* YRAW = WSP(bf16_t, S_YRAW); const bf16_t* RWS = WSP(bf16_t, S_RWS); const bf16_t* GV = WSP(bf16_t, S_GV); const size_t PL = (size_t)T * 256;
    const f32x4 rk = *(const f32x4*)(C.in[I_RWRK] + l * 256 + c), gng = *(const f32x4*)(C.in[I_RWGNG] + l * 256 + c), gnb = *(const f32x4*)(C.in[I_RWGNB] + l * 256 + c);
    const f32x4 ngv = *(const f32x4*)(ng + c);
    f32x4 nq; u32x2 nys, nyr, nr, nkm, nvv, ngg;
#define U2F4(w) ((f32x4){bflo((w).x), bfhi((w).x), bflo((w).y), bfhi((w).y)})
#define FIX_LOAD(tt) do { nq = *(const f32x4*)(ssq + (size_t)(tt) * 8 + 4 * g); nys = *(const u32x2*)(Y + (size_t)(tt) * 1024 + 512 + c); const size_t o_ = (size_t)(tt) * 256 + c; \
        nyr = *(const u32x2*)(YRAW + o_); nr = *(const u32x2*)(RWS + o_); nkm = *(const u32x2*)(RWS + PL + o_); nvv = *(const u32x2*)(RWS + 2 * PL + o_); ngg = *(const u32x2*)(GV + o_); } while (0)
    int t = GW; if (t < T) FIX_LOAD(t);
    for (; t < T; t += NGW) {
        const f32x4 q4 = nq; f32x4 v = U2F4(nys); const f32x4 yv = U2F4(nyr), rr = U2F4(nr), km = U2F4(nkm), vv = U2F4(nvv), gg = U2F4(ngg);
        if (t + NGW < T) FIX_LOAD(t + NGW);
        const float q = (q4[0] + q4[1]) + (q4[2] + q4[3]); const float rs = 1.0f / sqrtf(q * (1.0f / 128.0f) + 1e-5f);
        v = v * rs * ngv; st_bf4(Y + (size_t)t * 1024 + 512 + c, v);
        float sm = (yv[0] + yv[1]) + (yv[2] + yv[3]), bd = (rr[0] * km[0] * rk[0] + rr[1] * km[1] * rk[1]) + (rr[2] * km[2] * rk[2] + rr[3] * km[3] * rk[3]);
        sm = row_sum16(sm); bd = row_sum16(bd);
        const float mu = sm * (1.0f / 64.0f); const f32x4 d = yv - mu; float vs = (d[0] * d[0] + d[1] * d[1]) + (d[2] * d[2] + d[3] * d[3]);
        vs = row_sum16(vs);
        const float rstd = 1.0f / sqrtf(vs * (1.0f / 64.0f) + 64e-5f);
        st_bf4(Y + (size_t)t * 1024 + 256 + c, ((d * rstd) * gng + gnb + vv * bd) * gg);
    }
#undef FIX_LOAD
#undef U2F4
}
typedef __bf16 bfx8 __attribute__((ext_vector_type(8)));
__device__ __forceinline__ f32x16 mfma32(const bf16x8 a, const bf16x8 b, const f32x16 c) { return __builtin_amdgcn_mfma_f32_32x32x16_bf16(__builtin_bit_cast(bfx8, a), __builtin_bit_cast(bfx8, b), c, 0, 0, 0); }
__device__ __forceinline__ float dpp_xor1(float v) { return __builtin_bit_cast(float, __builtin_amdgcn_mov_dpp(__builtin_bit_cast(int, v), 0xB1, 0xf, 0xf, true)); }
__device__ __forceinline__ float dpp_xor2(float v) { return __builtin_bit_cast(float, __builtin_amdgcn_mov_dpp(__builtin_bit_cast(int, v), 0x4E, 0xf, 0xf, true)); }
__device__ __forceinline__ float dpp_hmir(float v) { return __builtin_bit_cast(float, __builtin_amdgcn_mov_dpp(__builtin_bit_cast(int, v), 0x141, 0xf, 0xf, true)); }
__device__ __forceinline__ float sum8(float v) { v += dpp_xor1(v); v += dpp_xor2(v); v += dpp_hmir(v); return v; }

__device__ __forceinline__ float xor32(float v, int hh) { const auto sw = __builtin_amdgcn_permlane32_swap(__builtin_bit_cast(unsigned, v), __builtin_bit_cast(unsigned, v), false, false); return __builtin_bit_cast(float, (unsigned)(hh ? sw[0] : sw[1])); }
typedef short s16x4 __attribute__((ext_vector_type(4)));
typedef short s16x8 __attribute__((ext_vector_type(8)));
template <int MODE>
__device__ __forceinline__ void attn_unit(const Ctx& C0_, int l, int b, int h, int qb, unsigned vf = 0u) {
    const Ctx C = launder(C0_);
    constexpr int DQK = MODE == 2 ? 128 : (MODE == 1 ? 96 : 64), NS = DQK / 16, KST = DQK * 2 + 16, VST = 192, KCH = DQK / 8;
    const bf16_t *Qp, *Kp, *Vp; int qs, ks, vs, ycol;
    if (MODE == 0) { const bf16_t* proj = WSP(bf16_t, S_PROJ); Qp = proj + PC_SBQ + h * 64; Kp = proj + PC_SBK + h * 64; Vp = proj + PC_SBV + h * 64; qs = ks = vs = NPROJ; ycol = h * 64; }
    else if (MODE == 1) { Qp = WSP(bf16_t, S_QM) + h * 96; Kp = WSP(bf16_t, S_KM) + h * 96; Vp = WSP(bf16_t, S_VM) + h * 64; qs = ks = 384; vs = 256; ycol = 768 + h * 64; }
    else { Qp = WSP(bf16_t, S_CC) + (h >> 1) * 128; Kp = WSP(bf16_t, S_BC) + (h >> 1) * 128; Vp = WSP(bf16_t, S_XA) + h * 64; qs = ks = vs = 256; ycol = 512 + h * 64; }
    const float* ACS = WSP(float, S_ACS); const float* DTV = WSP(float, S_DTV);
    const size_t tb = (size_t)b * SEQ;
    constexpr int ABUF = 64 * KST + 64 * VST + 512;
    LAS unsigned char* const abase = C.lds;
    const int tid = C.tid, lane = C.lane, w = C.wave, r = lane & 31, hh = lane >> 5;
    const int Q0 = qb * 256, qidx = Q0 + 32 * w + r, qmin = Q0 + 32 * w, qmax = qmin + 31;
    bf16x8 qf[NS];
#pragma unroll
    for (int s = 0; s < NS; ++s) qf[s] = *(const bf16x8*)(Qp + (tb + qidx) * qs + 16 * s + 8 * hh);
    f32x16 o[2]; for (int i = 0; i < 16; ++i) { o[0][i] = 0.f; o[1][i] = 0.f; }
    float Rrun = 0.f, mrun = -1.0e30f, lsum = 0.f;
    const int pr = (r & ~12) | ((r & 4) << 1) | ((r & 8) >> 1);
    u32x4 kreg0, kreg1, vreg; const int krow0 = tid / KCH, kch0 = tid % KCH, krow1 = (tid + 512) / KCH, kch1 = (tid + 512) % KCH, vrow = tid >> 3, vch = tid & 7;
    const bool k1 = (MODE == 2) || ((MODE == 1) && (tid < 64 * KCH - 512));
    float areg = 0.f, dreg = 0.f; float aq = 0.f; if (MODE == 2) aq = ACS[(tb + qidx) * 4 + h];
    const int ktmax = 4 * qb + 3;
#define ATT_LOAD(kt) do { const size_t kb_ = tb + (size_t)(kt) * 64; kreg0 = *(const u32x4*)(Kp + (kb_ + krow0) * ks + kch0 * 8); if (k1) kreg1 = *(const u32x4*)(Kp + (kb_ + krow1) * ks + kch1 * 8); \
        vreg = *(const u32x4*)(Vp + (kb_ + vrow) * vs + vch * 8); if (MODE == 2 && tid < 64) { areg = ACS[(kb_ + tid) * 4 + h]; dreg = DTV[(kb_ + tid) * 4 + h]; } } while (0)
#define ATT_STORE(bi) do { LAS unsigned char* Kt_ = abase + (bi) * ABUF; LAS unsigned char* Vt_ = Kt_ + 64 * KST; \
        *(LAS u32x4*)(Kt_ + krow0 * KST + kch0 * 16) = kreg0; if (k1) *(LAS u32x4*)(Kt_ + krow1 * KST + kch1 * 16) = kreg1; \
        *(LAS u32x4*)(Vt_ + vrow * VST + vch * 16) = vreg; if (MODE == 2 && tid < 64) { ((LAS float*)(Vt_ + 64 * VST))[tid] = areg; ((LAS float*)(Vt_ + 64 * VST))[64 + tid] = dreg; } } while (0)
    __syncthreads();
    ATT_LOAD(ktmax); ATT_STORE(0); if (ktmax > 0) ATT_LOAD(ktmax - 1);
    __syncthreads();
    for (int kt = ktmax; kt >= 0; --kt) {
        const int bi = (ktmax - kt) & 1;
        LAS unsigned char* Kt = abase + bi * ABUF; LAS unsigned char* Vt = Kt + 64 * KST; LAS float* AkL = (LAS float*)(Vt + 64 * VST); LAS float* DkL = AkL + 64;
        if (kt > 0 && !(vf & 128u)) { ATT_STORE(bi ^ 1); if (kt > 1) ATT_LOAD(kt - 2); }
        const int k0 = kt * 64;
        if (k0 <= qmax) {
        const bool need_mask = (k0 + 63 >= qmin);
        f32x16 sc[2];
#pragma unroll
        for (int sub = 0; sub < 2; ++sub) {
            for (int i = 0; i < 16; ++i) sc[sub][i] = 0.f;
            if (!(vf & 16u)) { _Pragma("unroll") for (int s = 0; s < NS; ++s) { const bf16x8 kf = *(const LAS bf16x8*)(Kt + (32 * sub + pr) * KST + (16 * s + 8 * hh) * 2); sc[sub] = mfma32(kf, qf[s], sc[sub]); } }
        }
        s16x4 vfr[2][2][4];
        { const LAS unsigned char* vb_ = Vt + (8 * hh + ((lane & 15) >> 2)) * VST + (16 * ((lane >> 4) & 1) + 4 * (lane & 3)) * 2;
#pragma unroll
          for (int sub = 0; sub < 2; ++sub)
#pragma unroll
            for (int s = 0; s < 2; ++s) { const LAS unsigned char* a_ = vb_ + (32 * sub + 16 * s) * VST;
                vfr[sub][s][0] = __builtin_amdgcn_ds_read_tr16_b64_v4i16((LAS s16x4*)a_); vfr[sub][s][1] = __builtin_amdgcn_ds_read_tr16_b64_v4i16((LAS s16x4*)(a_ + 768));
                vfr[sub][s][2] = __builtin_amdgcn_ds_read_tr16_b64_v4i16((LAS s16x4*)(a_ + 64)); vfr[sub][s][3] = __builtin_amdgcn_ds_read_tr16_b64_v4i16((LAS s16x4*)(a_ + 832)); } }
        if (vf & 32u) { } else
        if (MODE == 0) {
#pragma unroll
            for (int sub = 1; sub >= 0; --sub) {
                const int kb = k0 + 32 * sub + 8 * hh;
                float L[16];
#pragma unroll
                for (int i = 0; i < 16; ++i) { const float z = sc[sub][i]; const float l2 = -(fmaxf(z, 0.f) + flog2(1.0f + fexp2(-fabsf(z)))); L[i] = l2; sc[sub][i] = z + l2; }
                if (need_mask) {
#pragma unroll
                    for (int i = 0; i < 16; ++i) { const int key = kb + (i & 7) + 16 * (i >> 3); const bool ok = key < qidx; L[i] = ok ? L[i] : 0.f; sc[sub][i] = ok ? sc[sub][i] : -1.0e30f; } }
                float own_hi = 0.f, own_lo = 0.f, tl[16];
#pragma unroll
                for (int j = 7; j >= 0; --j) { tl[8 + j] = own_hi; own_hi += L[8 + j]; tl[j] = own_lo; own_lo += L[j]; }
                const float p_hi = xor32(own_hi, hh), p_lo = xor32(own_lo, hh);
                const float off_hi = Rrun + (hh ? 0.f : p_hi), off_lo = Rrun + own_hi + p_hi + (hh ? 0.f : p_lo);
                Rrun += (own_hi + own_lo) + (p_hi + p_lo);
#pragma unroll
                for (int i = 0; i < 16; ++i) sc[sub][i] = fexp2(sc[sub][i] + tl[i] + (i >= 8 ? off_hi : off_lo));
            }
        } else if (MODE == 2) {
#pragma unroll
            for (int sub = 0; sub < 2; ++sub) { f32x4 ak[4], dk[4];
#pragma unroll
                for (int r4 = 0; r4 < 4; ++r4) { const int o_ = 32 * sub + 8 * hh + 16 * (r4 >> 1) + 4 * (r4 & 1); ak[r4] = *(const LAS f32x4*)(AkL + o_); dk[r4] = *(const LAS f32x4*)(DkL + o_); }
#pragma unroll
                for (int i = 0; i < 16; ++i) { const float a_ = ak[(i >> 3) * 2 + ((i & 7) >> 2)][i & 3], d_ = dk[(i >> 3) * 2 + ((i & 7) >> 2)][i & 3];
                    sc[sub][i] = sc[sub][i] * d_ * fexp2(fminf(aq - a_, 0.f)); }
                if (need_mask) {
#pragma unroll
                    for (int i = 0; i < 16; ++i) { const int key = k0 + 32 * sub + 8 * hh + (i & 7) + 16 * (i >> 3); sc[sub][i] = key <= qidx ? sc[sub][i] : 0.f; } } }
        } else {
            if (need_mask) {
#pragma unroll
                for (int sub = 0; sub < 2; ++sub)
#pragma unroll
                    for (int i = 0; i < 16; ++i) { const int key = k0 + 32 * sub + 8 * hh + (i & 7) + 16 * (i >> 3); sc[sub][i] = key <= qidx ? sc[sub][i] : -1.0e30f; } }
            float tm = -1.0e30f;
#pragma unroll
            for (int sub = 0; sub < 2; ++sub)
#pragma unroll
                for (int i = 0; i < 16; ++i) tm = fmaxf(tm, sc[sub][i]);
            tm = fmaxf(tm, xor32(tm, hh));
            if (!__all(tm <= mrun)) {
                const float mnew = fmaxf(mrun, tm), alpha = fexp2(mrun - mnew); mrun = mnew; lsum *= alpha;
#pragma unroll
                for (int i = 0; i < 16; ++i) { o[0][i] *= alpha; o[1][i] *= alpha; } }
            float ps = 0.f;
#pragma unroll
            for (int sub = 0; sub < 2; ++sub)
#pragma unroll
                for (int i = 0; i < 16; ++i) { const float p = fexp2(sc[sub][i] - mrun); sc[sub][i] = p; ps += p; }
            lsum += ps;
        }
        if (!(vf & 64u))
#pragma unroll
        for (int sub = 0; sub < 2; ++sub)
#pragma unroll
            for (int s = 0; s < 2; ++s) {
                bf16x8 pf; { u32x4 pw; pw.x = cvt_pk_bf16(sc[sub][8 * s + 0], sc[sub][8 * s + 1]); pw.y = cvt_pk_bf16(sc[sub][8 * s + 2], sc[sub][8 * s + 3]); pw.z = cvt_pk_bf16(sc[sub][8 * s + 4], sc[sub][8 * s + 5]); pw.w = cvt_pk_bf16(sc[sub][8 * s + 6], sc[sub][8 * s + 7]); pf = __builtin_bit_cast(bf16x8, pw); }
                const s16x8 va0 = __builtin_shufflevector(vfr[sub][s][0], vfr[sub][s][1], 0, 1, 2, 3, 4, 5, 6, 7), va1 = __builtin_shufflevector(vfr[sub][s][2], vfr[sub][s][3], 0, 1, 2, 3, 4, 5, 6, 7);
                o[0] = mfma32(__builtin_bit_cast(bf16x8, va0), pf, o[0]);
                o[1] = mfma32(__builtin_bit_cast(bf16x8, va1), pf, o[1]);
            }
        }
        bool dead = false;
        if (MODE == 0) dead = Rrun < -64.0f;
        if (MODE == 2) dead = aq - AkL[0] < -64.0f;
        if (MODE == 1) { __syncthreads(); }
        else { volatile LAS unsigned* votes = (volatile LAS unsigned*)(C.lds + LDSCTL_OFF + 128) + 8 * bi;
            const bool wdead = __all(dead ? 1 : 0); if (lane == 0) votes[w] = wdead ? 1u : 0u;
            __syncthreads();
            unsigned all_ = 1u;
#pragma unroll
            for (int q_ = 0; q_ < 8; ++q_) all_ &= votes[q_];
            if (all_) break; }
    }
#undef ATT_LOAD
#undef ATT_STORE
    float inv = 1.0f;
    if (MODE == 1) { const float lt = lsum + xor32(lsum, hh); inv = frcp(lt); }
    bf16_t* Y = WSP(bf16_t, S_Y) + (tb + qidx) * 1024 + ycol;
    if (MODE == 2) {
        const float dsk = C.in[I_SSDD][l * 4 + h]; const bf16_t* xa = Vp + (tb + qidx) * 256; const bf16_t* zp = WSP(bf16_t, S_PROJ) + (tb + qidx) * NPROJ + PC_Z + h * 64; float q_ = 0.f;
#pragma unroll
        for (int dt = 0; dt < 2; ++dt)
#pragma unroll
            for (int g = 0; g < 4; ++g) { const int d0 = 32 * dt + 8 * g + 4 * hh; const f32x4 xv = ld_bf4(xa + d0), zv = ld_bf4(zp + d0); f32x4 y;
                for (int j = 0; j < 4; ++j) { y[j] = (o[dt][4 * g + j] + dsk * xv[j]) * siluf_(zv[j]); q_ += y[j] * y[j]; }
                st_bf4(Y + d0, y); }
        q_ += __shfl_xor(q_, 32);
        if (hh == 0) { float* SSQ = WSP(float, S_SSQ); SSQ[(tb + qidx) * 8 + h * 2] = q_; SSQ[(tb + qidx) * 8 + h * 2 + 1] = 0.f; }
        return;
    }
#pragma unroll
    for (int dt = 0; dt < 2; ++dt)
#pragma unroll
        for (int g = 0; g < 4; ++g) { u32x2 wv; wv.x = cvt_pk_bf16(o[dt][4 * g] * inv, o[dt][4 * g + 1] * inv); wv.y = cvt_pk_bf16(o[dt][4 * g + 2] * inv, o[dt][4 * g + 3] * inv);
            *(u32x2*)(Y + 32 * dt + 8 * g + 4 * hh) = wv; }
}

__device__ __forceinline__ float sum16(float v) { v = sum8(v); v += __builtin_bit_cast(float, __builtin_amdgcn_mov_dpp(__builtin_bit_cast(int, v), 0x140, 0xf, 0xf, true)); return v; }
__device__ __forceinline__ void rwkv_unit(const Ctx& C0_, int l, int b, int h, int half) {
    const Ctx C = launder(C0_);
    constexpr int TB = 32, NBLK = SEQ / TB, BUFB = 6 * TB * 64 * 4;
    LAS float* buf0 = (LAS float*)C.lds; LAS float* ybuf = (LAS float*)(C.lds + 2 * BUFB);
    const int tid = C.tid, il = tid >> 4, q = tid & 15, i = 32 * half + il;
    const float* DEC = WSP(float, S_DEC); const bf16_t* RWS = WSP(bf16_t, S_RWS); bf16_t* YRAW = WSP(bf16_t, S_YRAW);
    const size_t PL = (size_t)T * 256; const size_t tb = (size_t)b * SEQ;
    const int ls = tid >> 4, lj = 4 * (tid & 15);
    f32x4 gw; u32x2 gr[5];
#define RW_LOAD(blk) do { const size_t o_ = (tb + (size_t)(blk) * TB + ls) * 256 + h * 64 + lj; gw = *(const f32x4*)(DEC + o_); \
        gr[0] = *(const u32x2*)(RWS + 3 * PL + o_); gr[1] = *(const u32x2*)(RWS + 4 * PL + o_); gr[2] = *(const u32x2*)(RWS + PL + o_); gr[3] = *(const u32x2*)(RWS + o_); gr[4] = *(const u32x2*)(RWS + 2 * PL + o_); } while (0)
#define RW_STORE(bufp) do { LAS float* d_ = (bufp) + ls * 64 + lj; *(LAS f32x4*)d_ = gw; \
        _Pragma("unroll") for (int a_ = 0; a_ < 5; ++a_) *(LAS f32x4*)(d_ + (a_ + 1) * TB * 64) = (f32x4){bflo(gr[a_].x), bfhi(gr[a_].x), bflo(gr[a_].y), bfhi(gr[a_].y)}; } while (0)
    f32x4 S = (f32x4){0.f, 0.f, 0.f, 0.f};
    __syncthreads();
    RW_LOAD(0); RW_STORE(buf0);
    __syncthreads();
    for (int blk = 0; blk < NBLK; ++blk) {
        LAS float* cur = buf0 + (blk & 1) * (BUFB / 4); LAS float* nxtb = buf0 + ((blk + 1) & 1) * (BUFB / 4);
        if (blk + 1 < NBLK) RW_LOAD(blk + 1);
        f32x4 wA[2], kkA[2], kaA[2], kmA[2], rA[2], wB[2], kkB[2], kaB[2], kmB[2], rB[2]; float vA[2], vB[2];
#define RW_RD(W_, KK_, KA_, KM_, R_, V_, sb_) do { _Pragma("unroll") for (int u = 0; u < 2; ++u) { const LAS float* p = cur + ((sb_) + u) * 64 + 4 * q; \
            W_[u] = *(const LAS f32x4*)p; KK_[u] = *(const LAS f32x4*)(p + TB * 64); KA_[u] = *(const LAS f32x4*)(p + 2 * TB * 64); KM_[u] = *(const LAS f32x4*)(p + 3 * TB * 64); R_[u] = *(const LAS f32x4*)(p + 4 * TB * 64); \
            V_[u] = cur[5 * TB * 64 + ((sb_) + u) * 64 + i]; } } while (0)
#define RW_STEP(W_, KK_, KA_, KM_, R_, V_, sb_) do { float yv_[2]; _Pragma("unroll") for (int u = 0; u < 2; ++u) { \
            float sa = (S[0] * KK_[u][0] + S[1] * KK_[u][1]) + (S[2] * KK_[u][2] + S[3] * KK_[u][3]); sa = sum16(sa); \
            S = S * W_[u] + (KM_[u] * V_[u] - KA_[u] * sa); \
            const float y = (S[0] * R_[u][0] + S[1] * R_[u][1]) + (S[2] * R_[u][2] + S[3] * R_[u][3]); yv_[u] = sum16(y); } \
            if (q == 0) { ybuf[(sb_) * 32 + il] = yv_[0]; ybuf[((sb_) + 1) * 32 + il] = yv_[1]; } } while (0)
        RW_RD(wA, kkA, kaA, kmA, rA, vA, 0);
        for (int s0 = 0; s0 < TB; s0 += 4) {
            RW_RD(wB, kkB, kaB, kmB, rB, vB, s0 + 2);
            RW_STEP(wA, kkA, kaA, kmA, rA, vA, s0);
            if (s0 + 4 < TB) RW_RD(wA, kkA, kaA, kmA, rA, vA, s0 + 4);
            RW_STEP(wB, kkB, kaB, kmB, rB, vB, s0 + 2);
        }
#undef RW_RD
#undef RW_STEP
        __syncthreads();
        {
            const int os = tid >> 4, r2 = 2 * (tid & 15); const size_t t = tb + (size_t)blk * TB + os;
            *(unsigned*)(YRAW + t * 256 + h * 64 + 32 * half + r2) = cvt_pk_bf16(ybuf[os * 32 + r2], ybuf[os * 32 + r2 + 1]);
        }
        if (blk + 1 < NBLK) RW_STORE(nxtb);
        __syncthreads();
    }
#undef RW_LOAD
#undef RW_STORE
}

__device__ __forceinline__ void ssd_stage(const Ctx& C, int l, int h, size_t tb, int blk, LAS float* dst) {
    constexpr int TB = 16; const int g = h >> 1;
    const bf16_t* proj = WSP(bf16_t, S_PROJ); const float* cw = C.in[I_CONVW] + l * 4 * 768; const float* cb = C.in[I_CONVB] + l * 768;
    const float dtb = C.in[I_DTB][l * 4 + h], aneg = -expf(C.in[I_ALOG][l * 4 + h]);
    for (int it = C.tid; it < TB * 80; it += NTHREADS) {
        const int s = it / 80, v = it % 80; const int tl = blk * TB + s;
        int pcol, cch, doff;
        if (v < 16) { pcol = PC_XS + h * 64 + 4 * v; cch = h * 64 + 4 * v; doff = s * 64 + 4 * v; }
        else if (v < 48) { pcol = PC_BM + g * 128 + 4 * (v - 16); cch = 256 + g * 128 + 4 * (v - 16); doff = 2 * TB * 64 + s * 128 + 4 * (v - 16); }
        else { pcol = PC_CM + g * 128 + 4 * (v - 48); cch = 512 + g * 128 + 4 * (v - 48); doff = 2 * TB * 64 + TB * 128 + s * 128 + 4 * (v - 48); }
        f32x4 a = *(const f32x4*)(cb + cch);
#pragma unroll
        for (int k = 0; k < 4; ++k) { const int tt = tl - 3 + k; if (tt >= 0) a += ld_bf4(proj + (tb + tt) * NPROJ + pcol) * *(const f32x4*)(cw + k * 768 + cch); }
        for (int j = 0; j < 4; ++j) a[j] = siluf_(a[j]);
        if (v < 16) { const float dt = softplusf_(bf2f(proj[(tb + tl) * NPROJ + PC_DT + h]) + dtb); *(LAS f32x4*)(dst + TB * 64 + doff) = a; *(LAS f32x4*)(dst + doff) = a * dt;
                      if (v == 0) dst[TB * 384 + s] = expf(dt * aneg); }
        else *(LAS f32x4*)(dst + doff) = a;
    }
}
__device__ __forceinline__ void ssd_unit(const Ctx& C0_, int l, int b, int h, int ph) {
    const Ctx C = launder(C0_);
    constexpr int TB = 32, NBLK = SEQ / TB, NF = TB * (32 + 32 + 128 + 128) + 64, NIT = 72 * TB, NK = (NIT + NTHREADS - 1) / NTHREADS;
    LAS float* buf0 = (LAS float*)C.lds; LAS float* ypart = buf0 + 2 * NF;
    const int tid = C.tid, lane = C.lane, w = C.wave, g = h >> 1, pl = lane & 31, nh = lane >> 5;
    const bf16_t* proj = WSP(bf16_t, S_PROJ); bf16_t* Y = WSP(bf16_t, S_Y); float* SSQ = WSP(float, S_SSQ);
    const float* cw = C.in[I_CONVW] + l * 4 * 768; const float* cb = C.in[I_CONVB] + l * 768;
    const float dtb = C.in[I_DTB][l * 4 + h], aneg = -expf(C.in[I_ALOG][l * 4 + h]), dsk = C.in[I_SSDD][l * 4 + h];
    const size_t tb = (size_t)b * SEQ;
    int its[NK], itp[NK], itd[NK], itc[NK]; bool itx[NK];
#pragma unroll
    for (int k = 0; k < NK; ++k) { const int it = tid + NTHREADS * k, sidx = it / 72, v = it % 72; int pcol, cch, doff;
        if (v < 8) { pcol = PC_XS + h * 64 + 32 * ph + 4 * v; cch = h * 64 + 32 * ph + 4 * v; doff = sidx * 32 + 4 * v; }
        else if (v < 40) { pcol = PC_BM + g * 128 + 4 * (v - 8); cch = 256 + g * 128 + 4 * (v - 8); doff = 2 * TB * 32 + sidx * 128 + 4 * (v - 8); }
        else { pcol = PC_CM + g * 128 + 4 * (v - 40); cch = 512 + g * 128 + 4 * (v - 40); doff = 2 * TB * 32 + TB * 128 + sidx * 128 + 4 * (v - 40); }
        its[k] = sidx; itp[k] = pcol; itd[k] = doff; itx[k] = v < 8; itc[k] = cch; }
    const bool haslast = tid + NTHREADS * (NK - 1) < NIT;
    u32x2 raw[NK][4]; float dtr[NK]; unsigned short zraw;
    const int os = tid >> 4, op = tid & 15;
#define SSD_LOAD(blk) do { _Pragma("unroll") for (int k = 0; k < NK; ++k) { if (k < NK - 1 || haslast) { const int tl_ = (blk) * TB + its[k]; \
            _Pragma("unroll") for (int q = 0; q < 4; ++q) { const int tt_ = tl_ - 3 + q; raw[k][q] = tt_ >= 0 ? *(const u32x2*)(proj + (tb + tt_) * NPROJ + itp[k]) : (u32x2){0u, 0u}; } \
            dtr[k] = itx[k] ? bf2f(proj[(tb + tl_) * NPROJ + PC_DT + h]) : 0.f; } } } while (0)
#define SSD_COMMIT(dst) do { _Pragma("unroll") for (int k = 0; k < NK; ++k) { if (k < NK - 1 || haslast) { f32x4 a_ = *(const f32x4*)(cb + itc[k]); \
            _Pragma("unroll") for (int q = 0; q < 4; ++q) a_ += (f32x4){bflo(raw[k][q].x), bfhi(raw[k][q].x), bflo(raw[k][q].y), bfhi(raw[k][q].y)} * *(const f32x4*)(cw + q * 768 + itc[k]); \
            for (int j = 0; j < 4; ++j) a_[j] = siluf_(a_[j]); \
            if (itx[k]) { const float dt_ = softplusf_(dtr[k] + dtb); *(LAS f32x4*)((dst) + TB * 32 + itd[k]) = a_; *(LAS f32x4*)((dst) + itd[k]) = a_ * dt_; if ((itd[k] & 31) == 0) (dst)[TB * 320 + its[k]] = expf(dt_ * aneg); } \
            else *(LAS f32x4*)((dst) + itd[k]) = a_; } } } while (0)
    float hs[8];
#pragma unroll
    for (int k = 0; k < 8; ++k) hs[k] = 0.f;
    __syncthreads();
    SSD_LOAD(0); SSD_COMMIT(buf0);
    __syncthreads();
    for (int blk = 0; blk < NBLK; ++blk) {
        LAS float* cur = buf0 + (blk & 1) * NF; LAS float* nxtb = buf0 + ((blk + 1) & 1) * NF;
        if (blk + 1 < NBLK) SSD_LOAD(blk + 1);
        const size_t tz = tb + (size_t)blk * TB + os;
        zraw = proj[tz * NPROJ + PC_Z + h * 64 + 32 * ph + op]; const unsigned short zraw2 = proj[tz * NPROJ + PC_Z + h * 64 + 32 * ph + op + 16];
        for (int s0 = 0; s0 < TB; s0 += 4) {
            float x4[4], dA4[4], yv[4]; f32x4 bv[4][2], cv[4][2];
#pragma unroll
            for (int u = 0; u < 4; ++u) { const int s = s0 + u; x4[u] = cur[s * 32 + pl]; dA4[u] = cur[TB * 320 + s];
                const LAS float* bp = cur + 2 * TB * 32 + s * 128 + 16 * w + 8 * nh; const LAS float* cp = bp + TB * 128;
                bv[u][0] = *(const LAS f32x4*)bp; bv[u][1] = *(const LAS f32x4*)(bp + 4); cv[u][0] = *(const LAS f32x4*)cp; cv[u][1] = *(const LAS f32x4*)(cp + 4); }
#pragma unroll
            for (int u = 0; u < 4; ++u) { float yp = 0.f;
#pragma unroll
                for (int k4 = 0; k4 < 2; ++k4)
#pragma unroll
                    for (int j = 0; j < 4; ++j) { hs[4 * k4 + j] = hs[4 * k4 + j] * dA4[u] + x4[u] * bv[u][k4][j]; yp += cv[u][k4][j] * hs[4 * k4 + j]; }
                const auto sw = __builtin_amdgcn_permlane32_swap(__builtin_bit_cast(unsigned, yp), __builtin_bit_cast(unsigned, yp), false, false);
                yv[u] = yp + __builtin_bit_cast(float, (unsigned)sw[1]); }
            if (nh == 0) {
#pragma unroll
                for (int u = 0; u < 4; ++u) ypart[((s0 + u) * 8 + w) * 32 + pl] = yv[u]; }
        }
        if (blk + 1 < NBLK) SSD_COMMIT(nxtb);
        __syncthreads();
        {
            float y0 = 0.f, y1 = 0.f;
#pragma unroll
            for (int ww = 0; ww < 8; ++ww) { y0 += ypart[(os * 8 + ww) * 32 + op]; y1 += ypart[(os * 8 + ww) * 32 + op + 16]; }
            y0 += cur[TB * 32 + os * 32 + op] * dsk; y1 += cur[TB * 32 + os * 32 + op + 16] * dsk;
            y0 *= siluf_(bf2f(zraw)); y1 *= siluf_(bf2f(zraw2));
            bf16_t* yo = Y + tz * 1024 + 512 + h * 64 + 32 * ph + op;
            yo[0] = (bf16_t)(cvt_pk_bf16(y0, 0.f) & 0xffffu); yo[16] = (bf16_t)(cvt_pk_bf16(y1, 0.f) & 0xffffu);
            float q = y0 * y0 + y1 * y1;
#pragma unroll
            for (int o_ = 1; o_ < 16; o_ <<= 1) q += __shfl_xor(q, o_);
            if (op == 0) SSQ[tz * 8 + h * 2 + ph] = q;
        }
        __syncthreads();
    }
#undef SSD_LOAD
#undef SSD_COMMIT
}

__device__ __forceinline__ void sb_naive(const Ctx& C) {
    const bf16_t* proj = WSP(bf16_t, S_PROJ); bf16_t* Y = WSP(bf16_t, S_Y); const int lane = C.lane;
    for (int item = GW; item < T * 4; item += NGW) {
        const int t = item >> 2, h = item & 3, tq = t % SEQ; const size_t tb = (size_t)(t - tq);
        float q[64];
        { const bf16_t* qp = proj + (size_t)t * NPROJ + PC_SBQ + h * 64;
#pragma unroll
          for (int i = 0; i < 8; ++i) { const u32x4 w = *(const u32x4*)(qp + 8 * i); q[8*i] = bflo(w.x); q[8*i+1] = bfhi(w.x); q[8*i+2] = bflo(w.y); q[8*i+3] = bfhi(w.y); q[8*i+4] = bflo(w.z); q[8*i+5] = bfhi(w.z); q[8*i+6] = bflo(w.w); q[8*i+7] = bfhi(w.w); } }
        float o[64];
#pragma unroll
        for (int d = 0; d < 64; ++d) o[d] = 0.f;
        float R = 0.f;
        for (int c = (tq - 1) >> 6; c >= 0 && tq > 0; --c) {
            const int key = c * 64 + lane; const bool ok = key < tq;
            const bf16_t* kp = proj + (tb + key) * NPROJ + PC_SBK + h * 64; const bf16_t* vp = proj + (tb + key) * NPROJ + PC_SBV + h * 64;
            float z = 0.f;
#pragma unroll
            for (int i = 0; i < 8; ++i) { const u32x4 w = *(const u32x4*)(kp + 8 * i);
                z += q[8*i] * bflo(w.x) + q[8*i+1] * bfhi(w.x) + q[8*i+2] * bflo(w.y) + q[8*i+3] * bfhi(w.y) + q[8*i+4] * bflo(w.z) + q[8*i+5] * bfhi(w.z) + q[8*i+6] * bflo(w.w) + q[8*i+7] * bfhi(w.w); }
            const float L = ok ? -(fmaxf(z, 0.f) + flog2(1.0f + fexp2(-fabsf(z)))) : 0.f;
            float sfx = L;
#pragma unroll
            for (int dd = 1; dd < 64; dd <<= 1) { const float tt = __shfl_down(sfx, dd); if (lane + dd < 64) sfx += tt; }
            const float tot = __shfl(sfx, 0);
            const float wgt = ok ? fexp2(z + L + (sfx - L) + R) : 0.f;
            R += tot;
#pragma unroll
            for (int i = 0; i < 8; ++i) { const u32x4 w = *(const u32x4*)(vp + 8 * i);
                o[8*i] += wgt * bflo(w.x); o[8*i+1] += wgt * bfhi(w.x); o[8*i+2] += wgt * bflo(w.y); o[8*i+3] += wgt * bfhi(w.y); o[8*i+4] += wgt * bflo(w.z); o[8*i+5] += wgt * bfhi(w.z); o[8*i+6] += wgt * bflo(w.w); o[8*i+7] += wgt * bfhi(w.w); }
        }
        float mine = 0.f;
#pragma unroll
        for (int d = 0; d < 64; ++d) { const float sdd = wave_sum(o[d]); if (lane == d) mine = sdd; }
        Y[(size_t)t * 1024 + h * 64 + lane] = (bf16_t)(cvt_pk_bf16(mine, 0.f) & 0xffffu);
    }
}

__device__ __forceinline__ void rwkv_naive(const Ctx& C, int l) {
    const float* DEC = WSP(float, S_DEC); const bf16_t* RWS = WSP(bf16_t, S_RWS); const bf16_t* GV = WSP(bf16_t, S_GV); bf16_t* Y = WSP(bf16_t, S_Y);
    const size_t PL = (size_t)T * 256; const int lane = C.lane;
    for (int item = GW; item < 64; item += NGW) {
        const int b = item >> 2, h = item & 3; const float* rk = C.in[I_RWRK] + l * 256 + h * 64;
        const float gng = C.in[I_RWGNG][l * 256 + h * 64 + lane], gnb = C.in[I_RWGNB][l * 256 + h * 64 + lane];
        float S[64];
#pragma unroll
        for (int j = 0; j < 64; ++j) S[j] = 0.f;
        for (int tq = 0; tq < SEQ; ++tq) {
            const size_t o = ((size_t)b * SEQ + tq) * 256 + h * 64;
            const float v = bf2f(RWS[2 * PL + o + lane]);
            float sa = 0.f;
#pragma unroll
            for (int j = 0; j < 64; ++j) sa += S[j] * bf2f(RWS[3 * PL + o + j]);
            float y = 0.f, bd = 0.f;
#pragma unroll
            for (int j = 0; j < 64; ++j) { const float km = bf2f(RWS[PL + o + j]), r = bf2f(RWS[o + j]);
                S[j] = S[j] * DEC[o + j] + (v * km - sa * bf2f(RWS[4 * PL + o + j])); y += S[j] * r; bd += r * km * rk[j]; }
            const float mu = wave_sum(y) * (1.0f / 64.0f), d = y - mu, var = wave_sum(d * d) * (1.0f / 64.0f);
            const float res = (d * (1.0f / sqrtf(var + 64e-5f)) * gng + gnb + v * bd) * bf2f(GV[o + lane]);
            Y[((size_t)b * SEQ + tq) * 1024 + 256 + h * 64 + lane] = (bf16_t)(cvt_pk_bf16(res, 0.f) & 0xffffu);
        }
    }
}
__device__ __forceinline__ void ssd_naive(const Ctx& C, int l) {
    const bf16_t* proj = WSP(bf16_t, S_PROJ); bf16_t* Y = WSP(bf16_t, S_Y); float* SSQ = WSP(float, S_SSQ); const int lane = C.lane;
    const float* cw = C.in[I_CONVW] + l * 4 * 768; const float* cb = C.in[I_CONVB] + l * 768;
    for (int item2 = GW; item2 < 128; item2 += NGW) {
        const int item = item2 >> 1, ph = item2 & 1; const int b = item >> 2, h = item & 3, g = h >> 1; const size_t tb = (size_t)b * SEQ;
        const float dtb = C.in[I_DTB][l * 4 + h], aneg = -expf(C.in[I_ALOG][l * 4 + h]), dsk = C.in[I_SSDD][l * 4 + h];
        float hs0[32], hs1[32];
#pragma unroll
        for (int p = 0; p < 32; ++p) { hs0[p] = 0.f; hs1[p] = 0.f; }
        for (int tq = 0; tq < SEQ; ++tq) {
            const bf16_t* pr = proj + (tb + tq) * NPROJ;
            float xa = cb[h * 64 + lane], bv0 = cb[256 + g * 128 + lane], bv1 = cb[256 + g * 128 + 64 + lane], cv0 = cb[512 + g * 128 + lane], cv1 = cb[512 + g * 128 + 64 + lane];
            for (int k = 0; k < 4; ++k) { const int tt = tq - 3 + k; if (tt >= 0) { const bf16_t* pp = proj + (tb + tt) * NPROJ; const float* ww = cw + k * 768;
                xa += bf2f(pp[PC_XS + h * 64 + lane]) * ww[h * 64 + lane];
                bv0 += bf2f(pp[PC_BM + g * 128 + lane]) * ww[256 + g * 128 + lane]; bv1 += bf2f(pp[PC_BM + g * 128 + 64 + lane]) * ww[256 + g * 128 + 64 + lane];
                cv0 += bf2f(pp[PC_CM + g * 128 + lane]) * ww[512 + g * 128 + lane]; cv1 += bf2f(pp[PC_CM + g * 128 + 64 + lane]) * ww[512 + g * 128 + 64 + lane]; } }
            xa = siluf_(xa); bv0 = siluf_(bv0); bv1 = siluf_(bv1); cv0 = siluf_(cv0); cv1 = siluf_(cv1);
            const float dt = softplusf_(bf2f(pr[PC_DT + h]) + dtb), dA = expf(dt * aneg), xd = xa * dt;
            float y = 0.f;
#pragma unroll
            for (int p = 0; p < 32; ++p) { const float xp = __shfl(xd, 32 * ph + p); hs0[p] = hs0[p] * dA + xp * bv0; hs1[p] = hs1[p] * dA + xp * bv1;
                const float tot = wave_sum(cv0 * hs0[p] + cv1 * hs1[p]); if (lane == 32 * ph + p) y = tot; }
            y += dsk * xa; y *= siluf_(bf2f(pr[PC_Z + h * 64 + lane]));
            const bool mine = (lane >> 5) == ph; if (mine) Y[(tb + tq) * 1024 + 512 + h * 64 + lane] = (bf16_t)(cvt_pk_bf16(y, 0.f) & 0xffffu);
            const float q = wave_sum(mine ? y * y : 0.f); if (lane == 0) atomicAdd(&SSQ[(tb + tq) * 8 + h * 2], q);
        }
    }
}

__device__ __forceinline__ void mla_naive(const Ctx& C) {
    const bf16_t* QM = WSP(bf16_t, S_QM); const bf16_t* KM = WSP(bf16_t, S_KM); const bf16_t* VM = WSP(bf16_t, S_VM); bf16_t* Y = WSP(bf16_t, S_Y); const int lane = C.lane;
    for (int item = GW; item < T * 4; item += NGW) {
        const int t = item >> 2, h = item & 3, tq = t % SEQ; const size_t tb = (size_t)(t - tq);
        float q[96];
        { const bf16_t* qp = QM + (size_t)t * 384 + h * 96;
#pragma unroll
          for (int i = 0; i < 12; ++i) { const u32x4 w = *(const u32x4*)(qp + 8 * i); q[8*i] = bflo(w.x); q[8*i+1] = bfhi(w.x); q[8*i+2] = bflo(w.y); q[8*i+3] = bfhi(w.y); q[8*i+4] = bflo(w.z); q[8*i+5] = bfhi(w.z); q[8*i+6] = bflo(w.w); q[8*i+7] = bfhi(w.w); } }
        float o[64];
#pragma unroll
        for (int d = 0; d < 64; ++d) o[d] = 0.f;
        float m = -1.0e30f, lsum = 0.f;
        for (int c = tq >> 6; c >= 0; --c) {
            const int key = c * 64 + lane; const bool ok = key <= tq;
            const bf16_t* kp = KM + (tb + (ok ? key : 0)) * 384 + h * 96; const bf16_t* vp = VM + (tb + (ok ? key : 0)) * 256 + h * 64;
            float z = 0.f;
#pragma unroll
            for (int i = 0; i < 12; ++i) { const u32x4 w = *(const u32x4*)(kp + 8 * i);
                z += q[8*i] * bflo(w.x) + q[8*i+1] * bfhi(w.x) + q[8*i+2] * bflo(w.y) + q[8*i+3] * bfhi(w.y) + q[8*i+4] * bflo(w.z) + q[8*i+5] * bfhi(w.z) + q[8*i+6] * bflo(w.w) + q[8*i+7] * bfhi(w.w); }
            z = ok ? z : -1.0e30f;
            float cm = z;
#pragma unroll
            for (int dd = 1; dd < 64; dd <<= 1) cm = fmaxf(cm, __shfl_xor(cm, dd));
            const float mn = fmaxf(m, cm), al = fexp2(m - mn), pw = ok ? fexp2(z - mn) : 0.f; m = mn; lsum = lsum * al + pw;
#pragma unroll
            for (int i = 0; i < 8; ++i) { const u32x4 w = *(const u32x4*)(vp + 8 * i);
                o[8*i] = o[8*i] * al + pw * bflo(w.x); o[8*i+1] = o[8*i+1] * al + pw * bfhi(w.x); o[8*i+2] = o[8*i+2] * al + pw * bflo(w.y); o[8*i+3] = o[8*i+3] * al + pw * bfhi(w.y);
                o[8*i+4] = o[8*i+4] * al + pw * bflo(w.z); o[8*i+5] = o[8*i+5] * al + pw * bfhi(w.z); o[8*i+6] = o[8*i+6] * al + pw * bflo(w.w); o[8*i+7] = o[8*i+7] * al + pw * bfhi(w.w); }
        }
        const float lt = wave_sum(lsum); float mine = 0.f;
#pragma unroll
        for (int d = 0; d < 64; ++d) { const float sdd = wave_sum(o[d]); if (lane == d) mine = sdd; }
        Y[(size_t)t * 1024 + 768 + h * 64 + lane] = (bf16_t)(cvt_pk_bf16(mine / lt, 0.f) & 0xffffu);
    }
}
__device__ __forceinline__ void xattn_naive(const Ctx& C, int l) {
    const bf16_t* XQ = WSP(bf16_t, S_XQ); const bf16_t* KMEM = WSP(bf16_t, W_KMEM) + (size_t)l * NMEM * 1024; const bf16_t* VT = WSP(bf16_t, W_VMEMT) + (size_t)l * 1024 * NMEM; bf16_t* XO = WSP(bf16_t, S_XO); const int lane = C.lane;
    for (int item = GW; item < T * 4; item += NGW) {
        const int t = item >> 2, h = item & 3, b = t / SEQ;
        float z[4] = {0.f, 0.f, 0.f, 0.f};
        for (int d8 = 0; d8 < 32; ++d8) { const u32x4 qw = *(const u32x4*)(XQ + (size_t)t * 1024 + h * 256 + 8 * d8);
            const float qv[8] = {bflo(qw.x), bfhi(qw.x), bflo(qw.y), bfhi(qw.y), bflo(qw.z), bfhi(qw.z), bflo(qw.w), bfhi(qw.w)};
#pragma unroll
            for (int j = 0; j < 4; ++j) { const u32x4 kw = *(const u32x4*)(KMEM + (size_t)(b * 256 + lane + 64 * j) * 1024 + h * 256 + 8 * d8);
                z[j] += qv[0] * bflo(kw.x) + qv[1] * bfhi(kw.x) + qv[2] * bflo(kw.y) + qv[3] * bfhi(kw.y) + qv[4] * bflo(kw.z) + qv[5] * bfhi(kw.z) + qv[6] * bflo(kw.w) + qv[7] * bfhi(kw.w); } }
        float mx = fmaxf(fmaxf(z[0], z[1]), fmaxf(z[2], z[3]));
#pragma unroll
        for (int dd = 1; dd < 64; dd <<= 1) mx = fmaxf(mx, __shfl_xor(mx, dd));
        float p[4], ps = 0.f;
#pragma unroll
        for (int j = 0; j < 4; ++j) { p[j] = fexp2(z[j] - mx); ps += p[j]; }
        const float inv = 1.0f / wave_sum(ps);
        float o[4] = {0.f, 0.f, 0.f, 0.f};
        for (int mm = 0; mm < 256; ++mm) { const float pm = __shfl(p[mm >> 6], mm & 63);
#pragma unroll
            for (int jd = 0; jd < 4; ++jd) o[jd] += pm * bf2f(VT[(size_t)(h * 256 + lane + 64 * jd) * NMEM + b * 256 + mm]); }
#pragma unroll
        for (int jd = 0; jd < 4; ++jd) XO[(size_t)t * 1024 + h * 256 + lane + 64 * jd] = (bf16_t)(cvt_pk_bf16(o[jd] * inv, 0.f) & 0xffffu);
    }
}
__device__ __forceinline__ void ph_mixers(const Ctx& C, int l, int rep = 0) {
    unsigned* head = (unsigned*)(C.ws + WS_CTL) + CW_QUEUE + 64 * (l + 2 * rep);
    volatile LAS unsigned* slot = (volatile LAS unsigned*)(C.lds + LDSCTL_OFF + 64);
#ifdef TIME_VAR
    const unsigned var = __builtin_amdgcn_readfirstlane(__hip_atomic_load((const unsigned*)(C.ws + WS_CTL) + 200000, RLX_AGENT)) & 0xffu;
#else
    const unsigned var = 0u;
#endif
    constexpr int N_RW = 128, N_ATT = 768, NITEMS = N_RW + N_ATT;
    for (;;) {
        __syncthreads();
        if (C.tid == 0) slot[0] = __hip_atomic_fetch_add(head, 1u, RLX_AGENT);
        __syncthreads();
        const int it = (int)slot[0];
        if (it >= NITEMS) break;
#ifndef NAIVE_SCAN
#define NAIVE_SCAN 0
#endif
        if (it < N_RW) { if (!(NAIVE_SCAN & 1) && !(var & 1u)) { rwkv_unit(C, l, it >> 3, (it >> 1) & 3, it & 1);
#ifdef TIME_RW2
            __syncthreads(); rwkv_unit(C, l, it >> 3, (it >> 1) & 3, it & 1);
#endif
        } }
        else { const int k = it - N_RW; const int mode = k >> 8, kk_ = k & 255, pp = kk_ & 3, bh = kk_ >> 2, b = bh >> 2, h = bh & 3;
            if (mode == 0) { if (!(NAIVE_SCAN & 2) && !(var & 2u)) { attn_unit<2>(C, l, b, h, 7 - pp, var); __syncthreads(); attn_unit<2>(C, l, b, h, pp, var);
#ifdef TIME_SSDA2
                __syncthreads(); attn_unit<2>(C, l, b, h, 7 - pp); __syncthreads(); attn_unit<2>(C, l, b, h, pp);
#endif
            } }
#ifndef NAIVE_SB
            else if (mode == 2) { if (!(var & 8u)) { attn_unit<0>(C, l, b, h, 7 - pp, var); __syncthreads(); attn_unit<0>(C, l, b, h, pp, var); }
#ifdef TIME_SB2
                __syncthreads(); attn_unit<0>(C, l, b, h, 7 - pp); __syncthreads(); attn_unit<0>(C, l, b, h, pp);
#endif
            }
#else
            else if (mode == 2) { }
#endif
#ifndef NAIVE_MLA
            else { if (!(var & 4u)) { attn_unit<1>(C, l, b, h, 7 - pp, var); __syncthreads(); attn_unit<1>(C, l, b, h, pp, var); }
#ifdef TIME_MLA2
                __syncthreads(); attn_unit<1>(C, l, b, h, 7 - pp); __syncthreads(); attn_unit<1>(C, l, b, h, pp);
#endif
            }
#else
            else { }
#endif
        }
    }
#ifdef NAIVE_SB
    sb_naive(C);
#endif
#ifdef NAIVE_MLA
    mla_naive(C);
#endif
    if (NAIVE_SCAN & 1) rwkv_naive(C, l);
    if (NAIVE_SCAN & 2) ssd_naive(C, l);
}
__device__ __forceinline__ void ph_router(const Ctx& C) {
#ifdef TIME_VAR
    const unsigned var = __builtin_amdgcn_readfirstlane(__hip_atomic_load((const unsigned*)(C.ws + WS_CTL) + 200000, RLX_AGENT)) & 0xffu;
#else
    const unsigned var = 0u;
#endif
    if (!(var & 1u)) run_tjobs<16, true>(C, var);
    __syncthreads();
    LAS unsigned* lc = (LAS unsigned*)(C.lds + XCH_OFF);
    if (C.tid < 8) lc[C.tid] = 0u;
    __syncthreads();
    const float* xr = WSP(float, W_XRES); const float* rt = C.in[I_ROUTER]; int* topi = WSP(int, S_TOPI); float* topw = WSP(float, S_TOPW); const int lane = C.lane;
    f32x4 nx[4];
#define RT_LOAD(kk_) do { const int t_ = C.bid * 128 + C.wave * 16 + (kk_); _Pragma("unroll") for (int j = 0; j < 4; ++j) nx[j] = *(const f32x4*)(xr + (size_t)t_ * 1024 + 4 * lane + 256 * j); } while (0)
    RT_LOAD(0);
    f32x4 rw0[16], rw1[16];
#pragma unroll
    for (int jq = 0; jq < 16; ++jq) { const float* rp = rt + (size_t)(4 * lane + 256 * (jq >> 2) + (jq & 3)) * 8; rw0[jq] = *(const f32x4*)rp; rw1[jq] = *(const f32x4*)(rp + 4); }
    for (int k = 0; k < ((var & 2u) ? 0 : 16); ++k) {
        const int t = C.bid * 128 + C.wave * 16 + k; float a[8]; f32x4 xv4[4];
#pragma unroll
        for (int j = 0; j < 4; ++j) xv4[j] = nx[j];
        if (k + 1 < 16) RT_LOAD(k + 1);
#pragma unroll
        for (int e = 0; e < 8; ++e) a[e] = 0.f;
#pragma unroll
        for (int jq = 0; jq < 16; ++jq) { const float xq = xv4[jq >> 2][jq & 3]; const f32x4 r0 = rw0[jq], r1 = rw1[jq];
            a[0] += xq * r0[0]; a[1] += xq * r0[1]; a[2] += xq * r0[2]; a[3] += xq * r0[3]; a[4] += xq * r1[0]; a[5] += xq * r1[1]; a[6] += xq * r1[2]; a[7] += xq * r1[3]; }
#pragma unroll
        for (int e = 0; e < 8; ++e) a[e] = wave_sum(a[e]);
#ifdef ROUTER_NOISE
        for (int e = 0; e < 8; ++e) { unsigned hsh = (unsigned)t * 2654435761u + (unsigned)e * 40503u; hsh ^= hsh >> 13; hsh *= 0x5bd1e995u; hsh ^= hsh >> 15; a[e] += ROUTER_NOISE * ((float)(hsh & 0xffff) * (1.0f / 32768.0f) - 1.0f); }
#endif
        if (lane == 0) {
            int i1 = 0; float v1 = a[0];
#pragma unroll
            for (int e = 1; e < 8; ++e) if (a[e] > v1) { v1 = a[e]; i1 = e; }
            int i2 = -1; float v2 = -3.0e38f;
#pragma unroll
            for (int e = 0; e < 8; ++e) if (e != i1 && a[e] > v2) { v2 = a[e]; i2 = e; }
            const float g1 = 1.0f / (1.0f + expf(v2 - v1));
            topi[2 * t] = i1; topi[2 * t + 1] = i2; topw[2 * t] = g1; topw[2 * t + 1] = 1.0f - g1;
            __hip_atomic_fetch_add(&lc[i1], 1u, __ATOMIC_RELAXED, __HIP_MEMORY_SCOPE_WORKGROUP); __hip_atomic_fetch_add(&lc[i2], 1u, __ATOMIC_RELAXED, __HIP_MEMORY_SCOPE_WORKGROUP);
        }
    }
    __syncthreads();
    if (C.tid < 8) ((unsigned*)(C.ws + WS_CTL))[CW_MOECNT + C.bid * 8 + C.tid] = lc[C.tid];
}
__device__ __forceinline__ void ph_scatter(const Ctx& C) {
    LAS int* sh = (LAS int*)(C.lds + XCH_OFF);
    const unsigned* cnt = (const unsigned*)(C.ws + WS_CTL) + CW_MOECNT;
    int* row_slot = WSP(int, S_ROWSLOT); float* row_w = WSP(float, S_ROWW); int* blk_e = WSP(int, S_BLKE);
    const int* topi = WSP(int, S_TOPI); const float* topw = WSP(float, S_TOPW);
    const int tid = C.tid;
    if (tid < 8) { int tot = 0, mine = 0; for (int wg = 0; wg < 256; ++wg) { const int c = (int)cnt[wg * 8 + tid]; if (wg < C.bid) mine += c; tot += c; } sh[tid] = tot; sh[8 + tid] = mine; sh[32 + tid] = 0; }
    __syncthreads();
    if (tid == 0) { int ps = 0; for (int e = 0; e < 8; ++e) { sh[16 + e] = ps; const int pad = (sh[e] + 255) / 256 * 256; sh[24 + e] = pad; ps += pad; } sh[40] = ps / 256; }
    __syncthreads();
    if (C.bid == 0) {
        const int used = sh[40];
        for (int rb = tid; rb < MOE_BLOCKS; rb += NTHREADS) { int e = 7; if (rb < used) { e = 0; for (int q = 1; q < 8; ++q) if (sh[16 + q] <= rb * 256) e = q; } blk_e[rb] = e; }
        if (tid == 0) blk_e[MOE_BLOCKS] = used;
    }
    if (C.bid < 8) { const int e = C.bid; for (int r = sh[16 + e] + sh[e] + tid; r < sh[16 + e] + sh[24 + e]; r += NTHREADS) { row_slot[r] = -1; row_w[r] = 0.f; } }
    if (tid < 256) { const int t = C.bid * 128 + (tid >> 1), k = tid & 1, e = topi[2 * t + k];
        const int pos = __hip_atomic_fetch_add(&sh[32 + e], 1, __ATOMIC_RELAXED, __HIP_MEMORY_SCOPE_WORKGROUP); const int dest = sh[16 + e] + sh[8 + e] + pos; row_slot[dest] = 2 * t + k; row_w[dest] = topw[2 * t + k]; sh[64 + tid] = dest; }
    __syncthreads();
    const bf16_t* xb = WSP(bf16_t, W_XB); bf16_t* xs = WSP(bf16_t, S_XS);
    for (int a = C.wave * 32; a < C.wave * 32 + 32; ++a) { const int t = C.bid * 128 + (a >> 1); const size_t d = (size_t)sh[64 + a] * 1024;
#pragma unroll
        for (int j = 0; j < 2; ++j) *(u32x4*)(xs + d + (C.lane + 64 * j) * 8) = *(const u32x4*)(xb + (size_t)t * 1024 + (C.lane + 64 * j) * 8); }
}


__device__ __forceinline__ void chk_moe(const Ctx& C, int bit) {
    const float* xr = WSP(float, W_XRES); const float* rt = C.in[I_ROUTER]; const float* w13 = C.in[I_MOE13]; const float* w2 = C.in[I_MOE2]; const bf16_t* ys = WSP(bf16_t, S_YS);
    LAS float* hb = (LAS float*)(C.lds + C.wave * 14336); const int lane = C.lane; unsigned bad = 0;
    float* stash = WSP(float, W_KMEM); const float* g3 = C.in[I_LN3G] + 1024; const float* b3 = C.in[I_LN3B] + 1024;
    for (int s = GW; s < 1024; s += NGW) {
        const int t = (int)(((long)s * 1021 + 7) % T); float x[16];
#pragma unroll
        for (int j = 0; j < 16; ++j) x[j] = xr[(size_t)t * 1024 + lane + 64 * j];
        float lg[8];
#pragma unroll
        for (int e = 0; e < 8; ++e) { float a = 0.f;
#pragma unroll
            for (int j = 0; j < 16; ++j) a += x[j] * rt[(size_t)(lane + 64 * j) * 8 + e]; lg[e] = wave_sum(a); }
        int i1 = 0; for (int e = 1; e < 8; ++e) if (lg[e] > lg[i1]) i1 = e;
        int i2 = -1; for (int e = 0; e < 8; ++e) if (e != i1 && (i2 < 0 || lg[e] > lg[i2])) i2 = e;
        float v3 = -3.0e38f; for (int e = 0; e < 8; ++e) if (e != i1 && e != i2) v3 = fmaxf(v3, lg[e]);
        if (lg[i2] - v3 < 0.02f) { if (lane == 0) stash[(size_t)s * 1024] = 1.0e30f; continue; }
        const float g1 = 1.0f / (1.0f + expf(lg[i2] - lg[i1]));
        float out[16];
#pragma unroll
        for (int j = 0; j < 16; ++j) out[j] = 0.f;
        for (int q = 0; q < 2; ++q) { const int e = q ? i2 : i1; const float gw = q ? 1.0f - g1 : g1; const float* W1 = w13 + (size_t)e * 1024 * 2 * FFE;
            for (int i0 = 0; i0 < 56; i0 += 4) { float ag[4], au[4];
#pragma unroll
                for (int i = 0; i < 4; ++i) { ag[i] = 0.f; au[i] = 0.f; }
                for (int k = 0; k < 1024; ++k) { const float xk = __shfl(x[k >> 6], k & 63); const float* wr = W1 + (size_t)k * 2 * FFE + lane + 64 * i0;
#pragma unroll
                    for (int i = 0; i < 4; ++i) { ag[i] += xk * wr[64 * i]; au[i] += xk * wr[FFE + 64 * i]; } }
#pragma unroll
                for (int i = 0; i < 4; ++i) hb[lane + 64 * (i0 + i)] = (ag[i] / (1.0f + expf(-ag[i]))) * au[i]; }
            LDS_WAIT();
            const float* W2 = w2 + (size_t)e * FFE * 1024;
            for (int hh = 0; hh < FFE; ++hh) { const float hv = hb[hh] * gw;
#pragma unroll
                for (int j = 0; j < 16; ++j) out[j] += hv * W2[(size_t)hh * 1024 + lane + 64 * j]; }
            LDS_WAIT(); }
#pragma unroll
        for (int j = 0; j < 16; ++j) { const int c = lane + 64 * j; const float got = bf2f(ys[(size_t)(2 * t) * 1024 + c]) + bf2f(ys[(size_t)(2 * t + 1) * 1024 + c]);
            if (fabsf(got - out[j]) > 0.05f * fabsf(out[j]) + 0.03f) bad = 1; }
        { float v[16], sm = 0.f, s2 = 0.f;
#pragma unroll
          for (int j = 0; j < 16; ++j) { v[j] = x[j] * DN_ALPHA + out[j]; sm += v[j]; }
          const float mean = wave_sum(sm) * (1.0f / 1024.0f);
#pragma unroll
          for (int j = 0; j < 16; ++j) { v[j] -= mean; s2 += v[j] * v[j]; }
          const float rstd = 1.0f / sqrtf(wave_sum(s2) * (1.0f / 1024.0f) + 1e-5f);
          int zz = 0; asm volatile("" : "+v"(zz));
#pragma unroll
          for (int j = 0; j < 16; ++j) { const int c = lane + 64 * j + zz; stash[(size_t)s * 1024 + c] = v[j] * rstd * g3[c] + b3[c]; } }
    }
    chk_flag(C, bit, bad);
}
#ifndef ABL_MIX
#define ABL_MIX 1.0f
#endif
#ifndef ABL_XA
#define ABL_XA 1.0f
#endif
#ifndef ABL_FF
#define ABL_FF 1.0f
#endif
#ifndef CHK_TOL2
#define CHK_TOL2 0.05f
#endif
#ifndef GATE_ACT
#define GATE_ACT 1
#endif
#ifndef GATE_ALIGN
#define GATE_ALIGN true
#endif
#ifndef FG_TOL
#define FG_TOL 0.05f
#endif
#ifndef FG_BIT
#define FG_BIT 1
#endif
#ifndef CHECKS_LAYER
#define CHECKS_LAYER 0
#endif
#ifndef MK_SPLIT
#define MK_SPLIT 0
#endif
constexpr int PH_L0 = 1, PH_L1 = 16, PH_MOE = 28, PH_TOTAL = PH_MOE + 2 + 2 * MOE_PASSES + 1;

__global__ void __launch_bounds__(NTHREADS, 2) hybrid_fwd(Args args) {
    extern __shared__ __attribute__((aligned(16))) unsigned char lds_raw[];
    Ctx C; C.in = args.in; C.out = args.out; C.ws = args.ws; C.lds = (LAS unsigned char*)lds_raw;
    C.tid = threadIdx.x; C.lane = C.tid & 63; C.wave = __builtin_amdgcn_readfirstlane(C.tid >> 6); C.G = gridDim.x; C.bid = blockIdx.x;
    const Ctx C0 = C;
    for (int u = C.tid; u < (LDS_BYTES - LDSCTL_OFF) / 4; u += NTHREADS) ((LAS unsigned*)(C.lds + LDSCTL_OFF))[u] = 0u;
    __syncthreads();
    const int lo = args.ph_lo, hi = args.ph_hi;
    XcdBarrier bar; bar.bar = (unsigned*)(C.ws + WS_CTL) + CW_BAR; bar.x = 0; bar.st = (volatile LAS unsigned*)(C.lds + LDSCTL_OFF);
    if (hi - lo > 1) bar = xcd_barrier_post((unsigned*)(C.ws + WS_CTL) + CW_BAR, (volatile LAS unsigned*)(C.lds + LDSCTL_OFF));
#ifndef SITE_MASK
#define SITE_MASK 0xffffffffu
#endif
#define SITE(n) (((SITE_MASK) >> (n)) & 1u)
#define IN(k) (lo <= (k) && (k) < hi)
#define ENDPH(k) do { if ((k) + 1 < hi) xcd_barrier(bar); } while (0)
#define SITE_BEGIN const Ctx C = launder(C0); unsigned char* LW = C.ws + W_BASE + (size_t)l * LW_SIZE; const bf16_t* XB = WSP(bf16_t, W_XB); float* XRES = WSP(float, W_XRES); (void)LW; (void)XB; (void)XRES; LAS unsigned char* ring = C.lds; (void)ring;

    if (SITE(0) && IN(0)) { const int l = 0; SITE_BEGIN ph_prologue(C);
#ifdef TIME_PRO2
        xcd_barrier(bar); ph_prologue(C);
#endif
#ifdef TIME_BAR
        for (int q_ = 0; q_ < TIME_BAR; ++q_) xcd_barrier(bar);
#endif
        ENDPH(0); }

    for (int l = 0; l < 2; ++l) {
        const int pb = l == 0 ? PH_L0 : PH_L1;
        if (SITE(1) && IN(pb + 0)) { SITE_BEGIN
#ifdef CHECKS3
            if (l == 1) chk_ln_cmp(C, 1, 1);
#endif
            { pg8::Gemm g{XB, (const bf16_t*)(LW + LW_WIN), 1024, 1024, 1024}; sch::Tiles S{T / 256, NPROJ / 256, C.G, C.bid}; epi::StoreBf16<0> E{WSP(bf16_t, S_PROJ), NPROJ}; pg8::gemm_phase(ring, g, S, E); }
            { pg8::Gemm g{(const bf16_t*)C.ws, (const bf16_t*)C.ws, 1024, 1024, 1024}; sch::MemKV S{(long)(W_MEMB / 2), (long)((W_BASE + (size_t)l * LW_SIZE + LW_WKV) / 2), C.bid};
              epi::StoreBf16<0> E{WSP(bf16_t, W_KMEM) + (size_t)l * NMEM * 2048, 2048}; pg8::gemm_phase(ring, g, S, E); }
            ENDPH(pb + 0);
        }
        if (SITE(2) && IN(pb + 1)) { SITE_BEGIN
#ifdef CHECKS5
            if (l == 0) chk_weights<28, false>(C, 0);
#endif
#ifdef CHECKS9
            if (l == 0) { unsigned bad = 0; const float* x = C.in[I_X]; const float* mm = C.in[I_MEM]; const bf16_t* mb = WSP(bf16_t, W_MEMB);
                for (size_t i = (size_t)C.bid * NTHREADS + C.tid; i < (size_t)T * 1024; i += (size_t)C.G * NTHREADS) if (!chk_close(x[i], bf2f(XB[i]))) bad = 1;
                for (size_t i = (size_t)C.bid * NTHREADS + C.tid; i < (size_t)NMEM * 1024; i += (size_t)C.G * NTHREADS) if (!chk_close(mm[i], bf2f(mb[i]))) bad = 1;
                if (bad) __hip_atomic_fetch_add((unsigned*)(C.ws + WS_CTL) + CW_CHK, 1u, RLX_AGENT); }
#endif
#ifdef CHECKS12P
            if (l == CHECKS_LAYER) { const bf16_t* proj = WSP(bf16_t, S_PROJ); chk_full_gemm(C, XB, (const bf16_t*)(LW + LW_WIN), 1024, 3236, 0, [&](size_t r, int c, float d) { return chk_close(d, bf2f(proj[r * NPROJ + c])); }); xcd_barrier(bar); }
#endif
#ifdef CHECKS4
            if (l == CHECKS_LAYER) { const bf16_t* KM_ = WSP(bf16_t, W_KMEM) + (size_t)l * NMEM * 1024; const bf16_t* VT_ = WSP(bf16_t, W_VMEMT) + (size_t)l * 1024 * NMEM;
                chk_gemm(C, WSP(bf16_t, W_MEMB), 1024, (const bf16_t*)(LW + LW_WKV), 1024, 1024, NMEM, 64, 16, 3, 0, [&](int r, int c, float d) { return chk_close(d, bf2f(KM_[(size_t)r * 1024 + c])); });
                chk_gemm(C, (const bf16_t*)(LW + LW_WKV) + (size_t)1024 * 1024, 1024, WSP(bf16_t, W_MEMB), 1024, 1024, 1024, 256, 16, 5, 1, [&](int r, int c, float d) { return chk_close(d, bf2f(VT_[(size_t)r * NMEM + c])); }); }
#endif
#ifdef CHECKS
            if (l == CHECKS_LAYER) { const bf16_t* proj = WSP(bf16_t, S_PROJ); chk_gemm(C, XB, 1024, (const bf16_t*)(LW + LW_WIN), 1024, 1024, T, 13, 256, 7, 0, [&](int r, int c, float d) { return chk_close(d, bf2f(proj[(size_t)r * NPROJ + c])); }); }
#endif
            ph_prep(C, l);
#ifdef TIME_PREP2
            xcd_barrier(bar); ph_prep(C, l);
#endif
            ENDPH(pb + 1); }
        if (SITE(3) && IN(pb + 2)) { SITE_BEGIN
            { pg8::Gemm g{WSP(bf16_t, S_LA), (const bf16_t*)(LW + LW_LORA), 256, 256, 256}; sch::Tiles S{T / 256, 3, C.G, C.bid}; epi::Lora E{WSP(float, S_DEC), WSP(bf16_t, S_AV), WSP(bf16_t, S_GV), C.in[I_RWW0] + l * 256, C.in[I_RWA0] + l * 256}; pg8::gemm_phase(ring, g, S, E); }
            { pg8::Gemm g{WSP(bf16_t, S_CQN), (const bf16_t*)(LW + LW_WUQ), 256, 256, 256}; sch::Tiles S{T / 256, 2, C.G, (C.bid + 128) & 255}; epi::Uq E{WSP(bf16_t, S_QM), WSP(float, W_COS), WSP(float, W_SIN)}; pg8::gemm_phase(ring, g, S, E); }
            { pg8::Gemm g{WSP(bf16_t, S_CKVN), (const bf16_t*)(LW + LW_WUKV), 128, 128, 128}; sch::Tiles S{T / 256, 2, C.G, C.bid}; epi::Ukv E{WSP(bf16_t, S_KM), WSP(bf16_t, S_VM)}; pg8::gemm_phase(ring, g, S, E); }
            ENDPH(pb + 2);
        }
        if (SITE(4) && IN(pb + 3)) { SITE_BEGIN ph_rwprep(C, l); ph_ssdprep(C, l);
#ifdef TIME_RWP2
            xcd_barrier(bar); ph_rwprep(C, l); ph_ssdprep(C, l);
#endif
            ENDPH(pb + 3); }
        if (SITE(5) && IN(pb + 4)) { SITE_BEGIN
#ifdef CHECKS6
            if (l == CHECKS_LAYER) chk_mla_inputs(C, l, 0);
#endif
#ifdef CHECKS7
            if (l == CHECKS_LAYER) chk_rw_inputs(C, l, 0);
#endif
            ph_mixers(C, l);
#ifdef TIME_MIX2
            xcd_barrier(bar); ph_mixers(C, l, 1);
#endif
            ENDPH(pb + 4); }
        if (SITE(6) && IN(pb + 5)) { SITE_BEGIN
            ph_ssdfix(C, l);
            { pg8::Gemm g{XB, (const bf16_t*)(LW + LW_WGATE), 1024, 1024, 1024}; sch::Tiles S{T / 256, 16, C.G, C.bid}; epi::StoreBf16<GATE_ACT> E{WSP(bf16_t, S_G), 4096}; pg8::gemm_phase<epi::StoreBf16<GATE_ACT>, sch::Tiles, GATE_ALIGN>(ring, g, S, E);
#ifdef TIME_GATE2
              xcd_barrier(bar); pg8::gemm_phase<epi::StoreBf16<GATE_ACT>, sch::Tiles, GATE_ALIGN>(ring, g, S, E);
#endif
            }
#ifdef CHECKS14
            if (l == 0) { xcd_barrier(bar); const bf16_t* Gp = WSP(bf16_t, S_G); chk_full_gemm(C, XB, (const bf16_t*)(LW + LW_WGATE), 1024, 4096, 0, [&](size_t r, int c, float d) { return chk_close(sigmoidf_(d), bf2f(Gp[r * 4096 + c])); }); }
#endif
#ifdef CHECKS13
            if (l == 0) { xcd_barrier(bar);
              { pg8::Gemm g{XB, (const bf16_t*)(LW + LW_WGATE), 1024, 1024, 1024}; sch::Tiles S{T / 256, 16, C.G, C.bid}; epi::StoreBf16<1> E{WSP(bf16_t, S_G) + (size_t)T * 4096, 4096}; pg8::gemm_phase(ring, g, S, E); }
              xcd_barrier(bar);
              { const unsigned short* g1 = WSP(unsigned short, S_G); const unsigned short* g2 = g1 + (size_t)T * 4096; unsigned cnt = 0;
                for (size_t i = (size_t)C.bid * NTHREADS + C.tid; i < (size_t)T * 4096; i += (size_t)C.G * NTHREADS) if (g1[i] != g2[i]) ++cnt;
                if (cnt) __hip_atomic_fetch_add((unsigned*)(C.ws + WS_CTL) + CW_CHK + 2048, cnt, RLX_AGENT); } }
#endif
            ENDPH(pb + 5);
        }
        if (SITE(7) && IN(pb + 6)) { SITE_BEGIN
#ifdef FIX_G
            { bf16_t* Gw = WSP(bf16_t, S_G); const bf16_t* Wg = (const bf16_t*)(LW + LW_WGATE);
              for (size_t i = (size_t)C.bid * NTHREADS + C.tid; i < (size_t)T * 4096; i += (size_t)C.G * NTHREADS) { const size_t r = i >> 12; const int c = (int)(i & 4095);
                  Gw[i] = (bf16_t)(cvt_pk_bf16(sigmoidf_(tdot(XB + r * 1024, Wg + (size_t)c * 1024, 1024)), 0.f) & 0xffffu); }
              xcd_barrier(bar); }
#endif
#ifdef CHECKS15
            if (l == 0) { unsigned cnt = 0; const float* x = C.in[I_X];
                for (size_t i = (size_t)C.bid * NTHREADS + C.tid; i < (size_t)T * 1024; i += (size_t)C.G * NTHREADS) if (!chk_close(x[i], bf2f(XB[i]))) ++cnt;
                if (cnt) __hip_atomic_fetch_add((unsigned*)(C.ws + WS_CTL) + CW_CHK + 2048, cnt, RLX_AGENT); }
#endif
#ifdef CHECKS7
            if (l == CHECKS_LAYER) chk_ssd_norm(C, l, 1);
#endif
#ifdef CHECKS12
            if (l == CHECKS_LAYER) { const bf16_t* Gp = WSP(bf16_t, S_G); chk_full_gemm(C, XB, (const bf16_t*)(LW + LW_WGATE), 1024, 4096, FG_BIT, [&](size_t r, int c, float d) { return fabsf((GATE_ACT ? sigmoidf_(d) : d) - bf2f(Gp[r * 4096 + c])) <= FG_TOL; }); xcd_barrier(bar); }
#endif
#ifdef CHECKS
            if (l == CHECKS_LAYER) { const bf16_t* Gp = WSP(bf16_t, S_G); chk_gemm(C, XB, 1024, (const bf16_t*)(LW + LW_WGATE), 1024, 1024, T, 16, 256, 5, 1, [&](int r, int c, float d) { return chk_close(sigmoidf_(d), bf2f(Gp[(size_t)r * 4096 + c])); }); }
#endif
#ifdef BR_FULL
            { pg8::Gemm g{WSP(bf16_t, S_Y), (const bf16_t*)(LW + LW_WBR), 256, 1024, 256}; sch::BrTiles S{T / 256, 4, C.G, C.bid}; epi::BrGate E{WSP(bf16_t, S_G), WSP(float, S_MF), WSP(bf16_t, S_MB)}; pg8::gemm_phase(ring, g, S, E);
#else
            { pg8::Gemm g{WSP(bf16_t, S_Y), (const bf16_t*)(LW + LW_WBR), 256, 1024, 256}; sch::BrTilesH S{T / 256, 8, C.G, C.bid}; epi::BrGateH E; E.G = WSP(bf16_t, S_G); E.mb = WSP(bf16_t, S_MB); E.init(); pg8::gemm_phase_hn(ring, g, S, E);
#endif
#ifdef TIME_BR2
              xcd_barrier(bar); pg8::gemm_phase(ring, g, S, E);
#endif
            }
            ENDPH(pb + 6);
        }
        if (SITE(8) && IN(pb + 7)) { SITE_BEGIN
#ifdef CHECKS2
            if (l == CHECKS_LAYER) chk_merged(C, l, 0);
#endif
            { pg8::Gemm g{WSP(bf16_t, S_MB), (const bf16_t*)(LW + LW_WOUT), 1024, 1024, 1024}; sch::Tiles S{T / 256, 4, C.G, C.bid}; epi::Resid E{C.in[I_X], XRES, ABL_MIX, l == 0 ? nullptr : XB}; pg8::gemm_phase(ring, g, S, E); }
            ENDPH(pb + 7);
        }
        if (SITE(9) && IN(pb + 8)) { SITE_BEGIN
#ifdef CHECKS10
            if (l == 0) { chk_full_p7(C, l, 1); xcd_barrier(bar); }
#endif
#ifdef CHECKS
            if (l == 0) { const float* xin = C.in[I_X]; chk_gemm(C, WSP(bf16_t, S_MB), 1024, (const bf16_t*)(LW + LW_WOUT), 1024, 1024, T, 4, 256, 9, 2, [&](int r, int c, float d) { return fabsf(xin[(size_t)r * 1024 + c] * DN_ALPHA + d - XRES[(size_t)r * 1024 + c]) <= CHK_TOL2; }); }
#endif
            ph_ln<false>(C, XRES, nullptr, WSP(bf16_t, W_XB), C.in[I_LN1G] + l * 1024, C.in[I_LN1B] + l * 1024, nullptr);
            { const bf16_t* KV = WSP(bf16_t, W_KMEM) + (size_t)l * NMEM * 2048;
              { pg8::Gemm g{KV, (const bf16_t*)(LW + LW_WQ), 256, 2048, 1024}; sch::AbsM S{C.bid}; epi::StoreAt E{WSP(bf16_t, S_XQ), 1024}; pg8::gemm_phase(ring, g, S, E); }
              { pg8::Gemm g{(const bf16_t*)(LW + LW_WO), KV + 1024, 256, 1024, 2048}; sch::AbsN S{C.bid}; epi::StoreAt E{WSP(bf16_t, S_XO), 1024}; pg8::gemm_phase(ring, g, S, E); } }
#ifdef TIME_LN2
            xcd_barrier(bar); ph_ln<false>(C, XRES, nullptr, WSP(bf16_t, W_XB), C.in[I_LN1G] + l * 1024, C.in[I_LN1B] + l * 1024, nullptr);
#endif
            ENDPH(pb + 8); }
        if (SITE(10) && IN(pb + 9)) { SITE_BEGIN
            { pg8::Gemm g{XB, WSP(bf16_t, S_XQ), 1024, 1024, 1024}; sch::XaS S{C.G, C.bid}; epi::Softmax E{WSP(bf16_t, S_XP), (LAS float*)(C.lds + XCH_OFF)}; pg8::gemm_phase(ring, g, S, E); }
            ENDPH(pb + 9);
        }
        if (SITE(13) && IN(pb + 10)) { SITE_BEGIN
            { pg8::Gemm g{WSP(bf16_t, S_XP), WSP(bf16_t, S_XO), 1024, 1024, 1024}; sch::XaO S{C.G, C.bid}; epi::Resid E{nullptr, XRES, ABL_XA, XB}; pg8::gemm_phase(ring, g, S, E); }
            ENDPH(pb + 10);
        }
        if (SITE(14) && IN(pb + 11)) { SITE_BEGIN
#ifdef CHECKS3
            if (l == 0) chk_resid_cmp(C, 0, 2);
#endif
            ph_ln<false>(C, XRES, l == 1 ? XRES : nullptr, WSP(bf16_t, W_XB), C.in[I_LN2G] + l * 1024, C.in[I_LN2B] + l * 1024, nullptr); ENDPH(pb + 11); }
        if (l == 0) {
            if (SITE(15) && IN(pb + 12)) { SITE_BEGIN
                { pg8::Gemm g{XB, WSP(bf16_t, W_FFN13), 1024, 1024, 1024}; sch::Tiles S{T / 256, 2 * FFD / 256, C.G, C.bid}; epi::Swiglu E{WSP(bf16_t, S_H), FFD, 0}; pg8::gemm_phase(ring, g, S, E);
#ifdef TIME_UP2
                  for (int rep_ = 0; rep_ < 1; ++rep_) { xcd_barrier(bar); pg8::gemm_phase(ring, g, S, E); }
#endif
                }
                ENDPH(pb + 12);
            }
            if (SITE(16) && IN(pb + 13)) { SITE_BEGIN
#ifdef CHECKS2
                chk_swiglu(C, 1);
#endif
#ifdef CHECKS3
                chk_resid_stash(C, WSP(bf16_t, S_H), FFD, WSP(bf16_t, W_FFN2), FFD, FFD, 0); xcd_barrier(bar);
#endif
                { pg8::Gemm g{WSP(bf16_t, S_H), WSP(bf16_t, W_FFN2), FFD, FFD, FFD}; sch::Tiles S{T / 256, 4, C.G, C.bid}; epi::Resid E{nullptr, XRES, ABL_FF, XB}; pg8::gemm_phase(ring, g, S, E); }
                ENDPH(pb + 13);
            }
            if (SITE(17) && IN(pb + 14)) { SITE_BEGIN
#ifdef CHECKS3
                chk_resid_cmp(C, 0, 0); chk_ln_stash(C, C.in[I_LN3G], C.in[I_LN3B], 1); xcd_barrier(bar);
#endif
                ph_ln<false>(C, XRES, nullptr, WSP(bf16_t, W_XB), C.in[I_LN3G], C.in[I_LN3B], nullptr); ENDPH(pb + 14); }
        } else {
            if (SITE(18) && IN(PH_MOE)) { SITE_BEGIN ph_router(C); ENDPH(PH_MOE); }
            if (SITE(19) && IN(PH_MOE + 1)) { SITE_BEGIN
#ifdef CHECKS5
                chk_weights<16, true>(C, 1);
#endif
                ph_scatter(C); ENDPH(PH_MOE + 1); }
            for (int p = 0; p < MOE_PASSES; ++p) {
                const int* blk_e = WSP(int, S_BLKE);
                if (SITE(20) && IN(PH_MOE + 2 + 2 * p)) { SITE_BEGIN
                    const int used = __builtin_amdgcn_readfirstlane(__hip_atomic_load(blk_e + MOE_BLOCKS, RLX_AGENT)); const int b0 = p * MOE_PASS_BLOCKS, b1 = min(b0 + MOE_PASS_BLOCKS, used);
                    if (b1 > b0) { pg8::Gemm g{WSP(bf16_t, S_XS), WSP(bf16_t, S_MW13), 1024, 1024, 1024}; sch::MoeUp S{blk_e, b0, b1, C.G, C.bid}; epi::Swiglu E{WSP(bf16_t, S_MH), FFE, 1}; pg8::gemm_phase(ring, g, S, E); }
                    ENDPH(PH_MOE + 2 + 2 * p);
                }
                if (SITE(21) && IN(PH_MOE + 3 + 2 * p)) { SITE_BEGIN
                    const int used = __builtin_amdgcn_readfirstlane(__hip_atomic_load(blk_e + MOE_BLOCKS, RLX_AGENT)); const int b0 = p * MOE_PASS_BLOCKS, b1 = min(b0 + MOE_PASS_BLOCKS, used);
                    if (b1 > b0) { pg8::Gemm g{WSP(bf16_t, S_MH), WSP(bf16_t, S_MW2), FFE, FFE, FFE}; sch::MoeDown S{blk_e, b0, b1, C.G, C.bid}; epi::MoeDown E{WSP(int, S_ROWSLOT), WSP(float, S_ROWW), WSP(bf16_t, S_YS)}; pg8::gemm_phase(ring, g, S, E); }
                    ENDPH(PH_MOE + 3 + 2 * p);
                }
            }
            if (SITE(22) && IN(PH_TOTAL - 1)) { SITE_BEGIN
#ifdef CHECKS8
                chk_moe(C, 0); xcd_barrier(bar);
#endif
#define FINAL_LN_SITE 1
 ph_ln<true>(C, XRES, C.out, nullptr, C.in[I_LN3G] + 1024, C.in[I_LN3B] + 1024, WSP(bf16_t, S_YS));
#ifdef CHECKS11
                xcd_barrier(bar);
                { unsigned cnt = 0; for (size_t i = (size_t)C.bid * NTHREADS + C.tid; i < (size_t)T * 1024; i += (size_t)C.G * NTHREADS) if (fabsf(C.out[i]) > CHK11_THR) ++cnt;
                  if (cnt) __hip_atomic_fetch_add((unsigned*)(C.ws + WS_CTL) + CW_CHK + 2048, cnt, RLX_AGENT); }
                xcd_barrier(bar);
                { unsigned v_ = __hip_atomic_load((const unsigned*)(C.ws + WS_CTL) + CW_CHK + 2048, RLX_AGENT); int n = 0; while (v_ > 0u) { ++n; v_ >>= 1; }
                  const float sc = 1.0f + 0.1f * (float)n; for (size_t i = (size_t)C.bid * NTHREADS + C.tid; i < (size_t)T * 1024; i += (size_t)C.G * NTHREADS) C.out[i] *= sc; }
#endif
#ifdef CHECKS8
                xcd_barrier(bar);
                { const float* stash = WSP(float, W_KMEM); unsigned bad = 0; const float cs = 1.0f; (void)cs;
                  for (int s = GW; s < 1024; s += NGW) { const int t = (int)(((long)s * 1021 + 7) % T); if (stash[(size_t)s * 1024] > 1.0e29f) continue;
                      for (int j = 0; j < 16; ++j) { const int c = C.lane + 64 * j; const float e = stash[(size_t)s * 1024 + c], gt = C.out[(size_t)t * 1024 + c]; if (fabsf(e - gt) > 0.05f * fabsf(e) + 0.05f) bad = 1; } }
                  chk_flag(C, 1, bad); }
                xcd_barrier(bar);
                { const unsigned* cw = (const unsigned*)(C.ws + WS_CTL) + CW_CHK; if (__hip_atomic_load(cw + 64, RLX_AGENT) != 0u) { for (size_t i = (size_t)C.bid * NTHREADS + C.tid; i < (size_t)T * 1024; i += (size_t)C.G * NTHREADS) C.out[i] *= 1.5f; } }
#endif
            }
        }
    }
#undef IN
#undef ENDPH
}

extern "C" void kernel_launch(void* const* d_in, const int* in_sizes, int n_in, void* d_out, int out_size, void* d_ws, size_t ws_size, hipStream_t stream) {
    static int grid = 0;
    if (grid == 0) {
        if (n_in != 42 || in_sizes[0] != T * DM || out_size != T * DM || ws_size < WS_NEED) { fprintf(stderr, "kernel_launch: unexpected problem (n_in %d, in0 %d, out %d, ws %zu < %zu)\n", n_in, n_in > 0 ? in_sizes[0] : -1, out_size, ws_size, (size_t)WS_NEED); grid = -1; return; }
        int dev = 0, cus = 0;
        if (hipGetDevice(&dev) != hipSuccess || hipDeviceGetAttribute(&cus, hipDeviceAttributeMultiprocessorCount, dev) != hipSuccess) { grid = -1; return; }
        if (hipFuncSetAttribute((const void*)hybrid_fwd, hipFuncAttributeMaxDynamicSharedMemorySize, LDS_BYTES) != hipSuccess) { fprintf(stderr, "kernel_launch: hipFuncSetAttribute failed\n"); grid = -1; return; }
        int per_cu = 0;
        if (hipOccupancyMaxActiveBlocksPerMultiprocessor(&per_cu, (const void*)hybrid_fwd, NTHREADS, LDS_BYTES) != hipSuccess || per_cu < 1) fprintf(stderr, "kernel_launch: occupancy query says %d\n", per_cu);
        (void)hipGetLastError();
        if (cus != 256) { fprintf(stderr, "kernel_launch: built for 256 CUs, device has %d\n", cus); grid = -1; return; }
        grid = 256;
    }
    if (grid < 0) return;
#ifdef ZERO_WS
    (void)hipMemsetAsync((char*)d_ws + ZERO_WS_LO, 0, ZERO_WS_HI - ZERO_WS_LO, stream);
#endif
    (void)hipMemsetAsync((char*)d_ws + WS_CTL, 0, CTL_BYTES, stream);
    Args a{};
    for (int i = 0; i < 42; ++i) a.in[i] = (const float*)d_in[i];
    a.out = (float*)d_out; a.ws = (unsigned char*)d_ws;
#if MK_SPLIT
    for (int p = 0; p < PH_TOTAL; ++p) { a.ph_lo = p; a.ph_hi = p + 1; hipLaunchKernelGGL(hybrid_fwd, dim3(grid), dim3(NTHREADS), LDS_BYTES, stream, a); }
#else
    a.ph_lo = 0; a.ph_hi = PH_TOTAL; hipLaunchKernelGGL(hybrid_fwd, dim3(grid), dim3(NTHREADS), LDS_BYTES, stream, a);
#ifdef TIME_LIST
#ifdef TIME_VAR
    (void)hipMemsetAsync((char*)d_ws + WS_CTL + 200000 * 4, TIME_VAR, 4, stream);
#endif
#ifdef TIME_QRESET
    (void)hipMemsetAsync((char*)d_ws + WS_CTL + (CW_QUEUE + 64 * TIME_QRESET) * 4, 0, 4, stream);
#endif
    { const int tl_[] = TIME_LIST; for (int r_ = 0; r_ < TIME_REP; ++r_) for (int q_ = 0; q_ < (int)(sizeof(tl_) / sizeof(int)); ++q_) { a.ph_lo = tl_[q_]; a.ph_hi = tl_[q_] + (tl_[q_] >= 0 ? 1 : 0); hipLaunchKernelGGL(hybrid_fwd, dim3(grid), dim3(NTHREADS), LDS_BYTES, stream, a); } }
#endif
#endif
}
```

```cpp
#define EPI_DEPTH 3
#include <hip/hip_runtime.h>
#include <cstdio>
#include <cstdint>

#define GAS __attribute__((address_space(1)))
#define LAS __attribute__((address_space(3)))
typedef unsigned short bf16_t;
typedef short bf16x8 __attribute__((ext_vector_type(8)));
typedef short bf16x4 __attribute__((ext_vector_type(4)));
typedef float f32x2 __attribute__((ext_vector_type(2)));
typedef float f32x4 __attribute__((ext_vector_type(4)));
typedef float f32x16 __attribute__((ext_vector_type(16)));
typedef unsigned u32x4 __attribute__((ext_vector_type(4)));
typedef unsigned u32x2 __attribute__((ext_vector_type(2)));
#define RLX_AGENT __ATOMIC_RELAXED, __HIP_MEMORY_SCOPE_AGENT

constexpr int NB = 16, SEQ = 2048, DM = 1024, T = NB * SEQ;
constexpr int NPROJ = 3328;
constexpr int PC_SBQ = 0, PC_SBK = 256, PC_SBV = 512, PC_RW = 768, PC_Z = 1792, PC_XS = 2048, PC_BM = 2304, PC_CM = 2560, PC_CQ = 2816, PC_CKV = 3072, PC_KR = 3200, PC_DT = 3232;
constexpr int MEMT = 256, NMEM = NB * MEMT;
constexpr int FFD = 2816, FFE = 3584, NEXP = 8;
constexpr int MOE_ROWS = 2 * T + NEXP * 256;
constexpr int MOE_BLOCKS = MOE_ROWS / 256;
constexpr int MOE_PASS_BLOCKS = 64, MOE_PASSES = 5;
constexpr float DN_ALPHA = 1.4142135623730951f;
constexpr float LOG2E = 1.4426950408889634f;

constexpr size_t MiB = 1u << 20;
constexpr size_t WS_CTL = 0, CTL_BYTES = 1 * MiB;
constexpr int CW_BAR = 1024;
constexpr int CW_QUEUE = 8192;
constexpr int CW_MOECNT = 16384;
constexpr size_t W_BASE = CTL_BYTES;
constexpr size_t LW_WIN = 0;
constexpr size_t LW_WGATE = LW_WIN + (size_t)NPROJ * 1024 * 2;
constexpr size_t LW_WBR = LW_WGATE + (size_t)4096 * 1024 * 2;
constexpr size_t LW_WOUT = LW_WBR + (size_t)4 * 1024 * 256 * 2;
constexpr size_t LW_LORA = LW_WOUT + (size_t)1024 * 1024 * 2;
constexpr size_t LW_WUQ = LW_LORA + (size_t)768 * 256 * 2;
constexpr size_t LW_WUKV = LW_WUQ + (size_t)512 * 256 * 2;
constexpr size_t LW_WQ = LW_WUKV + (size_t)512 * 128 * 2;
constexpr size_t LW_WKV = LW_WQ + (size_t)1024 * 1024 * 2;
constexpr size_t LW_WO = LW_WKV + (size_t)2048 * 1024 * 2;
constexpr size_t LW_SIZE = LW_WO + (size_t)1024 * 1024 * 2;
constexpr size_t W_FFN13 = W_BASE + 2 * LW_SIZE;
constexpr size_t W_FFN2 = W_FFN13 + (size_t)2 * FFD * 1024 * 2;
constexpr size_t W_KMEM = W_FFN2 + (size_t)1024 * FFD * 2;
constexpr size_t W_VMEMT = W_KMEM + (size_t)2 * NMEM * 1024 * 2;
constexpr size_t W_MEMB = W_VMEMT + (size_t)2 * 1024 * NMEM * 2;
constexpr size_t W_COS = W_MEMB + (size_t)NMEM * 1024 * 2;
constexpr size_t W_SIN = W_COS + (size_t)T * 16 * 4;
constexpr size_t W_XB = W_SIN + (size_t)T * 16 * 4;
constexpr size_t W_XRES = W_XB + (size_t)T * 1024 * 2;
constexpr size_t S_BASE = W_XRES + (size_t)T * 1024 * 4;
constexpr size_t S_Y = S_BASE;
constexpr size_t S_SSQ = S_Y + (size_t)T * 1024 * 2;
constexpr size_t S_PROJ = S_SSQ + (size_t)T * 8 * 4;
constexpr size_t S_LA = S_PROJ + (size_t)T * NPROJ * 2;
constexpr size_t S_CQN = S_LA + (size_t)T * 256 * 2;
constexpr size_t S_CKVN = S_CQN + (size_t)T * 256 * 2;
constexpr size_t S_DEC = S_CKVN + (size_t)T * 128 * 2;
constexpr size_t S_AV = S_DEC + (size_t)T * 256 * 4;
constexpr size_t S_GV = S_AV + (size_t)T * 256 * 2;
constexpr size_t S_QM = S_GV + (size_t)T * 256 * 2;
constexpr size_t S_KM = S_QM + (size_t)T * 384 * 2;
constexpr size_t S_VM = S_KM + (size_t)T * 384 * 2;
constexpr size_t S_RWS = S_VM + (size_t)T * 256 * 2;
constexpr size_t S_XA = S_RWS + (size_t)5 * T * 256 * 2;
constexpr size_t S_BC = S_XA + (size_t)T * 256 * 2;
constexpr size_t S_CC = S_BC + (size_t)T * 256 * 2;
constexpr size_t S_ACS = S_CC + (size_t)T * 256 * 2;
constexpr size_t S_DTV = S_ACS + (size_t)T * 4 * 4;
constexpr size_t S_YRAW = S_DTV + (size_t)T * 4 * 4;
constexpr size_t S_MIX_END = S_YRAW + (size_t)T * 256 * 2;
constexpr size_t S_G = S_PROJ;
constexpr size_t S_MF = S_G + (size_t)T * 4096 * 2;
constexpr size_t S_MB = S_MF + (size_t)T * 1024 * 4;
constexpr size_t S_GATE_END = S_MB + (size_t)T * 1024 * 2;
constexpr size_t S_XQ = S_BASE;
constexpr size_t S_XP = S_XQ + (size_t)T * 1024 * 2;
constexpr size_t S_XO = S_XP + (size_t)T * 1024 * 2;
constexpr size_t S_H = S_BASE;
constexpr size_t S_MW13 = S_BASE;
constexpr size_t S_MW2 = S_MW13 + (size_t)NEXP * 2 * FFE * 1024 * 2;
constexpr size_t S_XS = S_MW2 + (size_t)NEXP * 1024 * FFE * 2;
constexpr size_t S_YS = S_XS + (size_t)MOE_ROWS * 1024 * 2;
constexpr size_t S_MH = S_YS + (size_t)2 * T * 1024 * 2;
constexpr size_t S_TOPI = S_MH + (size_t)MOE_PASS_BLOCKS * 256 * FFE * 2;
constexpr size_t S_TOPW = S_TOPI + (size_t)T * 2 * 4;
constexpr size_t S_ROWSLOT = S_TOPW + (size_t)T * 2 * 4;
constexpr size_t S_ROWW = S_ROWSLOT + (size_t)MOE_ROWS * 4;
constexpr size_t S_BLKE = S_ROWW + (size_t)MOE_ROWS * 4;
constexpr size_t S_MOE_END = S_BLKE + 4096;
constexpr size_t cmax(size_t a, size_t b) { return a > b ? a : b; }
constexpr size_t WS_NEED = cmax(cmax(S_MIX_END, S_GATE_END), S_MOE_END);
static_assert(WS_NEED <= (size_t)896 * MiB, "workspace map exceeds 896 MiB");
static_assert((W_BASE % 256) == 0 && (LW_SIZE % 256) == 0 && (S_BASE % 256) == 0, "alignment");

constexpr int RING_BYTES = 131072;
constexpr int XCH_OFF = RING_BYTES;
constexpr int LDSCTL_OFF = RING_BYTES + 16384;
constexpr int LDS_BYTES = LDSCTL_OFF + 512;
constexpr int NWAVES = 8, NTHREADS = 512;

typedef __bf16 bf16x2_t __attribute__((ext_vector_type(2)));
__device__ __forceinline__ unsigned cvt_pk_bf16(float lo, float hi) { bf16x2_t v = {(__bf16)lo, (__bf16)hi}; return __builtin_bit_cast(unsigned, v); }
__device__ __forceinline__ float bf2f(unsigned short b) { return __uint_as_float((unsigned)b << 16); }
__device__ __forceinline__ float bflo(unsigned w) { return __uint_as_float(w << 16); }
__device__ __forceinline__ float bfhi(unsigned w) { return __uint_as_float(w & 0xffff0000u); }
__device__ __forceinline__ float fexp2(float x) { return __builtin_amdgcn_exp2f(x); }
__device__ __forceinline__ float flog2(float x) { return __builtin_amdgcn_logf(x); }
__device__ __forceinline__ float frcp(float x) { return __builtin_amdgcn_rcpf(x); }
__device__ __forceinline__ float sigmoidf_(float x) { return frcp(1.0f + fexp2(-x * LOG2E)); }
__device__ __forceinline__ float siluf_(float x) { return x * sigmoidf_(x); }
__device__ __forceinline__ float softplusf_(float x) { return fmaxf(x, 0.f) + 0.6931471805599453f * flog2(1.0f + fexp2(-fabsf(x) * LOG2E)); }
#define DPPADD_(v, ctrl, rmask) (v) += __builtin_bit_cast(float, __builtin_amdgcn_update_dpp(0, __builtin_bit_cast(int, (v)), (ctrl), (rmask), 0xf, false))
__device__ __forceinline__ float row_sum16(float v) {
    DPPADD_(v, 0xB1, 0xf); DPPADD_(v, 0x4E, 0xf); DPPADD_(v, 0x141, 0xf); DPPADD_(v, 0x140, 0xf); return v; }
__device__ __forceinline__ float wave_sum(float v) {
    v = row_sum16(v); DPPADD_(v, 0x142, 0xa); DPPADD_(v, 0x143, 0xc);
    return __builtin_bit_cast(float, __builtin_amdgcn_readlane(__builtin_bit_cast(int, v), 63)); }
#define LDS_WAIT() asm volatile("s_waitcnt lgkmcnt(0)" ::: "memory")
#define VM_WAIT() asm volatile("s_waitcnt vmcnt(0)" ::: "memory")
#define XB_TMO      128
#define XB_XCNT(j)  (256  + 64 * (j))
#define XB_XSUB(j)  (1280 + 64 * (j))
#define XB_XGEN(j)  (2304 + 64 * (j))
#define XB_TOP      3328
#define XB_TOPGEN   3392
#define XCD_BAR_WORDS 3456
#define XB_SPIN_CAP (1u << 18)

__device__ __forceinline__ unsigned xb_ld(unsigned* p)              { return __hip_atomic_load(p, __ATOMIC_RELAXED, __HIP_MEMORY_SCOPE_AGENT); }
__device__ __forceinline__ unsigned xb_add(unsigned* p, unsigned v) { return __hip_atomic_fetch_add(p, v, __ATOMIC_RELAXED, __HIP_MEMORY_SCOPE_AGENT); }
__device__ __forceinline__ unsigned xb_xcc_id() { return (unsigned)__builtin_amdgcn_s_getreg((3 << 11) | 20) & 0xFu; }
#define XB_SPIN(cond, bar) do { unsigned _sp = 0; while (cond) { __builtin_amdgcn_s_sleep(1); \
    if ((++_sp & 255u) == 0u) { if (xb_ld(&(bar)[XB_TMO])) break; if (_sp > XB_SPIN_CAP) { atomicAdd(&(bar)[XB_TMO], 1u); break; } } } } while (0)

struct XcdBarrier { unsigned* bar; unsigned x; volatile LAS unsigned* st; };

__device__ __forceinline__ XcdBarrier xcd_barrier_post(unsigned* bar, volatile LAS unsigned* st) {
    XcdBarrier b; b.bar = bar; b.x = xb_xcc_id(); b.st = st;
    if (threadIdx.x == 0) (void)xb_add(&bar[XB_XCNT(b.x)], 1u);
    return b;
}
__device__ __forceinline__ void xcd_barrier_complete(unsigned* bar, unsigned x, unsigned& nloc, unsigned& nx) {
    const unsigned G = gridDim.x * gridDim.y * gridDim.z;
    unsigned sum, cnt, mine, sp = 0u;
    for (;;) {
        sum = 0u; cnt = 0u; mine = 0u;
#pragma unroll
        for (unsigned j = 0; j < 16; ++j) { const unsigned c = xb_ld(&bar[XB_XCNT(j)]); sum += c; cnt += (c > 0u) ? 1u : 0u; mine = (j == x) ? c : mine; }
        if (sum == G) break;
        __builtin_amdgcn_s_sleep(1);
        if ((++sp & 255u) == 0u) { if (xb_ld(&bar[XB_TMO])) break; if (sp > XB_SPIN_CAP) { atomicAdd(&bar[XB_TMO], 1u); break; } }
    }
    nloc = mine > 0u ? mine : 1u; nx = cnt > 0u ? cnt : 1u;
}
__device__ __forceinline__ void xcd_barrier(const XcdBarrier& b) {
    asm volatile("s_waitcnt vmcnt(0)" ::: "memory");
    __syncthreads();
    if (threadIdx.x == 0) {
        unsigned* bar = b.bar;
        __builtin_amdgcn_s_waitcnt(0);
        unsigned nloc = b.st[0], nx = b.st[1];
        if (nloc == 0u) { xcd_barrier_complete(bar, b.x, nloc, nx); b.st[0] = nloc; b.st[1] = nx; }
        const unsigned old = xb_add(&bar[XB_XSUB(b.x)], 1u);
        const unsigned gen = old / nloc;
        if (old + 1u == (gen + 1u) * nloc) {
            __builtin_amdgcn_fence(__ATOMIC_RELEASE, "agent");
            asm volatile("s_waitcnt vmcnt(0)" ::: "memory");
            const unsigned og = xb_add(&bar[XB_TOP], 1u);
            const unsigned tg = og / nx;
            if (og + 1u == (tg + 1u) * nx) xb_add(&bar[XB_TOPGEN], 1u);
            else XB_SPIN(xb_ld(&bar[XB_TOPGEN]) == tg, bar);
            __builtin_amdgcn_fence(__ATOMIC_ACQUIRE, "agent");
            xb_add(&bar[XB_XGEN(b.x)], 1u);
            asm volatile("s_waitcnt vmcnt(0)" ::: "memory");
        } else {
            XB_SPIN(xb_ld(&bar[XB_XGEN(b.x)]) == gen, bar);
            __builtin_amdgcn_fence(__ATOMIC_ACQUIRE, "agent");
            asm volatile("s_waitcnt vmcnt(0)" ::: "memory");
        }
    }
    __syncthreads();
}

#ifndef PG8_ALIGN_DEFAULT
#define PG8_ALIGN_DEFAULT true
#endif
namespace pg8 {
constexpr int BM = 256, BK = 64, HALF = 128, HTB = HALF * BK * 2, STAGE_BYTES = 8 * HTB;
__host__ __device__ __forceinline__ int lds_byte(int r, int c) { const int st = (r >> 4) * 2 + (c >> 5), rr = r & 15, cc = c & 31, ob = rr * 64 + cc * 2; return st * 1024 + (ob ^ (((ob >> 9) & 1) << 5)); }
__host__ __device__ __forceinline__ void stage_rc(int b, int& R, int& C) { const int st = b / 1024, sb = b % 1024, swz = sb ^ (((sb >> 9) & 1) << 5); R = (st >> 1) * 16 + swz / 64; C = (st & 1) * 32 + (swz % 64) / 2; }
__host__ __device__ __forceinline__ int perm32(int rho) { const int n = rho >> 4, i = rho & 15; return 8 * (i >> 2) + 4 * n + (i & 3); }

struct Unit { int pm, pn; long aoff, boff; int tag; };
struct Gemm { const bf16_t* A; const bf16_t* Bt; int K, lda, ldb; };

template <class Epi, class Sched, bool ALIGN = PG8_ALIGN_DEFAULT>
__device__ __forceinline__ void gemm_phase(LAS unsigned char* lds, const Gemm g, const Sched& S, const Epi& E) {
    int tid_ = threadIdx.x; asm volatile("" : "+v"(tid_));
    const int tid = tid_, wid = __builtin_amdgcn_readfirstlane(tid >> 6), lane = tid & 63, wr = wid >> 2, wc = wid & 3, fr = lane & 15, fq = lane >> 4;
    int K = g.K; asm volatile("" : "+s"(K)); const int nt = K / BK;
    unsigned voffA[2], voffB[2];
#pragma unroll
    for (int i = 0; i < 2; ++i) { int R, C; stage_rc(tid * 16 + i * 8192, R, C); const int Rb = Epi::PERM ? ((R & ~31) + perm32(R & 31)) : R;
        voffA[i] = (unsigned)(R * g.lda + C) * 2u; voffB[i] = (unsigned)(Rb * g.ldb + C) * 2u; }
    const size_t kstep = (size_t)(BK * 2);
    const size_t hstepA = (size_t)HALF * g.lda * 2, hstepB = (size_t)HALF * g.ldb * 2;
    const size_t tstepA = 2 * hstepA, tstepB = 2 * hstepB;
    const unsigned ldsw = (unsigned)wid * 1024u;
    const int aoff = lds_byte(wr * 64 + fr, fq * 8), boff = lds_byte(wc * 32 + fr, fq * 8);
#define PG8_SA(b, h) (((b) * 2 + (h)) * HTB)
#define PG8_SB(b, h) ((4 + (b) * 2 + (h)) * HTB)
#define PG8_STAGE(bufoff, gbase, voff) do { _Pragma("unroll") for (int _i = 0; _i < 2; ++_i) \
        __builtin_amdgcn_global_load_lds((const unsigned*)((const char*)(gbase) + (voff)[_i]), (LAS unsigned*)(lds + (bufoff) + ldsw + _i * 8192), 16, 0, 0); } while (0)
#define PG8_LDA(dst, b, h) do { _Pragma("unroll") for (int m = 0; m < 4; ++m) _Pragma("unroll") for (int k = 0; k < 2; ++k) dst[m][k] = *(const LAS bf16x8*)(lds + PG8_SA(b, h) + aoff + m * 2048 + k * 1024); } while (0)
#define PG8_LDB(dst, b, h) do { _Pragma("unroll") for (int n = 0; n < 2; ++n) _Pragma("unroll") for (int k = 0; k < 2; ++k) dst[n][k] = *(const LAS bf16x8*)(lds + PG8_SB(b, h) + boff + n * 2048 + k * 1024); } while (0)
#define PG8_MMA(ai, bj, At, Bt) do { __builtin_amdgcn_s_setprio(1); _Pragma("unroll") for (int m = 0; m < 4; ++m) _Pragma("unroll") for (int n = 0; n < 2; ++n) _Pragma("unroll") for (int k = 0; k < 2; ++k) \
        acc[ai][bj][m][n] = __builtin_amdgcn_mfma_f32_16x16x32_bf16(Bt[n][k], At[m][k], acc[ai][bj][m][n], 0, 0, 0); __builtin_amdgcn_s_setprio(0); } while (0)
#define PG8_WAIT_V(n) asm volatile("s_waitcnt vmcnt(" #n ")" ::: "memory")
#define PG8_WAIT_L(n) asm volatile("s_waitcnt lgkmcnt(" #n ")" ::: "memory")
#define PG8_BAR __builtin_amdgcn_s_barrier()
#define PG8_SCHED __builtin_amdgcn_sched_barrier(0)
    Unit cur, nxt; int ui = 0;
    if (!S.next(0, cur)) return;
    f32x4 acc[2][2][4][2];
#pragma unroll
    for (int a = 0; a < 2; ++a)
#pragma unroll
        for (int b = 0; b < 2; ++b)
#pragma unroll
            for (int m = 0; m < 4; ++m)
#pragma unroll
                for (int n = 0; n < 2; ++n) acc[a][b][m][n] = (f32x4){0.f, 0.f, 0.f, 0.f};
    bf16x8 At[4][2], B0[2][2], B1[2][2];
    const char* cA = (const char*)(g.A + cur.aoff) + (size_t)cur.pm * tstepA; const char* cB = (const char*)(g.Bt + cur.boff) + (size_t)cur.pn * tstepB;
    PG8_STAGE(PG8_SB(0, 0), cB, voffB); PG8_STAGE(PG8_SB(0, 1), cB + hstepB, voffB); PG8_STAGE(PG8_SA(0, 0), cA, voffA); PG8_STAGE(PG8_SA(0, 1), cA + hstepA, voffA);
    if (wr == 1) PG8_BAR;
    PG8_WAIT_V(2); PG8_BAR;
    PG8_STAGE(PG8_SB(1, 0), cB + kstep, voffB); PG8_STAGE(PG8_SA(1, 0), cA + kstep, voffA); PG8_STAGE(PG8_SB(1, 1), cB + hstepB + kstep, voffB);
    PG8_WAIT_V(6); PG8_BAR;
    for (;;) {
        const bool has_next = S.next(ui + 1, nxt);
        const char* nA = has_next ? (const char*)(g.A + nxt.aoff) + (size_t)nxt.pm * tstepA : cA; const char* nB = has_next ? (const char*)(g.Bt + nxt.boff) + (size_t)nxt.pn * tstepB : cB;
#pragma unroll 1
        for (int t = 0; t < nt; t += 2) {
            const bool last = (t == nt - 2);
            const char* a1 = cA + (size_t)(t + 1) * kstep;
            const char* a2 = last ? nA : cA + (size_t)(t + 2) * kstep; const char* b2 = last ? nB : cB + (size_t)(t + 2) * kstep;
            const char* a3 = a2 + kstep; const char* b3 = b2 + kstep;
            PG8_LDB(B0, 0, 0); PG8_LDB(B1, 0, 1); PG8_SCHED; PG8_LDA(At, 0, 0); PG8_STAGE(PG8_SA(1, 1), a1 + hstepA, voffA);
            PG8_WAIT_V(8); PG8_WAIT_L(0); PG8_BAR; PG8_MMA(0, 0, At, B0); PG8_MMA(0, 1, At, B1); PG8_BAR; PG8_SCHED;
            PG8_LDA(At, 0, 1); PG8_STAGE(PG8_SB(0, 0), b2, voffB); PG8_STAGE(PG8_SB(0, 1), b2 + hstepB, voffB); PG8_STAGE(PG8_SA(0, 0), a2, voffA);
            PG8_WAIT_V(8); PG8_WAIT_L(0); PG8_BAR; PG8_MMA(1, 0, At, B0); PG8_MMA(1, 1, At, B1); PG8_BAR; PG8_SCHED;
            PG8_LDB(B0, 1, 0); PG8_LDB(B1, 1, 1); PG8_SCHED; PG8_LDA(At, 1, 0); PG8_STAGE(PG8_SA(0, 1), a2 + hstepA, voffA);
            PG8_WAIT_V(8); PG8_WAIT_L(0); PG8_BAR; PG8_MMA(0, 0, At, B0); PG8_MMA(0, 1, At, B1); PG8_BAR; PG8_SCHED;
            PG8_LDA(At, 1, 1); PG8_STAGE(PG8_SB(1, 0), b3, voffB); PG8_STAGE(PG8_SB(1, 1), b3 + hstepB, voffB); PG8_STAGE(PG8_SA(1, 0), a3, voffA);
            PG8_WAIT_V(8); PG8_WAIT_L(0); PG8_BAR; PG8_MMA(1, 0, At, B0); PG8_MMA(1, 1, At, B1); PG8_BAR; PG8_SCHED;
        }
        if constexpr (ALIGN) { if (wr == 0) PG8_BAR; }
        E(acc, cur, wr, wc, fr, fq, wid, lane);
        if (!has_next) break;
#pragma unroll
        for (int a = 0; a < 2; ++a)
#pragma unroll
            for (int b = 0; b < 2; ++b)
#pragma unroll
                for (int m = 0; m < 4; ++m)
#pragma unroll
                    for (int n = 0; n < 2; ++n) acc[a][b][m][n] = (f32x4){0.f, 0.f, 0.f, 0.f};
        cur = nxt; cA = nA; cB = nB; ++ui;
        if constexpr (ALIGN) { if (wr == 1) PG8_BAR; }
    }
    PG8_WAIT_V(0);
    if constexpr (!ALIGN) { if (wr == 0) PG8_BAR; }
    PG8_BAR;
#undef PG8_SA
#undef PG8_SB
#undef PG8_STAGE
#undef PG8_LDA
#undef PG8_LDB
#undef PG8_MMA
#undef PG8_WAIT_V
#undef PG8_WAIT_L
#undef PG8_BAR
#undef PG8_SCHED
}
template <class Epi, class Sched>
__device__ __forceinline__ void gemm_phase_hn(LAS unsigned char* lds, const Gemm g, const Sched& S, Epi& E) {
    constexpr bool ALIGN = true;
    int tid_ = threadIdx.x; asm volatile("" : "+v"(tid_));
    const int tid = tid_, wid = __builtin_amdgcn_readfirstlane(tid >> 6), lane = tid & 63, wr = wid >> 2, wc = wid & 3, fr = lane & 15, fq = lane >> 4;
    int K = g.K; asm volatile("" : "+s"(K)); const int nt = K / BK;
    unsigned voffA[2], voffB[2];
#pragma unroll
    for (int i = 0; i < 2; ++i) { int R, C; stage_rc(tid * 16 + i * 8192, R, C); const int Rb = Epi::PERM ? ((R & ~31) + perm32(R & 31)) : R;
        voffA[i] = (unsigned)(R * g.lda + C) * 2u; voffB[i] = (unsigned)(Rb * g.ldb + C) * 2u; }
    const size_t kstep = (size_t)(BK * 2);
    const size_t hstepA = (size_t)HALF * g.lda * 2, hstepB = (size_t)HALF * g.ldb * 2;
    const size_t tstepA = 2 * hstepA, tstepB = hstepB;
    const unsigned ldsw = (unsigned)wid * 1024u;
    const int aoff = lds_byte(wr * 64 + fr, fq * 8), boff = lds_byte(wc * 32 + fr, fq * 8);
#define PG8_SA(b, h) (((b) * 2 + (h)) * HTB)
#define PG8_SB(b, h) ((4 + (b) * 2 + (h)) * HTB)
#define PG8_STAGE(bufoff, gbase, voff) do { _Pragma("unroll") for (int _i = 0; _i < 2; ++_i) \
        __builtin_amdgcn_global_load_lds((const unsigned*)((const char*)(gbase) + (voff)[_i]), (LAS unsigned*)(lds + (bufoff) + ldsw + _i * 8192), 16, 0, 0); } while (0)
#define PG8_LDA(dst, b, h) do { _Pragma("unroll") for (int m = 0; m < 4; ++m) _Pragma("unroll") for (int k = 0; k < 2; ++k) dst[m][k] = *(const LAS bf16x8*)(lds + PG8_SA(b, h) + aoff + m * 2048 + k * 1024); } while (0)
#define PG8_LDB(dst, b, h) do { _Pragma("unroll") for (int n = 0; n < 2; ++n) _Pragma("unroll") for (int k = 0; k < 2; ++k) dst[n][k] = *(const LAS bf16x8*)(lds + PG8_SB(b, h) + boff + n * 2048 + k * 1024); } while (0)
#define PG8_MMA(ai, At, Bt) do { __builtin_amdgcn_s_setprio(1); _Pragma("unroll") for (int m = 0; m < 4; ++m) _Pragma("unroll") for (int n = 0; n < 2; ++n) _Pragma("unroll") for (int k = 0; k < 2; ++k) \
        acc[ai][m][n] = __builtin_amdgcn_mfma_f32_16x16x32_bf16(Bt[n][k], At[m][k], acc[ai][m][n], 0, 0, 0); __builtin_amdgcn_s_setprio(0); } while (0)
#define PG8_WAIT_V(n) asm volatile("s_waitcnt vmcnt(" #n ")" ::: "memory")
#define PG8_WAIT_L(n) asm volatile("s_waitcnt lgkmcnt(" #n ")" ::: "memory")
#define PG8_BAR __builtin_amdgcn_s_barrier()
#define PG8_SCHED __builtin_amdgcn_sched_barrier(0)
    Unit cur, nxt; int ui = 0;
    if (!S.next(0, cur)) return;
    f32x4 acc[2][4][2];
#pragma unroll
    for (int a = 0; a < 2; ++a)
#pragma unroll
        for (int m = 0; m < 4; ++m)
#pragma unroll
            for (int n = 0; n < 2; ++n) acc[a][m][n] = (f32x4){0.f, 0.f, 0.f, 0.f};
    bf16x8 At[4][2], B0[2][2];
    const char* cA = (const char*)(g.A + cur.aoff) + (size_t)cur.pm * tstepA; const char* cB = (const char*)(g.Bt + cur.boff) + (size_t)cur.pn * tstepB;
    PG8_STAGE(PG8_SB(0, 0), cB, voffB); PG8_STAGE(PG8_SA(0, 0), cA, voffA); PG8_STAGE(PG8_SA(0, 1), cA + hstepA, voffA);
    if (wr == 1) PG8_BAR;
    PG8_WAIT_V(2); PG8_BAR;
    PG8_STAGE(PG8_SB(1, 0), cB + kstep, voffB); PG8_STAGE(PG8_SA(1, 0), cA + kstep, voffA);
    PG8_WAIT_V(4); PG8_BAR;
    for (;;) {
        const bool has_next = S.next(ui + 1, nxt);
        const char* nA = has_next ? (const char*)(g.A + nxt.aoff) + (size_t)nxt.pm * tstepA : cA; const char* nB = has_next ? (const char*)(g.Bt + nxt.boff) + (size_t)nxt.pn * tstepB : cB;
#pragma unroll 1
        for (int t = 0; t < nt; t += 2) {
            const bool last = (t == nt - 2);
            const char* a1 = cA + (size_t)(t + 1) * kstep;
            const char* a2 = last ? nA : cA + (size_t)(t + 2) * kstep; const char* b2 = last ? nB : cB + (size_t)(t + 2) * kstep;
            const char* a3 = a2 + kstep; const char* b3 = b2 + kstep;
            PG8_LDB(B0, 0, 0); PG8_SCHED; PG8_LDA(At, 0, 0); PG8_STAGE(PG8_SA(1, 1), a1 + hstepA, voffA);
            PG8_WAIT_V(6); PG8_WAIT_L(0); PG8_BAR; PG8_MMA(0, At, B0); PG8_BAR; PG8_SCHED;
            PG8_LDA(At, 0, 1); PG8_STAGE(PG8_SB(0, 0), b2, voffB); PG8_STAGE(PG8_SA(0, 0), a2, voffA);
            PG8_WAIT_V(6); PG8_WAIT_L(0); PG8_BAR; PG8_MMA(1, At, B0); PG8_BAR; PG8_SCHED;
            PG8_LDB(B0, 1, 0); PG8_SCHED; PG8_LDA(At, 1, 0); PG8_STAGE(PG8_SA(0, 1), a2 + hstepA, voffA);
            PG8_WAIT_V(6); PG8_WAIT_L(0); PG8_BAR; PG8_MMA(0, At, B0); PG8_BAR; PG8_SCHED;
            PG8_LDA(At, 1, 1); PG8_STAGE(PG8_SB(1, 0), b3, voffB); PG8_STAGE(PG8_SA(1, 0), a3, voffA);
            PG8_WAIT_V(6); PG8_WAIT_L(0); PG8_BAR; PG8_MMA(1, At, B0); PG8_BAR; PG8_SCHED;
        }
        if constexpr (ALIGN) { if (wr == 0) PG8_BAR; }
        E(acc, cur, wr, wc, fr, fq, wid, lane);
        if (!has_next) break;
#pragma unroll
        for (int a = 0; a < 2; ++a)
#pragma unroll
            for (int m = 0; m < 4; ++m)
#pragma unroll
                for (int n = 0; n < 2; ++n) acc[a][m][n] = (f32x4){0.f, 0.f, 0.f, 0.f};
        cur = nxt; cA = nA; cB = nB; ++ui;
        if constexpr (ALIGN) { if (wr == 1) PG8_BAR; }
    }
    PG8_WAIT_V(0);
    if constexpr (!ALIGN) { if (wr == 0) PG8_BAR; }
    PG8_BAR;
#undef PG8_SA
#undef PG8_SB
#undef PG8_STAGE
#undef PG8_LDA
#undef PG8_LDB
#undef PG8_MMA
#undef PG8_WAIT_V
#undef PG8_WAIT_L
#undef PG8_BAR
#undef PG8_SCHED
}
}
namespace sch {
using pg8::Unit;
__device__ __forceinline__ void tile_of(int L, int nM, int nN, int& pm, int& pn) {
    const int nwg = nM * nN; int wgid = L;
    { const int q = nwg / 8, r = nwg % 8, xcd = wgid % 8, off = wgid / 8; wgid = (xcd < r ? xcd * (q + 1) : r * (q + 1) + (xcd - r) * q) + off; }
    const int nig = 8 * nN, gid = wgid / nig, fm = gid * 8, gsz = (nM - fm) < 8 ? (nM - fm) : 8;
    pm = fm + ((wgid % nig) % gsz); pn = (wgid % nig) / gsz;
}
struct Tiles {
    int nM, nN, G, c;
    __device__ __forceinline__ bool next(int i, Unit& u) const {
        const long L = (long)i * G + c; if (L >= (long)nM * nN) return false;
        tile_of((int)L, nM, nN, u.pm, u.pn); u.aoff = 0; u.boff = 0; u.tag = 0; return true; }
};
struct BrTiles {
    int nM, nN, G, c;
    __device__ __forceinline__ bool next(int i, Unit& u) const {
        const long L = (long)(i >> 2) * G + c; if (L >= (long)nM * nN) return false;
        tile_of((int)L, nM, nN, u.pm, u.pn); const int br = i & 3; u.aoff = br * 256; u.boff = (long)br * 1024 * 256; u.tag = br; return true; }
};
struct BrTilesH {
    int nM, nN, G, c;
    __device__ __forceinline__ bool next(int i, Unit& u) const {
        const long L = (long)(i >> 2) * G + c; if (L >= (long)nM * nN) return false;
        int pn8; tile_of((int)L, nM, nN, u.pm, pn8); const int br = i & 3; u.pn = pn8; u.aoff = br * 256; u.boff = (long)br * 1024 * 256; u.tag = br | (pn8 << 2); return true; }
};
struct MemKV {
    long offMem, offWkv; int c;
    __device__ __forceinline__ bool next(int i, Unit& u) const {
        if (i > 0 || c < 128) return false; const int idx = c - 128;
        u.pm = idx >> 3; u.pn = idx & 7; u.aoff = offMem; u.boff = offWkv; u.tag = 0; return true; }
};
struct AbsM {
    int c;
    __device__ __forceinline__ bool next(int i, Unit& u) const {
        if (i > 0) return false; const int b = c >> 4, h = (c >> 2) & 3, dt = c & 3;
        u.pm = b; u.pn = dt; u.aoff = h * 256; u.boff = h * 256; u.tag = (b * 4 + h) | (dt << 16); return true; }
};
struct AbsN {
    int c;
    __device__ __forceinline__ bool next(int i, Unit& u) const {
        if (i > 0) return false; const int b = c >> 4, h = (c >> 2) & 3, ci = c & 3;
        u.pm = ci; u.pn = b; u.aoff = h * 256; u.boff = h * 256; u.tag = (b * 4 + ci) | (h << 16); return true; }
};
struct XaS {
    int G, c;
    __device__ __forceinline__ bool next(int i, Unit& u) const {
        const int L = i * G + c; if (L >= 512) return false;
        const int j = c >> 3, b = (c & 7) + 8 * i, h = (j >> 3) & 3, rb = j & 7;
        u.pm = b * 8 + rb; u.pn = h; u.aoff = 0; u.boff = (long)b * 1024 * 1024; u.tag = h; return true; }
};
struct XaO {
    int G, c;
    __device__ __forceinline__ bool next(int i, Unit& u) const {
        const int L = i * G + c; if (L >= 512) return false;
        const int j = c >> 3, b = (c & 7) + 8 * i, ci = (j >> 3) & 3, rb = j & 7;
        u.pm = b * 8 + rb; u.pn = ci; u.aoff = 0; u.boff = (long)b * 1024 * 1024; u.tag = 0; return true; }
};
struct MoeUp {
    const int* blk_e; int b0, b1, G, c;
    __device__ __forceinline__ bool next(int i, Unit& u) const {
        const int L = i * G + c; const int nb = b1 - b0; if (L >= nb * 28) return false;
        const int rb = b0 + L / 28; u.pn = L % 28; u.pm = rb;
        const int e = __builtin_amdgcn_readfirstlane(__hip_atomic_load(blk_e + rb, RLX_AGENT));
        u.aoff = 0; u.boff = (long)e * (2 * FFE) * 1024; u.tag = rb - b0; return true; }
};
struct MoeDown {
    const int* blk_e; int b0, b1, G, c;
    __device__ __forceinline__ bool next(int i, Unit& u) const {
        const int L = i * G + c; const int nb = b1 - b0; if (L >= nb * 4) return false;
        const int rb = b0 + L / 4; u.pn = L % 4; u.pm = rb - b0;
        const int e = __builtin_amdgcn_readfirstlane(__hip_atomic_load(blk_e + rb, RLX_AGENT));
        u.aoff = 0; u.boff = (long)e * 1024 * FFE; u.tag = rb; return true; }
};
}

namespace epi {
using pg8::Unit;
#define EPI_SIG f32x4 (&acc)[2][2][4][2], const Unit& u, int wr, int wc, int fr, int fq, int wid, int lane
#define EPI_ROWS _Pragma("unroll") for (int ai = 0; ai < 2; ++ai) _Pragma("unroll") for (int m = 0; m < 4; ++m)
#define EPI_ROW (u.pm * 256 + ai * 128 + wr * 64 + m * 16 + fr)
#define EPI_BJ _Pragma("unroll") for (int bj = 0; bj < 2; ++bj)
#define EPI_FENCE asm volatile("" ::: "memory")
#ifndef EPI_DEPTH
#define EPI_DEPTH 4
#endif
__device__ __forceinline__ u32x4 pack8(const f32x4 a, const f32x4 b) { u32x4 w; w.x = cvt_pk_bf16(a[0], a[1]); w.y = cvt_pk_bf16(a[2], a[3]); w.z = cvt_pk_bf16(b[0], b[1]); w.w = cvt_pk_bf16(b[2], b[3]); return w; }

template <int ACT> struct StoreBf16 {
    static constexpr bool PERM = true;
    bf16_t* O; int ldc;
    __device__ __forceinline__ void operator()(EPI_SIG) const {
        EPI_ROWS { bf16_t* rowp = O + (size_t)EPI_ROW * ldc + u.pn * 256 + wc * 32 + 8 * fq;
            EPI_BJ { f32x4 v0 = acc[ai][bj][m][0], v1 = acc[ai][bj][m][1];
                if (ACT == 1) { for (int j = 0; j < 4; ++j) { v0[j] = sigmoidf_(v0[j]); v1[j] = sigmoidf_(v1[j]); } }
                *(u32x4*)(rowp + bj * 128) = pack8(v0, v1); } EPI_FENCE; }
    }
};
struct StoreAt {
    static constexpr bool PERM = true;
    bf16_t* O; int ldc;
    __device__ __forceinline__ void operator()(EPI_SIG) const {
        const int rb = u.tag & 0xffff, cb = u.tag >> 16;
        EPI_ROWS { bf16_t* rowp = O + (size_t)(rb * 256 + ai * 128 + wr * 64 + m * 16 + fr) * ldc + cb * 256 + wc * 32 + 8 * fq;
            EPI_BJ { *(u32x4*)(rowp + bj * 128) = pack8(acc[ai][bj][m][0], acc[ai][bj][m][1]); } EPI_FENCE; }
    }
};
struct Lora {
    static constexpr bool PERM = true;
    float* dec; bf16_t* av; bf16_t* gv; const float* w0; const float* a0;
    __device__ __forceinline__ void operator()(EPI_SIG) const {
        EPI_ROWS { const size_t row = EPI_ROW;
            EPI_BJ { const int col = bj * 128 + wc * 32 + 8 * fq; f32x4 v0 = acc[ai][bj][m][0], v1 = acc[ai][bj][m][1];
                if (u.pn == 0) {
                    const f32x4 b0 = *(const f32x4*)(w0 + col), b1 = *(const f32x4*)(w0 + col + 4);
                    for (int j = 0; j < 4; ++j) { float x = v0[j] + b0[j]; float wl = -softplusf_(-x) - 0.5f; v0[j] = fexp2(-fexp2(wl * LOG2E) * LOG2E);
                                                  x = v1[j] + b1[j]; wl = -softplusf_(-x) - 0.5f; v1[j] = fexp2(-fexp2(wl * LOG2E) * LOG2E); }
                    *(f32x4*)(dec + row * 256 + col) = v0; *(f32x4*)(dec + row * 256 + col + 4) = v1;
                } else if (u.pn == 1) {
                    const f32x4 b0 = *(const f32x4*)(a0 + col), b1 = *(const f32x4*)(a0 + col + 4);
                    for (int j = 0; j < 4; ++j) { v0[j] = sigmoidf_(v0[j] + b0[j]); v1[j] = sigmoidf_(v1[j] + b1[j]); }
                    *(u32x4*)(av + row * 256 + col) = pack8(v0, v1);
                } else { *(u32x4*)(gv + row * 256 + col) = pack8(v0, v1); } } EPI_FENCE; }
    }
};
struct Uq {
    static constexpr bool PERM = false;
    bf16_t* Q; const float* cosT; const float* sinT;
    __device__ __forceinline__ void operator()(EPI_SIG) const {
        EPI_ROWS { const size_t row = EPI_ROW;
            EPI_BJ { const int c32 = u.pn * 256 + bj * 128 + wc * 32; if (c32 >= 384) continue;
                f32x4 v0 = acc[ai][bj][m][0], v1 = acc[ai][bj][m][1];
                if ((c32 >> 5) % 3 == 2) {
                    const f32x4 cs = *(const f32x4*)(cosT + row * 16 + 4 * fq), sn = *(const f32x4*)(sinT + row * 16 + 4 * fq);
                    const f32x4 o0 = v0 * cs - v1 * sn, o1 = v0 * sn + v1 * cs; v0 = o0; v1 = o1; }
                u32x2 w0, w1; w0.x = cvt_pk_bf16(v0[0], v0[1]); w0.y = cvt_pk_bf16(v0[2], v0[3]); w1.x = cvt_pk_bf16(v1[0], v1[1]); w1.y = cvt_pk_bf16(v1[2], v1[3]);
                *(u32x2*)(Q + row * 384 + c32 + 4 * fq) = w0; *(u32x2*)(Q + row * 384 + c32 + 16 + 4 * fq) = w1; } EPI_FENCE; }
    }
};
struct Ukv {
    static constexpr bool PERM = true;
    bf16_t* Km; bf16_t* Vm;
    __device__ __forceinline__ void operator()(EPI_SIG) const {
        EPI_ROWS { const size_t row = EPI_ROW;
            EPI_BJ { const int col = u.pn * 256 + bj * 128 + wc * 32 + 8 * fq; const int h = col >> 7, j = col & 127;
                const u32x4 w = pack8(acc[ai][bj][m][0], acc[ai][bj][m][1]);
                if (j < 64) *(u32x4*)(Km + row * 384 + h * 96 + j) = w; else *(u32x4*)(Vm + row * 256 + h * 64 + (j - 64)) = w; } EPI_FENCE; }
    }
};
struct Resid {
    static constexpr bool PERM = false;
    const float* res; float* out; float ascale; const bf16_t* res16;
    __device__ __forceinline__ void operator()(EPI_SIG) const {
        const size_t off0 = (size_t)(u.pm * 256 + wr * 64 + fr) * 1024 + u.pn * 256 + wc * 32 + 4 * fq;
#define RS_OFF(i) (off0 + (size_t)((((i) >> 2) * 128 + ((i) & 3) * 16) * 1024))
        if (res16) {
            u32x2 rq[8][4];
#define RS_LOAD(i) { _Pragma("unroll") for (int q = 0; q < 4; ++q) rq[i][q] = *(const u32x2*)(res16 + RS_OFF(i) + (q >> 1) * 128 + (q & 1) * 16); }
            _Pragma("unroll") for (int i = 0; i < EPI_DEPTH; ++i) RS_LOAD(i)
            _Pragma("unroll") for (int i = 0; i < 8; ++i) { if (i + EPI_DEPTH < 8) RS_LOAD(i + EPI_DEPTH)
                _Pragma("unroll") for (int q = 0; q < 4; ++q) { const u32x2 w = rq[i][q]; const f32x4 r = (f32x4){bflo(w.x), bfhi(w.x), bflo(w.y), bfhi(w.y)};
                    *(f32x4*)(out + RS_OFF(i) + (q >> 1) * 128 + (q & 1) * 16) = r * DN_ALPHA + acc[i >> 2][q >> 1][i & 3][q & 1] * ascale; } EPI_FENCE; }
#undef RS_LOAD
        } else {
            f32x4 rq[8][4];
#define RS_LOAD(i) { _Pragma("unroll") for (int q = 0; q < 4; ++q) rq[i][q] = *(const f32x4*)(res + RS_OFF(i) + (q >> 1) * 128 + (q & 1) * 16); }
            _Pragma("unroll") for (int i = 0; i < EPI_DEPTH; ++i) RS_LOAD(i)
            _Pragma("unroll") for (int i = 0; i < 8; ++i) { if (i + EPI_DEPTH < 8) RS_LOAD(i + EPI_DEPTH)
                _Pragma("unroll") for (int q = 0; q < 4; ++q)
                    *(f32x4*)(out + RS_OFF(i) + (q >> 1) * 128 + (q & 1) * 16) = rq[i][q] * DN_ALPHA + acc[i >> 2][q >> 1][i & 3][q & 1] * ascale; EPI_FENCE; }
#undef RS_LOAD
        }
#undef RS_OFF
    }
};
struct Swiglu {
    static constexpr bool PERM = false;
    bf16_t* H; int ldh; int use_tag;
    __device__ __forceinline__ void operator()(EPI_SIG) const {
        const int pmo = use_tag ? u.tag : u.pm;
        EPI_ROWS { const size_t row = (size_t)(pmo * 256 + ai * 128 + wr * 64 + m * 16 + fr);
            EPI_BJ { const int hc = (u.pn * 256 + bj * 128 + wc * 32) / 2 + 4 * fq; const f32x4 g = acc[ai][bj][m][0], up = acc[ai][bj][m][1];
                u32x2 w; w.x = cvt_pk_bf16(siluf_(g[0]) * up[0], siluf_(g[1]) * up[1]); w.y = cvt_pk_bf16(siluf_(g[2]) * up[2], siluf_(g[3]) * up[3]);
                *(u32x2*)(H + row * ldh + hc) = w; } EPI_FENCE; }
    }
};
struct BrGate {
    static constexpr bool PERM = true;
    const bf16_t* G; float* mf; bf16_t* mb;
    __device__ __forceinline__ void operator()(EPI_SIG) const {
        const int br = u.tag;
        const size_t row0 = (size_t)(u.pm * 256 + wr * 64 + fr); const int col0 = u.pn * 256 + wc * 32 + 8 * fq;
        const bf16_t* gp = G + row0 * 4096 + br * 1024 + col0; bf16_t* pp = mb + row0 * 1024 + col0;
#define BR_ROW(i) (((i) >> 2) * 128 + ((i) & 3) * 16)
        u32x4 gq[8][2], pq[8][2];
#define BR_LOAD(i) { _Pragma("unroll") for (int bj = 0; bj < 2; ++bj) { gq[i][bj] = *(const u32x4*)(gp + (size_t)BR_ROW(i) * 4096 + bj * 128); \
            if (br > 0) pq[i][bj] = *(const u32x4*)(pp + (size_t)BR_ROW(i) * 1024 + bj * 128); else pq[i][bj] = (u32x4){0u, 0u, 0u, 0u}; } }
        _Pragma("unroll") for (int i = 0; i < EPI_DEPTH; ++i) BR_LOAD(i)
        _Pragma("unroll") for (int i = 0; i < 8; ++i) { if (i + EPI_DEPTH < 8) BR_LOAD(i + EPI_DEPTH)
            _Pragma("unroll") for (int bj = 0; bj < 2; ++bj) { const u32x4 gw = gq[i][bj], pw = pq[i][bj];
                f32x4 v0 = acc[i >> 2][bj][i & 3][0], v1 = acc[i >> 2][bj][i & 3][1];
                v0[0] = v0[0] * bflo(gw.x) + bflo(pw.x); v0[1] = v0[1] * bfhi(gw.x) + bfhi(pw.x); v0[2] = v0[2] * bflo(gw.y) + bflo(pw.y); v0[3] = v0[3] * bfhi(gw.y) + bfhi(pw.y);
                v1[0] = v1[0] * bflo(gw.z) + bflo(pw.z); v1[1] = v1[1] * bfhi(gw.z) + bfhi(pw.z); v1[2] = v1[2] * bflo(gw.w) + bflo(pw.w); v1[3] = v1[3] * bfhi(gw.w) + bfhi(pw.w);
                *(u32x4*)(pp + (size_t)BR_ROW(i) * 1024 + bj * 128) = pack8(v0, v1); } EPI_FENCE; }
#undef BR_LOAD
#undef BR_ROW
    }
};
struct BrGateH {
    static constexpr bool PERM = true;
    const bf16_t* G; bf16_t* mb; f32x4 racc[2][4][2];
    __device__ __forceinline__ void init() { _Pragma("unroll") for (int a = 0; a < 2; ++a) _Pragma("unroll") for (int m = 0; m < 4; ++m) _Pragma("unroll") for (int n = 0; n < 2; ++n) racc[a][m][n] = (f32x4){0.f, 0.f, 0.f, 0.f}; }
    __device__ __forceinline__ void operator()(f32x4 (&acc)[2][4][2], const Unit& u, int wr, int wc, int fr, int fq, int wid, int lane) {
        const int br = u.tag & 3; const unsigned col0 = (unsigned)((u.tag >> 2) * 128 + wc * 32 + 8 * fq), row0 = (unsigned)(u.pm * 256 + wr * 64 + fr);
        const char* gb = (const char*)G; const unsigned goff = (row0 * 4096u + (unsigned)br * 1024u + col0) * 2u;
        u32x4 gq[8];
        _Pragma("unroll") for (int i = 0; i < 8; ++i) gq[i] = *(const u32x4*)(gb + (size_t)(goff + (unsigned)(((i >> 2) * 128 + (i & 3) * 16) * 8192)));
        _Pragma("unroll") for (int i = 0; i < 8; ++i) { const u32x4 gw = gq[i]; const f32x4 v0 = acc[i >> 2][i & 3][0], v1 = acc[i >> 2][i & 3][1]; f32x4 r0 = racc[i >> 2][i & 3][0], r1 = racc[i >> 2][i & 3][1];
            r0[0] += v0[0] * bflo(gw.x); r0[1] += v0[1] * bfhi(gw.x); r0[2] += v0[2] * bflo(gw.y); r0[3] += v0[3] * bfhi(gw.y); r1[0] += v1[0] * bflo(gw.z); r1[1] += v1[1] * bfhi(gw.z); r1[2] += v1[2] * bflo(gw.w); r1[3] += v1[3] * bfhi(gw.w);
            racc[i >> 2][i & 3][0] = r0; racc[i >> 2][i & 3][1] = r1; }
        if (br == 3) { char* pb = (char*)mb; const unsigned poff = (row0 * 1024u + col0) * 2u;
            _Pragma("unroll") for (int i = 0; i < 8; ++i) { *(u32x4*)(pb + (size_t)(poff + (unsigned)(((i >> 2) * 128 + (i & 3) * 16) * 2048))) = pack8(racc[i >> 2][i & 3][0], racc[i >> 2][i & 3][1]);
                racc[i >> 2][i & 3][0] = (f32x4){0.f, 0.f, 0.f, 0.f}; racc[i >> 2][i & 3][1] = (f32x4){0.f, 0.f, 0.f, 0.f}; } }
    }
};
struct MoeDown {
    static constexpr bool PERM = true;
    const int* row_slot; const float* row_w; bf16_t* ys;
    __device__ __forceinline__ void operator()(EPI_SIG) const {
        int slot[8]; float w[8];
        _Pragma("unroll") for (int i = 0; i < 8; ++i) { const int r = u.tag * 256 + (i >> 2) * 128 + wr * 64 + (i & 3) * 16 + fr; slot[i] = __hip_atomic_load(row_slot + r, RLX_AGENT); w[i] = __hip_atomic_load(row_w + r, RLX_AGENT); }
        _Pragma("unroll") for (int i = 0; i < 8; ++i) {
            if (slot[i] >= 0) { EPI_BJ { const int col = u.pn * 256 + bj * 128 + wc * 32 + 8 * fq;
                *(u32x4*)(ys + (size_t)slot[i] * 1024 + col) = pack8(acc[i >> 2][bj][i & 3][0] * w[i], acc[i >> 2][bj][i & 3][1] * w[i]); } } EPI_FENCE; }
    }
};
struct Softmax {
    static constexpr bool PERM = true;
    bf16_t* P; LAS float* xch;
    __device__ __forceinline__ void operator()(EPI_SIG) const {
        EPI_ROWS { float v = -3.0e38f;
            EPI_BJ { const f32x4 a = acc[ai][bj][m][0], b = acc[ai][bj][m][1]; v = fmaxf(v, fmaxf(fmaxf(fmaxf(a[0], a[1]), fmaxf(a[2], a[3])), fmaxf(fmaxf(b[0], b[1]), fmaxf(b[2], b[3])))); }
            v = fmaxf(v, __shfl_xor(v, 16)); v = fmaxf(v, __shfl_xor(v, 32));
            if (fq == 0) xch[(ai * 128 + wr * 64 + m * 16 + fr) * 4 + wc] = v; }
        LDS_WAIT(); __builtin_amdgcn_s_barrier(); asm volatile("" ::: "memory");
        EPI_ROWS { const f32x4 q = *(const LAS f32x4*)(xch + (ai * 128 + wr * 64 + m * 16 + fr) * 4);
            const float mm = fmaxf(fmaxf(q[0], q[1]), fmaxf(q[2], q[3])); float s = 0.f;
            EPI_BJ { _Pragma("unroll") for (int n = 0; n < 2; ++n) { f32x4 t = acc[ai][bj][m][n]; for (int j = 0; j < 4; ++j) { t[j] = fexp2(t[j] - mm); s += t[j]; } acc[ai][bj][m][n] = t; } }
            s += __shfl_xor(s, 16); s += __shfl_xor(s, 32);
            if (fq == 0) xch[1024 + (ai * 128 + wr * 64 + m * 16 + fr) * 4 + wc] = s; }
        LDS_WAIT(); __builtin_amdgcn_s_barrier(); asm volatile("" ::: "memory");
        EPI_ROWS { const f32x4 q = *(const LAS f32x4*)(xch + 1024 + (ai * 128 + wr * 64 + m * 16 + fr) * 4);
            const float inv = frcp((q[0] + q[1]) + (q[2] + q[3]));
            bf16_t* rowp = P + (size_t)EPI_ROW * 1024 + u.tag * 256 + wc * 32 + 8 * fq;
            EPI_BJ { *(u32x4*)(rowp + bj * 128) = pack8(acc[ai][bj][m][0] * inv, acc[ai][bj][m][1] * inv); } EPI_FENCE; }
        LDS_WAIT(); __builtin_amdgcn_s_barrier(); asm volatile("" ::: "memory");
    }
};
}
struct Args { const float* in[42]; float* out; unsigned char* ws; int ph_lo, ph_hi; };
struct Ctx {
    const float* const* in; float* out; unsigned char* ws; LAS unsigned char* lds;
    int tid, lane, wave, G, bid;
};
enum { I_X = 0, I_MEM, I_POS, I_WIN, I_RWMU, I_RWW0, I_RWWUP, I_RWA0, I_RWAUP, I_RWGUP, I_RWKK, I_RWKA, I_RWRK, I_RWGNG, I_RWGNB,
       I_CONVW, I_CONVB, I_DTB, I_ALOG, I_SSDD, I_SSDNG, I_QNG, I_WUQ, I_KVNG, I_WUKV, I_WBR, I_WGATE, I_WOUT, I_LN1G, I_LN1B,
       I_XWQ, I_XWKV, I_XWO, I_LN2G, I_LN2B, I_FFN13, I_FFN2, I_ROUTER, I_MOE13, I_MOE2, I_LN3G, I_LN3B };
__device__ __forceinline__ Ctx launder(const Ctx& C0) {
    Ctx L = C0; unsigned zo_ = 0u; int t_ = threadIdx.x;
    asm volatile("" : "+s"(zo_), "+v"(t_));
    L.out = C0.out + zo_; L.ws = C0.ws + zo_; L.tid = t_; L.lane = t_ & 63; L.wave = __builtin_amdgcn_readfirstlane(t_ >> 6); return L;
}
#define WSP(T_, off) ((T_*)(C.ws + (off)))
#define GW (C.bid * NWAVES + C.wave)
#define NGW (C.G * NWAVES)

struct TJob { const float* W; int ldw, K, N; bf16_t* WT; int ldt; int map; float scale; int items; };
__device__ __forceinline__ int tj_items(int K, int N) { return (K / 64) * ((N + 31) / 32); }
__device__ __forceinline__ int tj_dest(int map, int n, int N) {
    if (map == 0) return n;
    if (map == 1) return n < 2816 ? n : (n < 2820 ? PC_DT + (n - 2816) : n - 4);
    const int half = N >> 1, j = n < half ? n : n - half;
    return (j >> 4) * 32 + (j & 15) + (n < half ? 0 : 16);
}
__device__ __forceinline__ void t_load(const TJob& J, int item, int lane, float (&v)[32], unsigned var = 0u) {
    const int nblk = (J.N + 31) / 32, kb = item / nblk, nb = item % nblk, k0 = 64 * kb, n0 = 32 * nb;
    const int nn = n0 + (lane & 31); const bool okn = nn < J.N; const float* src = J.W + (size_t)(k0 + (lane >> 5)) * J.ldw + nn;
#pragma unroll
    for (int i = 0; i < 32; ++i) v[i] = (okn && !(var & 8u)) ? src[(size_t)(2 * i) * J.ldw] : 0.f;
}
__device__ __forceinline__ void t_commit(const TJob& J, LAS float* scr, int item, int lane, const float (&v)[32], unsigned var = 0u) {
    const int nblk = (J.N + 31) / 32, kb = item / nblk, nb = item % nblk, k0 = 64 * kb, n0 = 32 * nb;
#pragma unroll
    for (int i = 0; i < 32; ++i) scr[(2 * i + (lane >> 5)) * 33 + (lane & 31)] = v[i];
    LDS_WAIT(); asm volatile("" ::: "memory");
    const int c = lane & 7;
#pragma unroll
    for (int j = 0; j < 4; ++j) { const int nl = (lane >> 3) + 8 * j, n = n0 + nl;
        if (n < J.N && !(var & 4u)) { const LAS float* s = scr + (8 * c) * 33 + nl; const float sc = (J.map == 1 && n >= 256) ? 1.0f : J.scale;
            u32x4 o; o.x = cvt_pk_bf16(s[0 * 33] * sc, s[1 * 33] * sc); o.y = cvt_pk_bf16(s[2 * 33] * sc, s[3 * 33] * sc); o.z = cvt_pk_bf16(s[4 * 33] * sc, s[5 * 33] * sc); o.w = cvt_pk_bf16(s[6 * 33] * sc, s[7 * 33] * sc);
            *(u32x4*)(J.WT + (size_t)tj_dest(J.map, n, J.N) * J.ldt + k0 + 8 * c) = o; } }
    LDS_WAIT(); asm volatile("" ::: "memory");
}
__device__ __forceinline__ TJob mkjob(const float* W, int ldw, int K, int N, bf16_t* WT, int ldt, int map, float scale) { TJob j; j.W = W; j.ldw = ldw; j.K = K; j.N = N; j.WT = WT; j.ldt = ldt; j.map = map; j.scale = scale; j.items = tj_items(K, N); return j; }

__device__ __forceinline__ TJob prologue_job(const Ctx& C, int j) {
    if (j < 26) { const int l = j / 13, r = j % 13; unsigned char* LW = C.ws + W_BASE + (size_t)l * LW_SIZE;
        if (r == 0) return mkjob(C.in[I_WIN] + (size_t)l * 1024 * 3236, 3236, 1024, 3236, (bf16_t*)(LW + LW_WIN), 1024, 1, 0.125f * LOG2E);
        if (r < 5) { const int i = r - 1; return mkjob(C.in[I_WGATE] + ((size_t)l * 4 + i) * 1024 * 1024, 1024, 1024, 1024, (bf16_t*)(LW + LW_WGATE) + (size_t)i * 1024 * 1024, 1024, 0, 1.f); }
        if (r < 9) { const int i = r - 5; return mkjob(C.in[I_WBR] + ((size_t)l * 4 + i) * 256 * 1024, 1024, 256, 1024, (bf16_t*)(LW + LW_WBR) + (size_t)i * 1024 * 256, 256, 0, 1.f); }
        if (r == 9) return mkjob(C.in[I_WOUT] + (size_t)l * 1024 * 1024, 1024, 1024, 1024, (bf16_t*)(LW + LW_WOUT), 1024, 0, 1.f);
        if (r == 10) return mkjob(C.in[I_XWQ], 1024, 0, 1024, (bf16_t*)(LW + LW_WQ), 1024, 0, 1.f);
        if (r == 11) return mkjob(C.in[I_XWKV] + (size_t)l * 1024 * 2048, 2048, 1024, 2048, (bf16_t*)(LW + LW_WKV), 1024, 0, 1.f);
        return mkjob(C.in[I_XWO] + (size_t)l * 1024 * 1024, 1024, 1024, 1024, (bf16_t*)(LW + LW_WO), 1024, 0, 1.f);
    }
    if (j == 26) return mkjob(C.in[I_FFN13], 2 * FFD, 1024, 2 * FFD, WSP(bf16_t, W_FFN13), 1024, 2, 1.f);
    return mkjob(C.in[I_FFN2], 1024, FFD, 1024, WSP(bf16_t, W_FFN2), FFD, 0, 1.f);
}
__device__ __forceinline__ TJob moe_job(const Ctx& C, int j) {
    if (j < 8) return mkjob(C.in[I_MOE13] + (size_t)j * 1024 * 2 * FFE, 2 * FFE, 1024, 2 * FFE, WSP(bf16_t, S_MW13) + (size_t)j * 2 * FFE * 1024, 1024, 2, 1.f);
    const int e = j - 8; return mkjob(C.in[I_MOE2] + (size_t)e * FFE * 1024, 1024, FFE, 1024, WSP(bf16_t, S_MW2) + (size_t)e * 1024 * FFE, FFE, 0, 1.f);
}
__device__ __forceinline__ void t_load4(const TJob& J, int item, int lane, f32x4 (&v)[8], unsigned var = 0u) {
    const int nblk = (J.N + 31) / 32, kb = item / nblk, nb = item % nblk, k0 = 64 * kb, n0 = 32 * nb;
    const int nn = n0 + 4 * (lane & 7); const bool okn = nn < J.N && !(var & 8u); const float* src = J.W + (size_t)(k0 + (lane >> 3)) * J.ldw + nn;
#pragma unroll
    for (int i = 0; i < 8; ++i) v[i] = okn ? *(const f32x4*)(src + (size_t)(8 * i) * J.ldw) : (f32x4){0.f, 0.f, 0.f, 0.f};
}
__device__ __forceinline__ void t_commit4(const TJob& J, LAS float* scr, int item, int lane, const f32x4 (&v)[8], unsigned var = 0u) {
    const int nblk = (J.N + 31) / 32, kb = item / nblk, nb = item % nblk, k0 = 64 * kb, n0 = 32 * nb;
    LAS float* wp = scr + (4 * (lane & 7)) * 65 + (lane >> 3);
#pragma unroll
    for (int i = 0; i < 8; ++i) { wp[0 * 65 + 8 * i] = v[i][0]; wp[1 * 65 + 8 * i] = v[i][1]; wp[2 * 65 + 8 * i] = v[i][2]; wp[3 * 65 + 8 * i] = v[i][3]; }
    LDS_WAIT(); asm volatile("" ::: "memory");
    const int c = lane & 7;
#pragma unroll
    for (int j = 0; j < 4; ++j) { const int nl = (lane >> 3) + 8 * j, n = n0 + nl;
        if (n < J.N && !(var & 4u)) { const LAS float* s = scr + nl * 65 + 8 * c; const float sc = (J.map == 1 && n >= 256) ? 1.0f : J.scale;
            u32x4 o; o.x = cvt_pk_bf16(s[0] * sc, s[1] * sc); o.y = cvt_pk_bf16(s[2] * sc, s[3] * sc); o.z = cvt_pk_bf16(s[4] * sc, s[5] * sc); o.w = cvt_pk_bf16(s[6] * sc, s[7] * sc);
            *(u32x4*)(J.WT + (size_t)tj_dest(J.map, n, J.N) * J.ldt + k0 + 8 * c) = o; } }
    LDS_WAIT(); asm volatile("" ::: "memory");
}
template <int NJ, bool MOE> __device__ __forceinline__ void run_tjobs(const Ctx& C, unsigned var = 0u) {
    LAS float* scr = (LAS float*)(C.lds + C.wave * 16384);
    int total = 0;
    for (int j = 0; j < NJ; ++j) { const TJob J = MOE ? moe_job(C, j) : prologue_job(C, j); total += J.items; }
    int j = 0, jbase = 0, it = GW; TJob J = MOE ? moe_job(C, 0) : prologue_job(C, 0);
    auto next = [&](TJob& Jo, int& io) -> bool { if (it >= total) return false;
        while (it >= jbase + J.items) { jbase += J.items; ++j; J = MOE ? moe_job(C, j) : prologue_job(C, j); }
        Jo = J; io = it - jbase; it += NGW; return true; };
    TJob Ja, Jb, Jc; int ia = 0, ib = 0, ic = 0; f32x4 va[8], vb[8], vc[8];
    bool ha = next(Ja, ia); if (!ha) return; t_load4(Ja, ia, C.lane, va, var);
    bool hb = next(Jb, ib); if (hb) t_load4(Jb, ib, C.lane, vb, var);
    for (;;) {
        bool hc = next(Jc, ic); if (hc) t_load4(Jc, ic, C.lane, vc, var);
        t_commit4(Ja, scr, ia, C.lane, va, var); if (!hb) break;
        ha = next(Ja, ia); if (ha) t_load4(Ja, ia, C.lane, va, var);
        t_commit4(Jb, scr, ib, C.lane, vb, var); if (!hc) break;
        hb = next(Jb, ib); if (hb) t_load4(Jb, ib, C.lane, vb, var);
        t_commit4(Jc, scr, ic, C.lane, vc, var); if (!ha) break;
    }
}


constexpr int CW_CHK = 32768;
template <class OutF> __device__ __forceinline__ void chk_gemm(const Ctx& C, const bf16_t* A, int lda, const bf16_t* Bt, int ldb, int K, int nrows, int ncs, int cstride, int c0, int bit, OutF expect_vs_got) {
    unsigned bad = 0; const int lane = C.lane;
    for (int it = GW; it < nrows * ncs; it += NGW) {
        const int r = it / ncs, c = c0 + (it % ncs) * cstride; float d = 0.f;
        for (int k = lane * 8; k < K; k += 512) { const u32x4 a = *(const u32x4*)(A + (size_t)r * lda + k), b = *(const u32x4*)(Bt + (size_t)c * ldb + k);
            d += bflo(a.x) * bflo(b.x) + bfhi(a.x) * bfhi(b.x) + bflo(a.y) * bflo(b.y) + bfhi(a.y) * bfhi(b.y) + bflo(a.z) * bflo(b.z) + bfhi(a.z) * bfhi(b.z) + bflo(a.w) * bflo(b.w) + bfhi(a.w) * bfhi(b.w); }
        d = wave_sum(d);
        if (!expect_vs_got(r, c, d)) bad = 1;
    }
    if (lane == 0 && bad) __hip_atomic_fetch_add((unsigned*)(C.ws + WS_CTL) + CW_CHK + 64 * bit, 1u, RLX_AGENT);
}
__device__ __forceinline__ bool chk_close(float e, float g) { return fabsf(e - g) <= 0.03f * fabsf(e) + 0.03f; }

__device__ __forceinline__ float chk_dot(const bf16_t* a, const bf16_t* b, int K, int lane) {
    float d = 0.f;
    for (int k = lane * 8; k < K; k += 512) { const u32x4 x = *(const u32x4*)(a + k), y = *(const u32x4*)(b + k);
        d += bflo(x.x) * bflo(y.x) + bfhi(x.x) * bfhi(y.x) + bflo(x.y) * bflo(y.y) + bfhi(x.y) * bfhi(y.y) + bflo(x.z) * bflo(y.z) + bfhi(x.z) * bfhi(y.z) + bflo(x.w) * bflo(y.w) + bfhi(x.w) * bfhi(y.w); }
    return wave_sum(d);
}
__device__ __forceinline__ void chk_flag(const Ctx& C, int bit, unsigned bad) { if (C.lane == 0 && bad) __hip_atomic_fetch_add((unsigned*)(C.ws + WS_CTL) + CW_CHK + 64 * bit, 1u, RLX_AGENT); }
__device__ __forceinline__ void chk_merged(const Ctx& C, int l, int bit) {
    const bf16_t* Y = WSP(bf16_t, S_Y); const bf16_t* G = WSP(bf16_t, S_G); const bf16_t* MB = WSP(bf16_t, S_MB); const bf16_t* WBR = (const bf16_t*)(C.ws + W_BASE + (size_t)l * LW_SIZE + LW_WBR); unsigned bad = 0;
    for (int it = GW; it < T * 4; it += NGW) { const int r = it >> 2, c = 13 + 256 * (it & 3); float e = 0.f;
        for (int i = 0; i < 4; ++i) e += bf2f(G[(size_t)r * 4096 + i * 1024 + c]) * chk_dot(Y + (size_t)r * 1024 + 256 * i, WBR + ((size_t)i * 1024 + c) * 256, 256, C.lane);
        if (!chk_close(e, bf2f(MB[(size_t)r * 1024 + c]))) bad = 1; }
    chk_flag(C, bit, bad);
}
__device__ __forceinline__ void chk_swiglu(const Ctx& C, int bit) {
    const bf16_t* XB = WSP(bf16_t, W_XB); const bf16_t* W = WSP(bf16_t, W_FFN13); const bf16_t* H = WSP(bf16_t, S_H); unsigned bad = 0;
    for (int it = GW; it < T * 22; it += NGW) { const int r = it / 22, hc = 5 + 128 * (it % 22); const int grow = (hc >> 4) * 32 + (hc & 15);
        const float g = chk_dot(XB + (size_t)r * 1024, W + (size_t)grow * 1024, 1024, C.lane), u = chk_dot(XB + (size_t)r * 1024, W + (size_t)(grow + 16) * 1024, 1024, C.lane);
        if (!chk_close(siluf_(g) * u, bf2f(H[(size_t)r * FFD + hc]))) bad = 1; }
    chk_flag(C, bit, bad);
}

constexpr size_t S_CHKBUF = S_BASE + (size_t)400 * MiB;
__device__ __forceinline__ void chk_resid_stash(const Ctx& C, const bf16_t* A, int lda, const bf16_t* Bt, int ldb, int K, int slot) {
    const float* XR = WSP(float, W_XRES); float* CB = WSP(float, S_CHKBUF);
    for (int it = GW; it < T * 4; it += NGW) { const int r = it >> 2, q = it & 3, c = 17 + 256 * q; const float d = chk_dot(A + (size_t)r * lda, Bt + (size_t)c * ldb, K, C.lane);
        if (C.lane == 0) CB[(size_t)r * 8 + slot * 4 + q] = XR[(size_t)r * 1024 + c] * DN_ALPHA + d; }
}
__device__ __forceinline__ void chk_resid_cmp(const Ctx& C, int slot, int bit) {
    const float* XR = WSP(float, W_XRES); const float* CB = WSP(float, S_CHKBUF); unsigned bad = 0;
    for (int it = GW; it < T * 4; it += NGW) { const int r = it >> 2, q = it & 3, c = 17 + 256 * q; if (!chk_close(CB[(size_t)r * 8 + slot * 4 + q], XR[(size_t)r * 1024 + c])) bad = 1; }
    chk_flag(C, bit, bad);
}
__device__ __forceinline__ void chk_ln_stash(const Ctx& C, const float* g, const float* b, int slot) {
    const float* XR = WSP(float, W_XRES); float* CB = WSP(float, S_CHKBUF); const int lane = C.lane;
    for (int t = GW; t < T; t += NGW) { float s = 0.f, s2 = 0.f; float v[16];
        for (int j = 0; j < 16; ++j) { v[j] = XR[(size_t)t * 1024 + lane + 64 * j]; s += v[j]; }
        const float mean = wave_sum(s) * (1.0f / 1024.0f); for (int j = 0; j < 16; ++j) { const float d = v[j] - mean; s2 += d * d; }
        const float rstd = 1.0f / sqrtf(wave_sum(s2) * (1.0f / 1024.0f) + 1e-5f);
        if (lane < 4) { const int c = 17 + 256 * lane; CB[(size_t)t * 8 + slot * 4 + lane] = (XR[(size_t)t * 1024 + c] - mean) * rstd * g[c] + b[c]; } }
}
__device__ __forceinline__ void chk_ln_cmp(const Ctx& C, int slot, int bit) {
    const float* XR = WSP(float, W_XRES); const bf16_t* XB = WSP(bf16_t, W_XB); const float* CB = WSP(float, S_CHKBUF); unsigned bad = 0;
    for (int it = GW; it < T * 4; it += NGW) { const int r = it >> 2, q = it & 3, c = 17 + 256 * q; const float e = CB[(size_t)r * 8 + slot * 4 + q];
        if (!chk_close(e, XR[(size_t)r * 1024 + c]) || !chk_close(e, bf2f(XB[(size_t)r * 1024 + c]))) bad = 1; }
    chk_flag(C, bit, bad);
}

template <int NJ, bool MOE> __device__ __forceinline__ void chk_weights(const Ctx& C, int bit) {
    unsigned bad = 0; const int gt = C.bid * NTHREADS + C.tid, NT = C.G * NTHREADS;
    for (int j = 0; j < NJ; ++j) { const TJob J = MOE ? moe_job(C, j) : prologue_job(C, j);
        for (size_t i = gt; i < (size_t)J.K * J.N; i += NT) { const int k = (int)(i / J.N), n = (int)(i % J.N);
            const float sc = (J.map == 1 && n >= 256) ? 1.0f : J.scale; const bf16_t e = (bf16_t)(cvt_pk_bf16(J.W[(size_t)k * J.ldw + n] * sc, 0.f) & 0xffffu);
            if (J.WT[(size_t)tj_dest(J.map, n, J.N) * J.ldt + k] != e) bad = 1; } }
    if (bad) __hip_atomic_fetch_add((unsigned*)(C.ws + WS_CTL) + CW_CHK + 64 * bit, 1u, RLX_AGENT);
}

__device__ __forceinline__ void chk_mla_inputs(const Ctx& C, int l, int bit) {
    const bf16_t* proj = WSP(bf16_t, S_PROJ); const bf16_t* QM = WSP(bf16_t, S_QM); const bf16_t* KM = WSP(bf16_t, S_KM); const bf16_t* VM = WSP(bf16_t, S_VM);
    const float* wuq = C.in[I_WUQ] + (size_t)l * 256 * 384; const float* wukv = C.in[I_WUKV] + (size_t)l * 128 * 512; const float* qg = C.in[I_QNG] + l * 256; const float* kvg = C.in[I_KVNG] + l * 128;
    const int* pos = (const int*)C.in[I_POS]; const int lane = C.lane; unsigned bad = 0; const float qs = 0.10206207261596575f * LOG2E;
    for (int t = GW; t < T; t += NGW) {
        const bf16_t* pr = proj + (size_t)t * NPROJ; float cq[4], ck[2]; float ss = 0.f;
        for (int i = 0; i < 4; ++i) { cq[i] = bf2f(pr[PC_CQ + lane + 64 * i]); ss += cq[i] * cq[i]; }
        float rs = 1.0f / sqrtf(wave_sum(ss) * (1.0f / 256.0f) + 1e-6f); for (int i = 0; i < 4; ++i) cq[i] *= rs * qg[lane + 64 * i];
        ss = 0.f; for (int i = 0; i < 2; ++i) { ck[i] = bf2f(pr[PC_CKV + lane + 64 * i]); ss += ck[i] * ck[i]; }
        rs = 1.0f / sqrtf(wave_sum(ss) * (1.0f / 128.0f) + 1e-6f); for (int i = 0; i < 2; ++i) ck[i] *= rs * kvg[lane + 64 * i];
        const float ang = (float)pos[t] * exp2f(-6.0f * (13.287712379549449f / 32.0f)); const float c3 = cosf(ang), s3 = sinf(ang);
        const int h = t & 3;
        float qn = 0.f, q1 = 0.f, q2 = 0.f, kn = 0.f, vv = 0.f;
        for (int i = 0; i < 4; ++i) { const int k = lane + 64 * i; qn += cq[i] * wuq[(size_t)k * 384 + h * 96 + 5]; q1 += cq[i] * wuq[(size_t)k * 384 + h * 96 + 67]; q2 += cq[i] * wuq[(size_t)k * 384 + h * 96 + 83]; }
        for (int i = 0; i < 2; ++i) { const int k = lane + 64 * i; kn += ck[i] * wukv[(size_t)k * 512 + h * 128 + 7]; vv += ck[i] * wukv[(size_t)k * 512 + h * 128 + 64 + 9]; }
        qn = wave_sum(qn) * qs; q1 = wave_sum(q1) * qs; q2 = wave_sum(q2) * qs; kn = wave_sum(kn); vv = wave_sum(vv);
        const float kr1 = bf2f(pr[PC_KR + 3]), kr2 = bf2f(pr[PC_KR + 19]);
        const bf16_t* qrow = QM + (size_t)t * 384 + h * 96; const bf16_t* krow = KM + (size_t)t * 384 + h * 96;
        if (!chk_close(qn, bf2f(qrow[5])) || !chk_close(q1 * c3 - q2 * s3, bf2f(qrow[67])) || !chk_close(q1 * s3 + q2 * c3, bf2f(qrow[83])) || !chk_close(kn, bf2f(krow[7])) ||
            !chk_close(kr1 * c3 - kr2 * s3, bf2f(krow[67])) || !chk_close(kr1 * s3 + kr2 * c3, bf2f(krow[83])) || !chk_close(vv, bf2f(VM[(size_t)t * 256 + h * 64 + 9]))) bad = 1;
    }
    chk_flag(C, bit, bad);
}

__device__ __forceinline__ void chk_rw_inputs(const Ctx& C, int l, int bit) {
    const bf16_t* proj = WSP(bf16_t, S_PROJ); const float* DEC = WSP(float, S_DEC); const bf16_t* RWS = WSP(bf16_t, S_RWS); const bf16_t* GV = WSP(bf16_t, S_GV); const size_t PL = (size_t)T * 256;
    const float* mu = C.in[I_RWMU] + l * 1024; const float* w0 = C.in[I_RWW0] + l * 256; const float* a0 = C.in[I_RWA0] + l * 256;
    const float* wup = C.in[I_RWWUP] + l * 64 * 256; const float* aup = C.in[I_RWAUP] + l * 64 * 256; const float* gup = C.in[I_RWGUP] + l * 128 * 256;
    const float* kkw = C.in[I_RWKK] + l * 256; const float* kaw = C.in[I_RWKA] + l * 256; const int lane = C.lane; unsigned bad = 0;
    for (int t = GW; t < T; t += NGW) {
        const bf16_t* pr = proj + (size_t)t * NPROJ + PC_RW; const bool first = (t % SEQ) == 0; const int h = t & 3, c = h * 64 + 11;
        auto sh = [&](int col) { const float cur = bf2f(pr[col]); const float prv = first ? 0.f : bf2f(pr[col - NPROJ]); return cur + (prv - cur) * mu[col]; };
        float dw = tanhf(sh(768 + lane)) * wup[lane * 256 + c], da = sh(832 + lane) * aup[lane * 256 + c];
        float dg = (1.0f / (1.0f + expf(-sh(896 + lane)))) * gup[lane * 256 + c] + (1.0f / (1.0f + expf(-sh(960 + lane)))) * gup[(64 + lane) * 256 + c];
        dw = wave_sum(dw); da = wave_sum(da); dg = wave_sum(dg);
        const float xw = w0[c] + dw; const float wlog = -(fmaxf(-xw, 0.f) + log1pf(expf(-fabsf(xw)))) - 0.5f; const float dec = expf(-expf(wlog));
        const float a = 1.0f / (1.0f + expf(-(a0[c] + da)));
        const float kl = sh(256 + h * 64 + lane) * kkw[h * 64 + lane]; const float nrm = 1.0f / sqrtf(fmaxf(wave_sum(kl * kl), 1e-24f));
        const float r = sh(c), k = sh(256 + c), v = sh(512 + c); const float kk = k * kkw[c] * nrm, kmod = k * (1.0f + (a - 1.0f) * kaw[c]), ka = kk * a;
        const size_t o = (size_t)t * 256 + c;
        if (!chk_close(dec, DEC[o]) || fabsf(dec - DEC[o]) > 0.004f || !chk_close(r, bf2f(RWS[o])) || !chk_close(kmod, bf2f(RWS[PL + o])) || !chk_close(v, bf2f(RWS[2 * PL + o])) || !chk_close(kk, bf2f(RWS[3 * PL + o])) ||
            !chk_close(ka, bf2f(RWS[4 * PL + o])) || !chk_close(dg, bf2f(GV[o]))) bad = 1;
    }
    chk_flag(C, bit, bad);
}
__device__ __forceinline__ void chk_ssd_norm(const Ctx& C, int l, int bit) {
    const bf16_t* Y = WSP(bf16_t, S_Y); const float* ng = C.in[I_SSDNG] + l * 256; const int lane = C.lane; unsigned bad = 0;
    for (int t = GW; t < T; t += NGW) { float q = 0.f;
        for (int i = 0; i < 4; ++i) { const int c = (lane >> 5) * 128 + (lane & 31) * 4 + i; const float y = bf2f(Y[(size_t)t * 1024 + 512 + c]) / ng[c]; q += y * y; }
        for (int o_ = 1; o_ < 32; o_ <<= 1) q += __shfl_xor(q, o_);
        q *= (1.0f / 128.0f); if (q < 0.9f || q > 1.1f) bad = 1; }
    chk_flag(C, bit, bad);
}

#ifndef P7_COND
#define P7_COND 1
#endif
#ifndef P7_CLASS
#define P7_CLASS (((c & 31) < 16 ? 1u : 2u) | ((c & 255) < 128 ? 4u : 8u))
#endif
__device__ __forceinline__ float tdot(const bf16_t* a, const bf16_t* b, int K) { float d = 0.f;
    for (int k = 0; k < K; k += 8) { const u32x4 x = *(const u32x4*)(a + k), y = *(const u32x4*)(b + k);
        d += bflo(x.x) * bflo(y.x) + bfhi(x.x) * bfhi(y.x) + bflo(x.y) * bflo(y.y) + bfhi(x.y) * bfhi(y.y) + bflo(x.z) * bflo(y.z) + bfhi(x.z) * bfhi(y.z) + bflo(x.w) * bflo(y.w) + bfhi(x.w) * bfhi(y.w); }
    return d; }
__device__ __forceinline__ void chk_full_p7(const Ctx& C, int l, int bit) {
    const bf16_t* MB = WSP(bf16_t, S_MB); const bf16_t* W = (const bf16_t*)(C.ws + W_BASE + (size_t)l * LW_SIZE + LW_WOUT); const float* xin = C.in[I_X]; const float* XR = WSP(float, W_XRES); float num = 0.f, den = 0.f;
    for (size_t i = (size_t)C.bid * NTHREADS + C.tid; i < (size_t)T * 1024; i += (size_t)C.G * NTHREADS) { const size_t r = i >> 10; const int c = (int)(i & 1023);
        const float d = tdot(MB + r * 1024, W + (size_t)c * 1024, 1024), g = XR[i] - xin[i] * DN_ALPHA; num += (d - g) * (d - g); den += d * d; }
    num = wave_sum(num); den = wave_sum(den);
    if (C.lane == 0) { atomicAdd((float*)(C.ws + WS_CTL) + CW_CHK + 1024, num); atomicAdd((float*)(C.ws + WS_CTL) + CW_CHK + 1088, den); }
}
__device__ __forceinline__ void chk_full_merged(const Ctx& C, int l, int bit) {
    const bf16_t* Y = WSP(bf16_t, S_Y); const bf16_t* G = WSP(bf16_t, S_G); const bf16_t* MB = WSP(bf16_t, S_MB); const bf16_t* WBR = (const bf16_t*)(C.ws + W_BASE + (size_t)l * LW_SIZE + LW_WBR); unsigned bad = 0;
    for (size_t i = (size_t)C.bid * NTHREADS + C.tid; i < (size_t)T * 1024; i += (size_t)C.G * NTHREADS) { const size_t r = i >> 10; const int c = (int)(i & 1023); float e = 0.f;
        for (int q = 0; q < 4; ++q) e += bf2f(G[r * 4096 + q * 1024 + c]) * tdot(Y + r * 1024 + 256 * q, WBR + ((size_t)q * 1024 + c) * 256, 256);
        if (!chk_close(e, bf2f(MB[i]))) bad = 1; }
    if (bad) __hip_atomic_fetch_add((unsigned*)(C.ws + WS_CTL) + CW_CHK + 64 * bit, 1u, RLX_AGENT);
}

#ifndef FG_CLASS
#define FG_CLASS (1u << ((c >> 5) & 3))
#endif
template <class F> __device__ __forceinline__ void chk_full_gemm(const Ctx& C, const bf16_t* A, const bf16_t* Bt, int K, int N, int bit, F ok) {
    unsigned bad = 0, cntbad = 0;
    for (size_t i = (size_t)C.bid * NTHREADS + C.tid; i < (size_t)T * N; i += (size_t)C.G * NTHREADS) { const size_t r = i / N; const int c = (int)(i % N);
        if (!ok(r, c, tdot(A + r * K, Bt + (size_t)c * K, K))) { bad |= (bit < 0) ? (FG_CLASS) : (1u << bit); ++cntbad; } }
#ifdef FG_COUNT
    if (cntbad) __hip_atomic_fetch_add((unsigned*)(C.ws + WS_CTL) + CW_CHK + 2048, cntbad, RLX_AGENT);
#else
    for (int q = 0; q < 4; ++q) if ((bad >> q) & 1) __hip_atomic_fetch_add((unsigned*)(C.ws + WS_CTL) + CW_CHK + 64 * q, 1u, RLX_AGENT);
#endif
}
__device__ __forceinline__ void ph_prologue(const Ctx& C) {
    run_tjobs<28, false>(C);
    const int gt = C.bid * NTHREADS + C.tid, NT = C.G * NTHREADS;
    for (int l = 0; l < 2; ++l) {
        unsigned char* LW = C.ws + W_BASE + (size_t)l * LW_SIZE;
        bf16_t* lora = (bf16_t*)(LW + LW_LORA); const float* wup = C.in[I_RWWUP] + l * 64 * 256; const float* aup = C.in[I_RWAUP] + l * 64 * 256; const float* gup = C.in[I_RWGUP] + l * 128 * 256;
        for (int i = gt; i < 768 * 256; i += NT) { const int n = i >> 8, k = i & 255; float v = 0.f;
            if (n < 256) { if (k < 64) v = wup[k * 256 + n]; } else if (n < 512) { if (k >= 64 && k < 128) v = aup[(k - 64) * 256 + (n - 256)]; } else { if (k >= 128) v = gup[(k - 128) * 256 + (n - 512)]; }
            lora[i] = (bf16_t)(cvt_pk_bf16(v, 0.f) & 0xffffu); }
        bf16_t* wuq = (bf16_t*)(LW + LW_WUQ); const float* suq = C.in[I_WUQ] + l * 256 * 384;
        for (int i = gt; i < 512 * 256; i += NT) { const int n = i >> 8, k = i & 255; const float v = n < 384 ? suq[k * 384 + n] * (0.10206207261596575f * LOG2E) : 0.f; wuq[i] = (bf16_t)(cvt_pk_bf16(v, 0.f) & 0xffffu); }
        bf16_t* wukv = (bf16_t*)(LW + LW_WUKV); const float* sukv = C.in[I_WUKV] + l * 128 * 512;
        for (int i = gt; i < 512 * 128; i += NT) { const int n = i >> 7, k = i & 127; wukv[i] = (bf16_t)(cvt_pk_bf16(sukv[k * 512 + n], 0.f) & 0xffffu); }
        { const float* wq = C.in[I_XWQ] + (size_t)l * 1024 * 1024; bf16_t* wqp = (bf16_t*)(LW + LW_WQ);
          for (size_t i = gt; i < (size_t)1024 * 1024 / 8; i += NT) { const f32x4 a = *(const f32x4*)(wq + i * 8) * (0.0625f * LOG2E), b = *(const f32x4*)(wq + i * 8 + 4) * (0.0625f * LOG2E); *(u32x4*)(wqp + i * 8) = epi::pack8(a, b); } }
        bf16_t* win = (bf16_t*)(LW + LW_WIN);
        for (int i = gt; i < (NPROJ - 3236) * 1024; i += NT) win[(size_t)3236 * 1024 + i] = 0;
    }
    { const float* x = C.in[I_X]; bf16_t* xb = WSP(bf16_t, W_XB);
#pragma unroll 4
      for (size_t i = gt; i < (size_t)T * 1024 / 8; i += NT) { const f32x4 a = *(const f32x4*)(x + i * 8), b = *(const f32x4*)(x + i * 8 + 4); *(u32x4*)(xb + i * 8) = epi::pack8(a, b); }
      const float* mm = C.in[I_MEM]; bf16_t* mb = WSP(bf16_t, W_MEMB);
      for (size_t i = gt; i < (size_t)NMEM * 1024 / 8; i += NT) { const f32x4 a = *(const f32x4*)(mm + i * 8), b = *(const f32x4*)(mm + i * 8 + 4); *(u32x4*)(mb + i * 8) = epi::pack8(a, b); } }
    { const int* pos = (const int*)C.in[I_POS]; float* ct = WSP(float, W_COS); float* st = WSP(float, W_SIN);
      for (int i = gt; i < T * 16; i += NT) { const int t = i >> 4, j = i & 15; const float inv = exp2f(-(float)(2 * j) * (13.287712379549449f / 32.0f)); const float ang = (float)pos[t] * inv; ct[i] = cosf(ang); st[i] = sinf(ang); } }
}

__device__ __forceinline__ f32x4 ld_bf4(const bf16_t* p) { const u32x2 w = *(const u32x2*)p; return (f32x4){bflo(w.x), bfhi(w.x), bflo(w.y), bfhi(w.y)}; }
__device__ __forceinline__ void st_bf4(bf16_t* p, const f32x4 v) { u32x2 w; w.x = cvt_pk_bf16(v[0], v[1]); w.y = cvt_pk_bf16(v[2], v[3]); *(u32x2*)p = w; }
__device__ __forceinline__ float tanhf_(float x) { return 1.0f - 2.0f * frcp(1.0f + fexp2(2.0f * LOG2E * x)); }
__device__ __forceinline__ void ph_prep(const Ctx& C, int l) {
    const bf16_t* __restrict__ proj = WSP(bf16_t, S_PROJ); const float* mu = C.in[I_RWMU] + l * 1024;
    bf16_t* __restrict__ LA = WSP(bf16_t, S_LA); bf16_t* __restrict__ CQN = WSP(bf16_t, S_CQN); bf16_t* __restrict__ CKVN = WSP(bf16_t, S_CKVN); bf16_t* __restrict__ KM = WSP(bf16_t, S_KM);
    const float* qg = C.in[I_QNG] + l * 256; const float* kvg = C.in[I_KVNG] + l * 128; const float* ct = WSP(float, W_COS); const float* st = WSP(float, W_SIN);
    const int lane = C.lane, c4 = 4 * lane, c2 = 2 * lane, i16 = lane & 15;
    const f32x4 m = *(const f32x4*)(mu + 768 + c4), qgv = *(const f32x4*)(qg + c4); const float kg0 = kvg[c2], kg1 = kvg[c2 + 1];
    u32x2 n_cur, n_prv, n_cq; unsigned n_ckv; unsigned short n_kr; float n_cs, n_sn;
#define PREP_LOAD(tt) do { const bf16_t* pr_ = proj + (size_t)(tt) * NPROJ; n_cur = *(const u32x2*)(pr_ + PC_RW + 768 + c4); \
        n_prv = ((tt) % SEQ) == 0 ? (u32x2){0u, 0u} : *(const u32x2*)(pr_ - NPROJ + PC_RW + 768 + c4); n_cq = *(const u32x2*)(pr_ + PC_CQ + c4); n_ckv = *(const unsigned*)(pr_ + PC_CKV + c2); \
        n_kr = pr_[PC_KR + (lane & 31)]; n_cs = ct[(size_t)(tt) * 16 + i16]; n_sn = st[(size_t)(tt) * 16 + i16]; } while (0)
    int t = GW; if (t < T) PREP_LOAD(t);
    for (; t < T; t += NGW) {
        const u32x2 wc = n_cur, wp = n_prv, wq = n_cq; const unsigned wk = n_ckv; const float krv = bf2f(n_kr), cs = n_cs, sn = n_sn;
        if (t + NGW < T) PREP_LOAD(t + NGW);
        { const f32x4 cur = (f32x4){bflo(wc.x), bfhi(wc.x), bflo(wc.y), bfhi(wc.y)}, prv = (f32x4){bflo(wp.x), bfhi(wp.x), bflo(wp.y), bfhi(wp.y)}; f32x4 p = cur + (prv - cur) * m;
          if (c4 < 64) { for (int j = 0; j < 4; ++j) p[j] = tanhf_(p[j]); } else if (c4 >= 128) { for (int j = 0; j < 4; ++j) p[j] = sigmoidf_(p[j]); }
          st_bf4(LA + (size_t)t * 256 + c4, p); }
        { f32x4 v = (f32x4){bflo(wq.x), bfhi(wq.x), bflo(wq.y), bfhi(wq.y)}; const float ss = wave_sum((v[0] * v[0] + v[1] * v[1]) + (v[2] * v[2] + v[3] * v[3]));
          const float rs = 1.0f / sqrtf(ss * (1.0f / 256.0f) + 1e-6f); v = v * rs * qgv; st_bf4(CQN + (size_t)t * 256 + c4, v); }
        { float a = bflo(wk), b = bfhi(wk); const float ss = wave_sum(a * a + b * b);
          const float rs = 1.0f / sqrtf(ss * (1.0f / 128.0f) + 1e-6f); a *= rs * kg0; b *= rs * kg1; *(unsigned*)(CKVN + (size_t)t * 128 + c2) = cvt_pk_bf16(a, b); }
        { const float o = __shfl_xor(krv, 16);
          const float r = (lane & 16) ? (o * sn + krv * cs) : (krv * cs - o * sn);
          if (lane < 32) { const bf16_t rb = (bf16_t)(cvt_pk_bf16(r, 0.f) & 0xffffu); for (int h = 0; h < 4; ++h) KM[(size_t)t * 384 + h * 96 + 64 + lane] = rb; } }
    }
#undef PREP_LOAD
}
__device__ __forceinline__ void ph_rwprep(const Ctx& C, int l) {
#if defined(NAIVE_SCAN)
    if (NAIVE_SCAN & 2) { float* q_ = WSP(float, S_SSQ); for (int i = C.bid * NTHREADS + C.tid; i < T * 8; i += C.G * NTHREADS) q_[i] = 0.f; }
#endif
    const bf16_t* __restrict__ proj = WSP(bf16_t, S_PROJ); const float* mu = C.in[I_RWMU] + l * 1024; const bf16_t* __restrict__ AV = WSP(bf16_t, S_AV); bf16_t* __restrict__ RWS = WSP(bf16_t, S_RWS);
    const float* kkw = C.in[I_RWKK] + l * 256; const float* kaw = C.in[I_RWKA] + l * 256; const int lane = C.lane, c = 4 * lane;
    f32x4 muv[3];
#pragma unroll
    for (int q = 0; q < 3; ++q) muv[q] = *(const f32x4*)(mu + q * 256 + c);
    const f32x4 kkv = *(const f32x4*)(kkw + c), kav = *(const f32x4*)(kaw + c);
    u32x2 ncur[3], nprv[3], nav;
#define RWP_LOAD(tt) do { const bf16_t* pr_ = proj + (size_t)(tt) * NPROJ + PC_RW; const bool f_ = ((tt) % SEQ) == 0; \
        _Pragma("unroll") for (int q = 0; q < 3; ++q) { ncur[q] = *(const u32x2*)(pr_ + q * 256 + c); nprv[q] = f_ ? (u32x2){0u, 0u} : *(const u32x2*)(pr_ - NPROJ + q * 256 + c); } \
        nav = *(const u32x2*)(AV + (size_t)(tt) * 256 + c); } while (0)
#define U2F4(w) ((f32x4){bflo((w).x), bfhi((w).x), bflo((w).y), bfhi((w).y)})
    int t = GW; if (t < T) RWP_LOAD(t);
    for (; t < T; t += NGW) {
        f32x4 rkv[3];
#pragma unroll
        for (int q = 0; q < 3; ++q) { const f32x4 cur = U2F4(ncur[q]), prv = U2F4(nprv[q]); rkv[q] = cur + (prv - cur) * muv[q]; }
        const f32x4 a = U2F4(nav);
        if (t + NGW < T) RWP_LOAD(t + NGW);
        f32x4 kk = rkv[1] * kkv;
        float ss = (kk[0] * kk[0] + kk[1] * kk[1]) + (kk[2] * kk[2] + kk[3] * kk[3]);
        ss = row_sum16(ss);
        kk = kk * (1.0f / sqrtf(fmaxf(ss, 1e-24f)));
        const f32x4 kmod = rkv[1] * ((a - 1.0f) * kav + 1.0f), ka = kk * a;
        const size_t o = (size_t)t * 256 + c, PL = (size_t)T * 256;
        st_bf4(RWS + o, rkv[0]); st_bf4(RWS + PL + o, kmod); st_bf4(RWS + 2 * PL + o, rkv[2]); st_bf4(RWS + 3 * PL + o, kk); st_bf4(RWS + 4 * PL + o, ka);
    }
#undef RWP_LOAD
}
__device__ __forceinline__ void ph_ssdprep(const Ctx& C, int l) {
    const bf16_t* __restrict__ proj = WSP(bf16_t, S_PROJ); bf16_t* __restrict__ XA = WSP(bf16_t, S_XA); bf16_t* __restrict__ BC = WSP(bf16_t, S_BC); bf16_t* __restrict__ CC = WSP(bf16_t, S_CC); float* __restrict__ ACS = WSP(float, S_ACS); float* __restrict__ DTV = WSP(float, S_DTV);
    const float* cw = C.in[I_CONVW] + l * 4 * 768; const float* cb = C.in[I_CONVB] + l * 768; const float* dtbp = C.in[I_DTB] + l * 4; const float* alog = C.in[I_ALOG] + l * 4; const int lane = C.lane;
    for (int item = GW; item < 64; item += NGW) { const int b = item >> 2, h = item & 3; const float dtb = dtbp[h], a2 = -expf(alog[h]) * LOG2E; const size_t t0 = (size_t)b * SEQ + 32 * lane;
        unsigned short rawv[32];
#pragma unroll
        for (int i = 0; i < 32; ++i) rawv[i] = proj[(t0 + i) * NPROJ + PC_DT + h];
        float pre[32]; float run = 0.f;
#pragma unroll
        for (int i = 0; i < 32; ++i) { run += softplusf_(bf2f(rawv[i]) + dtb) * a2; pre[i] = run; }
        float sc_ = run;
#pragma unroll
        for (int d = 1; d < 64; d <<= 1) { const float o = __shfl_up(sc_, d); if (lane >= d) sc_ += o; }
        const float base = sc_ - run;
#pragma unroll
        for (int i = 0; i < 32; ++i) ACS[(t0 + i) * 4 + h] = base + pre[i]; }
    f32x4 cbv[3], cwv[3][4];
#pragma unroll
    for (int j = 0; j < 3; ++j) { const int c = 4 * lane + 256 * j; cbv[j] = *(const f32x4*)(cb + c);
#pragma unroll
        for (int k = 0; k < 4; ++k) cwv[j][k] = *(const f32x4*)(cw + k * 768 + c); }
    const float dtbl = dtbp[lane & 3];
    u32x2 nraw[3][4]; unsigned short ndt;
#define SSP_LOAD(tt) do { const int tl_ = (tt) % SEQ; _Pragma("unroll") for (int j = 0; j < 3; ++j) _Pragma("unroll") for (int k = 0; k < 4; ++k) \
        nraw[j][k] = (tl_ - 3 + k >= 0) ? *(const u32x2*)(proj + (size_t)((tt) - 3 + k) * NPROJ + PC_XS + 4 * lane + 256 * j) : (u32x2){0u, 0u}; \
        ndt = proj[(size_t)(tt) * NPROJ + PC_DT + (lane & 3)]; } while (0)
    int t = GW; if (t < T) SSP_LOAD(t);
    for (; t < T; t += NGW) {
        f32x4 acc3[3]; const float dtraw = bf2f(ndt);
#pragma unroll
        for (int j = 0; j < 3; ++j) { f32x4 a = cbv[j];
#pragma unroll
            for (int k = 0; k < 4; ++k) a += U2F4(nraw[j][k]) * cwv[j][k];
            acc3[j] = a; }
        if (t + NGW < T) SSP_LOAD(t + NGW);
#pragma unroll
        for (int j = 0; j < 3; ++j) { f32x4 a = acc3[j]; for (int q = 0; q < 4; ++q) a[q] = siluf_(a[q]);
            st_bf4((j == 0 ? XA : (j == 1 ? BC : CC)) + (size_t)t * 256 + 4 * lane, a); }
        if (lane < 4) DTV[(size_t)t * 4 + lane] = softplusf_(dtraw + dtbl);
    }
#undef SSP_LOAD
#undef U2F4
}
#ifndef ABL_MOE
#define ABL_MOE 1.0f
#endif
template <bool MOE> __device__ __forceinline__ void ph_ln(const Ctx& C, const float* src, float* dst, bf16_t* dstb, const float* g, const float* b, const bf16_t* ys) {
    const int lane = C.lane;
    float chkscale = 1.0f;
#if defined(CHECKS) || defined(CHECKS2) || defined(CHECKS3) || defined(CHECKS4) || defined(CHECKS5) || defined(CHECKS6) || defined(CHECKS7) || defined(CHECKS8) || defined(CHECKS9) || defined(CHECKS10) || defined(CHECKS12) || defined(CHECKS13) || defined(CHECKS14) || defined(CHECKS15)
    if (MOE) { const unsigned* cw = (const unsigned*)(C.ws + WS_CTL) + CW_CHK; int n = 0;
        for (int q = 0; q < 4; ++q) if (__hip_atomic_load(cw + 64 * q, RLX_AGENT) != 0u) n |= 1 << q;
#if defined(FG_COUNT) || defined(CHECKS13) || defined(CHECKS15)
        { unsigned v_ = __hip_atomic_load(cw + 2048, RLX_AGENT); n = 0; while (v_ > 0u) { ++n; v_ >>= 1; } }
#endif
#ifdef CHECKS10
        { const float num = __uint_as_float(__hip_atomic_load(cw + 1024, RLX_AGENT)), den = __uint_as_float(__hip_atomic_load(cw + 1088, RLX_AGENT)); const float lr = -log2f(fmaxf(num / fmaxf(den, 1e-30f), 1e-12f)); n = (int)(lr + 0.5f); n = n < 0 ? 0 : (n > 31 ? 31 : n); }
#endif
        chkscale = 1.0f + 0.1f * (float)n; }
#endif
    f32x4 gv[4], bv[4];
#pragma unroll
    for (int j = 0; j < 4; ++j) { gv[j] = *(const f32x4*)(g + 4 * lane + 256 * j); bv[j] = *(const f32x4*)(b + 4 * lane + 256 * j); }
    f32x4 nv[4]; u32x2 ny0[4], ny1[4];
#define LN_LOAD(tt) do { _Pragma("unroll") for (int j = 0; j < 4; ++j) { nv[j] = *(const f32x4*)(src + (size_t)(tt) * 1024 + 4 * lane + 256 * j); \
        if (MOE) { ny0[j] = *(const u32x2*)(ys + (size_t)(2 * (tt)) * 1024 + 4 * lane + 256 * j); ny1[j] = *(const u32x2*)(ys + (size_t)(2 * (tt) + 1) * 1024 + 4 * lane + 256 * j); } } } while (0)
    int t = GW; if (t < T) LN_LOAD(t);
    for (; t < T; t += NGW) {
        f32x4 v[4]; float s = 0.f;
#pragma unroll
        for (int j = 0; j < 4; ++j) { v[j] = nv[j];
            if (MOE) { const f32x4 y0 = (f32x4){bflo(ny0[j].x), bfhi(ny0[j].x), bflo(ny0[j].y), bfhi(ny0[j].y)}, y1 = (f32x4){bflo(ny1[j].x), bfhi(ny1[j].x), bflo(ny1[j].y), bfhi(ny1[j].y)}; v[j] = v[j] * DN_ALPHA + (y0 + y1) * ABL_MOE; } }
        if (t + NGW < T) LN_LOAD(t + NGW);
#pragma unroll
        for (int j = 0; j < 4; ++j) s += (v[j][0] + v[j][1]) + (v[j][2] + v[j][3]);
        const float mean = wave_sum(s) * (1.0f / 1024.0f); float s2 = 0.f;
#pragma unroll
        for (int j = 0; j < 4; ++j) { v[j] = v[j] - mean; s2 += (v[j][0] * v[j][0] + v[j][1] * v[j][1]) + (v[j][2] * v[j][2] + v[j][3] * v[j][3]); }
        const float rstd = 1.0f / sqrtf(wave_sum(s2) * (1.0f / 1024.0f) + 1e-5f);
#pragma unroll
        for (int j = 0; j < 4; ++j) { const int c = 4 * lane + 256 * j; const f32x4 o = (v[j] * rstd * gv[j] + bv[j]) * chkscale;
            if (dst) *(f32x4*)(dst + (size_t)t * 1024 + c) = o; if (dstb) st_bf4(dstb + (size_t)t * 1024 + c, o); }
    }
#undef LN_LOAD
}
__device__ __forceinline__ void ph_ssdfix(const Ctx& C, int l) {
    bf16_t* Y = WSP(bf16_t, S_Y); const float* ssq = WSP(float, S_SSQ); const float* ng = C.in[I_SSDNG] + l * 256; const int lane = C.lane, c = 4 * lane, g = lane >> 5;
    const bf16_t* YRAW = WSP(bf16_t, S_YRAW); const bf16_t* RWS = WSP(bf16_t, S_RWS); const bf16_t* GV = WSP(bf16_t, S_GV); const size_t PL = (size_t)T * 256;
    const f32x4 rk = *(const f32x4*)(C.in[I_RWRK] + l * 256 + c), gng = *(const f32x4*)(C.in[I_RWGNG] + l * 256 + c), gnb = *(const f32x4*)(C.in[I_RWGNB] + l * 256 + c);
    const f32x4 ngv = *(const f32x4*)(ng + c);
    f32x4 nq; u32x2 nys, nyr, nr, nkm, nvv, ngg;
#define U2F4(w) ((f32x4){bflo((w).x), bfhi((w).x), bflo((w).y), bfhi((w).y)})
#define FIX_LOAD(tt) do { nq = *(const f32x4*)(ssq + (size_t)(tt) * 8 + 4 * g); nys = *(const u32x2*)(Y + (size_t)(tt) * 1024 + 512 + c); const size_t o_ = (size_t)(tt) * 256 + c; \
        nyr = *(const u32x2*)(YRAW + o_); nr = *(const u32x2*)(RWS + o_); nkm = *(const u32x2*)(RWS + PL + o_); nvv = *(const u32x2*)(RWS + 2 * PL + o_); ngg = *(const u32x2*)(GV + o_); } while (0)
    int t = GW; if (t < T) FIX_LOAD(t);
    for (; t < T; t += NGW) {
        const f32x4 q4 = nq; f32x4 v = U2F4(nys); const f32x4 yv = U2F4(nyr), rr = U2F4(nr), km = U2F4(nkm), vv = U2F4(nvv), gg = U2F4(ngg);
        if (t + NGW < T) FIX_LOAD(t + NGW);
        const float q = (q4[0] + q4[1]) + (q4[2] + q4[3]); const float rs = 1.0f / sqrtf(q * (1.0f / 128.0f) + 1e-5f);
        v = v * rs * ngv; st_bf4(Y + (size_t)t * 1024 + 512 + c, v);
        float sm = (yv[0] + yv[1]) + (yv[2] + yv[3]), bd = (rr[0] * km[0] * rk[0] + rr[1] * km[1] * rk[1]) + (rr[2] * km[2] * rk[2] + rr[3] * km[3] * rk[3]);
        sm = row_sum16(sm); bd = row_sum16(bd);
        const float mu = sm * (1.0f / 64.0f); const f32x4 d = yv - mu; float vs = (d[0] * d[0] + d[1] * d[1]) + (d[2] * d[2] + d[3] * d[3]);
        vs = row_sum16(vs);
        const float rstd = 1.0f / sqrtf(vs * (1.0f / 64.0f) + 64e-5f);
        st_bf4(Y + (size_t)t * 1024 + 256 + c, ((d * rstd) * gng + gnb + vv * bd) * gg);
    }
#undef FIX_LOAD
#undef U2F4
}
typedef __bf16 bfx8 __attribute__((ext_vector_type(8)));
__device__ __forceinline__ f32x16 mfma32(const bf16x8 a, const bf16x8 b, const f32x16 c) { return __builtin_amdgcn_mfma_f32_32x32x16_bf16(__builtin_bit_cast(bfx8, a), __builtin_bit_cast(bfx8, b), c, 0, 0, 0); }
__device__ __forceinline__ float dpp_xor1(float v) { return __builtin_bit_cast(float, __builtin_amdgcn_mov_dpp(__builtin_bit_cast(int, v), 0xB1, 0xf, 0xf, true)); }
__device__ __forceinline__ float dpp_xor2(float v) { return __builtin_bit_cast(float, __builtin_amdgcn_mov_dpp(__builtin_bit_cast(int, v), 0x4E, 0xf, 0xf, true)); }
__device__ __forceinline__ float dpp_hmir(float v) { return __builtin_bit_cast(float, __builtin_amdgcn_mov_dpp(__builtin_bit_cast(int, v), 0x141, 0xf, 0xf, true)); }
__device__ __forceinline__ float sum8(float v) { v += dpp_xor1(v); v += dpp_xor2(v); v += dpp_hmir(v); return v; }

__device__ __forceinline__ float xor32(float v, int hh) { const auto sw = __builtin_amdgcn_permlane32_swap(__builtin_bit_cast(unsigned, v), __builtin_bit_cast(unsigned, v), false, false); return __builtin_bit_cast(float, (unsigned)(hh ? sw[0] : sw[1])); }
typedef short s16x4 __attribute__((ext_vector_type(4)));
typedef short s16x8 __attribute__((ext_vector_type(8)));
template <int MODE>
__device__ __forceinline__ void attn_unit(const Ctx& C0_, int l, int b, int h, int qb, unsigned vf = 0u) {
    const Ctx C = launder(C0_);
    constexpr int DQK = MODE == 2 ? 128 : (MODE == 1 ? 96 : 64), NS = DQK / 16, KST = DQK * 2 + 16, VST = 192, KCH = DQK / 8;
    const bf16_t *Qp, *Kp, *Vp; int qs, ks, vs, ycol;
    if (MODE == 0) { const bf16_t* proj = WSP(bf16_t, S_PROJ); Qp = proj + PC_SBQ + h * 64; Kp = proj + PC_SBK + h * 64; Vp = proj + PC_SBV + h * 64; qs = ks = vs = NPROJ; ycol = h * 64; }
    else if (MODE == 1) { Qp = WSP(bf16_t, S_QM) + h * 96; Kp = WSP(bf16_t, S_KM) + h * 96; Vp = WSP(bf16_t, S_VM) + h * 64; qs = ks = 384; vs = 256; ycol = 768 + h * 64; }
    else { Qp = WSP(bf16_t, S_CC) + (h >> 1) * 128; Kp = WSP(bf16_t, S_BC) + (h >> 1) * 128; Vp = WSP(bf16_t, S_XA) + h * 64; qs = ks = vs = 256; ycol = 512 + h * 64; }
    const float* ACS = WSP(float, S_ACS); const float* DTV = WSP(float, S_DTV);
    const size_t tb = (size_t)b * SEQ;
    constexpr int ABUF = 64 * KST + 64 * VST + 512;
    LAS unsigned char* const abase = C.lds;
    const int tid = C.tid, lane = C.lane, w = C.wave, r = lane & 31, hh = lane >> 5;
    const int Q0 = qb * 256, qidx = Q0 + 32 * w + r, qmin = Q0 + 32 * w, qmax = qmin + 31;
    bf16x8 qf[NS];
#pragma unroll
    for (int s = 0; s < NS; ++s) qf[s] = *(const bf16x8*)(Qp + (tb + qidx) * qs + 16 * s + 8 * hh);
    f32x16 o[2]; for (int i = 0; i < 16; ++i) { o[0][i] = 0.f; o[1][i] = 0.f; }
    float Rrun = 0.f, mrun = -1.0e30f, lsum = 0.f;
    const int pr = (r & ~12) | ((r & 4) << 1) | ((r & 8) >> 1);
    u32x4 kreg0, kreg1, vreg; const int krow0 = tid / KCH, kch0 = tid % KCH, krow1 = (tid + 512) / KCH, kch1 = (tid + 512) % KCH, vrow = tid >> 3, vch = tid & 7;
    const bool k1 = (MODE == 2) || ((MODE == 1) && (tid < 64 * KCH - 512));
    float areg = 0.f, dreg = 0.f; float aq = 0.f; if (MODE == 2) aq = ACS[(tb + qidx) * 4 + h];
    const int ktmax = 4 * qb + 3;
#define ATT_LOAD(kt) do { const size_t kb_ = tb + (size_t)(kt) * 64; kreg0 = *(const u32x4*)(Kp + (kb_ + krow0) * ks + kch0 * 8); if (k1) kreg1 = *(const u32x4*)(Kp + (kb_ + krow1) * ks + kch1 * 8); \
        vreg = *(const u32x4*)(Vp + (kb_ + vrow) * vs + vch * 8); if (MODE == 2 && tid < 64) { areg = ACS[(kb_ + tid) * 4 + h]; dreg = DTV[(kb_ + tid) * 4 + h]; } } while (0)
#define ATT_STORE(bi) do { LAS unsigned char* Kt_ = abase + (bi) * ABUF; LAS unsigned char* Vt_ = Kt_ + 64 * KST; \
        *(LAS u32x4*)(Kt_ + krow0 * KST + kch0 * 16) = kreg0; if (k1) *(LAS u32x4*)(Kt_ + krow1 * KST + kch1 * 16) = kreg1; \
        *(LAS u32x4*)(Vt_ + vrow * VST + vch * 16) = vreg; if (MODE == 2 && tid < 64) { ((LAS float*)(Vt_ + 64 * VST))[tid] = areg; ((LAS float*)(Vt_ + 64 * VST))[64 + tid] = dreg; } } while (0)
    __syncthreads();
    ATT_LOAD(ktmax); ATT_STORE(0); if (ktmax > 0) ATT_LOAD(ktmax - 1);
    __syncthreads();
    for (int kt = ktmax; kt >= 0; --kt) {
        const int bi = (ktmax - kt) & 1;
        LAS unsigned char* Kt = abase + bi * ABUF; LAS unsigned char* Vt = Kt + 64 * KST; LAS float* AkL = (LAS float*)(Vt + 64 * VST); LAS float* DkL = AkL + 64;
        if (kt > 0 && !(vf & 128u)) { ATT_STORE(bi ^ 1); if (kt > 1) ATT_LOAD(kt - 2); }
        const int k0 = kt * 64;
        if (k0 <= qmax) {
        const bool need_mask = (k0 + 63 >= qmin);
        f32x16 sc[2];
#pragma unroll
        for (int sub = 0; sub < 2; ++sub) {
            for (int i = 0; i < 16; ++i) sc[sub][i] = 0.f;
            if (!(vf & 16u)) { _Pragma("unroll") for (int s = 0; s < NS; ++s) { const bf16x8 kf = *(const LAS bf16x8*)(Kt + (32 * sub + pr) * KST + (16 * s + 8 * hh) * 2); sc[sub] = mfma32(kf, qf[s], sc[sub]); } }
        }
        s16x4 vfr[2][2][4];
        { const LAS unsigned char* vb_ = Vt + (8 * hh + ((lane & 15) >> 2)) * VST + (16 * ((lane >> 4) & 1) + 4 * (lane & 3)) * 2;
#pragma unroll
          for (int sub = 0; sub < 2; ++sub)
#pragma unroll
            for (int s = 0; s < 2; ++s) { const LAS unsigned char* a_ = vb_ + (32 * sub + 16 * s) * VST;
                vfr[sub][s][0] = __builtin_amdgcn_ds_read_tr16_b64_v4i16((LAS s16x4*)a_); vfr[sub][s][1] = __builtin_amdgcn_ds_read_tr16_b64_v4i16((LAS s16x4*)(a_ + 768));
                vfr[sub][s][2] = __builtin_amdgcn_ds_read_tr16_b64_v4i16((LAS s16x4*)(a_ + 64)); vfr[sub][s][3] = __builtin_amdgcn_ds_read_tr16_b64_v4i16((LAS s16x4*)(a_ + 832)); } }
        if (vf & 32u) { } else
        if (MODE == 0) {
#pragma unroll
            for (int sub = 1; sub >= 0; --sub) {
                const int kb = k0 + 32 * sub + 8 * hh;
                float L[16];
#pragma unroll
                for (int i = 0; i < 16; ++i) { const float z = sc[sub][i]; const float l2 = -(fmaxf(z, 0.f) + flog2(1.0f + fexp2(-fabsf(z)))); L[i] = l2; sc[sub][i] = z + l2; }
                if (need_mask) {
#pragma unroll
                    for (int i = 0; i < 16; ++i) { const int key = kb + (i & 7) + 16 * (i >> 3); const bool ok = key < qidx; L[i] = ok ? L[i] : 0.f; sc[sub][i] = ok ? sc[sub][i] : -1.0e30f; } }
                float own_hi = 0.f, own_lo = 0.f, tl[16];
#pragma unroll
                for (int j = 7; j >= 0; --j) { tl[8 + j] = own_hi; own_hi += L[8 + j]; tl[j] = own_lo; own_lo += L[j]; }
                const float p_hi = xor32(own_hi, hh), p_lo = xor32(own_lo, hh);
                const float off_hi = Rrun + (hh ? 0.f : p_hi), off_lo = Rrun + own_hi + p_hi + (hh ? 0.f : p_lo);
                Rrun += (own_hi + own_lo) + (p_hi + p_lo);
#pragma unroll
                for (int i = 0; i < 16; ++i) sc[sub][i] = fexp2(sc[sub][i] + tl[i] + (i >= 8 ? off_hi : off_lo));
            }
        } else if (MODE == 2) {
#pragma unroll
            for (int sub = 0; sub < 2; ++sub) { f32x4 ak[4], dk[4];
#pragma unroll
                for (int r4 = 0; r4 < 4; ++r4) { const int o_ = 32 * sub + 8 * hh + 16 * (r4 >> 1) + 4 * (r4 & 1); ak[r4] = *(const LAS f32x4*)(AkL + o_); dk[r4] = *(const LAS f32x4*)(DkL + o_); }
#pragma unroll
                for (int i = 0; i < 16; ++i) { const float a_ = ak[(i >> 3) * 2 + ((i & 7) >> 2)][i & 3], d_ = dk[(i >> 3) * 2 + ((i & 7) >> 2)][i & 3];
                    sc[sub][i] = sc[sub][i] * d_ * fexp2(fminf(aq - a_, 0.f)); }
                if (need_mask) {
#pragma unroll
                    for (int i = 0; i < 16; ++i) { const int key = k0 + 32 * sub + 8 * hh + (i & 7) + 16 * (i >> 3); sc[sub][i] = key <= qidx ? sc[sub][i] : 0.f; } } }
        } else {
            if (need_mask) {
#pragma unroll
                for (int sub = 0; sub < 2; ++sub)
#pragma unroll
                    for (int i = 0; i < 16; ++i) { const int key = k0 + 32 * sub + 8 * hh + (i & 7) + 16 * (i >> 3); sc[sub][i] = key <= qidx ? sc[sub][i] : -1.0e30f; } }
            float tm = -1.0e30f;
#pragma unroll
            for (int sub = 0; sub < 2; ++sub)
#pragma unroll
                for (int i = 0; i < 16; ++i) tm = fmaxf(tm, sc[sub][i]);
            tm = fmaxf(tm, xor32(tm, hh));
            if (!__all(tm <= mrun)) {
                const float mnew = fmaxf(mrun, tm), alpha = fexp2(mrun - mnew); mrun = mnew; lsum *= alpha;
#pragma unroll
                for (int i = 0; i < 16; ++i) { o[0][i] *= alpha; o[1][i] *= alpha; } }
            float ps = 0.f;
#pragma unroll
            for (int sub = 0; sub < 2; ++sub)
#pragma unroll
                for (int i = 0; i < 16; ++i) { const float p = fexp2(sc[sub][i] - mrun); sc[sub][i] = p; ps += p; }
            lsum += ps;
        }
        if (!(vf & 64u))
#pragma unroll
        for (int sub = 0; sub < 2; ++sub)
#pragma unroll
            for (int s = 0; s < 2; ++s) {
                bf16x8 pf; { u32x4 pw; pw.x = cvt_pk_bf16(sc[sub][8 * s + 0], sc[sub][8 * s + 1]); pw.y = cvt_pk_bf16(sc[sub][8 * s + 2], sc[sub][8 * s + 3]); pw.z = cvt_pk_bf16(sc[sub][8 * s + 4], sc[sub][8 * s + 5]); pw.w = cvt_pk_bf16(sc[sub][8 * s + 6], sc[sub][8 * s + 7]); pf = __builtin_bit_cast(bf16x8, pw); }
                const s16x8 va0 = __builtin_shufflevector(vfr[sub][s][0], vfr[sub][s][1], 0, 1, 2, 3, 4, 5, 6, 7), va1 = __builtin_shufflevector(vfr[sub][s][2], vfr[sub][s][3], 0, 1, 2, 3, 4, 5, 6, 7);
                o[0] = mfma32(__builtin_bit_cast(bf16x8, va0), pf, o[0]);
                o[1] = mfma32(__builtin_bit_cast(bf16x8, va1), pf, o[1]);
            }
        }
        bool dead = false;
        if (MODE == 0) dead = Rrun < -64.0f;
        if (MODE == 2) dead = aq - AkL[0] < -64.0f;
        if (MODE == 1) { __syncthreads(); }
        else { volatile LAS unsigned* votes = (volatile LAS unsigned*)(C.lds + LDSCTL_OFF + 128) + 8 * bi;
            const bool wdead = __all(dead ? 1 : 0); if (lane == 0) votes[w] = wdead ? 1u : 0u;
            __syncthreads();
            unsigned all_ = 1u;
#pragma unroll
            for (int q_ = 0; q_ < 8; ++q_) all_ &= votes[q_];
            if (all_) break; }
    }
#undef ATT_LOAD
#undef ATT_STORE
    float inv = 1.0f;
    if (MODE == 1) { const float lt = lsum + xor32(lsum, hh); inv = frcp(lt); }
    bf16_t* Y = WSP(bf16_t, S_Y) + (tb + qidx) * 1024 + ycol;
    if (MODE == 2) {
        const float dsk = C.in[I_SSDD][l * 4 + h]; const bf16_t* xa = Vp + (tb + qidx) * 256; const bf16_t* zp = WSP(bf16_t, S_PROJ) + (tb + qidx) * NPROJ + PC_Z + h * 64; float q_ = 0.f;
#pragma unroll
        for (int dt = 0; dt < 2; ++dt)
#pragma unroll
            for (int g = 0; g < 4; ++g) { const int d0 = 32 * dt + 8 * g + 4 * hh; const f32x4 xv = ld_bf4(xa + d0), zv = ld_bf4(zp + d0); f32x4 y;
                for (int j = 0; j < 4; ++j) { y[j] = (o[dt][4 * g + j] + dsk * xv[j]) * siluf_(zv[j]); q_ += y[j] * y[j]; }
                st_bf4(Y + d0, y); }
        q_ += __shfl_xor(q_, 32);
        if (hh == 0) { float* SSQ = WSP(float, S_SSQ); SSQ[(tb + qidx) * 8 + h * 2] = q_; SSQ[(tb + qidx) * 8 + h * 2 + 1] = 0.f; }
        return;
    }
#pragma unroll
    for (int dt = 0; dt < 2; ++dt)
#pragma unroll
        for (int g = 0; g < 4; ++g) { u32x2 wv; wv.x = cvt_pk_bf16(o[dt][4 * g] * inv, o[dt][4 * g + 1] * inv); wv.y = cvt_pk_bf16(o[dt][4 * g + 2] * inv, o[dt][4 * g + 3] * inv);
            *(u32x2*)(Y + 32 * dt + 8 * g + 4 * hh) = wv; }
}

__device__ __forceinline__ float sum16(float v) { v = sum8(v); v += __builtin_bit_cast(float, __builtin_amdgcn_mov_dpp(__builtin_bit_cast(int, v), 0x140, 0xf, 0xf, true)); return v; }
__device__ __forceinline__ void rwkv_unit(const Ctx& C0_, int l, int b, int h, int half) {
    const Ctx C = launder(C0_);
    constexpr int TB = 32, NBLK = SEQ / TB, BUFB = 6 * TB * 64 * 4;
    LAS float* buf0 = (LAS float*)C.lds; LAS float* ybuf = (LAS float*)(C.lds + 2 * BUFB);
    const int tid = C.tid, il = tid >> 4, q = tid & 15, i = 32 * half + il;
    const float* DEC = WSP(float, S_DEC); const bf16_t* RWS = WSP(bf16_t, S_RWS); bf16_t* YRAW = WSP(bf16_t, S_YRAW);
    const size_t PL = (size_t)T * 256; const size_t tb = (size_t)b * SEQ;
    const int ls = tid >> 4, lj = 4 * (tid & 15);
    f32x4 gw; u32x2 gr[5];
#define RW_LOAD(blk) do { const size_t o_ = (tb + (size_t)(blk) * TB + ls) * 256 + h * 64 + lj; gw = *(const f32x4*)(DEC + o_); \
        gr[0] = *(const u32x2*)(RWS + 3 * PL + o_); gr[1] = *(const u32x2*)(RWS + 4 * PL + o_); gr[2] = *(const u32x2*)(RWS + PL + o_); gr[3] = *(const u32x2*)(RWS + o_); gr[4] = *(const u32x2*)(RWS + 2 * PL + o_); } while (0)
#define RW_STORE(bufp) do { LAS float* d_ = (bufp) + ls * 64 + lj; *(LAS f32x4*)d_ = gw; \
        _Pragma("unroll") for (int a_ = 0; a_ < 5; ++a_) *(LAS f32x4*)(d_ + (a_ + 1) * TB * 64) = (f32x4){bflo(gr[a_].x), bfhi(gr[a_].x), bflo(gr[a_].y), bfhi(gr[a_].y)}; } while (0)
    f32x4 S = (f32x4){0.f, 0.f, 0.f, 0.f};
    __syncthreads();
    RW_LOAD(0); RW_STORE(buf0);
    __syncthreads();
    for (int blk = 0; blk < NBLK; ++blk) {
        LAS float* cur = buf0 + (blk & 1) * (BUFB / 4); LAS float* nxtb = buf0 + ((blk + 1) & 1) * (BUFB / 4);
        if (blk + 1 < NBLK) RW_LOAD(blk + 1);
        f32x4 wA[2], kkA[2], kaA[2], kmA[2], rA[2], wB[2], kkB[2], kaB[2], kmB[2], rB[2]; float vA[2], vB[2];
#define RW_RD(W_, KK_, KA_, KM_, R_, V_, sb_) do { _Pragma("unroll") for (int u = 0; u < 2; ++u) { const LAS float* p = cur + ((sb_) + u) * 64 + 4 * q; \
            W_[u] = *(const LAS f32x4*)p; KK_[u] = *(const LAS f32x4*)(p + TB * 64); KA_[u] = *(const LAS f32x4*)(p + 2 * TB * 64); KM_[u] = *(const LAS f32x4*)(p + 3 * TB * 64); R_[u] = *(const LAS f32x4*)(p + 4 * TB * 64); \
            V_[u] = cur[5 * TB * 64 + ((sb_) + u) * 64 + i]; } } while (0)
#define RW_STEP(W_, KK_, KA_, KM_, R_, V_, sb_) do { float yv_[2]; _Pragma("unroll") for (int u = 0; u < 2; ++u) { \
            float sa = (S[0] * KK_[u][0] + S[1] * KK_[u][1]) + (S[2] * KK_[u][2] + S[3] * KK_[u][3]); sa = sum16(sa); \
            S = S * W_[u] + (KM_[u] * V_[u] - KA_[u] * sa); \
            const float y = (S[0] * R_[u][0] + S[1] * R_[u][1]) + (S[2] * R_[u][2] + S[3] * R_[u][3]); yv_[u] = sum16(y); } \
            if (q == 0) { ybuf[(sb_) * 32 + il] = yv_[0]; ybuf[((sb_) + 1) * 32 + il] = yv_[1]; } } while (0)
        RW_RD(wA, kkA, kaA, kmA, rA, vA, 0);
        for (int s0 = 0; s0 < TB; s0 += 4) {
            RW_RD(wB, kkB, kaB, kmB, rB, vB, s0 + 2);
            RW_STEP(wA, kkA, kaA, kmA, rA, vA, s0);
            if (s0 + 4 < TB) RW_RD(wA, kkA, kaA, kmA, rA, vA, s0 + 4);
            RW_STEP(wB, kkB, kaB, kmB, rB, vB, s0 + 2);
        }
#undef RW_RD
#undef RW_STEP
        __syncthreads();
        {
            const int os = tid >> 4, r2 = 2 * (tid & 15); const size_t t = tb + (size_t)blk * TB + os;
            *(unsigned*)(YRAW + t * 256 + h * 64 + 32 * half + r2) = cvt_pk_bf16(ybuf[os * 32 + r2], ybuf[os * 32 + r2 + 1]);
        }
        if (blk + 1 < NBLK) RW_STORE(nxtb);
        __syncthreads();
    }
#undef RW_LOAD
#undef RW_STORE
}

__device__ __forceinline__ void ssd_stage(const Ctx& C, int l, int h, size_t tb, int blk, LAS float* dst) {
    constexpr int TB = 16; const int g = h >> 1;
    const bf16_t* proj = WSP(bf16_t, S_PROJ); const float* cw = C.in[I_CONVW] + l * 4 * 768; const float* cb = C.in[I_CONVB] + l * 768;
    const float dtb = C.in[I_DTB][l * 4 + h], aneg = -expf(C.in[I_ALOG][l * 4 + h]);
    for (int it = C.tid; it < TB * 80; it += NTHREADS) {
        const int s = it / 80, v = it % 80; const int tl = blk * TB + s;
        int pcol, cch, doff;
        if (v < 16) { pcol = PC_XS + h * 64 + 4 * v; cch = h * 64 + 4 * v; doff = s * 64 + 4 * v; }
        else if (v < 48) { pcol = PC_BM + g * 128 + 4 * (v - 16); cch = 256 + g * 128 + 4 * (v - 16); doff = 2 * TB * 64 + s * 128 + 4 * (v - 16); }
        else { pcol = PC_CM + g * 128 + 4 * (v - 48); cch = 512 + g * 128 + 4 * (v - 48); doff = 2 * TB * 64 + TB * 128 + s * 128 + 4 * (v - 48); }
        f32x4 a = *(const f32x4*)(cb + cch);
#pragma unroll
        for (int k = 0; k < 4; ++k) { const int tt = tl - 3 + k; if (tt >= 0) a += ld_bf4(proj + (tb + tt) * NPROJ + pcol) * *(const f32x4*)(cw + k * 768 + cch); }
        for (int j = 0; j < 4; ++j) a[j] = siluf_(a[j]);
        if (v < 16) { const float dt = softplusf_(bf2f(proj[(tb + tl) * NPROJ + PC_DT + h]) + dtb); *(LAS f32x4*)(dst + TB * 64 + doff) = a; *(LAS f32x4*)(dst + doff) = a * dt;
                      if (v == 0) dst[TB * 384 + s] = expf(dt * aneg); }
        else *(LAS f32x4*)(dst + doff) = a;
    }
}
__device__ __forceinline__ void ssd_unit(const Ctx& C0_, int l, int b, int h, int ph) {
    const Ctx C = launder(C0_);
    constexpr int TB = 32, NBLK = SEQ / TB, NF = TB * (32 + 32 + 128 + 128) + 64, NIT = 72 * TB, NK = (NIT + NTHREADS - 1) / NTHREADS;
    LAS float* buf0 = (LAS float*)C.lds; LAS float* ypart = buf0 + 2 * NF;
    const int tid = C.tid, lane = C.lane, w = C.wave, g = h >> 1, pl = lane & 31, nh = lane >> 5;
    const bf16_t* proj = WSP(bf16_t, S_PROJ); bf16_t* Y = WSP(bf16_t, S_Y); float* SSQ = WSP(float, S_SSQ);
    const float* cw = C.in[I_CONVW] + l * 4 * 768; const float* cb = C.in[I_CONVB] + l * 768;
    const float dtb = C.in[I_DTB][l * 4 + h], aneg = -expf(C.in[I_ALOG][l * 4 + h]), dsk = C.in[I_SSDD][l * 4 + h];
    const size_t tb = (size_t)b * SEQ;
    int its[NK], itp[NK], itd[NK], itc[NK]; bool itx[NK];
#pragma unroll
    for (int k = 0; k < NK; ++k) { const int it = tid + NTHREADS * k, sidx = it / 72, v = it % 72; int pcol, cch, doff;
        if (v < 8) { pcol = PC_XS + h * 64 + 32 * ph + 4 * v; cch = h * 64 + 32 * ph + 4 * v; doff = sidx * 32 + 4 * v; }
        else if (v < 40) { pcol = PC_BM + g * 128 + 4 * (v - 8); cch = 256 + g * 128 + 4 * (v - 8); doff = 2 * TB * 32 + sidx * 128 + 4 * (v - 8); }
        else { pcol = PC_CM + g * 128 + 4 * (v - 40); cch = 512 + g * 128 + 4 * (v - 40); doff = 2 * TB * 32 + TB * 128 + sidx * 128 + 4 * (v - 40); }
        its[k] = sidx; itp[k] = pcol; itd[k] = doff; itx[k] = v < 8; itc[k] = cch; }
    const bool haslast = tid + NTHREADS * (NK - 1) < NIT;
    u32x2 raw[NK][4]; float dtr[NK]; unsigned short zraw;
    const int os = tid >> 4, op = tid & 15;
#define SSD_LOAD(blk) do { _Pragma("unroll") for (int k = 0; k < NK; ++k) { if (k < NK - 1 || haslast) { const int tl_ = (blk) * TB + its[k]; \
            _Pragma("unroll") for (int q = 0; q < 4; ++q) { const int tt_ = tl_ - 3 + q; raw[k][q] = tt_ >= 0 ? *(const u32x2*)(proj + (tb + tt_) * NPROJ + itp[k]) : (u32x2){0u, 0u}; } \
            dtr[k] = itx[k] ? bf2f(proj[(tb + tl_) * NPROJ + PC_DT + h]) : 0.f; } } } while (0)
#define SSD_COMMIT(dst) do { _Pragma("unroll") for (int k = 0; k < NK; ++k) { if (k < NK - 1 || haslast) { f32x4 a_ = *(const f32x4*)(cb + itc[k]); \
            _Pragma("unroll") for (int q = 0; q < 4; ++q) a_ += (f32x4){bflo(raw[k][q].x), bfhi(raw[k][q].x), bflo(raw[k][q].y), bfhi(raw[k][q].y)} * *(const f32x4*)(cw + q * 768 + itc[k]); \
            for (int j = 0; j < 4; ++j) a_[j] = siluf_(a_[j]); \
            if (itx[k]) { const float dt_ = softplusf_(dtr[k] + dtb); *(LAS f32x4*)((dst) + TB * 32 + itd[k]) = a_; *(LAS f32x4*)((dst) + itd[k]) = a_ * dt_; if ((itd[k] & 31) == 0) (dst)[TB * 320 + its[k]] = expf(dt_ * aneg); } \
            else *(LAS f32x4*)((dst) + itd[k]) = a_; } } } while (0)
    float hs[8];
#pragma unroll
    for (int k = 0; k < 8; ++k) hs[k] = 0.f;
    __syncthreads();
    SSD_LOAD(0); SSD_COMMIT(buf0);
    __syncthreads();
    for (int blk = 0; blk < NBLK; ++blk) {
        LAS float* cur = buf0 + (blk & 1) * NF; LAS float* nxtb = buf0 + ((blk + 1) & 1) * NF;
        if (blk + 1 < NBLK) SSD_LOAD(blk + 1);
        const size_t tz = tb + (size_t)blk * TB + os;
        zraw = proj[tz * NPROJ + PC_Z + h * 64 + 32 * ph + op]; const unsigned short zraw2 = proj[tz * NPROJ + PC_Z + h * 64 + 32 * ph + op + 16];
        for (int s0 = 0; s0 < TB; s0 += 4) {
            float x4[4], dA4[4], yv[4]; f32x4 bv[4][2], cv[4][2];
#pragma unroll
            for (int u = 0; u < 4; ++u) { const int s = s0 + u; x4[u] = cur[s * 32 + pl]; dA4[u] = cur[TB * 320 + s];
                const LAS float* bp = cur + 2 * TB * 32 + s * 128 + 16 * w + 8 * nh; const LAS float* cp = bp + TB * 128;
                bv[u][0] = *(const LAS f32x4*)bp; bv[u][1] = *(const LAS f32x4*)(bp + 4); cv[u][0] = *(const LAS f32x4*)cp; cv[u][1] = *(const LAS f32x4*)(cp + 4); }
#pragma unroll
            for (int u = 0; u < 4; ++u) { float yp = 0.f;
#pragma unroll
                for (int k4 = 0; k4 < 2; ++k4)
#pragma unroll
                    for (int j = 0; j < 4; ++j) { hs[4 * k4 + j] = hs[4 * k4 + j] * dA4[u] + x4[u] * bv[u][k4][j]; yp += cv[u][k4][j] * hs[4 * k4 + j]; }
                const auto sw = __builtin_amdgcn_permlane32_swap(__builtin_bit_cast(unsigned, yp), __builtin_bit_cast(unsigned, yp), false, false);
                yv[u] = yp + __builtin_bit_cast(float, (unsigned)sw[1]); }
            if (nh == 0) {
#pragma unroll
                for (int u = 0; u < 4; ++u) ypart[((s0 + u) * 8 + w) * 32 + pl] = yv[u]; }
        }
        if (blk + 1 < NBLK) SSD_COMMIT(nxtb);
        __syncthreads();
        {
            float y0 = 0.f, y1 = 0.f;
#pragma unroll
            for (int ww = 0; ww < 8; ++ww) { y0 += ypart[(os * 8 + ww) * 32 + op]; y1 += ypart[(os * 8 + ww) * 32 + op + 16]; }
            y0 += cur[TB * 32 + os * 32 + op] * dsk; y1 += cur[TB * 32 + os * 32 + op + 16] * dsk;
            y0 *= siluf_(bf2f(zraw)); y1 *= siluf_(bf2f(zraw2));
            bf16_t* yo = Y + tz * 1024 + 512 + h * 64 + 32 * ph + op;
            yo[0] = (bf16_t)(cvt_pk_bf16(y0, 0.f) & 0xffffu); yo[16] = (bf16_t)(cvt_pk_bf16(y1, 0.f) & 0xffffu);
            float q = y0 * y0 + y1 * y1;
#pragma unroll
            for (int o_ = 1; o_ < 16; o_ <<= 1) q += __shfl_xor(q, o_);
            if (op == 0) SSQ[tz * 8 + h * 2 + ph] = q;
        }
        __syncthreads();
    }
#undef SSD_LOAD
#undef SSD_COMMIT
}

__device__ __forceinline__ void sb_naive(const Ctx& C) {
    const bf16_t* proj = WSP(bf16_t, S_PROJ); bf16_t* Y = WSP(bf16_t, S_Y); const int lane = C.lane;
    for (int item = GW; item < T * 4; item += NGW) {
        const int t = item >> 2, h = item & 3, tq = t % SEQ; const size_t tb = (size_t)(t - tq);
        float q[64];
        { const bf16_t* qp = proj + (size_t)t * NPROJ + PC_SBQ + h * 64;
#pragma unroll
          for (int i = 0; i < 8; ++i) { const u32x4 w = *(const u32x4*)(qp + 8 * i); q[8*i] = bflo(w.x); q[8*i+1] = bfhi(w.x); q[8*i+2] = bflo(w.y); q[8*i+3] = bfhi(w.y); q[8*i+4] = bflo(w.z); q[8*i+5] = bfhi(w.z); q[8*i+6] = bflo(w.w); q[8*i+7] = bfhi(w.w); } }
        float o[64];
#pragma unroll
        for (int d = 0; d < 64; ++d) o[d] = 0.f;
        float R = 0.f;
        for (int c = (tq - 1) >> 6; c >= 0 && tq > 0; --c) {
            const int key = c * 64 + lane; const bool ok = key < tq;
            const bf16_t* kp = proj + (tb + key) * NPROJ + PC_SBK + h * 64; const bf16_t* vp = proj + (tb + key) * NPROJ + PC_SBV + h * 64;
            float z = 0.f;
#pragma unroll
            for (int i = 0; i < 8; ++i) { const u32x4 w = *(const u32x4*)(kp + 8 * i);
                z += q[8*i] * bflo(w.x) + q[8*i+1] * bfhi(w.x) + q[8*i+2] * bflo(w.y) + q[8*i+3] * bfhi(w.y) + q[8*i+4] * bflo(w.z) + q[8*i+5] * bfhi(w.z) + q[8*i+6] * bflo(w.w) + q[8*i+7] * bfhi(w.w); }
            const float L = ok ? -(fmaxf(z, 0.f) + flog2(1.0f + fexp2(-fabsf(z)))) : 0.f;
            float sfx = L;
#pragma unroll
            for (int dd = 1; dd < 64; dd <<= 1) { const float tt = __shfl_down(sfx, dd); if (lane + dd < 64) sfx += tt; }
            const float tot = __shfl(sfx, 0);
            const float wgt = ok ? fexp2(z + L + (sfx - L) + R) : 0.f;
            R += tot;
#pragma unroll
            for (int i = 0; i < 8; ++i) { const u32x4 w = *(const u32x4*)(vp + 8 * i);
                o[8*i] += wgt * bflo(w.x); o[8*i+1] += wgt * bfhi(w.x); o[8*i+2] += wgt * bflo(w.y); o[8*i+3] += wgt * bfhi(w.y); o[8*i+4] += wgt * bflo(w.z); o[8*i+5] += wgt * bfhi(w.z); o[8*i+6] += wgt * bflo(w.w); o[8*i+7] += wgt * bfhi(w.w); }
        }
        float mine = 0.f;
#pragma unroll
        for (int d = 0; d < 64; ++d) { const float sdd = wave_sum(o[d]); if (lane == d) mine = sdd; }
        Y[(size_t)t * 1024 + h * 64 + lane] = (bf16_t)(cvt_pk_bf16(mine, 0.f) & 0xffffu);
    }
}

__device__ __forceinline__ void rwkv_naive(const Ctx& C, int l) {
    const float* DEC = WSP(float, S_DEC); const bf16_t* RWS = WSP(bf16_t, S_RWS); const bf16_t* GV = WSP(bf16_t, S_GV); bf16_t* Y = WSP(bf16_t, S_Y);
    const size_t PL = (size_t)T * 256; const int lane = C.lane;
    for (int item = GW; item < 64; item += NGW) {
        const int b = item >> 2, h = item & 3; const float* rk = C.in[I_RWRK] + l * 256 + h * 64;
        const float gng = C.in[I_RWGNG][l * 256 + h * 64 + lane], gnb = C.in[I_RWGNB][l * 256 + h * 64 + lane];
        float S[64];
#pragma unroll
        for (int j = 0; j < 64; ++j) S[j] = 0.f;
        for (int tq = 0; tq < SEQ; ++tq) {
            const size_t o = ((size_t)b * SEQ + tq) * 256 + h * 64;
            const float v = bf2f(RWS[2 * PL + o + lane]);
            float sa = 0.f;
#pragma unroll
            for (int j = 0; j < 64; ++j) sa += S[j] * bf2f(RWS[3 * PL + o + j]);
            float y = 0.f, bd = 0.f;
#pragma unroll
            for (int j = 0; j < 64; ++j) { const float km = bf2f(RWS[PL + o + j]), r = bf2f(RWS[o + j]);
                S[j] = S[j] * DEC[o + j] + (v * km - sa * bf2f(RWS[4 * PL + o + j])); y += S[j] * r; bd += r * km * rk[j]; }
            const float mu = wave_sum(y) * (1.0f / 64.0f), d = y - mu, var = wave_sum(d * d) * (1.0f / 64.0f);
            const float res = (d * (1.0f / sqrtf(var + 64e-5f)) * gng + gnb + v * bd) * bf2f(GV[o + lane]);
            Y[((size_t)b * SEQ + tq) * 1024 + 256 + h * 64 + lane] = (bf16_t)(cvt_pk_bf16(res, 0.f) & 0xffffu);
        }
    }
}
__device__ __forceinline__ void ssd_naive(const Ctx& C, int l) {
    const bf16_t* proj = WSP(bf16_t, S_PROJ); bf16_t* Y = WSP(bf16_t, S_Y); float* SSQ = WSP(float, S_SSQ); const int lane = C.lane;
    const float* cw = C.in[I_CONVW] + l * 4 * 768; const float* cb = C.in[I_CONVB] + l * 768;
    for (int item2 = GW; item2 < 128; item2 += NGW) {
        const int item = item2 >> 1, ph = item2 & 1; const int b = item >> 2, h = item & 3, g = h >> 1; const size_t tb = (size_t)b * SEQ;
        const float dtb = C.in[I_DTB][l * 4 + h], aneg = -expf(C.in[I_ALOG][l * 4 + h]), dsk = C.in[I_SSDD][l * 4 + h];
        float hs0[32], hs1[32];
#pragma unroll
        for (int p = 0; p < 32; ++p) { hs0[p] = 0.f; hs1[p] = 0.f; }
        for (int tq = 0; tq < SEQ; ++tq) {
            const bf16_t* pr = proj + (tb + tq) * NPROJ;
            float xa = cb[h * 64 + lane], bv0 = cb[256 + g * 128 + lane], bv1 = cb[256 + g * 128 + 64 + lane], cv0 = cb[512 + g * 128 + lane], cv1 = cb[512 + g * 128 + 64 + lane];
            for (int k = 0; k < 4; ++k) { const int tt = tq - 3 + k; if (tt >= 0) { const bf16_t* pp = proj + (tb + tt) * NPROJ; const float* ww = cw + k * 768;
                xa += bf2f(pp[PC_XS + h * 64 + lane]) * ww[h * 64 + lane];
                bv0 += bf2f(pp[PC_BM + g * 128 + lane]) * ww[256 + g * 128 + lane]; bv1 += bf2f(pp[PC_BM + g * 128 + 64 + lane]) * ww[256 + g * 128 + 64 + lane];
                cv0 += bf2f(pp[PC_CM + g * 128 + lane]) * ww[512 + g * 128 + lane]; cv1 += bf2f(pp[PC_CM + g * 128 + 64 + lane]) * ww[512 + g * 128 + 64 + lane]; } }
            xa = siluf_(xa); bv0 = siluf_(bv0); bv1 = siluf_(bv1); cv0 = siluf_(cv0); cv1 = siluf_(cv1);
            const float dt = softplusf_(bf2f(pr[PC_DT + h]) + dtb), dA = expf(dt * aneg), xd = xa * dt;
            float y = 0.f;
#pragma unroll
            for (int p = 0; p < 32; ++p) { const float xp = __shfl(xd, 32 * ph + p); hs0[p] = hs0[p] * dA + xp * bv0; hs1[p] = hs1[p] * dA + xp * bv1;
                const float tot = wave_sum(cv0 * hs0[p] + cv1 * hs1[p]); if (lane == 32 * ph + p) y = tot; }
            y += dsk * xa; y *= siluf_(bf2f(pr[PC_Z + h * 64 + lane]));
            const bool mine = (lane >> 5) == ph; if (mine) Y[(tb + tq) * 1024 + 512 + h * 64 + lane] = (bf16_t)(cvt_pk_bf16(y, 0.f) & 0xffffu);
            const float q = wave_sum(mine ? y * y : 0.f); if (lane == 0) atomicAdd(&SSQ[(tb + tq) * 8 + h * 2], q);
        }
    }
}

__device__ __forceinline__ void mla_naive(const Ctx& C) {
    const bf16_t* QM = WSP(bf16_t, S_QM); const bf16_t* KM = WSP(bf16_t, S_KM); const bf16_t* VM = WSP(bf16_t, S_VM); bf16_t* Y = WSP(bf16_t, S_Y); const int lane = C.lane;
    for (int item = GW; item < T * 4; item += NGW) {
        const int t = item >> 2, h = item & 3, tq = t % SEQ; const size_t tb = (size_t)(t - tq);
        float q[96];
        { const bf16_t* qp = QM + (size_t)t * 384 + h * 96;
#pragma unroll
          for (int i = 0; i < 12; ++i) { const u32x4 w = *(const u32x4*)(qp + 8 * i); q[8*i] = bflo(w.x); q[8*i+1] = bfhi(w.x); q[8*i+2] = bflo(w.y); q[8*i+3] = bfhi(w.y); q[8*i+4] = bflo(w.z); q[8*i+5] = bfhi(w.z); q[8*i+6] = bflo(w.w); q[8*i+7] = bfhi(w.w); } }
        float o[64];
#pragma unroll
        for (int d = 0; d < 64; ++d) o[d] = 0.f;
        float m = -1.0e30f, lsum = 0.f;
        for (int c = tq >> 6; c >= 0; --c) {
            const int key = c * 64 + lane; const bool ok = key <= tq;
            const bf16_t* kp = KM + (tb + (ok ? key : 0)) * 384 + h * 96; const bf16_t* vp = VM + (tb + (ok ? key : 0)) * 256 + h * 64;
            float z = 0.f;
#pragma unroll
            for (int i = 0; i < 12; ++i) { const u32x4 w = *(const u32x4*)(kp + 8 * i);
                z += q[8*i] * bflo(w.x) + q[8*i+1] * bfhi(w.x) + q[8*i+2] * bflo(w.y) + q[8*i+3] * bfhi(w.y) + q[8*i+4] * bflo(w.z) + q[8*i+5] * bfhi(w.z) + q[8*i+6] * bflo(w.w) + q[8*i+7] * bfhi(w.w); }
            z = ok ? z : -1.0e30f;
            float cm = z;
#pragma unroll
            for (int dd = 1; dd < 64; dd <<= 1) cm = fmaxf(cm, __shfl_xor(cm, dd));
            const float mn = fmaxf(m, cm), al = fexp2(m - mn), pw = ok ? fexp2(z - mn) : 0.f; m = mn; lsum = lsum * al + pw;
#pragma unroll
            for (int i = 0; i < 8; ++i) { const u32x4 w = *(const u32x4*)(vp + 8 * i);
                o[8*i] = o[8*i] * al + pw * bflo(w.x); o[8*i+1] = o[8*i+1] * al + pw * bfhi(w.x); o[8*i+2] = o[8*i+2] * al + pw * bflo(w.y); o[8*i+3] = o[8*i+3] * al + pw * bfhi(w.y);
                o[8*i+4] = o[8*i+4] * al + pw * bflo(w.z); o[8*i+5] = o[8*i+5] * al + pw * bfhi(w.z); o[8*i+6] = o[8*i+6] * al + pw * bflo(w.w); o[8*i+7] = o[8*i+7] * al + pw * bfhi(w.w); }
        }
        const float lt = wave_sum(lsum); float mine = 0.f;
#pragma unroll
        for (int d = 0; d < 64; ++d) { const float sdd = wave_sum(o[d]); if (lane == d) mine = sdd; }
        Y[(size_t)t * 1024 + 768 + h * 64 + lane] = (bf16_t)(cvt_pk_bf16(mine / lt, 0.f) & 0xffffu);
    }
}
__device__ __forceinline__ void xattn_naive(const Ctx& C, int l) {
    const bf16_t* XQ = WSP(bf16_t, S_XQ); const bf16_t* KMEM = WSP(bf16_t, W_KMEM) + (size_t)l * NMEM * 1024; const bf16_t* VT = WSP(bf16_t, W_VMEMT) + (size_t)l * 1024 * NMEM; bf16_t* XO = WSP(bf16_t, S_XO); const int lane = C.lane;
    for (int item = GW; item < T * 4; item += NGW) {
        const int t = item >> 2, h = item & 3, b = t / SEQ;
        float z[4] = {0.f, 0.f, 0.f, 0.f};
        for (int d8 = 0; d8 < 32; ++d8) { const u32x4 qw = *(const u32x4*)(XQ + (size_t)t * 1024 + h * 256 + 8 * d8);
            const float qv[8] = {bflo(qw.x), bfhi(qw.x), bflo(qw.y), bfhi(qw.y), bflo(qw.z), bfhi(qw.z), bflo(qw.w), bfhi(qw.w)};
#pragma unroll
            for (int j = 0; j < 4; ++j) { const u32x4 kw = *(const u32x4*)(KMEM + (size_t)(b * 256 + lane + 64 * j) * 1024 + h * 256 + 8 * d8);
                z[j] += qv[0] * bflo(kw.x) + qv[1] * bfhi(kw.x) + qv[2] * bflo(kw.y) + qv[3] * bfhi(kw.y) + qv[4] * bflo(kw.z) + qv[5] * bfhi(kw.z) + qv[6] * bflo(kw.w) + qv[7] * bfhi(kw.w); } }
        float mx = fmaxf(fmaxf(z[0], z[1]), fmaxf(z[2], z[3]));
#pragma unroll
        for (int dd = 1; dd < 64; dd <<= 1) mx = fmaxf(mx, __shfl_xor(mx, dd));
        float p[4], ps = 0.f;
#pragma unroll
        for (int j = 0; j < 4; ++j) { p[j] = fexp2(z[j] - mx); ps += p[j]; }
        const float inv = 1.0f / wave_sum(ps);
        float o[4] = {0.f, 0.f, 0.f, 0.f};
        for (int mm = 0; mm < 256; ++mm) { const float pm = __shfl(p[mm >> 6], mm & 63);
#pragma unroll
            for (int jd = 0; jd < 4; ++jd) o[jd] += pm * bf2f(VT[(size_t)(h * 256 + lane + 64 * jd) * NMEM + b * 256 + mm]); }
#pragma unroll
        for (int jd = 0; jd < 4; ++jd) XO[(size_t)t * 1024 + h * 256 + lane + 64 * jd] = (bf16_t)(cvt_pk_bf16(o[jd] * inv, 0.f) & 0xffffu);
    }
}
__device__ __forceinline__ void ph_mixers(const Ctx& C, int l, int rep = 0) {
    unsigned* head = (unsigned*)(C.ws + WS_CTL) + CW_QUEUE + 64 * (l + 2 * rep);
    volatile LAS unsigned* slot = (volatile LAS unsigned*)(C.lds + LDSCTL_OFF + 64);
#ifdef TIME_VAR
    const unsigned var = __builtin_amdgcn_readfirstlane(__hip_atomic_load((const unsigned*)(C.ws + WS_CTL) + 200000, RLX_AGENT)) & 0xffu;
#else
    const unsigned var = 0u;
#endif
    constexpr int N_RW = 128, N_ATT = 768, NITEMS = N_RW + N_ATT;
    for (;;) {
        __syncthreads();
        if (C.tid == 0) slot[0] = __hip_atomic_fetch_add(head, 1u, RLX_AGENT);
        __syncthreads();
        const int it = (int)slot[0];
        if (it >= NITEMS) break;
#ifndef NAIVE_SCAN
#define NAIVE_SCAN 0
#endif
        if (it < N_RW) { if (!(NAIVE_SCAN & 1) && !(var & 1u)) { rwkv_unit(C, l, it >> 3, (it >> 1) & 3, it & 1);
#ifdef TIME_RW2
            __syncthreads(); rwkv_unit(C, l, it >> 3, (it >> 1) & 3, it & 1);
#endif
        } }
        else { const int k = it - N_RW; const int mode = k >> 8, kk_ = k & 255, pp = kk_ & 3, bh = kk_ >> 2, b = bh >> 2, h = bh & 3;
            if (mode == 0) { if (!(NAIVE_SCAN & 2) && !(var & 2u)) { attn_unit<2>(C, l, b, h, 7 - pp, var); __syncthreads(); attn_unit<2>(C, l, b, h, pp, var);
#ifdef TIME_SSDA2
                __syncthreads(); attn_unit<2>(C, l, b, h, 7 - pp); __syncthreads(); attn_unit<2>(C, l, b, h, pp);
#endif
            } }
#ifndef NAIVE_SB
            else if (mode == 2) { if (!(var & 8u)) { attn_unit<0>(C, l, b, h, 7 - pp, var); __syncthreads(); attn_unit<0>(C, l, b, h, pp, var); }
#ifdef TIME_SB2
                __syncthreads(); attn_unit<0>(C, l, b, h, 7 - pp); __syncthreads(); attn_unit<0>(C, l, b, h, pp);
#endif
            }
#else
            else if (mode == 2) { }
#endif
#ifndef NAIVE_MLA
            else { if (!(var & 4u)) { attn_unit<1>(C, l, b, h, 7 - pp, var); __syncthreads(); attn_unit<1>(C, l, b, h, pp, var); }
#ifdef TIME_MLA2
                __syncthreads(); attn_unit<1>(C, l, b, h, 7 - pp); __syncthreads(); attn_unit<1>(C, l, b, h, pp);
#endif
            }
#else
            else { }
#endif
        }
    }
#ifdef NAIVE_SB
    sb_naive(C);
#endif
#ifdef NAIVE_MLA
    mla_naive(C);
#endif
    if (NAIVE_SCAN & 1) rwkv_naive(C, l);
    if (NAIVE_SCAN & 2) ssd_naive(C, l);
}
__device__ __forceinline__ void ph_router(const Ctx& C) {
#ifdef TIME_VAR
    const unsigned var = __builtin_amdgcn_readfirstlane(__hip_atomic_load((const unsigned*)(C.ws + WS_CTL) + 200000, RLX_AGENT)) & 0xffu;
#else
    const unsigned var = 0u;
#endif
    if (!(var & 1u)) run_tjobs<16, true>(C, var);
    __syncthreads();
    LAS unsigned* lc = (LAS unsigned*)(C.lds + XCH_OFF);
    if (C.tid < 8) lc[C.tid] = 0u;
    __syncthreads();
    const float* xr = WSP(float, W_XRES); const float* rt = C.in[I_ROUTER]; int* topi = WSP(int, S_TOPI); float* topw = WSP(float, S_TOPW); const int lane = C.lane;
    f32x4 nx[4];
#define RT_LOAD(kk_) do { const int t_ = C.bid * 128 + C.wave * 16 + (kk_); _Pragma("unroll") for (int j = 0; j < 4; ++j) nx[j] = *(const f32x4*)(xr + (size_t)t_ * 1024 + 4 * lane + 256 * j); } while (0)
    RT_LOAD(0);
    f32x4 rw0[16], rw1[16];
#pragma unroll
    for (int jq = 0; jq < 16; ++jq) { const float* rp = rt + (size_t)(4 * lane + 256 * (jq >> 2) + (jq & 3)) * 8; rw0[jq] = *(const f32x4*)rp; rw1[jq] = *(const f32x4*)(rp + 4); }
    for (int k = 0; k < ((var & 2u) ? 0 : 16); ++k) {
        const int t = C.bid * 128 + C.wave * 16 + k; float a[8]; f32x4 xv4[4];
#pragma unroll
        for (int j = 0; j < 4; ++j) xv4[j] = nx[j];
        if (k + 1 < 16) RT_LOAD(k + 1);
#pragma unroll
        for (int e = 0; e < 8; ++e) a[e] = 0.f;
#pragma unroll
        for (int jq = 0; jq < 16; ++jq) { const float xq = xv4[jq >> 2][jq & 3]; const f32x4 r0 = rw0[jq], r1 = rw1[jq];
            a[0] += xq * r0[0]; a[1] += xq * r0[1]; a[2] += xq * r0[2]; a[3] += xq * r0[3]; a[4] += xq * r1[0]; a[5] += xq * r1[1]; a[6] += xq * r1[2]; a[7] += xq * r1[3]; }
#pragma unroll
        for (int e = 0; e < 8; ++e) a[e] = wave_sum(a[e]);
#ifdef ROUTER_NOISE
        for (int e = 0; e < 8; ++e) { unsigned hsh = (unsigned)t * 2654435761u + (unsigned)e * 40503u; hsh ^= hsh >> 13; hsh *= 0x5bd1e995u; hsh ^= hsh >> 15; a[e] += ROUTER_NOISE * ((float)(hsh & 0xffff) * (1.0f / 32768.0f) - 1.0f); }
#endif
        if (lane == 0) {
            int i1 = 0; float v1 = a[0];
#pragma unroll
            for (int e = 1; e < 8; ++e) if (a[e] > v1) { v1 = a[e]; i1 = e; }
            int i2 = -1; float v2 = -3.0e38f;
#pragma unroll
            for (int e = 0; e < 8; ++e) if (e != i1 && a[e] > v2) { v2 = a[e]; i2 = e; }
            const float g1 = 1.0f / (1.0f + expf(v2 - v1));
            topi[2 * t] = i1; topi[2 * t + 1] = i2; topw[2 * t] = g1; topw[2 * t + 1] = 1.0f - g1;
            __hip_atomic_fetch_add(&lc[i1], 1u, __ATOMIC_RELAXED, __HIP_MEMORY_SCOPE_WORKGROUP); __hip_atomic_fetch_add(&lc[i2], 1u, __ATOMIC_RELAXED, __HIP_MEMORY_SCOPE_WORKGROUP);
        }
    }
    __syncthreads();
    if (C.tid < 8) ((unsigned*)(C.ws + WS_CTL))[CW_MOECNT + C.bid * 8 + C.tid] = lc[C.tid];
}
__device__ __forceinline__ void ph_scatter(const Ctx& C) {
    LAS int* sh = (LAS int*)(C.lds + XCH_OFF);
    const unsigned* cnt = (const unsigned*)(C.ws + WS_CTL) + CW_MOECNT;
    int* row_slot = WSP(int, S_ROWSLOT); float* row_w = WSP(float, S_ROWW); int* blk_e = WSP(int, S_BLKE);
    const int* topi = WSP(int, S_TOPI); const float* topw = WSP(float, S_TOPW);
    const int tid = C.tid;
    if (tid < 48) sh[tid] = 0;
    __syncthreads();
    { const int wg = tid & 255, e0 = (tid >> 8) * 4; const u32x4 c4 = *(const u32x4*)(cnt + wg * 8 + e0);
      const unsigned cv[4] = {c4.x, c4.y, c4.z, c4.w};
#pragma unroll
      for (int j = 0; j < 4; ++j) { __hip_atomic_fetch_add(&sh[e0 + j], (int)cv[j], __ATOMIC_RELAXED, __HIP_MEMORY_SCOPE_WORKGROUP); if (wg < C.bid) __hip_atomic_fetch_add(&sh[8 + e0 + j], (int)cv[j], __ATOMIC_RELAXED, __HIP_MEMORY_SCOPE_WORKGROUP); } }
    __syncthreads();
    if (tid == 0) { int ps = 0; for (int e = 0; e < 8; ++e) { sh[16 + e] = ps; const int pad = (sh[e] + 255) / 256 * 256; sh[24 + e] = pad; ps += pad; } sh[40] = ps / 256; }
    __syncthreads();
    if (C.bid == 0) {
        const int used = sh[40];
        for (int rb = tid; rb < MOE_BLOCKS; rb += NTHREADS) { int e = 7; if (rb < used) { e = 0; for (int q = 1; q < 8; ++q) if (sh[16 + q] <= rb * 256) e = q; } blk_e[rb] = e; }
        if (tid == 0) blk_e[MOE_BLOCKS] = used;
    }
    if (C.bid < 8) { const int e = C.bid; for (int r = sh[16 + e] + sh[e] + tid; r < sh[16 + e] + sh[24 + e]; r += NTHREADS) { row_slot[r] = -1; row_w[r] = 0.f; } }
    if (tid < 256) { const int t = C.bid * 128 + (tid >> 1), k = tid & 1, e = topi[2 * t + k];
        const int pos = __hip_atomic_fetch_add(&sh[32 + e], 1, __ATOMIC_RELAXED, __HIP_MEMORY_SCOPE_WORKGROUP); const int dest = sh[16 + e] + sh[8 + e] + pos; row_slot[dest] = 2 * t + k; row_w[dest] = topw[2 * t + k]; sh[64 + tid] = dest; }
    __syncthreads();
    const bf16_t* xb = WSP(bf16_t, W_XB); bf16_t* xs = WSP(bf16_t, S_XS);
    { u32x4 va[2][2]; const int a0 = C.wave * 32;
#define SC_LOAD(buf, a_) do { _Pragma("unroll") for (int u = 0; u < 2; ++u) { const int t_ = C.bid * 128 + (((a_) + u) >> 1); _Pragma("unroll") for (int j = 0; j < 2; ++j) buf[u][j] = *(const u32x4*)(xb + (size_t)t_ * 1024 + (C.lane + 64 * j) * 8); } } while (0)
#define SC_STORE(buf, a_) do { _Pragma("unroll") for (int u = 0; u < 2; ++u) { const size_t d_ = (size_t)sh[64 + (a_) + u] * 1024; _Pragma("unroll") for (int j = 0; j < 2; ++j) *(u32x4*)(xs + d_ + (C.lane + 64 * j) * 8) = buf[u][j]; } } while (0)
      u32x4 vb[2][2];
      SC_LOAD(va, a0);
      for (int a = a0; a < a0 + 32; a += 4) { SC_LOAD(vb, a + 2); SC_STORE(va, a); if (a + 4 < a0 + 32) SC_LOAD(va, a + 4); SC_STORE(vb, a + 2); }
#undef SC_LOAD
#undef SC_STORE
    }
}


__device__ __forceinline__ void chk_moe(const Ctx& C, int bit) {
    const float* xr = WSP(float, W_XRES); const float* rt = C.in[I_ROUTER]; const float* w13 = C.in[I_MOE13]; const float* w2 = C.in[I_MOE2]; const bf16_t* ys = WSP(bf16_t, S_YS);
    LAS float* hb = (LAS float*)(C.lds + C.wave * 14336); const int lane = C.lane; unsigned bad = 0;
    float* stash = WSP(float, W_KMEM); const float* g3 = C.in[I_LN3G] + 1024; const float* b3 = C.in[I_LN3B] + 1024;
    for (int s = GW; s < 1024; s += NGW) {
        const int t = (int)(((long)s * 1021 + 7) % T); float x[16];
#pragma unroll
        for (int j = 0; j < 16; ++j) x[j] = xr[(size_t)t * 1024 + lane + 64 * j];
        float lg[8];
#pragma unroll
        for (int e = 0; e < 8; ++e) { float a = 0.f;
#pragma unroll
            for (int j = 0; j < 16; ++j) a += x[j] * rt[(size_t)(lane + 64 * j) * 8 + e]; lg[e] = wave_sum(a); }
        int i1 = 0; for (int e = 1; e < 8; ++e) if (lg[e] > lg[i1]) i1 = e;
        int i2 = -1; for (int e = 0; e < 8; ++e) if (e != i1 && (i2 < 0 || lg[e] > lg[i2])) i2 = e;
        float v3 = -3.0e38f; for (int e = 0; e < 8; ++e) if (e != i1 && e != i2) v3 = fmaxf(v3, lg[e]);
        if (lg[i2] - v3 < 0.02f) { if (lane == 0) stash[(size_t)s * 1024] = 1.0e30f; continue; }
        const float g1 = 1.0f / (1.0f + expf(lg[i2] - lg[i1]));
        float out[16];
#pragma unroll
        for (int j = 0; j < 16; ++j) out[j] = 0.f;
        for (int q = 0; q < 2; ++q) { const int e = q ? i2 : i1; const float gw = q ? 1.0f - g1 : g1; const float* W1 = w13 + (size_t)e * 1024 * 2 * FFE;
            for (int i0 = 0; i0 < 56; i0 += 4) { float ag[4], au[4];
#pragma unroll
                for (int i = 0; i < 4; ++i) { ag[i] = 0.f; au[i] = 0.f; }
                for (int k = 0; k < 1024; ++k) { const float xk = __shfl(x[k >> 6], k & 63); const float* wr = W1 + (size_t)k * 2 * FFE + lane + 64 * i0;
#pragma unroll
                    for (int i = 0; i < 4; ++i) { ag[i] += xk * wr[64 * i]; au[i] += xk * wr[FFE + 64 * i]; } }
#pragma unroll
                for (int i = 0; i < 4; ++i) hb[lane + 64 * (i0 + i)] = (ag[i] / (1.0f + expf(-ag[i]))) * au[i]; }
            LDS_WAIT();
            const float* W2 = w2 + (size_t)e * FFE * 1024;
            for (int hh = 0; hh < FFE; ++hh) { const float hv = hb[hh] * gw;
#pragma unroll
                for (int j = 0; j < 16; ++j) out[j] += hv * W2[(size_t)hh * 1024 + lane + 64 * j]; }
            LDS_WAIT(); }
#pragma unroll
        for (int j = 0; j < 16; ++j) { const int c = lane + 64 * j; const float got = bf2f(ys[(size_t)(2 * t) * 1024 + c]) + bf2f(ys[(size_t)(2 * t + 1) * 1024 + c]);
            if (fabsf(got - out[j]) > 0.05f * fabsf(out[j]) + 0.03f) bad = 1; }
        { float v[16], sm = 0.f, s2 = 0.f;
#pragma unroll
          for (int j = 0; j < 16; ++j) { v[j] = x[j] * DN_ALPHA + out[j]; sm += v[j]; }
          const float mean = wave_sum(sm) * (1.0f / 1024.0f);
#pragma unroll
          for (int j = 0; j < 16; ++j) { v[j] -= mean; s2 += v[j] * v[j]; }
          const float rstd = 1.0f / sqrtf(wave_sum(s2) * (1.0f / 1024.0f) + 1e-5f);
          int zz = 0; asm volatile("" : "+v"(zz));
#pragma unroll
          for (int j = 0; j < 16; ++j) { const int c = lane + 64 * j + zz; stash[(size_t)s * 1024 + c] = v[j] * rstd * g3[c] + b3[c]; } }
    }
    chk_flag(C, bit, bad);
}
#ifndef ABL_MIX
#define ABL_MIX 1.0f
#endif
#ifndef ABL_XA
#define ABL_XA 1.0f
#endif
#ifndef ABL_FF
#define ABL_FF 1.0f
#endif
#ifndef CHK_TOL2
#define CHK_TOL2 0.05f
#endif
#ifndef GATE_ACT
#define GATE_ACT 1
#endif
#ifndef GATE_ALIGN
#define GATE_ALIGN true
#endif
#ifndef FG_TOL
#define FG_TOL 0.05f
#endif
#ifndef FG_BIT
#define FG_BIT 1
#endif
#ifndef CHECKS_LAYER
#define CHECKS_LAYER 0
#endif
#ifndef MK_SPLIT
#define MK_SPLIT 0
#endif
constexpr int PH_L0 = 1, PH_L1 = 16, PH_MOE = 28, PH_TOTAL = PH_MOE + 2 + 2 * MOE_PASSES + 1;

__global__ void __launch_bounds__(NTHREADS, 2) hybrid_fwd(Args args) {
    extern __shared__ __attribute__((aligned(16))) unsigned char lds_raw[];
    Ctx C; C.in = args.in; C.out = args.out; C.ws = args.ws; C.lds = (LAS unsigned char*)lds_raw;
    C.tid = threadIdx.x; C.lane = C.tid & 63; C.wave = __builtin_amdgcn_readfirstlane(C.tid >> 6); C.G = gridDim.x; C.bid = blockIdx.x;
    const Ctx C0 = C;
    for (int u = C.tid; u < (LDS_BYTES - LDSCTL_OFF) / 4; u += NTHREADS) ((LAS unsigned*)(C.lds + LDSCTL_OFF))[u] = 0u;
    __syncthreads();
    const int lo = args.ph_lo, hi = args.ph_hi;
    XcdBarrier bar; bar.bar = (unsigned*)(C.ws + WS_CTL) + CW_BAR; bar.x = 0; bar.st = (volatile LAS unsigned*)(C.lds + LDSCTL_OFF);
    if (hi - lo > 1) bar = xcd_barrier_post((unsigned*)(C.ws + WS_CTL) + CW_BAR, (volatile LAS unsigned*)(C.lds + LDSCTL_OFF));
#ifndef SITE_MASK
#define SITE_MASK 0xffffffffu
#endif
#define SITE(n) (((SITE_MASK) >> (n)) & 1u)
#define IN(k) (lo <= (k) && (k) < hi)
#define ENDPH(k) do { if ((k) + 1 < hi) xcd_barrier(bar); } while (0)
#define SITE_BEGIN const Ctx C = launder(C0); unsigned char* LW = C.ws + W_BASE + (size_t)l * LW_SIZE; const bf16_t* XB = WSP(bf16_t, W_XB); float* XRES = WSP(float, W_XRES); (void)LW; (void)XB; (void)XRES; LAS unsigned char* ring = C.lds; (void)ring;

    if (SITE(0) && IN(0)) { const int l = 0; SITE_BEGIN ph_prologue(C);
#ifdef TIME_PRO2
        xcd_barrier(bar); ph_prologue(C);
#endif
#ifdef TIME_BAR
        for (int q_ = 0; q_ < TIME_BAR; ++q_) xcd_barrier(bar);
#endif
        ENDPH(0); }

    for (int l = 0; l < 2; ++l) {
        const int pb = l == 0 ? PH_L0 : PH_L1;
        if (SITE(1) && IN(pb + 0)) { SITE_BEGIN
#ifdef CHECKS3
            if (l == 1) chk_ln_cmp(C, 1, 1);
#endif
            { pg8::Gemm g{XB, (const bf16_t*)(LW + LW_WIN), 1024, 1024, 1024}; sch::Tiles S{T / 256, NPROJ / 256, C.G, C.bid}; epi::StoreBf16<0> E{WSP(bf16_t, S_PROJ), NPROJ}; pg8::gemm_phase(ring, g, S, E); }
            { pg8::Gemm g{(const bf16_t*)C.ws, (const bf16_t*)C.ws, 1024, 1024, 1024}; sch::MemKV S{(long)(W_MEMB / 2), (long)((W_BASE + (size_t)l * LW_SIZE + LW_WKV) / 2), C.bid};
              epi::StoreBf16<0> E{WSP(bf16_t, W_KMEM) + (size_t)l * NMEM * 2048, 2048}; pg8::gemm_phase(ring, g, S, E); }
            ENDPH(pb + 0);
        }
        if (SITE(2) && IN(pb + 1)) { SITE_BEGIN
#ifdef CHECKS5
            if (l == 0) chk_weights<28, false>(C, 0);
#endif
#ifdef CHECKS9
            if (l == 0) { unsigned bad = 0; const float* x = C.in[I_X]; const float* mm = C.in[I_MEM]; const bf16_t* mb = WSP(bf16_t, W_MEMB);
                for (size_t i = (size_t)C.bid * NTHREADS + C.tid; i < (size_t)T * 1024; i += (size_t)C.G * NTHREADS) if (!chk_close(x[i], bf2f(XB[i]))) bad = 1;
                for (size_t i = (size_t)C.bid * NTHREADS + C.tid; i < (size_t)NMEM * 1024; i += (size_t)C.G * NTHREADS) if (!chk_close(mm[i], bf2f(mb[i]))) bad = 1;
                if (bad) __hip_atomic_fetch_add((unsigned*)(C.ws + WS_CTL) + CW_CHK, 1u, RLX_AGENT); }
#endif
#ifdef CHECKS12P
            if (l == CHECKS_LAYER) { const bf16_t* proj = WSP(bf16_t, S_PROJ); chk_full_gemm(C, XB, (const bf16_t*)(LW + LW_WIN), 1024, 3236, 0, [&](size_t r, int c, float d) { return chk_close(d, bf2f(proj[r * NPROJ + c])); }); xcd_barrier(bar); }
#endif
#ifdef CHECKS4
            if (l == CHECKS_LAYER) { const bf16_t* KM_ = WSP(bf16_t, W_KMEM) + (size_t)l * NMEM * 1024; const bf16_t* VT_ = WSP(bf16_t, W_VMEMT) + (size_t)l * 1024 * NMEM;
                chk_gemm(C, WSP(bf16_t, W_MEMB), 1024, (const bf16_t*)(LW + LW_WKV), 1024, 1024, NMEM, 64, 16, 3, 0, [&](int r, int c, float d) { return chk_close(d, bf2f(KM_[(size_t)r * 1024 + c])); });
                chk_gemm(C, (const bf16_t*)(LW + LW_WKV) + (size_t)1024 * 1024, 1024, WSP(bf16_t, W_MEMB), 1024, 1024, 1024, 256, 16, 5, 1, [&](int r, int c, float d) { return chk_close(d, bf2f(VT_[(size_t)r * NMEM + c])); }); }
#endif
#ifdef CHECKS
            if (l == CHECKS_LAYER) { const bf16_t* proj = WSP(bf16_t, S_PROJ); chk_gemm(C, XB, 1024, (const bf16_t*)(LW + LW_WIN), 1024, 1024, T, 13, 256, 7, 0, [&](int r, int c, float d) { return chk_close(d, bf2f(proj[(size_t)r * NPROJ + c])); }); }
#endif
            ph_prep(C, l);
#ifdef TIME_PREP2
            xcd_barrier(bar); ph_prep(C, l);
#endif
            ENDPH(pb + 1); }
        if (SITE(3) && IN(pb + 2)) { SITE_BEGIN
            { pg8::Gemm g{WSP(bf16_t, S_LA), (const bf16_t*)(LW + LW_LORA), 256, 256, 256}; sch::Tiles S{T / 256, 3, C.G, C.bid}; epi::Lora E{WSP(float, S_DEC), WSP(bf16_t, S_AV), WSP(bf16_t, S_GV), C.in[I_RWW0] + l * 256, C.in[I_RWA0] + l * 256}; pg8::gemm_phase(ring, g, S, E); }
            { pg8::Gemm g{WSP(bf16_t, S_CQN), (const bf16_t*)(LW + LW_WUQ), 256, 256, 256}; sch::Tiles S{T / 256, 2, C.G, (C.bid + 128) & 255}; epi::Uq E{WSP(bf16_t, S_QM), WSP(float, W_COS), WSP(float, W_SIN)}; pg8::gemm_phase(ring, g, S, E); }
            { pg8::Gemm g{WSP(bf16_t, S_CKVN), (const bf16_t*)(LW + LW_WUKV), 128, 128, 128}; sch::Tiles S{T / 256, 2, C.G, C.bid}; epi::Ukv E{WSP(bf16_t, S_KM), WSP(bf16_t, S_VM)}; pg8::gemm_phase(ring, g, S, E); }
            ENDPH(pb + 2);
        }
        if (SITE(4) && IN(pb + 3)) { SITE_BEGIN ph_rwprep(C, l); ph_ssdprep(C, l);
#ifdef TIME_RWP2
            xcd_barrier(bar); ph_rwprep(C, l); ph_ssdprep(C, l);
#endif
            ENDPH(pb + 3); }
        if (SITE(5) && IN(pb + 4)) { SITE_BEGIN
#ifdef CHECKS6
            if (l == CHECKS_LAYER) chk_mla_inputs(C, l, 0);
#endif
#ifdef CHECKS7
            if (l == CHECKS_LAYER) chk_rw_inputs(C, l, 0);
#endif
            ph_mixers(C, l);
#ifdef TIME_MIX2
            xcd_barrier(bar); ph_mixers(C, l, 1);
#endif
            ENDPH(pb + 4); }
        if (SITE(6) && IN(pb + 5)) { SITE_BEGIN
            ph_ssdfix(C, l);
            { pg8::Gemm g{XB, (const bf16_t*)(LW + LW_WGATE), 1024, 1024, 1024}; sch::Tiles S{T / 256, 16, C.G, C.bid}; epi::StoreBf16<GATE_ACT> E{WSP(bf16_t, S_G), 4096}; pg8::gemm_phase<epi::StoreBf16<GATE_ACT>, sch::Tiles, GATE_ALIGN>(ring, g, S, E);
#ifdef TIME_GATE2
              xcd_barrier(bar); pg8::gemm_phase<epi::StoreBf16<GATE_ACT>, sch::Tiles, GATE_ALIGN>(ring, g, S, E);
#endif
            }
#ifdef CHECKS14
            if (l == 0) { xcd_barrier(bar); const bf16_t* Gp = WSP(bf16_t, S_G); chk_full_gemm(C, XB, (const bf16_t*)(LW + LW_WGATE), 1024, 4096, 0, [&](size_t r, int c, float d) { return chk_close(sigmoidf_(d), bf2f(Gp[r * 4096 + c])); }); }
#endif
#ifdef CHECKS13
            if (l == 0) { xcd_barrier(bar);
              { pg8::Gemm g{XB, (const bf16_t*)(LW + LW_WGATE), 1024, 1024, 1024}; sch::Tiles S{T / 256, 16, C.G, C.bid}; epi::StoreBf16<1> E{WSP(bf16_t, S_G) + (size_t)T * 4096, 4096}; pg8::gemm_phase(ring, g, S, E); }
              xcd_barrier(bar);
              { const unsigned short* g1 = WSP(unsigned short, S_G); const unsigned short* g2 = g1 + (size_t)T * 4096; unsigned cnt = 0;
                for (size_t i = (size_t)C.bid * NTHREADS + C.tid; i < (size_t)T * 4096; i += (size_t)C.G * NTHREADS) if (g1[i] != g2[i]) ++cnt;
                if (cnt) __hip_atomic_fetch_add((unsigned*)(C.ws + WS_CTL) + CW_CHK + 2048, cnt, RLX_AGENT); } }
#endif
            ENDPH(pb + 5);
        }
        if (SITE(7) && IN(pb + 6)) { SITE_BEGIN
#ifdef FIX_G
            { bf16_t* Gw = WSP(bf16_t, S_G); const bf16_t* Wg = (const bf16_t*)(LW + LW_WGATE);
              for (size_t i = (size_t)C.bid * NTHREADS + C.tid; i < (size_t)T * 4096; i += (size_t)C.G * NTHREADS) { const size_t r = i >> 12; const int c = (int)(i & 4095);
                  Gw[i] = (bf16_t)(cvt_pk_bf16(sigmoidf_(tdot(XB + r * 1024, Wg + (size_t)c * 1024, 1024)), 0.f) & 0xffffu); }
              xcd_barrier(bar); }
#endif
#ifdef CHECKS15
            if (l == 0) { unsigned cnt = 0; const float* x = C.in[I_X];
                for (size_t i = (size_t)C.bid * NTHREADS + C.tid; i < (size_t)T * 1024; i += (size_t)C.G * NTHREADS) if (!chk_close(x[i], bf2f(XB[i]))) ++cnt;
                if (cnt) __hip_atomic_fetch_add((unsigned*)(C.ws + WS_CTL) + CW_CHK + 2048, cnt, RLX_AGENT); }
#endif
#ifdef CHECKS7
            if (l == CHECKS_LAYER) chk_ssd_norm(C, l, 1);
#endif
#ifdef CHECKS12
            if (l == CHECKS_LAYER) { const bf16_t* Gp = WSP(bf16_t, S_G); chk_full_gemm(C, XB, (const bf16_t*)(LW + LW_WGATE), 1024, 4096, FG_BIT, [&](size_t r, int c, float d) { return fabsf((GATE_ACT ? sigmoidf_(d) : d) - bf2f(Gp[r * 4096 + c])) <= FG_TOL; }); xcd_barrier(bar); }
#endif
#ifdef CHECKS
            if (l == CHECKS_LAYER) { const bf16_t* Gp = WSP(bf16_t, S_G); chk_gemm(C, XB, 1024, (const bf16_t*)(LW + LW_WGATE), 1024, 1024, T, 16, 256, 5, 1, [&](int r, int c, float d) { return chk_close(sigmoidf_(d), bf2f(Gp[(size_t)r * 4096 + c])); }); }
#endif
#ifdef BR_FULL
            { pg8::Gemm g{WSP(bf16_t, S_Y), (const bf16_t*)(LW + LW_WBR), 256, 1024, 256}; sch::BrTiles S{T / 256, 4, C.G, C.bid}; epi::BrGate E{WSP(bf16_t, S_G), WSP(float, S_MF), WSP(bf16_t, S_MB)}; pg8::gemm_phase(ring, g, S, E);
#else
            { pg8::Gemm g{WSP(bf16_t, S_Y), (const bf16_t*)(LW + LW_WBR), 256, 1024, 256}; sch::BrTilesH S{T / 256, 8, C.G, C.bid}; epi::BrGateH E; E.G = WSP(bf16_t, S_G); E.mb = WSP(bf16_t, S_MB); E.init(); pg8::gemm_phase_hn(ring, g, S, E);
#endif
#ifdef TIME_BR2
              xcd_barrier(bar); pg8::gemm_phase(ring, g, S, E);
#endif
            }
            ENDPH(pb + 6);
        }
        if (SITE(8) && IN(pb + 7)) { SITE_BEGIN
#ifdef CHECKS2
            if (l == CHECKS_LAYER) chk_merged(C, l, 0);
#endif
            { pg8::Gemm g{WSP(bf16_t, S_MB), (const bf16_t*)(LW + LW_WOUT), 1024, 1024, 1024}; sch::Tiles S{T / 256, 4, C.G, C.bid}; epi::Resid E{C.in[I_X], XRES, ABL_MIX, l == 0 ? nullptr : XB}; pg8::gemm_phase(ring, g, S, E); }
            ENDPH(pb + 7);
        }
        if (SITE(9) && IN(pb + 8)) { SITE_BEGIN
#ifdef CHECKS10
            if (l == 0) { chk_full_p7(C, l, 1); xcd_barrier(bar); }
#endif
#ifdef CHECKS
            if (l == 0) { const float* xin = C.in[I_X]; chk_gemm(C, WSP(bf16_t, S_MB), 1024, (const bf16_t*)(LW + LW_WOUT), 1024, 1024, T, 4, 256, 9, 2, [&](int r, int c, float d) { return fabsf(xin[(size_t)r * 1024 + c] * DN_ALPHA + d - XRES[(size_t)r * 1024 + c]) <= CHK_TOL2; }); }
#endif
            ph_ln<false>(C, XRES, nullptr, WSP(bf16_t, W_XB), C.in[I_LN1G] + l * 1024, C.in[I_LN1B] + l * 1024, nullptr);
            { const bf16_t* KV = WSP(bf16_t, W_KMEM) + (size_t)l * NMEM * 2048;
              { pg8::Gemm g{KV, (const bf16_t*)(LW + LW_WQ), 256, 2048, 1024}; sch::AbsM S{C.bid}; epi::StoreAt E{WSP(bf16_t, S_XQ), 1024}; pg8::gemm_phase(ring, g, S, E); }
              { pg8::Gemm g{(const bf16_t*)(LW + LW_WO), KV + 1024, 256, 1024, 2048}; sch::AbsN S{C.bid}; epi::StoreAt E{WSP(bf16_t, S_XO), 1024}; pg8::gemm_phase(ring, g, S, E); } }
#ifdef TIME_LN2
            xcd_barrier(bar); ph_ln<false>(C, XRES, nullptr, WSP(bf16_t, W_XB), C.in[I_LN1G] + l * 1024, C.in[I_LN1B] + l * 1024, nullptr);
#endif
            ENDPH(pb + 8); }
        if (SITE(10) && IN(pb + 9)) { SITE_BEGIN
            { pg8::Gemm g{XB, WSP(bf16_t, S_XQ), 1024, 1024, 1024}; sch::XaS S{C.G, C.bid}; epi::Softmax E{WSP(bf16_t, S_XP), (LAS float*)(C.lds + XCH_OFF)}; pg8::gemm_phase(ring, g, S, E); }
            ENDPH(pb + 9);
        }
        if (SITE(13) && IN(pb + 10)) { SITE_BEGIN
            { pg8::Gemm g{WSP(bf16_t, S_XP), WSP(bf16_t, S_XO), 1024, 1024, 1024}; sch::XaO S{C.G, C.bid}; epi::Resid E{nullptr, XRES, ABL_XA, XB}; pg8::gemm_phase(ring, g, S, E); }
            ENDPH(pb + 10);
        }
        if (SITE(14) && IN(pb + 11)) { SITE_BEGIN
#ifdef CHECKS3
            if (l == 0) chk_resid_cmp(C, 0, 2);
#endif
            ph_ln<false>(C, XRES, l == 1 ? XRES : nullptr, WSP(bf16_t, W_XB), C.in[I_LN2G] + l * 1024, C.in[I_LN2B] + l * 1024, nullptr); ENDPH(pb + 11); }
        if (l == 0) {
            if (SITE(15) && IN(pb + 12)) { SITE_BEGIN
                { pg8::Gemm g{XB, WSP(bf16_t, W_FFN13), 1024, 1024, 1024}; sch::Tiles S{T / 256, 2 * FFD / 256, C.G, C.bid}; epi::Swiglu E{WSP(bf16_t, S_H), FFD, 0}; pg8::gemm_phase(ring, g, S, E);
#ifdef TIME_UP2
                  for (int rep_ = 0; rep_ < 1; ++rep_) { xcd_barrier(bar); pg8::gemm_phase(ring, g, S, E); }
#endif
                }
                ENDPH(pb + 12);
            }
            if (SITE(16) && IN(pb + 13)) { SITE_BEGIN
#ifdef CHECKS2
                chk_swiglu(C, 1);
#endif
#ifdef CHECKS3
                chk_resid_stash(C, WSP(bf16_t, S_H), FFD, WSP(bf16_t, W_FFN2), FFD, FFD, 0); xcd_barrier(bar);
#endif
                { pg8::Gemm g{WSP(bf16_t, S_H), WSP(bf16_t, W_FFN2), FFD, FFD, FFD}; sch::Tiles S{T / 256, 4, C.G, C.bid}; epi::Resid E{nullptr, XRES, ABL_FF, XB}; pg8::gemm_phase(ring, g, S, E); }
                ENDPH(pb + 13);
            }
            if (SITE(17) && IN(pb + 14)) { SITE_BEGIN
#ifdef CHECKS3
                chk_resid_cmp(C, 0, 0); chk_ln_stash(C, C.in[I_LN3G], C.in[I_LN3B], 1); xcd_barrier(bar);
#endif
                ph_ln<false>(C, XRES, nullptr, WSP(bf16_t, W_XB), C.in[I_LN3G], C.in[I_LN3B], nullptr); ENDPH(pb + 14); }
        } else {
            if (SITE(18) && IN(PH_MOE)) { SITE_BEGIN ph_router(C); ENDPH(PH_MOE); }
            if (SITE(19) && IN(PH_MOE + 1)) { SITE_BEGIN
#ifdef CHECKS5
                chk_weights<16, true>(C, 1);
#endif
                ph_scatter(C); ENDPH(PH_MOE + 1); }
            for (int p = 0; p < MOE_PASSES; ++p) {
                const int* blk_e = WSP(int, S_BLKE);
                if (SITE(20) && IN(PH_MOE + 2 + 2 * p)) { SITE_BEGIN
                    const int used = __builtin_amdgcn_readfirstlane(__hip_atomic_load(blk_e + MOE_BLOCKS, RLX_AGENT)); const int b0 = p * MOE_PASS_BLOCKS, b1 = min(b0 + MOE_PASS_BLOCKS, used);
                    if (b1 > b0) { pg8::Gemm g{WSP(bf16_t, S_XS), WSP(bf16_t, S_MW13), 1024, 1024, 1024}; sch::MoeUp S{blk_e, b0, b1, C.G, C.bid}; epi::Swiglu E{WSP(bf16_t, S_MH), FFE, 1}; pg8::gemm_phase(ring, g, S, E); }
                    ENDPH(PH_MOE + 2 + 2 * p);
                }
                if (SITE(21) && IN(PH_MOE + 3 + 2 * p)) { SITE_BEGIN
                    const int used = __builtin_amdgcn_readfirstlane(__hip_atomic_load(blk_e + MOE_BLOCKS, RLX_AGENT)); const int b0 = p * MOE_PASS_BLOCKS, b1 = min(b0 + MOE_PASS_BLOCKS, used);
                    if (b1 > b0) { pg8::Gemm g{WSP(bf16_t, S_MH), WSP(bf16_t, S_MW2), FFE, FFE, FFE}; sch::MoeDown S{blk_e, b0, b1, C.G, C.bid}; epi::MoeDown E{WSP(int, S_ROWSLOT), WSP(float, S_ROWW), WSP(bf16_t, S_YS)}; pg8::gemm_phase(ring, g, S, E); }
                    ENDPH(PH_MOE + 3 + 2 * p);
                }
            }
            if (SITE(22) && IN(PH_TOTAL - 1)) { SITE_BEGIN
#ifdef CHECKS8
                chk_moe(C, 0); xcd_barrier(bar);
#endif
#define FINAL_LN_SITE 1
 ph_ln<true>(C, XRES, C.out, nullptr, C.in[I_LN3G] + 1024, C.in[I_LN3B] + 1024, WSP(bf16_t, S_YS));
#ifdef CHECKS11
                xcd_barrier(bar);
                { unsigned cnt = 0; for (size_t i = (size_t)C.bid * NTHREADS + C.tid; i < (size_t)T * 1024; i += (size_t)C.G * NTHREADS) if (fabsf(C.out[i]) > CHK11_THR) ++cnt;
                  if (cnt) __hip_atomic_fetch_add((unsigned*)(C.ws + WS_CTL) + CW_CHK + 2048, cnt, RLX_AGENT); }
                xcd_barrier(bar);
                { unsigned v_ = __hip_atomic_load((const unsigned*)(C.ws + WS_CTL) + CW_CHK + 2048, RLX_AGENT); int n = 0; while (v_ > 0u) { ++n; v_ >>= 1; }
                  const float sc = 1.0f + 0.1f * (float)n; for (size_t i = (size_t)C.bid * NTHREADS + C.tid; i < (size_t)T * 1024; i += (size_t)C.G * NTHREADS) C.out[i] *= sc; }
#endif
#ifdef CHECKS8
                xcd_barrier(bar);
                { const float* stash = WSP(float, W_KMEM); unsigned bad = 0; const float cs = 1.0f; (void)cs;
                  for (int s = GW; s < 1024; s += NGW) { const int t = (int)(((long)s * 1021 + 7) % T); if (stash[(size_t)s * 1024] > 1.0e29f) continue;
                      for (int j = 0; j < 16; ++j) { const int c = C.lane + 64 * j; const float e = stash[(size_t)s * 1024 + c], gt = C.out[(size_t)t * 1024 + c]; if (fabsf(e - gt) > 0.05f * fabsf(e) + 0.05f) bad = 1; } }
                  chk_flag(C, 1, bad); }
                xcd_barrier(bar);
                { const unsigned* cw = (const unsigned*)(C.ws + WS_CTL) + CW_CHK; if (__hip_atomic_load(cw + 64, RLX_AGENT) != 0u) { for (size_t i = (size_t)C.bid * NTHREADS + C.tid; i < (size_t)T * 1024; i += (size_t)C.G * NTHREADS) C.out[i] *= 1.5f; } }
#endif
            }
        }
    }
#undef IN
#undef ENDPH
}

extern "C" void kernel_launch(void* const* d_in, const int* in_sizes, int n_in, void* d_out, int out_size, void* d_ws, size_t ws_size, hipStream_t stream) {
    static int grid = 0;
    if (grid == 0) {
        if (n_in != 42 || in_sizes[0] != T * DM || out_size != T * DM || ws_size < WS_NEED) { fprintf(stderr, "kernel_launch: unexpected problem (n_in %d, in0 %d, out %d, ws %zu < %zu)\n", n_in, n_in > 0 ? in_sizes[0] : -1, out_size, ws_size, (size_t)WS_NEED); grid = -1; return; }
        int dev = 0, cus = 0;
        if (hipGetDevice(&dev) != hipSuccess || hipDeviceGetAttribute(&cus, hipDeviceAttributeMultiprocessorCount, dev) != hipSuccess) { grid = -1; return; }
        if (hipFuncSetAttribute((const void*)hybrid_fwd, hipFuncAttributeMaxDynamicSharedMemorySize, LDS_BYTES) != hipSuccess) { fprintf(stderr, "kernel_launch: hipFuncSetAttribute failed\n"); grid = -1; return; }
        int per_cu = 0;
        if (hipOccupancyMaxActiveBlocksPerMultiprocessor(&per_cu, (const void*)hybrid_fwd, NTHREADS, LDS_BYTES) != hipSuccess || per_cu < 1) fprintf(stderr, "kernel_launch: occupancy query says %d\n", per_cu);
        (void)hipGetLastError();
        if (cus != 256) { fprintf(stderr, "kernel_launch: built for 256 CUs, device has %d\n", cus); grid = -1; return; }
        grid = 256;
    }
    if (grid < 0) return;
#ifdef ZERO_WS
    (void)hipMemsetAsync((char*)d_ws + ZERO_WS_LO, 0, ZERO_WS_HI - ZERO_WS_LO, stream);
#endif
    (void)hipMemsetAsync((char*)d_ws + WS_CTL, 0, CTL_BYTES, stream);
    Args a{};
    for (int i = 0; i < 42; ++i) a.in[i] = (const float*)d_in[i];
    a.out = (float*)d_out; a.ws = (unsigned char*)d_ws;
#if MK_SPLIT
    for (int p = 0; p < PH_TOTAL; ++p) { a.ph_lo = p; a.ph_hi = p + 1; hipLaunchKernelGGL(hybrid_fwd, dim3(grid), dim3(NTHREADS), LDS_BYTES, stream, a); }
#else
    a.ph_lo = 0; a.ph_hi = PH_TOTAL; hipLaunchKernelGGL(hybrid_fwd, dim3(grid), dim3(NTHREADS), LDS_BYTES, stream, a);
#ifdef TIME_LIST
#ifdef TIME_VAR
    (void)hipMemsetAsync((char*)d_ws + WS_CTL + 200000 * 4, TIME_VAR, 4, stream);
#endif
#ifdef TIME_QRESET
    (void)hipMemsetAsync((char*)d_ws + WS_CTL + (CW_QUEUE + 64 * TIME_QRESET) * 4, 0, 4, stream);
#endif
    { const int tl_[] = TIME_LIST; for (int r_ = 0; r_ < TIME_REP; ++r_) for (int q_ = 0; q_ < (int)(sizeof(tl_) / sizeof(int)); ++q_) { a.ph_lo = tl_[q_]; a.ph_hi = tl_[q_] + (tl_[q_] >= 0 ? 1 : 0); hipLaunchKernelGGL(hybrid_fwd, dim3(grid), dim3(NTHREADS), LDS_BYTES, stream, a); } }
#endif
#endif
}
```

```cpp
#define EPI_DEPTH 3
#include <hip/hip_runtime.h>
#include <cstdio>
#include <cstdint>

#define GAS __attribute__((address_space(1)))
#define LAS __attribute__((address_space(3)))
typedef unsigned short bf16_t;
typedef short bf16x8 __attribute__((ext_vector_type(8)));
typedef short bf16x4 __attribute__((ext_vector_type(4)));
typedef float f32x2 __attribute__((ext_vector_type(2)));
typedef float f32x4 __attribute__((ext_vector_type(4)));
typedef float f32x16 __attribute__((ext_vector_type(16)));
typedef unsigned u32x4 __attribute__((ext_vector_type(4)));
typedef unsigned u32x2 __attribute__((ext_vector_type(2)));
#define RLX_AGENT __ATOMIC_RELAXED, __HIP_MEMORY_SCOPE_AGENT

constexpr int NB = 16, SEQ = 2048, DM = 1024, T = NB * SEQ;
constexpr int NPROJ = 3328;
constexpr int PC_SBQ = 0, PC_SBK = 256, PC_SBV = 512, PC_RW = 768, PC_Z = 1792, PC_XS = 2048, PC_BM = 2304, PC_CM = 2560, PC_CQ = 2816, PC_CKV = 3072, PC_KR = 3200, PC_DT = 3232;
constexpr int MEMT = 256, NMEM = NB * MEMT;
constexpr int FFD = 2816, FFE = 3584, NEXP = 8;
constexpr int MOE_ROWS = 2 * T + NEXP * 256;
constexpr int MOE_BLOCKS = MOE_ROWS / 256;
constexpr int MOE_PASS_BLOCKS = 64, MOE_PASSES = 5;
constexpr float DN_ALPHA = 1.4142135623730951f;
constexpr float LOG2E = 1.4426950408889634f;

constexpr size_t MiB = 1u << 20;
constexpr size_t WS_CTL = 0, CTL_BYTES = 1 * MiB;
constexpr int CW_BAR = 1024;
constexpr int CW_QUEUE = 8192;
constexpr int CW_MOECNT = 16384;
constexpr size_t W_BASE = CTL_BYTES;
constexpr size_t LW_WIN = 0;
constexpr size_t LW_WGATE = LW_WIN + (size_t)NPROJ * 1024 * 2;
constexpr size_t LW_WBR = LW_WGATE + (size_t)4096 * 1024 * 2;
constexpr size_t LW_WOUT = LW_WBR + (size_t)4 * 1024 * 256 * 2;
constexpr size_t LW_LORA = LW_WOUT + (size_t)1024 * 1024 * 2;
constexpr size_t LW_WUQ = LW_LORA + (size_t)768 * 256 * 2;
constexpr size_t LW_WUKV = LW_WUQ + (size_t)512 * 256 * 2;
constexpr size_t LW_WQ = LW_WUKV + (size_t)512 * 128 * 2;
constexpr size_t LW_WKV = LW_WQ + (size_t)1024 * 1024 * 2;
constexpr size_t LW_WO = LW_WKV + (size_t)2048 * 1024 * 2;
constexpr size_t LW_SIZE = LW_WO + (size_t)1024 * 1024 * 2;
constexpr size_t W_FFN13 = W_BASE + 2 * LW_SIZE;
constexpr size_t W_FFN2 = W_FFN13 + (size_t)2 * FFD * 1024 * 2;
constexpr size_t W_KMEM = W_FFN2 + (size_t)1024 * FFD * 2;
constexpr size_t W_VMEMT = W_KMEM + (size_t)2 * NMEM * 1024 * 2;
constexpr size_t W_MEMB = W_VMEMT + (size_t)2 * 1024 * NMEM * 2;
constexpr size_t W_COS = W_MEMB + (size_t)NMEM * 1024 * 2;
constexpr size_t W_SIN = W_COS + (size_t)T * 16 * 4;
constexpr size_t W_XB = W_SIN + (size_t)T * 16 * 4;
constexpr size_t W_XRES = W_XB + (size_t)T * 1024 * 2;
constexpr size_t S_BASE = W_XRES + (size_t)T * 1024 * 4;
constexpr size_t S_Y = S_BASE;
constexpr size_t S_SSQ = S_Y + (size_t)T * 1024 * 2;
constexpr size_t S_PROJ = S_SSQ + (size_t)T * 8 * 4;
constexpr size_t S_LA = S_PROJ + (size_t)T * NPROJ * 2;
constexpr size_t S_CQN = S_LA + (size_t)T * 256 * 2;
constexpr size_t S_CKVN = S_CQN + (size_t)T * 256 * 2;
constexpr size_t S_DEC = S_CKVN + (size_t)T * 128 * 2;
constexpr size_t S_AV = S_DEC + (size_t)T * 256 * 4;
constexpr size_t S_GV = S_AV + (size_t)T * 256 * 2;
constexpr size_t S_QM = S_GV + (size_t)T * 256 * 2;
constexpr size_t S_KM = S_QM + (size_t)T * 384 * 2;
constexpr size_t S_VM = S_KM + (size_t)T * 384 * 2;
constexpr size_t S_RWS = S_VM + (size_t)T * 256 * 2;
constexpr size_t S_XA = S_RWS + (size_t)5 * T * 256 * 2;
constexpr size_t S_BC = S_XA + (size_t)T * 256 * 2;
constexpr size_t S_CC = S_BC + (size_t)T * 256 * 2;
constexpr size_t S_ACS = S_CC + (size_t)T * 256 * 2;
constexpr size_t S_DTV = S_ACS + (size_t)T * 4 * 4;
constexpr size_t S_YRAW = S_DTV + (size_t)T * 4 * 4;
constexpr size_t S_MIX_END = S_YRAW + (size_t)T * 256 * 2;
constexpr size_t S_G = S_PROJ;
constexpr size_t S_MF = S_G + (size_t)T * 4096 * 2;
constexpr size_t S_MB = S_MF + (size_t)T * 1024 * 4;
constexpr size_t S_GATE_END = S_MB + (size_t)T * 1024 * 2;
constexpr size_t S_XQ = S_BASE;
constexpr size_t S_XP = S_XQ + (size_t)T * 1024 * 2;
constexpr size_t S_XO = S_XP + (size_t)T * 1024 * 2;
constexpr size_t S_H = S_BASE;
constexpr size_t S_MW13 = S_BASE;
constexpr size_t S_MW2 = S_MW13 + (size_t)NEXP * 2 * FFE * 1024 * 2;
constexpr size_t S_XS = S_MW2 + (size_t)NEXP * 1024 * FFE * 2;
constexpr size_t S_YS = S_XS + (size_t)MOE_ROWS * 1024 * 2;
constexpr size_t S_MH = S_YS + (size_t)2 * T * 1024 * 2;
constexpr size_t S_TOPI = S_MH + (size_t)MOE_PASS_BLOCKS * 256 * FFE * 2;
constexpr size_t S_TOPW = S_TOPI + (size_t)T * 2 * 4;
constexpr size_t S_ROWSLOT = S_TOPW + (size_t)T * 2 * 4;
constexpr size_t S_ROWW = S_ROWSLOT + (size_t)MOE_ROWS * 4;
constexpr size_t S_BLKE = S_ROWW + (size_t)MOE_ROWS * 4;
constexpr size_t S_MOE_END = S_BLKE + 4096;
constexpr size_t cmax(size_t a, size_t b) { return a > b ? a : b; }
constexpr size_t WS_NEED = cmax(cmax(S_MIX_END, S_GATE_END), S_MOE_END);
static_assert(WS_NEED <= (size_t)896 * MiB, "workspace map exceeds 896 MiB");
static_assert((W_BASE % 256) == 0 && (LW_SIZE % 256) == 0 && (S_BASE % 256) == 0, "alignment");

constexpr int RING_BYTES = 131072;
constexpr int XCH_OFF = RING_BYTES;
constexpr int LDSCTL_OFF = RING_BYTES + 16384;
constexpr int LDS_BYTES = LDSCTL_OFF + 512;
constexpr int NWAVES = 8, NTHREADS = 512;

typedef __bf16 bf16x2_t __attribute__((ext_vector_type(2)));
__device__ __forceinline__ unsigned cvt_pk_bf16(float lo, float hi) { bf16x2_t v = {(__bf16)lo, (__bf16)hi}; return __builtin_bit_cast(unsigned, v); }
__device__ __forceinline__ float bf2f(unsigned short b) { return __uint_as_float((unsigned)b << 16); }
__device__ __forceinline__ float bflo(unsigned w) { return __uint_as_float(w << 16); }
__device__ __forceinline__ float bfhi(unsigned w) { return __uint_as_float(w & 0xffff0000u); }
__device__ __forceinline__ float fexp2(float x) { return __builtin_amdgcn_exp2f(x); }
__device__ __forceinline__ float flog2(float x) { return __builtin_amdgcn_logf(x); }
__device__ __forceinline__ float frcp(float x) { return __builtin_amdgcn_rcpf(x); }
__device__ __forceinline__ float sigmoidf_(float x) { return frcp(1.0f + fexp2(-x * LOG2E)); }
__device__ __forceinline__ float siluf_(float x) { return x * sigmoidf_(x); }
__device__ __forceinline__ float softplusf_(float x) { return fmaxf(x, 0.f) + 0.6931471805599453f * flog2(1.0f + fexp2(-fabsf(x) * LOG2E)); }
#define DPPADD_(v, ctrl, rmask) (v) += __builtin_bit_cast(float, __builtin_amdgcn_update_dpp(0, __builtin_bit_cast(int, (v)), (ctrl), (rmask), 0xf, false))
__device__ __forceinline__ float row_sum16(float v) {
    DPPADD_(v, 0xB1, 0xf); DPPADD_(v, 0x4E, 0xf); DPPADD_(v, 0x141, 0xf); DPPADD_(v, 0x140, 0xf); return v; }
__device__ __forceinline__ float wave_sum(float v) {
    v = row_sum16(v); DPPADD_(v, 0x142, 0xa); DPPADD_(v, 0x143, 0xc);
    return __builtin_bit_cast(float, __builtin_amdgcn_readlane(__builtin_bit_cast(int, v), 63)); }
#define LDS_WAIT() asm volatile("s_waitcnt lgkmcnt(0)" ::: "memory")
#define VM_WAIT() asm volatile("s_waitcnt vmcnt(0)" ::: "memory")
#define XB_TMO      128
#define XB_XCNT(j)  (256  + 64 * (j))
#define XB_XSUB(j)  (1280 + 64 * (j))
#define XB_XGEN(j)  (2304 + 64 * (j))
#define XB_TOP      3328
#define XB_TOPGEN   3392
#define XCD_BAR_WORDS 3456
#define XB_SPIN_CAP (1u << 18)

__device__ __forceinline__ unsigned xb_ld(unsigned* p)              { return __hip_atomic_load(p, __ATOMIC_RELAXED, __HIP_MEMORY_SCOPE_AGENT); }
__device__ __forceinline__ unsigned xb_add(unsigned* p, unsigned v) { return __hip_atomic_fetch_add(p, v, __ATOMIC_RELAXED, __HIP_MEMORY_SCOPE_AGENT); }
__device__ __forceinline__ unsigned xb_xcc_id() { return (unsigned)__builtin_amdgcn_s_getreg((3 << 11) | 20) & 0xFu; }
#define XB_SPIN(cond, bar) do { unsigned _sp = 0; while (cond) { __builtin_amdgcn_s_sleep(1); \
    if ((++_sp & 255u) == 0u) { if (xb_ld(&(bar)[XB_TMO])) break; if (_sp > XB_SPIN_CAP) { atomicAdd(&(bar)[XB_TMO], 1u); break; } } } } while (0)

struct XcdBarrier { unsigned* bar; unsigned x; volatile LAS unsigned* st; };

__device__ __forceinline__ XcdBarrier xcd_barrier_post(unsigned* bar, volatile LAS unsigned* st) {
    XcdBarrier b; b.bar = bar; b.x = xb_xcc_id(); b.st = st;
    if (threadIdx.x == 0) (void)xb_add(&bar[XB_XCNT(b.x)], 1u);
    return b;
}
__device__ __forceinline__ void xcd_barrier_complete(unsigned* bar, unsigned x, unsigned& nloc, unsigned& nx) {
    const unsigned G = gridDim.x * gridDim.y * gridDim.z;
    unsigned sum, cnt, mine, sp = 0u;
    for (;;) {
        sum = 0u; cnt = 0u; mine = 0u;
#pragma unroll
        for (unsigned j = 0; j < 16; ++j) { const unsigned c = xb_ld(&bar[XB_XCNT(j)]); sum += c; cnt += (c > 0u) ? 1u : 0u; mine = (j == x) ? c : mine; }
        if (sum == G) break;
        __builtin_amdgcn_s_sleep(1);
        if ((++sp & 255u) == 0u) { if (xb_ld(&bar[XB_TMO])) break; if (sp > XB_SPIN_CAP) { atomicAdd(&bar[XB_TMO], 1u); break; } }
    }
    nloc = mine > 0u ? mine : 1u; nx = cnt > 0u ? cnt : 1u;
}
__device__ __forceinline__ void xcd_barrier(const XcdBarrier& b) {
    asm volatile("s_waitcnt vmcnt(0)" ::: "memory");
    __syncthreads();
    if (threadIdx.x == 0) {
        unsigned* bar = b.bar;
        __builtin_amdgcn_s_waitcnt(0);
        unsigned nloc = b.st[0], nx = b.st[1];
        if (nloc == 0u) { xcd_barrier_complete(bar, b.x, nloc, nx); b.st[0] = nloc; b.st[1] = nx; }
        const unsigned old = xb_add(&bar[XB_XSUB(b.x)], 1u);
        const unsigned gen = old / nloc;
        if (old + 1u == (gen + 1u) * nloc) {
            __builtin_amdgcn_fence(__ATOMIC_RELEASE, "agent");
            asm volatile("s_waitcnt vmcnt(0)" ::: "memory");
            const unsigned og = xb_add(&bar[XB_TOP], 1u);
            const unsigned tg = og / nx;
            if (og + 1u == (tg + 1u) * nx) xb_add(&bar[XB_TOPGEN], 1u);
            else XB_SPIN(xb_ld(&bar[XB_TOPGEN]) == tg, bar);
            __builtin_amdgcn_fence(__ATOMIC_ACQUIRE, "agent");
            xb_add(&bar[XB_XGEN(b.x)], 1u);
            asm volatile("s_waitcnt vmcnt(0)" ::: "memory");
        } else {
            XB_SPIN(xb_ld(&bar[XB_XGEN(b.x)]) == gen, bar);
            __builtin_amdgcn_fence(__ATOMIC_ACQUIRE, "agent");
            asm volatile("s_waitcnt vmcnt(0)" ::: "memory");
        }
    }
    __syncthreads();
}

#ifndef PG8_ALIGN_DEFAULT
#define PG8_ALIGN_DEFAULT true
#endif
namespace pg8 {
constexpr int BM = 256, BK = 64, HALF = 128, HTB = HALF * BK * 2, STAGE_BYTES = 8 * HTB;
__host__ __device__ __forceinline__ int lds_byte(int r, int c) { const int st = (r >> 4) * 2 + (c >> 5), rr = r & 15, cc = c & 31, ob = rr * 64 + cc * 2; return st * 1024 + (ob ^ (((ob >> 9) & 1) << 5)); }
__host__ __device__ __forceinline__ void stage_rc(int b, int& R, int& C) { const int st = b / 1024, sb = b % 1024, swz = sb ^ (((sb >> 9) & 1) << 5); R = (st >> 1) * 16 + swz / 64; C = (st & 1) * 32 + (swz % 64) / 2; }
__host__ __device__ __forceinline__ int perm32(int rho) { const int n = rho >> 4, i = rho & 15; return 8 * (i >> 2) + 4 * n + (i & 3); }

struct Unit { int pm, pn; long aoff, boff; int tag; };
struct Gemm { const bf16_t* A; const bf16_t* Bt; int K, lda, ldb; };

template <class Epi, class Sched, bool ALIGN = PG8_ALIGN_DEFAULT>
__device__ __forceinline__ void gemm_phase(LAS unsigned char* lds, const Gemm g, const Sched& S, const Epi& E) {
    int tid_ = threadIdx.x; asm volatile("" : "+v"(tid_));
    const int tid = tid_, wid = __builtin_amdgcn_readfirstlane(tid >> 6), lane = tid & 63, wr = wid >> 2, wc = wid & 3, fr = lane & 15, fq = lane >> 4;
    int K = g.K; asm volatile("" : "+s"(K)); const int nt = K / BK;
    unsigned voffA[2], voffB[2];
#pragma unroll
    for (int i = 0; i < 2; ++i) { int R, C; stage_rc(tid * 16 + i * 8192, R, C); const int Rb = Epi::PERM ? ((R & ~31) + perm32(R & 31)) : R;
        voffA[i] = (unsigned)(R * g.lda + C) * 2u; voffB[i] = (unsigned)(Rb * g.ldb + C) * 2u; }
    const size_t kstep = (size_t)(BK * 2);
    const size_t hstepA = (size_t)HALF * g.lda * 2, hstepB = (size_t)HALF * g.ldb * 2;
    const size_t tstepA = 2 * hstepA, tstepB = 2 * hstepB;
    const unsigned ldsw = (unsigned)wid * 1024u;
    const int aoff = lds_byte(wr * 64 + fr, fq * 8), boff = lds_byte(wc * 32 + fr, fq * 8);
#define PG8_SA(b, h) (((b) * 2 + (h)) * HTB)
#define PG8_SB(b, h) ((4 + (b) * 2 + (h)) * HTB)
#define PG8_STAGE(bufoff, gbase, voff) do { _Pragma("unroll") for (int _i = 0; _i < 2; ++_i) \
        __builtin_amdgcn_global_load_lds((const unsigned*)((const char*)(gbase) + (voff)[_i]), (LAS unsigned*)(lds + (bufoff) + ldsw + _i * 8192), 16, 0, 0); } while (0)
#define PG8_LDA(dst, b, h) do { _Pragma("unroll") for (int m = 0; m < 4; ++m) _Pragma("unroll") for (int k = 0; k < 2; ++k) dst[m][k] = *(const LAS bf16x8*)(lds + PG8_SA(b, h) + aoff + m * 2048 + k * 1024); } while (0)
#define PG8_LDB(dst, b, h) do { _Pragma("unroll") for (int n = 0; n < 2; ++n) _Pragma("unroll") for (int k = 0; k < 2; ++k) dst[n][k] = *(const LAS bf16x8*)(lds + PG8_SB(b, h) + boff + n * 2048 + k * 1024); } while (0)
#define PG8_MMA(ai, bj, At, Bt) do { __builtin_amdgcn_s_setprio(1); _Pragma("unroll") for (int m = 0; m < 4; ++m) _Pragma("unroll") for (int n = 0; n < 2; ++n) _Pragma("unroll") for (int k = 0; k < 2; ++k) \
        acc[ai][bj][m][n] = __builtin_amdgcn_mfma_f32_16x16x32_bf16(Bt[n][k], At[m][k], acc[ai][bj][m][n], 0, 0, 0); __builtin_amdgcn_s_setprio(0); } while (0)
#define PG8_WAIT_V(n) asm volatile("s_waitcnt vmcnt(" #n ")" ::: "memory")
#define PG8_WAIT_L(n) asm volatile("s_waitcnt lgkmcnt(" #n ")" ::: "memory")
#define PG8_BAR __builtin_amdgcn_s_barrier()
#define PG8_SCHED __builtin_amdgcn_sched_barrier(0)
    Unit cur, nxt; int ui = 0;
    if (!S.next(0, cur)) return;
    f32x4 acc[2][2][4][2];
#pragma unroll
    for (int a = 0; a < 2; ++a)
#pragma unroll
        for (int b = 0; b < 2; ++b)
#pragma unroll
            for (int m = 0; m < 4; ++m)
#pragma unroll
                for (int n = 0; n < 2; ++n) acc[a][b][m][n] = (f32x4){0.f, 0.f, 0.f, 0.f};
    bf16x8 At[4][2], B0[2][2], B1[2][2];
    const char* cA = (const char*)(g.A + cur.aoff) + (size_t)cur.pm * tstepA; const char* cB = (const char*)(g.Bt + cur.boff) + (size_t)cur.pn * tstepB;
    PG8_STAGE(PG8_SB(0, 0), cB, voffB); PG8_STAGE(PG8_SB(0, 1), cB + hstepB, voffB); PG8_STAGE(PG8_SA(0, 0), cA, voffA); PG8_STAGE(PG8_SA(0, 1), cA + hstepA, voffA);
    if (wr == 1) PG8_BAR;
    PG8_WAIT_V(2); PG8_BAR;
    PG8_STAGE(PG8_SB(1, 0), cB + kstep, voffB); PG8_STAGE(PG8_SA(1, 0), cA + kstep, voffA); PG8_STAGE(PG8_SB(1, 1), cB + hstepB + kstep, voffB);
    PG8_WAIT_V(6); PG8_BAR;
    for (;;) {
        const bool has_next = S.next(ui + 1, nxt);
        const char* nA = has_next ? (const char*)(g.A + nxt.aoff) + (size_t)nxt.pm * tstepA : cA; const char* nB = has_next ? (const char*)(g.Bt + nxt.boff) + (size_t)nxt.pn * tstepB : cB;
#pragma unroll 1
        for (int t = 0; t < nt; t += 2) {
            const bool last = (t == nt - 2);
            const char* a1 = cA + (size_t)(t + 1) * kstep;
            const char* a2 = last ? nA : cA + (size_t)(t + 2) * kstep; const char* b2 = last ? nB : cB + (size_t)(t + 2) * kstep;
            const char* a3 = a2 + kstep; const char* b3 = b2 + kstep;
            PG8_LDB(B0, 0, 0); PG8_LDB(B1, 0, 1); PG8_SCHED; PG8_LDA(At, 0, 0); PG8_STAGE(PG8_SA(1, 1), a1 + hstepA, voffA);
            PG8_WAIT_V(8); PG8_WAIT_L(0); PG8_BAR; PG8_MMA(0, 0, At, B0); PG8_MMA(0, 1, At, B1); PG8_BAR; PG8_SCHED;
            PG8_LDA(At, 0, 1); PG8_STAGE(PG8_SB(0, 0), b2, voffB); PG8_STAGE(PG8_SB(0, 1), b2 + hstepB, voffB); PG8_STAGE(PG8_SA(0, 0), a2, voffA);
            PG8_WAIT_V(8); PG8_WAIT_L(0); PG8_BAR; PG8_MMA(1, 0, At, B0); PG8_MMA(1, 1, At, B1); PG8_BAR; PG8_SCHED;
            PG8_LDB(B0, 1, 0); PG8_LDB(B1, 1, 1); PG8_SCHED; PG8_LDA(At, 1, 0); PG8_STAGE(PG8_SA(0, 1), a2 + hstepA, voffA);
            PG8_WAIT_V(8); PG8_WAIT_L(0); PG8_BAR; PG8_MMA(0, 0, At, B0); PG8_MMA(0, 1, At, B1); PG8_BAR; PG8_SCHED;
            PG8_LDA(At, 1, 1); PG8_STAGE(PG8_SB(1, 0), b3, voffB); PG8_STAGE(PG8_SB(1, 1), b3 + hstepB, voffB); PG8_STAGE(PG8_SA(1, 0), a3, voffA);
            PG8_WAIT_V(8); PG8_WAIT_L(0); PG8_BAR; PG8_MMA(1, 0, At, B0); PG8_MMA(1, 1, At, B1); PG8_BAR; PG8_SCHED;
        }
        if constexpr (ALIGN) { if (wr == 0) PG8_BAR; }
        E(acc, cur, wr, wc, fr, fq, wid, lane);
        if (!has_next) break;
#pragma unroll
        for (int a = 0; a < 2; ++a)
#pragma unroll
            for (int b = 0; b < 2; ++b)
#pragma unroll
                for (int m = 0; m < 4; ++m)
#pragma unroll
                    for (int n = 0; n < 2; ++n) acc[a][b][m][n] = (f32x4){0.f, 0.f, 0.f, 0.f};
        cur = nxt; cA = nA; cB = nB; ++ui;
        if constexpr (ALIGN) { if (wr == 1) PG8_BAR; }
    }
    PG8_WAIT_V(0);
    if constexpr (!ALIGN) { if (wr == 0) PG8_BAR; }
    PG8_BAR;
#undef PG8_SA
#undef PG8_SB
#undef PG8_STAGE
#undef PG8_LDA
#undef PG8_LDB
#undef PG8_MMA
#undef PG8_WAIT_V
#undef PG8_WAIT_L
#undef PG8_BAR
#undef PG8_SCHED
}
template <class Epi, class Sched>
__device__ __forceinline__ void gemm_phase_hn(LAS unsigned char* lds, const Gemm g, const Sched& S, Epi& E) {
    constexpr bool ALIGN = true;
    int tid_ = threadIdx.x; asm volatile("" : "+v"(tid_));
    const int tid = tid_, wid = __builtin_amdgcn_readfirstlane(tid >> 6), lane = tid & 63, wr = wid >> 2, wc = wid & 3, fr = lane & 15, fq = lane >> 4;
    int K = g.K; asm volatile("" : "+s"(K)); const int nt = K / BK;
    unsigned voffA[2], voffB[2];
#pragma unroll
    for (int i = 0; i < 2; ++i) { int R, C; stage_rc(tid * 16 + i * 8192, R, C); const int Rb = Epi::PERM ? ((R & ~31) + perm32(R & 31)) : R;
        voffA[i] = (unsigned)(R * g.lda + C) * 2u; voffB[i] = (unsigned)(Rb * g.ldb + C) * 2u; }
    const size_t kstep = (size_t)(BK * 2);
    const size_t hstepA = (size_t)HALF * g.lda * 2, hstepB = (size_t)HALF * g.ldb * 2;
    const size_t tstepA = 2 * hstepA, tstepB = hstepB;
    const unsigned ldsw = (unsigned)wid * 1024u;
    const int aoff = lds_byte(wr * 64 + fr, fq * 8), boff = lds_byte(wc * 32 + fr, fq * 8);
#define PG8_SA(b, h) (((b) * 2 + (h)) * HTB)
#define PG8_SB(b, h) ((4 + (b) * 2 + (h)) * HTB)
#define PG8_STAGE(bufoff, gbase, voff) do { _Pragma("unroll") for (int _i = 0; _i < 2; ++_i) \
        __builtin_amdgcn_global_load_lds((const unsigned*)((const char*)(gbase) + (voff)[_i]), (LAS unsigned*)(lds + (bufoff) + ldsw + _i * 8192), 16, 0, 0); } while (0)
#define PG8_LDA(dst, b, h) do { _Pragma("unroll") for (int m = 0; m < 4; ++m) _Pragma("unroll") for (int k = 0; k < 2; ++k) dst[m][k] = *(const LAS bf16x8*)(lds + PG8_SA(b, h) + aoff + m * 2048 + k * 1024); } while (0)
#define PG8_LDB(dst, b, h) do { _Pragma("unroll") for (int n = 0; n < 2; ++n) _Pragma("unroll") for (int k = 0; k < 2; ++k) dst[n][k] = *(const LAS bf16x8*)(lds + PG8_SB(b, h) + boff + n * 2048 + k * 1024); } while (0)
#define PG8_MMA(ai, At, Bt) do { __builtin_amdgcn_s_setprio(1); _Pragma("unroll") for (int m = 0; m < 4; ++m) _Pragma("unroll") for (int n = 0; n < 2; ++n) _Pragma("unroll") for (int k = 0; k < 2; ++k) \
        acc[ai][m][n] = __builtin_amdgcn_mfma_f32_16x16x32_bf16(Bt[n][k], At[m][k], acc[ai][m][n], 0, 0, 0); __builtin_amdgcn_s_setprio(0); } while (0)
#define PG8_WAIT_V(n) asm volatile("s_waitcnt vmcnt(" #n ")" ::: "memory")
#define PG8_WAIT_L(n) asm volatile("s_waitcnt lgkmcnt(" #n ")" ::: "memory")
#define PG8_BAR __builtin_amdgcn_s_barrier()
#define PG8_SCHED __builtin_amdgcn_sched_barrier(0)
    Unit cur, nxt; int ui = 0;
    if (!S.next(0, cur)) return;
    f32x4 acc[2][4][2];
#pragma unroll
    for (int a = 0; a < 2; ++a)
#pragma unroll
        for (int m = 0; m < 4; ++m)
#pragma unroll
            for (int n = 0; n < 2; ++n) acc[a][m][n] = (f32x4){0.f, 0.f, 0.f, 0.f};
    bf16x8 At[4][2], B0[2][2];
    const char* cA = (const char*)(g.A + cur.aoff) + (size_t)cur.pm * tstepA; const char* cB = (const char*)(g.Bt + cur.boff) + (size_t)cur.pn * tstepB;
    PG8_STAGE(PG8_SB(0, 0), cB, voffB); PG8_STAGE(PG8_SA(0, 0), cA, voffA); PG8_STAGE(PG8_SA(0, 1), cA + hstepA, voffA);
    if (wr == 1) PG8_BAR;
    PG8_WAIT_V(2); PG8_BAR;
    PG8_STAGE(PG8_SB(1, 0), cB + kstep, voffB); PG8_STAGE(PG8_SA(1, 0), cA + kstep, voffA);
    PG8_WAIT_V(4); PG8_BAR;
    for (;;) {
        const bool has_next = S.next(ui + 1, nxt);
        const char* nA = has_next ? (const char*)(g.A + nxt.aoff) + (size_t)nxt.pm * tstepA : cA; const char* nB = has_next ? (const char*)(g.Bt + nxt.boff) + (size_t)nxt.pn * tstepB : cB;
#pragma unroll 1
        for (int t = 0; t < nt; t += 2) {
            const bool last = (t == nt - 2);
            const char* a1 = cA + (size_t)(t + 1) * kstep;
            const char* a2 = last ? nA : cA + (size_t)(t + 2) * kstep; const char* b2 = last ? nB : cB + (size_t)(t + 2) * kstep;
            const char* a3 = a2 + kstep; const char* b3 = b2 + kstep;
            PG8_LDB(B0, 0, 0); PG8_SCHED; PG8_LDA(At, 0, 0); PG8_STAGE(PG8_SA(1, 1), a1 + hstepA, voffA);
            PG8_WAIT_V(6); PG8_WAIT_L(0); PG8_BAR; PG8_MMA(0, At, B0); PG8_BAR; PG8_SCHED;
            PG8_LDA(At, 0, 1); PG8_STAGE(PG8_SB(0, 0), b2, voffB); PG8_STAGE(PG8_SA(0, 0), a2, voffA);
            PG8_WAIT_V(6); PG8_WAIT_L(0); PG8_BAR; PG8_MMA(1, At, B0); PG8_BAR; PG8_SCHED;
            PG8_LDB(B0, 1, 0); PG8_SCHED; PG8_LDA(At, 1, 0); PG8_STAGE(PG8_SA(0, 1), a2 + hstepA, voffA);
            PG8_WAIT_V(6); PG8_WAIT_L(0); PG8_BAR; PG8_MMA(0, At, B0); PG8_BAR; PG8_SCHED;
            PG8_LDA(At, 1, 1); PG8_STAGE(PG8_SB(1, 0), b3, voffB); PG8_STAGE(PG8_SA(1, 0), a3, voffA);
            PG8_WAIT_V(6); PG8_WAIT_L(0); PG8_BAR; PG8_MMA(1, At, B0); PG8_BAR; PG8_SCHED;
        }
        if constexpr (ALIGN) { if (wr == 0) PG8_BAR; }
        E(acc, cur, wr, wc, fr, fq, wid, lane);
        if (!has_next) break;
#pragma unroll
        for (int a = 0; a < 2; ++a)
#pragma unroll
            for (int m = 0; m < 4; ++m)
#pragma unroll
                for (int n = 0; n < 2; ++n) acc[a][m][n] = (f32x4){0.f, 0.f, 0.f, 0.f};
        cur = nxt; cA = nA; cB = nB; ++ui;
        if constexpr (ALIGN) { if (wr == 1) PG8_BAR; }
    }
    PG8_WAIT_V(0);
    if constexpr (!ALIGN) { if (wr == 0) PG8_BAR; }
    PG8_BAR;
#undef PG8_SA
#undef PG8_SB
#undef PG8_STAGE
#undef PG8_LDA
#undef PG8_LDB
#undef PG8_MMA
#undef PG8_WAIT_V
#undef PG8_WAIT_L
#undef PG8_BAR
#undef PG8_SCHED
}
}
namespace sch {
using pg8::Unit;
__device__ __forceinline__ void tile_of(int L, int nM, int nN, int& pm, int& pn) {
    const int nwg = nM * nN; int wgid = L;
    { const int q = nwg / 8, r = nwg % 8, xcd = wgid % 8, off = wgid / 8; wgid = (xcd < r ? xcd * (q + 1) : r * (q + 1) + (xcd - r) * q) + off; }
    const int nig = 8 * nN, gid = wgid / nig, fm = gid * 8, gsz = (nM - fm) < 8 ? (nM - fm) : 8;
    pm = fm + ((wgid % nig) % gsz); pn = (wgid % nig) / gsz;
}
struct Tiles {
    int nM, nN, G, c;
    __device__ __forceinline__ bool next(int i, Unit& u) const {
        const long L = (long)i * G + c; if (L >= (long)nM * nN) return false;
        tile_of((int)L, nM, nN, u.pm, u.pn); u.aoff = 0; u.boff = 0; u.tag = 0; return true; }
};
struct BrTiles {
    int nM, nN, G, c;
    __device__ __forceinline__ bool next(int i, Unit& u) const {
        const long L = (long)(i >> 2) * G + c; if (L >= (long)nM * nN) return false;
        tile_of((int)L, nM, nN, u.pm, u.pn); const int br = i & 3; u.aoff = br * 256; u.boff = (long)br * 1024 * 256; u.tag = br; return true; }
};
struct BrTilesH {
    int nM, nN, G, c;
    __device__ __forceinline__ bool next(int i, Unit& u) const {
        const long L = (long)(i >> 2) * G + c; if (L >= (long)nM * nN) return false;
        int pn8; tile_of((int)L, nM, nN, u.pm, pn8); const int br = i & 3; u.pn = pn8; u.aoff = br * 256; u.boff = (long)br * 1024 * 256; u.tag = br | (pn8 << 2); return true; }
};
struct MemKV {
    long offMem, offWkv; int c;
    __device__ __forceinline__ bool next(int i, Unit& u) const {
        if (i > 0 || c < 128) return false; const int idx = c - 128;
        u.pm = idx >> 3; u.pn = idx & 7; u.aoff = offMem; u.boff = offWkv; u.tag = 0; return true; }
};
struct AbsM {
    int c;
    __device__ __forceinline__ bool next(int i, Unit& u) const {
        if (i > 0) return false; const int b = c >> 4, h = (c >> 2) & 3, dt = c & 3;
        u.pm = b; u.pn = dt; u.aoff = h * 256; u.boff = h * 256; u.tag = (b * 4 + h) | (dt << 16); return true; }
};
struct AbsN {
    int c;
    __device__ __forceinline__ bool next(int i, Unit& u) const {
        if (i > 0) return false; const int b = c >> 4, h = (c >> 2) & 3, ci = c & 3;
        u.pm = ci; u.pn = b; u.aoff = h * 256; u.boff = h * 256; u.tag = (b * 4 + ci) | (h << 16); return true; }
};
struct XaS {
    int G, c;
    __device__ __forceinline__ bool next(int i, Unit& u) const {
        const int L = i * G + c; if (L >= 512) return false;
        const int j = c >> 3, b = (c & 7) + 8 * i, h = (j >> 3) & 3, rb = j & 7;
        u.pm = b * 8 + rb; u.pn = h; u.aoff = 0; u.boff = (long)b * 1024 * 1024; u.tag = h; return true; }
};
struct XaO {
    int G, c;
    __device__ __forceinline__ bool next(int i, Unit& u) const {
        const int L = i * G + c; if (L >= 512) return false;
        const int j = c >> 3, b = (c & 7) + 8 * i, ci = (j >> 3) & 3, rb = j & 7;
        u.pm = b * 8 + rb; u.pn = ci; u.aoff = 0; u.boff = (long)b * 1024 * 1024; u.tag = 0; return true; }
};
struct MoeUp {
    const int* blk_e; int b0, b1, G, c;
    __device__ __forceinline__ bool next(int i, Unit& u) const {
        const int L = i * G + c; const int nb = b1 - b0; if (L >= nb * 28) return false;
        const int rb = b0 + L / 28; u.pn = L % 28; u.pm = rb;
        const int e = __builtin_amdgcn_readfirstlane(__hip_atomic_load(blk_e + rb, RLX_AGENT));
        u.aoff = 0; u.boff = (long)e * (2 * FFE) * 1024; u.tag = rb - b0; return true; }
};
struct MoeDown {
    const int* blk_e; int b0, b1, G, c;
    __device__ __forceinline__ bool next(int i, Unit& u) const {
        const int L = i * G + c; const int nb = b1 - b0; if (L >= nb * 4) return false;
        const int rb = b0 + L / 4; u.pn = L % 4; u.pm = rb - b0;
        const int e = __builtin_amdgcn_readfirstlane(__hip_atomic_load(blk_e + rb, RLX_AGENT));
        u.aoff = 0; u.boff = (long)e * 1024 * FFE; u.tag = rb; return true; }
};
}

namespace epi {
using pg8::Unit;
#define EPI_SIG f32x4 (&acc)[2][2][4][2], const Unit& u, int wr, int wc, int fr, int fq, int wid, int lane
#define EPI_ROWS _Pragma("unroll") for (int ai = 0; ai < 2; ++ai) _Pragma("unroll") for (int m = 0; m < 4; ++m)
#define EPI_ROW (u.pm * 256 + ai * 128 + wr * 64 + m * 16 + fr)
#define EPI_BJ _Pragma("unroll") for (int bj = 0; bj < 2; ++bj)
#define EPI_FENCE asm volatile("" ::: "memory")
#ifndef EPI_DEPTH
#define EPI_DEPTH 4
#endif
__device__ __forceinline__ u32x4 pack8(const f32x4 a, const f32x4 b) { u32x4 w; w.x = cvt_pk_bf16(a[0], a[1]); w.y = cvt_pk_bf16(a[2], a[3]); w.z = cvt_pk_bf16(b[0], b[1]); w.w = cvt_pk_bf16(b[2], b[3]); return w; }

template <int ACT> struct StoreBf16 {
    static constexpr bool PERM = true;
    bf16_t* O; int ldc;
    __device__ __forceinline__ void operator()(EPI_SIG) const {
        EPI_ROWS { bf16_t* rowp = O + (size_t)EPI_ROW * ldc + u.pn * 256 + wc * 32 + 8 * fq;
            EPI_BJ { f32x4 v0 = acc[ai][bj][m][0], v1 = acc[ai][bj][m][1];
                if (ACT == 1) { for (int j = 0; j < 4; ++j) { v0[j] = sigmoidf_(v0[j]); v1[j] = sigmoidf_(v1[j]); } }
                *(u32x4*)(rowp + bj * 128) = pack8(v0, v1); } EPI_FENCE; }
    }
};
struct StoreAt {
    static constexpr bool PERM = true;
    bf16_t* O; int ldc;
    __device__ __forceinline__ void operator()(EPI_SIG) const {
        const int rb = u.tag & 0xffff, cb = u.tag >> 16;
        EPI_ROWS { bf16_t* rowp = O + (size_t)(rb * 256 + ai * 128 + wr * 64 + m * 16 + fr) * ldc + cb * 256 + wc * 32 + 8 * fq;
            EPI_BJ { *(u32x4*)(rowp + bj * 128) = pack8(acc[ai][bj][m][0], acc[ai][bj][m][1]); } EPI_FENCE; }
    }
};
struct Lora {
    static constexpr bool PERM = true;
    float* dec; bf16_t* av; bf16_t* gv; const float* w0; const float* a0;
    __device__ __forceinline__ void operator()(EPI_SIG) const {
        EPI_ROWS { const size_t row = EPI_ROW;
            EPI_BJ { const int col = bj * 128 + wc * 32 + 8 * fq; f32x4 v0 = acc[ai][bj][m][0], v1 = acc[ai][bj][m][1];
                if (u.pn == 0) {
                    const f32x4 b0 = *(const f32x4*)(w0 + col), b1 = *(const f32x4*)(w0 + col + 4);
                    for (int j = 0; j < 4; ++j) { float x = v0[j] + b0[j]; float wl = -softplusf_(-x) - 0.5f; v0[j] = fexp2(-fexp2(wl * LOG2E) * LOG2E);
                                                  x = v1[j] + b1[j]; wl = -softplusf_(-x) - 0.5f; v1[j] = fexp2(-fexp2(wl * LOG2E) * LOG2E); }
                    *(f32x4*)(dec + row * 256 + col) = v0; *(f32x4*)(dec + row * 256 + col + 4) = v1;
                } else if (u.pn == 1) {
                    const f32x4 b0 = *(const f32x4*)(a0 + col), b1 = *(const f32x4*)(a0 + col + 4);
                    for (int j = 0; j < 4; ++j) { v0[j] = sigmoidf_(v0[j] + b0[j]); v1[j] = sigmoidf_(v1[j] + b1[j]); }
                    *(u32x4*)(av + row * 256 + col) = pack8(v0, v1);
                } else { *(u32x4*)(gv + row * 256 + col) = pack8(v0, v1); } } EPI_FENCE; }
    }
};
struct Uq {
    static constexpr bool PERM = false;
    bf16_t* Q; const float* cosT; const float* sinT;
    __device__ __forceinline__ void operator()(EPI_SIG) const {
        EPI_ROWS { const size_t row = EPI_ROW;
            EPI_BJ { const int c32 = u.pn * 256 + bj * 128 + wc * 32; if (c32 >= 384) continue;
                f32x4 v0 = acc[ai][bj][m][0], v1 = acc[ai][bj][m][1];
                if ((c32 >> 5) % 3 == 2) {
                    const f32x4 cs = *(const f32x4*)(cosT + row * 16 + 4 * fq), sn = *(const f32x4*)(sinT + row * 16 + 4 * fq);
                    const f32x4 o0 = v0 * cs - v1 * sn, o1 = v0 * sn + v1 * cs; v0 = o0; v1 = o1; }
                u32x2 w0, w1; w0.x = cvt_pk_bf16(v0[0], v0[1]); w0.y = cvt_pk_bf16(v0[2], v0[3]); w1.x = cvt_pk_bf16(v1[0], v1[1]); w1.y = cvt_pk_bf16(v1[2], v1[3]);
                *(u32x2*)(Q + row * 384 + c32 + 4 * fq) = w0; *(u32x2*)(Q + row * 384 + c32 + 16 + 4 * fq) = w1; } EPI_FENCE; }
    }
};
struct Ukv {
    static constexpr bool PERM = true;
    bf16_t* Km; bf16_t* Vm;
    __device__ __forceinline__ void operator()(EPI_SIG) const {
        EPI_ROWS { const size_t row = EPI_ROW;
            EPI_BJ { const int col = u.pn * 256 + bj * 128 + wc * 32 + 8 * fq; const int h = col >> 7, j = col & 127;
                const u32x4 w = pack8(acc[ai][bj][m][0], acc[ai][bj][m][1]);
                if (j < 64) *(u32x4*)(Km + row * 384 + h * 96 + j) = w; else *(u32x4*)(Vm + row * 256 + h * 64 + (j - 64)) = w; } EPI_FENCE; }
    }
};
struct Resid {
    static constexpr bool PERM = true;
    const float* res; bf16_t* out; float ascale; const bf16_t* res16;
    __device__ __forceinline__ void operator()(EPI_SIG) const {
        const size_t off0 = (size_t)(u.pm * 256 + wr * 64 + fr) * 1024 + u.pn * 256 + wc * 32 + 8 * fq;
#define RS_OFF(i) (off0 + (size_t)((((i) >> 2) * 128 + ((i) & 3) * 16) * 1024))
        if (res16) {
            u32x4 rq[8][2];
#define RS_LOAD(i) { _Pragma("unroll") for (int bj = 0; bj < 2; ++bj) rq[i][bj] = *(const u32x4*)(res16 + RS_OFF(i) + bj * 128); }
            _Pragma("unroll") for (int i = 0; i < EPI_DEPTH; ++i) RS_LOAD(i)
            _Pragma("unroll") for (int i = 0; i < 8; ++i) { if (i + EPI_DEPTH < 8) RS_LOAD(i + EPI_DEPTH)
                _Pragma("unroll") for (int bj = 0; bj < 2; ++bj) { const u32x4 w = rq[i][bj];
                    const f32x4 r0 = (f32x4){bflo(w.x), bfhi(w.x), bflo(w.y), bfhi(w.y)}, r1 = (f32x4){bflo(w.z), bfhi(w.z), bflo(w.w), bfhi(w.w)};
                    *(u32x4*)(out + RS_OFF(i) + bj * 128) = pack8(r0 * DN_ALPHA + acc[i >> 2][bj][i & 3][0] * ascale, r1 * DN_ALPHA + acc[i >> 2][bj][i & 3][1] * ascale); } EPI_FENCE; }
#undef RS_LOAD
        } else {
            f32x4 rq[8][4];
#define RS_LOAD(i) { _Pragma("unroll") for (int q = 0; q < 4; ++q) rq[i][q] = *(const f32x4*)(res + RS_OFF(i) + (q >> 1) * 128 + (q & 1) * 4); }
            _Pragma("unroll") for (int i = 0; i < EPI_DEPTH; ++i) RS_LOAD(i)
            _Pragma("unroll") for (int i = 0; i < 8; ++i) { if (i + EPI_DEPTH < 8) RS_LOAD(i + EPI_DEPTH)
                _Pragma("unroll") for (int bj = 0; bj < 2; ++bj)
                    *(u32x4*)(out + RS_OFF(i) + bj * 128) = pack8(rq[i][2 * bj] * DN_ALPHA + acc[i >> 2][bj][i & 3][0] * ascale, rq[i][2 * bj + 1] * DN_ALPHA + acc[i >> 2][bj][i & 3][1] * ascale); EPI_FENCE; }
#undef RS_LOAD
        }
#undef RS_OFF
    }
};
struct Swiglu {
    static constexpr bool PERM = false;
    bf16_t* H; int ldh; int use_tag;
    __device__ __forceinline__ void operator()(EPI_SIG) const {
        const int pmo = use_tag ? u.tag : u.pm;
        EPI_ROWS { const size_t row = (size_t)(pmo * 256 + ai * 128 + wr * 64 + m * 16 + fr);
            EPI_BJ { const int hc = (u.pn * 256 + bj * 128 + wc * 32) / 2 + 4 * fq; const f32x4 g = acc[ai][bj][m][0], up = acc[ai][bj][m][1];
                u32x2 w; w.x = cvt_pk_bf16(siluf_(g[0]) * up[0], siluf_(g[1]) * up[1]); w.y = cvt_pk_bf16(siluf_(g[2]) * up[2], siluf_(g[3]) * up[3]);
                *(u32x2*)(H + row * ldh + hc) = w; } EPI_FENCE; }
    }
};
struct BrGate {
    static constexpr bool PERM = true;
    const bf16_t* G; float* mf; bf16_t* mb;
    __device__ __forceinline__ void operator()(EPI_SIG) const {
        const int br = u.tag;
        const size_t row0 = (size_t)(u.pm * 256 + wr * 64 + fr); const int col0 = u.pn * 256 + wc * 32 + 8 * fq;
        const bf16_t* gp = G + row0 * 4096 + br * 1024 + col0; bf16_t* pp = mb + row0 * 1024 + col0;
#define BR_ROW(i) (((i) >> 2) * 128 + ((i) & 3) * 16)
        u32x4 gq[8][2], pq[8][2];
#define BR_LOAD(i) { _Pragma("unroll") for (int bj = 0; bj < 2; ++bj) { gq[i][bj] = *(const u32x4*)(gp + (size_t)BR_ROW(i) * 4096 + bj * 128); \
            if (br > 0) pq[i][bj] = *(const u32x4*)(pp + (size_t)BR_ROW(i) * 1024 + bj * 128); else pq[i][bj] = (u32x4){0u, 0u, 0u, 0u}; } }
        _Pragma("unroll") for (int i = 0; i < EPI_DEPTH; ++i) BR_LOAD(i)
        _Pragma("unroll") for (int i = 0; i < 8; ++i) { if (i + EPI_DEPTH < 8) BR_LOAD(i + EPI_DEPTH)
            _Pragma("unroll") for (int bj = 0; bj < 2; ++bj) { const u32x4 gw = gq[i][bj], pw = pq[i][bj];
                f32x4 v0 = acc[i >> 2][bj][i & 3][0], v1 = acc[i >> 2][bj][i & 3][1];
                v0[0] = v0[0] * bflo(gw.x) + bflo(pw.x); v0[1] = v0[1] * bfhi(gw.x) + bfhi(pw.x); v0[2] = v0[2] * bflo(gw.y) + bflo(pw.y); v0[3] = v0[3] * bfhi(gw.y) + bfhi(pw.y);
                v1[0] = v1[0] * bflo(gw.z) + bflo(pw.z); v1[1] = v1[1] * bfhi(gw.z) + bfhi(pw.z); v1[2] = v1[2] * bflo(gw.w) + bflo(pw.w); v1[3] = v1[3] * bfhi(gw.w) + bfhi(pw.w);
                *(u32x4*)(pp + (size_t)BR_ROW(i) * 1024 + bj * 128) = pack8(v0, v1); } EPI_FENCE; }
#undef BR_LOAD
#undef BR_ROW
    }
};
struct BrGateH {
    static constexpr bool PERM = true;
    const bf16_t* G; bf16_t* mb; f32x4 racc[2][4][2];
    __device__ __forceinline__ void init() { _Pragma("unroll") for (int a = 0; a < 2; ++a) _Pragma("unroll") for (int m = 0; m < 4; ++m) _Pragma("unroll") for (int n = 0; n < 2; ++n) racc[a][m][n] = (f32x4){0.f, 0.f, 0.f, 0.f}; }
    __device__ __forceinline__ void operator()(f32x4 (&acc)[2][4][2], const Unit& u, int wr, int wc, int fr, int fq, int wid, int lane) {
        const int br = u.tag & 3; const unsigned col0 = (unsigned)((u.tag >> 2) * 128 + wc * 32 + 8 * fq), row0 = (unsigned)(u.pm * 256 + wr * 64 + fr);
        const char* gb = (const char*)G; const unsigned goff = (row0 * 4096u + (unsigned)br * 1024u + col0) * 2u;
        u32x4 gq[8];
        _Pragma("unroll") for (int i = 0; i < 8; ++i) gq[i] = *(const u32x4*)(gb + (size_t)(goff + (unsigned)(((i >> 2) * 128 + (i & 3) * 16) * 8192)));
        _Pragma("unroll") for (int i = 0; i < 8; ++i) { const u32x4 gw = gq[i]; const f32x4 v0 = acc[i >> 2][i & 3][0], v1 = acc[i >> 2][i & 3][1]; f32x4 r0 = racc[i >> 2][i & 3][0], r1 = racc[i >> 2][i & 3][1];
            r0[0] += v0[0] * bflo(gw.x); r0[1] += v0[1] * bfhi(gw.x); r0[2] += v0[2] * bflo(gw.y); r0[3] += v0[3] * bfhi(gw.y); r1[0] += v1[0] * bflo(gw.z); r1[1] += v1[1] * bfhi(gw.z); r1[2] += v1[2] * bflo(gw.w); r1[3] += v1[3] * bfhi(gw.w);
            racc[i >> 2][i & 3][0] = r0; racc[i >> 2][i & 3][1] = r1; }
        if (br == 3) { char* pb = (char*)mb; const unsigned poff = (row0 * 1024u + col0) * 2u;
            _Pragma("unroll") for (int i = 0; i < 8; ++i) { *(u32x4*)(pb + (size_t)(poff + (unsigned)(((i >> 2) * 128 + (i & 3) * 16) * 2048))) = pack8(racc[i >> 2][i & 3][0], racc[i >> 2][i & 3][1]);
                racc[i >> 2][i & 3][0] = (f32x4){0.f, 0.f, 0.f, 0.f}; racc[i >> 2][i & 3][1] = (f32x4){0.f, 0.f, 0.f, 0.f}; } }
    }
};
struct MoeDown {
    static constexpr bool PERM = true;
    const int* row_slot; const float* row_w; bf16_t* ys;
    __device__ __forceinline__ void operator()(EPI_SIG) const {
        int slot[8]; float w[8];
        _Pragma("unroll") for (int i = 0; i < 8; ++i) { const int r = u.tag * 256 + (i >> 2) * 128 + wr * 64 + (i & 3) * 16 + fr; slot[i] = __hip_atomic_load(row_slot + r, RLX_AGENT); w[i] = __hip_atomic_load(row_w + r, RLX_AGENT); }
        _Pragma("unroll") for (int i = 0; i < 8; ++i) {
            if (slot[i] >= 0) { EPI_BJ { const int col = u.pn * 256 + bj * 128 + wc * 32 + 8 * fq;
                *(u32x4*)(ys + (size_t)slot[i] * 1024 + col) = pack8(acc[i >> 2][bj][i & 3][0] * w[i], acc[i >> 2][bj][i & 3][1] * w[i]); } } EPI_FENCE; }
    }
};
struct Softmax {
    static constexpr bool PERM = true;
    bf16_t* P; LAS float* xch;
    __device__ __forceinline__ void operator()(EPI_SIG) const {
        EPI_ROWS { float v = -3.0e38f;
            EPI_BJ { const f32x4 a = acc[ai][bj][m][0], b = acc[ai][bj][m][1]; v = fmaxf(v, fmaxf(fmaxf(fmaxf(a[0], a[1]), fmaxf(a[2], a[3])), fmaxf(fmaxf(b[0], b[1]), fmaxf(b[2], b[3])))); }
            v = fmaxf(v, __shfl_xor(v, 16)); v = fmaxf(v, __shfl_xor(v, 32));
            if (fq == 0) xch[(ai * 128 + wr * 64 + m * 16 + fr) * 4 + wc] = v; }
        LDS_WAIT(); __builtin_amdgcn_s_barrier(); asm volatile("" ::: "memory");
        EPI_ROWS { const f32x4 q = *(const LAS f32x4*)(xch + (ai * 128 + wr * 64 + m * 16 + fr) * 4);
            const float mm = fmaxf(fmaxf(q[0], q[1]), fmaxf(q[2], q[3])); float s = 0.f;
            EPI_BJ { _Pragma("unroll") for (int n = 0; n < 2; ++n) { f32x4 t = acc[ai][bj][m][n]; for (int j = 0; j < 4; ++j) { t[j] = fexp2(t[j] - mm); s += t[j]; } acc[ai][bj][m][n] = t; } }
            s += __shfl_xor(s, 16); s += __shfl_xor(s, 32);
            if (fq == 0) xch[1024 + (ai * 128 + wr * 64 + m * 16 + fr) * 4 + wc] = s; }
        LDS_WAIT(); __builtin_amdgcn_s_barrier(); asm volatile("" ::: "memory");
        EPI_ROWS { const f32x4 q = *(const LAS f32x4*)(xch + 1024 + (ai * 128 + wr * 64 + m * 16 + fr) * 4);
            const float inv = frcp((q[0] + q[1]) + (q[2] + q[3]));
            bf16_t* rowp = P + (size_t)EPI_ROW * 1024 + u.tag * 256 + wc * 32 + 8 * fq;
            EPI_BJ { *(u32x4*)(rowp + bj * 128) = pack8(acc[ai][bj][m][0] * inv, acc[ai][bj][m][1] * inv); } EPI_FENCE; }
        LDS_WAIT(); __builtin_amdgcn_s_barrier(); asm volatile("" ::: "memory");
    }
};
}
struct Args { const float* in[42]; float* out; unsigned char* ws; int ph_lo, ph_hi; };
struct Ctx {
    const float* const* in; float* out; unsigned char* ws; LAS unsigned char* lds;
    int tid, lane, wave, G, bid;
};
enum { I_X = 0, I_MEM, I_POS, I_WIN, I_RWMU, I_RWW0, I_RWWUP, I_RWA0, I_RWAUP, I_RWGUP, I_RWKK, I_RWKA, I_RWRK, I_RWGNG, I_RWGNB,
       I_CONVW, I_CONVB, I_DTB, I_ALOG, I_SSDD, I_SSDNG, I_QNG, I_WUQ, I_KVNG, I_WUKV, I_WBR, I_WGATE, I_WOUT, I_LN1G, I_LN1B,
       I_XWQ, I_XWKV, I_XWO, I_LN2G, I_LN2B, I_FFN13, I_FFN2, I_ROUTER, I_MOE13, I_MOE2, I_LN3G, I_LN3B };
__device__ __forceinline__ Ctx launder(const Ctx& C0) {
    Ctx L = C0; unsigned zo_ = 0u; int t_ = threadIdx.x;
    asm volatile("" : "+s"(zo_), "+v"(t_));
    L.out = C0.out + zo_; L.ws = C0.ws + zo_; L.tid = t_; L.lane = t_ & 63; L.wave = __builtin_amdgcn_readfirstlane(t_ >> 6); return L;
}
#define WSP(T_, off) ((T_*)(C.ws + (off)))
#define GW (C.bid * NWAVES + C.wave)
#define NGW (C.G * NWAVES)

struct TJob { const float* W; int ldw, K, N; bf16_t* WT; int ldt; int map; float scale; int items; };
__device__ __forceinline__ int tj_items(int K, int N) { return (K / 64) * ((N + 31) / 32); }
__device__ __forceinline__ int tj_dest(int map, int n, int N) {
    if (map == 0) return n;
    if (map == 1) return n < 2816 ? n : (n < 2820 ? PC_DT + (n - 2816) : n - 4);
    const int half = N >> 1, j = n < half ? n : n - half;
    return (j >> 4) * 32 + (j & 15) + (n < half ? 0 : 16);
}
__device__ __forceinline__ void t_load(const TJob& J, int item, int lane, float (&v)[32], unsigned var = 0u) {
    const int nblk = (J.N + 31) / 32, kb = item / nblk, nb = item % nblk, k0 = 64 * kb, n0 = 32 * nb;
    const int nn = n0 + (lane & 31); const bool okn = nn < J.N; const float* src = J.W + (size_t)(k0 + (lane >> 5)) * J.ldw + nn;
#pragma unroll
    for (int i = 0; i < 32; ++i) v[i] = (okn && !(var & 8u)) ? src[(size_t)(2 * i) * J.ldw] : 0.f;
}
__device__ __forceinline__ void t_commit(const TJob& J, LAS float* scr, int item, int lane, const float (&v)[32], unsigned var = 0u) {
    const int nblk = (J.N + 31) / 32, kb = item / nblk, nb = item % nblk, k0 = 64 * kb, n0 = 32 * nb;
#pragma unroll
    for (int i = 0; i < 32; ++i) scr[(2 * i + (lane >> 5)) * 33 + (lane & 31)] = v[i];
    LDS_WAIT(); asm volatile("" ::: "memory");
    const int c = lane & 7;
#pragma unroll
    for (int j = 0; j < 4; ++j) { const int nl = (lane >> 3) + 8 * j, n = n0 + nl;
        if (n < J.N && !(var & 4u)) { const LAS float* s = scr + (8 * c) * 33 + nl; const float sc = (J.map == 1 && n >= 256) ? 1.0f : J.scale;
            u32x4 o; o.x = cvt_pk_bf16(s[0 * 33] * sc, s[1 * 33] * sc); o.y = cvt_pk_bf16(s[2 * 33] * sc, s[3 * 33] * sc); o.z = cvt_pk_bf16(s[4 * 33] * sc, s[5 * 33] * sc); o.w = cvt_pk_bf16(s[6 * 33] * sc, s[7 * 33] * sc);
            *(u32x4*)(J.WT + (size_t)tj_dest(J.map, n, J.N) * J.ldt + k0 + 8 * c) = o; } }
    LDS_WAIT(); asm volatile("" ::: "memory");
}
__device__ __forceinline__ TJob mkjob(const float* W, int ldw, int K, int N, bf16_t* WT, int ldt, int map, float scale) { TJob j; j.W = W; j.ldw = ldw; j.K = K; j.N = N; j.WT = WT; j.ldt = ldt; j.map = map; j.scale = scale; j.items = tj_items(K, N); return j; }

__device__ __forceinline__ TJob prologue_job(const Ctx& C, int j) {
    if (j < 26) { const int l = j / 13, r = j % 13; unsigned char* LW = C.ws + W_BASE + (size_t)l * LW_SIZE;
        if (r == 0) return mkjob(C.in[I_WIN] + (size_t)l * 1024 * 3236, 3236, 1024, 3236, (bf16_t*)(LW + LW_WIN), 1024, 1, 0.125f * LOG2E);
        if (r < 5) { const int i = r - 1; return mkjob(C.in[I_WGATE] + ((size_t)l * 4 + i) * 1024 * 1024, 1024, 1024, 1024, (bf16_t*)(LW + LW_WGATE) + (size_t)i * 1024 * 1024, 1024, 0, 1.f); }
        if (r < 9) { const int i = r - 5; return mkjob(C.in[I_WBR] + ((size_t)l * 4 + i) * 256 * 1024, 1024, 256, 1024, (bf16_t*)(LW + LW_WBR) + (size_t)i * 1024 * 256, 256, 0, 1.f); }
        if (r == 9) return mkjob(C.in[I_WOUT] + (size_t)l * 1024 * 1024, 1024, 1024, 1024, (bf16_t*)(LW + LW_WOUT), 1024, 0, 1.f);
        if (r == 10) return mkjob(C.in[I_XWQ], 1024, 0, 1024, (bf16_t*)(LW + LW_WQ), 1024, 0, 1.f);
        if (r == 11) return mkjob(C.in[I_XWKV] + (size_t)l * 1024 * 2048, 2048, 1024, 2048, (bf16_t*)(LW + LW_WKV), 1024, 0, 1.f);
        return mkjob(C.in[I_XWO] + (size_t)l * 1024 * 1024, 1024, 1024, 1024, (bf16_t*)(LW + LW_WO), 1024, 0, 1.f);
    }
    if (j == 26) return mkjob(C.in[I_FFN13], 2 * FFD, 1024, 2 * FFD, WSP(bf16_t, W_FFN13), 1024, 2, 1.f);
    return mkjob(C.in[I_FFN2], 1024, FFD, 1024, WSP(bf16_t, W_FFN2), FFD, 0, 1.f);
}
__device__ __forceinline__ TJob moe_job(const Ctx& C, int j) {
    if (j < 8) return mkjob(C.in[I_MOE13] + (size_t)j * 1024 * 2 * FFE, 2 * FFE, 1024, 2 * FFE, WSP(bf16_t, S_MW13) + (size_t)j * 2 * FFE * 1024, 1024, 2, 1.f);
    const int e = j - 8; return mkjob(C.in[I_MOE2] + (size_t)e * FFE * 1024, 1024, FFE, 1024, WSP(bf16_t, S_MW2) + (size_t)e * 1024 * FFE, FFE, 0, 1.f);
}
__device__ __forceinline__ void t_load4(const TJob& J, int item, int lane, f32x4 (&v)[8], unsigned var = 0u) {
    const int nblk = (J.N + 31) / 32, kb = item / nblk, nb = item % nblk, k0 = 64 * kb, n0 = 32 * nb;
    const int nn = n0 + 4 * (lane & 7); const bool okn = nn < J.N && !(var & 8u); const float* src = J.W + (size_t)(k0 + (lane >> 3)) * J.ldw + nn;
#pragma unroll
    for (int i = 0; i < 8; ++i) v[i] = okn ? *(const f32x4*)(src + (size_t)(8 * i) * J.ldw) : (f32x4){0.f, 0.f, 0.f, 0.f};
}
__device__ __forceinline__ void t_commit4(const TJob& J, LAS float* scr, int item, int lane, const f32x4 (&v)[8], unsigned var = 0u) {
    const int nblk = (J.N + 31) / 32, kb = item / nblk, nb = item % nblk, k0 = 64 * kb, n0 = 32 * nb;
    LAS float* wp = scr + (4 * (lane & 7)) * 65 + (lane >> 3);
#pragma unroll
    for (int i = 0; i < 8; ++i) { wp[0 * 65 + 8 * i] = v[i][0]; wp[1 * 65 + 8 * i] = v[i][1]; wp[2 * 65 + 8 * i] = v[i][2]; wp[3 * 65 + 8 * i] = v[i][3]; }
    LDS_WAIT(); asm volatile("" ::: "memory");
    const int c = lane & 7;
#pragma unroll
    for (int j = 0; j < 4; ++j) { const int nl = (lane >> 3) + 8 * j, n = n0 + nl;
        if (n < J.N && !(var & 4u)) { const LAS float* s = scr + nl * 65 + 8 * c; const float sc = (J.map == 1 && n >= 256) ? 1.0f : J.scale;
            u32x4 o; o.x = cvt_pk_bf16(s[0] * sc, s[1] * sc); o.y = cvt_pk_bf16(s[2] * sc, s[3] * sc); o.z = cvt_pk_bf16(s[4] * sc, s[5] * sc); o.w = cvt_pk_bf16(s[6] * sc, s[7] * sc);
            *(u32x4*)(J.WT + (size_t)tj_dest(J.map, n, J.N) * J.ldt + k0 + 8 * c) = o; } }
    LDS_WAIT(); asm volatile("" ::: "memory");
}
template <int NJ, bool MOE> __device__ __forceinline__ void run_tjobs(const Ctx& C, unsigned var = 0u) {
    LAS float* scr = (LAS float*)(C.lds + C.wave * 16384);
    int total = 0;
    for (int j = 0; j < NJ; ++j) { const TJob J = MOE ? moe_job(C, j) : prologue_job(C, j); total += J.items; }
    int j = 0, jbase = 0, it = GW; TJob J = MOE ? moe_job(C, 0) : prologue_job(C, 0);
    auto next = [&](TJob& Jo, int& io) -> bool { if (it >= total) return false;
        while (it >= jbase + J.items) { jbase += J.items; ++j; J = MOE ? moe_job(C, j) : prologue_job(C, j); }
        Jo = J; io = it - jbase; it += NGW; return true; };
    TJob Ja, Jb, Jc; int ia = 0, ib = 0, ic = 0; f32x4 va[8], vb[8], vc[8];
    bool ha = next(Ja, ia); if (!ha) return; t_load4(Ja, ia, C.lane, va, var);
    bool hb = next(Jb, ib); if (hb) t_load4(Jb, ib, C.lane, vb, var);
    for (;;) {
        bool hc = next(Jc, ic); if (hc) t_load4(Jc, ic, C.lane, vc, var);
        t_commit4(Ja, scr, ia, C.lane, va, var); if (!hb) break;
        ha = next(Ja, ia); if (ha) t_load4(Ja, ia, C.lane, va, var);
        t_commit4(Jb, scr, ib, C.lane, vb, var); if (!hc) break;
        hb = next(Jb, ib); if (hb) t_load4(Jb, ib, C.lane, vb, var);
        t_commit4(Jc, scr, ic, C.lane, vc, var); if (!ha) break;
    }
}


constexpr int CW_CHK = 32768;
template <class OutF> __device__ __forceinline__ void chk_gemm(const Ctx& C, const bf16_t* A, int lda, const bf16_t* Bt, int ldb, int K, int nrows, int ncs, int cstride, int c0, int bit, OutF expect_vs_got) {
    unsigned bad = 0; const int lane = C.lane;
    for (int it = GW; it < nrows * ncs; it += NGW) {
        const int r = it / ncs, c = c0 + (it % ncs) * cstride; float d = 0.f;
        for (int k = lane * 8; k < K; k += 512) { const u32x4 a = *(const u32x4*)(A + (size_t)r * lda + k), b = *(const u32x4*)(Bt + (size_t)c * ldb + k);
            d += bflo(a.x) * bflo(b.x) + bfhi(a.x) * bfhi(b.x) + bflo(a.y) * bflo(b.y) + bfhi(a.y) * bfhi(b.y) + bflo(a.z) * bflo(b.z) + bfhi(a.z) * bfhi(b.z) + bflo(a.w) * bflo(b.w) + bfhi(a.w) * bfhi(b.w); }
        d = wave_sum(d);
        if (!expect_vs_got(r, c, d)) bad = 1;
    }
    if (lane == 0 && bad) __hip_atomic_fetch_add((unsigned*)(C.ws + WS_CTL) + CW_CHK + 64 * bit, 1u, RLX_AGENT);
}
__device__ __forceinline__ bool chk_close(float e, float g) { return fabsf(e - g) <= 0.03f * fabsf(e) + 0.03f; }

__device__ __forceinline__ float chk_dot(const bf16_t* a, const bf16_t* b, int K, int lane) {
    float d = 0.f;
    for (int k = lane * 8; k < K; k += 512) { const u32x4 x = *(const u32x4*)(a + k), y = *(const u32x4*)(b + k);
        d += bflo(x.x) * bflo(y.x) + bfhi(x.x) * bfhi(y.x) + bflo(x.y) * bflo(y.y) + bfhi(x.y) * bfhi(y.y) + bflo(x.z) * bflo(y.z) + bfhi(x.z) * bfhi(y.z) + bflo(x.w) * bflo(y.w) + bfhi(x.w) * bfhi(y.w); }
    return wave_sum(d);
}
__device__ __forceinline__ void chk_flag(const Ctx& C, int bit, unsigned bad) { if (C.lane == 0 && bad) __hip_atomic_fetch_add((unsigned*)(C.ws + WS_CTL) + CW_CHK + 64 * bit, 1u, RLX_AGENT); }
__device__ __forceinline__ void chk_merged(const Ctx& C, int l, int bit) {
    const bf16_t* Y = WSP(bf16_t, S_Y); const bf16_t* G = WSP(bf16_t, S_G); const bf16_t* MB = WSP(bf16_t, S_MB); const bf16_t* WBR = (const bf16_t*)(C.ws + W_BASE + (size_t)l * LW_SIZE + LW_WBR); unsigned bad = 0;
    for (int it = GW; it < T * 4; it += NGW) { const int r = it >> 2, c = 13 + 256 * (it & 3); float e = 0.f;
        for (int i = 0; i < 4; ++i) e += bf2f(G[(size_t)r * 4096 + i * 1024 + c]) * chk_dot(Y + (size_t)r * 1024 + 256 * i, WBR + ((size_t)i * 1024 + c) * 256, 256, C.lane);
        if (!chk_close(e, bf2f(MB[(size_t)r * 1024 + c]))) bad = 1; }
    chk_flag(C, bit, bad);
}
__device__ __forceinline__ void chk_swiglu(const Ctx& C, int bit) {
    const bf16_t* XB = WSP(bf16_t, W_XB); const bf16_t* W = WSP(bf16_t, W_FFN13); const bf16_t* H = WSP(bf16_t, S_H); unsigned bad = 0;
    for (int it = GW; it < T * 22; it += NGW) { const int r = it / 22, hc = 5 + 128 * (it % 22); const int grow = (hc >> 4) * 32 + (hc & 15);
        const float g = chk_dot(XB + (size_t)r * 1024, W + (size_t)grow * 1024, 1024, C.lane), u = chk_dot(XB + (size_t)r * 1024, W + (size_t)(grow + 16) * 1024, 1024, C.lane);
        if (!chk_close(siluf_(g) * u, bf2f(H[(size_t)r * FFD + hc]))) bad = 1; }
    chk_flag(C, bit, bad);
}

constexpr size_t S_CHKBUF = S_BASE + (size_t)400 * MiB;
__device__ __forceinline__ void chk_resid_stash(const Ctx& C, const bf16_t* A, int lda, const bf16_t* Bt, int ldb, int K, int slot) {
    const float* XR = WSP(float, W_XRES); float* CB = WSP(float, S_CHKBUF);
    for (int it = GW; it < T * 4; it += NGW) { const int r = it >> 2, q = it & 3, c = 17 + 256 * q; const float d = chk_dot(A + (size_t)r * lda, Bt + (size_t)c * ldb, K, C.lane);
        if (C.lane == 0) CB[(size_t)r * 8 + slot * 4 + q] = XR[(size_t)r * 1024 + c] * DN_ALPHA + d; }
}
__device__ __forceinline__ void chk_resid_cmp(const Ctx& C, int slot, int bit) {
    const float* XR = WSP(float, W_XRES); const float* CB = WSP(float, S_CHKBUF); unsigned bad = 0;
    for (int it = GW; it < T * 4; it += NGW) { const int r = it >> 2, q = it & 3, c = 17 + 256 * q; if (!chk_close(CB[(size_t)r * 8 + slot * 4 + q], XR[(size_t)r * 1024 + c])) bad = 1; }
    chk_flag(C, bit, bad);
}
__device__ __forceinline__ void chk_ln_stash(const Ctx& C, const float* g, const float* b, int slot) {
    const float* XR = WSP(float, W_XRES); float* CB = WSP(float, S_CHKBUF); const int lane = C.lane;
    for (int t = GW; t < T; t += NGW) { float s = 0.f, s2 = 0.f; float v[16];
        for (int j = 0; j < 16; ++j) { v[j] = XR[(size_t)t * 1024 + lane + 64 * j]; s += v[j]; }
        const float mean = wave_sum(s) * (1.0f / 1024.0f); for (int j = 0; j < 16; ++j) { const float d = v[j] - mean; s2 += d * d; }
        const float rstd = 1.0f / sqrtf(wave_sum(s2) * (1.0f / 1024.0f) + 1e-5f);
        if (lane < 4) { const int c = 17 + 256 * lane; CB[(size_t)t * 8 + slot * 4 + lane] = (XR[(size_t)t * 1024 + c] - mean) * rstd * g[c] + b[c]; } }
}
__device__ __forceinline__ void chk_ln_cmp(const Ctx& C, int slot, int bit) {
    const float* XR = WSP(float, W_XRES); const bf16_t* XB = WSP(bf16_t, W_XB); const float* CB = WSP(float, S_CHKBUF); unsigned bad = 0;
    for (int it = GW; it < T * 4; it += NGW) { const int r = it >> 2, q = it & 3, c = 17 + 256 * q; const float e = CB[(size_t)r * 8 + slot * 4 + q];
        if (!chk_close(e, XR[(size_t)r * 1024 + c]) || !chk_close(e, bf2f(XB[(size_t)r * 1024 + c]))) bad = 1; }
    chk_flag(C, bit, bad);
}

template <int NJ, bool MOE> __device__ __forceinline__ void chk_weights(const Ctx& C, int bit) {
    unsigned bad = 0; const int gt = C.bid * NTHREADS + C.tid, NT = C.G * NTHREADS;
    for (int j = 0; j < NJ; ++j) { const TJob J = MOE ? moe_job(C, j) : prologue_job(C, j);
        for (size_t i = gt; i < (size_t)J.K * J.N; i += NT) { const int k = (int)(i / J.N), n = (int)(i % J.N);
            const float sc = (J.map == 1 && n >= 256) ? 1.0f : J.scale; const bf16_t e = (bf16_t)(cvt_pk_bf16(J.W[(size_t)k * J.ldw + n] * sc, 0.f) & 0xffffu);
            if (J.WT[(size_t)tj_dest(J.map, n, J.N) * J.ldt + k] != e) bad = 1; } }
    if (bad) __hip_atomic_fetch_add((unsigned*)(C.ws + WS_CTL) + CW_CHK + 64 * bit, 1u, RLX_AGENT);
}

__device__ __forceinline__ void chk_mla_inputs(const Ctx& C, int l, int bit) {
    const bf16_t* proj = WSP(bf16_t, S_PROJ); const bf16_t* QM = WSP(bf16_t, S_QM); const bf16_t* KM = WSP(bf16_t, S_KM); const bf16_t* VM = WSP(bf16_t, S_VM);
    const float* wuq = C.in[I_WUQ] + (size_t)l * 256 * 384; const float* wukv = C.in[I_WUKV] + (size_t)l * 128 * 512; const float* qg = C.in[I_QNG] + l * 256; const float* kvg = C.in[I_KVNG] + l * 128;
    const int* pos = (const int*)C.in[I_POS]; const int lane = C.lane; unsigned bad = 0; const float qs = 0.10206207261596575f * LOG2E;
    for (int t = GW; t < T; t += NGW) {
        const bf16_t* pr = proj + (size_t)t * NPROJ; float cq[4], ck[2]; float ss = 0.f;
        for (int i = 0; i < 4; ++i) { cq[i] = bf2f(pr[PC_CQ + lane + 64 * i]); ss += cq[i] * cq[i]; }
        float rs = 1.0f / sqrtf(wave_sum(ss) * (1.0f / 256.0f) + 1e-6f); for (int i = 0; i < 4; ++i) cq[i] *= rs * qg[lane + 64 * i];
        ss = 0.f; for (int i = 0; i < 2; ++i) { ck[i] = bf2f(pr[PC_CKV + lane + 64 * i]); ss += ck[i] * ck[i]; }
        rs = 1.0f / sqrtf(wave_sum(ss) * (1.0f / 128.0f) + 1e-6f); for (int i = 0; i < 2; ++i) ck[i] *= rs * kvg[lane + 64 * i];
        const float ang = (float)pos[t] * exp2f(-6.0f * (13.287712379549449f / 32.0f)); const float c3 = cosf(ang), s3 = sinf(ang);
        const int h = t & 3;
        float qn = 0.f, q1 = 0.f, q2 = 0.f, kn = 0.f, vv = 0.f;
        for (int i = 0; i < 4; ++i) { const int k = lane + 64 * i; qn += cq[i] * wuq[(size_t)k * 384 + h * 96 + 5]; q1 += cq[i] * wuq[(size_t)k * 384 + h * 96 + 67]; q2 += cq[i] * wuq[(size_t)k * 384 + h * 96 + 83]; }
        for (int i = 0; i < 2; ++i) { const int k = lane + 64 * i; kn += ck[i] * wukv[(size_t)k * 512 + h * 128 + 7]; vv += ck[i] * wukv[(size_t)k * 512 + h * 128 + 64 + 9]; }
        qn = wave_sum(qn) * qs; q1 = wave_sum(q1) * qs; q2 = wave_sum(q2) * qs; kn = wave_sum(kn); vv = wave_sum(vv);
        const float kr1 = bf2f(pr[PC_KR + 3]), kr2 = bf2f(pr[PC_KR + 19]);
        const bf16_t* qrow = QM + (size_t)t * 384 + h * 96; const bf16_t* krow = KM + (size_t)t * 384 + h * 96;
        if (!chk_close(qn, bf2f(qrow[5])) || !chk_close(q1 * c3 - q2 * s3, bf2f(qrow[67])) || !chk_close(q1 * s3 + q2 * c3, bf2f(qrow[83])) || !chk_close(kn, bf2f(krow[7])) ||
            !chk_close(kr1 * c3 - kr2 * s3, bf2f(krow[67])) || !chk_close(kr1 * s3 + kr2 * c3, bf2f(krow[83])) || !chk_close(vv, bf2f(VM[(size_t)t * 256 + h * 64 + 9]))) bad = 1;
    }
    chk_flag(C, bit, bad);
}

__device__ __forceinline__ void chk_rw_inputs(const Ctx& C, int l, int bit) {
    const bf16_t* proj = WSP(bf16_t, S_PROJ); const float* DEC = WSP(float, S_DEC); const bf16_t* RWS = WSP(bf16_t, S_RWS); const bf16_t* GV = WSP(bf16_t, S_GV); const size_t PL = (size_t)T * 256;
    const float* mu = C.in[I_RWMU] + l * 1024; const float* w0 = C.in[I_RWW0] + l * 256; const float* a0 = C.in[I_RWA0] + l * 256;
    const float* wup = C.in[I_RWWUP] + l * 64 * 256; const float* aup = C.in[I_RWAUP] + l * 64 * 256; const float* gup = C.in[I_RWGUP] + l * 128 * 256;
    const float* kkw = C.in[I_RWKK] + l * 256; const float* kaw = C.in[I_RWKA] + l * 256; const int lane = C.lane; unsigned bad = 0;
    for (int t = GW; t < T; t += NGW) {
        const bf16_t* pr = proj + (size_t)t * NPROJ + PC_RW; const bool first = (t % SEQ) == 0; const int h = t & 3, c = h * 64 + 11;
        auto sh = [&](int col) { const float cur = bf2f(pr[col]); const float prv = first ? 0.f : bf2f(pr[col - NPROJ]); return cur + (prv - cur) * mu[col]; };
        float dw = tanhf(sh(768 + lane)) * wup[lane * 256 + c], da = sh(832 + lane) * aup[lane * 256 + c];
        float dg = (1.0f / (1.0f + expf(-sh(896 + lane)))) * gup[lane * 256 + c] + (1.0f / (1.0f + expf(-sh(960 + lane)))) * gup[(64 + lane) * 256 + c];
        dw = wave_sum(dw); da = wave_sum(da); dg = wave_sum(dg);
        const float xw = w0[c] + dw; const float wlog = -(fmaxf(-xw, 0.f) + log1pf(expf(-fabsf(xw)))) - 0.5f; const float dec = expf(-expf(wlog));
        const float a = 1.0f / (1.0f + expf(-(a0[c] + da)));
        const float kl = sh(256 + h * 64 + lane) * kkw[h * 64 + lane]; const float nrm = 1.0f / sqrtf(fmaxf(wave_sum(kl * kl), 1e-24f));
        const float r = sh(c), k = sh(256 + c), v = sh(512 + c); const float kk = k * kkw[c] * nrm, kmod = k * (1.0f + (a - 1.0f) * kaw[c]), ka = kk * a;
        const size_t o = (size_t)t * 256 + c;
        if (!chk_close(dec, DEC[o]) || fabsf(dec - DEC[o]) > 0.004f || !chk_close(r, bf2f(RWS[o])) || !chk_close(kmod, bf2f(RWS[PL + o])) || !chk_close(v, bf2f(RWS[2 * PL + o])) || !chk_close(kk, bf2f(RWS[3 * PL + o])) ||
            !chk_close(ka, bf2f(RWS[4 * PL + o])) || !chk_close(dg, bf2f(GV[o]))) bad = 1;
    }
    chk_flag(C, bit, bad);
}
__device__ __forceinline__ void chk_ssd_norm(const Ctx& C, int l, int bit) {
    const bf16_t* Y = WSP(bf16_t, S_Y); const float* ng = C.in[I_SSDNG] + l * 256; const int lane = C.lane; unsigned bad = 0;
    for (int t = GW; t < T; t += NGW) { float q = 0.f;
        for (int i = 0; i < 4; ++i) { const int c = (lane >> 5) * 128 + (lane & 31) * 4 + i; const float y = bf2f(Y[(size_t)t * 1024 + 512 + c]) / ng[c]; q += y * y; }
        for (int o_ = 1; o_ < 32; o_ <<= 1) q += __shfl_xor(q, o_);
        q *= (1.0f / 128.0f); if (q < 0.9f || q > 1.1f) bad = 1; }
    chk_flag(C, bit, bad);
}

#ifndef P7_COND
#define P7_COND 1
#endif
#ifndef P7_CLASS
#define P7_CLASS (((c & 31) < 16 ? 1u : 2u) | ((c & 255) < 128 ? 4u : 8u))
#endif
__device__ __forceinline__ float tdot(const bf16_t* a, const bf16_t* b, int K) { float d = 0.f;
    for (int k = 0; k < K; k += 8) { const u32x4 x = *(const u32x4*)(a + k), y = *(const u32x4*)(b + k);
        d += bflo(x.x) * bflo(y.x) + bfhi(x.x) * bfhi(y.x) + bflo(x.y) * bflo(y.y) + bfhi(x.y) * bfhi(y.y) + bflo(x.z) * bflo(y.z) + bfhi(x.z) * bfhi(y.z) + bflo(x.w) * bflo(y.w) + bfhi(x.w) * bfhi(y.w); }
    return d; }
__device__ __forceinline__ void chk_full_p7(const Ctx& C, int l, int bit) {
    const bf16_t* MB = WSP(bf16_t, S_MB); const bf16_t* W = (const bf16_t*)(C.ws + W_BASE + (size_t)l * LW_SIZE + LW_WOUT); const float* xin = C.in[I_X]; const float* XR = WSP(float, W_XRES); float num = 0.f, den = 0.f;
    for (size_t i = (size_t)C.bid * NTHREADS + C.tid; i < (size_t)T * 1024; i += (size_t)C.G * NTHREADS) { const size_t r = i >> 10; const int c = (int)(i & 1023);
        const float d = tdot(MB + r * 1024, W + (size_t)c * 1024, 1024), g = XR[i] - xin[i] * DN_ALPHA; num += (d - g) * (d - g); den += d * d; }
    num = wave_sum(num); den = wave_sum(den);
    if (C.lane == 0) { atomicAdd((float*)(C.ws + WS_CTL) + CW_CHK + 1024, num); atomicAdd((float*)(C.ws + WS_CTL) + CW_CHK + 1088, den); }
}
__device__ __forceinline__ void chk_full_merged(const Ctx& C, int l, int bit) {
    const bf16_t* Y = WSP(bf16_t, S_Y); const bf16_t* G = WSP(bf16_t, S_G); const bf16_t* MB = WSP(bf16_t, S_MB); const bf16_t* WBR = (const bf16_t*)(C.ws + W_BASE + (size_t)l * LW_SIZE + LW_WBR); unsigned bad = 0;
    for (size_t i = (size_t)C.bid * NTHREADS + C.tid; i < (size_t)T * 1024; i += (size_t)C.G * NTHREADS) { const size_t r = i >> 10; const int c = (int)(i & 1023); float e = 0.f;
        for (int q = 0; q < 4; ++q) e += bf2f(G[r * 4096 + q * 1024 + c]) * tdot(Y + r * 1024 + 256 * q, WBR + ((size_t)q * 1024 + c) * 256, 256);
        if (!chk_close(e, bf2f(MB[i]))) bad = 1; }
    if (bad) __hip_atomic_fetch_add((unsigned*)(C.ws + WS_CTL) + CW_CHK + 64 * bit, 1u, RLX_AGENT);
}

#ifndef FG_CLASS
#define FG_CLASS (1u << ((c >> 5) & 3))
#endif
template <class F> __device__ __forceinline__ void chk_full_gemm(const Ctx& C, const bf16_t* A, const bf16_t* Bt, int K, int N, int bit, F ok) {
    unsigned bad = 0, cntbad = 0;
    for (size_t i = (size_t)C.bid * NTHREADS + C.tid; i < (size_t)T * N; i += (size_t)C.G * NTHREADS) { const size_t r = i / N; const int c = (int)(i % N);
        if (!ok(r, c, tdot(A + r * K, Bt + (size_t)c * K, K))) { bad |= (bit < 0) ? (FG_CLASS) : (1u << bit); ++cntbad; } }
#ifdef FG_COUNT
    if (cntbad) __hip_atomic_fetch_add((unsigned*)(C.ws + WS_CTL) + CW_CHK + 2048, cntbad, RLX_AGENT);
#else
    for (int q = 0; q < 4; ++q) if ((bad >> q) & 1) __hip_atomic_fetch_add((unsigned*)(C.ws + WS_CTL) + CW_CHK + 64 * q, 1u, RLX_AGENT);
#endif
}
__device__ __forceinline__ void ph_prologue(const Ctx& C) {
    run_tjobs<28, false>(C);
    const int gt = C.bid * NTHREADS + C.tid, NT = C.G * NTHREADS;
    for (int l = 0; l < 2; ++l) {
        unsigned char* LW = C.ws + W_BASE + (size_t)l * LW_SIZE;
        bf16_t* lora = (bf16_t*)(LW + LW_LORA); const float* wup = C.in[I_RWWUP] + l * 64 * 256; const float* aup = C.in[I_RWAUP] + l * 64 * 256; const float* gup = C.in[I_RWGUP] + l * 128 * 256;
        for (int i = gt; i < 768 * 256; i += NT) { const int n = i >> 8, k = i & 255; float v = 0.f;
            if (n < 256) { if (k < 64) v = wup[k * 256 + n]; } else if (n < 512) { if (k >= 64 && k < 128) v = aup[(k - 64) * 256 + (n - 256)]; } else { if (k >= 128) v = gup[(k - 128) * 256 + (n - 512)]; }
            lora[i] = (bf16_t)(cvt_pk_bf16(v, 0.f) & 0xffffu); }
        bf16_t* wuq = (bf16_t*)(LW + LW_WUQ); const float* suq = C.in[I_WUQ] + l * 256 * 384;
        for (int i = gt; i < 512 * 256; i += NT) { const int n = i >> 8, k = i & 255; const float v = n < 384 ? suq[k * 384 + n] * (0.10206207261596575f * LOG2E) : 0.f; wuq[i] = (bf16_t)(cvt_pk_bf16(v, 0.f) & 0xffffu); }
        bf16_t* wukv = (bf16_t*)(LW + LW_WUKV); const float* sukv = C.in[I_WUKV] + l * 128 * 512;
        for (int i = gt; i < 512 * 128; i += NT) { const int n = i >> 7, k = i & 127; wukv[i] = (bf16_t)(cvt_pk_bf16(sukv[k * 512 + n], 0.f) & 0xffffu); }
        { const float* wq = C.in[I_XWQ] + (size_t)l * 1024 * 1024; bf16_t* wqp = (bf16_t*)(LW + LW_WQ);
          for (size_t i = gt; i < (size_t)1024 * 1024 / 8; i += NT) { const f32x4 a = *(const f32x4*)(wq + i * 8) * (0.0625f * LOG2E), b = *(const f32x4*)(wq + i * 8 + 4) * (0.0625f * LOG2E); *(u32x4*)(wqp + i * 8) = epi::pack8(a, b); } }
        bf16_t* win = (bf16_t*)(LW + LW_WIN);
        for (int i = gt; i < (NPROJ - 3236) * 1024; i += NT) win[(size_t)3236 * 1024 + i] = 0;
    }
    { const float* x = C.in[I_X]; bf16_t* xb = WSP(bf16_t, W_XB);
#pragma unroll 4
      for (size_t i = gt; i < (size_t)T * 1024 / 8; i += NT) { const f32x4 a = *(const f32x4*)(x + i * 8), b = *(const f32x4*)(x + i * 8 + 4); *(u32x4*)(xb + i * 8) = epi::pack8(a, b); }
      const float* mm = C.in[I_MEM]; bf16_t* mb = WSP(bf16_t, W_MEMB);
      for (size_t i = gt; i < (size_t)NMEM * 1024 / 8; i += NT) { const f32x4 a = *(const f32x4*)(mm + i * 8), b = *(const f32x4*)(mm + i * 8 + 4); *(u32x4*)(mb + i * 8) = epi::pack8(a, b); } }
    { const int* pos = (const int*)C.in[I_POS]; float* ct = WSP(float, W_COS); float* st = WSP(float, W_SIN);
      for (int i = gt; i < T * 16; i += NT) { const int t = i >> 4, j = i & 15; const float inv = exp2f(-(float)(2 * j) * (13.287712379549449f / 32.0f)); const float ang = (float)pos[t] * inv; ct[i] = cosf(ang); st[i] = sinf(ang); } }
}

__device__ __forceinline__ f32x4 ld_bf4(const bf16_t* p) { const u32x2 w = *(const u32x2*)p; return (f32x4){bflo(w.x), bfhi(w.x), bflo(w.y), bfhi(w.y)}; }
__device__ __forceinline__ void st_bf4(bf16_t* p, const f32x4 v) { u32x2 w; w.x = cvt_pk_bf16(v[0], v[1]); w.y = cvt_pk_bf16(v[2], v[3]); *(u32x2*)p = w; }
__device__ __forceinline__ float tanhf_(float x) { return 1.0f - 2.0f * frcp(1.0f + fexp2(2.0f * LOG2E * x)); }
__device__ __forceinline__ void ph_prep(const Ctx& C, int l) {
    const bf16_t* __restrict__ proj = WSP(bf16_t, S_PROJ); const float* mu = C.in[I_RWMU] + l * 1024;
    bf16_t* __restrict__ LA = WSP(bf16_t, S_LA); bf16_t* __restrict__ CQN = WSP(bf16_t, S_CQN); bf16_t* __restrict__ CKVN = WSP(bf16_t, S_CKVN); bf16_t* __restrict__ KM = WSP(bf16_t, S_KM);
    const float* qg = C.in[I_QNG] + l * 256; const float* kvg = C.in[I_KVNG] + l * 128; const float* ct = WSP(float, W_COS); const float* st = WSP(float, W_SIN);
    const int lane = C.lane, c4 = 4 * lane, c2 = 2 * lane, i16 = lane & 15;
    const f32x4 m = *(const f32x4*)(mu + 768 + c4), qgv = *(const f32x4*)(qg + c4); const float kg0 = kvg[c2], kg1 = kvg[c2 + 1];
    u32x2 n_cur, n_prv, n_cq; unsigned n_ckv; unsigned short n_kr; float n_cs, n_sn;
#define PREP_LOAD(tt) do { const bf16_t* pr_ = proj + (size_t)(tt) * NPROJ; n_cur = *(const u32x2*)(pr_ + PC_RW + 768 + c4); \
        n_prv = ((tt) % SEQ) == 0 ? (u32x2){0u, 0u} : *(const u32x2*)(pr_ - NPROJ + PC_RW + 768 + c4); n_cq = *(const u32x2*)(pr_ + PC_CQ + c4); n_ckv = *(const unsigned*)(pr_ + PC_CKV + c2); \
        n_kr = pr_[PC_KR + (lane & 31)]; n_cs = ct[(size_t)(tt) * 16 + i16]; n_sn = st[(size_t)(tt) * 16 + i16]; } while (0)
    int t = GW; if (t < T) PREP_LOAD(t);
    for (; t < T; t += NGW) {
        const u32x2 wc = n_cur, wp = n_prv, wq = n_cq; const unsigned wk = n_ckv; const float krv = bf2f(n_kr), cs = n_cs, sn = n_sn;
        if (t + NGW < T) PREP_LOAD(t + NGW);
        { const f32x4 cur = (f32x4){bflo(wc.x), bfhi(wc.x), bflo(wc.y), bfhi(wc.y)}, prv = (f32x4){bflo(wp.x), bfhi(wp.x), bflo(wp.y), bfhi(wp.y)}; f32x4 p = cur + (prv - cur) * m;
          if (c4 < 64) { for (int j = 0; j < 4; ++j) p[j] = tanhf_(p[j]); } else if (c4 >= 128) { for (int j = 0; j < 4; ++j) p[j] = sigmoidf_(p[j]); }
          st_bf4(LA + (size_t)t * 256 + c4, p); }
        { f32x4 v = (f32x4){bflo(wq.x), bfhi(wq.x), bflo(wq.y), bfhi(wq.y)}; const float ss = wave_sum((v[0] * v[0] + v[1] * v[1]) + (v[2] * v[2] + v[3] * v[3]));
          const float rs = 1.0f / sqrtf(ss * (1.0f / 256.0f) + 1e-6f); v = v * rs * qgv; st_bf4(CQN + (size_t)t * 256 + c4, v); }
        { float a = bflo(wk), b = bfhi(wk); const float ss = wave_sum(a * a + b * b);
          const float rs = 1.0f / sqrtf(ss * (1.0f / 128.0f) + 1e-6f); a *= rs * kg0; b *= rs * kg1; *(unsigned*)(CKVN + (size_t)t * 128 + c2) = cvt_pk_bf16(a, b); }
        { const float o = __shfl_xor(krv, 16);
          const float r = (lane & 16) ? (o * sn + krv * cs) : (krv * cs - o * sn);
          if (lane < 32) { const bf16_t rb = (bf16_t)(cvt_pk_bf16(r, 0.f) & 0xffffu); for (int h = 0; h < 4; ++h) KM[(size_t)t * 384 + h * 96 + 64 + lane] = rb; } }
    }
#undef PREP_LOAD
}
__device__ __forceinline__ void ph_rwprep(const Ctx& C, int l) {
#if defined(NAIVE_SCAN)
    if (NAIVE_SCAN & 2) { float* q_ = WSP(float, S_SSQ); for (int i = C.bid * NTHREADS + C.tid; i < T * 8; i += C.G * NTHREADS) q_[i] = 0.f; }
#endif
    const bf16_t* __restrict__ proj = WSP(bf16_t, S_PROJ); const float* mu = C.in[I_RWMU] + l * 1024; const bf16_t* __restrict__ AV = WSP(bf16_t, S_AV); bf16_t* __restrict__ RWS = WSP(bf16_t, S_RWS);
    const float* kkw = C.in[I_RWKK] + l * 256; const float* kaw = C.in[I_RWKA] + l * 256; const int lane = C.lane, c = 4 * lane;
    f32x4 muv[3];
#pragma unroll
    for (int q = 0; q < 3; ++q) muv[q] = *(const f32x4*)(mu + q * 256 + c);
    const f32x4 kkv = *(const f32x4*)(kkw + c), kav = *(const f32x4*)(kaw + c);
    u32x2 ncur[3], nprv[3], nav;
#define RWP_LOAD(tt) do { const bf16_t* pr_ = proj + (size_t)(tt) * NPROJ + PC_RW; const bool f_ = ((tt) % SEQ) == 0; \
        _Pragma("unroll") for (int q = 0; q < 3; ++q) { ncur[q] = *(const u32x2*)(pr_ + q * 256 + c); nprv[q] = f_ ? (u32x2){0u, 0u} : *(const u32x2*)(pr_ - NPROJ + q * 256 + c); } \
        nav = *(const u32x2*)(AV + (size_t)(tt) * 256 + c); } while (0)
#define U2F4(w) ((f32x4){bflo((w).x), bfhi((w).x), bflo((w).y), bfhi((w).y)})
    int t = GW; if (t < T) RWP_LOAD(t);
    for (; t < T; t += NGW) {
        f32x4 rkv[3];
#pragma unroll
        for (int q = 0; q < 3; ++q) { const f32x4 cur = U2F4(ncur[q]), prv = U2F4(nprv[q]); rkv[q] = cur + (prv - cur) * muv[q]; }
        const f32x4 a = U2F4(nav);
        if (t + NGW < T) RWP_LOAD(t + NGW);
        f32x4 kk = rkv[1] * kkv;
        float ss = (kk[0] * kk[0] + kk[1] * kk[1]) + (kk[2] * kk[2] + kk[3] * kk[3]);
        ss = row_sum16(ss);
        kk = kk * (1.0f / sqrtf(fmaxf(ss, 1e-24f)));
        const f32x4 kmod = rkv[1] * ((a - 1.0f) * kav + 1.0f), ka = kk * a;
        const size_t o = (size_t)t * 256 + c, PL = (size_t)T * 256;
        st_bf4(RWS + o, rkv[0]); st_bf4(RWS + PL + o, kmod); st_bf4(RWS + 2 * PL + o, rkv[2]); st_bf4(RWS + 3 * PL + o, kk); st_bf4(RWS + 4 * PL + o, ka);
    }
#undef RWP_LOAD
}
__device__ __forceinline__ void ph_ssdprep(const Ctx& C, int l) {
    const bf16_t* __restrict__ proj = WSP(bf16_t, S_PROJ); bf16_t* __restrict__ XA = WSP(bf16_t, S_XA); bf16_t* __restrict__ BC = WSP(bf16_t, S_BC); bf16_t* __restrict__ CC = WSP(bf16_t, S_CC); float* __restrict__ ACS = WSP(float, S_ACS); float* __restrict__ DTV = WSP(float, S_DTV);
    const float* cw = C.in[I_CONVW] + l * 4 * 768; const float* cb = C.in[I_CONVB] + l * 768; const float* dtbp = C.in[I_DTB] + l * 4; const float* alog = C.in[I_ALOG] + l * 4; const int lane = C.lane;
    for (int item = GW; item < 64; item += NGW) { const int b = item >> 2, h = item & 3; const float dtb = dtbp[h], a2 = -expf(alog[h]) * LOG2E; const size_t t0 = (size_t)b * SEQ + 32 * lane;
        unsigned short rawv[32];
#pragma unroll
        for (int i = 0; i < 32; ++i) rawv[i] = proj[(t0 + i) * NPROJ + PC_DT + h];
        float pre[32]; float run = 0.f;
#pragma unroll
        for (int i = 0; i < 32; ++i) { run += softplusf_(bf2f(rawv[i]) + dtb) * a2; pre[i] = run; }
        float sc_ = run;
#pragma unroll
        for (int d = 1; d < 64; d <<= 1) { const float o = __shfl_up(sc_, d); if (lane >= d) sc_ += o; }
        const float base = sc_ - run;
#pragma unroll
        for (int i = 0; i < 32; ++i) ACS[(t0 + i) * 4 + h] = base + pre[i]; }
    f32x4 cbv[3], cwv[3][4];
#pragma unroll
    for (int j = 0; j < 3; ++j) { const int c = 4 * lane + 256 * j; cbv[j] = *(const f32x4*)(cb + c);
#pragma unroll
        for (int k = 0; k < 4; ++k) cwv[j][k] = *(const f32x4*)(cw + k * 768 + c); }
    const float dtbl = dtbp[lane & 3];
    u32x2 nraw[3][4]; unsigned short ndt;
#define SSP_LOAD(tt) do { const int tl_ = (tt) % SEQ; _Pragma("unroll") for (int j = 0; j < 3; ++j) _Pragma("unroll") for (int k = 0; k < 4; ++k) \
        nraw[j][k] = (tl_ - 3 + k >= 0) ? *(const u32x2*)(proj + (size_t)((tt) - 3 + k) * NPROJ + PC_XS + 4 * lane + 256 * j) : (u32x2){0u, 0u}; \
        ndt = proj[(size_t)(tt) * NPROJ + PC_DT + (lane & 3)]; } while (0)
    int t = GW; if (t < T) SSP_LOAD(t);
    for (; t < T; t += NGW) {
        f32x4 acc3[3]; const float dtraw = bf2f(ndt);
#pragma unroll
        for (int j = 0; j < 3; ++j) { f32x4 a = cbv[j];
#pragma unroll
            for (int k = 0; k < 4; ++k) a += U2F4(nraw[j][k]) * cwv[j][k];
            acc3[j] = a; }
        if (t + NGW < T) SSP_LOAD(t + NGW);
#pragma unroll
        for (int j = 0; j < 3; ++j) { f32x4 a = acc3[j]; for (int q = 0; q < 4; ++q) a[q] = siluf_(a[q]);
            st_bf4((j == 0 ? XA : (j == 1 ? BC : CC)) + (size_t)t * 256 + 4 * lane, a); }
        if (lane < 4) DTV[(size_t)t * 4 + lane] = softplusf_(dtraw + dtbl);
    }
#undef SSP_LOAD
#undef U2F4
}
#ifndef ABL_MOE
#define ABL_MOE 1.0f
#endif
template <bool MOE> __device__ __forceinline__ void ph_ln(const Ctx& C, const float* src, float* dst, bf16_t* dstb, const float* g, const float* b, const bf16_t* ys, const bf16_t* src16 = nullptr) {
    const int lane = C.lane;
    float chkscale = 1.0f;
#if defined(CHECKS) || defined(CHECKS2) || defined(CHECKS3) || defined(CHECKS4) || defined(CHECKS5) || defined(CHECKS6) || defined(CHECKS7) || defined(CHECKS8) || defined(CHECKS9) || defined(CHECKS10) || defined(CHECKS12) || defined(CHECKS13) || defined(CHECKS14) || defined(CHECKS15)
    if (MOE) { const unsigned* cw = (const unsigned*)(C.ws + WS_CTL) + CW_CHK; int n = 0;
        for (int q = 0; q < 4; ++q) if (__hip_atomic_load(cw + 64 * q, RLX_AGENT) != 0u) n |= 1 << q;
#if defined(FG_COUNT) || defined(CHECKS13) || defined(CHECKS15)
        { unsigned v_ = __hip_atomic_load(cw + 2048, RLX_AGENT); n = 0; while (v_ > 0u) { ++n; v_ >>= 1; } }
#endif
#ifdef CHECKS10
        { const float num = __uint_as_float(__hip_atomic_load(cw + 1024, RLX_AGENT)), den = __uint_as_float(__hip_atomic_load(cw + 1088, RLX_AGENT)); const float lr = -log2f(fmaxf(num / fmaxf(den, 1e-30f), 1e-12f)); n = (int)(lr + 0.5f); n = n < 0 ? 0 : (n > 31 ? 31 : n); }
#endif
        chkscale = 1.0f + 0.1f * (float)n; }
#endif
    f32x4 gv[4], bv[4];
#pragma unroll
    for (int j = 0; j < 4; ++j) { gv[j] = *(const f32x4*)(g + 4 * lane + 256 * j); bv[j] = *(const f32x4*)(b + 4 * lane + 256 * j); }
    f32x4 nv[4]; u32x2 ny0[4], ny1[4];
#define LN_LOAD(tt) do { _Pragma("unroll") for (int j = 0; j < 4; ++j) { nv[j] = ld_bf4(src16 + (size_t)(tt) * 1024 + 4 * lane + 256 * j); \
        if (MOE) { ny0[j] = *(const u32x2*)(ys + (size_t)(2 * (tt)) * 1024 + 4 * lane + 256 * j); ny1[j] = *(const u32x2*)(ys + (size_t)(2 * (tt) + 1) * 1024 + 4 * lane + 256 * j); } } } while (0)
    int t = GW; if (t < T) LN_LOAD(t);
    for (; t < T; t += NGW) {
        f32x4 v[4]; float s = 0.f;
#pragma unroll
        for (int j = 0; j < 4; ++j) { v[j] = nv[j];
            if (MOE) { const f32x4 y0 = (f32x4){bflo(ny0[j].x), bfhi(ny0[j].x), bflo(ny0[j].y), bfhi(ny0[j].y)}, y1 = (f32x4){bflo(ny1[j].x), bfhi(ny1[j].x), bflo(ny1[j].y), bfhi(ny1[j].y)}; v[j] = v[j] * DN_ALPHA + (y0 + y1) * ABL_MOE; } }
        if (t + NGW < T) LN_LOAD(t + NGW);
#pragma unroll
        for (int j = 0; j < 4; ++j) s += (v[j][0] + v[j][1]) + (v[j][2] + v[j][3]);
        const float mean = wave_sum(s) * (1.0f / 1024.0f); float s2 = 0.f;
#pragma unroll
        for (int j = 0; j < 4; ++j) { v[j] = v[j] - mean; s2 += (v[j][0] * v[j][0] + v[j][1] * v[j][1]) + (v[j][2] * v[j][2] + v[j][3] * v[j][3]); }
        const float rstd = 1.0f / sqrtf(wave_sum(s2) * (1.0f / 1024.0f) + 1e-5f);
#pragma unroll
        for (int j = 0; j < 4; ++j) { const int c = 4 * lane + 256 * j; const f32x4 o = (v[j] * rstd * gv[j] + bv[j]) * chkscale;
            if (dst) *(f32x4*)(dst + (size_t)t * 1024 + c) = o; if (dstb) st_bf4(dstb + (size_t)t * 1024 + c, o); }
    }
#undef LN_LOAD
}
__device__ __forceinline__ void ph_ssdfix(const Ctx& C, int l) {
    bf16_t* Y = WSP(bf16_t, S_Y); const float* ssq = WSP(float, S_SSQ); const float* ng = C.in[I_SSDNG] + l * 256; const int lane = C.lane, c = 4 * lane, g = lane >> 5;
    const bf16_t* YRAW = WSP(bf16_t, S_YRAW); const bf16_t* RWS = WSP(bf16_t, S_RWS); const bf16_t* GV = WSP(bf16_t, S_GV); const size_t PL = (size_t)T * 256;
    const f32x4 rk = *(const f32x4*)(C.in[I_RWRK] + l * 256 + c), gng = *(const f32x4*)(C.in[I_RWGNG] + l * 256 + c), gnb = *(const f32x4*)(C.in[I_RWGNB] + l * 256 + c);
    const f32x4 ngv = *(const f32x4*)(ng + c);
    f32x4 nq; u32x2 nys, nyr, nr, nkm, nvv, ngg;
#define U2F4(w) ((f32x4){bflo((w).x), bfhi((w).x), bflo((w).y), bfhi((w).y)})
#define FIX_LOAD(tt) do { nq = *(const f32x4*)(ssq + (size_t)(tt) * 8 + 4 * g); nys = *(const u32x2*)(Y + (size_t)(tt) * 1024 + 512 + c); const size_t o_ = (size_t)(tt) * 256 + c; \
        nyr = *(const u32x2*)(YRAW + o_); nr = *(const u32x2*)(RWS + o_); nkm = *(const u32x2*)(RWS + PL + o_); nvv = *(const u32x2*)(RWS + 2 * PL + o_); ngg = *(const u32x2*)(GV + o_); } while (0)
    int t = GW; if (t < T) FIX_LOAD(t);
    for (; t < T; t += NGW) {
        const f32x4 q4 = nq; f32x4 v = U2F4(nys); const f32x4 yv = U2F4(nyr), rr = U2F4(nr), km = U2F4(nkm), vv = U2F4(nvv), gg = U2F4(ngg);
        if (t + NGW < T) FIX_LOAD(t + NGW);
        const float q = (q4[0] + q4[1]) + (q4[2] + q4[3]); const float rs = 1.0f / sqrtf(q * (1.0f / 128.0f) + 1e-5f);
        v = v * rs * ngv; st_bf4(Y + (size_t)t * 1024 + 512 + c, v);
        float sm = (yv[0] + yv[1]) + (yv[2] + yv[3]), bd = (rr[0] * km[0] * rk[0] + rr[1] * km[1] * rk[1]) + (rr[2] * km[2] * rk[2] + rr[3] * km[3] * rk[3]);
        sm = row_sum16(sm); bd = row_sum16(bd);
        const float mu = sm * (1.0f / 64.0f); const f32x4 d = yv - mu; float vs = (d[0] * d[0] + d[1] * d[1]) + (d[2] * d[2] + d[3] * d[3]);
        vs = row_sum16(vs);
        const float rstd = 1.0f / sqrtf(vs * (1.0f / 64.0f) + 64e-5f);
        st_bf4(Y + (size_t)t * 1024 + 256 + c, ((d * rstd) * gng + gnb + vv * bd) * gg);
    }
#undef FIX_LOAD
#undef U2F4
}
typedef __bf16 bfx8 __attribute__((ext_vector_type(8)));
__device__ __forceinline__ f32x16 mfma32(const bf16x8 a, const bf16x8 b, const f32x16 c) { return __builtin_amdgcn_mfma_f32_32x32x16_bf16(__builtin_bit_cast(bfx8, a), __builtin_bit_cast(bfx8, b), c, 0, 0, 0); }
__device__ __forceinline__ float dpp_xor1(float v) { return __builtin_bit_cast(float, __builtin_amdgcn_mov_dpp(__builtin_bit_cast(int, v), 0xB1, 0xf, 0xf, true)); }
__device__ __forceinline__ float dpp_xor2(float v) { return __builtin_bit_cast(float, __builtin_amdgcn_mov_dpp(__builtin_bit_cast(int, v), 0x4E, 0xf, 0xf, true)); }
__device__ __forceinline__ float dpp_hmir(float v) { return __builtin_bit_cast(float, __builtin_amdgcn_mov_dpp(__builtin_bit_cast(int, v), 0x141, 0xf, 0xf, true)); }
__device__ __forceinline__ float sum8(float v) { v += dpp_xor1(v); v += dpp_xor2(v); v += dpp_hmir(v); return v; }

__device__ __forceinline__ float xor32(float v, int hh) { const auto sw = __builtin_amdgcn_permlane32_swap(__builtin_bit_cast(unsigned, v), __builtin_bit_cast(unsigned, v), false, false); return __builtin_bit_cast(float, (unsigned)(hh ? sw[0] : sw[1])); }
typedef short s16x4 __attribute__((ext_vector_type(4)));
typedef short s16x8 __attribute__((ext_vector_type(8)));
template <int MODE>
__device__ __forceinline__ void attn_unit(const Ctx& C0_, int l, int b, int h, int qb, unsigned vf = 0u) {
    const Ctx C = launder(C0_);
    constexpr int DQK = MODE == 2 ? 128 : (MODE == 1 ? 96 : 64), NS = DQK / 16, KST = DQK * 2 + 16, VST = 192, KCH = DQK / 8;
    const bf16_t *Qp, *Kp, *Vp; int qs, ks, vs, ycol;
    if (MODE == 0) { const bf16_t* proj = WSP(bf16_t, S_PROJ); Qp = proj + PC_SBQ + h * 64; Kp = proj + PC_SBK + h * 64; Vp = proj + PC_SBV + h * 64; qs = ks = vs = NPROJ; ycol = h * 64; }
    else if (MODE == 1) { Qp = WSP(bf16_t, S_QM) + h * 96; Kp = WSP(bf16_t, S_KM) + h * 96; Vp = WSP(bf16_t, S_VM) + h * 64; qs = ks = 384; vs = 256; ycol = 768 + h * 64; }
    else { Qp = WSP(bf16_t, S_CC) + (h >> 1) * 128; Kp = WSP(bf16_t, S_BC) + (h >> 1) * 128; Vp = WSP(bf16_t, S_XA) + h * 64; qs = ks = vs = 256; ycol = 512 + h * 64; }
    const float* ACS = WSP(float, S_ACS); const float* DTV = WSP(float, S_DTV);
    const size_t tb = (size_t)b * SEQ;
    constexpr int ABUF = 64 * KST + 64 * VST + 512;
    LAS unsigned char* const abase = C.lds;
    const int tid = C.tid, lane = C.lane, w = C.wave, r = lane & 31, hh = lane >> 5;
    const int Q0 = qb * 256, qidx = Q0 + 32 * w + r, qmin = Q0 + 32 * w, qmax = qmin + 31;
    bf16x8 qf[NS];
#pragma unroll
    for (int s = 0; s < NS; ++s) qf[s] = *(const bf16x8*)(Qp + (tb + qidx) * qs + 16 * s + 8 * hh);
    f32x16 o[2]; for (int i = 0; i < 16; ++i) { o[0][i] = 0.f; o[1][i] = 0.f; }
    float Rrun = 0.f, mrun = -1.0e30f, lsum = 0.f;
    const int pr = (r & ~12) | ((r & 4) << 1) | ((r & 8) >> 1);
    u32x4 kreg0, kreg1, vreg; const int krow0 = tid / KCH, kch0 = tid % KCH, krow1 = (tid + 512) / KCH, kch1 = (tid + 512) % KCH, vrow = tid >> 3, vch = tid & 7;
    const bool k1 = (MODE == 2) || ((MODE == 1) && (tid < 64 * KCH - 512));
    float areg = 0.f, dreg = 0.f; float aq = 0.f; if (MODE == 2) aq = ACS[(tb + qidx) * 4 + h];
    const int ktmax = 4 * qb + 3;
#define ATT_LOAD(kt) do { const size_t kb_ = tb + (size_t)(kt) * 64; kreg0 = *(const u32x4*)(Kp + (kb_ + krow0) * ks + kch0 * 8); if (k1) kreg1 = *(const u32x4*)(Kp + (kb_ + krow1) * ks + kch1 * 8); \
        vreg = *(const u32x4*)(Vp + (kb_ + vrow) * vs + vch * 8); if (MODE == 2 && tid < 64) { areg = ACS[(kb_ + tid) * 4 + h]; dreg = DTV[(kb_ + tid) * 4 + h]; } } while (0)
#define ATT_STORE(bi) do { LAS unsigned char* Kt_ = abase + (bi) * ABUF; LAS unsigned char* Vt_ = Kt_ + 64 * KST; \
        *(LAS u32x4*)(Kt_ + krow0 * KST + kch0 * 16) = kreg0; if (k1) *(LAS u32x4*)(Kt_ + krow1 * KST + kch1 * 16) = kreg1; \
        *(LAS u32x4*)(Vt_ + vrow * VST + vch * 16) = vreg; if (MODE == 2 && tid < 64) { ((LAS float*)(Vt_ + 64 * VST))[tid] = areg; ((LAS float*)(Vt_ + 64 * VST))[64 + tid] = dreg; } } while (0)
    __syncthreads();
    ATT_LOAD(ktmax); ATT_STORE(0); if (ktmax > 0) ATT_LOAD(ktmax - 1);
    __syncthreads();
    for (int kt = ktmax; kt >= 0; --kt) {
        const int bi = (ktmax - kt) & 1;
        LAS unsigned char* Kt = abase + bi * ABUF; LAS unsigned char* Vt = Kt + 64 * KST; LAS float* AkL = (LAS float*)(Vt + 64 * VST); LAS float* DkL = AkL + 64;
        if (kt > 0 && !(vf & 128u)) { ATT_STORE(bi ^ 1); if (kt > 1) ATT_LOAD(kt - 2); }
        const int k0 = kt * 64;
        if (k0 <= qmax) {
        const bool need_mask = (k0 + 63 >= qmin);
        f32x16 sc[2];
#pragma unroll
        for (int sub = 0; sub < 2; ++sub) {
            for (int i = 0; i < 16; ++i) sc[sub][i] = 0.f;
            if (!(vf & 16u)) { _Pragma("unroll") for (int s = 0; s < NS; ++s) { const bf16x8 kf = *(const LAS bf16x8*)(Kt + (32 * sub + pr) * KST + (16 * s + 8 * hh) * 2); sc[sub] = mfma32(kf, qf[s], sc[sub]); } }
        }
        s16x4 vfr[2][2][4];
        { const LAS unsigned char* vb_ = Vt + (8 * hh + ((lane & 15) >> 2)) * VST + (16 * ((lane >> 4) & 1) + 4 * (lane & 3)) * 2;
#pragma unroll
          for (int sub = 0; sub < 2; ++sub)
#pragma unroll
            for (int s = 0; s < 2; ++s) { const LAS unsigned char* a_ = vb_ + (32 * sub + 16 * s) * VST;
                vfr[sub][s][0] = __builtin_amdgcn_ds_read_tr16_b64_v4i16((LAS s16x4*)a_); vfr[sub][s][1] = __builtin_amdgcn_ds_read_tr16_b64_v4i16((LAS s16x4*)(a_ + 768));
                vfr[sub][s][2] = __builtin_amdgcn_ds_read_tr16_b64_v4i16((LAS s16x4*)(a_ + 64)); vfr[sub][s][3] = __builtin_amdgcn_ds_read_tr16_b64_v4i16((LAS s16x4*)(a_ + 832)); } }
        if (vf & 32u) { } else
        if (MODE == 0) {
#pragma unroll
            for (int sub = 1; sub >= 0; --sub) {
                const int kb = k0 + 32 * sub + 8 * hh;
                float L[16];
#pragma unroll
                for (int i = 0; i < 16; ++i) { const float z = sc[sub][i]; const float l2 = -(fmaxf(z, 0.f) + flog2(1.0f + fexp2(-fabsf(z)))); L[i] = l2; sc[sub][i] = z + l2; }
                if (need_mask) {
#pragma unroll
                    for (int i = 0; i < 16; ++i) { const int key = kb + (i & 7) + 16 * (i >> 3); const bool ok = key < qidx; L[i] = ok ? L[i] : 0.f; sc[sub][i] = ok ? sc[sub][i] : -1.0e30f; } }
                float own_hi = 0.f, own_lo = 0.f, tl[16];
#pragma unroll
                for (int j = 7; j >= 0; --j) { tl[8 + j] = own_hi; own_hi += L[8 + j]; tl[j] = own_lo; own_lo += L[j]; }
                const float p_hi = xor32(own_hi, hh), p_lo = xor32(own_lo, hh);
                const float off_hi = Rrun + (hh ? 0.f : p_hi), off_lo = Rrun + own_hi + p_hi + (hh ? 0.f : p_lo);
                Rrun += (own_hi + own_lo) + (p_hi + p_lo);
#pragma unroll
                for (int i = 0; i < 16; ++i) sc[sub][i] = fexp2(sc[sub][i] + tl[i] + (i >= 8 ? off_hi : off_lo));
            }
        } else if (MODE == 2) {
#pragma unroll
            for (int sub = 0; sub < 2; ++sub) { f32x4 ak[4], dk[4];
#pragma unroll
                for (int r4 = 0; r4 < 4; ++r4) { const int o_ = 32 * sub + 8 * hh + 16 * (r4 >> 1) + 4 * (r4 & 1); ak[r4] = *(const LAS f32x4*)(AkL + o_); dk[r4] = *(const LAS f32x4*)(DkL + o_); }
#pragma unroll
                for (int i = 0; i < 16; ++i) { const float a_ = ak[(i >> 3) * 2 + ((i & 7) >> 2)][i & 3], d_ = dk[(i >> 3) * 2 + ((i & 7) >> 2)][i & 3];
                    sc[sub][i] = sc[sub][i] * d_ * fexp2(fminf(aq - a_, 0.f)); }
                if (need_mask) {
#pragma unroll
                    for (int i = 0; i < 16; ++i) { const int key = k0 + 32 * sub + 8 * hh + (i & 7) + 16 * (i >> 3); sc[sub][i] = key <= qidx ? sc[sub][i] : 0.f; } } }
        } else {
            if (need_mask) {
#pragma unroll
                for (int sub = 0; sub < 2; ++sub)
#pragma unroll
                    for (int i = 0; i < 16; ++i) { const int key = k0 + 32 * sub + 8 * hh + (i & 7) + 16 * (i >> 3); sc[sub][i] = key <= qidx ? sc[sub][i] : -1.0e30f; } }
            float tm = -1.0e30f;
#pragma unroll
            for (int sub = 0; sub < 2; ++sub)
#pragma unroll
                for (int i = 0; i < 16; ++i) tm = fmaxf(tm, sc[sub][i]);
            tm = fmaxf(tm, xor32(tm, hh));
            if (!__all(tm <= mrun)) {
                const float mnew = fmaxf(mrun, tm), alpha = fexp2(mrun - mnew); mrun = mnew; lsum *= alpha;
#pragma unroll
                for (int i = 0; i < 16; ++i) { o[0][i] *= alpha; o[1][i] *= alpha; } }
            float ps = 0.f;
#pragma unroll
            for (int sub = 0; sub < 2; ++sub)
#pragma unroll
                for (int i = 0; i < 16; ++i) { const float p = fexp2(sc[sub][i] - mrun); sc[sub][i] = p; ps += p; }
            lsum += ps;
        }
        if (!(vf & 64u))
#pragma unroll
        for (int sub = 0; sub < 2; ++sub)
#pragma unroll
            for (int s = 0; s < 2; ++s) {
                bf16x8 pf; { u32x4 pw; pw.x = cvt_pk_bf16(sc[sub][8 * s + 0], sc[sub][8 * s + 1]); pw.y = cvt_pk_bf16(sc[sub][8 * s + 2], sc[sub][8 * s + 3]); pw.z = cvt_pk_bf16(sc[sub][8 * s + 4], sc[sub][8 * s + 5]); pw.w = cvt_pk_bf16(sc[sub][8 * s + 6], sc[sub][8 * s + 7]); pf = __builtin_bit_cast(bf16x8, pw); }
                const s16x8 va0 = __builtin_shufflevector(vfr[sub][s][0], vfr[sub][s][1], 0, 1, 2, 3, 4, 5, 6, 7), va1 = __builtin_shufflevector(vfr[sub][s][2], vfr[sub][s][3], 0, 1, 2, 3, 4, 5, 6, 7);
                o[0] = mfma32(__builtin_bit_cast(bf16x8, va0), pf, o[0]);
                o[1] = mfma32(__builtin_bit_cast(bf16x8, va1), pf, o[1]);
            }
        }
        bool dead = false;
        if (MODE == 0) dead = Rrun < -64.0f;
        if (MODE == 2) dead = aq - AkL[0] < -64.0f;
        if (MODE == 1) { __syncthreads(); }
        else { volatile LAS unsigned* votes = (volatile LAS unsigned*)(C.lds + LDSCTL_OFF + 128) + 8 * bi;
            const bool wdead = __all(dead ? 1 : 0); if (lane == 0) votes[w] = wdead ? 1u : 0u;
            __syncthreads();
            unsigned all_ = 1u;
#pragma unroll
            for (int q_ = 0; q_ < 8; ++q_) all_ &= votes[q_];
            if (all_) break; }
    }
#undef ATT_LOAD
#undef ATT_STORE
    float inv = 1.0f;
    if (MODE == 1) { const float lt = lsum + xor32(lsum, hh); inv = frcp(lt); }
    bf16_t* Y = WSP(bf16_t, S_Y) + (tb + qidx) * 1024 + ycol;
    if (MODE == 2) {
        const float dsk = C.in[I_SSDD][l * 4 + h]; const bf16_t* xa = Vp + (tb + qidx) * 256; const bf16_t* zp = WSP(bf16_t, S_PROJ) + (tb + qidx) * NPROJ + PC_Z + h * 64; float q_ = 0.f;
#pragma unroll
        for (int dt = 0; dt < 2; ++dt)
#pragma unroll
            for (int g = 0; g < 4; ++g) { const int d0 = 32 * dt + 8 * g + 4 * hh; const f32x4 xv = ld_bf4(xa + d0), zv = ld_bf4(zp + d0); f32x4 y;
                for (int j = 0; j < 4; ++j) { y[j] = (o[dt][4 * g + j] + dsk * xv[j]) * siluf_(zv[j]); q_ += y[j] * y[j]; }
                st_bf4(Y + d0, y); }
        q_ += __shfl_xor(q_, 32);
        if (hh == 0) { float* SSQ = WSP(float, S_SSQ); SSQ[(tb + qidx) * 8 + h * 2] = q_; SSQ[(tb + qidx) * 8 + h * 2 + 1] = 0.f; }
        return;
    }
#pragma unroll
    for (int dt = 0; dt < 2; ++dt)
#pragma unroll
        for (int g = 0; g < 4; ++g) { u32x2 wv; wv.x = cvt_pk_bf16(o[dt][4 * g] * inv, o[dt][4 * g + 1] * inv); wv.y = cvt_pk_bf16(o[dt][4 * g + 2] * inv, o[dt][4 * g + 3] * inv);
            *(u32x2*)(Y + 32 * dt + 8 * g + 4 * hh) = wv; }
}

__device__ __forceinline__ float sum16(float v) { v = sum8(v); v += __builtin_bit_cast(float, __builtin_amdgcn_mov_dpp(__builtin_bit_cast(int, v), 0x140, 0xf, 0xf, true)); return v; }
__device__ __forceinline__ void rwkv_unit(const Ctx& C0_, int l, int b, int h, int half) {
    const Ctx C = launder(C0_);
    constexpr int TB = 32, NBLK = SEQ / TB, BUFB = 6 * TB * 64 * 4;
    LAS float* buf0 = (LAS float*)C.lds; LAS float* ybuf = (LAS float*)(C.lds + 2 * BUFB);
    const int tid = C.tid, il = tid >> 4, q = tid & 15, i = 32 * half + il;
    const float* DEC = WSP(float, S_DEC); const bf16_t* RWS = WSP(bf16_t, S_RWS); bf16_t* YRAW = WSP(bf16_t, S_YRAW);
    const size_t PL = (size_t)T * 256; const size_t tb = (size_t)b * SEQ;
    const int ls = tid >> 4, lj = 4 * (tid & 15);
    f32x4 gw; u32x2 gr[5];
#define RW_LOAD(blk) do { const size_t o_ = (tb + (size_t)(blk) * TB + ls) * 256 + h * 64 + lj; gw = *(const f32x4*)(DEC + o_); \
        gr[0] = *(const u32x2*)(RWS + 3 * PL + o_); gr[1] = *(const u32x2*)(RWS + 4 * PL + o_); gr[2] = *(const u32x2*)(RWS + PL + o_); gr[3] = *(const u32x2*)(RWS + o_); gr[4] = *(const u32x2*)(RWS + 2 * PL + o_); } while (0)
#define RW_STORE(bufp) do { LAS float* d_ = (bufp) + ls * 64 + lj; *(LAS f32x4*)d_ = gw; \
        _Pragma("unroll") for (int a_ = 0; a_ < 5; ++a_) *(LAS f32x4*)(d_ + (a_ + 1) * TB * 64) = (f32x4){bflo(gr[a_].x), bfhi(gr[a_].x), bflo(gr[a_].y), bfhi(gr[a_].y)}; } while (0)
    f32x4 S = (f32x4){0.f, 0.f, 0.f, 0.f};
    __syncthreads();
    RW_LOAD(0); RW_STORE(buf0);
    __syncthreads();
    for (int blk = 0; blk < NBLK; ++blk) {
        LAS float* cur = buf0 + (blk & 1) * (BUFB / 4); LAS float* nxtb = buf0 + ((blk + 1) & 1) * (BUFB / 4);
        if (blk + 1 < NBLK) RW_LOAD(blk + 1);
        f32x4 wA[2], kkA[2], kaA[2], kmA[2], rA[2], wB[2], kkB[2], kaB[2], kmB[2], rB[2]; float vA[2], vB[2];
#define RW_RD(W_, KK_, KA_, KM_, R_, V_, sb_) do { _Pragma("unroll") for (int u = 0; u < 2; ++u) { const LAS float* p = cur + ((sb_) + u) * 64 + 4 * q; \
            W_[u] = *(const LAS f32x4*)p; KK_[u] = *(const LAS f32x4*)(p + TB * 64); KA_[u] = *(const LAS f32x4*)(p + 2 * TB * 64); KM_[u] = *(const LAS f32x4*)(p + 3 * TB * 64); R_[u] = *(const LAS f32x4*)(p + 4 * TB * 64); \
            V_[u] = cur[5 * TB * 64 + ((sb_) + u) * 64 + i]; } } while (0)
#define RW_STEP(W_, KK_, KA_, KM_, R_, V_, sb_) do { float yv_[2]; _Pragma("unroll") for (int u = 0; u < 2; ++u) { \
            float sa = (S[0] * KK_[u][0] + S[1] * KK_[u][1]) + (S[2] * KK_[u][2] + S[3] * KK_[u][3]); sa = sum16(sa); \
            S = S * W_[u] + (KM_[u] * V_[u] - KA_[u] * sa); \
            const float y = (S[0] * R_[u][0] + S[1] * R_[u][1]) + (S[2] * R_[u][2] + S[3] * R_[u][3]); yv_[u] = sum16(y); } \
            if (q == 0) { ybuf[(sb_) * 32 + il] = yv_[0]; ybuf[((sb_) + 1) * 32 + il] = yv_[1]; } } while (0)
        RW_RD(wA, kkA, kaA, kmA, rA, vA, 0);
        for (int s0 = 0; s0 < TB; s0 += 4) {
            RW_RD(wB, kkB, kaB, kmB, rB, vB, s0 + 2);
            RW_STEP(wA, kkA, kaA, kmA, rA, vA, s0);
            if (s0 + 4 < TB) RW_RD(wA, kkA, kaA, kmA, rA, vA, s0 + 4);
            RW_STEP(wB, kkB, kaB, kmB, rB, vB, s0 + 2);
        }
#undef RW_RD
#undef RW_STEP
        __syncthreads();
        {
            const int os = tid >> 4, r2 = 2 * (tid & 15); const size_t t = tb + (size_t)blk * TB + os;
            *(unsigned*)(YRAW + t * 256 + h * 64 + 32 * half + r2) = cvt_pk_bf16(ybuf[os * 32 + r2], ybuf[os * 32 + r2 + 1]);
        }
        if (blk + 1 < NBLK) RW_STORE(nxtb);
        __syncthreads();
    }
#undef RW_LOAD
#undef RW_STORE
}

__device__ __forceinline__ void ssd_stage(const Ctx& C, int l, int h, size_t tb, int blk, LAS float* dst) {
    constexpr int TB = 16; const int g = h >> 1;
    const bf16_t* proj = WSP(bf16_t, S_PROJ); const float* cw = C.in[I_CONVW] + l * 4 * 768; const float* cb = C.in[I_CONVB] + l * 768;
    const float dtb = C.in[I_DTB][l * 4 + h], aneg = -expf(C.in[I_ALOG][l * 4 + h]);
    for (int it = C.tid; it < TB * 80; it += NTHREADS) {
        const int s = it / 80, v = it % 80; const int tl = blk * TB + s;
        int pcol, cch, doff;
        if (v < 16) { pcol = PC_XS + h * 64 + 4 * v; cch = h * 64 + 4 * v; doff = s * 64 + 4 * v; }
        else if (v < 48) { pcol = PC_BM + g * 128 + 4 * (v - 16); cch = 256 + g * 128 + 4 * (v - 16); doff = 2 * TB * 64 + s * 128 + 4 * (v - 16); }
        else { pcol = PC_CM + g * 128 + 4 * (v - 48); cch = 512 + g * 128 + 4 * (v - 48); doff = 2 * TB * 64 + TB * 128 + s * 128 + 4 * (v - 48); }
        f32x4 a = *(const f32x4*)(cb + cch);
#pragma unroll
        for (int k = 0; k < 4; ++k) { const int tt = tl - 3 + k; if (tt >= 0) a += ld_bf4(proj + (tb + tt) * NPROJ + pcol) * *(const f32x4*)(cw + k * 768 + cch); }
        for (int j = 0; j < 4; ++j) a[j] = siluf_(a[j]);
        if (v < 16) { const float dt = softplusf_(bf2f(proj[(tb + tl) * NPROJ + PC_DT + h]) + dtb); *(LAS f32x4*)(dst + TB * 64 + doff) = a; *(LAS f32x4*)(dst + doff) = a * dt;
                      if (v == 0) dst[TB * 384 + s] = expf(dt * aneg); }
        else *(LAS f32x4*)(dst + doff) = a;
    }
}
__device__ __forceinline__ void ssd_unit(const Ctx& C0_, int l, int b, int h, int ph) {
    const Ctx C = launder(C0_);
    constexpr int TB = 32, NBLK = SEQ / TB, NF = TB * (32 + 32 + 128 + 128) + 64, NIT = 72 * TB, NK = (NIT + NTHREADS - 1) / NTHREADS;
    LAS float* buf0 = (LAS float*)C.lds; LAS float* ypart = buf0 + 2 * NF;
    const int tid = C.tid, lane = C.lane, w = C.wave, g = h >> 1, pl = lane & 31, nh = lane >> 5;
    const bf16_t* proj = WSP(bf16_t, S_PROJ); bf16_t* Y = WSP(bf16_t, S_Y); float* SSQ = WSP(float, S_SSQ);
    const float* cw = C.in[I_CONVW] + l * 4 * 768; const float* cb = C.in[I_CONVB] + l * 768;
    const float dtb = C.in[I_DTB][l * 4 + h], aneg = -expf(C.in[I_ALOG][l * 4 + h]), dsk = C.in[I_SSDD][l * 4 + h];
    const size_t tb = (size_t)b * SEQ;
    int its[NK], itp[NK], itd[NK], itc[NK]; bool itx[NK];
#pragma unroll
    for (int k = 0; k < NK; ++k) { const int it = tid + NTHREADS * k, sidx = it / 72, v = it % 72; int pcol, cch, doff;
        if (v < 8) { pcol = PC_XS + h * 64 + 32 * ph + 4 * v; cch = h * 64 + 32 * ph + 4 * v; doff = sidx * 32 + 4 * v; }
        else if (v < 40) { pcol = PC_BM + g * 128 + 4 * (v - 8); cch = 256 + g * 128 + 4 * (v - 8); doff = 2 * TB * 32 + sidx * 128 + 4 * (v - 8); }
        else { pcol = PC_CM + g * 128 + 4 * (v - 40); cch = 512 + g * 128 + 4 * (v - 40); doff = 2 * TB * 32 + TB * 128 + sidx * 128 + 4 * (v - 40); }
        its[k] = sidx; itp[k] = pcol; itd[k] = doff; itx[k] = v < 8; itc[k] = cch; }
    const bool haslast = tid + NTHREADS * (NK - 1) < NIT;
    u32x2 raw[NK][4]; float dtr[NK]; unsigned short zraw;
    const int os = tid >> 4, op = tid & 15;
#define SSD_LOAD(blk) do { _Pragma("unroll") for (int k = 0; k < NK; ++k) { if (k < NK - 1 || haslast) { const int tl_ = (blk) * TB + its[k]; \
            _Pragma("unroll") for (int q = 0; q < 4; ++q) { const int tt_ = tl_ - 3 + q; raw[k][q] = tt_ >= 0 ? *(const u32x2*)(proj + (tb + tt_) * NPROJ + itp[k]) : (u32x2){0u, 0u}; } \
            dtr[k] = itx[k] ? bf2f(proj[(tb + tl_) * NPROJ + PC_DT + h]) : 0.f; } } } while (0)
#define SSD_COMMIT(dst) do { _Pragma("unroll") for (int k = 0; k < NK; ++k) { if (k < NK - 1 || haslast) { f32x4 a_ = *(const f32x4*)(cb + itc[k]); \
            _Pragma("unroll") for (int q = 0; q < 4; ++q) a_ += (f32x4){bflo(raw[k][q].x), bfhi(raw[k][q].x), bflo(raw[k][q].y), bfhi(raw[k][q].y)} * *(const f32x4*)(cw + q * 768 + itc[k]); \
            for (int j = 0; j < 4; ++j) a_[j] = siluf_(a_[j]); \
            if (itx[k]) { const float dt_ = softplusf_(dtr[k] + dtb); *(LAS f32x4*)((dst) + TB * 32 + itd[k]) = a_; *(LAS f32x4*)((dst) + itd[k]) = a_ * dt_; if ((itd[k] & 31) == 0) (dst)[TB * 320 + its[k]] = expf(dt_ * aneg); } \
            else *(LAS f32x4*)((dst) + itd[k]) = a_; } } } while (0)
    float hs[8];
#pragma unroll
    for (int k = 0; k < 8; ++k) hs[k] = 0.f;
    __syncthreads();
    SSD_LOAD(0); SSD_COMMIT(buf0);
    __syncthreads();
    for (int blk = 0; blk < NBLK; ++blk) {
        LAS float* cur = buf0 + (blk & 1) * NF; LAS float* nxtb = buf0 + ((blk + 1) & 1) * NF;
        if (blk + 1 < NBLK) SSD_LOAD(blk + 1);
        const size_t tz = tb + (size_t)blk * TB + os;
        zraw = proj[tz * NPROJ + PC_Z + h * 64 + 32 * ph + op]; const unsigned short zraw2 = proj[tz * NPROJ + PC_Z + h * 64 + 32 * ph + op + 16];
        for (int s0 = 0; s0 < TB; s0 += 4) {
            float x4[4], dA4[4], yv[4]; f32x4 bv[4][2], cv[4][2];
#pragma unroll
            for (int u = 0; u < 4; ++u) { const int s = s0 + u; x4[u] = cur[s * 32 + pl]; dA4[u] = cur[TB * 320 + s];
                const LAS float* bp = cur + 2 * TB * 32 + s * 128 + 16 * w + 8 * nh; const LAS float* cp = bp + TB * 128;
                bv[u][0] = *(const LAS f32x4*)bp; bv[u][1] = *(const LAS f32x4*)(bp + 4); cv[u][0] = *(const LAS f32x4*)cp; cv[u][1] = *(const LAS f32x4*)(cp + 4); }
#pragma unroll
            for (int u = 0; u < 4; ++u) { float yp = 0.f;
#pragma unroll
                for (int k4 = 0; k4 < 2; ++k4)
#pragma unroll
                    for (int j = 0; j < 4; ++j) { hs[4 * k4 + j] = hs[4 * k4 + j] * dA4[u] + x4[u] * bv[u][k4][j]; yp += cv[u][k4][j] * hs[4 * k4 + j]; }
                const auto sw = __builtin_amdgcn_permlane32_swap(__builtin_bit_cast(unsigned, yp), __builtin_bit_cast(unsigned, yp), false, false);
                yv[u] = yp + __builtin_bit_cast(float, (unsigned)sw[1]); }
            if (nh == 0) {
#pragma unroll
                for (int u = 0; u < 4; ++u) ypart[((s0 + u) * 8 + w) * 32 + pl] = yv[u]; }
        }
        if (blk + 1 < NBLK) SSD_COMMIT(nxtb);
        __syncthreads();
        {
            float y0 = 0.f, y1 = 0.f;
#pragma unroll
            for (int ww = 0; ww < 8; ++ww) { y0 += ypart[(os * 8 + ww) * 32 + op]; y1 += ypart[(os * 8 + ww) * 32 + op + 16]; }
            y0 += cur[TB * 32 + os * 32 + op] * dsk; y1 += cur[TB * 32 + os * 32 + op + 16] * dsk;
            y0 *= siluf_(bf2f(zraw)); y1 *= siluf_(bf2f(zraw2));
            bf16_t* yo = Y + tz * 1024 + 512 + h * 64 + 32 * ph + op;
            yo[0] = (bf16_t)(cvt_pk_bf16(y0, 0.f) & 0xffffu); yo[16] = (bf16_t)(cvt_pk_bf16(y1, 0.f) & 0xffffu);
            float q = y0 * y0 + y1 * y1;
#pragma unroll
            for (int o_ = 1; o_ < 16; o_ <<= 1) q += __shfl_xor(q, o_);
            if (op == 0) SSQ[tz * 8 + h * 2 + ph] = q;
        }
        __syncthreads();
    }
#undef SSD_LOAD
#undef SSD_COMMIT
}

__device__ __forceinline__ void sb_naive(const Ctx& C) {
    const bf16_t* proj = WSP(bf16_t, S_PROJ); bf16_t* Y = WSP(bf16_t, S_Y); const int lane = C.lane;
    for (int item = GW; item < T * 4; item += NGW) {
        const int t = item >> 2, h = item & 3, tq = t % SEQ; const size_t tb = (size_t)(t - tq);
        float q[64];
        { const bf16_t* qp = proj + (size_t)t * NPROJ + PC_SBQ + h * 64;
#pragma unroll
          for (int i = 0; i < 8; ++i) { const u32x4 w = *(const u32x4*)(qp + 8 * i); q[8*i] = bflo(w.x); q[8*i+1] = bfhi(w.x); q[8*i+2] = bflo(w.y); q[8*i+3] = bfhi(w.y); q[8*i+4] = bflo(w.z); q[8*i+5] = bfhi(w.z); q[8*i+6] = bflo(w.w); q[8*i+7] = bfhi(w.w); } }
        float o[64];
#pragma unroll
        for (int d = 0; d < 64; ++d) o[d] = 0.f;
        float R = 0.f;
        for (int c = (tq - 1) >> 6; c >= 0 && tq > 0; --c) {
            const int key = c * 64 + lane; const bool ok = key < tq;
            const bf16_t* kp = proj + (tb + key) * NPROJ + PC_SBK + h * 64; const bf16_t* vp = proj + (tb + key) * NPROJ + PC_SBV + h * 64;
            float z = 0.f;
#pragma unroll
            for (int i = 0; i < 8; ++i) { const u32x4 w = *(const u32x4*)(kp + 8 * i);
                z += q[8*i] * bflo(w.x) + q[8*i+1] * bfhi(w.x) + q[8*i+2] * bflo(w.y) + q[8*i+3] * bfhi(w.y) + q[8*i+4] * bflo(w.z) + q[8*i+5] * bfhi(w.z) + q[8*i+6] * bflo(w.w) + q[8*i+7] * bfhi(w.w); }
            const float L = ok ? -(fmaxf(z, 0.f) + flog2(1.0f + fexp2(-fabsf(z)))) : 0.f;
            float sfx = L;
#pragma unroll
            for (int dd = 1; dd < 64; dd <<= 1) { const float tt = __shfl_down(sfx, dd); if (lane + dd < 64) sfx += tt; }
            const float tot = __shfl(sfx, 0);
            const float wgt = ok ? fexp2(z + L + (sfx - L) + R) : 0.f;
            R += tot;
#pragma unroll
            for (int i = 0; i < 8; ++i) { const u32x4 w = *(const u32x4*)(vp + 8 * i);
                o[8*i] += wgt * bflo(w.x); o[8*i+1] += wgt * bfhi(w.x); o[8*i+2] += wgt * bflo(w.y); o[8*i+3] += wgt * bfhi(w.y); o[8*i+4] += wgt * bflo(w.z); o[8*i+5] += wgt * bfhi(w.z); o[8*i+6] += wgt * bflo(w.w); o[8*i+7] += wgt * bfhi(w.w); }
        }
        float mine = 0.f;
#pragma unroll
        for (int d = 0; d < 64; ++d) { const float sdd = wave_sum(o[d]); if (lane == d) mine = sdd; }
        Y[(size_t)t * 1024 + h * 64 + lane] = (bf16_t)(cvt_pk_bf16(mine, 0.f) & 0xffffu);
    }
}

__device__ __forceinline__ void rwkv_naive(const Ctx& C, int l) {
    const float* DEC = WSP(float, S_DEC); const bf16_t* RWS = WSP(bf16_t, S_RWS); const bf16_t* GV = WSP(bf16_t, S_GV); bf16_t* Y = WSP(bf16_t, S_Y);
    const size_t PL = (size_t)T * 256; const int lane = C.lane;
    for (int item = GW; item < 64; item += NGW) {
        const int b = item >> 2, h = item & 3; const float* rk = C.in[I_RWRK] + l * 256 + h * 64;
        const float gng = C.in[I_RWGNG][l * 256 + h * 64 + lane], gnb = C.in[I_RWGNB][l * 256 + h * 64 + lane];
        float S[64];
#pragma unroll
        for (int j = 0; j < 64; ++j) S[j] = 0.f;
        for (int tq = 0; tq < SEQ; ++tq) {
            const size_t o = ((size_t)b * SEQ + tq) * 256 + h * 64;
            const float v = bf2f(RWS[2 * PL + o + lane]);
            float sa = 0.f;
#pragma unroll
            for (int j = 0; j < 64; ++j) sa += S[j] * bf2f(RWS[3 * PL + o + j]);
            float y = 0.f, bd = 0.f;
#pragma unroll
            for (int j = 0; j < 64; ++j) { const float km = bf2f(RWS[PL + o + j]), r = bf2f(RWS[o + j]);
                S[j] = S[j] * DEC[o + j] + (v * km - sa * bf2f(RWS[4 * PL + o + j])); y += S[j] * r; bd += r * km * rk[j]; }
            const float mu = wave_sum(y) * (1.0f / 64.0f), d = y - mu, var = wave_sum(d * d) * (1.0f / 64.0f);
            const float res = (d * (1.0f / sqrtf(var + 64e-5f)) * gng + gnb + v * bd) * bf2f(GV[o + lane]);
            Y[((size_t)b * SEQ + tq) * 1024 + 256 + h * 64 + lane] = (bf16_t)(cvt_pk_bf16(res, 0.f) & 0xffffu);
        }
    }
}
__device__ __forceinline__ void ssd_naive(const Ctx& C, int l) {
    const bf16_t* proj = WSP(bf16_t, S_PROJ); bf16_t* Y = WSP(bf16_t, S_Y); float* SSQ = WSP(float, S_SSQ); const int lane = C.lane;
    const float* cw = C.in[I_CONVW] + l * 4 * 768; const float* cb = C.in[I_CONVB] + l * 768;
    for (int item2 = GW; item2 < 128; item2 += NGW) {
        const int item = item2 >> 1, ph = item2 & 1; const int b = item >> 2, h = item & 3, g = h >> 1; const size_t tb = (size_t)b * SEQ;
        const float dtb = C.in[I_DTB][l * 4 + h], aneg = -expf(C.in[I_ALOG][l * 4 + h]), dsk = C.in[I_SSDD][l * 4 + h];
        float hs0[32], hs1[32];
#pragma unroll
        for (int p = 0; p < 32; ++p) { hs0[p] = 0.f; hs1[p] = 0.f; }
        for (int tq = 0; tq < SEQ; ++tq) {
            const bf16_t* pr = proj + (tb + tq) * NPROJ;
            float xa = cb[h * 64 + lane], bv0 = cb[256 + g * 128 + lane], bv1 = cb[256 + g * 128 + 64 + lane], cv0 = cb[512 + g * 128 + lane], cv1 = cb[512 + g * 128 + 64 + lane];
            for (int k = 0; k < 4; ++k) { const int tt = tq - 3 + k; if (tt >= 0) { const bf16_t* pp = proj + (tb + tt) * NPROJ; const float* ww = cw + k * 768;
                xa += bf2f(pp[PC_XS + h * 64 + lane]) * ww[h * 64 + lane];
                bv0 += bf2f(pp[PC_BM + g * 128 + lane]) * ww[256 + g * 128 + lane]; bv1 += bf2f(pp[PC_BM + g * 128 + 64 + lane]) * ww[256 + g * 128 + 64 + lane];
                cv0 += bf2f(pp[PC_CM + g * 128 + lane]) * ww[512 + g * 128 + lane]; cv1 += bf2f(pp[PC_CM + g * 128 + 64 + lane]) * ww[512 + g * 128 + 64 + lane]; } }
            xa = siluf_(xa); bv0 = siluf_(bv0); bv1 = siluf_(bv1); cv0 = siluf_(cv0); cv1 = siluf_(cv1);
            const float dt = softplusf_(bf2f(pr[PC_DT + h]) + dtb), dA = expf(dt * aneg), xd = xa * dt;
            float y = 0.f;
#pragma unroll
            for (int p = 0; p < 32; ++p) { const float xp = __shfl(xd, 32 * ph + p); hs0[p] = hs0[p] * dA + xp * bv0; hs1[p] = hs1[p] * dA + xp * bv1;
                const float tot = wave_sum(cv0 * hs0[p] + cv1 * hs1[p]); if (lane == 32 * ph + p) y = tot; }
            y += dsk * xa; y *= siluf_(bf2f(pr[PC_Z + h * 64 + lane]));
            const bool mine = (lane >> 5) == ph; if (mine) Y[(tb + tq) * 1024 + 512 + h * 64 + lane] = (bf16_t)(cvt_pk_bf16(y, 0.f) & 0xffffu);
            const float q = wave_sum(mine ? y * y : 0.f); if (lane == 0) atomicAdd(&SSQ[(tb + tq) * 8 + h * 2], q);
        }
    }
}

__device__ __forceinline__ void mla_naive(const Ctx& C) {
    const bf16_t* QM = WSP(bf16_t, S_QM); const bf16_t* KM = WSP(bf16_t, S_KM); const bf16_t* VM = WSP(bf16_t, S_VM); bf16_t* Y = WSP(bf16_t, S_Y); const int lane = C.lane;
    for (int item = GW; item < T * 4; item += NGW) {
        const int t = item >> 2, h = item & 3, tq = t % SEQ; const size_t tb = (size_t)(t - tq);
        float q[96];
        { const bf16_t* qp = QM + (size_t)t * 384 + h * 96;
#pragma unroll
          for (int i = 0; i < 12; ++i) { const u32x4 w = *(const u32x4*)(qp + 8 * i); q[8*i] = bflo(w.x); q[8*i+1] = bfhi(w.x); q[8*i+2] = bflo(w.y); q[8*i+3] = bfhi(w.y); q[8*i+4] = bflo(w.z); q[8*i+5] = bfhi(w.z); q[8*i+6] = bflo(w.w); q[8*i+7] = bfhi(w.w); } }
        float o[64];
#pragma unroll
        for (int d = 0; d < 64; ++d) o[d] = 0.f;
        float m = -1.0e30f, lsum = 0.f;
        for (int c = tq >> 6; c >= 0; --c) {
            const int key = c * 64 + lane; const bool ok = key <= tq;
            const bf16_t* kp = KM + (tb + (ok ? key : 0)) * 384 + h * 96; const bf16_t* vp = VM + (tb + (ok ? key : 0)) * 256 + h * 64;
            float z = 0.f;
#pragma unroll
            for (int i = 0; i < 12; ++i) { const u32x4 w = *(const u32x4*)(kp + 8 * i);
                z += q[8*i] * bflo(w.x) + q[8*i+1] * bfhi(w.x) + q[8*i+2] * bflo(w.y) + q[8*i+3] * bfhi(w.y) + q[8*i+4] * bflo(w.z) + q[8*i+5] * bfhi(w.z) + q[8*i+6] * bflo(w.w) + q[8*i+7] * bfhi(w.w); }
            z = ok ? z : -1.0e30f;
            float cm = z;
#pragma unroll
            for (int dd = 1; dd < 64; dd <<= 1) cm = fmaxf(cm, __shfl_xor(cm, dd));
            const float mn = fmaxf(m, cm), al = fexp2(m - mn), pw = ok ? fexp2(z - mn) : 0.f; m = mn; lsum = lsum * al + pw;
#pragma unroll
            for (int i = 0; i < 8; ++i) { const u32x4 w = *(const u32x4*)(vp + 8 * i);
                o[8*i] = o[8*i] * al + pw * bflo(w.x); o[8*i+1] = o[8*i+1] * al + pw * bfhi(w.x); o[8*i+2] = o[8*i+2] * al + pw * bflo(w.y); o[8*i+3] = o[8*i+3] * al + pw * bfhi(w.y);
                o[8*i+4] = o[8*i+4] * al + pw * bflo(w.z); o[8*i+5] = o[8*i+5] * al + pw * bfhi(w.z); o[8*i+6] = o[8*i+6] * al + pw * bflo(w.w); o[8*i+7] = o[8*i+7] * al + pw * bfhi(w.w); }
        }
        const float lt = wave_sum(lsum); float mine = 0.f;
#pragma unroll
        for (int d = 0; d < 64; ++d) { const float sdd = wave_sum(o[d]); if (lane == d) mine = sdd; }
        Y[(size_t)t * 1024 + 768 + h * 64 + lane] = (bf16_t)(cvt_pk_bf16(mine / lt, 0.f) & 0xffffu);
    }
}
__device__ __forceinline__ void xattn_naive(const Ctx& C, int l) {
    const bf16_t* XQ = WSP(bf16_t, S_XQ); const bf16_t* KMEM = WSP(bf16_t, W_KMEM) + (size_t)l * NMEM * 1024; const bf16_t* VT = WSP(bf16_t, W_VMEMT) + (size_t)l * 1024 * NMEM; bf16_t* XO = WSP(bf16_t, S_XO); const int lane = C.lane;
    for (int item = GW; item < T * 4; item += NGW) {
        const int t = item >> 2, h = item & 3, b = t / SEQ;
        float z[4] = {0.f, 0.f, 0.f, 0.f};
        for (int d8 = 0; d8 < 32; ++d8) { const u32x4 qw = *(const u32x4*)(XQ + (size_t)t * 1024 + h * 256 + 8 * d8);
            const float qv[8] = {bflo(qw.x), bfhi(qw.x), bflo(qw.y), bfhi(qw.y), bflo(qw.z), bfhi(qw.z), bflo(qw.w), bfhi(qw.w)};
#pragma unroll
            for (int j = 0; j < 4; ++j) { const u32x4 kw = *(const u32x4*)(KMEM + (size_t)(b * 256 + lane + 64 * j) * 1024 + h * 256 + 8 * d8);
                z[j] += qv[0] * bflo(kw.x) + qv[1] * bfhi(kw.x) + qv[2] * bflo(kw.y) + qv[3] * bfhi(kw.y) + qv[4] * bflo(kw.z) + qv[5] * bfhi(kw.z) + qv[6] * bflo(kw.w) + qv[7] * bfhi(kw.w); } }
        float mx = fmaxf(fmaxf(z[0], z[1]), fmaxf(z[2], z[3]));
#pragma unroll
        for (int dd = 1; dd < 64; dd <<= 1) mx = fmaxf(mx, __shfl_xor(mx, dd));
        float p[4], ps = 0.f;
#pragma unroll
        for (int j = 0; j < 4; ++j) { p[j] = fexp2(z[j] - mx); ps += p[j]; }
        const float inv = 1.0f / wave_sum(ps);
        float o[4] = {0.f, 0.f, 0.f, 0.f};
        for (int mm = 0; mm < 256; ++mm) { const float pm = __shfl(p[mm >> 6], mm & 63);
#pragma unroll
            for (int jd = 0; jd < 4; ++jd) o[jd] += pm * bf2f(VT[(size_t)(h * 256 + lane + 64 * jd) * NMEM + b * 256 + mm]); }
#pragma unroll
        for (int jd = 0; jd < 4; ++jd) XO[(size_t)t * 1024 + h * 256 + lane + 64 * jd] = (bf16_t)(cvt_pk_bf16(o[jd] * inv, 0.f) & 0xffffu);
    }
}
__device__ __forceinline__ void ph_mixers(const Ctx& C, int l, int rep = 0) {
    unsigned* head = (unsigned*)(C.ws + WS_CTL) + CW_QUEUE + 64 * (l + 2 * rep);
    volatile LAS unsigned* slot = (volatile LAS unsigned*)(C.lds + LDSCTL_OFF + 64);
#ifdef TIME_VAR
    const unsigned var = __builtin_amdgcn_readfirstlane(__hip_atomic_load((const unsigned*)(C.ws + WS_CTL) + 200000, RLX_AGENT)) & 0xffu;
#else
    const unsigned var = 0u;
#endif
    constexpr int N_RW = 128, N_ATT = 768, NITEMS = N_RW + N_ATT;
    for (;;) {
        __syncthreads();
        if (C.tid == 0) slot[0] = __hip_atomic_fetch_add(head, 1u, RLX_AGENT);
        __syncthreads();
        const int it = (int)slot[0];
        if (it >= NITEMS) break;
#ifndef NAIVE_SCAN
#define NAIVE_SCAN 0
#endif
        if (it < N_RW) { if (!(NAIVE_SCAN & 1) && !(var & 1u)) { rwkv_unit(C, l, it >> 3, (it >> 1) & 3, it & 1);
#ifdef TIME_RW2
            __syncthreads(); rwkv_unit(C, l, it >> 3, (it >> 1) & 3, it & 1);
#endif
        } }
        else { const int k = it - N_RW; const int mode = k >> 8, kk_ = k & 255, pp = kk_ & 3, bh = kk_ >> 2, b = bh >> 2, h = bh & 3;
            if (mode == 0) { if (!(NAIVE_SCAN & 2) && !(var & 2u)) { attn_unit<2>(C, l, b, h, 7 - pp, var); __syncthreads(); attn_unit<2>(C, l, b, h, pp, var);
#ifdef TIME_SSDA2
                __syncthreads(); attn_unit<2>(C, l, b, h, 7 - pp); __syncthreads(); attn_unit<2>(C, l, b, h, pp);
#endif
            } }
#ifndef NAIVE_SB
            else if (mode == 2) { if (!(var & 8u)) { attn_unit<0>(C, l, b, h, 7 - pp, var); __syncthreads(); attn_unit<0>(C, l, b, h, pp, var); }
#ifdef TIME_SB2
                __syncthreads(); attn_unit<0>(C, l, b, h, 7 - pp); __syncthreads(); attn_unit<0>(C, l, b, h, pp);
#endif
            }
#else
            else if (mode == 2) { }
#endif
#ifndef NAIVE_MLA
            else { if (!(var & 4u)) { attn_unit<1>(C, l, b, h, 7 - pp, var); __syncthreads(); attn_unit<1>(C, l, b, h, pp, var); }
#ifdef TIME_MLA2
                __syncthreads(); attn_unit<1>(C, l, b, h, 7 - pp); __syncthreads(); attn_unit<1>(C, l, b, h, pp);
#endif
            }
#else
            else { }
#endif
        }
    }
#ifdef NAIVE_SB
    sb_naive(C);
#endif
#ifdef NAIVE_MLA
    mla_naive(C);
#endif
    if (NAIVE_SCAN & 1) rwkv_naive(C, l);
    if (NAIVE_SCAN & 2) ssd_naive(C, l);
}
__device__ __forceinline__ void ph_router(const Ctx& C, const bf16_t* src16, bf16_t* dstb, const float* g, const float* b) {
#ifdef TIME_VAR
    const unsigned var = __builtin_amdgcn_readfirstlane(__hip_atomic_load((const unsigned*)(C.ws + WS_CTL) + 200000, RLX_AGENT)) & 0xffu;
#else
    const unsigned var = 0u;
#endif
    if (!(var & 1u)) run_tjobs<16, true>(C, var);
    __syncthreads();
    LAS unsigned* lc = (LAS unsigned*)(C.lds + XCH_OFF);
    if (C.tid < 8) lc[C.tid] = 0u;
    __syncthreads();
    const float* rt = C.in[I_ROUTER]; int* topi = WSP(int, S_TOPI); float* topw = WSP(float, S_TOPW); const int lane = C.lane;
    f32x4 gv[4], bv[4];
#pragma unroll
    for (int j = 0; j < 4; ++j) { gv[j] = *(const f32x4*)(g + 4 * lane + 256 * j); bv[j] = *(const f32x4*)(b + 4 * lane + 256 * j); }
    u32x2 nx[4];
#define RT_LOAD(kk_) do { const int t_ = C.bid * 128 + C.wave * 16 + (kk_); _Pragma("unroll") for (int j = 0; j < 4; ++j) nx[j] = *(const u32x2*)(src16 + (size_t)t_ * 1024 + 4 * lane + 256 * j); } while (0)
    RT_LOAD(0);
    f32x4 rw0[16], rw1[16];
#pragma unroll
    for (int jq = 0; jq < 16; ++jq) { const float* rp = rt + (size_t)(4 * lane + 256 * (jq >> 2) + (jq & 3)) * 8; rw0[jq] = *(const f32x4*)rp; rw1[jq] = *(const f32x4*)(rp + 4); }
    for (int k = 0; k < ((var & 2u) ? 0 : 16); ++k) {
        const int t = C.bid * 128 + C.wave * 16 + k; float a[8]; f32x4 xv4[4]; float s = 0.f;
#pragma unroll
        for (int j = 0; j < 4; ++j) { xv4[j] = (f32x4){bflo(nx[j].x), bfhi(nx[j].x), bflo(nx[j].y), bfhi(nx[j].y)}; s += (xv4[j][0] + xv4[j][1]) + (xv4[j][2] + xv4[j][3]); }
        if (k + 1 < 16) RT_LOAD(k + 1);
        const float mean = wave_sum(s) * (1.0f / 1024.0f); float s2 = 0.f;
#pragma unroll
        for (int j = 0; j < 4; ++j) { xv4[j] = xv4[j] - mean; s2 += (xv4[j][0] * xv4[j][0] + xv4[j][1] * xv4[j][1]) + (xv4[j][2] * xv4[j][2] + xv4[j][3] * xv4[j][3]); }
        const float rstd = 1.0f / sqrtf(wave_sum(s2) * (1.0f / 1024.0f) + 1e-5f);
#pragma unroll
        for (int j = 0; j < 4; ++j) { xv4[j] = xv4[j] * rstd * gv[j] + bv[j]; st_bf4(dstb + (size_t)t * 1024 + 4 * lane + 256 * j, xv4[j]); }
#pragma unroll
        for (int e = 0; e < 8; ++e) a[e] = 0.f;
#pragma unroll
        for (int jq = 0; jq < 16; ++jq) { const float xq = xv4[jq >> 2][jq & 3]; const f32x4 r0 = rw0[jq], r1 = rw1[jq];
            a[0] += xq * r0[0]; a[1] += xq * r0[1]; a[2] += xq * r0[2]; a[3] += xq * r0[3]; a[4] += xq * r1[0]; a[5] += xq * r1[1]; a[6] += xq * r1[2]; a[7] += xq * r1[3]; }
#pragma unroll
        for (int e = 0; e < 8; ++e) a[e] = wave_sum(a[e]);
#ifdef ROUTER_NOISE
        for (int e = 0; e < 8; ++e) { unsigned hsh = (unsigned)t * 2654435761u + (unsigned)e * 40503u; hsh ^= hsh >> 13; hsh *= 0x5bd1e995u; hsh ^= hsh >> 15; a[e] += ROUTER_NOISE * ((float)(hsh & 0xffff) * (1.0f / 32768.0f) - 1.0f); }
#endif
        if (lane == 0) {
            int i1 = 0; float v1 = a[0];
#pragma unroll
            for (int e = 1; e < 8; ++e) if (a[e] > v1) { v1 = a[e]; i1 = e; }
            int i2 = -1; float v2 = -3.0e38f;
#pragma unroll
            for (int e = 0; e < 8; ++e) if (e != i1 && a[e] > v2) { v2 = a[e]; i2 = e; }
            const float g1 = 1.0f / (1.0f + expf(v2 - v1));
            topi[2 * t] = i1; topi[2 * t + 1] = i2; topw[2 * t] = g1; topw[2 * t + 1] = 1.0f - g1;
            __hip_atomic_fetch_add(&lc[i1], 1u, __ATOMIC_RELAXED, __HIP_MEMORY_SCOPE_WORKGROUP); __hip_atomic_fetch_add(&lc[i2], 1u, __ATOMIC_RELAXED, __HIP_MEMORY_SCOPE_WORKGROUP);
        }
    }
    __syncthreads();
    if (C.tid < 8) ((unsigned*)(C.ws + WS_CTL))[CW_MOECNT + C.bid * 8 + C.tid] = lc[C.tid];
}
__device__ __forceinline__ void ph_scatter(const Ctx& C) {
    LAS int* sh = (LAS int*)(C.lds + XCH_OFF);
    const unsigned* cnt = (const unsigned*)(C.ws + WS_CTL) + CW_MOECNT;
    int* row_slot = WSP(int, S_ROWSLOT); float* row_w = WSP(float, S_ROWW); int* blk_e = WSP(int, S_BLKE);
    const int* topi = WSP(int, S_TOPI); const float* topw = WSP(float, S_TOPW);
    const int tid = C.tid;
    if (tid < 48) sh[tid] = 0;
    __syncthreads();
    { const int wg = tid & 255, e0 = (tid >> 8) * 4; const u32x4 c4 = *(const u32x4*)(cnt + wg * 8 + e0);
      const unsigned cv[4] = {c4.x, c4.y, c4.z, c4.w};
#pragma unroll
      for (int j = 0; j < 4; ++j) { __hip_atomic_fetch_add(&sh[e0 + j], (int)cv[j], __ATOMIC_RELAXED, __HIP_MEMORY_SCOPE_WORKGROUP); if (wg < C.bid) __hip_atomic_fetch_add(&sh[8 + e0 + j], (int)cv[j], __ATOMIC_RELAXED, __HIP_MEMORY_SCOPE_WORKGROUP); } }
    __syncthreads();
    if (tid == 0) { int ps = 0; for (int e = 0; e < 8; ++e) { sh[16 + e] = ps; const int pad = (sh[e] + 255) / 256 * 256; sh[24 + e] = pad; ps += pad; } sh[40] = ps / 256; }
    __syncthreads();
    if (C.bid == 0) {
        const int used = sh[40];
        for (int rb = tid; rb < MOE_BLOCKS; rb += NTHREADS) { int e = 7; if (rb < used) { e = 0; for (int q = 1; q < 8; ++q) if (sh[16 + q] <= rb * 256) e = q; } blk_e[rb] = e; }
        if (tid == 0) blk_e[MOE_BLOCKS] = used;
    }
    if (C.bid < 8) { const int e = C.bid; for (int r = sh[16 + e] + sh[e] + tid; r < sh[16 + e] + sh[24 + e]; r += NTHREADS) { row_slot[r] = -1; row_w[r] = 0.f; } }
    if (tid < 256) { const int t = C.bid * 128 + (tid >> 1), k = tid & 1, e = topi[2 * t + k];
        const int pos = __hip_atomic_fetch_add(&sh[32 + e], 1, __ATOMIC_RELAXED, __HIP_MEMORY_SCOPE_WORKGROUP); const int dest = sh[16 + e] + sh[8 + e] + pos; row_slot[dest] = 2 * t + k; row_w[dest] = topw[2 * t + k]; sh[64 + tid] = dest; }
    __syncthreads();
    const bf16_t* xb = WSP(bf16_t, W_XB); bf16_t* xs = WSP(bf16_t, S_XS);
    { u32x4 va[2][2]; const int a0 = C.wave * 32;
#define SC_LOAD(buf, a_) do { _Pragma("unroll") for (int u = 0; u < 2; ++u) { const int t_ = C.bid * 128 + (((a_) + u) >> 1); _Pragma("unroll") for (int j = 0; j < 2; ++j) buf[u][j] = *(const u32x4*)(xb + (size_t)t_ * 1024 + (C.lane + 64 * j) * 8); } } while (0)
#define SC_STORE(buf, a_) do { _Pragma("unroll") for (int u = 0; u < 2; ++u) { const size_t d_ = (size_t)sh[64 + (a_) + u] * 1024; _Pragma("unroll") for (int j = 0; j < 2; ++j) *(u32x4*)(xs + d_ + (C.lane + 64 * j) * 8) = buf[u][j]; } } while (0)
      u32x4 vb[2][2];
      SC_LOAD(va, a0);
      for (int a = a0; a < a0 + 32; a += 4) { SC_LOAD(vb, a + 2); SC_STORE(va, a); if (a + 4 < a0 + 32) SC_LOAD(va, a + 4); SC_STORE(vb, a + 2); }
#undef SC_LOAD
#undef SC_STORE
    }
}


__device__ __forceinline__ void chk_moe(const Ctx& C, int bit) {
    const float* xr = WSP(float, W_XRES); const float* rt = C.in[I_ROUTER]; const float* w13 = C.in[I_MOE13]; const float* w2 = C.in[I_MOE2]; const bf16_t* ys = WSP(bf16_t, S_YS);
    LAS float* hb = (LAS float*)(C.lds + C.wave * 14336); const int lane = C.lane; unsigned bad = 0;
    float* stash = WSP(float, W_KMEM); const float* g3 = C.in[I_LN3G] + 1024; const float* b3 = C.in[I_LN3B] + 1024;
    for (int s = GW; s < 1024; s += NGW) {
        const int t = (int)(((long)s * 1021 + 7) % T); float x[16];
#pragma unroll
        for (int j = 0; j < 16; ++j) x[j] = xr[(size_t)t * 1024 + lane + 64 * j];
        float lg[8];
#pragma unroll
        for (int e = 0; e < 8; ++e) { float a = 0.f;
#pragma unroll
            for (int j = 0; j < 16; ++j) a += x[j] * rt[(size_t)(lane + 64 * j) * 8 + e]; lg[e] = wave_sum(a); }
        int i1 = 0; for (int e = 1; e < 8; ++e) if (lg[e] > lg[i1]) i1 = e;
        int i2 = -1; for (int e = 0; e < 8; ++e) if (e != i1 && (i2 < 0 || lg[e] > lg[i2])) i2 = e;
        float v3 = -3.0e38f; for (int e = 0; e < 8; ++e) if (e != i1 && e != i2) v3 = fmaxf(v3, lg[e]);
        if (lg[i2] - v3 < 0.02f) { if (lane == 0) stash[(size_t)s * 1024] = 1.0e30f; continue; }
        const float g1 = 1.0f / (1.0f + expf(lg[i2] - lg[i1]));
        float out[16];
#pragma unroll
        for (int j = 0; j < 16; ++j) out[j] = 0.f;
        for (int q = 0; q < 2; ++q) { const int e = q ? i2 : i1; const float gw = q ? 1.0f - g1 : g1; const float* W1 = w13 + (size_t)e * 1024 * 2 * FFE;
            for (int i0 = 0; i0 < 56; i0 += 4) { float ag[4], au[4];
#pragma unroll
                for (int i = 0; i < 4; ++i) { ag[i] = 0.f; au[i] = 0.f; }
                for (int k = 0; k < 1024; ++k) { const float xk = __shfl(x[k >> 6], k & 63); const float* wr = W1 + (size_t)k * 2 * FFE + lane + 64 * i0;
#pragma unroll
                    for (int i = 0; i < 4; ++i) { ag[i] += xk * wr[64 * i]; au[i] += xk * wr[FFE + 64 * i]; } }
#pragma unroll
                for (int i = 0; i < 4; ++i) hb[lane + 64 * (i0 + i)] = (ag[i] / (1.0f + expf(-ag[i]))) * au[i]; }
            LDS_WAIT();
            const float* W2 = w2 + (size_t)e * FFE * 1024;
            for (int hh = 0; hh < FFE; ++hh) { const float hv = hb[hh] * gw;
#pragma unroll
                for (int j = 0; j < 16; ++j) out[j] += hv * W2[(size_t)hh * 1024 + lane + 64 * j]; }
            LDS_WAIT(); }
#pragma unroll
        for (int j = 0; j < 16; ++j) { const int c = lane + 64 * j; const float got = bf2f(ys[(size_t)(2 * t) * 1024 + c]) + bf2f(ys[(size_t)(2 * t + 1) * 1024 + c]);
            if (fabsf(got - out[j]) > 0.05f * fabsf(out[j]) + 0.03f) bad = 1; }
        { float v[16], sm = 0.f, s2 = 0.f;
#pragma unroll
          for (int j = 0; j < 16; ++j) { v[j] = x[j] * DN_ALPHA + out[j]; sm += v[j]; }
          const float mean = wave_sum(sm) * (1.0f / 1024.0f);
#pragma unroll
          for (int j = 0; j < 16; ++j) { v[j] -= mean; s2 += v[j] * v[j]; }
          const float rstd = 1.0f / sqrtf(wave_sum(s2) * (1.0f / 1024.0f) + 1e-5f);
          int zz = 0; asm volatile("" : "+v"(zz));
#pragma unroll
          for (int j = 0; j < 16; ++j) { const int c = lane + 64 * j + zz; stash[(size_t)s * 1024 + c] = v[j] * rstd * g3[c] + b3[c]; } }
    }
    chk_flag(C, bit, bad);
}
#ifndef ABL_MIX
#define ABL_MIX 1.0f
#endif
#ifndef ABL_XA
#define ABL_XA 1.0f
#endif
#ifndef ABL_FF
#define ABL_FF 1.0f
#endif
#ifndef CHK_TOL2
#define CHK_TOL2 0.05f
#endif
#ifndef GATE_ACT
#define GATE_ACT 1
#endif
#ifndef GATE_ALIGN
#define GATE_ALIGN true
#endif
#ifndef FG_TOL
#define FG_TOL 0.05f
#endif
#ifndef FG_BIT
#define FG_BIT 1
#endif
#ifndef CHECKS_LAYER
#define CHECKS_LAYER 0
#endif
#ifndef MK_SPLIT
#define MK_SPLIT 0
#endif
constexpr int PH_L0 = 1, PH_L1 = 16, PH_MOE = 28, PH_TOTAL = PH_MOE + 1 + 2 * MOE_PASSES + 1;

__global__ void __launch_bounds__(NTHREADS, 2) hybrid_fwd(Args args) {
    extern __shared__ __attribute__((aligned(16))) unsigned char lds_raw[];
    Ctx C; C.in = args.in; C.out = args.out; C.ws = args.ws; C.lds = (LAS unsigned char*)lds_raw;
    C.tid = threadIdx.x; C.lane = C.tid & 63; C.wave = __builtin_amdgcn_readfirstlane(C.tid >> 6); C.G = gridDim.x; C.bid = blockIdx.x;
    const Ctx C0 = C;
    for (int u = C.tid; u < (LDS_BYTES - LDSCTL_OFF) / 4; u += NTHREADS) ((LAS unsigned*)(C.lds + LDSCTL_OFF))[u] = 0u;
    __syncthreads();
    const int lo = args.ph_lo, hi = args.ph_hi;
    XcdBarrier bar; bar.bar = (unsigned*)(C.ws + WS_CTL) + CW_BAR; bar.x = 0; bar.st = (volatile LAS unsigned*)(C.lds + LDSCTL_OFF);
    if (hi - lo > 1) bar = xcd_barrier_post((unsigned*)(C.ws + WS_CTL) + CW_BAR, (volatile LAS unsigned*)(C.lds + LDSCTL_OFF));
#ifndef SITE_MASK
#define SITE_MASK 0xffffffffu
#endif
#define SITE(n) (((SITE_MASK) >> (n)) & 1u)
#define IN(k) (lo <= (k) && (k) < hi)
#define ENDPH(k) do { if ((k) + 1 < hi) xcd_barrier(bar); } while (0)
#define SITE_BEGIN const Ctx C = launder(C0); unsigned char* LW = C.ws + W_BASE + (size_t)l * LW_SIZE; const bf16_t* XB = WSP(bf16_t, W_XB); bf16_t* XRES = WSP(bf16_t, W_XRES); (void)LW; (void)XB; (void)XRES; LAS unsigned char* ring = C.lds; (void)ring;

    if (SITE(0) && IN(0)) { const int l = 0; SITE_BEGIN ph_prologue(C);
#ifdef TIME_PRO2
        xcd_barrier(bar); ph_prologue(C);
#endif
#ifdef TIME_BAR
        for (int q_ = 0; q_ < TIME_BAR; ++q_) xcd_barrier(bar);
#endif
        ENDPH(0); }

    for (int l = 0; l < 2; ++l) {
        const int pb = l == 0 ? PH_L0 : PH_L1;
        if (SITE(1) && IN(pb + 0)) { SITE_BEGIN
#ifdef CHECKS3
            if (l == 1) chk_ln_cmp(C, 1, 1);
#endif
            { pg8::Gemm g{XB, (const bf16_t*)(LW + LW_WIN), 1024, 1024, 1024}; sch::Tiles S{T / 256, NPROJ / 256, C.G, C.bid}; epi::StoreBf16<0> E{WSP(bf16_t, S_PROJ), NPROJ}; pg8::gemm_phase(ring, g, S, E); }
            { pg8::Gemm g{(const bf16_t*)C.ws, (const bf16_t*)C.ws, 1024, 1024, 1024}; sch::MemKV S{(long)(W_MEMB / 2), (long)((W_BASE + (size_t)l * LW_SIZE + LW_WKV) / 2), C.bid};
              epi::StoreBf16<0> E{WSP(bf16_t, W_KMEM) + (size_t)l * NMEM * 2048, 2048}; pg8::gemm_phase(ring, g, S, E); }
            ENDPH(pb + 0);
        }
        if (SITE(2) && IN(pb + 1)) { SITE_BEGIN
#ifdef CHECKS5
            if (l == 0) chk_weights<28, false>(C, 0);
#endif
#ifdef CHECKS9
            if (l == 0) { unsigned bad = 0; const float* x = C.in[I_X]; const float* mm = C.in[I_MEM]; const bf16_t* mb = WSP(bf16_t, W_MEMB);
                for (size_t i = (size_t)C.bid * NTHREADS + C.tid; i < (size_t)T * 1024; i += (size_t)C.G * NTHREADS) if (!chk_close(x[i], bf2f(XB[i]))) bad = 1;
                for (size_t i = (size_t)C.bid * NTHREADS + C.tid; i < (size_t)NMEM * 1024; i += (size_t)C.G * NTHREADS) if (!chk_close(mm[i], bf2f(mb[i]))) bad = 1;
                if (bad) __hip_atomic_fetch_add((unsigned*)(C.ws + WS_CTL) + CW_CHK, 1u, RLX_AGENT); }
#endif
#ifdef CHECKS12P
            if (l == CHECKS_LAYER) { const bf16_t* proj = WSP(bf16_t, S_PROJ); chk_full_gemm(C, XB, (const bf16_t*)(LW + LW_WIN), 1024, 3236, 0, [&](size_t r, int c, float d) { return chk_close(d, bf2f(proj[r * NPROJ + c])); }); xcd_barrier(bar); }
#endif
#ifdef CHECKS4
            if (l == CHECKS_LAYER) { const bf16_t* KM_ = WSP(bf16_t, W_KMEM) + (size_t)l * NMEM * 1024; const bf16_t* VT_ = WSP(bf16_t, W_VMEMT) + (size_t)l * 1024 * NMEM;
                chk_gemm(C, WSP(bf16_t, W_MEMB), 1024, (const bf16_t*)(LW + LW_WKV), 1024, 1024, NMEM, 64, 16, 3, 0, [&](int r, int c, float d) { return chk_close(d, bf2f(KM_[(size_t)r * 1024 + c])); });
                chk_gemm(C, (const bf16_t*)(LW + LW_WKV) + (size_t)1024 * 1024, 1024, WSP(bf16_t, W_MEMB), 1024, 1024, 1024, 256, 16, 5, 1, [&](int r, int c, float d) { return chk_close(d, bf2f(VT_[(size_t)r * NMEM + c])); }); }
#endif
#ifdef CHECKS
            if (l == CHECKS_LAYER) { const bf16_t* proj = WSP(bf16_t, S_PROJ); chk_gemm(C, XB, 1024, (const bf16_t*)(LW + LW_WIN), 1024, 1024, T, 13, 256, 7, 0, [&](int r, int c, float d) { return chk_close(d, bf2f(proj[(size_t)r * NPROJ + c])); }); }
#endif
            ph_prep(C, l);
#ifdef TIME_PREP2
            xcd_barrier(bar); ph_prep(C, l);
#endif
            ENDPH(pb + 1); }
        if (SITE(3) && IN(pb + 2)) { SITE_BEGIN
            { pg8::Gemm g{WSP(bf16_t, S_LA), (const bf16_t*)(LW + LW_LORA), 256, 256, 256}; sch::Tiles S{T / 256, 3, C.G, C.bid}; epi::Lora E{WSP(float, S_DEC), WSP(bf16_t, S_AV), WSP(bf16_t, S_GV), C.in[I_RWW0] + l * 256, C.in[I_RWA0] + l * 256}; pg8::gemm_phase(ring, g, S, E); }
            { pg8::Gemm g{WSP(bf16_t, S_CQN), (const bf16_t*)(LW + LW_WUQ), 256, 256, 256}; sch::Tiles S{T / 256, 2, C.G, (C.bid + 128) & 255}; epi::Uq E{WSP(bf16_t, S_QM), WSP(float, W_COS), WSP(float, W_SIN)}; pg8::gemm_phase(ring, g, S, E); }
            { pg8::Gemm g{WSP(bf16_t, S_CKVN), (const bf16_t*)(LW + LW_WUKV), 128, 128, 128}; sch::Tiles S{T / 256, 2, C.G, C.bid}; epi::Ukv E{WSP(bf16_t, S_KM), WSP(bf16_t, S_VM)}; pg8::gemm_phase(ring, g, S, E); }
            ENDPH(pb + 2);
        }
        if (SITE(4) && IN(pb + 3)) { SITE_BEGIN ph_rwprep(C, l); ph_ssdprep(C, l);
#ifdef TIME_RWP2
            xcd_barrier(bar); ph_rwprep(C, l); ph_ssdprep(C, l);
#endif
            ENDPH(pb + 3); }
        if (SITE(5) && IN(pb + 4)) { SITE_BEGIN
#ifdef CHECKS6
            if (l == CHECKS_LAYER) chk_mla_inputs(C, l, 0);
#endif
#ifdef CHECKS7
            if (l == CHECKS_LAYER) chk_rw_inputs(C, l, 0);
#endif
            ph_mixers(C, l);
#ifdef TIME_MIX2
            xcd_barrier(bar); ph_mixers(C, l, 1);
#endif
            ENDPH(pb + 4); }
        if (SITE(6) && IN(pb + 5)) { SITE_BEGIN
            ph_ssdfix(C, l);
            { pg8::Gemm g{XB, (const bf16_t*)(LW + LW_WGATE), 1024, 1024, 1024}; sch::Tiles S{T / 256, 16, C.G, C.bid}; epi::StoreBf16<GATE_ACT> E{WSP(bf16_t, S_G), 4096}; pg8::gemm_phase<epi::StoreBf16<GATE_ACT>, sch::Tiles, GATE_ALIGN>(ring, g, S, E);
#ifdef TIME_GATE2
              xcd_barrier(bar); pg8::gemm_phase<epi::StoreBf16<GATE_ACT>, sch::Tiles, GATE_ALIGN>(ring, g, S, E);
#endif
            }
#ifdef CHECKS14
            if (l == 0) { xcd_barrier(bar); const bf16_t* Gp = WSP(bf16_t, S_G); chk_full_gemm(C, XB, (const bf16_t*)(LW + LW_WGATE), 1024, 4096, 0, [&](size_t r, int c, float d) { return chk_close(sigmoidf_(d), bf2f(Gp[r * 4096 + c])); }); }
#endif
#ifdef CHECKS13
            if (l == 0) { xcd_barrier(bar);
              { pg8::Gemm g{XB, (const bf16_t*)(LW + LW_WGATE), 1024, 1024, 1024}; sch::Tiles S{T / 256, 16, C.G, C.bid}; epi::StoreBf16<1> E{WSP(bf16_t, S_G) + (size_t)T * 4096, 4096}; pg8::gemm_phase(ring, g, S, E); }
              xcd_barrier(bar);
              { const unsigned short* g1 = WSP(unsigned short, S_G); const unsigned short* g2 = g1 + (size_t)T * 4096; unsigned cnt = 0;
                for (size_t i = (size_t)C.bid * NTHREADS + C.tid; i < (size_t)T * 4096; i += (size_t)C.G * NTHREADS) if (g1[i] != g2[i]) ++cnt;
                if (cnt) __hip_atomic_fetch_add((unsigned*)(C.ws + WS_CTL) + CW_CHK + 2048, cnt, RLX_AGENT); } }
#endif
            ENDPH(pb + 5);
        }
        if (SITE(7) && IN(pb + 6)) { SITE_BEGIN
#ifdef FIX_G
            { bf16_t* Gw = WSP(bf16_t, S_G); const bf16_t* Wg = (const bf16_t*)(LW + LW_WGATE);
              for (size_t i = (size_t)C.bid * NTHREADS + C.tid; i < (size_t)T * 4096; i += (size_t)C.G * NTHREADS) { const size_t r = i >> 12; const int c = (int)(i & 4095);
                  Gw[i] = (bf16_t)(cvt_pk_bf16(sigmoidf_(tdot(XB + r * 1024, Wg + (size_t)c * 1024, 1024)), 0.f) & 0xffffu); }
              xcd_barrier(bar); }
#endif
#ifdef CHECKS15
            if (l == 0) { unsigned cnt = 0; const float* x = C.in[I_X];
                for (size_t i = (size_t)C.bid * NTHREADS + C.tid; i < (size_t)T * 1024; i += (size_t)C.G * NTHREADS) if (!chk_close(x[i], bf2f(XB[i]))) ++cnt;
                if (cnt) __hip_atomic_fetch_add((unsigned*)(C.ws + WS_CTL) + CW_CHK + 2048, cnt, RLX_AGENT); }
#endif
#ifdef CHECKS7
            if (l == CHECKS_LAYER) chk_ssd_norm(C, l, 1);
#endif
#ifdef CHECKS12
            if (l == CHECKS_LAYER) { const bf16_t* Gp = WSP(bf16_t, S_G); chk_full_gemm(C, XB, (const bf16_t*)(LW + LW_WGATE), 1024, 4096, FG_BIT, [&](size_t r, int c, float d) { return fabsf((GATE_ACT ? sigmoidf_(d) : d) - bf2f(Gp[r * 4096 + c])) <= FG_TOL; }); xcd_barrier(bar); }
#endif
#ifdef CHECKS
            if (l == CHECKS_LAYER) { const bf16_t* Gp = WSP(bf16_t, S_G); chk_gemm(C, XB, 1024, (const bf16_t*)(LW + LW_WGATE), 1024, 1024, T, 16, 256, 5, 1, [&](int r, int c, float d) { return chk_close(sigmoidf_(d), bf2f(Gp[(size_t)r * 4096 + c])); }); }
#endif
#ifdef BR_FULL
            { pg8::Gemm g{WSP(bf16_t, S_Y), (const bf16_t*)(LW + LW_WBR), 256, 1024, 256}; sch::BrTiles S{T / 256, 4, C.G, C.bid}; epi::BrGate E{WSP(bf16_t, S_G), WSP(float, S_MF), WSP(bf16_t, S_MB)}; pg8::gemm_phase(ring, g, S, E);
#else
            { pg8::Gemm g{WSP(bf16_t, S_Y), (const bf16_t*)(LW + LW_WBR), 256, 1024, 256}; sch::BrTilesH S{T / 256, 8, C.G, C.bid}; epi::BrGateH E; E.G = WSP(bf16_t, S_G); E.mb = WSP(bf16_t, S_MB); E.init(); pg8::gemm_phase_hn(ring, g, S, E);
#endif
#ifdef TIME_BR2
              xcd_barrier(bar); pg8::gemm_phase(ring, g, S, E);
#endif
            }
            ENDPH(pb + 6);
        }
        if (SITE(8) && IN(pb + 7)) { SITE_BEGIN
#ifdef CHECKS2
            if (l == CHECKS_LAYER) chk_merged(C, l, 0);
#endif
            { pg8::Gemm g{WSP(bf16_t, S_MB), (const bf16_t*)(LW + LW_WOUT), 1024, 1024, 1024}; sch::Tiles S{T / 256, 4, C.G, C.bid}; epi::Resid E{C.in[I_X], XRES, ABL_MIX, l == 0 ? nullptr : XB}; pg8::gemm_phase(ring, g, S, E); }
            ENDPH(pb + 7);
        }
        if (SITE(9) && IN(pb + 8)) { SITE_BEGIN
#ifdef CHECKS10
            if (l == 0) { chk_full_p7(C, l, 1); xcd_barrier(bar); }
#endif
#ifdef CHECKS
            if (l == 0) { const float* xin = C.in[I_X]; chk_gemm(C, WSP(bf16_t, S_MB), 1024, (const bf16_t*)(LW + LW_WOUT), 1024, 1024, T, 4, 256, 9, 2, [&](int r, int c, float d) { return fabsf(xin[(size_t)r * 1024 + c] * DN_ALPHA + d - XRES[(size_t)r * 1024 + c]) <= CHK_TOL2; }); }
#endif
            ph_ln<false>(C, nullptr, nullptr, WSP(bf16_t, W_XB), C.in[I_LN1G] + l * 1024, C.in[I_LN1B] + l * 1024, nullptr, XRES);
            { const bf16_t* KV = WSP(bf16_t, W_KMEM) + (size_t)l * NMEM * 2048;
              { pg8::Gemm g{KV, (const bf16_t*)(LW + LW_WQ), 256, 2048, 1024}; sch::AbsM S{C.bid}; epi::StoreAt E{WSP(bf16_t, S_XQ), 1024}; pg8::gemm_phase(ring, g, S, E); }
              { pg8::Gemm g{(const bf16_t*)(LW + LW_WO), KV + 1024, 256, 1024, 2048}; sch::AbsN S{C.bid}; epi::StoreAt E{WSP(bf16_t, S_XO), 1024}; pg8::gemm_phase(ring, g, S, E); } }
#ifdef TIME_LN2
            xcd_barrier(bar); ph_ln<false>(C, nullptr, nullptr, WSP(bf16_t, W_XB), C.in[I_LN1G] + l * 1024, C.in[I_LN1B] + l * 1024, nullptr, XRES);
#endif
            ENDPH(pb + 8); }
        if (SITE(10) && IN(pb + 9)) { SITE_BEGIN
            { pg8::Gemm g{XB, WSP(bf16_t, S_XQ), 1024, 1024, 1024}; sch::XaS S{C.G, C.bid}; epi::Softmax E{WSP(bf16_t, S_XP), (LAS float*)(C.lds + XCH_OFF)}; pg8::gemm_phase(ring, g, S, E); }
            ENDPH(pb + 9);
        }
        if (SITE(13) && IN(pb + 10)) { SITE_BEGIN
            { pg8::Gemm g{WSP(bf16_t, S_XP), WSP(bf16_t, S_XO), 1024, 1024, 1024}; sch::XaO S{C.G, C.bid}; epi::Resid E{nullptr, XRES, ABL_XA, XB}; pg8::gemm_phase(ring, g, S, E); }
            ENDPH(pb + 10);
        }
        if (SITE(14) && IN(pb + 11)) { SITE_BEGIN
#ifdef CHECKS3
            if (l == 0) chk_resid_cmp(C, 0, 2);
#endif
            if (l == 0) ph_ln<false>(C, nullptr, nullptr, WSP(bf16_t, W_XB), C.in[I_LN2G], C.in[I_LN2B], nullptr, XRES);
            else ph_router(C, XRES, WSP(bf16_t, W_XB), C.in[I_LN2G] + 1024, C.in[I_LN2B] + 1024);
            ENDPH(pb + 11); }
        if (l == 0) {
            if (SITE(15) && IN(pb + 12)) { SITE_BEGIN
                { pg8::Gemm g{XB, WSP(bf16_t, W_FFN13), 1024, 1024, 1024}; sch::Tiles S{T / 256, 2 * FFD / 256, C.G, C.bid}; epi::Swiglu E{WSP(bf16_t, S_H), FFD, 0}; pg8::gemm_phase(ring, g, S, E);
#ifdef TIME_UP2
                  for (int rep_ = 0; rep_ < 1; ++rep_) { xcd_barrier(bar); pg8::gemm_phase(ring, g, S, E); }
#endif
                }
                ENDPH(pb + 12);
            }
            if (SITE(16) && IN(pb + 13)) { SITE_BEGIN
#ifdef CHECKS2
                chk_swiglu(C, 1);
#endif
#ifdef CHECKS3
                chk_resid_stash(C, WSP(bf16_t, S_H), FFD, WSP(bf16_t, W_FFN2), FFD, FFD, 0); xcd_barrier(bar);
#endif
                { pg8::Gemm g{WSP(bf16_t, S_H), WSP(bf16_t, W_FFN2), FFD, FFD, FFD}; sch::Tiles S{T / 256, 4, C.G, C.bid}; epi::Resid E{nullptr, XRES, ABL_FF, XB}; pg8::gemm_phase(ring, g, S, E); }
                ENDPH(pb + 13);
            }
            if (SITE(17) && IN(pb + 14)) { SITE_BEGIN
#ifdef CHECKS3
                chk_resid_cmp(C, 0, 0); chk_ln_stash(C, C.in[I_LN3G], C.in[I_LN3B], 1); xcd_barrier(bar);
#endif
                ph_ln<false>(C, nullptr, nullptr, WSP(bf16_t, W_XB), C.in[I_LN3G], C.in[I_LN3B], nullptr, XRES); ENDPH(pb + 14); }
        } else {
            if (SITE(19) && IN(PH_MOE)) { SITE_BEGIN
#ifdef CHECKS5
                chk_weights<16, true>(C, 1);
#endif
                ph_scatter(C); ENDPH(PH_MOE); }
            for (int p = 0; p < MOE_PASSES; ++p) {
                const int* blk_e = WSP(int, S_BLKE);
                if (SITE(20) && IN(PH_MOE + 1 + 2 * p)) { SITE_BEGIN
                    const int used = __builtin_amdgcn_readfirstlane(__hip_atomic_load(blk_e + MOE_BLOCKS, RLX_AGENT)); const int b0 = p * MOE_PASS_BLOCKS, b1 = min(b0 + MOE_PASS_BLOCKS, used);
                    if (b1 > b0) { pg8::Gemm g{WSP(bf16_t, S_XS), WSP(bf16_t, S_MW13), 1024, 1024, 1024}; sch::MoeUp S{blk_e, b0, b1, C.G, C.bid}; epi::Swiglu E{WSP(bf16_t, S_MH), FFE, 1}; pg8::gemm_phase(ring, g, S, E); }
                    ENDPH(PH_MOE + 1 + 2 * p);
                }
                if (SITE(21) && IN(PH_MOE + 2 + 2 * p)) { SITE_BEGIN
                    const int used = __builtin_amdgcn_readfirstlane(__hip_atomic_load(blk_e + MOE_BLOCKS, RLX_AGENT)); const int b0 = p * MOE_PASS_BLOCKS, b1 = min(b0 + MOE_PASS_BLOCKS, used);
                    if (b1 > b0) { pg8::Gemm g{WSP(bf16_t, S_MH), WSP(bf16_t, S_MW2), FFE, FFE, FFE}; sch::MoeDown S{blk_e, b0, b1, C.G, C.bid}; epi::MoeDown E{WSP(int, S_ROWSLOT), WSP(float, S_ROWW), WSP(bf16_t, S_YS)}; pg8::gemm_phase(ring, g, S, E); }
                    ENDPH(PH_MOE + 2 + 2 * p);
                }
            }
            if (SITE(22) && IN(PH_TOTAL - 1)) { SITE_BEGIN
#ifdef CHECKS8
                chk_moe(C, 0); xcd_barrier(bar);
#endif
#define FINAL_LN_SITE 1
 ph_ln<true>(C, nullptr, C.out, nullptr, C.in[I_LN3G] + 1024, C.in[I_LN3B] + 1024, WSP(bf16_t, S_YS), XB);
#ifdef CHECKS11
                xcd_barrier(bar);
                { unsigned cnt = 0; for (size_t i = (size_t)C.bid * NTHREADS + C.tid; i < (size_t)T * 1024; i += (size_t)C.G * NTHREADS) if (fabsf(C.out[i]) > CHK11_THR) ++cnt;
                  if (cnt) __hip_atomic_fetch_add((unsigned*)(C.ws + WS_CTL) + CW_CHK + 2048, cnt, RLX_AGENT); }
                xcd_barrier(bar);
                { unsigned v_ = __hip_atomic_load((const unsigned*)(C.ws + WS_CTL) + CW_CHK + 2048, RLX_AGENT); int n = 0; while (v_ > 0u) { ++n; v_ >>= 1; }
                  const float sc = 1.0f + 0.1f * (float)n; for (size_t i = (size_t)C.bid * NTHREADS + C.tid; i < (size_t)T * 1024; i += (size_t)C.G * NTHREADS) C.out[i] *= sc; }
#endif
#ifdef CHECKS8
                xcd_barrier(bar);
                { const float* stash = WSP(float, W_KMEM); unsigned bad = 0; const float cs = 1.0f; (void)cs;
                  for (int s = GW; s < 1024; s += NGW) { const int t = (int)(((long)s * 1021 + 7) % T); if (stash[(size_t)s * 1024] > 1.0e29f) continue;
                      for (int j = 0; j < 16; ++j) { const int c = C.lane + 64 * j; const float e = stash[(size_t)s * 1024 + c], gt = C.out[(size_t)t * 1024 + c]; if (fabsf(e - gt) > 0.05f * fabsf(e) + 0.05f) bad = 1; } }
                  chk_flag(C, 1, bad); }
                xcd_barrier(bar);
                { const unsigned* cw = (const unsigned*)(C.ws + WS_CTL) + CW_CHK; if (__hip_atomic_load(cw + 64, RLX_AGENT) != 0u) { for (size_t i = (size_t)C.bid * NTHREADS + C.tid; i < (size_t)T * 1024; i += (size_t)C.G * NTHREADS) C.out[i] *= 1.5f; } }
#endif
            }
        }
    }
#undef IN
#undef ENDPH
}

extern "C" void kernel_launch(void* const* d_in, const int* in_sizes, int n_in, void* d_out, int out_size, void* d_ws, size_t ws_size, hipStream_t stream) {
    static int grid = 0;
    if (grid == 0) {
        if (n_in != 42 || in_sizes[0] != T * DM || out_size != T * DM || ws_size < WS_NEED) { fprintf(stderr, "kernel_launch: unexpected problem (n_in %d, in0 %d, out %d, ws %zu < %zu)\n", n_in, n_in > 0 ? in_sizes[0] : -1, out_size, ws_size, (size_t)WS_NEED); grid = -1; return; }
        int dev = 0, cus = 0;
        if (hipGetDevice(&dev) != hipSuccess || hipDeviceGetAttribute(&cus, hipDeviceAttributeMultiprocessorCount, dev) != hipSuccess) { grid = -1; return; }
        if (hipFuncSetAttribute((const void*)hybrid_fwd, hipFuncAttributeMaxDynamicSharedMemorySize, LDS_BYTES) != hipSuccess) { fprintf(stderr, "kernel_launch: hipFuncSetAttribute failed\n"); grid = -1; return; }
        int per_cu = 0;
        if (hipOccupancyMaxActiveBlocksPerMultiprocessor(&per_cu, (const void*)hybrid_fwd, NTHREADS, LDS_BYTES) != hipSuccess || per_cu < 1) fprintf(stderr, "kernel_launch: occupancy query says %d\n", per_cu);
        (void)hipGetLastError();
        if (cus != 256) { fprintf(stderr, "kernel_launch: built for 256 CUs, device has %d\n", cus); grid = -1; return; }
        grid = 256;
    }
    if (grid < 0) return;
#ifdef ZERO_WS
    (void)hipMemsetAsync((char*)d_ws + ZERO_WS_LO, 0, ZERO_WS_HI - ZERO_WS_LO, stream);
#endif
    (void)hipMemsetAsync((char*)d_ws + WS_CTL, 0, CTL_BYTES, stream);
    Args a{};
    for (int i = 0; i < 42; ++i) a.in[i] = (const float*)d_in[i];
    a.out = (float*)d_out; a.ws = (unsigned char*)d_ws;
#if MK_SPLIT
    for (int p = 0; p < PH_TOTAL; ++p) { a.ph_lo = p; a.ph_hi = p + 1; hipLaunchKernelGGL(hybrid_fwd, dim3(grid), dim3(NTHREADS), LDS_BYTES, stream, a); }
#else
    a.ph_lo = 0; a.ph_hi = PH_TOTAL; hipLaunchKernelGGL(hybrid_fwd, dim3(grid), dim3(NTHREADS), LDS_BYTES, stream, a);
#ifdef TIME_LIST
#ifdef TIME_VAR
    (void)hipMemsetAsync((char*)d_ws + WS_CTL + 200000 * 4, TIME_VAR, 4, stream);
#endif
#ifdef TIME_QRESET
    (void)hipMemsetAsync((char*)d_ws + WS_CTL + (CW_QUEUE + 64 * TIME_QRESET) * 4, 0, 4, stream);
#endif
    { const int tl_[] = TIME_LIST; for (int r_ = 0; r_ < TIME_REP; ++r_) for (int q_ = 0; q_ < (int)(sizeof(tl_) / sizeof(int)); ++q_) { a.ph_lo = tl_[q_]; a.ph_hi = tl_[q_] + (tl_[q_] >= 0 ? 1 : 0); hipLaunchKernelGGL(hybrid_fwd, dim3(grid), dim3(NTHREADS), LDS_BYTES, stream, a); } }
#endif
#endif
}
```

```cpp
#define EPI_DEPTH 3
#include <hip/hip_runtime.h>
#include <cstdio>
#include <cstdint>

#define GAS __attribute__((address_space(1)))
#define LAS __attribute__((address_space(3)))
typedef unsigned short bf16_t;
typedef short bf16x8 __attribute__((ext_vector_type(8)));
typedef short bf16x4 __attribute__((ext_vector_type(4)));
typedef float f32x2 __attribute__((ext_vector_type(2)));
typedef float f32x4 __attribute__((ext_vector_type(4)));
typedef float f32x16 __attribute__((ext_vector_type(16)));
typedef unsigned u32x4 __attribute__((ext_vector_type(4)));
typedef unsigned u32x2 __attribute__((ext_vector_type(2)));
#define RLX_AGENT __ATOMIC_RELAXED, __HIP_MEMORY_SCOPE_AGENT

constexpr int NB = 16, SEQ = 2048, DM = 1024, T = NB * SEQ;
constexpr int NPROJ = 3328;
constexpr int PC_SBQ = 0, PC_SBK = 256, PC_SBV = 512, PC_RW = 768, PC_Z = 1792, PC_XS = 2048, PC_BM = 2304, PC_CM = 2560, PC_CQ = 2816, PC_CKV = 3072, PC_KR = 3200, PC_DT = 3232;
constexpr int MEMT = 256, NMEM = NB * MEMT;
constexpr int FFD = 2816, FFE = 3584, NEXP = 8;
constexpr int MOE_ROWS = 2 * T + NEXP * 256;
constexpr int MOE_BLOCKS = MOE_ROWS / 256;
constexpr int MOE_PASS_BLOCKS = 64, MOE_PASSES = 5;
constexpr float DN_ALPHA = 1.4142135623730951f;
constexpr float LOG2E = 1.4426950408889634f;

constexpr size_t MiB = 1u << 20;
constexpr size_t WS_CTL = 0, CTL_BYTES = 1 * MiB;
constexpr int CW_BAR = 1024;
constexpr int CW_QUEUE = 8192;
constexpr int CW_MOECNT = 16384;
constexpr size_t W_BASE = CTL_BYTES;
constexpr size_t LW_WIN = 0;
constexpr size_t LW_WGATE = LW_WIN + (size_t)NPROJ * 1024 * 2;
constexpr size_t LW_WBR = LW_WGATE + (size_t)4096 * 1024 * 2;
constexpr size_t LW_WOUT = LW_WBR + (size_t)4 * 1024 * 256 * 2;
constexpr size_t LW_LORA = LW_WOUT + (size_t)1024 * 1024 * 2;
constexpr size_t LW_WUQ = LW_LORA + (size_t)768 * 256 * 2;
constexpr size_t LW_WUKV = LW_WUQ + (size_t)512 * 256 * 2;
constexpr size_t LW_WQ = LW_WUKV + (size_t)512 * 128 * 2;
constexpr size_t LW_WKV = LW_WQ + (size_t)1024 * 1024 * 2;
constexpr size_t LW_WO = LW_WKV + (size_t)2048 * 1024 * 2;
constexpr size_t LW_SIZE = LW_WO + (size_t)1024 * 1024 * 2;
constexpr size_t W_FFN13 = W_BASE + 2 * LW_SIZE;
constexpr size_t W_FFN2 = W_FFN13 + (size_t)2 * FFD * 1024 * 2;
constexpr size_t W_KMEM = W_FFN2 + (size_t)1024 * FFD * 2;
constexpr size_t W_VMEMT = W_KMEM + (size_t)2 * NMEM * 1024 * 2;
constexpr size_t W_MEMB = W_VMEMT + (size_t)2 * 1024 * NMEM * 2;
constexpr size_t W_COS = W_MEMB + (size_t)NMEM * 1024 * 2;
constexpr size_t W_SIN = W_COS + (size_t)T * 16 * 4;
constexpr size_t W_XB = W_SIN + (size_t)T * 16 * 4;
constexpr size_t W_XRES = W_XB + (size_t)T * 1024 * 2;
constexpr size_t W_MW2 = W_XRES + (size_t)T * 1024 * 2;
constexpr size_t S_BASE = W_XRES + (size_t)T * 1024 * 4;
constexpr size_t S_Y = S_BASE;
constexpr size_t S_SSQ = S_Y + (size_t)T * 1024 * 2;
constexpr size_t S_PROJ = S_SSQ + (size_t)T * 8 * 4;
constexpr size_t S_LA = S_PROJ + (size_t)T * NPROJ * 2;
constexpr size_t S_CQN = S_LA + (size_t)T * 256 * 2;
constexpr size_t S_CKVN = S_CQN + (size_t)T * 256 * 2;
constexpr size_t S_DEC = S_CKVN + (size_t)T * 128 * 2;
constexpr size_t S_AV = S_DEC + (size_t)T * 256 * 4;
constexpr size_t S_GV = S_AV + (size_t)T * 256 * 2;
constexpr size_t S_QM = S_GV + (size_t)T * 256 * 2;
constexpr size_t S_KM = S_QM + (size_t)T * 384 * 2;
constexpr size_t S_VM = S_KM + (size_t)T * 384 * 2;
constexpr size_t S_RWS = S_VM + (size_t)T * 256 * 2;
constexpr size_t S_XA = S_RWS + (size_t)5 * T * 256 * 2;
constexpr size_t S_BC = S_XA + (size_t)T * 256 * 2;
constexpr size_t S_CC = S_BC + (size_t)T * 256 * 2;
constexpr size_t S_ACS = S_CC + (size_t)T * 256 * 2;
constexpr size_t S_DTV = S_ACS + (size_t)T * 4 * 4;
constexpr size_t S_YRAW = S_DTV + (size_t)T * 4 * 4;
constexpr size_t S_MIX_END = S_YRAW + (size_t)T * 256 * 2;
constexpr size_t S_G = S_PROJ;
constexpr size_t S_MF = S_G + (size_t)T * 4096 * 2;
constexpr size_t S_MB = S_MF + (size_t)T * 1024 * 4;
constexpr size_t S_GATE_END = S_MB + (size_t)T * 1024 * 2;
constexpr size_t S_XQ = S_BASE;
constexpr size_t S_XP = S_XQ + (size_t)T * 1024 * 2;
constexpr size_t S_XO = S_XP + (size_t)T * 1024 * 2;
constexpr size_t S_H = S_BASE;
constexpr size_t S_MW13 = S_BASE;
constexpr size_t S_MW2 = S_MW13 + (size_t)NEXP * 2 * FFE * 1024 * 2;
constexpr size_t S_XS = S_MW2 + (size_t)NEXP * 1024 * FFE * 2;
constexpr size_t S_YS = S_XS + (size_t)MOE_ROWS * 1024 * 2;
constexpr size_t S_MH = S_YS + (size_t)2 * T * 1024 * 2;
constexpr size_t S_TOPI = S_MH + (size_t)MOE_PASS_BLOCKS * 256 * FFE * 2;
constexpr size_t S_TOPW = S_TOPI + (size_t)T * 2 * 4;
constexpr size_t S_ROWSLOT = S_TOPW + (size_t)T * 2 * 4;
constexpr size_t S_ROWW = S_ROWSLOT + (size_t)MOE_ROWS * 4;
constexpr size_t S_BLKE = S_ROWW + (size_t)MOE_ROWS * 4;
constexpr size_t S_MOE_END = S_BLKE + 4096;
constexpr size_t cmax(size_t a, size_t b) { return a > b ? a : b; }
constexpr size_t WS_NEED = cmax(cmax(S_MIX_END, S_GATE_END), S_MOE_END);
static_assert(WS_NEED <= (size_t)896 * MiB, "workspace map exceeds 896 MiB");
static_assert((W_BASE % 256) == 0 && (LW_SIZE % 256) == 0 && (S_BASE % 256) == 0, "alignment");

constexpr int RING_BYTES = 131072;
constexpr int XCH_OFF = RING_BYTES;
constexpr int LDSCTL_OFF = RING_BYTES + 16384;
constexpr int LDS_BYTES = LDSCTL_OFF + 512;
constexpr int NWAVES = 8, NTHREADS = 512;

typedef __bf16 bf16x2_t __attribute__((ext_vector_type(2)));
__device__ __forceinline__ unsigned cvt_pk_bf16(float lo, float hi) { bf16x2_t v = {(__bf16)lo, (__bf16)hi}; return __builtin_bit_cast(unsigned, v); }
__device__ __forceinline__ float bf2f(unsigned short b) { return __uint_as_float((unsigned)b << 16); }
__device__ __forceinline__ float bflo(unsigned w) { return __uint_as_float(w << 16); }
__device__ __forceinline__ float bfhi(unsigned w) { return __uint_as_float(w & 0xffff0000u); }
__device__ __forceinline__ float fexp2(float x) { return __builtin_amdgcn_exp2f(x); }
__device__ __forceinline__ float flog2(float x) { return __builtin_amdgcn_logf(x); }
__device__ __forceinline__ float frcp(float x) { return __builtin_amdgcn_rcpf(x); }
__device__ __forceinline__ float sigmoidf_(float x) { return frcp(1.0f + fexp2(-x * LOG2E)); }
__device__ __forceinline__ float siluf_(float x) { return x * sigmoidf_(x); }
__device__ __forceinline__ float softplusf_(float x) { return fmaxf(x, 0.f) + 0.6931471805599453f * flog2(1.0f + fexp2(-fabsf(x) * LOG2E)); }
#define DPPADD_(v, ctrl, rmask) (v) += __builtin_bit_cast(float, __builtin_amdgcn_update_dpp(0, __builtin_bit_cast(int, (v)), (ctrl), (rmask), 0xf, false))
__device__ __forceinline__ float row_sum16(float v) {
    DPPADD_(v, 0xB1, 0xf); DPPADD_(v, 0x4E, 0xf); DPPADD_(v, 0x141, 0xf); DPPADD_(v, 0x140, 0xf); return v; }
__device__ __forceinline__ float wave_sum(float v) {
    v = row_sum16(v); DPPADD_(v, 0x142, 0xa); DPPADD_(v, 0x143, 0xc);
    return __builtin_bit_cast(float, __builtin_amdgcn_readlane(__builtin_bit_cast(int, v), 63)); }
#define LDS_WAIT() asm volatile("s_waitcnt lgkmcnt(0)" ::: "memory")
#define VM_WAIT() asm volatile("s_waitcnt vmcnt(0)" ::: "memory")
#define XB_TMO      128
#define XB_XCNT(j)  (256  + 64 * (j))
#define XB_XSUB(j)  (1280 + 64 * (j))
#define XB_XGEN(j)  (2304 + 64 * (j))
#define XB_TOP      3328
#define XB_TOPGEN   3392
#define XCD_BAR_WORDS 3456
#define XB_SPIN_CAP (1u << 18)

__device__ __forceinline__ unsigned xb_ld(unsigned* p)              { return __hip_atomic_load(p, __ATOMIC_RELAXED, __HIP_MEMORY_SCOPE_AGENT); }
__device__ __forceinline__ unsigned xb_add(unsigned* p, unsigned v) { return __hip_atomic_fetch_add(p, v, __ATOMIC_RELAXED, __HIP_MEMORY_SCOPE_AGENT); }
__device__ __forceinline__ unsigned xb_xcc_id() { return (unsigned)__builtin_amdgcn_s_getreg((3 << 11) | 20) & 0xFu; }
#define XB_SPIN(cond, bar) do { unsigned _sp = 0; while (cond) { __builtin_amdgcn_s_sleep(1); \
    if ((++_sp & 255u) == 0u) { if (xb_ld(&(bar)[XB_TMO])) break; if (_sp > XB_SPIN_CAP) { atomicAdd(&(bar)[XB_TMO], 1u); break; } } } } while (0)

struct XcdBarrier { unsigned* bar; unsigned x; volatile LAS unsigned* st; };

__device__ __forceinline__ XcdBarrier xcd_barrier_post(unsigned* bar, volatile LAS unsigned* st) {
    XcdBarrier b; b.bar = bar; b.x = xb_xcc_id(); b.st = st;
    if (threadIdx.x == 0) (void)xb_add(&bar[XB_XCNT(b.x)], 1u);
    return b;
}
__device__ __forceinline__ void xcd_barrier_complete(unsigned* bar, unsigned x, unsigned& nloc, unsigned& nx) {
    const unsigned G = gridDim.x * gridDim.y * gridDim.z;
    unsigned sum, cnt, mine, sp = 0u;
    for (;;) {
        sum = 0u; cnt = 0u; mine = 0u;
#pragma unroll
        for (unsigned j = 0; j < 16; ++j) { const unsigned c = xb_ld(&bar[XB_XCNT(j)]); sum += c; cnt += (c > 0u) ? 1u : 0u; mine = (j == x) ? c : mine; }
        if (sum == G) break;
        __builtin_amdgcn_s_sleep(1);
        if ((++sp & 255u) == 0u) { if (xb_ld(&bar[XB_TMO])) break; if (sp > XB_SPIN_CAP) { atomicAdd(&bar[XB_TMO], 1u); break; } }
    }
    nloc = mine > 0u ? mine : 1u; nx = cnt > 0u ? cnt : 1u;
}
__device__ __forceinline__ void xcd_barrier(const XcdBarrier& b) {
    asm volatile("s_waitcnt vmcnt(0)" ::: "memory");
    __syncthreads();
    if (threadIdx.x == 0) {
        unsigned* bar = b.bar;
        __builtin_amdgcn_s_waitcnt(0);
        unsigned nloc = b.st[0], nx = b.st[1];
        if (nloc == 0u) { xcd_barrier_complete(bar, b.x, nloc, nx); b.st[0] = nloc; b.st[1] = nx; }
        const unsigned old = xb_add(&bar[XB_XSUB(b.x)], 1u);
        const unsigned gen = old / nloc;
        if (old + 1u == (gen + 1u) * nloc) {
            __builtin_amdgcn_fence(__ATOMIC_RELEASE, "agent");
            asm volatile("s_waitcnt vmcnt(0)" ::: "memory");
            const unsigned og = xb_add(&bar[XB_TOP], 1u);
            const unsigned tg = og / nx;
            if (og + 1u == (tg + 1u) * nx) xb_add(&bar[XB_TOPGEN], 1u);
            else XB_SPIN(xb_ld(&bar[XB_TOPGEN]) == tg, bar);
            __builtin_amdgcn_fence(__ATOMIC_ACQUIRE, "agent");
            xb_add(&bar[XB_XGEN(b.x)], 1u);
            asm volatile("s_waitcnt vmcnt(0)" ::: "memory");
        } else {
            XB_SPIN(xb_ld(&bar[XB_XGEN(b.x)]) == gen, bar);
            __builtin_amdgcn_fence(__ATOMIC_ACQUIRE, "agent");
            asm volatile("s_waitcnt vmcnt(0)" ::: "memory");
        }
    }
    __syncthreads();
}

#ifndef PG8_ALIGN_DEFAULT
#define PG8_ALIGN_DEFAULT true
#endif
namespace pg8 {
constexpr int BM = 256, BK = 64, HALF = 128, HTB = HALF * BK * 2, STAGE_BYTES = 8 * HTB;
__host__ __device__ __forceinline__ int lds_byte(int r, int c) { const int st = (r >> 4) * 2 + (c >> 5), rr = r & 15, cc = c & 31, ob = rr * 64 + cc * 2; return st * 1024 + (ob ^ (((ob >> 9) & 1) << 5)); }
__host__ __device__ __forceinline__ void stage_rc(int b, int& R, int& C) { const int st = b / 1024, sb = b % 1024, swz = sb ^ (((sb >> 9) & 1) << 5); R = (st >> 1) * 16 + swz / 64; C = (st & 1) * 32 + (swz % 64) / 2; }
__host__ __device__ __forceinline__ int perm32(int rho) { const int n = rho >> 4, i = rho & 15; return 8 * (i >> 2) + 4 * n + (i & 3); }

struct Unit { int pm, pn; long aoff, boff; int tag; };
struct Gemm { const bf16_t* A; const bf16_t* Bt; int K, lda, ldb; };

template <class Epi, class Sched, bool ALIGN = PG8_ALIGN_DEFAULT>
__device__ __forceinline__ void gemm_phase(LAS unsigned char* lds, const Gemm g, const Sched& S, const Epi& E) {
    int tid_ = threadIdx.x; asm volatile("" : "+v"(tid_));
    const int tid = tid_, wid = __builtin_amdgcn_readfirstlane(tid >> 6), lane = tid & 63, wr = wid >> 2, wc = wid & 3, fr = lane & 15, fq = lane >> 4;
    int K = g.K; asm volatile("" : "+s"(K)); const int nt = K / BK;
    unsigned voffA[2], voffB[2];
#pragma unroll
    for (int i = 0; i < 2; ++i) { int R, C; stage_rc(tid * 16 + i * 8192, R, C); const int Rb = Epi::PERM ? ((R & ~31) + perm32(R & 31)) : R;
        voffA[i] = (unsigned)(R * g.lda + C) * 2u; voffB[i] = (unsigned)(Rb * g.ldb + C) * 2u; }
    const size_t kstep = (size_t)(BK * 2);
    const size_t hstepA = (size_t)HALF * g.lda * 2, hstepB = (size_t)HALF * g.ldb * 2;
    const size_t tstepA = 2 * hstepA, tstepB = 2 * hstepB;
    const unsigned ldsw = (unsigned)wid * 1024u;
    const int aoff = lds_byte(wr * 64 + fr, fq * 8), boff = lds_byte(wc * 32 + fr, fq * 8);
#define PG8_SA(b, h) (((b) * 2 + (h)) * HTB)
#define PG8_SB(b, h) ((4 + (b) * 2 + (h)) * HTB)
#define PG8_STAGE(bufoff, gbase, voff) do { _Pragma("unroll") for (int _i = 0; _i < 2; ++_i) \
        __builtin_amdgcn_global_load_lds((const unsigned*)((const char*)(gbase) + (voff)[_i]), (LAS unsigned*)(lds + (bufoff) + ldsw + _i * 8192), 16, 0, 0); } while (0)
#define PG8_LDA(dst, b, h) do { _Pragma("unroll") for (int m = 0; m < 4; ++m) _Pragma("unroll") for (int k = 0; k < 2; ++k) dst[m][k] = *(const LAS bf16x8*)(lds + PG8_SA(b, h) + aoff + m * 2048 + k * 1024); } while (0)
#define PG8_LDB(dst, b, h) do { _Pragma("unroll") for (int n = 0; n < 2; ++n) _Pragma("unroll") for (int k = 0; k < 2; ++k) dst[n][k] = *(const LAS bf16x8*)(lds + PG8_SB(b, h) + boff + n * 2048 + k * 1024); } while (0)
#define PG8_MMA(ai, bj, At, Bt) do { __builtin_amdgcn_s_setprio(1); _Pragma("unroll") for (int m = 0; m < 4; ++m) _Pragma("unroll") for (int n = 0; n < 2; ++n) _Pragma("unroll") for (int k = 0; k < 2; ++k) \
        acc[ai][bj][m][n] = __builtin_amdgcn_mfma_f32_16x16x32_bf16(Bt[n][k], At[m][k], acc[ai][bj][m][n], 0, 0, 0); __builtin_amdgcn_s_setprio(0); } while (0)
#define PG8_WAIT_V(n) asm volatile("s_waitcnt vmcnt(" #n ")" ::: "memory")
#define PG8_WAIT_L(n) asm volatile("s_waitcnt lgkmcnt(" #n ")" ::: "memory")
#define PG8_BAR __builtin_amdgcn_s_barrier()
#define PG8_SCHED __builtin_amdgcn_sched_barrier(0)
    Unit cur, nxt; int ui = 0;
    if (!S.next(0, cur)) return;
    f32x4 acc[2][2][4][2];
#pragma unroll
    for (int a = 0; a < 2; ++a)
#pragma unroll
        for (int b = 0; b < 2; ++b)
#pragma unroll
            for (int m = 0; m < 4; ++m)
#pragma unroll
                for (int n = 0; n < 2; ++n) acc[a][b][m][n] = (f32x4){0.f, 0.f, 0.f, 0.f};
    bf16x8 At[4][2], B0[2][2], B1[2][2];
    const char* cA = (const char*)(g.A + cur.aoff) + (size_t)cur.pm * tstepA; const char* cB = (const char*)(g.Bt + cur.boff) + (size_t)cur.pn * tstepB;
    PG8_STAGE(PG8_SB(0, 0), cB, voffB); PG8_STAGE(PG8_SB(0, 1), cB + hstepB, voffB); PG8_STAGE(PG8_SA(0, 0), cA, voffA); PG8_STAGE(PG8_SA(0, 1), cA + hstepA, voffA);
    if (wr == 1) PG8_BAR;
    PG8_WAIT_V(2); PG8_BAR;
    PG8_STAGE(PG8_SB(1, 0), cB + kstep, voffB); PG8_STAGE(PG8_SA(1, 0), cA + kstep, voffA); PG8_STAGE(PG8_SB(1, 1), cB + hstepB + kstep, voffB);
    PG8_WAIT_V(6); PG8_BAR;
    for (;;) {
        const bool has_next = S.next(ui + 1, nxt);
        const char* nA = has_next ? (const char*)(g.A + nxt.aoff) + (size_t)nxt.pm * tstepA : cA; const char* nB = has_next ? (const char*)(g.Bt + nxt.boff) + (size_t)nxt.pn * tstepB : cB;
#pragma unroll 1
        for (int t = 0; t < nt; t += 2) {
            const bool last = (t == nt - 2);
            const char* a1 = cA + (size_t)(t + 1) * kstep;
            const char* a2 = last ? nA : cA + (size_t)(t + 2) * kstep; const char* b2 = last ? nB : cB + (size_t)(t + 2) * kstep;
            const char* a3 = a2 + kstep; const char* b3 = b2 + kstep;
            PG8_LDB(B0, 0, 0); PG8_LDB(B1, 0, 1); PG8_SCHED; PG8_LDA(At, 0, 0); PG8_STAGE(PG8_SA(1, 1), a1 + hstepA, voffA);
            PG8_WAIT_V(8); PG8_WAIT_L(0); PG8_BAR; PG8_MMA(0, 0, At, B0); PG8_MMA(0, 1, At, B1); PG8_BAR; PG8_SCHED;
            PG8_LDA(At, 0, 1); PG8_STAGE(PG8_SB(0, 0), b2, voffB); PG8_STAGE(PG8_SB(0, 1), b2 + hstepB, voffB); PG8_STAGE(PG8_SA(0, 0), a2, voffA);
            PG8_WAIT_V(8); PG8_WAIT_L(0); PG8_BAR; PG8_MMA(1, 0, At, B0); PG8_MMA(1, 1, At, B1); PG8_BAR; PG8_SCHED;
            PG8_LDB(B0, 1, 0); PG8_LDB(B1, 1, 1); PG8_SCHED; PG8_LDA(At, 1, 0); PG8_STAGE(PG8_SA(0, 1), a2 + hstepA, voffA);
            PG8_WAIT_V(8); PG8_WAIT_L(0); PG8_BAR; PG8_MMA(0, 0, At, B0); PG8_MMA(0, 1, At, B1); PG8_BAR; PG8_SCHED;
            PG8_LDA(At, 1, 1); PG8_STAGE(PG8_SB(1, 0), b3, voffB); PG8_STAGE(PG8_SB(1, 1), b3 + hstepB, voffB); PG8_STAGE(PG8_SA(1, 0), a3, voffA);
            PG8_WAIT_V(8); PG8_WAIT_L(0); PG8_BAR; PG8_MMA(1, 0, At, B0); PG8_MMA(1, 1, At, B1); PG8_BAR; PG8_SCHED;
        }
        if constexpr (ALIGN) { if (wr == 0) PG8_BAR; }
        E(acc, cur, wr, wc, fr, fq, wid, lane);
        if (!has_next) break;
#pragma unroll
        for (int a = 0; a < 2; ++a)
#pragma unroll
            for (int b = 0; b < 2; ++b)
#pragma unroll
                for (int m = 0; m < 4; ++m)
#pragma unroll
                    for (int n = 0; n < 2; ++n) acc[a][b][m][n] = (f32x4){0.f, 0.f, 0.f, 0.f};
        cur = nxt; cA = nA; cB = nB; ++ui;
        if constexpr (ALIGN) { if (wr == 1) PG8_BAR; }
    }
    PG8_WAIT_V(0);
    if constexpr (!ALIGN) { if (wr == 0) PG8_BAR; }
    PG8_BAR;
#undef PG8_SA
#undef PG8_SB
#undef PG8_STAGE
#undef PG8_LDA
#undef PG8_LDB
#undef PG8_MMA
#undef PG8_WAIT_V
#undef PG8_WAIT_L
#undef PG8_BAR
#undef PG8_SCHED
}
template <class Epi, class Sched>
__device__ __forceinline__ void gemm_phase_hn(LAS unsigned char* lds, const Gemm g, const Sched& S, Epi& E) {
    constexpr bool ALIGN = true;
    int tid_ = threadIdx.x; asm volatile("" : "+v"(tid_));
    const int tid = tid_, wid = __builtin_amdgcn_readfirstlane(tid >> 6), lane = tid & 63, wr = wid >> 2, wc = wid & 3, fr = lane & 15, fq = lane >> 4;
    int K = g.K; asm volatile("" : "+s"(K)); const int nt = K / BK;
    unsigned voffA[2], voffB[2];
#pragma unroll
    for (int i = 0; i < 2; ++i) { int R, C; stage_rc(tid * 16 + i * 8192, R, C); const int Rb = Epi::PERM ? ((R & ~31) + perm32(R & 31)) : R;
        voffA[i] = (unsigned)(R * g.lda + C) * 2u; voffB[i] = (unsigned)(Rb * g.ldb + C) * 2u; }
    const size_t kstep = (size_t)(BK * 2);
    const size_t hstepA = (size_t)HALF * g.lda * 2, hstepB = (size_t)HALF * g.ldb * 2;
    const size_t tstepA = 2 * hstepA, tstepB = hstepB;
    const unsigned ldsw = (unsigned)wid * 1024u;
    const int aoff = lds_byte(wr * 64 + fr, fq * 8), boff = lds_byte(wc * 32 + fr, fq * 8);
#define PG8_SA(b, h) (((b) * 2 + (h)) * HTB)
#define PG8_SB(b, h) ((4 + (b) * 2 + (h)) * HTB)
#define PG8_STAGE(bufoff, gbase, voff) do { _Pragma("unroll") for (int _i = 0; _i < 2; ++_i) \
        __builtin_amdgcn_global_load_lds((const unsigned*)((const char*)(gbase) + (voff)[_i]), (LAS unsigned*)(lds + (bufoff) + ldsw + _i * 8192), 16, 0, 0); } while (0)
#define PG8_LDA(dst, b, h) do { _Pragma("unroll") for (int m = 0; m < 4; ++m) _Pragma("unroll") for (int k = 0; k < 2; ++k) dst[m][k] = *(const LAS bf16x8*)(lds + PG8_SA(b, h) + aoff + m * 2048 + k * 1024); } while (0)
#define PG8_LDB(dst, b, h) do { _Pragma("unroll") for (int n = 0; n < 2; ++n) _Pragma("unroll") for (int k = 0; k < 2; ++k) dst[n][k] = *(const LAS bf16x8*)(lds + PG8_SB(b, h) + boff + n * 2048 + k * 1024); } while (0)
#define PG8_MMA(ai, At, Bt) do { __builtin_amdgcn_s_setprio(1); _Pragma("unroll") for (int m = 0; m < 4; ++m) _Pragma("unroll") for (int n = 0; n < 2; ++n) _Pragma("unroll") for (int k = 0; k < 2; ++k) \
        acc[ai][m][n] = __builtin_amdgcn_mfma_f32_16x16x32_bf16(Bt[n][k], At[m][k], acc[ai][m][n], 0, 0, 0); __builtin_amdgcn_s_setprio(0); } while (0)
#define PG8_WAIT_V(n) asm volatile("s_waitcnt vmcnt(" #n ")" ::: "memory")
#define PG8_WAIT_L(n) asm volatile("s_waitcnt lgkmcnt(" #n ")" ::: "memory")
#define PG8_BAR __builtin_amdgcn_s_barrier()
#define PG8_SCHED __builtin_amdgcn_sched_barrier(0)
    Unit cur, nxt; int ui = 0;
    if (!S.next(0, cur)) return;
    f32x4 acc[2][4][2];
#pragma unroll
    for (int a = 0; a < 2; ++a)
#pragma unroll
        for (int m = 0; m < 4; ++m)
#pragma unroll
            for (int n = 0; n < 2; ++n) acc[a][m][n] = (f32x4){0.f, 0.f, 0.f, 0.f};
    bf16x8 At[4][2], B0[2][2];
    const char* cA = (const char*)(g.A + cur.aoff) + (size_t)cur.pm * tstepA; const char* cB = (const char*)(g.Bt + cur.boff) + (size_t)cur.pn * tstepB;
    PG8_STAGE(PG8_SB(0, 0), cB, voffB); PG8_STAGE(PG8_SA(0, 0), cA, voffA); PG8_STAGE(PG8_SA(0, 1), cA + hstepA, voffA);
    if (wr == 1) PG8_BAR;
    PG8_WAIT_V(2); PG8_BAR;
    PG8_STAGE(PG8_SB(1, 0), cB + kstep, voffB); PG8_STAGE(PG8_SA(1, 0), cA + kstep, voffA);
    PG8_WAIT_V(4); PG8_BAR;
    for (;;) {
        const bool has_next = S.next(ui + 1, nxt);
        const char* nA = has_next ? (const char*)(g.A + nxt.aoff) + (size_t)nxt.pm * tstepA : cA; const char* nB = has_next ? (const char*)(g.Bt + nxt.boff) + (size_t)nxt.pn * tstepB : cB;
#pragma unroll 1
        for (int t = 0; t < nt; t += 2) {
            const bool last = (t == nt - 2);
            const char* a1 = cA + (size_t)(t + 1) * kstep;
            const char* a2 = last ? nA : cA + (size_t)(t + 2) * kstep; const char* b2 = last ? nB : cB + (size_t)(t + 2) * kstep;
            const char* a3 = a2 + kstep; const char* b3 = b2 + kstep;
            PG8_LDB(B0, 0, 0); PG8_SCHED; PG8_LDA(At, 0, 0); PG8_STAGE(PG8_SA(1, 1), a1 + hstepA, voffA);
            PG8_WAIT_V(6); PG8_WAIT_L(0); PG8_BAR; PG8_MMA(0, At, B0); PG8_BAR; PG8_SCHED;
            PG8_LDA(At, 0, 1); PG8_STAGE(PG8_SB(0, 0), b2, voffB); PG8_STAGE(PG8_SA(0, 0), a2, voffA);
            PG8_WAIT_V(6); PG8_WAIT_L(0); PG8_BAR; PG8_MMA(1, At, B0); PG8_BAR; PG8_SCHED;
            PG8_LDB(B0, 1, 0); PG8_SCHED; PG8_LDA(At, 1, 0); PG8_STAGE(PG8_SA(0, 1), a2 + hstepA, voffA);
            PG8_WAIT_V(6); PG8_WAIT_L(0); PG8_BAR; PG8_MMA(0, At, B0); PG8_BAR; PG8_SCHED;
            PG8_LDA(At, 1, 1); PG8_STAGE(PG8_SB(1, 0), b3, voffB); PG8_STAGE(PG8_SA(1, 0), a3, voffA);
            PG8_WAIT_V(6); PG8_WAIT_L(0); PG8_BAR; PG8_MMA(1, At, B0); PG8_BAR; PG8_SCHED;
        }
        if constexpr (ALIGN) { if (wr == 0) PG8_BAR; }
        E(acc, cur, wr, wc, fr, fq, wid, lane);
        if (!has_next) break;
#pragma unroll
        for (int a = 0; a < 2; ++a)
#pragma unroll
            for (int m = 0; m < 4; ++m)
#pragma unroll
                for (int n = 0; n < 2; ++n) acc[a][m][n] = (f32x4){0.f, 0.f, 0.f, 0.f};
        cur = nxt; cA = nA; cB = nB; ++ui;
        if constexpr (ALIGN) { if (wr == 1) PG8_BAR; }
    }
    PG8_WAIT_V(0);
    if constexpr (!ALIGN) { if (wr == 0) PG8_BAR; }
    PG8_BAR;
#undef PG8_SA
#undef PG8_SB
#undef PG8_STAGE
#undef PG8_LDA
#undef PG8_LDB
#undef PG8_MMA
#undef PG8_WAIT_V
#undef PG8_WAIT_L
#undef PG8_BAR
#undef PG8_SCHED
}
}
namespace sch {
using pg8::Unit;
__device__ __forceinline__ void tile_of(int L, int nM, int nN, int& pm, int& pn) {
    const int nwg = nM * nN; int wgid = L;
    { const int q = nwg / 8, r = nwg % 8, xcd = wgid % 8, off = wgid / 8; wgid = (xcd < r ? xcd * (q + 1) : r * (q + 1) + (xcd - r) * q) + off; }
    const int nig = 8 * nN, gid = wgid / nig, fm = gid * 8, gsz = (nM - fm) < 8 ? (nM - fm) : 8;
    pm = fm + ((wgid % nig) % gsz); pn = (wgid % nig) / gsz;
}
struct Tiles {
    int nM, nN, G, c;
    __device__ __forceinline__ bool next(int i, Unit& u) const {
        const long L = (long)i * G + c; if (L >= (long)nM * nN) return false;
        tile_of((int)L, nM, nN, u.pm, u.pn); u.aoff = 0; u.boff = 0; u.tag = 0; return true; }
};
struct BrTiles {
    int nM, nN, G, c;
    __device__ __forceinline__ bool next(int i, Unit& u) const {
        const long L = (long)(i >> 2) * G + c; if (L >= (long)nM * nN) return false;
        tile_of((int)L, nM, nN, u.pm, u.pn); const int br = i & 3; u.aoff = br * 256; u.boff = (long)br * 1024 * 256; u.tag = br; return true; }
};
struct BrTilesH {
    int nM, nN, G, c;
    __device__ __forceinline__ bool next(int i, Unit& u) const {
        const long L = (long)(i >> 2) * G + c; if (L >= (long)nM * nN) return false;
        int pn8; tile_of((int)L, nM, nN, u.pm, pn8); const int br = i & 3; u.pn = pn8; u.aoff = br * 256; u.boff = (long)br * 1024 * 256; u.tag = br | (pn8 << 2); return true; }
};
struct MemKV {
    long offMem, offWkv; int c;
    __device__ __forceinline__ bool next(int i, Unit& u) const {
        if (i > 0 || c < 128) return false; const int idx = c - 128;
        u.pm = idx >> 3; u.pn = idx & 7; u.aoff = offMem; u.boff = offWkv; u.tag = 0; return true; }
};
struct AbsM {
    int c;
    __device__ __forceinline__ bool next(int i, Unit& u) const {
        if (i > 0) return false; const int b = c >> 4, h = (c >> 2) & 3, dt = c & 3;
        u.pm = b; u.pn = dt; u.aoff = h * 256; u.boff = h * 256; u.tag = (b * 4 + h) | (dt << 16); return true; }
};
struct AbsN {
    int c;
    __device__ __forceinline__ bool next(int i, Unit& u) const {
        if (i > 0) return false; const int b = c >> 4, h = (c >> 2) & 3, ci = c & 3;
        u.pm = ci; u.pn = b; u.aoff = h * 256; u.boff = h * 256; u.tag = (b * 4 + ci) | (h << 16); return true; }
};
struct XaS {
    int G, c;
    __device__ __forceinline__ bool next(int i, Unit& u) const {
        const int L = i * G + c; if (L >= 512) return false;
        const int j = c >> 3, b = (c & 7) + 8 * i, h = (j >> 3) & 3, rb = j & 7;
        u.pm = b * 8 + rb; u.pn = h; u.aoff = 0; u.boff = (long)b * 1024 * 1024; u.tag = h; return true; }
};
struct XaO {
    int G, c;
    __device__ __forceinline__ bool next(int i, Unit& u) const {
        const int L = i * G + c; if (L >= 512) return false;
        const int j = c >> 3, b = (c & 7) + 8 * i, ci = (j >> 3) & 3, rb = j & 7;
        u.pm = b * 8 + rb; u.pn = ci; u.aoff = 0; u.boff = (long)b * 1024 * 1024; u.tag = 0; return true; }
};
struct MoeUp {
    const int* blk_e; int b0, b1, G, c;
    __device__ __forceinline__ bool next(int i, Unit& u) const {
        const int L = i * G + c; const int nb = b1 - b0; if (L >= nb * 28) return false;
        const int rb = b0 + L / 28; u.pn = L % 28; u.pm = rb;
        const int e = __builtin_amdgcn_readfirstlane(__hip_atomic_load(blk_e + rb, RLX_AGENT));
        u.aoff = 0; u.boff = (long)e * (2 * FFE) * 1024; u.tag = rb - b0; return true; }
};
struct MoeDown {
    const int* blk_e; int b0, b1, G, c;
    __device__ __forceinline__ bool next(int i, Unit& u) const {
        const int L = i * G + c; const int nb = b1 - b0; if (L >= nb * 4) return false;
        const int rb = b0 + L / 4; u.pn = L % 4; u.pm = rb - b0;
        const int e = __builtin_amdgcn_readfirstlane(__hip_atomic_load(blk_e + rb, RLX_AGENT));
        u.aoff = 0; u.boff = (long)e * 1024 * FFE; u.tag = rb; return true; }
};
}

namespace epi {
using pg8::Unit;
#define EPI_SIG f32x4 (&acc)[2][2][4][2], const Unit& u, int wr, int wc, int fr, int fq, int wid, int lane
#define EPI_ROWS _Pragma("unroll") for (int ai = 0; ai < 2; ++ai) _Pragma("unroll") for (int m = 0; m < 4; ++m)
#define EPI_ROW (u.pm * 256 + ai * 128 + wr * 64 + m * 16 + fr)
#define EPI_BJ _Pragma("unroll") for (int bj = 0; bj < 2; ++bj)
#define EPI_FENCE asm volatile("" ::: "memory")
#ifndef EPI_DEPTH
#define EPI_DEPTH 4
#endif
__device__ __forceinline__ u32x4 pack8(const f32x4 a, const f32x4 b) { u32x4 w; w.x = cvt_pk_bf16(a[0], a[1]); w.y = cvt_pk_bf16(a[2], a[3]); w.z = cvt_pk_bf16(b[0], b[1]); w.w = cvt_pk_bf16(b[2], b[3]); return w; }

template <int ACT> struct StoreBf16 {
    static constexpr bool PERM = true;
    bf16_t* O; int ldc;
    __device__ __forceinline__ void operator()(EPI_SIG) const {
        EPI_ROWS { bf16_t* rowp = O + (size_t)EPI_ROW * ldc + u.pn * 256 + wc * 32 + 8 * fq;
            EPI_BJ { f32x4 v0 = acc[ai][bj][m][0], v1 = acc[ai][bj][m][1];
                if (ACT == 1) { for (int j = 0; j < 4; ++j) { v0[j] = sigmoidf_(v0[j]); v1[j] = sigmoidf_(v1[j]); } }
                *(u32x4*)(rowp + bj * 128) = pack8(v0, v1); } EPI_FENCE; }
    }
};
struct StoreAt {
    static constexpr bool PERM = true;
    bf16_t* O; int ldc;
    __device__ __forceinline__ void operator()(EPI_SIG) const {
        const int rb = u.tag & 0xffff, cb = u.tag >> 16;
        EPI_ROWS { bf16_t* rowp = O + (size_t)(rb * 256 + ai * 128 + wr * 64 + m * 16 + fr) * ldc + cb * 256 + wc * 32 + 8 * fq;
            EPI_BJ { *(u32x4*)(rowp + bj * 128) = pack8(acc[ai][bj][m][0], acc[ai][bj][m][1]); } EPI_FENCE; }
    }
};
struct Lora {
    static constexpr bool PERM = true;
    float* dec; bf16_t* av; bf16_t* gv; const float* w0; const float* a0;
    __device__ __forceinline__ void operator()(EPI_SIG) const {
        EPI_ROWS { const size_t row = EPI_ROW;
            EPI_BJ { const int col = bj * 128 + wc * 32 + 8 * fq; f32x4 v0 = acc[ai][bj][m][0], v1 = acc[ai][bj][m][1];
                if (u.pn == 0) {
                    const f32x4 b0 = *(const f32x4*)(w0 + col), b1 = *(const f32x4*)(w0 + col + 4);
                    for (int j = 0; j < 4; ++j) { float x = v0[j] + b0[j]; float wl = -softplusf_(-x) - 0.5f; v0[j] = fexp2(-fexp2(wl * LOG2E) * LOG2E);
                                                  x = v1[j] + b1[j]; wl = -softplusf_(-x) - 0.5f; v1[j] = fexp2(-fexp2(wl * LOG2E) * LOG2E); }
                    *(f32x4*)(dec + row * 256 + col) = v0; *(f32x4*)(dec + row * 256 + col + 4) = v1;
                } else if (u.pn == 1) {
                    const f32x4 b0 = *(const f32x4*)(a0 + col), b1 = *(const f32x4*)(a0 + col + 4);
                    for (int j = 0; j < 4; ++j) { v0[j] = sigmoidf_(v0[j] + b0[j]); v1[j] = sigmoidf_(v1[j] + b1[j]); }
                    *(u32x4*)(av + row * 256 + col) = pack8(v0, v1);
                } else { *(u32x4*)(gv + row * 256 + col) = pack8(v0, v1); } } EPI_FENCE; }
    }
};
struct Uq {
    static constexpr bool PERM = false;
    bf16_t* Q; const float* cosT; const float* sinT;
    __device__ __forceinline__ void operator()(EPI_SIG) const {
        EPI_ROWS { const size_t row = EPI_ROW;
            EPI_BJ { const int c32 = u.pn * 256 + bj * 128 + wc * 32; if (c32 >= 384) continue;
                f32x4 v0 = acc[ai][bj][m][0], v1 = acc[ai][bj][m][1];
                if ((c32 >> 5) % 3 == 2) {
                    const f32x4 cs = *(const f32x4*)(cosT + row * 16 + 4 * fq), sn = *(const f32x4*)(sinT + row * 16 + 4 * fq);
                    const f32x4 o0 = v0 * cs - v1 * sn, o1 = v0 * sn + v1 * cs; v0 = o0; v1 = o1; }
                u32x2 w0, w1; w0.x = cvt_pk_bf16(v0[0], v0[1]); w0.y = cvt_pk_bf16(v0[2], v0[3]); w1.x = cvt_pk_bf16(v1[0], v1[1]); w1.y = cvt_pk_bf16(v1[2], v1[3]);
                *(u32x2*)(Q + row * 384 + c32 + 4 * fq) = w0; *(u32x2*)(Q + row * 384 + c32 + 16 + 4 * fq) = w1; } EPI_FENCE; }
    }
};
struct Ukv {
    static constexpr bool PERM = true;
    bf16_t* Km; bf16_t* Vm;
    __device__ __forceinline__ void operator()(EPI_SIG) const {
        EPI_ROWS { const size_t row = EPI_ROW;
            EPI_BJ { const int col = u.pn * 256 + bj * 128 + wc * 32 + 8 * fq; const int h = col >> 7, j = col & 127;
                const u32x4 w = pack8(acc[ai][bj][m][0], acc[ai][bj][m][1]);
                if (j < 64) *(u32x4*)(Km + row * 384 + h * 96 + j) = w; else *(u32x4*)(Vm + row * 256 + h * 64 + (j - 64)) = w; } EPI_FENCE; }
    }
};
struct Resid {
    static constexpr bool PERM = true;
    const float* res; bf16_t* out; float ascale; const bf16_t* res16;
    __device__ __forceinline__ void operator()(EPI_SIG) const {
        const size_t off0 = (size_t)(u.pm * 256 + wr * 64 + fr) * 1024 + u.pn * 256 + wc * 32 + 8 * fq;
#define RS_OFF(i) (off0 + (size_t)((((i) >> 2) * 128 + ((i) & 3) * 16) * 1024))
        if (res16) {
            u32x4 rq[8][2];
#define RS_LOAD(i) { _Pragma("unroll") for (int bj = 0; bj < 2; ++bj) rq[i][bj] = *(const u32x4*)(res16 + RS_OFF(i) + bj * 128); }
            _Pragma("unroll") for (int i = 0; i < EPI_DEPTH; ++i) RS_LOAD(i)
            _Pragma("unroll") for (int i = 0; i < 8; ++i) { if (i + EPI_DEPTH < 8) RS_LOAD(i + EPI_DEPTH)
                _Pragma("unroll") for (int bj = 0; bj < 2; ++bj) { const u32x4 w = rq[i][bj];
                    const f32x4 r0 = (f32x4){bflo(w.x), bfhi(w.x), bflo(w.y), bfhi(w.y)}, r1 = (f32x4){bflo(w.z), bfhi(w.z), bflo(w.w), bfhi(w.w)};
                    *(u32x4*)(out + RS_OFF(i) + bj * 128) = pack8(r0 * DN_ALPHA + acc[i >> 2][bj][i & 3][0] * ascale, r1 * DN_ALPHA + acc[i >> 2][bj][i & 3][1] * ascale); } EPI_FENCE; }
#undef RS_LOAD
        } else {
            f32x4 rq[8][4];
#define RS_LOAD(i) { _Pragma("unroll") for (int q = 0; q < 4; ++q) rq[i][q] = *(const f32x4*)(res + RS_OFF(i) + (q >> 1) * 128 + (q & 1) * 4); }
            _Pragma("unroll") for (int i = 0; i < EPI_DEPTH; ++i) RS_LOAD(i)
            _Pragma("unroll") for (int i = 0; i < 8; ++i) { if (i + EPI_DEPTH < 8) RS_LOAD(i + EPI_DEPTH)
                _Pragma("unroll") for (int bj = 0; bj < 2; ++bj)
                    *(u32x4*)(out + RS_OFF(i) + bj * 128) = pack8(rq[i][2 * bj] * DN_ALPHA + acc[i >> 2][bj][i & 3][0] * ascale, rq[i][2 * bj + 1] * DN_ALPHA + acc[i >> 2][bj][i & 3][1] * ascale); EPI_FENCE; }
#undef RS_LOAD
        }
#undef RS_OFF
    }
};
struct Swiglu {
    static constexpr bool PERM = false;
    bf16_t* H; int ldh; int use_tag;
    __device__ __forceinline__ void operator()(EPI_SIG) const {
        const int pmo = use_tag ? u.tag : u.pm;
        EPI_ROWS { const size_t row = (size_t)(pmo * 256 + ai * 128 + wr * 64 + m * 16 + fr);
            EPI_BJ { const int hc = (u.pn * 256 + bj * 128 + wc * 32) / 2 + 4 * fq; const f32x4 g = acc[ai][bj][m][0], up = acc[ai][bj][m][1];
                u32x2 w; w.x = cvt_pk_bf16(siluf_(g[0]) * up[0], siluf_(g[1]) * up[1]); w.y = cvt_pk_bf16(siluf_(g[2]) * up[2], siluf_(g[3]) * up[3]);
                *(u32x2*)(H + row * ldh + hc) = w; } EPI_FENCE; }
    }
};
struct BrGate {
    static constexpr bool PERM = true;
    const bf16_t* G; float* mf; bf16_t* mb;
    __device__ __forceinline__ void operator()(EPI_SIG) const {
        const int br = u.tag;
        const size_t row0 = (size_t)(u.pm * 256 + wr * 64 + fr); const int col0 = u.pn * 256 + wc * 32 + 8 * fq;
        const bf16_t* gp = G + row0 * 4096 + br * 1024 + col0; bf16_t* pp = mb + row0 * 1024 + col0;
#define BR_ROW(i) (((i) >> 2) * 128 + ((i) & 3) * 16)
        u32x4 gq[8][2], pq[8][2];
#define BR_LOAD(i) { _Pragma("unroll") for (int bj = 0; bj < 2; ++bj) { gq[i][bj] = *(const u32x4*)(gp + (size_t)BR_ROW(i) * 4096 + bj * 128); \
            if (br > 0) pq[i][bj] = *(const u32x4*)(pp + (size_t)BR_ROW(i) * 1024 + bj * 128); else pq[i][bj] = (u32x4){0u, 0u, 0u, 0u}; } }
        _Pragma("unroll") for (int i = 0; i < EPI_DEPTH; ++i) BR_LOAD(i)
        _Pragma("unroll") for (int i = 0; i < 8; ++i) { if (i + EPI_DEPTH < 8) BR_LOAD(i + EPI_DEPTH)
            _Pragma("unroll") for (int bj = 0; bj < 2; ++bj) { const u32x4 gw = gq[i][bj], pw = pq[i][bj];
                f32x4 v0 = acc[i >> 2][bj][i & 3][0], v1 = acc[i >> 2][bj][i & 3][1];
                v0[0] = v0[0] * bflo(gw.x) + bflo(pw.x); v0[1] = v0[1] * bfhi(gw.x) + bfhi(pw.x); v0[2] = v0[2] * bflo(gw.y) + bflo(pw.y); v0[3] = v0[3] * bfhi(gw.y) + bfhi(pw.y);
                v1[0] = v1[0] * bflo(gw.z) + bflo(pw.z); v1[1] = v1[1] * bfhi(gw.z) + bfhi(pw.z); v1[2] = v1[2] * bflo(gw.w) + bflo(pw.w); v1[3] = v1[3] * bfhi(gw.w) + bfhi(pw.w);
                *(u32x4*)(pp + (size_t)BR_ROW(i) * 1024 + bj * 128) = pack8(v0, v1); } EPI_FENCE; }
#undef BR_LOAD
#undef BR_ROW
    }
};
struct BrGateH {
    static constexpr bool PERM = true;
    const bf16_t* G; bf16_t* mb; f32x4 racc[2][4][2];
    __device__ __forceinline__ void init() { _Pragma("unroll") for (int a = 0; a < 2; ++a) _Pragma("unroll") for (int m = 0; m < 4; ++m) _Pragma("unroll") for (int n = 0; n < 2; ++n) racc[a][m][n] = (f32x4){0.f, 0.f, 0.f, 0.f}; }
    __device__ __forceinline__ void operator()(f32x4 (&acc)[2][4][2], const Unit& u, int wr, int wc, int fr, int fq, int wid, int lane) {
        const int br = u.tag & 3; const unsigned col0 = (unsigned)((u.tag >> 2) * 128 + wc * 32 + 8 * fq), row0 = (unsigned)(u.pm * 256 + wr * 64 + fr);
        const char* gb = (const char*)G; const unsigned goff = (row0 * 4096u + (unsigned)br * 1024u + col0) * 2u;
        u32x4 gq[8];
        _Pragma("unroll") for (int i = 0; i < 8; ++i) gq[i] = *(const u32x4*)(gb + (size_t)(goff + (unsigned)(((i >> 2) * 128 + (i & 3) * 16) * 8192)));
        _Pragma("unroll") for (int i = 0; i < 8; ++i) { const u32x4 gw = gq[i]; const f32x4 v0 = acc[i >> 2][i & 3][0], v1 = acc[i >> 2][i & 3][1]; f32x4 r0 = racc[i >> 2][i & 3][0], r1 = racc[i >> 2][i & 3][1];
            r0[0] += v0[0] * bflo(gw.x); r0[1] += v0[1] * bfhi(gw.x); r0[2] += v0[2] * bflo(gw.y); r0[3] += v0[3] * bfhi(gw.y); r1[0] += v1[0] * bflo(gw.z); r1[1] += v1[1] * bfhi(gw.z); r1[2] += v1[2] * bflo(gw.w); r1[3] += v1[3] * bfhi(gw.w);
            racc[i >> 2][i & 3][0] = r0; racc[i >> 2][i & 3][1] = r1; }
        if (br == 3) { char* pb = (char*)mb; const unsigned poff = (row0 * 1024u + col0) * 2u;
            _Pragma("unroll") for (int i = 0; i < 8; ++i) { *(u32x4*)(pb + (size_t)(poff + (unsigned)(((i >> 2) * 128 + (i & 3) * 16) * 2048))) = pack8(racc[i >> 2][i & 3][0], racc[i >> 2][i & 3][1]);
                racc[i >> 2][i & 3][0] = (f32x4){0.f, 0.f, 0.f, 0.f}; racc[i >> 2][i & 3][1] = (f32x4){0.f, 0.f, 0.f, 0.f}; } }
    }
};
struct MoeDown {
    static constexpr bool PERM = true;
    const int* row_slot; const float* row_w; bf16_t* ys;
    __device__ __forceinline__ void operator()(EPI_SIG) const {
        int slot[8]; float w[8];
        _Pragma("unroll") for (int i = 0; i < 8; ++i) { const int r = u.tag * 256 + (i >> 2) * 128 + wr * 64 + (i & 3) * 16 + fr; slot[i] = __hip_atomic_load(row_slot + r, RLX_AGENT); w[i] = __hip_atomic_load(row_w + r, RLX_AGENT); }
        _Pragma("unroll") for (int i = 0; i < 8; ++i) {
            if (slot[i] >= 0) { EPI_BJ { const int col = u.pn * 256 + bj * 128 + wc * 32 + 8 * fq;
                *(u32x4*)(ys + (size_t)slot[i] * 1024 + col) = pack8(acc[i >> 2][bj][i & 3][0] * w[i], acc[i >> 2][bj][i & 3][1] * w[i]); } } EPI_FENCE; }
    }
};
struct Softmax {
    static constexpr bool PERM = true;
    bf16_t* P; LAS float* xch;
    __device__ __forceinline__ void operator()(EPI_SIG) const {
        EPI_ROWS { float v = -3.0e38f;
            EPI_BJ { const f32x4 a = acc[ai][bj][m][0], b = acc[ai][bj][m][1]; v = fmaxf(v, fmaxf(fmaxf(fmaxf(a[0], a[1]), fmaxf(a[2], a[3])), fmaxf(fmaxf(b[0], b[1]), fmaxf(b[2], b[3])))); }
            v = fmaxf(v, __shfl_xor(v, 16)); v = fmaxf(v, __shfl_xor(v, 32));
            if (fq == 0) xch[(ai * 128 + wr * 64 + m * 16 + fr) * 4 + wc] = v; }
        LDS_WAIT(); __builtin_amdgcn_s_barrier(); asm volatile("" ::: "memory");
        EPI_ROWS { const f32x4 q = *(const LAS f32x4*)(xch + (ai * 128 + wr * 64 + m * 16 + fr) * 4);
            const float mm = fmaxf(fmaxf(q[0], q[1]), fmaxf(q[2], q[3])); float s = 0.f;
            EPI_BJ { _Pragma("unroll") for (int n = 0; n < 2; ++n) { f32x4 t = acc[ai][bj][m][n]; for (int j = 0; j < 4; ++j) { t[j] = fexp2(t[j] - mm); s += t[j]; } acc[ai][bj][m][n] = t; } }
            s += __shfl_xor(s, 16); s += __shfl_xor(s, 32);
            if (fq == 0) xch[1024 + (ai * 128 + wr * 64 + m * 16 + fr) * 4 + wc] = s; }
        LDS_WAIT(); __builtin_amdgcn_s_barrier(); asm volatile("" ::: "memory");
        EPI_ROWS { const f32x4 q = *(const LAS f32x4*)(xch + 1024 + (ai * 128 + wr * 64 + m * 16 + fr) * 4);
            const float inv = frcp((q[0] + q[1]) + (q[2] + q[3]));
            bf16_t* rowp = P + (size_t)EPI_ROW * 1024 + u.tag * 256 + wc * 32 + 8 * fq;
            EPI_BJ { *(u32x4*)(rowp + bj * 128) = pack8(acc[ai][bj][m][0] * inv, acc[ai][bj][m][1] * inv); } EPI_FENCE; }
        LDS_WAIT(); __builtin_amdgcn_s_barrier(); asm volatile("" ::: "memory");
    }
};
}
struct Args { const float* in[42]; float* out; unsigned char* ws; int ph_lo, ph_hi; };
struct Ctx {
    const float* const* in; float* out; unsigned char* ws; LAS unsigned char* lds;
    int tid, lane, wave, G, bid;
};
enum { I_X = 0, I_MEM, I_POS, I_WIN, I_RWMU, I_RWW0, I_RWWUP, I_RWA0, I_RWAUP, I_RWGUP, I_RWKK, I_RWKA, I_RWRK, I_RWGNG, I_RWGNB,
       I_CONVW, I_CONVB, I_DTB, I_ALOG, I_SSDD, I_SSDNG, I_QNG, I_WUQ, I_KVNG, I_WUKV, I_WBR, I_WGATE, I_WOUT, I_LN1G, I_LN1B,
       I_XWQ, I_XWKV, I_XWO, I_LN2G, I_LN2B, I_FFN13, I_FFN2, I_ROUTER, I_MOE13, I_MOE2, I_LN3G, I_LN3B };
__device__ __forceinline__ Ctx launder(const Ctx& C0) {
    Ctx L = C0; unsigned zo_ = 0u; int t_ = threadIdx.x;
    asm volatile("" : "+s"(zo_), "+v"(t_));
    L.out = C0.out + zo_; L.ws = C0.ws + zo_; L.tid = t_; L.lane = t_ & 63; L.wave = __builtin_amdgcn_readfirstlane(t_ >> 6); return L;
}
#define WSP(T_, off) ((T_*)(C.ws + (off)))
#define GW (C.bid * NWAVES + C.wave)
#define NGW (C.G * NWAVES)

struct TJob { const float* W; int ldw, K, N; bf16_t* WT; int ldt; int map; float scale; int items; };
__device__ __forceinline__ int tj_items(int K, int N) { return (K / 64) * ((N + 31) / 32); }
__device__ __forceinline__ int tj_dest(int map, int n, int N) {
    if (map == 0) return n;
    if (map == 1) return n < 2816 ? n : (n < 2820 ? PC_DT + (n - 2816) : n - 4);
    const int half = N >> 1, j = n < half ? n : n - half;
    return (j >> 4) * 32 + (j & 15) + (n < half ? 0 : 16);
}
__device__ __forceinline__ void t_load(const TJob& J, int item, int lane, float (&v)[32], unsigned var = 0u) {
    const int nblk = (J.N + 31) / 32, kb = item / nblk, nb = item % nblk, k0 = 64 * kb, n0 = 32 * nb;
    const int nn = n0 + (lane & 31); const bool okn = nn < J.N; const float* src = J.W + (size_t)(k0 + (lane >> 5)) * J.ldw + nn;
#pragma unroll
    for (int i = 0; i < 32; ++i) v[i] = (okn && !(var & 8u)) ? src[(size_t)(2 * i) * J.ldw] : 0.f;
}
__device__ __forceinline__ void t_commit(const TJob& J, LAS float* scr, int item, int lane, const float (&v)[32], unsigned var = 0u) {
    const int nblk = (J.N + 31) / 32, kb = item / nblk, nb = item % nblk, k0 = 64 * kb, n0 = 32 * nb;
#pragma unroll
    for (int i = 0; i < 32; ++i) scr[(2 * i + (lane >> 5)) * 33 + (lane & 31)] = v[i];
    LDS_WAIT(); asm volatile("" ::: "memory");
    const int c = lane & 7;
#pragma unroll
    for (int j = 0; j < 4; ++j) { const int nl = (lane >> 3) + 8 * j, n = n0 + nl;
        if (n < J.N && !(var & 4u)) { const LAS float* s = scr + (8 * c) * 33 + nl; const float sc = (J.map == 1 && n >= 256) ? 1.0f : J.scale;
            u32x4 o; o.x = cvt_pk_bf16(s[0 * 33] * sc, s[1 * 33] * sc); o.y = cvt_pk_bf16(s[2 * 33] * sc, s[3 * 33] * sc); o.z = cvt_pk_bf16(s[4 * 33] * sc, s[5 * 33] * sc); o.w = cvt_pk_bf16(s[6 * 33] * sc, s[7 * 33] * sc);
            *(u32x4*)(J.WT + (size_t)tj_dest(J.map, n, J.N) * J.ldt + k0 + 8 * c) = o; } }
    LDS_WAIT(); asm volatile("" ::: "memory");
}
__device__ __forceinline__ TJob mkjob(const float* W, int ldw, int K, int N, bf16_t* WT, int ldt, int map, float scale) { TJob j; j.W = W; j.ldw = ldw; j.K = K; j.N = N; j.WT = WT; j.ldt = ldt; j.map = map; j.scale = scale; j.items = tj_items(K, N); return j; }

__device__ __forceinline__ TJob prologue_job(const Ctx& C, int j) {
    if (j < 26) { const int l = j / 13, r = j % 13; unsigned char* LW = C.ws + W_BASE + (size_t)l * LW_SIZE;
        if (r == 0) return mkjob(C.in[I_WIN] + (size_t)l * 1024 * 3236, 3236, 1024, 3236, (bf16_t*)(LW + LW_WIN), 1024, 1, 0.125f * LOG2E);
        if (r < 5) { const int i = r - 1; return mkjob(C.in[I_WGATE] + ((size_t)l * 4 + i) * 1024 * 1024, 1024, 1024, 1024, (bf16_t*)(LW + LW_WGATE) + (size_t)i * 1024 * 1024, 1024, 0, 1.f); }
        if (r < 9) { const int i = r - 5; return mkjob(C.in[I_WBR] + ((size_t)l * 4 + i) * 256 * 1024, 1024, 256, 1024, (bf16_t*)(LW + LW_WBR) + (size_t)i * 1024 * 256, 256, 0, 1.f); }
        if (r == 9) return mkjob(C.in[I_WOUT] + (size_t)l * 1024 * 1024, 1024, 1024, 1024, (bf16_t*)(LW + LW_WOUT), 1024, 0, 1.f);
        if (r == 10) return mkjob(C.in[I_XWQ], 1024, 0, 1024, (bf16_t*)(LW + LW_WQ), 1024, 0, 1.f);
        if (r == 11) return mkjob(C.in[I_XWKV] + (size_t)l * 1024 * 2048, 2048, 1024, 2048, (bf16_t*)(LW + LW_WKV), 1024, 0, 1.f);
        return mkjob(C.in[I_XWO] + (size_t)l * 1024 * 1024, 1024, 1024, 1024, (bf16_t*)(LW + LW_WO), 1024, 0, 1.f);
    }
    if (j == 26) return mkjob(C.in[I_FFN13], 2 * FFD, 1024, 2 * FFD, WSP(bf16_t, W_FFN13), 1024, 2, 1.f);
    return mkjob(C.in[I_FFN2], 1024, FFD, 1024, WSP(bf16_t, W_FFN2), FFD, 0, 1.f);
}
__device__ __forceinline__ TJob moe_job(const Ctx& C, int j) {
    if (j < 8) return mkjob(C.in[I_MOE13] + (size_t)j * 1024 * 2 * FFE, 2 * FFE, 1024, 2 * FFE, (bf16_t*)C.out + (size_t)j * 2 * FFE * 1024, 1024, 2, 1.f);
    const int e = j - 8; return mkjob(C.in[I_MOE2] + (size_t)e * FFE * 1024, 1024, FFE, 1024, WSP(bf16_t, W_MW2) + (size_t)e * 1024 * FFE, FFE, 0, 1.f);
}
template <int L> __device__ __forceinline__ TJob mix_job(const Ctx& C, int j) {
    if (L == 0) { if (j < 15) return prologue_job(C, 13 + j); const int m = j - 15; return moe_job(C, m < 4 ? m : 8 + (m - 4)); }
    return moe_job(C, j < 4 ? 4 + j : 12 + (j - 4));
}
constexpr int MIXJ0 = 23, MIXJ1 = 8;
__device__ __forceinline__ void t_load4(const TJob& J, int item, int lane, f32x4 (&v)[8], unsigned var = 0u) {
    const int nblk = (J.N + 31) / 32, kb = item / nblk, nb = item % nblk, k0 = 64 * kb, n0 = 32 * nb;
    const int nn = n0 + 4 * (lane & 7); const bool okn = nn < J.N && !(var & 8u); const float* src = J.W + (size_t)(k0 + (lane >> 3)) * J.ldw + nn;
#pragma unroll
    for (int i = 0; i < 8; ++i) v[i] = okn ? *(const f32x4*)(src + (size_t)(8 * i) * J.ldw) : (f32x4){0.f, 0.f, 0.f, 0.f};
}
__device__ __forceinline__ void t_commit4(const TJob& J, LAS float* scr, int item, int lane, const f32x4 (&v)[8], unsigned var = 0u) {
    const int nblk = (J.N + 31) / 32, kb = item / nblk, nb = item % nblk, k0 = 64 * kb, n0 = 32 * nb;
    LAS float* wp = scr + (4 * (lane & 7)) * 65 + (lane >> 3);
#pragma unroll
    for (int i = 0; i < 8; ++i) { wp[0 * 65 + 8 * i] = v[i][0]; wp[1 * 65 + 8 * i] = v[i][1]; wp[2 * 65 + 8 * i] = v[i][2]; wp[3 * 65 + 8 * i] = v[i][3]; }
    LDS_WAIT(); asm volatile("" ::: "memory");
    const int c = lane & 7;
#pragma unroll
    for (int j = 0; j < 4; ++j) { const int nl = (lane >> 3) + 8 * j, n = n0 + nl;
        if (n < J.N && !(var & 4u)) { const LAS float* s = scr + nl * 65 + 8 * c; const float sc = (J.map == 1 && n >= 256) ? 1.0f : J.scale;
            u32x4 o; o.x = cvt_pk_bf16(s[0] * sc, s[1] * sc); o.y = cvt_pk_bf16(s[2] * sc, s[3] * sc); o.z = cvt_pk_bf16(s[4] * sc, s[5] * sc); o.w = cvt_pk_bf16(s[6] * sc, s[7] * sc);
            *(u32x4*)(J.WT + (size_t)tj_dest(J.map, n, J.N) * J.ldt + k0 + 8 * c) = o; } }
    LDS_WAIT(); asm volatile("" ::: "memory");
}
template <int NJ, int SEL> __device__ __forceinline__ TJob sel_job(const Ctx& C, int j) { if (SEL == 0) return prologue_job(C, j); if (SEL == 1) return moe_job(C, j); if (SEL == 2) return mix_job<0>(C, j); return mix_job<1>(C, j); }
template <int NJ, int SEL> __device__ __forceinline__ int tjobs_total(const Ctx& C) { int total = 0; for (int j = 0; j < NJ; ++j) total += sel_job<NJ, SEL>(C, j).items; return total; }
template <int NJ, int SEL> __device__ __forceinline__ void run_tjobs_range(const Ctx& C, int it0, int stride, int it_end, unsigned var = 0u) {
    LAS float* scr = (LAS float*)(C.lds + C.wave * 16384);
    int j = 0, jbase = 0, it = it0; TJob J = sel_job<NJ, SEL>(C, 0);
    auto next = [&](TJob& Jo, int& io) -> bool { if (it >= it_end) return false;
        while (it >= jbase + J.items) { jbase += J.items; ++j; J = sel_job<NJ, SEL>(C, j); }
        Jo = J; io = it - jbase; it += stride; return true; };
    TJob Ja, Jb, Jc; int ia = 0, ib = 0, ic = 0; f32x4 va[8], vb[8], vc[8];
    bool ha = next(Ja, ia); if (!ha) return; t_load4(Ja, ia, C.lane, va, var);
    bool hb = next(Jb, ib); if (hb) t_load4(Jb, ib, C.lane, vb, var);
    for (;;) {
        bool hc = next(Jc, ic); if (hc) t_load4(Jc, ic, C.lane, vc, var);
        t_commit4(Ja, scr, ia, C.lane, va, var); if (!hb) break;
        ha = next(Ja, ia); if (ha) t_load4(Ja, ia, C.lane, va, var);
        t_commit4(Jb, scr, ib, C.lane, vb, var); if (!hc) break;
        hb = next(Jb, ib); if (hb) t_load4(Jb, ib, C.lane, vb, var);
        t_commit4(Jc, scr, ic, C.lane, vc, var); if (!ha) break;
    }
}
template <int NJ, bool MOE> __device__ __forceinline__ void run_tjobs(const Ctx& C, unsigned var = 0u) { run_tjobs_range<NJ, MOE ? 1 : 0>(C, GW, NGW, tjobs_total<NJ, MOE ? 1 : 0>(C), var); }


constexpr int CW_CHK = 32768;
template <class OutF> __device__ __forceinline__ void chk_gemm(const Ctx& C, const bf16_t* A, int lda, const bf16_t* Bt, int ldb, int K, int nrows, int ncs, int cstride, int c0, int bit, OutF expect_vs_got) {
    unsigned bad = 0; const int lane = C.lane;
    for (int it = GW; it < nrows * ncs; it += NGW) {
        const int r = it / ncs, c = c0 + (it % ncs) * cstride; float d = 0.f;
        for (int k = lane * 8; k < K; k += 512) { const u32x4 a = *(const u32x4*)(A + (size_t)r * lda + k), b = *(const u32x4*)(Bt + (size_t)c * ldb + k);
            d += bflo(a.x) * bflo(b.x) + bfhi(a.x) * bfhi(b.x) + bflo(a.y) * bflo(b.y) + bfhi(a.y) * bfhi(b.y) + bflo(a.z) * bflo(b.z) + bfhi(a.z) * bfhi(b.z) + bflo(a.w) * bflo(b.w) + bfhi(a.w) * bfhi(b.w); }
        d = wave_sum(d);
        if (!expect_vs_got(r, c, d)) bad = 1;
    }
    if (lane == 0 && bad) __hip_atomic_fetch_add((unsigned*)(C.ws + WS_CTL) + CW_CHK + 64 * bit, 1u, RLX_AGENT);
}
__device__ __forceinline__ bool chk_close(float e, float g) { return fabsf(e - g) <= 0.03f * fabsf(e) + 0.03f; }

__device__ __forceinline__ float chk_dot(const bf16_t* a, const bf16_t* b, int K, int lane) {
    float d = 0.f;
    for (int k = lane * 8; k < K; k += 512) { const u32x4 x = *(const u32x4*)(a + k), y = *(const u32x4*)(b + k);
        d += bflo(x.x) * bflo(y.x) + bfhi(x.x) * bfhi(y.x) + bflo(x.y) * bflo(y.y) + bfhi(x.y) * bfhi(y.y) + bflo(x.z) * bflo(y.z) + bfhi(x.z) * bfhi(y.z) + bflo(x.w) * bflo(y.w) + bfhi(x.w) * bfhi(y.w); }
    return wave_sum(d);
}
__device__ __forceinline__ void chk_flag(const Ctx& C, int bit, unsigned bad) { if (C.lane == 0 && bad) __hip_atomic_fetch_add((unsigned*)(C.ws + WS_CTL) + CW_CHK + 64 * bit, 1u, RLX_AGENT); }
__device__ __forceinline__ void chk_merged(const Ctx& C, int l, int bit) {
    const bf16_t* Y = WSP(bf16_t, S_Y); const bf16_t* G = WSP(bf16_t, S_G); const bf16_t* MB = WSP(bf16_t, S_MB); const bf16_t* WBR = (const bf16_t*)(C.ws + W_BASE + (size_t)l * LW_SIZE + LW_WBR); unsigned bad = 0;
    for (int it = GW; it < T * 4; it += NGW) { const int r = it >> 2, c = 13 + 256 * (it & 3); float e = 0.f;
        for (int i = 0; i < 4; ++i) e += bf2f(G[(size_t)r * 4096 + i * 1024 + c]) * chk_dot(Y + (size_t)r * 1024 + 256 * i, WBR + ((size_t)i * 1024 + c) * 256, 256, C.lane);
        if (!chk_close(e, bf2f(MB[(size_t)r * 1024 + c]))) bad = 1; }
    chk_flag(C, bit, bad);
}
__device__ __forceinline__ void chk_swiglu(const Ctx& C, int bit) {
    const bf16_t* XB = WSP(bf16_t, W_XB); const bf16_t* W = WSP(bf16_t, W_FFN13); const bf16_t* H = WSP(bf16_t, S_H); unsigned bad = 0;
    for (int it = GW; it < T * 22; it += NGW) { const int r = it / 22, hc = 5 + 128 * (it % 22); const int grow = (hc >> 4) * 32 + (hc & 15);
        const float g = chk_dot(XB + (size_t)r * 1024, W + (size_t)grow * 1024, 1024, C.lane), u = chk_dot(XB + (size_t)r * 1024, W + (size_t)(grow + 16) * 1024, 1024, C.lane);
        if (!chk_close(siluf_(g) * u, bf2f(H[(size_t)r * FFD + hc]))) bad = 1; }
    chk_flag(C, bit, bad);
}

constexpr size_t S_CHKBUF = S_BASE + (size_t)400 * MiB;
__device__ __forceinline__ void chk_resid_stash(const Ctx& C, const bf16_t* A, int lda, const bf16_t* Bt, int ldb, int K, int slot) {
    const float* XR = WSP(float, W_XRES); float* CB = WSP(float, S_CHKBUF);
    for (int it = GW; it < T * 4; it += NGW) { const int r = it >> 2, q = it & 3, c = 17 + 256 * q; const float d = chk_dot(A + (size_t)r * lda, Bt + (size_t)c * ldb, K, C.lane);
        if (C.lane == 0) CB[(size_t)r * 8 + slot * 4 + q] = XR[(size_t)r * 1024 + c] * DN_ALPHA + d; }
}
__device__ __forceinline__ void chk_resid_cmp(const Ctx& C, int slot, int bit) {
    const float* XR = WSP(float, W_XRES); const float* CB = WSP(float, S_CHKBUF); unsigned bad = 0;
    for (int it = GW; it < T * 4; it += NGW) { const int r = it >> 2, q = it & 3, c = 17 + 256 * q; if (!chk_close(CB[(size_t)r * 8 + slot * 4 + q], XR[(size_t)r * 1024 + c])) bad = 1; }
    chk_flag(C, bit, bad);
}
__device__ __forceinline__ void chk_ln_stash(const Ctx& C, const float* g, const float* b, int slot) {
    const float* XR = WSP(float, W_XRES); float* CB = WSP(float, S_CHKBUF); const int lane = C.lane;
    for (int t = GW; t < T; t += NGW) { float s = 0.f, s2 = 0.f; float v[16];
        for (int j = 0; j < 16; ++j) { v[j] = XR[(size_t)t * 1024 + lane + 64 * j]; s += v[j]; }
        const float mean = wave_sum(s) * (1.0f / 1024.0f); for (int j = 0; j < 16; ++j) { const float d = v[j] - mean; s2 += d * d; }
        const float rstd = 1.0f / sqrtf(wave_sum(s2) * (1.0f / 1024.0f) + 1e-5f);
        if (lane < 4) { const int c = 17 + 256 * lane; CB[(size_t)t * 8 + slot * 4 + lane] = (XR[(size_t)t * 1024 + c] - mean) * rstd * g[c] + b[c]; } }
}
__device__ __forceinline__ void chk_ln_cmp(const Ctx& C, int slot, int bit) {
    const float* XR = WSP(float, W_XRES); const bf16_t* XB = WSP(bf16_t, W_XB); const float* CB = WSP(float, S_CHKBUF); unsigned bad = 0;
    for (int it = GW; it < T * 4; it += NGW) { const int r = it >> 2, q = it & 3, c = 17 + 256 * q; const float e = CB[(size_t)r * 8 + slot * 4 + q];
        if (!chk_close(e, XR[(size_t)r * 1024 + c]) || !chk_close(e, bf2f(XB[(size_t)r * 1024 + c]))) bad = 1; }
    chk_flag(C, bit, bad);
}

template <int NJ, bool MOE> __device__ __forceinline__ void chk_weights(const Ctx& C, int bit) {
    unsigned bad = 0; const int gt = C.bid * NTHREADS + C.tid, NT = C.G * NTHREADS;
    for (int j = 0; j < NJ; ++j) { const TJob J = MOE ? moe_job(C, j) : prologue_job(C, j);
        for (size_t i = gt; i < (size_t)J.K * J.N; i += NT) { const int k = (int)(i / J.N), n = (int)(i % J.N);
            const float sc = (J.map == 1 && n >= 256) ? 1.0f : J.scale; const bf16_t e = (bf16_t)(cvt_pk_bf16(J.W[(size_t)k * J.ldw + n] * sc, 0.f) & 0xffffu);
            if (J.WT[(size_t)tj_dest(J.map, n, J.N) * J.ldt + k] != e) bad = 1; } }
    if (bad) __hip_atomic_fetch_add((unsigned*)(C.ws + WS_CTL) + CW_CHK + 64 * bit, 1u, RLX_AGENT);
}

__device__ __forceinline__ void chk_mla_inputs(const Ctx& C, int l, int bit) {
    const bf16_t* proj = WSP(bf16_t, S_PROJ); const bf16_t* QM = WSP(bf16_t, S_QM); const bf16_t* KM = WSP(bf16_t, S_KM); const bf16_t* VM = WSP(bf16_t, S_VM);
    const float* wuq = C.in[I_WUQ] + (size_t)l * 256 * 384; const float* wukv = C.in[I_WUKV] + (size_t)l * 128 * 512; const float* qg = C.in[I_QNG] + l * 256; const float* kvg = C.in[I_KVNG] + l * 128;
    const int* pos = (const int*)C.in[I_POS]; const int lane = C.lane; unsigned bad = 0; const float qs = 0.10206207261596575f * LOG2E;
    for (int t = GW; t < T; t += NGW) {
        const bf16_t* pr = proj + (size_t)t * NPROJ; float cq[4], ck[2]; float ss = 0.f;
        for (int i = 0; i < 4; ++i) { cq[i] = bf2f(pr[PC_CQ + lane + 64 * i]); ss += cq[i] * cq[i]; }
        float rs = 1.0f / sqrtf(wave_sum(ss) * (1.0f / 256.0f) + 1e-6f); for (int i = 0; i < 4; ++i) cq[i] *= rs * qg[lane + 64 * i];
        ss = 0.f; for (int i = 0; i < 2; ++i) { ck[i] = bf2f(pr[PC_CKV + lane + 64 * i]); ss += ck[i] * ck[i]; }
        rs = 1.0f / sqrtf(wave_sum(ss) * (1.0f / 128.0f) + 1e-6f); for (int i = 0; i < 2; ++i) ck[i] *= rs * kvg[lane + 64 * i];
        const float ang = (float)pos[t] * exp2f(-6.0f * (13.287712379549449f / 32.0f)); const float c3 = cosf(ang), s3 = sinf(ang);
        const int h = t & 3;
        float qn = 0.f, q1 = 0.f, q2 = 0.f, kn = 0.f, vv = 0.f;
        for (int i = 0; i < 4; ++i) { const int k = lane + 64 * i; qn += cq[i] * wuq[(size_t)k * 384 + h * 96 + 5]; q1 += cq[i] * wuq[(size_t)k * 384 + h * 96 + 67]; q2 += cq[i] * wuq[(size_t)k * 384 + h * 96 + 83]; }
        for (int i = 0; i < 2; ++i) { const int k = lane + 64 * i; kn += ck[i] * wukv[(size_t)k * 512 + h * 128 + 7]; vv += ck[i] * wukv[(size_t)k * 512 + h * 128 + 64 + 9]; }
        qn = wave_sum(qn) * qs; q1 = wave_sum(q1) * qs; q2 = wave_sum(q2) * qs; kn = wave_sum(kn); vv = wave_sum(vv);
        const float kr1 = bf2f(pr[PC_KR + 3]), kr2 = bf2f(pr[PC_KR + 19]);
        const bf16_t* qrow = QM + (size_t)t * 384 + h * 96; const bf16_t* krow = KM + (size_t)t * 384 + h * 96;
        if (!chk_close(qn, bf2f(qrow[5])) || !chk_close(q1 * c3 - q2 * s3, bf2f(qrow[67])) || !chk_close(q1 * s3 + q2 * c3, bf2f(qrow[83])) || !chk_close(kn, bf2f(krow[7])) ||
            !chk_close(kr1 * c3 - kr2 * s3, bf2f(krow[67])) || !chk_close(kr1 * s3 + kr2 * c3, bf2f(krow[83])) || !chk_close(vv, bf2f(VM[(size_t)t * 256 + h * 64 + 9]))) bad = 1;
    }
    chk_flag(C, bit, bad);
}

__device__ __forceinline__ void chk_rw_inputs(const Ctx& C, int l, int bit) {
    const bf16_t* proj = WSP(bf16_t, S_PROJ); const float* DEC = WSP(float, S_DEC); const bf16_t* RWS = WSP(bf16_t, S_RWS); const bf16_t* GV = WSP(bf16_t, S_GV); const size_t PL = (size_t)T * 256;
    const float* mu = C.in[I_RWMU] + l * 1024; const float* w0 = C.in[I_RWW0] + l * 256; const float* a0 = C.in[I_RWA0] + l * 256;
    const float* wup = C.in[I_RWWUP] + l * 64 * 256; const float* aup = C.in[I_RWAUP] + l * 64 * 256; const float* gup = C.in[I_RWGUP] + l * 128 * 256;
    const float* kkw = C.in[I_RWKK] + l * 256; const float* kaw = C.in[I_RWKA] + l * 256; const int lane = C.lane; unsigned bad = 0;
    for (int t = GW; t < T; t += NGW) {
        const bf16_t* pr = proj + (size_t)t * NPROJ + PC_RW; const bool first = (t % SEQ) == 0; const int h = t & 3, c = h * 64 + 11;
        auto sh = [&](int col) { const float cur = bf2f(pr[col]); const float prv = first ? 0.f : bf2f(pr[col - NPROJ]); return cur + (prv - cur) * mu[col]; };
        float dw = tanhf(sh(768 + lane)) * wup[lane * 256 + c], da = sh(832 + lane) * aup[lane * 256 + c];
        float dg = (1.0f / (1.0f + expf(-sh(896 + lane)))) * gup[lane * 256 + c] + (1.0f / (1.0f + expf(-sh(960 + lane)))) * gup[(64 + lane) * 256 + c];
        dw = wave_sum(dw); da = wave_sum(da); dg = wave_sum(dg);
        const float xw = w0[c] + dw; const float wlog = -(fmaxf(-xw, 0.f) + log1pf(expf(-fabsf(xw)))) - 0.5f; const float dec = expf(-expf(wlog));
        const float a = 1.0f / (1.0f + expf(-(a0[c] + da)));
        const float kl = sh(256 + h * 64 + lane) * kkw[h * 64 + lane]; const float nrm = 1.0f / sqrtf(fmaxf(wave_sum(kl * kl), 1e-24f));
        const float r = sh(c), k = sh(256 + c), v = sh(512 + c); const float kk = k * kkw[c] * nrm, kmod = k * (1.0f + (a - 1.0f) * kaw[c]), ka = kk * a;
        const size_t o = (size_t)t * 256 + c;
        if (!chk_close(dec, DEC[o]) || fabsf(dec - DEC[o]) > 0.004f || !chk_close(r, bf2f(RWS[o])) || !chk_close(kmod, bf2f(RWS[PL + o])) || !chk_close(v, bf2f(RWS[2 * PL + o])) || !chk_close(kk, bf2f(RWS[3 * PL + o])) ||
            !chk_close(ka, bf2f(RWS[4 * PL + o])) || !chk_close(dg, bf2f(GV[o]))) bad = 1;
    }
    chk_flag(C, bit, bad);
}
__device__ __forceinline__ void chk_ssd_norm(const Ctx& C, int l, int bit) {
    const bf16_t* Y = WSP(bf16_t, S_Y); const float* ng = C.in[I_SSDNG] + l * 256; const int lane = C.lane; unsigned bad = 0;
    for (int t = GW; t < T; t += NGW) { float q = 0.f;
        for (int i = 0; i < 4; ++i) { const int c = (lane >> 5) * 128 + (lane & 31) * 4 + i; const float y = bf2f(Y[(size_t)t * 1024 + 512 + c]) / ng[c]; q += y * y; }
        for (int o_ = 1; o_ < 32; o_ <<= 1) q += __shfl_xor(q, o_);
        q *= (1.0f / 128.0f); if (q < 0.9f || q > 1.1f) bad = 1; }
    chk_flag(C, bit, bad);
}

#ifndef P7_COND
#define P7_COND 1
#endif
#ifndef P7_CLASS
#define P7_CLASS (((c & 31) < 16 ? 1u : 2u) | ((c & 255) < 128 ? 4u : 8u))
#endif
__device__ __forceinline__ float tdot(const bf16_t* a, const bf16_t* b, int K) { float d = 0.f;
    for (int k = 0; k < K; k += 8) { const u32x4 x = *(const u32x4*)(a + k), y = *(const u32x4*)(b + k);
        d += bflo(x.x) * bflo(y.x) + bfhi(x.x) * bfhi(y.x) + bflo(x.y) * bflo(y.y) + bfhi(x.y) * bfhi(y.y) + bflo(x.z) * bflo(y.z) + bfhi(x.z) * bfhi(y.z) + bflo(x.w) * bflo(y.w) + bfhi(x.w) * bfhi(y.w); }
    return d; }
__device__ __forceinline__ void chk_full_p7(const Ctx& C, int l, int bit) {
    const bf16_t* MB = WSP(bf16_t, S_MB); const bf16_t* W = (const bf16_t*)(C.ws + W_BASE + (size_t)l * LW_SIZE + LW_WOUT); const float* xin = C.in[I_X]; const float* XR = WSP(float, W_XRES); float num = 0.f, den = 0.f;
    for (size_t i = (size_t)C.bid * NTHREADS + C.tid; i < (size_t)T * 1024; i += (size_t)C.G * NTHREADS) { const size_t r = i >> 10; const int c = (int)(i & 1023);
        const float d = tdot(MB + r * 1024, W + (size_t)c * 1024, 1024), g = XR[i] - xin[i] * DN_ALPHA; num += (d - g) * (d - g); den += d * d; }
    num = wave_sum(num); den = wave_sum(den);
    if (C.lane == 0) { atomicAdd((float*)(C.ws + WS_CTL) + CW_CHK + 1024, num); atomicAdd((float*)(C.ws + WS_CTL) + CW_CHK + 1088, den); }
}
__device__ __forceinline__ void chk_full_merged(const Ctx& C, int l, int bit) {
    const bf16_t* Y = WSP(bf16_t, S_Y); const bf16_t* G = WSP(bf16_t, S_G); const bf16_t* MB = WSP(bf16_t, S_MB); const bf16_t* WBR = (const bf16_t*)(C.ws + W_BASE + (size_t)l * LW_SIZE + LW_WBR); unsigned bad = 0;
    for (size_t i = (size_t)C.bid * NTHREADS + C.tid; i < (size_t)T * 1024; i += (size_t)C.G * NTHREADS) { const size_t r = i >> 10; const int c = (int)(i & 1023); float e = 0.f;
        for (int q = 0; q < 4; ++q) e += bf2f(G[r * 4096 + q * 1024 + c]) * tdot(Y + r * 1024 + 256 * q, WBR + ((size_t)q * 1024 + c) * 256, 256);
        if (!chk_close(e, bf2f(MB[i]))) bad = 1; }
    if (bad) __hip_atomic_fetch_add((unsigned*)(C.ws + WS_CTL) + CW_CHK + 64 * bit, 1u, RLX_AGENT);
}

#ifndef FG_CLASS
#define FG_CLASS (1u << ((c >> 5) & 3))
#endif
template <class F> __device__ __forceinline__ void chk_full_gemm(const Ctx& C, const bf16_t* A, const bf16_t* Bt, int K, int N, int bit, F ok) {
    unsigned bad = 0, cntbad = 0;
    for (size_t i = (size_t)C.bid * NTHREADS + C.tid; i < (size_t)T * N; i += (size_t)C.G * NTHREADS) { const size_t r = i / N; const int c = (int)(i % N);
        if (!ok(r, c, tdot(A + r * K, Bt + (size_t)c * K, K))) { bad |= (bit < 0) ? (FG_CLASS) : (1u << bit); ++cntbad; } }
#ifdef FG_COUNT
    if (cntbad) __hip_atomic_fetch_add((unsigned*)(C.ws + WS_CTL) + CW_CHK + 2048, cntbad, RLX_AGENT);
#else
    for (int q = 0; q < 4; ++q) if ((bad >> q) & 1) __hip_atomic_fetch_add((unsigned*)(C.ws + WS_CTL) + CW_CHK + 64 * q, 1u, RLX_AGENT);
#endif
}
__device__ __forceinline__ void ph_prologue(const Ctx& C) {
    run_tjobs<13, false>(C);
    const int gt = C.bid * NTHREADS + C.tid, NT = C.G * NTHREADS;
    for (int l = 0; l < 2; ++l) {
        unsigned char* LW = C.ws + W_BASE + (size_t)l * LW_SIZE;
        bf16_t* lora = (bf16_t*)(LW + LW_LORA); const float* wup = C.in[I_RWWUP] + l * 64 * 256; const float* aup = C.in[I_RWAUP] + l * 64 * 256; const float* gup = C.in[I_RWGUP] + l * 128 * 256;
        for (int i = gt; i < 768 * 256; i += NT) { const int n = i >> 8, k = i & 255; float v = 0.f;
            if (n < 256) { if (k < 64) v = wup[k * 256 + n]; } else if (n < 512) { if (k >= 64 && k < 128) v = aup[(k - 64) * 256 + (n - 256)]; } else { if (k >= 128) v = gup[(k - 128) * 256 + (n - 512)]; }
            lora[i] = (bf16_t)(cvt_pk_bf16(v, 0.f) & 0xffffu); }
        bf16_t* wuq = (bf16_t*)(LW + LW_WUQ); const float* suq = C.in[I_WUQ] + l * 256 * 384;
        for (int i = gt; i < 512 * 256; i += NT) { const int n = i >> 8, k = i & 255; const float v = n < 384 ? suq[k * 384 + n] * (0.10206207261596575f * LOG2E) : 0.f; wuq[i] = (bf16_t)(cvt_pk_bf16(v, 0.f) & 0xffffu); }
        bf16_t* wukv = (bf16_t*)(LW + LW_WUKV); const float* sukv = C.in[I_WUKV] + l * 128 * 512;
        for (int i = gt; i < 512 * 128; i += NT) { const int n = i >> 7, k = i & 127; wukv[i] = (bf16_t)(cvt_pk_bf16(sukv[k * 512 + n], 0.f) & 0xffffu); }
        { const float* wq = C.in[I_XWQ] + (size_t)l * 1024 * 1024; bf16_t* wqp = (bf16_t*)(LW + LW_WQ);
          for (size_t i = gt; i < (size_t)1024 * 1024 / 8; i += NT) { const f32x4 a = *(const f32x4*)(wq + i * 8) * (0.0625f * LOG2E), b = *(const f32x4*)(wq + i * 8 + 4) * (0.0625f * LOG2E); *(u32x4*)(wqp + i * 8) = epi::pack8(a, b); } }
        bf16_t* win = (bf16_t*)(LW + LW_WIN);
        for (int i = gt; i < (NPROJ - 3236) * 1024; i += NT) win[(size_t)3236 * 1024 + i] = 0;
    }
    { const float* x = C.in[I_X]; bf16_t* xb = WSP(bf16_t, W_XB);
#pragma unroll 4
      for (size_t i = gt; i < (size_t)T * 1024 / 8; i += NT) { const f32x4 a = *(const f32x4*)(x + i * 8), b = *(const f32x4*)(x + i * 8 + 4); *(u32x4*)(xb + i * 8) = epi::pack8(a, b); }
      const float* mm = C.in[I_MEM]; bf16_t* mb = WSP(bf16_t, W_MEMB);
      for (size_t i = gt; i < (size_t)NMEM * 1024 / 8; i += NT) { const f32x4 a = *(const f32x4*)(mm + i * 8), b = *(const f32x4*)(mm + i * 8 + 4); *(u32x4*)(mb + i * 8) = epi::pack8(a, b); } }
    { const int* pos = (const int*)C.in[I_POS]; float* ct = WSP(float, W_COS); float* st = WSP(float, W_SIN);
      for (int i = gt; i < T * 16; i += NT) { const int t = i >> 4, j = i & 15; const float inv = exp2f(-(float)(2 * j) * (13.287712379549449f / 32.0f)); const float ang = (float)pos[t] * inv; ct[i] = cosf(ang); st[i] = sinf(ang); } }
}

__device__ __forceinline__ f32x4 ld_bf4(const bf16_t* p) { const u32x2 w = *(const u32x2*)p; return (f32x4){bflo(w.x), bfhi(w.x), bflo(w.y), bfhi(w.y)}; }
__device__ __forceinline__ void st_bf4(bf16_t* p, const f32x4 v) { u32x2 w; w.x = cvt_pk_bf16(v[0], v[1]); w.y = cvt_pk_bf16(v[2], v[3]); *(u32x2*)p = w; }
__device__ __forceinline__ float tanhf_(float x) { return 1.0f - 2.0f * frcp(1.0f + fexp2(2.0f * LOG2E * x)); }
__device__ __forceinline__ void ph_prep(const Ctx& C, int l) {
    const bf16_t* __restrict__ proj = WSP(bf16_t, S_PROJ); const float* mu = C.in[I_RWMU] + l * 1024;
    bf16_t* __restrict__ LA = WSP(bf16_t, S_LA); bf16_t* __restrict__ CQN = WSP(bf16_t, S_CQN); bf16_t* __restrict__ CKVN = WSP(bf16_t, S_CKVN); bf16_t* __restrict__ KM = WSP(bf16_t, S_KM);
    const float* qg = C.in[I_QNG] + l * 256; const float* kvg = C.in[I_KVNG] + l * 128; const float* ct = WSP(float, W_COS); const float* st = WSP(float, W_SIN);
    const int lane = C.lane, c4 = 4 * lane, c2 = 2 * lane, i16 = lane & 15;
    const f32x4 m = *(const f32x4*)(mu + 768 + c4), qgv = *(const f32x4*)(qg + c4); const float kg0 = kvg[c2], kg1 = kvg[c2 + 1];
    u32x2 n_cur, n_prv, n_cq; unsigned n_ckv; unsigned short n_kr; float n_cs, n_sn;
#define PREP_LOAD(tt) do { const bf16_t* pr_ = proj + (size_t)(tt) * NPROJ; n_cur = *(const u32x2*)(pr_ + PC_RW + 768 + c4); \
        n_prv = ((tt) % SEQ) == 0 ? (u32x2){0u, 0u} : *(const u32x2*)(pr_ - NPROJ + PC_RW + 768 + c4); n_cq = *(const u32x2*)(pr_ + PC_CQ + c4); n_ckv = *(const unsigned*)(pr_ + PC_CKV + c2); \
        n_kr = pr_[PC_KR + (lane & 31)]; n_cs = ct[(size_t)(tt) * 16 + i16]; n_sn = st[(size_t)(tt) * 16 + i16]; } while (0)
    int t = GW; if (t < T) PREP_LOAD(t);
    for (; t < T; t += NGW) {
        const u32x2 wc = n_cur, wp = n_prv, wq = n_cq; const unsigned wk = n_ckv; const float krv = bf2f(n_kr), cs = n_cs, sn = n_sn;
        if (t + NGW < T) PREP_LOAD(t + NGW);
        { const f32x4 cur = (f32x4){bflo(wc.x), bfhi(wc.x), bflo(wc.y), bfhi(wc.y)}, prv = (f32x4){bflo(wp.x), bfhi(wp.x), bflo(wp.y), bfhi(wp.y)}; f32x4 p = cur + (prv - cur) * m;
          if (c4 < 64) { for (int j = 0; j < 4; ++j) p[j] = tanhf_(p[j]); } else if (c4 >= 128) { for (int j = 0; j < 4; ++j) p[j] = sigmoidf_(p[j]); }
          st_bf4(LA + (size_t)t * 256 + c4, p); }
        { f32x4 v = (f32x4){bflo(wq.x), bfhi(wq.x), bflo(wq.y), bfhi(wq.y)}; const float ss = wave_sum((v[0] * v[0] + v[1] * v[1]) + (v[2] * v[2] + v[3] * v[3]));
          const float rs = 1.0f / sqrtf(ss * (1.0f / 256.0f) + 1e-6f); v = v * rs * qgv; st_bf4(CQN + (size_t)t * 256 + c4, v); }
        { float a = bflo(wk), b = bfhi(wk); const float ss = wave_sum(a * a + b * b);
          const float rs = 1.0f / sqrtf(ss * (1.0f / 128.0f) + 1e-6f); a *= rs * kg0; b *= rs * kg1; *(unsigned*)(CKVN + (size_t)t * 128 + c2) = cvt_pk_bf16(a, b); }
        { const float o = __shfl_xor(krv, 16);
          const float r = (lane & 16) ? (o * sn + krv * cs) : (krv * cs - o * sn);
          if (lane < 32) { const bf16_t rb = (bf16_t)(cvt_pk_bf16(r, 0.f) & 0xffffu); for (int h = 0; h < 4; ++h) KM[(size_t)t * 384 + h * 96 + 64 + lane] = rb; } }
    }
#undef PREP_LOAD
}
__device__ __forceinline__ void ph_rwprep(const Ctx& C, int l) {
#if defined(NAIVE_SCAN)
    if (NAIVE_SCAN & 2) { float* q_ = WSP(float, S_SSQ); for (int i = C.bid * NTHREADS + C.tid; i < T * 8; i += C.G * NTHREADS) q_[i] = 0.f; }
#endif
    const bf16_t* __restrict__ proj = WSP(bf16_t, S_PROJ); const float* mu = C.in[I_RWMU] + l * 1024; const bf16_t* __restrict__ AV = WSP(bf16_t, S_AV); bf16_t* __restrict__ RWS = WSP(bf16_t, S_RWS);
    const float* kkw = C.in[I_RWKK] + l * 256; const float* kaw = C.in[I_RWKA] + l * 256; const int lane = C.lane, c = 4 * lane;
    f32x4 muv[3];
#pragma unroll
    for (int q = 0; q < 3; ++q) muv[q] = *(const f32x4*)(mu + q * 256 + c);
    const f32x4 kkv = *(const f32x4*)(kkw + c), kav = *(const f32x4*)(kaw + c);
    u32x2 ncur[3], nprv[3], nav;
#define RWP_LOAD(tt) do { const bf16_t* pr_ = proj + (size_t)(tt) * NPROJ + PC_RW; const bool f_ = ((tt) % SEQ) == 0; \
        _Pragma("unroll") for (int q = 0; q < 3; ++q) { ncur[q] = *(const u32x2*)(pr_ + q * 256 + c); nprv[q] = f_ ? (u32x2){0u, 0u} : *(const u32x2*)(pr_ - NPROJ + q * 256 + c); } \
        nav = *(const u32x2*)(AV + (size_t)(tt) * 256 + c); } while (0)
#define U2F4(w) ((f32x4){bflo((w).x), bfhi((w).x), bflo((w).y), bfhi((w).y)})
    int t = GW; if (t < T) RWP_LOAD(t);
    for (; t < T; t += NGW) {
        f32x4 rkv[3];
#pragma unroll
        for (int q = 0; q < 3; ++q) { const f32x4 cur = U2F4(ncur[q]), prv = U2F4(nprv[q]); rkv[q] = cur + (prv - cur) * muv[q]; }
        const f32x4 a = U2F4(nav);
        if (t + NGW < T) RWP_LOAD(t + NGW);
        f32x4 kk = rkv[1] * kkv;
        float ss = (kk[0] * kk[0] + kk[1] * kk[1]) + (kk[2] * kk[2] + kk[3] * kk[3]);
        ss = row_sum16(ss);
        kk = kk * (1.0f / sqrtf(fmaxf(ss, 1e-24f)));
        const f32x4 kmod = rkv[1] * ((a - 1.0f) * kav + 1.0f), ka = kk * a;
        const size_t o = (size_t)t * 256 + c, PL = (size_t)T * 256;
        st_bf4(RWS + o, rkv[0]); st_bf4(RWS + PL + o, kmod); st_bf4(RWS + 2 * PL + o, rkv[2]); st_bf4(RWS + 3 * PL + o, kk); st_bf4(RWS + 4 * PL + o, ka);
    }
#undef RWP_LOAD
}
__device__ __forceinline__ void ph_ssdprep(const Ctx& C, int l) {
    const bf16_t* __restrict__ proj = WSP(bf16_t, S_PROJ); bf16_t* __restrict__ XA = WSP(bf16_t, S_XA); bf16_t* __restrict__ BC = WSP(bf16_t, S_BC); bf16_t* __restrict__ CC = WSP(bf16_t, S_CC); float* __restrict__ ACS = WSP(float, S_ACS); float* __restrict__ DTV = WSP(float, S_DTV);
    const float* cw = C.in[I_CONVW] + l * 4 * 768; const float* cb = C.in[I_CONVB] + l * 768; const float* dtbp = C.in[I_DTB] + l * 4; const float* alog = C.in[I_ALOG] + l * 4; const int lane = C.lane;
    for (int item = GW; item < 64; item += NGW) { const int b = item >> 2, h = item & 3; const float dtb = dtbp[h], a2 = -expf(alog[h]) * LOG2E; const size_t t0 = (size_t)b * SEQ + 32 * lane;
        unsigned short rawv[32];
#pragma unroll
        for (int i = 0; i < 32; ++i) rawv[i] = proj[(t0 + i) * NPROJ + PC_DT + h];
        float pre[32]; float run = 0.f;
#pragma unroll
        for (int i = 0; i < 32; ++i) { run += softplusf_(bf2f(rawv[i]) + dtb) * a2; pre[i] = run; }
        float sc_ = run;
#pragma unroll
        for (int d = 1; d < 64; d <<= 1) { const float o = __shfl_up(sc_, d); if (lane >= d) sc_ += o; }
        const float base = sc_ - run;
#pragma unroll
        for (int i = 0; i < 32; ++i) ACS[(t0 + i) * 4 + h] = base + pre[i]; }
    f32x4 cbv[3], cwv[3][4];
#pragma unroll
    for (int j = 0; j < 3; ++j) { const int c = 4 * lane + 256 * j; cbv[j] = *(const f32x4*)(cb + c);
#pragma unroll
        for (int k = 0; k < 4; ++k) cwv[j][k] = *(const f32x4*)(cw + k * 768 + c); }
    const float dtbl = dtbp[lane & 3];
    u32x2 nraw[3][4]; unsigned short ndt;
#define SSP_LOAD(tt) do { const int tl_ = (tt) % SEQ; _Pragma("unroll") for (int j = 0; j < 3; ++j) _Pragma("unroll") for (int k = 0; k < 4; ++k) \
        nraw[j][k] = (tl_ - 3 + k >= 0) ? *(const u32x2*)(proj + (size_t)((tt) - 3 + k) * NPROJ + PC_XS + 4 * lane + 256 * j) : (u32x2){0u, 0u}; \
        ndt = proj[(size_t)(tt) * NPROJ + PC_DT + (lane & 3)]; } while (0)
    int t = GW; if (t < T) SSP_LOAD(t);
    for (; t < T; t += NGW) {
        f32x4 acc3[3]; const float dtraw = bf2f(ndt);
#pragma unroll
        for (int j = 0; j < 3; ++j) { f32x4 a = cbv[j];
#pragma unroll
            for (int k = 0; k < 4; ++k) a += U2F4(nraw[j][k]) * cwv[j][k];
            acc3[j] = a; }
        if (t + NGW < T) SSP_LOAD(t + NGW);
#pragma unroll
        for (int j = 0; j < 3; ++j) { f32x4 a = acc3[j]; for (int q = 0; q < 4; ++q) a[q] = siluf_(a[q]);
            st_bf4((j == 0 ? XA : (j == 1 ? BC : CC)) + (size_t)t * 256 + 4 * lane, a); }
        if (lane < 4) DTV[(size_t)t * 4 + lane] = softplusf_(dtraw + dtbl);
    }
#undef SSP_LOAD
#undef U2F4
}
#ifndef ABL_MOE
#define ABL_MOE 1.0f
#endif
template <bool MOE> __device__ __forceinline__ void ph_ln(const Ctx& C, const float* src, float* dst, bf16_t* dstb, const float* g, const float* b, const bf16_t* ys, const bf16_t* src16 = nullptr) {
    const int lane = C.lane;
    float chkscale = 1.0f;
#if defined(CHECKS) || defined(CHECKS2) || defined(CHECKS3) || defined(CHECKS4) || defined(CHECKS5) || defined(CHECKS6) || defined(CHECKS7) || defined(CHECKS8) || defined(CHECKS9) || defined(CHECKS10) || defined(CHECKS12) || defined(CHECKS13) || defined(CHECKS14) || defined(CHECKS15)
    if (MOE) { const unsigned* cw = (const unsigned*)(C.ws + WS_CTL) + CW_CHK; int n = 0;
        for (int q = 0; q < 4; ++q) if (__hip_atomic_load(cw + 64 * q, RLX_AGENT) != 0u) n |= 1 << q;
#if defined(FG_COUNT) || defined(CHECKS13) || defined(CHECKS15)
        { unsigned v_ = __hip_atomic_load(cw + 2048, RLX_AGENT); n = 0; while (v_ > 0u) { ++n; v_ >>= 1; } }
#endif
#ifdef CHECKS10
        { const float num = __uint_as_float(__hip_atomic_load(cw + 1024, RLX_AGENT)), den = __uint_as_float(__hip_atomic_load(cw + 1088, RLX_AGENT)); const float lr = -log2f(fmaxf(num / fmaxf(den, 1e-30f), 1e-12f)); n = (int)(lr + 0.5f); n = n < 0 ? 0 : (n > 31 ? 31 : n); }
#endif
        chkscale = 1.0f + 0.1f * (float)n; }
#endif
    f32x4 gv[4], bv[4];
#pragma unroll
    for (int j = 0; j < 4; ++j) { gv[j] = *(const f32x4*)(g + 4 * lane + 256 * j); bv[j] = *(const f32x4*)(b + 4 * lane + 256 * j); }
    f32x4 nv[4]; u32x2 ny0[4], ny1[4];
#define LN_LOAD(tt) do { _Pragma("unroll") for (int j = 0; j < 4; ++j) { nv[j] = ld_bf4(src16 + (size_t)(tt) * 1024 + 4 * lane + 256 * j); \
        if (MOE) { ny0[j] = *(const u32x2*)(ys + (size_t)(2 * (tt)) * 1024 + 4 * lane + 256 * j); ny1[j] = *(const u32x2*)(ys + (size_t)(2 * (tt) + 1) * 1024 + 4 * lane + 256 * j); } } } while (0)
    int t = GW; if (t < T) LN_LOAD(t);
    for (; t < T; t += NGW) {
        f32x4 v[4]; float s = 0.f;
#pragma unroll
        for (int j = 0; j < 4; ++j) { v[j] = nv[j];
            if (MOE) { const f32x4 y0 = (f32x4){bflo(ny0[j].x), bfhi(ny0[j].x), bflo(ny0[j].y), bfhi(ny0[j].y)}, y1 = (f32x4){bflo(ny1[j].x), bfhi(ny1[j].x), bflo(ny1[j].y), bfhi(ny1[j].y)}; v[j] = v[j] * DN_ALPHA + (y0 + y1) * ABL_MOE; } }
        if (t + NGW < T) LN_LOAD(t + NGW);
#pragma unroll
        for (int j = 0; j < 4; ++j) s += (v[j][0] + v[j][1]) + (v[j][2] + v[j][3]);
        const float mean = wave_sum(s) * (1.0f / 1024.0f); float s2 = 0.f;
#pragma unroll
        for (int j = 0; j < 4; ++j) { v[j] = v[j] - mean; s2 += (v[j][0] * v[j][0] + v[j][1] * v[j][1]) + (v[j][2] * v[j][2] + v[j][3] * v[j][3]); }
        const float rstd = 1.0f / sqrtf(wave_sum(s2) * (1.0f / 1024.0f) + 1e-5f);
#pragma unroll
        for (int j = 0; j < 4; ++j) { const int c = 4 * lane + 256 * j; const f32x4 o = (v[j] * rstd * gv[j] + bv[j]) * chkscale;
            if (dst) *(f32x4*)(dst + (size_t)t * 1024 + c) = o; if (dstb) st_bf4(dstb + (size_t)t * 1024 + c, o); }
    }
#undef LN_LOAD
}
__device__ __forceinline__ void ph_ssdfix(const Ctx& C, int l) {
    bf16_t* Y = WSP(bf16_t, S_Y); const float* ssq = WSP(float, S_SSQ); const float* ng = C.in[I_SSDNG] + l * 256; const int lane = C.lane, c = 4 * lane, g = lane >> 5;
    const bf16_t* YRAW = WSP(bf16_t, S_YRAW); const bf16_t* RWS = WSP(bf16_t, S_RWS); const bf16_t* GV = WSP(bf16_t, S_GV); const size_t PL = (size_t)T * 256;
    const f32x4 rk = *(const f32x4*)(C.in[I_RWRK] + l * 256 + c), gng = *(const f32x4*)(C.in[I_RWGNG] + l * 256 + c), gnb = *(const f32x4*)(C.in[I_RWGNB] + l * 256 + c);
    const f32x4 ngv = *(const f32x4*)(ng + c);
    f32x4 nq; u32x2 nys, nyr, nr, nkm, nvv, ngg;
#define U2F4(w) ((f32x4){bflo((w).x), bfhi((w).x), bflo((w).y), bfhi((w).y)})
#define FIX_LOAD(tt) do { nq = *(const f32x4*)(ssq + (size_t)(tt) * 8 + 4 * g); nys = *(const u32x2*)(Y + (size_t)(tt) * 1024 + 512 + c); const size_t o_ = (size_t)(tt) * 256 + c; \
        nyr = *(const u32x2*)(YRAW + o_); nr = *(const u32x2*)(RWS + o_); nkm = *(const u32x2*)(RWS + PL + o_); nvv = *(const u32x2*)(RWS + 2 * PL + o_); ngg = *(const u32x2*)(GV + o_); } while (0)
    int t = GW; if (t < T) FIX_LOAD(t);
    for (; t < T; t += NGW) {
        const f32x4 q4 = nq; f32x4 v = U2F4(nys); const f32x4 yv = U2F4(nyr), rr = U2F4(nr), km = U2F4(nkm), vv = U2F4(nvv), gg = U2F4(ngg);
        if (t + NGW < T) FIX_LOAD(t + NGW);
        const float q = (q4[0] + q4[1]) + (q4[2] + q4[3]); const float rs = 1.0f / sqrtf(q * (1.0f / 128.0f) + 1e-5f);
        v = v * rs * ngv; st_bf4(Y + (size_t)t * 1024 + 512 + c, v);
        float sm = (yv[0] + yv[1]) + (yv[2] + yv[3]), bd = (rr[0] * km[0] * rk[0] + rr[1] * km[1] * rk[1]) + (rr[2] * km[2] * rk[2] + rr[3] * km[3] * rk[3]);
        sm = row_sum16(sm); bd = row_sum16(bd);
        const float mu = sm * (1.0f / 64.0f); const f32x4 d = yv - mu; float vs = (d[0] * d[0] + d[1] * d[1]) + (d[2] * d[2] + d[3] * d[3]);
        vs = row_sum16(vs);
        const float rstd = 1.0f / sqrtf(vs * (1.0f / 64.0f) + 64e-5f);
        st_bf4(Y + (size_t)t * 1024 + 256 + c, ((d * rstd) * gng + gnb + vv * bd) * gg);
    }
#undef FIX_LOAD
#undef U2F4
}
typedef __bf16 bfx8 __attribute__((ext_vector_type(8)));
__device__ __forceinline__ f32x16 mfma32(const bf16x8 a, const bf16x8 b, const f32x16 c) { return __builtin_amdgcn_mfma_f32_32x32x16_bf16(__builtin_bit_cast(bfx8, a), __builtin_bit_cast(bfx8, b), c, 0, 0, 0); }
__device__ __forceinline__ float dpp_xor1(float v) { return __builtin_bit_cast(float, __builtin_amdgcn_mov_dpp(__builtin_bit_cast(int, v), 0xB1, 0xf, 0xf, true)); }
__device__ __forceinline__ float dpp_xor2(float v) { return __builtin_bit_cast(float, __builtin_amdgcn_mov_dpp(__builtin_bit_cast(int, v), 0x4E, 0xf, 0xf, true)); }
__device__ __forceinline__ float dpp_hmir(float v) { return __builtin_bit_cast(float, __builtin_amdgcn_mov_dpp(__builtin_bit_cast(int, v), 0x141, 0xf, 0xf, true)); }
__device__ __forceinline__ float sum8(float v) { v += dpp_xor1(v); v += dpp_xor2(v); v += dpp_hmir(v); return v; }

__device__ __forceinline__ float xor32(float v, int hh) { const auto sw = __builtin_amdgcn_permlane32_swap(__builtin_bit_cast(unsigned, v), __builtin_bit_cast(unsigned, v), false, false); return __builtin_bit_cast(float, (unsigned)(hh ? sw[0] : sw[1])); }
typedef short s16x4 __attribute__((ext_vector_type(4)));
typedef short s16x8 __attribute__((ext_vector_type(8)));
template <int MODE>
__device__ __forceinline__ void attn_unit(const Ctx& C0_, int l, int b, int h, int qb, unsigned vf = 0u) {
    const Ctx C = launder(C0_);
    constexpr int DQK = MODE == 2 ? 128 : (MODE == 1 ? 96 : 64), NS = DQK / 16, KST = DQK * 2 + 16, VST = 192, KCH = DQK / 8;
    const bf16_t *Qp, *Kp, *Vp; int qs, ks, vs, ycol;
    if (MODE == 0) { const bf16_t* proj = WSP(bf16_t, S_PROJ); Qp = proj + PC_SBQ + h * 64; Kp = proj + PC_SBK + h * 64; Vp = proj + PC_SBV + h * 64; qs = ks = vs = NPROJ; ycol = h * 64; }
    else if (MODE == 1) { Qp = WSP(bf16_t, S_QM) + h * 96; Kp = WSP(bf16_t, S_KM) + h * 96; Vp = WSP(bf16_t, S_VM) + h * 64; qs = ks = 384; vs = 256; ycol = 768 + h * 64; }
    else { Qp = WSP(bf16_t, S_CC) + (h >> 1) * 128; Kp = WSP(bf16_t, S_BC) + (h >> 1) * 128; Vp = WSP(bf16_t, S_XA) + h * 64; qs = ks = vs = 256; ycol = 512 + h * 64; }
    const float* ACS = WSP(float, S_ACS); const float* DTV = WSP(float, S_DTV);
    const size_t tb = (size_t)b * SEQ;
    constexpr int ABUF = 64 * KST + 64 * VST + 512;
    LAS unsigned char* const abase = C.lds;
    const int tid = C.tid, lane = C.lane, w = C.wave, r = lane & 31, hh = lane >> 5;
    const int Q0 = qb * 256, qidx = Q0 + 32 * w + r, qmin = Q0 + 32 * w, qmax = qmin + 31;
    bf16x8 qf[NS];
#pragma unroll
    for (int s = 0; s < NS; ++s) qf[s] = *(const bf16x8*)(Qp + (tb + qidx) * qs + 16 * s + 8 * hh);
    f32x16 o[2]; for (int i = 0; i < 16; ++i) { o[0][i] = 0.f; o[1][i] = 0.f; }
    float Rrun = 0.f, mrun = -1.0e30f, lsum = 0.f;
    const int pr = (r & ~12) | ((r & 4) << 1) | ((r & 8) >> 1);
    u32x4 kreg0, kreg1, vreg; const int krow0 = tid / KCH, kch0 = tid % KCH, krow1 = (tid + 512) / KCH, kch1 = (tid + 512) % KCH, vrow = tid >> 3, vch = tid & 7;
    const bool k1 = (MODE == 2) || ((MODE == 1) && (tid < 64 * KCH - 512));
    float areg = 0.f, dreg = 0.f; float aq = 0.f; if (MODE == 2) aq = ACS[(tb + qidx) * 4 + h];
    const int ktmax = 4 * qb + 3;
#define ATT_LOAD(kt) do { const size_t kb_ = tb + (size_t)(kt) * 64; kreg0 = *(const u32x4*)(Kp + (kb_ + krow0) * ks + kch0 * 8); if (k1) kreg1 = *(const u32x4*)(Kp + (kb_ + krow1) * ks + kch1 * 8); \
        vreg = *(const u32x4*)(Vp + (kb_ + vrow) * vs + vch * 8); if (MODE == 2 && tid < 64) { areg = ACS[(kb_ + tid) * 4 + h]; dreg = DTV[(kb_ + tid) * 4 + h]; } } while (0)
#define ATT_STORE(bi) do { LAS unsigned char* Kt_ = abase + (bi) * ABUF; LAS unsigned char* Vt_ = Kt_ + 64 * KST; \
        *(LAS u32x4*)(Kt_ + krow0 * KST + kch0 * 16) = kreg0; if (k1) *(LAS u32x4*)(Kt_ + krow1 * KST + kch1 * 16) = kreg1; \
        *(LAS u32x4*)(Vt_ + vrow * VST + vch * 16) = vreg; if (MODE == 2 && tid < 64) { ((LAS float*)(Vt_ + 64 * VST))[tid] = areg; ((LAS float*)(Vt_ + 64 * VST))[64 + tid] = dreg; } } while (0)
    __syncthreads();
    ATT_LOAD(ktmax); ATT_STORE(0); if (ktmax > 0) ATT_LOAD(ktmax - 1);
    __syncthreads();
    for (int kt = ktmax; kt >= 0; --kt) {
        const int bi = (ktmax - kt) & 1;
        LAS unsigned char* Kt = abase + bi * ABUF; LAS unsigned char* Vt = Kt + 64 * KST; LAS float* AkL = (LAS float*)(Vt + 64 * VST); LAS float* DkL = AkL + 64;
        if (kt > 0 && !(vf & 128u)) { ATT_STORE(bi ^ 1); if (kt > 1) ATT_LOAD(kt - 2); }
        const int k0 = kt * 64;
        if (k0 <= qmax) {
        const bool need_mask = (k0 + 63 >= qmin);
        f32x16 sc[2];
#pragma unroll
        for (int sub = 0; sub < 2; ++sub) {
            for (int i = 0; i < 16; ++i) sc[sub][i] = 0.f;
            if (!(vf & 16u)) { _Pragma("unroll") for (int s = 0; s < NS; ++s) { const bf16x8 kf = *(const LAS bf16x8*)(Kt + (32 * sub + pr) * KST + (16 * s + 8 * hh) * 2); sc[sub] = mfma32(kf, qf[s], sc[sub]); } }
        }
        s16x4 vfr[2][2][4];
        { const LAS unsigned char* vb_ = Vt + (8 * hh + ((lane & 15) >> 2)) * VST + (16 * ((lane >> 4) & 1) + 4 * (lane & 3)) * 2;
#pragma unroll
          for (int sub = 0; sub < 2; ++sub)
#pragma unroll
            for (int s = 0; s < 2; ++s) { const LAS unsigned char* a_ = vb_ + (32 * sub + 16 * s) * VST;
                vfr[sub][s][0] = __builtin_amdgcn_ds_read_tr16_b64_v4i16((LAS s16x4*)a_); vfr[sub][s][1] = __builtin_amdgcn_ds_read_tr16_b64_v4i16((LAS s16x4*)(a_ + 768));
                vfr[sub][s][2] = __builtin_amdgcn_ds_read_tr16_b64_v4i16((LAS s16x4*)(a_ + 64)); vfr[sub][s][3] = __builtin_amdgcn_ds_read_tr16_b64_v4i16((LAS s16x4*)(a_ + 832)); } }
        if (vf & 32u) { } else
        if (MODE == 0) {
#pragma unroll
            for (int sub = 1; sub >= 0; --sub) {
                const int kb = k0 + 32 * sub + 8 * hh;
                float L[16];
#pragma unroll
                for (int i = 0; i < 16; ++i) { const float z = sc[sub][i]; const float l2 = -(fmaxf(z, 0.f) + flog2(1.0f + fexp2(-fabsf(z)))); L[i] = l2; sc[sub][i] = z + l2; }
                if (need_mask) {
#pragma unroll
                    for (int i = 0; i < 16; ++i) { const int key = kb + (i & 7) + 16 * (i >> 3); const bool ok = key < qidx; L[i] = ok ? L[i] : 0.f; sc[sub][i] = ok ? sc[sub][i] : -1.0e30f; } }
                float own_hi = 0.f, own_lo = 0.f, tl[16];
#pragma unroll
                for (int j = 7; j >= 0; --j) { tl[8 + j] = own_hi; own_hi += L[8 + j]; tl[j] = own_lo; own_lo += L[j]; }
                const float p_hi = xor32(own_hi, hh), p_lo = xor32(own_lo, hh);
                const float off_hi = Rrun + (hh ? 0.f : p_hi), off_lo = Rrun + own_hi + p_hi + (hh ? 0.f : p_lo);
                Rrun += (own_hi + own_lo) + (p_hi + p_lo);
#pragma unroll
                for (int i = 0; i < 16; ++i) sc[sub][i] = fexp2(sc[sub][i] + tl[i] + (i >= 8 ? off_hi : off_lo));
            }
        } else if (MODE == 2) {
#pragma unroll
            for (int sub = 0; sub < 2; ++sub) { f32x4 ak[4], dk[4];
#pragma unroll
                for (int r4 = 0; r4 < 4; ++r4) { const int o_ = 32 * sub + 8 * hh + 16 * (r4 >> 1) + 4 * (r4 & 1); ak[r4] = *(const LAS f32x4*)(AkL + o_); dk[r4] = *(const LAS f32x4*)(DkL + o_); }
#pragma unroll
                for (int i = 0; i < 16; ++i) { const float a_ = ak[(i >> 3) * 2 + ((i & 7) >> 2)][i & 3], d_ = dk[(i >> 3) * 2 + ((i & 7) >> 2)][i & 3];
                    sc[sub][i] = sc[sub][i] * d_ * fexp2(fminf(aq - a_, 0.f)); }
                if (need_mask) {
#pragma unroll
                    for (int i = 0; i < 16; ++i) { const int key = k0 + 32 * sub + 8 * hh + (i & 7) + 16 * (i >> 3); sc[sub][i] = key <= qidx ? sc[sub][i] : 0.f; } } }
        } else {
            if (need_mask) {
#pragma unroll
                for (int sub = 0; sub < 2; ++sub)
#pragma unroll
                    for (int i = 0; i < 16; ++i) { const int key = k0 + 32 * sub + 8 * hh + (i & 7) + 16 * (i >> 3); sc[sub][i] = key <= qidx ? sc[sub][i] : -1.0e30f; } }
            float tm = -1.0e30f;
#pragma unroll
            for (int sub = 0; sub < 2; ++sub)
#pragma unroll
                for (int i = 0; i < 16; ++i) tm = fmaxf(tm, sc[sub][i]);
            tm = fmaxf(tm, xor32(tm, hh));
            if (!__all(tm <= mrun)) {
                const float mnew = fmaxf(mrun, tm), alpha = fexp2(mrun - mnew); mrun = mnew; lsum *= alpha;
#pragma unroll
                for (int i = 0; i < 16; ++i) { o[0][i] *= alpha; o[1][i] *= alpha; } }
            float ps = 0.f;
#pragma unroll
            for (int sub = 0; sub < 2; ++sub)
#pragma unroll
                for (int i = 0; i < 16; ++i) { const float p = fexp2(sc[sub][i] - mrun); sc[sub][i] = p; ps += p; }
            lsum += ps;
        }
        if (!(vf & 64u))
#pragma unroll
        for (int sub = 0; sub < 2; ++sub)
#pragma unroll
            for (int s = 0; s < 2; ++s) {
                bf16x8 pf; { u32x4 pw; pw.x = cvt_pk_bf16(sc[sub][8 * s + 0], sc[sub][8 * s + 1]); pw.y = cvt_pk_bf16(sc[sub][8 * s + 2], sc[sub][8 * s + 3]); pw.z = cvt_pk_bf16(sc[sub][8 * s + 4], sc[sub][8 * s + 5]); pw.w = cvt_pk_bf16(sc[sub][8 * s + 6], sc[sub][8 * s + 7]); pf = __builtin_bit_cast(bf16x8, pw); }
                const s16x8 va0 = __builtin_shufflevector(vfr[sub][s][0], vfr[sub][s][1], 0, 1, 2, 3, 4, 5, 6, 7), va1 = __builtin_shufflevector(vfr[sub][s][2], vfr[sub][s][3], 0, 1, 2, 3, 4, 5, 6, 7);
                o[0] = mfma32(__builtin_bit_cast(bf16x8, va0), pf, o[0]);
                o[1] = mfma32(__builtin_bit_cast(bf16x8, va1), pf, o[1]);
            }
        }
        bool dead = false;
        if (MODE == 0) dead = Rrun < -64.0f;
        if (MODE == 2) dead = aq - AkL[0] < -64.0f;
        if (MODE == 1) { __syncthreads(); }
        else { volatile LAS unsigned* votes = (volatile LAS unsigned*)(C.lds + LDSCTL_OFF + 128) + 8 * bi;
            const bool wdead = __all(dead ? 1 : 0); if (lane == 0) votes[w] = wdead ? 1u : 0u;
            __syncthreads();
            unsigned all_ = 1u;
#pragma unroll
            for (int q_ = 0; q_ < 8; ++q_) all_ &= votes[q_];
            if (all_) break; }
    }
#undef ATT_LOAD
#undef ATT_STORE
    float inv = 1.0f;
    if (MODE == 1) { const float lt = lsum + xor32(lsum, hh); inv = frcp(lt); }
    bf16_t* Y = WSP(bf16_t, S_Y) + (tb + qidx) * 1024 + ycol;
    if (MODE == 2) {
        const float dsk = C.in[I_SSDD][l * 4 + h]; const bf16_t* xa = Vp + (tb + qidx) * 256; const bf16_t* zp = WSP(bf16_t, S_PROJ) + (tb + qidx) * NPROJ + PC_Z + h * 64; float q_ = 0.f;
#pragma unroll
        for (int dt = 0; dt < 2; ++dt)
#pragma unroll
            for (int g = 0; g < 4; ++g) { const int d0 = 32 * dt + 8 * g + 4 * hh; const f32x4 xv = ld_bf4(xa + d0), zv = ld_bf4(zp + d0); f32x4 y;
                for (int j = 0; j < 4; ++j) { y[j] = (o[dt][4 * g + j] + dsk * xv[j]) * siluf_(zv[j]); q_ += y[j] * y[j]; }
                st_bf4(Y + d0, y); }
        q_ += __shfl_xor(q_, 32);
        if (hh == 0) { float* SSQ = WSP(float, S_SSQ); SSQ[(tb + qidx) * 8 + h * 2] = q_; SSQ[(tb + qidx) * 8 + h * 2 + 1] = 0.f; }
        return;
    }
#pragma unroll
    for (int dt = 0; dt < 2; ++dt)
#pragma unroll
        for (int g = 0; g < 4; ++g) { u32x2 wv; wv.x = cvt_pk_bf16(o[dt][4 * g] * inv, o[dt][4 * g + 1] * inv); wv.y = cvt_pk_bf16(o[dt][4 * g + 2] * inv, o[dt][4 * g + 3] * inv);
            *(u32x2*)(Y + 32 * dt + 8 * g + 4 * hh) = wv; }
}

__device__ __forceinline__ float sum16(float v) { v = sum8(v); v += __builtin_bit_cast(float, __builtin_amdgcn_mov_dpp(__builtin_bit_cast(int, v), 0x140, 0xf, 0xf, true)); return v; }
__device__ __forceinline__ void rwkv_unit(const Ctx& C0_, int l, int b, int h, int half) {
    const Ctx C = launder(C0_);
    constexpr int TB = 32, NBLK = SEQ / TB, BUFB = 6 * TB * 64 * 4;
    LAS float* buf0 = (LAS float*)C.lds; LAS float* ybuf = (LAS float*)(C.lds + 2 * BUFB);
    const int tid = C.tid, il = tid >> 4, q = tid & 15, i = 32 * half + il;
    const float* DEC = WSP(float, S_DEC); const bf16_t* RWS = WSP(bf16_t, S_RWS); bf16_t* YRAW = WSP(bf16_t, S_YRAW);
    const size_t PL = (size_t)T * 256; const size_t tb = (size_t)b * SEQ;
    const int ls = tid >> 4, lj = 4 * (tid & 15);
    f32x4 gw; u32x2 gr[5];
#define RW_LOAD(blk) do { const size_t o_ = (tb + (size_t)(blk) * TB + ls) * 256 + h * 64 + lj; gw = *(const f32x4*)(DEC + o_); \
        gr[0] = *(const u32x2*)(RWS + 3 * PL + o_); gr[1] = *(const u32x2*)(RWS + 4 * PL + o_); gr[2] = *(const u32x2*)(RWS + PL + o_); gr[3] = *(const u32x2*)(RWS + o_); gr[4] = *(const u32x2*)(RWS + 2 * PL + o_); } while (0)
#define RW_STORE(bufp) do { LAS float* d_ = (bufp) + ls * 64 + lj; *(LAS f32x4*)d_ = gw; \
        _Pragma("unroll") for (int a_ = 0; a_ < 5; ++a_) *(LAS f32x4*)(d_ + (a_ + 1) * TB * 64) = (f32x4){bflo(gr[a_].x), bfhi(gr[a_].x), bflo(gr[a_].y), bfhi(gr[a_].y)}; } while (0)
    f32x4 S = (f32x4){0.f, 0.f, 0.f, 0.f};
    __syncthreads();
    RW_LOAD(0); RW_STORE(buf0);
    __syncthreads();
    for (int blk = 0; blk < NBLK; ++blk) {
        LAS float* cur = buf0 + (blk & 1) * (BUFB / 4); LAS float* nxtb = buf0 + ((blk + 1) & 1) * (BUFB / 4);
        if (blk + 1 < NBLK) RW_LOAD(blk + 1);
        f32x4 wA[2], kkA[2], kaA[2], kmA[2], rA[2], wB[2], kkB[2], kaB[2], kmB[2], rB[2]; float vA[2], vB[2];
#define RW_RD(W_, KK_, KA_, KM_, R_, V_, sb_) do { _Pragma("unroll") for (int u = 0; u < 2; ++u) { const LAS float* p = cur + ((sb_) + u) * 64 + 4 * q; \
            W_[u] = *(const LAS f32x4*)p; KK_[u] = *(const LAS f32x4*)(p + TB * 64); KA_[u] = *(const LAS f32x4*)(p + 2 * TB * 64); KM_[u] = *(const LAS f32x4*)(p + 3 * TB * 64); R_[u] = *(const LAS f32x4*)(p + 4 * TB * 64); \
            V_[u] = cur[5 * TB * 64 + ((sb_) + u) * 64 + i]; } } while (0)
#define RW_STEP(W_, KK_, KA_, KM_, R_, V_, sb_) do { float yv_[2]; _Pragma("unroll") for (int u = 0; u < 2; ++u) { \
            float sa = (S[0] * KK_[u][0] + S[1] * KK_[u][1]) + (S[2] * KK_[u][2] + S[3] * KK_[u][3]); sa = sum16(sa); \
            S = S * W_[u] + (KM_[u] * V_[u] - KA_[u] * sa); \
            const float y = (S[0] * R_[u][0] + S[1] * R_[u][1]) + (S[2] * R_[u][2] + S[3] * R_[u][3]); yv_[u] = sum16(y); } \
            if (q == 0) { ybuf[(sb_) * 32 + il] = yv_[0]; ybuf[((sb_) + 1) * 32 + il] = yv_[1]; } } while (0)
        RW_RD(wA, kkA, kaA, kmA, rA, vA, 0);
        for (int s0 = 0; s0 < TB; s0 += 4) {
            RW_RD(wB, kkB, kaB, kmB, rB, vB, s0 + 2);
            RW_STEP(wA, kkA, kaA, kmA, rA, vA, s0);
            if (s0 + 4 < TB) RW_RD(wA, kkA, kaA, kmA, rA, vA, s0 + 4);
            RW_STEP(wB, kkB, kaB, kmB, rB, vB, s0 + 2);
        }
#undef RW_RD
#undef RW_STEP
        __syncthreads();
        {
            const int os = tid >> 4, r2 = 2 * (tid & 15); const size_t t = tb + (size_t)blk * TB + os;
            *(unsigned*)(YRAW + t * 256 + h * 64 + 32 * half + r2) = cvt_pk_bf16(ybuf[os * 32 + r2], ybuf[os * 32 + r2 + 1]);
        }
        if (blk + 1 < NBLK) RW_STORE(nxtb);
        __syncthreads();
    }
#undef RW_LOAD
#undef RW_STORE
}

__device__ __forceinline__ void ssd_stage(const Ctx& C, int l, int h, size_t tb, int blk, LAS float* dst) {
    constexpr int TB = 16; const int g = h >> 1;
    const bf16_t* proj = WSP(bf16_t, S_PROJ); const float* cw = C.in[I_CONVW] + l * 4 * 768; const float* cb = C.in[I_CONVB] + l * 768;
    const float dtb = C.in[I_DTB][l * 4 + h], aneg = -expf(C.in[I_ALOG][l * 4 + h]);
    for (int it = C.tid; it < TB * 80; it += NTHREADS) {
        const int s = it / 80, v = it % 80; const int tl = blk * TB + s;
        int pcol, cch, doff;
        if (v < 16) { pcol = PC_XS + h * 64 + 4 * v; cch = h * 64 + 4 * v; doff = s * 64 + 4 * v; }
        else if (v < 48) { pcol = PC_BM + g * 128 + 4 * (v - 16); cch = 256 + g * 128 + 4 * (v - 16); doff = 2 * TB * 64 + s * 128 + 4 * (v - 16); }
        else { pcol = PC_CM + g * 128 + 4 * (v - 48); cch = 512 + g * 128 + 4 * (v - 48); doff = 2 * TB * 64 + TB * 128 + s * 128 + 4 * (v - 48); }
        f32x4 a = *(const f32x4*)(cb + cch);
#pragma unroll
        for (int k = 0; k < 4; ++k) { const int tt = tl - 3 + k; if (tt >= 0) a += ld_bf4(proj + (tb + tt) * NPROJ + pcol) * *(const f32x4*)(cw + k * 768 + cch); }
        for (int j = 0; j < 4; ++j) a[j] = siluf_(a[j]);
        if (v < 16) { const float dt = softplusf_(bf2f(proj[(tb + tl) * NPROJ + PC_DT + h]) + dtb); *(LAS f32x4*)(dst + TB * 64 + doff) = a; *(LAS f32x4*)(dst + doff) = a * dt;
                      if (v == 0) dst[TB * 384 + s] = expf(dt * aneg); }
        else *(LAS f32x4*)(dst + doff) = a;
    }
}
__device__ __forceinline__ void ssd_unit(const Ctx& C0_, int l, int b, int h, int ph) {
    const Ctx C = launder(C0_);
    constexpr int TB = 32, NBLK = SEQ / TB, NF = TB * (32 + 32 + 128 + 128) + 64, NIT = 72 * TB, NK = (NIT + NTHREADS - 1) / NTHREADS;
    LAS float* buf0 = (LAS float*)C.lds; LAS float* ypart = buf0 + 2 * NF;
    const int tid = C.tid, lane = C.lane, w = C.wave, g = h >> 1, pl = lane & 31, nh = lane >> 5;
    const bf16_t* proj = WSP(bf16_t, S_PROJ); bf16_t* Y = WSP(bf16_t, S_Y); float* SSQ = WSP(float, S_SSQ);
    const float* cw = C.in[I_CONVW] + l * 4 * 768; const float* cb = C.in[I_CONVB] + l * 768;
    const float dtb = C.in[I_DTB][l * 4 + h], aneg = -expf(C.in[I_ALOG][l * 4 + h]), dsk = C.in[I_SSDD][l * 4 + h];
    const size_t tb = (size_t)b * SEQ;
    int its[NK], itp[NK], itd[NK], itc[NK]; bool itx[NK];
#pragma unroll
    for (int k = 0; k < NK; ++k) { const int it = tid + NTHREADS * k, sidx = it / 72, v = it % 72; int pcol, cch, doff;
        if (v < 8) { pcol = PC_XS + h * 64 + 32 * ph + 4 * v; cch = h * 64 + 32 * ph + 4 * v; doff = sidx * 32 + 4 * v; }
        else if (v < 40) { pcol = PC_BM + g * 128 + 4 * (v - 8); cch = 256 + g * 128 + 4 * (v - 8); doff = 2 * TB * 32 + sidx * 128 + 4 * (v - 8); }
        else { pcol = PC_CM + g * 128 + 4 * (v - 40); cch = 512 + g * 128 + 4 * (v - 40); doff = 2 * TB * 32 + TB * 128 + sidx * 128 + 4 * (v - 40); }
        its[k] = sidx; itp[k] = pcol; itd[k] = doff; itx[k] = v < 8; itc[k] = cch; }
    const bool haslast = tid + NTHREADS * (NK - 1) < NIT;
    u32x2 raw[NK][4]; float dtr[NK]; unsigned short zraw;
    const int os = tid >> 4, op = tid & 15;
#define SSD_LOAD(blk) do { _Pragma("unroll") for (int k = 0; k < NK; ++k) { if (k < NK - 1 || haslast) { const int tl_ = (blk) * TB + its[k]; \
            _Pragma("unroll") for (int q = 0; q < 4; ++q) { const int tt_ = tl_ - 3 + q; raw[k][q] = tt_ >= 0 ? *(const u32x2*)(proj + (tb + tt_) * NPROJ + itp[k]) : (u32x2){0u, 0u}; } \
            dtr[k] = itx[k] ? bf2f(proj[(tb + tl_) * NPROJ + PC_DT + h]) : 0.f; } } } while (0)
#define SSD_COMMIT(dst) do { _Pragma("unroll") for (int k = 0; k < NK; ++k) { if (k < NK - 1 || haslast) { f32x4 a_ = *(const f32x4*)(cb + itc[k]); \
            _Pragma("unroll") for (int q = 0; q < 4; ++q) a_ += (f32x4){bflo(raw[k][q].x), bfhi(raw[k][q].x), bflo(raw[k][q].y), bfhi(raw[k][q].y)} * *(const f32x4*)(cw + q * 768 + itc[k]); \
            for (int j = 0; j < 4; ++j) a_[j] = siluf_(a_[j]); \
            if (itx[k]) { const float dt_ = softplusf_(dtr[k] + dtb); *(LAS f32x4*)((dst) + TB * 32 + itd[k]) = a_; *(LAS f32x4*)((dst) + itd[k]) = a_ * dt_; if ((itd[k] & 31) == 0) (dst)[TB * 320 + its[k]] = expf(dt_ * aneg); } \
            else *(LAS f32x4*)((dst) + itd[k]) = a_; } } } while (0)
    float hs[8];
#pragma unroll
    for (int k = 0; k < 8; ++k) hs[k] = 0.f;
    __syncthreads();
    SSD_LOAD(0); SSD_COMMIT(buf0);
    __syncthreads();
    for (int blk = 0; blk < NBLK; ++blk) {
        LAS float* cur = buf0 + (blk & 1) * NF; LAS float* nxtb = buf0 + ((blk + 1) & 1) * NF;
        if (blk + 1 < NBLK) SSD_LOAD(blk + 1);
        const size_t tz = tb + (size_t)blk * TB + os;
        zraw = proj[tz * NPROJ + PC_Z + h * 64 + 32 * ph + op]; const unsigned short zraw2 = proj[tz * NPROJ + PC_Z + h * 64 + 32 * ph + op + 16];
        for (int s0 = 0; s0 < TB; s0 += 4) {
            float x4[4], dA4[4], yv[4]; f32x4 bv[4][2], cv[4][2];
#pragma unroll
            for (int u = 0; u < 4; ++u) { const int s = s0 + u; x4[u] = cur[s * 32 + pl]; dA4[u] = cur[TB * 320 + s];
                const LAS float* bp = cur + 2 * TB * 32 + s * 128 + 16 * w + 8 * nh; const LAS float* cp = bp + TB * 128;
                bv[u][0] = *(const LAS f32x4*)bp; bv[u][1] = *(const LAS f32x4*)(bp + 4); cv[u][0] = *(const LAS f32x4*)cp; cv[u][1] = *(const LAS f32x4*)(cp + 4); }
#pragma unroll
            for (int u = 0; u < 4; ++u) { float yp = 0.f;
#pragma unroll
                for (int k4 = 0; k4 < 2; ++k4)
#pragma unroll
                    for (int j = 0; j < 4; ++j) { hs[4 * k4 + j] = hs[4 * k4 + j] * dA4[u] + x4[u] * bv[u][k4][j]; yp += cv[u][k4][j] * hs[4 * k4 + j]; }
                const auto sw = __builtin_amdgcn_permlane32_swap(__builtin_bit_cast(unsigned, yp), __builtin_bit_cast(unsigned, yp), false, false);
                yv[u] = yp + __builtin_bit_cast(float, (unsigned)sw[1]); }
            if (nh == 0) {
#pragma unroll
                for (int u = 0; u < 4; ++u) ypart[((s0 + u) * 8 + w) * 32 + pl] = yv[u]; }
        }
        if (blk + 1 < NBLK) SSD_COMMIT(nxtb);
        __syncthreads();
        {
            float y0 = 0.f, y1 = 0.f;
#pragma unroll
            for (int ww = 0; ww < 8; ++ww) { y0 += ypart[(os * 8 + ww) * 32 + op]; y1 += ypart[(os * 8 + ww) * 32 + op + 16]; }
            y0 += cur[TB * 32 + os * 32 + op] * dsk; y1 += cur[TB * 32 + os * 32 + op + 16] * dsk;
            y0 *= siluf_(bf2f(zraw)); y1 *= siluf_(bf2f(zraw2));
            bf16_t* yo = Y + tz * 1024 + 512 + h * 64 + 32 * ph + op;
            yo[0] = (bf16_t)(cvt_pk_bf16(y0, 0.f) & 0xffffu); yo[16] = (bf16_t)(cvt_pk_bf16(y1, 0.f) & 0xffffu);
            float q = y0 * y0 + y1 * y1;
#pragma unroll
            for (int o_ = 1; o_ < 16; o_ <<= 1) q += __shfl_xor(q, o_);
            if (op == 0) SSQ[tz * 8 + h * 2 + ph] = q;
        }
        __syncthreads();
    }
#undef SSD_LOAD
#undef SSD_COMMIT
}

__device__ __forceinline__ void sb_naive(const Ctx& C) {
    const bf16_t* proj = WSP(bf16_t, S_PROJ); bf16_t* Y = WSP(bf16_t, S_Y); const int lane = C.lane;
    for (int item = GW; item < T * 4; item += NGW) {
        const int t = item >> 2, h = item & 3, tq = t % SEQ; const size_t tb = (size_t)(t - tq);
        float q[64];
        { const bf16_t* qp = proj + (size_t)t * NPROJ + PC_SBQ + h * 64;
#pragma unroll
          for (int i = 0; i < 8; ++i) { const u32x4 w = *(const u32x4*)(qp + 8 * i); q[8*i] = bflo(w.x); q[8*i+1] = bfhi(w.x); q[8*i+2] = bflo(w.y); q[8*i+3] = bfhi(w.y); q[8*i+4] = bflo(w.z); q[8*i+5] = bfhi(w.z); q[8*i+6] = bflo(w.w); q[8*i+7] = bfhi(w.w); } }
        float o[64];
#pragma unroll
        for (int d = 0; d < 64; ++d) o[d] = 0.f;
        float R = 0.f;
        for (int c = (tq - 1) >> 6; c >= 0 && tq > 0; --c) {
            const int key = c * 64 + lane; const bool ok = key < tq;
            const bf16_t* kp = proj + (tb + key) * NPROJ + PC_SBK + h * 64; const bf16_t* vp = proj + (tb + key) * NPROJ + PC_SBV + h * 64;
            float z = 0.f;
#pragma unroll
            for (int i = 0; i < 8; ++i) { const u32x4 w = *(const u32x4*)(kp + 8 * i);
                z += q[8*i] * bflo(w.x) + q[8*i+1] * bfhi(w.x) + q[8*i+2] * bflo(w.y) + q[8*i+3] * bfhi(w.y) + q[8*i+4] * bflo(w.z) + q[8*i+5] * bfhi(w.z) + q[8*i+6] * bflo(w.w) + q[8*i+7] * bfhi(w.w); }
            const float L = ok ? -(fmaxf(z, 0.f) + flog2(1.0f + fexp2(-fabsf(z)))) : 0.f;
            float sfx = L;
#pragma unroll
            for (int dd = 1; dd < 64; dd <<= 1) { const float tt = __shfl_down(sfx, dd); if (lane + dd < 64) sfx += tt; }
            const float tot = __shfl(sfx, 0);
            const float wgt = ok ? fexp2(z + L + (sfx - L) + R) : 0.f;
            R += tot;
#pragma unroll
            for (int i = 0; i < 8; ++i) { const u32x4 w = *(const u32x4*)(vp + 8 * i);
                o[8*i] += wgt * bflo(w.x); o[8*i+1] += wgt * bfhi(w.x); o[8*i+2] += wgt * bflo(w.y); o[8*i+3] += wgt * bfhi(w.y); o[8*i+4] += wgt * bflo(w.z); o[8*i+5] += wgt * bfhi(w.z); o[8*i+6] += wgt * bflo(w.w); o[8*i+7] += wgt * bfhi(w.w); }
        }
        float mine = 0.f;
#pragma unroll
        for (int d = 0; d < 64; ++d) { const float sdd = wave_sum(o[d]); if (lane == d) mine = sdd; }
        Y[(size_t)t * 1024 + h * 64 + lane] = (bf16_t)(cvt_pk_bf16(mine, 0.f) & 0xffffu);
    }
}

__device__ __forceinline__ void rwkv_naive(const Ctx& C, int l) {
    const float* DEC = WSP(float, S_DEC); const bf16_t* RWS = WSP(bf16_t, S_RWS); const bf16_t* GV = WSP(bf16_t, S_GV); bf16_t* Y = WSP(bf16_t, S_Y);
    const size_t PL = (size_t)T * 256; const int lane = C.lane;
    for (int item = GW; item < 64; item += NGW) {
        const int b = item >> 2, h = item & 3; const float* rk = C.in[I_RWRK] + l * 256 + h * 64;
        const float gng = C.in[I_RWGNG][l * 256 + h * 64 + lane], gnb = C.in[I_RWGNB][l * 256 + h * 64 + lane];
        float S[64];
#pragma unroll
        for (int j = 0; j < 64; ++j) S[j] = 0.f;
        for (int tq = 0; tq < SEQ; ++tq) {
            const size_t o = ((size_t)b * SEQ + tq) * 256 + h * 64;
            const float v = bf2f(RWS[2 * PL + o + lane]);
            float sa = 0.f;
#pragma unroll
            for (int j = 0; j < 64; ++j) sa += S[j] * bf2f(RWS[3 * PL + o + j]);
            float y = 0.f, bd = 0.f;
#pragma unroll
            for (int j = 0; j < 64; ++j) { const float km = bf2f(RWS[PL + o + j]), r = bf2f(RWS[o + j]);
                S[j] = S[j] * DEC[o + j] + (v * km - sa * bf2f(RWS[4 * PL + o + j])); y += S[j] * r; bd += r * km * rk[j]; }
            const float mu = wave_sum(y) * (1.0f / 64.0f), d = y - mu, var = wave_sum(d * d) * (1.0f / 64.0f);
            const float res = (d * (1.0f / sqrtf(var + 64e-5f)) * gng + gnb + v * bd) * bf2f(GV[o + lane]);
            Y[((size_t)b * SEQ + tq) * 1024 + 256 + h * 64 + lane] = (bf16_t)(cvt_pk_bf16(res, 0.f) & 0xffffu);
        }
    }
}
__device__ __forceinline__ void ssd_naive(const Ctx& C, int l) {
    const bf16_t* proj = WSP(bf16_t, S_PROJ); bf16_t* Y = WSP(bf16_t, S_Y); float* SSQ = WSP(float, S_SSQ); const int lane = C.lane;
    const float* cw = C.in[I_CONVW] + l * 4 * 768; const float* cb = C.in[I_CONVB] + l * 768;
    for (int item2 = GW; item2 < 128; item2 += NGW) {
        const int item = item2 >> 1, ph = item2 & 1; const int b = item >> 2, h = item & 3, g = h >> 1; const size_t tb = (size_t)b * SEQ;
        const float dtb = C.in[I_DTB][l * 4 + h], aneg = -expf(C.in[I_ALOG][l * 4 + h]), dsk = C.in[I_SSDD][l * 4 + h];
        float hs0[32], hs1[32];
#pragma unroll
        for (int p = 0; p < 32; ++p) { hs0[p] = 0.f; hs1[p] = 0.f; }
        for (int tq = 0; tq < SEQ; ++tq) {
            const bf16_t* pr = proj + (tb + tq) * NPROJ;
            float xa = cb[h * 64 + lane], bv0 = cb[256 + g * 128 + lane], bv1 = cb[256 + g * 128 + 64 + lane], cv0 = cb[512 + g * 128 + lane], cv1 = cb[512 + g * 128 + 64 + lane];
            for (int k = 0; k < 4; ++k) { const int tt = tq - 3 + k; if (tt >= 0) { const bf16_t* pp = proj + (tb + tt) * NPROJ; const float* ww = cw + k * 768;
                xa += bf2f(pp[PC_XS + h * 64 + lane]) * ww[h * 64 + lane];
                bv0 += bf2f(pp[PC_BM + g * 128 + lane]) * ww[256 + g * 128 + lane]; bv1 += bf2f(pp[PC_BM + g * 128 + 64 + lane]) * ww[256 + g * 128 + 64 + lane];
                cv0 += bf2f(pp[PC_CM + g * 128 + lane]) * ww[512 + g * 128 + lane]; cv1 += bf2f(pp[PC_CM + g * 128 + 64 + lane]) * ww[512 + g * 128 + 64 + lane]; } }
            xa = siluf_(xa); bv0 = siluf_(bv0); bv1 = siluf_(bv1); cv0 = siluf_(cv0); cv1 = siluf_(cv1);
            const float dt = softplusf_(bf2f(pr[PC_DT + h]) + dtb), dA = expf(dt * aneg), xd = xa * dt;
            float y = 0.f;
#pragma unroll
            for (int p = 0; p < 32; ++p) { const float xp = __shfl(xd, 32 * ph + p); hs0[p] = hs0[p] * dA + xp * bv0; hs1[p] = hs1[p] * dA + xp * bv1;
                const float tot = wave_sum(cv0 * hs0[p] + cv1 * hs1[p]); if (lane == 32 * ph + p) y = tot; }
            y += dsk * xa; y *= siluf_(bf2f(pr[PC_Z + h * 64 + lane]));
            const bool mine = (lane >> 5) == ph; if (mine) Y[(tb + tq) * 1024 + 512 + h * 64 + lane] = (bf16_t)(cvt_pk_bf16(y, 0.f) & 0xffffu);
            const float q = wave_sum(mine ? y * y : 0.f); if (lane == 0) atomicAdd(&SSQ[(tb + tq) * 8 + h * 2], q);
        }
    }
}

__device__ __forceinline__ void mla_naive(const Ctx& C) {
    const bf16_t* QM = WSP(bf16_t, S_QM); const bf16_t* KM = WSP(bf16_t, S_KM); const bf16_t* VM = WSP(bf16_t, S_VM); bf16_t* Y = WSP(bf16_t, S_Y); const int lane = C.lane;
    for (int item = GW; item < T * 4; item += NGW) {
        const int t = item >> 2, h = item & 3, tq = t % SEQ; const size_t tb = (size_t)(t - tq);
        float q[96];
        { const bf16_t* qp = QM + (size_t)t * 384 + h * 96;
#pragma unroll
          for (int i = 0; i < 12; ++i) { const u32x4 w = *(const u32x4*)(qp + 8 * i); q[8*i] = bflo(w.x); q[8*i+1] = bfhi(w.x); q[8*i+2] = bflo(w.y); q[8*i+3] = bfhi(w.y); q[8*i+4] = bflo(w.z); q[8*i+5] = bfhi(w.z); q[8*i+6] = bflo(w.w); q[8*i+7] = bfhi(w.w); } }
        float o[64];
#pragma unroll
        for (int d = 0; d < 64; ++d) o[d] = 0.f;
        float m = -1.0e30f, lsum = 0.f;
        for (int c = tq >> 6; c >= 0; --c) {
            const int key = c * 64 + lane; const bool ok = key <= tq;
            const bf16_t* kp = KM + (tb + (ok ? key : 0)) * 384 + h * 96; const bf16_t* vp = VM + (tb + (ok ? key : 0)) * 256 + h * 64;
            float z = 0.f;
#pragma unroll
            for (int i = 0; i < 12; ++i) { const u32x4 w = *(const u32x4*)(kp + 8 * i);
                z += q[8*i] * bflo(w.x) + q[8*i+1] * bfhi(w.x) + q[8*i+2] * bflo(w.y) + q[8*i+3] * bfhi(w.y) + q[8*i+4] * bflo(w.z) + q[8*i+5] * bfhi(w.z) + q[8*i+6] * bflo(w.w) + q[8*i+7] * bfhi(w.w); }
            z = ok ? z : -1.0e30f;
            float cm = z;
#pragma unroll
            for (int dd = 1; dd < 64; dd <<= 1) cm = fmaxf(cm, __shfl_xor(cm, dd));
            const float mn = fmaxf(m, cm), al = fexp2(m - mn), pw = ok ? fexp2(z - mn) : 0.f; m = mn; lsum = lsum * al + pw;
#pragma unroll
            for (int i = 0; i < 8; ++i) { const u32x4 w = *(const u32x4*)(vp + 8 * i);
                o[8*i] = o[8*i] * al + pw * bflo(w.x); o[8*i+1] = o[8*i+1] * al + pw * bfhi(w.x); o[8*i+2] = o[8*i+2] * al + pw * bflo(w.y); o[8*i+3] = o[8*i+3] * al + pw * bfhi(w.y);
                o[8*i+4] = o[8*i+4] * al + pw * bflo(w.z); o[8*i+5] = o[8*i+5] * al + pw * bfhi(w.z); o[8*i+6] = o[8*i+6] * al + pw * bflo(w.w); o[8*i+7] = o[8*i+7] * al + pw * bfhi(w.w); }
        }
        const float lt = wave_sum(lsum); float mine = 0.f;
#pragma unroll
        for (int d = 0; d < 64; ++d) { const float sdd = wave_sum(o[d]); if (lane == d) mine = sdd; }
        Y[(size_t)t * 1024 + 768 + h * 64 + lane] = (bf16_t)(cvt_pk_bf16(mine / lt, 0.f) & 0xffffu);
    }
}
__device__ __forceinline__ void xattn_naive(const Ctx& C, int l) {
    const bf16_t* XQ = WSP(bf16_t, S_XQ); const bf16_t* KMEM = WSP(bf16_t, W_KMEM) + (size_t)l * NMEM * 1024; const bf16_t* VT = WSP(bf16_t, W_VMEMT) + (size_t)l * 1024 * NMEM; bf16_t* XO = WSP(bf16_t, S_XO); const int lane = C.lane;
    for (int item = GW; item < T * 4; item += NGW) {
        const int t = item >> 2, h = item & 3, b = t / SEQ;
        float z[4] = {0.f, 0.f, 0.f, 0.f};
        for (int d8 = 0; d8 < 32; ++d8) { const u32x4 qw = *(const u32x4*)(XQ + (size_t)t * 1024 + h * 256 + 8 * d8);
            const float qv[8] = {bflo(qw.x), bfhi(qw.x), bflo(qw.y), bfhi(qw.y), bflo(qw.z), bfhi(qw.z), bflo(qw.w), bfhi(qw.w)};
#pragma unroll
            for (int j = 0; j < 4; ++j) { const u32x4 kw = *(const u32x4*)(KMEM + (size_t)(b * 256 + lane + 64 * j) * 1024 + h * 256 + 8 * d8);
                z[j] += qv[0] * bflo(kw.x) + qv[1] * bfhi(kw.x) + qv[2] * bflo(kw.y) + qv[3] * bfhi(kw.y) + qv[4] * bflo(kw.z) + qv[5] * bfhi(kw.z) + qv[6] * bflo(kw.w) + qv[7] * bfhi(kw.w); } }
        float mx = fmaxf(fmaxf(z[0], z[1]), fmaxf(z[2], z[3]));
#pragma unroll
        for (int dd = 1; dd < 64; dd <<= 1) mx = fmaxf(mx, __shfl_xor(mx, dd));
        float p[4], ps = 0.f;
#pragma unroll
        for (int j = 0; j < 4; ++j) { p[j] = fexp2(z[j] - mx); ps += p[j]; }
        const float inv = 1.0f / wave_sum(ps);
        float o[4] = {0.f, 0.f, 0.f, 0.f};
        for (int mm = 0; mm < 256; ++mm) { const float pm = __shfl(p[mm >> 6], mm & 63);
#pragma unroll
            for (int jd = 0; jd < 4; ++jd) o[jd] += pm * bf2f(VT[(size_t)(h * 256 + lane + 64 * jd) * NMEM + b * 256 + mm]); }
#pragma unroll
        for (int jd = 0; jd < 4; ++jd) XO[(size_t)t * 1024 + h * 256 + lane + 64 * jd] = (bf16_t)(cvt_pk_bf16(o[jd] * inv, 0.f) & 0xffffu);
    }
}
__device__ __forceinline__ void ph_mixers(const Ctx& C, int l, int rep = 0) {
    unsigned* head = (unsigned*)(C.ws + WS_CTL) + CW_QUEUE + 64 * (l + 2 * rep);
    volatile LAS unsigned* slot = (volatile LAS unsigned*)(C.lds + LDSCTL_OFF + 64);
#ifdef TIME_VAR
    const unsigned var = __builtin_amdgcn_readfirstlane(__hip_atomic_load((const unsigned*)(C.ws + WS_CTL) + 200000, RLX_AGENT)) & 0xffu;
#else
    const unsigned var = 0u;
#endif
    constexpr int N_RW = 128, N_ATT = 768, N_CV = 384, NITEMS = N_RW + N_ATT + N_CV;
    const int cv_total = l == 0 ? tjobs_total<MIXJ0, 2>(C) : tjobs_total<MIXJ1, 3>(C), cv_chunk = (cv_total + N_CV - 1) / N_CV;
    for (;;) {
        __syncthreads();
        if (C.tid == 0) slot[0] = __hip_atomic_fetch_add(head, 1u, RLX_AGENT);
        __syncthreads();
        const int it = (int)slot[0];
        if (it >= NITEMS) break;
#ifndef NAIVE_SCAN
#define NAIVE_SCAN 0
#endif
        if (it < N_RW) { if (!(NAIVE_SCAN & 1) && !(var & 1u)) { rwkv_unit(C, l, it >> 3, (it >> 1) & 3, it & 1);
#ifdef TIME_RW2
            __syncthreads(); rwkv_unit(C, l, it >> 3, (it >> 1) & 3, it & 1);
#endif
        } }
        else if ((it - N_RW) % 3 == 2) { const int c0 = ((it - N_RW) / 3) * cv_chunk, c1 = min(c0 + cv_chunk, cv_total);
            if (l == 0) run_tjobs_range<MIXJ0, 2>(C, c0 + C.wave, NWAVES, c1); else run_tjobs_range<MIXJ1, 3>(C, c0 + C.wave, NWAVES, c1); }
        else { const int k = ((it - N_RW) / 3) * 2 + (it - N_RW) % 3; const int mode = k >> 8, kk_ = k & 255, pp = kk_ & 3, bh = kk_ >> 2, b = bh >> 2, h = bh & 3;
            if (mode == 0) { if (!(NAIVE_SCAN & 2) && !(var & 2u)) { attn_unit<2>(C, l, b, h, 7 - pp, var); __syncthreads(); attn_unit<2>(C, l, b, h, pp, var);
#ifdef TIME_SSDA2
                __syncthreads(); attn_unit<2>(C, l, b, h, 7 - pp); __syncthreads(); attn_unit<2>(C, l, b, h, pp);
#endif
            } }
#ifndef NAIVE_SB
            else if (mode == 2) { if (!(var & 8u)) { attn_unit<0>(C, l, b, h, 7 - pp, var); __syncthreads(); attn_unit<0>(C, l, b, h, pp, var); }
#ifdef TIME_SB2
                __syncthreads(); attn_unit<0>(C, l, b, h, 7 - pp); __syncthreads(); attn_unit<0>(C, l, b, h, pp);
#endif
            }
#else
            else if (mode == 2) { }
#endif
#ifndef NAIVE_MLA
            else { if (!(var & 4u)) { attn_unit<1>(C, l, b, h, 7 - pp, var); __syncthreads(); attn_unit<1>(C, l, b, h, pp, var); }
#ifdef TIME_MLA2
                __syncthreads(); attn_unit<1>(C, l, b, h, 7 - pp); __syncthreads(); attn_unit<1>(C, l, b, h, pp);
#endif
            }
#else
            else { }
#endif
        }
    }
#ifdef NAIVE_SB
    sb_naive(C);
#endif
#ifdef NAIVE_MLA
    mla_naive(C);
#endif
    if (NAIVE_SCAN & 1) rwkv_naive(C, l);
    if (NAIVE_SCAN & 2) ssd_naive(C, l);
}
__device__ __forceinline__ void ph_router(const Ctx& C, const bf16_t* src16, bf16_t* dstb, const float* g, const float* b) {
#ifdef TIME_VAR
    const unsigned var = __builtin_amdgcn_readfirstlane(__hip_atomic_load((const unsigned*)(C.ws + WS_CTL) + 200000, RLX_AGENT)) & 0xffu;
#else
    const unsigned var = 0u;
#endif
    LAS unsigned* lc = (LAS unsigned*)(C.lds + XCH_OFF);
    if (C.tid < 8) lc[C.tid] = 0u;
    __syncthreads();
    const float* rt = C.in[I_ROUTER]; int* topi = WSP(int, S_TOPI); float* topw = WSP(float, S_TOPW); const int lane = C.lane;
    f32x4 gv[4], bv[4];
#pragma unroll
    for (int j = 0; j < 4; ++j) { gv[j] = *(const f32x4*)(g + 4 * lane + 256 * j); bv[j] = *(const f32x4*)(b + 4 * lane + 256 * j); }
    u32x2 nx[4];
#define RT_LOAD(kk_) do { const int t_ = C.bid * 128 + C.wave * 16 + (kk_); _Pragma("unroll") for (int j = 0; j < 4; ++j) nx[j] = *(const u32x2*)(src16 + (size_t)t_ * 1024 + 4 * lane + 256 * j); } while (0)
    RT_LOAD(0);
    f32x4 rw0[16], rw1[16];
#pragma unroll
    for (int jq = 0; jq < 16; ++jq) { const float* rp = rt + (size_t)(4 * lane + 256 * (jq >> 2) + (jq & 3)) * 8; rw0[jq] = *(const f32x4*)rp; rw1[jq] = *(const f32x4*)(rp + 4); }
    for (int k = 0; k < ((var & 2u) ? 0 : 16); ++k) {
        const int t = C.bid * 128 + C.wave * 16 + k; float a[8]; f32x4 xv4[4]; float s = 0.f;
#pragma unroll
        for (int j = 0; j < 4; ++j) { xv4[j] = (f32x4){bflo(nx[j].x), bfhi(nx[j].x), bflo(nx[j].y), bfhi(nx[j].y)}; s += (xv4[j][0] + xv4[j][1]) + (xv4[j][2] + xv4[j][3]); }
        if (k + 1 < 16) RT_LOAD(k + 1);
        const float mean = wave_sum(s) * (1.0f / 1024.0f); float s2 = 0.f;
#pragma unroll
        for (int j = 0; j < 4; ++j) { xv4[j] = xv4[j] - mean; s2 += (xv4[j][0] * xv4[j][0] + xv4[j][1] * xv4[j][1]) + (xv4[j][2] * xv4[j][2] + xv4[j][3] * xv4[j][3]); }
        const float rstd = 1.0f / sqrtf(wave_sum(s2) * (1.0f / 1024.0f) + 1e-5f);
#pragma unroll
        for (int j = 0; j < 4; ++j) { xv4[j] = xv4[j] * rstd * gv[j] + bv[j]; st_bf4(dstb + (size_t)t * 1024 + 4 * lane + 256 * j, xv4[j]); }
#pragma unroll
        for (int e = 0; e < 8; ++e) a[e] = 0.f;
#pragma unroll
        for (int jq = 0; jq < 16; ++jq) { const float xq = xv4[jq >> 2][jq & 3]; const f32x4 r0 = rw0[jq], r1 = rw1[jq];
            a[0] += xq * r0[0]; a[1] += xq * r0[1]; a[2] += xq * r0[2]; a[3] += xq * r0[3]; a[4] += xq * r1[0]; a[5] += xq * r1[1]; a[6] += xq * r1[2]; a[7] += xq * r1[3]; }
#pragma unroll
        for (int e = 0; e < 8; ++e) a[e] = wave_sum(a[e]);
#ifdef ROUTER_NOISE
        for (int e = 0; e < 8; ++e) { unsigned hsh = (unsigned)t * 2654435761u + (unsigned)e * 40503u; hsh ^= hsh >> 13; hsh *= 0x5bd1e995u; hsh ^= hsh >> 15; a[e] += ROUTER_NOISE * ((float)(hsh & 0xffff) * (1.0f / 32768.0f) - 1.0f); }
#endif
        if (lane == 0) {
            int i1 = 0; float v1 = a[0];
#pragma unroll
            for (int e = 1; e < 8; ++e) if (a[e] > v1) { v1 = a[e]; i1 = e; }
            int i2 = -1; float v2 = -3.0e38f;
#pragma unroll
            for (int e = 0; e < 8; ++e) if (e != i1 && a[e] > v2) { v2 = a[e]; i2 = e; }
            const float g1 = 1.0f / (1.0f + expf(v2 - v1));
            topi[2 * t] = i1; topi[2 * t + 1] = i2; topw[2 * t] = g1; topw[2 * t + 1] = 1.0f - g1;
            __hip_atomic_fetch_add(&lc[i1], 1u, __ATOMIC_RELAXED, __HIP_MEMORY_SCOPE_WORKGROUP); __hip_atomic_fetch_add(&lc[i2], 1u, __ATOMIC_RELAXED, __HIP_MEMORY_SCOPE_WORKGROUP);
        }
    }
    __syncthreads();
    if (C.tid < 8) ((unsigned*)(C.ws + WS_CTL))[CW_MOECNT + C.bid * 8 + C.tid] = lc[C.tid];
}
__device__ __forceinline__ void ph_scatter(const Ctx& C) {
    LAS int* sh = (LAS int*)(C.lds + XCH_OFF);
    const unsigned* cnt = (const unsigned*)(C.ws + WS_CTL) + CW_MOECNT;
    int* row_slot = WSP(int, S_ROWSLOT); float* row_w = WSP(float, S_ROWW); int* blk_e = WSP(int, S_BLKE);
    const int* topi = WSP(int, S_TOPI); const float* topw = WSP(float, S_TOPW);
    const int tid = C.tid;
    if (tid < 48) sh[tid] = 0;
    __syncthreads();
    { const int wg = tid & 255, e0 = (tid >> 8) * 4; const u32x4 c4 = *(const u32x4*)(cnt + wg * 8 + e0);
      const unsigned cv[4] = {c4.x, c4.y, c4.z, c4.w};
#pragma unroll
      for (int j = 0; j < 4; ++j) { __hip_atomic_fetch_add(&sh[e0 + j], (int)cv[j], __ATOMIC_RELAXED, __HIP_MEMORY_SCOPE_WORKGROUP); if (wg < C.bid) __hip_atomic_fetch_add(&sh[8 + e0 + j], (int)cv[j], __ATOMIC_RELAXED, __HIP_MEMORY_SCOPE_WORKGROUP); } }
    __syncthreads();
    if (tid == 0) { int ps = 0; for (int e = 0; e < 8; ++e) { sh[16 + e] = ps; const int pad = (sh[e] + 255) / 256 * 256; sh[24 + e] = pad; ps += pad; } sh[40] = ps / 256; }
    __syncthreads();
    if (C.bid == 0) {
        const int used = sh[40];
        for (int rb = tid; rb < MOE_BLOCKS; rb += NTHREADS) { int e = 7; if (rb < used) { e = 0; for (int q = 1; q < 8; ++q) if (sh[16 + q] <= rb * 256) e = q; } blk_e[rb] = e; }
        if (tid == 0) blk_e[MOE_BLOCKS] = used;
    }
    if (C.bid < 8) { const int e = C.bid; for (int r = sh[16 + e] + sh[e] + tid; r < sh[16 + e] + sh[24 + e]; r += NTHREADS) { row_slot[r] = -1; row_w[r] = 0.f; } }
    if (tid < 256) { const int t = C.bid * 128 + (tid >> 1), k = tid & 1, e = topi[2 * t + k];
        const int pos = __hip_atomic_fetch_add(&sh[32 + e], 1, __ATOMIC_RELAXED, __HIP_MEMORY_SCOPE_WORKGROUP); const int dest = sh[16 + e] + sh[8 + e] + pos; row_slot[dest] = 2 * t + k; row_w[dest] = topw[2 * t + k]; sh[64 + tid] = dest; }
    __syncthreads();
    const bf16_t* xb = WSP(bf16_t, W_XB); bf16_t* xs = WSP(bf16_t, S_XS);
    { u32x4 va[2][2]; const int a0 = C.wave * 32;
#define SC_LOAD(buf, a_) do { _Pragma("unroll") for (int u = 0; u < 2; ++u) { const int t_ = C.bid * 128 + (((a_) + u) >> 1); _Pragma("unroll") for (int j = 0; j < 2; ++j) buf[u][j] = *(const u32x4*)(xb + (size_t)t_ * 1024 + (C.lane + 64 * j) * 8); } } while (0)
#define SC_STORE(buf, a_) do { _Pragma("unroll") for (int u = 0; u < 2; ++u) { const size_t d_ = (size_t)sh[64 + (a_) + u] * 1024; _Pragma("unroll") for (int j = 0; j < 2; ++j) *(u32x4*)(xs + d_ + (C.lane + 64 * j) * 8) = buf[u][j]; } } while (0)
      u32x4 vb[2][2];
      SC_LOAD(va, a0);
      for (int a = a0; a < a0 + 32; a += 4) { SC_LOAD(vb, a + 2); SC_STORE(va, a); if (a + 4 < a0 + 32) SC_LOAD(va, a + 4); SC_STORE(vb, a + 2); }
#undef SC_LOAD
#undef SC_STORE
    }
}


__device__ __forceinline__ void chk_moe(const Ctx& C, int bit) {
    const float* xr = WSP(float, W_XRES); const float* rt = C.in[I_ROUTER]; const float* w13 = C.in[I_MOE13]; const float* w2 = C.in[I_MOE2]; const bf16_t* ys = WSP(bf16_t, S_YS);
    LAS float* hb = (LAS float*)(C.lds + C.wave * 14336); const int lane = C.lane; unsigned bad = 0;
    float* stash = WSP(float, W_KMEM); const float* g3 = C.in[I_LN3G] + 1024; const float* b3 = C.in[I_LN3B] + 1024;
    for (int s = GW; s < 1024; s += NGW) {
        const int t = (int)(((long)s * 1021 + 7) % T); float x[16];
#pragma unroll
        for (int j = 0; j < 16; ++j) x[j] = xr[(size_t)t * 1024 + lane + 64 * j];
        float lg[8];
#pragma unroll
        for (int e = 0; e < 8; ++e) { float a = 0.f;
#pragma unroll
            for (int j = 0; j < 16; ++j) a += x[j] * rt[(size_t)(lane + 64 * j) * 8 + e]; lg[e] = wave_sum(a); }
        int i1 = 0; for (int e = 1; e < 8; ++e) if (lg[e] > lg[i1]) i1 = e;
        int i2 = -1; for (int e = 0; e < 8; ++e) if (e != i1 && (i2 < 0 || lg[e] > lg[i2])) i2 = e;
        float v3 = -3.0e38f; for (int e = 0; e < 8; ++e) if (e != i1 && e != i2) v3 = fmaxf(v3, lg[e]);
        if (lg[i2] - v3 < 0.02f) { if (lane == 0) stash[(size_t)s * 1024] = 1.0e30f; continue; }
        const float g1 = 1.0f / (1.0f + expf(lg[i2] - lg[i1]));
        float out[16];
#pragma unroll
        for (int j = 0; j < 16; ++j) out[j] = 0.f;
        for (int q = 0; q < 2; ++q) { const int e = q ? i2 : i1; const float gw = q ? 1.0f - g1 : g1; const float* W1 = w13 + (size_t)e * 1024 * 2 * FFE;
            for (int i0 = 0; i0 < 56; i0 += 4) { float ag[4], au[4];
#pragma unroll
                for (int i = 0; i < 4; ++i) { ag[i] = 0.f; au[i] = 0.f; }
                for (int k = 0; k < 1024; ++k) { const float xk = __shfl(x[k >> 6], k & 63); const float* wr = W1 + (size_t)k * 2 * FFE + lane + 64 * i0;
#pragma unroll
                    for (int i = 0; i < 4; ++i) { ag[i] += xk * wr[64 * i]; au[i] += xk * wr[FFE + 64 * i]; } }
#pragma unroll
                for (int i = 0; i < 4; ++i) hb[lane + 64 * (i0 + i)] = (ag[i] / (1.0f + expf(-ag[i]))) * au[i]; }
            LDS_WAIT();
            const float* W2 = w2 + (size_t)e * FFE * 1024;
            for (int hh = 0; hh < FFE; ++hh) { const float hv = hb[hh] * gw;
#pragma unroll
                for (int j = 0; j < 16; ++j) out[j] += hv * W2[(size_t)hh * 1024 + lane + 64 * j]; }
            LDS_WAIT(); }
#pragma unroll
        for (int j = 0; j < 16; ++j) { const int c = lane + 64 * j; const float got = bf2f(ys[(size_t)(2 * t) * 1024 + c]) + bf2f(ys[(size_t)(2 * t + 1) * 1024 + c]);
            if (fabsf(got - out[j]) > 0.05f * fabsf(out[j]) + 0.03f) bad = 1; }
        { float v[16], sm = 0.f, s2 = 0.f;
#pragma unroll
          for (int j = 0; j < 16; ++j) { v[j] = x[j] * DN_ALPHA + out[j]; sm += v[j]; }
          const float mean = wave_sum(sm) * (1.0f / 1024.0f);
#pragma unroll
          for (int j = 0; j < 16; ++j) { v[j] -= mean; s2 += v[j] * v[j]; }
          const float rstd = 1.0f / sqrtf(wave_sum(s2) * (1.0f / 1024.0f) + 1e-5f);
          int zz = 0; asm volatile("" : "+v"(zz));
#pragma unroll
          for (int j = 0; j < 16; ++j) { const int c = lane + 64 * j + zz; stash[(size_t)s * 1024 + c] = v[j] * rstd * g3[c] + b3[c]; } }
    }
    chk_flag(C, bit, bad);
}
#ifndef ABL_MIX
#define ABL_MIX 1.0f
#endif
#ifndef ABL_XA
#define ABL_XA 1.0f
#endif
#ifndef ABL_FF
#define ABL_FF 1.0f
#endif
#ifndef CHK_TOL2
#define CHK_TOL2 0.05f
#endif
#ifndef GATE_ACT
#define GATE_ACT 1
#endif
#ifndef GATE_ALIGN
#define GATE_ALIGN true
#endif
#ifndef FG_TOL
#define FG_TOL 0.05f
#endif
#ifndef FG_BIT
#define FG_BIT 1
#endif
#ifndef CHECKS_LAYER
#define CHECKS_LAYER 0
#endif
#ifndef MK_SPLIT
#define MK_SPLIT 0
#endif
constexpr int PH_L0 = 1, PH_L1 = 16, PH_MOE = 28, PH_TOTAL = PH_MOE + 1 + 2 * MOE_PASSES + 1;

__global__ void __launch_bounds__(NTHREADS, 2) hybrid_fwd(Args args) {
    extern __shared__ __attribute__((aligned(16))) unsigned char lds_raw[];
    Ctx C; C.in = args.in; C.out = args.out; C.ws = args.ws; C.lds = (LAS unsigned char*)lds_raw;
    C.tid = threadIdx.x; C.lane = C.tid & 63; C.wave = __builtin_amdgcn_readfirstlane(C.tid >> 6); C.G = gridDim.x; C.bid = blockIdx.x;
    const Ctx C0 = C;
    for (int u = C.tid; u < (LDS_BYTES - LDSCTL_OFF) / 4; u += NTHREADS) ((LAS unsigned*)(C.lds + LDSCTL_OFF))[u] = 0u;
    __syncthreads();
    const int lo = args.ph_lo, hi = args.ph_hi;
    XcdBarrier bar; bar.bar = (unsigned*)(C.ws + WS_CTL) + CW_BAR; bar.x = 0; bar.st = (volatile LAS unsigned*)(C.lds + LDSCTL_OFF);
    if (hi - lo > 1) bar = xcd_barrier_post((unsigned*)(C.ws + WS_CTL) + CW_BAR, (volatile LAS unsigned*)(C.lds + LDSCTL_OFF));
#ifndef SITE_MASK
#define SITE_MASK 0xffffffffu
#endif
#define SITE(n) (((SITE_MASK) >> (n)) & 1u)
#define IN(k) (lo <= (k) && (k) < hi)
#define ENDPH(k) do { if ((k) + 1 < hi) xcd_barrier(bar); } while (0)
#define SITE_BEGIN const Ctx C = launder(C0); unsigned char* LW = C.ws + W_BASE + (size_t)l * LW_SIZE; const bf16_t* XB = WSP(bf16_t, W_XB); bf16_t* XRES = WSP(bf16_t, W_XRES); (void)LW; (void)XB; (void)XRES; LAS unsigned char* ring = C.lds; (void)ring;

    if (SITE(0) && IN(0)) { const int l = 0; SITE_BEGIN ph_prologue(C);
#ifdef TIME_PRO2
        xcd_barrier(bar); ph_prologue(C);
#endif
#ifdef TIME_BAR
        for (int q_ = 0; q_ < TIME_BAR; ++q_) xcd_barrier(bar);
#endif
        ENDPH(0); }

    for (int l = 0; l < 2; ++l) {
        const int pb = l == 0 ? PH_L0 : PH_L1;
        if (SITE(1) && IN(pb + 0)) { SITE_BEGIN
#ifdef CHECKS3
            if (l == 1) chk_ln_cmp(C, 1, 1);
#endif
            { pg8::Gemm g{XB, (const bf16_t*)(LW + LW_WIN), 1024, 1024, 1024}; sch::Tiles S{T / 256, NPROJ / 256, C.G, C.bid}; epi::StoreBf16<0> E{WSP(bf16_t, S_PROJ), NPROJ}; pg8::gemm_phase(ring, g, S, E); }
            { pg8::Gemm g{(const bf16_t*)C.ws, (const bf16_t*)C.ws, 1024, 1024, 1024}; sch::MemKV S{(long)(W_MEMB / 2), (long)((W_BASE + (size_t)l * LW_SIZE + LW_WKV) / 2), C.bid};
              epi::StoreBf16<0> E{WSP(bf16_t, W_KMEM) + (size_t)l * NMEM * 2048, 2048}; pg8::gemm_phase(ring, g, S, E); }
            ENDPH(pb + 0);
        }
        if (SITE(2) && IN(pb + 1)) { SITE_BEGIN
#ifdef CHECKS5
            if (l == 0) chk_weights<28, false>(C, 0);
#endif
#ifdef CHECKS9
            if (l == 0) { unsigned bad = 0; const float* x = C.in[I_X]; const float* mm = C.in[I_MEM]; const bf16_t* mb = WSP(bf16_t, W_MEMB);
                for (size_t i = (size_t)C.bid * NTHREADS + C.tid; i < (size_t)T * 1024; i += (size_t)C.G * NTHREADS) if (!chk_close(x[i], bf2f(XB[i]))) bad = 1;
                for (size_t i = (size_t)C.bid * NTHREADS + C.tid; i < (size_t)NMEM * 1024; i += (size_t)C.G * NTHREADS) if (!chk_close(mm[i], bf2f(mb[i]))) bad = 1;
                if (bad) __hip_atomic_fetch_add((unsigned*)(C.ws + WS_CTL) + CW_CHK, 1u, RLX_AGENT); }
#endif
#ifdef CHECKS12P
            if (l == CHECKS_LAYER) { const bf16_t* proj = WSP(bf16_t, S_PROJ); chk_full_gemm(C, XB, (const bf16_t*)(LW + LW_WIN), 1024, 3236, 0, [&](size_t r, int c, float d) { return chk_close(d, bf2f(proj[r * NPROJ + c])); }); xcd_barrier(bar); }
#endif
#ifdef CHECKS4
            if (l == CHECKS_LAYER) { const bf16_t* KM_ = WSP(bf16_t, W_KMEM) + (size_t)l * NMEM * 1024; const bf16_t* VT_ = WSP(bf16_t, W_VMEMT) + (size_t)l * 1024 * NMEM;
                chk_gemm(C, WSP(bf16_t, W_MEMB), 1024, (const bf16_t*)(LW + LW_WKV), 1024, 1024, NMEM, 64, 16, 3, 0, [&](int r, int c, float d) { return chk_close(d, bf2f(KM_[(size_t)r * 1024 + c])); });
                chk_gemm(C, (const bf16_t*)(LW + LW_WKV) + (size_t)1024 * 1024, 1024, WSP(bf16_t, W_MEMB), 1024, 1024, 1024, 256, 16, 5, 1, [&](int r, int c, float d) { return chk_close(d, bf2f(VT_[(size_t)r * NMEM + c])); }); }
#endif
#ifdef CHECKS
            if (l == CHECKS_LAYER) { const bf16_t* proj = WSP(bf16_t, S_PROJ); chk_gemm(C, XB, 1024, (const bf16_t*)(LW + LW_WIN), 1024, 1024, T, 13, 256, 7, 0, [&](int r, int c, float d) { return chk_close(d, bf2f(proj[(size_t)r * NPROJ + c])); }); }
#endif
            ph_prep(C, l);
#ifdef TIME_PREP2
            xcd_barrier(bar); ph_prep(C, l);
#endif
            ENDPH(pb + 1); }
        if (SITE(3) && IN(pb + 2)) { SITE_BEGIN
            { pg8::Gemm g{WSP(bf16_t, S_LA), (const bf16_t*)(LW + LW_LORA), 256, 256, 256}; sch::Tiles S{T / 256, 3, C.G, C.bid}; epi::Lora E{WSP(float, S_DEC), WSP(bf16_t, S_AV), WSP(bf16_t, S_GV), C.in[I_RWW0] + l * 256, C.in[I_RWA0] + l * 256}; pg8::gemm_phase(ring, g, S, E); }
            { pg8::Gemm g{WSP(bf16_t, S_CQN), (const bf16_t*)(LW + LW_WUQ), 256, 256, 256}; sch::Tiles S{T / 256, 2, C.G, (C.bid + 128) & 255}; epi::Uq E{WSP(bf16_t, S_QM), WSP(float, W_COS), WSP(float, W_SIN)}; pg8::gemm_phase(ring, g, S, E); }
            { pg8::Gemm g{WSP(bf16_t, S_CKVN), (const bf16_t*)(LW + LW_WUKV), 128, 128, 128}; sch::Tiles S{T / 256, 2, C.G, C.bid}; epi::Ukv E{WSP(bf16_t, S_KM), WSP(bf16_t, S_VM)}; pg8::gemm_phase(ring, g, S, E); }
            ENDPH(pb + 2);
        }
        if (SITE(4) && IN(pb + 3)) { SITE_BEGIN ph_rwprep(C, l); ph_ssdprep(C, l);
#ifdef TIME_RWP2
            xcd_barrier(bar); ph_rwprep(C, l); ph_ssdprep(C, l);
#endif
            ENDPH(pb + 3); }
        if (SITE(5) && IN(pb + 4)) { SITE_BEGIN
#ifdef CHECKS6
            if (l == CHECKS_LAYER) chk_mla_inputs(C, l, 0);
#endif
#ifdef CHECKS7
            if (l == CHECKS_LAYER) chk_rw_inputs(C, l, 0);
#endif
            ph_mixers(C, l);
#ifdef TIME_MIX2
            xcd_barrier(bar); ph_mixers(C, l, 1);
#endif
            ENDPH(pb + 4); }
        if (SITE(6) && IN(pb + 5)) { SITE_BEGIN
            ph_ssdfix(C, l);
            { pg8::Gemm g{XB, (const bf16_t*)(LW + LW_WGATE), 1024, 1024, 1024}; sch::Tiles S{T / 256, 16, C.G, C.bid}; epi::StoreBf16<GATE_ACT> E{WSP(bf16_t, S_G), 4096}; pg8::gemm_phase<epi::StoreBf16<GATE_ACT>, sch::Tiles, GATE_ALIGN>(ring, g, S, E);
#ifdef TIME_GATE2
              xcd_barrier(bar); pg8::gemm_phase<epi::StoreBf16<GATE_ACT>, sch::Tiles, GATE_ALIGN>(ring, g, S, E);
#endif
            }
#ifdef CHECKS14
            if (l == 0) { xcd_barrier(bar); const bf16_t* Gp = WSP(bf16_t, S_G); chk_full_gemm(C, XB, (const bf16_t*)(LW + LW_WGATE), 1024, 4096, 0, [&](size_t r, int c, float d) { return chk_close(sigmoidf_(d), bf2f(Gp[r * 4096 + c])); }); }
#endif
#ifdef CHECKS13
            if (l == 0) { xcd_barrier(bar);
              { pg8::Gemm g{XB, (const bf16_t*)(LW + LW_WGATE), 1024, 1024, 1024}; sch::Tiles S{T / 256, 16, C.G, C.bid}; epi::StoreBf16<1> E{WSP(bf16_t, S_G) + (size_t)T * 4096, 4096}; pg8::gemm_phase(ring, g, S, E); }
              xcd_barrier(bar);
              { const unsigned short* g1 = WSP(unsigned short, S_G); const unsigned short* g2 = g1 + (size_t)T * 4096; unsigned cnt = 0;
                for (size_t i = (size_t)C.bid * NTHREADS + C.tid; i < (size_t)T * 4096; i += (size_t)C.G * NTHREADS) if (g1[i] != g2[i]) ++cnt;
                if (cnt) __hip_atomic_fetch_add((unsigned*)(C.ws + WS_CTL) + CW_CHK + 2048, cnt, RLX_AGENT); } }
#endif
            ENDPH(pb + 5);
        }
        if (SITE(7) && IN(pb + 6)) { SITE_BEGIN
#ifdef FIX_G
            { bf16_t* Gw = WSP(bf16_t, S_G); const bf16_t* Wg = (const bf16_t*)(LW + LW_WGATE);
              for (size_t i = (size_t)C.bid * NTHREADS + C.tid; i < (size_t)T * 4096; i += (size_t)C.G * NTHREADS) { const size_t r = i >> 12; const int c = (int)(i & 4095);
                  Gw[i] = (bf16_t)(cvt_pk_bf16(sigmoidf_(tdot(XB + r * 1024, Wg + (size_t)c * 1024, 1024)), 0.f) & 0xffffu); }
              xcd_barrier(bar); }
#endif
#ifdef CHECKS15
            if (l == 0) { unsigned cnt = 0; const float* x = C.in[I_X];
                for (size_t i = (size_t)C.bid * NTHREADS + C.tid; i < (size_t)T * 1024; i += (size_t)C.G * NTHREADS) if (!chk_close(x[i], bf2f(XB[i]))) ++cnt;
                if (cnt) __hip_atomic_fetch_add((unsigned*)(C.ws + WS_CTL) + CW_CHK + 2048, cnt, RLX_AGENT); }
#endif
#ifdef CHECKS7
            if (l == CHECKS_LAYER) chk_ssd_norm(C, l, 1);
#endif
#ifdef CHECKS12
            if (l == CHECKS_LAYER) { const bf16_t* Gp = WSP(bf16_t, S_G); chk_full_gemm(C, XB, (const bf16_t*)(LW + LW_WGATE), 1024, 4096, FG_BIT, [&](size_t r, int c, float d) { return fabsf((GATE_ACT ? sigmoidf_(d) : d) - bf2f(Gp[r * 4096 + c])) <= FG_TOL; }); xcd_barrier(bar); }
#endif
#ifdef CHECKS
            if (l == CHECKS_LAYER) { const bf16_t* Gp = WSP(bf16_t, S_G); chk_gemm(C, XB, 1024, (const bf16_t*)(LW + LW_WGATE), 1024, 1024, T, 16, 256, 5, 1, [&](int r, int c, float d) { return chk_close(sigmoidf_(d), bf2f(Gp[(size_t)r * 4096 + c])); }); }
#endif
#ifdef BR_FULL
            { pg8::Gemm g{WSP(bf16_t, S_Y), (const bf16_t*)(LW + LW_WBR), 256, 1024, 256}; sch::BrTiles S{T / 256, 4, C.G, C.bid}; epi::BrGate E{WSP(bf16_t, S_G), WSP(float, S_MF), WSP(bf16_t, S_MB)}; pg8::gemm_phase(ring, g, S, E);
#else
            { pg8::Gemm g{WSP(bf16_t, S_Y), (const bf16_t*)(LW + LW_WBR), 256, 1024, 256}; sch::BrTilesH S{T / 256, 8, C.G, C.bid}; epi::BrGateH E; E.G = WSP(bf16_t, S_G); E.mb = WSP(bf16_t, S_MB); E.init(); pg8::gemm_phase_hn(ring, g, S, E);
#endif
#ifdef TIME_BR2
              xcd_barrier(bar); pg8::gemm_phase(ring, g, S, E);
#endif
            }
            ENDPH(pb + 6);
        }
        if (SITE(8) && IN(pb + 7)) { SITE_BEGIN
#ifdef CHECKS2
            if (l == CHECKS_LAYER) chk_merged(C, l, 0);
#endif
            { pg8::Gemm g{WSP(bf16_t, S_MB), (const bf16_t*)(LW + LW_WOUT), 1024, 1024, 1024}; sch::Tiles S{T / 256, 4, C.G, C.bid}; epi::Resid E{C.in[I_X], XRES, ABL_MIX, l == 0 ? nullptr : XB}; pg8::gemm_phase(ring, g, S, E); }
            ENDPH(pb + 7);
        }
        if (SITE(9) && IN(pb + 8)) { SITE_BEGIN
#ifdef CHECKS10
            if (l == 0) { chk_full_p7(C, l, 1); xcd_barrier(bar); }
#endif
#ifdef CHECKS
            if (l == 0) { const float* xin = C.in[I_X]; chk_gemm(C, WSP(bf16_t, S_MB), 1024, (const bf16_t*)(LW + LW_WOUT), 1024, 1024, T, 4, 256, 9, 2, [&](int r, int c, float d) { return fabsf(xin[(size_t)r * 1024 + c] * DN_ALPHA + d - XRES[(size_t)r * 1024 + c]) <= CHK_TOL2; }); }
#endif
            ph_ln<false>(C, nullptr, nullptr, WSP(bf16_t, W_XB), C.in[I_LN1G] + l * 1024, C.in[I_LN1B] + l * 1024, nullptr, XRES);
            { const bf16_t* KV = WSP(bf16_t, W_KMEM) + (size_t)l * NMEM * 2048;
              { pg8::Gemm g{KV, (const bf16_t*)(LW + LW_WQ), 256, 2048, 1024}; sch::AbsM S{C.bid}; epi::StoreAt E{WSP(bf16_t, S_XQ), 1024}; pg8::gemm_phase(ring, g, S, E); }
              { pg8::Gemm g{(const bf16_t*)(LW + LW_WO), KV + 1024, 256, 1024, 2048}; sch::AbsN S{C.bid}; epi::StoreAt E{WSP(bf16_t, S_XO), 1024}; pg8::gemm_phase(ring, g, S, E); } }
#ifdef TIME_LN2
            xcd_barrier(bar); ph_ln<false>(C, nullptr, nullptr, WSP(bf16_t, W_XB), C.in[I_LN1G] + l * 1024, C.in[I_LN1B] + l * 1024, nullptr, XRES);
#endif
            ENDPH(pb + 8); }
        if (SITE(10) && IN(pb + 9)) { SITE_BEGIN
            { pg8::Gemm g{XB, WSP(bf16_t, S_XQ), 1024, 1024, 1024}; sch::XaS S{C.G, C.bid}; epi::Softmax E{WSP(bf16_t, S_XP), (LAS float*)(C.lds + XCH_OFF)}; pg8::gemm_phase(ring, g, S, E); }
            ENDPH(pb + 9);
        }
        if (SITE(13) && IN(pb + 10)) { SITE_BEGIN
            { pg8::Gemm g{WSP(bf16_t, S_XP), WSP(bf16_t, S_XO), 1024, 1024, 1024}; sch::XaO S{C.G, C.bid}; epi::Resid E{nullptr, XRES, ABL_XA, XB}; pg8::gemm_phase(ring, g, S, E); }
            ENDPH(pb + 10);
        }
        if (SITE(14) && IN(pb + 11)) { SITE_BEGIN
#ifdef CHECKS3
            if (l == 0) chk_resid_cmp(C, 0, 2);
#endif
            if (l == 0) ph_ln<false>(C, nullptr, nullptr, WSP(bf16_t, W_XB), C.in[I_LN2G], C.in[I_LN2B], nullptr, XRES);
            else ph_router(C, XRES, WSP(bf16_t, W_XB), C.in[I_LN2G] + 1024, C.in[I_LN2B] + 1024);
            ENDPH(pb + 11); }
        if (l == 0) {
            if (SITE(15) && IN(pb + 12)) { SITE_BEGIN
                { pg8::Gemm g{XB, WSP(bf16_t, W_FFN13), 1024, 1024, 1024}; sch::Tiles S{T / 256, 2 * FFD / 256, C.G, C.bid}; epi::Swiglu E{WSP(bf16_t, S_H), FFD, 0}; pg8::gemm_phase(ring, g, S, E);
#ifdef TIME_UP2
                  for (int rep_ = 0; rep_ < 1; ++rep_) { xcd_barrier(bar); pg8::gemm_phase(ring, g, S, E); }
#endif
                }
                ENDPH(pb + 12);
            }
            if (SITE(16) && IN(pb + 13)) { SITE_BEGIN
#ifdef CHECKS2
                chk_swiglu(C, 1);
#endif
#ifdef CHECKS3
                chk_resid_stash(C, WSP(bf16_t, S_H), FFD, WSP(bf16_t, W_FFN2), FFD, FFD, 0); xcd_barrier(bar);
#endif
                { pg8::Gemm g{WSP(bf16_t, S_H), WSP(bf16_t, W_FFN2), FFD, FFD, FFD}; sch::Tiles S{T / 256, 4, C.G, C.bid}; epi::Resid E{nullptr, XRES, ABL_FF, XB}; pg8::gemm_phase(ring, g, S, E); }
                ENDPH(pb + 13);
            }
            if (SITE(17) && IN(pb + 14)) { SITE_BEGIN
#ifdef CHECKS3
                chk_resid_cmp(C, 0, 0); chk_ln_stash(C, C.in[I_LN3G], C.in[I_LN3B], 1); xcd_barrier(bar);
#endif
                ph_ln<false>(C, nullptr, nullptr, WSP(bf16_t, W_XB), C.in[I_LN3G], C.in[I_LN3B], nullptr, XRES); ENDPH(pb + 14); }
        } else {
            if (SITE(19) && IN(PH_MOE)) { SITE_BEGIN
#ifdef CHECKS5
                chk_weights<16, true>(C, 1);
#endif
                ph_scatter(C); ENDPH(PH_MOE); }
            for (int p = 0; p < MOE_PASSES; ++p) {
                const int* blk_e = WSP(int, S_BLKE);
                if (SITE(20) && IN(PH_MOE + 1 + 2 * p)) { SITE_BEGIN
                    const int used = __builtin_amdgcn_readfirstlane(__hip_atomic_load(blk_e + MOE_BLOCKS, RLX_AGENT)); const int b0 = p * MOE_PASS_BLOCKS, b1 = min(b0 + MOE_PASS_BLOCKS, used);
                    if (b1 > b0) { pg8::Gemm g{WSP(bf16_t, S_XS), (const bf16_t*)C.out, 1024, 1024, 1024}; sch::MoeUp S{blk_e, b0, b1, C.G, C.bid}; epi::Swiglu E{WSP(bf16_t, S_MH), FFE, 1}; pg8::gemm_phase(ring, g, S, E); }
                    ENDPH(PH_MOE + 1 + 2 * p);
                }
                if (SITE(21) && IN(PH_MOE + 2 + 2 * p)) { SITE_BEGIN
                    const int used = __builtin_amdgcn_readfirstlane(__hip_atomic_load(blk_e + MOE_BLOCKS, RLX_AGENT)); const int b0 = p * MOE_PASS_BLOCKS, b1 = min(b0 + MOE_PASS_BLOCKS, used);
                    if (b1 > b0) { pg8::Gemm g{WSP(bf16_t, S_MH), WSP(bf16_t, W_MW2), FFE, FFE, FFE}; sch::MoeDown S{blk_e, b0, b1, C.G, C.bid}; epi::MoeDown E{WSP(int, S_ROWSLOT), WSP(float, S_ROWW), WSP(bf16_t, S_YS)}; pg8::gemm_phase(ring, g, S, E); }
                    ENDPH(PH_MOE + 2 + 2 * p);
                }
            }
            if (SITE(22) && IN(PH_TOTAL - 1)) { SITE_BEGIN
#ifdef CHECKS8
                chk_moe(C, 0); xcd_barrier(bar);
#endif
#define FINAL_LN_SITE 1
 ph_ln<true>(C, nullptr, C.out, nullptr, C.in[I_LN3G] + 1024, C.in[I_LN3B] + 1024, WSP(bf16_t, S_YS), XB);
#ifdef CHECKS11
                xcd_barrier(bar);
                { unsigned cnt = 0; for (size_t i = (size_t)C.bid * NTHREADS + C.tid; i < (size_t)T * 1024; i += (size_t)C.G * NTHREADS) if (fabsf(C.out[i]) > CHK11_THR) ++cnt;
                  if (cnt) __hip_atomic_fetch_add((unsigned*)(C.ws + WS_CTL) + CW_CHK + 2048, cnt, RLX_AGENT); }
                xcd_barrier(bar);
                { unsigned v_ = __hip_atomic_load((const unsigned*)(C.ws + WS_CTL) + CW_CHK + 2048, RLX_AGENT); int n = 0; while (v_ > 0u) { ++n; v_ >>= 1; }
                  const float sc = 1.0f + 0.1f * (float)n; for (size_t i = (size_t)C.bid * NTHREADS + C.tid; i < (size_t)T * 1024; i += (size_t)C.G * NTHREADS) C.out[i] *= sc; }
#endif
#ifdef CHECKS8
                xcd_barrier(bar);
                { const float* stash = WSP(float, W_KMEM); unsigned bad = 0; const float cs = 1.0f; (void)cs;
                  for (int s = GW; s < 1024; s += NGW) { const int t = (int)(((long)s * 1021 + 7) % T); if (stash[(size_t)s * 1024] > 1.0e29f) continue;
                      for (int j = 0; j < 16; ++j) { const int c = C.lane + 64 * j; const float e = stash[(size_t)s * 1024 + c], gt = C.out[(size_t)t * 1024 + c]; if (fabsf(e - gt) > 0.05f * fabsf(e) + 0.05f) bad = 1; } }
                  chk_flag(C, 1, bad); }
                xcd_barrier(bar);
                { const unsigned* cw = (const unsigned*)(C.ws + WS_CTL) + CW_CHK; if (__hip_atomic_load(cw + 64, RLX_AGENT) != 0u) { for (size_t i = (size_t)C.bid * NTHREADS + C.tid; i < (size_t)T * 1024; i += (size_t)C.G * NTHREADS) C.out[i] *= 1.5f; } }
#endif
            }
        }
    }
#undef IN
#undef ENDPH
}

extern "C" void kernel_launch(void* const* d_in, const int* in_sizes, int n_in, void* d_out, int out_size, void* d_ws, size_t ws_size, hipStream_t stream) {
    static int grid = 0;
    if (grid == 0) {
        if (n_in != 42 || in_sizes[0] != T * DM || out_size != T * DM || ws_size < WS_NEED) { fprintf(stderr, "kernel_launch: unexpected problem (n_in %d, in0 %d, out %d, ws %zu < %zu)\n", n_in, n_in > 0 ? in_sizes[0] : -1, out_size, ws_size, (size_t)WS_NEED); grid = -1; return; }
        int dev = 0, cus = 0;
        if (hipGetDevice(&dev) != hipSuccess || hipDeviceGetAttribute(&cus, hipDeviceAttributeMultiprocessorCount, dev) != hipSuccess) { grid = -1; return; }
        if (hipFuncSetAttribute((const void*)hybrid_fwd, hipFuncAttributeMaxDynamicSharedMemorySize, LDS_BYTES) != hipSuccess) { fprintf(stderr, "kernel_launch: hipFuncSetAttribute failed\n"); grid = -1; return; }
        int per_cu = 0;
        if (hipOccupancyMaxActiveBlocksPerMultiprocessor(&per_cu, (const void*)hybrid_fwd, NTHREADS, LDS_BYTES) != hipSuccess || per_cu < 1) fprintf(stderr, "kernel_launch: occupancy query says %d\n", per_cu);
        (void)hipGetLastError();
        if (cus != 256) { fprintf(stderr, "kernel_launch: built for 256 CUs, device has %d\n", cus); grid = -1; return; }
        grid = 256;
    }
    if (grid < 0) return;
#ifdef ZERO_WS
    (void)hipMemsetAsync((char*)d_ws + ZERO_WS_LO, 0, ZERO_WS_HI - ZERO_WS_LO, stream);
#endif
    (void)hipMemsetAsync((char*)d_ws + WS_CTL, 0, CTL_BYTES, stream);
    Args a{};
    for (int i = 0; i < 42; ++i) a.in[i] = (const float*)d_in[i];
    a.out = (float*)d_out; a.ws = (unsigned char*)d_ws;
#if MK_SPLIT
    for (int p = 0; p < PH_TOTAL; ++p) { a.ph_lo = p; a.ph_hi = p + 1; hipLaunchKernelGGL(hybrid_fwd, dim3(grid), dim3(NTHREADS), LDS_BYTES, stream, a); }
#else
    a.ph_lo = 0; a.ph_hi = PH_TOTAL; hipLaunchKernelGGL(hybrid_fwd, dim3(grid), dim3(NTHREADS), LDS_BYTES, stream, a);
#ifdef TIME_LIST
#ifdef TIME_VAR
    (void)hipMemsetAsync((char*)d_ws + WS_CTL + 200000 * 4, TIME_VAR, 4, stream);
#endif
#ifdef TIME_QRESET
    (void)hipMemsetAsync((char*)d_ws + WS_CTL + (CW_QUEUE + 64 * TIME_QRESET) * 4, 0, 4, stream);
#endif
    { const int tl_[] = TIME_LIST; for (int r_ = 0; r_ < TIME_REP; ++r_) for (int q_ = 0; q_ < (int)(sizeof(tl_) / sizeof(int)); ++q_) { a.ph_lo = tl_[q_]; a.ph_hi = tl_[q_] + (tl_[q_] >= 0 ? 1 : 0); hipLaunchKernelGGL(hybrid_fwd, dim3(grid), dim3(NTHREADS), LDS_BYTES, stream, a); } }
#endif
#endif
}
```

```cpp
#define EPI_DEPTH 3
#include <hip/hip_runtime.h>
#include <cstdio>
#include <cstdint>

#define GAS __attribute__((address_space(1)))
#define LAS __attribute__((address_space(3)))
typedef unsigned short bf16_t;
typedef short bf16x8 __attribute__((ext_vector_type(8)));
typedef short bf16x4 __attribute__((ext_vector_type(4)));
typedef float f32x2 __attribute__((ext_vector_type(2)));
typedef float f32x4 __attribute__((ext_vector_type(4)));
typedef float f32x16 __attribute__((ext_vector_type(16)));
typedef unsigned u32x4 __attribute__((ext_vector_type(4)));
typedef unsigned u32x2 __attribute__((ext_vector_type(2)));
#define RLX_AGENT __ATOMIC_RELAXED, __HIP_MEMORY_SCOPE_AGENT

constexpr int NB = 16, SEQ = 2048, DM = 1024, T = NB * SEQ;
constexpr int NPROJ = 3328;
constexpr int PC_SBQ = 0, PC_SBK = 256, PC_SBV = 512, PC_RW = 768, PC_Z = 1792, PC_XS = 2048, PC_BM = 2304, PC_CM = 2560, PC_CQ = 2816, PC_CKV = 3072, PC_KR = 3200, PC_DT = 3232;
constexpr int MEMT = 256, NMEM = NB * MEMT;
constexpr int FFD = 2816, FFE = 3584, NEXP = 8;
constexpr int MOE_ROWS = 2 * T + NEXP * 256;
constexpr int MOE_BLOCKS = MOE_ROWS / 256;
constexpr int MOE_PASS_BLOCKS = 128, MOE_PASSES = 2;
constexpr float DN_ALPHA = 1.4142135623730951f;
constexpr float LOG2E = 1.4426950408889634f;

constexpr size_t MiB = 1u << 20;
constexpr size_t WS_CTL = 0, CTL_BYTES = 1 * MiB;
constexpr int CW_BAR = 1024;
constexpr int CW_QUEUE = 8192;
constexpr int CW_MOECNT = 16384;
constexpr size_t W_BASE = CTL_BYTES;
constexpr size_t LW_WIN = 0;
constexpr size_t LW_WGATE = LW_WIN + (size_t)NPROJ * 1024 * 2;
constexpr size_t LW_WBR = LW_WGATE + (size_t)4096 * 1024 * 2;
constexpr size_t LW_WOUT = LW_WBR + (size_t)4 * 1024 * 256 * 2;
constexpr size_t LW_LORA = LW_WOUT + (size_t)1024 * 1024 * 2;
constexpr size_t LW_WUQ = LW_LORA + (size_t)768 * 256 * 2;
constexpr size_t LW_WUKV = LW_WUQ + (size_t)512 * 256 * 2;
constexpr size_t LW_WQ = LW_WUKV + (size_t)512 * 128 * 2;
constexpr size_t LW_WKV = LW_WQ + (size_t)1024 * 1024 * 2;
constexpr size_t LW_WO = LW_WKV + (size_t)2048 * 1024 * 2;
constexpr size_t LW_SIZE = LW_WO + (size_t)1024 * 1024 * 2;
constexpr size_t W_FFN13 = W_BASE + 2 * LW_SIZE;
constexpr size_t W_FFN2 = W_FFN13 + (size_t)2 * FFD * 1024 * 2;
constexpr size_t W_KMEM = W_FFN2 + (size_t)1024 * FFD * 2;
constexpr size_t W_VMEMT = W_KMEM + (size_t)2 * NMEM * 1024 * 2;
constexpr size_t W_MEMB = W_VMEMT + (size_t)2 * 1024 * NMEM * 2;
constexpr size_t W_COS = W_MEMB + (size_t)NMEM * 1024 * 2;
constexpr size_t W_SIN = W_COS + (size_t)T * 16 * 4;
constexpr size_t W_XB = W_SIN + (size_t)T * 16 * 4;
constexpr size_t W_XRES = W_XB + (size_t)T * 1024 * 2;
constexpr size_t W_MW2 = W_XRES + (size_t)T * 1024 * 2;
constexpr size_t S_BASE = W_XRES + (size_t)T * 1024 * 4;
constexpr size_t S_Y = S_BASE;
constexpr size_t S_SSQ = S_Y + (size_t)T * 1024 * 2;
constexpr size_t S_PROJ = S_SSQ + (size_t)T * 8 * 4;
constexpr size_t S_LA = S_PROJ + (size_t)T * NPROJ * 2;
constexpr size_t S_CQN = S_LA + (size_t)T * 256 * 2;
constexpr size_t S_CKVN = S_CQN + (size_t)T * 256 * 2;
constexpr size_t S_DEC = S_CKVN + (size_t)T * 128 * 2;
constexpr size_t S_AV = S_DEC + (size_t)T * 256 * 4;
constexpr size_t S_GV = S_AV + (size_t)T * 256 * 2;
constexpr size_t S_QM = S_GV + (size_t)T * 256 * 2;
constexpr size_t S_KM = S_QM + (size_t)T * 384 * 2;
constexpr size_t S_VM = S_KM + (size_t)T * 384 * 2;
constexpr size_t S_RWS = S_VM + (size_t)T * 256 * 2;
constexpr size_t S_XA = S_RWS + (size_t)5 * T * 256 * 2;
constexpr size_t S_BC = S_XA + (size_t)T * 256 * 2;
constexpr size_t S_CC = S_BC + (size_t)T * 256 * 2;
constexpr size_t S_ACS = S_CC + (size_t)T * 256 * 2;
constexpr size_t S_DTV = S_ACS + (size_t)T * 4 * 4;
constexpr size_t S_YRAW = S_DTV + (size_t)T * 4 * 4;
constexpr size_t S_MIX_END = S_YRAW + (size_t)T * 256 * 2;
constexpr size_t S_G = S_PROJ;
constexpr size_t S_MF = S_G + (size_t)T * 4096 * 2;
constexpr size_t S_MB = S_MF + (size_t)T * 1024 * 4;
constexpr size_t S_GATE_END = S_MB + (size_t)T * 1024 * 2;
constexpr size_t S_XQ = S_BASE;
constexpr size_t S_XP = S_XQ + (size_t)T * 1024 * 2;
constexpr size_t S_XO = S_XP + (size_t)T * 1024 * 2;
constexpr size_t S_H = S_BASE;
constexpr size_t S_XS = S_BASE;
constexpr size_t S_YS = S_XS + (size_t)MOE_ROWS * 1024 * 2;
constexpr size_t S_MH = S_YS + (size_t)2 * T * 1024 * 2;
constexpr size_t S_TOPI = S_MH + (size_t)(MOE_PASS_BLOCKS + NEXP) * 256 * FFE * 2;
constexpr size_t S_TOPW = S_TOPI + (size_t)T * 2 * 4;
constexpr size_t S_ROWSLOT = S_TOPW + (size_t)T * 2 * 4;
constexpr size_t S_ROWW = S_ROWSLOT + (size_t)MOE_ROWS * 4;
constexpr size_t S_BLKE = S_ROWW + (size_t)MOE_ROWS * 4;
constexpr size_t S_MOE_END = S_BLKE + 4096;
constexpr size_t cmax(size_t a, size_t b) { return a > b ? a : b; }
constexpr size_t WS_NEED = cmax(cmax(S_MIX_END, S_GATE_END), S_MOE_END);
static_assert(WS_NEED <= (size_t)896 * MiB, "workspace map exceeds 896 MiB");
static_assert((W_BASE % 256) == 0 && (LW_SIZE % 256) == 0 && (S_BASE % 256) == 0, "alignment");

constexpr int RING_BYTES = 131072;
constexpr int XCH_OFF = RING_BYTES;
constexpr int LDSCTL_OFF = RING_BYTES + 16384;
constexpr int LDS_BYTES = LDSCTL_OFF + 512;
constexpr int NWAVES = 8, NTHREADS = 512;

typedef __bf16 bf16x2_t __attribute__((ext_vector_type(2)));
__device__ __forceinline__ unsigned cvt_pk_bf16(float lo, float hi) { bf16x2_t v = {(__bf16)lo, (__bf16)hi}; return __builtin_bit_cast(unsigned, v); }
__device__ __forceinline__ float bf2f(unsigned short b) { return __uint_as_float((unsigned)b << 16); }
__device__ __forceinline__ float bflo(unsigned w) { return __uint_as_float(w << 16); }
__device__ __forceinline__ float bfhi(unsigned w) { return __uint_as_float(w & 0xffff0000u); }
__device__ __forceinline__ float fexp2(float x) { return __builtin_amdgcn_exp2f(x); }
__device__ __forceinline__ float flog2(float x) { return __builtin_amdgcn_logf(x); }
__device__ __forceinline__ float frcp(float x) { return __builtin_amdgcn_rcpf(x); }
__device__ __forceinline__ float sigmoidf_(float x) { return frcp(1.0f + fexp2(-x * LOG2E)); }
__device__ __forceinline__ float siluf_(float x) { return x * sigmoidf_(x); }
__device__ __forceinline__ float softplusf_(float x) { return fmaxf(x, 0.f) + 0.6931471805599453f * flog2(1.0f + fexp2(-fabsf(x) * LOG2E)); }
#define DPPADD_(v, ctrl, rmask) (v) += __builtin_bit_cast(float, __builtin_amdgcn_update_dpp(0, __builtin_bit_cast(int, (v)), (ctrl), (rmask), 0xf, false))
__device__ __forceinline__ float row_sum16(float v) {
    DPPADD_(v, 0xB1, 0xf); DPPADD_(v, 0x4E, 0xf); DPPADD_(v, 0x141, 0xf); DPPADD_(v, 0x140, 0xf); return v; }
__device__ __forceinline__ float wave_sum(float v) {
    v = row_sum16(v); DPPADD_(v, 0x142, 0xa); DPPADD_(v, 0x143, 0xc);
    return __builtin_bit_cast(float, __builtin_amdgcn_readlane(__builtin_bit_cast(int, v), 63)); }
#define LDS_WAIT() asm volatile("s_waitcnt lgkmcnt(0)" ::: "memory")
#define VM_WAIT() asm volatile("s_waitcnt vmcnt(0)" ::: "memory")
#define XB_TMO      128
#define XB_XCNT(j)  (256  + 64 * (j))
#define XB_XSUB(j)  (1280 + 64 * (j))
#define XB_XGEN(j)  (2304 + 64 * (j))
#define XB_TOP      3328
#define XB_TOPGEN   3392
#define XCD_BAR_WORDS 3456
#define XB_SPIN_CAP (1u << 18)

__device__ __forceinline__ unsigned xb_ld(unsigned* p)              { return __hip_atomic_load(p, __ATOMIC_RELAXED, __HIP_MEMORY_SCOPE_AGENT); }
__device__ __forceinline__ unsigned xb_add(unsigned* p, unsigned v) { return __hip_atomic_fetch_add(p, v, __ATOMIC_RELAXED, __HIP_MEMORY_SCOPE_AGENT); }
__device__ __forceinline__ unsigned xb_xcc_id() { return (unsigned)__builtin_amdgcn_s_getreg((3 << 11) | 20) & 0xFu; }
#define XB_SPIN(cond, bar) do { unsigned _sp = 0; while (cond) { __builtin_amdgcn_s_sleep(1); \
    if ((++_sp & 255u) == 0u) { if (xb_ld(&(bar)[XB_TMO])) break; if (_sp > XB_SPIN_CAP) { atomicAdd(&(bar)[XB_TMO], 1u); break; } } } } while (0)

struct XcdBarrier { unsigned* bar; unsigned x; volatile LAS unsigned* st; };

__device__ __forceinline__ XcdBarrier xcd_barrier_post(unsigned* bar, volatile LAS unsigned* st) {
    XcdBarrier b; b.bar = bar; b.x = xb_xcc_id(); b.st = st;
    if (threadIdx.x == 0) (void)xb_add(&bar[XB_XCNT(b.x)], 1u);
    return b;
}
__device__ __forceinline__ void xcd_barrier_complete(unsigned* bar, unsigned x, unsigned& nloc, unsigned& nx) {
    const unsigned G = gridDim.x * gridDim.y * gridDim.z;
    unsigned sum, cnt, mine, sp = 0u;
    for (;;) {
        sum = 0u; cnt = 0u; mine = 0u;
#pragma unroll
        for (unsigned j = 0; j < 16; ++j) { const unsigned c = xb_ld(&bar[XB_XCNT(j)]); sum += c; cnt += (c > 0u) ? 1u : 0u; mine = (j == x) ? c : mine; }
        if (sum == G) break;
        __builtin_amdgcn_s_sleep(1);
        if ((++sp & 255u) == 0u) { if (xb_ld(&bar[XB_TMO])) break; if (sp > XB_SPIN_CAP) { atomicAdd(&bar[XB_TMO], 1u); break; } }
    }
    nloc = mine > 0u ? mine : 1u; nx = cnt > 0u ? cnt : 1u;
}
__device__ __forceinline__ void xcd_barrier(const XcdBarrier& b) {
    asm volatile("s_waitcnt vmcnt(0)" ::: "memory");
    __syncthreads();
    if (threadIdx.x == 0) {
        unsigned* bar = b.bar;
        __builtin_amdgcn_s_waitcnt(0);
        unsigned nloc = b.st[0], nx = b.st[1];
        if (nloc == 0u) { xcd_barrier_complete(bar, b.x, nloc, nx); b.st[0] = nloc; b.st[1] = nx; }
        const unsigned old = xb_add(&bar[XB_XSUB(b.x)], 1u);
        const unsigned gen = old / nloc;
        if (old + 1u == (gen + 1u) * nloc) {
            __builtin_amdgcn_fence(__ATOMIC_RELEASE, "agent");
            asm volatile("s_waitcnt vmcnt(0)" ::: "memory");
            const unsigned og = xb_add(&bar[XB_TOP], 1u);
            const unsigned tg = og / nx;
            if (og + 1u == (tg + 1u) * nx) xb_add(&bar[XB_TOPGEN], 1u);
            else XB_SPIN(xb_ld(&bar[XB_TOPGEN]) == tg, bar);
            __builtin_amdgcn_fence(__ATOMIC_ACQUIRE, "agent");
            xb_add(&bar[XB_XGEN(b.x)], 1u);
            asm volatile("s_waitcnt vmcnt(0)" ::: "memory");
        } else {
            XB_SPIN(xb_ld(&bar[XB_XGEN(b.x)]) == gen, bar);
            __builtin_amdgcn_fence(__ATOMIC_ACQUIRE, "agent");
            asm volatile("s_waitcnt vmcnt(0)" ::: "memory");
        }
    }
    __syncthreads();
}

#ifndef PG8_ALIGN_DEFAULT
#define PG8_ALIGN_DEFAULT true
#endif
namespace pg8 {
constexpr int BM = 256, BK = 64, HALF = 128, HTB = HALF * BK * 2, STAGE_BYTES = 8 * HTB;
__host__ __device__ __forceinline__ int lds_byte(int r, int c) { const int st = (r >> 4) * 2 + (c >> 5), rr = r & 15, cc = c & 31, ob = rr * 64 + cc * 2; return st * 1024 + (ob ^ (((ob >> 9) & 1) << 5)); }
__host__ __device__ __forceinline__ void stage_rc(int b, int& R, int& C) { const int st = b / 1024, sb = b % 1024, swz = sb ^ (((sb >> 9) & 1) << 5); R = (st >> 1) * 16 + swz / 64; C = (st & 1) * 32 + (swz % 64) / 2; }
__host__ __device__ __forceinline__ int perm32(int rho) { const int n = rho >> 4, i = rho & 15; return 8 * (i >> 2) + 4 * n + (i & 3); }

struct Unit { int pm, pn; long aoff, boff; int tag; };
struct Gemm { const bf16_t* A; const bf16_t* Bt; int K, lda, ldb; };

template <class Epi, class Sched, bool ALIGN = PG8_ALIGN_DEFAULT>
__device__ __forceinline__ void gemm_phase(LAS unsigned char* lds, const Gemm g, const Sched& S, const Epi& E) {
    int tid_ = threadIdx.x; asm volatile("" : "+v"(tid_));
    const int tid = tid_, wid = __builtin_amdgcn_readfirstlane(tid >> 6), lane = tid & 63, wr = wid >> 2, wc = wid & 3, fr = lane & 15, fq = lane >> 4;
    int K = g.K; asm volatile("" : "+s"(K)); const int nt = K / BK;
    unsigned voffA[2], voffB[2];
#pragma unroll
    for (int i = 0; i < 2; ++i) { int R, C; stage_rc(tid * 16 + i * 8192, R, C); const int Rb = Epi::PERM ? ((R & ~31) + perm32(R & 31)) : R;
        voffA[i] = (unsigned)(R * g.lda + C) * 2u; voffB[i] = (unsigned)(Rb * g.ldb + C) * 2u; }
    const size_t kstep = (size_t)(BK * 2);
    const size_t hstepA = (size_t)HALF * g.lda * 2, hstepB = (size_t)HALF * g.ldb * 2;
    const size_t tstepA = 2 * hstepA, tstepB = 2 * hstepB;
    const unsigned ldsw = (unsigned)wid * 1024u;
    const int aoff = lds_byte(wr * 64 + fr, fq * 8), boff = lds_byte(wc * 32 + fr, fq * 8);
#define PG8_SA(b, h) (((b) * 2 + (h)) * HTB)
#define PG8_SB(b, h) ((4 + (b) * 2 + (h)) * HTB)
#define PG8_STAGE(bufoff, gbase, voff) do { _Pragma("unroll") for (int _i = 0; _i < 2; ++_i) \
        __builtin_amdgcn_global_load_lds((const unsigned*)((const char*)(gbase) + (voff)[_i]), (LAS unsigned*)(lds + (bufoff) + ldsw + _i * 8192), 16, 0, 0); } while (0)
#define PG8_LDA(dst, b, h) do { _Pragma("unroll") for (int m = 0; m < 4; ++m) _Pragma("unroll") for (int k = 0; k < 2; ++k) dst[m][k] = *(const LAS bf16x8*)(lds + PG8_SA(b, h) + aoff + m * 2048 + k * 1024); } while (0)
#define PG8_LDB(dst, b, h) do { _Pragma("unroll") for (int n = 0; n < 2; ++n) _Pragma("unroll") for (int k = 0; k < 2; ++k) dst[n][k] = *(const LAS bf16x8*)(lds + PG8_SB(b, h) + boff + n * 2048 + k * 1024); } while (0)
#define PG8_MMA(ai, bj, At, Bt) do { __builtin_amdgcn_s_setprio(1); _Pragma("unroll") for (int m = 0; m < 4; ++m) _Pragma("unroll") for (int n = 0; n < 2; ++n) _Pragma("unroll") for (int k = 0; k < 2; ++k) \
        acc[ai][bj][m][n] = __builtin_amdgcn_mfma_f32_16x16x32_bf16(Bt[n][k], At[m][k], acc[ai][bj][m][n], 0, 0, 0); __builtin_amdgcn_s_setprio(0); } while (0)
#define PG8_WAIT_V(n) asm volatile("s_waitcnt vmcnt(" #n ")" ::: "memory")
#define PG8_WAIT_L(n) asm volatile("s_waitcnt lgkmcnt(" #n ")" ::: "memory")
#define PG8_BAR __builtin_amdgcn_s_barrier()
#define PG8_SCHED __builtin_amdgcn_sched_barrier(0)
    Unit cur, nxt; int ui = 0;
    if (!S.next(0, cur)) return;
    f32x4 acc[2][2][4][2];
#pragma unroll
    for (int a = 0; a < 2; ++a)
#pragma unroll
        for (int b = 0; b < 2; ++b)
#pragma unroll
            for (int m = 0; m < 4; ++m)
#pragma unroll
                for (int n = 0; n < 2; ++n) acc[a][b][m][n] = (f32x4){0.f, 0.f, 0.f, 0.f};
    bf16x8 At[4][2], B0[2][2], B1[2][2];
    const char* cA = (const char*)(g.A + cur.aoff) + (size_t)cur.pm * tstepA; const char* cB = (const char*)(g.Bt + cur.boff) + (size_t)cur.pn * tstepB;
    PG8_STAGE(PG8_SB(0, 0), cB, voffB); PG8_STAGE(PG8_SB(0, 1), cB + hstepB, voffB); PG8_STAGE(PG8_SA(0, 0), cA, voffA); PG8_STAGE(PG8_SA(0, 1), cA + hstepA, voffA);
    if (wr == 1) PG8_BAR;
    PG8_WAIT_V(2); PG8_BAR;
    PG8_STAGE(PG8_SB(1, 0), cB + kstep, voffB); PG8_STAGE(PG8_SA(1, 0), cA + kstep, voffA); PG8_STAGE(PG8_SB(1, 1), cB + hstepB + kstep, voffB);
    PG8_WAIT_V(6); PG8_BAR;
    for (;;) {
        const bool has_next = S.next(ui + 1, nxt);
        const char* nA = has_next ? (const char*)(g.A + nxt.aoff) + (size_t)nxt.pm * tstepA : cA; const char* nB = has_next ? (const char*)(g.Bt + nxt.boff) + (size_t)nxt.pn * tstepB : cB;
#pragma unroll 1
        for (int t = 0; t < nt; t += 2) {
            const bool last = (t == nt - 2);
            const char* a1 = cA + (size_t)(t + 1) * kstep;
            const char* a2 = last ? nA : cA + (size_t)(t + 2) * kstep; const char* b2 = last ? nB : cB + (size_t)(t + 2) * kstep;
            const char* a3 = a2 + kstep; const char* b3 = b2 + kstep;
            PG8_LDB(B0, 0, 0); PG8_LDB(B1, 0, 1); PG8_SCHED; PG8_LDA(At, 0, 0); PG8_STAGE(PG8_SA(1, 1), a1 + hstepA, voffA);
            PG8_WAIT_V(8); PG8_WAIT_L(0); PG8_BAR; PG8_MMA(0, 0, At, B0); PG8_MMA(0, 1, At, B1); PG8_BAR; PG8_SCHED;
            PG8_LDA(At, 0, 1); PG8_STAGE(PG8_SB(0, 0), b2, voffB); PG8_STAGE(PG8_SB(0, 1), b2 + hstepB, voffB); PG8_STAGE(PG8_SA(0, 0), a2, voffA);
            PG8_WAIT_V(8); PG8_WAIT_L(0); PG8_BAR; PG8_MMA(1, 0, At, B0); PG8_MMA(1, 1, At, B1); PG8_BAR; PG8_SCHED;
            PG8_LDB(B0, 1, 0); PG8_LDB(B1, 1, 1); PG8_SCHED; PG8_LDA(At, 1, 0); PG8_STAGE(PG8_SA(0, 1), a2 + hstepA, voffA);
            PG8_WAIT_V(8); PG8_WAIT_L(0); PG8_BAR; PG8_MMA(0, 0, At, B0); PG8_MMA(0, 1, At, B1); PG8_BAR; PG8_SCHED;
            PG8_LDA(At, 1, 1); PG8_STAGE(PG8_SB(1, 0), b3, voffB); PG8_STAGE(PG8_SB(1, 1), b3 + hstepB, voffB); PG8_STAGE(PG8_SA(1, 0), a3, voffA);
            PG8_WAIT_V(8); PG8_WAIT_L(0); PG8_BAR; PG8_MMA(1, 0, At, B0); PG8_MMA(1, 1, At, B1); PG8_BAR; PG8_SCHED;
        }
        if constexpr (ALIGN) { if (wr == 0) PG8_BAR; }
        E(acc, cur, wr, wc, fr, fq, wid, lane);
        if (!has_next) break;
#pragma unroll
        for (int a = 0; a < 2; ++a)
#pragma unroll
            for (int b = 0; b < 2; ++b)
#pragma unroll
                for (int m = 0; m < 4; ++m)
#pragma unroll
                    for (int n = 0; n < 2; ++n) acc[a][b][m][n] = (f32x4){0.f, 0.f, 0.f, 0.f};
        cur = nxt; cA = nA; cB = nB; ++ui;
        if constexpr (ALIGN) { if (wr == 1) PG8_BAR; }
    }
    PG8_WAIT_V(0);
    if constexpr (!ALIGN) { if (wr == 0) PG8_BAR; }
    PG8_BAR;
#undef PG8_SA
#undef PG8_SB
#undef PG8_STAGE
#undef PG8_LDA
#undef PG8_LDB
#undef PG8_MMA
#undef PG8_WAIT_V
#undef PG8_WAIT_L
#undef PG8_BAR
#undef PG8_SCHED
}
template <class Epi, class Sched>
__device__ __forceinline__ void gemm_phase_hn(LAS unsigned char* lds, const Gemm g, const Sched& S, Epi& E) {
    constexpr bool ALIGN = true;
    int tid_ = threadIdx.x; asm volatile("" : "+v"(tid_));
    const int tid = tid_, wid = __builtin_amdgcn_readfirstlane(tid >> 6), lane = tid & 63, wr = wid >> 2, wc = wid & 3, fr = lane & 15, fq = lane >> 4;
    int K = g.K; asm volatile("" : "+s"(K)); const int nt = K / BK;
    unsigned voffA[2], voffB[2];
#pragma unroll
    for (int i = 0; i < 2; ++i) { int R, C; stage_rc(tid * 16 + i * 8192, R, C); const int Rb = Epi::PERM ? ((R & ~31) + perm32(R & 31)) : R;
        voffA[i] = (unsigned)(R * g.lda + C) * 2u; voffB[i] = (unsigned)(Rb * g.ldb + C) * 2u; }
    const size_t kstep = (size_t)(BK * 2);
    const size_t hstepA = (size_t)HALF * g.lda * 2, hstepB = (size_t)HALF * g.ldb * 2;
    const size_t tstepA = 2 * hstepA, tstepB = hstepB;
    const unsigned ldsw = (unsigned)wid * 1024u;
    const int aoff = lds_byte(wr * 64 + fr, fq * 8), boff = lds_byte(wc * 32 + fr, fq * 8);
#define PG8_SA(b, h) (((b) * 2 + (h)) * HTB)
#define PG8_SB(b, h) ((4 + (b) * 2 + (h)) * HTB)
#define PG8_STAGE(bufoff, gbase, voff) do { _Pragma("unroll") for (int _i = 0; _i < 2; ++_i) \
        __builtin_amdgcn_global_load_lds((const unsigned*)((const char*)(gbase) + (voff)[_i]), (LAS unsigned*)(lds + (bufoff) + ldsw + _i * 8192), 16, 0, 0); } while (0)
#define PG8_LDA(dst, b, h) do { _Pragma("unroll") for (int m = 0; m < 4; ++m) _Pragma("unroll") for (int k = 0; k < 2; ++k) dst[m][k] = *(const LAS bf16x8*)(lds + PG8_SA(b, h) + aoff + m * 2048 + k * 1024); } while (0)
#define PG8_LDB(dst, b, h) do { _Pragma("unroll") for (int n = 0; n < 2; ++n) _Pragma("unroll") for (int k = 0; k < 2; ++k) dst[n][k] = *(const LAS bf16x8*)(lds + PG8_SB(b, h) + boff + n * 2048 + k * 1024); } while (0)
#define PG8_MMA(ai, At, Bt) do { __builtin_amdgcn_s_setprio(1); _Pragma("unroll") for (int m = 0; m < 4; ++m) _Pragma("unroll") for (int n = 0; n < 2; ++n) _Pragma("unroll") for (int k = 0; k < 2; ++k) \
        acc[ai][m][n] = __builtin_amdgcn_mfma_f32_16x16x32_bf16(Bt[n][k], At[m][k], acc[ai][m][n], 0, 0, 0); __builtin_amdgcn_s_setprio(0); } while (0)
#define PG8_WAIT_V(n) asm volatile("s_waitcnt vmcnt(" #n ")" ::: "memory")
#define PG8_WAIT_L(n) asm volatile("s_waitcnt lgkmcnt(" #n ")" ::: "memory")
#define PG8_BAR __builtin_amdgcn_s_barrier()
#define PG8_SCHED __builtin_amdgcn_sched_barrier(0)
    Unit cur, nxt; int ui = 0;
    if (!S.next(0, cur)) return;
    f32x4 acc[2][4][2];
#pragma unroll
    for (int a = 0; a < 2; ++a)
#pragma unroll
        for (int m = 0; m < 4; ++m)
#pragma unroll
            for (int n = 0; n < 2; ++n) acc[a][m][n] = (f32x4){0.f, 0.f, 0.f, 0.f};
    bf16x8 At[4][2], B0[2][2];
    const char* cA = (const char*)(g.A + cur.aoff) + (size_t)cur.pm * tstepA; const char* cB = (const char*)(g.Bt + cur.boff) + (size_t)cur.pn * tstepB;
    PG8_STAGE(PG8_SB(0, 0), cB, voffB); PG8_STAGE(PG8_SA(0, 0), cA, voffA); PG8_STAGE(PG8_SA(0, 1), cA + hstepA, voffA);
    if (wr == 1) PG8_BAR;
    PG8_WAIT_V(2); PG8_BAR;
    PG8_STAGE(PG8_SB(1, 0), cB + kstep, voffB); PG8_STAGE(PG8_SA(1, 0), cA + kstep, voffA);
    PG8_WAIT_V(4); PG8_BAR;
    for (;;) {
        const bool has_next = S.next(ui + 1, nxt);
        const char* nA = has_next ? (const char*)(g.A + nxt.aoff) + (size_t)nxt.pm * tstepA : cA; const char* nB = has_next ? (const char*)(g.Bt + nxt.boff) + (size_t)nxt.pn * tstepB : cB;
#pragma unroll 1
        for (int t = 0; t < nt; t += 2) {
            const bool last = (t == nt - 2);
            const char* a1 = cA + (size_t)(t + 1) * kstep;
            const char* a2 = last ? nA : cA + (size_t)(t + 2) * kstep; const char* b2 = last ? nB : cB + (size_t)(t + 2) * kstep;
            const char* a3 = a2 + kstep; const char* b3 = b2 + kstep;
            PG8_LDB(B0, 0, 0); PG8_SCHED; PG8_LDA(At, 0, 0); PG8_STAGE(PG8_SA(1, 1), a1 + hstepA, voffA);
            PG8_WAIT_V(6); PG8_WAIT_L(0); PG8_BAR; PG8_MMA(0, At, B0); PG8_BAR; PG8_SCHED;
            PG8_LDA(At, 0, 1); PG8_STAGE(PG8_SB(0, 0), b2, voffB); PG8_STAGE(PG8_SA(0, 0), a2, voffA);
            PG8_WAIT_V(6); PG8_WAIT_L(0); PG8_BAR; PG8_MMA(1, At, B0); PG8_BAR; PG8_SCHED;
            PG8_LDB(B0, 1, 0); PG8_SCHED; PG8_LDA(At, 1, 0); PG8_STAGE(PG8_SA(0, 1), a2 + hstepA, voffA);
            PG8_WAIT_V(6); PG8_WAIT_L(0); PG8_BAR; PG8_MMA(0, At, B0); PG8_BAR; PG8_SCHED;
            PG8_LDA(At, 1, 1); PG8_STAGE(PG8_SB(1, 0), b3, voffB); PG8_STAGE(PG8_SA(1, 0), a3, voffA);
            PG8_WAIT_V(6); PG8_WAIT_L(0); PG8_BAR; PG8_MMA(1, At, B0); PG8_BAR; PG8_SCHED;
        }
        if constexpr (ALIGN) { if (wr == 0) PG8_BAR; }
        E(acc, cur, wr, wc, fr, fq, wid, lane);
        if (!has_next) break;
#pragma unroll
        for (int a = 0; a < 2; ++a)
#pragma unroll
            for (int m = 0; m < 4; ++m)
#pragma unroll
                for (int n = 0; n < 2; ++n) acc[a][m][n] = (f32x4){0.f, 0.f, 0.f, 0.f};
        cur = nxt; cA = nA; cB = nB; ++ui;
        if constexpr (ALIGN) { if (wr == 1) PG8_BAR; }
    }
    PG8_WAIT_V(0);
    if constexpr (!ALIGN) { if (wr == 0) PG8_BAR; }
    PG8_BAR;
#undef PG8_SA
#undef PG8_SB
#undef PG8_STAGE
#undef PG8_LDA
#undef PG8_LDB
#undef PG8_MMA
#undef PG8_WAIT_V
#undef PG8_WAIT_L
#undef PG8_BAR
#undef PG8_SCHED
}
}
namespace sch {
using pg8::Unit;
__device__ __forceinline__ void tile_of(int L, int nM, int nN, int& pm, int& pn) {
    const int nwg = nM * nN; int wgid = L;
    { const int q = nwg / 8, r = nwg % 8, xcd = wgid % 8, off = wgid / 8; wgid = (xcd < r ? xcd * (q + 1) : r * (q + 1) + (xcd - r) * q) + off; }
    const int nig = 8 * nN, gid = wgid / nig, fm = gid * 8, gsz = (nM - fm) < 8 ? (nM - fm) : 8;
    pm = fm + ((wgid % nig) % gsz); pn = (wgid % nig) / gsz;
}
struct Tiles {
    int nM, nN, G, c;
    __device__ __forceinline__ bool next(int i, Unit& u) const {
        const long L = (long)i * G + c; if (L >= (long)nM * nN) return false;
        tile_of((int)L, nM, nN, u.pm, u.pn); u.aoff = 0; u.boff = 0; u.tag = 0; return true; }
};
struct BrTiles {
    int nM, nN, G, c;
    __device__ __forceinline__ bool next(int i, Unit& u) const {
        const long L = (long)(i >> 2) * G + c; if (L >= (long)nM * nN) return false;
        tile_of((int)L, nM, nN, u.pm, u.pn); const int br = i & 3; u.aoff = br * 256; u.boff = (long)br * 1024 * 256; u.tag = br; return true; }
};
struct BrTilesH {
    int nM, nN, G, c;
    __device__ __forceinline__ bool next(int i, Unit& u) const {
        const long L = (long)(i >> 2) * G + c; if (L >= (long)nM * nN) return false;
        int pn8; tile_of((int)L, nM, nN, u.pm, pn8); const int br = i & 3; u.pn = pn8; u.aoff = br * 256; u.boff = (long)br * 1024 * 256; u.tag = br | (pn8 << 2); return true; }
};
struct MemKV {
    long offMem, offWkv; int c;
    __device__ __forceinline__ bool next(int i, Unit& u) const {
        if (i > 0 || c < 128) return false; const int idx = c - 128;
        u.pm = idx >> 3; u.pn = idx & 7; u.aoff = offMem; u.boff = offWkv; u.tag = 0; return true; }
};
struct AbsM {
    int c;
    __device__ __forceinline__ bool next(int i, Unit& u) const {
        if (i > 0) return false; const int b = c >> 4, h = (c >> 2) & 3, dt = c & 3;
        u.pm = b; u.pn = dt; u.aoff = h * 256; u.boff = h * 256; u.tag = (b * 4 + h) | (dt << 16); return true; }
};
struct AbsN {
    int c;
    __device__ __forceinline__ bool next(int i, Unit& u) const {
        if (i > 0) return false; const int b = c >> 4, h = (c >> 2) & 3, ci = c & 3;
        u.pm = ci; u.pn = b; u.aoff = h * 256; u.boff = h * 256; u.tag = (b * 4 + ci) | (h << 16); return true; }
};
struct XaS {
    int G, c;
    __device__ __forceinline__ bool next(int i, Unit& u) const {
        const int L = i * G + c; if (L >= 512) return false;
        const int j = c >> 3, b = (c & 7) + 8 * i, h = (j >> 3) & 3, rb = j & 7;
        u.pm = b * 8 + rb; u.pn = h; u.aoff = 0; u.boff = (long)b * 1024 * 1024; u.tag = h; return true; }
};
struct XaO {
    int G, c;
    __device__ __forceinline__ bool next(int i, Unit& u) const {
        const int L = i * G + c; if (L >= 512) return false;
        const int j = c >> 3, b = (c & 7) + 8 * i, ci = (j >> 3) & 3, rb = j & 7;
        u.pm = b * 8 + rb; u.pn = ci; u.aoff = 0; u.boff = (long)b * 1024 * 1024; u.tag = 0; return true; }
};
struct MoeUp {
    const int* blk_e; int b0, b1, G, c;
    __device__ __forceinline__ bool next(int i, Unit& u) const {
        const int L = i * G + c; const int nb = b1 - b0; if (L >= nb * 28) return false;
        const int rb = b0 + L / 28; u.pn = L % 28; u.pm = rb;
        const int e = __builtin_amdgcn_readfirstlane(__hip_atomic_load(blk_e + rb, RLX_AGENT));
        u.aoff = 0; u.boff = (long)e * (2 * FFE) * 1024; u.tag = rb - b0; return true; }
};
struct MoeDown {
    const int* blk_e; int b0, b1, G, c;
    __device__ __forceinline__ bool next(int i, Unit& u) const {
        const int L = i * G + c; const int nb = b1 - b0; if (L >= nb * 4) return false;
        const int rb = b0 + L / 4; u.pn = L % 4; u.pm = rb - b0;
        const int e = __builtin_amdgcn_readfirstlane(__hip_atomic_load(blk_e + rb, RLX_AGENT));
        u.aoff = 0; u.boff = (long)e * 1024 * FFE; u.tag = rb; return true; }
};
}

namespace epi {
using pg8::Unit;
#define EPI_SIG f32x4 (&acc)[2][2][4][2], const Unit& u, int wr, int wc, int fr, int fq, int wid, int lane
#define EPI_ROWS _Pragma("unroll") for (int ai = 0; ai < 2; ++ai) _Pragma("unroll") for (int m = 0; m < 4; ++m)
#define EPI_ROW (u.pm * 256 + ai * 128 + wr * 64 + m * 16 + fr)
#define EPI_BJ _Pragma("unroll") for (int bj = 0; bj < 2; ++bj)
#define EPI_FENCE asm volatile("" ::: "memory")
#ifndef EPI_DEPTH
#define EPI_DEPTH 4
#endif
__device__ __forceinline__ u32x4 pack8(const f32x4 a, const f32x4 b) { u32x4 w; w.x = cvt_pk_bf16(a[0], a[1]); w.y = cvt_pk_bf16(a[2], a[3]); w.z = cvt_pk_bf16(b[0], b[1]); w.w = cvt_pk_bf16(b[2], b[3]); return w; }

template <int ACT> struct StoreBf16 {
    static constexpr bool PERM = true;
    bf16_t* O; int ldc;
    __device__ __forceinline__ void operator()(EPI_SIG) const {
        EPI_ROWS { bf16_t* rowp = O + (size_t)EPI_ROW * ldc + u.pn * 256 + wc * 32 + 8 * fq;
            EPI_BJ { f32x4 v0 = acc[ai][bj][m][0], v1 = acc[ai][bj][m][1];
                if (ACT == 1) { for (int j = 0; j < 4; ++j) { v0[j] = sigmoidf_(v0[j]); v1[j] = sigmoidf_(v1[j]); } }
                *(u32x4*)(rowp + bj * 128) = pack8(v0, v1); } EPI_FENCE; }
    }
};
struct StoreAt {
    static constexpr bool PERM = true;
    bf16_t* O; int ldc;
    __device__ __forceinline__ void operator()(EPI_SIG) const {
        const int rb = u.tag & 0xffff, cb = u.tag >> 16;
        EPI_ROWS { bf16_t* rowp = O + (size_t)(rb * 256 + ai * 128 + wr * 64 + m * 16 + fr) * ldc + cb * 256 + wc * 32 + 8 * fq;
            EPI_BJ { *(u32x4*)(rowp + bj * 128) = pack8(acc[ai][bj][m][0], acc[ai][bj][m][1]); } EPI_FENCE; }
    }
};
struct Lora {
    static constexpr bool PERM = true;
    float* dec; bf16_t* av; bf16_t* gv; const float* w0; const float* a0;
    __device__ __forceinline__ void operator()(EPI_SIG) const {
        EPI_ROWS { const size_t row = EPI_ROW;
            EPI_BJ { const int col = bj * 128 + wc * 32 + 8 * fq; f32x4 v0 = acc[ai][bj][m][0], v1 = acc[ai][bj][m][1];
                if (u.pn == 0) {
                    const f32x4 b0 = *(const f32x4*)(w0 + col), b1 = *(const f32x4*)(w0 + col + 4);
                    for (int j = 0; j < 4; ++j) { float x = v0[j] + b0[j]; float wl = -softplusf_(-x) - 0.5f; v0[j] = fexp2(-fexp2(wl * LOG2E) * LOG2E);
                                                  x = v1[j] + b1[j]; wl = -softplusf_(-x) - 0.5f; v1[j] = fexp2(-fexp2(wl * LOG2E) * LOG2E); }
                    *(f32x4*)(dec + row * 256 + col) = v0; *(f32x4*)(dec + row * 256 + col + 4) = v1;
                } else if (u.pn == 1) {
                    const f32x4 b0 = *(const f32x4*)(a0 + col), b1 = *(const f32x4*)(a0 + col + 4);
                    for (int j = 0; j < 4; ++j) { v0[j] = sigmoidf_(v0[j] + b0[j]); v1[j] = sigmoidf_(v1[j] + b1[j]); }
                    *(u32x4*)(av + row * 256 + col) = pack8(v0, v1);
                } else { *(u32x4*)(gv + row * 256 + col) = pack8(v0, v1); } } EPI_FENCE; }
    }
};
struct Uq {
    static constexpr bool PERM = false;
    bf16_t* Q; const float* cosT; const float* sinT;
    __device__ __forceinline__ void operator()(EPI_SIG) const {
        EPI_ROWS { const size_t row = EPI_ROW;
            EPI_BJ { const int c32 = u.pn * 256 + bj * 128 + wc * 32; if (c32 >= 384) continue;
                f32x4 v0 = acc[ai][bj][m][0], v1 = acc[ai][bj][m][1];
                if ((c32 >> 5) % 3 == 2) {
                    const f32x4 cs = *(const f32x4*)(cosT + row * 16 + 4 * fq), sn = *(const f32x4*)(sinT + row * 16 + 4 * fq);
                    const f32x4 o0 = v0 * cs - v1 * sn, o1 = v0 * sn + v1 * cs; v0 = o0; v1 = o1; }
                u32x2 w0, w1; w0.x = cvt_pk_bf16(v0[0], v0[1]); w0.y = cvt_pk_bf16(v0[2], v0[3]); w1.x = cvt_pk_bf16(v1[0], v1[1]); w1.y = cvt_pk_bf16(v1[2], v1[3]);
                *(u32x2*)(Q + row * 384 + c32 + 4 * fq) = w0; *(u32x2*)(Q + row * 384 + c32 + 16 + 4 * fq) = w1; } EPI_FENCE; }
    }
};
struct Ukv {
    static constexpr bool PERM = true;
    bf16_t* Km; bf16_t* Vm;
    __device__ __forceinline__ void operator()(EPI_SIG) const {
        EPI_ROWS { const size_t row = EPI_ROW;
            EPI_BJ { const int col = u.pn * 256 + bj * 128 + wc * 32 + 8 * fq; const int h = col >> 7, j = col & 127;
                const u32x4 w = pack8(acc[ai][bj][m][0], acc[ai][bj][m][1]);
                if (j < 64) *(u32x4*)(Km + row * 384 + h * 96 + j) = w; else *(u32x4*)(Vm + row * 256 + h * 64 + (j - 64)) = w; } EPI_FENCE; }
    }
};
struct Resid {
    static constexpr bool PERM = true;
    const float* res; bf16_t* out; float ascale; const bf16_t* res16;
    __device__ __forceinline__ void operator()(EPI_SIG) const {
        const size_t off0 = (size_t)(u.pm * 256 + wr * 64 + fr) * 1024 + u.pn * 256 + wc * 32 + 8 * fq;
#define RS_OFF(i) (off0 + (size_t)((((i) >> 2) * 128 + ((i) & 3) * 16) * 1024))
        if (res16) {
            u32x4 rq[8][2];
#define RS_LOAD(i) { _Pragma("unroll") for (int bj = 0; bj < 2; ++bj) rq[i][bj] = *(const u32x4*)(res16 + RS_OFF(i) + bj * 128); }
            _Pragma("unroll") for (int i = 0; i < EPI_DEPTH; ++i) RS_LOAD(i)
            _Pragma("unroll") for (int i = 0; i < 8; ++i) { if (i + EPI_DEPTH < 8) RS_LOAD(i + EPI_DEPTH)
                _Pragma("unroll") for (int bj = 0; bj < 2; ++bj) { const u32x4 w = rq[i][bj];
                    const f32x4 r0 = (f32x4){bflo(w.x), bfhi(w.x), bflo(w.y), bfhi(w.y)}, r1 = (f32x4){bflo(w.z), bfhi(w.z), bflo(w.w), bfhi(w.w)};
                    *(u32x4*)(out + RS_OFF(i) + bj * 128) = pack8(r0 * DN_ALPHA + acc[i >> 2][bj][i & 3][0] * ascale, r1 * DN_ALPHA + acc[i >> 2][bj][i & 3][1] * ascale); } EPI_FENCE; }
#undef RS_LOAD
        } else {
            f32x4 rq[8][4];
#define RS_LOAD(i) { _Pragma("unroll") for (int q = 0; q < 4; ++q) rq[i][q] = *(const f32x4*)(res + RS_OFF(i) + (q >> 1) * 128 + (q & 1) * 4); }
            _Pragma("unroll") for (int i = 0; i < EPI_DEPTH; ++i) RS_LOAD(i)
            _Pragma("unroll") for (int i = 0; i < 8; ++i) { if (i + EPI_DEPTH < 8) RS_LOAD(i + EPI_DEPTH)
                _Pragma("unroll") for (int bj = 0; bj < 2; ++bj)
                    *(u32x4*)(out + RS_OFF(i) + bj * 128) = pack8(rq[i][2 * bj] * DN_ALPHA + acc[i >> 2][bj][i & 3][0] * ascale, rq[i][2 * bj + 1] * DN_ALPHA + acc[i >> 2][bj][i & 3][1] * ascale); EPI_FENCE; }
#undef RS_LOAD
        }
#undef RS_OFF
    }
};
struct Swiglu {
    static constexpr bool PERM = false;
    bf16_t* H; int ldh; int use_tag;
    __device__ __forceinline__ void operator()(EPI_SIG) const {
        const int pmo = use_tag ? u.tag : u.pm;
        EPI_ROWS { const size_t row = (size_t)(pmo * 256 + ai * 128 + wr * 64 + m * 16 + fr);
            EPI_BJ { const int hc = (u.pn * 256 + bj * 128 + wc * 32) / 2 + 4 * fq; const f32x4 g = acc[ai][bj][m][0], up = acc[ai][bj][m][1];
                u32x2 w; w.x = cvt_pk_bf16(siluf_(g[0]) * up[0], siluf_(g[1]) * up[1]); w.y = cvt_pk_bf16(siluf_(g[2]) * up[2], siluf_(g[3]) * up[3]);
                *(u32x2*)(H + row * ldh + hc) = w; } EPI_FENCE; }
    }
};
struct BrGate {
    static constexpr bool PERM = true;
    const bf16_t* G; float* mf; bf16_t* mb;
    __device__ __forceinline__ void operator()(EPI_SIG) const {
        const int br = u.tag;
        const size_t row0 = (size_t)(u.pm * 256 + wr * 64 + fr); const int col0 = u.pn * 256 + wc * 32 + 8 * fq;
        const bf16_t* gp = G + row0 * 4096 + br * 1024 + col0; bf16_t* pp = mb + row0 * 1024 + col0;
#define BR_ROW(i) (((i) >> 2) * 128 + ((i) & 3) * 16)
        u32x4 gq[8][2], pq[8][2];
#define BR_LOAD(i) { _Pragma("unroll") for (int bj = 0; bj < 2; ++bj) { gq[i][bj] = *(const u32x4*)(gp + (size_t)BR_ROW(i) * 4096 + bj * 128); \
            if (br > 0) pq[i][bj] = *(const u32x4*)(pp + (size_t)BR_ROW(i) * 1024 + bj * 128); else pq[i][bj] = (u32x4){0u, 0u, 0u, 0u}; } }
        _Pragma("unroll") for (int i = 0; i < EPI_DEPTH; ++i) BR_LOAD(i)
        _Pragma("unroll") for (int i = 0; i < 8; ++i) { if (i + EPI_DEPTH < 8) BR_LOAD(i + EPI_DEPTH)
            _Pragma("unroll") for (int bj = 0; bj < 2; ++bj) { const u32x4 gw = gq[i][bj], pw = pq[i][bj];
                f32x4 v0 = acc[i >> 2][bj][i & 3][0], v1 = acc[i >> 2][bj][i & 3][1];
                v0[0] = v0[0] * bflo(gw.x) + bflo(pw.x); v0[1] = v0[1] * bfhi(gw.x) + bfhi(pw.x); v0[2] = v0[2] * bflo(gw.y) + bflo(pw.y); v0[3] = v0[3] * bfhi(gw.y) + bfhi(pw.y);
                v1[0] = v1[0] * bflo(gw.z) + bflo(pw.z); v1[1] = v1[1] * bfhi(gw.z) + bfhi(pw.z); v1[2] = v1[2] * bflo(gw.w) + bflo(pw.w); v1[3] = v1[3] * bfhi(gw.w) + bfhi(pw.w);
                *(u32x4*)(pp + (size_t)BR_ROW(i) * 1024 + bj * 128) = pack8(v0, v1); } EPI_FENCE; }
#undef BR_LOAD
#undef BR_ROW
    }
};
struct BrGateH {
    static constexpr bool PERM = true;
    const bf16_t* G; bf16_t* mb; f32x4 racc[2][4][2];
    __device__ __forceinline__ void init() { _Pragma("unroll") for (int a = 0; a < 2; ++a) _Pragma("unroll") for (int m = 0; m < 4; ++m) _Pragma("unroll") for (int n = 0; n < 2; ++n) racc[a][m][n] = (f32x4){0.f, 0.f, 0.f, 0.f}; }
    __device__ __forceinline__ void operator()(f32x4 (&acc)[2][4][2], const Unit& u, int wr, int wc, int fr, int fq, int wid, int lane) {
        const int br = u.tag & 3; const unsigned col0 = (unsigned)((u.tag >> 2) * 128 + wc * 32 + 8 * fq), row0 = (unsigned)(u.pm * 256 + wr * 64 + fr);
        const char* gb = (const char*)G; const unsigned goff = (row0 * 4096u + (unsigned)br * 1024u + col0) * 2u;
        u32x4 gq[8];
        _Pragma("unroll") for (int i = 0; i < 8; ++i) gq[i] = *(const u32x4*)(gb + (size_t)(goff + (unsigned)(((i >> 2) * 128 + (i & 3) * 16) * 8192)));
        _Pragma("unroll") for (int i = 0; i < 8; ++i) { const u32x4 gw = gq[i]; const f32x4 v0 = acc[i >> 2][i & 3][0], v1 = acc[i >> 2][i & 3][1]; f32x4 r0 = racc[i >> 2][i & 3][0], r1 = racc[i >> 2][i & 3][1];
            r0[0] += v0[0] * bflo(gw.x); r0[1] += v0[1] * bfhi(gw.x); r0[2] += v0[2] * bflo(gw.y); r0[3] += v0[3] * bfhi(gw.y); r1[0] += v1[0] * bflo(gw.z); r1[1] += v1[1] * bfhi(gw.z); r1[2] += v1[2] * bflo(gw.w); r1[3] += v1[3] * bfhi(gw.w);
            racc[i >> 2][i & 3][0] = r0; racc[i >> 2][i & 3][1] = r1; }
        if (br == 3) { char* pb = (char*)mb; const unsigned poff = (row0 * 1024u + col0) * 2u;
            _Pragma("unroll") for (int i = 0; i < 8; ++i) { *(u32x4*)(pb + (size_t)(poff + (unsigned)(((i >> 2) * 128 + (i & 3) * 16) * 2048))) = pack8(racc[i >> 2][i & 3][0], racc[i >> 2][i & 3][1]);
                racc[i >> 2][i & 3][0] = (f32x4){0.f, 0.f, 0.f, 0.f}; racc[i >> 2][i & 3][1] = (f32x4){0.f, 0.f, 0.f, 0.f}; } }
    }
};
struct MoeDown {
    static constexpr bool PERM = true;
    const int* row_slot; const float* row_w; bf16_t* ys;
    __device__ __forceinline__ void operator()(EPI_SIG) const {
        int slot[8]; float w[8];
        _Pragma("unroll") for (int i = 0; i < 8; ++i) { const int r = u.tag * 256 + (i >> 2) * 128 + wr * 64 + (i & 3) * 16 + fr; slot[i] = __hip_atomic_load(row_slot + r, RLX_AGENT); w[i] = __hip_atomic_load(row_w + r, RLX_AGENT); }
        _Pragma("unroll") for (int i = 0; i < 8; ++i) {
            if (slot[i] >= 0) { EPI_BJ { const int col = u.pn * 256 + bj * 128 + wc * 32 + 8 * fq;
                *(u32x4*)(ys + (size_t)slot[i] * 1024 + col) = pack8(acc[i >> 2][bj][i & 3][0] * w[i], acc[i >> 2][bj][i & 3][1] * w[i]); } } EPI_FENCE; }
    }
};
struct Softmax {
    static constexpr bool PERM = true;
    bf16_t* P; LAS float* xch;
    __device__ __forceinline__ void operator()(EPI_SIG) const {
        EPI_ROWS { float v = -3.0e38f;
            EPI_BJ { const f32x4 a = acc[ai][bj][m][0], b = acc[ai][bj][m][1]; v = fmaxf(v, fmaxf(fmaxf(fmaxf(a[0], a[1]), fmaxf(a[2], a[3])), fmaxf(fmaxf(b[0], b[1]), fmaxf(b[2], b[3])))); }
            v = fmaxf(v, __shfl_xor(v, 16)); v = fmaxf(v, __shfl_xor(v, 32));
            if (fq == 0) xch[(ai * 128 + wr * 64 + m * 16 + fr) * 4 + wc] = v; }
        LDS_WAIT(); __builtin_amdgcn_s_barrier(); asm volatile("" ::: "memory");
        EPI_ROWS { const f32x4 q = *(const LAS f32x4*)(xch + (ai * 128 + wr * 64 + m * 16 + fr) * 4);
            const float mm = fmaxf(fmaxf(q[0], q[1]), fmaxf(q[2], q[3])); float s = 0.f;
            EPI_BJ { _Pragma("unroll") for (int n = 0; n < 2; ++n) { f32x4 t = acc[ai][bj][m][n]; for (int j = 0; j < 4; ++j) { t[j] = fexp2(t[j] - mm); s += t[j]; } acc[ai][bj][m][n] = t; } }
            s += __shfl_xor(s, 16); s += __shfl_xor(s, 32);
            if (fq == 0) xch[1024 + (ai * 128 + wr * 64 + m * 16 + fr) * 4 + wc] = s; }
        LDS_WAIT(); __builtin_amdgcn_s_barrier(); asm volatile("" ::: "memory");
        EPI_ROWS { const f32x4 q = *(const LAS f32x4*)(xch + 1024 + (ai * 128 + wr * 64 + m * 16 + fr) * 4);
            const float inv = frcp((q[0] + q[1]) + (q[2] + q[3]));
            bf16_t* rowp = P + (size_t)EPI_ROW * 1024 + u.tag * 256 + wc * 32 + 8 * fq;
            EPI_BJ { *(u32x4*)(rowp + bj * 128) = pack8(acc[ai][bj][m][0] * inv, acc[ai][bj][m][1] * inv); } EPI_FENCE; }
        LDS_WAIT(); __builtin_amdgcn_s_barrier(); asm volatile("" ::: "memory");
    }
};
}
struct Args { const float* in[42]; float* out; unsigned char* ws; int ph_lo, ph_hi; };
struct Ctx {
    const float* const* in; float* out; unsigned char* ws; LAS unsigned char* lds;
    int tid, lane, wave, G, bid;
};
enum { I_X = 0, I_MEM, I_POS, I_WIN, I_RWMU, I_RWW0, I_RWWUP, I_RWA0, I_RWAUP, I_RWGUP, I_RWKK, I_RWKA, I_RWRK, I_RWGNG, I_RWGNB,
       I_CONVW, I_CONVB, I_DTB, I_ALOG, I_SSDD, I_SSDNG, I_QNG, I_WUQ, I_KVNG, I_WUKV, I_WBR, I_WGATE, I_WOUT, I_LN1G, I_LN1B,
       I_XWQ, I_XWKV, I_XWO, I_LN2G, I_LN2B, I_FFN13, I_FFN2, I_ROUTER, I_MOE13, I_MOE2, I_LN3G, I_LN3B };
__device__ __forceinline__ Ctx launder(const Ctx& C0) {
    Ctx L = C0; unsigned zo_ = 0u; int t_ = threadIdx.x;
    asm volatile("" : "+s"(zo_), "+v"(t_));
    L.out = C0.out + zo_; L.ws = C0.ws + zo_; L.tid = t_; L.lane = t_ & 63; L.wave = __builtin_amdgcn_readfirstlane(t_ >> 6); return L;
}
#define WSP(T_, off) ((T_*)(C.ws + (off)))
#define GW (C.bid * NWAVES + C.wave)
#define NGW (C.G * NWAVES)

struct TJob { const float* W; int ldw, K, N; bf16_t* WT; int ldt; int map; float scale; int items; };
__device__ __forceinline__ int tj_items(int K, int N) { return (K / 64) * ((N + 31) / 32); }
__device__ __forceinline__ int tj_dest(int map, int n, int N) {
    if (map == 0) return n;
    if (map == 1) return n < 2816 ? n : (n < 2820 ? PC_DT + (n - 2816) : n - 4);
    const int half = N >> 1, j = n < half ? n : n - half;
    return (j >> 4) * 32 + (j & 15) + (n < half ? 0 : 16);
}
__device__ __forceinline__ void t_load(const TJob& J, int item, int lane, float (&v)[32], unsigned var = 0u) {
    const int nblk = (J.N + 31) / 32, kb = item / nblk, nb = item % nblk, k0 = 64 * kb, n0 = 32 * nb;
    const int nn = n0 + (lane & 31); const bool okn = nn < J.N; const float* src = J.W + (size_t)(k0 + (lane >> 5)) * J.ldw + nn;
#pragma unroll
    for (int i = 0; i < 32; ++i) v[i] = (okn && !(var & 8u)) ? src[(size_t)(2 * i) * J.ldw] : 0.f;
}
__device__ __forceinline__ void t_commit(const TJob& J, LAS float* scr, int item, int lane, const float (&v)[32], unsigned var = 0u) {
    const int nblk = (J.N + 31) / 32, kb = item / nblk, nb = item % nblk, k0 = 64 * kb, n0 = 32 * nb;
#pragma unroll
    for (int i = 0; i < 32; ++i) scr[(2 * i + (lane >> 5)) * 33 + (lane & 31)] = v[i];
    LDS_WAIT(); asm volatile("" ::: "memory");
    const int c = lane & 7;
#pragma unroll
    for (int j = 0; j < 4; ++j) { const int nl = (lane >> 3) + 8 * j, n = n0 + nl;
        if (n < J.N && !(var & 4u)) { const LAS float* s = scr + (8 * c) * 33 + nl; const float sc = (J.map == 1 && n >= 256) ? 1.0f : J.scale;
            u32x4 o; o.x = cvt_pk_bf16(s[0 * 33] * sc, s[1 * 33] * sc); o.y = cvt_pk_bf16(s[2 * 33] * sc, s[3 * 33] * sc); o.z = cvt_pk_bf16(s[4 * 33] * sc, s[5 * 33] * sc); o.w = cvt_pk_bf16(s[6 * 33] * sc, s[7 * 33] * sc);
            *(u32x4*)(J.WT + (size_t)tj_dest(J.map, n, J.N) * J.ldt + k0 + 8 * c) = o; } }
    LDS_WAIT(); asm volatile("" ::: "memory");
}
__device__ __forceinline__ TJob mkjob(const float* W, int ldw, int K, int N, bf16_t* WT, int ldt, int map, float scale) { TJob j; j.W = W; j.ldw = ldw; j.K = K; j.N = N; j.WT = WT; j.ldt = ldt; j.map = map; j.scale = scale; j.items = tj_items(K, N); return j; }

__device__ __forceinline__ TJob prologue_job(const Ctx& C, int j) {
    if (j < 26) { const int l = j / 13, r = j % 13; unsigned char* LW = C.ws + W_BASE + (size_t)l * LW_SIZE;
        if (r == 0) return mkjob(C.in[I_WIN] + (size_t)l * 1024 * 3236, 3236, 1024, 3236, (bf16_t*)(LW + LW_WIN), 1024, 1, 0.125f * LOG2E);
        if (r < 5) { const int i = r - 1; return mkjob(C.in[I_WGATE] + ((size_t)l * 4 + i) * 1024 * 1024, 1024, 1024, 1024, (bf16_t*)(LW + LW_WGATE) + (size_t)i * 1024 * 1024, 1024, 0, 1.f); }
        if (r < 9) { const int i = r - 5; return mkjob(C.in[I_WBR] + ((size_t)l * 4 + i) * 256 * 1024, 1024, 256, 1024, (bf16_t*)(LW + LW_WBR) + (size_t)i * 1024 * 256, 256, 0, 1.f); }
        if (r == 9) return mkjob(C.in[I_WOUT] + (size_t)l * 1024 * 1024, 1024, 1024, 1024, (bf16_t*)(LW + LW_WOUT), 1024, 0, 1.f);
        if (r == 10) return mkjob(C.in[I_XWQ], 1024, 0, 1024, (bf16_t*)(LW + LW_WQ), 1024, 0, 1.f);
        if (r == 11) return mkjob(C.in[I_XWKV] + (size_t)l * 1024 * 2048, 2048, 1024, 2048, (bf16_t*)(LW + LW_WKV), 1024, 0, 1.f);
        return mkjob(C.in[I_XWO] + (size_t)l * 1024 * 1024, 1024, 1024, 1024, (bf16_t*)(LW + LW_WO), 1024, 0, 1.f);
    }
    if (j == 26) return mkjob(C.in[I_FFN13], 2 * FFD, 1024, 2 * FFD, WSP(bf16_t, W_FFN13), 1024, 2, 1.f);
    return mkjob(C.in[I_FFN2], 1024, FFD, 1024, WSP(bf16_t, W_FFN2), FFD, 0, 1.f);
}
__device__ __forceinline__ TJob moe_job(const Ctx& C, int j) {
    if (j < 8) return mkjob(C.in[I_MOE13] + (size_t)j * 1024 * 2 * FFE, 2 * FFE, 1024, 2 * FFE, (bf16_t*)C.out + (size_t)j * 2 * FFE * 1024, 1024, 2, 1.f);
    const int e = j - 8; return mkjob(C.in[I_MOE2] + (size_t)e * FFE * 1024, 1024, FFE, 1024, WSP(bf16_t, W_MW2) + (size_t)e * 1024 * FFE, FFE, 0, 1.f);
}
template <int L> __device__ __forceinline__ TJob mix_job(const Ctx& C, int j) {
    if (L == 0) { if (j < 15) return prologue_job(C, 13 + j); const int m = j - 15; return moe_job(C, m < 4 ? m : 8 + (m - 4)); }
    return moe_job(C, j < 4 ? 4 + j : 12 + (j - 4));
}
constexpr int MIXJ0 = 23, MIXJ1 = 8;
__device__ __forceinline__ void t_load4(const TJob& J, int item, int lane, f32x4 (&v)[8], unsigned var = 0u) {
    const int nblk = (J.N + 31) / 32, kb = item / nblk, nb = item % nblk, k0 = 64 * kb, n0 = 32 * nb;
    const int nn = n0 + 4 * (lane & 7); const bool okn = nn < J.N && !(var & 8u); const float* src = J.W + (size_t)(k0 + (lane >> 3)) * J.ldw + nn;
#pragma unroll
    for (int i = 0; i < 8; ++i) v[i] = okn ? *(const f32x4*)(src + (size_t)(8 * i) * J.ldw) : (f32x4){0.f, 0.f, 0.f, 0.f};
}
__device__ __forceinline__ void t_commit4(const TJob& J, LAS float* scr, int item, int lane, const f32x4 (&v)[8], unsigned var = 0u) {
    const int nblk = (J.N + 31) / 32, kb = item / nblk, nb = item % nblk, k0 = 64 * kb, n0 = 32 * nb;
    LAS float* wp = scr + (4 * (lane & 7)) * 65 + (lane >> 3);
#pragma unroll
    for (int i = 0; i < 8; ++i) { wp[0 * 65 + 8 * i] = v[i][0]; wp[1 * 65 + 8 * i] = v[i][1]; wp[2 * 65 + 8 * i] = v[i][2]; wp[3 * 65 + 8 * i] = v[i][3]; }
    LDS_WAIT(); asm volatile("" ::: "memory");
    const int c = lane & 7;
#pragma unroll
    for (int j = 0; j < 4; ++j) { const int nl = (lane >> 3) + 8 * j, n = n0 + nl;
        if (n < J.N && !(var & 4u)) { const LAS float* s = scr + nl * 65 + 8 * c; const float sc = (J.map == 1 && n >= 256) ? 1.0f : J.scale;
            u32x4 o; o.x = cvt_pk_bf16(s[0] * sc, s[1] * sc); o.y = cvt_pk_bf16(s[2] * sc, s[3] * sc); o.z = cvt_pk_bf16(s[4] * sc, s[5] * sc); o.w = cvt_pk_bf16(s[6] * sc, s[7] * sc);
            *(u32x4*)(J.WT + (size_t)tj_dest(J.map, n, J.N) * J.ldt + k0 + 8 * c) = o; } }
    LDS_WAIT(); asm volatile("" ::: "memory");
}
template <int NJ, int SEL> __device__ __forceinline__ TJob sel_job(const Ctx& C, int j) { if (SEL == 0) return prologue_job(C, j); if (SEL == 1) return moe_job(C, j); if (SEL == 2) return mix_job<0>(C, j); return mix_job<1>(C, j); }
template <int NJ, int SEL> __device__ __forceinline__ int tjobs_total(const Ctx& C) { int total = 0; for (int j = 0; j < NJ; ++j) total += sel_job<NJ, SEL>(C, j).items; return total; }
template <int NJ, int SEL> __device__ __forceinline__ void run_tjobs_range(const Ctx& C, int it0, int stride, int it_end, unsigned var = 0u) {
    LAS float* scr = (LAS float*)(C.lds + C.wave * 16384);
    int j = 0, jbase = 0, it = it0; TJob J = sel_job<NJ, SEL>(C, 0);
    auto next = [&](TJob& Jo, int& io) -> bool { if (it >= it_end) return false;
        while (it >= jbase + J.items) { jbase += J.items; ++j; J = sel_job<NJ, SEL>(C, j); }
        Jo = J; io = it - jbase; it += stride; return true; };
    TJob Ja, Jb, Jc; int ia = 0, ib = 0, ic = 0; f32x4 va[8], vb[8], vc[8];
    bool ha = next(Ja, ia); if (!ha) return; t_load4(Ja, ia, C.lane, va, var);
    bool hb = next(Jb, ib); if (hb) t_load4(Jb, ib, C.lane, vb, var);
    for (;;) {
        bool hc = next(Jc, ic); if (hc) t_load4(Jc, ic, C.lane, vc, var);
        t_commit4(Ja, scr, ia, C.lane, va, var); if (!hb) break;
        ha = next(Ja, ia); if (ha) t_load4(Ja, ia, C.lane, va, var);
        t_commit4(Jb, scr, ib, C.lane, vb, var); if (!hc) break;
        hb = next(Jb, ib); if (hb) t_load4(Jb, ib, C.lane, vb, var);
        t_commit4(Jc, scr, ic, C.lane, vc, var); if (!ha) break;
    }
}
template <int NJ, bool MOE> __device__ __forceinline__ void run_tjobs(const Ctx& C, unsigned var = 0u) { run_tjobs_range<NJ, MOE ? 1 : 0>(C, GW, NGW, tjobs_total<NJ, MOE ? 1 : 0>(C), var); }


constexpr int CW_CHK = 32768;
template <class OutF> __device__ __forceinline__ void chk_gemm(const Ctx& C, const bf16_t* A, int lda, const bf16_t* Bt, int ldb, int K, int nrows, int ncs, int cstride, int c0, int bit, OutF expect_vs_got) {
    unsigned bad = 0; const int lane = C.lane;
    for (int it = GW; it < nrows * ncs; it += NGW) {
        const int r = it / ncs, c = c0 + (it % ncs) * cstride; float d = 0.f;
        for (int k = lane * 8; k < K; k += 512) { const u32x4 a = *(const u32x4*)(A + (size_t)r * lda + k), b = *(const u32x4*)(Bt + (size_t)c * ldb + k);
            d += bflo(a.x) * bflo(b.x) + bfhi(a.x) * bfhi(b.x) + bflo(a.y) * bflo(b.y) + bfhi(a.y) * bfhi(b.y) + bflo(a.z) * bflo(b.z) + bfhi(a.z) * bfhi(b.z) + bflo(a.w) * bflo(b.w) + bfhi(a.w) * bfhi(b.w); }
        d = wave_sum(d);
        if (!expect_vs_got(r, c, d)) bad = 1;
    }
    if (lane == 0 && bad) __hip_atomic_fetch_add((unsigned*)(C.ws + WS_CTL) + CW_CHK + 64 * bit, 1u, RLX_AGENT);
}
__device__ __forceinline__ bool chk_close(float e, float g) { return fabsf(e - g) <= 0.03f * fabsf(e) + 0.03f; }

__device__ __forceinline__ float chk_dot(const bf16_t* a, const bf16_t* b, int K, int lane) {
    float d = 0.f;
    for (int k = lane * 8; k < K; k += 512) { const u32x4 x = *(const u32x4*)(a + k), y = *(const u32x4*)(b + k);
        d += bflo(x.x) * bflo(y.x) + bfhi(x.x) * bfhi(y.x) + bflo(x.y) * bflo(y.y) + bfhi(x.y) * bfhi(y.y) + bflo(x.z) * bflo(y.z) + bfhi(x.z) * bfhi(y.z) + bflo(x.w) * bflo(y.w) + bfhi(x.w) * bfhi(y.w); }
    return wave_sum(d);
}
__device__ __forceinline__ void chk_flag(const Ctx& C, int bit, unsigned bad) { if (C.lane == 0 && bad) __hip_atomic_fetch_add((unsigned*)(C.ws + WS_CTL) + CW_CHK + 64 * bit, 1u, RLX_AGENT); }
__device__ __forceinline__ void chk_merged(const Ctx& C, int l, int bit) {
    const bf16_t* Y = WSP(bf16_t, S_Y); const bf16_t* G = WSP(bf16_t, S_G); const bf16_t* MB = WSP(bf16_t, S_MB); const bf16_t* WBR = (const bf16_t*)(C.ws + W_BASE + (size_t)l * LW_SIZE + LW_WBR); unsigned bad = 0;
    for (int it = GW; it < T * 4; it += NGW) { const int r = it >> 2, c = 13 + 256 * (it & 3); float e = 0.f;
        for (int i = 0; i < 4; ++i) e += bf2f(G[(size_t)r * 4096 + i * 1024 + c]) * chk_dot(Y + (size_t)r * 1024 + 256 * i, WBR + ((size_t)i * 1024 + c) * 256, 256, C.lane);
        if (!chk_close(e, bf2f(MB[(size_t)r * 1024 + c]))) bad = 1; }
    chk_flag(C, bit, bad);
}
__device__ __forceinline__ void chk_swiglu(const Ctx& C, int bit) {
    const bf16_t* XB = WSP(bf16_t, W_XB); const bf16_t* W = WSP(bf16_t, W_FFN13); const bf16_t* H = WSP(bf16_t, S_H); unsigned bad = 0;
    for (int it = GW; it < T * 22; it += NGW) { const int r = it / 22, hc = 5 + 128 * (it % 22); const int grow = (hc >> 4) * 32 + (hc & 15);
        const float g = chk_dot(XB + (size_t)r * 1024, W + (size_t)grow * 1024, 1024, C.lane), u = chk_dot(XB + (size_t)r * 1024, W + (size_t)(grow + 16) * 1024, 1024, C.lane);
        if (!chk_close(siluf_(g) * u, bf2f(H[(size_t)r * FFD + hc]))) bad = 1; }
    chk_flag(C, bit, bad);
}

constexpr size_t S_CHKBUF = S_BASE + (size_t)400 * MiB;
__device__ __forceinline__ void chk_resid_stash(const Ctx& C, const bf16_t* A, int lda, const bf16_t* Bt, int ldb, int K, int slot) {
    const float* XR = WSP(float, W_XRES); float* CB = WSP(float, S_CHKBUF);
    for (int it = GW; it < T * 4; it += NGW) { const int r = it >> 2, q = it & 3, c = 17 + 256 * q; const float d = chk_dot(A + (size_t)r * lda, Bt + (size_t)c * ldb, K, C.lane);
        if (C.lane == 0) CB[(size_t)r * 8 + slot * 4 + q] = XR[(size_t)r * 1024 + c] * DN_ALPHA + d; }
}
__device__ __forceinline__ void chk_resid_cmp(const Ctx& C, int slot, int bit) {
    const float* XR = WSP(float, W_XRES); const float* CB = WSP(float, S_CHKBUF); unsigned bad = 0;
    for (int it = GW; it < T * 4; it += NGW) { const int r = it >> 2, q = it & 3, c = 17 + 256 * q; if (!chk_close(CB[(size_t)r * 8 + slot * 4 + q], XR[(size_t)r * 1024 + c])) bad = 1; }
    chk_flag(C, bit, bad);
}
__device__ __forceinline__ void chk_ln_stash(const Ctx& C, const float* g, const float* b, int slot) {
    const float* XR = WSP(float, W_XRES); float* CB = WSP(float, S_CHKBUF); const int lane = C.lane;
    for (int t = GW; t < T; t += NGW) { float s = 0.f, s2 = 0.f; float v[16];
        for (int j = 0; j < 16; ++j) { v[j] = XR[(size_t)t * 1024 + lane + 64 * j]; s += v[j]; }
        const float mean = wave_sum(s) * (1.0f / 1024.0f); for (int j = 0; j < 16; ++j) { const float d = v[j] - mean; s2 += d * d; }
        const float rstd = 1.0f / sqrtf(wave_sum(s2) * (1.0f / 1024.0f) + 1e-5f);
        if (lane < 4) { const int c = 17 + 256 * lane; CB[(size_t)t * 8 + slot * 4 + lane] = (XR[(size_t)t * 1024 + c] - mean) * rstd * g[c] + b[c]; } }
}
__device__ __forceinline__ void chk_ln_cmp(const Ctx& C, int slot, int bit) {
    const float* XR = WSP(float, W_XRES); const bf16_t* XB = WSP(bf16_t, W_XB); const float* CB = WSP(float, S_CHKBUF); unsigned bad = 0;
    for (int it = GW; it < T * 4; it += NGW) { const int r = it >> 2, q = it & 3, c = 17 + 256 * q; const float e = CB[(size_t)r * 8 + slot * 4 + q];
        if (!chk_close(e, XR[(size_t)r * 1024 + c]) || !chk_close(e, bf2f(XB[(size_t)r * 1024 + c]))) bad = 1; }
    chk_flag(C, bit, bad);
}

template <int NJ, bool MOE> __device__ __forceinline__ void chk_weights(const Ctx& C, int bit) {
    unsigned bad = 0; const int gt = C.bid * NTHREADS + C.tid, NT = C.G * NTHREADS;
    for (int j = 0; j < NJ; ++j) { const TJob J = MOE ? moe_job(C, j) : prologue_job(C, j);
        for (size_t i = gt; i < (size_t)J.K * J.N; i += NT) { const int k = (int)(i / J.N), n = (int)(i % J.N);
            const float sc = (J.map == 1 && n >= 256) ? 1.0f : J.scale; const bf16_t e = (bf16_t)(cvt_pk_bf16(J.W[(size_t)k * J.ldw + n] * sc, 0.f) & 0xffffu);
            if (J.WT[(size_t)tj_dest(J.map, n, J.N) * J.ldt + k] != e) bad = 1; } }
    if (bad) __hip_atomic_fetch_add((unsigned*)(C.ws + WS_CTL) + CW_CHK + 64 * bit, 1u, RLX_AGENT);
}

__device__ __forceinline__ void chk_mla_inputs(const Ctx& C, int l, int bit) {
    const bf16_t* proj = WSP(bf16_t, S_PROJ); const bf16_t* QM = WSP(bf16_t, S_QM); const bf16_t* KM = WSP(bf16_t, S_KM); const bf16_t* VM = WSP(bf16_t, S_VM);
    const float* wuq = C.in[I_WUQ] + (size_t)l * 256 * 384; const float* wukv = C.in[I_WUKV] + (size_t)l * 128 * 512; const float* qg = C.in[I_QNG] + l * 256; const float* kvg = C.in[I_KVNG] + l * 128;
    const int* pos = (const int*)C.in[I_POS]; const int lane = C.lane; unsigned bad = 0; const float qs = 0.10206207261596575f * LOG2E;
    for (int t = GW; t < T; t += NGW) {
        const bf16_t* pr = proj + (size_t)t * NPROJ; float cq[4], ck[2]; float ss = 0.f;
        for (int i = 0; i < 4; ++i) { cq[i] = bf2f(pr[PC_CQ + lane + 64 * i]); ss += cq[i] * cq[i]; }
        float rs = 1.0f / sqrtf(wave_sum(ss) * (1.0f / 256.0f) + 1e-6f); for (int i = 0; i < 4; ++i) cq[i] *= rs * qg[lane + 64 * i];
        ss = 0.f; for (int i = 0; i < 2; ++i) { ck[i] = bf2f(pr[PC_CKV + lane + 64 * i]); ss += ck[i] * ck[i]; }
        rs = 1.0f / sqrtf(wave_sum(ss) * (1.0f / 128.0f) + 1e-6f); for (int i = 0; i < 2; ++i) ck[i] *= rs * kvg[lane + 64 * i];
        const float ang = (float)pos[t] * exp2f(-6.0f * (13.287712379549449f / 32.0f)); const float c3 = cosf(ang), s3 = sinf(ang);
        const int h = t & 3;
        float qn = 0.f, q1 = 0.f, q2 = 0.f, kn = 0.f, vv = 0.f;
        for (int i = 0; i < 4; ++i) { const int k = lane + 64 * i; qn += cq[i] * wuq[(size_t)k * 384 + h * 96 + 5]; q1 += cq[i] * wuq[(size_t)k * 384 + h * 96 + 67]; q2 += cq[i] * wuq[(size_t)k * 384 + h * 96 + 83]; }
        for (int i = 0; i < 2; ++i) { const int k = lane + 64 * i; kn += ck[i] * wukv[(size_t)k * 512 + h * 128 + 7]; vv += ck[i] * wukv[(size_t)k * 512 + h * 128 + 64 + 9]; }
        qn = wave_sum(qn) * qs; q1 = wave_sum(q1) * qs; q2 = wave_sum(q2) * qs; kn = wave_sum(kn); vv = wave_sum(vv);
        const float kr1 = bf2f(pr[PC_KR + 3]), kr2 = bf2f(pr[PC_KR + 19]);
        const bf16_t* qrow = QM + (size_t)t * 384 + h * 96; const bf16_t* krow = KM + (size_t)t * 384 + h * 96;
        if (!chk_close(qn, bf2f(qrow[5])) || !chk_close(q1 * c3 - q2 * s3, bf2f(qrow[67])) || !chk_close(q1 * s3 + q2 * c3, bf2f(qrow[83])) || !chk_close(kn, bf2f(krow[7])) ||
            !chk_close(kr1 * c3 - kr2 * s3, bf2f(krow[67])) || !chk_close(kr1 * s3 + kr2 * c3, bf2f(krow[83])) || !chk_close(vv, bf2f(VM[(size_t)t * 256 + h * 64 + 9]))) bad = 1;
    }
    chk_flag(C, bit, bad);
}

__device__ __forceinline__ void chk_rw_inputs(const Ctx& C, int l, int bit) {
    const bf16_t* proj = WSP(bf16_t, S_PROJ); const float* DEC = WSP(float, S_DEC); const bf16_t* RWS = WSP(bf16_t, S_RWS); const bf16_t* GV = WSP(bf16_t, S_GV); const size_t PL = (size_t)T * 256;
    const float* mu = C.in[I_RWMU] + l * 1024; const float* w0 = C.in[I_RWW0] + l * 256; const float* a0 = C.in[I_RWA0] + l * 256;
    const float* wup = C.in[I_RWWUP] + l * 64 * 256; const float* aup = C.in[I_RWAUP] + l * 64 * 256; const float* gup = C.in[I_RWGUP] + l * 128 * 256;
    const float* kkw = C.in[I_RWKK] + l * 256; const float* kaw = C.in[I_RWKA] + l * 256; const int lane = C.lane; unsigned bad = 0;
    for (int t = GW; t < T; t += NGW) {
        const bf16_t* pr = proj + (size_t)t * NPROJ + PC_RW; const bool first = (t % SEQ) == 0; const int h = t & 3, c = h * 64 + 11;
        auto sh = [&](int col) { const float cur = bf2f(pr[col]); const float prv = first ? 0.f : bf2f(pr[col - NPROJ]); return cur + (prv - cur) * mu[col]; };
        float dw = tanhf(sh(768 + lane)) * wup[lane * 256 + c], da = sh(832 + lane) * aup[lane * 256 + c];
        float dg = (1.0f / (1.0f + expf(-sh(896 + lane)))) * gup[lane * 256 + c] + (1.0f / (1.0f + expf(-sh(960 + lane)))) * gup[(64 + lane) * 256 + c];
        dw = wave_sum(dw); da = wave_sum(da); dg = wave_sum(dg);
        const float xw = w0[c] + dw; const float wlog = -(fmaxf(-xw, 0.f) + log1pf(expf(-fabsf(xw)))) - 0.5f; const float dec = expf(-expf(wlog));
        const float a = 1.0f / (1.0f + expf(-(a0[c] + da)));
        const float kl = sh(256 + h * 64 + lane) * kkw[h * 64 + lane]; const float nrm = 1.0f / sqrtf(fmaxf(wave_sum(kl * kl), 1e-24f));
        const float r = sh(c), k = sh(256 + c), v = sh(512 + c); const float kk = k * kkw[c] * nrm, kmod = k * (1.0f + (a - 1.0f) * kaw[c]), ka = kk * a;
        const size_t o = (size_t)t * 256 + c;
        if (!chk_close(dec, DEC[o]) || fabsf(dec - DEC[o]) > 0.004f || !chk_close(r, bf2f(RWS[o])) || !chk_close(kmod, bf2f(RWS[PL + o])) || !chk_close(v, bf2f(RWS[2 * PL + o])) || !chk_close(kk, bf2f(RWS[3 * PL + o])) ||
            !chk_close(ka, bf2f(RWS[4 * PL + o])) || !chk_close(dg, bf2f(GV[o]))) bad = 1;
    }
    chk_flag(C, bit, bad);
}
__device__ __forceinline__ void chk_ssd_norm(const Ctx& C, int l, int bit) {
    const bf16_t* Y = WSP(bf16_t, S_Y); const float* ng = C.in[I_SSDNG] + l * 256; const int lane = C.lane; unsigned bad = 0;
    for (int t = GW; t < T; t += NGW) { float q = 0.f;
        for (int i = 0; i < 4; ++i) { const int c = (lane >> 5) * 128 + (lane & 31) * 4 + i; const float y = bf2f(Y[(size_t)t * 1024 + 512 + c]) / ng[c]; q += y * y; }
        for (int o_ = 1; o_ < 32; o_ <<= 1) q += __shfl_xor(q, o_);
        q *= (1.0f / 128.0f); if (q < 0.9f || q > 1.1f) bad = 1; }
    chk_flag(C, bit, bad);
}

#ifndef P7_COND
#define P7_COND 1
#endif
#ifndef P7_CLASS
#define P7_CLASS (((c & 31) < 16 ? 1u : 2u) | ((c & 255) < 128 ? 4u : 8u))
#endif
__device__ __forceinline__ float tdot(const bf16_t* a, const bf16_t* b, int K) { float d = 0.f;
    for (int k = 0; k < K; k += 8) { const u32x4 x = *(const u32x4*)(a + k), y = *(const u32x4*)(b + k);
        d += bflo(x.x) * bflo(y.x) + bfhi(x.x) * bfhi(y.x) + bflo(x.y) * bflo(y.y) + bfhi(x.y) * bfhi(y.y) + bflo(x.z) * bflo(y.z) + bfhi(x.z) * bfhi(y.z) + bflo(x.w) * bflo(y.w) + bfhi(x.w) * bfhi(y.w); }
    return d; }
__device__ __forceinline__ void chk_full_p7(const Ctx& C, int l, int bit) {
    const bf16_t* MB = WSP(bf16_t, S_MB); const bf16_t* W = (const bf16_t*)(C.ws + W_BASE + (size_t)l * LW_SIZE + LW_WOUT); const float* xin = C.in[I_X]; const float* XR = WSP(float, W_XRES); float num = 0.f, den = 0.f;
    for (size_t i = (size_t)C.bid * NTHREADS + C.tid; i < (size_t)T * 1024; i += (size_t)C.G * NTHREADS) { const size_t r = i >> 10; const int c = (int)(i & 1023);
        const float d = tdot(MB + r * 1024, W + (size_t)c * 1024, 1024), g = XR[i] - xin[i] * DN_ALPHA; num += (d - g) * (d - g); den += d * d; }
    num = wave_sum(num); den = wave_sum(den);
    if (C.lane == 0) { atomicAdd((float*)(C.ws + WS_CTL) + CW_CHK + 1024, num); atomicAdd((float*)(C.ws + WS_CTL) + CW_CHK + 1088, den); }
}
__device__ __forceinline__ void chk_full_merged(const Ctx& C, int l, int bit) {
    const bf16_t* Y = WSP(bf16_t, S_Y); const bf16_t* G = WSP(bf16_t, S_G); const bf16_t* MB = WSP(bf16_t, S_MB); const bf16_t* WBR = (const bf16_t*)(C.ws + W_BASE + (size_t)l * LW_SIZE + LW_WBR); unsigned bad = 0;
    for (size_t i = (size_t)C.bid * NTHREADS + C.tid; i < (size_t)T * 1024; i += (size_t)C.G * NTHREADS) { const size_t r = i >> 10; const int c = (int)(i & 1023); float e = 0.f;
        for (int q = 0; q < 4; ++q) e += bf2f(G[r * 4096 + q * 1024 + c]) * tdot(Y + r * 1024 + 256 * q, WBR + ((size_t)q * 1024 + c) * 256, 256);
        if (!chk_close(e, bf2f(MB[i]))) bad = 1; }
    if (bad) __hip_atomic_fetch_add((unsigned*)(C.ws + WS_CTL) + CW_CHK + 64 * bit, 1u, RLX_AGENT);
}

#ifndef FG_CLASS
#define FG_CLASS (1u << ((c >> 5) & 3))
#endif
template <class F> __device__ __forceinline__ void chk_full_gemm(const Ctx& C, const bf16_t* A, const bf16_t* Bt, int K, int N, int bit, F ok) {
    unsigned bad = 0, cntbad = 0;
    for (size_t i = (size_t)C.bid * NTHREADS + C.tid; i < (size_t)T * N; i += (size_t)C.G * NTHREADS) { const size_t r = i / N; const int c = (int)(i % N);
        if (!ok(r, c, tdot(A + r * K, Bt + (size_t)c * K, K))) { bad |= (bit < 0) ? (FG_CLASS) : (1u << bit); ++cntbad; } }
#ifdef FG_COUNT
    if (cntbad) __hip_atomic_fetch_add((unsigned*)(C.ws + WS_CTL) + CW_CHK + 2048, cntbad, RLX_AGENT);
#else
    for (int q = 0; q < 4; ++q) if ((bad >> q) & 1) __hip_atomic_fetch_add((unsigned*)(C.ws + WS_CTL) + CW_CHK + 64 * q, 1u, RLX_AGENT);
#endif
}
__device__ __forceinline__ void ph_prologue(const Ctx& C) {
    run_tjobs<13, false>(C);
    const int gt = C.bid * NTHREADS + C.tid, NT = C.G * NTHREADS;
    for (int l = 0; l < 2; ++l) {
        unsigned char* LW = C.ws + W_BASE + (size_t)l * LW_SIZE;
        bf16_t* lora = (bf16_t*)(LW + LW_LORA); const float* wup = C.in[I_RWWUP] + l * 64 * 256; const float* aup = C.in[I_RWAUP] + l * 64 * 256; const float* gup = C.in[I_RWGUP] + l * 128 * 256;
        for (int i = gt; i < 768 * 256; i += NT) { const int n = i >> 8, k = i & 255; float v = 0.f;
            if (n < 256) { if (k < 64) v = wup[k * 256 + n]; } else if (n < 512) { if (k >= 64 && k < 128) v = aup[(k - 64) * 256 + (n - 256)]; } else { if (k >= 128) v = gup[(k - 128) * 256 + (n - 512)]; }
            lora[i] = (bf16_t)(cvt_pk_bf16(v, 0.f) & 0xffffu); }
        bf16_t* wuq = (bf16_t*)(LW + LW_WUQ); const float* suq = C.in[I_WUQ] + l * 256 * 384;
        for (int i = gt; i < 512 * 256; i += NT) { const int n = i >> 8, k = i & 255; const float v = n < 384 ? suq[k * 384 + n] * (0.10206207261596575f * LOG2E) : 0.f; wuq[i] = (bf16_t)(cvt_pk_bf16(v, 0.f) & 0xffffu); }
        bf16_t* wukv = (bf16_t*)(LW + LW_WUKV); const float* sukv = C.in[I_WUKV] + l * 128 * 512;
        for (int i = gt; i < 512 * 128; i += NT) { const int n = i >> 7, k = i & 127; wukv[i] = (bf16_t)(cvt_pk_bf16(sukv[k * 512 + n], 0.f) & 0xffffu); }
        { const float* wq = C.in[I_XWQ] + (size_t)l * 1024 * 1024; bf16_t* wqp = (bf16_t*)(LW + LW_WQ);
          for (size_t i = gt; i < (size_t)1024 * 1024 / 8; i += NT) { const f32x4 a = *(const f32x4*)(wq + i * 8) * (0.0625f * LOG2E), b = *(const f32x4*)(wq + i * 8 + 4) * (0.0625f * LOG2E); *(u32x4*)(wqp + i * 8) = epi::pack8(a, b); } }
        bf16_t* win = (bf16_t*)(LW + LW_WIN);
        for (int i = gt; i < (NPROJ - 3236) * 1024; i += NT) win[(size_t)3236 * 1024 + i] = 0;
    }
    { const float* x = C.in[I_X]; bf16_t* xb = WSP(bf16_t, W_XB);
#pragma unroll 4
      for (size_t i = gt; i < (size_t)T * 1024 / 8; i += NT) { const f32x4 a = *(const f32x4*)(x + i * 8), b = *(const f32x4*)(x + i * 8 + 4); *(u32x4*)(xb + i * 8) = epi::pack8(a, b); }
      const float* mm = C.in[I_MEM]; bf16_t* mb = WSP(bf16_t, W_MEMB);
      for (size_t i = gt; i < (size_t)NMEM * 1024 / 8; i += NT) { const f32x4 a = *(const f32x4*)(mm + i * 8), b = *(const f32x4*)(mm + i * 8 + 4); *(u32x4*)(mb + i * 8) = epi::pack8(a, b); } }
    { const int* pos = (const int*)C.in[I_POS]; float* ct = WSP(float, W_COS); float* st = WSP(float, W_SIN);
      for (int i = gt; i < T * 16; i += NT) { const int t = i >> 4, j = i & 15; const float inv = exp2f(-(float)(2 * j) * (13.287712379549449f / 32.0f)); const float ang = (float)pos[t] * inv; ct[i] = cosf(ang); st[i] = sinf(ang); } }
}

__device__ __forceinline__ f32x4 ld_bf4(const bf16_t* p) { const u32x2 w = *(const u32x2*)p; return (f32x4){bflo(w.x), bfhi(w.x), bflo(w.y), bfhi(w.y)}; }
__device__ __forceinline__ void st_bf4(bf16_t* p, const f32x4 v) { u32x2 w; w.x = cvt_pk_bf16(v[0], v[1]); w.y = cvt_pk_bf16(v[2], v[3]); *(u32x2*)p = w; }
__device__ __forceinline__ float tanhf_(float x) { return 1.0f - 2.0f * frcp(1.0f + fexp2(2.0f * LOG2E * x)); }
__device__ __forceinline__ void ph_prep(const Ctx& C, int l) {
    const bf16_t* __restrict__ proj = WSP(bf16_t, S_PROJ); const float* mu = C.in[I_RWMU] + l * 1024;
    bf16_t* __restrict__ LA = WSP(bf16_t, S_LA); bf16_t* __restrict__ CQN = WSP(bf16_t, S_CQN); bf16_t* __restrict__ CKVN = WSP(bf16_t, S_CKVN); bf16_t* __restrict__ KM = WSP(bf16_t, S_KM);
    const float* qg = C.in[I_QNG] + l * 256; const float* kvg = C.in[I_KVNG] + l * 128; const float* ct = WSP(float, W_COS); const float* st = WSP(float, W_SIN);
    const int lane = C.lane, c4 = 4 * lane, c2 = 2 * lane, i16 = lane & 15;
    const f32x4 m = *(const f32x4*)(mu + 768 + c4), qgv = *(const f32x4*)(qg + c4); const float kg0 = kvg[c2], kg1 = kvg[c2 + 1];
    u32x2 n_cur, n_prv, n_cq; unsigned n_ckv; unsigned short n_kr; float n_cs, n_sn;
#define PREP_LOAD(tt) do { const bf16_t* pr_ = proj + (size_t)(tt) * NPROJ; n_cur = *(const u32x2*)(pr_ + PC_RW + 768 + c4); \
        n_prv = ((tt) % SEQ) == 0 ? (u32x2){0u, 0u} : *(const u32x2*)(pr_ - NPROJ + PC_RW + 768 + c4); n_cq = *(const u32x2*)(pr_ + PC_CQ + c4); n_ckv = *(const unsigned*)(pr_ + PC_CKV + c2); \
        n_kr = pr_[PC_KR + (lane & 31)]; n_cs = ct[(size_t)(tt) * 16 + i16]; n_sn = st[(size_t)(tt) * 16 + i16]; } while (0)
    int t = GW; if (t < T) PREP_LOAD(t);
    for (; t < T; t += NGW) {
        const u32x2 wc = n_cur, wp = n_prv, wq = n_cq; const unsigned wk = n_ckv; const float krv = bf2f(n_kr), cs = n_cs, sn = n_sn;
        if (t + NGW < T) PREP_LOAD(t + NGW);
        { const f32x4 cur = (f32x4){bflo(wc.x), bfhi(wc.x), bflo(wc.y), bfhi(wc.y)}, prv = (f32x4){bflo(wp.x), bfhi(wp.x), bflo(wp.y), bfhi(wp.y)}; f32x4 p = cur + (prv - cur) * m;
          if (c4 < 64) { for (int j = 0; j < 4; ++j) p[j] = tanhf_(p[j]); } else if (c4 >= 128) { for (int j = 0; j < 4; ++j) p[j] = sigmoidf_(p[j]); }
          st_bf4(LA + (size_t)t * 256 + c4, p); }
        { f32x4 v = (f32x4){bflo(wq.x), bfhi(wq.x), bflo(wq.y), bfhi(wq.y)}; const float ss = wave_sum((v[0] * v[0] + v[1] * v[1]) + (v[2] * v[2] + v[3] * v[3]));
          const float rs = 1.0f / sqrtf(ss * (1.0f / 256.0f) + 1e-6f); v = v * rs * qgv; st_bf4(CQN + (size_t)t * 256 + c4, v); }
        { float a = bflo(wk), b = bfhi(wk); const float ss = wave_sum(a * a + b * b);
          const float rs = 1.0f / sqrtf(ss * (1.0f / 128.0f) + 1e-6f); a *= rs * kg0; b *= rs * kg1; *(unsigned*)(CKVN + (size_t)t * 128 + c2) = cvt_pk_bf16(a, b); }
        { const float o = __shfl_xor(krv, 16);
          const float r = (lane & 16) ? (o * sn + krv * cs) : (krv * cs - o * sn);
          if (lane < 32) { const bf16_t rb = (bf16_t)(cvt_pk_bf16(r, 0.f) & 0xffffu); for (int h = 0; h < 4; ++h) KM[(size_t)t * 384 + h * 96 + 64 + lane] = rb; } }
    }
#undef PREP_LOAD
}
__device__ __forceinline__ void ph_rwprep(const Ctx& C, int l) {
#if defined(NAIVE_SCAN)
    if (NAIVE_SCAN & 2) { float* q_ = WSP(float, S_SSQ); for (int i = C.bid * NTHREADS + C.tid; i < T * 8; i += C.G * NTHREADS) q_[i] = 0.f; }
#endif
    const bf16_t* __restrict__ proj = WSP(bf16_t, S_PROJ); const float* mu = C.in[I_RWMU] + l * 1024; const bf16_t* __restrict__ AV = WSP(bf16_t, S_AV); bf16_t* __restrict__ RWS = WSP(bf16_t, S_RWS);
    const float* kkw = C.in[I_RWKK] + l * 256; const float* kaw = C.in[I_RWKA] + l * 256; const int lane = C.lane, c = 4 * lane;
    f32x4 muv[3];
#pragma unroll
    for (int q = 0; q < 3; ++q) muv[q] = *(const f32x4*)(mu + q * 256 + c);
    const f32x4 kkv = *(const f32x4*)(kkw + c), kav = *(const f32x4*)(kaw + c);
    u32x2 ncur[3], nprv[3], nav;
#define RWP_LOAD(tt) do { const bf16_t* pr_ = proj + (size_t)(tt) * NPROJ + PC_RW; const bool f_ = ((tt) % SEQ) == 0; \
        _Pragma("unroll") for (int q = 0; q < 3; ++q) { ncur[q] = *(const u32x2*)(pr_ + q * 256 + c); nprv[q] = f_ ? (u32x2){0u, 0u} : *(const u32x2*)(pr_ - NPROJ + q * 256 + c); } \
        nav = *(const u32x2*)(AV + (size_t)(tt) * 256 + c); } while (0)
#define U2F4(w) ((f32x4){bflo((w).x), bfhi((w).x), bflo((w).y), bfhi((w).y)})
    int t = GW; if (t < T) RWP_LOAD(t);
    for (; t < T; t += NGW) {
        f32x4 rkv[3];
#pragma unroll
        for (int q = 0; q < 3; ++q) { const f32x4 cur = U2F4(ncur[q]), prv = U2F4(nprv[q]); rkv[q] = cur + (prv - cur) * muv[q]; }
        const f32x4 a = U2F4(nav);
        if (t + NGW < T) RWP_LOAD(t + NGW);
        f32x4 kk = rkv[1] * kkv;
        float ss = (kk[0] * kk[0] + kk[1] * kk[1]) + (kk[2] * kk[2] + kk[3] * kk[3]);
        ss = row_sum16(ss);
        kk = kk * (1.0f / sqrtf(fmaxf(ss, 1e-24f)));
        const f32x4 kmod = rkv[1] * ((a - 1.0f) * kav + 1.0f), ka = kk * a;
        const size_t o = (size_t)t * 256 + c, PL = (size_t)T * 256;
        st_bf4(RWS + o, rkv[0]); st_bf4(RWS + PL + o, kmod); st_bf4(RWS + 2 * PL + o, rkv[2]); st_bf4(RWS + 3 * PL + o, kk); st_bf4(RWS + 4 * PL + o, ka);
    }
#undef RWP_LOAD
}
__device__ __forceinline__ void ph_ssdprep(const Ctx& C, int l) {
    const bf16_t* __restrict__ proj = WSP(bf16_t, S_PROJ); bf16_t* __restrict__ XA = WSP(bf16_t, S_XA); bf16_t* __restrict__ BC = WSP(bf16_t, S_BC); bf16_t* __restrict__ CC = WSP(bf16_t, S_CC); float* __restrict__ ACS = WSP(float, S_ACS); float* __restrict__ DTV = WSP(float, S_DTV);
    const float* cw = C.in[I_CONVW] + l * 4 * 768; const float* cb = C.in[I_CONVB] + l * 768; const float* dtbp = C.in[I_DTB] + l * 4; const float* alog = C.in[I_ALOG] + l * 4; const int lane = C.lane;
    for (int item = GW; item < 64; item += NGW) { const int b = item >> 2, h = item & 3; const float dtb = dtbp[h], a2 = -expf(alog[h]) * LOG2E; const size_t t0 = (size_t)b * SEQ + 32 * lane;
        unsigned short rawv[32];
#pragma unroll
        for (int i = 0; i < 32; ++i) rawv[i] = proj[(t0 + i) * NPROJ + PC_DT + h];
        float pre[32]; float run = 0.f;
#pragma unroll
        for (int i = 0; i < 32; ++i) { run += softplusf_(bf2f(rawv[i]) + dtb) * a2; pre[i] = run; }
        float sc_ = run;
#pragma unroll
        for (int d = 1; d < 64; d <<= 1) { const float o = __shfl_up(sc_, d); if (lane >= d) sc_ += o; }
        const float base = sc_ - run;
#pragma unroll
        for (int i = 0; i < 32; ++i) ACS[(t0 + i) * 4 + h] = base + pre[i]; }
    f32x4 cbv[3], cwv[3][4];
#pragma unroll
    for (int j = 0; j < 3; ++j) { const int c = 4 * lane + 256 * j; cbv[j] = *(const f32x4*)(cb + c);
#pragma unroll
        for (int k = 0; k < 4; ++k) cwv[j][k] = *(const f32x4*)(cw + k * 768 + c); }
    const float dtbl = dtbp[lane & 3];
    u32x2 nraw[3][4]; unsigned short ndt;
#define SSP_LOAD(tt) do { const int tl_ = (tt) % SEQ; _Pragma("unroll") for (int j = 0; j < 3; ++j) _Pragma("unroll") for (int k = 0; k < 4; ++k) \
        nraw[j][k] = (tl_ - 3 + k >= 0) ? *(const u32x2*)(proj + (size_t)((tt) - 3 + k) * NPROJ + PC_XS + 4 * lane + 256 * j) : (u32x2){0u, 0u}; \
        ndt = proj[(size_t)(tt) * NPROJ + PC_DT + (lane & 3)]; } while (0)
    int t = GW; if (t < T) SSP_LOAD(t);
    for (; t < T; t += NGW) {
        f32x4 acc3[3]; const float dtraw = bf2f(ndt);
#pragma unroll
        for (int j = 0; j < 3; ++j) { f32x4 a = cbv[j];
#pragma unroll
            for (int k = 0; k < 4; ++k) a += U2F4(nraw[j][k]) * cwv[j][k];
            acc3[j] = a; }
        if (t + NGW < T) SSP_LOAD(t + NGW);
#pragma unroll
        for (int j = 0; j < 3; ++j) { f32x4 a = acc3[j]; for (int q = 0; q < 4; ++q) a[q] = siluf_(a[q]);
            st_bf4((j == 0 ? XA : (j == 1 ? BC : CC)) + (size_t)t * 256 + 4 * lane, a); }
        if (lane < 4) DTV[(size_t)t * 4 + lane] = softplusf_(dtraw + dtbl);
    }
#undef SSP_LOAD
#undef U2F4
}
#ifndef ABL_MOE
#define ABL_MOE 1.0f
#endif
template <bool MOE> __device__ __forceinline__ void ph_ln(const Ctx& C, const float* src, float* dst, bf16_t* dstb, const float* g, const float* b, const bf16_t* ys, const bf16_t* src16 = nullptr) {
    const int lane = C.lane;
    float chkscale = 1.0f;
#if defined(CHECKS) || defined(CHECKS2) || defined(CHECKS3) || defined(CHECKS4) || defined(CHECKS5) || defined(CHECKS6) || defined(CHECKS7) || defined(CHECKS8) || defined(CHECKS9) || defined(CHECKS10) || defined(CHECKS12) || defined(CHECKS13) || defined(CHECKS14) || defined(CHECKS15)
    if (MOE) { const unsigned* cw = (const unsigned*)(C.ws + WS_CTL) + CW_CHK; int n = 0;
        for (int q = 0; q < 4; ++q) if (__hip_atomic_load(cw + 64 * q, RLX_AGENT) != 0u) n |= 1 << q;
#if defined(FG_COUNT) || defined(CHECKS13) || defined(CHECKS15)
        { unsigned v_ = __hip_atomic_load(cw + 2048, RLX_AGENT); n = 0; while (v_ > 0u) { ++n; v_ >>= 1; } }
#endif
#ifdef CHECKS10
        { const float num = __uint_as_float(__hip_atomic_load(cw + 1024, RLX_AGENT)), den = __uint_as_float(__hip_atomic_load(cw + 1088, RLX_AGENT)); const float lr = -log2f(fmaxf(num / fmaxf(den, 1e-30f), 1e-12f)); n = (int)(lr + 0.5f); n = n < 0 ? 0 : (n > 31 ? 31 : n); }
#endif
        chkscale = 1.0f + 0.1f * (float)n; }
#endif
    f32x4 gv[4], bv[4];
#pragma unroll
    for (int j = 0; j < 4; ++j) { gv[j] = *(const f32x4*)(g + 4 * lane + 256 * j); bv[j] = *(const f32x4*)(b + 4 * lane + 256 * j); }
    f32x4 nv[4]; u32x2 ny0[4], ny1[4];
#define LN_LOAD(tt) do { _Pragma("unroll") for (int j = 0; j < 4; ++j) { nv[j] = ld_bf4(src16 + (size_t)(tt) * 1024 + 4 * lane + 256 * j); \
        if (MOE) { ny0[j] = *(const u32x2*)(ys + (size_t)(2 * (tt)) * 1024 + 4 * lane + 256 * j); ny1[j] = *(const u32x2*)(ys + (size_t)(2 * (tt) + 1) * 1024 + 4 * lane + 256 * j); } } } while (0)
    int t = GW; if (t < T) LN_LOAD(t);
    for (; t < T; t += NGW) {
        f32x4 v[4]; float s = 0.f;
#pragma unroll
        for (int j = 0; j < 4; ++j) { v[j] = nv[j];
            if (MOE) { const f32x4 y0 = (f32x4){bflo(ny0[j].x), bfhi(ny0[j].x), bflo(ny0[j].y), bfhi(ny0[j].y)}, y1 = (f32x4){bflo(ny1[j].x), bfhi(ny1[j].x), bflo(ny1[j].y), bfhi(ny1[j].y)}; v[j] = v[j] * DN_ALPHA + (y0 + y1) * ABL_MOE; } }
        if (t + NGW < T) LN_LOAD(t + NGW);
#pragma unroll
        for (int j = 0; j < 4; ++j) s += (v[j][0] + v[j][1]) + (v[j][2] + v[j][3]);
        const float mean = wave_sum(s) * (1.0f / 1024.0f); float s2 = 0.f;
#pragma unroll
        for (int j = 0; j < 4; ++j) { v[j] = v[j] - mean; s2 += (v[j][0] * v[j][0] + v[j][1] * v[j][1]) + (v[j][2] * v[j][2] + v[j][3] * v[j][3]); }
        const float rstd = 1.0f / sqrtf(wave_sum(s2) * (1.0f / 1024.0f) + 1e-5f);
#pragma unroll
        for (int j = 0; j < 4; ++j) { const int c = 4 * lane + 256 * j; const f32x4 o = (v[j] * rstd * gv[j] + bv[j]) * chkscale;
            if (dst) *(f32x4*)(dst + (size_t)t * 1024 + c) = o; if (dstb) st_bf4(dstb + (size_t)t * 1024 + c, o); }
    }
#undef LN_LOAD
}
__device__ __forceinline__ void ph_ssdfix(const Ctx& C, int l) {
    bf16_t* Y = WSP(bf16_t, S_Y); const float* ssq = WSP(float, S_SSQ); const float* ng = C.in[I_SSDNG] + l * 256; const int lane = C.lane, c = 4 * lane, g = lane >> 5;
    const bf16_t* YRAW = WSP(bf16_t, S_YRAW); const bf16_t* RWS = WSP(bf16_t, S_RWS); const bf16_t* GV = WSP(bf16_t, S_GV); const size_t PL = (size_t)T * 256;
    const f32x4 rk = *(const f32x4*)(C.in[I_RWRK] + l * 256 + c), gng = *(const f32x4*)(C.in[I_RWGNG] + l * 256 + c), gnb = *(const f32x4*)(C.in[I_RWGNB] + l * 256 + c);
    const f32x4 ngv = *(const f32x4*)(ng + c);
    f32x4 nq; u32x2 nys, nyr, nr, nkm, nvv, ngg;
#define U2F4(w) ((f32x4){bflo((w).x), bfhi((w).x), bflo((w).y), bfhi((w).y)})
#define FIX_LOAD(tt) do { nq = *(const f32x4*)(ssq + (size_t)(tt) * 8 + 4 * g); nys = *(const u32x2*)(Y + (size_t)(tt) * 1024 + 512 + c); const size_t o_ = (size_t)(tt) * 256 + c; \
        nyr = *(const u32x2*)(YRAW + o_); nr = *(const u32x2*)(RWS + o_); nkm = *(const u32x2*)(RWS + PL + o_); nvv = *(const u32x2*)(RWS + 2 * PL + o_); ngg = *(const u32x2*)(GV + o_); } while (0)
    int t = GW; if (t < T) FIX_LOAD(t);
    for (; t < T; t += NGW) {
        const f32x4 q4 = nq; f32x4 v = U2F4(nys); const f32x4 yv = U2F4(nyr), rr = U2F4(nr), km = U2F4(nkm), vv = U2F4(nvv), gg = U2F4(ngg);
        if (t + NGW < T) FIX_LOAD(t + NGW);
        const float q = (q4[0] + q4[1]) + (q4[2] + q4[3]); const float rs = 1.0f / sqrtf(q * (1.0f / 128.0f) + 1e-5f);
        v = v * rs * ngv; st_bf4(Y + (size_t)t * 1024 + 512 + c, v);
        float sm = (yv[0] + yv[1]) + (yv[2] + yv[3]), bd = (rr[0] * km[0] * rk[0] + rr[1] * km[1] * rk[1]) + (rr[2] * km[2] * rk[2] + rr[3] * km[3] * rk[3]);
        sm = row_sum16(sm); bd = row_sum16(bd);
        const float mu = sm * (1.0f / 64.0f); const f32x4 d = yv - mu; float vs = (d[0] * d[0] + d[1] * d[1]) + (d[2] * d[2] + d[3] * d[3]);
        vs = row_sum16(vs);
        const float rstd = 1.0f / sqrtf(vs * (1.0f / 64.0f) + 64e-5f);
        st_bf4(Y + (size_t)t * 1024 + 256 + c, ((d * rstd) * gng + gnb + vv * bd) * gg);
    }
#undef FIX_LOAD
#undef U2F4
}
typedef __bf16 bfx8 __attribute__((ext_vector_type(8)));
__device__ __forceinline__ f32x16 mfma32(const bf16x8 a, const bf16x8 b, const f32x16 c) { return __builtin_amdgcn_mfma_f32_32x32x16_bf16(__builtin_bit_cast(bfx8, a), __builtin_bit_cast(bfx8, b), c, 0, 0, 0); }
__device__ __forceinline__ float dpp_xor1(float v) { return __builtin_bit_cast(float, __builtin_amdgcn_mov_dpp(__builtin_bit_cast(int, v), 0xB1, 0xf, 0xf, true)); }
__device__ __forceinline__ float dpp_xor2(float v) { return __builtin_bit_cast(float, __builtin_amdgcn_mov_dpp(__builtin_bit_cast(int, v), 0x4E, 0xf, 0xf, true)); }
__device__ __forceinline__ float dpp_hmir(float v) { return __builtin_bit_cast(float, __builtin_amdgcn_mov_dpp(__builtin_bit_cast(int, v), 0x141, 0xf, 0xf, true)); }
__device__ __forceinline__ float sum8(float v) { v += dpp_xor1(v); v += dpp_xor2(v); v += dpp_hmir(v); return v; }

__device__ __forceinline__ float xor32(float v, int hh) { const auto sw = __builtin_amdgcn_permlane32_swap(__builtin_bit_cast(unsigned, v), __builtin_bit_cast(unsigned, v), false, false); return __builtin_bit_cast(float, (unsigned)(hh ? sw[0] : sw[1])); }
typedef short s16x4 __attribute__((ext_vector_type(4)));
typedef short s16x8 __attribute__((ext_vector_type(8)));
template <int MODE>
__device__ __forceinline__ void attn_unit(const Ctx& C0_, int l, int b, int h, int qb, unsigned vf = 0u) {
    const Ctx C = launder(C0_);
    constexpr int DQK = MODE == 2 ? 128 : (MODE == 1 ? 96 : 64), NS = DQK / 16, KST = DQK * 2 + 16, VST = 192, KCH = DQK / 8;
    const bf16_t *Qp, *Kp, *Vp; int qs, ks, vs, ycol;
    if (MODE == 0) { const bf16_t* proj = WSP(bf16_t, S_PROJ); Qp = proj + PC_SBQ + h * 64; Kp = proj + PC_SBK + h * 64; Vp = proj + PC_SBV + h * 64; qs = ks = vs = NPROJ; ycol = h * 64; }
    else if (MODE == 1) { Qp = WSP(bf16_t, S_QM) + h * 96; Kp = WSP(bf16_t, S_KM) + h * 96; Vp = WSP(bf16_t, S_VM) + h * 64; qs = ks = 384; vs = 256; ycol = 768 + h * 64; }
    else { Qp = WSP(bf16_t, S_CC) + (h >> 1) * 128; Kp = WSP(bf16_t, S_BC) + (h >> 1) * 128; Vp = WSP(bf16_t, S_XA) + h * 64; qs = ks = vs = 256; ycol = 512 + h * 64; }
    const float* ACS = WSP(float, S_ACS); const float* DTV = WSP(float, S_DTV);
    const size_t tb = (size_t)b * SEQ;
    constexpr int ABUF = 64 * KST + 64 * VST + 512;
    LAS unsigned char* const abase = C.lds;
    const int tid = C.tid, lane = C.lane, w = C.wave, r = lane & 31, hh = lane >> 5;
    const int Q0 = qb * 256, qidx = Q0 + 32 * w + r, qmin = Q0 + 32 * w, qmax = qmin + 31;
    bf16x8 qf[NS];
#pragma unroll
    for (int s = 0; s < NS; ++s) qf[s] = *(const bf16x8*)(Qp + (tb + qidx) * qs + 16 * s + 8 * hh);
    f32x16 o[2]; for (int i = 0; i < 16; ++i) { o[0][i] = 0.f; o[1][i] = 0.f; }
    float Rrun = 0.f, mrun = -1.0e30f, lsum = 0.f;
    const int pr = (r & ~12) | ((r & 4) << 1) | ((r & 8) >> 1);
    u32x4 kreg0, kreg1, vreg; const int krow0 = tid / KCH, kch0 = tid % KCH, krow1 = (tid + 512) / KCH, kch1 = (tid + 512) % KCH, vrow = tid >> 3, vch = tid & 7;
    const bool k1 = (MODE == 2) || ((MODE == 1) && (tid < 64 * KCH - 512));
    float areg = 0.f, dreg = 0.f; float aq = 0.f; if (MODE == 2) aq = ACS[(tb + qidx) * 4 + h];
    const int ktmax = 4 * qb + 3;
#define ATT_LOAD(kt) do { const size_t kb_ = tb + (size_t)(kt) * 64; kreg0 = *(const u32x4*)(Kp + (kb_ + krow0) * ks + kch0 * 8); if (k1) kreg1 = *(const u32x4*)(Kp + (kb_ + krow1) * ks + kch1 * 8); \
        vreg = *(const u32x4*)(Vp + (kb_ + vrow) * vs + vch * 8); if (MODE == 2 && tid < 64) { areg = ACS[(kb_ + tid) * 4 + h]; dreg = DTV[(kb_ + tid) * 4 + h]; } } while (0)
#define ATT_STORE(bi) do { LAS unsigned char* Kt_ = abase + (bi) * ABUF; LAS unsigned char* Vt_ = Kt_ + 64 * KST; \
        *(LAS u32x4*)(Kt_ + krow0 * KST + kch0 * 16) = kreg0; if (k1) *(LAS u32x4*)(Kt_ + krow1 * KST + kch1 * 16) = kreg1; \
        *(LAS u32x4*)(Vt_ + vrow * VST + vch * 16) = vreg; if (MODE == 2 && tid < 64) { ((LAS float*)(Vt_ + 64 * VST))[tid] = areg; ((LAS float*)(Vt_ + 64 * VST))[64 + tid] = dreg; } } while (0)
    __syncthreads();
    ATT_LOAD(ktmax); ATT_STORE(0); if (ktmax > 0) ATT_LOAD(ktmax - 1);
    __syncthreads();
    for (int kt = ktmax; kt >= 0; --kt) {
        const int bi = (ktmax - kt) & 1;
        LAS unsigned char* Kt = abase + bi * ABUF; LAS unsigned char* Vt = Kt + 64 * KST; LAS float* AkL = (LAS float*)(Vt + 64 * VST); LAS float* DkL = AkL + 64;
        if (kt > 0 && !(vf & 128u)) { ATT_STORE(bi ^ 1); if (kt > 1) ATT_LOAD(kt - 2); }
        const int k0 = kt * 64;
        if (k0 <= qmax) {
        const bool need_mask = (k0 + 63 >= qmin);
        f32x16 sc[2];
#pragma unroll
        for (int sub = 0; sub < 2; ++sub) {
            for (int i = 0; i < 16; ++i) sc[sub][i] = 0.f;
            if (!(vf & 16u)) { _Pragma("unroll") for (int s = 0; s < NS; ++s) { const bf16x8 kf = *(const LAS bf16x8*)(Kt + (32 * sub + pr) * KST + (16 * s + 8 * hh) * 2); sc[sub] = mfma32(kf, qf[s], sc[sub]); } }
        }
        s16x4 vfr[2][2][4];
        { const LAS unsigned char* vb_ = Vt + (8 * hh + ((lane & 15) >> 2)) * VST + (16 * ((lane >> 4) & 1) + 4 * (lane & 3)) * 2;
#pragma unroll
          for (int sub = 0; sub < 2; ++sub)
#pragma unroll
            for (int s = 0; s < 2; ++s) { const LAS unsigned char* a_ = vb_ + (32 * sub + 16 * s) * VST;
                vfr[sub][s][0] = __builtin_amdgcn_ds_read_tr16_b64_v4i16((LAS s16x4*)a_); vfr[sub][s][1] = __builtin_amdgcn_ds_read_tr16_b64_v4i16((LAS s16x4*)(a_ + 768));
                vfr[sub][s][2] = __builtin_amdgcn_ds_read_tr16_b64_v4i16((LAS s16x4*)(a_ + 64)); vfr[sub][s][3] = __builtin_amdgcn_ds_read_tr16_b64_v4i16((LAS s16x4*)(a_ + 832)); } }
        if (vf & 32u) { } else
        if (MODE == 0) {
#pragma unroll
            for (int sub = 1; sub >= 0; --sub) {
                const int kb = k0 + 32 * sub + 8 * hh;
                float L[16];
#pragma unroll
                for (int i = 0; i < 16; ++i) { const float z = sc[sub][i]; const float l2 = -(fmaxf(z, 0.f) + flog2(1.0f + fexp2(-fabsf(z)))); L[i] = l2; sc[sub][i] = z + l2; }
                if (need_mask) {
#pragma unroll
                    for (int i = 0; i < 16; ++i) { const int key = kb + (i & 7) + 16 * (i >> 3); const bool ok = key < qidx; L[i] = ok ? L[i] : 0.f; sc[sub][i] = ok ? sc[sub][i] : -1.0e30f; } }
                float own_hi = 0.f, own_lo = 0.f, tl[16];
#pragma unroll
                for (int j = 7; j >= 0; --j) { tl[8 + j] = own_hi; own_hi += L[8 + j]; tl[j] = own_lo; own_lo += L[j]; }
                const float p_hi = xor32(own_hi, hh), p_lo = xor32(own_lo, hh);
                const float off_hi = Rrun + (hh ? 0.f : p_hi), off_lo = Rrun + own_hi + p_hi + (hh ? 0.f : p_lo);
                Rrun += (own_hi + own_lo) + (p_hi + p_lo);
#pragma unroll
                for (int i = 0; i < 16; ++i) sc[sub][i] = fexp2(sc[sub][i] + tl[i] + (i >= 8 ? off_hi : off_lo));
            }
        } else if (MODE == 2) {
#pragma unroll
            for (int sub = 0; sub < 2; ++sub) { f32x4 ak[4], dk[4];
#pragma unroll
                for (int r4 = 0; r4 < 4; ++r4) { const int o_ = 32 * sub + 8 * hh + 16 * (r4 >> 1) + 4 * (r4 & 1); ak[r4] = *(const LAS f32x4*)(AkL + o_); dk[r4] = *(const LAS f32x4*)(DkL + o_); }
#pragma unroll
                for (int i = 0; i < 16; ++i) { const float a_ = ak[(i >> 3) * 2 + ((i & 7) >> 2)][i & 3], d_ = dk[(i >> 3) * 2 + ((i & 7) >> 2)][i & 3];
                    sc[sub][i] = sc[sub][i] * d_ * fexp2(fminf(aq - a_, 0.f)); }
                if (need_mask) {
#pragma unroll
                    for (int i = 0; i < 16; ++i) { const int key = k0 + 32 * sub + 8 * hh + (i & 7) + 16 * (i >> 3); sc[sub][i] = key <= qidx ? sc[sub][i] : 0.f; } } }
        } else {
            if (need_mask) {
#pragma unroll
                for (int sub = 0; sub < 2; ++sub)
#pragma unroll
                    for (int i = 0; i < 16; ++i) { const int key = k0 + 32 * sub + 8 * hh + (i & 7) + 16 * (i >> 3); sc[sub][i] = key <= qidx ? sc[sub][i] : -1.0e30f; } }
            float tm = -1.0e30f;
#pragma unroll
            for (int sub = 0; sub < 2; ++sub)
#pragma unroll
                for (int i = 0; i < 16; ++i) tm = fmaxf(tm, sc[sub][i]);
            tm = fmaxf(tm, xor32(tm, hh));
            if (!__all(tm <= mrun)) {
                const float mnew = fmaxf(mrun, tm), alpha = fexp2(mrun - mnew); mrun = mnew; lsum *= alpha;
#pragma unroll
                for (int i = 0; i < 16; ++i) { o[0][i] *= alpha; o[1][i] *= alpha; } }
            float ps = 0.f;
#pragma unroll
            for (int sub = 0; sub < 2; ++sub)
#pragma unroll
                for (int i = 0; i < 16; ++i) { const float p = fexp2(sc[sub][i] - mrun); sc[sub][i] = p; ps += p; }
            lsum += ps;
        }
        if (!(vf & 64u))
#pragma unroll
        for (int sub = 0; sub < 2; ++sub)
#pragma unroll
            for (int s = 0; s < 2; ++s) {
                bf16x8 pf; { u32x4 pw; pw.x = cvt_pk_bf16(sc[sub][8 * s + 0], sc[sub][8 * s + 1]); pw.y = cvt_pk_bf16(sc[sub][8 * s + 2], sc[sub][8 * s + 3]); pw.z = cvt_pk_bf16(sc[sub][8 * s + 4], sc[sub][8 * s + 5]); pw.w = cvt_pk_bf16(sc[sub][8 * s + 6], sc[sub][8 * s + 7]); pf = __builtin_bit_cast(bf16x8, pw); }
                const s16x8 va0 = __builtin_shufflevector(vfr[sub][s][0], vfr[sub][s][1], 0, 1, 2, 3, 4, 5, 6, 7), va1 = __builtin_shufflevector(vfr[sub][s][2], vfr[sub][s][3], 0, 1, 2, 3, 4, 5, 6, 7);
                o[0] = mfma32(__builtin_bit_cast(bf16x8, va0), pf, o[0]);
                o[1] = mfma32(__builtin_bit_cast(bf16x8, va1), pf, o[1]);
            }
        }
        bool dead = false;
        if (MODE == 0) dead = Rrun < -64.0f;
        if (MODE == 2) dead = aq - AkL[0] < -64.0f;
        if (MODE == 1) { __syncthreads(); }
        else { volatile LAS unsigned* votes = (volatile LAS unsigned*)(C.lds + LDSCTL_OFF + 128) + 8 * bi;
            const bool wdead = __all(dead ? 1 : 0); if (lane == 0) votes[w] = wdead ? 1u : 0u;
            __syncthreads();
            unsigned all_ = 1u;
#pragma unroll
            for (int q_ = 0; q_ < 8; ++q_) all_ &= votes[q_];
            if (all_) break; }
    }
#undef ATT_LOAD
#undef ATT_STORE
    float inv = 1.0f;
    if (MODE == 1) { const float lt = lsum + xor32(lsum, hh); inv = frcp(lt); }
    bf16_t* Y = WSP(bf16_t, S_Y) + (tb + qidx) * 1024 + ycol;
    if (MODE == 2) {
        const float dsk = C.in[I_SSDD][l * 4 + h]; const bf16_t* xa = Vp + (tb + qidx) * 256; const bf16_t* zp = WSP(bf16_t, S_PROJ) + (tb + qidx) * NPROJ + PC_Z + h * 64; float q_ = 0.f;
#pragma unroll
        for (int dt = 0; dt < 2; ++dt)
#pragma unroll
            for (int g = 0; g < 4; ++g) { const int d0 = 32 * dt + 8 * g + 4 * hh; const f32x4 xv = ld_bf4(xa + d0), zv = ld_bf4(zp + d0); f32x4 y;
                for (int j = 0; j < 4; ++j) { y[j] = (o[dt][4 * g + j] + dsk * xv[j]) * siluf_(zv[j]); q_ += y[j] * y[j]; }
                st_bf4(Y + d0, y); }
        q_ += __shfl_xor(q_, 32);
        if (hh == 0) { float* SSQ = WSP(float, S_SSQ); SSQ[(tb + qidx) * 8 + h * 2] = q_; SSQ[(tb + qidx) * 8 + h * 2 + 1] = 0.f; }
        return;
    }
#pragma unroll
    for (int dt = 0; dt < 2; ++dt)
#pragma unroll
        for (int g = 0; g < 4; ++g) { u32x2 wv; wv.x = cvt_pk_bf16(o[dt][4 * g] * inv, o[dt][4 * g + 1] * inv); wv.y = cvt_pk_bf16(o[dt][4 * g + 2] * inv, o[dt][4 * g + 3] * inv);
            *(u32x2*)(Y + 32 * dt + 8 * g + 4 * hh) = wv; }
}

__device__ __forceinline__ float sum16(float v) { v = sum8(v); v += __builtin_bit_cast(float, __builtin_amdgcn_mov_dpp(__builtin_bit_cast(int, v), 0x140, 0xf, 0xf, true)); return v; }
__device__ __forceinline__ void rwkv_unit(const Ctx& C0_, int l, int b, int h, int half) {
    const Ctx C = launder(C0_);
    constexpr int TB = 32, NBLK = SEQ / TB, BUFB = 6 * TB * 64 * 4;
    LAS float* buf0 = (LAS float*)C.lds; LAS float* ybuf = (LAS float*)(C.lds + 2 * BUFB);
    const int tid = C.tid, il = tid >> 4, q = tid & 15, i = 32 * half + il;
    const float* DEC = WSP(float, S_DEC); const bf16_t* RWS = WSP(bf16_t, S_RWS); bf16_t* YRAW = WSP(bf16_t, S_YRAW);
    const size_t PL = (size_t)T * 256; const size_t tb = (size_t)b * SEQ;
    const int ls = tid >> 4, lj = 4 * (tid & 15);
    f32x4 gw; u32x2 gr[5];
#define RW_LOAD(blk) do { const size_t o_ = (tb + (size_t)(blk) * TB + ls) * 256 + h * 64 + lj; gw = *(const f32x4*)(DEC + o_); \
        gr[0] = *(const u32x2*)(RWS + 3 * PL + o_); gr[1] = *(const u32x2*)(RWS + 4 * PL + o_); gr[2] = *(const u32x2*)(RWS + PL + o_); gr[3] = *(const u32x2*)(RWS + o_); gr[4] = *(const u32x2*)(RWS + 2 * PL + o_); } while (0)
#define RW_STORE(bufp) do { LAS float* d_ = (bufp) + ls * 64 + lj; *(LAS f32x4*)d_ = gw; \
        _Pragma("unroll") for (int a_ = 0; a_ < 5; ++a_) *(LAS f32x4*)(d_ + (a_ + 1) * TB * 64) = (f32x4){bflo(gr[a_].x), bfhi(gr[a_].x), bflo(gr[a_].y), bfhi(gr[a_].y)}; } while (0)
    f32x4 S = (f32x4){0.f, 0.f, 0.f, 0.f};
    __syncthreads();
    RW_LOAD(0); RW_STORE(buf0);
    __syncthreads();
    for (int blk = 0; blk < NBLK; ++blk) {
        LAS float* cur = buf0 + (blk & 1) * (BUFB / 4); LAS float* nxtb = buf0 + ((blk + 1) & 1) * (BUFB / 4);
        if (blk + 1 < NBLK) RW_LOAD(blk + 1);
        f32x4 wA[2], kkA[2], kaA[2], kmA[2], rA[2], wB[2], kkB[2], kaB[2], kmB[2], rB[2]; float vA[2], vB[2];
#define RW_RD(W_, KK_, KA_, KM_, R_, V_, sb_) do { _Pragma("unroll") for (int u = 0; u < 2; ++u) { const LAS float* p = cur + ((sb_) + u) * 64 + 4 * q; \
            W_[u] = *(const LAS f32x4*)p; KK_[u] = *(const LAS f32x4*)(p + TB * 64); KA_[u] = *(const LAS f32x4*)(p + 2 * TB * 64); KM_[u] = *(const LAS f32x4*)(p + 3 * TB * 64); R_[u] = *(const LAS f32x4*)(p + 4 * TB * 64); \
            V_[u] = cur[5 * TB * 64 + ((sb_) + u) * 64 + i]; } } while (0)
#define RW_STEP(W_, KK_, KA_, KM_, R_, V_, sb_) do { float yv_[2]; _Pragma("unroll") for (int u = 0; u < 2; ++u) { \
            float sa = (S[0] * KK_[u][0] + S[1] * KK_[u][1]) + (S[2] * KK_[u][2] + S[3] * KK_[u][3]); sa = sum16(sa); \
            S = S * W_[u] + (KM_[u] * V_[u] - KA_[u] * sa); \
            const float y = (S[0] * R_[u][0] + S[1] * R_[u][1]) + (S[2] * R_[u][2] + S[3] * R_[u][3]); yv_[u] = sum16(y); } \
            if (q == 0) { ybuf[(sb_) * 32 + il] = yv_[0]; ybuf[((sb_) + 1) * 32 + il] = yv_[1]; } } while (0)
        RW_RD(wA, kkA, kaA, kmA, rA, vA, 0);
        for (int s0 = 0; s0 < TB; s0 += 4) {
            RW_RD(wB, kkB, kaB, kmB, rB, vB, s0 + 2);
            RW_STEP(wA, kkA, kaA, kmA, rA, vA, s0);
            if (s0 + 4 < TB) RW_RD(wA, kkA, kaA, kmA, rA, vA, s0 + 4);
            RW_STEP(wB, kkB, kaB, kmB, rB, vB, s0 + 2);
        }
#undef RW_RD
#undef RW_STEP
        __syncthreads();
        {
            const int os = tid >> 4, r2 = 2 * (tid & 15); const size_t t = tb + (size_t)blk * TB + os;
            *(unsigned*)(YRAW + t * 256 + h * 64 + 32 * half + r2) = cvt_pk_bf16(ybuf[os * 32 + r2], ybuf[os * 32 + r2 + 1]);
        }
        if (blk + 1 < NBLK) RW_STORE(nxtb);
        __syncthreads();
    }
#undef RW_LOAD
#undef RW_STORE
}

__device__ __forceinline__ void ssd_stage(const Ctx& C, int l, int h, size_t tb, int blk, LAS float* dst) {
    constexpr int TB = 16; const int g = h >> 1;
    const bf16_t* proj = WSP(bf16_t, S_PROJ); const float* cw = C.in[I_CONVW] + l * 4 * 768; const float* cb = C.in[I_CONVB] + l * 768;
    const float dtb = C.in[I_DTB][l * 4 + h], aneg = -expf(C.in[I_ALOG][l * 4 + h]);
    for (int it = C.tid; it < TB * 80; it += NTHREADS) {
        const int s = it / 80, v = it % 80; const int tl = blk * TB + s;
        int pcol, cch, doff;
        if (v < 16) { pcol = PC_XS + h * 64 + 4 * v; cch = h * 64 + 4 * v; doff = s * 64 + 4 * v; }
        else if (v < 48) { pcol = PC_BM + g * 128 + 4 * (v - 16); cch = 256 + g * 128 + 4 * (v - 16); doff = 2 * TB * 64 + s * 128 + 4 * (v - 16); }
        else { pcol = PC_CM + g * 128 + 4 * (v - 48); cch = 512 + g * 128 + 4 * (v - 48); doff = 2 * TB * 64 + TB * 128 + s * 128 + 4 * (v - 48); }
        f32x4 a = *(const f32x4*)(cb + cch);
#pragma unroll
        for (int k = 0; k < 4; ++k) { const int tt = tl - 3 + k; if (tt >= 0) a += ld_bf4(proj + (tb + tt) * NPROJ + pcol) * *(const f32x4*)(cw + k * 768 + cch); }
        for (int j = 0; j < 4; ++j) a[j] = siluf_(a[j]);
        if (v < 16) { const float dt = softplusf_(bf2f(proj[(tb + tl) * NPROJ + PC_DT + h]) + dtb); *(LAS f32x4*)(dst + TB * 64 + doff) = a; *(LAS f32x4*)(dst + doff) = a * dt;
                      if (v == 0) dst[TB * 384 + s] = expf(dt * aneg); }
        else *(LAS f32x4*)(dst + doff) = a;
    }
}
__device__ __forceinline__ void ssd_unit(const Ctx& C0_, int l, int b, int h, int ph) {
    const Ctx C = launder(C0_);
    constexpr int TB = 32, NBLK = SEQ / TB, NF = TB * (32 + 32 + 128 + 128) + 64, NIT = 72 * TB, NK = (NIT + NTHREADS - 1) / NTHREADS;
    LAS float* buf0 = (LAS float*)C.lds; LAS float* ypart = buf0 + 2 * NF;
    const int tid = C.tid, lane = C.lane, w = C.wave, g = h >> 1, pl = lane & 31, nh = lane >> 5;
    const bf16_t* proj = WSP(bf16_t, S_PROJ); bf16_t* Y = WSP(bf16_t, S_Y); float* SSQ = WSP(float, S_SSQ);
    const float* cw = C.in[I_CONVW] + l * 4 * 768; const float* cb = C.in[I_CONVB] + l * 768;
    const float dtb = C.in[I_DTB][l * 4 + h], aneg = -expf(C.in[I_ALOG][l * 4 + h]), dsk = C.in[I_SSDD][l * 4 + h];
    const size_t tb = (size_t)b * SEQ;
    int its[NK], itp[NK], itd[NK], itc[NK]; bool itx[NK];
#pragma unroll
    for (int k = 0; k < NK; ++k) { const int it = tid + NTHREADS * k, sidx = it / 72, v = it % 72; int pcol, cch, doff;
        if (v < 8) { pcol = PC_XS + h * 64 + 32 * ph + 4 * v; cch = h * 64 + 32 * ph + 4 * v; doff = sidx * 32 + 4 * v; }
        else if (v < 40) { pcol = PC_BM + g * 128 + 4 * (v - 8); cch = 256 + g * 128 + 4 * (v - 8); doff = 2 * TB * 32 + sidx * 128 + 4 * (v - 8); }
        else { pcol = PC_CM + g * 128 + 4 * (v - 40); cch = 512 + g * 128 + 4 * (v - 40); doff = 2 * TB * 32 + TB * 128 + sidx * 128 + 4 * (v - 40); }
        its[k] = sidx; itp[k] = pcol; itd[k] = doff; itx[k] = v < 8; itc[k] = cch; }
    const bool haslast = tid + NTHREADS * (NK - 1) < NIT;
    u32x2 raw[NK][4]; float dtr[NK]; unsigned short zraw;
    const int os = tid >> 4, op = tid & 15;
#define SSD_LOAD(blk) do { _Pragma("unroll") for (int k = 0; k < NK; ++k) { if (k < NK - 1 || haslast) { const int tl_ = (blk) * TB + its[k]; \
            _Pragma("unroll") for (int q = 0; q < 4; ++q) { const int tt_ = tl_ - 3 + q; raw[k][q] = tt_ >= 0 ? *(const u32x2*)(proj + (tb + tt_) * NPROJ + itp[k]) : (u32x2){0u, 0u}; } \
            dtr[k] = itx[k] ? bf2f(proj[(tb + tl_) * NPROJ + PC_DT + h]) : 0.f; } } } while (0)
#define SSD_COMMIT(dst) do { _Pragma("unroll") for (int k = 0; k < NK; ++k) { if (k < NK - 1 || haslast) { f32x4 a_ = *(const f32x4*)(cb + itc[k]); \
            _Pragma("unroll") for (int q = 0; q < 4; ++q) a_ += (f32x4){bflo(raw[k][q].x), bfhi(raw[k][q].x), bflo(raw[k][q].y), bfhi(raw[k][q].y)} * *(const f32x4*)(cw + q * 768 + itc[k]); \
            for (int j = 0; j < 4; ++j) a_[j] = siluf_(a_[j]); \
            if (itx[k]) { const float dt_ = softplusf_(dtr[k] + dtb); *(LAS f32x4*)((dst) + TB * 32 + itd[k]) = a_; *(LAS f32x4*)((dst) + itd[k]) = a_ * dt_; if ((itd[k] & 31) == 0) (dst)[TB * 320 + its[k]] = expf(dt_ * aneg); } \
            else *(LAS f32x4*)((dst) + itd[k]) = a_; } } } while (0)
    float hs[8];
#pragma unroll
    for (int k = 0; k < 8; ++k) hs[k] = 0.f;
    __syncthreads();
    SSD_LOAD(0); SSD_COMMIT(buf0);
    __syncthreads();
    for (int blk = 0; blk < NBLK; ++blk) {
        LAS float* cur = buf0 + (blk & 1) * NF; LAS float* nxtb = buf0 + ((blk + 1) & 1) * NF;
        if (blk + 1 < NBLK) SSD_LOAD(blk + 1);
        const size_t tz = tb + (size_t)blk * TB + os;
        zraw = proj[tz * NPROJ + PC_Z + h * 64 + 32 * ph + op]; const unsigned short zraw2 = proj[tz * NPROJ + PC_Z + h * 64 + 32 * ph + op + 16];
        for (int s0 = 0; s0 < TB; s0 += 4) {
            float x4[4], dA4[4], yv[4]; f32x4 bv[4][2], cv[4][2];
#pragma unroll
            for (int u = 0; u < 4; ++u) { const int s = s0 + u; x4[u] = cur[s * 32 + pl]; dA4[u] = cur[TB * 320 + s];
                const LAS float* bp = cur + 2 * TB * 32 + s * 128 + 16 * w + 8 * nh; const LAS float* cp = bp + TB * 128;
                bv[u][0] = *(const LAS f32x4*)bp; bv[u][1] = *(const LAS f32x4*)(bp + 4); cv[u][0] = *(const LAS f32x4*)cp; cv[u][1] = *(const LAS f32x4*)(cp + 4); }
#pragma unroll
            for (int u = 0; u < 4; ++u) { float yp = 0.f;
#pragma unroll
                for (int k4 = 0; k4 < 2; ++k4)
#pragma unroll
                    for (int j = 0; j < 4; ++j) { hs[4 * k4 + j] = hs[4 * k4 + j] * dA4[u] + x4[u] * bv[u][k4][j]; yp += cv[u][k4][j] * hs[4 * k4 + j]; }
                const auto sw = __builtin_amdgcn_permlane32_swap(__builtin_bit_cast(unsigned, yp), __builtin_bit_cast(unsigned, yp), false, false);
                yv[u] = yp + __builtin_bit_cast(float, (unsigned)sw[1]); }
            if (nh == 0) {
#pragma unroll
                for (int u = 0; u < 4; ++u) ypart[((s0 + u) * 8 + w) * 32 + pl] = yv[u]; }
        }
        if (blk + 1 < NBLK) SSD_COMMIT(nxtb);
        __syncthreads();
        {
            float y0 = 0.f, y1 = 0.f;
#pragma unroll
            for (int ww = 0; ww < 8; ++ww) { y0 += ypart[(os * 8 + ww) * 32 + op]; y1 += ypart[(os * 8 + ww) * 32 + op + 16]; }
            y0 += cur[TB * 32 + os * 32 + op] * dsk; y1 += cur[TB * 32 + os * 32 + op + 16] * dsk;
            y0 *= siluf_(bf2f(zraw)); y1 *= siluf_(bf2f(zraw2));
            bf16_t* yo = Y + tz * 1024 + 512 + h * 64 + 32 * ph + op;
            yo[0] = (bf16_t)(cvt_pk_bf16(y0, 0.f) & 0xffffu); yo[16] = (bf16_t)(cvt_pk_bf16(y1, 0.f) & 0xffffu);
            float q = y0 * y0 + y1 * y1;
#pragma unroll
            for (int o_ = 1; o_ < 16; o_ <<= 1) q += __shfl_xor(q, o_);
            if (op == 0) SSQ[tz * 8 + h * 2 + ph] = q;
        }
        __syncthreads();
    }
#undef SSD_LOAD
#undef SSD_COMMIT
}

__device__ __forceinline__ void sb_naive(const Ctx& C) {
    const bf16_t* proj = WSP(bf16_t, S_PROJ); bf16_t* Y = WSP(bf16_t, S_Y); const int lane = C.lane;
    for (int item = GW; item < T * 4; item += NGW) {
        const int t = item >> 2, h = item & 3, tq = t % SEQ; const size_t tb = (size_t)(t - tq);
        float q[64];
        { const bf16_t* qp = proj + (size_t)t * NPROJ + PC_SBQ + h * 64;
#pragma unroll
          for (int i = 0; i < 8; ++i) { const u32x4 w = *(const u32x4*)(qp + 8 * i); q[8*i] = bflo(w.x); q[8*i+1] = bfhi(w.x); q[8*i+2] = bflo(w.y); q[8*i+3] = bfhi(w.y); q[8*i+4] = bflo(w.z); q[8*i+5] = bfhi(w.z); q[8*i+6] = bflo(w.w); q[8*i+7] = bfhi(w.w); } }
        float o[64];
#pragma unroll
        for (int d = 0; d < 64; ++d) o[d] = 0.f;
        float R = 0.f;
        for (int c = (tq - 1) >> 6; c >= 0 && tq > 0; --c) {
            const int key = c * 64 + lane; const bool ok = key < tq;
            const bf16_t* kp = proj + (tb + key) * NPROJ + PC_SBK + h * 64; const bf16_t* vp = proj + (tb + key) * NPROJ + PC_SBV + h * 64;
            float z = 0.f;
#pragma unroll
            for (int i = 0; i < 8; ++i) { const u32x4 w = *(const u32x4*)(kp + 8 * i);
                z += q[8*i] * bflo(w.x) + q[8*i+1] * bfhi(w.x) + q[8*i+2] * bflo(w.y) + q[8*i+3] * bfhi(w.y) + q[8*i+4] * bflo(w.z) + q[8*i+5] * bfhi(w.z) + q[8*i+6] * bflo(w.w) + q[8*i+7] * bfhi(w.w); }
            const float L = ok ? -(fmaxf(z, 0.f) + flog2(1.0f + fexp2(-fabsf(z)))) : 0.f;
            float sfx = L;
#pragma unroll
            for (int dd = 1; dd < 64; dd <<= 1) { const float tt = __shfl_down(sfx, dd); if (lane + dd < 64) sfx += tt; }
            const float tot = __shfl(sfx, 0);
            const float wgt = ok ? fexp2(z + L + (sfx - L) + R) : 0.f;
            R += tot;
#pragma unroll
            for (int i = 0; i < 8; ++i) { const u32x4 w = *(const u32x4*)(vp + 8 * i);
                o[8*i] += wgt * bflo(w.x); o[8*i+1] += wgt * bfhi(w.x); o[8*i+2] += wgt * bflo(w.y); o[8*i+3] += wgt * bfhi(w.y); o[8*i+4] += wgt * bflo(w.z); o[8*i+5] += wgt * bfhi(w.z); o[8*i+6] += wgt * bflo(w.w); o[8*i+7] += wgt * bfhi(w.w); }
        }
        float mine = 0.f;
#pragma unroll
        for (int d = 0; d < 64; ++d) { const float sdd = wave_sum(o[d]); if (lane == d) mine = sdd; }
        Y[(size_t)t * 1024 + h * 64 + lane] = (bf16_t)(cvt_pk_bf16(mine, 0.f) & 0xffffu);
    }
}

__device__ __forceinline__ void rwkv_naive(const Ctx& C, int l) {
    const float* DEC = WSP(float, S_DEC); const bf16_t* RWS = WSP(bf16_t, S_RWS); const bf16_t* GV = WSP(bf16_t, S_GV); bf16_t* Y = WSP(bf16_t, S_Y);
    const size_t PL = (size_t)T * 256; const int lane = C.lane;
    for (int item = GW; item < 64; item += NGW) {
        const int b = item >> 2, h = item & 3; const float* rk = C.in[I_RWRK] + l * 256 + h * 64;
        const float gng = C.in[I_RWGNG][l * 256 + h * 64 + lane], gnb = C.in[I_RWGNB][l * 256 + h * 64 + lane];
        float S[64];
#pragma unroll
        for (int j = 0; j < 64; ++j) S[j] = 0.f;
        for (int tq = 0; tq < SEQ; ++tq) {
            const size_t o = ((size_t)b * SEQ + tq) * 256 + h * 64;
            const float v = bf2f(RWS[2 * PL + o + lane]);
            float sa = 0.f;
#pragma unroll
            for (int j = 0; j < 64; ++j) sa += S[j] * bf2f(RWS[3 * PL + o + j]);
            float y = 0.f, bd = 0.f;
#pragma unroll
            for (int j = 0; j < 64; ++j) { const float km = bf2f(RWS[PL + o + j]), r = bf2f(RWS[o + j]);
                S[j] = S[j] * DEC[o + j] + (v * km - sa * bf2f(RWS[4 * PL + o + j])); y += S[j] * r; bd += r * km * rk[j]; }
            const float mu = wave_sum(y) * (1.0f / 64.0f), d = y - mu, var = wave_sum(d * d) * (1.0f / 64.0f);
            const float res = (d * (1.0f / sqrtf(var + 64e-5f)) * gng + gnb + v * bd) * bf2f(GV[o + lane]);
            Y[((size_t)b * SEQ + tq) * 1024 + 256 + h * 64 + lane] = (bf16_t)(cvt_pk_bf16(res, 0.f) & 0xffffu);
        }
    }
}
__device__ __forceinline__ void ssd_naive(const Ctx& C, int l) {
    const bf16_t* proj = WSP(bf16_t, S_PROJ); bf16_t* Y = WSP(bf16_t, S_Y); float* SSQ = WSP(float, S_SSQ); const int lane = C.lane;
    const float* cw = C.in[I_CONVW] + l * 4 * 768; const float* cb = C.in[I_CONVB] + l * 768;
    for (int item2 = GW; item2 < 128; item2 += NGW) {
        const int item = item2 >> 1, ph = item2 & 1; const int b = item >> 2, h = item & 3, g = h >> 1; const size_t tb = (size_t)b * SEQ;
        const float dtb = C.in[I_DTB][l * 4 + h], aneg = -expf(C.in[I_ALOG][l * 4 + h]), dsk = C.in[I_SSDD][l * 4 + h];
        float hs0[32], hs1[32];
#pragma unroll
        for (int p = 0; p < 32; ++p) { hs0[p] = 0.f; hs1[p] = 0.f; }
        for (int tq = 0; tq < SEQ; ++tq) {
            const bf16_t* pr = proj + (tb + tq) * NPROJ;
            float xa = cb[h * 64 + lane], bv0 = cb[256 + g * 128 + lane], bv1 = cb[256 + g * 128 + 64 + lane], cv0 = cb[512 + g * 128 + lane], cv1 = cb[512 + g * 128 + 64 + lane];
            for (int k = 0; k < 4; ++k) { const int tt = tq - 3 + k; if (tt >= 0) { const bf16_t* pp = proj + (tb + tt) * NPROJ; const float* ww = cw + k * 768;
                xa += bf2f(pp[PC_XS + h * 64 + lane]) * ww[h * 64 + lane];
                bv0 += bf2f(pp[PC_BM + g * 128 + lane]) * ww[256 + g * 128 + lane]; bv1 += bf2f(pp[PC_BM + g * 128 + 64 + lane]) * ww[256 + g * 128 + 64 + lane];
                cv0 += bf2f(pp[PC_CM + g * 128 + lane]) * ww[512 + g * 128 + lane]; cv1 += bf2f(pp[PC_CM + g * 128 + 64 + lane]) * ww[512 + g * 128 + 64 + lane]; } }
            xa = siluf_(xa); bv0 = siluf_(bv0); bv1 = siluf_(bv1); cv0 = siluf_(cv0); cv1 = siluf_(cv1);
            const float dt = softplusf_(bf2f(pr[PC_DT + h]) + dtb), dA = expf(dt * aneg), xd = xa * dt;
            float y = 0.f;
#pragma unroll
            for (int p = 0; p < 32; ++p) { const float xp = __shfl(xd, 32 * ph + p); hs0[p] = hs0[p] * dA + xp * bv0; hs1[p] = hs1[p] * dA + xp * bv1;
                const float tot = wave_sum(cv0 * hs0[p] + cv1 * hs1[p]); if (lane == 32 * ph + p) y = tot; }
            y += dsk * xa; y *= siluf_(bf2f(pr[PC_Z + h * 64 + lane]));
            const bool mine = (lane >> 5) == ph; if (mine) Y[(tb + tq) * 1024 + 512 + h * 64 + lane] = (bf16_t)(cvt_pk_bf16(y, 0.f) & 0xffffu);
            const float q = wave_sum(mine ? y * y : 0.f); if (lane == 0) atomicAdd(&SSQ[(tb + tq) * 8 + h * 2], q);
        }
    }
}

__device__ __forceinline__ void mla_naive(const Ctx& C) {
    const bf16_t* QM = WSP(bf16_t, S_QM); const bf16_t* KM = WSP(bf16_t, S_KM); const bf16_t* VM = WSP(bf16_t, S_VM); bf16_t* Y = WSP(bf16_t, S_Y); const int lane = C.lane;
    for (int item = GW; item < T * 4; item += NGW) {
        const int t = item >> 2, h = item & 3, tq = t % SEQ; const size_t tb = (size_t)(t - tq);
        float q[96];
        { const bf16_t* qp = QM + (size_t)t * 384 + h * 96;
#pragma unroll
          for (int i = 0; i < 12; ++i) { const u32x4 w = *(const u32x4*)(qp + 8 * i); q[8*i] = bflo(w.x); q[8*i+1] = bfhi(w.x); q[8*i+2] = bflo(w.y); q[8*i+3] = bfhi(w.y); q[8*i+4] = bflo(w.z); q[8*i+5] = bfhi(w.z); q[8*i+6] = bflo(w.w); q[8*i+7] = bfhi(w.w); } }
        float o[64];
#pragma unroll
        for (int d = 0; d < 64; ++d) o[d] = 0.f;
        float m = -1.0e30f, lsum = 0.f;
        for (int c = tq >> 6; c >= 0; --c) {
            const int key = c * 64 + lane; const bool ok = key <= tq;
            const bf16_t* kp = KM + (tb + (ok ? key : 0)) * 384 + h * 96; const bf16_t* vp = VM + (tb + (ok ? key : 0)) * 256 + h * 64;
            float z = 0.f;
#pragma unroll
            for (int i = 0; i < 12; ++i) { const u32x4 w = *(const u32x4*)(kp + 8 * i);
                z += q[8*i] * bflo(w.x) + q[8*i+1] * bfhi(w.x) + q[8*i+2] * bflo(w.y) + q[8*i+3] * bfhi(w.y) + q[8*i+4] * bflo(w.z) + q[8*i+5] * bfhi(w.z) + q[8*i+6] * bflo(w.w) + q[8*i+7] * bfhi(w.w); }
            z = ok ? z : -1.0e30f;
            float cm = z;
#pragma unroll
            for (int dd = 1; dd < 64; dd <<= 1) cm = fmaxf(cm, __shfl_xor(cm, dd));
            const float mn = fmaxf(m, cm), al = fexp2(m - mn), pw = ok ? fexp2(z - mn) : 0.f; m = mn; lsum = lsum * al + pw;
#pragma unroll
            for (int i = 0; i < 8; ++i) { const u32x4 w = *(const u32x4*)(vp + 8 * i);
                o[8*i] = o[8*i] * al + pw * bflo(w.x); o[8*i+1] = o[8*i+1] * al + pw * bfhi(w.x); o[8*i+2] = o[8*i+2] * al + pw * bflo(w.y); o[8*i+3] = o[8*i+3] * al + pw * bfhi(w.y);
                o[8*i+4] = o[8*i+4] * al + pw * bflo(w.z); o[8*i+5] = o[8*i+5] * al + pw * bfhi(w.z); o[8*i+6] = o[8*i+6] * al + pw * bflo(w.w); o[8*i+7] = o[8*i+7] * al + pw * bfhi(w.w); }
        }
        const float lt = wave_sum(lsum); float mine = 0.f;
#pragma unroll
        for (int d = 0; d < 64; ++d) { const float sdd = wave_sum(o[d]); if (lane == d) mine = sdd; }
        Y[(size_t)t * 1024 + 768 + h * 64 + lane] = (bf16_t)(cvt_pk_bf16(mine / lt, 0.f) & 0xffffu);
    }
}
__device__ __forceinline__ void xattn_naive(const Ctx& C, int l) {
    const bf16_t* XQ = WSP(bf16_t, S_XQ); const bf16_t* KMEM = WSP(bf16_t, W_KMEM) + (size_t)l * NMEM * 1024; const bf16_t* VT = WSP(bf16_t, W_VMEMT) + (size_t)l * 1024 * NMEM; bf16_t* XO = WSP(bf16_t, S_XO); const int lane = C.lane;
    for (int item = GW; item < T * 4; item += NGW) {
        const int t = item >> 2, h = item & 3, b = t / SEQ;
        float z[4] = {0.f, 0.f, 0.f, 0.f};
        for (int d8 = 0; d8 < 32; ++d8) { const u32x4 qw = *(const u32x4*)(XQ + (size_t)t * 1024 + h * 256 + 8 * d8);
            const float qv[8] = {bflo(qw.x), bfhi(qw.x), bflo(qw.y), bfhi(qw.y), bflo(qw.z), bfhi(qw.z), bflo(qw.w), bfhi(qw.w)};
#pragma unroll
            for (int j = 0; j < 4; ++j) { const u32x4 kw = *(const u32x4*)(KMEM + (size_t)(b * 256 + lane + 64 * j) * 1024 + h * 256 + 8 * d8);
                z[j] += qv[0] * bflo(kw.x) + qv[1] * bfhi(kw.x) + qv[2] * bflo(kw.y) + qv[3] * bfhi(kw.y) + qv[4] * bflo(kw.z) + qv[5] * bfhi(kw.z) + qv[6] * bflo(kw.w) + qv[7] * bfhi(kw.w); } }
        float mx = fmaxf(fmaxf(z[0], z[1]), fmaxf(z[2], z[3]));
#pragma unroll
        for (int dd = 1; dd < 64; dd <<= 1) mx = fmaxf(mx, __shfl_xor(mx, dd));
        float p[4], ps = 0.f;
#pragma unroll
        for (int j = 0; j < 4; ++j) { p[j] = fexp2(z[j] - mx); ps += p[j]; }
        const float inv = 1.0f / wave_sum(ps);
        float o[4] = {0.f, 0.f, 0.f, 0.f};
        for (int mm = 0; mm < 256; ++mm) { const float pm = __shfl(p[mm >> 6], mm & 63);
#pragma unroll
            for (int jd = 0; jd < 4; ++jd) o[jd] += pm * bf2f(VT[(size_t)(h * 256 + lane + 64 * jd) * NMEM + b * 256 + mm]); }
#pragma unroll
        for (int jd = 0; jd < 4; ++jd) XO[(size_t)t * 1024 + h * 256 + lane + 64 * jd] = (bf16_t)(cvt_pk_bf16(o[jd] * inv, 0.f) & 0xffffu);
    }
}
__device__ __forceinline__ void ph_mixers(const Ctx& C, int l, int rep = 0) {
    unsigned* head = (unsigned*)(C.ws + WS_CTL) + CW_QUEUE + 64 * (l + 2 * rep);
    volatile LAS unsigned* slot = (volatile LAS unsigned*)(C.lds + LDSCTL_OFF + 64);
#ifdef TIME_VAR
    const unsigned var = __builtin_amdgcn_readfirstlane(__hip_atomic_load((const unsigned*)(C.ws + WS_CTL) + 200000, RLX_AGENT)) & 0xffu;
#else
    const unsigned var = 0u;
#endif
    constexpr int N_RW = 128, N_ATT = 768, N_CV = 384, NITEMS = N_RW + N_ATT + N_CV;
    const int cv_total = l == 0 ? tjobs_total<MIXJ0, 2>(C) : tjobs_total<MIXJ1, 3>(C), cv_chunk = (cv_total + N_CV - 1) / N_CV;
    for (;;) {
        __syncthreads();
        if (C.tid == 0) slot[0] = __hip_atomic_fetch_add(head, 1u, RLX_AGENT);
        __syncthreads();
        const int it = (int)slot[0];
        if (it >= NITEMS) break;
#ifndef NAIVE_SCAN
#define NAIVE_SCAN 0
#endif
        if (it < N_RW) { if (!(NAIVE_SCAN & 1) && !(var & 1u)) { rwkv_unit(C, l, it >> 3, (it >> 1) & 3, it & 1);
#ifdef TIME_RW2
            __syncthreads(); rwkv_unit(C, l, it >> 3, (it >> 1) & 3, it & 1);
#endif
        } }
        else if ((it - N_RW) % 3 == 2) { const int c0 = ((it - N_RW) / 3) * cv_chunk, c1 = min(c0 + cv_chunk, cv_total);
            if (var == 0u) { if (l == 0) run_tjobs_range<MIXJ0, 2>(C, c0 + C.wave, NWAVES, c1); else run_tjobs_range<MIXJ1, 3>(C, c0 + C.wave, NWAVES, c1); } }
        else { const int k = ((it - N_RW) / 3) * 2 + (it - N_RW) % 3; const int mode = k >> 8, kk_ = k & 255, pp = kk_ & 3, bh = kk_ >> 2, b = bh >> 2, h = bh & 3;
            if (mode == 0) { if (!(NAIVE_SCAN & 2) && !(var & 2u)) { attn_unit<2>(C, l, b, h, 7 - pp, var); __syncthreads(); attn_unit<2>(C, l, b, h, pp, var);
#ifdef TIME_SSDA2
                __syncthreads(); attn_unit<2>(C, l, b, h, 7 - pp); __syncthreads(); attn_unit<2>(C, l, b, h, pp);
#endif
            } }
#ifndef NAIVE_SB
            else if (mode == 2) { if (!(var & 8u)) { attn_unit<0>(C, l, b, h, 7 - pp, var); __syncthreads(); attn_unit<0>(C, l, b, h, pp, var); }
#ifdef TIME_SB2
                __syncthreads(); attn_unit<0>(C, l, b, h, 7 - pp); __syncthreads(); attn_unit<0>(C, l, b, h, pp);
#endif
            }
#else
            else if (mode == 2) { }
#endif
#ifndef NAIVE_MLA
            else { if (!(var & 4u)) { attn_unit<1>(C, l, b, h, 7 - pp, var); __syncthreads(); attn_unit<1>(C, l, b, h, pp, var); }
#ifdef TIME_MLA2
                __syncthreads(); attn_unit<1>(C, l, b, h, 7 - pp); __syncthreads(); attn_unit<1>(C, l, b, h, pp);
#endif
            }
#else
            else { }
#endif
        }
    }
#ifdef NAIVE_SB
    sb_naive(C);
#endif
#ifdef NAIVE_MLA
    mla_naive(C);
#endif
    if (NAIVE_SCAN & 1) rwkv_naive(C, l);
    if (NAIVE_SCAN & 2) ssd_naive(C, l);
}
__device__ __forceinline__ void ph_router(const Ctx& C, const bf16_t* src16, bf16_t* dstb, const float* g, const float* b) {
#ifdef TIME_VAR
    const unsigned var = __builtin_amdgcn_readfirstlane(__hip_atomic_load((const unsigned*)(C.ws + WS_CTL) + 200000, RLX_AGENT)) & 0xffu;
#else
    const unsigned var = 0u;
#endif
    LAS unsigned* lc = (LAS unsigned*)(C.lds + XCH_OFF);
    if (C.tid < 8) lc[C.tid] = 0u;
    __syncthreads();
    const float* rt = C.in[I_ROUTER]; int* topi = WSP(int, S_TOPI); float* topw = WSP(float, S_TOPW); const int lane = C.lane;
    f32x4 gv[4], bv[4];
#pragma unroll
    for (int j = 0; j < 4; ++j) { gv[j] = *(const f32x4*)(g + 4 * lane + 256 * j); bv[j] = *(const f32x4*)(b + 4 * lane + 256 * j); }
    u32x2 nx[4];
#define RT_LOAD(kk_) do { const int t_ = C.bid * 128 + C.wave * 16 + (kk_); _Pragma("unroll") for (int j = 0; j < 4; ++j) nx[j] = *(const u32x2*)(src16 + (size_t)t_ * 1024 + 4 * lane + 256 * j); } while (0)
    RT_LOAD(0);
    f32x4 rw0[16], rw1[16];
#pragma unroll
    for (int jq = 0; jq < 16; ++jq) { const float* rp = rt + (size_t)(4 * lane + 256 * (jq >> 2) + (jq & 3)) * 8; rw0[jq] = *(const f32x4*)rp; rw1[jq] = *(const f32x4*)(rp + 4); }
    for (int k = 0; k < ((var & 2u) ? 0 : 16); ++k) {
        const int t = C.bid * 128 + C.wave * 16 + k; float a[8]; f32x4 xv4[4]; float s = 0.f;
#pragma unroll
        for (int j = 0; j < 4; ++j) { xv4[j] = (f32x4){bflo(nx[j].x), bfhi(nx[j].x), bflo(nx[j].y), bfhi(nx[j].y)}; s += (xv4[j][0] + xv4[j][1]) + (xv4[j][2] + xv4[j][3]); }
        if (k + 1 < 16) RT_LOAD(k + 1);
        const float mean = wave_sum(s) * (1.0f / 1024.0f); float s2 = 0.f;
#pragma unroll
        for (int j = 0; j < 4; ++j) { xv4[j] = xv4[j] - mean; s2 += (xv4[j][0] * xv4[j][0] + xv4[j][1] * xv4[j][1]) + (xv4[j][2] * xv4[j][2] + xv4[j][3] * xv4[j][3]); }
        const float rstd = 1.0f / sqrtf(wave_sum(s2) * (1.0f / 1024.0f) + 1e-5f);
#pragma unroll
        for (int j = 0; j < 4; ++j) { xv4[j] = xv4[j] * rstd * gv[j] + bv[j]; st_bf4(dstb + (size_t)t * 1024 + 4 * lane + 256 * j, xv4[j]); }
#pragma unroll
        for (int e = 0; e < 8; ++e) a[e] = 0.f;
#pragma unroll
        for (int jq = 0; jq < 16; ++jq) { const float xq = xv4[jq >> 2][jq & 3]; const f32x4 r0 = rw0[jq], r1 = rw1[jq];
            a[0] += xq * r0[0]; a[1] += xq * r0[1]; a[2] += xq * r0[2]; a[3] += xq * r0[3]; a[4] += xq * r1[0]; a[5] += xq * r1[1]; a[6] += xq * r1[2]; a[7] += xq * r1[3]; }
#pragma unroll
        for (int e = 0; e < 8; ++e) a[e] = wave_sum(a[e]);
#ifdef ROUTER_NOISE
        for (int e = 0; e < 8; ++e) { unsigned hsh = (unsigned)t * 2654435761u + (unsigned)e * 40503u; hsh ^= hsh >> 13; hsh *= 0x5bd1e995u; hsh ^= hsh >> 15; a[e] += ROUTER_NOISE * ((float)(hsh & 0xffff) * (1.0f / 32768.0f) - 1.0f); }
#endif
        if (lane == 0) {
            int i1 = 0; float v1 = a[0];
#pragma unroll
            for (int e = 1; e < 8; ++e) if (a[e] > v1) { v1 = a[e]; i1 = e; }
            int i2 = -1; float v2 = -3.0e38f;
#pragma unroll
            for (int e = 0; e < 8; ++e) if (e != i1 && a[e] > v2) { v2 = a[e]; i2 = e; }
            const float g1 = 1.0f / (1.0f + expf(v2 - v1));
            topi[2 * t] = i1; topi[2 * t + 1] = i2; topw[2 * t] = g1; topw[2 * t + 1] = 1.0f - g1;
            __hip_atomic_fetch_add(&lc[i1], 1u, __ATOMIC_RELAXED, __HIP_MEMORY_SCOPE_WORKGROUP); __hip_atomic_fetch_add(&lc[i2], 1u, __ATOMIC_RELAXED, __HIP_MEMORY_SCOPE_WORKGROUP);
        }
    }
    __syncthreads();
    if (C.tid < 8) ((unsigned*)(C.ws + WS_CTL))[CW_MOECNT + C.bid * 8 + C.tid] = lc[C.tid];
}
__device__ __forceinline__ void ph_scatter(const Ctx& C) {
    LAS int* sh = (LAS int*)(C.lds + XCH_OFF);
    const unsigned* cnt = (const unsigned*)(C.ws + WS_CTL) + CW_MOECNT;
    int* row_slot = WSP(int, S_ROWSLOT); float* row_w = WSP(float, S_ROWW); int* blk_e = WSP(int, S_BLKE);
    const int* topi = WSP(int, S_TOPI); const float* topw = WSP(float, S_TOPW);
    const int tid = C.tid;
    if (tid < 48) sh[tid] = 0;
    __syncthreads();
    { const int wg = tid & 255, e0 = (tid >> 8) * 4; const u32x4 c4 = *(const u32x4*)(cnt + wg * 8 + e0);
      const unsigned cv[4] = {c4.x, c4.y, c4.z, c4.w};
#pragma unroll
      for (int j = 0; j < 4; ++j) { __hip_atomic_fetch_add(&sh[e0 + j], (int)cv[j], __ATOMIC_RELAXED, __HIP_MEMORY_SCOPE_WORKGROUP); if (wg < C.bid) __hip_atomic_fetch_add(&sh[8 + e0 + j], (int)cv[j], __ATOMIC_RELAXED, __HIP_MEMORY_SCOPE_WORKGROUP); } }
    __syncthreads();
    if (tid == 0) { int ps = 0; for (int e = 0; e < 8; ++e) { sh[16 + e] = ps; const int pad = (sh[e] + 255) / 256 * 256; sh[24 + e] = pad; ps += pad; } sh[40] = ps / 256; }
    __syncthreads();
    if (C.bid == 0) {
        const int used = sh[40];
        for (int rb = tid; rb < MOE_BLOCKS; rb += NTHREADS) { int e = 7; if (rb < used) { e = 0; for (int q = 1; q < 8; ++q) if (sh[16 + q] <= rb * 256) e = q; } blk_e[rb] = e; }
        if (tid == 0) blk_e[MOE_BLOCKS] = used;
    }
    if (C.bid < 8) { const int e = C.bid; for (int r = sh[16 + e] + sh[e] + tid; r < sh[16 + e] + sh[24 + e]; r += NTHREADS) { row_slot[r] = -1; row_w[r] = 0.f; } }
    if (tid < 256) { const int t = C.bid * 128 + (tid >> 1), k = tid & 1, e = topi[2 * t + k];
        const int pos = __hip_atomic_fetch_add(&sh[32 + e], 1, __ATOMIC_RELAXED, __HIP_MEMORY_SCOPE_WORKGROUP); const int dest = sh[16 + e] + sh[8 + e] + pos; row_slot[dest] = 2 * t + k; row_w[dest] = topw[2 * t + k]; sh[64 + tid] = dest; }
    __syncthreads();
    const bf16_t* xb = WSP(bf16_t, W_XB); bf16_t* xs = WSP(bf16_t, S_XS);
    { u32x4 va[2][2]; const int a0 = C.wave * 32;
#define SC_LOAD(buf, a_) do { _Pragma("unroll") for (int u = 0; u < 2; ++u) { const int t_ = C.bid * 128 + (((a_) + u) >> 1); _Pragma("unroll") for (int j = 0; j < 2; ++j) buf[u][j] = *(const u32x4*)(xb + (size_t)t_ * 1024 + (C.lane + 64 * j) * 8); } } while (0)
#define SC_STORE(buf, a_) do { _Pragma("unroll") for (int u = 0; u < 2; ++u) { const size_t d_ = (size_t)sh[64 + (a_) + u] * 1024; _Pragma("unroll") for (int j = 0; j < 2; ++j) *(u32x4*)(xs + d_ + (C.lane + 64 * j) * 8) = buf[u][j]; } } while (0)
      u32x4 vb[2][2];
      SC_LOAD(va, a0);
      for (int a = a0; a < a0 + 32; a += 4) { SC_LOAD(vb, a + 2); SC_STORE(va, a); if (a + 4 < a0 + 32) SC_LOAD(va, a + 4); SC_STORE(vb, a + 2); }
#undef SC_LOAD
#undef SC_STORE
    }
}


__device__ __forceinline__ void chk_moe(const Ctx& C, int bit) {
    const float* xr = WSP(float, W_XRES); const float* rt = C.in[I_ROUTER]; const float* w13 = C.in[I_MOE13]; const float* w2 = C.in[I_MOE2]; const bf16_t* ys = WSP(bf16_t, S_YS);
    LAS float* hb = (LAS float*)(C.lds + C.wave * 14336); const int lane = C.lane; unsigned bad = 0;
    float* stash = WSP(float, W_KMEM); const float* g3 = C.in[I_LN3G] + 1024; const float* b3 = C.in[I_LN3B] + 1024;
    for (int s = GW; s < 1024; s += NGW) {
        const int t = (int)(((long)s * 1021 + 7) % T); float x[16];
#pragma unroll
        for (int j = 0; j < 16; ++j) x[j] = xr[(size_t)t * 1024 + lane + 64 * j];
        float lg[8];
#pragma unroll
        for (int e = 0; e < 8; ++e) { float a = 0.f;
#pragma unroll
            for (int j = 0; j < 16; ++j) a += x[j] * rt[(size_t)(lane + 64 * j) * 8 + e]; lg[e] = wave_sum(a); }
        int i1 = 0; for (int e = 1; e < 8; ++e) if (lg[e] > lg[i1]) i1 = e;
        int i2 = -1; for (int e = 0; e < 8; ++e) if (e != i1 && (i2 < 0 || lg[e] > lg[i2])) i2 = e;
        float v3 = -3.0e38f; for (int e = 0; e < 8; ++e) if (e != i1 && e != i2) v3 = fmaxf(v3, lg[e]);
        if (lg[i2] - v3 < 0.02f) { if (lane == 0) stash[(size_t)s * 1024] = 1.0e30f; continue; }
        const float g1 = 1.0f / (1.0f + expf(lg[i2] - lg[i1]));
        float out[16];
#pragma unroll
        for (int j = 0; j < 16; ++j) out[j] = 0.f;
        for (int q = 0; q < 2; ++q) { const int e = q ? i2 : i1; const float gw = q ? 1.0f - g1 : g1; const float* W1 = w13 + (size_t)e * 1024 * 2 * FFE;
            for (int i0 = 0; i0 < 56; i0 += 4) { float ag[4], au[4];
#pragma unroll
                for (int i = 0; i < 4; ++i) { ag[i] = 0.f; au[i] = 0.f; }
                for (int k = 0; k < 1024; ++k) { const float xk = __shfl(x[k >> 6], k & 63); const float* wr = W1 + (size_t)k * 2 * FFE + lane + 64 * i0;
#pragma unroll
                    for (int i = 0; i < 4; ++i) { ag[i] += xk * wr[64 * i]; au[i] += xk * wr[FFE + 64 * i]; } }
#pragma unroll
                for (int i = 0; i < 4; ++i) hb[lane + 64 * (i0 + i)] = (ag[i] / (1.0f + expf(-ag[i]))) * au[i]; }
            LDS_WAIT();
            const float* W2 = w2 + (size_t)e * FFE * 1024;
            for (int hh = 0; hh < FFE; ++hh) { const float hv = hb[hh] * gw;
#pragma unroll
                for (int j = 0; j < 16; ++j) out[j] += hv * W2[(size_t)hh * 1024 + lane + 64 * j]; }
            LDS_WAIT(); }
#pragma unroll
        for (int j = 0; j < 16; ++j) { const int c = lane + 64 * j; const float got = bf2f(ys[(size_t)(2 * t) * 1024 + c]) + bf2f(ys[(size_t)(2 * t + 1) * 1024 + c]);
            if (fabsf(got - out[j]) > 0.05f * fabsf(out[j]) + 0.03f) bad = 1; }
        { float v[16], sm = 0.f, s2 = 0.f;
#pragma unroll
          for (int j = 0; j < 16; ++j) { v[j] = x[j] * DN_ALPHA + out[j]; sm += v[j]; }
          const float mean = wave_sum(sm) * (1.0f / 1024.0f);
#pragma unroll
          for (int j = 0; j < 16; ++j) { v[j] -= mean; s2 += v[j] * v[j]; }
          const float rstd = 1.0f / sqrtf(wave_sum(s2) * (1.0f / 1024.0f) + 1e-5f);
          int zz = 0; asm volatile("" : "+v"(zz));
#pragma unroll
          for (int j = 0; j < 16; ++j) { const int c = lane + 64 * j + zz; stash[(size_t)s * 1024 + c] = v[j] * rstd * g3[c] + b3[c]; } }
    }
    chk_flag(C, bit, bad);
}
#ifndef ABL_MIX
#define ABL_MIX 1.0f
#endif
#ifndef ABL_XA
#define ABL_XA 1.0f
#endif
#ifndef ABL_FF
#define ABL_FF 1.0f
#endif
#ifndef CHK_TOL2
#define CHK_TOL2 0.05f
#endif
#ifndef GATE_ACT
#define GATE_ACT 1
#endif
#ifndef GATE_ALIGN
#define GATE_ALIGN true
#endif
#ifndef FG_TOL
#define FG_TOL 0.05f
#endif
#ifndef FG_BIT
#define FG_BIT 1
#endif
#ifndef CHECKS_LAYER
#define CHECKS_LAYER 0
#endif
#ifndef MK_SPLIT
#define MK_SPLIT 0
#endif
constexpr int PH_L0 = 1, PH_L1 = 16, PH_MOE = 28, PH_TOTAL = PH_MOE + 1 + 2 * MOE_PASSES + 1;

__global__ void __launch_bounds__(NTHREADS, 2) hybrid_fwd(Args args) {
    extern __shared__ __attribute__((aligned(16))) unsigned char lds_raw[];
    Ctx C; C.in = args.in; C.out = args.out; C.ws = args.ws; C.lds = (LAS unsigned char*)lds_raw;
    C.tid = threadIdx.x; C.lane = C.tid & 63; C.wave = __builtin_amdgcn_readfirstlane(C.tid >> 6); C.G = gridDim.x; C.bid = blockIdx.x;
    const Ctx C0 = C;
    for (int u = C.tid; u < (LDS_BYTES - LDSCTL_OFF) / 4; u += NTHREADS) ((LAS unsigned*)(C.lds + LDSCTL_OFF))[u] = 0u;
    __syncthreads();
    const int lo = args.ph_lo, hi = args.ph_hi;
    XcdBarrier bar; bar.bar = (unsigned*)(C.ws + WS_CTL) + CW_BAR; bar.x = 0; bar.st = (volatile LAS unsigned*)(C.lds + LDSCTL_OFF);
    if (hi - lo > 1) bar = xcd_barrier_post((unsigned*)(C.ws + WS_CTL) + CW_BAR, (volatile LAS unsigned*)(C.lds + LDSCTL_OFF));
#ifndef SITE_MASK
#define SITE_MASK 0xffffffffu
#endif
#define SITE(n) (((SITE_MASK) >> (n)) & 1u)
#define IN(k) (lo <= (k) && (k) < hi)
#define ENDPH(k) do { if ((k) + 1 < hi) xcd_barrier(bar); } while (0)
#define SITE_BEGIN const Ctx C = launder(C0); unsigned char* LW = C.ws + W_BASE + (size_t)l * LW_SIZE; const bf16_t* XB = WSP(bf16_t, W_XB); bf16_t* XRES = WSP(bf16_t, W_XRES); (void)LW; (void)XB; (void)XRES; LAS unsigned char* ring = C.lds; (void)ring;

    if (SITE(0) && IN(0)) { const int l = 0; SITE_BEGIN ph_prologue(C);
#ifdef TIME_PRO2
        xcd_barrier(bar); ph_prologue(C);
#endif
#ifdef TIME_BAR
        for (int q_ = 0; q_ < TIME_BAR; ++q_) xcd_barrier(bar);
#endif
        ENDPH(0); }

    for (int l = 0; l < 2; ++l) {
        const int pb = l == 0 ? PH_L0 : PH_L1;
        if (SITE(1) && IN(pb + 0)) { SITE_BEGIN
#ifdef CHECKS3
            if (l == 1) chk_ln_cmp(C, 1, 1);
#endif
            { pg8::Gemm g{XB, (const bf16_t*)(LW + LW_WIN), 1024, 1024, 1024}; sch::Tiles S{T / 256, NPROJ / 256, C.G, C.bid}; epi::StoreBf16<0> E{WSP(bf16_t, S_PROJ), NPROJ}; pg8::gemm_phase(ring, g, S, E); }
            { pg8::Gemm g{(const bf16_t*)C.ws, (const bf16_t*)C.ws, 1024, 1024, 1024}; sch::MemKV S{(long)(W_MEMB / 2), (long)((W_BASE + (size_t)l * LW_SIZE + LW_WKV) / 2), C.bid};
              epi::StoreBf16<0> E{WSP(bf16_t, W_KMEM) + (size_t)l * NMEM * 2048, 2048}; pg8::gemm_phase(ring, g, S, E); }
            ENDPH(pb + 0);
        }
        if (SITE(2) && IN(pb + 1)) { SITE_BEGIN
#ifdef CHECKS5
            if (l == 0) chk_weights<28, false>(C, 0);
#endif
#ifdef CHECKS9
            if (l == 0) { unsigned bad = 0; const float* x = C.in[I_X]; const float* mm = C.in[I_MEM]; const bf16_t* mb = WSP(bf16_t, W_MEMB);
                for (size_t i = (size_t)C.bid * NTHREADS + C.tid; i < (size_t)T * 1024; i += (size_t)C.G * NTHREADS) if (!chk_close(x[i], bf2f(XB[i]))) bad = 1;
                for (size_t i = (size_t)C.bid * NTHREADS + C.tid; i < (size_t)NMEM * 1024; i += (size_t)C.G * NTHREADS) if (!chk_close(mm[i], bf2f(mb[i]))) bad = 1;
                if (bad) __hip_atomic_fetch_add((unsigned*)(C.ws + WS_CTL) + CW_CHK, 1u, RLX_AGENT); }
#endif
#ifdef CHECKS12P
            if (l == CHECKS_LAYER) { const bf16_t* proj = WSP(bf16_t, S_PROJ); chk_full_gemm(C, XB, (const bf16_t*)(LW + LW_WIN), 1024, 3236, 0, [&](size_t r, int c, float d) { return chk_close(d, bf2f(proj[r * NPROJ + c])); }); xcd_barrier(bar); }
#endif
#ifdef CHECKS4
            if (l == CHECKS_LAYER) { const bf16_t* KM_ = WSP(bf16_t, W_KMEM) + (size_t)l * NMEM * 1024; const bf16_t* VT_ = WSP(bf16_t, W_VMEMT) + (size_t)l * 1024 * NMEM;
                chk_gemm(C, WSP(bf16_t, W_MEMB), 1024, (const bf16_t*)(LW + LW_WKV), 1024, 1024, NMEM, 64, 16, 3, 0, [&](int r, int c, float d) { return chk_close(d, bf2f(KM_[(size_t)r * 1024 + c])); });
                chk_gemm(C, (const bf16_t*)(LW + LW_WKV) + (size_t)1024 * 1024, 1024, WSP(bf16_t, W_MEMB), 1024, 1024, 1024, 256, 16, 5, 1, [&](int r, int c, float d) { return chk_close(d, bf2f(VT_[(size_t)r * NMEM + c])); }); }
#endif
#ifdef CHECKS
            if (l == CHECKS_LAYER) { const bf16_t* proj = WSP(bf16_t, S_PROJ); chk_gemm(C, XB, 1024, (const bf16_t*)(LW + LW_WIN), 1024, 1024, T, 13, 256, 7, 0, [&](int r, int c, float d) { return chk_close(d, bf2f(proj[(size_t)r * NPROJ + c])); }); }
#endif
            ph_prep(C, l);
#ifdef TIME_PREP2
            xcd_barrier(bar); ph_prep(C, l);
#endif
            ENDPH(pb + 1); }
        if (SITE(3) && IN(pb + 2)) { SITE_BEGIN
            { pg8::Gemm g{WSP(bf16_t, S_LA), (const bf16_t*)(LW + LW_LORA), 256, 256, 256}; sch::Tiles S{T / 256, 3, C.G, C.bid}; epi::Lora E{WSP(float, S_DEC), WSP(bf16_t, S_AV), WSP(bf16_t, S_GV), C.in[I_RWW0] + l * 256, C.in[I_RWA0] + l * 256}; pg8::gemm_phase(ring, g, S, E); }
            { pg8::Gemm g{WSP(bf16_t, S_CQN), (const bf16_t*)(LW + LW_WUQ), 256, 256, 256}; sch::Tiles S{T / 256, 2, C.G, (C.bid + 128) & 255}; epi::Uq E{WSP(bf16_t, S_QM), WSP(float, W_COS), WSP(float, W_SIN)}; pg8::gemm_phase(ring, g, S, E); }
            { pg8::Gemm g{WSP(bf16_t, S_CKVN), (const bf16_t*)(LW + LW_WUKV), 128, 128, 128}; sch::Tiles S{T / 256, 2, C.G, C.bid}; epi::Ukv E{WSP(bf16_t, S_KM), WSP(bf16_t, S_VM)}; pg8::gemm_phase(ring, g, S, E); }
            ENDPH(pb + 2);
        }
        if (SITE(4) && IN(pb + 3)) { SITE_BEGIN ph_rwprep(C, l); ph_ssdprep(C, l);
#ifdef TIME_RWP2
            xcd_barrier(bar); ph_rwprep(C, l); ph_ssdprep(C, l);
#endif
            ENDPH(pb + 3); }
        if (SITE(5) && IN(pb + 4)) { SITE_BEGIN
#ifdef CHECKS6
            if (l == CHECKS_LAYER) chk_mla_inputs(C, l, 0);
#endif
#ifdef CHECKS7
            if (l == CHECKS_LAYER) chk_rw_inputs(C, l, 0);
#endif
            ph_mixers(C, l);
#ifdef TIME_MIX2
            xcd_barrier(bar); ph_mixers(C, l, 1);
#endif
            ENDPH(pb + 4); }
        if (SITE(6) && IN(pb + 5)) { SITE_BEGIN
            ph_ssdfix(C, l);
            { pg8::Gemm g{XB, (const bf16_t*)(LW + LW_WGATE), 1024, 1024, 1024}; sch::Tiles S{T / 256, 16, C.G, C.bid}; epi::StoreBf16<GATE_ACT> E{WSP(bf16_t, S_G), 4096}; pg8::gemm_phase<epi::StoreBf16<GATE_ACT>, sch::Tiles, GATE_ALIGN>(ring, g, S, E);
#ifdef TIME_GATE2
              xcd_barrier(bar); pg8::gemm_phase<epi::StoreBf16<GATE_ACT>, sch::Tiles, GATE_ALIGN>(ring, g, S, E);
#endif
            }
#ifdef CHECKS14
            if (l == 0) { xcd_barrier(bar); const bf16_t* Gp = WSP(bf16_t, S_G); chk_full_gemm(C, XB, (const bf16_t*)(LW + LW_WGATE), 1024, 4096, 0, [&](size_t r, int c, float d) { return chk_close(sigmoidf_(d), bf2f(Gp[r * 4096 + c])); }); }
#endif
#ifdef CHECKS13
            if (l == 0) { xcd_barrier(bar);
              { pg8::Gemm g{XB, (const bf16_t*)(LW + LW_WGATE), 1024, 1024, 1024}; sch::Tiles S{T / 256, 16, C.G, C.bid}; epi::StoreBf16<1> E{WSP(bf16_t, S_G) + (size_t)T * 4096, 4096}; pg8::gemm_phase(ring, g, S, E); }
              xcd_barrier(bar);
              { const unsigned short* g1 = WSP(unsigned short, S_G); const unsigned short* g2 = g1 + (size_t)T * 4096; unsigned cnt = 0;
                for (size_t i = (size_t)C.bid * NTHREADS + C.tid; i < (size_t)T * 4096; i += (size_t)C.G * NTHREADS) if (g1[i] != g2[i]) ++cnt;
                if (cnt) __hip_atomic_fetch_add((unsigned*)(C.ws + WS_CTL) + CW_CHK + 2048, cnt, RLX_AGENT); } }
#endif
            ENDPH(pb + 5);
        }
        if (SITE(7) && IN(pb + 6)) { SITE_BEGIN
#ifdef FIX_G
            { bf16_t* Gw = WSP(bf16_t, S_G); const bf16_t* Wg = (const bf16_t*)(LW + LW_WGATE);
              for (size_t i = (size_t)C.bid * NTHREADS + C.tid; i < (size_t)T * 4096; i += (size_t)C.G * NTHREADS) { const size_t r = i >> 12; const int c = (int)(i & 4095);
                  Gw[i] = (bf16_t)(cvt_pk_bf16(sigmoidf_(tdot(XB + r * 1024, Wg + (size_t)c * 1024, 1024)), 0.f) & 0xffffu); }
              xcd_barrier(bar); }
#endif
#ifdef CHECKS15
            if (l == 0) { unsigned cnt = 0; const float* x = C.in[I_X];
                for (size_t i = (size_t)C.bid * NTHREADS + C.tid; i < (size_t)T * 1024; i += (size_t)C.G * NTHREADS) if (!chk_close(x[i], bf2f(XB[i]))) ++cnt;
                if (cnt) __hip_atomic_fetch_add((unsigned*)(C.ws + WS_CTL) + CW_CHK + 2048, cnt, RLX_AGENT); }
#endif
#ifdef CHECKS7
            if (l == CHECKS_LAYER) chk_ssd_norm(C, l, 1);
#endif
#ifdef CHECKS12
            if (l == CHECKS_LAYER) { const bf16_t* Gp = WSP(bf16_t, S_G); chk_full_gemm(C, XB, (const bf16_t*)(LW + LW_WGATE), 1024, 4096, FG_BIT, [&](size_t r, int c, float d) { return fabsf((GATE_ACT ? sigmoidf_(d) : d) - bf2f(Gp[r * 4096 + c])) <= FG_TOL; }); xcd_barrier(bar); }
#endif
#ifdef CHECKS
            if (l == CHECKS_LAYER) { const bf16_t* Gp = WSP(bf16_t, S_G); chk_gemm(C, XB, 1024, (const bf16_t*)(LW + LW_WGATE), 1024, 1024, T, 16, 256, 5, 1, [&](int r, int c, float d) { return chk_close(sigmoidf_(d), bf2f(Gp[(size_t)r * 4096 + c])); }); }
#endif
#ifdef BR_FULL
            { pg8::Gemm g{WSP(bf16_t, S_Y), (const bf16_t*)(LW + LW_WBR), 256, 1024, 256}; sch::BrTiles S{T / 256, 4, C.G, C.bid}; epi::BrGate E{WSP(bf16_t, S_G), WSP(float, S_MF), WSP(bf16_t, S_MB)}; pg8::gemm_phase(ring, g, S, E);
#else
            { pg8::Gemm g{WSP(bf16_t, S_Y), (const bf16_t*)(LW + LW_WBR), 256, 1024, 256}; sch::BrTilesH S{T / 256, 8, C.G, C.bid}; epi::BrGateH E; E.G = WSP(bf16_t, S_G); E.mb = WSP(bf16_t, S_MB); E.init(); pg8::gemm_phase_hn(ring, g, S, E);
#endif
#ifdef TIME_BR2
              xcd_barrier(bar); pg8::gemm_phase(ring, g, S, E);
#endif
            }
            ENDPH(pb + 6);
        }
        if (SITE(8) && IN(pb + 7)) { SITE_BEGIN
#ifdef CHECKS2
            if (l == CHECKS_LAYER) chk_merged(C, l, 0);
#endif
            { pg8::Gemm g{WSP(bf16_t, S_MB), (const bf16_t*)(LW + LW_WOUT), 1024, 1024, 1024}; sch::Tiles S{T / 256, 4, C.G, C.bid}; epi::Resid E{C.in[I_X], XRES, ABL_MIX, l == 0 ? nullptr : XB}; pg8::gemm_phase(ring, g, S, E); }
            ENDPH(pb + 7);
        }
        if (SITE(9) && IN(pb + 8)) { SITE_BEGIN
#ifdef CHECKS10
            if (l == 0) { chk_full_p7(C, l, 1); xcd_barrier(bar); }
#endif
#ifdef CHECKS
            if (l == 0) { const float* xin = C.in[I_X]; chk_gemm(C, WSP(bf16_t, S_MB), 1024, (const bf16_t*)(LW + LW_WOUT), 1024, 1024, T, 4, 256, 9, 2, [&](int r, int c, float d) { return fabsf(xin[(size_t)r * 1024 + c] * DN_ALPHA + d - XRES[(size_t)r * 1024 + c]) <= CHK_TOL2; }); }
#endif
            ph_ln<false>(C, nullptr, nullptr, WSP(bf16_t, W_XB), C.in[I_LN1G] + l * 1024, C.in[I_LN1B] + l * 1024, nullptr, XRES);
            { const bf16_t* KV = WSP(bf16_t, W_KMEM) + (size_t)l * NMEM * 2048;
              { pg8::Gemm g{KV, (const bf16_t*)(LW + LW_WQ), 256, 2048, 1024}; sch::AbsM S{C.bid}; epi::StoreAt E{WSP(bf16_t, S_XQ), 1024}; pg8::gemm_phase(ring, g, S, E); }
              { pg8::Gemm g{(const bf16_t*)(LW + LW_WO), KV + 1024, 256, 1024, 2048}; sch::AbsN S{C.bid}; epi::StoreAt E{WSP(bf16_t, S_XO), 1024}; pg8::gemm_phase(ring, g, S, E); } }
#ifdef TIME_LN2
            xcd_barrier(bar); ph_ln<false>(C, nullptr, nullptr, WSP(bf16_t, W_XB), C.in[I_LN1G] + l * 1024, C.in[I_LN1B] + l * 1024, nullptr, XRES);
#endif
            ENDPH(pb + 8); }
        if (SITE(10) && IN(pb + 9)) { SITE_BEGIN
            { pg8::Gemm g{XB, WSP(bf16_t, S_XQ), 1024, 1024, 1024}; sch::XaS S{C.G, C.bid}; epi::Softmax E{WSP(bf16_t, S_XP), (LAS float*)(C.lds + XCH_OFF)}; pg8::gemm_phase(ring, g, S, E); }
            ENDPH(pb + 9);
        }
        if (SITE(13) && IN(pb + 10)) { SITE_BEGIN
            { pg8::Gemm g{WSP(bf16_t, S_XP), WSP(bf16_t, S_XO), 1024, 1024, 1024}; sch::XaO S{C.G, C.bid}; epi::Resid E{nullptr, XRES, ABL_XA, XB}; pg8::gemm_phase(ring, g, S, E); }
            ENDPH(pb + 10);
        }
        if (SITE(14) && IN(pb + 11)) { SITE_BEGIN
#ifdef CHECKS3
            if (l == 0) chk_resid_cmp(C, 0, 2);
#endif
            if (l == 0) ph_ln<false>(C, nullptr, nullptr, WSP(bf16_t, W_XB), C.in[I_LN2G], C.in[I_LN2B], nullptr, XRES);
            else ph_router(C, XRES, WSP(bf16_t, W_XB), C.in[I_LN2G] + 1024, C.in[I_LN2B] + 1024);
            ENDPH(pb + 11); }
        if (l == 0) {
            if (SITE(15) && IN(pb + 12)) { SITE_BEGIN
                { pg8::Gemm g{XB, WSP(bf16_t, W_FFN13), 1024, 1024, 1024}; sch::Tiles S{T / 256, 2 * FFD / 256, C.G, C.bid}; epi::Swiglu E{WSP(bf16_t, S_H), FFD, 0}; pg8::gemm_phase(ring, g, S, E);
#ifdef TIME_UP2
                  for (int rep_ = 0; rep_ < 1; ++rep_) { xcd_barrier(bar); pg8::gemm_phase(ring, g, S, E); }
#endif
                }
                ENDPH(pb + 12);
            }
            if (SITE(16) && IN(pb + 13)) { SITE_BEGIN
#ifdef CHECKS2
                chk_swiglu(C, 1);
#endif
#ifdef CHECKS3
                chk_resid_stash(C, WSP(bf16_t, S_H), FFD, WSP(bf16_t, W_FFN2), FFD, FFD, 0); xcd_barrier(bar);
#endif
                { pg8::Gemm g{WSP(bf16_t, S_H), WSP(bf16_t, W_FFN2), FFD, FFD, FFD}; sch::Tiles S{T / 256, 4, C.G, C.bid}; epi::Resid E{nullptr, XRES, ABL_FF, XB}; pg8::gemm_phase(ring, g, S, E); }
                ENDPH(pb + 13);
            }
            if (SITE(17) && IN(pb + 14)) { SITE_BEGIN
#ifdef CHECKS3
                chk_resid_cmp(C, 0, 0); chk_ln_stash(C, C.in[I_LN3G], C.in[I_LN3B], 1); xcd_barrier(bar);
#endif
                ph_ln<false>(C, nullptr, nullptr, WSP(bf16_t, W_XB), C.in[I_LN3G], C.in[I_LN3B], nullptr, XRES); ENDPH(pb + 14); }
        } else {
            if (SITE(19) && IN(PH_MOE)) { SITE_BEGIN
#ifdef CHECKS5
                chk_weights<16, true>(C, 1);
#endif
                ph_scatter(C); ENDPH(PH_MOE); }
            for (int p = 0; p < MOE_PASSES; ++p) {
                const int* blk_e = WSP(int, S_BLKE);
                if (SITE(20) && IN(PH_MOE + 1 + 2 * p)) { SITE_BEGIN
                    const int used = __builtin_amdgcn_readfirstlane(__hip_atomic_load(blk_e + MOE_BLOCKS, RLX_AGENT)); const int b0 = p * MOE_PASS_BLOCKS, b1 = p == MOE_PASSES - 1 ? used : min(b0 + MOE_PASS_BLOCKS, used);
                    if (b1 > b0) { pg8::Gemm g{WSP(bf16_t, S_XS), (const bf16_t*)C.out, 1024, 1024, 1024}; sch::MoeUp S{blk_e, b0, b1, C.G, C.bid}; epi::Swiglu E{WSP(bf16_t, S_MH), FFE, 1}; pg8::gemm_phase(ring, g, S, E); }
                    ENDPH(PH_MOE + 1 + 2 * p);
                }
                if (SITE(21) && IN(PH_MOE + 2 + 2 * p)) { SITE_BEGIN
                    const int used = __builtin_amdgcn_readfirstlane(__hip_atomic_load(blk_e + MOE_BLOCKS, RLX_AGENT)); const int b0 = p * MOE_PASS_BLOCKS, b1 = p == MOE_PASSES - 1 ? used : min(b0 + MOE_PASS_BLOCKS, used);
                    if (b1 > b0) { pg8::Gemm g{WSP(bf16_t, S_MH), WSP(bf16_t, W_MW2), FFE, FFE, FFE}; sch::MoeDown S{blk_e, b0, b1, C.G, C.bid}; epi::MoeDown E{WSP(int, S_ROWSLOT), WSP(float, S_ROWW), WSP(bf16_t, S_YS)}; pg8::gemm_phase(ring, g, S, E); }
                    ENDPH(PH_MOE + 2 + 2 * p);
                }
            }
            if (SITE(22) && IN(PH_TOTAL - 1)) { SITE_BEGIN
#ifdef CHECKS8
                chk_moe(C, 0); xcd_barrier(bar);
#endif
#define FINAL_LN_SITE 1
 ph_ln<true>(C, nullptr, C.out, nullptr, C.in[I_LN3G] + 1024, C.in[I_LN3B] + 1024, WSP(bf16_t, S_YS), XB);
#ifdef CHECKS11
                xcd_barrier(bar);
                { unsigned cnt = 0; for (size_t i = (size_t)C.bid * NTHREADS + C.tid; i < (size_t)T * 1024; i += (size_t)C.G * NTHREADS) if (fabsf(C.out[i]) > CHK11_THR) ++cnt;
                  if (cnt) __hip_atomic_fetch_add((unsigned*)(C.ws + WS_CTL) + CW_CHK + 2048, cnt, RLX_AGENT); }
                xcd_barrier(bar);
                { unsigned v_ = __hip_atomic_load((const unsigned*)(C.ws + WS_CTL) + CW_CHK + 2048, RLX_AGENT); int n = 0; while (v_ > 0u) { ++n; v_ >>= 1; }
                  const float sc = 1.0f + 0.1f * (float)n; for (size_t i = (size_t)C.bid * NTHREADS + C.tid; i < (size_t)T * 1024; i += (size_t)C.G * NTHREADS) C.out[i] *= sc; }
#endif
#ifdef CHECKS8
                xcd_barrier(bar);
                { const float* stash = WSP(float, W_KMEM); unsigned bad = 0; const float cs = 1.0f; (void)cs;
                  for (int s = GW; s < 1024; s += NGW) { const int t = (int)(((long)s * 1021 + 7) % T); if (stash[(size_t)s * 1024] > 1.0e29f) continue;
                      for (int j = 0; j < 16; ++j) { const int c = C.lane + 64 * j; const float e = stash[(size_t)s * 1024 + c], gt = C.out[(size_t)t * 1024 + c]; if (fabsf(e - gt) > 0.05f * fabsf(e) + 0.05f) bad = 1; } }
                  chk_flag(C, 1, bad); }
                xcd_barrier(bar);
                { const unsigned* cw = (const unsigned*)(C.ws + WS_CTL) + CW_CHK; if (__hip_atomic_load(cw + 64, RLX_AGENT) != 0u) { for (size_t i = (size_t)C.bid * NTHREADS + C.tid; i < (size_t)T * 1024; i += (size_t)C.G * NTHREADS) C.out[i] *= 1.5f; } }
#endif
            }
        }
    }
#undef IN
#undef ENDPH
}

extern "C" void kernel_launch(void* const* d_in, const int* in_sizes, int n_in, void* d_out, int out_size, void* d_ws, size_t ws_size, hipStream_t stream) {
    static int grid = 0;
    if (grid == 0) {
        if (n_in != 42 || in_sizes[0] != T * DM || out_size != T * DM || ws_size < WS_NEED) { fprintf(stderr, "kernel_launch: unexpected problem (n_in %d, in0 %d, out %d, ws %zu < %zu)\n", n_in, n_in > 0 ? in_sizes[0] : -1, out_size, ws_size, (size_t)WS_NEED); grid = -1; return; }
        int dev = 0, cus = 0;
        if (hipGetDevice(&dev) != hipSuccess || hipDeviceGetAttribute(&cus, hipDeviceAttributeMultiprocessorCount, dev) != hipSuccess) { grid = -1; return; }
        if (hipFuncSetAttribute((const void*)hybrid_fwd, hipFuncAttributeMaxDynamicSharedMemorySize, LDS_BYTES) != hipSuccess) { fprintf(stderr, "kernel_launch: hipFuncSetAttribute failed\n"); grid = -1; return; }
        int per_cu = 0;
        if (hipOccupancyMaxActiveBlocksPerMultiprocessor(&per_cu, (const void*)hybrid_fwd, NTHREADS, LDS_BYTES) != hipSuccess || per_cu < 1) fprintf(stderr, "kernel_launch: occupancy query says %d\n", per_cu);
        (void)hipGetLastError();
        if (cus != 256) { fprintf(stderr, "kernel_launch: built for 256 CUs, device has %d\n", cus); grid = -1; return; }
        grid = 256;
    }
    if (grid < 0) return;
#ifdef ZERO_WS
    (void)hipMemsetAsync((char*)d_ws + ZERO_WS_LO, 0, ZERO_WS_HI - ZERO_WS_LO, stream);
#endif
    (void)hipMemsetAsync((char*)d_ws + WS_CTL, 0, CTL_BYTES, stream);
    Args a{};
    for (int i = 0; i < 42; ++i) a.in[i] = (const float*)d_in[i];
    a.out = (float*)d_out; a.ws = (unsigned char*)d_ws;
#if MK_SPLIT
    for (int p = 0; p < PH_TOTAL; ++p) { a.ph_lo = p; a.ph_hi = p + 1; hipLaunchKernelGGL(hybrid_fwd, dim3(grid), dim3(NTHREADS), LDS_BYTES, stream, a); }
#else
    a.ph_lo = 0; a.ph_hi = PH_TOTAL; hipLaunchKernelGGL(hybrid_fwd, dim3(grid), dim3(NTHREADS), LDS_BYTES, stream, a);
#ifdef TIME_LIST
#ifdef TIME_VAR
    (void)hipMemsetAsync((char*)d_ws + WS_CTL + 200000 * 4, TIME_VAR, 4, stream);
#endif
#ifdef TIME_QRESET
    (void)hipMemsetAsync((char*)d_ws + WS_CTL + (CW_QUEUE + 64 * TIME_QRESET) * 4, 0, 4, stream);
#endif
    { const int tl_[] = TIME_LIST; for (int r_ = 0; r_ < TIME_REP; ++r_) for (int q_ = 0; q_ < (int)(sizeof(tl_) / sizeof(int)); ++q_) { a.ph_lo = tl_[q_]; a.ph_hi = tl_[q_] + (tl_[q_] >= 0 ? 1 : 0); hipLaunchKernelGGL(hybrid_fwd, dim3(grid), dim3(NTHREADS), LDS_BYTES, stream, a); } }
#endif
#endif
}
```
